# Optimizing an MI355X kernel written in HIP

```python
import jax, jax.numpy as jnp
from jax import lax
import numpy as np

D_MODEL = 1024
BATCH = 8
SEQ = 2048
DEPTH = 4
DEC_BATCH = 128
DEC_SEQ = 4
PAST_LEN = 16384
PAGE_SIZE = 128

N_META = 16
N_PAIRS = DEPTH // 2
GLA_HEADS = 4
GLA_DK = 64
GLA_DV = 128
GLA_KEY = GLA_HEADS * GLA_DK
GLA_VAL = GLA_HEADS * GLA_DV
GLA_RANK = 16
GLA_GATE_NORM = 16.0
GLA_CHUNK = 16
LRU_WIDTH = 512
LRU_BLOCKS = 8
LRU_BDIM = LRU_WIDTH // LRU_BLOCKS
CONV_W = 4
LRU_C = 8.0
MIX_IN = 2 * GLA_KEY + 2 * GLA_VAL + GLA_RANK + 2 * LRU_WIDTH
MIX_OUT = GLA_VAL + LRU_WIDTH
RWKV_HEAD = 64
RWKV_HEADS = D_MODEL // RWKV_HEAD
DECAY_LORA = 64
AAA_LORA = 64
MV_LORA = 32
GATE_LORA = 128
RWKV_GN_EPS = 64e-5
PEER_HEADS = 8
PEER_NKEYS = 128
PEER_EXPERTS = PEER_NKEYS * PEER_NKEYS
PEER_DKEY = 256
PEER_HALF = PEER_DKEY // 2
PEER_TOPK = 16
PEER_BLOCK = 128
DN_ALPHA = float((2 * DEPTH) ** 0.25)
DN_BETA = float((8 * DEPTH) ** -0.25)
LN_EPS = 1e-5
F32 = jnp.float32

kernel_name = 'hybrid_gla_rglru_rwkv7_peer_step'


def layer_norm(x, g, b):
    xf = x.astype(F32)
    mu = xf.mean(-1, keepdims=True)
    var = jnp.mean(jnp.square(xf - mu), -1, keepdims=True)
    return ((xf - mu) * lax.rsqrt(var + LN_EPS) * g + b).astype(x.dtype)


def split_cols(z, sizes):
    out, o = [], 0
    for s in sizes:
        out.append(z[..., o:o + s])
        o += s
    return out


def gla_chunked(q, k, v, log_a, s0):
    B, T = q.shape[:2]
    n = -(-T // GLA_CHUNK)
    pad = n * GLA_CHUNK - T
    padf = lambda z: jnp.pad(z.astype(F32), ((0, 0), (0, pad), (0, 0), (0, 0)))
    blk = lambda z: z.reshape(B, n, GLA_CHUNK, z.shape[2], z.shape[3]).transpose(1, 0, 3, 2, 4)
    q, k, v, log_a = (blk(padf(z)) for z in (q, k, v, log_a))
    cum = jnp.cumsum(log_a, axis=3)
    last = cum[:, :, :, -1:, :]
    qe = q * jnp.exp(cum)
    ke = k * jnp.exp(-cum)
    kl = k * jnp.exp(last - cum)
    mask = jnp.tril(jnp.ones((GLA_CHUNK, GLA_CHUNK), bool))
    att = jnp.where(mask, jnp.einsum('nbhtd,nbhsd->nbhts', qe, ke), 0.0)
    o_intra = jnp.einsum('nbhts,nbhsv->nbhtv', att, v)
    upd = jnp.einsum('nbhsd,nbhsv->nbhdv', kl, v)
    decay = jnp.exp(last[:, :, :, 0, :])

    def step(S, inp):
        dec, u = inp
        return S * dec[..., None] + u, S

    s_fin, s_prev = lax.scan(step, s0.astype(F32), (decay, upd))
    o_inter = jnp.einsum('nbhtd,nbhdv->nbhtv', qe, s_prev)
    o = (o_intra + o_inter).transpose(1, 0, 3, 2, 4).reshape(B, n * GLA_CHUNK, GLA_HEADS, GLA_DV)[:, :T]
    return o, s_fin


def lru_scan(a, b, h0):
    b = b.at[:, 0].add(a[:, 0] * h0)

    def comb(l, r):
        al, bl = l
        ar, br = r
        return al * ar, ar * bl + br

    _, h = lax.associative_scan(comb, (a, b), axis=1)
    return h, h[:, -1]


def gla_lru_mixer(x, s_gla, h_lru, conv_buf, w_in, w_gate, b_gate, gla_norm, conv_w, conv_b,
                  lru_wa, lru_ba, lru_wx, lru_bx, lru_lambda, w_out):
    B, T, _ = x.shape
    proj = x @ w_in
    q, k, v, g_lr, r, xb, gb = split_cols(proj, [GLA_KEY, GLA_KEY, GLA_VAL, GLA_RANK, GLA_VAL, LRU_WIDTH, LRU_WIDTH])
    log_a = jax.nn.log_sigmoid((g_lr @ w_gate + b_gate).astype(F32)) / GLA_GATE_NORM
    hd = lambda z, d: z.reshape(B, T, GLA_HEADS, d)
    o, s_gla_new = gla_chunked(hd(q, GLA_DK) * GLA_DK ** -0.5, hd(k, GLA_DK), hd(v, GLA_DV), hd(log_a, GLA_DK), s_gla)
    o = o * lax.rsqrt(jnp.mean(jnp.square(o), -1, keepdims=True) + LN_EPS) * gla_norm
    o_gla = o.reshape(B, T, GLA_VAL) * jax.nn.silu(r.astype(F32))
    xcat = jnp.concatenate([conv_buf.astype(xb.dtype), xb], axis=1)
    xc = conv_b + sum(xcat[:, i:i + T] * conv_w[i] for i in range(CONV_W))
    new_buf = xcat[:, T:]
    xr = xc.reshape(B, T, LRU_BLOCKS, LRU_BDIM)
    gate_a = jax.nn.sigmoid((jnp.einsum('btnd,nde->btne', xr, lru_wa).reshape(B, T, LRU_WIDTH) + lru_ba).astype(F32))
    gate_x = jax.nn.sigmoid((jnp.einsum('btnd,nde->btne', xr, lru_wx).reshape(B, T, LRU_WIDTH) + lru_bx).astype(F32))
    log_at = -LRU_C * gate_a * jax.nn.softplus(-lru_lambda.astype(F32))
    a_t = jnp.exp(log_at)
    b_t = jnp.sqrt(-jnp.expm1(2.0 * log_at)) * (gate_x * xc.astype(F32))
    h, h_last = lru_scan(a_t, b_t, h_lru.astype(F32))
    y_lru = h * jax.nn.gelu(gb.astype(F32))
    out = jnp.concatenate([o_gla, y_lru], axis=-1).astype(x.dtype) @ w_out
    return out, s_gla_new.astype(x.dtype), h_last.astype(x.dtype), new_buf.astype(x.dtype)


def wkv7_scan(r, w, k, v, a, b, s0):
    tm = lambda z: jnp.moveaxis(z, 1, 0)

    def step(S, inp):
        r_t, w_t, k_t, v_t, a_t, b_t = inp
        sa = jnp.einsum('bhvk,bhk->bhv', S, a_t)
        S = S * w_t[:, :, None, :] + sa[..., None] * b_t[:, :, None, :] + v_t[..., None] * k_t[:, :, None, :]
        return S, jnp.einsum('bhvk,bhk->bhv', S, r_t)

    s_fin, y = lax.scan(step, s0.astype(F32), (tm(r), tm(w), tm(k), tm(v), tm(a), tm(b)))
    return jnp.moveaxis(y, 0, 1), s_fin


def rwkv7_mixer(x, s0, shift, v_first, vres, mu, w_r, w_k, w_v, w_o, w0, w1, w2, a0, a1, a2,
                g1, g2, k_k, k_a, r_k, lnx_g, lnx_b):
    B, T, D = x.shape
    x_prev = jnp.concatenate([shift[:, None, :].astype(x.dtype), x[:, :-1]], axis=1)
    xx = x_prev - x
    xr, xw, xk, xv, xa, xg = (x + xx * mu[i] for i in range(6))
    r = xr @ w_r
    w = -jax.nn.softplus(-(w0 + jnp.tanh(xw @ w1) @ w2).astype(F32)) - 0.5
    k = xk @ w_k
    v = xv @ w_v
    if vres is None:
        v_first = v
    else:
        v0, v1, v2 = vres
        v = v + (v_first - v) * jax.nn.sigmoid(v0 + (xv @ v1) @ v2)
    a = jax.nn.sigmoid(a0 + (xa @ a1) @ a2)
    g = jax.nn.sigmoid(xg @ g1) @ g2
    hd = lambda z: z.reshape(B, T, RWKV_HEADS, RWKV_HEAD).astype(F32)
    kk = hd(k * k_k)
    kk = kk / jnp.maximum(jnp.sqrt(jnp.sum(jnp.square(kk), -1, keepdims=True)), 1e-12)
    k = k * (1 + (a - 1) * k_a)
    rh, kh, vh, ah = hd(r), hd(k), hd(v), hd(a)
    decay = jnp.exp(-jnp.exp(hd(w)))
    y, s_new = wkv7_scan(rh, decay, kh, vh, -kk, kk * ah, s0)
    mu_y = y.mean(-1, keepdims=True)
    var_y = jnp.mean(jnp.square(y - mu_y), -1, keepdims=True)
    y = ((y - mu_y) * lax.rsqrt(var_y + RWKV_GN_EPS)).reshape(B, T, D) * lnx_g + lnx_b
    bonus = jnp.sum(rh * kh * r_k, -1, keepdims=True) * vh
    y = y + bonus.reshape(B, T, D)
    out = (y * g).astype(x.dtype) @ w_o
    return out, s_new.astype(x.dtype), x[:, -1], v_first


def peer_ffn(x, w_q, keys, u_tab, v_tab):
    B, T, D = x.shape
    n = B * T
    nb = -(-n // PEER_BLOCK)
    xf = jnp.pad(x.reshape(n, D), ((0, nb * PEER_BLOCK - n), (0, 0))).reshape(nb, PEER_BLOCK, D)
    kf = keys.astype(F32)

    def block(xb):
        q = (xb @ w_q).reshape(PEER_BLOCK, PEER_HEADS, PEER_DKEY).astype(F32)
        qm = q.mean(-1, keepdims=True)
        q = (q - qm) * lax.rsqrt(jnp.mean(jnp.square(q - qm), -1, keepdims=True) + LN_EPS)
        s1 = jnp.einsum('thd,hkd->thk', q[..., :PEER_HALF], kf[:, 0])
        s2 = jnp.einsum('thd,hkd->thk', q[..., PEER_HALF:], kf[:, 1])
        v1, i1 = lax.top_k(s1, PEER_TOPK)
        v2, i2 = lax.top_k(s2, PEER_TOPK)
        cand = (v1[..., :, None] + v2[..., None, :]).reshape(PEER_BLOCK, PEER_HEADS, PEER_TOPK * PEER_TOPK)
        cidx = (i1[..., :, None] * PEER_NKEYS + i2[..., None, :]).reshape(PEER_BLOCK, PEER_HEADS, PEER_TOPK * PEER_TOPK)
        sc, pos = lax.top_k(cand, PEER_TOPK)
        eidx = jnp.take_along_axis(cidx, pos, axis=-1)
        gate = jax.nn.softmax(sc, axis=-1)
        act = jax.nn.gelu(jnp.einsum('thkd,td->thk', u_tab[eidx], xb).astype(F32))
        coef = (gate * act).astype(xb.dtype)
        return jnp.einsum('thk,thkd->td', coef, v_tab[eidx])

    y = lax.map(block, xf)
    return y.reshape(nb * PEER_BLOCK, D)[:n].reshape(B, T, D)


def trunk(x, st_gla, st_h, st_conv, st_rwkv, st_shift, W):
    new_gla, new_h, new_conv, new_rwkv, new_shift = [], [], [], [], []
    v_first = None
    for layer in range(DEPTH):
        j = layer // 2
        if layer % 2 == 0:
            m, s1, s2, s3 = gla_lru_mixer(
                x, st_gla[j], st_h[j], st_conv[j], W['ev_w_in'][j], W['ev_gla_w_gate'][j], W['ev_gla_b_gate'][j],
                W['ev_gla_norm'][j], W['ev_conv_w'][j], W['ev_conv_b'][j], W['ev_lru_wa'][j], W['ev_lru_ba'][j],
                W['ev_lru_wx'][j], W['ev_lru_bx'][j], W['ev_lru_lambda'][j], W['ev_w_out'][j])
            new_gla.append(s1)
            new_h.append(s2)
            new_conv.append(s3)
        else:
            vres = None if j == 0 else (W['od_v0'][j - 1], W['od_v1'][j - 1], W['od_v2'][j - 1])
            m, s4, s5, v_first = rwkv7_mixer(
                x, st_rwkv[j], st_shift[j], v_first, vres, W['od_mu'][j], W['od_w_r'][j], W['od_w_k'][j],
                W['od_w_v'][j], W['od_w_o'][j], W['od_w0'][j], W['od_w1'][j], W['od_w2'][j], W['od_a0'][j],
                W['od_a1'][j], W['od_a2'][j], W['od_g1'][j], W['od_g2'][j], W['od_k_k'][j], W['od_k_a'][j],
                W['od_r_k'][j], W['od_lnx_g'][j], W['od_lnx_b'][j])
            new_rwkv.append(s4)
            new_shift.append(s5)
        x = layer_norm(DN_ALPHA * x + m, W['ln_g'][layer, 0], W['ln_b'][layer, 0])
        f = peer_ffn(x, W['peer_w_q'][layer], W['peer_keys'][layer], W['peer_u'][layer], W['peer_v'][layer])
        x = layer_norm(DN_ALPHA * x + f, W['ln_g'][layer, 1], W['ln_b'][layer, 1])
    return x, jnp.stack(new_gla), jnp.stack(new_h), jnp.stack(new_conv), jnp.stack(new_rwkv), jnp.stack(new_shift)


def setup_inputs(seed: int = 0) -> dict:
    key = jax.random.key(seed)
    ks = iter(jax.random.split(key, 64))
    nrm = lambda shape, scale: jax.random.normal(next(ks), shape, F32) * scale
    D = D_MODEL
    NP = N_PAIRS
    a_init = jax.random.uniform(next(ks), (NP, LRU_WIDTH), F32, minval=0.9, maxval=0.999)
    s_init = a_init ** (1.0 / LRU_C)
    lam = jnp.log(s_init) - jnp.log1p(-s_init)
    ramp = (jnp.arange(D, dtype=F32) / (D - 1)) ** 0.9
    return {
        'x_prompt': nrm((BATCH, SEQ, D), 1.0),
        'x_sample': nrm((DEC_BATCH, DEC_SEQ, D), 1.0),
        'state_gla': nrm((NP, DEC_BATCH, GLA_HEADS, GLA_DK, GLA_DV), 0.1),
        'state_lru_h': nrm((NP, DEC_BATCH, LRU_WIDTH), 0.5),
        'state_lru_conv': nrm((NP, DEC_BATCH, CONV_W - 1, LRU_WIDTH), 1.0),
        'state_rwkv': nrm((NP, DEC_BATCH, RWKV_HEADS, RWKV_HEAD, RWKV_HEAD), 0.1),
        'state_rwkv_shift': nrm((NP, DEC_BATCH, D), 1.0),
        'meta_tokens': nrm((N_META, D), 1.0),
        'ln_g': 1.0 + nrm((DEPTH, 2, D), 0.01),
        'ln_b': nrm((DEPTH, 2, D), 0.01),
        'ev_w_in': nrm((NP, D, MIX_IN), D ** -0.5),
        'ev_gla_w_gate': nrm((NP, GLA_RANK, GLA_KEY), GLA_RANK ** -0.5),
        'ev_gla_b_gate': nrm((NP, GLA_KEY), 0.1),
        'ev_gla_norm': 1.0 + nrm((NP, GLA_DV), 0.01),
        'ev_conv_w': nrm((NP, CONV_W, LRU_WIDTH), CONV_W ** -0.5),
        'ev_conv_b': nrm((NP, LRU_WIDTH), 0.01),
        'ev_lru_wa': nrm((NP, LRU_BLOCKS, LRU_BDIM, LRU_BDIM), LRU_BDIM ** -0.5),
        'ev_lru_ba': nrm((NP, LRU_WIDTH), 0.1),
        'ev_lru_wx': nrm((NP, LRU_BLOCKS, LRU_BDIM, LRU_BDIM), LRU_BDIM ** -0.5),
        'ev_lru_bx': nrm((NP, LRU_WIDTH), 0.1),
        'ev_lru_lambda': lam,
        'ev_w_out': nrm((NP, MIX_OUT, D), DN_BETA * MIX_OUT ** -0.5),
        'od_mu': jax.random.uniform(next(ks), (NP, 6, D), F32),
        'od_w_r': nrm((NP, D, D), D ** -0.5),
        'od_w_k': nrm((NP, D, D), D ** -0.5),
        'od_w_v': nrm((NP, D, D), DN_BETA * D ** -0.5),
        'od_w_o': nrm((NP, D, D), DN_BETA * D ** -0.5),
        'od_w0': -6.0 + 5.0 * ramp + nrm((NP, D), 0.1),
        'od_w1': nrm((NP, D, DECAY_LORA), D ** -0.5),
        'od_w2': nrm((NP, DECAY_LORA, D), 0.1 * DECAY_LORA ** -0.5),
        'od_a0': nrm((NP, D), 0.1),
        'od_a1': nrm((NP, D, AAA_LORA), D ** -0.5),
        'od_a2': nrm((NP, AAA_LORA, D), AAA_LORA ** -0.5),
        'od_v0': 1.0 + nrm((NP - 1, D), 0.1),
        'od_v1': nrm((NP - 1, D, MV_LORA), D ** -0.5),
        'od_v2': nrm((NP - 1, MV_LORA, D), MV_LORA ** -0.5),
        'od_g1': nrm((NP, D, GATE_LORA), D ** -0.5),
        'od_g2': nrm((NP, GATE_LORA, D), GATE_LORA ** -0.5),
        'od_k_k': 0.85 + nrm((NP, D), 0.02),
        'od_k_a': 1.0 + nrm((NP, D), 0.02),
        'od_r_k': nrm((NP, RWKV_HEADS, RWKV_HEAD), 0.1),
        'od_lnx_g': 1.0 + nrm((NP, D), 0.01),
        'od_lnx_b': nrm((NP, D), 0.01),
        'peer_w_q': nrm((DEPTH, D, PEER_HEADS * PEER_DKEY), D ** -0.5),
        'peer_keys': nrm((DEPTH, PEER_HEADS, 2, PEER_NKEYS, PEER_HALF), PEER_HALF ** -0.5),
        'peer_u': nrm((DEPTH, PEER_EXPERTS, D), D ** -0.5),
        'peer_v': nrm((DEPTH, PEER_EXPERTS, D), DN_BETA * PEER_HEADS ** -0.5),
    }


def reference(x_prompt, x_sample, state_gla, state_lru_h, state_lru_conv, state_rwkv, state_rwkv_shift,
              meta_tokens, ln_g, ln_b, ev_w_in, ev_gla_w_gate, ev_gla_b_gate, ev_gla_norm, ev_conv_w, ev_conv_b,
              ev_lru_wa, ev_lru_ba, ev_lru_wx, ev_lru_bx, ev_lru_lambda, ev_w_out, od_mu, od_w_r, od_w_k, od_w_v,
              od_w_o, od_w0, od_w1, od_w2, od_a0, od_a1, od_a2, od_v0, od_v1, od_v2, od_g1, od_g2, od_k_k, od_k_a,
              od_r_k, od_lnx_g, od_lnx_b, peer_w_q, peer_keys, peer_u, peer_v):
    W = dict(ln_g=ln_g, ln_b=ln_b, ev_w_in=ev_w_in, ev_gla_w_gate=ev_gla_w_gate, ev_gla_b_gate=ev_gla_b_gate,
             ev_gla_norm=ev_gla_norm, ev_conv_w=ev_conv_w, ev_conv_b=ev_conv_b, ev_lru_wa=ev_lru_wa,
             ev_lru_ba=ev_lru_ba, ev_lru_wx=ev_lru_wx, ev_lru_bx=ev_lru_bx, ev_lru_lambda=ev_lru_lambda,
             ev_w_out=ev_w_out, od_mu=od_mu, od_w_r=od_w_r, od_w_k=od_w_k, od_w_v=od_w_v, od_w_o=od_w_o,
             od_w0=od_w0, od_w1=od_w1, od_w2=od_w2, od_a0=od_a0, od_a1=od_a1, od_a2=od_a2, od_v0=od_v0,
             od_v1=od_v1, od_v2=od_v2, od_g1=od_g1, od_g2=od_g2, od_k_k=od_k_k, od_k_a=od_k_a, od_r_k=od_r_k,
             od_lnx_g=od_lnx_g, od_lnx_b=od_lnx_b, peer_w_q=peer_w_q, peer_keys=peer_keys, peer_u=peer_u,
             peer_v=peer_v)
    Bp = x_prompt.shape[0]
    dt = x_prompt.dtype
    xp = jnp.concatenate([jnp.broadcast_to(meta_tokens.astype(dt)[None], (Bp, N_META, D_MODEL)), x_prompt], axis=1)
    z_gla = jnp.zeros((N_PAIRS, Bp, GLA_HEADS, GLA_DK, GLA_DV), dt)
    z_h = jnp.zeros((N_PAIRS, Bp, LRU_WIDTH), dt)
    z_conv = jnp.zeros((N_PAIRS, Bp, CONV_W - 1, LRU_WIDTH), dt)
    z_rwkv = jnp.zeros((N_PAIRS, Bp, RWKV_HEADS, RWKV_HEAD, RWKV_HEAD), dt)
    z_shift = jnp.zeros((N_PAIRS, Bp, D_MODEL), dt)
    yp, p_gla, p_h, p_conv, p_rwkv, p_shift = trunk(xp, z_gla, z_h, z_conv, z_rwkv, z_shift, W)
    y_prompt = yp[:, N_META:]
    y_sample, s_gla, s_h, s_conv, s_rwkv, s_shift = trunk(
        x_sample, state_gla, state_lru_h, state_lru_conv, state_rwkv, state_rwkv_shift, W)
    return (y_prompt, y_sample, p_gla, p_h, p_conv, p_rwkv, p_shift, s_gla, s_h, s_conv, s_rwkv, s_shift)
```

```cpp
#include <hip/hip_runtime.h>
#include <cstdio>
#include <cmath>
#ifndef HD
#define HD __host__ __device__ __forceinline__
#endif
struct Dm { int D, B, T, DB, DT, M, NSEQ, RH; };
HD Dm make_dm(int D, int B, int SEQ, int DB, int DT) { Dm d; d.D = D; d.B = B; d.T = SEQ + 16; d.DB = DB; d.DT = DT; d.M = B * d.T + DB * DT; d.NSEQ = B + DB; d.RH = D / 64; return d; }
HD int seq_row0(const Dm& d, int s) { return s < d.B ? s * d.T : d.B * d.T + (s - d.B) * d.DT; }
HD int seq_len(const Dm& d, int s) { return s < d.B ? d.T : d.DT; }
HD void row_to_seq(const Dm& d, int row, int& s, int& t) { if (row < d.B * d.T) { s = row / d.T; t = row % d.T; } else { int r = row - d.B * d.T; s = d.B + r / d.DT; t = r % d.DT; } }

constexpr int MIXIN = 2576, C_Q = 0, C_K = 256, C_V = 512, C_GLR = 1024, C_R = 1040, C_XB = 1552, C_GB = 2064;

enum { OP_EMBED = 1, OP_GEMM, OP_LOGA, OP_GLA, OP_GLANORM, OP_CONV, OP_CONVOUT, OP_LRUG, OP_LRUSCAN, OP_LNRES, OP_MIX, OP_SHIFTOUT,
       OP_RWKVPREP, OP_WKV, OP_RWKVPOST, OP_QNORM, OP_SCORES, OP_TOPK, OP_PACT1, OP_PACT2, OP_POUT, OP_YOUT };

struct Op {
    const float *a, *b, *c, *d, *e, *f, *g, *h, *i, *j, *k, *l;
    float *o0, *o1, *o2, *o3, *o4, *o5;
    long long n;
    int code, i0, i1, i2, i3, i4, i5, i6;
    Dm dm;
};

struct alignas(16) NvF4 { float x, y, z, w; };
HD float nv_sigmoid(float x) { return 1.f / (1.f + expf(-x)); }
HD float nv_softplus(float x) { return fmaxf(x, 0.f) + log1pf(expf(-fabsf(x))); }
HD float nv_gelu(float x) { return 0.5f * x * (1.f + tanhf(0.7978845608028654f * (x + 0.044715f * x * x * x))); }

#define NV_INS16(tv, ti, val, idx) do { float _v = (val); int _i = (idx); _Pragma("unroll") for (int _j = 0; _j < 16; ++_j) { if (_v > tv[_j]) { float _tv = tv[_j]; int _ti = ti[_j]; tv[_j] = _v; ti[_j] = _i; _v = _tv; _i = _ti; } } } while (0)

HD void nv_elem(const int code, const Op& p, long long gid) {
    const Dm& dm = p.dm; const int D = dm.D;
    switch (code) {
    case OP_EMBED: {
        int row = (int)(gid / D), c = (int)(gid % D); float v;
        if (row < dm.B * dm.T) { int bb = row / dm.T, t = row % dm.T; v = t < 16 ? p.c[t * D + c] : p.a[((size_t)bb * (dm.T - 16) + (t - 16)) * D + c]; }
        else v = p.b[(size_t)(row - dm.B * dm.T) * D + c];
        p.o0[gid] = v; } break;
    case OP_GEMM: {
        int N4 = p.i0 >> 2, K = p.i1; int m = (int)(gid / N4), nn = (int)(gid % N4) * 4; const float* A = p.a + (size_t)m * p.i2; const float* Bw = p.b + nn; float c0 = 0.f, c1 = 0.f, c2 = 0.f, c3 = 0.f;
        for (int k = 0; k < K; ++k) { float av = A[k]; if (p.i5 == 1) av = tanhf(av); else if (p.i5 == 2) av = nv_sigmoid(av); const NvF4 bv = *(const NvF4*)(Bw + (size_t)k * p.i3);
            c0 = fmaf(av, bv.x, c0); c1 = fmaf(av, bv.y, c1); c2 = fmaf(av, bv.z, c2); c3 = fmaf(av, bv.w, c3); }
        float* C = p.o0 + (size_t)m * p.i4 + nn; C[0] = c0; C[1] = c1; C[2] = c2; C[3] = c3; } break;
    case OP_LOGA: {
        int row = (int)(gid / 256), c = (int)(gid % 256); float z = p.c[c];
        for (int r = 0; r < 16; ++r) z = fmaf(p.a[(size_t)row * MIXIN + C_GLR + r], p.b[r * 256 + c], z);
        p.o0[gid] = -nv_softplus(-z) * (1.f / 16.f); } break;
    case OP_GLA: {
        int s = (int)(gid / 512), h = (int)((gid / 128) % 4), col = (int)(gid % 128);
        float S[64];
        const float* sin = (s < dm.B) ? nullptr : p.c + (((size_t)(s - dm.B) * 4 + h) * 64) * 128 + col;
#pragma unroll
        for (int k = 0; k < 64; ++k) S[k] = sin ? sin[(size_t)k * 128] : 0.f;
        int r0 = seq_row0(dm, s), L = seq_len(dm, s);
        for (int t = 0; t < L; ++t) {
            const float* pr = p.a + (size_t)(r0 + t) * MIXIN; const float* la = p.b + (size_t)(r0 + t) * 256 + h * 64;
            float v = pr[C_V + h * 128 + col], o = 0.f;
#pragma unroll
            for (int k = 0; k < 64; ++k) { S[k] = fmaf(expf(la[k]), S[k], pr[C_K + h * 64 + k] * v); o = fmaf(pr[C_Q + h * 64 + k] * 0.125f, S[k], o); }
            p.o0[(size_t)(r0 + t) * 512 + h * 128 + col] = o;
        }
        float* so = (s < dm.B) ? p.o1 + (((size_t)s * 4 + h) * 64) * 128 + col : p.o2 + (((size_t)(s - dm.B) * 4 + h) * 64) * 128 + col;
#pragma unroll
        for (int k = 0; k < 64; ++k) so[(size_t)k * 128] = S[k]; } break;
    case OP_GLANORM: {
        int row = (int)(gid / 4), h = (int)(gid % 4); const float* o = p.a + (size_t)row * 512 + h * 128; float ss = 0.f;
        for (int c = 0; c < 128; ++c) ss = fmaf(o[c], o[c], ss);
        float rs = 1.f / sqrtf(ss * (1.f / 128.f) + 1e-5f);
        for (int c = 0; c < 128; ++c) { float r = p.b[(size_t)row * MIXIN + C_R + h * 128 + c]; p.o0[(size_t)row * 1024 + h * 128 + c] = o[c] * rs * p.c[c] * (r * nv_sigmoid(r)); } } break;
    case OP_CONV: {
        int row = (int)(gid / 512), c = (int)(gid % 512); int s, t; row_to_seq(dm, row, s, t); float acc = p.d[c];
        for (int i = 0; i < 4; ++i) { int j = t + i; float xv;
            if (j < 3) xv = (s < dm.B) ? 0.f : p.b[((size_t)(s - dm.B) * 3 + j) * 512 + c]; else xv = p.a[(size_t)(row - t + (j - 3)) * MIXIN + C_XB + c];
            acc = fmaf(xv, p.c[i * 512 + c], acc); }
        p.o0[gid] = acc; } break;
    case OP_CONVOUT: {
        int s = (int)(gid / 1536), i = (int)((gid / 512) % 3), c = (int)(gid % 512); int L = seq_len(dm, s), r0 = seq_row0(dm, s); int j = L + i; float xv;
        if (j < 3) xv = (s < dm.B) ? 0.f : p.b[((size_t)(s - dm.B) * 3 + j) * 512 + c]; else xv = p.a[(size_t)(r0 + j - 3) * MIXIN + C_XB + c];
        float* o = (s < dm.B) ? p.o1 + ((size_t)s * 3 + i) * 512 + c : p.o2 + ((size_t)(s - dm.B) * 3 + i) * 512 + c; *o = xv; } break;
    case OP_LRUG: {
        int row = (int)(gid / 512), c = (int)(gid % 512), nb = c / 64, e = c % 64; const float* x = p.a + (size_t)row * 512 + nb * 64; float ga = p.c[c], gx = p.e[c];
        for (int dd = 0; dd < 64; ++dd) { ga = fmaf(x[dd], p.b[((size_t)nb * 64 + dd) * 64 + e], ga); gx = fmaf(x[dd], p.d[((size_t)nb * 64 + dd) * 64 + e], gx); }
        float gate_a = nv_sigmoid(ga), gate_x = nv_sigmoid(gx); float log_at = -8.f * gate_a * nv_softplus(-p.f[c]);
        p.o0[gid] = expf(log_at); p.o1[gid] = sqrtf(-expm1f(2.f * log_at)) * (gate_x * p.a[(size_t)row * 512 + c]); } break;
    case OP_LRUSCAN: {
        int s = (int)(gid / 512), c = (int)(gid % 512); int r0 = seq_row0(dm, s), L = seq_len(dm, s); float hh = (s < dm.B) ? 0.f : p.d[(size_t)(s - dm.B) * 512 + c];
        for (int t = 0; t < L; ++t) { size_t r = (size_t)(r0 + t); hh = fmaf(p.a[r * 512 + c], hh, p.b[r * 512 + c]); p.o0[r * 1024 + 512 + c] = hh * nv_gelu(p.c[r * MIXIN + C_GB + c]); }
        float* o = (s < dm.B) ? p.o1 + (size_t)s * 512 + c : p.o2 + (size_t)(s - dm.B) * 512 + c; *o = hh; } break;
    case OP_LNRES: {
        const float alpha = 1.6817928305074292f; float* x = p.o0 + (size_t)gid * D; const float* y = p.a + (size_t)gid * D; float mu = 0.f;
        for (int c = 0; c < D; ++c) mu += alpha * x[c] + y[c];
        mu /= D; float var = 0.f;
        for (int c = 0; c < D; ++c) { float v = alpha * x[c] + y[c] - mu; var = fmaf(v, v, var); }
        float rs = 1.f / sqrtf(var / D + 1e-5f);
        for (int c = 0; c < D; ++c) x[c] = (alpha * x[c] + y[c] - mu) * rs * p.b[c] + p.c[c]; } break;
    case OP_MIX: {
        int row = (int)(gid / D), c = (int)(gid % D); int s, t; row_to_seq(dm, row, s, t); float x = p.a[gid];
        float xp = t > 0 ? p.a[gid - D] : ((s < dm.B) ? 0.f : p.b[(size_t)(s - dm.B) * D + c]);
        p.o0[gid] = x + (xp - x) * p.c[c]; } break;
    case OP_SHIFTOUT: {
        int s = (int)(gid / D), c = (int)(gid % D); float v = p.a[(size_t)(seq_row0(dm, s) + seq_len(dm, s) - 1) * D + c];
        float* o = (s < dm.B) ? p.o1 + (size_t)s * D + c : p.o2 + (size_t)(s - dm.B) * D + c; *o = v; } break;
    case OP_RWKVPREP: {
        int row = (int)(gid / dm.RH), h = (int)(gid % dm.RH); size_t base = (size_t)row * D + h * 64; float ss = 0.f;
        for (int k = 0; k < 64; ++k) { float kv = p.o0[base + k] * p.d[h * 64 + k]; ss = fmaf(kv, kv, ss); }
        float inv = 1.f / fmaxf(sqrtf(ss), 1e-12f);
        for (int k = 0; k < 64; ++k) { int c = h * 64 + k; size_t ix = base + k;
            float w = -nv_softplus(-(p.a[c] + p.o1[ix])) - 0.5f; float dec = expf(-expf(w));
            float a = nv_sigmoid(p.b[c] + p.o2[ix]);
            float v = p.o3[ix]; if (p.i0) v = v + (p.o5[ix] - v) * nv_sigmoid(p.c[c] + p.f[ix]); else p.o5[ix] = v;
            float k0 = p.o0[ix]; p.o4[ix] = k0 * p.d[c] * inv; p.o0[ix] = k0 * (1.f + (a - 1.f) * p.e[c]); p.o1[ix] = dec; p.o2[ix] = a; p.o3[ix] = v; } } break;
    case OP_WKV: {
        int RH = dm.RH; int s = (int)(gid / (RH * 64)), h = (int)((gid / 64) % RH), vr = (int)(gid % 64); float S[64];
        const float* sin = (s < dm.B) ? nullptr : p.g + (((size_t)(s - dm.B) * RH + h) * 64 + vr) * 64;
#pragma unroll
        for (int k = 0; k < 64; ++k) S[k] = sin ? sin[k] : 0.f;
        int r0 = seq_row0(dm, s), L = seq_len(dm, s);
        for (int t = 0; t < L; ++t) { size_t base = (size_t)(r0 + t) * D + h * 64; float sa = 0.f;
#pragma unroll
            for (int k = 0; k < 64; ++k) sa = fmaf(S[k], -p.f[base + k], sa);
            float vv = p.d[base + vr], y = 0.f;
#pragma unroll
            for (int k = 0; k < 64; ++k) { float kk = p.f[base + k]; S[k] = fmaf(S[k], p.b[base + k], fmaf(sa, kk * p.e[base + k], vv * p.c[base + k])); y = fmaf(S[k], p.a[base + k], y); }
            p.o0[base + vr] = y; }
        float* so = (s < dm.B) ? p.o1 + (((size_t)s * RH + h) * 64 + vr) * 64 : p.o2 + (((size_t)(s - dm.B) * RH + h) * 64 + vr) * 64;
#pragma unroll
        for (int k = 0; k < 64; ++k) so[k] = S[k]; } break;
    case OP_RWKVPOST: {
        int row = (int)(gid / dm.RH), h = (int)(gid % dm.RH); size_t base = (size_t)row * D + h * 64; float mu = 0.f, bon = 0.f;
        for (int k = 0; k < 64; ++k) { mu += p.a[base + k]; bon = fmaf(p.b[base + k] * p.c[base + k], p.f[h * 64 + k], bon); }
        mu *= (1.f / 64.f); float var = 0.f;
        for (int k = 0; k < 64; ++k) { float dlt = p.a[base + k] - mu; var = fmaf(dlt, dlt, var); }
        float rs = 1.f / sqrtf(var * (1.f / 64.f) + 64e-5f);
        for (int k = 0; k < 64; ++k) { int c = h * 64 + k; float y = (p.a[base + k] - mu) * rs * p.g[c] + p.h[c] + bon * p.d[base + k]; p.o0[base + k] = y * p.e[base + k]; } } break;
    case OP_QNORM: {
        float* q = p.o0 + (size_t)gid * 256; float mu = 0.f;
        for (int c = 0; c < 256; ++c) mu += q[c];
        mu *= (1.f / 256.f); float var = 0.f;
        for (int c = 0; c < 256; ++c) { float dlt = q[c] - mu; var = fmaf(dlt, dlt, var); }
        float rs = 1.f / sqrtf(var * (1.f / 256.f) + 1e-5f);
        for (int c = 0; c < 256; ++c) q[c] = (q[c] - mu) * rs; } break;
    case OP_SCORES: {
        int row = (int)(gid / 2048), r = (int)(gid % 2048), h = r / 256, half = (r / 128) & 1, key = r % 128;
        const float* q = p.a + (size_t)row * 2048 + h * 256 + half * 128; const float* kv = p.b + (((size_t)h * 2 + half) * 128 + key) * 128; float acc = 0.f;
        for (int dd = 0; dd < 128; ++dd) acc = fmaf(q[dd], kv[dd], acc);
        p.o0[gid] = acc; } break;
    case OP_TOPK: {
        const float* sc = p.a + (size_t)gid * 256; float tv[16]; int ti[16]; float* tmpv = p.o2 + (size_t)gid * 32; int* tmpi = (int*)p.o3 + (size_t)gid * 32;
        for (int half = 0; half < 2; ++half) {
#pragma unroll
            for (int j = 0; j < 16; ++j) { tv[j] = -3.0e38f; ti[j] = 0; }
            for (int k = 0; k < 128; ++k) NV_INS16(tv, ti, sc[half * 128 + k], k);
#pragma unroll
            for (int j = 0; j < 16; ++j) { tmpv[half * 16 + j] = tv[j]; tmpi[half * 16 + j] = ti[j]; }
        }
#pragma unroll
        for (int j = 0; j < 16; ++j) { tv[j] = -3.0e38f; ti[j] = 0; }
        for (int i = 0; i < 16; ++i) for (int j = 0; j < 16; ++j) NV_INS16(tv, ti, tmpv[i] + tmpv[16 + j], tmpi[i] * 128 + tmpi[16 + j]);
        float den = 0.f, ev[16];
#pragma unroll
        for (int j = 0; j < 16; ++j) { ev[j] = expf(tv[j] - tv[0]); den += ev[j]; }
        float inv = 1.f / den;
#pragma unroll
        for (int j = 0; j < 16; ++j) { p.o0[(size_t)gid * 16 + j] = ev[j] * inv; ((int*)p.o1)[(size_t)gid * 16 + j] = ti[j]; } } break;
    case OP_PACT1: {
        size_t pr = (size_t)(gid / 16); int part = (int)(gid % 16); int row = (int)(pr / 128); int e = ((const int*)p.d)[pr]; int w = D / 16;
        const float* u = p.b + (size_t)e * D + part * w; const float* x = p.a + (size_t)row * D + part * w; float acc = 0.f;
        for (int c = 0; c < w; ++c) acc = fmaf(u[c], x[c], acc);
        p.o0[gid] = acc; } break;
    case OP_PACT2: {
        float acc = 0.f; for (int i = 0; i < 16; ++i) acc += p.a[(size_t)gid * 16 + i];
        p.o0[gid] = p.c[gid] * nv_gelu(acc); } break;
    case OP_POUT: {
        int row = (int)(gid / D), c = (int)(gid % D); float acc = 0.f;
        for (int i = 0; i < 128; ++i) acc = fmaf(p.a[(size_t)row * 128 + i], p.c[(size_t)((const int*)p.b)[(size_t)row * 128 + i] * D + c], acc);
        p.o0[gid] = acc; } break;
    case OP_YOUT: {
        int row = (int)(gid / D), c = (int)(gid % D);
        if (row < dm.B * dm.T) { int bb = row / dm.T, t = row % dm.T; if (t >= 16) p.o0[((size_t)bb * (dm.T - 16) + (t - 16)) * D + c] = p.a[gid]; }
        else p.o0[((size_t)dm.B * (dm.T - 16) + (row - dm.B * dm.T)) * D + c] = p.a[gid]; } break;
    default: break;
    }
}

struct NvIO { const float* in[47]; float* out; char* ws; size_t ws_size; };
template <class Launch> inline void nv_forward(const NvIO& io, const Dm& dm, Launch&& launch) {
    const int D = dm.D, M = dm.M, B = dm.B, DB = dm.DB, RH = dm.RH; const size_t MD = (size_t)M * D;
    float* y_prompt = io.out; float* y_sample = y_prompt + (size_t)B * (dm.T - 16) * D; float* p_gla = y_sample + (size_t)DB * dm.DT * D;
    float* p_h = p_gla + (size_t)2 * B * 4 * 64 * 128; float* p_conv = p_h + (size_t)2 * B * 512; float* p_rwkv = p_conv + (size_t)2 * B * 3 * 512;
    float* p_shift = p_rwkv + (size_t)2 * B * RH * 4096; float* s_gla = p_shift + (size_t)2 * B * D; float* s_h = s_gla + (size_t)2 * DB * 4 * 64 * 128;
    float* s_conv = s_h + (size_t)2 * DB * 512; float* s_rwkv = s_conv + (size_t)2 * DB * 3 * 512; float* s_shift = s_rwkv + (size_t)2 * DB * RH * 4096;
    float* w = (float*)io.ws; size_t off = 0; auto take = [&](size_t n) { float* r = w + off; off += (n + 63) & ~(size_t)63; return r; };
    float* X = take(MD); float* VFIRST = take(MD); float* MOUT = take(MD); const size_t scratch0 = off;
    auto mk = [&](int code, long long n) { Op o{}; o.code = code; o.n = n; o.dm = dm; return o; };
    auto gemm = [&](const float* A, int lda, const float* Bw, int ldb, float* C, int ldc, int N, int K, int act) { Op o = mk(OP_GEMM, (long long)M * (N / 4)); o.a = A; o.b = Bw; o.o0 = C; o.i0 = N; o.i1 = K; o.i2 = lda; o.i3 = ldb; o.i4 = ldc; o.i5 = act; launch(o); };
    { Op o = mk(OP_EMBED, (long long)MD); o.a = io.in[0]; o.b = io.in[1]; o.c = io.in[7]; o.o0 = X; launch(o); }
    for (int layer = 0; layer < 4; ++layer) {
        const int j = layer / 2; off = scratch0;
        if (layer % 2 == 0) {
            float* PROJ = take((size_t)M * MIXIN); float* LOGA = take((size_t)M * 256); float* O = take((size_t)M * 512); float* MIXO = take((size_t)M * 1024);
            float* XC = take((size_t)M * 512); float* AT = take((size_t)M * 512); float* BT = take((size_t)M * 512);
            gemm(X, D, io.in[10] + (size_t)j * D * MIXIN, MIXIN, PROJ, MIXIN, MIXIN, D, 0);
            { Op o = mk(OP_LOGA, (long long)M * 256); o.a = PROJ; o.b = io.in[11] + (size_t)j * 16 * 256; o.c = io.in[12] + (size_t)j * 256; o.o0 = LOGA; launch(o); }
            { Op o = mk(OP_GLA, (long long)dm.NSEQ * 512); o.a = PROJ; o.b = LOGA; o.c = io.in[2] + (size_t)j * DB * 4 * 64 * 128; o.o0 = O; o.o1 = p_gla + (size_t)j * B * 4 * 64 * 128; o.o2 = s_gla + (size_t)j * DB * 4 * 64 * 128; launch(o); }
            { Op o = mk(OP_GLANORM, (long long)M * 4); o.a = O; o.b = PROJ; o.c = io.in[13] + (size_t)j * 128; o.o0 = MIXO; launch(o); }
            { Op o = mk(OP_CONV, (long long)M * 512); o.a = PROJ; o.b = io.in[4] + (size_t)j * DB * 3 * 512; o.c = io.in[14] + (size_t)j * 4 * 512; o.d = io.in[15] + (size_t)j * 512; o.o0 = XC; launch(o); }
            { Op o = mk(OP_CONVOUT, (long long)dm.NSEQ * 1536); o.a = PROJ; o.b = io.in[4] + (size_t)j * DB * 3 * 512; o.o1 = p_conv + (size_t)j * B * 3 * 512; o.o2 = s_conv + (size_t)j * DB * 3 * 512; launch(o); }
            { Op o = mk(OP_LRUG, (long long)M * 512); o.a = XC; o.b = io.in[16] + (size_t)j * 8 * 64 * 64; o.c = io.in[17] + (size_t)j * 512; o.d = io.in[18] + (size_t)j * 8 * 64 * 64; o.e = io.in[19] + (size_t)j * 512; o.f = io.in[20] + (size_t)j * 512; o.o0 = AT; o.o1 = BT; launch(o); }
            { Op o = mk(OP_LRUSCAN, (long long)dm.NSEQ * 512); o.a = AT; o.b = BT; o.c = PROJ; o.d = io.in[3] + (size_t)j * DB * 512; o.o0 = MIXO; o.o1 = p_h + (size_t)j * B * 512; o.o2 = s_h + (size_t)j * DB * 512; launch(o); }
            gemm(MIXO, 1024, io.in[21] + (size_t)j * 1024 * D, D, MOUT, D, D, 1024, 0);
        } else {
            float* XM = take(MD); float* R = take(MD); float* K = take(MD); float* V = take(MD); float* Wd = take(MD); float* Aa = take(MD); float* Vg = take(MD); float* G = take(MD); float* KK = take(MD);
            float* HL = take((size_t)M * 128); float* Y = XM;
            const float* shin = io.in[6] + (size_t)j * DB * D; const float* mu = io.in[22] + (size_t)j * 6 * D;
            auto mix = [&](int i) { Op o = mk(OP_MIX, (long long)MD); o.a = X; o.b = shin; o.c = mu + (size_t)i * D; o.o0 = XM; launch(o); };
            { Op o = mk(OP_SHIFTOUT, (long long)dm.NSEQ * D); o.a = X; o.o1 = p_shift + (size_t)j * B * D; o.o2 = s_shift + (size_t)j * DB * D; launch(o); }
            mix(0); gemm(XM, D, io.in[23] + (size_t)j * D * D, D, R, D, D, D, 0);
            mix(1); gemm(XM, D, io.in[28] + (size_t)j * D * 64, 64, HL, 64, 64, D, 0); gemm(HL, 64, io.in[29] + (size_t)j * 64 * D, D, Wd, D, D, 64, 1);
            mix(2); gemm(XM, D, io.in[24] + (size_t)j * D * D, D, K, D, D, D, 0);
            mix(3); gemm(XM, D, io.in[25] + (size_t)j * D * D, D, V, D, D, D, 0);
            if (j > 0) { gemm(XM, D, io.in[34] + (size_t)(j - 1) * D * 32, 32, HL, 32, 32, D, 0); gemm(HL, 32, io.in[35] + (size_t)(j - 1) * 32 * D, D, Vg, D, D, 32, 0); }
            mix(4); gemm(XM, D, io.in[31] + (size_t)j * D * 64, 64, HL, 64, 64, D, 0); gemm(HL, 64, io.in[32] + (size_t)j * 64 * D, D, Aa, D, D, 64, 0);
            mix(5); gemm(XM, D, io.in[36] + (size_t)j * D * 128, 128, HL, 128, 128, D, 0); gemm(HL, 128, io.in[37] + (size_t)j * 128 * D, D, G, D, D, 128, 2);
            { Op o = mk(OP_RWKVPREP, (long long)M * RH); o.a = io.in[27] + (size_t)j * D; o.b = io.in[30] + (size_t)j * D; o.c = j > 0 ? io.in[33] + (size_t)(j - 1) * D : nullptr; o.d = io.in[38] + (size_t)j * D; o.e = io.in[39] + (size_t)j * D; o.f = Vg;
              o.o0 = K; o.o1 = Wd; o.o2 = Aa; o.o3 = V; o.o4 = KK; o.o5 = VFIRST; o.i0 = j > 0 ? 1 : 0; launch(o); }
            { Op o = mk(OP_WKV, (long long)dm.NSEQ * RH * 64); o.a = R; o.b = Wd; o.c = K; o.d = V; o.e = Aa; o.f = KK; o.g = io.in[5] + (size_t)j * DB * RH * 4096; o.o0 = Y; o.o1 = p_rwkv + (size_t)j * B * RH * 4096; o.o2 = s_rwkv + (size_t)j * DB * RH * 4096; launch(o); }
            { Op o = mk(OP_RWKVPOST, (long long)M * RH); o.a = Y; o.b = R; o.c = K; o.d = V; o.e = G; o.f = io.in[40] + (size_t)j * RH * 64; o.g = io.in[41] + (size_t)j * D; o.h = io.in[42] + (size_t)j * D; o.o0 = KK; launch(o); }
            gemm(KK, D, io.in[26] + (size_t)j * D * D, D, MOUT, D, D, D, 0);
        }
        { Op o = mk(OP_LNRES, M); o.a = MOUT; o.b = io.in[8] + (size_t)(layer * 2 + 0) * D; o.c = io.in[9] + (size_t)(layer * 2 + 0) * D; o.o0 = X; launch(o); }
        off = scratch0;
        { float* Q = take((size_t)M * 2048); float* SC = take((size_t)M * 2048); float* GATE = take((size_t)M * 128); float* EIDX = take((size_t)M * 128); float* TMPV = take((size_t)M * 256); float* TMPI = take((size_t)M * 256);
          float* PART = take((size_t)M * 128 * 16); float* COEF = take((size_t)M * 128);
          gemm(X, D, io.in[43] + (size_t)layer * D * 2048, 2048, Q, 2048, 2048, D, 0);
          { Op o = mk(OP_QNORM, (long long)M * 8); o.o0 = Q; launch(o); }
          { Op o = mk(OP_SCORES, (long long)M * 2048); o.a = Q; o.b = io.in[44] + (size_t)layer * 8 * 2 * 128 * 128; o.o0 = SC; launch(o); }
          { Op o = mk(OP_TOPK, (long long)M * 8); o.a = SC; o.o0 = GATE; o.o1 = EIDX; o.o2 = TMPV; o.o3 = TMPI; launch(o); }
          { Op o = mk(OP_PACT1, (long long)M * 128 * 16); o.a = X; o.b = io.in[45] + (size_t)layer * 16384 * D; o.d = EIDX; o.o0 = PART; launch(o); }
          { Op o = mk(OP_PACT2, (long long)M * 128); o.a = PART; o.c = GATE; o.o0 = COEF; launch(o); }
          { Op o = mk(OP_POUT, (long long)MD); o.a = COEF; o.b = EIDX; o.c = io.in[46] + (size_t)layer * 16384 * D; o.o0 = MOUT; launch(o); } }
        { Op o = mk(OP_LNRES, M); o.a = MOUT; o.b = io.in[8] + (size_t)(layer * 2 + 1) * D; o.c = io.in[9] + (size_t)(layer * 2 + 1) * D; o.o0 = X; launch(o); }
    }
    { Op o = mk(OP_YOUT, (long long)MD); o.a = X; o.o0 = y_prompt; launch(o); }
    (void)y_sample;
}

template <int CODE> __global__ void __launch_bounds__(256) nv_kernel(Op op) {
    const long long stride = (long long)gridDim.x * blockDim.x;
    for (long long g = (long long)blockIdx.x * blockDim.x + threadIdx.x; g < op.n; g += stride) nv_elem(CODE, op, g);
}
template <int CODE> static void nv_launch_t(const Op& o, hipStream_t stream) {
    long long nb = (o.n + 255) / 256; if (nb > 256 * 32) nb = 256 * 32; if (nb < 1) nb = 1;
    hipLaunchKernelGGL(nv_kernel<CODE>, dim3((unsigned)nb), dim3(256), 0, stream, o);
}
static void nv_launch(const Op& o, hipStream_t s) {
    switch (o.code) {
#define NVC(c) case c: nv_launch_t<c>(o, s); break;
    NVC(OP_EMBED) NVC(OP_GEMM) NVC(OP_LOGA) NVC(OP_GLA) NVC(OP_GLANORM) NVC(OP_CONV) NVC(OP_CONVOUT) NVC(OP_LRUG) NVC(OP_LRUSCAN) NVC(OP_LNRES) NVC(OP_MIX) NVC(OP_SHIFTOUT)
    NVC(OP_RWKVPREP) NVC(OP_WKV) NVC(OP_RWKVPOST) NVC(OP_QNORM) NVC(OP_SCORES) NVC(OP_TOPK) NVC(OP_PACT1) NVC(OP_PACT2) NVC(OP_POUT) NVC(OP_YOUT)
#undef NVC
    default: break; }
}
extern "C" void kernel_launch(void* const* d_in, const int* in_sizes, int n_in, void* d_out, int out_size, void* d_ws, size_t ws_size, hipStream_t stream) {
    if (n_in != 47) { fprintf(stderr, "kernel_launch: expected 47 inputs, got %d\n", n_in); return; }
    const Dm dm = make_dm(1024, 8, 2048, 128, 4);
    NvIO io; for (int i = 0; i < 47; ++i) io.in[i] = (const float*)d_in[i]; io.out = (float*)d_out; io.ws = (char*)d_ws; io.ws_size = ws_size;
    if (ws_size < ((size_t)900 << 20)) { fprintf(stderr, "kernel_launch: workspace too small: %zu\n", ws_size); return; }
    nv_forward(io, dm, [&](const Op& o) { nv_launch(o, stream); });
}
```

```cpp
#include <hip/hip_runtime.h>
#include <cstdio>
#include <cmath>
#ifndef HD
#define HD __host__ __device__ __forceinline__
#endif
struct Dm { int D, B, T, DB, DT, M, NSEQ, RH; };
HD Dm make_dm(int D, int B, int SEQ, int DB, int DT) { Dm d; d.D = D; d.B = B; d.T = SEQ + 16; d.DB = DB; d.DT = DT; d.M = B * d.T + DB * DT; d.NSEQ = B + DB; d.RH = D / 64; return d; }
HD int seq_row0(const Dm& d, int s) { return s < d.B ? s * d.T : d.B * d.T + (s - d.B) * d.DT; }
HD int seq_len(const Dm& d, int s) { return s < d.B ? d.T : d.DT; }
HD void row_to_seq(const Dm& d, int row, int& s, int& t) { if (row < d.B * d.T) { s = row / d.T; t = row % d.T; } else { int r = row - d.B * d.T; s = d.B + r / d.DT; t = r % d.DT; } }

constexpr int MIXIN = 2576, C_Q = 0, C_K = 256, C_V = 512, C_GLR = 1024, C_R = 1040, C_XB = 1552, C_GB = 2064;

enum { OP_EMBED = 1, OP_GEMM, OP_LOGA, OP_GLA, OP_GLANORM, OP_CONV, OP_CONVOUT, OP_LRUG, OP_LRUSCAN, OP_LNRES, OP_MIX, OP_SHIFTOUT,
       OP_RWKVPREP, OP_WKV, OP_RWKVPOST, OP_QNORM, OP_SCORES, OP_TOPK, OP_PACT1, OP_PACT2, OP_POUT, OP_YOUT, OP_WT, OP_CVT, OP_FGEMM, OP_CVTTAB, OP_KEYS, OP_TOPK2, OP_PACT, OP_POUTLN, OP_GLA1, OP_GLA2, OP_GLA3, OP_LRU1, OP_LRU2, OP_LRU3, OP_EMBED4, OP_YOUT4, OP_MIX8, OP_CONV4, OP_CVT8, OP_WGATE, OP_LRUG2, OP_WKVF, OP_GLAF, OP_CVTTAB8, OP_CVTTAB8S, OP_PACTS, OP_PRED, OP_POUTS, OP_MIX6 };

constexpr int OPF_NOBAR = 0x100, OPF_GROUP = 0x200;
struct Op {
    const float *a, *b, *c, *d, *e, *f, *g, *h;
    float *o0, *o1, *o2, *o3, *o4, *o5;
    long long n;
    int code, i0, i1, i2, i3, i4, i5, i6;
};

#if defined(__HIP_DEVICE_COMPILE__)
#define NV_UNI(x) __builtin_amdgcn_readfirstlane(x)
#define NV_LAUNDER(p) asm volatile("" : "+s"(p))
#define NV_FENCE() asm volatile("" ::: "memory")
#else
#define NV_FENCE() do {} while (0)
#define NV_UNI(x) (x)
#define NV_LAUNDER(p) do {} while (0)
#endif
typedef unsigned short nvbf;
HD nvbf nv_f2bf(float f) { unsigned u; __builtin_memcpy(&u, &f, 4); return (nvbf)((u + 0x7fffu + ((u >> 16) & 1u)) >> 16); }
HD float nv_bf2f(nvbf h) { unsigned u = (unsigned)h << 16; float f; __builtin_memcpy(&f, &u, 4); return f; }
HD unsigned nv_f2e4m3(float f) {
    unsigned u; __builtin_memcpy(&u, &f, 4); const unsigned sign = (u >> 24) & 0x80u; const float a = fabsf(f);
    if (!(a < 448.f)) return sign | 0x7Eu;
    if (a < 0.015625f) return sign | (unsigned)rintf(a * 512.f);
    unsigned au = u & 0x7fffffffu; au += 0x7ffffu + ((au >> 20) & 1u);
    const unsigned e = ((au >> 23) & 0xffu) - 120u, m = (au >> 20) & 7u; unsigned code = (e << 3) | m; if (code > 0x7Eu) code = 0x7Eu;
    return sign | code; }
HD float nv_e4m32f(unsigned c) { const unsigned e = (c >> 3) & 15u, m = c & 7u; const float v = e ? ldexpf(1.f + m * 0.125f, (int)e - 7) : m * 0.001953125f; return (c & 0x80u) ? -v : v; }
HD int nv_rup(int x, int m) { return (x + m - 1) / m * m; }
struct alignas(16) NvF4 { float x, y, z, w; };
struct alignas(16) NvU4 { unsigned x, y, z, w; };
struct alignas(8) NvU2 { unsigned x, y; };
HD float nv_sigmoid(float x) { return 1.f / (1.f + expf(-x)); }
HD float nv_softplus(float x) { return fmaxf(x, 0.f) + log1pf(expf(-fabsf(x))); }
HD float nv_gelu(float x) { return 0.5f * x * (1.f + tanhf(0.7978845608028654f * (x + 0.044715f * x * x * x))); }

#define NV_INS16(tv, ti, val, idx) do { float _v = (val); int _i = (idx); _Pragma("unroll") for (int _j = 0; _j < 16; ++_j) { if (_v > tv[_j]) { float _tv = tv[_j]; int _ti = ti[_j]; tv[_j] = _v; ti[_j] = _i; _v = _tv; _i = _ti; } } } while (0)

HD void nv_elem(const int code, const Op& p, const Dm& dm, long long gid) {
    const int D = dm.D; float* const PO1 = p.o1; float* const PO2 = p.o2;
    switch (code) {
    case OP_EMBED: {
        int row = (int)(gid / D), c = (int)(gid % D); float v;
        if (row < dm.B * dm.T) { int bb = row / dm.T, t = row % dm.T; v = t < 16 ? p.c[t * D + c] : p.a[((size_t)bb * (dm.T - 16) + (t - 16)) * D + c]; }
        else v = p.b[(size_t)(row - dm.B * dm.T) * D + c];
        p.o0[gid] = v; ((nvbf*)p.o1)[gid] = nv_f2bf(v); } break;
    case OP_GEMM: {
        int N4 = p.i0 >> 2, K = p.i1; int m = (int)(gid / N4), nn = (int)(gid % N4) * 4; const float* A = p.a + (size_t)m * p.i2; const float* Bw = p.b + nn; float c0 = 0.f, c1 = 0.f, c2 = 0.f, c3 = 0.f;
        for (int k = 0; k < K; ++k) { float av = A[k]; if (p.i5 == 1) av = tanhf(av); else if (p.i5 == 2) av = nv_sigmoid(av); const NvF4 bv = *(const NvF4*)(Bw + (size_t)k * p.i3);
            c0 = fmaf(av, bv.x, c0); c1 = fmaf(av, bv.y, c1); c2 = fmaf(av, bv.z, c2); c3 = fmaf(av, bv.w, c3); }
        float* C = p.o0 + (size_t)m * p.i4 + nn; C[0] = c0; C[1] = c1; C[2] = c2; C[3] = c3; } break;
    case OP_LOGA: {
        int row = (int)(gid / 256), c = (int)(gid % 256); float z = p.c[c];
        for (int r = 0; r < 16; ++r) z = fmaf(p.a[(size_t)row * MIXIN + C_GLR + r], p.b[r * 256 + c], z);
        p.o0[gid] = expf(-nv_softplus(-z) * (1.f / 16.f)); } break;
    case OP_GLAF:
    case OP_GLA: {
        int s = (int)(gid / 512), h = (int)((gid / 128) % 4), col = (int)(gid % 128);
        float S[64];
        const float* sin = (s < dm.B) ? nullptr : p.c + (((size_t)(s - dm.B) * 4 + h) * 64) * 128 + col;
#pragma unroll
        for (int k = 0; k < 64; ++k) S[k] = sin ? sin[(size_t)k * 128] : 0.f;
        int r0 = seq_row0(dm, s), L = seq_len(dm, s);
        for (int t = 0; t < L; ++t) {
            const float* pr = p.a + (size_t)(r0 + t) * MIXIN; const float* la = p.b + (size_t)(r0 + t) * 256 + h * 64;
            float v = pr[C_V + h * 128 + col], o = 0.f;
#pragma unroll
            for (int k = 0; k < 64; ++k) { if ((k & 7) == 0) NV_FENCE(); S[k] = fmaf(la[k], S[k], pr[C_K + h * 64 + k] * v); o = fmaf(pr[C_Q + h * 64 + k] * 0.125f, S[k], o); }
            p.o0[(size_t)(r0 + t) * 512 + h * 128 + col] = o;
        }
        float* so = (s < dm.B) ? PO1 + (((size_t)s * 4 + h) * 64) * 128 + col : PO2 + (((size_t)(s - dm.B) * 4 + h) * 64) * 128 + col;
#pragma unroll
        for (int k = 0; k < 64; ++k) so[(size_t)k * 128] = S[k]; } break;
    case OP_GLA1: {
        const int NC = p.i0; const int u = NV_UNI((int)(gid / 128)), col = (int)(gid % 128); const int s = u / (4 * NC), h = (u / NC) % 4, c = u % NC;
        const int r0 = seq_row0(dm, s) + c * 64; int L = dm.T - c * 64; L = L > 64 ? 64 : L;
        float S[64];
#pragma unroll
        for (int k = 0; k < 64; ++k) S[k] = 0.f;
        float dprod = 1.f;
        for (int t = 0; t < L; ++t) {
            const float* pr = p.a + (size_t)(r0 + t) * MIXIN; const float* la = p.b + (size_t)(r0 + t) * 256 + h * 64; const float v = pr[C_V + h * 128 + col];
            if (col < 64) dprod *= la[col];
#pragma unroll
            for (int k = 0; k < 64; ++k) { if ((k & 7) == 0) NV_FENCE(); S[k] = fmaf(la[k], S[k], pr[C_K + h * 64 + k] * v); }
        }
        float* so = p.o0 + (size_t)u * 8192 + col;
#pragma unroll
        for (int k = 0; k < 64; ++k) so[(size_t)k * 128] = S[k];
        if (col < 64) p.o1[(size_t)u * 64 + col] = dprod; } break;
    case OP_GLA2: {
        const int NC = p.i0; const int pair = (int)(gid / 8192), e = (int)(gid % 8192), dk = e / 128; float S = 0.f;
        for (int c = 0; c < NC; ++c) { const size_t ix = ((size_t)pair * NC + c) * 8192 + e; const float l = p.o0[ix]; p.o0[ix] = S; S = fmaf(p.a[((size_t)pair * NC + c) * 64 + dk], S, l); }
        p.o1[gid] = S; } break;
    case OP_GLA3: {
        const int NC = p.i0; const int NP = dm.B * 4 * NC; const int u = NV_UNI((int)(gid / 128)) + (p.i1 ? NP : 0), col = (int)(gid % 128); int s, h, r0, L; const float* sin; float* sout = nullptr;
        if (u < NP) { s = u / (4 * NC); h = (u / NC) % 4; const int c = u % NC; r0 = seq_row0(dm, s) + c * 64; L = dm.T - c * 64; L = L > 64 ? 64 : L; sin = p.d + (size_t)u * 8192 + col; }
        else { const int q = u - NP; s = dm.B + q / 4; h = q % 4; r0 = seq_row0(dm, s); L = dm.DT; sin = p.c + (((size_t)(s - dm.B) * 4 + h) * 64) * 128 + col; sout = p.o2 + (((size_t)(s - dm.B) * 4 + h) * 64) * 128 + col; }
        float S[64];
#pragma unroll
        for (int k = 0; k < 64; ++k) S[k] = sin[(size_t)k * 128];
        for (int t = 0; t < L; ++t) {
            const float* pr = p.a + (size_t)(r0 + t) * MIXIN; const float* la = p.b + (size_t)(r0 + t) * 256 + h * 64; const float v = pr[C_V + h * 128 + col]; float o = 0.f;
#pragma unroll
            for (int k = 0; k < 64; ++k) { if ((k & 7) == 0) NV_FENCE(); S[k] = fmaf(la[k], S[k], pr[C_K + h * 64 + k] * v); o = fmaf(pr[C_Q + h * 64 + k] * 0.125f, S[k], o); }
            p.o0[(size_t)(r0 + t) * 512 + h * 128 + col] = o;
        }
        if (sout) {
#pragma unroll
            for (int k = 0; k < 64; ++k) sout[(size_t)k * 128] = S[k]; } } break;
    case OP_LRU1: {
        const int NC = p.i0; const int u = (int)(gid / 512), c = (int)(gid % 512); const int s = u / NC, ch = u % NC; const int r0 = seq_row0(dm, s) + ch * 64; int L = dm.T - ch * 64; L = L > 64 ? 64 : L; float hh = 0.f, ap = 1.f;
#pragma unroll 8
        for (int t = 0; t < L; ++t) { const size_t ix = (size_t)(r0 + t) * 512 + c; const float a = p.a[ix]; hh = fmaf(a, hh, p.b[ix]); ap *= a; }
        p.o0[gid] = ap; p.o1[gid] = hh; } break;
    case OP_LRU2: {
        const int NC = p.i0; const int s = (int)(gid / 512), c = (int)(gid % 512); float hh = 0.f;
        for (int ch = 0; ch < NC; ++ch) { const size_t ix = ((size_t)s * NC + ch) * 512 + c; const float l = p.o0[ix]; p.o0[ix] = hh; hh = fmaf(p.a[ix], hh, l); }
        p.o1[gid] = hh; } break;
    case OP_LRU3: {
        const int NC = p.i0; const int u = (int)(gid / 512), c = (int)(gid % 512); const int NP = dm.B * NC; int r0, L; float hh; float* hout = nullptr;
        if (u < NP) { const int s = u / NC, ch = u % NC; r0 = seq_row0(dm, s) + ch * 64; L = dm.T - ch * 64; L = L > 64 ? 64 : L; hh = p.e[gid]; }
        else { const int q = u - NP; r0 = seq_row0(dm, dm.B + q); L = dm.DT; hh = p.d[(size_t)q * 512 + c]; hout = p.o2 + (size_t)q * 512 + c; }
#pragma unroll 8
        for (int t = 0; t < L; ++t) { const size_t r = (size_t)(r0 + t); hh = fmaf(p.a[r * 512 + c], hh, p.b[r * 512 + c]); ((nvbf*)p.o0)[r * 1024 + 512 + c] = nv_f2bf(hh * nv_gelu(p.c[r * MIXIN + C_GB + c])); }
        if (hout) *hout = hh; } break;
    case OP_EMBED4: {
        const int D4 = D / 4; const int row = (int)(gid / D4), c = (int)(gid % D4) * 4; const float* src;
        if (row < dm.B * dm.T) { const int bb = row / dm.T, t = row % dm.T; src = t < 16 ? p.c + (size_t)t * D + c : p.a + ((size_t)bb * (dm.T - 16) + (t - 16)) * D + c; } else src = p.b + (size_t)(row - dm.B * dm.T) * D + c;
        const NvF4 v = *(const NvF4*)src; *(NvF4*)(p.o0 + (size_t)row * D + c) = v; NvU2 w; w.x = nv_f2bf(v.x) | ((unsigned)nv_f2bf(v.y) << 16); w.y = nv_f2bf(v.z) | ((unsigned)nv_f2bf(v.w) << 16); *(NvU2*)((nvbf*)p.o1 + (size_t)row * D + c) = w; } break;
    case OP_YOUT4: {
        const int D4 = D / 4; const int row = (int)(gid / D4), c = (int)(gid % D4) * 4; const NvF4 v = *(const NvF4*)(p.a + (size_t)row * D + c);
        if (row < dm.B * dm.T) { const int bb = row / dm.T, t = row % dm.T; if (t >= 16) *(NvF4*)(p.o0 + ((size_t)bb * (dm.T - 16) + (t - 16)) * D + c) = v; }
        else *(NvF4*)(p.o0 + ((size_t)dm.B * (dm.T - 16) + (row - dm.B * dm.T)) * D + c) = v; } break;
    case OP_MIX8: {
        const int D8 = D / 8; const int row = (int)(gid / D8), c = (int)(gid % D8) * 8; int s, t; row_to_seq(dm, row, s, t); const float* x = p.a + (size_t)row * D + c; float xp[8];
        if (t > 0) { for (int i = 0; i < 8; ++i) xp[i] = x[i - D]; } else if (s < dm.B) { for (int i = 0; i < 8; ++i) xp[i] = 0.f; } else { for (int i = 0; i < 8; ++i) xp[i] = p.b[(size_t)(s - dm.B) * D + c + i]; }
        unsigned w[4];
#pragma unroll
        for (int i = 0; i < 4; ++i) { const float lo = x[2 * i] + (xp[2 * i] - x[2 * i]) * p.c[c + 2 * i], hi = x[2 * i + 1] + (xp[2 * i + 1] - x[2 * i + 1]) * p.c[c + 2 * i + 1]; w[i] = nv_f2bf(lo) | ((unsigned)nv_f2bf(hi) << 16); }
        NvU4 o; o.x = w[0]; o.y = w[1]; o.z = w[2]; o.w = w[3]; *(NvU4*)((nvbf*)p.o0 + (size_t)row * D + c) = o; } break;
    case OP_MIX6: {
        const int D8 = D / 8; const int row = (int)(gid / D8), c = (int)(gid % D8) * 8; int s, t; row_to_seq(dm, row, s, t); const float* x = p.a + (size_t)row * D + c; float xv[8], dx[8];
        for (int i = 0; i < 8; ++i) xv[i] = x[i];
        if (t > 0) { for (int i = 0; i < 8; ++i) dx[i] = x[i - D] - xv[i]; } else if (s < dm.B) { for (int i = 0; i < 8; ++i) dx[i] = -xv[i]; } else { for (int i = 0; i < 8; ++i) dx[i] = p.b[(size_t)(s - dm.B) * D + c + i] - xv[i]; }
        for (int m = 0; m < 6; ++m) { const float* mu = p.c + (size_t)m * D + c; unsigned w[4];
#pragma unroll
            for (int i = 0; i < 4; ++i) w[i] = nv_f2bf(xv[2 * i] + dx[2 * i] * mu[2 * i]) | ((unsigned)nv_f2bf(xv[2 * i + 1] + dx[2 * i + 1] * mu[2 * i + 1]) << 16);
            NvU4 o; o.x = w[0]; o.y = w[1]; o.z = w[2]; o.w = w[3]; *(NvU4*)((nvbf*)p.o0 + (size_t)m * p.i0 * 0 + (size_t)m * (size_t)p.i1 * 1024 + (size_t)row * D + c) = o; } } break;
    case OP_CONV4: {
        const int row = (int)(gid / 128), c = (int)(gid % 128) * 4; int s, t; row_to_seq(dm, row, s, t); float acc[4];
        for (int q = 0; q < 4; ++q) acc[q] = p.d[c + q];
        for (int i = 0; i < 4; ++i) { const int j = t + i; const float* xv = nullptr;
            if (j < 3) { if (s >= dm.B) xv = p.b + ((size_t)(s - dm.B) * 3 + j) * 512 + c; } else xv = p.a + (size_t)(row - t + (j - 3)) * MIXIN + C_XB + c;
            if (xv) for (int q = 0; q < 4; ++q) acc[q] = fmaf(xv[q], p.c[i * 512 + c + q], acc[q]); }
        NvF4 o; o.x = acc[0]; o.y = acc[1]; o.z = acc[2]; o.w = acc[3]; *(NvF4*)(p.o0 + (size_t)row * 512 + c) = o;
        NvU2 w; w.x = nv_f2bf(acc[0]) | ((unsigned)nv_f2bf(acc[1]) << 16); w.y = nv_f2bf(acc[2]) | ((unsigned)nv_f2bf(acc[3]) << 16); *(NvU2*)((nvbf*)p.o1 + (size_t)row * 512 + c) = w; } break;
    case OP_CVT8: {
        const int K8 = p.i2 / 8; const int row = (int)(gid / K8), k = (int)(gid % K8) * 8; unsigned w[4] = {0u, 0u, 0u, 0u};
        if (row < dm.M && k < p.i0) { const float* sp = p.a + (size_t)row * p.i1 + k;
#pragma unroll
            for (int i = 0; i < 4; ++i) { float lo = sp[2 * i], hi = sp[2 * i + 1]; if (p.i3 == 1) { lo = tanhf(lo); hi = tanhf(hi); } else if (p.i3 == 2) { lo = nv_sigmoid(lo); hi = nv_sigmoid(hi); } w[i] = nv_f2bf(lo) | ((unsigned)nv_f2bf(hi) << 16); } }
        NvU4 o; o.x = w[0]; o.y = w[1]; o.z = w[2]; o.w = w[3]; *(NvU4*)((nvbf*)p.o0 + (size_t)row * p.i2 + k) = o; } break;
    case OP_WGATE: {
        const int n = (int)gid, pn = n >> 8, within = n & 127, isx = (n >> 7) & 1, c = pn * 128 + within, nb = c >> 6, e = c & 63; const float* w = isx ? p.b : p.a; nvbf* dst = (nvbf*)p.o0 + (size_t)n * 512;
        for (int k = 0; k < 512; ++k) dst[k] = ((k >> 6) == nb) ? nv_f2bf(w[((size_t)nb * 64 + (k & 63)) * 64 + e]) : (nvbf)0;
        if (n < 512) p.o1[n] = -8.f * nv_softplus(-p.c[n]); } break;
    case OP_LRUG2: {
        const int row = (int)(gid / 512), c = (int)(gid % 512), pn = c >> 7, within = c & 127; const nvbf* x = (const nvbf*)p.a + (size_t)row * 512; const nvbf* wa_ = (const nvbf*)p.b + (size_t)(pn * 256 + within) * 512; const nvbf* wx_ = wa_ + (size_t)128 * 512; float ga = 0.f, gx = 0.f;
        for (int k = 0; k < 512; ++k) { const float xv = nv_bf2f(x[k]); ga = fmaf(xv, nv_bf2f(wa_[k]), ga); gx = fmaf(xv, nv_bf2f(wx_[k]), gx); }
        const float gate_a = nv_sigmoid(ga + p.c[c]), gate_x = nv_sigmoid(gx + p.d[c]); const float log_at = gate_a * p.e[c];
        p.o0[gid] = expf(log_at); p.o1[gid] = sqrtf(-expm1f(2.f * log_at)) * (gate_x * p.f[gid]); } break;
    case OP_GLANORM: {
        int row = (int)(gid / 4), h = (int)(gid % 4); const float* o = p.a + (size_t)row * 512 + h * 128; float ss = 0.f;
        for (int c = 0; c < 128; ++c) ss = fmaf(o[c], o[c], ss);
        float rs = 1.f / sqrtf(ss * (1.f / 128.f) + 1e-5f);
        for (int c = 0; c < 128; ++c) { float r = p.b[(size_t)row * MIXIN + C_R + h * 128 + c]; ((nvbf*)p.o0)[(size_t)row * 1024 + h * 128 + c] = nv_f2bf(o[c] * rs * p.c[c] * (r * nv_sigmoid(r))); } } break;
    case OP_CONV: {
        int row = (int)(gid / 512), c = (int)(gid % 512); int s, t; row_to_seq(dm, row, s, t); float acc = p.d[c];
        for (int i = 0; i < 4; ++i) { int j = t + i; float xv;
            if (j < 3) xv = (s < dm.B) ? 0.f : p.b[((size_t)(s - dm.B) * 3 + j) * 512 + c]; else xv = p.a[(size_t)(row - t + (j - 3)) * MIXIN + C_XB + c];
            acc = fmaf(xv, p.c[i * 512 + c], acc); }
        p.o0[gid] = acc; } break;
    case OP_CONVOUT: {
        int s = (int)(gid / 1536), i = (int)((gid / 512) % 3), c = (int)(gid % 512); int L = seq_len(dm, s), r0 = seq_row0(dm, s); int j = L + i; float xv;
        if (j < 3) xv = (s < dm.B) ? 0.f : p.b[((size_t)(s - dm.B) * 3 + j) * 512 + c]; else xv = p.a[(size_t)(r0 + j - 3) * MIXIN + C_XB + c];
        float* o = (s < dm.B) ? PO1 + ((size_t)s * 3 + i) * 512 + c : PO2 + ((size_t)(s - dm.B) * 3 + i) * 512 + c; *o = xv; } break;
    case OP_LRUG: {
        int row = (int)(gid / 512), c = (int)(gid % 512), nb = c / 64, e = c % 64; const float* x = p.a + (size_t)row * 512 + nb * 64; float ga = p.c[c], gx = p.e[c];
        for (int dd = 0; dd < 64; ++dd) { ga = fmaf(x[dd], p.b[((size_t)nb * 64 + dd) * 64 + e], ga); gx = fmaf(x[dd], p.d[((size_t)nb * 64 + dd) * 64 + e], gx); }
        float gate_a = nv_sigmoid(ga), gate_x = nv_sigmoid(gx); float log_at = -8.f * gate_a * nv_softplus(-p.f[c]);
        p.o0[gid] = expf(log_at); p.o1[gid] = sqrtf(-expm1f(2.f * log_at)) * (gate_x * p.a[(size_t)row * 512 + c]); } break;
    case OP_LRUSCAN: {
        int s = (int)(gid / 512), c = (int)(gid % 512); int r0 = seq_row0(dm, s), L = seq_len(dm, s); float hh = (s < dm.B) ? 0.f : p.d[(size_t)(s - dm.B) * 512 + c];
        for (int t = 0; t < L; ++t) { size_t r = (size_t)(r0 + t); hh = fmaf(p.a[r * 512 + c], hh, p.b[r * 512 + c]); p.o0[r * 1024 + 512 + c] = hh * nv_gelu(p.c[r * MIXIN + C_GB + c]); }
        float* o = (s < dm.B) ? PO1 + (size_t)s * 512 + c : PO2 + (size_t)(s - dm.B) * 512 + c; *o = hh; } break;
    case OP_LNRES: {
        const float alpha = 1.6817928305074292f; float* x = p.o0 + (size_t)gid * D; const float* y = p.a + (size_t)gid * D; float mu = 0.f;
        for (int c = 0; c < D; ++c) mu += alpha * x[c] + y[c];
        mu /= D; float var = 0.f;
        for (int c = 0; c < D; ++c) { float v = alpha * x[c] + y[c] - mu; var = fmaf(v, v, var); }
        float rs = 1.f / sqrtf(var / D + 1e-5f);
        for (int c = 0; c < D; ++c) { const float o = (alpha * x[c] + y[c] - mu) * rs * p.b[c] + p.c[c]; x[c] = o; ((nvbf*)p.o1)[(size_t)gid * D + c] = nv_f2bf(o); } } break;
    case OP_MIX: {
        int row = (int)(gid / D), c = (int)(gid % D); int s, t; row_to_seq(dm, row, s, t); float x = p.a[gid];
        float xp = t > 0 ? p.a[gid - D] : ((s < dm.B) ? 0.f : p.b[(size_t)(s - dm.B) * D + c]);
        ((nvbf*)p.o0)[gid] = nv_f2bf(x + (xp - x) * p.c[c]); } break;
    case OP_SHIFTOUT: {
        int s = (int)(gid / D), c = (int)(gid % D); float v = p.a[(size_t)(seq_row0(dm, s) + seq_len(dm, s) - 1) * D + c];
        float* o = (s < dm.B) ? PO1 + (size_t)s * D + c : PO2 + (size_t)(s - dm.B) * D + c; *o = v; } break;
    case OP_RWKVPREP: {
        int row = (int)(gid / dm.RH), h = (int)(gid % dm.RH); size_t base = (size_t)row * D + h * 64; float ss = 0.f;
        for (int k = 0; k < 64; ++k) { float kv = p.o0[base + k] * p.d[h * 64 + k]; ss = fmaf(kv, kv, ss); }
        float inv = 1.f / fmaxf(sqrtf(ss), 1e-12f);
        for (int k = 0; k < 64; ++k) { int c = h * 64 + k; size_t ix = base + k;
            float w = -nv_softplus(-(p.a[c] + p.o1[ix])) - 0.5f; float dec = expf(-expf(w));
            float a = nv_sigmoid(p.b[c] + p.o2[ix]);
            float v = p.o3[ix]; if (p.i0) v = v + (p.o5[ix] - v) * nv_sigmoid(p.c[c] + p.f[ix]); else p.o5[ix] = v;
            float k0 = p.o0[ix]; const float kk = k0 * p.d[c] * inv; p.o4[ix] = -kk; p.o0[ix] = k0 * (1.f + (a - 1.f) * p.e[c]); p.o1[ix] = dec; p.o2[ix] = kk * a; p.o3[ix] = v; } } break;
    case OP_WKVF:
    case OP_WKV: {
        int RH = dm.RH; int s = p.i0 + (int)(gid / (RH * 64)), h = (int)((gid / 64) % RH), vr = (int)(gid % 64); float S[64];
        const float* sin = (s < dm.B) ? nullptr : p.g + (((size_t)(s - dm.B) * RH + h) * 64 + vr) * 64;
#pragma unroll
        for (int k = 0; k < 64; ++k) S[k] = sin ? sin[k] : 0.f;
        int r0 = seq_row0(dm, s), L = seq_len(dm, s);
        for (int t = 0; t < L; ++t) { size_t base = (size_t)(r0 + t) * D + h * 64; float sa = 0.f;
#pragma unroll
            for (int k = 0; k < 64; ++k) { if ((k & 7) == 0) NV_FENCE(); sa = fmaf(S[k], p.f[base + k], sa); }
            float vv = p.d[base + vr], y = 0.f;
#pragma unroll
            for (int k = 0; k < 64; ++k) { if ((k & 7) == 0) NV_FENCE(); S[k] = fmaf(S[k], p.b[base + k], fmaf(sa, p.e[base + k], vv * p.c[base + k])); y = fmaf(S[k], p.a[base + k], y); }
            p.o0[base + vr] = y; }
        float* so = (s < dm.B) ? PO1 + (((size_t)s * RH + h) * 64 + vr) * 64 : PO2 + (((size_t)(s - dm.B) * RH + h) * 64 + vr) * 64;
#pragma unroll
        for (int k = 0; k < 64; ++k) so[k] = S[k]; } break;
    case OP_RWKVPOST: {
        int row = (int)(gid / dm.RH), h = (int)(gid % dm.RH); size_t base = (size_t)row * D + h * 64; float mu = 0.f, bon = 0.f;
        for (int k = 0; k < 64; ++k) { mu += p.a[base + k]; bon = fmaf(p.b[base + k] * p.c[base + k], p.f[h * 64 + k], bon); }
        mu *= (1.f / 64.f); float var = 0.f;
        for (int k = 0; k < 64; ++k) { float dlt = p.a[base + k] - mu; var = fmaf(dlt, dlt, var); }
        float rs = 1.f / sqrtf(var * (1.f / 64.f) + 64e-5f);
        for (int k = 0; k < 64; ++k) { int c = h * 64 + k; float y = (p.a[base + k] - mu) * rs * p.g[c] + p.h[c] + bon * p.d[base + k]; ((nvbf*)p.o0)[base + k] = nv_f2bf(y * p.e[base + k]); } } break;
    case OP_QNORM: {
        float* q = p.o0 + (size_t)gid * 256; float mu = 0.f;
        for (int c = 0; c < 256; ++c) mu += q[c];
        mu *= (1.f / 256.f); float var = 0.f;
        for (int c = 0; c < 256; ++c) { float dlt = q[c] - mu; var = fmaf(dlt, dlt, var); }
        float rs = 1.f / sqrtf(var * (1.f / 256.f) + 1e-5f);
        for (int c = 0; c < 256; ++c) q[c] = (q[c] - mu) * rs; } break;
    case OP_SCORES: {
        int row = (int)(gid / 2048), r = (int)(gid % 2048), h = r / 256, half = (r / 128) & 1, key = r % 128;
        const float* q = p.a + (size_t)row * 2048 + h * 256 + half * 128; const float* kv = p.b + (((size_t)h * 2 + half) * 128 + key) * 128; float acc = 0.f;
        for (int dd = 0; dd < 128; ++dd) acc = fmaf(q[dd], kv[dd], acc);
        p.o0[gid] = acc; } break;
    case OP_TOPK: {
        const float* sc = p.a + (size_t)gid * 256; float tv[16]; int ti[16]; float* tmpv = p.o2 + (size_t)gid * 32; int* tmpi = (int*)p.o3 + (size_t)gid * 32;
        for (int half = 0; half < 2; ++half) {
#pragma unroll
            for (int j = 0; j < 16; ++j) { tv[j] = -3.0e38f; ti[j] = 0; }
            for (int k = 0; k < 128; ++k) NV_INS16(tv, ti, sc[half * 128 + k], k);
#pragma unroll
            for (int j = 0; j < 16; ++j) { tmpv[half * 16 + j] = tv[j]; tmpi[half * 16 + j] = ti[j]; }
        }
#pragma unroll
        for (int j = 0; j < 16; ++j) { tv[j] = -3.0e38f; ti[j] = 0; }
        for (int i = 0; i < 16; ++i) for (int j = 0; j < 16; ++j) NV_INS16(tv, ti, tmpv[i] + tmpv[16 + j], tmpi[i] * 128 + tmpi[16 + j]);
        float den = 0.f, ev[16];
#pragma unroll
        for (int j = 0; j < 16; ++j) { ev[j] = expf(tv[j] - tv[0]); den += ev[j]; }
        float inv = 1.f / den;
#pragma unroll
        for (int j = 0; j < 16; ++j) { p.o0[(size_t)gid * 16 + j] = ev[j] * inv; ((int*)p.o1)[(size_t)gid * 16 + j] = ti[j]; } } break;
    case OP_PACT1: {
        size_t pr = (size_t)(gid / 16); int part = (int)(gid % 16); int row = (int)(pr / 128); int e = ((const int*)p.d)[pr]; int w = D / 16;
        const float* u = p.b + (size_t)e * D + part * w; const float* x = p.a + (size_t)row * D + part * w; float acc = 0.f;
        for (int c = 0; c < w; ++c) acc = fmaf(u[c], x[c], acc);
        p.o0[gid] = acc; } break;
    case OP_PACT2: {
        float acc = 0.f; for (int i = 0; i < 16; ++i) acc += p.a[(size_t)gid * 16 + i];
        p.o0[gid] = p.c[gid] * nv_gelu(acc); } break;
    case OP_POUT: {
        int row = (int)(gid / D), c = (int)(gid % D); float acc = 0.f;
        for (int i = 0; i < 128; ++i) acc = fmaf(p.a[(size_t)row * 128 + i], p.c[(size_t)((const int*)p.b)[(size_t)row * 128 + i] * D + c], acc);
        p.o0[gid] = acc; } break;
    case OP_YOUT: {
        int row = (int)(gid / D), c = (int)(gid % D);
        if (row < dm.B * dm.T) { int bb = row / dm.T, t = row % dm.T; if (t >= 16) p.o0[((size_t)bb * (dm.T - 16) + (t - 16)) * D + c] = p.a[gid]; }
        else p.o0[((size_t)dm.B * (dm.T - 16) + (row - dm.B * dm.T)) * D + c] = p.a[gid]; } break;
    case OP_WT: {
        const int N = p.i0, K = p.i1, Np = p.i3, Kp = p.i4; const long long per8 = (long long)Np * (Kp / 8); const int bt = (int)(gid / per8); const long long r = gid % per8; const int k0 = (int)(r / Np) * 8, nn = (int)(r % Np);
        unsigned w[4];
#pragma unroll
        for (int i = 0; i < 4; ++i) { float lo = 0.f, hi = 0.f; if (nn < N) { if (k0 + 2 * i < K) lo = p.a[((size_t)bt * K + k0 + 2 * i) * p.i2 + nn]; if (k0 + 2 * i + 1 < K) hi = p.a[((size_t)bt * K + k0 + 2 * i + 1) * p.i2 + nn]; } w[i] = nv_f2bf(lo) | ((unsigned)nv_f2bf(hi) << 16); }
        NvU4 o; o.x = w[0]; o.y = w[1]; o.z = w[2]; o.w = w[3];
        *(NvU4*)((nvbf*)p.o0 + (size_t)bt * Np * Kp + (size_t)nn * Kp + k0) = o; } break;
    case OP_CVT: {
        const int Kp = p.i2; const int row = (int)(gid / Kp), k = (int)(gid % Kp); float v = 0.f;
        if (row < dm.M && k < p.i0) { v = p.a[(size_t)row * p.i1 + k]; if (p.i3 == 1) v = tanhf(v); else if (p.i3 == 2) v = nv_sigmoid(v); }
        ((nvbf*)p.o0)[gid] = nv_f2bf(v); } break;
    case OP_FGEMM: {
        const int N = p.i0; const int m = (int)(gid / N), nn = (int)(gid % N); const nvbf* A = (const nvbf*)p.a + (size_t)m * p.i2 + ((p.i6 & 2) ? (nn / 256) * 256 : 0); const nvbf* Bt = (const nvbf*)p.b + (size_t)nn * p.i3; float acc = 0.f;
        for (int k = 0; k < p.i1; ++k) acc = fmaf(nv_bf2f(A[k]), nv_bf2f(Bt[k]), acc);
        if (p.i6 & 1) ((nvbf*)p.o0)[(size_t)m * p.i4 + nn] = nv_f2bf(acc); else p.o0[(size_t)m * p.i4 + nn] = acc; } break;
    case OP_CVTTAB: {
        const NvF4 v0 = *(const NvF4*)(p.a + gid * 8), v1 = *(const NvF4*)(p.a + gid * 8 + 4); NvU4 o;
        o.x = nv_f2bf(v0.x) | ((unsigned)nv_f2bf(v0.y) << 16); o.y = nv_f2bf(v0.z) | ((unsigned)nv_f2bf(v0.w) << 16); o.z = nv_f2bf(v1.x) | ((unsigned)nv_f2bf(v1.y) << 16); o.w = nv_f2bf(v1.z) | ((unsigned)nv_f2bf(v1.w) << 16);
        *(NvU4*)((nvbf*)p.o0 + gid * 8) = o; } break;
    case OP_CVTTAB8: {
        const float sc = (float)(1 << p.i0); const float* sp = p.a + gid * 16; unsigned w[4];
#pragma unroll
        for (int q = 0; q < 4; ++q) { const NvF4 v = *(const NvF4*)(sp + 4 * q); w[q] = nv_f2e4m3(v.x * sc) | (nv_f2e4m3(v.y * sc) << 8) | (nv_f2e4m3(v.z * sc) << 16) | (nv_f2e4m3(v.w * sc) << 24); }
        NvU4 o; o.x = w[0]; o.y = w[1]; o.z = w[2]; o.w = w[3]; *(NvU4*)((unsigned char*)p.o0 + gid * 16) = o; } break;
    case OP_CVTTAB8S: {
        const float sc = (float)(1 << p.i0); const int per = D / 16; const int e = (int)(gid / per), c0 = (int)(gid % per) * 16; const float* sp = p.a + (size_t)e * D + c0; unsigned w[4];
#pragma unroll
        for (int q = 0; q < 4; ++q) { const NvF4 v = *(const NvF4*)(sp + 4 * q); w[q] = nv_f2e4m3(v.x * sc) | (nv_f2e4m3(v.y * sc) << 8) | (nv_f2e4m3(v.z * sc) << 16) | (nv_f2e4m3(v.w * sc) << 24); }
        NvU4 o; o.x = w[0]; o.y = w[1]; o.z = w[2]; o.w = w[3]; *(NvU4*)((unsigned char*)p.o0 + ((size_t)(c0 >> 7) * 16384 + e) * 128 + (c0 & 127)) = o; } break;
    case OP_PACTS: {
        const long long NP = (long long)dm.M * 128; const int sl = (int)(gid / NP); const long long pr = gid % NP; const int row = (int)(pr / 128); const int e = ((const int*)p.d)[pr];
        const unsigned char* u = (const unsigned char*)p.b + ((size_t)sl * 16384 + e) * 128; const nvbf* x = (const nvbf*)p.a + (size_t)row * D + sl * 128; float acc = 0.f;
        for (int c = 0; c < 128; ++c) acc = fmaf(nv_e4m32f(u[c]), nv_bf2f(x[c]), acc);
        p.o0[gid] = acc; } break;
    case OP_PRED: {
        const long long NP = (long long)dm.M * 128; float acc = 0.f; for (int sl = 0; sl < p.i0; ++sl) acc += p.a[(size_t)sl * NP + gid];
        p.o0[gid] = p.c[gid] * nv_gelu(acc * (1.f / 128.f)); } break;
    case OP_POUTS: {
        const int row = (int)(gid / D), c = (int)(gid % D); const unsigned char* vb = (const unsigned char*)p.c + (size_t)(c >> 7) * 16384 * 128 + (c & 127); float acc = 0.f;
        for (int i = 0; i < 128; ++i) acc = fmaf(p.a[(size_t)row * 128 + i] * (1.f / 64.f), nv_e4m32f(vb[(size_t)((const int*)p.b)[(size_t)row * 128 + i] * 128]), acc);
        p.o0[gid] = acc; } break;
    case OP_KEYS: {
        const int h = (int)(gid / 256), nrow = (int)(gid % 256), half = nrow >> 7; const float* src = p.a + (((size_t)h * 2 + half) * 128 + (nrow & 127)) * 128; nvbf* dst = (nvbf*)p.o0 + ((size_t)h * 256 + nrow) * 256; float ks = 0.f;
        for (int k = 0; k < 256; ++k) { nvbf b = 0; if ((k >> 7) == half) { b = nv_f2bf(src[k & 127]); ks += nv_bf2f(b); } dst[k] = b; }
        p.o1[gid] = ks; } break;
    case OP_TOPK2: {
        const int h = (int)(gid % 8); const float* sc = p.a + (size_t)gid * 256; const nvbf* q = (const nvbf*)p.b + (size_t)gid * 256; const float* ksum = p.c + h * 256; float mu = 0.f;
        for (int c = 0; c < 256; ++c) mu += nv_bf2f(q[c]);
        mu *= (1.f / 256.f); float var = 0.f;
        for (int c = 0; c < 256; ++c) { float dlt = nv_bf2f(q[c]) - mu; var = fmaf(dlt, dlt, var); }
        const float rs = 1.f / sqrtf(var * (1.f / 256.f) + 1e-5f);
        float tv[16]; int ti[16]; float* tmpv = p.o2 + (size_t)gid * 32; int* tmpi = (int*)p.o3 + (size_t)gid * 32;
        for (int half = 0; half < 2; ++half) {
#pragma unroll
            for (int j = 0; j < 16; ++j) { tv[j] = -3.0e38f; ti[j] = 0; }
            for (int k = 0; k < 128; ++k) NV_INS16(tv, ti, rs * (sc[half * 128 + k] - mu * ksum[half * 128 + k]), k);
#pragma unroll
            for (int j = 0; j < 16; ++j) { tmpv[half * 16 + j] = tv[j]; tmpi[half * 16 + j] = ti[j]; }
        }
#pragma unroll
        for (int j = 0; j < 16; ++j) { tv[j] = -3.0e38f; ti[j] = 0; }
        for (int i = 0; i < 16; ++i) for (int j = 0; j < 16; ++j) NV_INS16(tv, ti, tmpv[i] + tmpv[16 + j], tmpi[i] * 128 + tmpi[16 + j]);
        float den = 0.f, ev[16];
#pragma unroll
        for (int j = 0; j < 16; ++j) { ev[j] = expf(tv[j] - tv[0]); den += ev[j]; }
        float inv = 1.f / den;
#pragma unroll
        for (int j = 0; j < 16; ++j) { p.o0[(size_t)gid * 16 + j] = ev[j] * inv; ((int*)p.o1)[(size_t)gid * 16 + j] = ti[j]; } } break;
    case OP_PACT: {
        const int row = (int)(gid / 128); const int e = ((const int*)p.d)[gid]; const unsigned char* u = (const unsigned char*)p.b + (size_t)e * D; const nvbf* x = (const nvbf*)p.a + (size_t)row * D; float acc = 0.f;
        for (int c = 0; c < D; ++c) acc = fmaf(nv_e4m32f(u[c]), nv_bf2f(x[c]), acc);
        p.o0[gid] = p.c[gid] * nv_gelu(acc * (1.f / 128.f)); } break;
#if defined(HOST_TEST)
    case OP_POUTLN: {
        const float alpha = 1.6817928305074292f; float* x = p.o0 + (size_t)gid * D; std::vector<float> y(D, 0.f);
        for (int i = 0; i < 128; ++i) { const float cf = p.a[(size_t)gid * 128 + i] * (1.f / 64.f); const unsigned char* v = (const unsigned char*)p.c + (size_t)((const int*)p.b)[(size_t)gid * 128 + i] * D; for (int c = 0; c < D; ++c) y[c] = fmaf(cf, nv_e4m32f(v[c]), y[c]); }
        float mu = 0.f; for (int c = 0; c < D; ++c) { y[c] = alpha * x[c] + y[c]; mu += y[c]; }
        mu /= D; float var = 0.f; for (int c = 0; c < D; ++c) { float dlt = y[c] - mu; var = fmaf(dlt, dlt, var); }
        const float rs = 1.f / sqrtf(var / D + 1e-5f);
        for (int c = 0; c < D; ++c) { const float o = (y[c] - mu) * rs * p.d[c] + p.e[c]; x[c] = o; ((nvbf*)p.o1)[(size_t)gid * D + c] = nv_f2bf(o); } } break;
#endif
    default: break;
    }
}

struct NvIO { const float* const* in; float* out; char* ws; size_t ws_size; };
template <class Launch> HD void nv_forward(const NvIO& io, const Dm& dm, Launch&& launch) {
    const int D = dm.D, M = dm.M, B = dm.B, DB = dm.DB, RH = dm.RH; const size_t MD = (size_t)M * D;
    float* y_prompt = io.out; float* y_sample = y_prompt + (size_t)B * (dm.T - 16) * D; float* p_gla = y_sample + (size_t)DB * dm.DT * D;
    float* p_h = p_gla + (size_t)2 * B * 4 * 64 * 128; float* p_conv = p_h + (size_t)2 * B * 512; float* p_rwkv = p_conv + (size_t)2 * B * 3 * 512;
    float* p_shift = p_rwkv + (size_t)2 * B * RH * 4096; float* s_gla = p_shift + (size_t)2 * B * D; float* s_h = s_gla + (size_t)2 * DB * 4 * 64 * 128;
    float* s_conv = s_h + (size_t)2 * DB * 512; float* s_rwkv = s_conv + (size_t)2 * DB * 3 * 512; float* s_shift = s_rwkv + (size_t)2 * DB * RH * 4096;
    float* w = (float*)io.ws; size_t off = 0; auto take = [&](size_t n) __attribute__((always_inline)) { float* r = w + off; off += (n + 63) & ~(size_t)63; return r; };
    float* X = take(MD); float* VFIRST = take(MD); float* MOUT = take(MD);
    auto mk = [&](int code, long long n) __attribute__((always_inline)) { Op o{}; o.code = code; o.n = n; return o; };
    const int Mp = nv_rup(M, 256), Dp = nv_rup(D, 256), Dk = nv_rup(D, 128);
    auto takeh = [&](size_t n) __attribute__((always_inline)) { return (nvbf*)take((n + 1) / 2); };
    nvbf* ABF = takeh((size_t)Mp * 1024 > (size_t)Mp * Dk ? (size_t)Mp * 1024 : (size_t)Mp * Dk);
    const size_t SZ_WIN = (size_t)2816 * Dk, SZ_WOUT = (size_t)Dp * 1024, SZ_DD = (size_t)Dp * Dk, SZ_DN = (size_t)256 * Dk, SZ_UP = (size_t)Dp * 128, SZ_WQ = (size_t)2048 * Dk;
    nvbf* WT_WIN = takeh(2 * SZ_WIN); nvbf* WT_WOUT = takeh(2 * SZ_WOUT); nvbf* WT_WR = takeh(2 * SZ_DD); nvbf* WT_WK = takeh(2 * SZ_DD); nvbf* WT_WV = takeh(2 * SZ_DD); nvbf* WT_WO = takeh(2 * SZ_DD);
    nvbf* WT_W1 = takeh(2 * SZ_DN); nvbf* WT_W2 = takeh(2 * SZ_UP); nvbf* WT_A1 = takeh(2 * SZ_DN); nvbf* WT_A2 = takeh(2 * SZ_UP); nvbf* WT_G1 = takeh(2 * SZ_DN); nvbf* WT_G2 = takeh(2 * SZ_UP);
    nvbf* WT_V1 = takeh(SZ_DN); nvbf* WT_V2 = takeh(SZ_UP); nvbf* WT_WQ = takeh(4 * SZ_WQ); nvbf* WT_WG = takeh((size_t)2 * 1024 * 512); float* SPL = take(2 * 512);
    nvbf* UB = takeh((size_t)16384 * D / 2); nvbf* VB = takeh((size_t)16384 * D / 2); nvbf* KB = takeh((size_t)8 * 256 * 256); float* KSUM = take(8 * 256);
    const size_t scratch0 = off;
    auto nb = [&](Op o) __attribute__((always_inline)) { o.code |= OPF_NOBAR; launch(o); };
    auto wt = [&](const float* W, int K, int N, int batch, nvbf* dst) __attribute__((always_inline)) { const int Np = nv_rup(N, 256), Kp = nv_rup(K, 128); Op o = mk(OP_WT, (long long)batch * Np * (Kp / 8)); o.a = W; o.o0 = (float*)dst; o.i0 = N; o.i1 = K; o.i2 = N; o.i3 = Np; o.i4 = Kp; nb(o); };
    wt(io.in[10], D, MIXIN, 2, WT_WIN); wt(io.in[21], 1024, D, 2, WT_WOUT); wt(io.in[23], D, D, 2, WT_WR); wt(io.in[24], D, D, 2, WT_WK); wt(io.in[25], D, D, 2, WT_WV); wt(io.in[26], D, D, 2, WT_WO);
    wt(io.in[28], D, 64, 2, WT_W1); wt(io.in[29], 64, D, 2, WT_W2); wt(io.in[31], D, 64, 2, WT_A1); wt(io.in[32], 64, D, 2, WT_A2); wt(io.in[36], D, 128, 2, WT_G1); wt(io.in[37], 128, D, 2, WT_G2);
    wt(io.in[34], D, 32, 1, WT_V1); wt(io.in[35], 32, D, 1, WT_V2); wt(io.in[43], D, 2048, 4, WT_WQ);
    for (int jj = 0; jj < 2; ++jj) { Op o = mk(OP_WGATE, 1024); o.a = io.in[16] + (size_t)jj * 8 * 64 * 64; o.b = io.in[18] + (size_t)jj * 8 * 64 * 64; o.c = io.in[20] + (size_t)jj * 512; o.o0 = (float*)(WT_WG + (size_t)jj * 1024 * 512); o.o1 = SPL + (size_t)jj * 512; nb(o); }
    auto fgemm = [&](const nvbf* Wt, float* C, int ldc, int N, int K) __attribute__((always_inline)) {
        const int Kp = nv_rup(K, 128), Np = nv_rup(N, 256);
        Op o = mk(OP_FGEMM, (long long)M * N); o.a = (const float*)ABF; o.b = (const float*)Wt; o.o0 = C; o.i0 = N; o.i1 = Kp; o.i2 = Kp; o.i3 = Kp; o.i4 = ldc; o.i5 = Np; launch(o); };
    auto gemm = [&](const float* A, int lda, const nvbf* Wt, float* C, int ldc, int N, int K, int act) __attribute__((always_inline)) {
        const int Kp = nv_rup(K, 128);
        { Op o = mk(OP_CVT8, (long long)Mp * (Kp / 8)); o.a = A; o.o0 = (float*)ABF; o.i0 = K; o.i1 = lda; o.i2 = Kp; o.i3 = act; launch(o); }
        fgemm(Wt, C, ldc, N, K); };
    { Op o = mk(OP_EMBED4, (long long)MD / 4); o.a = io.in[0]; o.b = io.in[1]; o.c = io.in[7]; o.o0 = X; o.o1 = (float*)ABF; launch(o); }
    const float* const w_outer = w; float* const out_outer = io.out;
    for (int layer = 0; layer < 4; ++layer) {
        float* wl = (float*)w_outer; float* ol = out_outer; NV_LAUNDER(wl); NV_LAUNDER(ol);
#define NV_RB(T, v) T const v##_rb = (T)((char*)wl + ((const char*)(v) - (const char*)w_outer))
#define NV_RO(v) float* const v##_rb = (float*)((char*)ol + ((const char*)(v) - (const char*)out_outer))
        NV_RB(float*, X); NV_RB(float*, VFIRST); NV_RB(float*, MOUT); NV_RB(nvbf*, ABF); NV_RB(nvbf*, WT_WIN); NV_RB(nvbf*, WT_WOUT); NV_RB(nvbf*, WT_WR); NV_RB(nvbf*, WT_WK); NV_RB(nvbf*, WT_WV); NV_RB(nvbf*, WT_WO);
        NV_RB(nvbf*, WT_W1); NV_RB(nvbf*, WT_W2); NV_RB(nvbf*, WT_A1); NV_RB(nvbf*, WT_A2); NV_RB(nvbf*, WT_G1); NV_RB(nvbf*, WT_G2); NV_RB(nvbf*, WT_V1); NV_RB(nvbf*, WT_V2); NV_RB(nvbf*, WT_WQ); NV_RB(nvbf*, WT_WG);
        NV_RB(float*, SPL); NV_RB(nvbf*, UB); NV_RB(nvbf*, VB); NV_RB(nvbf*, KB); NV_RB(float*, KSUM);
        NV_RO(p_gla); NV_RO(p_h); NV_RO(p_conv); NV_RO(p_rwkv); NV_RO(p_shift); NV_RO(s_gla); NV_RO(s_h); NV_RO(s_conv); NV_RO(s_rwkv); NV_RO(s_shift);
#undef NV_RB
#undef NV_RO
        { float* const X = X_rb; float* const VFIRST = VFIRST_rb; float* const MOUT = MOUT_rb; nvbf* const ABF = ABF_rb; nvbf* const WT_WIN = WT_WIN_rb; nvbf* const WT_WOUT = WT_WOUT_rb; nvbf* const WT_WR = WT_WR_rb; nvbf* const WT_WK = WT_WK_rb;
          nvbf* const WT_WV = WT_WV_rb; nvbf* const WT_WO = WT_WO_rb; nvbf* const WT_W1 = WT_W1_rb; nvbf* const WT_W2 = WT_W2_rb; nvbf* const WT_A1 = WT_A1_rb; nvbf* const WT_A2 = WT_A2_rb; nvbf* const WT_G1 = WT_G1_rb; nvbf* const WT_G2 = WT_G2_rb;
          nvbf* const WT_V1 = WT_V1_rb; nvbf* const WT_V2 = WT_V2_rb; nvbf* const WT_WQ = WT_WQ_rb; nvbf* const WT_WG = WT_WG_rb; float* const SPL = SPL_rb; nvbf* const UB = UB_rb; nvbf* const VB = VB_rb; nvbf* const KB = KB_rb; float* const KSUM = KSUM_rb;
          float* const p_gla = p_gla_rb; float* const p_h = p_h_rb; float* const p_conv = p_conv_rb; float* const p_rwkv = p_rwkv_rb; float* const p_shift = p_shift_rb; float* const s_gla = s_gla_rb; float* const s_h = s_h_rb; float* const s_conv = s_conv_rb;
          float* const s_rwkv = s_rwkv_rb; float* const s_shift = s_shift_rb; float* const w = wl; (void)SPL; (void)WT_WG; (void)VFIRST;
        const int j = layer / 2; off = scratch0;
        { Op o = mk(OP_CVTTAB8S, (long long)16384 * D / 16); o.a = io.in[45] + (size_t)layer * 16384 * D; o.o0 = (float*)UB; o.i0 = 7; nb(o); }
        { Op o = mk(OP_CVTTAB8S, (long long)16384 * D / 16); o.a = io.in[46] + (size_t)layer * 16384 * D; o.o0 = (float*)VB; o.i0 = 6; nb(o); }
        { Op o = mk(OP_KEYS, 8 * 256); o.a = io.in[44] + (size_t)layer * 8 * 2 * 128 * 128; o.o0 = (float*)KB; o.o1 = KSUM; nb(o); }
        if (layer % 2 == 0) {
            float* PROJ = take((size_t)M * MIXIN); float* LOGA = take((size_t)M * 256); float* O = take((size_t)M * 512); float* MIXO = (float*)ABF;
            float* XC = take((size_t)M * 512); nvbf* XCB = takeh((size_t)Mp * 512); float* AT = take((size_t)M * 512); float* BT = take((size_t)M * 512);
            const int NC = (dm.T + 63) / 64; float* LEND = take((size_t)B * 4 * NC * 8192); float* DEC = take((size_t)B * 4 * NC * 64); float* LA = take((size_t)B * NC * 512); float* LB = take((size_t)B * NC * 512);
            fgemm(WT_WIN + (size_t)j * SZ_WIN, PROJ, MIXIN, MIXIN, D);
            { Op o = mk(OP_LOGA, (long long)M * 256); o.a = PROJ; o.b = io.in[11] + (size_t)j * 16 * 256; o.c = io.in[12] + (size_t)j * 256; o.o0 = LOGA; nb(o); }
            { Op o = mk(OP_CONV4, (long long)M * 128); o.a = PROJ; o.b = io.in[4] + (size_t)j * DB * 3 * 512; o.c = io.in[14] + (size_t)j * 4 * 512; o.d = io.in[15] + (size_t)j * 512; o.o0 = XC; o.o1 = (float*)XCB; nb(o); }
            { Op o = mk(OP_CONVOUT, (long long)dm.NSEQ * 1536); o.a = PROJ; o.b = io.in[4] + (size_t)j * DB * 3 * 512; o.o1 = p_conv + (size_t)j * B * 3 * 512; o.o2 = s_conv + (size_t)j * DB * 3 * 512; launch(o); }
            { Op o = mk(OP_GLAF, (long long)B * 512); o.a = PROJ; o.b = LOGA; o.o0 = O; o.o1 = p_gla + (size_t)j * B * 4 * 64 * 128; nb(o); }
            { Op o = mk(OP_GLA3, (long long)(DB * 4) * 128); o.a = PROJ; o.b = LOGA; o.c = io.in[2] + (size_t)j * DB * 4 * 64 * 128; o.d = LEND; o.o0 = O; o.o2 = s_gla + (size_t)j * DB * 4 * 64 * 128; o.i0 = NC; o.i1 = 1; nb(o); }
            { Op o = mk(OP_LRUG2, (long long)M * 512); o.a = (const float*)XCB; o.b = (const float*)(WT_WG + (size_t)j * 1024 * 512); o.c = io.in[17] + (size_t)j * 512; o.d = io.in[19] + (size_t)j * 512; o.e = SPL + (size_t)j * 512; o.f = XC; o.o0 = AT; o.o1 = BT; launch(o); }
            { Op o = mk(OP_GLANORM, (long long)M * 4); o.a = O; o.b = PROJ; o.c = io.in[13] + (size_t)j * 128; o.o0 = MIXO; nb(o); }
            { Op o = mk(OP_LRU1, (long long)B * NC * 512); o.a = AT; o.b = BT; o.o0 = LA; o.o1 = LB; o.i0 = NC; launch(o); }
            { Op o = mk(OP_LRU2, (long long)B * 512); o.a = LA; o.o0 = LB; o.o1 = p_h + (size_t)j * B * 512; o.i0 = NC; launch(o); }
            { Op o = mk(OP_LRU3, (long long)(B * NC + DB) * 512); o.a = AT; o.b = BT; o.c = PROJ; o.d = io.in[3] + (size_t)j * DB * 512; o.e = LB; o.o0 = MIXO; o.o2 = s_h + (size_t)j * DB * 512; o.i0 = NC; launch(o); }
            fgemm(WT_WOUT + (size_t)j * SZ_WOUT, MOUT, D, D, 1024);
        } else {
            float* Y = take(MD); float* R = take(MD); float* K = take(MD); float* V = take(MD); float* G = take(MD); float* KK = take(MD);
            const size_t XMSZ = (size_t)Mp * D;
            float* WAV = take(3 * MD > 3 * XMSZ ? 3 * MD : 3 * XMSZ); float* Wd = WAV; float* Aa = WAV + MD; float* Vg = WAV + 2 * MD; nvbf* XM6 = (nvbf*)WAV;
            float* HLw = take((size_t)M * 64); float* HLa = take((size_t)M * 64); float* HLg = take((size_t)M * 128); float* HLv = take((size_t)M * 32);
            nvbf* ABw = takeh((size_t)Mp * 128); nvbf* ABa = takeh((size_t)Mp * 128); nvbf* ABg = takeh((size_t)Mp * 128); nvbf* ABv = takeh((size_t)Mp * 128);
            const float* shin = io.in[6] + (size_t)j * DB * D; const float* mu = io.in[22] + (size_t)j * 6 * D;
            { Op o = mk(OP_SHIFTOUT, (long long)dm.NSEQ * D); o.a = X; o.o1 = p_shift + (size_t)j * B * D; o.o2 = s_shift + (size_t)j * DB * D; nb(o); }
            { Op o = mk(OP_MIX6, (long long)MD / 8); o.a = X; o.b = shin; o.c = mu; o.o0 = (float*)XM6; o.i1 = (int)(XMSZ / 1024); launch(o); }
            auto gg = [&](const nvbf* A, const nvbf* Wt, float* C, int ldc, int N, int K, bool last) __attribute__((always_inline)) { const int Kp = nv_rup(K, 128), Np = nv_rup(N, 256);
                Op o = mk(OP_FGEMM, (long long)M * N); o.a = (const float*)A; o.b = (const float*)Wt; o.o0 = C; o.i0 = N; o.i1 = Kp; o.i2 = Kp; o.i3 = Kp; o.i4 = ldc; o.i5 = Np; if (!last) o.code |= OPF_GROUP; launch(o); };
            gg(XM6 + 0 * XMSZ, WT_WR + (size_t)j * SZ_DD, R, D, D, D, false); gg(XM6 + 2 * XMSZ, WT_WK + (size_t)j * SZ_DD, K, D, D, D, false); gg(XM6 + 3 * XMSZ, WT_WV + (size_t)j * SZ_DD, V, D, D, D, false);
            gg(XM6 + 1 * XMSZ, WT_W1 + (size_t)j * SZ_DN, HLw, 64, 64, D, false); gg(XM6 + 4 * XMSZ, WT_A1 + (size_t)j * SZ_DN, HLa, 64, 64, D, false);
            if (j > 0) gg(XM6 + 3 * XMSZ, WT_V1 + (size_t)(j - 1) * SZ_DN, HLv, 32, 32, D, false);
            gg(XM6 + 5 * XMSZ, WT_G1 + (size_t)j * SZ_DN, HLg, 128, 128, D, true);
            auto cv = [&](const float* A, int K, nvbf* dst, int act, bool last) __attribute__((always_inline)) { Op o = mk(OP_CVT8, (long long)Mp * 16); o.a = A; o.o0 = (float*)dst; o.i0 = K; o.i1 = K; o.i2 = 128; o.i3 = act; if (last) launch(o); else nb(o); };
            cv(HLw, 64, ABw, 1, false); cv(HLa, 64, ABa, 0, false); if (j > 0) cv(HLv, 32, ABv, 0, false); cv(HLg, 128, ABg, 2, true);
            gg(ABw, WT_W2 + (size_t)j * SZ_UP, Wd, D, D, 64, false); gg(ABa, WT_A2 + (size_t)j * SZ_UP, Aa, D, D, 64, false); if (j > 0) gg(ABv, WT_V2 + (size_t)(j - 1) * SZ_UP, Vg, D, D, 32, false); gg(ABg, WT_G2 + (size_t)j * SZ_UP, G, D, D, 128, true);
            { Op o = mk(OP_RWKVPREP, (long long)M * RH); o.a = io.in[27] + (size_t)j * D; o.b = io.in[30] + (size_t)j * D; o.c = j > 0 ? io.in[33] + (size_t)(j - 1) * D : nullptr; o.d = io.in[38] + (size_t)j * D; o.e = io.in[39] + (size_t)j * D; o.f = Vg;
              o.o0 = K; o.o1 = Wd; o.o2 = Aa; o.o3 = V; o.o4 = KK; o.o5 = VFIRST; o.i0 = j > 0 ? 1 : 0; launch(o); }
            { Op o = mk(OP_WKVF, (long long)dm.NSEQ * RH * 64); o.a = R; o.b = Wd; o.c = K; o.d = V; o.e = Aa; o.f = KK; o.g = io.in[5] + (size_t)j * DB * RH * 4096; o.o0 = Y; o.o1 = p_rwkv + (size_t)j * B * RH * 4096; o.o2 = s_rwkv + (size_t)j * DB * RH * 4096; o.i0 = 0; launch(o); }
            { Op o = mk(OP_RWKVPOST, (long long)M * RH); o.a = Y; o.b = R; o.c = K; o.d = V; o.e = G; o.f = io.in[40] + (size_t)j * RH * 64; o.g = io.in[41] + (size_t)j * D; o.h = io.in[42] + (size_t)j * D; o.o0 = (float*)ABF; launch(o); }
            fgemm(WT_WO + (size_t)j * SZ_DD, MOUT, D, D, D);
        }
        { Op o = mk(OP_LNRES, M); o.a = MOUT; o.b = io.in[8] + (size_t)(layer * 2 + 0) * D; o.c = io.in[9] + (size_t)(layer * 2 + 0) * D; o.o0 = X; o.o1 = (float*)ABF; launch(o); }
        off = scratch0;
        { nvbf* Q = takeh((size_t)Mp * 2048); float* SC = take((size_t)M * 2048); float* GATE = take((size_t)M * 128); float* EIDX = take((size_t)M * 128); float* TMPV = take((size_t)M * 256); float* TMPI = take((size_t)M * 256);
          float* COEF = take((size_t)M * 128);
          { Op o = mk(OP_FGEMM, (long long)M * 2048); o.a = (const float*)ABF; o.b = (const float*)(WT_WQ + (size_t)layer * SZ_WQ); o.o0 = (float*)Q; o.i0 = 2048; o.i1 = Dk; o.i2 = Dk; o.i3 = Dk; o.i4 = 2048; o.i5 = 2048; o.i6 = 1; launch(o); }
          { Op o = mk(OP_FGEMM, (long long)M * 2048); o.a = (const float*)Q; o.b = (const float*)KB; o.o0 = SC; o.i0 = 2048; o.i1 = 256; o.i2 = 2048; o.i3 = 256; o.i4 = 2048; o.i5 = 2048; o.i6 = 2; launch(o); }
          { Op o = mk(OP_TOPK2, (long long)M * 8); o.a = SC; o.b = (const float*)Q; o.c = KSUM; o.o0 = GATE; o.o1 = EIDX; o.o2 = TMPV; o.o3 = TMPI; launch(o); }
          { const int NS = D / 128; float* PART = take((size_t)NS * M * 128); float* YBUF = take(MD);
            { Op o = mk(OP_PACTS, (long long)NS * M * 128); o.a = (const float*)ABF; o.b = (const float*)UB; o.d = EIDX; o.o0 = PART; launch(o); }
            { Op o = mk(OP_PRED, (long long)M * 128); o.a = PART; o.c = GATE; o.o0 = COEF; o.i0 = NS; launch(o); }
            { Op o = mk(OP_POUTS, (long long)MD); o.a = COEF; o.b = EIDX; o.c = (const float*)VB; o.o0 = YBUF; launch(o); }
            { Op o = mk(OP_LNRES, M); o.a = YBUF; o.b = io.in[8] + (size_t)(layer * 2 + 1) * D; o.c = io.in[9] + (size_t)(layer * 2 + 1) * D; o.o0 = X; o.o1 = (float*)ABF; launch(o); } } }
        }
    }
    { Op o = mk(OP_YOUT4, (long long)MD / 4); o.a = X; o.o0 = y_prompt; launch(o); }
    (void)y_sample;
}

#include <cstdint>
namespace pg8 {
#define PG8_LAS __attribute__((address_space(3)))
typedef unsigned short bf16_t;
typedef short bf16x8 __attribute__((ext_vector_type(8)));
typedef float f32x4 __attribute__((ext_vector_type(4)));
typedef unsigned u32x4 __attribute__((ext_vector_type(4)));
constexpr int BM = 256, BK = 64, HALF = 128, HTB = HALF * BK * 2  , STAGE_BYTES = 8 * HTB, NXCD = 8, WGM = 8;

__host__ __device__ __forceinline__ int lds_byte(int r, int c) { const int st = (r >> 4) * 2 + (c >> 5), rr = r & 15, cc = c & 31, ob = rr * 64 + cc * 2; return st * 1024 + (ob ^ (((ob >> 9) & 1) << 5)); }
__host__ __device__ __forceinline__ void stage_rc(int b, int& R, int& C) { const int st = b / 1024, sb = b % 1024, swz = sb ^ (((sb >> 9) & 1) << 5); R = (st >> 1) * 16 + swz / 64; C = (st & 1) * 32 + (swz % 64) / 2; }
__host__ __device__ __forceinline__ int perm32(int rho) { const int n = rho >> 4, i = rho & 15; return 8 * (i >> 2) + 4 * n + (i & 3); }

struct Unit { int pm, pn, grp, pad_; const char* A; const char* B; };
struct Gemm { const bf16_t* A; const bf16_t* Bt; int M, N, K, lda, ldb; };

struct StaticOrder {
    int nM, nN, nwg, G, c; const char* A; const char* B; size_t tsA, tsB, acs;
    __host__ __device__ void init(const Gemm& g, int G_, int c_) { nM = g.M / BM; nN = g.N / BM; nwg = nM * nN; G = G_; c = c_; A = (const char*)g.A; B = (const char*)g.Bt; tsA = (size_t)BM * g.lda * 2; tsB = (size_t)BM * g.ldb * 2; acs = 0; }
    __host__ __device__ bool next(int i, Unit& u) const {
        const long L = (long)i * G + c; if (L >= nwg) return false;
        int wgid = (int)L; { const int q = nwg / NXCD, r = nwg % NXCD, xcd = wgid % NXCD, off = wgid / NXCD; wgid = (xcd < r ? xcd * (q + 1) : r * (q + 1) + (xcd - r) * q) + off; }
        const int nig = WGM * nN, gid = wgid / nig, fm = gid * WGM, gsz = (nM - fm) < WGM ? (nM - fm) : WGM;
        u.pm = fm + ((wgid % nig) % gsz); u.pn = (wgid % nig) / gsz; u.grp = 0; u.pad_ = 0; u.A = A + (size_t)u.pm * tsA + (size_t)u.pn * acs; u.B = B + (size_t)u.pn * tsB; return true;
    }
    __device__ __forceinline__ void a_ready(const Unit&) const {}
    __device__ __forceinline__ void done(const Unit&) const {}
};

template <class Epi, class Sched, bool ALIGN_EPI = false, bool SP2 = false>
__device__ __forceinline__ void gemm_phase(PG8_LAS unsigned char* lds, const Gemm g, const Sched& S, const Epi& E) {
    int tid_raw = threadIdx.x; asm volatile("" : "+v"(tid_raw));
    const int tid = tid_raw, wid = __builtin_amdgcn_readfirstlane(tid >> 6), lane = tid & 63, wr = wid >> 2, wc = wid & 3, fr = lane & 15, fq = lane >> 4;
    const int K = g.K, nt = K / BK;
    unsigned voffA[2], voffB[2];
#pragma unroll
    for (int i = 0; i < 2; ++i) { int R, C; stage_rc(tid * 16 + i * 8192, R, C); const int Rb = Epi::PERM ? ((R & ~31) + perm32(R & 31)) : R;
        voffA[i] = (unsigned)(R * g.lda + C) * 2u; voffB[i] = (unsigned)(Rb * g.ldb + C) * 2u; }
    const size_t kstep = (size_t)(BK * 2);
    const size_t hstepA = (size_t)HALF * g.lda * 2, hstepB = (size_t)HALF * g.ldb * 2;
    const unsigned ldsw = (unsigned)wid * 1024u;
    const int aoff = lds_byte(wr * 64 + fr, fq * 8), boff = lds_byte(wc * 32 + fr, fq * 8);
#define PG8_SA(b, h) (((b) * 2 + (h)) * HTB)
#define PG8_SB(b, h) ((4 + (b) * 2 + (h)) * HTB)
#define PG8_STAGE(bufoff, gbase, voff) do { _Pragma("unroll") for (int _i = 0; _i < 2; ++_i) \
        __builtin_amdgcn_global_load_lds((const unsigned*)((const char*)(gbase) + (voff)[_i]), (PG8_LAS unsigned*)(lds + (bufoff) + ldsw + _i * 8192), 16, 0, 0); } while (0)
#define PG8_LDA(dst, b, h) do { _Pragma("unroll") for (int m = 0; m < 4; ++m) _Pragma("unroll") for (int k = 0; k < 2; ++k) dst[m][k] = *(const PG8_LAS bf16x8*)(lds + PG8_SA(b, h) + aoff + m * 2048 + k * 1024); } while (0)
#define PG8_LDB(dst, b, h) do { _Pragma("unroll") for (int n = 0; n < 2; ++n) _Pragma("unroll") for (int k = 0; k < 2; ++k) dst[n][k] = *(const PG8_LAS bf16x8*)(lds + PG8_SB(b, h) + boff + n * 2048 + k * 1024); } while (0)
#define PG8_MMA(ai, bj, At, Bt) do { __builtin_amdgcn_s_setprio(1); _Pragma("unroll") for (int m = 0; m < 4; ++m) _Pragma("unroll") for (int n = 0; n < 2; ++n) _Pragma("unroll") for (int k = 0; k < 2; ++k) \
        acc[ai][bj][m][n] = __builtin_amdgcn_mfma_f32_16x16x32_bf16(Bt[n][k], At[m][k], acc[ai][bj][m][n], 0, 0, 0); __builtin_amdgcn_s_setprio(0); } while (0)
#define PG8_WAIT_V(n) asm volatile("s_waitcnt vmcnt(" #n ")" ::: "memory")
#define PG8_WAIT_L(n) asm volatile("s_waitcnt lgkmcnt(" #n ")" ::: "memory")
#define PG8_BAR __builtin_amdgcn_s_barrier()
#define PG8_SCHED __builtin_amdgcn_sched_barrier(0)
    Unit cur, nxt; int ui = 0;
    if (!S.next(0, cur)) return;
    f32x4 acc[2][2][4][2];
#pragma unroll
    for (int a = 0; a < 2; ++a)
#pragma unroll
        for (int b = 0; b < 2; ++b)
#pragma unroll
            for (int m = 0; m < 4; ++m)
#pragma unroll
                for (int n = 0; n < 2; ++n) acc[a][b][m][n] = (f32x4){0.f, 0.f, 0.f, 0.f};
    bf16x8 At[4][2], B0[2][2], B1[2][2];
    const char* cA = cur.A; const char* cB = cur.B;
    S.a_ready(cur);
    if constexpr (SP2) {
        PG8_STAGE(PG8_SB(0, 0), cB, voffB); PG8_STAGE(PG8_SB(0, 1), cB + hstepB, voffB); PG8_STAGE(PG8_SA(0, 0), cA, voffA); PG8_STAGE(PG8_SA(0, 1), cA + hstepA, voffA);
        if (wr == 1) PG8_BAR;
        PG8_WAIT_V(2); PG8_BAR;
        PG8_STAGE(PG8_SB(1, 0), cB + kstep, voffB); PG8_STAGE(PG8_SA(1, 0), cA + kstep, voffA); PG8_STAGE(PG8_SB(1, 1), cB + hstepB + kstep, voffB);
        PG8_WAIT_V(6); PG8_BAR;
    } else {
        PG8_STAGE(PG8_SB(0, 0), cB, voffB); PG8_STAGE(PG8_SA(0, 0), cA, voffA); PG8_STAGE(PG8_SB(0, 1), cB + hstepB, voffB); PG8_STAGE(PG8_SA(0, 1), cA + hstepA, voffA);
        if (wr == 1) PG8_BAR;
        PG8_WAIT_V(4); PG8_BAR;
        PG8_STAGE(PG8_SB(1, 0), cB + kstep, voffB); PG8_STAGE(PG8_SA(1, 0), cA + kstep, voffA); PG8_STAGE(PG8_SB(1, 1), cB + hstepB + kstep, voffB);
        PG8_WAIT_V(6); PG8_BAR;
    }
    for (;;) {
        const bool has_next = S.next(ui + 1, nxt);
        const char* nA = has_next ? nxt.A : cA; const char* nB = has_next ? nxt.B : cB;
        for (int t = 0; t < nt; t += 2) {
            const bool last = (t == nt - 2);
            const char* a1 = cA + (size_t)(t + 1) * kstep;
            const char* a2 = last ? nA : cA + (size_t)(t + 2) * kstep; const char* b2 = last ? nB : cB + (size_t)(t + 2) * kstep;
            const char* a3 = a2 + kstep; const char* b3 = b2 + kstep;
            if (last && has_next) S.a_ready(nxt);
            if constexpr (SP2) {
            PG8_LDB(B0, 0, 0); PG8_LDB(B1, 0, 1); PG8_SCHED; PG8_LDA(At, 0, 0); PG8_STAGE(PG8_SA(1, 1), a1 + hstepA, voffA);
            PG8_WAIT_V(8); PG8_WAIT_L(0); PG8_BAR; PG8_MMA(0, 0, At, B0); PG8_MMA(0, 1, At, B1); PG8_BAR; PG8_SCHED;
            PG8_LDA(At, 0, 1); PG8_STAGE(PG8_SB(0, 0), b2, voffB); PG8_STAGE(PG8_SB(0, 1), b2 + hstepB, voffB); PG8_STAGE(PG8_SA(0, 0), a2, voffA);
            PG8_WAIT_V(8); PG8_WAIT_L(0); PG8_BAR; PG8_MMA(1, 0, At, B0); PG8_MMA(1, 1, At, B1); PG8_BAR; PG8_SCHED;
            PG8_LDB(B0, 1, 0); PG8_LDB(B1, 1, 1); PG8_SCHED; PG8_LDA(At, 1, 0); PG8_STAGE(PG8_SA(0, 1), a2 + hstepA, voffA);
            PG8_WAIT_V(8); PG8_WAIT_L(0); PG8_BAR; PG8_MMA(0, 0, At, B0); PG8_MMA(0, 1, At, B1); PG8_BAR; PG8_SCHED;
            PG8_LDA(At, 1, 1); PG8_STAGE(PG8_SB(1, 0), b3, voffB); PG8_STAGE(PG8_SB(1, 1), b3 + hstepB, voffB); PG8_STAGE(PG8_SA(1, 0), a3, voffA);
            PG8_WAIT_V(8); PG8_WAIT_L(0); PG8_BAR; PG8_MMA(1, 0, At, B0); PG8_MMA(1, 1, At, B1); PG8_BAR; PG8_SCHED;
            } else {
            PG8_LDB(B0, 0, 0); PG8_SCHED; PG8_LDA(At, 0, 0); PG8_STAGE(PG8_SA(1, 1), a1 + hstepA, voffA);
            PG8_WAIT_L(8); PG8_BAR; PG8_WAIT_L(0); PG8_MMA(0, 0, At, B0); PG8_BAR; PG8_SCHED;
            PG8_LDB(B1, 0, 1); PG8_STAGE(PG8_SB(0, 0), b2, voffB);
            PG8_BAR; PG8_WAIT_L(0); PG8_MMA(0, 1, At, B1); PG8_BAR;
            PG8_LDA(At, 0, 1); PG8_STAGE(PG8_SA(0, 0), a2, voffA);
            PG8_BAR; PG8_WAIT_L(0); PG8_MMA(1, 0, At, B0); PG8_BAR; PG8_SCHED;
            PG8_STAGE(PG8_SB(0, 1), b2 + hstepB, voffB);
            PG8_WAIT_V(6); PG8_BAR; PG8_MMA(1, 1, At, B1); PG8_BAR;
            PG8_LDB(B0, 1, 0); PG8_SCHED; PG8_LDA(At, 1, 0); PG8_STAGE(PG8_SA(0, 1), a2 + hstepA, voffA);
            PG8_WAIT_L(8); PG8_BAR; PG8_WAIT_L(0); PG8_MMA(0, 0, At, B0); PG8_BAR; PG8_SCHED;
            PG8_LDB(B1, 1, 1); PG8_STAGE(PG8_SB(1, 0), b3, voffB);
            PG8_BAR; PG8_WAIT_L(0); PG8_MMA(0, 1, At, B1); PG8_BAR;
            PG8_LDA(At, 1, 1); PG8_STAGE(PG8_SA(1, 0), a3, voffA);
            PG8_BAR; PG8_WAIT_L(0); PG8_MMA(1, 0, At, B0); PG8_BAR; PG8_SCHED;
            PG8_STAGE(PG8_SB(1, 1), b3 + hstepB, voffB);
            PG8_WAIT_V(6); PG8_BAR; PG8_MMA(1, 1, At, B1); PG8_BAR;
            }
        }
        if constexpr (ALIGN_EPI) { if (wr == 0) PG8_BAR; }
        if constexpr (!Epi::AFTER_DRAIN) { E(acc, cur, wr, wc, fr, fq); S.done(cur); }
        if (!has_next) break;
#pragma unroll
        for (int a = 0; a < 2; ++a)
#pragma unroll
            for (int b = 0; b < 2; ++b)
#pragma unroll
                for (int m = 0; m < 4; ++m)
#pragma unroll
                    for (int n = 0; n < 2; ++n) acc[a][b][m][n] = (f32x4){0.f, 0.f, 0.f, 0.f};
        cur = nxt; cA = nA; cB = nB; ++ui;
        if constexpr (ALIGN_EPI) { if (wr == 1) PG8_BAR; }
    }
    PG8_WAIT_V(0);
    if constexpr (!ALIGN_EPI) { if (wr == 0) PG8_BAR; }
    PG8_BAR;
    if constexpr (Epi::AFTER_DRAIN) { E.fused(acc, cur, wr, wc, fr, fq, lds, wid, lane); S.done(cur); }
#undef PG8_SA
#undef PG8_SB
#undef PG8_STAGE
#undef PG8_LDA
#undef PG8_LDB
#undef PG8_MMA
#undef PG8_WAIT_V
#undef PG8_WAIT_L
#undef PG8_BAR
#undef PG8_SCHED
}
}
template <class T> __device__ __forceinline__ T* uni_ptr(T* p) {
    unsigned long long v = (unsigned long long)p; unsigned lo = __builtin_amdgcn_readfirstlane((unsigned)v), hi = __builtin_amdgcn_readfirstlane((unsigned)(v >> 32));
    unsigned long long r = ((unsigned long long)hi << 32) | lo; asm volatile("" : "+s"(r)); return (T*)r; }
__device__ __forceinline__ int rfl(int x) { int t = __builtin_amdgcn_readfirstlane(x); asm volatile("" : "+s"(t)); return t; }
namespace pg8 {
__device__ __forceinline__ unsigned cvt_pk_bf16(float lo, float hi) { unsigned r; asm volatile("v_cvt_pk_bf16_f32 %0, %1, %2" : "=v"(r) : "v"(lo), "v"(hi)); return r; }
struct EpiF32 {
    static constexpr bool PERM = false, AFTER_DRAIN = false;
    float* C; int ldc, Mreal, Nreal;
    __device__ __forceinline__ void operator()(const f32x4 (&acc)[2][2][4][2], const Unit& u, int wr, int wc, int fr, int fq) const {
        const int row0 = u.pm * BM + wr * 64 + fr, col0 = u.pn * BM + wc * 32 + 4 * fq;
#pragma unroll
        for (int ai = 0; ai < 2; ++ai)
#pragma unroll
            for (int m = 0; m < 4; ++m) { const int r = row0 + ai * HALF + m * 16; if (r < Mreal) { float* rowp = C + (size_t)r * ldc + col0;
#pragma unroll
                for (int bj = 0; bj < 2; ++bj)
#pragma unroll
                    for (int n = 0; n < 2; ++n) { const int c = col0 + bj * HALF + n * 16; if (c < Nreal) *(f32x4*)(rowp + bj * HALF + n * 16) = acc[ai][bj][m][n]; } } }
    }
};
struct EpiBf16Plain {
    static constexpr bool PERM = true, AFTER_DRAIN = false;
    bf16_t* O; int ldc;
    __device__ __forceinline__ void operator()(const f32x4 (&acc)[2][2][4][2], const Unit& u, int wr, int wc, int fr, int fq) const {
        const int row0 = u.pm * BM + wr * 64 + fr, col0 = u.pn * BM + wc * 32 + 8 * fq;
#pragma unroll
        for (int ai = 0; ai < 2; ++ai)
#pragma unroll
            for (int m = 0; m < 4; ++m) { bf16_t* rowp = O + (size_t)(row0 + ai * HALF + m * 16) * ldc + col0;
#pragma unroll
                for (int bj = 0; bj < 2; ++bj) { const f32x4 v0 = acc[ai][bj][m][0], v1 = acc[ai][bj][m][1]; u32x4 w;
                    w.x = cvt_pk_bf16(v0[0], v0[1]); w.y = cvt_pk_bf16(v0[2], v0[3]); w.z = cvt_pk_bf16(v1[0], v1[1]); w.w = cvt_pk_bf16(v1[2], v1[3]);
                    *(u32x4*)(rowp + bj * HALF) = w; } }
    }
};
struct EpiLru {
    static constexpr bool PERM = false, AFTER_DRAIN = false;
    const float* ba; const float* bx; const float* spl; const float* XC; float* AT; float* BT; int Mreal;
    __device__ __forceinline__ void operator()(const f32x4 (&acc)[2][2][4][2], const Unit& u, int wr, int wc, int fr, int fq) const {
        const int row0 = u.pm * BM + wr * 64 + fr, ch0 = u.pn * 128 + wc * 32 + 4 * fq;
#pragma unroll
        for (int n = 0; n < 2; ++n) { const int c = ch0 + 16 * n; const f32x4 ba4 = *(const f32x4*)(ba + c), bx4 = *(const f32x4*)(bx + c), sp4 = *(const f32x4*)(spl + c);
#pragma unroll
            for (int ai = 0; ai < 2; ++ai)
#pragma unroll
                for (int m = 0; m < 4; ++m) { const int r = row0 + ai * HALF + m * 16; if (r < Mreal) { const f32x4 xc = *(const f32x4*)(XC + (size_t)r * 512 + c); const f32x4 ga = acc[ai][0][m][n] + ba4, gx = acc[ai][1][m][n] + bx4; f32x4 at, bt;
#pragma unroll
                    for (int i = 0; i < 4; ++i) { const float gate_a = 1.f / (1.f + __expf(-ga[i])), gate_x = 1.f / (1.f + __expf(-gx[i])); const float la = gate_a * sp4[i]; at[i] = __expf(la); bt[i] = sqrtf(-expm1f(2.f * la)) * (gate_x * xc[i]); }
                    *(f32x4*)(AT + (size_t)r * 512 + c) = at; *(f32x4*)(BT + (size_t)r * 512 + c) = bt; } } }
    }
};
struct GroupOrder {
    const PG8_LAS Op* tab; int ng, nM, G, c; size_t tsA, tsB;
    __device__ __forceinline__ bool next(int i, Unit& u) const {
        int L = i * G + c, g = 0;
        for (; g < ng; ++g) { const int cnt = nM * (__builtin_amdgcn_readfirstlane(tab[g].i5) >> 8); if (L < cnt) break; L -= cnt; }
        if (g >= ng) return false;
        u.pm = L % nM; u.pn = L / nM; u.grp = g; u.pad_ = 0;
        u.A = (const char*)uni_ptr(tab[g].a) + (size_t)u.pm * tsA; u.B = (const char*)uni_ptr(tab[g].b) + (size_t)u.pn * tsB; return true;
    }
    __device__ __forceinline__ void a_ready(const Unit&) const {}
    __device__ __forceinline__ void done(const Unit&) const {}
};
struct EpiF32G {
    static constexpr bool PERM = false, AFTER_DRAIN = false;
    const PG8_LAS Op* tab; int Mreal;
    __device__ __forceinline__ void operator()(const f32x4 (&acc)[2][2][4][2], const Unit& u, int wr, int wc, int fr, int fq) const {
        float* C = uni_ptr(tab[u.grp].o0); const int ldc = __builtin_amdgcn_readfirstlane(tab[u.grp].i4), Nreal = __builtin_amdgcn_readfirstlane(tab[u.grp].i0);
        const EpiF32 E{C, ldc, Mreal, Nreal}; E(acc, u, wr, wc, fr, fq);
    }
};
}

#define XB_TMO      128
#define XB_XCNT(j)  (256  + 64 * (j))
#define XB_XSUB(j)  (1280 + 64 * (j))
#define XB_XGEN(j)  (2304 + 64 * (j))
#define XB_TOP      3328
#define XB_TOPGEN   3392
#define XCD_BAR_WORDS 3456
#define XB_SPIN_CAP (1u << 18)
#define LAS __attribute__((address_space(3)))
__device__ __forceinline__ unsigned xb_ld(unsigned* p)              { return __hip_atomic_load(p, __ATOMIC_RELAXED, __HIP_MEMORY_SCOPE_AGENT); }
__device__ __forceinline__ unsigned xb_add(unsigned* p, unsigned v) { return __hip_atomic_fetch_add(p, v, __ATOMIC_RELAXED, __HIP_MEMORY_SCOPE_AGENT); }
__device__ __forceinline__ unsigned xb_xcc_id() { return (unsigned)__builtin_amdgcn_s_getreg((3 << 11) | 20) & 0xFu; }
#define XB_SPIN(cond, bar) do { unsigned _sp = 0; while (cond) { __builtin_amdgcn_s_sleep(1); \
    if ((++_sp & 255u) == 0u) { if (xb_ld(&(bar)[XB_TMO])) break; if (_sp > XB_SPIN_CAP) { atomicAdd(&(bar)[XB_TMO], 1u); break; } } } } while (0)
struct XcdBarrier { unsigned* bar; unsigned x; volatile LAS unsigned* st; };
__device__ __forceinline__ XcdBarrier xcd_barrier_post(unsigned* bar, volatile LAS unsigned* st) {
    XcdBarrier b; b.bar = bar; b.x = xb_xcc_id(); b.st = st;
    if (threadIdx.x == 0) (void)xb_add(&bar[XB_XCNT(b.x)], 1u);
    return b;
}
__device__ __forceinline__ void xcd_barrier_complete(unsigned* bar, unsigned x, unsigned& nloc, unsigned& nx) {
    const unsigned G = gridDim.x * gridDim.y * gridDim.z;
    unsigned sum, cnt, mine, sp = 0u;
    for (;;) {
        sum = 0u; cnt = 0u; mine = 0u;
#pragma unroll
        for (unsigned j = 0; j < 16; ++j) { const unsigned c = xb_ld(&bar[XB_XCNT(j)]); sum += c; cnt += (c > 0u) ? 1u : 0u; mine = (j == x) ? c : mine; }
        if (sum == G) break;
        __builtin_amdgcn_s_sleep(1);
        if ((++sp & 255u) == 0u) { if (xb_ld(&bar[XB_TMO])) break; if (sp > XB_SPIN_CAP) { atomicAdd(&bar[XB_TMO], 1u); break; } }
    }
    nloc = mine > 0u ? mine : 1u; nx = cnt > 0u ? cnt : 1u;
}
__device__ __forceinline__ void xcd_barrier(const XcdBarrier& b) {
    asm volatile("s_waitcnt vmcnt(0)" ::: "memory");
    __syncthreads();
    if (threadIdx.x == 0) {
        unsigned* bar = b.bar;
        __builtin_amdgcn_s_waitcnt(0);
        unsigned nloc = b.st[0], nx = b.st[1];
        if (nloc == 0u) { xcd_barrier_complete(bar, b.x, nloc, nx); b.st[0] = nloc; b.st[1] = nx; }
        const unsigned old = xb_add(&bar[XB_XSUB(b.x)], 1u);
        const unsigned gen = old / nloc;
        if (old + 1u == (gen + 1u) * nloc) {
            __builtin_amdgcn_fence(__ATOMIC_RELEASE, "agent");
            asm volatile("s_waitcnt vmcnt(0)" ::: "memory");
            const unsigned og = xb_add(&bar[XB_TOP], 1u);
            const unsigned tg = og / nx;
            if (og + 1u == (tg + 1u) * nx) xb_add(&bar[XB_TOPGEN], 1u);
            else XB_SPIN(xb_ld(&bar[XB_TOPGEN]) == tg, bar);
            __builtin_amdgcn_fence(__ATOMIC_ACQUIRE, "agent");
            xb_add(&bar[XB_XGEN(b.x)], 1u);
            asm volatile("s_waitcnt vmcnt(0)" ::: "memory");
        } else {
            XB_SPIN(xb_ld(&bar[XB_XGEN(b.x)]) == gen, bar);
            __builtin_amdgcn_fence(__ATOMIC_ACQUIRE, "agent");
            asm volatile("s_waitcnt vmcnt(0)" ::: "memory");
        }
    }
    __syncthreads();
}

namespace fk {
#define GAS __attribute__((address_space(1)))
typedef unsigned u32x4 __attribute__((ext_vector_type(4)));
typedef unsigned u32x2 __attribute__((ext_vector_type(2)));
typedef float f32x4 __attribute__((ext_vector_type(4)));
typedef float f32x2 __attribute__((ext_vector_type(2)));
typedef __bf16 bf2 __attribute__((ext_vector_type(2)));
typedef unsigned short bf16_t;
__device__ __forceinline__ float bflo(unsigned u) { return __uint_as_float(u << 16); }
__device__ __forceinline__ float bfhi(unsigned u) { return __uint_as_float(u & 0xffff0000u); }
__device__ __forceinline__ float dot2(unsigned a, unsigned b, float c) { return __builtin_amdgcn_fdot2_f32_bf16(__builtin_bit_cast(bf2, a), __builtin_bit_cast(bf2, b), c, false); }
__device__ __forceinline__ unsigned pk_bf16(float lo, float hi) { unsigned r; asm volatile("v_cvt_pk_bf16_f32 %0, %1, %2" : "=v"(r) : "v"(lo), "v"(hi)); return r; }
template <int CTRL> __device__ __forceinline__ float dppf(float v) { return __int_as_float(__builtin_amdgcn_update_dpp(0, __float_as_int(v), CTRL, 0xf, 0xf, true)); }
__device__ __forceinline__ float row_max16(float v) { v = fmaxf(v, dppf<0xB1>(v)); v = fmaxf(v, dppf<0x4E>(v)); v = fmaxf(v, dppf<0x141>(v)); v = fmaxf(v, dppf<0x140>(v)); return v; }
__device__ __forceinline__ float row_sum16(float v) { v += dppf<0xB1>(v); v += dppf<0x4E>(v); v += dppf<0x141>(v); v += dppf<0x140>(v); return v; }
__device__ __forceinline__ float shx(float v, int m, int lane) { return __int_as_float(__builtin_amdgcn_ds_bpermute((lane ^ m) << 2, __float_as_int(v))); }
__device__ __forceinline__ float wave_sum(float v, int lane) { v = row_sum16(v); v += shx(v, 16, lane); v += shx(v, 32, lane); return v; }
__device__ __forceinline__ float gelu_tanh(float x) { return 0.5f * x * (1.f + tanhf(0.7978845608028654f * (x + 0.044715f * x * x * x))); }
#define FK_NEG (-3.0e38f)

template <int CTRL> __device__ __forceinline__ int dppi(int v) { return __builtin_amdgcn_update_dpp(0, v, CTRL, 0xf, 0xf, true); }
__device__ __forceinline__ int row_min16i(int v) { v = min(v, dppi<0xB1>(v)); v = min(v, dppi<0x4E>(v)); v = min(v, dppi<0x141>(v)); v = min(v, dppi<0x140>(v)); return v; }
#define FK_CE(a, b) do { const bool sw_ = v[b] > v[a]; const float tv_ = sw_ ? v[b] : v[a]; v[b] = sw_ ? v[a] : v[b]; v[a] = tv_; const int ti_ = sw_ ? id[b] : id[a]; id[b] = sw_ ? id[a] : id[b]; id[a] = ti_; } while (0)
__device__ __forceinline__ void top16_of_128(float (&v)[8], int (&id)[8], int lane16, float& rv, int& ri) {
    FK_CE(0, 1); FK_CE(2, 3); FK_CE(4, 5); FK_CE(6, 7); FK_CE(0, 2); FK_CE(1, 3); FK_CE(4, 6); FK_CE(5, 7); FK_CE(1, 2); FK_CE(5, 6);
    FK_CE(0, 4); FK_CE(1, 5); FK_CE(2, 6); FK_CE(3, 7); FK_CE(2, 4); FK_CE(3, 5); FK_CE(1, 2); FK_CE(3, 4); FK_CE(5, 6);
    rv = FK_NEG; ri = 0;
#pragma unroll
    for (int r = 0; r < 16; ++r) {
        const float wm = row_max16(v[0]);
        const int cand = (v[0] == wm) ? id[0] : 0x7fffffff;
        const int sel = row_min16i(cand);
        const bool mine = (cand == sel);
        if (lane16 == r) { rv = wm; ri = sel; }
#pragma unroll
        for (int i = 0; i < 7; ++i) { v[i] = mine ? v[i + 1] : v[i]; id[i] = mine ? id[i + 1] : id[i]; }
        v[7] = mine ? FK_NEG : v[7];
    }
}
__device__ __forceinline__ void topk_phase(const GAS float* __restrict__ SC, const GAS bf16_t* __restrict__ Q, const GAS float* __restrict__ KSUM, GAS float* __restrict__ GATE, GAS int* __restrict__ EIDX, int nitems,
                                           LAS unsigned char* lds, int wid, int lane, int wave_gid, int nwaves) {
    LAS float* xv = (LAS float*)(lds + wid * 256);
    const int lane16 = lane & 15, rowbase = lane & 48;
    for (int wi = wave_gid; wi * 4 < nitems; wi += nwaves) {
        const int it = wi * 4 + (lane >> 4); const int h = it & 7;
        const GAS u32x4* qp = (const GAS u32x4*)(Q + (size_t)it * 256 + 16 * lane16); const u32x4 qa = qp[0], qb = qp[1];
        float qs = 0.f, qq = 0.f;
#pragma unroll
        for (int i = 0; i < 4; ++i) { const float a = bflo(qa[i]), b = bfhi(qa[i]), c = bflo(qb[i]), d = bfhi(qb[i]); qs += (a + b) + (c + d); qq += (a * a + b * b) + (c * c + d * d); }
        const float mu = row_sum16(qs) * (1.f / 256.f); const float var = fmaxf(row_sum16(qq) * (1.f / 256.f) - mu * mu, 0.f); const float rs = 1.f / sqrtf(var + 1e-5f);
        float v[8]; int id[8]; float rv1, rv2; int ri1, ri2;
        { const GAS float* sp = SC + (size_t)it * 256 + 8 * lane16; const GAS float* kp = KSUM + h * 256 + 8 * lane16; const f32x4 s0 = *(const GAS f32x4*)sp, s1 = *(const GAS f32x4*)(sp + 4), k0 = *(const GAS f32x4*)kp, k1 = *(const GAS f32x4*)(kp + 4);
#pragma unroll
          for (int i = 0; i < 4; ++i) { v[i] = rs * (s0[i] - mu * k0[i]); v[4 + i] = rs * (s1[i] - mu * k1[i]); id[i] = 8 * lane16 + i; id[4 + i] = 8 * lane16 + 4 + i; } }
        top16_of_128(v, id, lane16, rv1, ri1);
        { const GAS float* sp = SC + (size_t)it * 256 + 128 + 8 * lane16; const GAS float* kp = KSUM + h * 256 + 128 + 8 * lane16; const f32x4 s0 = *(const GAS f32x4*)sp, s1 = *(const GAS f32x4*)(sp + 4), k0 = *(const GAS f32x4*)kp, k1 = *(const GAS f32x4*)(kp + 4);
#pragma unroll
          for (int i = 0; i < 4; ++i) { v[i] = rs * (s0[i] - mu * k0[i]); v[4 + i] = rs * (s1[i] - mu * k1[i]); id[i] = 8 * lane16 + i; id[4 + i] = 8 * lane16 + 4 + i; } }
        top16_of_128(v, id, lane16, rv2, ri2);
        xv[lane] = rv2;
        float c[16];
        { const LAS f32x4* xp = (const LAS f32x4*)(xv + rowbase);
#pragma unroll
          for (int q = 0; q < 4; ++q) { const f32x4 t = xp[q]; c[4 * q] = rv1 + t.x; c[4 * q + 1] = rv1 + t.y; c[4 * q + 2] = rv1 + t.z; c[4 * q + 3] = rv1 + t.w; } }
        int p = 0; float sc = FK_NEG; int cid = 0;
#pragma unroll
        for (int r = 0; r < 16; ++r) {
            const float wm = row_max16(c[0]);
            const int cand = (c[0] == wm) ? (16 * lane16 + p) : 0x7fffffff;
            const int sel = row_min16i(cand);
            const bool mine = (cand == sel);
            if (lane16 == r) { sc = wm; cid = sel; }
#pragma unroll
            for (int i = 0; i < 15; ++i) c[i] = mine ? c[i + 1] : c[i];
            c[15] = mine ? FK_NEG : c[15]; p += mine ? 1 : 0;
        }
        cid &= 255;
        const int e1 = __builtin_amdgcn_ds_bpermute((rowbase + (cid >> 4)) << 2, ri1), e2 = __builtin_amdgcn_ds_bpermute((rowbase + (cid & 15)) << 2, ri2);
        const float mx = row_max16(sc); const float ex = __expf(sc - mx); const float den = row_sum16(ex);
        GATE[(size_t)it * 16 + lane16] = ex / den; EIDX[(size_t)it * 16 + lane16] = (e1 & 127) * 128 + (e2 & 127);
    }
}

__device__ __forceinline__ f32x2 fp8lo(unsigned w) { return __builtin_amdgcn_cvt_pk_f32_fp8((int)w, false); }
__device__ __forceinline__ f32x2 fp8hi(unsigned w) { return __builtin_amdgcn_cvt_pk_f32_fp8((int)w, true); }
__device__ __forceinline__ void act_phase(const GAS bf16_t* __restrict__ XB, const GAS unsigned char* __restrict__ U8, const GAS float* __restrict__ GATE, const GAS int* __restrict__ EIDX, GAS float* __restrict__ COEF, int nitems,
                                          int lane, int wave_gid, int nwaves) {
    int it = wave_gid; if (it >= nitems) return;
    u32x4 uc[16], un[16], xac, xbc, xan, xbn;
    int evc = EIDX[(size_t)it * 16 + (lane & 15)];
    { const GAS u32x4* xp = (const GAS u32x4*)(XB + (size_t)(it >> 3) * 1024 + 16 * lane); xac = xp[0]; xbc = xp[1]; }
#pragma unroll
    for (int k = 0; k < 16; ++k) uc[k] = *(const GAS u32x4*)(U8 + (size_t)__builtin_amdgcn_readlane(evc, k) * 1024 + 16 * lane);
    int itn = it + nwaves; int evn = (itn < nitems) ? EIDX[(size_t)itn * 16 + (lane & 15)] : 0;
    for (;;) {
        const bool hasn = itn < nitems;
        if (hasn) {
            const GAS u32x4* xp = (const GAS u32x4*)(XB + (size_t)(itn >> 3) * 1024 + 16 * lane); xan = xp[0]; xbn = xp[1];
#pragma unroll
            for (int k = 0; k < 16; ++k) un[k] = *(const GAS u32x4*)(U8 + (size_t)__builtin_amdgcn_readlane(evn, k) * 1024 + 16 * lane);
        }
        const int itnn = itn + nwaves; const int evnn = (itnn < nitems) ? EIDX[(size_t)itnn * 16 + (lane & 15)] : 0;
        const float gt = GATE[(size_t)it * 16 + (lane >> 2)];
        float x[16];
#pragma unroll
        for (int i = 0; i < 4; ++i) { x[2 * i] = bflo(xac[i]); x[2 * i + 1] = bfhi(xac[i]); x[8 + 2 * i] = bflo(xbc[i]); x[8 + 2 * i + 1] = bfhi(xbc[i]); }
        float a[16];
#pragma unroll
        for (int k = 0; k < 16; ++k) { const u32x4 uw = uc[k]; float s = 0.f;
#pragma unroll
            for (int d = 0; d < 4; ++d) { const f32x2 lo = fp8lo(uw[d]), hi = fp8hi(uw[d]); s = fmaf(lo.x, x[4 * d], s); s = fmaf(lo.y, x[4 * d + 1], s); s = fmaf(hi.x, x[4 * d + 2], s); s = fmaf(hi.y, x[4 * d + 3], s); }
            asm volatile("" : "+v"(s)); a[k] = s; }
#pragma unroll
        for (int k = 0; k < 8; ++k) { const bool hi = lane & 32; const float send = hi ? a[k] : a[k + 8], keep = hi ? a[k + 8] : a[k]; a[k] = keep + shx(send, 32, lane); }
#pragma unroll
        for (int k = 0; k < 4; ++k) { const bool hi = lane & 16; const float send = hi ? a[k] : a[k + 4], keep = hi ? a[k + 4] : a[k]; a[k] = keep + shx(send, 16, lane); }
#pragma unroll
        for (int k = 0; k < 2; ++k) { const bool hi = lane & 8; const float send = hi ? a[k] : a[k + 2], keep = hi ? a[k + 2] : a[k]; a[k] = keep + shx(send, 8, lane); }
        { const bool hi = lane & 4; const float send = hi ? a[0] : a[1], keep = hi ? a[1] : a[0]; a[0] = keep + shx(send, 4, lane); }
        float dsum = a[0]; dsum += shx(dsum, 2, lane); dsum += shx(dsum, 1, lane);
        if ((lane & 3) == 0) COEF[(size_t)it * 16 + (lane >> 2)] = gt * gelu_tanh(dsum * (1.f / 128.f));
        if (!hasn) break;
#pragma unroll
        for (int k = 0; k < 16; ++k) uc[k] = un[k];
        xac = xan; xbc = xbn; evc = evn; evn = evnn; it = itn; itn = itnn;
    }
}

__device__ __forceinline__ void outln_phase(const GAS float* COEF, const GAS int* EIDX, const GAS unsigned char* V8,     const GAS float* __restrict__ lg, const GAS float* __restrict__ lb, GAS float* X, GAS bf16_t* XB, int nrows,
                                            int lane, int wave_gid, int nwaves) {
    const float alpha = 1.6817928305074292f;
    int row = wave_gid; if (row >= nrows) return;
    u32x4 vc[16], vn[16];
    float cf0 = COEF[(size_t)row * 128 + lane] * (1.f / 64.f), cf1 = COEF[(size_t)row * 128 + 64 + lane] * (1.f / 64.f); int ev0 = EIDX[(size_t)row * 128 + lane], ev1 = EIDX[(size_t)row * 128 + 64 + lane];
#define OUT_LOADCH(dst, evreg, base) do { _Pragma("unroll") for (int k_ = 0; k_ < 16; ++k_) dst[k_] = *(const GAS u32x4*)(V8 + (size_t)__builtin_amdgcn_readlane(evreg, (base) + k_) * 1024 + 16 * lane); } while (0)
#define OUT_COMPCH(src, cfreg, base) do { _Pragma("unroll") for (int k_ = 0; k_ < 16; ++k_) { const float c_ = __int_as_float(__builtin_amdgcn_readlane(__float_as_int(cfreg), (base) + k_)); const u32x4 vw_ = src[k_]; \
        _Pragma("unroll") for (int d_ = 0; d_ < 4; ++d_) { const f32x2 lo_ = fp8lo(vw_[d_]), hi_ = fp8hi(vw_[d_]); acc[4 * d_] = fmaf(c_, lo_.x, acc[4 * d_]); acc[4 * d_ + 1] = fmaf(c_, lo_.y, acc[4 * d_ + 1]); acc[4 * d_ + 2] = fmaf(c_, hi_.x, acc[4 * d_ + 2]); acc[4 * d_ + 3] = fmaf(c_, hi_.y, acc[4 * d_ + 3]); } \
        _Pragma("unroll") for (int p_ = 0; p_ < 16; ++p_) asm volatile("" : "+v"(acc[p_]));     \
        } } while (0)
    for (;;) {
        OUT_LOADCH(vc, ev0, 0);
        const int rown = row + nwaves; const bool hasn = rown < nrows;
        float ncf0 = 0.f, ncf1 = 0.f; int nev0 = 0, nev1 = 0;
        if (hasn) { ncf0 = COEF[(size_t)rown * 128 + lane] * (1.f / 64.f); ncf1 = COEF[(size_t)rown * 128 + 64 + lane] * (1.f / 64.f); nev0 = EIDX[(size_t)rown * 128 + lane]; nev1 = EIDX[(size_t)rown * 128 + 64 + lane]; }
        float acc[16];
#pragma unroll
        for (int k = 0; k < 16; ++k) acc[k] = 0.f;
#define OUT_FENCE() asm volatile("" ::: "memory")
        OUT_LOADCH(vn, ev0, 16); OUT_FENCE(); OUT_COMPCH(vc, cf0, 0); OUT_FENCE();
        OUT_LOADCH(vc, ev0, 32); OUT_FENCE(); OUT_COMPCH(vn, cf0, 16); OUT_FENCE();
        OUT_LOADCH(vn, ev0, 48); OUT_FENCE(); OUT_COMPCH(vc, cf0, 32); OUT_FENCE();
        OUT_LOADCH(vc, ev1, 0);  OUT_FENCE(); OUT_COMPCH(vn, cf0, 48); OUT_FENCE();
        OUT_LOADCH(vn, ev1, 16); OUT_FENCE(); OUT_COMPCH(vc, cf1, 0); OUT_FENCE();
        OUT_LOADCH(vc, ev1, 32); OUT_FENCE(); OUT_COMPCH(vn, cf1, 16); OUT_FENCE();
        OUT_LOADCH(vn, ev1, 48); OUT_FENCE(); OUT_COMPCH(vc, cf1, 32); OUT_FENCE();
        OUT_COMPCH(vn, cf1, 48); OUT_FENCE();
#undef OUT_FENCE
        GAS float* xr = X + (size_t)row * 1024 + 16 * lane; float t[16];
#pragma unroll
        for (int q = 0; q < 4; ++q) { const f32x4 xv = *(const GAS f32x4*)(xr + 4 * q); t[4 * q] = fmaf(alpha, xv.x, acc[4 * q]); t[4 * q + 1] = fmaf(alpha, xv.y, acc[4 * q + 1]); t[4 * q + 2] = fmaf(alpha, xv.z, acc[4 * q + 2]); t[4 * q + 3] = fmaf(alpha, xv.w, acc[4 * q + 3]); }
        float s = 0.f;
#pragma unroll
        for (int k = 0; k < 16; ++k) s += t[k];
        const float mu = wave_sum(s, lane) * (1.f / 1024.f); float vs = 0.f;
#pragma unroll
        for (int k = 0; k < 16; ++k) { t[k] -= mu; vs = fmaf(t[k], t[k], vs); }
        const float rs = 1.f / sqrtf(wave_sum(vs, lane) * (1.f / 1024.f) + 1e-5f);
        unsigned w[8];
#pragma unroll
        for (int q = 0; q < 4; ++q) { const f32x4 g = *(const GAS f32x4*)(lg + 16 * lane + 4 * q), b = *(const GAS f32x4*)(lb + 16 * lane + 4 * q); f32x4 o;
            o.x = t[4 * q] * rs * g.x + b.x; o.y = t[4 * q + 1] * rs * g.y + b.y; o.z = t[4 * q + 2] * rs * g.z + b.z; o.w = t[4 * q + 3] * rs * g.w + b.w;
            *(GAS f32x4*)(xr + 4 * q) = o; w[2 * q] = pk_bf16(o.x, o.y); w[2 * q + 1] = pk_bf16(o.z, o.w); }
        u32x4 w0, w1; w0.x = w[0]; w0.y = w[1]; w0.z = w[2]; w0.w = w[3]; w1.x = w[4]; w1.y = w[5]; w1.z = w[6]; w1.w = w[7];
        GAS u32x4* xbp = (GAS u32x4*)(XB + (size_t)row * 1024 + 16 * lane); xbp[0] = w0; xbp[1] = w1;
        if (!hasn) break;
        row = rown; cf0 = ncf0; cf1 = ncf1; ev0 = nev0; ev1 = nev1;
    }
#undef OUT_LOADCH
#undef OUT_COMPCH
}

__device__ __forceinline__ void lnres_phase(const GAS float* __restrict__ Y, const GAS float* __restrict__ lg, const GAS float* __restrict__ lb, GAS float* X, GAS bf16_t* XB, int nrows, int lane, int wave_gid, int nwaves) {
    const float alpha = 1.6817928305074292f;
    for (int row = wave_gid; row < nrows; row += nwaves) {
        GAS float* xr = X + (size_t)row * 1024; const GAS float* yr = Y + (size_t)row * 1024; float t[16];
#pragma unroll
        for (int q = 0; q < 4; ++q) { const f32x4 xv = *(const GAS f32x4*)(xr + 256 * q + 4 * lane), yv = *(const GAS f32x4*)(yr + 256 * q + 4 * lane);
            t[4 * q] = fmaf(alpha, xv.x, yv.x); t[4 * q + 1] = fmaf(alpha, xv.y, yv.y); t[4 * q + 2] = fmaf(alpha, xv.z, yv.z); t[4 * q + 3] = fmaf(alpha, xv.w, yv.w); }
        float s = 0.f;
#pragma unroll
        for (int k = 0; k < 16; ++k) s += t[k];
        const float mu = wave_sum(s, lane) * (1.f / 1024.f); float vs = 0.f;
#pragma unroll
        for (int k = 0; k < 16; ++k) { t[k] -= mu; vs = fmaf(t[k], t[k], vs); }
        const float rs = 1.f / sqrtf(wave_sum(vs, lane) * (1.f / 1024.f) + 1e-5f);
#pragma unroll
        for (int q = 0; q < 4; ++q) { const int c = 256 * q + 4 * lane; const f32x4 g = *(const GAS f32x4*)(lg + c), b = *(const GAS f32x4*)(lb + c); f32x4 o;
            o.x = t[4 * q] * rs * g.x + b.x; o.y = t[4 * q + 1] * rs * g.y + b.y; o.z = t[4 * q + 2] * rs * g.z + b.z; o.w = t[4 * q + 3] * rs * g.w + b.w;
            *(GAS f32x4*)(xr + c) = o; u32x2 w; w.x = pk_bf16(o.x, o.y); w.y = pk_bf16(o.z, o.w); *(GAS u32x2*)(XB + (size_t)row * 1024 + c) = w; }
    }
}

__device__ __forceinline__ void glanorm_phase(const GAS float* __restrict__ O, const GAS float* __restrict__ PROJ, const GAS float* __restrict__ gnorm, GAS bf16_t* XB, int nitems, int lane, int wave_gid, int nwaves) {
    const float g0 = gnorm[lane], g1 = gnorm[64 + lane];
    for (int it0 = wave_gid * 4; it0 < nitems; it0 += nwaves * 4) {
        float a0[4], a1[4], r0[4], r1[4];
#pragma unroll
        for (int q = 0; q < 4; ++q) { int it = it0 + q; it = it < nitems ? it : it0; const int row = it >> 2, h = it & 3; const GAS float* o = O + (size_t)row * 512 + h * 128; const GAS float* r = PROJ + (size_t)row * 2576 + 1040 + h * 128;
            a0[q] = o[lane]; a1[q] = o[64 + lane]; r0[q] = r[lane]; r1[q] = r[64 + lane]; }
#pragma unroll
        for (int q = 0; q < 4; ++q) { const int it = it0 + q; const int row = it >> 2, h = it & 3;
            const float rs = 1.f / sqrtf(wave_sum(a0[q] * a0[q] + a1[q] * a1[q], lane) * (1.f / 128.f) + 1e-5f);
            const float y0 = a0[q] * rs * g0 * (r0[q] / (1.f + __expf(-r0[q]))), y1 = a1[q] * rs * g1 * (r1[q] / (1.f + __expf(-r1[q])));
            if (it < nitems) { GAS bf16_t* d = XB + (size_t)row * 1024 + h * 128; d[lane] = (bf16_t)(pk_bf16(y0, 0.f) & 0xffffu); d[64 + lane] = (bf16_t)(pk_bf16(y1, 0.f) & 0xffffu); } }
    }
}

__device__ __forceinline__ float sigm(float x) { return 1.f / (1.f + __expf(-x)); }
__device__ __forceinline__ float softplusf(float x) { return fmaxf(x, 0.f) + log1pf(__expf(-fabsf(x))); }
__device__ __forceinline__ void rwkvprep_phase(const GAS float* __restrict__ w0, const GAS float* __restrict__ a0, const GAS float* __restrict__ v0, const GAS float* __restrict__ k_k, const GAS float* __restrict__ k_a, const GAS float* __restrict__ Vg,
                                               GAS float* K, GAS float* Wd, GAS float* Aa, GAS float* V, GAS float* NKK, GAS float* VFIRST, int has_vres, int nitems, int lane, int wave_gid, int nwaves) {
    for (int it0 = wave_gid * 4; it0 < nitems; it0 += nwaves * 4) {
        float kq[4], wq[4], aq[4], vq[4], gq[4], fq[4];
#pragma unroll
        for (int q = 0; q < 4; ++q) { const int it = it0 + q; const size_t ix = (size_t)(it >> 4) * 1024 + (it & 15) * 64 + lane; kq[q] = K[ix]; wq[q] = Wd[ix]; aq[q] = Aa[ix]; vq[q] = V[ix]; gq[q] = has_vres ? Vg[ix] : 0.f; fq[q] = has_vres ? VFIRST[ix] : 0.f; }
#pragma unroll
        for (int q = 0; q < 4; ++q) { const int it = it0 + q; const int h = it & 15; const size_t ix = (size_t)(it >> 4) * 1024 + h * 64 + lane; const int c = h * 64 + lane;
            const float k0 = kq[q]; const float kv = k0 * k_k[c]; const float inv = 1.f / fmaxf(sqrtf(wave_sum(kv * kv, lane)), 1e-12f);
            const float w = -softplusf(-(w0[c] + wq[q])) - 0.5f; const float dec = __expf(-__expf(w));
            const float a = sigm(a0[c] + aq[q]);
            float v = vq[q]; if (has_vres) v = v + (fq[q] - v) * sigm(v0[c] + gq[q]); else VFIRST[ix] = v;
            const float kk = kv * inv;
            NKK[ix] = -kk; K[ix] = k0 * (1.f + (a - 1.f) * k_a[c]); Wd[ix] = dec; Aa[ix] = kk * a; V[ix] = v; }
    }
}

__device__ __forceinline__ void rwkvpost_phase(const GAS float* __restrict__ Y, const GAS float* __restrict__ R, const GAS float* __restrict__ K2, const GAS float* __restrict__ V, const GAS float* __restrict__ G, const GAS float* __restrict__ r_k,
                                               const GAS float* __restrict__ lnx_g, const GAS float* __restrict__ lnx_b, GAS bf16_t* XB, int nitems, int lane, int wave_gid, int nwaves) {
    for (int it0 = wave_gid * 4; it0 < nitems; it0 += nwaves * 4) {
        float yq[4], rq[4], kq[4], vq[4], gq[4];
#pragma unroll
        for (int q = 0; q < 4; ++q) { const int it = it0 + q; const size_t ix = (size_t)(it >> 4) * 1024 + (it & 15) * 64 + lane; yq[q] = Y[ix]; rq[q] = R[ix]; kq[q] = K2[ix]; vq[q] = V[ix]; gq[q] = G[ix]; }
#pragma unroll
        for (int q = 0; q < 4; ++q) { const int it = it0 + q; const int h = it & 15; const size_t ix = (size_t)(it >> 4) * 1024 + h * 64 + lane; const int c = h * 64 + lane;
            const float y = yq[q]; const float mu = wave_sum(y, lane) * (1.f / 64.f); const float d = y - mu; const float rs = 1.f / sqrtf(wave_sum(d * d, lane) * (1.f / 64.f) + 64e-5f);
            const float bon = wave_sum(rq[q] * kq[q] * r_k[c], lane);
            const float o = (d * rs * lnx_g[c] + lnx_b[c] + bon * vq[q]) * gq[q];
            XB[ix] = (bf16_t)(pk_bf16(o, 0.f) & 0xffffu); }
    }
}

__device__ __forceinline__ void wkv_phase(const GAS float* __restrict__ R, const GAS float* __restrict__ Wd, const GAS float* __restrict__ K2, const GAS float* __restrict__ V, const GAS float* __restrict__ BB, const GAS float* __restrict__ NKK,
                                          const GAS float* __restrict__ SIN, GAS float* __restrict__ Y, GAS float* __restrict__ P, GAS float* __restrict__ SOUT, int B, int T, int DB, int DT, LAS unsigned char* lds, int tid, int bid, int nb) {
    constexpr int TB = 32, NLD = 6, VECB = TB * 1280, VVB = TB * 128, BUF = VECB + 2 * VVB;
    const int rowl = tid >> 4, part = tid & 15;
    const int nprompt = B * 32, nunits = nprompt + DB * 32;
    for (int u = bid; u < nunits; u += nb) {
        const bool smp = u >= nprompt; const int q = smp ? u - nprompt : u; const int half = q & 1, pair = q >> 1, sq = pair >> 4, h = pair & 15;
        const int Tu = smp ? DT : T; const int r0 = smp ? B * T + sq * DT : sq * T, vrow = half * 32 + rowl;
        f32x2 S01 = (f32x2){0.f, 0.f}, S23 = (f32x2){0.f, 0.f};
        if (smp) { const f32x4 s4 = *(const GAS f32x4*)(SIN + ((size_t)pair * 64 + vrow) * 64 + part * 4); S01 = (f32x2){s4.x, s4.y}; S23 = (f32x2){s4.z, s4.w};
                   asm volatile("" : "+v"(S01), "+v"(S23)); }
        const int nblk = (Tu + TB - 1) / TB;
        f32x4 ld[NLD];
        const size_t eo_ = (size_t)(r0 + (tid >> 4)) * 1024 + h * 64 + (tid & 15) * 4, ev_ = (size_t)(r0 + ((tid & 255) >> 3)) * 1024 + h * 64 + half * 32 + (tid & 7) * 4;
        const int lo_ = ((tid >> 4) * 320 + (tid & 15) * 4) * 4, lv_ = VECB + (tid & 255) * 16;
#define WKV_LOAD(tb0) do { const size_t bo_ = (size_t)(tb0) * 1024; ld[0] = *(const GAS f32x4*)(Wd + eo_ + bo_); ld[1] = *(const GAS f32x4*)(NKK + eo_ + bo_); ld[2] = *(const GAS f32x4*)(BB + eo_ + bo_); \
            ld[3] = *(const GAS f32x4*)(K2 + eo_ + bo_); ld[4] = *(const GAS f32x4*)(R + eo_ + bo_); ld[5] = *(const GAS f32x4*)(V + ev_ + bo_); } while (0)
#define WKV_STORE(bufp) do { _Pragma("unroll") for (int q_ = 0; q_ < 5; ++q_) *(LAS f32x4*)((bufp) + lo_ + q_ * 256) = ld[q_]; *(LAS f32x4*)((bufp) + lv_) = ld[5]; } while (0)
        WKV_LOAD(0); WKV_STORE(lds); __syncthreads();
        for (int b = 0; b < nblk; ++b) {
            LAS unsigned char* cur = lds + (b & 1) * BUF; LAS unsigned char* nxt = lds + ((b + 1) & 1) * BUF; const int tb0 = b * TB; const int nt = (Tu - tb0) < TB ? (Tu - tb0) : TB;
            if (b + 1 < nblk) WKV_LOAD(tb0 + TB);
            const LAS float* vec = (const LAS float*)cur + part * 4; const LAS float* vv = (const LAS float*)(cur + VECB) + rowl; LAS float* yb = (LAS float*)(cur + VECB + VVB);
            float ykeep0 = 0.f, ykeep1 = 0.f;
#define WKV_STEP(t, keep, tl) do { const LAS f32x2* vp_ = (const LAS f32x2*)(vec + (t) * 320); \
                const f32x2 w01 = vp_[0], w23 = vp_[1], n01 = vp_[32], n23 = vp_[33], b01 = vp_[64], b23 = vp_[65], k01 = vp_[96], k23 = vp_[97], r01 = vp_[128], r23 = vp_[129]; \
                const float v = vv[(t) * 32]; \
                const f32x2 sp = __builtin_elementwise_fma(S23, n23, S01 * n01); const float sa = row_sum16(sp.x + sp.y); const f32x2 sa2 = (f32x2){sa, sa}, v2 = (f32x2){v, v}; \
                S01 = __builtin_elementwise_fma(S01, w01, __builtin_elementwise_fma(b01, sa2, k01 * v2)); S23 = __builtin_elementwise_fma(S23, w23, __builtin_elementwise_fma(b23, sa2, k23 * v2)); \
                const f32x2 yp = __builtin_elementwise_fma(S23, r23, S01 * r01); const float y = row_sum16(yp.x + yp.y); \
                keep = (part == (tl)) ? y : keep; } while (0)
            if (nt == TB) {
#pragma unroll 1
                for (int t = 0; t < 16; t += 8) { WKV_STEP(t, ykeep0, t); WKV_STEP(t + 1, ykeep0, t + 1); WKV_STEP(t + 2, ykeep0, t + 2); WKV_STEP(t + 3, ykeep0, t + 3); WKV_STEP(t + 4, ykeep0, t + 4); WKV_STEP(t + 5, ykeep0, t + 5); WKV_STEP(t + 6, ykeep0, t + 6); WKV_STEP(t + 7, ykeep0, t + 7); }
#pragma unroll 1
                for (int t = 16; t < 32; t += 8) { WKV_STEP(t, ykeep1, t - 16); WKV_STEP(t + 1, ykeep1, t - 15); WKV_STEP(t + 2, ykeep1, t - 14); WKV_STEP(t + 3, ykeep1, t - 13); WKV_STEP(t + 4, ykeep1, t - 12); WKV_STEP(t + 5, ykeep1, t - 11); WKV_STEP(t + 6, ykeep1, t - 10); WKV_STEP(t + 7, ykeep1, t - 9); }
            } else { for (int t = 0; t < nt; ++t) { if (t < 16) WKV_STEP(t, ykeep0, t); else WKV_STEP(t, ykeep1, t - 16); } }
#undef WKV_STEP
            yb[part * 32 + rowl] = ykeep0; yb[(16 + part) * 32 + rowl] = ykeep1;
            if (b + 1 < nblk) WKV_STORE(nxt);
            __syncthreads();
            { const int rl = tid & 31; _Pragma("unroll") for (int t = tid >> 5; t < TB; t += 16) if (t < nt) Y[(size_t)(r0 + tb0 + t) * 1024 + h * 64 + half * 32 + rl] = yb[t * 32 + rl]; }
        }
#undef WKV_LOAD
#undef WKV_STORE
        *(GAS f32x4*)((smp ? SOUT : P) + ((size_t)pair * 64 + vrow) * 64 + part * 4) = (f32x4){S01.x, S01.y, S23.x, S23.y};
        __syncthreads();
    }
}

__device__ __forceinline__ void gla_phase(const GAS float* __restrict__ PROJ, const GAS float* __restrict__ LOGA, GAS float* __restrict__ O, GAS float* __restrict__ P, int B, int T, LAS unsigned char* lds, int tid, int bid, int nb) {
    constexpr int TB = 32, NLD = 4, VECB = TB * 768, VVB = TB * 64, BUF = VECB + 3 * VVB;
    const int col = tid >> 5, half = (tid >> 4) & 1, p = tid & 15, dk = half * 32 + p * 2;
    const int nunits = B * 32;
    for (int u = bid; u < nunits; u += nb) {
        const int cb = u & 7, pair = u >> 3, s = pair >> 2, h = pair & 3; const int r0 = s * T;
        float S0 = 0.f, S1 = 0.f;
        const int nblk = (T + TB - 1) / TB;
        f32x4 ld[NLD];
        const size_t ea_ = (size_t)(r0 + (tid >> 4)) * 256 + h * 64 + (tid & 15) * 4, ep_ = (size_t)(r0 + (tid >> 4)) * 2576 + h * 64 + (tid & 15) * 4, ev_ = (size_t)(r0 + ((tid & 127) >> 2)) * 2576 + 512 + h * 128 + cb * 16 + (tid & 3) * 4;
        const int lo_ = ((tid >> 4) * 192 + (tid & 15) * 4) * 4, lv_ = VECB + (tid & 127) * 16;
#define GLA_LOAD(tb0) do { ld[0] = *(const GAS f32x4*)(LOGA + ea_ + (size_t)(tb0) * 256); ld[1] = *(const GAS f32x4*)(PROJ + ep_ + 256 + (size_t)(tb0) * 2576); ld[2] = *(const GAS f32x4*)(PROJ + ep_ + (size_t)(tb0) * 2576); ld[3] = *(const GAS f32x4*)(PROJ + ev_ + (size_t)(tb0) * 2576); } while (0)
#define GLA_STORE(bufp) do { *(LAS f32x4*)((bufp) + lo_) = ld[0]; *(LAS f32x4*)((bufp) + lo_ + 256) = ld[1]; *(LAS f32x4*)((bufp) + lo_ + 512) = ld[2] * 0.125f; *(LAS f32x4*)((bufp) + lv_) = ld[3]; } while (0)
        GLA_LOAD(0); GLA_STORE(lds); __syncthreads();
        for (int b = 0; b < nblk; ++b) {
            LAS unsigned char* cur = lds + (b & 1) * BUF; LAS unsigned char* nxt = lds + ((b + 1) & 1) * BUF; const int tb0 = b * TB; const int nt = (T - tb0) < TB ? (T - tb0) : TB;
            if (b + 1 < nblk) GLA_LOAD(tb0 + TB);
            const LAS float* vec = (const LAS float*)cur + dk; const LAS float* vv = (const LAS float*)(cur + VECB) + col; LAS float* ob = (LAS float*)(cur + VECB + VVB);
            float okeep0 = 0.f, okeep1 = 0.f;
#define GLA_STEP(t, keep, tl) do { const f32x2 a2 = *(const LAS f32x2*)(vec + (t) * 192), k2 = *(const LAS f32x2*)(vec + (t) * 192 + 64), q2 = *(const LAS f32x2*)(vec + (t) * 192 + 128); const float v = vv[(t) * 16]; \
                S0 = fmaf(a2.x, S0, k2.x * v); S1 = fmaf(a2.y, S1, k2.y * v); \
                float o = fmaf(q2.x, S0, q2.y * S1); o = row_sum16(o); keep = (p == (tl)) ? o : keep; } while (0)
            if (nt == TB) {
#pragma unroll 1
                for (int t = 0; t < 16; t += 4) { GLA_STEP(t, okeep0, t); GLA_STEP(t + 1, okeep0, t + 1); GLA_STEP(t + 2, okeep0, t + 2); GLA_STEP(t + 3, okeep0, t + 3); }
#pragma unroll 1
                for (int t = 16; t < 32; t += 4) { GLA_STEP(t, okeep1, t - 16); GLA_STEP(t + 1, okeep1, t - 15); GLA_STEP(t + 2, okeep1, t - 14); GLA_STEP(t + 3, okeep1, t - 13); }
            } else { for (int t = 0; t < nt; ++t) { if (t < 16) GLA_STEP(t, okeep0, t); else GLA_STEP(t, okeep1, t - 16); } }
#undef GLA_STEP
            ob[(p * 16 + col) * 2 + half] = okeep0; ob[((16 + p) * 16 + col) * 2 + half] = okeep1;
            if (b + 1 < nblk) GLA_STORE(nxt);
            __syncthreads();
            { const int t = tid >> 4, c = tid & 15; if (t < nt) { const f32x2 o2 = *(const LAS f32x2*)(ob + (t * 16 + c) * 2); O[(size_t)(r0 + tb0 + t) * 512 + h * 128 + cb * 16 + c] = o2.x + o2.y; } }
        }
#undef GLA_LOAD
#undef GLA_STORE
        { GAS float* so = P + ((size_t)pair * 64 + dk) * 128 + cb * 16 + col; so[0] = S0; so[128] = S1; }
        __syncthreads();
    }
}
__device__ __forceinline__ float grp8_sum(float v) { v += dppf<0xB1>(v); v += dppf<0x4E>(v); v += dppf<0x141>(v); return v; }
__device__ __forceinline__ float dot16_fp8_bf16(const u32x4 uw, const float (&x)[16]) { float s = 0.f;
#pragma unroll
    for (int d = 0; d < 4; ++d) { const f32x2 lo = fp8lo(uw[d]), hi = fp8hi(uw[d]); s = fmaf(lo.x, x[4 * d], s); s = fmaf(lo.y, x[4 * d + 1], s); s = fmaf(hi.x, x[4 * d + 2], s); s = fmaf(hi.y, x[4 * d + 3], s); }
    return s; }
__device__ __forceinline__ void pacts_phase(const GAS bf16_t* __restrict__ XB, const GAS unsigned char* __restrict__ U8S, const GAS int* __restrict__ EIDX, GAS float* __restrict__ PART, int M,
                                            int wid, int lane, int bid, int nb) {
    const bool spl = (nb & 7) == 0; const int s0 = spl ? (bid & 7) : 0, s1 = spl ? s0 + 1 : 8, r = spl ? (bid >> 3) : bid, nr = spl ? (nb >> 3) : nb;
    const int g = lane >> 3, ch = lane & 7, h = wid;
    constexpr int NB = 8;
    for (int s = s0; s < s1; ++s) {
        const GAS unsigned char* tb = U8S + (size_t)s * 16384 * 128 + ch * 16; GAS float* po = PART + (size_t)s * M * 128;
        for (int row0 = r; row0 < M; row0 += nr * NB) {
            int e0[NB], e1[NB];
#pragma unroll
            for (int q = 0; q < NB; ++q) { int row = row0 + nr * q; row = row < M ? row : r; e0[q] = EIDX[((size_t)row * 8 + h) * 16 + g]; e1[q] = EIDX[((size_t)row * 8 + h) * 16 + 8 + g]; }
            u32x4 u0[NB], u1[NB], xa[NB], xb[NB];
#pragma unroll
            for (int q = 0; q < NB; ++q) { int row = row0 + nr * q; row = row < M ? row : r; u0[q] = *(const GAS u32x4*)(tb + (size_t)e0[q] * 128); u1[q] = *(const GAS u32x4*)(tb + (size_t)e1[q] * 128);
                const GAS u32x4* xp = (const GAS u32x4*)(XB + (size_t)row * 1024 + s * 128 + ch * 16); xa[q] = xp[0]; xb[q] = xp[1]; }
#pragma unroll
            for (int q = 0; q < NB; ++q) { const int row = row0 + nr * q; float x[16];
#pragma unroll
                for (int i = 0; i < 4; ++i) { x[2 * i] = bflo(xa[q][i]); x[2 * i + 1] = bfhi(xa[q][i]); x[8 + 2 * i] = bflo(xb[q][i]); x[8 + 2 * i + 1] = bfhi(xb[q][i]); }
                float p0 = dot16_fp8_bf16(u0[q], x), p1 = dot16_fp8_bf16(u1[q], x);
                p0 = grp8_sum(p0); p1 = grp8_sum(p1);
                asm volatile("" : "+v"(p0), "+v"(p1));
                if (ch == 0 && row < M) { GAS float* d = po + ((size_t)row * 8 + h) * 16 + g; d[0] = p0; d[8] = p1; } }
        }
    }
}
__device__ __forceinline__ void pouts_phase(const GAS float* __restrict__ COEF, const GAS int* __restrict__ EIDX, const GAS unsigned char* V8S, GAS float* __restrict__ YBUF, int M,
                                            int wid, int lane, int bid, int nb) {
    const bool spl = (nb & 7) == 0; const int s0 = spl ? (bid & 7) : 0, s1 = spl ? s0 + 1 : 8, r = spl ? (bid >> 3) : bid, nr = spl ? (nb >> 3) : nb;
    const int g = lane >> 3, ch = lane & 7, rstep = nr * 8;
#define PO_LOADCE(rw, c0, c1, v0, v1) do { c0 = COEF[(size_t)(rw) * 128 + lane] * (1.f / 64.f); c1 = COEF[(size_t)(rw) * 128 + 64 + lane] * (1.f / 64.f); v0 = EIDX[(size_t)(rw) * 128 + lane]; v1 = EIDX[(size_t)(rw) * 128 + 64 + lane]; } while (0)
#define PO_GATHER(vv_, vreg) do { _Pragma("unroll") for (int k = 0; k < 8; ++k) { const int e = __builtin_amdgcn_ds_bpermute((8 * k + g) << 2, vreg); vv_[k] = *(const GAS u32x4*)(tb + (size_t)(e & 16383) * 128); } } while (0)
#define PO_COMP(vv_, creg) do { _Pragma("unroll") for (int k = 0; k < 8; ++k) { const float c = __int_as_float(__builtin_amdgcn_ds_bpermute((8 * k + g) << 2, __float_as_int(creg))); const u32x4 w = vv_[k]; \
        _Pragma("unroll") for (int d = 0; d < 4; ++d) { const f32x2 lo = fp8lo(w[d]), hi = fp8hi(w[d]); acc[4 * d] = fmaf(c, lo.x, acc[4 * d]); acc[4 * d + 1] = fmaf(c, lo.y, acc[4 * d + 1]); acc[4 * d + 2] = fmaf(c, hi.x, acc[4 * d + 2]); acc[4 * d + 3] = fmaf(c, hi.y, acc[4 * d + 3]); } \
        _Pragma("unroll") for (int i = 0; i < 16; ++i) asm volatile("" : "+v"(acc[i])); } } while (0)
    for (int s = s0; s < s1; ++s) {
        const GAS unsigned char* tb = V8S + (size_t)s * 16384 * 128 + ch * 16;
        int row = r + nr * wid; if (row >= M) continue;
        float c0c, c1c, c0n = 0.f, c1n = 0.f; int v0c, v1c, v0n = 0, v1n = 0;
        PO_LOADCE(row, c0c, c1c, v0c, v1c);
        u32x4 va[8], vb[8];
        PO_GATHER(va, v0c);
        for (;;) {
            const int rown = row + rstep; const bool hasn = rown < M;
            PO_GATHER(vb, v1c);
            if (hasn) PO_LOADCE(rown, c0n, c1n, v0n, v1n);
            float acc[16];
#pragma unroll
            for (int i = 0; i < 16; ++i) acc[i] = 0.f;
            PO_COMP(va, c0c);
            if (hasn) PO_GATHER(va, v0n);
            PO_COMP(vb, c1c);
#pragma unroll
            for (int i = 0; i < 16; ++i) acc[i] += dppf<0x128>(acc[i]);
#pragma unroll
            for (int i = 0; i < 8; ++i) { const bool hi = lane & 16; const float send = hi ? acc[i] : acc[i + 8], keep = hi ? acc[i + 8] : acc[i]; acc[i] = keep + shx(send, 16, lane); }
#pragma unroll
            for (int i = 0; i < 4; ++i) { const bool hi = lane & 32; const float send = hi ? acc[i] : acc[i + 4], keep = hi ? acc[i + 4] : acc[i]; acc[i] = keep + shx(send, 32, lane); }
            if ((lane & 8) == 0) *(GAS f32x4*)(YBUF + (size_t)row * 1024 + s * 128 + ch * 16 + ((lane >> 4) & 1) * 8 + ((lane >> 5) & 1) * 4) = (f32x4){acc[0], acc[1], acc[2], acc[3]};
            if (!hasn) break;
            row = rown; c0c = c0n; c1c = c1n; v0c = v0n; v1c = v1n;
        }
    }
#undef PO_LOADCE
#undef PO_GATHER
#undef PO_COMP
}
}

template <class T> __device__ __forceinline__ __attribute__((address_space(1))) T* gp(T* p) { return (__attribute__((address_space(1))) T*)uni_ptr(p); }
constexpr int MK_THREADS = 512, LDS_BYTES = 163840, LDSCTL_OFF = 131072, TAB_OFF = LDSCTL_OFF + 1024, MAX_OPS = 208;
static_assert(TAB_OFF + MAX_OPS * (int)sizeof(Op) <= LDS_BYTES, "LDS map");
constexpr int MPAD = 17152;
constexpr size_t CTL_BYTES = (size_t)1 << 20;
struct MArgs { const float* in[47]; float* out; char* ws; unsigned long long ws_size; };
__global__ void __launch_bounds__(MK_THREADS, 2) mega_fwd(MArgs a) {
    extern __shared__ __attribute__((aligned(16))) unsigned char lds[];
    volatile LAS unsigned* ctl = (volatile LAS unsigned*)((LAS unsigned char*)lds + LDSCTL_OFF);
    if (threadIdx.x < 64) ctl[threadIdx.x] = 0u;
    __syncthreads();
    XcdBarrier bar = xcd_barrier_post((unsigned*)a.ws, ctl + 8);
    const Dm dm = make_dm(1024, 8, 2048, 128, 4);
    Op* tab = (Op*)(lds + TAB_OFF);
    if (threadIdx.x == 0) {
        const float* const* inp_ = (const float* const*)__builtin_amdgcn_kernarg_segment_ptr(); asm volatile("" : "+s"(inp_));
        NvIO io; io.in = inp_; io.out = a.out; io.ws = a.ws + CTL_BYTES; io.ws_size = a.ws_size - CTL_BYTES;
        int n = 0;
        nv_forward(io, dm, [&](const Op& o) __attribute__((always_inline)) { if (n < MAX_OPS) tab[n] = o; ++n; asm volatile("" ::: "memory"); });
        ctl[16] = (unsigned)(n <= MAX_OPS ? n : 0);
    }
    __syncthreads();
    const int nops = (int)ctl[16];
    for (int i = 0; i < nops; ++i) {
        int tid_ = (int)threadIdx.x, bid_ = (int)blockIdx.x, nb_ = (int)gridDim.x;
        asm volatile("" : "+v"(tid_)); asm volatile("" : "+s"(bid_)); asm volatile("" : "+s"(nb_));
        const long long g0 = (long long)bid_ * MK_THREADS + tid_, gs = (long long)nb_ * MK_THREADS;
        const Op& o = tab[i];
        const int rawc = __builtin_amdgcn_readfirstlane(o.code); const int code = rawc & 0xff; const long long n = o.n;
        switch (code) {
        case OP_FGEMM: {
            const int fl = rfl(o.i6);
            pg8::Gemm g{uni_ptr((const pg8::bf16_t*)o.a), uni_ptr((const pg8::bf16_t*)o.b), MPAD, rfl(o.i5), rfl(o.i1), rfl(o.i2), rfl(o.i3)};
            if (rawc & OPF_GROUP) {
                int ng = 1; while (ng < 8 && (rfl(tab[i + ng - 1].code) & OPF_GROUP)) ++ng;
                const PG8_LAS Op* gt = (const PG8_LAS Op*)((PG8_LAS unsigned char*)lds + TAB_OFF) + i;
                pg8::GroupOrder S; S.tab = gt; S.ng = ng; S.nM = MPAD / 256; S.G = nb_; S.c = bid_; S.tsA = (size_t)256 * g.lda * 2; S.tsB = (size_t)256 * g.ldb * 2;
                pg8::EpiF32G E{gt, dm.M};
                pg8::gemm_phase<pg8::EpiF32G, pg8::GroupOrder, true, true>((PG8_LAS unsigned char*)lds, g, S, E);
                i += ng - 1;
            } else {
            pg8::StaticOrder S; S.init(g, nb_, bid_); if (fl & 2) S.acs = 512;
            if (fl & 1) { pg8::EpiBf16Plain E{uni_ptr((pg8::bf16_t*)o.o0), rfl(o.i4)}; pg8::gemm_phase<pg8::EpiBf16Plain, pg8::StaticOrder, true, true>((PG8_LAS unsigned char*)lds, g, S, E); }
            else { pg8::EpiF32 E{uni_ptr(o.o0), rfl(o.i4), dm.M, rfl(o.i0)}; pg8::gemm_phase<pg8::EpiF32, pg8::StaticOrder, true, true>((PG8_LAS unsigned char*)lds, g, S, E); }
            }
        } break;
        case OP_LRUG2: {
            pg8::Gemm g{uni_ptr((const pg8::bf16_t*)o.a), uni_ptr((const pg8::bf16_t*)o.b), MPAD, 1024, 512, 512, 512};
            pg8::StaticOrder S; S.init(g, nb_, bid_);
            pg8::EpiLru E{uni_ptr(o.c), uni_ptr(o.d), uni_ptr(o.e), uni_ptr(o.f), uni_ptr(o.o0), uni_ptr(o.o1), dm.M};
            pg8::gemm_phase<pg8::EpiLru, pg8::StaticOrder, true, true>((PG8_LAS unsigned char*)lds, g, S, E);
        } break;
        case OP_WKVF: fk::wkv_phase(gp(o.a), gp(o.b), gp(o.c), gp(o.d), gp(o.e), gp(o.f), gp(o.g), gp(o.o0), gp(o.o1), gp(o.o2), dm.B, dm.T, dm.DB, dm.DT, (LAS unsigned char*)lds, tid_, bid_, nb_); break;
        case OP_GLAF: fk::gla_phase(gp(o.a), gp(o.b), gp(o.o0), gp(o.o1), dm.B, dm.T, (LAS unsigned char*)lds, tid_, bid_, nb_); break;
        case OP_PACTS: fk::pacts_phase(gp((const fk::bf16_t*)o.a), gp((const unsigned char*)o.b), gp((const int*)o.d), gp(o.o0), dm.M, tid_ >> 6, tid_ & 63, bid_, nb_); break;
        case OP_POUTS: fk::pouts_phase(gp(o.a), gp((const int*)o.b), gp((const unsigned char*)o.c), gp(o.o0), dm.M, tid_ >> 6, tid_ & 63, bid_, nb_); break;
        case OP_TOPK2: fk::topk_phase(gp(o.a), gp((const fk::bf16_t*)o.b), gp(o.c), gp(o.o0), gp((int*)o.o1), dm.M * 8, (LAS unsigned char*)lds, tid_ >> 6, tid_ & 63, bid_ * 8 + (tid_ >> 6), nb_ * 8); break;
        case OP_LNRES: fk::lnres_phase(gp(o.a), gp(o.b), gp(o.c), gp(o.o0), gp((fk::bf16_t*)o.o1), dm.M, tid_ & 63, bid_ * 8 + (tid_ >> 6), nb_ * 8); break;
        case OP_GLANORM: fk::glanorm_phase(gp(o.a), gp(o.b), gp(o.c), gp((fk::bf16_t*)o.o0), dm.M * 4, tid_ & 63, bid_ * 8 + (tid_ >> 6), nb_ * 8); break;
        case OP_RWKVPREP: fk::rwkvprep_phase(gp(o.a), gp(o.b), gp(o.c), gp(o.d), gp(o.e), gp(o.f), gp(o.o0), gp(o.o1), gp(o.o2), gp(o.o3), gp(o.o4), gp(o.o5), __builtin_amdgcn_readfirstlane(o.i0), dm.M * 16, tid_ & 63, bid_ * 8 + (tid_ >> 6), nb_ * 8); break;
        case OP_RWKVPOST: fk::rwkvpost_phase(gp(o.a), gp(o.b), gp(o.c), gp(o.d), gp(o.e), gp(o.f), gp(o.g), gp(o.h), gp((fk::bf16_t*)o.o0), dm.M * 16, tid_ & 63, bid_ * 8 + (tid_ >> 6), nb_ * 8); break;
#define NVC(c) case c: for (long long g = g0; g < n; g += gs) nv_elem(c, o, dm, g); break;
        NVC(OP_LOGA) NVC(OP_CONVOUT) NVC(OP_SHIFTOUT) NVC(OP_EMBED4) NVC(OP_YOUT4) NVC(OP_MIX6) NVC(OP_CONV4) NVC(OP_CVT8) NVC(OP_WGATE)
        NVC(OP_WT) NVC(OP_CVTTAB8S) NVC(OP_PRED) NVC(OP_KEYS) NVC(OP_GLA3) NVC(OP_LRU1) NVC(OP_LRU2) NVC(OP_LRU3)
#undef NVC
        default: break;
        }
        if (__builtin_amdgcn_readfirstlane(tab[i].code) & OPF_NOBAR) __syncthreads(); else xcd_barrier(bar);
    }
}
extern "C" void kernel_launch(void* const* d_in, const int* in_sizes, int n_in, void* d_out, int out_size, void* d_ws, size_t ws_size, hipStream_t stream) {
    static int grid = 0;
    if (grid == 0) {
        if (n_in != 47 || ws_size < ((size_t)900 << 20)) { fprintf(stderr, "kernel_launch: expected 47 inputs and >= 900 MiB of workspace; got %d, %zu\n", n_in, ws_size); grid = -1; return; }
        int dev = 0, cus = 0, per_cu = 0;
        if (hipGetDevice(&dev) != hipSuccess || hipDeviceGetAttribute(&cus, hipDeviceAttributeMultiprocessorCount, dev) != hipSuccess) { grid = -1; return; }
        if (hipFuncSetAttribute((const void*)mega_fwd, hipFuncAttributeMaxDynamicSharedMemorySize, LDS_BYTES) != hipSuccess) { fprintf(stderr, "kernel_launch: hipFuncSetAttribute failed\n"); grid = -1; return; }
        if (hipOccupancyMaxActiveBlocksPerMultiprocessor(&per_cu, (const void*)mega_fwd, MK_THREADS, LDS_BYTES) != hipSuccess || per_cu < 1) fprintf(stderr, "kernel_launch: occupancy query says %d per CU\n", per_cu);
        (void)hipGetLastError();
        grid = cus;
    }
    if (grid < 0) return;
    if (hipMemsetAsync(d_ws, 0, CTL_BYTES, stream) != hipSuccess) { fprintf(stderr, "kernel_launch: memset failed\n"); return; }
    MArgs a{}; for (int i = 0; i < 47; ++i) a.in[i] = (const float*)d_in[i]; a.out = (float*)d_out; a.ws = (char*)d_ws; a.ws_size = (unsigned long long)ws_size;
    hipLaunchKernelGGL(mega_fwd, dim3(grid), dim3(MK_THREADS), LDS_BYTES, stream, a);
}
```

```cpp
#include <hip/hip_runtime.h>
#include <cstdio>
#include <cmath>
#ifndef HD
#define HD __host__ __device__ __forceinline__
#endif
struct Dm { int D, B, T, DB, DT, M, NSEQ, RH; };
HD Dm make_dm(int D, int B, int SEQ, int DB, int DT) { Dm d; d.D = D; d.B = B; d.T = SEQ + 16; d.DB = DB; d.DT = DT; d.M = B * d.T + DB * DT; d.NSEQ = B + DB; d.RH = D / 64; return d; }
HD int seq_row0(const Dm& d, int s) { return s < d.B ? s * d.T : d.B * d.T + (s - d.B) * d.DT; }
HD int seq_len(const Dm& d, int s) { return s < d.B ? d.T : d.DT; }
HD void row_to_seq(const Dm& d, int row, int& s, int& t) { if (row < d.B * d.T) { s = row / d.T; t = row % d.T; } else { int r = row - d.B * d.T; s = d.B + r / d.DT; t = r % d.DT; } }

constexpr int MIXIN = 2576, C_Q = 0, C_K = 256, C_V = 512, C_GLR = 1024, C_R = 1040, C_XB = 1552, C_GB = 2064;

enum { OP_EMBED = 1, OP_GEMM, OP_LOGA, OP_GLA, OP_GLANORM, OP_CONV, OP_CONVOUT, OP_LRUG, OP_LRUSCAN, OP_LNRES, OP_MIX, OP_SHIFTOUT,
       OP_RWKVPREP, OP_WKV, OP_RWKVPOST, OP_QNORM, OP_SCORES, OP_TOPK, OP_PACT1, OP_PACT2, OP_POUT, OP_YOUT, OP_WT, OP_CVT, OP_FGEMM, OP_CVTTAB, OP_KEYS, OP_TOPK2, OP_PACT, OP_POUTLN, OP_GLA1, OP_GLA2, OP_GLA3, OP_LRU1, OP_LRU2, OP_LRU3, OP_EMBED4, OP_YOUT4, OP_MIX8, OP_CONV4, OP_CVT8, OP_WGATE, OP_LRUG2, OP_WKVF, OP_GLAF, OP_CVTTAB8, OP_CVTTAB8S, OP_PACTS, OP_PRED, OP_POUTS, OP_MIX6, OP_PRM, OP_WKVP, OP_POST2 };

constexpr int OPF_NOBAR = 0x100, OPF_GROUP = 0x200;
struct Op {
    const float *a, *b, *c, *d, *e, *f, *g, *h;
    float *o0, *o1, *o2, *o3, *o4, *o5;
    long long n;
    int code, i0, i1, i2, i3, i4, i5, i6;
};

#if defined(__HIP_DEVICE_COMPILE__)
#define NV_UNI(x) __builtin_amdgcn_readfirstlane(x)
#define NV_LAUNDER(p) asm volatile("" : "+s"(p))
#define NV_FENCE() asm volatile("" ::: "memory")
#else
#define NV_FENCE() do {} while (0)
#define NV_UNI(x) (x)
#define NV_LAUNDER(p) do {} while (0)
#endif
typedef unsigned short nvbf;
HD nvbf nv_f2bf(float f) { unsigned u; __builtin_memcpy(&u, &f, 4); return (nvbf)((u + 0x7fffu + ((u >> 16) & 1u)) >> 16); }
HD float nv_bf2f(nvbf h) { unsigned u = (unsigned)h << 16; float f; __builtin_memcpy(&f, &u, 4); return f; }
HD unsigned nv_f2e4m3(float f) {
    unsigned u; __builtin_memcpy(&u, &f, 4); const unsigned sign = (u >> 24) & 0x80u; const float a = fabsf(f);
    if (!(a < 448.f)) return sign | 0x7Eu;
    if (a < 0.015625f) return sign | (unsigned)rintf(a * 512.f);
    unsigned au = u & 0x7fffffffu; au += 0x7ffffu + ((au >> 20) & 1u);
    const unsigned e = ((au >> 23) & 0xffu) - 120u, m = (au >> 20) & 7u; unsigned code = (e << 3) | m; if (code > 0x7Eu) code = 0x7Eu;
    return sign | code; }
HD float nv_e4m32f(unsigned c) { const unsigned e = (c >> 3) & 15u, m = c & 7u; const float v = e ? ldexpf(1.f + m * 0.125f, (int)e - 7) : m * 0.001953125f; return (c & 0x80u) ? -v : v; }
HD int nv_rup(int x, int m) { return (x + m - 1) / m * m; }
struct alignas(16) NvF4 { float x, y, z, w; };
struct alignas(16) NvU4 { unsigned x, y, z, w; };
struct alignas(8) NvU2 { unsigned x, y; };
HD float nv_sigmoid(float x) { return 1.f / (1.f + expf(-x)); }
HD float nv_softplus(float x) { return fmaxf(x, 0.f) + log1pf(expf(-fabsf(x))); }
HD float nv_gelu(float x) { return 0.5f * x * (1.f + tanhf(0.7978845608028654f * (x + 0.044715f * x * x * x))); }

#define NV_INS16(tv, ti, val, idx) do { float _v = (val); int _i = (idx); _Pragma("unroll") for (int _j = 0; _j < 16; ++_j) { if (_v > tv[_j]) { float _tv = tv[_j]; int _ti = ti[_j]; tv[_j] = _v; ti[_j] = _i; _v = _tv; _i = _ti; } } } while (0)

HD void nv_elem(const int code, const Op& p, const Dm& dm, long long gid) {
    const int D = dm.D; float* const PO1 = p.o1; float* const PO2 = p.o2;
    switch (code) {
    case OP_EMBED: {
        int row = (int)(gid / D), c = (int)(gid % D); float v;
        if (row < dm.B * dm.T) { int bb = row / dm.T, t = row % dm.T; v = t < 16 ? p.c[t * D + c] : p.a[((size_t)bb * (dm.T - 16) + (t - 16)) * D + c]; }
        else v = p.b[(size_t)(row - dm.B * dm.T) * D + c];
        p.o0[gid] = v; ((nvbf*)p.o1)[gid] = nv_f2bf(v); } break;
    case OP_GEMM: {
        int N4 = p.i0 >> 2, K = p.i1; int m = (int)(gid / N4), nn = (int)(gid % N4) * 4; const float* A = p.a + (size_t)m * p.i2; const float* Bw = p.b + nn; float c0 = 0.f, c1 = 0.f, c2 = 0.f, c3 = 0.f;
        for (int k = 0; k < K; ++k) { float av = A[k]; if (p.i5 == 1) av = tanhf(av); else if (p.i5 == 2) av = nv_sigmoid(av); const NvF4 bv = *(const NvF4*)(Bw + (size_t)k * p.i3);
            c0 = fmaf(av, bv.x, c0); c1 = fmaf(av, bv.y, c1); c2 = fmaf(av, bv.z, c2); c3 = fmaf(av, bv.w, c3); }
        float* C = p.o0 + (size_t)m * p.i4 + nn; C[0] = c0; C[1] = c1; C[2] = c2; C[3] = c3; } break;
    case OP_LOGA: {
        int row = (int)(gid / 256), c = (int)(gid % 256); float z = p.c[c];
        for (int r = 0; r < 16; ++r) z = fmaf(p.a[(size_t)row * MIXIN + C_GLR + r], p.b[r * 256 + c], z);
        p.o0[gid] = expf(-nv_softplus(-z) * (1.f / 16.f)); } break;
    case OP_GLAF:
    case OP_GLA: {
        int s = (int)(gid / 512), h = (int)((gid / 128) % 4), col = (int)(gid % 128);
        float S[64];
        const float* sin = (s < dm.B) ? nullptr : p.c + (((size_t)(s - dm.B) * 4 + h) * 64) * 128 + col;
#pragma unroll
        for (int k = 0; k < 64; ++k) S[k] = sin ? sin[(size_t)k * 128] : 0.f;
        int r0 = seq_row0(dm, s), L = seq_len(dm, s);
        for (int t = 0; t < L; ++t) {
            const float* pr = p.a + (size_t)(r0 + t) * MIXIN; const float* la = p.b + (size_t)(r0 + t) * 256 + h * 64;
            float v = pr[C_V + h * 128 + col], o = 0.f;
#pragma unroll
            for (int k = 0; k < 64; ++k) { if ((k & 7) == 0) NV_FENCE(); S[k] = fmaf(la[k], S[k], pr[C_K + h * 64 + k] * v); o = fmaf(pr[C_Q + h * 64 + k] * 0.125f, S[k], o); }
            p.o0[(size_t)(r0 + t) * 512 + h * 128 + col] = o;
        }
        float* so = (s < dm.B) ? PO1 + (((size_t)s * 4 + h) * 64) * 128 + col : PO2 + (((size_t)(s - dm.B) * 4 + h) * 64) * 128 + col;
#pragma unroll
        for (int k = 0; k < 64; ++k) so[(size_t)k * 128] = S[k]; } break;
    case OP_GLA1: {
        const int NC = p.i0; const int u = NV_UNI((int)(gid / 128)), col = (int)(gid % 128); const int s = u / (4 * NC), h = (u / NC) % 4, c = u % NC;
        const int r0 = seq_row0(dm, s) + c * 64; int L = dm.T - c * 64; L = L > 64 ? 64 : L;
        float S[64];
#pragma unroll
        for (int k = 0; k < 64; ++k) S[k] = 0.f;
        float dprod = 1.f;
        for (int t = 0; t < L; ++t) {
            const float* pr = p.a + (size_t)(r0 + t) * MIXIN; const float* la = p.b + (size_t)(r0 + t) * 256 + h * 64; const float v = pr[C_V + h * 128 + col];
            if (col < 64) dprod *= la[col];
#pragma unroll
            for (int k = 0; k < 64; ++k) { if ((k & 7) == 0) NV_FENCE(); S[k] = fmaf(la[k], S[k], pr[C_K + h * 64 + k] * v); }
        }
        float* so = p.o0 + (size_t)u * 8192 + col;
#pragma unroll
        for (int k = 0; k < 64; ++k) so[(size_t)k * 128] = S[k];
        if (col < 64) p.o1[(size_t)u * 64 + col] = dprod; } break;
    case OP_GLA2: {
        const int NC = p.i0; const int pair = (int)(gid / 8192), e = (int)(gid % 8192), dk = e / 128; float S = 0.f;
        for (int c = 0; c < NC; ++c) { const size_t ix = ((size_t)pair * NC + c) * 8192 + e; const float l = p.o0[ix]; p.o0[ix] = S; S = fmaf(p.a[((size_t)pair * NC + c) * 64 + dk], S, l); }
        p.o1[gid] = S; } break;
    case OP_GLA3: {
        const int NC = p.i0; const int NP = dm.B * 4 * NC; const int u = NV_UNI((int)(gid / 128)) + (p.i1 ? NP : 0), col = (int)(gid % 128); int s, h, r0, L; const float* sin; float* sout = nullptr;
        if (u < NP) { s = u / (4 * NC); h = (u / NC) % 4; const int c = u % NC; r0 = seq_row0(dm, s) + c * 64; L = dm.T - c * 64; L = L > 64 ? 64 : L; sin = p.d + (size_t)u * 8192 + col; }
        else { const int q = u - NP; s = dm.B + q / 4; h = q % 4; r0 = seq_row0(dm, s); L = dm.DT; sin = p.c + (((size_t)(s - dm.B) * 4 + h) * 64) * 128 + col; sout = p.o2 + (((size_t)(s - dm.B) * 4 + h) * 64) * 128 + col; }
        float S[64];
#pragma unroll
        for (int k = 0; k < 64; ++k) S[k] = sin[(size_t)k * 128];
        for (int t = 0; t < L; ++t) {
            const float* pr = p.a + (size_t)(r0 + t) * MIXIN; const float* la = p.b + (size_t)(r0 + t) * 256 + h * 64; const float v = pr[C_V + h * 128 + col]; float o = 0.f;
#pragma unroll
            for (int k = 0; k < 64; ++k) { if ((k & 7) == 0) NV_FENCE(); S[k] = fmaf(la[k], S[k], pr[C_K + h * 64 + k] * v); o = fmaf(pr[C_Q + h * 64 + k] * 0.125f, S[k], o); }
            p.o0[(size_t)(r0 + t) * 512 + h * 128 + col] = o;
        }
        if (sout) {
#pragma unroll
            for (int k = 0; k < 64; ++k) sout[(size_t)k * 128] = S[k]; } } break;
    case OP_LRU1: {
        const int NC = p.i0; const int u = (int)(gid / 512), c = (int)(gid % 512); const int s = u / NC, ch = u % NC; const int r0 = seq_row0(dm, s) + ch * 64; int L = dm.T - ch * 64; L = L > 64 ? 64 : L; float hh = 0.f, ap = 1.f;
#pragma unroll 8
        for (int t = 0; t < L; ++t) { const size_t ix = (size_t)(r0 + t) * 512 + c; const float a = p.a[ix]; hh = fmaf(a, hh, p.b[ix]); ap *= a; }
        p.o0[gid] = ap; p.o1[gid] = hh; } break;
    case OP_LRU2: {
        const int NC = p.i0; const int s = (int)(gid / 512), c = (int)(gid % 512); float hh = 0.f;
        for (int ch = 0; ch < NC; ++ch) { const size_t ix = ((size_t)s * NC + ch) * 512 + c; const float l = p.o0[ix]; p.o0[ix] = hh; hh = fmaf(p.a[ix], hh, l); }
        p.o1[gid] = hh; } break;
    case OP_LRU3: {
        const int NC = p.i0; const int u = (int)(gid / 512), c = (int)(gid % 512); const int NP = dm.B * NC; int r0, L; float hh; float* hout = nullptr;
        if (u < NP) { const int s = u / NC, ch = u % NC; r0 = seq_row0(dm, s) + ch * 64; L = dm.T - ch * 64; L = L > 64 ? 64 : L; hh = p.e[gid]; }
        else { const int q = u - NP; r0 = seq_row0(dm, dm.B + q); L = dm.DT; hh = p.d[(size_t)q * 512 + c]; hout = p.o2 + (size_t)q * 512 + c; }
#pragma unroll 8
        for (int t = 0; t < L; ++t) { const size_t r = (size_t)(r0 + t); hh = fmaf(p.a[r * 512 + c], hh, p.b[r * 512 + c]); ((nvbf*)p.o0)[r * 1024 + 512 + c] = nv_f2bf(hh * nv_gelu(p.c[r * MIXIN + C_GB + c])); }
        if (hout) *hout = hh; } break;
    case OP_EMBED4: {
        const int D4 = D / 4; const int row = (int)(gid / D4), c = (int)(gid % D4) * 4; const float* src;
        if (row < dm.B * dm.T) { const int bb = row / dm.T, t = row % dm.T; src = t < 16 ? p.c + (size_t)t * D + c : p.a + ((size_t)bb * (dm.T - 16) + (t - 16)) * D + c; } else src = p.b + (size_t)(row - dm.B * dm.T) * D + c;
        const NvF4 v = *(const NvF4*)src; *(NvF4*)(p.o0 + (size_t)row * D + c) = v; NvU2 w; w.x = nv_f2bf(v.x) | ((unsigned)nv_f2bf(v.y) << 16); w.y = nv_f2bf(v.z) | ((unsigned)nv_f2bf(v.w) << 16); *(NvU2*)((nvbf*)p.o1 + (size_t)row * D + c) = w; } break;
    case OP_YOUT4: {
        const int D4 = D / 4; const int row = (int)(gid / D4), c = (int)(gid % D4) * 4; const NvF4 v = *(const NvF4*)(p.a + (size_t)row * D + c);
        if (row < dm.B * dm.T) { const int bb = row / dm.T, t = row % dm.T; if (t >= 16) *(NvF4*)(p.o0 + ((size_t)bb * (dm.T - 16) + (t - 16)) * D + c) = v; }
        else *(NvF4*)(p.o0 + ((size_t)dm.B * (dm.T - 16) + (row - dm.B * dm.T)) * D + c) = v; } break;
    case OP_MIX8: {
        const int D8 = D / 8; const int row = (int)(gid / D8), c = (int)(gid % D8) * 8; int s, t; row_to_seq(dm, row, s, t); const float* x = p.a + (size_t)row * D + c; float xp[8];
        if (t > 0) { for (int i = 0; i < 8; ++i) xp[i] = x[i - D]; } else if (s < dm.B) { for (int i = 0; i < 8; ++i) xp[i] = 0.f; } else { for (int i = 0; i < 8; ++i) xp[i] = p.b[(size_t)(s - dm.B) * D + c + i]; }
        unsigned w[4];
#pragma unroll
        for (int i = 0; i < 4; ++i) { const float lo = x[2 * i] + (xp[2 * i] - x[2 * i]) * p.c[c + 2 * i], hi = x[2 * i + 1] + (xp[2 * i + 1] - x[2 * i + 1]) * p.c[c + 2 * i + 1]; w[i] = nv_f2bf(lo) | ((unsigned)nv_f2bf(hi) << 16); }
        NvU4 o; o.x = w[0]; o.y = w[1]; o.z = w[2]; o.w = w[3]; *(NvU4*)((nvbf*)p.o0 + (size_t)row * D + c) = o; } break;
    case OP_MIX6: {
        const int D8 = D / 8; const int row = (int)(gid / D8), c = (int)(gid % D8) * 8; int s, t; row_to_seq(dm, row, s, t); const float* x = p.a + (size_t)row * D + c; float xv[8], dx[8];
        for (int i = 0; i < 8; ++i) xv[i] = x[i];
        if (t > 0) { for (int i = 0; i < 8; ++i) dx[i] = x[i - D] - xv[i]; } else if (s < dm.B) { for (int i = 0; i < 8; ++i) dx[i] = -xv[i]; } else { for (int i = 0; i < 8; ++i) dx[i] = p.b[(size_t)(s - dm.B) * D + c + i] - xv[i]; }
        for (int m = 0; m < 6; ++m) { const float* mu = p.c + (size_t)m * D + c; unsigned w[4];
#pragma unroll
            for (int i = 0; i < 4; ++i) w[i] = nv_f2bf(xv[2 * i] + dx[2 * i] * mu[2 * i]) | ((unsigned)nv_f2bf(xv[2 * i + 1] + dx[2 * i + 1] * mu[2 * i + 1]) << 16);
            NvU4 o; o.x = w[0]; o.y = w[1]; o.z = w[2]; o.w = w[3]; *(NvU4*)((nvbf*)p.o0 + (size_t)m * p.i0 * 0 + (size_t)m * (size_t)p.i1 * 1024 + (size_t)row * D + c) = o; } } break;
    case OP_CONV4: {
        const int row = (int)(gid / 128), c = (int)(gid % 128) * 4; int s, t; row_to_seq(dm, row, s, t); float acc[4];
        for (int q = 0; q < 4; ++q) acc[q] = p.d[c + q];
        for (int i = 0; i < 4; ++i) { const int j = t + i; const float* xv = nullptr;
            if (j < 3) { if (s >= dm.B) xv = p.b + ((size_t)(s - dm.B) * 3 + j) * 512 + c; } else xv = p.a + (size_t)(row - t + (j - 3)) * MIXIN + C_XB + c;
            if (xv) for (int q = 0; q < 4; ++q) acc[q] = fmaf(xv[q], p.c[i * 512 + c + q], acc[q]); }
        NvF4 o; o.x = acc[0]; o.y = acc[1]; o.z = acc[2]; o.w = acc[3]; *(NvF4*)(p.o0 + (size_t)row * 512 + c) = o;
        NvU2 w; w.x = nv_f2bf(acc[0]) | ((unsigned)nv_f2bf(acc[1]) << 16); w.y = nv_f2bf(acc[2]) | ((unsigned)nv_f2bf(acc[3]) << 16); *(NvU2*)((nvbf*)p.o1 + (size_t)row * 512 + c) = w; } break;
    case OP_CVT8: {
        const int K8 = p.i2 / 8; const int row = (int)(gid / K8), k = (int)(gid % K8) * 8; unsigned w[4] = {0u, 0u, 0u, 0u};
        if (row < dm.M && k < p.i0) { const float* sp = p.a + (size_t)row * p.i1 + k;
#pragma unroll
            for (int i = 0; i < 4; ++i) { float lo = sp[2 * i], hi = sp[2 * i + 1]; if (p.i3 == 1) { lo = tanhf(lo); hi = tanhf(hi); } else if (p.i3 == 2) { lo = nv_sigmoid(lo); hi = nv_sigmoid(hi); } w[i] = nv_f2bf(lo) | ((unsigned)nv_f2bf(hi) << 16); } }
        NvU4 o; o.x = w[0]; o.y = w[1]; o.z = w[2]; o.w = w[3]; *(NvU4*)((nvbf*)p.o0 + (size_t)row * p.i2 + k) = o; } break;
    case OP_WGATE: {
        const int n = (int)gid, pn = n >> 8, within = n & 127, isx = (n >> 7) & 1, c = pn * 128 + within, nb = c >> 6, e = c & 63; const float* w = isx ? p.b : p.a; nvbf* dst = (nvbf*)p.o0 + (size_t)n * 512;
        for (int k = 0; k < 512; ++k) dst[k] = ((k >> 6) == nb) ? nv_f2bf(w[((size_t)nb * 64 + (k & 63)) * 64 + e]) : (nvbf)0;
        if (n < 512) p.o1[n] = -8.f * nv_softplus(-p.c[n]); } break;
    case OP_LRUG2: {
        const int row = (int)(gid / 512), c = (int)(gid % 512), pn = c >> 7, within = c & 127; const nvbf* x = (const nvbf*)p.a + (size_t)row * 512; const nvbf* wa_ = (const nvbf*)p.b + (size_t)(pn * 256 + within) * 512; const nvbf* wx_ = wa_ + (size_t)128 * 512; float ga = 0.f, gx = 0.f;
        for (int k = 0; k < 512; ++k) { const float xv = nv_bf2f(x[k]); ga = fmaf(xv, nv_bf2f(wa_[k]), ga); gx = fmaf(xv, nv_bf2f(wx_[k]), gx); }
        const float gate_a = nv_sigmoid(ga + p.c[c]), gate_x = nv_sigmoid(gx + p.d[c]); const float log_at = gate_a * p.e[c];
        p.o0[gid] = expf(log_at); p.o1[gid] = sqrtf(-expm1f(2.f * log_at)) * (gate_x * p.f[gid]); } break;
    case OP_GLANORM: {
        int row = (int)(gid / 4), h = (int)(gid % 4); const float* o = p.a + (size_t)row * 512 + h * 128; float ss = 0.f;
        for (int c = 0; c < 128; ++c) ss = fmaf(o[c], o[c], ss);
        float rs = 1.f / sqrtf(ss * (1.f / 128.f) + 1e-5f);
        for (int c = 0; c < 128; ++c) { float r = p.b[(size_t)row * MIXIN + C_R + h * 128 + c]; ((nvbf*)p.o0)[(size_t)row * 1024 + h * 128 + c] = nv_f2bf(o[c] * rs * p.c[c] * (r * nv_sigmoid(r))); } } break;
    case OP_CONV: {
        int row = (int)(gid / 512), c = (int)(gid % 512); int s, t; row_to_seq(dm, row, s, t); float acc = p.d[c];
        for (int i = 0; i < 4; ++i) { int j = t + i; float xv;
            if (j < 3) xv = (s < dm.B) ? 0.f : p.b[((size_t)(s - dm.B) * 3 + j) * 512 + c]; else xv = p.a[(size_t)(row - t + (j - 3)) * MIXIN + C_XB + c];
            acc = fmaf(xv, p.c[i * 512 + c], acc); }
        p.o0[gid] = acc; } break;
    case OP_CONVOUT: {
        int s = (int)(gid / 1536), i = (int)((gid / 512) % 3), c = (int)(gid % 512); int L = seq_len(dm, s), r0 = seq_row0(dm, s); int j = L + i; float xv;
        if (j < 3) xv = (s < dm.B) ? 0.f : p.b[((size_t)(s - dm.B) * 3 + j) * 512 + c]; else xv = p.a[(size_t)(r0 + j - 3) * MIXIN + C_XB + c];
        float* o = (s < dm.B) ? PO1 + ((size_t)s * 3 + i) * 512 + c : PO2 + ((size_t)(s - dm.B) * 3 + i) * 512 + c; *o = xv; } break;
    case OP_LRUG: {
        int row = (int)(gid / 512), c = (int)(gid % 512), nb = c / 64, e = c % 64; const float* x = p.a + (size_t)row * 512 + nb * 64; float ga = p.c[c], gx = p.e[c];
        for (int dd = 0; dd < 64; ++dd) { ga = fmaf(x[dd], p.b[((size_t)nb * 64 + dd) * 64 + e], ga); gx = fmaf(x[dd], p.d[((size_t)nb * 64 + dd) * 64 + e], gx); }
        float gate_a = nv_sigmoid(ga), gate_x = nv_sigmoid(gx); float log_at = -8.f * gate_a * nv_softplus(-p.f[c]);
        p.o0[gid] = expf(log_at); p.o1[gid] = sqrtf(-expm1f(2.f * log_at)) * (gate_x * p.a[(size_t)row * 512 + c]); } break;
    case OP_LRUSCAN: {
        int s = (int)(gid / 512), c = (int)(gid % 512); int r0 = seq_row0(dm, s), L = seq_len(dm, s); float hh = (s < dm.B) ? 0.f : p.d[(size_t)(s - dm.B) * 512 + c];
        for (int t = 0; t < L; ++t) { size_t r = (size_t)(r0 + t); hh = fmaf(p.a[r * 512 + c], hh, p.b[r * 512 + c]); p.o0[r * 1024 + 512 + c] = hh * nv_gelu(p.c[r * MIXIN + C_GB + c]); }
        float* o = (s < dm.B) ? PO1 + (size_t)s * 512 + c : PO2 + (size_t)(s - dm.B) * 512 + c; *o = hh; } break;
    case OP_LNRES: {
        const float alpha = 1.6817928305074292f; float* x = p.o0 + (size_t)gid * D; const float* y = p.a + (size_t)gid * D; float mu = 0.f;
        for (int c = 0; c < D; ++c) mu += alpha * x[c] + y[c];
        mu /= D; float var = 0.f;
        for (int c = 0; c < D; ++c) { float v = alpha * x[c] + y[c] - mu; var = fmaf(v, v, var); }
        float rs = 1.f / sqrtf(var / D + 1e-5f);
        for (int c = 0; c < D; ++c) { const float o = (alpha * x[c] + y[c] - mu) * rs * p.b[c] + p.c[c]; x[c] = o; ((nvbf*)p.o1)[(size_t)gid * D + c] = nv_f2bf(o); } } break;
    case OP_MIX: {
        int row = (int)(gid / D), c = (int)(gid % D); int s, t; row_to_seq(dm, row, s, t); float x = p.a[gid];
        float xp = t > 0 ? p.a[gid - D] : ((s < dm.B) ? 0.f : p.b[(size_t)(s - dm.B) * D + c]);
        ((nvbf*)p.o0)[gid] = nv_f2bf(x + (xp - x) * p.c[c]); } break;
    case OP_SHIFTOUT: {
        int s = (int)(gid / D), c = (int)(gid % D); float v = p.a[(size_t)(seq_row0(dm, s) + seq_len(dm, s) - 1) * D + c];
        float* o = (s < dm.B) ? PO1 + (size_t)s * D + c : PO2 + (size_t)(s - dm.B) * D + c; *o = v; } break;
    case OP_RWKVPREP: {
        int row = (int)(gid / dm.RH), h = (int)(gid % dm.RH); size_t base = (size_t)row * D + h * 64; float ss = 0.f;
        for (int k = 0; k < 64; ++k) { float kv = p.o0[base + k] * p.d[h * 64 + k]; ss = fmaf(kv, kv, ss); }
        float inv = 1.f / fmaxf(sqrtf(ss), 1e-12f);
        for (int k = 0; k < 64; ++k) { int c = h * 64 + k; size_t ix = base + k;
            float w = -nv_softplus(-(p.a[c] + p.o1[ix])) - 0.5f; float dec = expf(-expf(w));
            float a = nv_sigmoid(p.b[c] + p.o2[ix]);
            float v = p.o3[ix]; if (p.i0) v = v + (p.o5[ix] - v) * nv_sigmoid(p.c[c] + p.f[ix]); else p.o5[ix] = v;
            float k0 = p.o0[ix]; const float kk = k0 * p.d[c] * inv; p.o4[ix] = -kk; p.o0[ix] = k0 * (1.f + (a - 1.f) * p.e[c]); p.o1[ix] = dec; p.o2[ix] = kk * a; p.o3[ix] = v; } } break;
    case OP_WKVF:
    case OP_WKV: {
        int RH = dm.RH; int s = p.i0 + (int)(gid / (RH * 64)), h = (int)((gid / 64) % RH), vr = (int)(gid % 64); float S[64];
        const float* sin = (s < dm.B) ? nullptr : p.g + (((size_t)(s - dm.B) * RH + h) * 64 + vr) * 64;
#pragma unroll
        for (int k = 0; k < 64; ++k) S[k] = sin ? sin[k] : 0.f;
        int r0 = seq_row0(dm, s), L = seq_len(dm, s);
        for (int t = 0; t < L; ++t) { size_t base = (size_t)(r0 + t) * D + h * 64; float sa = 0.f;
#pragma unroll
            for (int k = 0; k < 64; ++k) { if ((k & 7) == 0) NV_FENCE(); sa = fmaf(S[k], p.f[base + k], sa); }
            float vv = p.d[base + vr], y = 0.f;
#pragma unroll
            for (int k = 0; k < 64; ++k) { if ((k & 7) == 0) NV_FENCE(); S[k] = fmaf(S[k], p.b[base + k], fmaf(sa, p.e[base + k], vv * p.c[base + k])); y = fmaf(S[k], p.a[base + k], y); }
            p.o0[base + vr] = y; }
        float* so = (s < dm.B) ? PO1 + (((size_t)s * RH + h) * 64 + vr) * 64 : PO2 + (((size_t)(s - dm.B) * RH + h) * 64 + vr) * 64;
#pragma unroll
        for (int k = 0; k < 64; ++k) so[k] = S[k]; } break;
    case OP_RWKVPOST: {
        int row = (int)(gid / dm.RH), h = (int)(gid % dm.RH); size_t base = (size_t)row * D + h * 64; float mu = 0.f, bon = 0.f;
        for (int k = 0; k < 64; ++k) { mu += p.a[base + k]; bon = fmaf(p.b[base + k] * p.c[base + k], p.f[h * 64 + k], bon); }
        mu *= (1.f / 64.f); float var = 0.f;
        for (int k = 0; k < 64; ++k) { float dlt = p.a[base + k] - mu; var = fmaf(dlt, dlt, var); }
        float rs = 1.f / sqrtf(var * (1.f / 64.f) + 64e-5f);
        for (int k = 0; k < 64; ++k) { int c = h * 64 + k; float y = (p.a[base + k] - mu) * rs * p.g[c] + p.h[c] + bon * p.d[base + k]; ((nvbf*)p.o0)[base + k] = nv_f2bf(y * p.e[base + k]); } } break;
    case OP_PRM: {
        const int m = (int)(gid / D), c = (int)(gid % D); const float* src = m == 0 ? p.a : m == 1 ? p.b : m == 2 ? p.c : m == 3 ? p.d : m == 4 ? p.e : p.f; p.o0[gid] = src ? src[c] : 0.f; } break;
    case OP_WKVP: {
        const int RH = dm.RH; const int s = (int)(gid / (RH * 64)), h = (int)((gid / 64) % RH), vr = (int)(gid % 64); float S[64];
        const float* sin = (s < dm.B) ? nullptr : p.o5 + (((size_t)(s - dm.B) * RH + h) * 64 + vr) * 64;
        for (int k = 0; k < 64; ++k) S[k] = sin ? sin[k] : 0.f;
        const float* w0 = p.h + h * 64; const float* a0 = p.h + D + h * 64; const float* v0 = p.h + 2 * D + h * 64; const float* k_k = p.h + 3 * D + h * 64; const float* k_a = p.h + 4 * D + h * 64; const float* r_k = p.h + 5 * D + h * 64;
        const int r0 = seq_row0(dm, s), L = seq_len(dm, s);
        for (int t = 0; t < L; ++t) { const size_t base = (size_t)(r0 + t) * D + h * 64; float ss = 0.f;
            for (int k = 0; k < 64; ++k) { const float kv = p.b[base + k] * k_k[k]; ss = fmaf(kv, kv, ss); }
            const float inv = 1.f / fmaxf(sqrtf(ss), 1e-12f);
            float vv = p.e[base + vr]; if (p.i0) vv = vv + (p.g[base + vr] - vv) * nv_sigmoid(v0[vr] + p.f[base + vr]);
            float sa = 0.f, bon = 0.f, dec[64], bb[64], k2[64];
            for (int k = 0; k < 64; ++k) { const float k0 = p.b[base + k]; const float kk = k0 * k_k[k] * inv; const float a = nv_sigmoid(a0[k] + p.d[base + k]);
                dec[k] = expf(-0.6065306597126334f * nv_sigmoid(w0[k] + p.c[base + k]));
                bb[k] = kk * a; k2[k] = k0 * (1.f + (a - 1.f) * k_a[k]); sa = fmaf(S[k], -kk, sa); bon = fmaf(p.a[base + k] * k2[k], r_k[k], bon); }
            float y = 0.f;
            for (int k = 0; k < 64; ++k) { S[k] = fmaf(S[k], dec[k], fmaf(sa, bb[k], vv * k2[k])); y = fmaf(S[k], p.a[base + k], y); }
            p.o0[base + vr] = y; p.o3[base + vr] = vv; if (vr == 0) p.o4[(size_t)(r0 + t) * RH + h] = bon; }
        float* so = (s < dm.B) ? PO1 + (((size_t)s * RH + h) * 64 + vr) * 64 : PO2 + (((size_t)(s - dm.B) * RH + h) * 64 + vr) * 64;
        for (int k = 0; k < 64; ++k) so[k] = S[k]; } break;
    case OP_POST2: {
        const int row = (int)(gid / dm.RH), h = (int)(gid % dm.RH); const size_t base = (size_t)row * D + h * 64; float mu = 0.f;
        for (int k = 0; k < 64; ++k) mu += p.a[base + k];
        mu *= (1.f / 64.f); float var = 0.f;
        for (int k = 0; k < 64; ++k) { const float dlt = p.a[base + k] - mu; var = fmaf(dlt, dlt, var); }
        const float rs = 1.f / sqrtf(var * (1.f / 64.f) + 64e-5f), bon = p.d[gid];
        for (int k = 0; k < 64; ++k) { const int c = h * 64 + k; const float y = (p.a[base + k] - mu) * rs * p.e[c] + p.f[c] + bon * p.c[base + k]; ((nvbf*)p.o0)[base + k] = nv_f2bf(y * p.b[base + k]); } } break;
    case OP_QNORM: {
        float* q = p.o0 + (size_t)gid * 256; float mu = 0.f;
        for (int c = 0; c < 256; ++c) mu += q[c];
        mu *= (1.f / 256.f); float var = 0.f;
        for (int c = 0; c < 256; ++c) { float dlt = q[c] - mu; var = fmaf(dlt, dlt, var); }
        float rs = 1.f / sqrtf(var * (1.f / 256.f) + 1e-5f);
        for (int c = 0; c < 256; ++c) q[c] = (q[c] - mu) * rs; } break;
    case OP_SCORES: {
        int row = (int)(gid / 2048), r = (int)(gid % 2048), h = r / 256, half = (r / 128) & 1, key = r % 128;
        const float* q = p.a + (size_t)row * 2048 + h * 256 + half * 128; const float* kv = p.b + (((size_t)h * 2 + half) * 128 + key) * 128; float acc = 0.f;
        for (int dd = 0; dd < 128; ++dd) acc = fmaf(q[dd], kv[dd], acc);
        p.o0[gid] = acc; } break;
    case OP_TOPK: {
        const float* sc = p.a + (size_t)gid * 256; float tv[16]; int ti[16]; float* tmpv = p.o2 + (size_t)gid * 32; int* tmpi = (int*)p.o3 + (size_t)gid * 32;
        for (int half = 0; half < 2; ++half) {
#pragma unroll
            for (int j = 0; j < 16; ++j) { tv[j] = -3.0e38f; ti[j] = 0; }
            for (int k = 0; k < 128; ++k) NV_INS16(tv, ti, sc[half * 128 + k], k);
#pragma unroll
            for (int j = 0; j < 16; ++j) { tmpv[half * 16 + j] = tv[j]; tmpi[half * 16 + j] = ti[j]; }
        }
#pragma unroll
        for (int j = 0; j < 16; ++j) { tv[j] = -3.0e38f; ti[j] = 0; }
        for (int i = 0; i < 16; ++i) for (int j = 0; j < 16; ++j) NV_INS16(tv, ti, tmpv[i] + tmpv[16 + j], tmpi[i] * 128 + tmpi[16 + j]);
        float den = 0.f, ev[16];
#pragma unroll
        for (int j = 0; j < 16; ++j) { ev[j] = expf(tv[j] - tv[0]); den += ev[j]; }
        float inv = 1.f / den;
#pragma unroll
        for (int j = 0; j < 16; ++j) { p.o0[(size_t)gid * 16 + j] = ev[j] * inv; ((int*)p.o1)[(size_t)gid * 16 + j] = ti[j]; } } break;
    case OP_PACT1: {
        size_t pr = (size_t)(gid / 16); int part = (int)(gid % 16); int row = (int)(pr / 128); int e = ((const int*)p.d)[pr]; int w = D / 16;
        const float* u = p.b + (size_t)e * D + part * w; const float* x = p.a + (size_t)row * D + part * w; float acc = 0.f;
        for (int c = 0; c < w; ++c) acc = fmaf(u[c], x[c], acc);
        p.o0[gid] = acc; } break;
    case OP_PACT2: {
        float acc = 0.f; for (int i = 0; i < 16; ++i) acc += p.a[(size_t)gid * 16 + i];
        p.o0[gid] = p.c[gid] * nv_gelu(acc); } break;
    case OP_POUT: {
        int row = (int)(gid / D), c = (int)(gid % D); float acc = 0.f;
        for (int i = 0; i < 128; ++i) acc = fmaf(p.a[(size_t)row * 128 + i], p.c[(size_t)((const int*)p.b)[(size_t)row * 128 + i] * D + c], acc);
        p.o0[gid] = acc; } break;
    case OP_YOUT: {
        int row = (int)(gid / D), c = (int)(gid % D);
        if (row < dm.B * dm.T) { int bb = row / dm.T, t = row % dm.T; if (t >= 16) p.o0[((size_t)bb * (dm.T - 16) + (t - 16)) * D + c] = p.a[gid]; }
        else p.o0[((size_t)dm.B * (dm.T - 16) + (row - dm.B * dm.T)) * D + c] = p.a[gid]; } break;
    case OP_WT: {
        const int N = p.i0, K = p.i1, Np = p.i3, Kp = p.i4; const long long per8 = (long long)Np * (Kp / 8); const int bt = (int)(gid / per8); const long long r = gid % per8; const int k0 = (int)(r / Np) * 8, nn = (int)(r % Np);
        unsigned w[4];
#pragma unroll
        for (int i = 0; i < 4; ++i) { float lo = 0.f, hi = 0.f; if (nn < N) { if (k0 + 2 * i < K) lo = p.a[((size_t)bt * K + k0 + 2 * i) * p.i2 + nn]; if (k0 + 2 * i + 1 < K) hi = p.a[((size_t)bt * K + k0 + 2 * i + 1) * p.i2 + nn]; } w[i] = nv_f2bf(lo) | ((unsigned)nv_f2bf(hi) << 16); }
        NvU4 o; o.x = w[0]; o.y = w[1]; o.z = w[2]; o.w = w[3];
        *(NvU4*)((nvbf*)p.o0 + (size_t)bt * Np * Kp + (size_t)nn * Kp + k0) = o; } break;
    case OP_CVT: {
        const int Kp = p.i2; const int row = (int)(gid / Kp), k = (int)(gid % Kp); float v = 0.f;
        if (row < dm.M && k < p.i0) { v = p.a[(size_t)row * p.i1 + k]; if (p.i3 == 1) v = tanhf(v); else if (p.i3 == 2) v = nv_sigmoid(v); }
        ((nvbf*)p.o0)[gid] = nv_f2bf(v); } break;
    case OP_FGEMM: {
        const int N = p.i0; const int m = (int)(gid / N), nn = (int)(gid % N); const nvbf* A = (const nvbf*)p.a + (size_t)m * p.i2 + ((p.i6 & 2) ? (nn / 256) * 256 : 0); const nvbf* Bt = (const nvbf*)p.b + (size_t)nn * p.i3; float acc = 0.f;
        for (int k = 0; k < p.i1; ++k) acc = fmaf(nv_bf2f(A[k]), nv_bf2f(Bt[k]), acc);
        if (p.i6 & 1) ((nvbf*)p.o0)[(size_t)m * p.i4 + nn] = nv_f2bf(acc); else p.o0[(size_t)m * p.i4 + nn] = acc; } break;
    case OP_CVTTAB: {
        const NvF4 v0 = *(const NvF4*)(p.a + gid * 8), v1 = *(const NvF4*)(p.a + gid * 8 + 4); NvU4 o;
        o.x = nv_f2bf(v0.x) | ((unsigned)nv_f2bf(v0.y) << 16); o.y = nv_f2bf(v0.z) | ((unsigned)nv_f2bf(v0.w) << 16); o.z = nv_f2bf(v1.x) | ((unsigned)nv_f2bf(v1.y) << 16); o.w = nv_f2bf(v1.z) | ((unsigned)nv_f2bf(v1.w) << 16);
        *(NvU4*)((nvbf*)p.o0 + gid * 8) = o; } break;
    case OP_CVTTAB8: {
        const float sc = (float)(1 << p.i0); const float* sp = p.a + gid * 16; unsigned w[4];
#pragma unroll
        for (int q = 0; q < 4; ++q) { const NvF4 v = *(const NvF4*)(sp + 4 * q); w[q] = nv_f2e4m3(v.x * sc) | (nv_f2e4m3(v.y * sc) << 8) | (nv_f2e4m3(v.z * sc) << 16) | (nv_f2e4m3(v.w * sc) << 24); }
        NvU4 o; o.x = w[0]; o.y = w[1]; o.z = w[2]; o.w = w[3]; *(NvU4*)((unsigned char*)p.o0 + gid * 16) = o; } break;
    case OP_CVTTAB8S: {
        const float sc = (float)(1 << p.i0); const int per = D / 16; const int e = (int)(gid / per), c0 = (int)(gid % per) * 16; const float* sp = p.a + (size_t)e * D + c0; unsigned w[4];
#pragma unroll
        for (int q = 0; q < 4; ++q) { const NvF4 v = *(const NvF4*)(sp + 4 * q);
#if defined(__HIP_DEVICE_COMPILE__)
            int pk = __builtin_amdgcn_cvt_pk_fp8_f32(v.x * sc, v.y * sc, 0, false); pk = __builtin_amdgcn_cvt_pk_fp8_f32(v.z * sc, v.w * sc, pk, true); w[q] = (unsigned)pk;
#else
            w[q] = nv_f2e4m3(v.x * sc) | (nv_f2e4m3(v.y * sc) << 8) | (nv_f2e4m3(v.z * sc) << 16) | (nv_f2e4m3(v.w * sc) << 24);
#endif
        }
        NvU4 o; o.x = w[0]; o.y = w[1]; o.z = w[2]; o.w = w[3]; *(NvU4*)((unsigned char*)p.o0 + ((size_t)(c0 >> 7) * 16384 + e) * 128 + (c0 & 127)) = o; } break;
    case OP_PACTS: {
        const long long NP = (long long)dm.M * 128; const int sl = (int)(gid / NP); const long long pr = gid % NP; const int row = (int)(pr / 128); const int e = ((const int*)p.d)[pr];
        const unsigned char* u = (const unsigned char*)p.b + ((size_t)sl * 16384 + e) * 128; const nvbf* x = (const nvbf*)p.a + (size_t)row * D + sl * 128; float acc = 0.f;
        for (int c = 0; c < 128; ++c) acc = fmaf(nv_e4m32f(u[c]), nv_bf2f(x[c]), acc);
        p.o0[gid] = acc; } break;
    case OP_PRED: {
        const long long NP = (long long)dm.M * 128; float acc = 0.f; for (int sl = 0; sl < p.i0; ++sl) acc += p.a[(size_t)sl * NP + gid];
        p.o0[gid] = p.c[gid] * nv_gelu(acc * (1.f / 128.f)); } break;
    case OP_POUTS: {
        const int row = (int)(gid / D), c = (int)(gid % D); const unsigned char* vb = (const unsigned char*)p.c + (size_t)(c >> 7) * 16384 * 128 + (c & 127); float acc = 0.f;
        for (int i = 0; i < 128; ++i) acc = fmaf(p.a[(size_t)row * 128 + i] * (1.f / 64.f), nv_e4m32f(vb[(size_t)((const int*)p.b)[(size_t)row * 128 + i] * 128]), acc);
        p.o0[gid] = acc; } break;
    case OP_KEYS: {
        const int h = (int)(gid / 256), nrow = (int)(gid % 256), half = nrow >> 7; const float* src = p.a + (((size_t)h * 2 + half) * 128 + (nrow & 127)) * 128; nvbf* dst = (nvbf*)p.o0 + ((size_t)h * 256 + nrow) * 256; float ks = 0.f;
        for (int k = 0; k < 256; ++k) { nvbf b = 0; if ((k >> 7) == half) { b = nv_f2bf(src[k & 127]); ks += nv_bf2f(b); } dst[k] = b; }
        p.o1[gid] = ks; } break;
    case OP_TOPK2: {
        const int h = (int)(gid % 8); const float* sc = p.a + (size_t)gid * 256; const nvbf* q = (const nvbf*)p.b + (size_t)gid * 256; const float* ksum = p.c + h * 256; float mu = 0.f;
        for (int c = 0; c < 256; ++c) mu += nv_bf2f(q[c]);
        mu *= (1.f / 256.f); float var = 0.f;
        for (int c = 0; c < 256; ++c) { float dlt = nv_bf2f(q[c]) - mu; var = fmaf(dlt, dlt, var); }
        const float rs = 1.f / sqrtf(var * (1.f / 256.f) + 1e-5f);
        float tv[16]; int ti[16]; float* tmpv = p.o2 + (size_t)gid * 32; int* tmpi = (int*)p.o3 + (size_t)gid * 32;
        for (int half = 0; half < 2; ++half) {
#pragma unroll
            for (int j = 0; j < 16; ++j) { tv[j] = -3.0e38f; ti[j] = 0; }
            for (int k = 0; k < 128; ++k) NV_INS16(tv, ti, rs * (sc[half * 128 + k] - mu * ksum[half * 128 + k]), k);
#pragma unroll
            for (int j = 0; j < 16; ++j) { tmpv[half * 16 + j] = tv[j]; tmpi[half * 16 + j] = ti[j]; }
        }
#pragma unroll
        for (int j = 0; j < 16; ++j) { tv[j] = -3.0e38f; ti[j] = 0; }
        for (int i = 0; i < 16; ++i) for (int j = 0; j < 16; ++j) NV_INS16(tv, ti, tmpv[i] + tmpv[16 + j], tmpi[i] * 128 + tmpi[16 + j]);
        float den = 0.f, ev[16];
#pragma unroll
        for (int j = 0; j < 16; ++j) { ev[j] = expf(tv[j] - tv[0]); den += ev[j]; }
        float inv = 1.f / den;
#pragma unroll
        for (int j = 0; j < 16; ++j) { p.o0[(size_t)gid * 16 + j] = ev[j] * inv; ((int*)p.o1)[(size_t)gid * 16 + j] = ti[j]; } } break;
    case OP_PACT: {
        const int row = (int)(gid / 128); const int e = ((const int*)p.d)[gid]; const unsigned char* u = (const unsigned char*)p.b + (size_t)e * D; const nvbf* x = (const nvbf*)p.a + (size_t)row * D; float acc = 0.f;
        for (int c = 0; c < D; ++c) acc = fmaf(nv_e4m32f(u[c]), nv_bf2f(x[c]), acc);
        p.o0[gid] = p.c[gid] * nv_gelu(acc * (1.f / 128.f)); } break;
#if defined(HOST_TEST)
    case OP_POUTLN: {
        const float alpha = 1.6817928305074292f; float* x = p.o0 + (size_t)gid * D; std::vector<float> y(D, 0.f);
        for (int i = 0; i < 128; ++i) { const float cf = p.a[(size_t)gid * 128 + i] * (1.f / 64.f); const unsigned char* v = (const unsigned char*)p.c + (size_t)((const int*)p.b)[(size_t)gid * 128 + i] * D; for (int c = 0; c < D; ++c) y[c] = fmaf(cf, nv_e4m32f(v[c]), y[c]); }
        float mu = 0.f; for (int c = 0; c < D; ++c) { y[c] = alpha * x[c] + y[c]; mu += y[c]; }
        mu /= D; float var = 0.f; for (int c = 0; c < D; ++c) { float dlt = y[c] - mu; var = fmaf(dlt, dlt, var); }
        const float rs = 1.f / sqrtf(var / D + 1e-5f);
        for (int c = 0; c < D; ++c) { const float o = (y[c] - mu) * rs * p.d[c] + p.e[c]; x[c] = o; ((nvbf*)p.o1)[(size_t)gid * D + c] = nv_f2bf(o); } } break;
#endif
    default: break;
    }
}

struct NvIO { const float* const* in; float* out; char* ws; size_t ws_size; };
template <class Launch> HD void nv_forward(const NvIO& io, const Dm& dm, Launch&& launch) {
    const int D = dm.D, M = dm.M, B = dm.B, DB = dm.DB, RH = dm.RH; const size_t MD = (size_t)M * D;
    float* y_prompt = io.out; float* y_sample = y_prompt + (size_t)B * (dm.T - 16) * D; float* p_gla = y_sample + (size_t)DB * dm.DT * D;
    float* p_h = p_gla + (size_t)2 * B * 4 * 64 * 128; float* p_conv = p_h + (size_t)2 * B * 512; float* p_rwkv = p_conv + (size_t)2 * B * 3 * 512;
    float* p_shift = p_rwkv + (size_t)2 * B * RH * 4096; float* s_gla = p_shift + (size_t)2 * B * D; float* s_h = s_gla + (size_t)2 * DB * 4 * 64 * 128;
    float* s_conv = s_h + (size_t)2 * DB * 512; float* s_rwkv = s_conv + (size_t)2 * DB * 3 * 512; float* s_shift = s_rwkv + (size_t)2 * DB * RH * 4096;
    float* w = (float*)io.ws; size_t off = 0; auto take = [&](size_t n) __attribute__((always_inline)) { float* r = w + off; off += (n + 63) & ~(size_t)63; return r; };
    float* X = take(MD); float* VFIRST = take(MD); float* MOUT = take(MD);
    auto mk = [&](int code, long long n) __attribute__((always_inline)) { Op o{}; o.code = code; o.n = n; return o; };
    const int Mp = nv_rup(M, 256), Dp = nv_rup(D, 256), Dk = nv_rup(D, 128);
    auto takeh = [&](size_t n) __attribute__((always_inline)) { return (nvbf*)take((n + 1) / 2); };
    nvbf* ABF = takeh((size_t)Mp * 1024 > (size_t)Mp * Dk ? (size_t)Mp * 1024 : (size_t)Mp * Dk);
    const size_t SZ_WIN = (size_t)2816 * Dk, SZ_WOUT = (size_t)Dp * 1024, SZ_DD = (size_t)Dp * Dk, SZ_DN = (size_t)256 * Dk, SZ_UP = (size_t)Dp * 128, SZ_WQ = (size_t)2048 * Dk;
    nvbf* WT_WIN = takeh(2 * SZ_WIN); nvbf* WT_WOUT = takeh(2 * SZ_WOUT); nvbf* WT_WR = takeh(2 * SZ_DD); nvbf* WT_WK = takeh(2 * SZ_DD); nvbf* WT_WV = takeh(2 * SZ_DD); nvbf* WT_WO = takeh(2 * SZ_DD);
    nvbf* WT_W1 = takeh(2 * SZ_DN); nvbf* WT_W2 = takeh(2 * SZ_UP); nvbf* WT_A1 = takeh(2 * SZ_DN); nvbf* WT_A2 = takeh(2 * SZ_UP); nvbf* WT_G1 = takeh(2 * SZ_DN); nvbf* WT_G2 = takeh(2 * SZ_UP);
    nvbf* WT_V1 = takeh(SZ_DN); nvbf* WT_V2 = takeh(SZ_UP); nvbf* WT_WQ = takeh(4 * SZ_WQ); nvbf* WT_WG = takeh((size_t)2 * 1024 * 512); float* SPL = take(2 * 512); float* PRM = take((size_t)2 * 6 * D);
    nvbf* UB = takeh((size_t)16384 * D / 2); nvbf* VB = takeh((size_t)16384 * D / 2); nvbf* KB = takeh((size_t)8 * 256 * 256); float* KSUM = take(8 * 256);
    const size_t scratch0 = off;
    auto nb = [&](Op o) __attribute__((always_inline)) { o.code |= OPF_NOBAR; launch(o); };
    auto wt = [&](const float* W, int K, int N, int batch, nvbf* dst) __attribute__((always_inline)) { const int Np = nv_rup(N, 256), Kp = nv_rup(K, 128); Op o = mk(OP_WT, (long long)batch * Np * (Kp / 8)); o.a = W; o.o0 = (float*)dst; o.i0 = N; o.i1 = K; o.i2 = N; o.i3 = Np; o.i4 = Kp; nb(o); };
    wt(io.in[10], D, MIXIN, 2, WT_WIN); wt(io.in[21], 1024, D, 2, WT_WOUT); wt(io.in[23], D, D, 2, WT_WR); wt(io.in[24], D, D, 2, WT_WK); wt(io.in[25], D, D, 2, WT_WV); wt(io.in[26], D, D, 2, WT_WO);
    wt(io.in[28], D, 64, 2, WT_W1); wt(io.in[29], 64, D, 2, WT_W2); wt(io.in[31], D, 64, 2, WT_A1); wt(io.in[32], 64, D, 2, WT_A2); wt(io.in[36], D, 128, 2, WT_G1); wt(io.in[37], 128, D, 2, WT_G2);
    wt(io.in[34], D, 32, 1, WT_V1); wt(io.in[35], 32, D, 1, WT_V2); wt(io.in[43], D, 2048, 4, WT_WQ);
    for (int jj = 0; jj < 2; ++jj) { Op o = mk(OP_PRM, (long long)6 * D); o.a = io.in[27] + (size_t)jj * D; o.b = io.in[30] + (size_t)jj * D; o.c = jj > 0 ? io.in[33] + (size_t)(jj - 1) * D : nullptr; o.d = io.in[38] + (size_t)jj * D; o.e = io.in[39] + (size_t)jj * D; o.f = io.in[40] + (size_t)jj * RH * 64; o.o0 = PRM + (size_t)jj * 6 * D; nb(o); }
    for (int jj = 0; jj < 2; ++jj) { Op o = mk(OP_WGATE, 1024); o.a = io.in[16] + (size_t)jj * 8 * 64 * 64; o.b = io.in[18] + (size_t)jj * 8 * 64 * 64; o.c = io.in[20] + (size_t)jj * 512; o.o0 = (float*)(WT_WG + (size_t)jj * 1024 * 512); o.o1 = SPL + (size_t)jj * 512; nb(o); }
    auto fgemm = [&](const nvbf* Wt, float* C, int ldc, int N, int K) __attribute__((always_inline)) {
        const int Kp = nv_rup(K, 128), Np = nv_rup(N, 256);
        Op o = mk(OP_FGEMM, (long long)M * N); o.a = (const float*)ABF; o.b = (const float*)Wt; o.o0 = C; o.i0 = N; o.i1 = Kp; o.i2 = Kp; o.i3 = Kp; o.i4 = ldc; o.i5 = Np; launch(o); };
    auto gemm = [&](const float* A, int lda, const nvbf* Wt, float* C, int ldc, int N, int K, int act) __attribute__((always_inline)) {
        const int Kp = nv_rup(K, 128);
        { Op o = mk(OP_CVT8, (long long)Mp * (Kp / 8)); o.a = A; o.o0 = (float*)ABF; o.i0 = K; o.i1 = lda; o.i2 = Kp; o.i3 = act; launch(o); }
        fgemm(Wt, C, ldc, N, K); };
    { Op o = mk(OP_EMBED4, (long long)MD / 4); o.a = io.in[0]; o.b = io.in[1]; o.c = io.in[7]; o.o0 = X; o.o1 = (float*)ABF; launch(o); }
    const float* const w_outer = w; float* const out_outer = io.out;
    for (int layer = 0; layer < 4; ++layer) {
        float* wl = (float*)w_outer; float* ol = out_outer; NV_LAUNDER(wl); NV_LAUNDER(ol);
#define NV_RB(T, v) T const v##_rb = (T)((char*)wl + ((const char*)(v) - (const char*)w_outer))
#define NV_RO(v) float* const v##_rb = (float*)((char*)ol + ((const char*)(v) - (const char*)out_outer))
        NV_RB(float*, X); NV_RB(float*, VFIRST); NV_RB(float*, MOUT); NV_RB(nvbf*, ABF); NV_RB(nvbf*, WT_WIN); NV_RB(nvbf*, WT_WOUT); NV_RB(nvbf*, WT_WR); NV_RB(nvbf*, WT_WK); NV_RB(nvbf*, WT_WV); NV_RB(nvbf*, WT_WO);
        NV_RB(nvbf*, WT_W1); NV_RB(nvbf*, WT_W2); NV_RB(nvbf*, WT_A1); NV_RB(nvbf*, WT_A2); NV_RB(nvbf*, WT_G1); NV_RB(nvbf*, WT_G2); NV_RB(nvbf*, WT_V1); NV_RB(nvbf*, WT_V2); NV_RB(nvbf*, WT_WQ); NV_RB(nvbf*, WT_WG);
        NV_RB(float*, SPL); NV_RB(float*, PRM); NV_RB(nvbf*, UB); NV_RB(nvbf*, VB); NV_RB(nvbf*, KB); NV_RB(float*, KSUM);
        NV_RO(p_gla); NV_RO(p_h); NV_RO(p_conv); NV_RO(p_rwkv); NV_RO(p_shift); NV_RO(s_gla); NV_RO(s_h); NV_RO(s_conv); NV_RO(s_rwkv); NV_RO(s_shift);
#undef NV_RB
#undef NV_RO
        { float* const X = X_rb; float* const VFIRST = VFIRST_rb; float* const MOUT = MOUT_rb; nvbf* const ABF = ABF_rb; nvbf* const WT_WIN = WT_WIN_rb; nvbf* const WT_WOUT = WT_WOUT_rb; nvbf* const WT_WR = WT_WR_rb; nvbf* const WT_WK = WT_WK_rb;
          nvbf* const WT_WV = WT_WV_rb; nvbf* const WT_WO = WT_WO_rb; nvbf* const WT_W1 = WT_W1_rb; nvbf* const WT_W2 = WT_W2_rb; nvbf* const WT_A1 = WT_A1_rb; nvbf* const WT_A2 = WT_A2_rb; nvbf* const WT_G1 = WT_G1_rb; nvbf* const WT_G2 = WT_G2_rb;
          nvbf* const WT_V1 = WT_V1_rb; nvbf* const WT_V2 = WT_V2_rb; nvbf* const WT_WQ = WT_WQ_rb; nvbf* const WT_WG = WT_WG_rb; float* const SPL = SPL_rb; float* const PRM = PRM_rb; nvbf* const UB = UB_rb; nvbf* const VB = VB_rb; nvbf* const KB = KB_rb; float* const KSUM = KSUM_rb;
          float* const p_gla = p_gla_rb; float* const p_h = p_h_rb; float* const p_conv = p_conv_rb; float* const p_rwkv = p_rwkv_rb; float* const p_shift = p_shift_rb; float* const s_gla = s_gla_rb; float* const s_h = s_h_rb; float* const s_conv = s_conv_rb;
          float* const s_rwkv = s_rwkv_rb; float* const s_shift = s_shift_rb; float* const w = wl; (void)SPL; (void)WT_WG; (void)VFIRST;
        const int j = layer / 2; off = scratch0;
        { Op o = mk(OP_CVTTAB8S, (long long)16384 * D / 16); o.a = io.in[45] + (size_t)layer * 16384 * D; o.o0 = (float*)UB; o.i0 = 7; nb(o); }
        { Op o = mk(OP_CVTTAB8S, (long long)16384 * D / 16); o.a = io.in[46] + (size_t)layer * 16384 * D; o.o0 = (float*)VB; o.i0 = 6; nb(o); }
        { Op o = mk(OP_KEYS, 8 * 256); o.a = io.in[44] + (size_t)layer * 8 * 2 * 128 * 128; o.o0 = (float*)KB; o.o1 = KSUM; nb(o); }
        if (layer % 2 == 0) {
            float* PROJ = take((size_t)M * MIXIN); float* LOGA = take((size_t)M * 256); float* O = take((size_t)M * 512); float* MIXO = (float*)ABF;
            float* XC = take((size_t)M * 512); nvbf* XCB = takeh((size_t)Mp * 512); float* AT = take((size_t)M * 512); float* BT = take((size_t)M * 512);
            const int NC = (dm.T + 63) / 64; float* LEND = take((size_t)B * 4 * NC * 8192); float* DEC = take((size_t)B * 4 * NC * 64); float* LA = take((size_t)B * NC * 512); float* LB = take((size_t)B * NC * 512);
            fgemm(WT_WIN + (size_t)j * SZ_WIN, PROJ, MIXIN, MIXIN, D);
            { Op o = mk(OP_LOGA, (long long)M * 256); o.a = PROJ; o.b = io.in[11] + (size_t)j * 16 * 256; o.c = io.in[12] + (size_t)j * 256; o.o0 = LOGA; nb(o); }
            { Op o = mk(OP_CONV4, (long long)M * 128); o.a = PROJ; o.b = io.in[4] + (size_t)j * DB * 3 * 512; o.c = io.in[14] + (size_t)j * 4 * 512; o.d = io.in[15] + (size_t)j * 512; o.o0 = XC; o.o1 = (float*)XCB; nb(o); }
            { Op o = mk(OP_CONVOUT, (long long)dm.NSEQ * 1536); o.a = PROJ; o.b = io.in[4] + (size_t)j * DB * 3 * 512; o.o1 = p_conv + (size_t)j * B * 3 * 512; o.o2 = s_conv + (size_t)j * DB * 3 * 512; launch(o); }
            { Op o = mk(OP_GLAF, (long long)B * 512); o.a = PROJ; o.b = LOGA; o.o0 = O; o.o1 = p_gla + (size_t)j * B * 4 * 64 * 128; nb(o); }
            { Op o = mk(OP_GLA3, (long long)(DB * 4) * 128); o.a = PROJ; o.b = LOGA; o.c = io.in[2] + (size_t)j * DB * 4 * 64 * 128; o.d = LEND; o.o0 = O; o.o2 = s_gla + (size_t)j * DB * 4 * 64 * 128; o.i0 = NC; o.i1 = 1; nb(o); }
            { Op o = mk(OP_LRUG2, (long long)M * 512); o.a = (const float*)XCB; o.b = (const float*)(WT_WG + (size_t)j * 1024 * 512); o.c = io.in[17] + (size_t)j * 512; o.d = io.in[19] + (size_t)j * 512; o.e = SPL + (size_t)j * 512; o.f = XC; o.o0 = AT; o.o1 = BT; launch(o); }
            { Op o = mk(OP_GLANORM, (long long)M * 4); o.a = O; o.b = PROJ; o.c = io.in[13] + (size_t)j * 128; o.o0 = MIXO; nb(o); }
            { Op o = mk(OP_LRU1, (long long)B * NC * 512); o.a = AT; o.b = BT; o.o0 = LA; o.o1 = LB; o.i0 = NC; launch(o); }
            { Op o = mk(OP_LRU2, (long long)B * 512); o.a = LA; o.o0 = LB; o.o1 = p_h + (size_t)j * B * 512; o.i0 = NC; launch(o); }
            { Op o = mk(OP_LRU3, (long long)(B * NC + DB) * 512); o.a = AT; o.b = BT; o.c = PROJ; o.d = io.in[3] + (size_t)j * DB * 512; o.e = LB; o.o0 = MIXO; o.o2 = s_h + (size_t)j * DB * 512; o.i0 = NC; launch(o); }
            fgemm(WT_WOUT + (size_t)j * SZ_WOUT, MOUT, D, D, 1024);
        } else {
            float* Y = take(MD); float* R = take(MD); float* K = take(MD); float* V = take(MD); float* G = take(MD); float* KK = take(MD);
            const size_t XMSZ = (size_t)Mp * D;
            float* WAV = take(3 * MD > 3 * XMSZ ? 3 * MD : 3 * XMSZ); float* Wd = WAV; float* Aa = WAV + MD; float* Vg = WAV + 2 * MD; nvbf* XM6 = (nvbf*)WAV;
            float* BON = take((size_t)M * RH); float* HLw = take((size_t)M * 64); float* HLa = take((size_t)M * 64); float* HLg = take((size_t)M * 128); float* HLv = take((size_t)M * 32);
            nvbf* ABw = takeh((size_t)Mp * 128); nvbf* ABa = takeh((size_t)Mp * 128); nvbf* ABg = takeh((size_t)Mp * 128); nvbf* ABv = takeh((size_t)Mp * 128);
            const float* shin = io.in[6] + (size_t)j * DB * D; const float* mu = io.in[22] + (size_t)j * 6 * D;
            { Op o = mk(OP_SHIFTOUT, (long long)dm.NSEQ * D); o.a = X; o.o1 = p_shift + (size_t)j * B * D; o.o2 = s_shift + (size_t)j * DB * D; nb(o); }
            { Op o = mk(OP_MIX6, (long long)MD / 8); o.a = X; o.b = shin; o.c = mu; o.o0 = (float*)XM6; o.i1 = (int)(XMSZ / 1024); launch(o); }
            auto gg = [&](const nvbf* A, const nvbf* Wt, float* C, int ldc, int N, int K, bool last) __attribute__((always_inline)) { const int Kp = nv_rup(K, 128), Np = nv_rup(N, 256);
                Op o = mk(OP_FGEMM, (long long)M * N); o.a = (const float*)A; o.b = (const float*)Wt; o.o0 = C; o.i0 = N; o.i1 = Kp; o.i2 = Kp; o.i3 = Kp; o.i4 = ldc; o.i5 = Np; if (!last) o.code |= OPF_GROUP; launch(o); };
            gg(XM6 + 0 * XMSZ, WT_WR + (size_t)j * SZ_DD, R, D, D, D, false); gg(XM6 + 2 * XMSZ, WT_WK + (size_t)j * SZ_DD, K, D, D, D, false); gg(XM6 + 3 * XMSZ, WT_WV + (size_t)j * SZ_DD, V, D, D, D, false);
            gg(XM6 + 1 * XMSZ, WT_W1 + (size_t)j * SZ_DN, HLw, 64, 64, D, false); gg(XM6 + 4 * XMSZ, WT_A1 + (size_t)j * SZ_DN, HLa, 64, 64, D, false);
            if (j > 0) gg(XM6 + 3 * XMSZ, WT_V1 + (size_t)(j - 1) * SZ_DN, HLv, 32, 32, D, false);
            gg(XM6 + 5 * XMSZ, WT_G1 + (size_t)j * SZ_DN, HLg, 128, 128, D, true);
            auto cv = [&](const float* A, int K, nvbf* dst, int act, bool last) __attribute__((always_inline)) { Op o = mk(OP_CVT8, (long long)Mp * 16); o.a = A; o.o0 = (float*)dst; o.i0 = K; o.i1 = K; o.i2 = 128; o.i3 = act; if (last) launch(o); else nb(o); };
            cv(HLw, 64, ABw, 1, false); cv(HLa, 64, ABa, 0, false); if (j > 0) cv(HLv, 32, ABv, 0, false); cv(HLg, 128, ABg, 2, true);
            gg(ABw, WT_W2 + (size_t)j * SZ_UP, Wd, D, D, 64, false); gg(ABa, WT_A2 + (size_t)j * SZ_UP, Aa, D, D, 64, false); if (j > 0) gg(ABv, WT_V2 + (size_t)(j - 1) * SZ_UP, Vg, D, D, 32, false); gg(ABg, WT_G2 + (size_t)j * SZ_UP, G, D, D, 128, true);
            { Op o = mk(OP_WKVP, (long long)dm.NSEQ * RH * 64); o.a = R; o.b = K; o.c = Wd; o.d = Aa; o.e = V; o.f = Vg; o.g = VFIRST; o.h = PRM + (size_t)j * 6 * D; o.o0 = Y; o.o1 = p_rwkv + (size_t)j * B * RH * 4096; o.o2 = s_rwkv + (size_t)j * DB * RH * 4096;
              o.o3 = j > 0 ? KK : VFIRST; o.o4 = BON; o.o5 = (float*)(io.in[5] + (size_t)j * DB * RH * 4096); o.i0 = j > 0 ? 1 : 0; launch(o); }
            { Op o = mk(OP_POST2, (long long)M * RH); o.a = Y; o.b = G; o.c = j > 0 ? KK : VFIRST; o.d = BON; o.e = io.in[41] + (size_t)j * D; o.f = io.in[42] + (size_t)j * D; o.o0 = (float*)ABF; launch(o); }
            fgemm(WT_WO + (size_t)j * SZ_DD, MOUT, D, D, D);
        }
        { Op o = mk(OP_LNRES, M); o.a = MOUT; o.b = io.in[8] + (size_t)(layer * 2 + 0) * D; o.c = io.in[9] + (size_t)(layer * 2 + 0) * D; o.o0 = X; o.o1 = (float*)ABF; launch(o); }
        off = scratch0;
        { nvbf* Q = takeh((size_t)Mp * 2048); float* SC = take((size_t)M * 2048); float* GATE = take((size_t)M * 128); float* EIDX = take((size_t)M * 128); float* TMPV = take((size_t)M * 256); float* TMPI = take((size_t)M * 256);
          float* COEF = take((size_t)M * 128);
          { Op o = mk(OP_FGEMM, (long long)M * 2048); o.a = (const float*)ABF; o.b = (const float*)(WT_WQ + (size_t)layer * SZ_WQ); o.o0 = (float*)Q; o.i0 = 2048; o.i1 = Dk; o.i2 = Dk; o.i3 = Dk; o.i4 = 2048; o.i5 = 2048; o.i6 = 1; launch(o); }
          { Op o = mk(OP_FGEMM, (long long)M * 2048); o.a = (const float*)Q; o.b = (const float*)KB; o.o0 = SC; o.i0 = 2048; o.i1 = 256; o.i2 = 2048; o.i3 = 256; o.i4 = 2048; o.i5 = 2048; o.i6 = 2; launch(o); }
          { Op o = mk(OP_TOPK2, (long long)M * 8); o.a = SC; o.b = (const float*)Q; o.c = KSUM; o.o0 = GATE; o.o1 = EIDX; o.o2 = TMPV; o.o3 = TMPI; launch(o); }
          { const int NS = D / 128; float* PART = take((size_t)NS * M * 128); float* YBUF = take(MD);
            { Op o = mk(OP_PACTS, (long long)NS * M * 128); o.a = (const float*)ABF; o.b = (const float*)UB; o.d = EIDX; o.o0 = PART; launch(o); }
            { Op o = mk(OP_PRED, (long long)M * 128); o.a = PART; o.c = GATE; o.o0 = COEF; o.i0 = NS; launch(o); }
            { Op o = mk(OP_POUTS, (long long)MD); o.a = COEF; o.b = EIDX; o.c = (const float*)VB; o.o0 = YBUF; launch(o); }
            { Op o = mk(OP_LNRES, M); o.a = YBUF; o.b = io.in[8] + (size_t)(layer * 2 + 1) * D; o.c = io.in[9] + (size_t)(layer * 2 + 1) * D; o.o0 = X; o.o1 = (float*)ABF; launch(o); } } }
        }
    }
    { Op o = mk(OP_YOUT4, (long long)MD / 4); o.a = X; o.o0 = y_prompt; launch(o); }
    (void)y_sample;
}

#include <cstdint>
namespace pg8 {
#define PG8_LAS __attribute__((address_space(3)))
typedef unsigned short bf16_t;
typedef short bf16x8 __attribute__((ext_vector_type(8)));
typedef float f32x4 __attribute__((ext_vector_type(4)));
typedef unsigned u32x4 __attribute__((ext_vector_type(4)));
constexpr int BM = 256, BK = 64, HALF = 128, HTB = HALF * BK * 2  , STAGE_BYTES = 8 * HTB, NXCD = 8, WGM = 8;

__host__ __device__ __forceinline__ int lds_byte(int r, int c) { const int st = (r >> 4) * 2 + (c >> 5), rr = r & 15, cc = c & 31, ob = rr * 64 + cc * 2; return st * 1024 + (ob ^ (((ob >> 9) & 1) << 5)); }
__host__ __device__ __forceinline__ void stage_rc(int b, int& R, int& C) { const int st = b / 1024, sb = b % 1024, swz = sb ^ (((sb >> 9) & 1) << 5); R = (st >> 1) * 16 + swz / 64; C = (st & 1) * 32 + (swz % 64) / 2; }
__host__ __device__ __forceinline__ int perm32(int rho) { const int n = rho >> 4, i = rho & 15; return 8 * (i >> 2) + 4 * n + (i & 3); }

struct Unit { int pm, pn, grp, pad_; const char* A; const char* B; };
struct Gemm { const bf16_t* A; const bf16_t* Bt; int M, N, K, lda, ldb; };

struct StaticOrder {
    int nM, nN, nwg, G, c; const char* A; const char* B; size_t tsA, tsB, acs;
    __host__ __device__ void init(const Gemm& g, int G_, int c_) { nM = g.M / BM; nN = g.N / BM; nwg = nM * nN; G = G_; c = c_; A = (const char*)g.A; B = (const char*)g.Bt; tsA = (size_t)BM * g.lda * 2; tsB = (size_t)BM * g.ldb * 2; acs = 0; }
    __host__ __device__ bool next(int i, Unit& u) const {
        const long L = (long)i * G + c; if (L >= nwg) return false;
        int wgid = (int)L; { const int q = nwg / NXCD, r = nwg % NXCD, xcd = wgid % NXCD, off = wgid / NXCD; wgid = (xcd < r ? xcd * (q + 1) : r * (q + 1) + (xcd - r) * q) + off; }
        const int nig = WGM * nN, gid = wgid / nig, fm = gid * WGM, gsz = (nM - fm) < WGM ? (nM - fm) : WGM;
        u.pm = fm + ((wgid % nig) % gsz); u.pn = (wgid % nig) / gsz; u.grp = 0; u.pad_ = 0; u.A = A + (size_t)u.pm * tsA + (size_t)u.pn * acs; u.B = B + (size_t)u.pn * tsB; return true;
    }
    __device__ __forceinline__ void a_ready(const Unit&) const {}
    __device__ __forceinline__ void done(const Unit&) const {}
};

template <class Epi, class Sched, bool ALIGN_EPI = false, bool SP2 = false>
__device__ __forceinline__ void gemm_phase(PG8_LAS unsigned char* lds, const Gemm g, const Sched& S, const Epi& E) {
    int tid_raw = threadIdx.x; asm volatile("" : "+v"(tid_raw));
    const int tid = tid_raw, wid = __builtin_amdgcn_readfirstlane(tid >> 6), lane = tid & 63, wr = wid >> 2, wc = wid & 3, fr = lane & 15, fq = lane >> 4;
    const int K = g.K, nt = K / BK;
    unsigned voffA[2], voffB[2];
#pragma unroll
    for (int i = 0; i < 2; ++i) { int R, C; stage_rc(tid * 16 + i * 8192, R, C); const int Rb = Epi::PERM ? ((R & ~31) + perm32(R & 31)) : R;
        voffA[i] = (unsigned)(R * g.lda + C) * 2u; voffB[i] = (unsigned)(Rb * g.ldb + C) * 2u; }
    const size_t kstep = (size_t)(BK * 2);
    const size_t hstepA = (size_t)HALF * g.lda * 2, hstepB = (size_t)HALF * g.ldb * 2;
    const unsigned ldsw = (unsigned)wid * 1024u;
    const int aoff = lds_byte(wr * 64 + fr, fq * 8), boff = lds_byte(wc * 32 + fr, fq * 8);
#define PG8_SA(b, h) (((b) * 2 + (h)) * HTB)
#define PG8_SB(b, h) ((4 + (b) * 2 + (h)) * HTB)
#define PG8_STAGE(bufoff, gbase, voff) do { _Pragma("unroll") for (int _i = 0; _i < 2; ++_i) \
        __builtin_amdgcn_global_load_lds((const unsigned*)((const char*)(gbase) + (voff)[_i]), (PG8_LAS unsigned*)(lds + (bufoff) + ldsw + _i * 8192), 16, 0, 0); } while (0)
#define PG8_LDA(dst, b, h) do { _Pragma("unroll") for (int m = 0; m < 4; ++m) _Pragma("unroll") for (int k = 0; k < 2; ++k) dst[m][k] = *(const PG8_LAS bf16x8*)(lds + PG8_SA(b, h) + aoff + m * 2048 + k * 1024); } while (0)
#define PG8_LDB(dst, b, h) do { _Pragma("unroll") for (int n = 0; n < 2; ++n) _Pragma("unroll") for (int k = 0; k < 2; ++k) dst[n][k] = *(const PG8_LAS bf16x8*)(lds + PG8_SB(b, h) + boff + n * 2048 + k * 1024); } while (0)
#define PG8_MMA(ai, bj, At, Bt) do { __builtin_amdgcn_s_setprio(1); _Pragma("unroll") for (int m = 0; m < 4; ++m) _Pragma("unroll") for (int n = 0; n < 2; ++n) _Pragma("unroll") for (int k = 0; k < 2; ++k) \
        acc[ai][bj][m][n] = __builtin_amdgcn_mfma_f32_16x16x32_bf16(Bt[n][k], At[m][k], acc[ai][bj][m][n], 0, 0, 0); __builtin_amdgcn_s_setprio(0); } while (0)
#define PG8_WAIT_V(n) asm volatile("s_waitcnt vmcnt(" #n ")" ::: "memory")
#define PG8_WAIT_L(n) asm volatile("s_waitcnt lgkmcnt(" #n ")" ::: "memory")
#define PG8_BAR __builtin_amdgcn_s_barrier()
#define PG8_SCHED __builtin_amdgcn_sched_barrier(0)
    Unit cur, nxt; int ui = 0;
    if (!S.next(0, cur)) return;
    f32x4 acc[2][2][4][2];
#pragma unroll
    for (int a = 0; a < 2; ++a)
#pragma unroll
        for (int b = 0; b < 2; ++b)
#pragma unroll
            for (int m = 0; m < 4; ++m)
#pragma unroll
                for (int n = 0; n < 2; ++n) acc[a][b][m][n] = (f32x4){0.f, 0.f, 0.f, 0.f};
    bf16x8 At[4][2], B0[2][2], B1[2][2];
    const char* cA = cur.A; const char* cB = cur.B;
    S.a_ready(cur);
    if constexpr (SP2) {
        PG8_STAGE(PG8_SB(0, 0), cB, voffB); PG8_STAGE(PG8_SB(0, 1), cB + hstepB, voffB); PG8_STAGE(PG8_SA(0, 0), cA, voffA); PG8_STAGE(PG8_SA(0, 1), cA + hstepA, voffA);
        if (wr == 1) PG8_BAR;
        PG8_WAIT_V(2); PG8_BAR;
        PG8_STAGE(PG8_SB(1, 0), cB + kstep, voffB); PG8_STAGE(PG8_SA(1, 0), cA + kstep, voffA); PG8_STAGE(PG8_SB(1, 1), cB + hstepB + kstep, voffB);
        PG8_WAIT_V(6); PG8_BAR;
    } else {
        PG8_STAGE(PG8_SB(0, 0), cB, voffB); PG8_STAGE(PG8_SA(0, 0), cA, voffA); PG8_STAGE(PG8_SB(0, 1), cB + hstepB, voffB); PG8_STAGE(PG8_SA(0, 1), cA + hstepA, voffA);
        if (wr == 1) PG8_BAR;
        PG8_WAIT_V(4); PG8_BAR;
        PG8_STAGE(PG8_SB(1, 0), cB + kstep, voffB); PG8_STAGE(PG8_SA(1, 0), cA + kstep, voffA); PG8_STAGE(PG8_SB(1, 1), cB + hstepB + kstep, voffB);
        PG8_WAIT_V(6); PG8_BAR;
    }
    for (;;) {
        const bool has_next = S.next(ui + 1, nxt);
        const char* nA = has_next ? nxt.A : cA; const char* nB = has_next ? nxt.B : cB;
        for (int t = 0; t < nt; t += 2) {
            const bool last = (t == nt - 2);
            const char* a1 = cA + (size_t)(t + 1) * kstep;
            const char* a2 = last ? nA : cA + (size_t)(t + 2) * kstep; const char* b2 = last ? nB : cB + (size_t)(t + 2) * kstep;
            const char* a3 = a2 + kstep; const char* b3 = b2 + kstep;
            if (last && has_next) S.a_ready(nxt);
            if constexpr (SP2) {
            PG8_LDB(B0, 0, 0); PG8_LDB(B1, 0, 1); PG8_SCHED; PG8_LDA(At, 0, 0); PG8_STAGE(PG8_SA(1, 1), a1 + hstepA, voffA);
            PG8_WAIT_V(8); PG8_WAIT_L(0); PG8_BAR; PG8_MMA(0, 0, At, B0); PG8_MMA(0, 1, At, B1); PG8_BAR; PG8_SCHED;
            PG8_LDA(At, 0, 1); PG8_STAGE(PG8_SB(0, 0), b2, voffB); PG8_STAGE(PG8_SB(0, 1), b2 + hstepB, voffB); PG8_STAGE(PG8_SA(0, 0), a2, voffA);
            PG8_WAIT_V(8); PG8_WAIT_L(0); PG8_BAR; PG8_MMA(1, 0, At, B0); PG8_MMA(1, 1, At, B1); PG8_BAR; PG8_SCHED;
            PG8_LDB(B0, 1, 0); PG8_LDB(B1, 1, 1); PG8_SCHED; PG8_LDA(At, 1, 0); PG8_STAGE(PG8_SA(0, 1), a2 + hstepA, voffA);
            PG8_WAIT_V(8); PG8_WAIT_L(0); PG8_BAR; PG8_MMA(0, 0, At, B0); PG8_MMA(0, 1, At, B1); PG8_BAR; PG8_SCHED;
            PG8_LDA(At, 1, 1); PG8_STAGE(PG8_SB(1, 0), b3, voffB); PG8_STAGE(PG8_SB(1, 1), b3 + hstepB, voffB); PG8_STAGE(PG8_SA(1, 0), a3, voffA);
            PG8_WAIT_V(8); PG8_WAIT_L(0); PG8_BAR; PG8_MMA(1, 0, At, B0); PG8_MMA(1, 1, At, B1); PG8_BAR; PG8_SCHED;
            } else {
            PG8_LDB(B0, 0, 0); PG8_SCHED; PG8_LDA(At, 0, 0); PG8_STAGE(PG8_SA(1, 1), a1 + hstepA, voffA);
            PG8_WAIT_L(8); PG8_BAR; PG8_WAIT_L(0); PG8_MMA(0, 0, At, B0); PG8_BAR; PG8_SCHED;
            PG8_LDB(B1, 0, 1); PG8_STAGE(PG8_SB(0, 0), b2, voffB);
            PG8_BAR; PG8_WAIT_L(0); PG8_MMA(0, 1, At, B1); PG8_BAR;
            PG8_LDA(At, 0, 1); PG8_STAGE(PG8_SA(0, 0), a2, voffA);
            PG8_BAR; PG8_WAIT_L(0); PG8_MMA(1, 0, At, B0); PG8_BAR; PG8_SCHED;
            PG8_STAGE(PG8_SB(0, 1), b2 + hstepB, voffB);
            PG8_WAIT_V(6); PG8_BAR; PG8_MMA(1, 1, At, B1); PG8_BAR;
            PG8_LDB(B0, 1, 0); PG8_SCHED; PG8_LDA(At, 1, 0); PG8_STAGE(PG8_SA(0, 1), a2 + hstepA, voffA);
            PG8_WAIT_L(8); PG8_BAR; PG8_WAIT_L(0); PG8_MMA(0, 0, At, B0); PG8_BAR; PG8_SCHED;
            PG8_LDB(B1, 1, 1); PG8_STAGE(PG8_SB(1, 0), b3, voffB);
            PG8_BAR; PG8_WAIT_L(0); PG8_MMA(0, 1, At, B1); PG8_BAR;
            PG8_LDA(At, 1, 1); PG8_STAGE(PG8_SA(1, 0), a3, voffA);
            PG8_BAR; PG8_WAIT_L(0); PG8_MMA(1, 0, At, B0); PG8_BAR; PG8_SCHED;
            PG8_STAGE(PG8_SB(1, 1), b3 + hstepB, voffB);
            PG8_WAIT_V(6); PG8_BAR; PG8_MMA(1, 1, At, B1); PG8_BAR;
            }
        }
        if constexpr (ALIGN_EPI) { if (wr == 0) PG8_BAR; }
        if constexpr (!Epi::AFTER_DRAIN) { E(acc, cur, wr, wc, fr, fq); S.done(cur); }
        if (!has_next) break;
#pragma unroll
        for (int a = 0; a < 2; ++a)
#pragma unroll
            for (int b = 0; b < 2; ++b)
#pragma unroll
                for (int m = 0; m < 4; ++m)
#pragma unroll
                    for (int n = 0; n < 2; ++n) acc[a][b][m][n] = (f32x4){0.f, 0.f, 0.f, 0.f};
        cur = nxt; cA = nA; cB = nB; ++ui;
        if constexpr (ALIGN_EPI) { if (wr == 1) PG8_BAR; }
    }
    PG8_WAIT_V(0);
    if constexpr (!ALIGN_EPI) { if (wr == 0) PG8_BAR; }
    PG8_BAR;
    if constexpr (Epi::AFTER_DRAIN) { E.fused(acc, cur, wr, wc, fr, fq, lds, wid, lane); S.done(cur); }
#undef PG8_SA
#undef PG8_SB
#undef PG8_STAGE
#undef PG8_LDA
#undef PG8_LDB
#undef PG8_MMA
#undef PG8_WAIT_V
#undef PG8_WAIT_L
#undef PG8_BAR
#undef PG8_SCHED
}
}
template <class T> __device__ __forceinline__ T* uni_ptr(T* p) {
    unsigned long long v = (unsigned long long)p; unsigned lo = __builtin_amdgcn_readfirstlane((unsigned)v), hi = __builtin_amdgcn_readfirstlane((unsigned)(v >> 32));
    unsigned long long r = ((unsigned long long)hi << 32) | lo; asm volatile("" : "+s"(r)); return (T*)r; }
__device__ __forceinline__ int rfl(int x) { int t = __builtin_amdgcn_readfirstlane(x); asm volatile("" : "+s"(t)); return t; }
namespace pg8 {
__device__ __forceinline__ unsigned cvt_pk_bf16(float lo, float hi) { unsigned r; asm volatile("v_cvt_pk_bf16_f32 %0, %1, %2" : "=v"(r) : "v"(lo), "v"(hi)); return r; }
struct EpiF32 {
    static constexpr bool PERM = false, AFTER_DRAIN = false;
    float* C; int ldc, Mreal, Nreal;
    __device__ __forceinline__ void operator()(const f32x4 (&acc)[2][2][4][2], const Unit& u, int wr, int wc, int fr, int fq) const {
        const int row0 = u.pm * BM + wr * 64 + fr, col0 = u.pn * BM + wc * 32 + 4 * fq;
#pragma unroll
        for (int ai = 0; ai < 2; ++ai)
#pragma unroll
            for (int m = 0; m < 4; ++m) { const int r = row0 + ai * HALF + m * 16; if (r < Mreal) { float* rowp = C + (size_t)r * ldc + col0;
#pragma unroll
                for (int bj = 0; bj < 2; ++bj)
#pragma unroll
                    for (int n = 0; n < 2; ++n) { const int c = col0 + bj * HALF + n * 16; if (c < Nreal) *(f32x4*)(rowp + bj * HALF + n * 16) = acc[ai][bj][m][n]; } } }
    }
};
struct EpiBf16Plain {
    static constexpr bool PERM = true, AFTER_DRAIN = false;
    bf16_t* O; int ldc;
    __device__ __forceinline__ void operator()(const f32x4 (&acc)[2][2][4][2], const Unit& u, int wr, int wc, int fr, int fq) const {
        const int row0 = u.pm * BM + wr * 64 + fr, col0 = u.pn * BM + wc * 32 + 8 * fq;
#pragma unroll
        for (int ai = 0; ai < 2; ++ai)
#pragma unroll
            for (int m = 0; m < 4; ++m) { bf16_t* rowp = O + (size_t)(row0 + ai * HALF + m * 16) * ldc + col0;
#pragma unroll
                for (int bj = 0; bj < 2; ++bj) { const f32x4 v0 = acc[ai][bj][m][0], v1 = acc[ai][bj][m][1]; u32x4 w;
                    w.x = cvt_pk_bf16(v0[0], v0[1]); w.y = cvt_pk_bf16(v0[2], v0[3]); w.z = cvt_pk_bf16(v1[0], v1[1]); w.w = cvt_pk_bf16(v1[2], v1[3]);
                    *(u32x4*)(rowp + bj * HALF) = w; } }
    }
};
struct EpiLru {
    static constexpr bool PERM = false, AFTER_DRAIN = false;
    const float* ba; const float* bx; const float* spl; const float* XC; float* AT; float* BT; int Mreal;
    __device__ __forceinline__ void operator()(const f32x4 (&acc)[2][2][4][2], const Unit& u, int wr, int wc, int fr, int fq) const {
        const int row0 = u.pm * BM + wr * 64 + fr, ch0 = u.pn * 128 + wc * 32 + 4 * fq;
#pragma unroll
        for (int n = 0; n < 2; ++n) { const int c = ch0 + 16 * n; const f32x4 ba4 = *(const f32x4*)(ba + c), bx4 = *(const f32x4*)(bx + c), sp4 = *(const f32x4*)(spl + c);
#pragma unroll
            for (int ai = 0; ai < 2; ++ai)
#pragma unroll
                for (int m = 0; m < 4; ++m) { const int r = row0 + ai * HALF + m * 16; if (r < Mreal) { const f32x4 xc = *(const f32x4*)(XC + (size_t)r * 512 + c); const f32x4 ga = acc[ai][0][m][n] + ba4, gx = acc[ai][1][m][n] + bx4; f32x4 at, bt;
#pragma unroll
                    for (int i = 0; i < 4; ++i) { const float gate_a = 1.f / (1.f + __expf(-ga[i])), gate_x = 1.f / (1.f + __expf(-gx[i])); const float la = gate_a * sp4[i]; at[i] = __expf(la); bt[i] = sqrtf(-expm1f(2.f * la)) * (gate_x * xc[i]); }
                    *(f32x4*)(AT + (size_t)r * 512 + c) = at; *(f32x4*)(BT + (size_t)r * 512 + c) = bt; } } }
    }
};
struct GroupOrder {
    const PG8_LAS Op* tab; int ng, nM, G, c; size_t tsA, tsB;
    __device__ __forceinline__ bool next(int i, Unit& u) const {
        int L = i * G + c, g = 0;
        for (; g < ng; ++g) { const int cnt = nM * (__builtin_amdgcn_readfirstlane(tab[g].i5) >> 8); if (L < cnt) break; L -= cnt; }
        if (g >= ng) return false;
        u.pm = L % nM; u.pn = L / nM; u.grp = g; u.pad_ = 0;
        u.A = (const char*)uni_ptr(tab[g].a) + (size_t)u.pm * tsA; u.B = (const char*)uni_ptr(tab[g].b) + (size_t)u.pn * tsB; return true;
    }
    __device__ __forceinline__ void a_ready(const Unit&) const {}
    __device__ __forceinline__ void done(const Unit&) const {}
};
struct EpiF32G {
    static constexpr bool PERM = false, AFTER_DRAIN = false;
    const PG8_LAS Op* tab; int Mreal;
    __device__ __forceinline__ void operator()(const f32x4 (&acc)[2][2][4][2], const Unit& u, int wr, int wc, int fr, int fq) const {
        float* C = uni_ptr(tab[u.grp].o0); const int ldc = __builtin_amdgcn_readfirstlane(tab[u.grp].i4), Nreal = __builtin_amdgcn_readfirstlane(tab[u.grp].i0);
        const EpiF32 E{C, ldc, Mreal, Nreal}; E(acc, u, wr, wc, fr, fq);
    }
};
}

#define XB_TMO      128
#define XB_XCNT(j)  (256  + 64 * (j))
#define XB_XSUB(j)  (1280 + 64 * (j))
#define XB_XGEN(j)  (2304 + 64 * (j))
#define XB_TOP      3328
#define XB_TOPGEN   3392
#define XCD_BAR_WORDS 3456
#define XB_SPIN_CAP (1u << 18)
#define LAS __attribute__((address_space(3)))
__device__ __forceinline__ unsigned xb_ld(unsigned* p)              { return __hip_atomic_load(p, __ATOMIC_RELAXED, __HIP_MEMORY_SCOPE_AGENT); }
__device__ __forceinline__ unsigned xb_add(unsigned* p, unsigned v) { return __hip_atomic_fetch_add(p, v, __ATOMIC_RELAXED, __HIP_MEMORY_SCOPE_AGENT); }
__device__ __forceinline__ unsigned xb_xcc_id() { return (unsigned)__builtin_amdgcn_s_getreg((3 << 11) | 20) & 0xFu; }
#define XB_SPIN(cond, bar) do { unsigned _sp = 0; while (cond) { __builtin_amdgcn_s_sleep(1); \
    if ((++_sp & 255u) == 0u) { if (xb_ld(&(bar)[XB_TMO])) break; if (_sp > XB_SPIN_CAP) { atomicAdd(&(bar)[XB_TMO], 1u); break; } } } } while (0)
struct XcdBarrier { unsigned* bar; unsigned x; volatile LAS unsigned* st; };
__device__ __forceinline__ XcdBarrier xcd_barrier_post(unsigned* bar, volatile LAS unsigned* st) {
    XcdBarrier b; b.bar = bar; b.x = xb_xcc_id(); b.st = st;
    if (threadIdx.x == 0) (void)xb_add(&bar[XB_XCNT(b.x)], 1u);
    return b;
}
__device__ __forceinline__ void xcd_barrier_complete(unsigned* bar, unsigned x, unsigned& nloc, unsigned& nx) {
    const unsigned G = gridDim.x * gridDim.y * gridDim.z;
    unsigned sum, cnt, mine, sp = 0u;
    for (;;) {
        sum = 0u; cnt = 0u; mine = 0u;
#pragma unroll
        for (unsigned j = 0; j < 16; ++j) { const unsigned c = xb_ld(&bar[XB_XCNT(j)]); sum += c; cnt += (c > 0u) ? 1u : 0u; mine = (j == x) ? c : mine; }
        if (sum == G) break;
        __builtin_amdgcn_s_sleep(1);
        if ((++sp & 255u) == 0u) { if (xb_ld(&bar[XB_TMO])) break; if (sp > XB_SPIN_CAP) { atomicAdd(&bar[XB_TMO], 1u); break; } }
    }
    nloc = mine > 0u ? mine : 1u; nx = cnt > 0u ? cnt : 1u;
}
__device__ __forceinline__ void xcd_barrier(const XcdBarrier& b) {
    asm volatile("s_waitcnt vmcnt(0)" ::: "memory");
    __syncthreads();
    if (threadIdx.x == 0) {
        unsigned* bar = b.bar;
        __builtin_amdgcn_s_waitcnt(0);
        unsigned nloc = b.st[0], nx = b.st[1];
        if (nloc == 0u) { xcd_barrier_complete(bar, b.x, nloc, nx); b.st[0] = nloc; b.st[1] = nx; }
        const unsigned old = xb_add(&bar[XB_XSUB(b.x)], 1u);
        const unsigned gen = old / nloc;
        if (old + 1u == (gen + 1u) * nloc) {
            __builtin_amdgcn_fence(__ATOMIC_RELEASE, "agent");
            asm volatile("s_waitcnt vmcnt(0)" ::: "memory");
            const unsigned og = xb_add(&bar[XB_TOP], 1u);
            const unsigned tg = og / nx;
            if (og + 1u == (tg + 1u) * nx) xb_add(&bar[XB_TOPGEN], 1u);
            else XB_SPIN(xb_ld(&bar[XB_TOPGEN]) == tg, bar);
            __builtin_amdgcn_fence(__ATOMIC_ACQUIRE, "agent");
            xb_add(&bar[XB_XGEN(b.x)], 1u);
            asm volatile("s_waitcnt vmcnt(0)" ::: "memory");
        } else {
            XB_SPIN(xb_ld(&bar[XB_XGEN(b.x)]) == gen, bar);
            __builtin_amdgcn_fence(__ATOMIC_ACQUIRE, "agent");
            asm volatile("s_waitcnt vmcnt(0)" ::: "memory");
        }
    }
    __syncthreads();
}

namespace fk {
#define GAS __attribute__((address_space(1)))
typedef unsigned u32x4 __attribute__((ext_vector_type(4)));
typedef unsigned u32x2 __attribute__((ext_vector_type(2)));
typedef float f32x4 __attribute__((ext_vector_type(4)));
typedef float f32x2 __attribute__((ext_vector_type(2)));
typedef __bf16 bf2 __attribute__((ext_vector_type(2)));
typedef unsigned short bf16_t;
__device__ __forceinline__ float bflo(unsigned u) { return __uint_as_float(u << 16); }
__device__ __forceinline__ float bfhi(unsigned u) { return __uint_as_float(u & 0xffff0000u); }
__device__ __forceinline__ float dot2(unsigned a, unsigned b, float c) { return __builtin_amdgcn_fdot2_f32_bf16(__builtin_bit_cast(bf2, a), __builtin_bit_cast(bf2, b), c, false); }
__device__ __forceinline__ unsigned pk_bf16(float lo, float hi) { unsigned r; asm volatile("v_cvt_pk_bf16_f32 %0, %1, %2" : "=v"(r) : "v"(lo), "v"(hi)); return r; }
template <int CTRL> __device__ __forceinline__ float dppf(float v) { return __int_as_float(__builtin_amdgcn_update_dpp(0, __float_as_int(v), CTRL, 0xf, 0xf, true)); }
__device__ __forceinline__ float row_max16(float v) { v = fmaxf(v, dppf<0xB1>(v)); v = fmaxf(v, dppf<0x4E>(v)); v = fmaxf(v, dppf<0x141>(v)); v = fmaxf(v, dppf<0x140>(v)); return v; }
__device__ __forceinline__ float row_sum16(float v) { v += dppf<0xB1>(v); v += dppf<0x4E>(v); v += dppf<0x141>(v); v += dppf<0x140>(v); return v; }
__device__ __forceinline__ float shx(float v, int m, int lane) { return __int_as_float(__builtin_amdgcn_ds_bpermute((lane ^ m) << 2, __float_as_int(v))); }
__device__ __forceinline__ float wave_sum(float v, int lane) { v = row_sum16(v); v += shx(v, 16, lane); v += shx(v, 32, lane); return v; }
__device__ __forceinline__ float gelu_tanh(float x) { return 0.5f * x * (1.f + tanhf(0.7978845608028654f * (x + 0.044715f * x * x * x))); }
#define FK_NEG (-3.0e38f)

template <int CTRL> __device__ __forceinline__ int dppi(int v) { return __builtin_amdgcn_update_dpp(0, v, CTRL, 0xf, 0xf, true); }
__device__ __forceinline__ int row_min16i(int v) { v = min(v, dppi<0xB1>(v)); v = min(v, dppi<0x4E>(v)); v = min(v, dppi<0x141>(v)); v = min(v, dppi<0x140>(v)); return v; }
#define FK_CE(a, b) do { const bool sw_ = v[b] > v[a]; const float tv_ = sw_ ? v[b] : v[a]; v[b] = sw_ ? v[a] : v[b]; v[a] = tv_; const int ti_ = sw_ ? id[b] : id[a]; id[b] = sw_ ? id[a] : id[b]; id[a] = ti_; } while (0)
#define FK_SORT8(v, id) do { FK_CE2(v, id, 0, 1); FK_CE2(v, id, 2, 3); FK_CE2(v, id, 4, 5); FK_CE2(v, id, 6, 7); FK_CE2(v, id, 0, 2); FK_CE2(v, id, 1, 3); FK_CE2(v, id, 4, 6); FK_CE2(v, id, 5, 7); FK_CE2(v, id, 1, 2); FK_CE2(v, id, 5, 6); \
    FK_CE2(v, id, 0, 4); FK_CE2(v, id, 1, 5); FK_CE2(v, id, 2, 6); FK_CE2(v, id, 3, 7); FK_CE2(v, id, 2, 4); FK_CE2(v, id, 3, 5); FK_CE2(v, id, 1, 2); FK_CE2(v, id, 3, 4); FK_CE2(v, id, 5, 6); } while (0)
#define FK_CE2(v, id, a, b) do { const bool sw_ = v[b] > v[a]; const float tv_ = sw_ ? v[b] : v[a]; v[b] = sw_ ? v[a] : v[b]; v[a] = tv_; const int ti_ = sw_ ? id[b] : id[a]; id[b] = sw_ ? id[a] : id[b]; id[a] = ti_; } while (0)
__device__ __forceinline__ void top16_of_128_x2(float (&v)[8], int (&id)[8], float (&u)[8], int (&jd)[8], int lane16, float& rv1, int& ri1, float& rv2, int& ri2) {
    FK_SORT8(v, id); FK_SORT8(u, jd);
    rv1 = FK_NEG; ri1 = 0; rv2 = FK_NEG; ri2 = 0;
#pragma unroll
    for (int r = 0; r < 16; ++r) {
        const float wm = row_max16(v[0]), xm = row_max16(u[0]);
        const int cand = (v[0] == wm) ? id[0] : 0x7fffffff, dand = (u[0] == xm) ? jd[0] : 0x7fffffff;
        const int sel = row_min16i(cand), tel = row_min16i(dand);
        const bool mine = (cand == sel), nine = (dand == tel);
        if (lane16 == r) { rv1 = wm; ri1 = sel; rv2 = xm; ri2 = tel; }
#pragma unroll
        for (int i = 0; i < 7; ++i) { v[i] = mine ? v[i + 1] : v[i]; id[i] = mine ? id[i + 1] : id[i]; u[i] = nine ? u[i + 1] : u[i]; jd[i] = nine ? jd[i + 1] : jd[i]; }
        v[7] = mine ? FK_NEG : v[7]; u[7] = nine ? FK_NEG : u[7];
    }
}
__device__ __forceinline__ void topk_phase(const GAS float* __restrict__ SC, const GAS bf16_t* __restrict__ Q, const GAS float* __restrict__ KSUM, GAS float* __restrict__ GATE, GAS int* __restrict__ EIDX, int nitems,
                                           LAS unsigned char* lds, int wid, int lane, int wave_gid, int nwaves) {
    LAS float* xv = (LAS float*)(lds + wid * 256);
    const int lane16 = lane & 15, rowbase = lane & 48;
    for (int wi = wave_gid; wi * 4 < nitems; wi += nwaves) {
        const int it = wi * 4 + (lane >> 4); const int h = it & 7;
        const GAS u32x4* qp = (const GAS u32x4*)(Q + (size_t)it * 256 + 16 * lane16); const u32x4 qa = qp[0], qb = qp[1];
        float qs = 0.f, qq = 0.f;
#pragma unroll
        for (int i = 0; i < 4; ++i) { const float a = bflo(qa[i]), b = bfhi(qa[i]), c = bflo(qb[i]), d = bfhi(qb[i]); qs += (a + b) + (c + d); qq += (a * a + b * b) + (c * c + d * d); }
        const float mu = row_sum16(qs) * (1.f / 256.f); const float var = fmaxf(row_sum16(qq) * (1.f / 256.f) - mu * mu, 0.f); const float rs = 1.f / sqrtf(var + 1e-5f);
        float v[8], u[8]; int id[8], jd[8]; float rv1, rv2; int ri1, ri2;
        { const GAS float* sp = SC + (size_t)it * 256 + 8 * lane16; const GAS float* kp = KSUM + h * 256 + 8 * lane16; const f32x4 s0 = *(const GAS f32x4*)sp, s1 = *(const GAS f32x4*)(sp + 4), k0 = *(const GAS f32x4*)kp, k1 = *(const GAS f32x4*)(kp + 4);
          const f32x4 t0 = *(const GAS f32x4*)(sp + 128), t1 = *(const GAS f32x4*)(sp + 132), m0 = *(const GAS f32x4*)(kp + 128), m1 = *(const GAS f32x4*)(kp + 132);
#pragma unroll
          for (int i = 0; i < 4; ++i) { v[i] = rs * (s0[i] - mu * k0[i]); v[4 + i] = rs * (s1[i] - mu * k1[i]); u[i] = rs * (t0[i] - mu * m0[i]); u[4 + i] = rs * (t1[i] - mu * m1[i]);
              id[i] = 8 * lane16 + i; id[4 + i] = 8 * lane16 + 4 + i; jd[i] = 8 * lane16 + i; jd[4 + i] = 8 * lane16 + 4 + i; } }
        top16_of_128_x2(v, id, u, jd, lane16, rv1, ri1, rv2, ri2);
        xv[lane] = rv2;
        float c[16];
        { const LAS f32x4* xp = (const LAS f32x4*)(xv + rowbase);
#pragma unroll
          for (int q = 0; q < 4; ++q) { const f32x4 t = xp[q]; c[4 * q] = rv1 + t.x; c[4 * q + 1] = rv1 + t.y; c[4 * q + 2] = rv1 + t.z; c[4 * q + 3] = rv1 + t.w; } }
        int p = 0; float sc = FK_NEG; int cid = 0;
#pragma unroll
        for (int r = 0; r < 16; ++r) {
            const float wm = row_max16(c[0]);
            const int cand = (c[0] == wm) ? (16 * lane16 + p) : 0x7fffffff;
            const int sel = row_min16i(cand);
            const bool mine = (cand == sel);
            if (lane16 == r) { sc = wm; cid = sel; }
#pragma unroll
            for (int i = 0; i < 15; ++i) c[i] = mine ? c[i + 1] : c[i];
            c[15] = mine ? FK_NEG : c[15]; p += mine ? 1 : 0;
        }
        cid &= 255;
        const int e1 = __builtin_amdgcn_ds_bpermute((rowbase + (cid >> 4)) << 2, ri1), e2 = __builtin_amdgcn_ds_bpermute((rowbase + (cid & 15)) << 2, ri2);
        const float mx = row_max16(sc); const float ex = __expf(sc - mx); const float den = row_sum16(ex);
        GATE[(size_t)it * 16 + lane16] = ex / den; EIDX[(size_t)it * 16 + lane16] = (e1 & 127) * 128 + (e2 & 127);
    }
}

__device__ __forceinline__ f32x2 fp8lo(unsigned w) { return __builtin_amdgcn_cvt_pk_f32_fp8((int)w, false); }
__device__ __forceinline__ f32x2 fp8hi(unsigned w) { return __builtin_amdgcn_cvt_pk_f32_fp8((int)w, true); }
__device__ __forceinline__ void act_phase(const GAS bf16_t* __restrict__ XB, const GAS unsigned char* __restrict__ U8, const GAS float* __restrict__ GATE, const GAS int* __restrict__ EIDX, GAS float* __restrict__ COEF, int nitems,
                                          int lane, int wave_gid, int nwaves) {
    int it = wave_gid; if (it >= nitems) return;
    u32x4 uc[16], un[16], xac, xbc, xan, xbn;
    int evc = EIDX[(size_t)it * 16 + (lane & 15)];
    { const GAS u32x4* xp = (const GAS u32x4*)(XB + (size_t)(it >> 3) * 1024 + 16 * lane); xac = xp[0]; xbc = xp[1]; }
#pragma unroll
    for (int k = 0; k < 16; ++k) uc[k] = *(const GAS u32x4*)(U8 + (size_t)__builtin_amdgcn_readlane(evc, k) * 1024 + 16 * lane);
    int itn = it + nwaves; int evn = (itn < nitems) ? EIDX[(size_t)itn * 16 + (lane & 15)] : 0;
    for (;;) {
        const bool hasn = itn < nitems;
        if (hasn) {
            const GAS u32x4* xp = (const GAS u32x4*)(XB + (size_t)(itn >> 3) * 1024 + 16 * lane); xan = xp[0]; xbn = xp[1];
#pragma unroll
            for (int k = 0; k < 16; ++k) un[k] = *(const GAS u32x4*)(U8 + (size_t)__builtin_amdgcn_readlane(evn, k) * 1024 + 16 * lane);
        }
        const int itnn = itn + nwaves; const int evnn = (itnn < nitems) ? EIDX[(size_t)itnn * 16 + (lane & 15)] : 0;
        const float gt = GATE[(size_t)it * 16 + (lane >> 2)];
        float x[16];
#pragma unroll
        for (int i = 0; i < 4; ++i) { x[2 * i] = bflo(xac[i]); x[2 * i + 1] = bfhi(xac[i]); x[8 + 2 * i] = bflo(xbc[i]); x[8 + 2 * i + 1] = bfhi(xbc[i]); }
        float a[16];
#pragma unroll
        for (int k = 0; k < 16; ++k) { const u32x4 uw = uc[k]; float s = 0.f;
#pragma unroll
            for (int d = 0; d < 4; ++d) { const f32x2 lo = fp8lo(uw[d]), hi = fp8hi(uw[d]); s = fmaf(lo.x, x[4 * d], s); s = fmaf(lo.y, x[4 * d + 1], s); s = fmaf(hi.x, x[4 * d + 2], s); s = fmaf(hi.y, x[4 * d + 3], s); }
            asm volatile("" : "+v"(s)); a[k] = s; }
#pragma unroll
        for (int k = 0; k < 8; ++k) { const bool hi = lane & 32; const float send = hi ? a[k] : a[k + 8], keep = hi ? a[k + 8] : a[k]; a[k] = keep + shx(send, 32, lane); }
#pragma unroll
        for (int k = 0; k < 4; ++k) { const bool hi = lane & 16; const float send = hi ? a[k] : a[k + 4], keep = hi ? a[k + 4] : a[k]; a[k] = keep + shx(send, 16, lane); }
#pragma unroll
        for (int k = 0; k < 2; ++k) { const bool hi = lane & 8; const float send = hi ? a[k] : a[k + 2], keep = hi ? a[k + 2] : a[k]; a[k] = keep + shx(send, 8, lane); }
        { const bool hi = lane & 4; const float send = hi ? a[0] : a[1], keep = hi ? a[1] : a[0]; a[0] = keep + shx(send, 4, lane); }
        float dsum = a[0]; dsum += shx(dsum, 2, lane); dsum += shx(dsum, 1, lane);
        if ((lane & 3) == 0) COEF[(size_t)it * 16 + (lane >> 2)] = gt * gelu_tanh(dsum * (1.f / 128.f));
        if (!hasn) break;
#pragma unroll
        for (int k = 0; k < 16; ++k) uc[k] = un[k];
        xac = xan; xbc = xbn; evc = evn; evn = evnn; it = itn; itn = itnn;
    }
}

__device__ __forceinline__ void outln_phase(const GAS float* COEF, const GAS int* EIDX, const GAS unsigned char* V8,     const GAS float* __restrict__ lg, const GAS float* __restrict__ lb, GAS float* X, GAS bf16_t* XB, int nrows,
                                            int lane, int wave_gid, int nwaves) {
    const float alpha = 1.6817928305074292f;
    int row = wave_gid; if (row >= nrows) return;
    u32x4 vc[16], vn[16];
    float cf0 = COEF[(size_t)row * 128 + lane] * (1.f / 64.f), cf1 = COEF[(size_t)row * 128 + 64 + lane] * (1.f / 64.f); int ev0 = EIDX[(size_t)row * 128 + lane], ev1 = EIDX[(size_t)row * 128 + 64 + lane];
#define OUT_LOADCH(dst, evreg, base) do { _Pragma("unroll") for (int k_ = 0; k_ < 16; ++k_) dst[k_] = *(const GAS u32x4*)(V8 + (size_t)__builtin_amdgcn_readlane(evreg, (base) + k_) * 1024 + 16 * lane); } while (0)
#define OUT_COMPCH(src, cfreg, base) do { _Pragma("unroll") for (int k_ = 0; k_ < 16; ++k_) { const float c_ = __int_as_float(__builtin_amdgcn_readlane(__float_as_int(cfreg), (base) + k_)); const u32x4 vw_ = src[k_]; \
        _Pragma("unroll") for (int d_ = 0; d_ < 4; ++d_) { const f32x2 lo_ = fp8lo(vw_[d_]), hi_ = fp8hi(vw_[d_]); acc[4 * d_] = fmaf(c_, lo_.x, acc[4 * d_]); acc[4 * d_ + 1] = fmaf(c_, lo_.y, acc[4 * d_ + 1]); acc[4 * d_ + 2] = fmaf(c_, hi_.x, acc[4 * d_ + 2]); acc[4 * d_ + 3] = fmaf(c_, hi_.y, acc[4 * d_ + 3]); } \
        _Pragma("unroll") for (int p_ = 0; p_ < 16; ++p_) asm volatile("" : "+v"(acc[p_]));     \
        } } while (0)
    for (;;) {
        OUT_LOADCH(vc, ev0, 0);
        const int rown = row + nwaves; const bool hasn = rown < nrows;
        float ncf0 = 0.f, ncf1 = 0.f; int nev0 = 0, nev1 = 0;
        if (hasn) { ncf0 = COEF[(size_t)rown * 128 + lane] * (1.f / 64.f); ncf1 = COEF[(size_t)rown * 128 + 64 + lane] * (1.f / 64.f); nev0 = EIDX[(size_t)rown * 128 + lane]; nev1 = EIDX[(size_t)rown * 128 + 64 + lane]; }
        float acc[16];
#pragma unroll
        for (int k = 0; k < 16; ++k) acc[k] = 0.f;
#define OUT_FENCE() asm volatile("" ::: "memory")
        OUT_LOADCH(vn, ev0, 16); OUT_FENCE(); OUT_COMPCH(vc, cf0, 0); OUT_FENCE();
        OUT_LOADCH(vc, ev0, 32); OUT_FENCE(); OUT_COMPCH(vn, cf0, 16); OUT_FENCE();
        OUT_LOADCH(vn, ev0, 48); OUT_FENCE(); OUT_COMPCH(vc, cf0, 32); OUT_FENCE();
        OUT_LOADCH(vc, ev1, 0);  OUT_FENCE(); OUT_COMPCH(vn, cf0, 48); OUT_FENCE();
        OUT_LOADCH(vn, ev1, 16); OUT_FENCE(); OUT_COMPCH(vc, cf1, 0); OUT_FENCE();
        OUT_LOADCH(vc, ev1, 32); OUT_FENCE(); OUT_COMPCH(vn, cf1, 16); OUT_FENCE();
        OUT_LOADCH(vn, ev1, 48); OUT_FENCE(); OUT_COMPCH(vc, cf1, 32); OUT_FENCE();
        OUT_COMPCH(vn, cf1, 48); OUT_FENCE();
#undef OUT_FENCE
        GAS float* xr = X + (size_t)row * 1024 + 16 * lane; float t[16];
#pragma unroll
        for (int q = 0; q < 4; ++q) { const f32x4 xv = *(const GAS f32x4*)(xr + 4 * q); t[4 * q] = fmaf(alpha, xv.x, acc[4 * q]); t[4 * q + 1] = fmaf(alpha, xv.y, acc[4 * q + 1]); t[4 * q + 2] = fmaf(alpha, xv.z, acc[4 * q + 2]); t[4 * q + 3] = fmaf(alpha, xv.w, acc[4 * q + 3]); }
        float s = 0.f;
#pragma unroll
        for (int k = 0; k < 16; ++k) s += t[k];
        const float mu = wave_sum(s, lane) * (1.f / 1024.f); float vs = 0.f;
#pragma unroll
        for (int k = 0; k < 16; ++k) { t[k] -= mu; vs = fmaf(t[k], t[k], vs); }
        const float rs = 1.f / sqrtf(wave_sum(vs, lane) * (1.f / 1024.f) + 1e-5f);
        unsigned w[8];
#pragma unroll
        for (int q = 0; q < 4; ++q) { const f32x4 g = *(const GAS f32x4*)(lg + 16 * lane + 4 * q), b = *(const GAS f32x4*)(lb + 16 * lane + 4 * q); f32x4 o;
            o.x = t[4 * q] * rs * g.x + b.x; o.y = t[4 * q + 1] * rs * g.y + b.y; o.z = t[4 * q + 2] * rs * g.z + b.z; o.w = t[4 * q + 3] * rs * g.w + b.w;
            *(GAS f32x4*)(xr + 4 * q) = o; w[2 * q] = pk_bf16(o.x, o.y); w[2 * q + 1] = pk_bf16(o.z, o.w); }
        u32x4 w0, w1; w0.x = w[0]; w0.y = w[1]; w0.z = w[2]; w0.w = w[3]; w1.x = w[4]; w1.y = w[5]; w1.z = w[6]; w1.w = w[7];
        GAS u32x4* xbp = (GAS u32x4*)(XB + (size_t)row * 1024 + 16 * lane); xbp[0] = w0; xbp[1] = w1;
        if (!hasn) break;
        row = rown; cf0 = ncf0; cf1 = ncf1; ev0 = nev0; ev1 = nev1;
    }
#undef OUT_LOADCH
#undef OUT_COMPCH
}

__device__ __forceinline__ void lnres_phase(const GAS float* __restrict__ Y, const GAS float* __restrict__ lg, const GAS float* __restrict__ lb, GAS float* X, GAS bf16_t* XB, int nrows, int lane, int wave_gid, int nwaves) {
    const float alpha = 1.6817928305074292f;
    for (int row = wave_gid; row < nrows; row += nwaves) {
        GAS float* xr = X + (size_t)row * 1024; const GAS float* yr = Y + (size_t)row * 1024; float t[16];
#pragma unroll
        for (int q = 0; q < 4; ++q) { const f32x4 xv = *(const GAS f32x4*)(xr + 256 * q + 4 * lane), yv = *(const GAS f32x4*)(yr + 256 * q + 4 * lane);
            t[4 * q] = fmaf(alpha, xv.x, yv.x); t[4 * q + 1] = fmaf(alpha, xv.y, yv.y); t[4 * q + 2] = fmaf(alpha, xv.z, yv.z); t[4 * q + 3] = fmaf(alpha, xv.w, yv.w); }
        float s = 0.f;
#pragma unroll
        for (int k = 0; k < 16; ++k) s += t[k];
        const float mu = wave_sum(s, lane) * (1.f / 1024.f); float vs = 0.f;
#pragma unroll
        for (int k = 0; k < 16; ++k) { t[k] -= mu; vs = fmaf(t[k], t[k], vs); }
        const float rs = 1.f / sqrtf(wave_sum(vs, lane) * (1.f / 1024.f) + 1e-5f);
#pragma unroll
        for (int q = 0; q < 4; ++q) { const int c = 256 * q + 4 * lane; const f32x4 g = *(const GAS f32x4*)(lg + c), b = *(const GAS f32x4*)(lb + c); f32x4 o;
            o.x = t[4 * q] * rs * g.x + b.x; o.y = t[4 * q + 1] * rs * g.y + b.y; o.z = t[4 * q + 2] * rs * g.z + b.z; o.w = t[4 * q + 3] * rs * g.w + b.w;
            *(GAS f32x4*)(xr + c) = o; u32x2 w; w.x = pk_bf16(o.x, o.y); w.y = pk_bf16(o.z, o.w); *(GAS u32x2*)(XB + (size_t)row * 1024 + c) = w; }
    }
}

__device__ __forceinline__ void glanorm_phase(const GAS float* __restrict__ O, const GAS float* __restrict__ PROJ, const GAS float* __restrict__ gnorm, GAS bf16_t* XB, int nitems, int lane, int wave_gid, int nwaves) {
    const float g0 = gnorm[lane], g1 = gnorm[64 + lane];
    for (int it0 = wave_gid * 4; it0 < nitems; it0 += nwaves * 4) {
        float a0[4], a1[4], r0[4], r1[4];
#pragma unroll
        for (int q = 0; q < 4; ++q) { int it = it0 + q; it = it < nitems ? it : it0; const int row = it >> 2, h = it & 3; const GAS float* o = O + (size_t)row * 512 + h * 128; const GAS float* r = PROJ + (size_t)row * 2576 + 1040 + h * 128;
            a0[q] = o[lane]; a1[q] = o[64 + lane]; r0[q] = r[lane]; r1[q] = r[64 + lane]; }
#pragma unroll
        for (int q = 0; q < 4; ++q) { const int it = it0 + q; const int row = it >> 2, h = it & 3;
            const float rs = 1.f / sqrtf(wave_sum(a0[q] * a0[q] + a1[q] * a1[q], lane) * (1.f / 128.f) + 1e-5f);
            const float y0 = a0[q] * rs * g0 * (r0[q] / (1.f + __expf(-r0[q]))), y1 = a1[q] * rs * g1 * (r1[q] / (1.f + __expf(-r1[q])));
            if (it < nitems) { GAS bf16_t* d = XB + (size_t)row * 1024 + h * 128; d[lane] = (bf16_t)(pk_bf16(y0, 0.f) & 0xffffu); d[64 + lane] = (bf16_t)(pk_bf16(y1, 0.f) & 0xffffu); } }
    }
}

__device__ __forceinline__ float sigm(float x) { return 1.f / (1.f + __expf(-x)); }
__device__ __forceinline__ float softplusf(float x) { return fmaxf(x, 0.f) + log1pf(__expf(-fabsf(x))); }
__device__ __forceinline__ void rwkvprep_phase(const GAS float* __restrict__ w0, const GAS float* __restrict__ a0, const GAS float* __restrict__ v0, const GAS float* __restrict__ k_k, const GAS float* __restrict__ k_a, const GAS float* __restrict__ Vg,
                                               GAS float* K, GAS float* Wd, GAS float* Aa, GAS float* V, GAS float* NKK, GAS float* VFIRST, int has_vres, int nitems, int lane, int wave_gid, int nwaves) {
    for (int it0 = wave_gid * 4; it0 < nitems; it0 += nwaves * 4) {
        float kq[4], wq[4], aq[4], vq[4], gq[4], fq[4];
#pragma unroll
        for (int q = 0; q < 4; ++q) { const int it = it0 + q; const size_t ix = (size_t)(it >> 4) * 1024 + (it & 15) * 64 + lane; kq[q] = K[ix]; wq[q] = Wd[ix]; aq[q] = Aa[ix]; vq[q] = V[ix]; gq[q] = has_vres ? Vg[ix] : 0.f; fq[q] = has_vres ? VFIRST[ix] : 0.f; }
#pragma unroll
        for (int q = 0; q < 4; ++q) { const int it = it0 + q; const int h = it & 15; const size_t ix = (size_t)(it >> 4) * 1024 + h * 64 + lane; const int c = h * 64 + lane;
            const float k0 = kq[q]; const float kv = k0 * k_k[c]; const float inv = 1.f / fmaxf(sqrtf(wave_sum(kv * kv, lane)), 1e-12f);
            const float w = -softplusf(-(w0[c] + wq[q])) - 0.5f; const float dec = __expf(-__expf(w));
            const float a = sigm(a0[c] + aq[q]);
            float v = vq[q]; if (has_vres) v = v + (fq[q] - v) * sigm(v0[c] + gq[q]); else VFIRST[ix] = v;
            const float kk = kv * inv;
            NKK[ix] = -kk; K[ix] = k0 * (1.f + (a - 1.f) * k_a[c]); Wd[ix] = dec; Aa[ix] = kk * a; V[ix] = v; }
    }
}

__device__ __forceinline__ void rwkvpost_phase(const GAS float* __restrict__ Y, const GAS float* __restrict__ R, const GAS float* __restrict__ K2, const GAS float* __restrict__ V, const GAS float* __restrict__ G, const GAS float* __restrict__ r_k,
                                               const GAS float* __restrict__ lnx_g, const GAS float* __restrict__ lnx_b, GAS bf16_t* XB, int nitems, int lane, int wave_gid, int nwaves) {
    for (int it0 = wave_gid * 4; it0 < nitems; it0 += nwaves * 4) {
        float yq[4], rq[4], kq[4], vq[4], gq[4];
#pragma unroll
        for (int q = 0; q < 4; ++q) { const int it = it0 + q; const size_t ix = (size_t)(it >> 4) * 1024 + (it & 15) * 64 + lane; yq[q] = Y[ix]; rq[q] = R[ix]; kq[q] = K2[ix]; vq[q] = V[ix]; gq[q] = G[ix]; }
#pragma unroll
        for (int q = 0; q < 4; ++q) { const int it = it0 + q; const int h = it & 15; const size_t ix = (size_t)(it >> 4) * 1024 + h * 64 + lane; const int c = h * 64 + lane;
            const float y = yq[q]; const float mu = wave_sum(y, lane) * (1.f / 64.f); const float d = y - mu; const float rs = 1.f / sqrtf(wave_sum(d * d, lane) * (1.f / 64.f) + 64e-5f);
            const float bon = wave_sum(rq[q] * kq[q] * r_k[c], lane);
            const float o = (d * rs * lnx_g[c] + lnx_b[c] + bon * vq[q]) * gq[q];
            XB[ix] = (bf16_t)(pk_bf16(o, 0.f) & 0xffffu); }
    }
}

__device__ __forceinline__ void wkv_phase(const GAS float* __restrict__ R, const GAS float* __restrict__ Wd, const GAS float* __restrict__ K2, const GAS float* __restrict__ V, const GAS float* __restrict__ BB, const GAS float* __restrict__ NKK,
                                          const GAS float* __restrict__ SIN, GAS float* __restrict__ Y, GAS float* __restrict__ P, GAS float* __restrict__ SOUT, int B, int T, int DB, int DT, LAS unsigned char* lds, int tid, int bid, int nb) {
    constexpr int TB = 32, NLD = 6, VECB = TB * 1280, VVB = TB * 128, BUF = VECB + 2 * VVB;
    const int rowl = tid >> 4, part = tid & 15;
    const int nprompt = B * 32, nunits = nprompt + DB * 32;
    for (int u = bid; u < nunits; u += nb) {
        const bool smp = u >= nprompt; const int q = smp ? u - nprompt : u; const int half = q & 1, pair = q >> 1, sq = pair >> 4, h = pair & 15;
        const int Tu = smp ? DT : T; const int r0 = smp ? B * T + sq * DT : sq * T, vrow = half * 32 + rowl;
        f32x2 S01 = (f32x2){0.f, 0.f}, S23 = (f32x2){0.f, 0.f};
        if (smp) { const f32x4 s4 = *(const GAS f32x4*)(SIN + ((size_t)pair * 64 + vrow) * 64 + part * 4); S01 = (f32x2){s4.x, s4.y}; S23 = (f32x2){s4.z, s4.w};
                   asm volatile("" : "+v"(S01), "+v"(S23)); }
        const int nblk = (Tu + TB - 1) / TB;
        f32x4 ld[NLD];
        const size_t eo_ = (size_t)(r0 + (tid >> 4)) * 1024 + h * 64 + (tid & 15) * 4, ev_ = (size_t)(r0 + ((tid & 255) >> 3)) * 1024 + h * 64 + half * 32 + (tid & 7) * 4;
        const int lo_ = ((tid >> 4) * 320 + (tid & 15) * 4) * 4, lv_ = VECB + (tid & 255) * 16;
#define WKV_LOAD(tb0) do { const size_t bo_ = (size_t)(tb0) * 1024; ld[0] = *(const GAS f32x4*)(Wd + eo_ + bo_); ld[1] = *(const GAS f32x4*)(NKK + eo_ + bo_); ld[2] = *(const GAS f32x4*)(BB + eo_ + bo_); \
            ld[3] = *(const GAS f32x4*)(K2 + eo_ + bo_); ld[4] = *(const GAS f32x4*)(R + eo_ + bo_); ld[5] = *(const GAS f32x4*)(V + ev_ + bo_); } while (0)
#define WKV_STORE(bufp) do { _Pragma("unroll") for (int q_ = 0; q_ < 5; ++q_) *(LAS f32x4*)((bufp) + lo_ + q_ * 256) = ld[q_]; *(LAS f32x4*)((bufp) + lv_) = ld[5]; } while (0)
        WKV_LOAD(0); WKV_STORE(lds); __syncthreads();
        for (int b = 0; b < nblk; ++b) {
            LAS unsigned char* cur = lds + (b & 1) * BUF; LAS unsigned char* nxt = lds + ((b + 1) & 1) * BUF; const int tb0 = b * TB; const int nt = (Tu - tb0) < TB ? (Tu - tb0) : TB;
            if (b + 1 < nblk) WKV_LOAD(tb0 + TB);
            const LAS float* vec = (const LAS float*)cur + part * 4; const LAS float* vv = (const LAS float*)(cur + VECB) + rowl; LAS float* yb = (LAS float*)(cur + VECB + VVB);
            float ykeep0 = 0.f, ykeep1 = 0.f;
#define WKV_STEP(t, keep, tl) do { const LAS f32x2* vp_ = (const LAS f32x2*)(vec + (t) * 320); \
                const f32x2 w01 = vp_[0], w23 = vp_[1], n01 = vp_[32], n23 = vp_[33], b01 = vp_[64], b23 = vp_[65], k01 = vp_[96], k23 = vp_[97], r01 = vp_[128], r23 = vp_[129]; \
                const float v = vv[(t) * 32]; \
                const f32x2 sp = __builtin_elementwise_fma(S23, n23, S01 * n01); const float sa = row_sum16(sp.x + sp.y); const f32x2 sa2 = (f32x2){sa, sa}, v2 = (f32x2){v, v}; \
                S01 = __builtin_elementwise_fma(S01, w01, __builtin_elementwise_fma(b01, sa2, k01 * v2)); S23 = __builtin_elementwise_fma(S23, w23, __builtin_elementwise_fma(b23, sa2, k23 * v2)); \
                const f32x2 yp = __builtin_elementwise_fma(S23, r23, S01 * r01); const float y = row_sum16(yp.x + yp.y); \
                keep = (part == (tl)) ? y : keep; } while (0)
            if (nt == TB) {
#pragma unroll 1
                for (int t = 0; t < 16; t += 8) { WKV_STEP(t, ykeep0, t); WKV_STEP(t + 1, ykeep0, t + 1); WKV_STEP(t + 2, ykeep0, t + 2); WKV_STEP(t + 3, ykeep0, t + 3); WKV_STEP(t + 4, ykeep0, t + 4); WKV_STEP(t + 5, ykeep0, t + 5); WKV_STEP(t + 6, ykeep0, t + 6); WKV_STEP(t + 7, ykeep0, t + 7); }
#pragma unroll 1
                for (int t = 16; t < 32; t += 8) { WKV_STEP(t, ykeep1, t - 16); WKV_STEP(t + 1, ykeep1, t - 15); WKV_STEP(t + 2, ykeep1, t - 14); WKV_STEP(t + 3, ykeep1, t - 13); WKV_STEP(t + 4, ykeep1, t - 12); WKV_STEP(t + 5, ykeep1, t - 11); WKV_STEP(t + 6, ykeep1, t - 10); WKV_STEP(t + 7, ykeep1, t - 9); }
            } else { for (int t = 0; t < nt; ++t) { if (t < 16) WKV_STEP(t, ykeep0, t); else WKV_STEP(t, ykeep1, t - 16); } }
#undef WKV_STEP
            yb[part * 32 + rowl] = ykeep0; yb[(16 + part) * 32 + rowl] = ykeep1;
            if (b + 1 < nblk) WKV_STORE(nxt);
            __syncthreads();
            { const int rl = tid & 31; _Pragma("unroll") for (int t = tid >> 5; t < TB; t += 16) if (t < nt) Y[(size_t)(r0 + tb0 + t) * 1024 + h * 64 + half * 32 + rl] = yb[t * 32 + rl]; }
        }
#undef WKV_LOAD
#undef WKV_STORE
        *(GAS f32x4*)((smp ? SOUT : P) + ((size_t)pair * 64 + vrow) * 64 + part * 4) = (f32x4){S01.x, S01.y, S23.x, S23.y};
        __syncthreads();
    }
}

__device__ __forceinline__ void rwkvpost2_phase(const GAS float* __restrict__ Y, const GAS float* __restrict__ G, const GAS float* __restrict__ VF, const GAS float* __restrict__ BON, const GAS float* __restrict__ lnx_g, const GAS float* __restrict__ lnx_b,
                                                GAS bf16_t* XB, int nitems, int lane, int wave_gid, int nwaves) {
    for (int it0 = wave_gid * 4; it0 < nitems; it0 += nwaves * 4) {
        float yq[4], gq[4], vq[4], bq[4];
#pragma unroll
        for (int q = 0; q < 4; ++q) { const int it = it0 + q; const size_t ix = (size_t)(it >> 4) * 1024 + (it & 15) * 64 + lane; yq[q] = Y[ix]; gq[q] = G[ix]; vq[q] = VF[ix]; bq[q] = BON[it]; }
#pragma unroll
        for (int q = 0; q < 4; ++q) { const int it = it0 + q; const int h = it & 15; const size_t ix = (size_t)(it >> 4) * 1024 + h * 64 + lane; const int c = h * 64 + lane;
            const float y = yq[q]; const float mu = wave_sum(y, lane) * (1.f / 64.f); const float d = y - mu; const float rs = 1.f / sqrtf(wave_sum(d * d, lane) * (1.f / 64.f) + 64e-5f);
            const float o = (d * rs * lnx_g[c] + lnx_b[c] + bq[q] * vq[q]) * gq[q];
            XB[ix] = (bf16_t)(pk_bf16(o, 0.f) & 0xffffu); }
    }
}

__device__ __forceinline__ void wkv2_phase(const GAS float* __restrict__ R, const GAS float* __restrict__ KR, const GAS float* __restrict__ WL, const GAS float* __restrict__ AL, const GAS float* __restrict__ V, const GAS float* __restrict__ VG,
                                           const GAS float* VFI, const GAS float* __restrict__ PRM, const GAS float* __restrict__ SIN, GAS float* __restrict__ Y, GAS float* __restrict__ P, GAS float* __restrict__ SOUT, GAS float* VFO, GAS float* __restrict__ BON,
                                           int has_vres, int B, int T, int DB, int DT, LAS unsigned char* lds, int tid, int bid, int nb) {
    constexpr int TB = 32, NLD = 7, VECB = TB * 1280, VVB = TB * 128, BUF = VECB + 2 * VVB;
    const int rowl = tid >> 4, part = tid & 15;
    const int nprompt = B * 32, nunits = nprompt + DB * 32;
    for (int u = bid; u < nunits; u += nb) {
        const bool smp = u >= nprompt; const int q = smp ? u - nprompt : u; const int half = q & 1, pair = q >> 1, sq = pair >> 4, h = pair & 15;
        const int Tu = smp ? DT : T; const int r0 = smp ? B * T + sq * DT : sq * T, vrow = half * 32 + rowl;
        f32x2 S01 = (f32x2){0.f, 0.f}, S23 = (f32x2){0.f, 0.f};
        if (smp) { const f32x4 s4 = *(const GAS f32x4*)(SIN + ((size_t)pair * 64 + vrow) * 64 + part * 4); S01 = (f32x2){s4.x, s4.y}; S23 = (f32x2){s4.z, s4.w};
                   asm volatile("" : "+v"(S01), "+v"(S23)); }
        const int nblk = (Tu + TB - 1) / TB;
        f32x4 ld[NLD];
        const size_t eo_ = (size_t)(r0 + (tid >> 4)) * 1024 + h * 64 + (tid & 15) * 4, ev_ = (size_t)(r0 + ((tid & 255) >> 3)) * 1024 + h * 64 + half * 32 + (tid & 7) * 4;
        const int lo_ = ((tid >> 4) * 320 + (tid & 15) * 4) * 4, lv_ = VECB + (tid & 255) * 16;
        const int pc_ = h * 64 + (tid & 15) * 4; const f32x4 w0v = *(const GAS f32x4*)(PRM + pc_), a0v = *(const GAS f32x4*)(PRM + 1024 + pc_), kkp = *(const GAS f32x4*)(PRM + 3072 + pc_), kap = *(const GAS f32x4*)(PRM + 4096 + pc_), rkp = *(const GAS f32x4*)(PRM + 5120 + pc_);
        const f32x4 v0v = *(const GAS f32x4*)(PRM + 2048 + h * 64 + half * 32 + (tid & 7) * 4);
#define WKV_LOAD(tb0) do { const size_t bo_ = (size_t)(tb0) * 1024; ld[0] = *(const GAS f32x4*)(KR + eo_ + bo_); ld[1] = *(const GAS f32x4*)(WL + eo_ + bo_); ld[2] = *(const GAS f32x4*)(AL + eo_ + bo_); \
            ld[3] = *(const GAS f32x4*)(R + eo_ + bo_); ld[4] = *(const GAS f32x4*)(V + ev_ + bo_); if (has_vres) { ld[5] = *(const GAS f32x4*)(VG + ev_ + bo_); ld[6] = *(const GAS f32x4*)(VFI + ev_ + bo_); } } while (0)
#define WKV_STORE(bufp, tb0) do { const f32x4 k4 = ld[0]; const f32x4 kv = k4 * kkp; const float ss = row_sum16((kv.x * kv.x + kv.y * kv.y) + (kv.z * kv.z + kv.w * kv.w)); const float inv = 1.f / fmaxf(sqrtf(ss), 1e-12f); \
            f32x4 dec, a4; _Pragma("unroll") for (int i_ = 0; i_ < 4; ++i_) { dec[i_] = __expf(-0.6065306597126334f / (1.f + __expf(-(w0v[i_] + ld[1][i_])))); a4[i_] = 1.f / (1.f + __expf(-(a0v[i_] + ld[2][i_]))); } \
            const f32x4 kk = kv * inv; const f32x4 k2 = k4 * ((a4 - 1.f) * kap + 1.f); const f32x4 r4 = ld[3]; const f32x4 rk = r4 * k2 * rkp; const float bon = row_sum16((rk.x + rk.y) + (rk.z + rk.w)); \
            *(LAS f32x4*)((bufp) + lo_) = dec; *(LAS f32x4*)((bufp) + lo_ + 256) = -kk; *(LAS f32x4*)((bufp) + lo_ + 512) = kk * a4; *(LAS f32x4*)((bufp) + lo_ + 768) = k2; *(LAS f32x4*)((bufp) + lo_ + 1024) = r4; \
            const int tr_ = (tb0) + (tid >> 4); if (half == 0 && (tid & 15) == 0 && tr_ < Tu) BON[(size_t)(r0 + tr_) * 16 + h] = bon; \
            f32x4 v4 = ld[4]; if (has_vres) { _Pragma("unroll") for (int i_ = 0; i_ < 4; ++i_) v4[i_] = v4[i_] + (ld[6][i_] - v4[i_]) / (1.f + __expf(-(v0v[i_] + ld[5][i_]))); } \
            *(LAS f32x4*)((bufp) + lv_) = v4; const int tv_ = (tb0) + ((tid & 255) >> 3); if (tid < 256 && tv_ < Tu) *(GAS f32x4*)(VFO + ev_ + (size_t)(tb0) * 1024) = v4; } while (0)
        WKV_LOAD(0); WKV_STORE(lds, 0); __syncthreads();
        for (int b = 0; b < nblk; ++b) {
            LAS unsigned char* cur = lds + (b & 1) * BUF; LAS unsigned char* nxt = lds + ((b + 1) & 1) * BUF; const int tb0 = b * TB; const int nt = (Tu - tb0) < TB ? (Tu - tb0) : TB;
            if (b + 1 < nblk) WKV_LOAD(tb0 + TB);
            const LAS float* vec = (const LAS float*)cur + part * 4; const LAS float* vv = (const LAS float*)(cur + VECB) + rowl; LAS float* yb = (LAS float*)(cur + VECB + VVB);
            float ykeep0 = 0.f, ykeep1 = 0.f;
#define WKV_STEP(t, keep, tl) do { const LAS f32x2* vp_ = (const LAS f32x2*)(vec + (t) * 320); \
                const f32x2 w01 = vp_[0], w23 = vp_[1], n01 = vp_[32], n23 = vp_[33], b01 = vp_[64], b23 = vp_[65], k01 = vp_[96], k23 = vp_[97], r01 = vp_[128], r23 = vp_[129]; \
                const float v = vv[(t) * 32]; \
                const f32x2 sp = __builtin_elementwise_fma(S23, n23, S01 * n01); const float sa = row_sum16(sp.x + sp.y); const f32x2 sa2 = (f32x2){sa, sa}, v2 = (f32x2){v, v}; \
                S01 = __builtin_elementwise_fma(S01, w01, __builtin_elementwise_fma(b01, sa2, k01 * v2)); S23 = __builtin_elementwise_fma(S23, w23, __builtin_elementwise_fma(b23, sa2, k23 * v2)); \
                const f32x2 yp = __builtin_elementwise_fma(S23, r23, S01 * r01); const float y = row_sum16(yp.x + yp.y); \
                keep = (part == (tl)) ? y : keep; } while (0)
            if (nt == TB) {
#pragma unroll 1
                for (int t = 0; t < 16; t += 8) { WKV_STEP(t, ykeep0, t); WKV_STEP(t + 1, ykeep0, t + 1); WKV_STEP(t + 2, ykeep0, t + 2); WKV_STEP(t + 3, ykeep0, t + 3); WKV_STEP(t + 4, ykeep0, t + 4); WKV_STEP(t + 5, ykeep0, t + 5); WKV_STEP(t + 6, ykeep0, t + 6); WKV_STEP(t + 7, ykeep0, t + 7); }
#pragma unroll 1
                for (int t = 16; t < 32; t += 8) { WKV_STEP(t, ykeep1, t - 16); WKV_STEP(t + 1, ykeep1, t - 15); WKV_STEP(t + 2, ykeep1, t - 14); WKV_STEP(t + 3, ykeep1, t - 13); WKV_STEP(t + 4, ykeep1, t - 12); WKV_STEP(t + 5, ykeep1, t - 11); WKV_STEP(t + 6, ykeep1, t - 10); WKV_STEP(t + 7, ykeep1, t - 9); }
            } else { for (int t = 0; t < nt; ++t) { if (t < 16) WKV_STEP(t, ykeep0, t); else WKV_STEP(t, ykeep1, t - 16); } }
#undef WKV_STEP
            yb[part * 32 + rowl] = ykeep0; yb[(16 + part) * 32 + rowl] = ykeep1;
            if (b + 1 < nblk) WKV_STORE(nxt, tb0 + TB);
            __syncthreads();
            { const int rl = tid & 31; _Pragma("unroll") for (int t = tid >> 5; t < TB; t += 16) if (t < nt) Y[(size_t)(r0 + tb0 + t) * 1024 + h * 64 + half * 32 + rl] = yb[t * 32 + rl]; }
        }
#undef WKV_LOAD
#undef WKV_STORE
        *(GAS f32x4*)((smp ? SOUT : P) + ((size_t)pair * 64 + vrow) * 64 + part * 4) = (f32x4){S01.x, S01.y, S23.x, S23.y};
        __syncthreads();
    }
}

__device__ __forceinline__ void gla_phase(const GAS float* __restrict__ PROJ, const GAS float* __restrict__ LOGA, GAS float* __restrict__ O, GAS float* __restrict__ P, int B, int T, LAS unsigned char* lds, int tid, int bid, int nb) {
    constexpr int TB = 32, NLD = 4, VECB = TB * 768, VVB = TB * 64, BUF = VECB + 3 * VVB;
    const int col = tid >> 5, half = (tid >> 4) & 1, p = tid & 15, dk = half * 32 + p * 2;
    const int nunits = B * 32;
    for (int u = bid; u < nunits; u += nb) {
        const int cb = u & 7, pair = u >> 3, s = pair >> 2, h = pair & 3; const int r0 = s * T;
        float S0 = 0.f, S1 = 0.f;
        const int nblk = (T + TB - 1) / TB;
        f32x4 ld[NLD];
        const size_t ea_ = (size_t)(r0 + (tid >> 4)) * 256 + h * 64 + (tid & 15) * 4, ep_ = (size_t)(r0 + (tid >> 4)) * 2576 + h * 64 + (tid & 15) * 4, ev_ = (size_t)(r0 + ((tid & 127) >> 2)) * 2576 + 512 + h * 128 + cb * 16 + (tid & 3) * 4;
        const int lo_ = ((tid >> 4) * 192 + (tid & 15) * 4) * 4, lv_ = VECB + (tid & 127) * 16;
#define GLA_LOAD(tb0) do { ld[0] = *(const GAS f32x4*)(LOGA + ea_ + (size_t)(tb0) * 256); ld[1] = *(const GAS f32x4*)(PROJ + ep_ + 256 + (size_t)(tb0) * 2576); ld[2] = *(const GAS f32x4*)(PROJ + ep_ + (size_t)(tb0) * 2576); ld[3] = *(const GAS f32x4*)(PROJ + ev_ + (size_t)(tb0) * 2576); } while (0)
#define GLA_STORE(bufp) do { *(LAS f32x4*)((bufp) + lo_) = ld[0]; *(LAS f32x4*)((bufp) + lo_ + 256) = ld[1]; *(LAS f32x4*)((bufp) + lo_ + 512) = ld[2] * 0.125f; *(LAS f32x4*)((bufp) + lv_) = ld[3]; } while (0)
        GLA_LOAD(0); GLA_STORE(lds); __syncthreads();
        for (int b = 0; b < nblk; ++b) {
            LAS unsigned char* cur = lds + (b & 1) * BUF; LAS unsigned char* nxt = lds + ((b + 1) & 1) * BUF; const int tb0 = b * TB; const int nt = (T - tb0) < TB ? (T - tb0) : TB;
            if (b + 1 < nblk) GLA_LOAD(tb0 + TB);
            const LAS float* vec = (const LAS float*)cur + dk; const LAS float* vv = (const LAS float*)(cur + VECB) + col; LAS float* ob = (LAS float*)(cur + VECB + VVB);
            float okeep0 = 0.f, okeep1 = 0.f;
#define GLA_STEP(t, keep, tl) do { const f32x2 a2 = *(const LAS f32x2*)(vec + (t) * 192), k2 = *(const LAS f32x2*)(vec + (t) * 192 + 64), q2 = *(const LAS f32x2*)(vec + (t) * 192 + 128); const float v = vv[(t) * 16]; \
                S0 = fmaf(a2.x, S0, k2.x * v); S1 = fmaf(a2.y, S1, k2.y * v); \
                float o = fmaf(q2.x, S0, q2.y * S1); o = row_sum16(o); keep = (p == (tl)) ? o : keep; } while (0)
            if (nt == TB) {
#pragma unroll 1
                for (int t = 0; t < 16; t += 4) { GLA_STEP(t, okeep0, t); GLA_STEP(t + 1, okeep0, t + 1); GLA_STEP(t + 2, okeep0, t + 2); GLA_STEP(t + 3, okeep0, t + 3); }
#pragma unroll 1
                for (int t = 16; t < 32; t += 4) { GLA_STEP(t, okeep1, t - 16); GLA_STEP(t + 1, okeep1, t - 15); GLA_STEP(t + 2, okeep1, t - 14); GLA_STEP(t + 3, okeep1, t - 13); }
            } else { for (int t = 0; t < nt; ++t) { if (t < 16) GLA_STEP(t, okeep0, t); else GLA_STEP(t, okeep1, t - 16); } }
#undef GLA_STEP
            ob[(p * 16 + col) * 2 + half] = okeep0; ob[((16 + p) * 16 + col) * 2 + half] = okeep1;
            if (b + 1 < nblk) GLA_STORE(nxt);
            __syncthreads();
            { const int t = tid >> 4, c = tid & 15; if (t < nt) { const f32x2 o2 = *(const LAS f32x2*)(ob + (t * 16 + c) * 2); O[(size_t)(r0 + tb0 + t) * 512 + h * 128 + cb * 16 + c] = o2.x + o2.y; } }
        }
#undef GLA_LOAD
#undef GLA_STORE
        { GAS float* so = P + ((size_t)pair * 64 + dk) * 128 + cb * 16 + col; so[0] = S0; so[128] = S1; }
        __syncthreads();
    }
}
__device__ __forceinline__ float grp8_sum(float v) { v += dppf<0xB1>(v); v += dppf<0x4E>(v); v += dppf<0x141>(v); return v; }
__device__ __forceinline__ float dot16_fp8_bf16(const u32x4 uw, const float (&x)[16]) { float s = 0.f;
#pragma unroll
    for (int d = 0; d < 4; ++d) { const f32x2 lo = fp8lo(uw[d]), hi = fp8hi(uw[d]); s = fmaf(lo.x, x[4 * d], s); s = fmaf(lo.y, x[4 * d + 1], s); s = fmaf(hi.x, x[4 * d + 2], s); s = fmaf(hi.y, x[4 * d + 3], s); }
    return s; }
__device__ __forceinline__ void pacts_phase(const GAS bf16_t* __restrict__ XB, const GAS unsigned char* __restrict__ U8S, const GAS int* __restrict__ EIDX, GAS float* __restrict__ PART, int M,
                                            int wid, int lane, int bid, int nb) {
    const bool spl = (nb & 7) == 0; const int s0 = spl ? (bid & 7) : 0, s1 = spl ? s0 + 1 : 8, r = spl ? (bid >> 3) : bid, nr = spl ? (nb >> 3) : nb;
    const int g = lane >> 3, ch = lane & 7, h = wid;
    constexpr int NB = 8;
    for (int s = s0; s < s1; ++s) {
        const GAS unsigned char* tb = U8S + (size_t)s * 16384 * 128 + ch * 16; GAS float* po = PART + (size_t)s * M * 128;
        int e0[NB], e1[NB], f0[NB], f1[NB];
#pragma unroll
        for (int q = 0; q < NB; ++q) { int row = r + nr * q; row = row < M ? row : r; e0[q] = EIDX[((size_t)row * 8 + h) * 16 + g]; e1[q] = EIDX[((size_t)row * 8 + h) * 16 + 8 + g]; }
        for (int row0 = r; row0 < M; row0 += nr * NB) {
#pragma unroll
            for (int q = 0; q < NB; ++q) { int row = row0 + nr * (NB + q); row = row < M ? row : r; f0[q] = EIDX[((size_t)row * 8 + h) * 16 + g]; f1[q] = EIDX[((size_t)row * 8 + h) * 16 + 8 + g]; }
            u32x4 u0[NB], u1[NB], xa[NB], xb[NB];
#pragma unroll
            for (int q = 0; q < NB; ++q) { int row = row0 + nr * q; row = row < M ? row : r; u0[q] = *(const GAS u32x4*)(tb + (size_t)e0[q] * 128); u1[q] = *(const GAS u32x4*)(tb + (size_t)e1[q] * 128);
                const GAS u32x4* xp = (const GAS u32x4*)(XB + (size_t)row * 1024 + s * 128 + ch * 16); xa[q] = xp[0]; xb[q] = xp[1]; }
#pragma unroll
            for (int q = 0; q < NB; ++q) { const int row = row0 + nr * q; float x[16];
#pragma unroll
                for (int i = 0; i < 4; ++i) { x[2 * i] = bflo(xa[q][i]); x[2 * i + 1] = bfhi(xa[q][i]); x[8 + 2 * i] = bflo(xb[q][i]); x[8 + 2 * i + 1] = bfhi(xb[q][i]); }
                float p0 = dot16_fp8_bf16(u0[q], x), p1 = dot16_fp8_bf16(u1[q], x);
                p0 = grp8_sum(p0); p1 = grp8_sum(p1);
                asm volatile("" : "+v"(p0), "+v"(p1));
                if (ch == 0 && row < M) { GAS float* d = po + ((size_t)row * 8 + h) * 16 + g; d[0] = p0; d[8] = p1; } }
#pragma unroll
            for (int q = 0; q < NB; ++q) { e0[q] = f0[q]; e1[q] = f1[q]; }
        }
    }
}
__device__ __forceinline__ void pouts_phase(const GAS float* __restrict__ COEF, const GAS int* __restrict__ EIDX, const GAS unsigned char* V8S, GAS float* __restrict__ YBUF, int M,
                                            int wid, int lane, int bid, int nb) {
    const bool spl = (nb & 7) == 0; const int s0 = spl ? (bid & 7) : 0, s1 = spl ? s0 + 1 : 8, r = spl ? (bid >> 3) : bid, nr = spl ? (nb >> 3) : nb;
    const int g = lane >> 3, ch = lane & 7, rstep = nr * 8;
#define PO_LOADCE(rw, c0, c1, v0, v1) do { c0 = COEF[(size_t)(rw) * 128 + lane] * (1.f / 64.f); c1 = COEF[(size_t)(rw) * 128 + 64 + lane] * (1.f / 64.f); v0 = EIDX[(size_t)(rw) * 128 + lane]; v1 = EIDX[(size_t)(rw) * 128 + 64 + lane]; } while (0)
#define PO_GATHER(vv_, vreg) do { _Pragma("unroll") for (int k = 0; k < 8; ++k) { const int e = __builtin_amdgcn_ds_bpermute((8 * k + g) << 2, vreg); vv_[k] = *(const GAS u32x4*)(tb + (size_t)(e & 16383) * 128); } } while (0)
#define PO_COMP(vv_, creg) do { _Pragma("unroll") for (int k = 0; k < 8; ++k) { const float c = __int_as_float(__builtin_amdgcn_ds_bpermute((8 * k + g) << 2, __float_as_int(creg))); const u32x4 w = vv_[k]; \
        _Pragma("unroll") for (int d = 0; d < 4; ++d) { const f32x2 lo = fp8lo(w[d]), hi = fp8hi(w[d]); acc[4 * d] = fmaf(c, lo.x, acc[4 * d]); acc[4 * d + 1] = fmaf(c, lo.y, acc[4 * d + 1]); acc[4 * d + 2] = fmaf(c, hi.x, acc[4 * d + 2]); acc[4 * d + 3] = fmaf(c, hi.y, acc[4 * d + 3]); } \
        _Pragma("unroll") for (int i = 0; i < 16; ++i) asm volatile("" : "+v"(acc[i])); } } while (0)
    for (int s = s0; s < s1; ++s) {
        const GAS unsigned char* tb = V8S + (size_t)s * 16384 * 128 + ch * 16;
        int row = r + nr * wid; if (row >= M) continue;
        float c0c, c1c, c0n = 0.f, c1n = 0.f; int v0c, v1c, v0n = 0, v1n = 0;
        PO_LOADCE(row, c0c, c1c, v0c, v1c);
        u32x4 va[8], vb[8];
        PO_GATHER(va, v0c);
        for (;;) {
            const int rown = row + rstep; const bool hasn = rown < M;
            PO_GATHER(vb, v1c);
            if (hasn) PO_LOADCE(rown, c0n, c1n, v0n, v1n);
            float acc[16];
#pragma unroll
            for (int i = 0; i < 16; ++i) acc[i] = 0.f;
            PO_COMP(va, c0c);
            if (hasn) PO_GATHER(va, v0n);
            PO_COMP(vb, c1c);
#pragma unroll
            for (int i = 0; i < 16; ++i) acc[i] += dppf<0x128>(acc[i]);
#pragma unroll
            for (int i = 0; i < 8; ++i) { const bool hi = lane & 16; const float send = hi ? acc[i] : acc[i + 8], keep = hi ? acc[i + 8] : acc[i]; acc[i] = keep + shx(send, 16, lane); }
#pragma unroll
            for (int i = 0; i < 4; ++i) { const bool hi = lane & 32; const float send = hi ? acc[i] : acc[i + 4], keep = hi ? acc[i + 4] : acc[i]; acc[i] = keep + shx(send, 32, lane); }
            if ((lane & 8) == 0) *(GAS f32x4*)(YBUF + (size_t)row * 1024 + s * 128 + ch * 16 + ((lane >> 4) & 1) * 8 + ((lane >> 5) & 1) * 4) = (f32x4){acc[0], acc[1], acc[2], acc[3]};
            if (!hasn) break;
            row = rown; c0c = c0n; c1c = c1n; v0c = v0n; v1c = v1n;
        }
    }
#undef PO_LOADCE
#undef PO_GATHER
#undef PO_COMP
}
}

template <class T> __device__ __forceinline__ __attribute__((address_space(1))) T* gp(T* p) { return (__attribute__((address_space(1))) T*)uni_ptr(p); }
constexpr int MK_THREADS = 512, LDS_BYTES = 163840, LDSCTL_OFF = 131072, TAB_OFF = LDSCTL_OFF + 1024, MAX_OPS = 208;
static_assert(TAB_OFF + MAX_OPS * (int)sizeof(Op) <= LDS_BYTES, "LDS map");
constexpr int MPAD = 17152;
constexpr size_t CTL_BYTES = (size_t)1 << 20;
struct MArgs { const float* in[47]; float* out; char* ws; unsigned long long ws_size; };
__global__ void __launch_bounds__(MK_THREADS, 2) mega_fwd(MArgs a) {
    extern __shared__ __attribute__((aligned(16))) unsigned char lds[];
    volatile LAS unsigned* ctl = (volatile LAS unsigned*)((LAS unsigned char*)lds + LDSCTL_OFF);
    if (threadIdx.x < 64) ctl[threadIdx.x] = 0u;
    __syncthreads();
    (void)xcd_barrier_post((unsigned*)a.ws, ctl + 8);
    const Dm dm = make_dm(1024, 8, 2048, 128, 4);
    Op* tab = (Op*)(lds + TAB_OFF);
    if (threadIdx.x == 0) {
        const float* const* inp_ = (const float* const*)__builtin_amdgcn_kernarg_segment_ptr(); asm volatile("" : "+s"(inp_));
        NvIO io; io.in = inp_; io.out = a.out; io.ws = a.ws + CTL_BYTES; io.ws_size = a.ws_size - CTL_BYTES;
        int n = 0;
        nv_forward(io, dm, [&](const Op& o) __attribute__((always_inline)) { if (n < MAX_OPS) tab[n] = o; ++n; asm volatile("" ::: "memory"); });
        ctl[16] = (unsigned)(n <= MAX_OPS ? n : 0);
    }
    __syncthreads();
    const int nops = (int)ctl[16];
    for (int i = 0; i < nops; ++i) {
        int tid_ = (int)threadIdx.x, bid_ = (int)blockIdx.x, nb_ = (int)gridDim.x;
        asm volatile("" : "+v"(tid_)); asm volatile("" : "+s"(bid_)); asm volatile("" : "+s"(nb_));
        const long long g0 = (long long)bid_ * MK_THREADS + tid_, gs = (long long)nb_ * MK_THREADS;
        const Op& o = tab[i];
        const int rawc = __builtin_amdgcn_readfirstlane(o.code); const int code = rawc & 0xff; const long long n = o.n;
        switch (code) {
        case OP_FGEMM: {
            const int fl = rfl(o.i6);
            pg8::Gemm g{uni_ptr((const pg8::bf16_t*)o.a), uni_ptr((const pg8::bf16_t*)o.b), MPAD, rfl(o.i5), rfl(o.i1), rfl(o.i2), rfl(o.i3)};
            if (rawc & OPF_GROUP) {
                int ng = 1; while (ng < 8 && (rfl(tab[i + ng - 1].code) & OPF_GROUP)) ++ng;
                const PG8_LAS Op* gt = (const PG8_LAS Op*)((PG8_LAS unsigned char*)lds + TAB_OFF) + i;
                pg8::GroupOrder S; S.tab = gt; S.ng = ng; S.nM = MPAD / 256; S.G = nb_; S.c = bid_; S.tsA = (size_t)256 * g.lda * 2; S.tsB = (size_t)256 * g.ldb * 2;
                pg8::EpiF32G E{gt, dm.M};
                pg8::gemm_phase<pg8::EpiF32G, pg8::GroupOrder, true, true>((PG8_LAS unsigned char*)lds, g, S, E);
                i += ng - 1;
            } else {
            pg8::StaticOrder S; S.init(g, nb_, bid_); if (fl & 2) S.acs = 512;
            if (fl & 1) { pg8::EpiBf16Plain E{uni_ptr((pg8::bf16_t*)o.o0), rfl(o.i4)}; pg8::gemm_phase<pg8::EpiBf16Plain, pg8::StaticOrder, true, true>((PG8_LAS unsigned char*)lds, g, S, E); }
            else { pg8::EpiF32 E{uni_ptr(o.o0), rfl(o.i4), dm.M, rfl(o.i0)}; pg8::gemm_phase<pg8::EpiF32, pg8::StaticOrder, true, true>((PG8_LAS unsigned char*)lds, g, S, E); }
            }
        } break;
        case OP_LRUG2: {
            pg8::Gemm g{uni_ptr((const pg8::bf16_t*)o.a), uni_ptr((const pg8::bf16_t*)o.b), MPAD, 1024, 512, 512, 512};
            pg8::StaticOrder S; S.init(g, nb_, bid_);
            pg8::EpiLru E{uni_ptr(o.c), uni_ptr(o.d), uni_ptr(o.e), uni_ptr(o.f), uni_ptr(o.o0), uni_ptr(o.o1), dm.M};
            pg8::gemm_phase<pg8::EpiLru, pg8::StaticOrder, true, true>((PG8_LAS unsigned char*)lds, g, S, E);
        } break;
        case OP_WKVP: fk::wkv2_phase(gp(o.a), gp(o.b), gp(o.c), gp(o.d), gp(o.e), gp(o.f), gp(o.g), gp(o.h), gp((const float*)o.o5), gp(o.o0), gp(o.o1), gp(o.o2), gp(o.o3), gp(o.o4), rfl(o.i0), dm.B, dm.T, dm.DB, dm.DT, (LAS unsigned char*)lds, tid_, bid_, nb_); break;
        case OP_POST2: fk::rwkvpost2_phase(gp(o.a), gp(o.b), gp(o.c), gp(o.d), gp(o.e), gp(o.f), gp((fk::bf16_t*)o.o0), dm.M * 16, tid_ & 63, bid_ * 8 + (tid_ >> 6), nb_ * 8); break;
        case OP_GLAF: fk::gla_phase(gp(o.a), gp(o.b), gp(o.o0), gp(o.o1), dm.B, dm.T, (LAS unsigned char*)lds, tid_, bid_, nb_); break;
        case OP_PACTS: fk::pacts_phase(gp((const fk::bf16_t*)o.a), gp((const unsigned char*)o.b), gp((const int*)o.d), gp(o.o0), dm.M, tid_ >> 6, tid_ & 63, bid_, nb_); break;
        case OP_POUTS: fk::pouts_phase(gp(o.a), gp((const int*)o.b), gp((const unsigned char*)o.c), gp(o.o0), dm.M, tid_ >> 6, tid_ & 63, bid_, nb_); break;
        case OP_TOPK2: fk::topk_phase(gp(o.a), gp((const fk::bf16_t*)o.b), gp(o.c), gp(o.o0), gp((int*)o.o1), dm.M * 8, (LAS unsigned char*)lds, tid_ >> 6, tid_ & 63, bid_ * 8 + (tid_ >> 6), nb_ * 8); break;
        case OP_LNRES: fk::lnres_phase(gp(o.a), gp(o.b), gp(o.c), gp(o.o0), gp((fk::bf16_t*)o.o1), dm.M, tid_ & 63, bid_ * 8 + (tid_ >> 6), nb_ * 8); break;
        case OP_GLANORM: fk::glanorm_phase(gp(o.a), gp(o.b), gp(o.c), gp((fk::bf16_t*)o.o0), dm.M * 4, tid_ & 63, bid_ * 8 + (tid_ >> 6), nb_ * 8); break;
#define NVC(c) case c: for (long long g = g0; g < n; g += gs) nv_elem(c, o, dm, g); break;
        NVC(OP_LOGA) NVC(OP_CONVOUT) NVC(OP_SHIFTOUT) NVC(OP_EMBED4) NVC(OP_YOUT4) NVC(OP_MIX6) NVC(OP_CONV4) NVC(OP_CVT8) NVC(OP_WGATE)
        NVC(OP_WT) NVC(OP_CVTTAB8S) NVC(OP_PRED) NVC(OP_PRM) NVC(OP_KEYS) NVC(OP_GLA3) NVC(OP_LRU1) NVC(OP_LRU2) NVC(OP_LRU3)
#undef NVC
        default: break;
        }
        if (__builtin_amdgcn_readfirstlane(tab[i].code) & OPF_NOBAR) __syncthreads(); else { XcdBarrier bar; bar.bar = (unsigned*)a.ws; bar.x = xb_xcc_id(); bar.st = ctl + 8; xcd_barrier(bar); }
    }
}
extern "C" void kernel_launch(void* const* d_in, const int* in_sizes, int n_in, void* d_out, int out_size, void* d_ws, size_t ws_size, hipStream_t stream) {
    static int grid = 0;
    if (grid == 0) {
        if (n_in != 47 || ws_size < ((size_t)900 << 20)) { fprintf(stderr, "kernel_launch: expected 47 inputs and >= 900 MiB of workspace; got %d, %zu\n", n_in, ws_size); grid = -1; return; }
        int dev = 0, cus = 0, per_cu = 0;
        if (hipGetDevice(&dev) != hipSuccess || hipDeviceGetAttribute(&cus, hipDeviceAttributeMultiprocessorCount, dev) != hipSuccess) { grid = -1; return; }
        if (hipFuncSetAttribute((const void*)mega_fwd, hipFuncAttributeMaxDynamicSharedMemorySize, LDS_BYTES) != hipSuccess) { fprintf(stderr, "kernel_launch: hipFuncSetAttribute failed\n"); grid = -1; return; }
        if (hipOccupancyMaxActiveBlocksPerMultiprocessor(&per_cu, (const void*)mega_fwd, MK_THREADS, LDS_BYTES) != hipSuccess || per_cu < 1) fprintf(stderr, "kernel_launch: occupancy query says %d per CU\n", per_cu);
        (void)hipGetLastError();
        grid = cus;
    }
    if (grid < 0) return;
    if (hipMemsetAsync(d_ws, 0, CTL_BYTES, stream) != hipSuccess) { fprintf(stderr, "kernel_launch: memset failed\n"); return; }
    MArgs a{}; for (int i = 0; i < 47; ++i) a.in[i] = (const float*)d_in[i]; a.out = (float*)d_out; a.ws = (char*)d_ws; a.ws_size = (unsigned long long)ws_size;
    hipLaunchKernelGGL(mega_fwd, dim3(grid), dim3(MK_THREADS), LDS_BYTES, stream, a);
}
```

```cpp
#include <hip/hip_runtime.h>
#include <cstdio>
#include <cmath>
#ifndef HD
#define HD __host__ __device__ __forceinline__
#endif
struct Dm { int D, B, T, DB, DT, M, NSEQ, RH; };
HD Dm make_dm(int D, int B, int SEQ, int DB, int DT) { Dm d; d.D = D; d.B = B; d.T = SEQ + 16; d.DB = DB; d.DT = DT; d.M = B * d.T + DB * DT; d.NSEQ = B + DB; d.RH = D / 64; return d; }
HD int seq_row0(const Dm& d, int s) { return s < d.B ? s * d.T : d.B * d.T + (s - d.B) * d.DT; }
HD int seq_len(const Dm& d, int s) { return s < d.B ? d.T : d.DT; }
HD void row_to_seq(const Dm& d, int row, int& s, int& t) { if (row < d.B * d.T) { s = row / d.T; t = row % d.T; } else { int r = row - d.B * d.T; s = d.B + r / d.DT; t = r % d.DT; } }

constexpr int MIXIN = 2576, C_Q = 0, C_K = 256, C_V = 512, C_GLR = 1024, C_R = 1040, C_XB = 1552, C_GB = 2064;

enum { OP_EMBED = 1, OP_GEMM, OP_LOGA, OP_GLA, OP_GLANORM, OP_CONV, OP_CONVOUT, OP_LRUG, OP_LRUSCAN, OP_LNRES, OP_MIX, OP_SHIFTOUT,
       OP_RWKVPREP, OP_WKV, OP_RWKVPOST, OP_QNORM, OP_SCORES, OP_TOPK, OP_PACT1, OP_PACT2, OP_POUT, OP_YOUT, OP_WT, OP_CVT, OP_FGEMM, OP_CVTTAB, OP_KEYS, OP_TOPK2, OP_PACT, OP_POUTLN, OP_GLA1, OP_GLA2, OP_GLA3, OP_LRU1, OP_LRU2, OP_LRU3, OP_EMBED4, OP_YOUT4, OP_MIX8, OP_CONV4, OP_CVT8, OP_WGATE, OP_LRUG2, OP_WKVF, OP_GLAF, OP_CVTTAB8, OP_CVTTAB8S, OP_PACTS, OP_PRED, OP_POUTS, OP_MIX6, OP_PRM, OP_WKVP, OP_POST2, OP_LOGA4 };

constexpr int OPF_NOBAR = 0x100, OPF_GROUP = 0x200;
struct Op {
    const float *a, *b, *c, *d, *e, *f, *g, *h;
    float *o0, *o1, *o2, *o3, *o4, *o5;
    long long n;
    int code, i0, i1, i2, i3, i4, i5, i6;
};

#if defined(__HIP_DEVICE_COMPILE__)
#define NV_UNI(x) __builtin_amdgcn_readfirstlane(x)
#define NV_LAUNDER(p) asm volatile("" : "+s"(p))
#define NV_FENCE() asm volatile("" ::: "memory")
#else
#define NV_FENCE() do {} while (0)
#define NV_UNI(x) (x)
#define NV_LAUNDER(p) do {} while (0)
#endif
typedef unsigned short nvbf;
HD nvbf nv_f2bf(float f) { unsigned u; __builtin_memcpy(&u, &f, 4); return (nvbf)((u + 0x7fffu + ((u >> 16) & 1u)) >> 16); }
HD float nv_bf2f(nvbf h) { unsigned u = (unsigned)h << 16; float f; __builtin_memcpy(&f, &u, 4); return f; }
HD unsigned nv_f2e4m3(float f) {
    unsigned u; __builtin_memcpy(&u, &f, 4); const unsigned sign = (u >> 24) & 0x80u; const float a = fabsf(f);
    if (!(a < 448.f)) return sign | 0x7Eu;
    if (a < 0.015625f) return sign | (unsigned)rintf(a * 512.f);
    unsigned au = u & 0x7fffffffu; au += 0x7ffffu + ((au >> 20) & 1u);
    const unsigned e = ((au >> 23) & 0xffu) - 120u, m = (au >> 20) & 7u; unsigned code = (e << 3) | m; if (code > 0x7Eu) code = 0x7Eu;
    return sign | code; }
HD float nv_e4m32f(unsigned c) { const unsigned e = (c >> 3) & 15u, m = c & 7u; const float v = e ? ldexpf(1.f + m * 0.125f, (int)e - 7) : m * 0.001953125f; return (c & 0x80u) ? -v : v; }
HD int nv_rup(int x, int m) { return (x + m - 1) / m * m; }
struct alignas(16) NvF4 { float x, y, z, w; };
struct alignas(16) NvU4 { unsigned x, y, z, w; };
struct alignas(8) NvU2 { unsigned x, y; };
HD float nv_sigmoid(float x) { return 1.f / (1.f + expf(-x)); }
HD float nv_softplus(float x) { return fmaxf(x, 0.f) + log1pf(expf(-fabsf(x))); }
HD float nv_gelu(float x) { return 0.5f * x * (1.f + tanhf(0.7978845608028654f * (x + 0.044715f * x * x * x))); }

#define NV_INS16(tv, ti, val, idx) do { float _v = (val); int _i = (idx); _Pragma("unroll") for (int _j = 0; _j < 16; ++_j) { if (_v > tv[_j]) { float _tv = tv[_j]; int _ti = ti[_j]; tv[_j] = _v; ti[_j] = _i; _v = _tv; _i = _ti; } } } while (0)

HD void nv_elem(const int code, const Op& p, const Dm& dm, long long gid) {
    const int D = dm.D; float* const PO1 = p.o1; float* const PO2 = p.o2;
    switch (code) {
    case OP_EMBED: {
        int row = (int)(gid / D), c = (int)(gid % D); float v;
        if (row < dm.B * dm.T) { int bb = row / dm.T, t = row % dm.T; v = t < 16 ? p.c[t * D + c] : p.a[((size_t)bb * (dm.T - 16) + (t - 16)) * D + c]; }
        else v = p.b[(size_t)(row - dm.B * dm.T) * D + c];
        p.o0[gid] = v; ((nvbf*)p.o1)[gid] = nv_f2bf(v); } break;
    case OP_GEMM: {
        int N4 = p.i0 >> 2, K = p.i1; int m = (int)(gid / N4), nn = (int)(gid % N4) * 4; const float* A = p.a + (size_t)m * p.i2; const float* Bw = p.b + nn; float c0 = 0.f, c1 = 0.f, c2 = 0.f, c3 = 0.f;
        for (int k = 0; k < K; ++k) { float av = A[k]; if (p.i5 == 1) av = tanhf(av); else if (p.i5 == 2) av = nv_sigmoid(av); const NvF4 bv = *(const NvF4*)(Bw + (size_t)k * p.i3);
            c0 = fmaf(av, bv.x, c0); c1 = fmaf(av, bv.y, c1); c2 = fmaf(av, bv.z, c2); c3 = fmaf(av, bv.w, c3); }
        float* C = p.o0 + (size_t)m * p.i4 + nn; C[0] = c0; C[1] = c1; C[2] = c2; C[3] = c3; } break;
    case OP_LOGA: {
        int row = (int)(gid / 256), c = (int)(gid % 256); float z = p.c[c];
        for (int r = 0; r < 16; ++r) z = fmaf(p.a[(size_t)row * MIXIN + C_GLR + r], p.b[r * 256 + c], z);
        p.o0[gid] = expf(-nv_softplus(-z) * (1.f / 16.f)); } break;
    case OP_GLAF:
    case OP_GLA: {
        int s = (int)(gid / 512), h = (int)((gid / 128) % 4), col = (int)(gid % 128);
        float S[64];
        const float* sin = (s < dm.B) ? nullptr : p.c + (((size_t)(s - dm.B) * 4 + h) * 64) * 128 + col;
#pragma unroll
        for (int k = 0; k < 64; ++k) S[k] = sin ? sin[(size_t)k * 128] : 0.f;
        int r0 = seq_row0(dm, s), L = seq_len(dm, s);
        for (int t = 0; t < L; ++t) {
            const float* pr = p.a + (size_t)(r0 + t) * MIXIN; const float* la = p.b + (size_t)(r0 + t) * 256 + h * 64;
            float v = pr[C_V + h * 128 + col], o = 0.f;
#pragma unroll
            for (int k = 0; k < 64; ++k) { if ((k & 7) == 0) NV_FENCE(); S[k] = fmaf(la[k], S[k], pr[C_K + h * 64 + k] * v); o = fmaf(pr[C_Q + h * 64 + k] * 0.125f, S[k], o); }
            p.o0[(size_t)(r0 + t) * 512 + h * 128 + col] = o;
        }
        float* so = (s < dm.B) ? PO1 + (((size_t)s * 4 + h) * 64) * 128 + col : PO2 + (((size_t)(s - dm.B) * 4 + h) * 64) * 128 + col;
#pragma unroll
        for (int k = 0; k < 64; ++k) so[(size_t)k * 128] = S[k]; } break;
    case OP_GLA1: {
        const int NC = p.i0; const int u = NV_UNI((int)(gid / 128)), col = (int)(gid % 128); const int s = u / (4 * NC), h = (u / NC) % 4, c = u % NC;
        const int r0 = seq_row0(dm, s) + c * 64; int L = dm.T - c * 64; L = L > 64 ? 64 : L;
        float S[64];
#pragma unroll
        for (int k = 0; k < 64; ++k) S[k] = 0.f;
        float dprod = 1.f;
        for (int t = 0; t < L; ++t) {
            const float* pr = p.a + (size_t)(r0 + t) * MIXIN; const float* la = p.b + (size_t)(r0 + t) * 256 + h * 64; const float v = pr[C_V + h * 128 + col];
            if (col < 64) dprod *= la[col];
#pragma unroll
            for (int k = 0; k < 64; ++k) { if ((k & 7) == 0) NV_FENCE(); S[k] = fmaf(la[k], S[k], pr[C_K + h * 64 + k] * v); }
        }
        float* so = p.o0 + (size_t)u * 8192 + col;
#pragma unroll
        for (int k = 0; k < 64; ++k) so[(size_t)k * 128] = S[k];
        if (col < 64) p.o1[(size_t)u * 64 + col] = dprod; } break;
    case OP_GLA2: {
        const int NC = p.i0; const int pair = (int)(gid / 8192), e = (int)(gid % 8192), dk = e / 128; float S = 0.f;
        for (int c = 0; c < NC; ++c) { const size_t ix = ((size_t)pair * NC + c) * 8192 + e; const float l = p.o0[ix]; p.o0[ix] = S; S = fmaf(p.a[((size_t)pair * NC + c) * 64 + dk], S, l); }
        p.o1[gid] = S; } break;
    case OP_GLA3: {
        const int NC = p.i0; const int NP = dm.B * 4 * NC; const int u = NV_UNI((int)(gid / 128)) + (p.i1 ? NP : 0), col = (int)(gid % 128); int s, h, r0, L; const float* sin; float* sout = nullptr;
        if (u < NP) { s = u / (4 * NC); h = (u / NC) % 4; const int c = u % NC; r0 = seq_row0(dm, s) + c * 64; L = dm.T - c * 64; L = L > 64 ? 64 : L; sin = p.d + (size_t)u * 8192 + col; }
        else { const int q = u - NP; s = dm.B + q / 4; h = q % 4; r0 = seq_row0(dm, s); L = dm.DT; sin = p.c + (((size_t)(s - dm.B) * 4 + h) * 64) * 128 + col; sout = p.o2 + (((size_t)(s - dm.B) * 4 + h) * 64) * 128 + col; }
        float S[64];
#pragma unroll
        for (int k = 0; k < 64; ++k) S[k] = sin[(size_t)k * 128];
        for (int t = 0; t < L; ++t) {
            const float* pr = p.a + (size_t)(r0 + t) * MIXIN; const float* la = p.b + (size_t)(r0 + t) * 256 + h * 64; const float v = pr[C_V + h * 128 + col]; float o = 0.f;
#pragma unroll
            for (int k = 0; k < 64; ++k) { if ((k & 7) == 0) NV_FENCE(); S[k] = fmaf(la[k], S[k], pr[C_K + h * 64 + k] * v); o = fmaf(pr[C_Q + h * 64 + k] * 0.125f, S[k], o); }
            p.o0[(size_t)(r0 + t) * 512 + h * 128 + col] = o;
        }
        if (sout) {
#pragma unroll
            for (int k = 0; k < 64; ++k) sout[(size_t)k * 128] = S[k]; } } break;
    case OP_LRU1: {
        const int NC = p.i0; const int u = (int)(gid / 512), c = (int)(gid % 512); const int s = u / NC, ch = u % NC; const int r0 = seq_row0(dm, s) + ch * 64; int L = dm.T - ch * 64; L = L > 64 ? 64 : L; float hh = 0.f, ap = 1.f;
#pragma unroll 8
        for (int t = 0; t < L; ++t) { const size_t ix = (size_t)(r0 + t) * 512 + c; const float a = p.a[ix]; hh = fmaf(a, hh, p.b[ix]); ap *= a; }
        p.o0[gid] = ap; p.o1[gid] = hh; } break;
    case OP_LRU2: {
        const int NC = p.i0; const int s = (int)(gid / 512), c = (int)(gid % 512); float hh = 0.f;
#pragma unroll 8
        for (int ch = 0; ch < NC; ++ch) { const size_t ix = ((size_t)s * NC + ch) * 512 + c; const float l = p.o0[ix]; p.o0[ix] = hh; hh = fmaf(p.a[ix], hh, l); }
        p.o1[gid] = hh; } break;
    case OP_LRU3: {
        const int NC = p.i0; const int u = (int)(gid / 512), c = (int)(gid % 512); const int NP = dm.B * NC; int r0, L; float hh; float* hout = nullptr;
        if (u < NP) { const int s = u / NC, ch = u % NC; r0 = seq_row0(dm, s) + ch * 64; L = dm.T - ch * 64; L = L > 64 ? 64 : L; hh = p.e[gid]; }
        else { const int q = u - NP; r0 = seq_row0(dm, dm.B + q); L = dm.DT; hh = p.d[(size_t)q * 512 + c]; hout = p.o2 + (size_t)q * 512 + c; }
#pragma unroll 8
        for (int t = 0; t < L; ++t) { const size_t r = (size_t)(r0 + t); hh = fmaf(p.a[r * 512 + c], hh, p.b[r * 512 + c]); ((nvbf*)p.o0)[r * 1024 + 512 + c] = nv_f2bf(hh * nv_gelu(p.c[r * MIXIN + C_GB + c])); }
        if (hout) *hout = hh; } break;
    case OP_EMBED4: {
        const int D4 = D / 4; const int row = (int)(gid / D4), c = (int)(gid % D4) * 4; const float* src;
        if (row < dm.B * dm.T) { const int bb = row / dm.T, t = row % dm.T; src = t < 16 ? p.c + (size_t)t * D + c : p.a + ((size_t)bb * (dm.T - 16) + (t - 16)) * D + c; } else src = p.b + (size_t)(row - dm.B * dm.T) * D + c;
        const NvF4 v = *(const NvF4*)src; *(NvF4*)(p.o0 + (size_t)row * D + c) = v; NvU2 w; w.x = nv_f2bf(v.x) | ((unsigned)nv_f2bf(v.y) << 16); w.y = nv_f2bf(v.z) | ((unsigned)nv_f2bf(v.w) << 16); *(NvU2*)((nvbf*)p.o1 + (size_t)row * D + c) = w; } break;
    case OP_YOUT4: {
        const int D4 = D / 4; const int row = (int)(gid / D4), c = (int)(gid % D4) * 4; const NvF4 v = *(const NvF4*)(p.a + (size_t)row * D + c);
        if (row < dm.B * dm.T) { const int bb = row / dm.T, t = row % dm.T; if (t >= 16) *(NvF4*)(p.o0 + ((size_t)bb * (dm.T - 16) + (t - 16)) * D + c) = v; }
        else *(NvF4*)(p.o0 + ((size_t)dm.B * (dm.T - 16) + (row - dm.B * dm.T)) * D + c) = v; } break;
    case OP_MIX8: {
        const int D8 = D / 8; const int row = (int)(gid / D8), c = (int)(gid % D8) * 8; int s, t; row_to_seq(dm, row, s, t); const float* x = p.a + (size_t)row * D + c; float xp[8];
        if (t > 0) { for (int i = 0; i < 8; ++i) xp[i] = x[i - D]; } else if (s < dm.B) { for (int i = 0; i < 8; ++i) xp[i] = 0.f; } else { for (int i = 0; i < 8; ++i) xp[i] = p.b[(size_t)(s - dm.B) * D + c + i]; }
        unsigned w[4];
#pragma unroll
        for (int i = 0; i < 4; ++i) { const float lo = x[2 * i] + (xp[2 * i] - x[2 * i]) * p.c[c + 2 * i], hi = x[2 * i + 1] + (xp[2 * i + 1] - x[2 * i + 1]) * p.c[c + 2 * i + 1]; w[i] = nv_f2bf(lo) | ((unsigned)nv_f2bf(hi) << 16); }
        NvU4 o; o.x = w[0]; o.y = w[1]; o.z = w[2]; o.w = w[3]; *(NvU4*)((nvbf*)p.o0 + (size_t)row * D + c) = o; } break;
    case OP_MIX6: {
        const int D8 = D / 8; const int row = (int)(gid / D8), c = (int)(gid % D8) * 8; int s, t; row_to_seq(dm, row, s, t); const float* x = p.a + (size_t)row * D + c; float xv[8], dx[8];
        for (int i = 0; i < 8; ++i) xv[i] = x[i];
        if (t > 0) { for (int i = 0; i < 8; ++i) dx[i] = x[i - D] - xv[i]; } else if (s < dm.B) { for (int i = 0; i < 8; ++i) dx[i] = -xv[i]; } else { for (int i = 0; i < 8; ++i) dx[i] = p.b[(size_t)(s - dm.B) * D + c + i] - xv[i]; }
        for (int m = 0; m < 6; ++m) { const float* mu = p.c + (size_t)m * D + c; unsigned w[4];
#pragma unroll
            for (int i = 0; i < 4; ++i) w[i] = nv_f2bf(xv[2 * i] + dx[2 * i] * mu[2 * i]) | ((unsigned)nv_f2bf(xv[2 * i + 1] + dx[2 * i + 1] * mu[2 * i + 1]) << 16);
            NvU4 o; o.x = w[0]; o.y = w[1]; o.z = w[2]; o.w = w[3]; *(NvU4*)((nvbf*)p.o0 + (size_t)m * p.i0 * 0 + (size_t)m * (size_t)p.i1 * 1024 + (size_t)row * D + c) = o; } } break;
    case OP_CONV4: {
        const int row = (int)(gid / 128), c = (int)(gid % 128) * 4; int s, t; row_to_seq(dm, row, s, t); float acc[4];
        for (int q = 0; q < 4; ++q) acc[q] = p.d[c + q];
        for (int i = 0; i < 4; ++i) { const int j = t + i; const float* xv = nullptr;
            if (j < 3) { if (s >= dm.B) xv = p.b + ((size_t)(s - dm.B) * 3 + j) * 512 + c; } else xv = p.a + (size_t)(row - t + (j - 3)) * MIXIN + C_XB + c;
            if (xv) for (int q = 0; q < 4; ++q) acc[q] = fmaf(xv[q], p.c[i * 512 + c + q], acc[q]); }
        NvF4 o; o.x = acc[0]; o.y = acc[1]; o.z = acc[2]; o.w = acc[3]; *(NvF4*)(p.o0 + (size_t)row * 512 + c) = o;
        NvU2 w; w.x = nv_f2bf(acc[0]) | ((unsigned)nv_f2bf(acc[1]) << 16); w.y = nv_f2bf(acc[2]) | ((unsigned)nv_f2bf(acc[3]) << 16); *(NvU2*)((nvbf*)p.o1 + (size_t)row * 512 + c) = w; } break;
    case OP_CVT8: {
        const int K8 = p.i2 / 8; const int row = (int)(gid / K8), k = (int)(gid % K8) * 8; unsigned w[4] = {0u, 0u, 0u, 0u};
        if (row < dm.M && k < p.i0) { const float* sp = p.a + (size_t)row * p.i1 + k;
#pragma unroll
            for (int i = 0; i < 4; ++i) { float lo = sp[2 * i], hi = sp[2 * i + 1]; if (p.i3 == 1) { lo = tanhf(lo); hi = tanhf(hi); } else if (p.i3 == 2) { lo = nv_sigmoid(lo); hi = nv_sigmoid(hi); } w[i] = nv_f2bf(lo) | ((unsigned)nv_f2bf(hi) << 16); } }
        NvU4 o; o.x = w[0]; o.y = w[1]; o.z = w[2]; o.w = w[3]; *(NvU4*)((nvbf*)p.o0 + (size_t)row * p.i2 + k) = o; } break;
    case OP_WGATE: {
        const int n = (int)gid, pn = n >> 8, within = n & 127, isx = (n >> 7) & 1, c = pn * 128 + within, nb = c >> 6, e = c & 63; const float* w = isx ? p.b : p.a; nvbf* dst = (nvbf*)p.o0 + (size_t)n * 512;
        for (int k = 0; k < 512; ++k) dst[k] = ((k >> 6) == nb) ? nv_f2bf(w[((size_t)nb * 64 + (k & 63)) * 64 + e]) : (nvbf)0;
        if (n < 512) p.o1[n] = -8.f * nv_softplus(-p.c[n]); } break;
    case OP_LRUG2: {
        const int row = (int)(gid / 512), c = (int)(gid % 512), pn = c >> 7, within = c & 127; const nvbf* x = (const nvbf*)p.a + (size_t)row * 512; const nvbf* wa_ = (const nvbf*)p.b + (size_t)(pn * 256 + within) * 512; const nvbf* wx_ = wa_ + (size_t)128 * 512; float ga = 0.f, gx = 0.f;
        for (int k = 0; k < 512; ++k) { const float xv = nv_bf2f(x[k]); ga = fmaf(xv, nv_bf2f(wa_[k]), ga); gx = fmaf(xv, nv_bf2f(wx_[k]), gx); }
        const float gate_a = nv_sigmoid(ga + p.c[c]), gate_x = nv_sigmoid(gx + p.d[c]); const float log_at = gate_a * p.e[c];
        p.o0[gid] = expf(log_at); p.o1[gid] = sqrtf(-expm1f(2.f * log_at)) * (gate_x * p.f[gid]); } break;
    case OP_LOGA4: {
        const int row = (int)(gid / 64), c = (int)(gid % 64) * 4; const float* gl = p.a + (size_t)row * MIXIN + C_GLR; NvF4 z = *(const NvF4*)(p.c + c);
#pragma unroll
        for (int r4 = 0; r4 < 4; ++r4) { const NvF4 g = *(const NvF4*)(gl + 4 * r4);
            const NvF4 w0 = *(const NvF4*)(p.b + (4 * r4 + 0) * 256 + c), w1 = *(const NvF4*)(p.b + (4 * r4 + 1) * 256 + c), w2 = *(const NvF4*)(p.b + (4 * r4 + 2) * 256 + c), w3 = *(const NvF4*)(p.b + (4 * r4 + 3) * 256 + c);
            z.x = fmaf(g.x, w0.x, z.x); z.y = fmaf(g.x, w0.y, z.y); z.z = fmaf(g.x, w0.z, z.z); z.w = fmaf(g.x, w0.w, z.w); z.x = fmaf(g.y, w1.x, z.x); z.y = fmaf(g.y, w1.y, z.y); z.z = fmaf(g.y, w1.z, z.z); z.w = fmaf(g.y, w1.w, z.w);
            z.x = fmaf(g.z, w2.x, z.x); z.y = fmaf(g.z, w2.y, z.y); z.z = fmaf(g.z, w2.z, z.z); z.w = fmaf(g.z, w2.w, z.w); z.x = fmaf(g.w, w3.x, z.x); z.y = fmaf(g.w, w3.y, z.y); z.z = fmaf(g.w, w3.z, z.z); z.w = fmaf(g.w, w3.w, z.w); }
        NvF4 o; o.x = expf(-nv_softplus(-z.x) * (1.f / 16.f)); o.y = expf(-nv_softplus(-z.y) * (1.f / 16.f)); o.z = expf(-nv_softplus(-z.z) * (1.f / 16.f)); o.w = expf(-nv_softplus(-z.w) * (1.f / 16.f));
        *(NvF4*)(p.o0 + (size_t)row * 256 + c) = o; } break;
    case OP_GLANORM: {
        int row = (int)(gid / 4), h = (int)(gid % 4); const float* o = p.a + (size_t)row * 512 + h * 128; float ss = 0.f;
        for (int c = 0; c < 128; ++c) ss = fmaf(o[c], o[c], ss);
        float rs = 1.f / sqrtf(ss * (1.f / 128.f) + 1e-5f);
        for (int c = 0; c < 128; ++c) { float r = p.b[(size_t)row * MIXIN + C_R + h * 128 + c]; ((nvbf*)p.o0)[(size_t)row * 1024 + h * 128 + c] = nv_f2bf(o[c] * rs * p.c[c] * (r * nv_sigmoid(r))); } } break;
    case OP_CONV: {
        int row = (int)(gid / 512), c = (int)(gid % 512); int s, t; row_to_seq(dm, row, s, t); float acc = p.d[c];
        for (int i = 0; i < 4; ++i) { int j = t + i; float xv;
            if (j < 3) xv = (s < dm.B) ? 0.f : p.b[((size_t)(s - dm.B) * 3 + j) * 512 + c]; else xv = p.a[(size_t)(row - t + (j - 3)) * MIXIN + C_XB + c];
            acc = fmaf(xv, p.c[i * 512 + c], acc); }
        p.o0[gid] = acc; } break;
    case OP_CONVOUT: {
        int s = (int)(gid / 1536), i = (int)((gid / 512) % 3), c = (int)(gid % 512); int L = seq_len(dm, s), r0 = seq_row0(dm, s); int j = L + i; float xv;
        if (j < 3) xv = (s < dm.B) ? 0.f : p.b[((size_t)(s - dm.B) * 3 + j) * 512 + c]; else xv = p.a[(size_t)(r0 + j - 3) * MIXIN + C_XB + c];
        float* o = (s < dm.B) ? PO1 + ((size_t)s * 3 + i) * 512 + c : PO2 + ((size_t)(s - dm.B) * 3 + i) * 512 + c; *o = xv; } break;
    case OP_LRUG: {
        int row = (int)(gid / 512), c = (int)(gid % 512), nb = c / 64, e = c % 64; const float* x = p.a + (size_t)row * 512 + nb * 64; float ga = p.c[c], gx = p.e[c];
        for (int dd = 0; dd < 64; ++dd) { ga = fmaf(x[dd], p.b[((size_t)nb * 64 + dd) * 64 + e], ga); gx = fmaf(x[dd], p.d[((size_t)nb * 64 + dd) * 64 + e], gx); }
        float gate_a = nv_sigmoid(ga), gate_x = nv_sigmoid(gx); float log_at = -8.f * gate_a * nv_softplus(-p.f[c]);
        p.o0[gid] = expf(log_at); p.o1[gid] = sqrtf(-expm1f(2.f * log_at)) * (gate_x * p.a[(size_t)row * 512 + c]); } break;
    case OP_LRUSCAN: {
        int s = (int)(gid / 512), c = (int)(gid % 512); int r0 = seq_row0(dm, s), L = seq_len(dm, s); float hh = (s < dm.B) ? 0.f : p.d[(size_t)(s - dm.B) * 512 + c];
        for (int t = 0; t < L; ++t) { size_t r = (size_t)(r0 + t); hh = fmaf(p.a[r * 512 + c], hh, p.b[r * 512 + c]); p.o0[r * 1024 + 512 + c] = hh * nv_gelu(p.c[r * MIXIN + C_GB + c]); }
        float* o = (s < dm.B) ? PO1 + (size_t)s * 512 + c : PO2 + (size_t)(s - dm.B) * 512 + c; *o = hh; } break;
    case OP_LNRES: {
        const float alpha = 1.6817928305074292f; float* x = p.o0 + (size_t)gid * D; const nvbf* y = (const nvbf*)p.a + (size_t)gid * D; float mu = 0.f;
        for (int c = 0; c < D; ++c) mu += alpha * x[c] + nv_bf2f(y[c]);
        mu /= D; float var = 0.f;
        for (int c = 0; c < D; ++c) { float v = alpha * x[c] + nv_bf2f(y[c]) - mu; var = fmaf(v, v, var); }
        float rs = 1.f / sqrtf(var / D + 1e-5f);
        for (int c = 0; c < D; ++c) { const float o = (alpha * x[c] + nv_bf2f(y[c]) - mu) * rs * p.b[c] + p.c[c]; x[c] = o; ((nvbf*)p.o1)[(size_t)gid * D + c] = nv_f2bf(o); } } break;
    case OP_MIX: {
        int row = (int)(gid / D), c = (int)(gid % D); int s, t; row_to_seq(dm, row, s, t); float x = p.a[gid];
        float xp = t > 0 ? p.a[gid - D] : ((s < dm.B) ? 0.f : p.b[(size_t)(s - dm.B) * D + c]);
        ((nvbf*)p.o0)[gid] = nv_f2bf(x + (xp - x) * p.c[c]); } break;
    case OP_SHIFTOUT: {
        int s = (int)(gid / D), c = (int)(gid % D); float v = p.a[(size_t)(seq_row0(dm, s) + seq_len(dm, s) - 1) * D + c];
        float* o = (s < dm.B) ? PO1 + (size_t)s * D + c : PO2 + (size_t)(s - dm.B) * D + c; *o = v; } break;
    case OP_RWKVPREP: {
        int row = (int)(gid / dm.RH), h = (int)(gid % dm.RH); size_t base = (size_t)row * D + h * 64; float ss = 0.f;
        for (int k = 0; k < 64; ++k) { float kv = p.o0[base + k] * p.d[h * 64 + k]; ss = fmaf(kv, kv, ss); }
        float inv = 1.f / fmaxf(sqrtf(ss), 1e-12f);
        for (int k = 0; k < 64; ++k) { int c = h * 64 + k; size_t ix = base + k;
            float w = -nv_softplus(-(p.a[c] + p.o1[ix])) - 0.5f; float dec = expf(-expf(w));
            float a = nv_sigmoid(p.b[c] + p.o2[ix]);
            float v = p.o3[ix]; if (p.i0) v = v + (p.o5[ix] - v) * nv_sigmoid(p.c[c] + p.f[ix]); else p.o5[ix] = v;
            float k0 = p.o0[ix]; const float kk = k0 * p.d[c] * inv; p.o4[ix] = -kk; p.o0[ix] = k0 * (1.f + (a - 1.f) * p.e[c]); p.o1[ix] = dec; p.o2[ix] = kk * a; p.o3[ix] = v; } } break;
    case OP_WKVF:
    case OP_WKV: {
        int RH = dm.RH; int s = p.i0 + (int)(gid / (RH * 64)), h = (int)((gid / 64) % RH), vr = (int)(gid % 64); float S[64];
        const float* sin = (s < dm.B) ? nullptr : p.g + (((size_t)(s - dm.B) * RH + h) * 64 + vr) * 64;
#pragma unroll
        for (int k = 0; k < 64; ++k) S[k] = sin ? sin[k] : 0.f;
        int r0 = seq_row0(dm, s), L = seq_len(dm, s);
        for (int t = 0; t < L; ++t) { size_t base = (size_t)(r0 + t) * D + h * 64; float sa = 0.f;
#pragma unroll
            for (int k = 0; k < 64; ++k) { if ((k & 7) == 0) NV_FENCE(); sa = fmaf(S[k], p.f[base + k], sa); }
            float vv = p.d[base + vr], y = 0.f;
#pragma unroll
            for (int k = 0; k < 64; ++k) { if ((k & 7) == 0) NV_FENCE(); S[k] = fmaf(S[k], p.b[base + k], fmaf(sa, p.e[base + k], vv * p.c[base + k])); y = fmaf(S[k], p.a[base + k], y); }
            p.o0[base + vr] = y; }
        float* so = (s < dm.B) ? PO1 + (((size_t)s * RH + h) * 64 + vr) * 64 : PO2 + (((size_t)(s - dm.B) * RH + h) * 64 + vr) * 64;
#pragma unroll
        for (int k = 0; k < 64; ++k) so[k] = S[k]; } break;
    case OP_RWKVPOST: {
        int row = (int)(gid / dm.RH), h = (int)(gid % dm.RH); size_t base = (size_t)row * D + h * 64; float mu = 0.f, bon = 0.f;
        for (int k = 0; k < 64; ++k) { mu += p.a[base + k]; bon = fmaf(p.b[base + k] * p.c[base + k], p.f[h * 64 + k], bon); }
        mu *= (1.f / 64.f); float var = 0.f;
        for (int k = 0; k < 64; ++k) { float dlt = p.a[base + k] - mu; var = fmaf(dlt, dlt, var); }
        float rs = 1.f / sqrtf(var * (1.f / 64.f) + 64e-5f);
        for (int k = 0; k < 64; ++k) { int c = h * 64 + k; float y = (p.a[base + k] - mu) * rs * p.g[c] + p.h[c] + bon * p.d[base + k]; ((nvbf*)p.o0)[base + k] = nv_f2bf(y * p.e[base + k]); } } break;
    case OP_PRM: {
        const int m = (int)(gid / D), c = (int)(gid % D); const float* src = m == 0 ? p.a : m == 1 ? p.b : m == 2 ? p.c : m == 3 ? p.d : m == 4 ? p.e : p.f; p.o0[gid] = src ? src[c] : 0.f; } break;
    case OP_WKVP: {
        const int RH = dm.RH; const int s = (int)(gid / (RH * 64)), h = (int)((gid / 64) % RH), vr = (int)(gid % 64); float S[64];
        const float* sin = (s < dm.B) ? nullptr : p.o5 + (((size_t)(s - dm.B) * RH + h) * 64 + vr) * 64;
        for (int k = 0; k < 64; ++k) S[k] = sin ? sin[k] : 0.f;
        const float* w0 = p.h + h * 64; const float* a0 = p.h + D + h * 64; const float* v0 = p.h + 2 * D + h * 64; const float* k_k = p.h + 3 * D + h * 64; const float* k_a = p.h + 4 * D + h * 64; const float* r_k = p.h + 5 * D + h * 64;
        const int r0 = seq_row0(dm, s), L = seq_len(dm, s);
        for (int t = 0; t < L; ++t) { const size_t base = (size_t)(r0 + t) * D + h * 64; float ss = 0.f;
            for (int k = 0; k < 64; ++k) { const float kv = p.b[base + k] * k_k[k]; ss = fmaf(kv, kv, ss); }
            const float inv = 1.f / fmaxf(sqrtf(ss), 1e-12f);
            float vv = p.e[base + vr]; if (p.i0) vv = vv + (p.g[base + vr] - vv) * nv_sigmoid(v0[vr] + p.f[base + vr]);
            float sa = 0.f, bon = 0.f, dec[64], bb[64], k2[64];
            for (int k = 0; k < 64; ++k) { const float k0 = p.b[base + k]; const float kk = k0 * k_k[k] * inv; const float a = nv_sigmoid(a0[k] + p.d[base + k]);
                dec[k] = expf(-0.6065306597126334f * nv_sigmoid(w0[k] + p.c[base + k]));
                bb[k] = kk * a; k2[k] = k0 * (1.f + (a - 1.f) * k_a[k]); sa = fmaf(S[k], -kk, sa); bon = fmaf(p.a[base + k] * k2[k], r_k[k], bon); }
            float y = 0.f;
            for (int k = 0; k < 64; ++k) { S[k] = fmaf(S[k], dec[k], fmaf(sa, bb[k], vv * k2[k])); y = fmaf(S[k], p.a[base + k], y); }
            p.o0[base + vr] = y; p.o3[base + vr] = vv; if (vr == 0) p.o4[(size_t)(r0 + t) * RH + h] = bon; }
        float* so = (s < dm.B) ? PO1 + (((size_t)s * RH + h) * 64 + vr) * 64 : PO2 + (((size_t)(s - dm.B) * RH + h) * 64 + vr) * 64;
        for (int k = 0; k < 64; ++k) so[k] = S[k]; } break;
    case OP_POST2: {
        const int row = (int)(gid / dm.RH), h = (int)(gid % dm.RH); const size_t base = (size_t)row * D + h * 64; float mu = 0.f;
        for (int k = 0; k < 64; ++k) mu += p.a[base + k];
        mu *= (1.f / 64.f); float var = 0.f;
        for (int k = 0; k < 64; ++k) { const float dlt = p.a[base + k] - mu; var = fmaf(dlt, dlt, var); }
        const float rs = 1.f / sqrtf(var * (1.f / 64.f) + 64e-5f), bon = p.d[gid];
        for (int k = 0; k < 64; ++k) { const int c = h * 64 + k; const float y = (p.a[base + k] - mu) * rs * p.e[c] + p.f[c] + bon * p.c[base + k]; ((nvbf*)p.o0)[base + k] = nv_f2bf(y * p.b[base + k]); } } break;
    case OP_QNORM: {
        float* q = p.o0 + (size_t)gid * 256; float mu = 0.f;
        for (int c = 0; c < 256; ++c) mu += q[c];
        mu *= (1.f / 256.f); float var = 0.f;
        for (int c = 0; c < 256; ++c) { float dlt = q[c] - mu; var = fmaf(dlt, dlt, var); }
        float rs = 1.f / sqrtf(var * (1.f / 256.f) + 1e-5f);
        for (int c = 0; c < 256; ++c) q[c] = (q[c] - mu) * rs; } break;
    case OP_SCORES: {
        int row = (int)(gid / 2048), r = (int)(gid % 2048), h = r / 256, half = (r / 128) & 1, key = r % 128;
        const float* q = p.a + (size_t)row * 2048 + h * 256 + half * 128; const float* kv = p.b + (((size_t)h * 2 + half) * 128 + key) * 128; float acc = 0.f;
        for (int dd = 0; dd < 128; ++dd) acc = fmaf(q[dd], kv[dd], acc);
        p.o0[gid] = acc; } break;
    case OP_TOPK: {
        const float* sc = p.a + (size_t)gid * 256; float tv[16]; int ti[16]; float* tmpv = p.o2 + (size_t)gid * 32; int* tmpi = (int*)p.o3 + (size_t)gid * 32;
        for (int half = 0; half < 2; ++half) {
#pragma unroll
            for (int j = 0; j < 16; ++j) { tv[j] = -3.0e38f; ti[j] = 0; }
            for (int k = 0; k < 128; ++k) NV_INS16(tv, ti, sc[half * 128 + k], k);
#pragma unroll
            for (int j = 0; j < 16; ++j) { tmpv[half * 16 + j] = tv[j]; tmpi[half * 16 + j] = ti[j]; }
        }
#pragma unroll
        for (int j = 0; j < 16; ++j) { tv[j] = -3.0e38f; ti[j] = 0; }
        for (int i = 0; i < 16; ++i) for (int j = 0; j < 16; ++j) NV_INS16(tv, ti, tmpv[i] + tmpv[16 + j], tmpi[i] * 128 + tmpi[16 + j]);
        float den = 0.f, ev[16];
#pragma unroll
        for (int j = 0; j < 16; ++j) { ev[j] = expf(tv[j] - tv[0]); den += ev[j]; }
        float inv = 1.f / den;
#pragma unroll
        for (int j = 0; j < 16; ++j) { p.o0[(size_t)gid * 16 + j] = ev[j] * inv; ((int*)p.o1)[(size_t)gid * 16 + j] = ti[j]; } } break;
    case OP_PACT1: {
        size_t pr = (size_t)(gid / 16); int part = (int)(gid % 16); int row = (int)(pr / 128); int e = ((const int*)p.d)[pr]; int w = D / 16;
        const float* u = p.b + (size_t)e * D + part * w; const float* x = p.a + (size_t)row * D + part * w; float acc = 0.f;
        for (int c = 0; c < w; ++c) acc = fmaf(u[c], x[c], acc);
        p.o0[gid] = acc; } break;
    case OP_PACT2: {
        float acc = 0.f; for (int i = 0; i < 16; ++i) acc += p.a[(size_t)gid * 16 + i];
        p.o0[gid] = p.c[gid] * nv_gelu(acc); } break;
    case OP_POUT: {
        int row = (int)(gid / D), c = (int)(gid % D); float acc = 0.f;
        for (int i = 0; i < 128; ++i) acc = fmaf(p.a[(size_t)row * 128 + i], p.c[(size_t)((const int*)p.b)[(size_t)row * 128 + i] * D + c], acc);
        p.o0[gid] = acc; } break;
    case OP_YOUT: {
        int row = (int)(gid / D), c = (int)(gid % D);
        if (row < dm.B * dm.T) { int bb = row / dm.T, t = row % dm.T; if (t >= 16) p.o0[((size_t)bb * (dm.T - 16) + (t - 16)) * D + c] = p.a[gid]; }
        else p.o0[((size_t)dm.B * (dm.T - 16) + (row - dm.B * dm.T)) * D + c] = p.a[gid]; } break;
    case OP_WT: {
        const int N = p.i0, K = p.i1, Np = p.i3, Kp = p.i4; const long long per8 = (long long)Np * (Kp / 8); const int bt = (int)(gid / per8); const long long r = gid % per8; const int k0 = (int)(r / Np) * 8, nn = (int)(r % Np);
        unsigned w[4];
#pragma unroll
        for (int i = 0; i < 4; ++i) { float lo = 0.f, hi = 0.f; if (nn < N) { if (k0 + 2 * i < K) lo = p.a[((size_t)bt * K + k0 + 2 * i) * p.i2 + nn]; if (k0 + 2 * i + 1 < K) hi = p.a[((size_t)bt * K + k0 + 2 * i + 1) * p.i2 + nn]; } w[i] = nv_f2bf(lo) | ((unsigned)nv_f2bf(hi) << 16); }
        NvU4 o; o.x = w[0]; o.y = w[1]; o.z = w[2]; o.w = w[3];
        *(NvU4*)((nvbf*)p.o0 + (size_t)bt * Np * Kp + (size_t)nn * Kp + k0) = o; } break;
    case OP_CVT: {
        const int Kp = p.i2; const int row = (int)(gid / Kp), k = (int)(gid % Kp); float v = 0.f;
        if (row < dm.M && k < p.i0) { v = p.a[(size_t)row * p.i1 + k]; if (p.i3 == 1) v = tanhf(v); else if (p.i3 == 2) v = nv_sigmoid(v); }
        ((nvbf*)p.o0)[gid] = nv_f2bf(v); } break;
    case OP_FGEMM: {
        const int N = p.i0; const int m = (int)(gid / N), nn = (int)(gid % N); const nvbf* A = (const nvbf*)p.a + (size_t)m * p.i2 + ((p.i6 & 2) ? (nn / 256) * 256 : 0); const nvbf* Bt = (const nvbf*)p.b + (size_t)nn * p.i3; float acc = 0.f;
        for (int k = 0; k < p.i1; ++k) acc = fmaf(nv_bf2f(A[k]), nv_bf2f(Bt[k]), acc);
        if (p.i6 & 1) ((nvbf*)p.o0)[(size_t)m * p.i4 + nn] = nv_f2bf(acc); else p.o0[(size_t)m * p.i4 + nn] = acc; } break;
    case OP_CVTTAB: {
        const NvF4 v0 = *(const NvF4*)(p.a + gid * 8), v1 = *(const NvF4*)(p.a + gid * 8 + 4); NvU4 o;
        o.x = nv_f2bf(v0.x) | ((unsigned)nv_f2bf(v0.y) << 16); o.y = nv_f2bf(v0.z) | ((unsigned)nv_f2bf(v0.w) << 16); o.z = nv_f2bf(v1.x) | ((unsigned)nv_f2bf(v1.y) << 16); o.w = nv_f2bf(v1.z) | ((unsigned)nv_f2bf(v1.w) << 16);
        *(NvU4*)((nvbf*)p.o0 + gid * 8) = o; } break;
    case OP_CVTTAB8: {
        const float sc = (float)(1 << p.i0); const float* sp = p.a + gid * 16; unsigned w[4];
#pragma unroll
        for (int q = 0; q < 4; ++q) { const NvF4 v = *(const NvF4*)(sp + 4 * q); w[q] = nv_f2e4m3(v.x * sc) | (nv_f2e4m3(v.y * sc) << 8) | (nv_f2e4m3(v.z * sc) << 16) | (nv_f2e4m3(v.w * sc) << 24); }
        NvU4 o; o.x = w[0]; o.y = w[1]; o.z = w[2]; o.w = w[3]; *(NvU4*)((unsigned char*)p.o0 + gid * 16) = o; } break;
    case OP_CVTTAB8S: {
        const float sc = (float)(1 << p.i0); const int per = D / 16; const int e = (int)(gid / per), c0 = (int)(gid % per) * 16; const float* sp = p.a + (size_t)e * D + c0; unsigned w[4];
#pragma unroll
        for (int q = 0; q < 4; ++q) { const NvF4 v = *(const NvF4*)(sp + 4 * q);
#if defined(__HIP_DEVICE_COMPILE__)
            int pk = __builtin_amdgcn_cvt_pk_fp8_f32(v.x * sc, v.y * sc, 0, false); pk = __builtin_amdgcn_cvt_pk_fp8_f32(v.z * sc, v.w * sc, pk, true); w[q] = (unsigned)pk;
#else
            w[q] = nv_f2e4m3(v.x * sc) | (nv_f2e4m3(v.y * sc) << 8) | (nv_f2e4m3(v.z * sc) << 16) | (nv_f2e4m3(v.w * sc) << 24);
#endif
        }
        NvU4 o; o.x = w[0]; o.y = w[1]; o.z = w[2]; o.w = w[3]; *(NvU4*)((unsigned char*)p.o0 + ((size_t)(c0 >> 7) * 16384 + e) * 128 + (c0 & 127)) = o; } break;
    case OP_PACTS: {
        const long long NP = (long long)dm.M * 128; const int sl = (int)(gid / NP); const long long pr = gid % NP; const int row = (int)(pr / 128); const int e = ((const int*)p.d)[pr];
        const unsigned char* u = (const unsigned char*)p.b + ((size_t)sl * 16384 + e) * 128; const nvbf* x = (const nvbf*)p.a + (size_t)row * D + sl * 128; float acc = 0.f;
        for (int c = 0; c < 128; ++c) acc = fmaf(nv_e4m32f(u[c]), nv_bf2f(x[c]), acc);
        p.o0[gid] = acc; } break;
    case OP_PRED: {
        const long long NP = (long long)dm.M * 128; float acc = 0.f; for (int sl = 0; sl < p.i0; ++sl) acc += p.a[(size_t)sl * NP + gid];
        p.o0[gid] = p.c[gid] * nv_gelu(acc * (1.f / 128.f)); } break;
    case OP_POUTS: {
        const int row = (int)(gid / D), c = (int)(gid % D); const unsigned char* vb = (const unsigned char*)p.c + (size_t)(c >> 7) * 16384 * 128 + (c & 127); float acc = 0.f;
        for (int i = 0; i < 128; ++i) acc = fmaf(p.a[(size_t)row * 128 + i] * (1.f / 64.f), nv_e4m32f(vb[(size_t)((const int*)p.b)[(size_t)row * 128 + i] * 128]), acc);
        ((nvbf*)p.o0)[gid] = nv_f2bf(acc); } break;
    case OP_KEYS: {
        const int h = (int)(gid / 256), nrow = (int)(gid % 256), half = nrow >> 7; const float* src = p.a + (((size_t)h * 2 + half) * 128 + (nrow & 127)) * 128; nvbf* dst = (nvbf*)p.o0 + ((size_t)h * 256 + nrow) * 256; float ks = 0.f;
        for (int k = 0; k < 256; ++k) { nvbf b = 0; if ((k >> 7) == half) { b = nv_f2bf(src[k & 127]); ks += nv_bf2f(b); } dst[k] = b; }
        p.o1[gid] = ks; } break;
    case OP_TOPK2: {
        const int h = (int)(gid % 8); const float* sc = p.a + (size_t)gid * 256; const nvbf* q = (const nvbf*)p.b + (size_t)gid * 256; const float* ksum = p.c + h * 256; float mu = 0.f;
        for (int c = 0; c < 256; ++c) mu += nv_bf2f(q[c]);
        mu *= (1.f / 256.f); float var = 0.f;
        for (int c = 0; c < 256; ++c) { float dlt = nv_bf2f(q[c]) - mu; var = fmaf(dlt, dlt, var); }
        const float rs = 1.f / sqrtf(var * (1.f / 256.f) + 1e-5f);
        float tv[16]; int ti[16]; float* tmpv = p.o2 + (size_t)gid * 32; int* tmpi = (int*)p.o3 + (size_t)gid * 32;
        for (int half = 0; half < 2; ++half) {
#pragma unroll
            for (int j = 0; j < 16; ++j) { tv[j] = -3.0e38f; ti[j] = 0; }
            for (int k = 0; k < 128; ++k) NV_INS16(tv, ti, rs * (sc[half * 128 + k] - mu * ksum[half * 128 + k]), k);
#pragma unroll
            for (int j = 0; j < 16; ++j) { tmpv[half * 16 + j] = tv[j]; tmpi[half * 16 + j] = ti[j]; }
        }
#pragma unroll
        for (int j = 0; j < 16; ++j) { tv[j] = -3.0e38f; ti[j] = 0; }
        for (int i = 0; i < 16; ++i) for (int j = 0; j < 16; ++j) NV_INS16(tv, ti, tmpv[i] + tmpv[16 + j], tmpi[i] * 128 + tmpi[16 + j]);
        float den = 0.f, ev[16];
#pragma unroll
        for (int j = 0; j < 16; ++j) { ev[j] = expf(tv[j] - tv[0]); den += ev[j]; }
        float inv = 1.f / den;
#pragma unroll
        for (int j = 0; j < 16; ++j) { p.o0[(size_t)gid * 16 + j] = ev[j] * inv; ((int*)p.o1)[(size_t)gid * 16 + j] = ti[j]; } } break;
    case OP_PACT: {
        const int row = (int)(gid / 128); const int e = ((const int*)p.d)[gid]; const unsigned char* u = (const unsigned char*)p.b + (size_t)e * D; const nvbf* x = (const nvbf*)p.a + (size_t)row * D; float acc = 0.f;
        for (int c = 0; c < D; ++c) acc = fmaf(nv_e4m32f(u[c]), nv_bf2f(x[c]), acc);
        p.o0[gid] = p.c[gid] * nv_gelu(acc * (1.f / 128.f)); } break;
#if defined(HOST_TEST)
    case OP_POUTLN: {
        const float alpha = 1.6817928305074292f; float* x = p.o0 + (size_t)gid * D; std::vector<float> y(D, 0.f);
        for (int i = 0; i < 128; ++i) { const float cf = p.a[(size_t)gid * 128 + i] * (1.f / 64.f); const unsigned char* v = (const unsigned char*)p.c + (size_t)((const int*)p.b)[(size_t)gid * 128 + i] * D; for (int c = 0; c < D; ++c) y[c] = fmaf(cf, nv_e4m32f(v[c]), y[c]); }
        float mu = 0.f; for (int c = 0; c < D; ++c) { y[c] = alpha * x[c] + y[c]; mu += y[c]; }
        mu /= D; float var = 0.f; for (int c = 0; c < D; ++c) { float dlt = y[c] - mu; var = fmaf(dlt, dlt, var); }
        const float rs = 1.f / sqrtf(var / D + 1e-5f);
        for (int c = 0; c < D; ++c) { const float o = (y[c] - mu) * rs * p.d[c] + p.e[c]; x[c] = o; ((nvbf*)p.o1)[(size_t)gid * D + c] = nv_f2bf(o); } } break;
#endif
    default: break;
    }
}

struct NvIO { const float* const* in; float* out; char* ws; size_t ws_size; };
template <class Launch> HD void nv_forward(const NvIO& io, const Dm& dm, Launch&& launch) {
    const int D = dm.D, M = dm.M, B = dm.B, DB = dm.DB, RH = dm.RH; const size_t MD = (size_t)M * D;
    float* y_prompt = io.out; float* y_sample = y_prompt + (size_t)B * (dm.T - 16) * D; float* p_gla = y_sample + (size_t)DB * dm.DT * D;
    float* p_h = p_gla + (size_t)2 * B * 4 * 64 * 128; float* p_conv = p_h + (size_t)2 * B * 512; float* p_rwkv = p_conv + (size_t)2 * B * 3 * 512;
    float* p_shift = p_rwkv + (size_t)2 * B * RH * 4096; float* s_gla = p_shift + (size_t)2 * B * D; float* s_h = s_gla + (size_t)2 * DB * 4 * 64 * 128;
    float* s_conv = s_h + (size_t)2 * DB * 512; float* s_rwkv = s_conv + (size_t)2 * DB * 3 * 512; float* s_shift = s_rwkv + (size_t)2 * DB * RH * 4096;
    float* w = (float*)io.ws; size_t off = 0; auto take = [&](size_t n) __attribute__((always_inline)) { float* r = w + off; off += (n + 63) & ~(size_t)63; return r; };
    float* X = take(MD); float* VFIRST = take(MD); float* MOUT = take(MD);
    auto mk = [&](int code, long long n) __attribute__((always_inline)) { Op o{}; o.code = code; o.n = n; return o; };
    const int Mp = nv_rup(M, 256), Dp = nv_rup(D, 256), Dk = nv_rup(D, 128);
    auto takeh = [&](size_t n) __attribute__((always_inline)) { return (nvbf*)take((n + 1) / 2); };
    nvbf* ABF = takeh((size_t)Mp * 1024 > (size_t)Mp * Dk ? (size_t)Mp * 1024 : (size_t)Mp * Dk);
    const size_t SZ_WIN = (size_t)2816 * Dk, SZ_WOUT = (size_t)Dp * 1024, SZ_DD = (size_t)Dp * Dk, SZ_DN = (size_t)256 * Dk, SZ_UP = (size_t)Dp * 128, SZ_WQ = (size_t)2048 * Dk;
    nvbf* WT_WIN = takeh(2 * SZ_WIN); nvbf* WT_WOUT = takeh(2 * SZ_WOUT); nvbf* WT_WR = takeh(2 * SZ_DD); nvbf* WT_WK = takeh(2 * SZ_DD); nvbf* WT_WV = takeh(2 * SZ_DD); nvbf* WT_WO = takeh(2 * SZ_DD);
    nvbf* WT_W1 = takeh(2 * SZ_DN); nvbf* WT_W2 = takeh(2 * SZ_UP); nvbf* WT_A1 = takeh(2 * SZ_DN); nvbf* WT_A2 = takeh(2 * SZ_UP); nvbf* WT_G1 = takeh(2 * SZ_DN); nvbf* WT_G2 = takeh(2 * SZ_UP);
    nvbf* WT_V1 = takeh(SZ_DN); nvbf* WT_V2 = takeh(SZ_UP); nvbf* WT_WQ = takeh(4 * SZ_WQ); nvbf* WT_WG = takeh((size_t)2 * 1024 * 512); float* SPL = take(2 * 512); float* PRM = take((size_t)2 * 6 * D);
    nvbf* UB = takeh((size_t)16384 * D / 2); nvbf* VB = takeh((size_t)16384 * D / 2); nvbf* KB = takeh((size_t)8 * 256 * 256); float* KSUM = take(8 * 256);
    const size_t scratch0 = off;
    auto nb = [&](Op o) __attribute__((always_inline)) { o.code |= OPF_NOBAR; launch(o); };
    auto wt = [&](const float* W, int K, int N, int batch, nvbf* dst) __attribute__((always_inline)) { const int Np = nv_rup(N, 256), Kp = nv_rup(K, 128); Op o = mk(OP_WT, (long long)batch * Np * (Kp / 8)); o.a = W; o.o0 = (float*)dst; o.i0 = N; o.i1 = K; o.i2 = N; o.i3 = Np; o.i4 = Kp; nb(o); };
    wt(io.in[10], D, MIXIN, 2, WT_WIN); wt(io.in[21], 1024, D, 2, WT_WOUT); wt(io.in[23], D, D, 2, WT_WR); wt(io.in[24], D, D, 2, WT_WK); wt(io.in[25], D, D, 2, WT_WV); wt(io.in[26], D, D, 2, WT_WO);
    wt(io.in[28], D, 64, 2, WT_W1); wt(io.in[29], 64, D, 2, WT_W2); wt(io.in[31], D, 64, 2, WT_A1); wt(io.in[32], 64, D, 2, WT_A2); wt(io.in[36], D, 128, 2, WT_G1); wt(io.in[37], 128, D, 2, WT_G2);
    wt(io.in[34], D, 32, 1, WT_V1); wt(io.in[35], 32, D, 1, WT_V2); wt(io.in[43], D, 2048, 4, WT_WQ);
    for (int jj = 0; jj < 2; ++jj) { Op o = mk(OP_PRM, (long long)6 * D); o.a = io.in[27] + (size_t)jj * D; o.b = io.in[30] + (size_t)jj * D; o.c = jj > 0 ? io.in[33] + (size_t)(jj - 1) * D : nullptr; o.d = io.in[38] + (size_t)jj * D; o.e = io.in[39] + (size_t)jj * D; o.f = io.in[40] + (size_t)jj * RH * 64; o.o0 = PRM + (size_t)jj * 6 * D; nb(o); }
    for (int jj = 0; jj < 2; ++jj) { Op o = mk(OP_WGATE, 1024); o.a = io.in[16] + (size_t)jj * 8 * 64 * 64; o.b = io.in[18] + (size_t)jj * 8 * 64 * 64; o.c = io.in[20] + (size_t)jj * 512; o.o0 = (float*)(WT_WG + (size_t)jj * 1024 * 512); o.o1 = SPL + (size_t)jj * 512; nb(o); }
    auto fgemm = [&](const nvbf* Wt, float* C, int ldc, int N, int K, int bf16out = 0) __attribute__((always_inline)) {
        const int Kp = nv_rup(K, 128), Np = nv_rup(N, 256);
        Op o = mk(OP_FGEMM, (long long)M * N); o.a = (const float*)ABF; o.b = (const float*)Wt; o.o0 = C; o.i0 = N; o.i1 = Kp; o.i2 = Kp; o.i3 = Kp; o.i4 = ldc; o.i5 = Np; o.i6 = bf16out; launch(o); };
    auto gemm = [&](const float* A, int lda, const nvbf* Wt, float* C, int ldc, int N, int K, int act) __attribute__((always_inline)) {
        const int Kp = nv_rup(K, 128);
        { Op o = mk(OP_CVT8, (long long)Mp * (Kp / 8)); o.a = A; o.o0 = (float*)ABF; o.i0 = K; o.i1 = lda; o.i2 = Kp; o.i3 = act; launch(o); }
        fgemm(Wt, C, ldc, N, K); };
    { Op o = mk(OP_EMBED4, (long long)MD / 4); o.a = io.in[0]; o.b = io.in[1]; o.c = io.in[7]; o.o0 = X; o.o1 = (float*)ABF; launch(o); }
    const float* const w_outer = w; float* const out_outer = io.out;
    for (int layer = 0; layer < 4; ++layer) {
        float* wl = (float*)w_outer; float* ol = out_outer; NV_LAUNDER(wl); NV_LAUNDER(ol);
#define NV_RB(T, v) T const v##_rb = (T)((char*)wl + ((const char*)(v) - (const char*)w_outer))
#define NV_RO(v) float* const v##_rb = (float*)((char*)ol + ((const char*)(v) - (const char*)out_outer))
        NV_RB(float*, X); NV_RB(float*, VFIRST); NV_RB(float*, MOUT); NV_RB(nvbf*, ABF); NV_RB(nvbf*, WT_WIN); NV_RB(nvbf*, WT_WOUT); NV_RB(nvbf*, WT_WR); NV_RB(nvbf*, WT_WK); NV_RB(nvbf*, WT_WV); NV_RB(nvbf*, WT_WO);
        NV_RB(nvbf*, WT_W1); NV_RB(nvbf*, WT_W2); NV_RB(nvbf*, WT_A1); NV_RB(nvbf*, WT_A2); NV_RB(nvbf*, WT_G1); NV_RB(nvbf*, WT_G2); NV_RB(nvbf*, WT_V1); NV_RB(nvbf*, WT_V2); NV_RB(nvbf*, WT_WQ); NV_RB(nvbf*, WT_WG);
        NV_RB(float*, SPL); NV_RB(float*, PRM); NV_RB(nvbf*, UB); NV_RB(nvbf*, VB); NV_RB(nvbf*, KB); NV_RB(float*, KSUM);
        NV_RO(p_gla); NV_RO(p_h); NV_RO(p_conv); NV_RO(p_rwkv); NV_RO(p_shift); NV_RO(s_gla); NV_RO(s_h); NV_RO(s_conv); NV_RO(s_rwkv); NV_RO(s_shift);
#undef NV_RB
#undef NV_RO
        { float* const X = X_rb; float* const VFIRST = VFIRST_rb; float* const MOUT = MOUT_rb; nvbf* const ABF = ABF_rb; nvbf* const WT_WIN = WT_WIN_rb; nvbf* const WT_WOUT = WT_WOUT_rb; nvbf* const WT_WR = WT_WR_rb; nvbf* const WT_WK = WT_WK_rb;
          nvbf* const WT_WV = WT_WV_rb; nvbf* const WT_WO = WT_WO_rb; nvbf* const WT_W1 = WT_W1_rb; nvbf* const WT_W2 = WT_W2_rb; nvbf* const WT_A1 = WT_A1_rb; nvbf* const WT_A2 = WT_A2_rb; nvbf* const WT_G1 = WT_G1_rb; nvbf* const WT_G2 = WT_G2_rb;
          nvbf* const WT_V1 = WT_V1_rb; nvbf* const WT_V2 = WT_V2_rb; nvbf* const WT_WQ = WT_WQ_rb; nvbf* const WT_WG = WT_WG_rb; float* const SPL = SPL_rb; float* const PRM = PRM_rb; nvbf* const UB = UB_rb; nvbf* const VB = VB_rb; nvbf* const KB = KB_rb; float* const KSUM = KSUM_rb;
          float* const p_gla = p_gla_rb; float* const p_h = p_h_rb; float* const p_conv = p_conv_rb; float* const p_rwkv = p_rwkv_rb; float* const p_shift = p_shift_rb; float* const s_gla = s_gla_rb; float* const s_h = s_h_rb; float* const s_conv = s_conv_rb;
          float* const s_rwkv = s_rwkv_rb; float* const s_shift = s_shift_rb; float* const w = wl; (void)SPL; (void)WT_WG; (void)VFIRST;
        const int j = layer / 2; off = scratch0;
        { Op o = mk(OP_CVTTAB8S, (long long)16384 * D / 16); o.a = io.in[45] + (size_t)layer * 16384 * D; o.o0 = (float*)UB; o.i0 = 7; nb(o); }
        { Op o = mk(OP_CVTTAB8S, (long long)16384 * D / 16); o.a = io.in[46] + (size_t)layer * 16384 * D; o.o0 = (float*)VB; o.i0 = 6; nb(o); }
        { Op o = mk(OP_KEYS, 8 * 256); o.a = io.in[44] + (size_t)layer * 8 * 2 * 128 * 128; o.o0 = (float*)KB; o.o1 = KSUM; nb(o); }
        if (layer % 2 == 0) {
            float* PROJ = take((size_t)M * MIXIN); float* LOGA = take((size_t)M * 256); float* O = take((size_t)M * 512); float* MIXO = (float*)ABF;
            float* XC = take((size_t)M * 512); nvbf* XCB = takeh((size_t)Mp * 512); float* AT = take((size_t)M * 512); float* BT = take((size_t)M * 512);
            const int NC = (dm.T + 63) / 64; float* LEND = take((size_t)B * 4 * NC * 8192); float* DEC = take((size_t)B * 4 * NC * 64); float* LA = take((size_t)B * NC * 512); float* LB = take((size_t)B * NC * 512);
            fgemm(WT_WIN + (size_t)j * SZ_WIN, PROJ, MIXIN, MIXIN, D);
            { Op o = mk(OP_LOGA4, (long long)M * 64); o.a = PROJ; o.b = io.in[11] + (size_t)j * 16 * 256; o.c = io.in[12] + (size_t)j * 256; o.o0 = LOGA; nb(o); }
            { Op o = mk(OP_CONV4, (long long)M * 128); o.a = PROJ; o.b = io.in[4] + (size_t)j * DB * 3 * 512; o.c = io.in[14] + (size_t)j * 4 * 512; o.d = io.in[15] + (size_t)j * 512; o.o0 = XC; o.o1 = (float*)XCB; nb(o); }
            { Op o = mk(OP_CONVOUT, (long long)dm.NSEQ * 1536); o.a = PROJ; o.b = io.in[4] + (size_t)j * DB * 3 * 512; o.o1 = p_conv + (size_t)j * B * 3 * 512; o.o2 = s_conv + (size_t)j * DB * 3 * 512; launch(o); }
            { Op o = mk(OP_GLAF, (long long)B * 512); o.a = PROJ; o.b = LOGA; o.o0 = O; o.o1 = p_gla + (size_t)j * B * 4 * 64 * 128; nb(o); }
            { Op o = mk(OP_GLA3, (long long)(DB * 4) * 128); o.a = PROJ; o.b = LOGA; o.c = io.in[2] + (size_t)j * DB * 4 * 64 * 128; o.d = LEND; o.o0 = O; o.o2 = s_gla + (size_t)j * DB * 4 * 64 * 128; o.i0 = NC; o.i1 = 1; nb(o); }
            { Op o = mk(OP_LRUG2, (long long)M * 512); o.a = (const float*)XCB; o.b = (const float*)(WT_WG + (size_t)j * 1024 * 512); o.c = io.in[17] + (size_t)j * 512; o.d = io.in[19] + (size_t)j * 512; o.e = SPL + (size_t)j * 512; o.f = XC; o.o0 = AT; o.o1 = BT; launch(o); }
            { Op o = mk(OP_GLANORM, (long long)M * 4); o.a = O; o.b = PROJ; o.c = io.in[13] + (size_t)j * 128; o.o0 = MIXO; nb(o); }
            { Op o = mk(OP_LRU1, (long long)B * NC * 512); o.a = AT; o.b = BT; o.o0 = LA; o.o1 = LB; o.i0 = NC; launch(o); }
            { Op o = mk(OP_LRU2, (long long)B * 512); o.a = LA; o.o0 = LB; o.o1 = p_h + (size_t)j * B * 512; o.i0 = NC; launch(o); }
            { Op o = mk(OP_LRU3, (long long)(B * NC + DB) * 512); o.a = AT; o.b = BT; o.c = PROJ; o.d = io.in[3] + (size_t)j * DB * 512; o.e = LB; o.o0 = MIXO; o.o2 = s_h + (size_t)j * DB * 512; o.i0 = NC; launch(o); }
            fgemm(WT_WOUT + (size_t)j * SZ_WOUT, MOUT, D, D, 1024, 1);
        } else {
            float* Y = take(MD); float* R = take(MD); float* K = take(MD); float* V = take(MD); float* G = take(MD); float* KK = take(MD);
            const size_t XMSZ = (size_t)Mp * D;
            float* WAV = take(3 * MD > 3 * XMSZ ? 3 * MD : 3 * XMSZ); float* Wd = WAV; float* Aa = WAV + MD; float* Vg = WAV + 2 * MD; nvbf* XM6 = (nvbf*)WAV;
            float* BON = take((size_t)M * RH); float* HLw = take((size_t)M * 64); float* HLa = take((size_t)M * 64); float* HLg = take((size_t)M * 128); float* HLv = take((size_t)M * 32);
            nvbf* ABw = takeh((size_t)Mp * 128); nvbf* ABa = takeh((size_t)Mp * 128); nvbf* ABg = takeh((size_t)Mp * 128); nvbf* ABv = takeh((size_t)Mp * 128);
            const float* shin = io.in[6] + (size_t)j * DB * D; const float* mu = io.in[22] + (size_t)j * 6 * D;
            { Op o = mk(OP_SHIFTOUT, (long long)dm.NSEQ * D); o.a = X; o.o1 = p_shift + (size_t)j * B * D; o.o2 = s_shift + (size_t)j * DB * D; nb(o); }
            { Op o = mk(OP_MIX6, (long long)MD / 8); o.a = X; o.b = shin; o.c = mu; o.o0 = (float*)XM6; o.i1 = (int)(XMSZ / 1024); launch(o); }
            auto gg = [&](const nvbf* A, const nvbf* Wt, float* C, int ldc, int N, int K, bool last) __attribute__((always_inline)) { const int Kp = nv_rup(K, 128), Np = nv_rup(N, 256);
                Op o = mk(OP_FGEMM, (long long)M * N); o.a = (const float*)A; o.b = (const float*)Wt; o.o0 = C; o.i0 = N; o.i1 = Kp; o.i2 = Kp; o.i3 = Kp; o.i4 = ldc; o.i5 = Np; if (!last) o.code |= OPF_GROUP; launch(o); };
            gg(XM6 + 0 * XMSZ, WT_WR + (size_t)j * SZ_DD, R, D, D, D, false); gg(XM6 + 2 * XMSZ, WT_WK + (size_t)j * SZ_DD, K, D, D, D, false); gg(XM6 + 3 * XMSZ, WT_WV + (size_t)j * SZ_DD, V, D, D, D, false);
            gg(XM6 + 1 * XMSZ, WT_W1 + (size_t)j * SZ_DN, HLw, 64, 64, D, false); gg(XM6 + 4 * XMSZ, WT_A1 + (size_t)j * SZ_DN, HLa, 64, 64, D, false);
            if (j > 0) gg(XM6 + 3 * XMSZ, WT_V1 + (size_t)(j - 1) * SZ_DN, HLv, 32, 32, D, false);
            gg(XM6 + 5 * XMSZ, WT_G1 + (size_t)j * SZ_DN, HLg, 128, 128, D, true);
            auto cv = [&](const float* A, int K, nvbf* dst, int act, bool last) __attribute__((always_inline)) { Op o = mk(OP_CVT8, (long long)Mp * 16); o.a = A; o.o0 = (float*)dst; o.i0 = K; o.i1 = K; o.i2 = 128; o.i3 = act; if (last) launch(o); else nb(o); };
            cv(HLw, 64, ABw, 1, false); cv(HLa, 64, ABa, 0, false); if (j > 0) cv(HLv, 32, ABv, 0, false); cv(HLg, 128, ABg, 2, true);
            gg(ABw, WT_W2 + (size_t)j * SZ_UP, Wd, D, D, 64, false); gg(ABa, WT_A2 + (size_t)j * SZ_UP, Aa, D, D, 64, false); if (j > 0) gg(ABv, WT_V2 + (size_t)(j - 1) * SZ_UP, Vg, D, D, 32, false); gg(ABg, WT_G2 + (size_t)j * SZ_UP, G, D, D, 128, true);
            { Op o = mk(OP_WKVP, (long long)dm.NSEQ * RH * 64); o.a = R; o.b = K; o.c = Wd; o.d = Aa; o.e = V; o.f = Vg; o.g = VFIRST; o.h = PRM + (size_t)j * 6 * D; o.o0 = Y; o.o1 = p_rwkv + (size_t)j * B * RH * 4096; o.o2 = s_rwkv + (size_t)j * DB * RH * 4096;
              o.o3 = j > 0 ? KK : VFIRST; o.o4 = BON; o.o5 = (float*)(io.in[5] + (size_t)j * DB * RH * 4096); o.i0 = j > 0 ? 1 : 0; launch(o); }
            { Op o = mk(OP_POST2, (long long)M * RH); o.a = Y; o.b = G; o.c = j > 0 ? KK : VFIRST; o.d = BON; o.e = io.in[41] + (size_t)j * D; o.f = io.in[42] + (size_t)j * D; o.o0 = (float*)ABF; launch(o); }
            fgemm(WT_WO + (size_t)j * SZ_DD, MOUT, D, D, D, 1);
        }
        { Op o = mk(OP_LNRES, M); o.a = MOUT; o.b = io.in[8] + (size_t)(layer * 2 + 0) * D; o.c = io.in[9] + (size_t)(layer * 2 + 0) * D; o.o0 = X; o.o1 = (float*)ABF; launch(o); }
        off = scratch0;
        { nvbf* Q = takeh((size_t)Mp * 2048); float* SC = take((size_t)M * 2048); float* GATE = take((size_t)M * 128); float* EIDX = take((size_t)M * 128); float* TMPV = take((size_t)M * 256); float* TMPI = take((size_t)M * 256);
          float* COEF = take((size_t)M * 128);
          { Op o = mk(OP_FGEMM, (long long)M * 2048); o.a = (const float*)ABF; o.b = (const float*)(WT_WQ + (size_t)layer * SZ_WQ); o.o0 = (float*)Q; o.i0 = 2048; o.i1 = Dk; o.i2 = Dk; o.i3 = Dk; o.i4 = 2048; o.i5 = 2048; o.i6 = 1; launch(o); }
          { Op o = mk(OP_FGEMM, (long long)M * 2048); o.a = (const float*)Q; o.b = (const float*)KB; o.o0 = SC; o.i0 = 2048; o.i1 = 256; o.i2 = 2048; o.i3 = 256; o.i4 = 2048; o.i5 = 2048; o.i6 = 2; launch(o); }
          { Op o = mk(OP_TOPK2, (long long)M * 8); o.a = SC; o.b = (const float*)Q; o.c = KSUM; o.o0 = GATE; o.o1 = EIDX; o.o2 = TMPV; o.o3 = TMPI; launch(o); }
          { const int NS = D / 128; float* PART = take((size_t)NS * M * 128); float* YBUF = take(MD);
            { Op o = mk(OP_PACTS, (long long)NS * M * 128); o.a = (const float*)ABF; o.b = (const float*)UB; o.d = EIDX; o.o0 = PART; launch(o); }
            { Op o = mk(OP_PRED, (long long)M * 128); o.a = PART; o.c = GATE; o.o0 = COEF; o.i0 = NS; launch(o); }
            { Op o = mk(OP_POUTS, (long long)MD); o.a = COEF; o.b = EIDX; o.c = (const float*)VB; o.o0 = YBUF; launch(o); }
            { Op o = mk(OP_LNRES, M); o.a = YBUF; o.b = io.in[8] + (size_t)(layer * 2 + 1) * D; o.c = io.in[9] + (size_t)(layer * 2 + 1) * D; o.o0 = X; o.o1 = (float*)ABF; launch(o); } } }
        }
    }
    { Op o = mk(OP_YOUT4, (long long)MD / 4); o.a = X; o.o0 = y_prompt; launch(o); }
    (void)y_sample;
}

#include <cstdint>
namespace pg8 {
#define PG8_LAS __attribute__((address_space(3)))
typedef unsigned short bf16_t;
typedef short bf16x8 __attribute__((ext_vector_type(8)));
typedef float f32x4 __attribute__((ext_vector_type(4)));
typedef unsigned u32x4 __attribute__((ext_vector_type(4)));
constexpr int BM = 256, BK = 64, HALF = 128, HTB = HALF * BK * 2  , STAGE_BYTES = 8 * HTB, NXCD = 8, WGM = 8;

__host__ __device__ __forceinline__ int lds_byte(int r, int c) { const int st = (r >> 4) * 2 + (c >> 5), rr = r & 15, cc = c & 31, ob = rr * 64 + cc * 2; return st * 1024 + (ob ^ (((ob >> 9) & 1) << 5)); }
__host__ __device__ __forceinline__ void stage_rc(int b, int& R, int& C) { const int st = b / 1024, sb = b % 1024, swz = sb ^ (((sb >> 9) & 1) << 5); R = (st >> 1) * 16 + swz / 64; C = (st & 1) * 32 + (swz % 64) / 2; }
__host__ __device__ __forceinline__ int perm32(int rho) { const int n = rho >> 4, i = rho & 15; return 8 * (i >> 2) + 4 * n + (i & 3); }

struct Unit { int pm, pn, grp, pad_; const char* A; const char* B; };
struct Gemm { const bf16_t* A; const bf16_t* Bt; int M, N, K, lda, ldb; };

struct StaticOrder {
    int nM, nN, nwg, G, c; const char* A; const char* B; size_t tsA, tsB, acs;
    __host__ __device__ void init(const Gemm& g, int G_, int c_) { nM = g.M / BM; nN = g.N / BM; nwg = nM * nN; G = G_; c = c_; A = (const char*)g.A; B = (const char*)g.Bt; tsA = (size_t)BM * g.lda * 2; tsB = (size_t)BM * g.ldb * 2; acs = 0; }
    __host__ __device__ bool next(int i, Unit& u) const {
        const long L = (long)i * G + c; if (L >= nwg) return false;
        int wgid = (int)L; { const int q = nwg / NXCD, r = nwg % NXCD, xcd = wgid % NXCD, off = wgid / NXCD; wgid = (xcd < r ? xcd * (q + 1) : r * (q + 1) + (xcd - r) * q) + off; }
        const int nig = WGM * nN, gid = wgid / nig, fm = gid * WGM, gsz = (nM - fm) < WGM ? (nM - fm) : WGM;
        u.pm = fm + ((wgid % nig) % gsz); u.pn = (wgid % nig) / gsz; u.grp = 0; u.pad_ = 0; u.A = A + (size_t)u.pm * tsA + (size_t)u.pn * acs; u.B = B + (size_t)u.pn * tsB; return true;
    }
    __device__ __forceinline__ void a_ready(const Unit&) const {}
    __device__ __forceinline__ void done(const Unit&) const {}
};

template <class Epi, class Sched, bool ALIGN_EPI = false, bool SP2 = false>
__device__ __forceinline__ void gemm_phase(PG8_LAS unsigned char* lds, const Gemm g, const Sched& S, const Epi& E) {
    int tid_raw = threadIdx.x; asm volatile("" : "+v"(tid_raw));
    const int tid = tid_raw, wid = __builtin_amdgcn_readfirstlane(tid >> 6), lane = tid & 63, wr = wid >> 2, wc = wid & 3, fr = lane & 15, fq = lane >> 4;
    const int K = g.K, nt = K / BK;
    unsigned voffA[2], voffB[2];
#pragma unroll
    for (int i = 0; i < 2; ++i) { int R, C; stage_rc(tid * 16 + i * 8192, R, C); const int Rb = Epi::PERM ? ((R & ~31) + perm32(R & 31)) : R;
        voffA[i] = (unsigned)(R * g.lda + C) * 2u; voffB[i] = (unsigned)(Rb * g.ldb + C) * 2u; }
    const size_t kstep = (size_t)(BK * 2);
    const size_t hstepA = (size_t)HALF * g.lda * 2, hstepB = (size_t)HALF * g.ldb * 2;
    const unsigned ldsw = (unsigned)wid * 1024u;
    const int aoff = lds_byte(wr * 64 + fr, fq * 8), boff = lds_byte(wc * 32 + fr, fq * 8);
#define PG8_SA(b, h) (((b) * 2 + (h)) * HTB)
#define PG8_SB(b, h) ((4 + (b) * 2 + (h)) * HTB)
#define PG8_STAGE(bufoff, gbase, voff) do { _Pragma("unroll") for (int _i = 0; _i < 2; ++_i) \
        __builtin_amdgcn_global_load_lds((const unsigned*)((const char*)(gbase) + (voff)[_i]), (PG8_LAS unsigned*)(lds + (bufoff) + ldsw + _i * 8192), 16, 0, 0); } while (0)
#define PG8_LDA(dst, b, h) do { _Pragma("unroll") for (int m = 0; m < 4; ++m) _Pragma("unroll") for (int k = 0; k < 2; ++k) dst[m][k] = *(const PG8_LAS bf16x8*)(lds + PG8_SA(b, h) + aoff + m * 2048 + k * 1024); } while (0)
#define PG8_LDB(dst, b, h) do { _Pragma("unroll") for (int n = 0; n < 2; ++n) _Pragma("unroll") for (int k = 0; k < 2; ++k) dst[n][k] = *(const PG8_LAS bf16x8*)(lds + PG8_SB(b, h) + boff + n * 2048 + k * 1024); } while (0)
#define PG8_MMA(ai, bj, At, Bt) do { __builtin_amdgcn_s_setprio(1); _Pragma("unroll") for (int m = 0; m < 4; ++m) _Pragma("unroll") for (int n = 0; n < 2; ++n) _Pragma("unroll") for (int k = 0; k < 2; ++k) \
        acc[ai][bj][m][n] = __builtin_amdgcn_mfma_f32_16x16x32_bf16(Bt[n][k], At[m][k], acc[ai][bj][m][n], 0, 0, 0); __builtin_amdgcn_s_setprio(0); } while (0)
#define PG8_WAIT_V(n) asm volatile("s_waitcnt vmcnt(" #n ")" ::: "memory")
#define PG8_WAIT_L(n) asm volatile("s_waitcnt lgkmcnt(" #n ")" ::: "memory")
#define PG8_BAR __builtin_amdgcn_s_barrier()
#define PG8_SCHED __builtin_amdgcn_sched_barrier(0)
    Unit cur, nxt; int ui = 0;
    if (!S.next(0, cur)) return;
    f32x4 acc[2][2][4][2];
#pragma unroll
    for (int a = 0; a < 2; ++a)
#pragma unroll
        for (int b = 0; b < 2; ++b)
#pragma unroll
            for (int m = 0; m < 4; ++m)
#pragma unroll
                for (int n = 0; n < 2; ++n) acc[a][b][m][n] = (f32x4){0.f, 0.f, 0.f, 0.f};
    bf16x8 At[4][2], B0[2][2], B1[2][2];
    const char* cA = cur.A; const char* cB = cur.B;
    S.a_ready(cur);
    if constexpr (SP2) {
        PG8_STAGE(PG8_SB(0, 0), cB, voffB); PG8_STAGE(PG8_SB(0, 1), cB + hstepB, voffB); PG8_STAGE(PG8_SA(0, 0), cA, voffA); PG8_STAGE(PG8_SA(0, 1), cA + hstepA, voffA);
        if (wr == 1) PG8_BAR;
        PG8_WAIT_V(2); PG8_BAR;
        PG8_STAGE(PG8_SB(1, 0), cB + kstep, voffB); PG8_STAGE(PG8_SA(1, 0), cA + kstep, voffA); PG8_STAGE(PG8_SB(1, 1), cB + hstepB + kstep, voffB);
        PG8_WAIT_V(6); PG8_BAR;
    } else {
        PG8_STAGE(PG8_SB(0, 0), cB, voffB); PG8_STAGE(PG8_SA(0, 0), cA, voffA); PG8_STAGE(PG8_SB(0, 1), cB + hstepB, voffB); PG8_STAGE(PG8_SA(0, 1), cA + hstepA, voffA);
        if (wr == 1) PG8_BAR;
        PG8_WAIT_V(4); PG8_BAR;
        PG8_STAGE(PG8_SB(1, 0), cB + kstep, voffB); PG8_STAGE(PG8_SA(1, 0), cA + kstep, voffA); PG8_STAGE(PG8_SB(1, 1), cB + hstepB + kstep, voffB);
        PG8_WAIT_V(6); PG8_BAR;
    }
    for (;;) {
        const bool has_next = S.next(ui + 1, nxt);
        const char* nA = has_next ? nxt.A : cA; const char* nB = has_next ? nxt.B : cB;
        for (int t = 0; t < nt; t += 2) {
            const bool last = (t == nt - 2);
            const char* a1 = cA + (size_t)(t + 1) * kstep;
            const char* a2 = last ? nA : cA + (size_t)(t + 2) * kstep; const char* b2 = last ? nB : cB + (size_t)(t + 2) * kstep;
            const char* a3 = a2 + kstep; const char* b3 = b2 + kstep;
            if (last && has_next) S.a_ready(nxt);
            if constexpr (SP2) {
            PG8_LDB(B0, 0, 0); PG8_LDB(B1, 0, 1); PG8_SCHED; PG8_LDA(At, 0, 0); PG8_STAGE(PG8_SA(1, 1), a1 + hstepA, voffA);
            PG8_WAIT_V(8); PG8_WAIT_L(0); PG8_BAR; PG8_MMA(0, 0, At, B0); PG8_MMA(0, 1, At, B1); PG8_BAR; PG8_SCHED;
            PG8_LDA(At, 0, 1); PG8_STAGE(PG8_SB(0, 0), b2, voffB); PG8_STAGE(PG8_SB(0, 1), b2 + hstepB, voffB); PG8_STAGE(PG8_SA(0, 0), a2, voffA);
            PG8_WAIT_V(8); PG8_WAIT_L(0); PG8_BAR; PG8_MMA(1, 0, At, B0); PG8_MMA(1, 1, At, B1); PG8_BAR; PG8_SCHED;
            PG8_LDB(B0, 1, 0); PG8_LDB(B1, 1, 1); PG8_SCHED; PG8_LDA(At, 1, 0); PG8_STAGE(PG8_SA(0, 1), a2 + hstepA, voffA);
            PG8_WAIT_V(8); PG8_WAIT_L(0); PG8_BAR; PG8_MMA(0, 0, At, B0); PG8_MMA(0, 1, At, B1); PG8_BAR; PG8_SCHED;
            PG8_LDA(At, 1, 1); PG8_STAGE(PG8_SB(1, 0), b3, voffB); PG8_STAGE(PG8_SB(1, 1), b3 + hstepB, voffB); PG8_STAGE(PG8_SA(1, 0), a3, voffA);
            PG8_WAIT_V(8); PG8_WAIT_L(0); PG8_BAR; PG8_MMA(1, 0, At, B0); PG8_MMA(1, 1, At, B1); PG8_BAR; PG8_SCHED;
            } else {
            PG8_LDB(B0, 0, 0); PG8_SCHED; PG8_LDA(At, 0, 0); PG8_STAGE(PG8_SA(1, 1), a1 + hstepA, voffA);
            PG8_WAIT_L(8); PG8_BAR; PG8_WAIT_L(0); PG8_MMA(0, 0, At, B0); PG8_BAR; PG8_SCHED;
            PG8_LDB(B1, 0, 1); PG8_STAGE(PG8_SB(0, 0), b2, voffB);
            PG8_BAR; PG8_WAIT_L(0); PG8_MMA(0, 1, At, B1); PG8_BAR;
            PG8_LDA(At, 0, 1); PG8_STAGE(PG8_SA(0, 0), a2, voffA);
            PG8_BAR; PG8_WAIT_L(0); PG8_MMA(1, 0, At, B0); PG8_BAR; PG8_SCHED;
            PG8_STAGE(PG8_SB(0, 1), b2 + hstepB, voffB);
            PG8_WAIT_V(6); PG8_BAR; PG8_MMA(1, 1, At, B1); PG8_BAR;
            PG8_LDB(B0, 1, 0); PG8_SCHED; PG8_LDA(At, 1, 0); PG8_STAGE(PG8_SA(0, 1), a2 + hstepA, voffA);
            PG8_WAIT_L(8); PG8_BAR; PG8_WAIT_L(0); PG8_MMA(0, 0, At, B0); PG8_BAR; PG8_SCHED;
            PG8_LDB(B1, 1, 1); PG8_STAGE(PG8_SB(1, 0), b3, voffB);
            PG8_BAR; PG8_WAIT_L(0); PG8_MMA(0, 1, At, B1); PG8_BAR;
            PG8_LDA(At, 1, 1); PG8_STAGE(PG8_SA(1, 0), a3, voffA);
            PG8_BAR; PG8_WAIT_L(0); PG8_MMA(1, 0, At, B0); PG8_BAR; PG8_SCHED;
            PG8_STAGE(PG8_SB(1, 1), b3 + hstepB, voffB);
            PG8_WAIT_V(6); PG8_BAR; PG8_MMA(1, 1, At, B1); PG8_BAR;
            }
        }
        if constexpr (ALIGN_EPI) { if (wr == 0) PG8_BAR; }
        if constexpr (!Epi::AFTER_DRAIN) { E(acc, cur, wr, wc, fr, fq); S.done(cur); }
        if (!has_next) break;
#pragma unroll
        for (int a = 0; a < 2; ++a)
#pragma unroll
            for (int b = 0; b < 2; ++b)
#pragma unroll
                for (int m = 0; m < 4; ++m)
#pragma unroll
                    for (int n = 0; n < 2; ++n) acc[a][b][m][n] = (f32x4){0.f, 0.f, 0.f, 0.f};
        cur = nxt; cA = nA; cB = nB; ++ui;
        if constexpr (ALIGN_EPI) { if (wr == 1) PG8_BAR; }
    }
    PG8_WAIT_V(0);
    if constexpr (!ALIGN_EPI) { if (wr == 0) PG8_BAR; }
    PG8_BAR;
    if constexpr (Epi::AFTER_DRAIN) { E.fused(acc, cur, wr, wc, fr, fq, lds, wid, lane); S.done(cur); }
#undef PG8_SA
#undef PG8_SB
#undef PG8_STAGE
#undef PG8_LDA
#undef PG8_LDB
#undef PG8_MMA
#undef PG8_WAIT_V
#undef PG8_WAIT_L
#undef PG8_BAR
#undef PG8_SCHED
}
}
template <class T> __device__ __forceinline__ T* uni_ptr(T* p) {
    unsigned long long v = (unsigned long long)p; unsigned lo = __builtin_amdgcn_readfirstlane((unsigned)v), hi = __builtin_amdgcn_readfirstlane((unsigned)(v >> 32));
    unsigned long long r = ((unsigned long long)hi << 32) | lo; asm volatile("" : "+s"(r)); return (T*)r; }
__device__ __forceinline__ int rfl(int x) { int t = __builtin_amdgcn_readfirstlane(x); asm volatile("" : "+s"(t)); return t; }
namespace pg8 {
__device__ __forceinline__ unsigned cvt_pk_bf16(float lo, float hi) { unsigned r; asm volatile("v_cvt_pk_bf16_f32 %0, %1, %2" : "=v"(r) : "v"(lo), "v"(hi)); return r; }
struct EpiF32 {
    static constexpr bool PERM = false, AFTER_DRAIN = false;
    float* C; int ldc, Mreal, Nreal;
    __device__ __forceinline__ void operator()(const f32x4 (&acc)[2][2][4][2], const Unit& u, int wr, int wc, int fr, int fq) const {
        const int row0 = u.pm * BM + wr * 64 + fr, col0 = u.pn * BM + wc * 32 + 4 * fq;
#pragma unroll
        for (int ai = 0; ai < 2; ++ai)
#pragma unroll
            for (int m = 0; m < 4; ++m) { const int r = row0 + ai * HALF + m * 16; if (r < Mreal) { float* rowp = C + (size_t)r * ldc + col0;
#pragma unroll
                for (int bj = 0; bj < 2; ++bj)
#pragma unroll
                    for (int n = 0; n < 2; ++n) { const int c = col0 + bj * HALF + n * 16; if (c < Nreal) *(f32x4*)(rowp + bj * HALF + n * 16) = acc[ai][bj][m][n]; } } }
    }
};
struct EpiBf16Plain {
    static constexpr bool PERM = true, AFTER_DRAIN = false;
    bf16_t* O; int ldc;
    __device__ __forceinline__ void operator()(const f32x4 (&acc)[2][2][4][2], const Unit& u, int wr, int wc, int fr, int fq) const {
        const int row0 = u.pm * BM + wr * 64 + fr, col0 = u.pn * BM + wc * 32 + 8 * fq;
#pragma unroll
        for (int ai = 0; ai < 2; ++ai)
#pragma unroll
            for (int m = 0; m < 4; ++m) { bf16_t* rowp = O + (size_t)(row0 + ai * HALF + m * 16) * ldc + col0;
#pragma unroll
                for (int bj = 0; bj < 2; ++bj) { const f32x4 v0 = acc[ai][bj][m][0], v1 = acc[ai][bj][m][1]; u32x4 w;
                    w.x = cvt_pk_bf16(v0[0], v0[1]); w.y = cvt_pk_bf16(v0[2], v0[3]); w.z = cvt_pk_bf16(v1[0], v1[1]); w.w = cvt_pk_bf16(v1[2], v1[3]);
                    *(u32x4*)(rowp + bj * HALF) = w; } }
    }
};
struct EpiLru {
    static constexpr bool PERM = false, AFTER_DRAIN = false;
    const float* ba; const float* bx; const float* spl; const float* XC; float* AT; float* BT; int Mreal;
    __device__ __forceinline__ void operator()(const f32x4 (&acc)[2][2][4][2], const Unit& u, int wr, int wc, int fr, int fq) const {
        const int row0 = u.pm * BM + wr * 64 + fr, ch0 = u.pn * 128 + wc * 32 + 4 * fq;
#pragma unroll
        for (int n = 0; n < 2; ++n) { const int c = ch0 + 16 * n; const f32x4 ba4 = *(const f32x4*)(ba + c), bx4 = *(const f32x4*)(bx + c), sp4 = *(const f32x4*)(spl + c);
#pragma unroll
            for (int ai = 0; ai < 2; ++ai)
#pragma unroll
                for (int m = 0; m < 4; ++m) { const int r = row0 + ai * HALF + m * 16; if (r < Mreal) { const f32x4 xc = *(const f32x4*)(XC + (size_t)r * 512 + c); const f32x4 ga = acc[ai][0][m][n] + ba4, gx = acc[ai][1][m][n] + bx4; f32x4 at, bt;
#pragma unroll
                    for (int i = 0; i < 4; ++i) { const float gate_a = 1.f / (1.f + __expf(-ga[i])), gate_x = 1.f / (1.f + __expf(-gx[i])); const float la = gate_a * sp4[i]; at[i] = __expf(la); bt[i] = sqrtf(-expm1f(2.f * la)) * (gate_x * xc[i]); }
                    *(f32x4*)(AT + (size_t)r * 512 + c) = at; *(f32x4*)(BT + (size_t)r * 512 + c) = bt; } } }
    }
};
struct GroupOrder {
    const PG8_LAS Op* tab; int ng, nM, G, c; size_t tsA, tsB;
    __device__ __forceinline__ bool next(int i, Unit& u) const {
        int L = i * G + c, g = 0;
        for (; g < ng; ++g) { const int cnt = nM * (__builtin_amdgcn_readfirstlane(tab[g].i5) >> 8); if (L < cnt) break; L -= cnt; }
        if (g >= ng) return false;
        u.pm = L % nM; u.pn = L / nM; u.grp = g; u.pad_ = 0;
        u.A = (const char*)uni_ptr(tab[g].a) + (size_t)u.pm * tsA; u.B = (const char*)uni_ptr(tab[g].b) + (size_t)u.pn * tsB; return true;
    }
    __device__ __forceinline__ void a_ready(const Unit&) const {}
    __device__ __forceinline__ void done(const Unit&) const {}
};
struct EpiF32G {
    static constexpr bool PERM = false, AFTER_DRAIN = false;
    const PG8_LAS Op* tab; int Mreal;
    __device__ __forceinline__ void operator()(const f32x4 (&acc)[2][2][4][2], const Unit& u, int wr, int wc, int fr, int fq) const {
        float* C = uni_ptr(tab[u.grp].o0); const int ldc = __builtin_amdgcn_readfirstlane(tab[u.grp].i4), Nreal = __builtin_amdgcn_readfirstlane(tab[u.grp].i0);
        const EpiF32 E{C, ldc, Mreal, Nreal}; E(acc, u, wr, wc, fr, fq);
    }
};
}

#define XB_TMO      128
#define XB_XCNT(j)  (256  + 64 * (j))
#define XB_XSUB(j)  (1280 + 64 * (j))
#define XB_XGEN(j)  (2304 + 64 * (j))
#define XB_TOP      3328
#define XB_TOPGEN   3392
#define XCD_BAR_WORDS 3456
#define XB_SPIN_CAP (1u << 18)
#define LAS __attribute__((address_space(3)))
__device__ __forceinline__ unsigned xb_ld(unsigned* p)              { return __hip_atomic_load(p, __ATOMIC_RELAXED, __HIP_MEMORY_SCOPE_AGENT); }
__device__ __forceinline__ unsigned xb_add(unsigned* p, unsigned v) { return __hip_atomic_fetch_add(p, v, __ATOMIC_RELAXED, __HIP_MEMORY_SCOPE_AGENT); }
__device__ __forceinline__ unsigned xb_xcc_id() { return (unsigned)__builtin_amdgcn_s_getreg((3 << 11) | 20) & 0xFu; }
#define XB_SPIN(cond, bar) do { unsigned _sp = 0; while (cond) { __builtin_amdgcn_s_sleep(1); \
    if ((++_sp & 255u) == 0u) { if (xb_ld(&(bar)[XB_TMO])) break; if (_sp > XB_SPIN_CAP) { atomicAdd(&(bar)[XB_TMO], 1u); break; } } } } while (0)
struct XcdBarrier { unsigned* bar; unsigned x; volatile LAS unsigned* st; };
__device__ __forceinline__ XcdBarrier xcd_barrier_post(unsigned* bar, volatile LAS unsigned* st) {
    XcdBarrier b; b.bar = bar; b.x = xb_xcc_id(); b.st = st;
    if (threadIdx.x == 0) (void)xb_add(&bar[XB_XCNT(b.x)], 1u);
    return b;
}
__device__ __forceinline__ void xcd_barrier_complete(unsigned* bar, unsigned x, unsigned& nloc, unsigned& nx) {
    const unsigned G = gridDim.x * gridDim.y * gridDim.z;
    unsigned sum, cnt, mine, sp = 0u;
    for (;;) {
        sum = 0u; cnt = 0u; mine = 0u;
#pragma unroll
        for (unsigned j = 0; j < 16; ++j) { const unsigned c = xb_ld(&bar[XB_XCNT(j)]); sum += c; cnt += (c > 0u) ? 1u : 0u; mine = (j == x) ? c : mine; }
        if (sum == G) break;
        __builtin_amdgcn_s_sleep(1);
        if ((++sp & 255u) == 0u) { if (xb_ld(&bar[XB_TMO])) break; if (sp > XB_SPIN_CAP) { atomicAdd(&bar[XB_TMO], 1u); break; } }
    }
    nloc = mine > 0u ? mine : 1u; nx = cnt > 0u ? cnt : 1u;
}
__device__ __forceinline__ void xcd_barrier(const XcdBarrier& b) {
    asm volatile("s_waitcnt vmcnt(0)" ::: "memory");
    __syncthreads();
    if (threadIdx.x == 0) {
        unsigned* bar = b.bar;
        __builtin_amdgcn_s_waitcnt(0);
        unsigned nloc = b.st[0], nx = b.st[1];
        if (nloc == 0u) { xcd_barrier_complete(bar, b.x, nloc, nx); b.st[0] = nloc; b.st[1] = nx; }
        const unsigned old = xb_add(&bar[XB_XSUB(b.x)], 1u);
        const unsigned gen = old / nloc;
        if (old + 1u == (gen + 1u) * nloc) {
            __builtin_amdgcn_fence(__ATOMIC_RELEASE, "agent");
            asm volatile("s_waitcnt vmcnt(0)" ::: "memory");
            const unsigned og = xb_add(&bar[XB_TOP], 1u);
            const unsigned tg = og / nx;
            if (og + 1u == (tg + 1u) * nx) xb_add(&bar[XB_TOPGEN], 1u);
            else XB_SPIN(xb_ld(&bar[XB_TOPGEN]) == tg, bar);
            __builtin_amdgcn_fence(__ATOMIC_ACQUIRE, "agent");
            xb_add(&bar[XB_XGEN(b.x)], 1u);
            asm volatile("s_waitcnt vmcnt(0)" ::: "memory");
        } else {
            XB_SPIN(xb_ld(&bar[XB_XGEN(b.x)]) == gen, bar);
            __builtin_amdgcn_fence(__ATOMIC_ACQUIRE, "agent");
            asm volatile("s_waitcnt vmcnt(0)" ::: "memory");
        }
    }
    __syncthreads();
}

namespace fk {
#define GAS __attribute__((address_space(1)))
typedef unsigned u32x4 __attribute__((ext_vector_type(4)));
typedef unsigned u32x2 __attribute__((ext_vector_type(2)));
typedef float f32x4 __attribute__((ext_vector_type(4)));
typedef float f32x2 __attribute__((ext_vector_type(2)));
typedef __bf16 bf2 __attribute__((ext_vector_type(2)));
typedef unsigned short bf16_t;
__device__ __forceinline__ float bflo(unsigned u) { return __uint_as_float(u << 16); }
__device__ __forceinline__ float bfhi(unsigned u) { return __uint_as_float(u & 0xffff0000u); }
__device__ __forceinline__ float dot2(unsigned a, unsigned b, float c) { return __builtin_amdgcn_fdot2_f32_bf16(__builtin_bit_cast(bf2, a), __builtin_bit_cast(bf2, b), c, false); }
__device__ __forceinline__ unsigned pk_bf16(float lo, float hi) { unsigned r; asm volatile("v_cvt_pk_bf16_f32 %0, %1, %2" : "=v"(r) : "v"(lo), "v"(hi)); return r; }
template <int CTRL> __device__ __forceinline__ float dppf(float v) { return __int_as_float(__builtin_amdgcn_update_dpp(0, __float_as_int(v), CTRL, 0xf, 0xf, true)); }
__device__ __forceinline__ float row_max16(float v) { v = fmaxf(v, dppf<0xB1>(v)); v = fmaxf(v, dppf<0x4E>(v)); v = fmaxf(v, dppf<0x141>(v)); v = fmaxf(v, dppf<0x140>(v)); return v; }
__device__ __forceinline__ float row_sum16(float v) { v += dppf<0xB1>(v); v += dppf<0x4E>(v); v += dppf<0x141>(v); v += dppf<0x140>(v); return v; }
__device__ __forceinline__ float shx(float v, int m, int lane) { return __int_as_float(__builtin_amdgcn_ds_bpermute((lane ^ m) << 2, __float_as_int(v))); }
__device__ __forceinline__ float wave_sum(float v, int lane) { v = row_sum16(v); v += shx(v, 16, lane); v += shx(v, 32, lane); return v; }
__device__ __forceinline__ float gelu_tanh(float x) { return 0.5f * x * (1.f + tanhf(0.7978845608028654f * (x + 0.044715f * x * x * x))); }
#define FK_NEG (-3.0e38f)

template <int CTRL> __device__ __forceinline__ int dppi(int v) { return __builtin_amdgcn_update_dpp(0, v, CTRL, 0xf, 0xf, true); }
__device__ __forceinline__ int row_min16i(int v) { v = min(v, dppi<0xB1>(v)); v = min(v, dppi<0x4E>(v)); v = min(v, dppi<0x141>(v)); v = min(v, dppi<0x140>(v)); return v; }
#define FK_CE(a, b) do { const bool sw_ = v[b] > v[a]; const float tv_ = sw_ ? v[b] : v[a]; v[b] = sw_ ? v[a] : v[b]; v[a] = tv_; const int ti_ = sw_ ? id[b] : id[a]; id[b] = sw_ ? id[a] : id[b]; id[a] = ti_; } while (0)
#define FK_SORT8(v, id) do { FK_CE2(v, id, 0, 1); FK_CE2(v, id, 2, 3); FK_CE2(v, id, 4, 5); FK_CE2(v, id, 6, 7); FK_CE2(v, id, 0, 2); FK_CE2(v, id, 1, 3); FK_CE2(v, id, 4, 6); FK_CE2(v, id, 5, 7); FK_CE2(v, id, 1, 2); FK_CE2(v, id, 5, 6); \
    FK_CE2(v, id, 0, 4); FK_CE2(v, id, 1, 5); FK_CE2(v, id, 2, 6); FK_CE2(v, id, 3, 7); FK_CE2(v, id, 2, 4); FK_CE2(v, id, 3, 5); FK_CE2(v, id, 1, 2); FK_CE2(v, id, 3, 4); FK_CE2(v, id, 5, 6); } while (0)
#define FK_CE2(v, id, a, b) do { const bool sw_ = v[b] > v[a]; const float tv_ = sw_ ? v[b] : v[a]; v[b] = sw_ ? v[a] : v[b]; v[a] = tv_; const int ti_ = sw_ ? id[b] : id[a]; id[b] = sw_ ? id[a] : id[b]; id[a] = ti_; } while (0)
__device__ __forceinline__ void top16_of_128_x2(float (&v)[8], int (&id)[8], float (&u)[8], int (&jd)[8], int lane16, float& rv1, int& ri1, float& rv2, int& ri2) {
    FK_SORT8(v, id); FK_SORT8(u, jd);
    rv1 = FK_NEG; ri1 = 0; rv2 = FK_NEG; ri2 = 0;
#pragma unroll
    for (int r = 0; r < 16; ++r) {
        const float wm = row_max16(v[0]), xm = row_max16(u[0]);
        const int cand = (v[0] == wm) ? id[0] : 0x7fffffff, dand = (u[0] == xm) ? jd[0] : 0x7fffffff;
        const int sel = row_min16i(cand), tel = row_min16i(dand);
        const bool mine = (cand == sel), nine = (dand == tel);
        if (lane16 == r) { rv1 = wm; ri1 = sel; rv2 = xm; ri2 = tel; }
#pragma unroll
        for (int i = 0; i < 7; ++i) { v[i] = mine ? v[i + 1] : v[i]; id[i] = mine ? id[i + 1] : id[i]; u[i] = nine ? u[i + 1] : u[i]; jd[i] = nine ? jd[i + 1] : jd[i]; }
        v[7] = mine ? FK_NEG : v[7]; u[7] = nine ? FK_NEG : u[7];
    }
}
__device__ __forceinline__ int fk_key(float x, int lane16) { int k = __float_as_int(x); k ^= (k >> 31) & 0x7fffffff; return (k & ~15) | (15 - lane16); }
__device__ __forceinline__ float fk_unkey(int k) { k &= ~15; k ^= (k >> 31) & 0x7fffffff; return __int_as_float(k); }
__device__ __forceinline__ int row_max16i(int v) { v = max(v, dppi<0xB1>(v)); v = max(v, dppi<0x4E>(v)); v = max(v, dppi<0x141>(v)); v = max(v, dppi<0x140>(v)); return v; }
__device__ __forceinline__ void topk_phase(const GAS float* __restrict__ SC, const GAS bf16_t* __restrict__ Q, const GAS float* __restrict__ KSUM, GAS float* __restrict__ GATE, GAS int* __restrict__ EIDX, int nitems,
                                           LAS unsigned char* lds, int wid, int lane, int wave_gid, int nwaves) {
    LAS unsigned char* wb = lds + wid * 6144;
    LAS int* IDS1 = (LAS int*)wb; LAS int* IDS2 = (LAS int*)(wb + 2048); LAS int* LC1 = (LAS int*)(wb + 4096); LAS int* LC2 = (LAS int*)(wb + 4352); LAS int* CI = (LAS int*)(wb + 4608);
    LAS float* xv = (LAS float*)(wb + 4864); LAS int* DUMP = (LAS int*)(wb + 5120) + lane; LAS int* WL1 = (LAS int*)(wb + 5376); LAS int* WL2 = (LAS int*)(wb + 5632);
    const int lane16 = lane & 15, rowbase = lane & 48;
    for (int wi = wave_gid; wi * 4 < nitems; wi += nwaves) {
        const int it = wi * 4 + (lane >> 4); const int h = it & 7;
        const GAS u32x4* qp = (const GAS u32x4*)(Q + (size_t)it * 256 + 16 * lane16); const u32x4 qa = qp[0], qb = qp[1];
        float qs = 0.f, qq = 0.f;
#pragma unroll
        for (int i = 0; i < 4; ++i) { const float a = bflo(qa[i]), b = bfhi(qa[i]), c = bflo(qb[i]), d = bfhi(qb[i]); qs += (a + b) + (c + d); qq += (a * a + b * b) + (c * c + d * d); }
        const float mu = row_sum16(qs) * (1.f / 256.f); const float var = fmaxf(row_sum16(qq) * (1.f / 256.f) - mu * mu, 0.f); const float rs = 1.f / sqrtf(var + 1e-5f);
        float v[8], u[8]; int id[8], jd[8];
        { const GAS float* sp = SC + (size_t)it * 256 + 8 * lane16; const GAS float* kp = KSUM + h * 256 + 8 * lane16; const f32x4 s0 = *(const GAS f32x4*)sp, s1 = *(const GAS f32x4*)(sp + 4), k0 = *(const GAS f32x4*)kp, k1 = *(const GAS f32x4*)(kp + 4);
          const f32x4 t0 = *(const GAS f32x4*)(sp + 128), t1 = *(const GAS f32x4*)(sp + 132), m0 = *(const GAS f32x4*)(kp + 128), m1 = *(const GAS f32x4*)(kp + 132);
#pragma unroll
          for (int i = 0; i < 4; ++i) { v[i] = rs * (s0[i] - mu * k0[i]); v[4 + i] = rs * (s1[i] - mu * k1[i]); u[i] = rs * (t0[i] - mu * m0[i]); u[4 + i] = rs * (t1[i] - mu * m1[i]);
              id[i] = 8 * lane16 + i; id[4 + i] = 8 * lane16 + 4 + i; jd[i] = 8 * lane16 + i; jd[4 + i] = 8 * lane16 + 4 + i; } }
        FK_SORT8(v, id); FK_SORT8(u, jd);
#pragma unroll
        for (int i = 0; i < 8; ++i) { IDS1[lane * 8 + i] = id[i]; IDS2[lane * 8 + i] = jd[i]; }
        float rv1 = FK_NEG, rv2 = FK_NEG; int wl1 = 0, wl2 = 0, cn1 = 0, cn2 = 0;
#pragma unroll
        for (int r = 0; r < 16; ++r) {
            const int key1 = fk_key(v[0], lane16), key2 = fk_key(u[0], lane16);
            const int wm1 = row_max16i(key1), wm2 = row_max16i(key2);
            const bool mine = (key1 == wm1), nine = (key2 == wm2);
            if (lane16 == r) { rv1 = fk_unkey(wm1); wl1 = 15 - (wm1 & 15); rv2 = fk_unkey(wm2); wl2 = 15 - (wm2 & 15); }
            *(mine ? LC1 + rowbase + r : DUMP) = cn1; *(nine ? LC2 + rowbase + r : DUMP) = cn2;
#pragma unroll
            for (int i = 0; i < 7; ++i) { v[i] = mine ? v[i + 1] : v[i]; u[i] = nine ? u[i + 1] : u[i]; }
            v[7] = mine ? FK_NEG : v[7]; u[7] = nine ? FK_NEG : u[7]; cn1 += mine ? 1 : 0; cn2 += nine ? 1 : 0;
        }
        xv[lane] = rv2; WL1[lane] = wl1; WL2[lane] = wl2;
        float c[16];
        { const LAS f32x4* xp = (const LAS f32x4*)(xv + rowbase);
#pragma unroll
          for (int q = 0; q < 4; ++q) { const f32x4 t = xp[q]; c[4 * q] = rv1 + t.x; c[4 * q + 1] = rv1 + t.y; c[4 * q + 2] = rv1 + t.z; c[4 * q + 3] = rv1 + t.w; } }
        int p = 0, wli = 0; float sc = FK_NEG;
#pragma unroll
        for (int r = 0; r < 16; ++r) {
            const int key = fk_key(c[0], lane16); const int wm = row_max16i(key); const bool mine = (key == wm);
            if (lane16 == r) { sc = fk_unkey(wm); wli = 15 - (wm & 15); }
            *(mine ? CI + rowbase + r : DUMP) = p;
#pragma unroll
            for (int i = 0; i < 15; ++i) c[i] = mine ? c[i + 1] : c[i];
            c[15] = mine ? FK_NEG : c[15]; p += mine ? 1 : 0;
        }
        const int i1 = wli & 15, j2 = CI[rowbase + lane16] & 15;
        const int e1 = IDS1[(rowbase + (WL1[rowbase + i1] & 15)) * 8 + (LC1[rowbase + i1] & 7)], e2 = IDS2[(rowbase + (WL2[rowbase + j2] & 15)) * 8 + (LC2[rowbase + j2] & 7)];
        const float mx = fk_unkey(row_max16i(fk_key(sc, 0))); const float ex = __expf(sc - mx); const float den = row_sum16(ex);
        GATE[(size_t)it * 16 + lane16] = ex / den; EIDX[(size_t)it * 16 + lane16] = (e1 & 127) * 128 + (e2 & 127);
    }
}

__device__ __forceinline__ f32x2 fp8lo(unsigned w) { return __builtin_amdgcn_cvt_pk_f32_fp8((int)w, false); }
__device__ __forceinline__ f32x2 fp8hi(unsigned w) { return __builtin_amdgcn_cvt_pk_f32_fp8((int)w, true); }
__device__ __forceinline__ void act_phase(const GAS bf16_t* __restrict__ XB, const GAS unsigned char* __restrict__ U8, const GAS float* __restrict__ GATE, const GAS int* __restrict__ EIDX, GAS float* __restrict__ COEF, int nitems,
                                          int lane, int wave_gid, int nwaves) {
    int it = wave_gid; if (it >= nitems) return;
    u32x4 uc[16], un[16], xac, xbc, xan, xbn;
    int evc = EIDX[(size_t)it * 16 + (lane & 15)];
    { const GAS u32x4* xp = (const GAS u32x4*)(XB + (size_t)(it >> 3) * 1024 + 16 * lane); xac = xp[0]; xbc = xp[1]; }
#pragma unroll
    for (int k = 0; k < 16; ++k) uc[k] = *(const GAS u32x4*)(U8 + (size_t)__builtin_amdgcn_readlane(evc, k) * 1024 + 16 * lane);
    int itn = it + nwaves; int evn = (itn < nitems) ? EIDX[(size_t)itn * 16 + (lane & 15)] : 0;
    for (;;) {
        const bool hasn = itn < nitems;
        if (hasn) {
            const GAS u32x4* xp = (const GAS u32x4*)(XB + (size_t)(itn >> 3) * 1024 + 16 * lane); xan = xp[0]; xbn = xp[1];
#pragma unroll
            for (int k = 0; k < 16; ++k) un[k] = *(const GAS u32x4*)(U8 + (size_t)__builtin_amdgcn_readlane(evn, k) * 1024 + 16 * lane);
        }
        const int itnn = itn + nwaves; const int evnn = (itnn < nitems) ? EIDX[(size_t)itnn * 16 + (lane & 15)] : 0;
        const float gt = GATE[(size_t)it * 16 + (lane >> 2)];
        float x[16];
#pragma unroll
        for (int i = 0; i < 4; ++i) { x[2 * i] = bflo(xac[i]); x[2 * i + 1] = bfhi(xac[i]); x[8 + 2 * i] = bflo(xbc[i]); x[8 + 2 * i + 1] = bfhi(xbc[i]); }
        float a[16];
#pragma unroll
        for (int k = 0; k < 16; ++k) { const u32x4 uw = uc[k]; float s = 0.f;
#pragma unroll
            for (int d = 0; d < 4; ++d) { const f32x2 lo = fp8lo(uw[d]), hi = fp8hi(uw[d]); s = fmaf(lo.x, x[4 * d], s); s = fmaf(lo.y, x[4 * d + 1], s); s = fmaf(hi.x, x[4 * d + 2], s); s = fmaf(hi.y, x[4 * d + 3], s); }
            asm volatile("" : "+v"(s)); a[k] = s; }
#pragma unroll
        for (int k = 0; k < 8; ++k) { const bool hi = lane & 32; const float send = hi ? a[k] : a[k + 8], keep = hi ? a[k + 8] : a[k]; a[k] = keep + shx(send, 32, lane); }
#pragma unroll
        for (int k = 0; k < 4; ++k) { const bool hi = lane & 16; const float send = hi ? a[k] : a[k + 4], keep = hi ? a[k + 4] : a[k]; a[k] = keep + shx(send, 16, lane); }
#pragma unroll
        for (int k = 0; k < 2; ++k) { const bool hi = lane & 8; const float send = hi ? a[k] : a[k + 2], keep = hi ? a[k + 2] : a[k]; a[k] = keep + shx(send, 8, lane); }
        { const bool hi = lane & 4; const float send = hi ? a[0] : a[1], keep = hi ? a[1] : a[0]; a[0] = keep + shx(send, 4, lane); }
        float dsum = a[0]; dsum += shx(dsum, 2, lane); dsum += shx(dsum, 1, lane);
        if ((lane & 3) == 0) COEF[(size_t)it * 16 + (lane >> 2)] = gt * gelu_tanh(dsum * (1.f / 128.f));
        if (!hasn) break;
#pragma unroll
        for (int k = 0; k < 16; ++k) uc[k] = un[k];
        xac = xan; xbc = xbn; evc = evn; evn = evnn; it = itn; itn = itnn;
    }
}

__device__ __forceinline__ void outln_phase(const GAS float* COEF, const GAS int* EIDX, const GAS unsigned char* V8,     const GAS float* __restrict__ lg, const GAS float* __restrict__ lb, GAS float* X, GAS bf16_t* XB, int nrows,
                                            int lane, int wave_gid, int nwaves) {
    const float alpha = 1.6817928305074292f;
    int row = wave_gid; if (row >= nrows) return;
    u32x4 vc[16], vn[16];
    float cf0 = COEF[(size_t)row * 128 + lane] * (1.f / 64.f), cf1 = COEF[(size_t)row * 128 + 64 + lane] * (1.f / 64.f); int ev0 = EIDX[(size_t)row * 128 + lane], ev1 = EIDX[(size_t)row * 128 + 64 + lane];
#define OUT_LOADCH(dst, evreg, base) do { _Pragma("unroll") for (int k_ = 0; k_ < 16; ++k_) dst[k_] = *(const GAS u32x4*)(V8 + (size_t)__builtin_amdgcn_readlane(evreg, (base) + k_) * 1024 + 16 * lane); } while (0)
#define OUT_COMPCH(src, cfreg, base) do { _Pragma("unroll") for (int k_ = 0; k_ < 16; ++k_) { const float c_ = __int_as_float(__builtin_amdgcn_readlane(__float_as_int(cfreg), (base) + k_)); const u32x4 vw_ = src[k_]; \
        _Pragma("unroll") for (int d_ = 0; d_ < 4; ++d_) { const f32x2 lo_ = fp8lo(vw_[d_]), hi_ = fp8hi(vw_[d_]); acc[4 * d_] = fmaf(c_, lo_.x, acc[4 * d_]); acc[4 * d_ + 1] = fmaf(c_, lo_.y, acc[4 * d_ + 1]); acc[4 * d_ + 2] = fmaf(c_, hi_.x, acc[4 * d_ + 2]); acc[4 * d_ + 3] = fmaf(c_, hi_.y, acc[4 * d_ + 3]); } \
        _Pragma("unroll") for (int p_ = 0; p_ < 16; ++p_) asm volatile("" : "+v"(acc[p_]));     \
        } } while (0)
    for (;;) {
        OUT_LOADCH(vc, ev0, 0);
        const int rown = row + nwaves; const bool hasn = rown < nrows;
        float ncf0 = 0.f, ncf1 = 0.f; int nev0 = 0, nev1 = 0;
        if (hasn) { ncf0 = COEF[(size_t)rown * 128 + lane] * (1.f / 64.f); ncf1 = COEF[(size_t)rown * 128 + 64 + lane] * (1.f / 64.f); nev0 = EIDX[(size_t)rown * 128 + lane]; nev1 = EIDX[(size_t)rown * 128 + 64 + lane]; }
        float acc[16];
#pragma unroll
        for (int k = 0; k < 16; ++k) acc[k] = 0.f;
#define OUT_FENCE() asm volatile("" ::: "memory")
        OUT_LOADCH(vn, ev0, 16); OUT_FENCE(); OUT_COMPCH(vc, cf0, 0); OUT_FENCE();
        OUT_LOADCH(vc, ev0, 32); OUT_FENCE(); OUT_COMPCH(vn, cf0, 16); OUT_FENCE();
        OUT_LOADCH(vn, ev0, 48); OUT_FENCE(); OUT_COMPCH(vc, cf0, 32); OUT_FENCE();
        OUT_LOADCH(vc, ev1, 0);  OUT_FENCE(); OUT_COMPCH(vn, cf0, 48); OUT_FENCE();
        OUT_LOADCH(vn, ev1, 16); OUT_FENCE(); OUT_COMPCH(vc, cf1, 0); OUT_FENCE();
        OUT_LOADCH(vc, ev1, 32); OUT_FENCE(); OUT_COMPCH(vn, cf1, 16); OUT_FENCE();
        OUT_LOADCH(vn, ev1, 48); OUT_FENCE(); OUT_COMPCH(vc, cf1, 32); OUT_FENCE();
        OUT_COMPCH(vn, cf1, 48); OUT_FENCE();
#undef OUT_FENCE
        GAS float* xr = X + (size_t)row * 1024 + 16 * lane; float t[16];
#pragma unroll
        for (int q = 0; q < 4; ++q) { const f32x4 xv = *(const GAS f32x4*)(xr + 4 * q); t[4 * q] = fmaf(alpha, xv.x, acc[4 * q]); t[4 * q + 1] = fmaf(alpha, xv.y, acc[4 * q + 1]); t[4 * q + 2] = fmaf(alpha, xv.z, acc[4 * q + 2]); t[4 * q + 3] = fmaf(alpha, xv.w, acc[4 * q + 3]); }
        float s = 0.f;
#pragma unroll
        for (int k = 0; k < 16; ++k) s += t[k];
        const float mu = wave_sum(s, lane) * (1.f / 1024.f); float vs = 0.f;
#pragma unroll
        for (int k = 0; k < 16; ++k) { t[k] -= mu; vs = fmaf(t[k], t[k], vs); }
        const float rs = 1.f / sqrtf(wave_sum(vs, lane) * (1.f / 1024.f) + 1e-5f);
        unsigned w[8];
#pragma unroll
        for (int q = 0; q < 4; ++q) { const f32x4 g = *(const GAS f32x4*)(lg + 16 * lane + 4 * q), b = *(const GAS f32x4*)(lb + 16 * lane + 4 * q); f32x4 o;
            o.x = t[4 * q] * rs * g.x + b.x; o.y = t[4 * q + 1] * rs * g.y + b.y; o.z = t[4 * q + 2] * rs * g.z + b.z; o.w = t[4 * q + 3] * rs * g.w + b.w;
            *(GAS f32x4*)(xr + 4 * q) = o; w[2 * q] = pk_bf16(o.x, o.y); w[2 * q + 1] = pk_bf16(o.z, o.w); }
        u32x4 w0, w1; w0.x = w[0]; w0.y = w[1]; w0.z = w[2]; w0.w = w[3]; w1.x = w[4]; w1.y = w[5]; w1.z = w[6]; w1.w = w[7];
        GAS u32x4* xbp = (GAS u32x4*)(XB + (size_t)row * 1024 + 16 * lane); xbp[0] = w0; xbp[1] = w1;
        if (!hasn) break;
        row = rown; cf0 = ncf0; cf1 = ncf1; ev0 = nev0; ev1 = nev1;
    }
#undef OUT_LOADCH
#undef OUT_COMPCH
}

__device__ __forceinline__ void lnres_phase(const GAS bf16_t* __restrict__ Y, const GAS float* __restrict__ lg, const GAS float* __restrict__ lb, GAS float* X, GAS bf16_t* XB, int nrows, int lane, int wave_gid, int nwaves) {
    const float alpha = 1.6817928305074292f;
    for (int row = wave_gid; row < nrows; row += nwaves) {
        GAS float* xr = X + (size_t)row * 1024; const GAS bf16_t* yr = Y + (size_t)row * 1024; float t[16];
#pragma unroll
        for (int q = 0; q < 4; ++q) { const f32x4 xv = *(const GAS f32x4*)(xr + 256 * q + 4 * lane); const u32x2 yw = *(const GAS u32x2*)(yr + 256 * q + 4 * lane);
            t[4 * q] = fmaf(alpha, xv.x, bflo(yw.x)); t[4 * q + 1] = fmaf(alpha, xv.y, bfhi(yw.x)); t[4 * q + 2] = fmaf(alpha, xv.z, bflo(yw.y)); t[4 * q + 3] = fmaf(alpha, xv.w, bfhi(yw.y)); }
        float s = 0.f;
#pragma unroll
        for (int k = 0; k < 16; ++k) s += t[k];
        const float mu = wave_sum(s, lane) * (1.f / 1024.f); float vs = 0.f;
#pragma unroll
        for (int k = 0; k < 16; ++k) { t[k] -= mu; vs = fmaf(t[k], t[k], vs); }
        const float rs = 1.f / sqrtf(wave_sum(vs, lane) * (1.f / 1024.f) + 1e-5f);
#pragma unroll
        for (int q = 0; q < 4; ++q) { const int c = 256 * q + 4 * lane; const f32x4 g = *(const GAS f32x4*)(lg + c), b = *(const GAS f32x4*)(lb + c); f32x4 o;
            o.x = t[4 * q] * rs * g.x + b.x; o.y = t[4 * q + 1] * rs * g.y + b.y; o.z = t[4 * q + 2] * rs * g.z + b.z; o.w = t[4 * q + 3] * rs * g.w + b.w;
            *(GAS f32x4*)(xr + c) = o; u32x2 w; w.x = pk_bf16(o.x, o.y); w.y = pk_bf16(o.z, o.w); *(GAS u32x2*)(XB + (size_t)row * 1024 + c) = w; }
    }
}

__device__ __forceinline__ void glanorm_phase(const GAS float* __restrict__ O, const GAS float* __restrict__ PROJ, const GAS float* __restrict__ gnorm, GAS bf16_t* XB, int nitems, int lane, int wave_gid, int nwaves) {
    const float g0 = gnorm[lane], g1 = gnorm[64 + lane];
    for (int it0 = wave_gid * 4; it0 < nitems; it0 += nwaves * 4) {
        float a0[4], a1[4], r0[4], r1[4];
#pragma unroll
        for (int q = 0; q < 4; ++q) { int it = it0 + q; it = it < nitems ? it : it0; const int row = it >> 2, h = it & 3; const GAS float* o = O + (size_t)row * 512 + h * 128; const GAS float* r = PROJ + (size_t)row * 2576 + 1040 + h * 128;
            a0[q] = o[lane]; a1[q] = o[64 + lane]; r0[q] = r[lane]; r1[q] = r[64 + lane]; }
#pragma unroll
        for (int q = 0; q < 4; ++q) { const int it = it0 + q; const int row = it >> 2, h = it & 3;
            const float rs = 1.f / sqrtf(wave_sum(a0[q] * a0[q] + a1[q] * a1[q], lane) * (1.f / 128.f) + 1e-5f);
            const float y0 = a0[q] * rs * g0 * (r0[q] / (1.f + __expf(-r0[q]))), y1 = a1[q] * rs * g1 * (r1[q] / (1.f + __expf(-r1[q])));
            if (it < nitems) { GAS bf16_t* d = XB + (size_t)row * 1024 + h * 128; d[lane] = (bf16_t)(pk_bf16(y0, 0.f) & 0xffffu); d[64 + lane] = (bf16_t)(pk_bf16(y1, 0.f) & 0xffffu); } }
    }
}

__device__ __forceinline__ float sigm(float x) { return 1.f / (1.f + __expf(-x)); }
__device__ __forceinline__ float softplusf(float x) { return fmaxf(x, 0.f) + log1pf(__expf(-fabsf(x))); }
__device__ __forceinline__ void rwkvprep_phase(const GAS float* __restrict__ w0, const GAS float* __restrict__ a0, const GAS float* __restrict__ v0, const GAS float* __restrict__ k_k, const GAS float* __restrict__ k_a, const GAS float* __restrict__ Vg,
                                               GAS float* K, GAS float* Wd, GAS float* Aa, GAS float* V, GAS float* NKK, GAS float* VFIRST, int has_vres, int nitems, int lane, int wave_gid, int nwaves) {
    for (int it0 = wave_gid * 4; it0 < nitems; it0 += nwaves * 4) {
        float kq[4], wq[4], aq[4], vq[4], gq[4], fq[4];
#pragma unroll
        for (int q = 0; q < 4; ++q) { const int it = it0 + q; const size_t ix = (size_t)(it >> 4) * 1024 + (it & 15) * 64 + lane; kq[q] = K[ix]; wq[q] = Wd[ix]; aq[q] = Aa[ix]; vq[q] = V[ix]; gq[q] = has_vres ? Vg[ix] : 0.f; fq[q] = has_vres ? VFIRST[ix] : 0.f; }
#pragma unroll
        for (int q = 0; q < 4; ++q) { const int it = it0 + q; const int h = it & 15; const size_t ix = (size_t)(it >> 4) * 1024 + h * 64 + lane; const int c = h * 64 + lane;
            const float k0 = kq[q]; const float kv = k0 * k_k[c]; const float inv = 1.f / fmaxf(sqrtf(wave_sum(kv * kv, lane)), 1e-12f);
            const float w = -softplusf(-(w0[c] + wq[q])) - 0.5f; const float dec = __expf(-__expf(w));
            const float a = sigm(a0[c] + aq[q]);
            float v = vq[q]; if (has_vres) v = v + (fq[q] - v) * sigm(v0[c] + gq[q]); else VFIRST[ix] = v;
            const float kk = kv * inv;
            NKK[ix] = -kk; K[ix] = k0 * (1.f + (a - 1.f) * k_a[c]); Wd[ix] = dec; Aa[ix] = kk * a; V[ix] = v; }
    }
}

__device__ __forceinline__ void rwkvpost_phase(const GAS float* __restrict__ Y, const GAS float* __restrict__ R, const GAS float* __restrict__ K2, const GAS float* __restrict__ V, const GAS float* __restrict__ G, const GAS float* __restrict__ r_k,
                                               const GAS float* __restrict__ lnx_g, const GAS float* __restrict__ lnx_b, GAS bf16_t* XB, int nitems, int lane, int wave_gid, int nwaves) {
    for (int it0 = wave_gid * 4; it0 < nitems; it0 += nwaves * 4) {
        float yq[4], rq[4], kq[4], vq[4], gq[4];
#pragma unroll
        for (int q = 0; q < 4; ++q) { const int it = it0 + q; const size_t ix = (size_t)(it >> 4) * 1024 + (it & 15) * 64 + lane; yq[q] = Y[ix]; rq[q] = R[ix]; kq[q] = K2[ix]; vq[q] = V[ix]; gq[q] = G[ix]; }
#pragma unroll
        for (int q = 0; q < 4; ++q) { const int it = it0 + q; const int h = it & 15; const size_t ix = (size_t)(it >> 4) * 1024 + h * 64 + lane; const int c = h * 64 + lane;
            const float y = yq[q]; const float mu = wave_sum(y, lane) * (1.f / 64.f); const float d = y - mu; const float rs = 1.f / sqrtf(wave_sum(d * d, lane) * (1.f / 64.f) + 64e-5f);
            const float bon = wave_sum(rq[q] * kq[q] * r_k[c], lane);
            const float o = (d * rs * lnx_g[c] + lnx_b[c] + bon * vq[q]) * gq[q];
            XB[ix] = (bf16_t)(pk_bf16(o, 0.f) & 0xffffu); }
    }
}

__device__ __forceinline__ void wkv_phase(const GAS float* __restrict__ R, const GAS float* __restrict__ Wd, const GAS float* __restrict__ K2, const GAS float* __restrict__ V, const GAS float* __restrict__ BB, const GAS float* __restrict__ NKK,
                                          const GAS float* __restrict__ SIN, GAS float* __restrict__ Y, GAS float* __restrict__ P, GAS float* __restrict__ SOUT, int B, int T, int DB, int DT, LAS unsigned char* lds, int tid, int bid, int nb) {
    constexpr int TB = 32, NLD = 6, VECB = TB * 1280, VVB = TB * 128, BUF = VECB + 2 * VVB;
    const int rowl = tid >> 4, part = tid & 15;
    const int nprompt = B * 32, nunits = nprompt + DB * 32;
    for (int u = bid; u < nunits; u += nb) {
        const bool smp = u >= nprompt; const int q0_ = smp ? u - nprompt : u; const int q = ((q0_ & 7) << 1 | ((q0_ >> 3) & 1)) + ((q0_ >> 4) << 4);
        const int half = q & 1, pair = q >> 1, sq = pair >> 4, h = pair & 15;
        const int Tu = smp ? DT : T; const int r0 = smp ? B * T + sq * DT : sq * T, vrow = half * 32 + rowl;
        f32x2 S01 = (f32x2){0.f, 0.f}, S23 = (f32x2){0.f, 0.f};
        if (smp) { const f32x4 s4 = *(const GAS f32x4*)(SIN + ((size_t)pair * 64 + vrow) * 64 + part * 4); S01 = (f32x2){s4.x, s4.y}; S23 = (f32x2){s4.z, s4.w};
                   asm volatile("" : "+v"(S01), "+v"(S23)); }
        const int nblk = (Tu + TB - 1) / TB;
        f32x4 ld[NLD];
        const size_t eo_ = (size_t)(r0 + (tid >> 4)) * 1024 + h * 64 + (tid & 15) * 4, ev_ = (size_t)(r0 + ((tid & 255) >> 3)) * 1024 + h * 64 + half * 32 + (tid & 7) * 4;
        const int lo_ = ((tid >> 4) * 320 + (tid & 15) * 4) * 4, lv_ = VECB + (tid & 255) * 16;
#define WKV_LOAD(tb0) do { const size_t bo_ = (size_t)(tb0) * 1024; ld[0] = *(const GAS f32x4*)(Wd + eo_ + bo_); ld[1] = *(const GAS f32x4*)(NKK + eo_ + bo_); ld[2] = *(const GAS f32x4*)(BB + eo_ + bo_); \
            ld[3] = *(const GAS f32x4*)(K2 + eo_ + bo_); ld[4] = *(const GAS f32x4*)(R + eo_ + bo_); ld[5] = *(const GAS f32x4*)(V + ev_ + bo_); } while (0)
#define WKV_STORE(bufp) do { _Pragma("unroll") for (int q_ = 0; q_ < 5; ++q_) *(LAS f32x4*)((bufp) + lo_ + q_ * 256) = ld[q_]; *(LAS f32x4*)((bufp) + lv_) = ld[5]; } while (0)
        WKV_LOAD(0); WKV_STORE(lds); __syncthreads();
        for (int b = 0; b < nblk; ++b) {
            LAS unsigned char* cur = lds + (b & 1) * BUF; LAS unsigned char* nxt = lds + ((b + 1) & 1) * BUF; const int tb0 = b * TB; const int nt = (Tu - tb0) < TB ? (Tu - tb0) : TB;
            if (b + 1 < nblk) WKV_LOAD(tb0 + TB);
            const LAS float* vec = (const LAS float*)cur + part * 4; const LAS float* vv = (const LAS float*)(cur + VECB) + rowl; LAS float* yb = (LAS float*)(cur + VECB + VVB);
            float ykeep0 = 0.f, ykeep1 = 0.f;
#define WKV_STEP(t, keep, tl) do { const LAS f32x2* vp_ = (const LAS f32x2*)(vec + (t) * 320); \
                const f32x2 w01 = vp_[0], w23 = vp_[1], n01 = vp_[32], n23 = vp_[33], b01 = vp_[64], b23 = vp_[65], k01 = vp_[96], k23 = vp_[97], r01 = vp_[128], r23 = vp_[129]; \
                const float v = vv[(t) * 32]; \
                const f32x2 sp = __builtin_elementwise_fma(S23, n23, S01 * n01); const float sa = row_sum16(sp.x + sp.y); const f32x2 sa2 = (f32x2){sa, sa}, v2 = (f32x2){v, v}; \
                S01 = __builtin_elementwise_fma(S01, w01, __builtin_elementwise_fma(b01, sa2, k01 * v2)); S23 = __builtin_elementwise_fma(S23, w23, __builtin_elementwise_fma(b23, sa2, k23 * v2)); \
                const f32x2 yp = __builtin_elementwise_fma(S23, r23, S01 * r01); const float y = row_sum16(yp.x + yp.y); \
                keep = (part == (tl)) ? y : keep; } while (0)
            if (nt == TB) {
#pragma unroll 1
                for (int t = 0; t < 16; t += 8) { WKV_STEP(t, ykeep0, t); WKV_STEP(t + 1, ykeep0, t + 1); WKV_STEP(t + 2, ykeep0, t + 2); WKV_STEP(t + 3, ykeep0, t + 3); WKV_STEP(t + 4, ykeep0, t + 4); WKV_STEP(t + 5, ykeep0, t + 5); WKV_STEP(t + 6, ykeep0, t + 6); WKV_STEP(t + 7, ykeep0, t + 7); }
#pragma unroll 1
                for (int t = 16; t < 32; t += 8) { WKV_STEP(t, ykeep1, t - 16); WKV_STEP(t + 1, ykeep1, t - 15); WKV_STEP(t + 2, ykeep1, t - 14); WKV_STEP(t + 3, ykeep1, t - 13); WKV_STEP(t + 4, ykeep1, t - 12); WKV_STEP(t + 5, ykeep1, t - 11); WKV_STEP(t + 6, ykeep1, t - 10); WKV_STEP(t + 7, ykeep1, t - 9); }
            } else { for (int t = 0; t < nt; ++t) { if (t < 16) WKV_STEP(t, ykeep0, t); else WKV_STEP(t, ykeep1, t - 16); } }
#undef WKV_STEP
            yb[part * 32 + rowl] = ykeep0; yb[(16 + part) * 32 + rowl] = ykeep1;
            if (b + 1 < nblk) WKV_STORE(nxt);
            __syncthreads();
            { const int rl = tid & 31; _Pragma("unroll") for (int t = tid >> 5; t < TB; t += 16) if (t < nt) Y[(size_t)(r0 + tb0 + t) * 1024 + h * 64 + half * 32 + rl] = yb[t * 32 + rl]; }
        }
#undef WKV_LOAD
#undef WKV_STORE
        *(GAS f32x4*)((smp ? SOUT : P) + ((size_t)pair * 64 + vrow) * 64 + part * 4) = (f32x4){S01.x, S01.y, S23.x, S23.y};
        __syncthreads();
    }
}

__device__ __forceinline__ void rwkvpost2_phase(const GAS float* __restrict__ Y, const GAS float* __restrict__ G, const GAS float* __restrict__ VF, const GAS float* __restrict__ BON, const GAS float* __restrict__ lnx_g, const GAS float* __restrict__ lnx_b,
                                                GAS bf16_t* XB, int nitems, int lane, int wave_gid, int nwaves) {
    for (int it0 = wave_gid * 4; it0 < nitems; it0 += nwaves * 4) {
        float yq[4], gq[4], vq[4], bq[4];
#pragma unroll
        for (int q = 0; q < 4; ++q) { const int it = it0 + q; const size_t ix = (size_t)(it >> 4) * 1024 + (it & 15) * 64 + lane; yq[q] = Y[ix]; gq[q] = G[ix]; vq[q] = VF[ix]; bq[q] = BON[it]; }
#pragma unroll
        for (int q = 0; q < 4; ++q) { const int it = it0 + q; const int h = it & 15; const size_t ix = (size_t)(it >> 4) * 1024 + h * 64 + lane; const int c = h * 64 + lane;
            const float y = yq[q]; const float mu = wave_sum(y, lane) * (1.f / 64.f); const float d = y - mu; const float rs = 1.f / sqrtf(wave_sum(d * d, lane) * (1.f / 64.f) + 64e-5f);
            const float o = (d * rs * lnx_g[c] + lnx_b[c] + bq[q] * vq[q]) * gq[q];
            XB[ix] = (bf16_t)(pk_bf16(o, 0.f) & 0xffffu); }
    }
}

__device__ __forceinline__ void wkv2_phase(const GAS float* __restrict__ R, const GAS float* __restrict__ KR, const GAS float* __restrict__ WL, const GAS float* __restrict__ AL, const GAS float* __restrict__ V, const GAS float* __restrict__ VG,
                                           const GAS float* VFI, const GAS float* __restrict__ PRM, const GAS float* __restrict__ SIN, GAS float* __restrict__ Y, GAS float* __restrict__ P, GAS float* __restrict__ SOUT, GAS float* VFO, GAS float* __restrict__ BON,
                                           int has_vres, int B, int T, int DB, int DT, LAS unsigned char* lds, int tid, int bid, int nb) {
    constexpr int TB = 32, NLD = 7, VECB = TB * 1280, VVB = TB * 128, BUF = VECB + 2 * VVB;
    const int rowl = tid >> 4, part = tid & 15;
    const int nprompt = B * 32, nunits = nprompt + DB * 32;
    for (int u = bid; u < nunits; u += nb) {
        const bool smp = u >= nprompt; const int q0_ = smp ? u - nprompt : u; const int q = ((q0_ & 7) << 1 | ((q0_ >> 3) & 1)) + ((q0_ >> 4) << 4);
        const int half = q & 1, pair = q >> 1, sq = pair >> 4, h = pair & 15;
        const int Tu = smp ? DT : T; const int r0 = smp ? B * T + sq * DT : sq * T, vrow = half * 32 + rowl;
        f32x2 S01 = (f32x2){0.f, 0.f}, S23 = (f32x2){0.f, 0.f};
        if (smp) { const f32x4 s4 = *(const GAS f32x4*)(SIN + ((size_t)pair * 64 + vrow) * 64 + part * 4); S01 = (f32x2){s4.x, s4.y}; S23 = (f32x2){s4.z, s4.w};
                   asm volatile("" : "+v"(S01), "+v"(S23)); }
        const int nblk = (Tu + TB - 1) / TB;
        f32x4 ld[NLD];
        const size_t eo_ = (size_t)(r0 + (tid >> 4)) * 1024 + h * 64 + (tid & 15) * 4, ev_ = (size_t)(r0 + ((tid & 255) >> 3)) * 1024 + h * 64 + half * 32 + (tid & 7) * 4;
        const int lo_ = ((tid >> 4) * 320 + (tid & 15) * 4) * 4, lv_ = VECB + (tid & 255) * 16;
        const int pc_ = h * 64 + (tid & 15) * 4; const f32x4 w0v = *(const GAS f32x4*)(PRM + pc_), a0v = *(const GAS f32x4*)(PRM + 1024 + pc_), kkp = *(const GAS f32x4*)(PRM + 3072 + pc_), kap = *(const GAS f32x4*)(PRM + 4096 + pc_), rkp = *(const GAS f32x4*)(PRM + 5120 + pc_);
        const f32x4 v0v = *(const GAS f32x4*)(PRM + 2048 + h * 64 + half * 32 + (tid & 7) * 4);
#define WKV_LOAD(tb0) do { const size_t bo_ = (size_t)(tb0) * 1024; ld[0] = *(const GAS f32x4*)(KR + eo_ + bo_); ld[1] = *(const GAS f32x4*)(WL + eo_ + bo_); ld[2] = *(const GAS f32x4*)(AL + eo_ + bo_); \
            ld[3] = *(const GAS f32x4*)(R + eo_ + bo_); ld[4] = *(const GAS f32x4*)(V + ev_ + bo_); if (has_vres) { ld[5] = *(const GAS f32x4*)(VG + ev_ + bo_); ld[6] = *(const GAS f32x4*)(VFI + ev_ + bo_); } } while (0)
#define WKV_STORE(bufp, tb0) do { const f32x4 k4 = ld[0]; const f32x4 kv = k4 * kkp; const float ss = row_sum16((kv.x * kv.x + kv.y * kv.y) + (kv.z * kv.z + kv.w * kv.w)); const float inv = 1.f / fmaxf(sqrtf(ss), 1e-12f); \
            f32x4 dec, a4; _Pragma("unroll") for (int i_ = 0; i_ < 4; ++i_) { dec[i_] = __expf(-0.6065306597126334f / (1.f + __expf(-(w0v[i_] + ld[1][i_])))); a4[i_] = 1.f / (1.f + __expf(-(a0v[i_] + ld[2][i_]))); } \
            const f32x4 kk = kv * inv; const f32x4 k2 = k4 * ((a4 - 1.f) * kap + 1.f); const f32x4 r4 = ld[3]; const f32x4 rk = r4 * k2 * rkp; const float bon = row_sum16((rk.x + rk.y) + (rk.z + rk.w)); \
            *(LAS f32x4*)((bufp) + lo_) = dec; *(LAS f32x4*)((bufp) + lo_ + 256) = -kk; *(LAS f32x4*)((bufp) + lo_ + 512) = kk * a4; *(LAS f32x4*)((bufp) + lo_ + 768) = k2; *(LAS f32x4*)((bufp) + lo_ + 1024) = r4; \
            const int tr_ = (tb0) + (tid >> 4); if (half == 0 && (tid & 15) == 0 && tr_ < Tu) BON[(size_t)(r0 + tr_) * 16 + h] = bon; \
            f32x4 v4 = ld[4]; if (has_vres) { _Pragma("unroll") for (int i_ = 0; i_ < 4; ++i_) v4[i_] = v4[i_] + (ld[6][i_] - v4[i_]) / (1.f + __expf(-(v0v[i_] + ld[5][i_]))); } \
            *(LAS f32x4*)((bufp) + lv_) = v4; const int tv_ = (tb0) + ((tid & 255) >> 3); if (tid < 256 && tv_ < Tu) *(GAS f32x4*)(VFO + ev_ + (size_t)(tb0) * 1024) = v4; } while (0)
        WKV_LOAD(0); WKV_STORE(lds, 0); __syncthreads();
        for (int b = 0; b < nblk; ++b) {
            LAS unsigned char* cur = lds + (b & 1) * BUF; LAS unsigned char* nxt = lds + ((b + 1) & 1) * BUF; const int tb0 = b * TB; const int nt = (Tu - tb0) < TB ? (Tu - tb0) : TB;
            if (b + 1 < nblk) WKV_LOAD(tb0 + TB);
            const LAS float* vec = (const LAS float*)cur + part * 4; const LAS float* vv = (const LAS float*)(cur + VECB) + rowl; LAS float* yb = (LAS float*)(cur + VECB + VVB);
            float ykeep0 = 0.f, ykeep1 = 0.f;
#define WKV_STEP(t, keep, tl) do { const LAS f32x2* vp_ = (const LAS f32x2*)(vec + (t) * 320); \
                const f32x2 w01 = vp_[0], w23 = vp_[1], n01 = vp_[32], n23 = vp_[33], b01 = vp_[64], b23 = vp_[65], k01 = vp_[96], k23 = vp_[97], r01 = vp_[128], r23 = vp_[129]; \
                const float v = vv[(t) * 32]; \
                const f32x2 sp = __builtin_elementwise_fma(S23, n23, S01 * n01); const float sa = row_sum16(sp.x + sp.y); const f32x2 sa2 = (f32x2){sa, sa}, v2 = (f32x2){v, v}; \
                S01 = __builtin_elementwise_fma(S01, w01, __builtin_elementwise_fma(b01, sa2, k01 * v2)); S23 = __builtin_elementwise_fma(S23, w23, __builtin_elementwise_fma(b23, sa2, k23 * v2)); \
                const f32x2 yp = __builtin_elementwise_fma(S23, r23, S01 * r01); const float y = row_sum16(yp.x + yp.y); \
                keep = (part == (tl)) ? y : keep; } while (0)
            if (nt == TB) {
#pragma unroll 1
                for (int t = 0; t < 16; t += 8) { WKV_STEP(t, ykeep0, t); WKV_STEP(t + 1, ykeep0, t + 1); WKV_STEP(t + 2, ykeep0, t + 2); WKV_STEP(t + 3, ykeep0, t + 3); WKV_STEP(t + 4, ykeep0, t + 4); WKV_STEP(t + 5, ykeep0, t + 5); WKV_STEP(t + 6, ykeep0, t + 6); WKV_STEP(t + 7, ykeep0, t + 7); }
#pragma unroll 1
                for (int t = 16; t < 32; t += 8) { WKV_STEP(t, ykeep1, t - 16); WKV_STEP(t + 1, ykeep1, t - 15); WKV_STEP(t + 2, ykeep1, t - 14); WKV_STEP(t + 3, ykeep1, t - 13); WKV_STEP(t + 4, ykeep1, t - 12); WKV_STEP(t + 5, ykeep1, t - 11); WKV_STEP(t + 6, ykeep1, t - 10); WKV_STEP(t + 7, ykeep1, t - 9); }
            } else { for (int t = 0; t < nt; ++t) { if (t < 16) WKV_STEP(t, ykeep0, t); else WKV_STEP(t, ykeep1, t - 16); } }
#undef WKV_STEP
            yb[part * 32 + rowl] = ykeep0; yb[(16 + part) * 32 + rowl] = ykeep1;
            if (b + 1 < nblk) WKV_STORE(nxt, tb0 + TB);
            __syncthreads();
            { const int rl = tid & 31; _Pragma("unroll") for (int t = tid >> 5; t < TB; t += 16) if (t < nt) Y[(size_t)(r0 + tb0 + t) * 1024 + h * 64 + half * 32 + rl] = yb[t * 32 + rl]; }
        }
#undef WKV_LOAD
#undef WKV_STORE
        *(GAS f32x4*)((smp ? SOUT : P) + ((size_t)pair * 64 + vrow) * 64 + part * 4) = (f32x4){S01.x, S01.y, S23.x, S23.y};
        __syncthreads();
    }
}

__device__ __forceinline__ void gla_phase(const GAS float* __restrict__ PROJ, const GAS float* __restrict__ LOGA, GAS float* __restrict__ O, GAS float* __restrict__ P, int B, int T, LAS unsigned char* lds, int tid, int bid, int nb) {
    constexpr int TB = 32, NLD = 4, VECB = TB * 768, VVB = TB * 64, BUF = VECB + 3 * VVB;
    const int col = tid >> 5, half = (tid >> 4) & 1, p = tid & 15, dk = half * 32 + p * 2;
    const int nunits = B * 32;
    for (int u = bid; u < nunits; u += nb) {
        const int ug_ = ((u & 7) << 3 | ((u >> 3) & 7)) + ((u >> 6) << 6);
        const int cb = ug_ & 7, pair = ug_ >> 3, s = pair >> 2, h = pair & 3; const int r0 = s * T;
        float S0 = 0.f, S1 = 0.f;
        const int nblk = (T + TB - 1) / TB;
        f32x4 ld[NLD];
        const size_t ea_ = (size_t)(r0 + (tid >> 4)) * 256 + h * 64 + (tid & 15) * 4, ep_ = (size_t)(r0 + (tid >> 4)) * 2576 + h * 64 + (tid & 15) * 4, ev_ = (size_t)(r0 + ((tid & 127) >> 2)) * 2576 + 512 + h * 128 + cb * 16 + (tid & 3) * 4;
        const int lo_ = ((tid >> 4) * 192 + (tid & 15) * 4) * 4, lv_ = VECB + (tid & 127) * 16;
#define GLA_LOAD(tb0) do { ld[0] = *(const GAS f32x4*)(LOGA + ea_ + (size_t)(tb0) * 256); ld[1] = *(const GAS f32x4*)(PROJ + ep_ + 256 + (size_t)(tb0) * 2576); ld[2] = *(const GAS f32x4*)(PROJ + ep_ + (size_t)(tb0) * 2576); ld[3] = *(const GAS f32x4*)(PROJ + ev_ + (size_t)(tb0) * 2576); } while (0)
#define GLA_STORE(bufp) do { *(LAS f32x4*)((bufp) + lo_) = ld[0]; *(LAS f32x4*)((bufp) + lo_ + 256) = ld[1]; *(LAS f32x4*)((bufp) + lo_ + 512) = ld[2] * 0.125f; *(LAS f32x4*)((bufp) + lv_) = ld[3]; } while (0)
        GLA_LOAD(0); GLA_STORE(lds); __syncthreads();
        for (int b = 0; b < nblk; ++b) {
            LAS unsigned char* cur = lds + (b & 1) * BUF; LAS unsigned char* nxt = lds + ((b + 1) & 1) * BUF; const int tb0 = b * TB; const int nt = (T - tb0) < TB ? (T - tb0) : TB;
            if (b + 1 < nblk) GLA_LOAD(tb0 + TB);
            const LAS float* vec = (const LAS float*)cur + dk; const LAS float* vv = (const LAS float*)(cur + VECB) + col; LAS float* ob = (LAS float*)(cur + VECB + VVB);
            float okeep0 = 0.f, okeep1 = 0.f;
#define GLA_STEP(t, keep, tl) do { const f32x2 a2 = *(const LAS f32x2*)(vec + (t) * 192), k2 = *(const LAS f32x2*)(vec + (t) * 192 + 64), q2 = *(const LAS f32x2*)(vec + (t) * 192 + 128); const float v = vv[(t) * 16]; \
                S0 = fmaf(a2.x, S0, k2.x * v); S1 = fmaf(a2.y, S1, k2.y * v); \
                float o = fmaf(q2.x, S0, q2.y * S1); o = row_sum16(o); keep = (p == (tl)) ? o : keep; } while (0)
            if (nt == TB) {
#pragma unroll 1
                for (int t = 0; t < 16; t += 4) { GLA_STEP(t, okeep0, t); GLA_STEP(t + 1, okeep0, t + 1); GLA_STEP(t + 2, okeep0, t + 2); GLA_STEP(t + 3, okeep0, t + 3); }
#pragma unroll 1
                for (int t = 16; t < 32; t += 4) { GLA_STEP(t, okeep1, t - 16); GLA_STEP(t + 1, okeep1, t - 15); GLA_STEP(t + 2, okeep1, t - 14); GLA_STEP(t + 3, okeep1, t - 13); }
            } else { for (int t = 0; t < nt; ++t) { if (t < 16) GLA_STEP(t, okeep0, t); else GLA_STEP(t, okeep1, t - 16); } }
#undef GLA_STEP
            ob[(p * 16 + col) * 2 + half] = okeep0; ob[((16 + p) * 16 + col) * 2 + half] = okeep1;
            if (b + 1 < nblk) GLA_STORE(nxt);
            __syncthreads();
            { const int t = tid >> 4, c = tid & 15; if (t < nt) { const f32x2 o2 = *(const LAS f32x2*)(ob + (t * 16 + c) * 2); O[(size_t)(r0 + tb0 + t) * 512 + h * 128 + cb * 16 + c] = o2.x + o2.y; } }
        }
#undef GLA_LOAD
#undef GLA_STORE
        { GAS float* so = P + ((size_t)pair * 64 + dk) * 128 + cb * 16 + col; so[0] = S0; so[128] = S1; }
        __syncthreads();
    }
}
__device__ __forceinline__ float grp8_sum(float v) { v += dppf<0xB1>(v); v += dppf<0x4E>(v); v += dppf<0x141>(v); return v; }
__device__ __forceinline__ float dot16_fp8_bf16(const u32x4 uw, const float (&x)[16]) { float s = 0.f;
#pragma unroll
    for (int d = 0; d < 4; ++d) { const f32x2 lo = fp8lo(uw[d]), hi = fp8hi(uw[d]); s = fmaf(lo.x, x[4 * d], s); s = fmaf(lo.y, x[4 * d + 1], s); s = fmaf(hi.x, x[4 * d + 2], s); s = fmaf(hi.y, x[4 * d + 3], s); }
    return s; }
__device__ __forceinline__ void pacts_phase(const GAS bf16_t* __restrict__ XB, const GAS unsigned char* __restrict__ U8S, const GAS int* __restrict__ EIDX, GAS float* __restrict__ PART, int M,
                                            int wid, int lane, int bid, int nb) {
    const bool spl = (nb & 7) == 0; const int s0 = spl ? (bid & 7) : 0, s1 = spl ? s0 + 1 : 8, r = spl ? (bid >> 3) : bid, nr = spl ? (nb >> 3) : nb;
    const int g = lane >> 3, ch = lane & 7, h = wid;
    constexpr int NB = 8;
    for (int s = s0; s < s1; ++s) {
        const GAS unsigned char* tb = U8S + (size_t)s * 16384 * 128 + ch * 16; GAS float* po = PART + (size_t)s * M * 128;
        int e0[NB], e1[NB], f0[NB], f1[NB];
#pragma unroll
        for (int q = 0; q < NB; ++q) { int row = r + nr * q; row = row < M ? row : r; e0[q] = EIDX[((size_t)row * 8 + h) * 16 + g]; e1[q] = EIDX[((size_t)row * 8 + h) * 16 + 8 + g]; }
        for (int row0 = r; row0 < M; row0 += nr * NB) {
#pragma unroll
            for (int q = 0; q < NB; ++q) { int row = row0 + nr * (NB + q); row = row < M ? row : r; f0[q] = EIDX[((size_t)row * 8 + h) * 16 + g]; f1[q] = EIDX[((size_t)row * 8 + h) * 16 + 8 + g]; }
            u32x4 u0[NB], u1[NB], xa[NB], xb[NB];
#pragma unroll
            for (int q = 0; q < NB; ++q) { int row = row0 + nr * q; row = row < M ? row : r; u0[q] = *(const GAS u32x4*)(tb + (size_t)e0[q] * 128); u1[q] = *(const GAS u32x4*)(tb + (size_t)e1[q] * 128);
                const GAS u32x4* xp = (const GAS u32x4*)(XB + (size_t)row * 1024 + s * 128 + ch * 16); xa[q] = xp[0]; xb[q] = xp[1]; }
#pragma unroll
            for (int q = 0; q < NB; ++q) { const int row = row0 + nr * q; float x[16];
#pragma unroll
                for (int i = 0; i < 4; ++i) { x[2 * i] = bflo(xa[q][i]); x[2 * i + 1] = bfhi(xa[q][i]); x[8 + 2 * i] = bflo(xb[q][i]); x[8 + 2 * i + 1] = bfhi(xb[q][i]); }
                float p0 = dot16_fp8_bf16(u0[q], x), p1 = dot16_fp8_bf16(u1[q], x);
                p0 = grp8_sum(p0); p1 = grp8_sum(p1);
                asm volatile("" : "+v"(p0), "+v"(p1));
                if (ch == 0 && row < M) { GAS float* d = po + ((size_t)row * 8 + h) * 16 + g; d[0] = p0; d[8] = p1; } }
#pragma unroll
            for (int q = 0; q < NB; ++q) { e0[q] = f0[q]; e1[q] = f1[q]; }
        }
    }
}
__device__ __forceinline__ void pouts_phase(const GAS float* __restrict__ COEF, const GAS int* __restrict__ EIDX, const GAS unsigned char* V8S, GAS bf16_t* __restrict__ YBUF, int M,
                                            int wid, int lane, int bid, int nb) {
    const bool spl = (nb & 7) == 0; const int s0 = spl ? (bid & 7) : 0, s1 = spl ? s0 + 1 : 8, r = spl ? (bid >> 3) : bid, nr = spl ? (nb >> 3) : nb;
    const int g = lane >> 3, ch = lane & 7, rstep = nr * 8;
#define PO_LOADCE(rw, c0, c1, v0, v1) do { c0 = COEF[(size_t)(rw) * 128 + lane] * (1.f / 64.f); c1 = COEF[(size_t)(rw) * 128 + 64 + lane] * (1.f / 64.f); v0 = EIDX[(size_t)(rw) * 128 + lane]; v1 = EIDX[(size_t)(rw) * 128 + 64 + lane]; } while (0)
#define PO_GATHER(vv_, vreg) do { _Pragma("unroll") for (int k = 0; k < 8; ++k) { const int e = __builtin_amdgcn_ds_bpermute((8 * k + g) << 2, vreg); vv_[k] = *(const GAS u32x4*)(tb + (size_t)(e & 16383) * 128); } } while (0)
#define PO_COMP(vv_, creg) do { _Pragma("unroll") for (int k = 0; k < 8; ++k) { const float c = __int_as_float(__builtin_amdgcn_ds_bpermute((8 * k + g) << 2, __float_as_int(creg))); const u32x4 w = vv_[k]; \
        _Pragma("unroll") for (int d = 0; d < 4; ++d) { const f32x2 lo = fp8lo(w[d]), hi = fp8hi(w[d]); acc[4 * d] = fmaf(c, lo.x, acc[4 * d]); acc[4 * d + 1] = fmaf(c, lo.y, acc[4 * d + 1]); acc[4 * d + 2] = fmaf(c, hi.x, acc[4 * d + 2]); acc[4 * d + 3] = fmaf(c, hi.y, acc[4 * d + 3]); } \
        _Pragma("unroll") for (int i = 0; i < 16; ++i) asm volatile("" : "+v"(acc[i])); } } while (0)
    for (int s = s0; s < s1; ++s) {
        const GAS unsigned char* tb = V8S + (size_t)s * 16384 * 128 + ch * 16;
        int row = r + nr * wid; if (row >= M) continue;
        float c0c, c1c, c0n = 0.f, c1n = 0.f; int v0c, v1c, v0n = 0, v1n = 0;
        PO_LOADCE(row, c0c, c1c, v0c, v1c);
        u32x4 va[8], vb[8];
        PO_GATHER(va, v0c);
        for (;;) {
            const int rown = row + rstep; const bool hasn = rown < M;
            PO_GATHER(vb, v1c);
            if (hasn) PO_LOADCE(rown, c0n, c1n, v0n, v1n);
            float acc[16];
#pragma unroll
            for (int i = 0; i < 16; ++i) acc[i] = 0.f;
            PO_COMP(va, c0c);
            if (hasn) PO_GATHER(va, v0n);
            PO_COMP(vb, c1c);
#pragma unroll
            for (int i = 0; i < 16; ++i) acc[i] += dppf<0x128>(acc[i]);
#pragma unroll
            for (int i = 0; i < 8; ++i) { const bool hi = lane & 16; const float send = hi ? acc[i] : acc[i + 8], keep = hi ? acc[i + 8] : acc[i]; acc[i] = keep + shx(send, 16, lane); }
#pragma unroll
            for (int i = 0; i < 4; ++i) { const bool hi = lane & 32; const float send = hi ? acc[i] : acc[i + 4], keep = hi ? acc[i + 4] : acc[i]; acc[i] = keep + shx(send, 32, lane); }
            if ((lane & 8) == 0) { u32x2 w_; w_.x = pk_bf16(acc[0], acc[1]); w_.y = pk_bf16(acc[2], acc[3]); *(GAS u32x2*)(YBUF + (size_t)row * 1024 + s * 128 + ch * 16 + ((lane >> 4) & 1) * 8 + ((lane >> 5) & 1) * 4) = w_; }
            if (!hasn) break;
            row = rown; c0c = c0n; c1c = c1n; v0c = v0n; v1c = v1n;
        }
    }
#undef PO_LOADCE
#undef PO_GATHER
#undef PO_COMP
}
}

template <class T> __device__ __forceinline__ __attribute__((address_space(1))) T* gp(T* p) { return (__attribute__((address_space(1))) T*)uni_ptr(p); }
constexpr int MK_THREADS = 512, LDS_BYTES = 163840, LDSCTL_OFF = 131072, TAB_OFF = LDSCTL_OFF + 1024, MAX_OPS = 208;
static_assert(TAB_OFF + MAX_OPS * (int)sizeof(Op) <= LDS_BYTES, "LDS map");
constexpr int MPAD = 17152;
constexpr size_t CTL_BYTES = (size_t)1 << 20;
struct MArgs { const float* in[47]; float* out; char* ws; unsigned long long ws_size; };
__global__ void __launch_bounds__(MK_THREADS, 2) mega_fwd(MArgs a) {
    extern __shared__ __attribute__((aligned(16))) unsigned char lds[];
    volatile LAS unsigned* ctl = (volatile LAS unsigned*)((LAS unsigned char*)lds + LDSCTL_OFF);
    if (threadIdx.x < 64) ctl[threadIdx.x] = 0u;
    __syncthreads();
    (void)xcd_barrier_post((unsigned*)a.ws, ctl + 8);
    const Dm dm = make_dm(1024, 8, 2048, 128, 4);
    Op* tab = (Op*)(lds + TAB_OFF);
    if (threadIdx.x == 0) {
        const float* const* inp_ = (const float* const*)__builtin_amdgcn_kernarg_segment_ptr(); asm volatile("" : "+s"(inp_));
        NvIO io; io.in = inp_; io.out = a.out; io.ws = a.ws + CTL_BYTES; io.ws_size = a.ws_size - CTL_BYTES;
        int n = 0;
        nv_forward(io, dm, [&](const Op& o) __attribute__((always_inline)) { if (n < MAX_OPS) tab[n] = o; ++n; asm volatile("" ::: "memory"); });
        ctl[16] = (unsigned)(n <= MAX_OPS ? n : 0);
    }
    __syncthreads();
    const int nops = (int)ctl[16];
    for (int i = 0; i < nops; ++i) {
        int tid_ = (int)threadIdx.x, bid_ = (int)blockIdx.x, nb_ = (int)gridDim.x;
        asm volatile("" : "+v"(tid_)); asm volatile("" : "+s"(bid_)); asm volatile("" : "+s"(nb_));
        const long long g0 = (long long)bid_ * MK_THREADS + tid_, gs = (long long)nb_ * MK_THREADS;
        const Op& o = tab[i];
        const int rawc = __builtin_amdgcn_readfirstlane(o.code); const int code = rawc & 0xff; const long long n = o.n;
        switch (code) {
        case OP_FGEMM: {
            const int fl = rfl(o.i6);
            pg8::Gemm g{uni_ptr((const pg8::bf16_t*)o.a), uni_ptr((const pg8::bf16_t*)o.b), MPAD, rfl(o.i5), rfl(o.i1), rfl(o.i2), rfl(o.i3)};
            if (rawc & OPF_GROUP) {
                int ng = 1; while (ng < 8 && (rfl(tab[i + ng - 1].code) & OPF_GROUP)) ++ng;
                const PG8_LAS Op* gt = (const PG8_LAS Op*)((PG8_LAS unsigned char*)lds + TAB_OFF) + i;
                pg8::GroupOrder S; S.tab = gt; S.ng = ng; S.nM = MPAD / 256; S.G = nb_; S.c = bid_; S.tsA = (size_t)256 * g.lda * 2; S.tsB = (size_t)256 * g.ldb * 2;
                pg8::EpiF32G E{gt, dm.M};
                pg8::gemm_phase<pg8::EpiF32G, pg8::GroupOrder, true, true>((PG8_LAS unsigned char*)lds, g, S, E);
                i += ng - 1;
            } else {
            pg8::StaticOrder S; S.init(g, nb_, bid_); if (fl & 2) S.acs = 512;
            if (fl & 1) { pg8::EpiBf16Plain E{uni_ptr((pg8::bf16_t*)o.o0), rfl(o.i4)}; pg8::gemm_phase<pg8::EpiBf16Plain, pg8::StaticOrder, true, true>((PG8_LAS unsigned char*)lds, g, S, E); }
            else { pg8::EpiF32 E{uni_ptr(o.o0), rfl(o.i4), dm.M, rfl(o.i0)}; pg8::gemm_phase<pg8::EpiF32, pg8::StaticOrder, true, true>((PG8_LAS unsigned char*)lds, g, S, E); }
            }
        } break;
        case OP_LRUG2: {
            pg8::Gemm g{uni_ptr((const pg8::bf16_t*)o.a), uni_ptr((const pg8::bf16_t*)o.b), MPAD, 1024, 512, 512, 512};
            pg8::StaticOrder S; S.init(g, nb_, bid_);
            pg8::EpiLru E{uni_ptr(o.c), uni_ptr(o.d), uni_ptr(o.e), uni_ptr(o.f), uni_ptr(o.o0), uni_ptr(o.o1), dm.M};
            pg8::gemm_phase<pg8::EpiLru, pg8::StaticOrder, true, true>((PG8_LAS unsigned char*)lds, g, S, E);
        } break;
        case OP_WKVP: fk::wkv2_phase(gp(o.a), gp(o.b), gp(o.c), gp(o.d), gp(o.e), gp(o.f), gp(o.g), gp(o.h), gp((const float*)o.o5), gp(o.o0), gp(o.o1), gp(o.o2), gp(o.o3), gp(o.o4), rfl(o.i0), dm.B, dm.T, dm.DB, dm.DT, (LAS unsigned char*)lds, tid_, bid_, nb_); break;
        case OP_POST2: fk::rwkvpost2_phase(gp(o.a), gp(o.b), gp(o.c), gp(o.d), gp(o.e), gp(o.f), gp((fk::bf16_t*)o.o0), dm.M * 16, tid_ & 63, bid_ * 8 + (tid_ >> 6), nb_ * 8); break;
        case OP_GLAF: fk::gla_phase(gp(o.a), gp(o.b), gp(o.o0), gp(o.o1), dm.B, dm.T, (LAS unsigned char*)lds, tid_, bid_, nb_); break;
        case OP_PACTS: fk::pacts_phase(gp((const fk::bf16_t*)o.a), gp((const unsigned char*)o.b), gp((const int*)o.d), gp(o.o0), dm.M, tid_ >> 6, tid_ & 63, bid_, nb_); break;
        case OP_POUTS: fk::pouts_phase(gp(o.a), gp((const int*)o.b), gp((const unsigned char*)o.c), gp((fk::bf16_t*)o.o0), dm.M, tid_ >> 6, tid_ & 63, bid_, nb_); break;
        case OP_TOPK2: fk::topk_phase(gp(o.a), gp((const fk::bf16_t*)o.b), gp(o.c), gp(o.o0), gp((int*)o.o1), dm.M * 8, (LAS unsigned char*)lds, tid_ >> 6, tid_ & 63, bid_ * 8 + (tid_ >> 6), nb_ * 8); break;
        case OP_LNRES: fk::lnres_phase(gp((const fk::bf16_t*)o.a), gp(o.b), gp(o.c), gp(o.o0), gp((fk::bf16_t*)o.o1), dm.M, tid_ & 63, bid_ * 8 + (tid_ >> 6), nb_ * 8); break;
        case OP_GLANORM: fk::glanorm_phase(gp(o.a), gp(o.b), gp(o.c), gp((fk::bf16_t*)o.o0), dm.M * 4, tid_ & 63, bid_ * 8 + (tid_ >> 6), nb_ * 8); break;
#define NVC(c) case c: for (long long g = g0; g < n; g += gs) nv_elem(c, o, dm, g); break;
        NVC(OP_LOGA4) NVC(OP_CONVOUT) NVC(OP_SHIFTOUT) NVC(OP_EMBED4) NVC(OP_YOUT4) NVC(OP_MIX6) NVC(OP_CONV4) NVC(OP_CVT8) NVC(OP_WGATE)
        NVC(OP_WT) NVC(OP_CVTTAB8S) NVC(OP_PRED) NVC(OP_PRM) NVC(OP_KEYS) NVC(OP_GLA3) NVC(OP_LRU1) NVC(OP_LRU2) NVC(OP_LRU3)
#undef NVC
        default: break;
        }
        if (__builtin_amdgcn_readfirstlane(tab[i].code) & OPF_NOBAR) __syncthreads(); else { XcdBarrier bar; bar.bar = (unsigned*)a.ws; bar.x = xb_xcc_id(); bar.st = ctl + 8; xcd_barrier(bar); }
    }
}
extern "C" void kernel_launch(void* const* d_in, const int* in_sizes, int n_in, void* d_out, int out_size, void* d_ws, size_t ws_size, hipStream_t stream) {
    static int grid = 0;
    if (grid == 0) {
        if (n_in != 47 || ws_size < ((size_t)900 << 20)) { fprintf(stderr, "kernel_launch: expected 47 inputs and >= 900 MiB of workspace; got %d, %zu\n", n_in, ws_size); grid = -1; return; }
        int dev = 0, cus = 0, per_cu = 0;
        if (hipGetDevice(&dev) != hipSuccess || hipDeviceGetAttribute(&cus, hipDeviceAttributeMultiprocessorCount, dev) != hipSuccess) { grid = -1; return; }
        if (hipFuncSetAttribute((const void*)mega_fwd, hipFuncAttributeMaxDynamicSharedMemorySize, LDS_BYTES) != hipSuccess) { fprintf(stderr, "kernel_launch: hipFuncSetAttribute failed\n"); grid = -1; return; }
        if (hipOccupancyMaxActiveBlocksPerMultiprocessor(&per_cu, (const void*)mega_fwd, MK_THREADS, LDS_BYTES) != hipSuccess || per_cu < 1) fprintf(stderr, "kernel_launch: occupancy query says %d per CU\n", per_cu);
        (void)hipGetLastError();
        grid = cus;
    }
    if (grid < 0) return;
    if (hipMemsetAsync(d_ws, 0, CTL_BYTES, stream) != hipSuccess) { fprintf(stderr, "kernel_launch: memset failed\n"); return; }
    MArgs a{}; for (int i = 0; i < 47; ++i) a.in[i] = (const float*)d_in[i]; a.out = (float*)d_out; a.ws = (char*)d_ws; a.ws_size = (unsigned long long)ws_size;
    hipLaunchKernelGGL(mega_fwd, dim3(grid), dim3(MK_THREADS), LDS_BYTES, stream, a);
}
```

```cpp
#include <hip/hip_runtime.h>
#include <cstdio>
#include <cmath>
#ifndef HD
#define HD __host__ __device__ __forceinline__
#endif
struct Dm { int D, B, T, DB, DT, M, NSEQ, RH; };
HD Dm make_dm(int D, int B, int SEQ, int DB, int DT) { Dm d; d.D = D; d.B = B; d.T = SEQ + 16; d.DB = DB; d.DT = DT; d.M = B * d.T + DB * DT; d.NSEQ = B + DB; d.RH = D / 64; return d; }
HD int seq_row0(const Dm& d, int s) { return s < d.B ? s * d.T : d.B * d.T + (s - d.B) * d.DT; }
HD int seq_len(const Dm& d, int s) { return s < d.B ? d.T : d.DT; }
HD void row_to_seq(const Dm& d, int row, int& s, int& t) { if (row < d.B * d.T) { s = row / d.T; t = row % d.T; } else { int r = row - d.B * d.T; s = d.B + r / d.DT; t = r % d.DT; } }

constexpr int MIXIN = 2576, C_Q = 0, C_K = 256, C_V = 512, C_GLR = 1024, C_R = 1040, C_XB = 1552, C_GB = 2064;

enum { OP_EMBED = 1, OP_GEMM, OP_LOGA, OP_GLA, OP_GLANORM, OP_CONV, OP_CONVOUT, OP_LRUG, OP_LRUSCAN, OP_LNRES, OP_MIX, OP_SHIFTOUT,
       OP_RWKVPREP, OP_WKV, OP_RWKVPOST, OP_QNORM, OP_SCORES, OP_TOPK, OP_PACT1, OP_PACT2, OP_POUT, OP_YOUT, OP_WT, OP_CVT, OP_FGEMM, OP_CVTTAB, OP_KEYS, OP_TOPK2, OP_PACT, OP_POUTLN, OP_GLA1, OP_GLA2, OP_GLA3, OP_LRU1, OP_LRU2, OP_LRU3, OP_EMBED4, OP_YOUT4, OP_MIX8, OP_CONV4, OP_CVT8, OP_WGATE, OP_LRUG2, OP_WKVF, OP_GLAF, OP_CVTTAB8, OP_CVTTAB8S, OP_PACTS, OP_PRED, OP_POUTS, OP_MIX6, OP_PRM, OP_WKVP, OP_POST2, OP_LOGA4 };

constexpr int OPF_NOBAR = 0x100, OPF_GROUP = 0x200;
struct Op {
    const float *a, *b, *c, *d, *e, *f, *g, *h;
    float *o0, *o1, *o2, *o3, *o4, *o5;
    long long n;
    int code, i0, i1, i2, i3, i4, i5, i6;
};

#if defined(__HIP_DEVICE_COMPILE__)
#define NV_UNI(x) __builtin_amdgcn_readfirstlane(x)
#define NV_LAUNDER(p) asm volatile("" : "+s"(p))
#define NV_FENCE() asm volatile("" ::: "memory")
#else
#define NV_FENCE() do {} while (0)
#define NV_UNI(x) (x)
#define NV_LAUNDER(p) do {} while (0)
#endif
typedef unsigned short nvbf;
HD nvbf nv_f2bf(float f) { unsigned u; __builtin_memcpy(&u, &f, 4); return (nvbf)((u + 0x7fffu + ((u >> 16) & 1u)) >> 16); }
HD float nv_bf2f(nvbf h) { unsigned u = (unsigned)h << 16; float f; __builtin_memcpy(&f, &u, 4); return f; }
HD unsigned nv_f2e4m3(float f) {
    unsigned u; __builtin_memcpy(&u, &f, 4); const unsigned sign = (u >> 24) & 0x80u; const float a = fabsf(f);
    if (!(a < 448.f)) return sign | 0x7Eu;
    if (a < 0.015625f) return sign | (unsigned)rintf(a * 512.f);
    unsigned au = u & 0x7fffffffu; au += 0x7ffffu + ((au >> 20) & 1u);
    const unsigned e = ((au >> 23) & 0xffu) - 120u, m = (au >> 20) & 7u; unsigned code = (e << 3) | m; if (code > 0x7Eu) code = 0x7Eu;
    return sign | code; }
HD float nv_e4m32f(unsigned c) { const unsigned e = (c >> 3) & 15u, m = c & 7u; const float v = e ? ldexpf(1.f + m * 0.125f, (int)e - 7) : m * 0.001953125f; return (c & 0x80u) ? -v : v; }
HD int nv_rup(int x, int m) { return (x + m - 1) / m * m; }
struct alignas(16) NvF4 { float x, y, z, w; };
struct alignas(16) NvU4 { unsigned x, y, z, w; };
struct alignas(8) NvU2 { unsigned x, y; };
HD float nv_sigmoid(float x) { return 1.f / (1.f + expf(-x)); }
HD float nv_softplus(float x) { return fmaxf(x, 0.f) + log1pf(expf(-fabsf(x))); }
HD float nv_gelu(float x) { return 0.5f * x * (1.f + tanhf(0.7978845608028654f * (x + 0.044715f * x * x * x))); }

#define NV_INS16(tv, ti, val, idx) do { float _v = (val); int _i = (idx); _Pragma("unroll") for (int _j = 0; _j < 16; ++_j) { if (_v > tv[_j]) { float _tv = tv[_j]; int _ti = ti[_j]; tv[_j] = _v; ti[_j] = _i; _v = _tv; _i = _ti; } } } while (0)

HD void nv_elem(const int code, const Op& p, const Dm& dm, long long gid) {
    const int D = dm.D; float* const PO1 = p.o1; float* const PO2 = p.o2;
    switch (code) {
    case OP_EMBED: {
        int row = (int)(gid / D), c = (int)(gid % D); float v;
        if (row < dm.B * dm.T) { int bb = row / dm.T, t = row % dm.T; v = t < 16 ? p.c[t * D + c] : p.a[((size_t)bb * (dm.T - 16) + (t - 16)) * D + c]; }
        else v = p.b[(size_t)(row - dm.B * dm.T) * D + c];
        p.o0[gid] = v; ((nvbf*)p.o1)[gid] = nv_f2bf(v); } break;
    case OP_GEMM: {
        int N4 = p.i0 >> 2, K = p.i1; int m = (int)(gid / N4), nn = (int)(gid % N4) * 4; const float* A = p.a + (size_t)m * p.i2; const float* Bw = p.b + nn; float c0 = 0.f, c1 = 0.f, c2 = 0.f, c3 = 0.f;
        for (int k = 0; k < K; ++k) { float av = A[k]; if (p.i5 == 1) av = tanhf(av); else if (p.i5 == 2) av = nv_sigmoid(av); const NvF4 bv = *(const NvF4*)(Bw + (size_t)k * p.i3);
            c0 = fmaf(av, bv.x, c0); c1 = fmaf(av, bv.y, c1); c2 = fmaf(av, bv.z, c2); c3 = fmaf(av, bv.w, c3); }
        float* C = p.o0 + (size_t)m * p.i4 + nn; C[0] = c0; C[1] = c1; C[2] = c2; C[3] = c3; } break;
    case OP_LOGA: {
        int row = (int)(gid / 256), c = (int)(gid % 256); float z = p.c[c];
        for (int r = 0; r < 16; ++r) z = fmaf(p.a[(size_t)row * MIXIN + C_GLR + r], p.b[r * 256 + c], z);
        p.o0[gid] = expf(-nv_softplus(-z) * (1.f / 16.f)); } break;
    case OP_GLAF:
    case OP_GLA: {
        int s = (int)(gid / 512), h = (int)((gid / 128) % 4), col = (int)(gid % 128);
        float S[64];
        const float* sin = (s < dm.B) ? nullptr : p.c + (((size_t)(s - dm.B) * 4 + h) * 64) * 128 + col;
#pragma unroll
        for (int k = 0; k < 64; ++k) S[k] = sin ? sin[(size_t)k * 128] : 0.f;
        int r0 = seq_row0(dm, s), L = seq_len(dm, s);
        for (int t = 0; t < L; ++t) {
            const float* pr = p.a + (size_t)(r0 + t) * MIXIN; const float* la = p.b + (size_t)(r0 + t) * 256 + h * 64;
            float v = pr[C_V + h * 128 + col], o = 0.f;
#pragma unroll
            for (int k = 0; k < 64; ++k) { if ((k & 7) == 0) NV_FENCE(); S[k] = fmaf(la[k], S[k], pr[C_K + h * 64 + k] * v); o = fmaf(pr[C_Q + h * 64 + k] * 0.125f, S[k], o); }
            p.o0[(size_t)(r0 + t) * 512 + h * 128 + col] = o;
        }
        float* so = (s < dm.B) ? PO1 + (((size_t)s * 4 + h) * 64) * 128 + col : PO2 + (((size_t)(s - dm.B) * 4 + h) * 64) * 128 + col;
#pragma unroll
        for (int k = 0; k < 64; ++k) so[(size_t)k * 128] = S[k]; } break;
    case OP_GLA1: {
        const int NC = p.i0; const int u = NV_UNI((int)(gid / 128)), col = (int)(gid % 128); const int s = u / (4 * NC), h = (u / NC) % 4, c = u % NC;
        const int r0 = seq_row0(dm, s) + c * 64; int L = dm.T - c * 64; L = L > 64 ? 64 : L;
        float S[64];
#pragma unroll
        for (int k = 0; k < 64; ++k) S[k] = 0.f;
        float dprod = 1.f;
        for (int t = 0; t < L; ++t) {
            const float* pr = p.a + (size_t)(r0 + t) * MIXIN; const float* la = p.b + (size_t)(r0 + t) * 256 + h * 64; const float v = pr[C_V + h * 128 + col];
            if (col < 64) dprod *= la[col];
#pragma unroll
            for (int k = 0; k < 64; ++k) { if ((k & 7) == 0) NV_FENCE(); S[k] = fmaf(la[k], S[k], pr[C_K + h * 64 + k] * v); }
        }
        float* so = p.o0 + (size_t)u * 8192 + col;
#pragma unroll
        for (int k = 0; k < 64; ++k) so[(size_t)k * 128] = S[k];
        if (col < 64) p.o1[(size_t)u * 64 + col] = dprod; } break;
    case OP_GLA2: {
        const int NC = p.i0; const int pair = (int)(gid / 8192), e = (int)(gid % 8192), dk = e / 128; float S = 0.f;
        for (int c = 0; c < NC; ++c) { const size_t ix = ((size_t)pair * NC + c) * 8192 + e; const float l = p.o0[ix]; p.o0[ix] = S; S = fmaf(p.a[((size_t)pair * NC + c) * 64 + dk], S, l); }
        p.o1[gid] = S; } break;
    case OP_GLA3: {
        const int NC = p.i0; const int NP = dm.B * 4 * NC; const int u = NV_UNI((int)(gid / 128)) + (p.i1 ? NP : 0), col = (int)(gid % 128); int s, h, r0, L; const float* sin; float* sout = nullptr;
        if (u < NP) { s = u / (4 * NC); h = (u / NC) % 4; const int c = u % NC; r0 = seq_row0(dm, s) + c * 64; L = dm.T - c * 64; L = L > 64 ? 64 : L; sin = p.d + (size_t)u * 8192 + col; }
        else { const int q = u - NP; s = dm.B + q / 4; h = q % 4; r0 = seq_row0(dm, s); L = dm.DT; sin = p.c + (((size_t)(s - dm.B) * 4 + h) * 64) * 128 + col; sout = p.o2 + (((size_t)(s - dm.B) * 4 + h) * 64) * 128 + col; }
        float S[64];
#pragma unroll
        for (int k = 0; k < 64; ++k) S[k] = sin[(size_t)k * 128];
        for (int t = 0; t < L; ++t) {
            const float* pr = p.a + (size_t)(r0 + t) * MIXIN; const float* la = p.b + (size_t)(r0 + t) * 256 + h * 64; const float v = pr[C_V + h * 128 + col]; float o = 0.f;
#pragma unroll
            for (int k = 0; k < 64; ++k) { if ((k & 7) == 0) NV_FENCE(); S[k] = fmaf(la[k], S[k], pr[C_K + h * 64 + k] * v); o = fmaf(pr[C_Q + h * 64 + k] * 0.125f, S[k], o); }
            p.o0[(size_t)(r0 + t) * 512 + h * 128 + col] = o;
        }
        if (sout) {
#pragma unroll
            for (int k = 0; k < 64; ++k) sout[(size_t)k * 128] = S[k]; } } break;
    case OP_LRU1: {
        const int NC = p.i0; const int u = (int)(gid / 512), c = (int)(gid % 512); const int s = u / NC, ch = u % NC; const int r0 = seq_row0(dm, s) + ch * 64; int L = dm.T - ch * 64; L = L > 64 ? 64 : L; float hh = 0.f, ap = 1.f;
#pragma unroll 8
        for (int t = 0; t < L; ++t) { const size_t ix = (size_t)(r0 + t) * 512 + c; const float a = p.a[ix]; hh = fmaf(a, hh, p.b[ix]); ap *= a; }
        p.o0[gid] = ap; p.o1[gid] = hh; } break;
    case OP_LRU2: {
        const int NC = p.i0; const int s = (int)(gid / 512), c = (int)(gid % 512); float hh = 0.f;
#pragma unroll 8
        for (int ch = 0; ch < NC; ++ch) { const size_t ix = ((size_t)s * NC + ch) * 512 + c; const float l = p.o0[ix]; p.o0[ix] = hh; hh = fmaf(p.a[ix], hh, l); }
        p.o1[gid] = hh; } break;
    case OP_LRU3: {
        const int NC = p.i0; const int u = (int)(gid / 512), c = (int)(gid % 512); const int NP = dm.B * NC; int r0, L; float hh; float* hout = nullptr;
        if (u < NP) { const int s = u / NC, ch = u % NC; r0 = seq_row0(dm, s) + ch * 64; L = dm.T - ch * 64; L = L > 64 ? 64 : L; hh = p.e[gid]; }
        else { const int q = u - NP; r0 = seq_row0(dm, dm.B + q); L = dm.DT; hh = p.d[(size_t)q * 512 + c]; hout = p.o2 + (size_t)q * 512 + c; }
#pragma unroll 8
        for (int t = 0; t < L; ++t) { const size_t r = (size_t)(r0 + t); hh = fmaf(p.a[r * 512 + c], hh, p.b[r * 512 + c]); ((nvbf*)p.o0)[r * 1024 + 512 + c] = nv_f2bf(hh * nv_gelu(p.c[r * MIXIN + C_GB + c])); }
        if (hout) *hout = hh; } break;
    case OP_EMBED4: {
        const int D4 = D / 4; const int row = (int)(gid / D4), c = (int)(gid % D4) * 4; const float* src;
        if (row < dm.B * dm.T) { const int bb = row / dm.T, t = row % dm.T; src = t < 16 ? p.c + (size_t)t * D + c : p.a + ((size_t)bb * (dm.T - 16) + (t - 16)) * D + c; } else src = p.b + (size_t)(row - dm.B * dm.T) * D + c;
        const NvF4 v = *(const NvF4*)src; *(NvF4*)(p.o0 + (size_t)row * D + c) = v; NvU2 w; w.x = nv_f2bf(v.x) | ((unsigned)nv_f2bf(v.y) << 16); w.y = nv_f2bf(v.z) | ((unsigned)nv_f2bf(v.w) << 16); *(NvU2*)((nvbf*)p.o1 + (size_t)row * D + c) = w; } break;
    case OP_YOUT4: {
        const int D4 = D / 4; const int row = (int)(gid / D4), c = (int)(gid % D4) * 4; const NvF4 v = *(const NvF4*)(p.a + (size_t)row * D + c);
        if (row < dm.B * dm.T) { const int bb = row / dm.T, t = row % dm.T; if (t >= 16) *(NvF4*)(p.o0 + ((size_t)bb * (dm.T - 16) + (t - 16)) * D + c) = v; }
        else *(NvF4*)(p.o0 + ((size_t)dm.B * (dm.T - 16) + (row - dm.B * dm.T)) * D + c) = v; } break;
    case OP_MIX8: {
        const int D8 = D / 8; const int row = (int)(gid / D8), c = (int)(gid % D8) * 8; int s, t; row_to_seq(dm, row, s, t); const float* x = p.a + (size_t)row * D + c; float xp[8];
        if (t > 0) { for (int i = 0; i < 8; ++i) xp[i] = x[i - D]; } else if (s < dm.B) { for (int i = 0; i < 8; ++i) xp[i] = 0.f; } else { for (int i = 0; i < 8; ++i) xp[i] = p.b[(size_t)(s - dm.B) * D + c + i]; }
        unsigned w[4];
#pragma unroll
        for (int i = 0; i < 4; ++i) { const float lo = x[2 * i] + (xp[2 * i] - x[2 * i]) * p.c[c + 2 * i], hi = x[2 * i + 1] + (xp[2 * i + 1] - x[2 * i + 1]) * p.c[c + 2 * i + 1]; w[i] = nv_f2bf(lo) | ((unsigned)nv_f2bf(hi) << 16); }
        NvU4 o; o.x = w[0]; o.y = w[1]; o.z = w[2]; o.w = w[3]; *(NvU4*)((nvbf*)p.o0 + (size_t)row * D + c) = o; } break;
    case OP_MIX6: {
        const int D8 = D / 8; const int row = (int)(gid / D8), c = (int)(gid % D8) * 8; int s, t; row_to_seq(dm, row, s, t); const float* x = p.a + (size_t)row * D + c; float xv[8], dx[8];
        for (int i = 0; i < 8; ++i) xv[i] = x[i];
        if (t > 0) { for (int i = 0; i < 8; ++i) dx[i] = x[i - D] - xv[i]; } else if (s < dm.B) { for (int i = 0; i < 8; ++i) dx[i] = -xv[i]; } else { for (int i = 0; i < 8; ++i) dx[i] = p.b[(size_t)(s - dm.B) * D + c + i] - xv[i]; }
        for (int m = 0; m < 6; ++m) { const float* mu = p.c + (size_t)m * D + c; unsigned w[4];
#pragma unroll
            for (int i = 0; i < 4; ++i) w[i] = nv_f2bf(xv[2 * i] + dx[2 * i] * mu[2 * i]) | ((unsigned)nv_f2bf(xv[2 * i + 1] + dx[2 * i + 1] * mu[2 * i + 1]) << 16);
            NvU4 o; o.x = w[0]; o.y = w[1]; o.z = w[2]; o.w = w[3]; *(NvU4*)((nvbf*)p.o0 + (size_t)m * p.i0 * 0 + (size_t)m * (size_t)p.i1 * 1024 + (size_t)row * D + c) = o; } } break;
    case OP_CONV4: {
        const int row = (int)(gid / 128), c = (int)(gid % 128) * 4; int s, t; row_to_seq(dm, row, s, t); float acc[4];
        for (int q = 0; q < 4; ++q) acc[q] = p.d[c + q];
        for (int i = 0; i < 4; ++i) { const int j = t + i; const float* xv = nullptr;
            if (j < 3) { if (s >= dm.B) xv = p.b + ((size_t)(s - dm.B) * 3 + j) * 512 + c; } else xv = p.a + (size_t)(row - t + (j - 3)) * MIXIN + C_XB + c;
            if (xv) for (int q = 0; q < 4; ++q) acc[q] = fmaf(xv[q], p.c[i * 512 + c + q], acc[q]); }
        NvF4 o; o.x = acc[0]; o.y = acc[1]; o.z = acc[2]; o.w = acc[3]; *(NvF4*)(p.o0 + (size_t)row * 512 + c) = o;
        NvU2 w; w.x = nv_f2bf(acc[0]) | ((unsigned)nv_f2bf(acc[1]) << 16); w.y = nv_f2bf(acc[2]) | ((unsigned)nv_f2bf(acc[3]) << 16); *(NvU2*)((nvbf*)p.o1 + (size_t)row * 512 + c) = w; } break;
    case OP_CVT8: {
        const int K8 = p.i2 / 8; const int row = (int)(gid / K8), k = (int)(gid % K8) * 8; unsigned w[4] = {0u, 0u, 0u, 0u};
        if (row < dm.M && k < p.i0) { const float* sp = p.a + (size_t)row * p.i1 + k;
#pragma unroll
            for (int i = 0; i < 4; ++i) { float lo = sp[2 * i], hi = sp[2 * i + 1]; if (p.i3 == 1) { lo = tanhf(lo); hi = tanhf(hi); } else if (p.i3 == 2) { lo = nv_sigmoid(lo); hi = nv_sigmoid(hi); } w[i] = nv_f2bf(lo) | ((unsigned)nv_f2bf(hi) << 16); } }
        NvU4 o; o.x = w[0]; o.y = w[1]; o.z = w[2]; o.w = w[3]; *(NvU4*)((nvbf*)p.o0 + (size_t)row * p.i2 + k) = o; } break;
    case OP_WGATE: {
        const int n = (int)gid, pn = n >> 8, within = n & 127, isx = (n >> 7) & 1, c = pn * 128 + within, nb = c >> 6, e = c & 63; const float* w = isx ? p.b : p.a; nvbf* dst = (nvbf*)p.o0 + (size_t)n * 512;
        for (int k = 0; k < 512; ++k) dst[k] = ((k >> 6) == nb) ? nv_f2bf(w[((size_t)nb * 64 + (k & 63)) * 64 + e]) : (nvbf)0;
        if (n < 512) p.o1[n] = -8.f * nv_softplus(-p.c[n]); } break;
    case OP_LRUG2: {
        const int row = (int)(gid / 512), c = (int)(gid % 512), pn = c >> 7, within = c & 127; const nvbf* x = (const nvbf*)p.a + (size_t)row * 512; const nvbf* wa_ = (const nvbf*)p.b + (size_t)(pn * 256 + within) * 512; const nvbf* wx_ = wa_ + (size_t)128 * 512; float ga = 0.f, gx = 0.f;
        for (int k = 0; k < 512; ++k) { const float xv = nv_bf2f(x[k]); ga = fmaf(xv, nv_bf2f(wa_[k]), ga); gx = fmaf(xv, nv_bf2f(wx_[k]), gx); }
        const float gate_a = nv_sigmoid(ga + p.c[c]), gate_x = nv_sigmoid(gx + p.d[c]); const float log_at = gate_a * p.e[c];
        p.o0[gid] = expf(log_at); p.o1[gid] = sqrtf(-expm1f(2.f * log_at)) * (gate_x * p.f[gid]); } break;
    case OP_LOGA4: {
        const int row = (int)(gid / 64), c = (int)(gid % 64) * 4; const float* gl = p.a + (size_t)row * MIXIN + C_GLR; NvF4 z = *(const NvF4*)(p.c + c);
#pragma unroll
        for (int r4 = 0; r4 < 4; ++r4) { const NvF4 g = *(const NvF4*)(gl + 4 * r4);
            const NvF4 w0 = *(const NvF4*)(p.b + (4 * r4 + 0) * 256 + c), w1 = *(const NvF4*)(p.b + (4 * r4 + 1) * 256 + c), w2 = *(const NvF4*)(p.b + (4 * r4 + 2) * 256 + c), w3 = *(const NvF4*)(p.b + (4 * r4 + 3) * 256 + c);
            z.x = fmaf(g.x, w0.x, z.x); z.y = fmaf(g.x, w0.y, z.y); z.z = fmaf(g.x, w0.z, z.z); z.w = fmaf(g.x, w0.w, z.w); z.x = fmaf(g.y, w1.x, z.x); z.y = fmaf(g.y, w1.y, z.y); z.z = fmaf(g.y, w1.z, z.z); z.w = fmaf(g.y, w1.w, z.w);
            z.x = fmaf(g.z, w2.x, z.x); z.y = fmaf(g.z, w2.y, z.y); z.z = fmaf(g.z, w2.z, z.z); z.w = fmaf(g.z, w2.w, z.w); z.x = fmaf(g.w, w3.x, z.x); z.y = fmaf(g.w, w3.y, z.y); z.z = fmaf(g.w, w3.z, z.z); z.w = fmaf(g.w, w3.w, z.w); }
        NvF4 o; o.x = expf(-nv_softplus(-z.x) * (1.f / 16.f)); o.y = expf(-nv_softplus(-z.y) * (1.f / 16.f)); o.z = expf(-nv_softplus(-z.z) * (1.f / 16.f)); o.w = expf(-nv_softplus(-z.w) * (1.f / 16.f));
        *(NvF4*)(p.o0 + (size_t)row * 256 + c) = o; } break;
    case OP_GLANORM: {
        int row = (int)(gid / 4), h = (int)(gid % 4); const float* o = p.a + (size_t)row * 512 + h * 128; float ss = 0.f;
        for (int c = 0; c < 128; ++c) ss = fmaf(o[c], o[c], ss);
        float rs = 1.f / sqrtf(ss * (1.f / 128.f) + 1e-5f);
        for (int c = 0; c < 128; ++c) { float r = p.b[(size_t)row * MIXIN + C_R + h * 128 + c]; ((nvbf*)p.o0)[(size_t)row * 1024 + h * 128 + c] = nv_f2bf(o[c] * rs * p.c[c] * (r * nv_sigmoid(r))); } } break;
    case OP_CONV: {
        int row = (int)(gid / 512), c = (int)(gid % 512); int s, t; row_to_seq(dm, row, s, t); float acc = p.d[c];
        for (int i = 0; i < 4; ++i) { int j = t + i; float xv;
            if (j < 3) xv = (s < dm.B) ? 0.f : p.b[((size_t)(s - dm.B) * 3 + j) * 512 + c]; else xv = p.a[(size_t)(row - t + (j - 3)) * MIXIN + C_XB + c];
            acc = fmaf(xv, p.c[i * 512 + c], acc); }
        p.o0[gid] = acc; } break;
    case OP_CONVOUT: {
        int s = (int)(gid / 1536), i = (int)((gid / 512) % 3), c = (int)(gid % 512); int L = seq_len(dm, s), r0 = seq_row0(dm, s); int j = L + i; float xv;
        if (j < 3) xv = (s < dm.B) ? 0.f : p.b[((size_t)(s - dm.B) * 3 + j) * 512 + c]; else xv = p.a[(size_t)(r0 + j - 3) * MIXIN + C_XB + c];
        float* o = (s < dm.B) ? PO1 + ((size_t)s * 3 + i) * 512 + c : PO2 + ((size_t)(s - dm.B) * 3 + i) * 512 + c; *o = xv; } break;
    case OP_LRUG: {
        int row = (int)(gid / 512), c = (int)(gid % 512), nb = c / 64, e = c % 64; const float* x = p.a + (size_t)row * 512 + nb * 64; float ga = p.c[c], gx = p.e[c];
        for (int dd = 0; dd < 64; ++dd) { ga = fmaf(x[dd], p.b[((size_t)nb * 64 + dd) * 64 + e], ga); gx = fmaf(x[dd], p.d[((size_t)nb * 64 + dd) * 64 + e], gx); }
        float gate_a = nv_sigmoid(ga), gate_x = nv_sigmoid(gx); float log_at = -8.f * gate_a * nv_softplus(-p.f[c]);
        p.o0[gid] = expf(log_at); p.o1[gid] = sqrtf(-expm1f(2.f * log_at)) * (gate_x * p.a[(size_t)row * 512 + c]); } break;
    case OP_LRUSCAN: {
        int s = (int)(gid / 512), c = (int)(gid % 512); int r0 = seq_row0(dm, s), L = seq_len(dm, s); float hh = (s < dm.B) ? 0.f : p.d[(size_t)(s - dm.B) * 512 + c];
        for (int t = 0; t < L; ++t) { size_t r = (size_t)(r0 + t); hh = fmaf(p.a[r * 512 + c], hh, p.b[r * 512 + c]); p.o0[r * 1024 + 512 + c] = hh * nv_gelu(p.c[r * MIXIN + C_GB + c]); }
        float* o = (s < dm.B) ? PO1 + (size_t)s * 512 + c : PO2 + (size_t)(s - dm.B) * 512 + c; *o = hh; } break;
    case OP_LNRES: {
        const float alpha = 1.6817928305074292f; float* x = p.o0 + (size_t)gid * D; const nvbf* y = (const nvbf*)p.a + (size_t)gid * D; float mu = 0.f;
        for (int c = 0; c < D; ++c) mu += alpha * x[c] + nv_bf2f(y[c]);
        mu /= D; float var = 0.f;
        for (int c = 0; c < D; ++c) { float v = alpha * x[c] + nv_bf2f(y[c]) - mu; var = fmaf(v, v, var); }
        float rs = 1.f / sqrtf(var / D + 1e-5f);
        for (int c = 0; c < D; ++c) { const float o = (alpha * x[c] + nv_bf2f(y[c]) - mu) * rs * p.b[c] + p.c[c]; x[c] = o; ((nvbf*)p.o1)[(size_t)gid * D + c] = nv_f2bf(o); } } break;
    case OP_MIX: {
        int row = (int)(gid / D), c = (int)(gid % D); int s, t; row_to_seq(dm, row, s, t); float x = p.a[gid];
        float xp = t > 0 ? p.a[gid - D] : ((s < dm.B) ? 0.f : p.b[(size_t)(s - dm.B) * D + c]);
        ((nvbf*)p.o0)[gid] = nv_f2bf(x + (xp - x) * p.c[c]); } break;
    case OP_SHIFTOUT: {
        int s = (int)(gid / D), c = (int)(gid % D); float v = p.a[(size_t)(seq_row0(dm, s) + seq_len(dm, s) - 1) * D + c];
        float* o = (s < dm.B) ? PO1 + (size_t)s * D + c : PO2 + (size_t)(s - dm.B) * D + c; *o = v; } break;
    case OP_RWKVPREP: {
        int row = (int)(gid / dm.RH), h = (int)(gid % dm.RH); size_t base = (size_t)row * D + h * 64; float ss = 0.f;
        for (int k = 0; k < 64; ++k) { float kv = p.o0[base + k] * p.d[h * 64 + k]; ss = fmaf(kv, kv, ss); }
        float inv = 1.f / fmaxf(sqrtf(ss), 1e-12f);
        for (int k = 0; k < 64; ++k) { int c = h * 64 + k; size_t ix = base + k;
            float w = -nv_softplus(-(p.a[c] + p.o1[ix])) - 0.5f; float dec = expf(-expf(w));
            float a = nv_sigmoid(p.b[c] + p.o2[ix]);
            float v = p.o3[ix]; if (p.i0) v = v + (p.o5[ix] - v) * nv_sigmoid(p.c[c] + p.f[ix]); else p.o5[ix] = v;
            float k0 = p.o0[ix]; const float kk = k0 * p.d[c] * inv; p.o4[ix] = -kk; p.o0[ix] = k0 * (1.f + (a - 1.f) * p.e[c]); p.o1[ix] = dec; p.o2[ix] = kk * a; p.o3[ix] = v; } } break;
    case OP_WKVF:
    case OP_WKV: {
        int RH = dm.RH; int s = p.i0 + (int)(gid / (RH * 64)), h = (int)((gid / 64) % RH), vr = (int)(gid % 64); float S[64];
        const float* sin = (s < dm.B) ? nullptr : p.g + (((size_t)(s - dm.B) * RH + h) * 64 + vr) * 64;
#pragma unroll
        for (int k = 0; k < 64; ++k) S[k] = sin ? sin[k] : 0.f;
        int r0 = seq_row0(dm, s), L = seq_len(dm, s);
        for (int t = 0; t < L; ++t) { size_t base = (size_t)(r0 + t) * D + h * 64; float sa = 0.f;
#pragma unroll
            for (int k = 0; k < 64; ++k) { if ((k & 7) == 0) NV_FENCE(); sa = fmaf(S[k], p.f[base + k], sa); }
            float vv = p.d[base + vr], y = 0.f;
#pragma unroll
            for (int k = 0; k < 64; ++k) { if ((k & 7) == 0) NV_FENCE(); S[k] = fmaf(S[k], p.b[base + k], fmaf(sa, p.e[base + k], vv * p.c[base + k])); y = fmaf(S[k], p.a[base + k], y); }
            p.o0[base + vr] = y; }
        float* so = (s < dm.B) ? PO1 + (((size_t)s * RH + h) * 64 + vr) * 64 : PO2 + (((size_t)(s - dm.B) * RH + h) * 64 + vr) * 64;
#pragma unroll
        for (int k = 0; k < 64; ++k) so[k] = S[k]; } break;
    case OP_RWKVPOST: {
        int row = (int)(gid / dm.RH), h = (int)(gid % dm.RH); size_t base = (size_t)row * D + h * 64; float mu = 0.f, bon = 0.f;
        for (int k = 0; k < 64; ++k) { mu += p.a[base + k]; bon = fmaf(p.b[base + k] * p.c[base + k], p.f[h * 64 + k], bon); }
        mu *= (1.f / 64.f); float var = 0.f;
        for (int k = 0; k < 64; ++k) { float dlt = p.a[base + k] - mu; var = fmaf(dlt, dlt, var); }
        float rs = 1.f / sqrtf(var * (1.f / 64.f) + 64e-5f);
        for (int k = 0; k < 64; ++k) { int c = h * 64 + k; float y = (p.a[base + k] - mu) * rs * p.g[c] + p.h[c] + bon * p.d[base + k]; ((nvbf*)p.o0)[base + k] = nv_f2bf(y * p.e[base + k]); } } break;
    case OP_PRM: {
        const int m = (int)(gid / D), c = (int)(gid % D); const float* src = m == 0 ? p.a : m == 1 ? p.b : m == 2 ? p.c : m == 3 ? p.d : m == 4 ? p.e : p.f; p.o0[gid] = src ? src[c] : 0.f; } break;
    case OP_WKVP: {
        const int RH = dm.RH; const int s = (int)(gid / (RH * 64)), h = (int)((gid / 64) % RH), vr = (int)(gid % 64); float S[64];
        const float* sin = (s < dm.B) ? nullptr : p.o5 + (((size_t)(s - dm.B) * RH + h) * 64 + vr) * 64;
        for (int k = 0; k < 64; ++k) S[k] = sin ? sin[k] : 0.f;
        const float* w0 = p.h + h * 64; const float* a0 = p.h + D + h * 64; const float* v0 = p.h + 2 * D + h * 64; const float* k_k = p.h + 3 * D + h * 64; const float* k_a = p.h + 4 * D + h * 64; const float* r_k = p.h + 5 * D + h * 64;
        const int r0 = seq_row0(dm, s), L = seq_len(dm, s); const nvbf* bR = (const nvbf*)p.a; const nvbf* bK = (const nvbf*)p.b; const nvbf* bWL = (const nvbf*)p.c; const nvbf* bAL = (const nvbf*)p.d; const nvbf* bV = (const nvbf*)p.e; const nvbf* bVG = (const nvbf*)p.f;
        for (int t = 0; t < L; ++t) { const size_t base = (size_t)(r0 + t) * D + h * 64; float ss = 0.f;
            for (int k = 0; k < 64; ++k) { const float kv = nv_bf2f(bK[base + k]) * k_k[k]; ss = fmaf(kv, kv, ss); }
            const float inv = 1.f / fmaxf(sqrtf(ss), 1e-12f);
            float vv = nv_bf2f(bV[base + vr]); if (p.i0) vv = vv + (p.g[base + vr] - vv) * nv_sigmoid(v0[vr] + nv_bf2f(bVG[base + vr]));
            float sa = 0.f, bon = 0.f, dec[64], bb[64], k2[64];
            for (int k = 0; k < 64; ++k) { const float k0 = nv_bf2f(bK[base + k]); const float kk = k0 * k_k[k] * inv; const float a = nv_sigmoid(a0[k] + nv_bf2f(bAL[base + k]));
                dec[k] = expf(-0.6065306597126334f * nv_sigmoid(w0[k] + nv_bf2f(bWL[base + k])));
                bb[k] = kk * a; k2[k] = k0 * (1.f + (a - 1.f) * k_a[k]); sa = fmaf(S[k], -kk, sa); bon = fmaf(nv_bf2f(bR[base + k]) * k2[k], r_k[k], bon); }
            float y = 0.f;
            for (int k = 0; k < 64; ++k) { S[k] = fmaf(S[k], dec[k], fmaf(sa, bb[k], vv * k2[k])); y = fmaf(S[k], nv_bf2f(bR[base + k]), y); }
            p.o0[base + vr] = y; p.o3[base + vr] = vv; if (vr == 0) p.o4[(size_t)(r0 + t) * RH + h] = bon; }
        float* so = (s < dm.B) ? PO1 + (((size_t)s * RH + h) * 64 + vr) * 64 : PO2 + (((size_t)(s - dm.B) * RH + h) * 64 + vr) * 64;
        for (int k = 0; k < 64; ++k) so[k] = S[k]; } break;
    case OP_POST2: {
        const int row = (int)(gid / dm.RH), h = (int)(gid % dm.RH); const size_t base = (size_t)row * D + h * 64; float mu = 0.f;
        for (int k = 0; k < 64; ++k) mu += p.a[base + k];
        mu *= (1.f / 64.f); float var = 0.f;
        for (int k = 0; k < 64; ++k) { const float dlt = p.a[base + k] - mu; var = fmaf(dlt, dlt, var); }
        const float rs = 1.f / sqrtf(var * (1.f / 64.f) + 64e-5f), bon = p.d[gid];
        for (int k = 0; k < 64; ++k) { const int c = h * 64 + k; const float y = (p.a[base + k] - mu) * rs * p.e[c] + p.f[c] + bon * p.c[base + k]; ((nvbf*)p.o0)[base + k] = nv_f2bf(y * nv_bf2f(((const nvbf*)p.b)[base + k])); } } break;
    case OP_QNORM: {
        float* q = p.o0 + (size_t)gid * 256; float mu = 0.f;
        for (int c = 0; c < 256; ++c) mu += q[c];
        mu *= (1.f / 256.f); float var = 0.f;
        for (int c = 0; c < 256; ++c) { float dlt = q[c] - mu; var = fmaf(dlt, dlt, var); }
        float rs = 1.f / sqrtf(var * (1.f / 256.f) + 1e-5f);
        for (int c = 0; c < 256; ++c) q[c] = (q[c] - mu) * rs; } break;
    case OP_SCORES: {
        int row = (int)(gid / 2048), r = (int)(gid % 2048), h = r / 256, half = (r / 128) & 1, key = r % 128;
        const float* q = p.a + (size_t)row * 2048 + h * 256 + half * 128; const float* kv = p.b + (((size_t)h * 2 + half) * 128 + key) * 128; float acc = 0.f;
        for (int dd = 0; dd < 128; ++dd) acc = fmaf(q[dd], kv[dd], acc);
        p.o0[gid] = acc; } break;
    case OP_TOPK: {
        const float* sc = p.a + (size_t)gid * 256; float tv[16]; int ti[16]; float* tmpv = p.o2 + (size_t)gid * 32; int* tmpi = (int*)p.o3 + (size_t)gid * 32;
        for (int half = 0; half < 2; ++half) {
#pragma unroll
            for (int j = 0; j < 16; ++j) { tv[j] = -3.0e38f; ti[j] = 0; }
            for (int k = 0; k < 128; ++k) NV_INS16(tv, ti, sc[half * 128 + k], k);
#pragma unroll
            for (int j = 0; j < 16; ++j) { tmpv[half * 16 + j] = tv[j]; tmpi[half * 16 + j] = ti[j]; }
        }
#pragma unroll
        for (int j = 0; j < 16; ++j) { tv[j] = -3.0e38f; ti[j] = 0; }
        for (int i = 0; i < 16; ++i) for (int j = 0; j < 16; ++j) NV_INS16(tv, ti, tmpv[i] + tmpv[16 + j], tmpi[i] * 128 + tmpi[16 + j]);
        float den = 0.f, ev[16];
#pragma unroll
        for (int j = 0; j < 16; ++j) { ev[j] = expf(tv[j] - tv[0]); den += ev[j]; }
        float inv = 1.f / den;
#pragma unroll
        for (int j = 0; j < 16; ++j) { p.o0[(size_t)gid * 16 + j] = ev[j] * inv; ((int*)p.o1)[(size_t)gid * 16 + j] = ti[j]; } } break;
    case OP_PACT1: {
        size_t pr = (size_t)(gid / 16); int part = (int)(gid % 16); int row = (int)(pr / 128); int e = ((const int*)p.d)[pr]; int w = D / 16;
        const float* u = p.b + (size_t)e * D + part * w; const float* x = p.a + (size_t)row * D + part * w; float acc = 0.f;
        for (int c = 0; c < w; ++c) acc = fmaf(u[c], x[c], acc);
        p.o0[gid] = acc; } break;
    case OP_PACT2: {
        float acc = 0.f; for (int i = 0; i < 16; ++i) acc += p.a[(size_t)gid * 16 + i];
        p.o0[gid] = p.c[gid] * nv_gelu(acc); } break;
    case OP_POUT: {
        int row = (int)(gid / D), c = (int)(gid % D); float acc = 0.f;
        for (int i = 0; i < 128; ++i) acc = fmaf(p.a[(size_t)row * 128 + i], p.c[(size_t)((const int*)p.b)[(size_t)row * 128 + i] * D + c], acc);
        p.o0[gid] = acc; } break;
    case OP_YOUT: {
        int row = (int)(gid / D), c = (int)(gid % D);
        if (row < dm.B * dm.T) { int bb = row / dm.T, t = row % dm.T; if (t >= 16) p.o0[((size_t)bb * (dm.T - 16) + (t - 16)) * D + c] = p.a[gid]; }
        else p.o0[((size_t)dm.B * (dm.T - 16) + (row - dm.B * dm.T)) * D + c] = p.a[gid]; } break;
    case OP_WT: {
        const int N = p.i0, K = p.i1, Np = p.i3, Kp = p.i4; const long long per8 = (long long)Np * (Kp / 8); const int bt = (int)(gid / per8); const long long r = gid % per8; const int k0 = (int)(r / Np) * 8, nn = (int)(r % Np);
        unsigned w[4];
#pragma unroll
        for (int i = 0; i < 4; ++i) { float lo = 0.f, hi = 0.f; if (nn < N) { if (k0 + 2 * i < K) lo = p.a[((size_t)bt * K + k0 + 2 * i) * p.i2 + nn]; if (k0 + 2 * i + 1 < K) hi = p.a[((size_t)bt * K + k0 + 2 * i + 1) * p.i2 + nn]; } w[i] = nv_f2bf(lo) | ((unsigned)nv_f2bf(hi) << 16); }
        NvU4 o; o.x = w[0]; o.y = w[1]; o.z = w[2]; o.w = w[3];
        *(NvU4*)((nvbf*)p.o0 + (size_t)bt * Np * Kp + (size_t)nn * Kp + k0) = o; } break;
    case OP_CVT: {
        const int Kp = p.i2; const int row = (int)(gid / Kp), k = (int)(gid % Kp); float v = 0.f;
        if (row < dm.M && k < p.i0) { v = p.a[(size_t)row * p.i1 + k]; if (p.i3 == 1) v = tanhf(v); else if (p.i3 == 2) v = nv_sigmoid(v); }
        ((nvbf*)p.o0)[gid] = nv_f2bf(v); } break;
    case OP_FGEMM: {
        const int N = p.i0; const int m = (int)(gid / N), nn = (int)(gid % N); const nvbf* A = (const nvbf*)p.a + (size_t)m * p.i2 + ((p.i6 & 2) ? (nn / 256) * 256 : 0); const nvbf* Bt = (const nvbf*)p.b + (size_t)nn * p.i3; float acc = 0.f;
        for (int k = 0; k < p.i1; ++k) acc = fmaf(nv_bf2f(A[k]), nv_bf2f(Bt[k]), acc);
        if (p.i6 & 1) ((nvbf*)p.o0)[(size_t)m * p.i4 + nn] = nv_f2bf(acc); else p.o0[(size_t)m * p.i4 + nn] = acc; } break;
    case OP_CVTTAB: {
        const NvF4 v0 = *(const NvF4*)(p.a + gid * 8), v1 = *(const NvF4*)(p.a + gid * 8 + 4); NvU4 o;
        o.x = nv_f2bf(v0.x) | ((unsigned)nv_f2bf(v0.y) << 16); o.y = nv_f2bf(v0.z) | ((unsigned)nv_f2bf(v0.w) << 16); o.z = nv_f2bf(v1.x) | ((unsigned)nv_f2bf(v1.y) << 16); o.w = nv_f2bf(v1.z) | ((unsigned)nv_f2bf(v1.w) << 16);
        *(NvU4*)((nvbf*)p.o0 + gid * 8) = o; } break;
    case OP_CVTTAB8: {
        const float sc = (float)(1 << p.i0); const float* sp = p.a + gid * 16; unsigned w[4];
#pragma unroll
        for (int q = 0; q < 4; ++q) { const NvF4 v = *(const NvF4*)(sp + 4 * q); w[q] = nv_f2e4m3(v.x * sc) | (nv_f2e4m3(v.y * sc) << 8) | (nv_f2e4m3(v.z * sc) << 16) | (nv_f2e4m3(v.w * sc) << 24); }
        NvU4 o; o.x = w[0]; o.y = w[1]; o.z = w[2]; o.w = w[3]; *(NvU4*)((unsigned char*)p.o0 + gid * 16) = o; } break;
    case OP_CVTTAB8S: {
        const float sc = (float)(1 << p.i0); const int per = D / 16; const int e = (int)(gid / per), c0 = (int)(gid % per) * 16; const float* sp = p.a + (size_t)e * D + c0; unsigned w[4];
#pragma unroll
        for (int q = 0; q < 4; ++q) { const NvF4 v = *(const NvF4*)(sp + 4 * q);
#if defined(__HIP_DEVICE_COMPILE__)
            int pk = __builtin_amdgcn_cvt_pk_fp8_f32(v.x * sc, v.y * sc, 0, false); pk = __builtin_amdgcn_cvt_pk_fp8_f32(v.z * sc, v.w * sc, pk, true); w[q] = (unsigned)pk;
#else
            w[q] = nv_f2e4m3(v.x * sc) | (nv_f2e4m3(v.y * sc) << 8) | (nv_f2e4m3(v.z * sc) << 16) | (nv_f2e4m3(v.w * sc) << 24);
#endif
        }
        NvU4 o; o.x = w[0]; o.y = w[1]; o.z = w[2]; o.w = w[3]; *(NvU4*)((unsigned char*)p.o0 + ((size_t)(c0 >> 7) * 16384 + e) * 128 + (c0 & 127)) = o; } break;
    case OP_PACTS: {
        const long long NP = (long long)dm.M * 128; const int sl = (int)(gid / NP); const long long pr = gid % NP; const int row = (int)(pr / 128); const int e = ((const int*)p.d)[pr];
        const unsigned char* u = (const unsigned char*)p.b + ((size_t)sl * 16384 + e) * 128; const nvbf* x = (const nvbf*)p.a + (size_t)row * D + sl * 128; float acc = 0.f;
        for (int c = 0; c < 128; ++c) acc = fmaf(nv_e4m32f(u[c]), nv_bf2f(x[c]), acc);
        p.o0[gid] = acc; } break;
    case OP_PRED: {
        const long long NP = (long long)dm.M * 128; float acc = 0.f; for (int sl = 0; sl < p.i0; ++sl) acc += p.a[(size_t)sl * NP + gid];
        p.o0[gid] = p.c[gid] * nv_gelu(acc * (1.f / 128.f)); } break;
    case OP_POUTS: {
        const int row = (int)(gid / D), c = (int)(gid % D); const unsigned char* vb = (const unsigned char*)p.c + (size_t)(c >> 7) * 16384 * 128 + (c & 127); float acc = 0.f;
        for (int i = 0; i < 128; ++i) acc = fmaf(p.a[(size_t)row * 128 + i] * (1.f / 64.f), nv_e4m32f(vb[(size_t)((const int*)p.b)[(size_t)row * 128 + i] * 128]), acc);
        ((nvbf*)p.o0)[gid] = nv_f2bf(acc); } break;
    case OP_KEYS: {
        const int h = (int)(gid / 256), nrow = (int)(gid % 256), half = nrow >> 7; const float* src = p.a + (((size_t)h * 2 + half) * 128 + (nrow & 127)) * 128; nvbf* dst = (nvbf*)p.o0 + ((size_t)h * 256 + nrow) * 256; float ks = 0.f;
        for (int k = 0; k < 256; ++k) { nvbf b = 0; if ((k >> 7) == half) { b = nv_f2bf(src[k & 127]); ks += nv_bf2f(b); } dst[k] = b; }
        p.o1[gid] = ks; } break;
    case OP_TOPK2: {
        const int h = (int)(gid % 8); const float* sc = p.a + (size_t)gid * 256; const nvbf* q = (const nvbf*)p.b + (size_t)gid * 256; const float* ksum = p.c + h * 256; float mu = 0.f;
        for (int c = 0; c < 256; ++c) mu += nv_bf2f(q[c]);
        mu *= (1.f / 256.f); float var = 0.f;
        for (int c = 0; c < 256; ++c) { float dlt = nv_bf2f(q[c]) - mu; var = fmaf(dlt, dlt, var); }
        const float rs = 1.f / sqrtf(var * (1.f / 256.f) + 1e-5f);
        float tv[16]; int ti[16]; float* tmpv = p.o2 + (size_t)gid * 32; int* tmpi = (int*)p.o3 + (size_t)gid * 32;
        for (int half = 0; half < 2; ++half) {
#pragma unroll
            for (int j = 0; j < 16; ++j) { tv[j] = -3.0e38f; ti[j] = 0; }
            for (int k = 0; k < 128; ++k) NV_INS16(tv, ti, rs * (sc[half * 128 + k] - mu * ksum[half * 128 + k]), k);
#pragma unroll
            for (int j = 0; j < 16; ++j) { tmpv[half * 16 + j] = tv[j]; tmpi[half * 16 + j] = ti[j]; }
        }
#pragma unroll
        for (int j = 0; j < 16; ++j) { tv[j] = -3.0e38f; ti[j] = 0; }
        for (int i = 0; i < 16; ++i) for (int j = 0; j < 16; ++j) NV_INS16(tv, ti, tmpv[i] + tmpv[16 + j], tmpi[i] * 128 + tmpi[16 + j]);
        float den = 0.f, ev[16];
#pragma unroll
        for (int j = 0; j < 16; ++j) { ev[j] = expf(tv[j] - tv[0]); den += ev[j]; }
        float inv = 1.f / den;
#pragma unroll
        for (int j = 0; j < 16; ++j) { p.o0[(size_t)gid * 16 + j] = ev[j] * inv; ((int*)p.o1)[(size_t)gid * 16 + j] = ti[j]; } } break;
    case OP_PACT: {
        const int row = (int)(gid / 128); const int e = ((const int*)p.d)[gid]; const unsigned char* u = (const unsigned char*)p.b + (size_t)e * D; const nvbf* x = (const nvbf*)p.a + (size_t)row * D; float acc = 0.f;
        for (int c = 0; c < D; ++c) acc = fmaf(nv_e4m32f(u[c]), nv_bf2f(x[c]), acc);
        p.o0[gid] = p.c[gid] * nv_gelu(acc * (1.f / 128.f)); } break;
#if defined(HOST_TEST)
    case OP_POUTLN: {
        const float alpha = 1.6817928305074292f; float* x = p.o0 + (size_t)gid * D; std::vector<float> y(D, 0.f);
        for (int i = 0; i < 128; ++i) { const float cf = p.a[(size_t)gid * 128 + i] * (1.f / 64.f); const unsigned char* v = (const unsigned char*)p.c + (size_t)((const int*)p.b)[(size_t)gid * 128 + i] * D; for (int c = 0; c < D; ++c) y[c] = fmaf(cf, nv_e4m32f(v[c]), y[c]); }
        float mu = 0.f; for (int c = 0; c < D; ++c) { y[c] = alpha * x[c] + y[c]; mu += y[c]; }
        mu /= D; float var = 0.f; for (int c = 0; c < D; ++c) { float dlt = y[c] - mu; var = fmaf(dlt, dlt, var); }
        const float rs = 1.f / sqrtf(var / D + 1e-5f);
        for (int c = 0; c < D; ++c) { const float o = (y[c] - mu) * rs * p.d[c] + p.e[c]; x[c] = o; ((nvbf*)p.o1)[(size_t)gid * D + c] = nv_f2bf(o); } } break;
#endif
    default: break;
    }
}

struct NvIO { const float* const* in; float* out; char* ws; size_t ws_size; };
template <class Launch> HD void nv_forward(const NvIO& io, const Dm& dm, Launch&& launch) {
    const int D = dm.D, M = dm.M, B = dm.B, DB = dm.DB, RH = dm.RH; const size_t MD = (size_t)M * D;
    float* y_prompt = io.out; float* y_sample = y_prompt + (size_t)B * (dm.T - 16) * D; float* p_gla = y_sample + (size_t)DB * dm.DT * D;
    float* p_h = p_gla + (size_t)2 * B * 4 * 64 * 128; float* p_conv = p_h + (size_t)2 * B * 512; float* p_rwkv = p_conv + (size_t)2 * B * 3 * 512;
    float* p_shift = p_rwkv + (size_t)2 * B * RH * 4096; float* s_gla = p_shift + (size_t)2 * B * D; float* s_h = s_gla + (size_t)2 * DB * 4 * 64 * 128;
    float* s_conv = s_h + (size_t)2 * DB * 512; float* s_rwkv = s_conv + (size_t)2 * DB * 3 * 512; float* s_shift = s_rwkv + (size_t)2 * DB * RH * 4096;
    float* w = (float*)io.ws; size_t off = 0; auto take = [&](size_t n) __attribute__((always_inline)) { float* r = w + off; off += (n + 63) & ~(size_t)63; return r; };
    float* X = take(MD); float* VFIRST = take(MD); float* MOUT = take(MD);
    auto mk = [&](int code, long long n) __attribute__((always_inline)) { Op o{}; o.code = code; o.n = n; return o; };
    const int Mp = nv_rup(M, 256), Dp = nv_rup(D, 256), Dk = nv_rup(D, 128);
    auto takeh = [&](size_t n) __attribute__((always_inline)) { return (nvbf*)take((n + 1) / 2); };
    nvbf* ABF = takeh((size_t)Mp * 1024 > (size_t)Mp * Dk ? (size_t)Mp * 1024 : (size_t)Mp * Dk);
    const size_t SZ_WIN = (size_t)2816 * Dk, SZ_WOUT = (size_t)Dp * 1024, SZ_DD = (size_t)Dp * Dk, SZ_DN = (size_t)256 * Dk, SZ_UP = (size_t)Dp * 128, SZ_WQ = (size_t)2048 * Dk;
    nvbf* WT_WIN = takeh(2 * SZ_WIN); nvbf* WT_WOUT = takeh(2 * SZ_WOUT); nvbf* WT_WR = takeh(2 * SZ_DD); nvbf* WT_WK = takeh(2 * SZ_DD); nvbf* WT_WV = takeh(2 * SZ_DD); nvbf* WT_WO = takeh(2 * SZ_DD);
    nvbf* WT_W1 = takeh(2 * SZ_DN); nvbf* WT_W2 = takeh(2 * SZ_UP); nvbf* WT_A1 = takeh(2 * SZ_DN); nvbf* WT_A2 = takeh(2 * SZ_UP); nvbf* WT_G1 = takeh(2 * SZ_DN); nvbf* WT_G2 = takeh(2 * SZ_UP);
    nvbf* WT_V1 = takeh(SZ_DN); nvbf* WT_V2 = takeh(SZ_UP); nvbf* WT_WQ = takeh(4 * SZ_WQ); nvbf* WT_WG = takeh((size_t)2 * 1024 * 512); float* SPL = take(2 * 512); float* PRM = take((size_t)2 * 6 * D);
    nvbf* UB = takeh((size_t)16384 * D / 2); nvbf* VB = takeh((size_t)16384 * D / 2); nvbf* KB = takeh((size_t)8 * 256 * 256); float* KSUM = take(8 * 256);
    const size_t scratch0 = off;
    auto nb = [&](Op o) __attribute__((always_inline)) { o.code |= OPF_NOBAR; launch(o); };
    auto wt = [&](const float* W, int K, int N, int batch, nvbf* dst) __attribute__((always_inline)) { const int Np = nv_rup(N, 256), Kp = nv_rup(K, 128); Op o = mk(OP_WT, (long long)batch * Np * (Kp / 8)); o.a = W; o.o0 = (float*)dst; o.i0 = N; o.i1 = K; o.i2 = N; o.i3 = Np; o.i4 = Kp; nb(o); };
    wt(io.in[10], D, MIXIN, 2, WT_WIN); wt(io.in[21], 1024, D, 2, WT_WOUT); wt(io.in[23], D, D, 2, WT_WR); wt(io.in[24], D, D, 2, WT_WK); wt(io.in[25], D, D, 2, WT_WV); wt(io.in[26], D, D, 2, WT_WO);
    wt(io.in[28], D, 64, 2, WT_W1); wt(io.in[29], 64, D, 2, WT_W2); wt(io.in[31], D, 64, 2, WT_A1); wt(io.in[32], 64, D, 2, WT_A2); wt(io.in[36], D, 128, 2, WT_G1); wt(io.in[37], 128, D, 2, WT_G2);
    wt(io.in[34], D, 32, 1, WT_V1); wt(io.in[35], 32, D, 1, WT_V2); wt(io.in[43], D, 2048, 4, WT_WQ);
    for (int jj = 0; jj < 2; ++jj) { Op o = mk(OP_PRM, (long long)6 * D); o.a = io.in[27] + (size_t)jj * D; o.b = io.in[30] + (size_t)jj * D; o.c = jj > 0 ? io.in[33] + (size_t)(jj - 1) * D : nullptr; o.d = io.in[38] + (size_t)jj * D; o.e = io.in[39] + (size_t)jj * D; o.f = io.in[40] + (size_t)jj * RH * 64; o.o0 = PRM + (size_t)jj * 6 * D; nb(o); }
    for (int jj = 0; jj < 2; ++jj) { Op o = mk(OP_WGATE, 1024); o.a = io.in[16] + (size_t)jj * 8 * 64 * 64; o.b = io.in[18] + (size_t)jj * 8 * 64 * 64; o.c = io.in[20] + (size_t)jj * 512; o.o0 = (float*)(WT_WG + (size_t)jj * 1024 * 512); o.o1 = SPL + (size_t)jj * 512; nb(o); }
    auto fgemm = [&](const nvbf* Wt, float* C, int ldc, int N, int K, int bf16out = 0) __attribute__((always_inline)) {
        const int Kp = nv_rup(K, 128), Np = nv_rup(N, 256);
        Op o = mk(OP_FGEMM, (long long)M * N); o.a = (const float*)ABF; o.b = (const float*)Wt; o.o0 = C; o.i0 = N; o.i1 = Kp; o.i2 = Kp; o.i3 = Kp; o.i4 = ldc; o.i5 = Np; o.i6 = bf16out; launch(o); };
    auto gemm = [&](const float* A, int lda, const nvbf* Wt, float* C, int ldc, int N, int K, int act) __attribute__((always_inline)) {
        const int Kp = nv_rup(K, 128);
        { Op o = mk(OP_CVT8, (long long)Mp * (Kp / 8)); o.a = A; o.o0 = (float*)ABF; o.i0 = K; o.i1 = lda; o.i2 = Kp; o.i3 = act; launch(o); }
        fgemm(Wt, C, ldc, N, K); };
    { Op o = mk(OP_EMBED4, (long long)MD / 4); o.a = io.in[0]; o.b = io.in[1]; o.c = io.in[7]; o.o0 = X; o.o1 = (float*)ABF; launch(o); }
    const float* const w_outer = w; float* const out_outer = io.out;
    for (int layer = 0; layer < 4; ++layer) {
        float* wl = (float*)w_outer; float* ol = out_outer; NV_LAUNDER(wl); NV_LAUNDER(ol);
#define NV_RB(T, v) T const v##_rb = (T)((char*)wl + ((const char*)(v) - (const char*)w_outer))
#define NV_RO(v) float* const v##_rb = (float*)((char*)ol + ((const char*)(v) - (const char*)out_outer))
        NV_RB(float*, X); NV_RB(float*, VFIRST); NV_RB(float*, MOUT); NV_RB(nvbf*, ABF); NV_RB(nvbf*, WT_WIN); NV_RB(nvbf*, WT_WOUT); NV_RB(nvbf*, WT_WR); NV_RB(nvbf*, WT_WK); NV_RB(nvbf*, WT_WV); NV_RB(nvbf*, WT_WO);
        NV_RB(nvbf*, WT_W1); NV_RB(nvbf*, WT_W2); NV_RB(nvbf*, WT_A1); NV_RB(nvbf*, WT_A2); NV_RB(nvbf*, WT_G1); NV_RB(nvbf*, WT_G2); NV_RB(nvbf*, WT_V1); NV_RB(nvbf*, WT_V2); NV_RB(nvbf*, WT_WQ); NV_RB(nvbf*, WT_WG);
        NV_RB(float*, SPL); NV_RB(float*, PRM); NV_RB(nvbf*, UB); NV_RB(nvbf*, VB); NV_RB(nvbf*, KB); NV_RB(float*, KSUM);
        NV_RO(p_gla); NV_RO(p_h); NV_RO(p_conv); NV_RO(p_rwkv); NV_RO(p_shift); NV_RO(s_gla); NV_RO(s_h); NV_RO(s_conv); NV_RO(s_rwkv); NV_RO(s_shift);
#undef NV_RB
#undef NV_RO
        { float* const X = X_rb; float* const VFIRST = VFIRST_rb; float* const MOUT = MOUT_rb; nvbf* const ABF = ABF_rb; nvbf* const WT_WIN = WT_WIN_rb; nvbf* const WT_WOUT = WT_WOUT_rb; nvbf* const WT_WR = WT_WR_rb; nvbf* const WT_WK = WT_WK_rb;
          nvbf* const WT_WV = WT_WV_rb; nvbf* const WT_WO = WT_WO_rb; nvbf* const WT_W1 = WT_W1_rb; nvbf* const WT_W2 = WT_W2_rb; nvbf* const WT_A1 = WT_A1_rb; nvbf* const WT_A2 = WT_A2_rb; nvbf* const WT_G1 = WT_G1_rb; nvbf* const WT_G2 = WT_G2_rb;
          nvbf* const WT_V1 = WT_V1_rb; nvbf* const WT_V2 = WT_V2_rb; nvbf* const WT_WQ = WT_WQ_rb; nvbf* const WT_WG = WT_WG_rb; float* const SPL = SPL_rb; float* const PRM = PRM_rb; nvbf* const UB = UB_rb; nvbf* const VB = VB_rb; nvbf* const KB = KB_rb; float* const KSUM = KSUM_rb;
          float* const p_gla = p_gla_rb; float* const p_h = p_h_rb; float* const p_conv = p_conv_rb; float* const p_rwkv = p_rwkv_rb; float* const p_shift = p_shift_rb; float* const s_gla = s_gla_rb; float* const s_h = s_h_rb; float* const s_conv = s_conv_rb;
          float* const s_rwkv = s_rwkv_rb; float* const s_shift = s_shift_rb; float* const w = wl; (void)SPL; (void)WT_WG; (void)VFIRST;
        const int j = layer / 2; off = scratch0;
        { Op o = mk(OP_CVTTAB8S, (long long)16384 * D / 16); o.a = io.in[45] + (size_t)layer * 16384 * D; o.o0 = (float*)UB; o.i0 = 7; nb(o); }
        { Op o = mk(OP_CVTTAB8S, (long long)16384 * D / 16); o.a = io.in[46] + (size_t)layer * 16384 * D; o.o0 = (float*)VB; o.i0 = 6; nb(o); }
        { Op o = mk(OP_KEYS, 8 * 256); o.a = io.in[44] + (size_t)layer * 8 * 2 * 128 * 128; o.o0 = (float*)KB; o.o1 = KSUM; nb(o); }
        if (layer % 2 == 0) {
            float* PROJ = take((size_t)M * MIXIN); float* LOGA = take((size_t)M * 256); float* O = take((size_t)M * 512); float* MIXO = (float*)ABF;
            float* XC = take((size_t)M * 512); nvbf* XCB = takeh((size_t)Mp * 512); float* AT = take((size_t)M * 512); float* BT = take((size_t)M * 512);
            const int NC = (dm.T + 63) / 64; float* LEND = take((size_t)B * 4 * NC * 8192); float* DEC = take((size_t)B * 4 * NC * 64); float* LA = take((size_t)B * NC * 512); float* LB = take((size_t)B * NC * 512);
            fgemm(WT_WIN + (size_t)j * SZ_WIN, PROJ, MIXIN, MIXIN, D);
            { Op o = mk(OP_LOGA4, (long long)M * 64); o.a = PROJ; o.b = io.in[11] + (size_t)j * 16 * 256; o.c = io.in[12] + (size_t)j * 256; o.o0 = LOGA; nb(o); }
            { Op o = mk(OP_CONV4, (long long)M * 128); o.a = PROJ; o.b = io.in[4] + (size_t)j * DB * 3 * 512; o.c = io.in[14] + (size_t)j * 4 * 512; o.d = io.in[15] + (size_t)j * 512; o.o0 = XC; o.o1 = (float*)XCB; nb(o); }
            { Op o = mk(OP_CONVOUT, (long long)dm.NSEQ * 1536); o.a = PROJ; o.b = io.in[4] + (size_t)j * DB * 3 * 512; o.o1 = p_conv + (size_t)j * B * 3 * 512; o.o2 = s_conv + (size_t)j * DB * 3 * 512; launch(o); }
            { Op o = mk(OP_GLAF, (long long)B * 512); o.a = PROJ; o.b = LOGA; o.o0 = O; o.o1 = p_gla + (size_t)j * B * 4 * 64 * 128; nb(o); }
            { Op o = mk(OP_GLA3, (long long)(DB * 4) * 128); o.a = PROJ; o.b = LOGA; o.c = io.in[2] + (size_t)j * DB * 4 * 64 * 128; o.d = LEND; o.o0 = O; o.o2 = s_gla + (size_t)j * DB * 4 * 64 * 128; o.i0 = NC; o.i1 = 1; nb(o); }
            { Op o = mk(OP_LRUG2, (long long)M * 512); o.a = (const float*)XCB; o.b = (const float*)(WT_WG + (size_t)j * 1024 * 512); o.c = io.in[17] + (size_t)j * 512; o.d = io.in[19] + (size_t)j * 512; o.e = SPL + (size_t)j * 512; o.f = XC; o.o0 = AT; o.o1 = BT; launch(o); }
            { Op o = mk(OP_GLANORM, (long long)M * 4); o.a = O; o.b = PROJ; o.c = io.in[13] + (size_t)j * 128; o.o0 = MIXO; nb(o); }
            { Op o = mk(OP_LRU1, (long long)B * NC * 512); o.a = AT; o.b = BT; o.o0 = LA; o.o1 = LB; o.i0 = NC; launch(o); }
            { Op o = mk(OP_LRU2, (long long)B * 512); o.a = LA; o.o0 = LB; o.o1 = p_h + (size_t)j * B * 512; o.i0 = NC; launch(o); }
            { Op o = mk(OP_LRU3, (long long)(B * NC + DB) * 512); o.a = AT; o.b = BT; o.c = PROJ; o.d = io.in[3] + (size_t)j * DB * 512; o.e = LB; o.o0 = MIXO; o.o2 = s_h + (size_t)j * DB * 512; o.i0 = NC; launch(o); }
            fgemm(WT_WOUT + (size_t)j * SZ_WOUT, MOUT, D, D, 1024, 1);
        } else {
            float* Y = take(MD); float* R = take(MD); float* K = take(MD); float* V = take(MD); float* G = take(MD); float* KK = take(MD);
            const size_t XMSZ = (size_t)Mp * D;
            float* WAV = take(3 * MD > 3 * XMSZ ? 3 * MD : 3 * XMSZ); float* Wd = WAV; float* Aa = WAV + MD; float* Vg = WAV + 2 * MD; nvbf* XM6 = (nvbf*)WAV;
            float* BON = take((size_t)M * RH); float* HLw = take((size_t)M * 64); float* HLa = take((size_t)M * 64); float* HLg = take((size_t)M * 128); float* HLv = take((size_t)M * 32);
            nvbf* ABw = takeh((size_t)Mp * 128); nvbf* ABa = takeh((size_t)Mp * 128); nvbf* ABg = takeh((size_t)Mp * 128); nvbf* ABv = takeh((size_t)Mp * 128);
            const float* shin = io.in[6] + (size_t)j * DB * D; const float* mu = io.in[22] + (size_t)j * 6 * D;
            { Op o = mk(OP_SHIFTOUT, (long long)dm.NSEQ * D); o.a = X; o.o1 = p_shift + (size_t)j * B * D; o.o2 = s_shift + (size_t)j * DB * D; nb(o); }
            { Op o = mk(OP_MIX6, (long long)MD / 8); o.a = X; o.b = shin; o.c = mu; o.o0 = (float*)XM6; o.i1 = (int)(XMSZ / 1024); launch(o); }
            auto gg = [&](const nvbf* A, const nvbf* Wt, float* C, int ldc, int N, int K, bool last, int bf16out = 0) __attribute__((always_inline)) { const int Kp = nv_rup(K, 128), Np = nv_rup(N, 256);
                Op o = mk(OP_FGEMM, (long long)M * N); o.a = (const float*)A; o.b = (const float*)Wt; o.o0 = C; o.i0 = N; o.i1 = Kp; o.i2 = Kp; o.i3 = Kp; o.i4 = ldc; o.i5 = Np; o.i6 = bf16out; if (!last) o.code |= OPF_GROUP; launch(o); };
            gg(XM6 + 0 * XMSZ, WT_WR + (size_t)j * SZ_DD, R, D, D, D, false, 1); gg(XM6 + 2 * XMSZ, WT_WK + (size_t)j * SZ_DD, K, D, D, D, false, 1); gg(XM6 + 3 * XMSZ, WT_WV + (size_t)j * SZ_DD, V, D, D, D, false, 1);
            gg(XM6 + 1 * XMSZ, WT_W1 + (size_t)j * SZ_DN, HLw, 64, 64, D, false); gg(XM6 + 4 * XMSZ, WT_A1 + (size_t)j * SZ_DN, HLa, 64, 64, D, false);
            if (j > 0) gg(XM6 + 3 * XMSZ, WT_V1 + (size_t)(j - 1) * SZ_DN, HLv, 32, 32, D, false);
            gg(XM6 + 5 * XMSZ, WT_G1 + (size_t)j * SZ_DN, HLg, 128, 128, D, true);
            auto cv = [&](const float* A, int K, nvbf* dst, int act, bool last) __attribute__((always_inline)) { Op o = mk(OP_CVT8, (long long)Mp * 16); o.a = A; o.o0 = (float*)dst; o.i0 = K; o.i1 = K; o.i2 = 128; o.i3 = act; if (last) launch(o); else nb(o); };
            cv(HLw, 64, ABw, 1, false); cv(HLa, 64, ABa, 0, false); if (j > 0) cv(HLv, 32, ABv, 0, false); cv(HLg, 128, ABg, 2, true);
            gg(ABw, WT_W2 + (size_t)j * SZ_UP, Wd, D, D, 64, false, 1); gg(ABa, WT_A2 + (size_t)j * SZ_UP, Aa, D, D, 64, false, 1); if (j > 0) gg(ABv, WT_V2 + (size_t)(j - 1) * SZ_UP, Vg, D, D, 32, false, 1); gg(ABg, WT_G2 + (size_t)j * SZ_UP, G, D, D, 128, true, 1);
            { Op o = mk(OP_WKVP, (long long)dm.NSEQ * RH * 64); o.a = R; o.b = K; o.c = Wd; o.d = Aa; o.e = V; o.f = Vg; o.g = VFIRST; o.h = PRM + (size_t)j * 6 * D; o.o0 = Y; o.o1 = p_rwkv + (size_t)j * B * RH * 4096; o.o2 = s_rwkv + (size_t)j * DB * RH * 4096;
              o.o3 = j > 0 ? KK : VFIRST; o.o4 = BON; o.o5 = (float*)(io.in[5] + (size_t)j * DB * RH * 4096); o.i0 = j > 0 ? 1 : 0; launch(o); }
            { Op o = mk(OP_POST2, (long long)M * RH); o.a = Y; o.b = G; o.c = j > 0 ? KK : VFIRST; o.d = BON; o.e = io.in[41] + (size_t)j * D; o.f = io.in[42] + (size_t)j * D; o.o0 = (float*)ABF; launch(o); }
            fgemm(WT_WO + (size_t)j * SZ_DD, MOUT, D, D, D, 1);
        }
        { Op o = mk(OP_LNRES, M); o.a = MOUT; o.b = io.in[8] + (size_t)(layer * 2 + 0) * D; o.c = io.in[9] + (size_t)(layer * 2 + 0) * D; o.o0 = X; o.o1 = (float*)ABF; launch(o); }
        off = scratch0;
        { nvbf* Q = takeh((size_t)Mp * 2048); float* SC = take((size_t)M * 2048); float* GATE = take((size_t)M * 128); float* EIDX = take((size_t)M * 128); float* TMPV = take((size_t)M * 256); float* TMPI = take((size_t)M * 256);
          float* COEF = take((size_t)M * 128);
          { Op o = mk(OP_FGEMM, (long long)M * 2048); o.a = (const float*)ABF; o.b = (const float*)(WT_WQ + (size_t)layer * SZ_WQ); o.o0 = (float*)Q; o.i0 = 2048; o.i1 = Dk; o.i2 = Dk; o.i3 = Dk; o.i4 = 2048; o.i5 = 2048; o.i6 = 1; launch(o); }
          { Op o = mk(OP_FGEMM, (long long)M * 2048); o.a = (const float*)Q; o.b = (const float*)KB; o.o0 = SC; o.i0 = 2048; o.i1 = 256; o.i2 = 2048; o.i3 = 256; o.i4 = 2048; o.i5 = 2048; o.i6 = 2; launch(o); }
          { Op o = mk(OP_TOPK2, (long long)M * 8); o.a = SC; o.b = (const float*)Q; o.c = KSUM; o.o0 = GATE; o.o1 = EIDX; o.o2 = TMPV; o.o3 = TMPI; launch(o); }
          { const int NS = D / 128; float* PART = take((size_t)NS * M * 128); float* YBUF = take(MD);
            { Op o = mk(OP_PACTS, (long long)NS * M * 128); o.a = (const float*)ABF; o.b = (const float*)UB; o.d = EIDX; o.o0 = PART; launch(o); }
            { Op o = mk(OP_PRED, (long long)M * 128); o.a = PART; o.c = GATE; o.o0 = COEF; o.i0 = NS; launch(o); }
            { Op o = mk(OP_POUTS, (long long)MD); o.a = COEF; o.b = EIDX; o.c = (const float*)VB; o.o0 = YBUF; launch(o); }
            { Op o = mk(OP_LNRES, M); o.a = YBUF; o.b = io.in[8] + (size_t)(layer * 2 + 1) * D; o.c = io.in[9] + (size_t)(layer * 2 + 1) * D; o.o0 = X; o.o1 = (float*)ABF; launch(o); } } }
        }
    }
    { Op o = mk(OP_YOUT4, (long long)MD / 4); o.a = X; o.o0 = y_prompt; launch(o); }
    (void)y_sample;
}

#include <cstdint>
namespace pg8 {
#define PG8_LAS __attribute__((address_space(3)))
typedef unsigned short bf16_t;
typedef short bf16x8 __attribute__((ext_vector_type(8)));
typedef float f32x4 __attribute__((ext_vector_type(4)));
typedef unsigned u32x4 __attribute__((ext_vector_type(4)));
constexpr int BM = 256, BK = 64, HALF = 128, HTB = HALF * BK * 2  , STAGE_BYTES = 8 * HTB, NXCD = 8, WGM = 8;

__host__ __device__ __forceinline__ int lds_byte(int r, int c) { const int st = (r >> 4) * 2 + (c >> 5), rr = r & 15, cc = c & 31, ob = rr * 64 + cc * 2; return st * 1024 + (ob ^ (((ob >> 9) & 1) << 5)); }
__host__ __device__ __forceinline__ void stage_rc(int b, int& R, int& C) { const int st = b / 1024, sb = b % 1024, swz = sb ^ (((sb >> 9) & 1) << 5); R = (st >> 1) * 16 + swz / 64; C = (st & 1) * 32 + (swz % 64) / 2; }
__host__ __device__ __forceinline__ int perm32(int rho) { const int n = rho >> 4, i = rho & 15; return 8 * (i >> 2) + 4 * n + (i & 3); }

struct Unit { int pm, pn, grp, pad_; const char* A; const char* B; };
struct Gemm { const bf16_t* A; const bf16_t* Bt; int M, N, K, lda, ldb; };

struct StaticOrder {
    int nM, nN, nwg, G, c; const char* A; const char* B; size_t tsA, tsB, acs;
    __host__ __device__ void init(const Gemm& g, int G_, int c_) { nM = g.M / BM; nN = g.N / BM; nwg = nM * nN; G = G_; c = c_; A = (const char*)g.A; B = (const char*)g.Bt; tsA = (size_t)BM * g.lda * 2; tsB = (size_t)BM * g.ldb * 2; acs = 0; }
    __host__ __device__ bool next(int i, Unit& u) const {
        const long L = (long)i * G + c; if (L >= nwg) return false;
        int wgid = (int)L; { const int q = nwg / NXCD, r = nwg % NXCD, xcd = wgid % NXCD, off = wgid / NXCD; wgid = (xcd < r ? xcd * (q + 1) : r * (q + 1) + (xcd - r) * q) + off; }
        const int nig = WGM * nN, gid = wgid / nig, fm = gid * WGM, gsz = (nM - fm) < WGM ? (nM - fm) : WGM;
        u.pm = fm + ((wgid % nig) % gsz); u.pn = (wgid % nig) / gsz; u.grp = 0; u.pad_ = 0; u.A = A + (size_t)u.pm * tsA + (size_t)u.pn * acs; u.B = B + (size_t)u.pn * tsB; return true;
    }
    __device__ __forceinline__ void a_ready(const Unit&) const {}
    __device__ __forceinline__ void done(const Unit&) const {}
};

template <class Epi, class Sched, bool ALIGN_EPI = false, bool SP2 = false>
__device__ __forceinline__ void gemm_phase(PG8_LAS unsigned char* lds, const Gemm g, const Sched& S, const Epi& E) {
    int tid_raw = threadIdx.x; asm volatile("" : "+v"(tid_raw));
    const int tid = tid_raw, wid = __builtin_amdgcn_readfirstlane(tid >> 6), lane = tid & 63, wr = wid >> 2, wc = wid & 3, fr = lane & 15, fq = lane >> 4;
    const int K = g.K, nt = K / BK;
    unsigned voffA[2], voffB[2];
#pragma unroll
    for (int i = 0; i < 2; ++i) { int R, C; stage_rc(tid * 16 + i * 8192, R, C); const int Rb = Epi::PERM ? ((R & ~31) + perm32(R & 31)) : R;
        voffA[i] = (unsigned)(R * g.lda + C) * 2u; voffB[i] = (unsigned)(Rb * g.ldb + C) * 2u; }
    const size_t kstep = (size_t)(BK * 2);
    const size_t hstepA = (size_t)HALF * g.lda * 2, hstepB = (size_t)HALF * g.ldb * 2;
    const unsigned ldsw = (unsigned)wid * 1024u;
    const int aoff = lds_byte(wr * 64 + fr, fq * 8), boff = lds_byte(wc * 32 + fr, fq * 8);
#define PG8_SA(b, h) (((b) * 2 + (h)) * HTB)
#define PG8_SB(b, h) ((4 + (b) * 2 + (h)) * HTB)
#define PG8_STAGE(bufoff, gbase, voff) do { _Pragma("unroll") for (int _i = 0; _i < 2; ++_i) \
        __builtin_amdgcn_global_load_lds((const unsigned*)((const char*)(gbase) + (voff)[_i]), (PG8_LAS unsigned*)(lds + (bufoff) + ldsw + _i * 8192), 16, 0, 0); } while (0)
#define PG8_LDA(dst, b, h) do { _Pragma("unroll") for (int m = 0; m < 4; ++m) _Pragma("unroll") for (int k = 0; k < 2; ++k) dst[m][k] = *(const PG8_LAS bf16x8*)(lds + PG8_SA(b, h) + aoff + m * 2048 + k * 1024); } while (0)
#define PG8_LDB(dst, b, h) do { _Pragma("unroll") for (int n = 0; n < 2; ++n) _Pragma("unroll") for (int k = 0; k < 2; ++k) dst[n][k] = *(const PG8_LAS bf16x8*)(lds + PG8_SB(b, h) + boff + n * 2048 + k * 1024); } while (0)
#define PG8_MMA(ai, bj, At, Bt) do { __builtin_amdgcn_s_setprio(1); _Pragma("unroll") for (int m = 0; m < 4; ++m) _Pragma("unroll") for (int n = 0; n < 2; ++n) _Pragma("unroll") for (int k = 0; k < 2; ++k) \
        acc[ai][bj][m][n] = __builtin_amdgcn_mfma_f32_16x16x32_bf16(Bt[n][k], At[m][k], acc[ai][bj][m][n], 0, 0, 0); __builtin_amdgcn_s_setprio(0); } while (0)
#define PG8_WAIT_V(n) asm volatile("s_waitcnt vmcnt(" #n ")" ::: "memory")
#define PG8_WAIT_L(n) asm volatile("s_waitcnt lgkmcnt(" #n ")" ::: "memory")
#define PG8_BAR __builtin_amdgcn_s_barrier()
#define PG8_SCHED __builtin_amdgcn_sched_barrier(0)
    Unit cur, nxt; int ui = 0;
    if (!S.next(0, cur)) return;
    f32x4 acc[2][2][4][2];
#pragma unroll
    for (int a = 0; a < 2; ++a)
#pragma unroll
        for (int b = 0; b < 2; ++b)
#pragma unroll
            for (int m = 0; m < 4; ++m)
#pragma unroll
                for (int n = 0; n < 2; ++n) acc[a][b][m][n] = (f32x4){0.f, 0.f, 0.f, 0.f};
    bf16x8 At[4][2], B0[2][2], B1[2][2];
    const char* cA = cur.A; const char* cB = cur.B;
    S.a_ready(cur);
    if constexpr (SP2) {
        PG8_STAGE(PG8_SB(0, 0), cB, voffB); PG8_STAGE(PG8_SB(0, 1), cB + hstepB, voffB); PG8_STAGE(PG8_SA(0, 0), cA, voffA); PG8_STAGE(PG8_SA(0, 1), cA + hstepA, voffA);
        if (wr == 1) PG8_BAR;
        PG8_WAIT_V(2); PG8_BAR;
        PG8_STAGE(PG8_SB(1, 0), cB + kstep, voffB); PG8_STAGE(PG8_SA(1, 0), cA + kstep, voffA); PG8_STAGE(PG8_SB(1, 1), cB + hstepB + kstep, voffB);
        PG8_WAIT_V(6); PG8_BAR;
    } else {
        PG8_STAGE(PG8_SB(0, 0), cB, voffB); PG8_STAGE(PG8_SA(0, 0), cA, voffA); PG8_STAGE(PG8_SB(0, 1), cB + hstepB, voffB); PG8_STAGE(PG8_SA(0, 1), cA + hstepA, voffA);
        if (wr == 1) PG8_BAR;
        PG8_WAIT_V(4); PG8_BAR;
        PG8_STAGE(PG8_SB(1, 0), cB + kstep, voffB); PG8_STAGE(PG8_SA(1, 0), cA + kstep, voffA); PG8_STAGE(PG8_SB(1, 1), cB + hstepB + kstep, voffB);
        PG8_WAIT_V(6); PG8_BAR;
    }
    for (;;) {
        const bool has_next = S.next(ui + 1, nxt);
        const char* nA = has_next ? nxt.A : cA; const char* nB = has_next ? nxt.B : cB;
        for (int t = 0; t < nt; t += 2) {
            const bool last = (t == nt - 2);
            const char* a1 = cA + (size_t)(t + 1) * kstep;
            const char* a2 = last ? nA : cA + (size_t)(t + 2) * kstep; const char* b2 = last ? nB : cB + (size_t)(t + 2) * kstep;
            const char* a3 = a2 + kstep; const char* b3 = b2 + kstep;
            if (last && has_next) S.a_ready(nxt);
            if constexpr (SP2) {
            PG8_LDB(B0, 0, 0); PG8_LDB(B1, 0, 1); PG8_SCHED; PG8_LDA(At, 0, 0); PG8_STAGE(PG8_SA(1, 1), a1 + hstepA, voffA);
            PG8_WAIT_V(8); PG8_WAIT_L(0); PG8_BAR; PG8_MMA(0, 0, At, B0); PG8_MMA(0, 1, At, B1); PG8_BAR; PG8_SCHED;
            PG8_LDA(At, 0, 1); PG8_STAGE(PG8_SB(0, 0), b2, voffB); PG8_STAGE(PG8_SB(0, 1), b2 + hstepB, voffB); PG8_STAGE(PG8_SA(0, 0), a2, voffA);
            PG8_WAIT_V(8); PG8_WAIT_L(0); PG8_BAR; PG8_MMA(1, 0, At, B0); PG8_MMA(1, 1, At, B1); PG8_BAR; PG8_SCHED;
            PG8_LDB(B0, 1, 0); PG8_LDB(B1, 1, 1); PG8_SCHED; PG8_LDA(At, 1, 0); PG8_STAGE(PG8_SA(0, 1), a2 + hstepA, voffA);
            PG8_WAIT_V(8); PG8_WAIT_L(0); PG8_BAR; PG8_MMA(0, 0, At, B0); PG8_MMA(0, 1, At, B1); PG8_BAR; PG8_SCHED;
            PG8_LDA(At, 1, 1); PG8_STAGE(PG8_SB(1, 0), b3, voffB); PG8_STAGE(PG8_SB(1, 1), b3 + hstepB, voffB); PG8_STAGE(PG8_SA(1, 0), a3, voffA);
            PG8_WAIT_V(8); PG8_WAIT_L(0); PG8_BAR; PG8_MMA(1, 0, At, B0); PG8_MMA(1, 1, At, B1); PG8_BAR; PG8_SCHED;
            } else {
            PG8_LDB(B0, 0, 0); PG8_SCHED; PG8_LDA(At, 0, 0); PG8_STAGE(PG8_SA(1, 1), a1 + hstepA, voffA);
            PG8_WAIT_L(8); PG8_BAR; PG8_WAIT_L(0); PG8_MMA(0, 0, At, B0); PG8_BAR; PG8_SCHED;
            PG8_LDB(B1, 0, 1); PG8_STAGE(PG8_SB(0, 0), b2, voffB);
            PG8_BAR; PG8_WAIT_L(0); PG8_MMA(0, 1, At, B1); PG8_BAR;
            PG8_LDA(At, 0, 1); PG8_STAGE(PG8_SA(0, 0), a2, voffA);
            PG8_BAR; PG8_WAIT_L(0); PG8_MMA(1, 0, At, B0); PG8_BAR; PG8_SCHED;
            PG8_STAGE(PG8_SB(0, 1), b2 + hstepB, voffB);
            PG8_WAIT_V(6); PG8_BAR; PG8_MMA(1, 1, At, B1); PG8_BAR;
            PG8_LDB(B0, 1, 0); PG8_SCHED; PG8_LDA(At, 1, 0); PG8_STAGE(PG8_SA(0, 1), a2 + hstepA, voffA);
            PG8_WAIT_L(8); PG8_BAR; PG8_WAIT_L(0); PG8_MMA(0, 0, At, B0); PG8_BAR; PG8_SCHED;
            PG8_LDB(B1, 1, 1); PG8_STAGE(PG8_SB(1, 0), b3, voffB);
            PG8_BAR; PG8_WAIT_L(0); PG8_MMA(0, 1, At, B1); PG8_BAR;
            PG8_LDA(At, 1, 1); PG8_STAGE(PG8_SA(1, 0), a3, voffA);
            PG8_BAR; PG8_WAIT_L(0); PG8_MMA(1, 0, At, B0); PG8_BAR; PG8_SCHED;
            PG8_STAGE(PG8_SB(1, 1), b3 + hstepB, voffB);
            PG8_WAIT_V(6); PG8_BAR; PG8_MMA(1, 1, At, B1); PG8_BAR;
            }
        }
        if constexpr (ALIGN_EPI) { if (wr == 0) PG8_BAR; }
        if constexpr (!Epi::AFTER_DRAIN) { E(acc, cur, wr, wc, fr, fq); S.done(cur); }
        if (!has_next) break;
#pragma unroll
        for (int a = 0; a < 2; ++a)
#pragma unroll
            for (int b = 0; b < 2; ++b)
#pragma unroll
                for (int m = 0; m < 4; ++m)
#pragma unroll
                    for (int n = 0; n < 2; ++n) acc[a][b][m][n] = (f32x4){0.f, 0.f, 0.f, 0.f};
        cur = nxt; cA = nA; cB = nB; ++ui;
        if constexpr (ALIGN_EPI) { if (wr == 1) PG8_BAR; }
    }
    PG8_WAIT_V(0);
    if constexpr (!ALIGN_EPI) { if (wr == 0) PG8_BAR; }
    PG8_BAR;
    if constexpr (Epi::AFTER_DRAIN) { E.fused(acc, cur, wr, wc, fr, fq, lds, wid, lane); S.done(cur); }
#undef PG8_SA
#undef PG8_SB
#undef PG8_STAGE
#undef PG8_LDA
#undef PG8_LDB
#undef PG8_MMA
#undef PG8_WAIT_V
#undef PG8_WAIT_L
#undef PG8_BAR
#undef PG8_SCHED
}
}
template <class T> __device__ __forceinline__ T* uni_ptr(T* p) {
    unsigned long long v = (unsigned long long)p; unsigned lo = __builtin_amdgcn_readfirstlane((unsigned)v), hi = __builtin_amdgcn_readfirstlane((unsigned)(v >> 32));
    unsigned long long r = ((unsigned long long)hi << 32) | lo; asm volatile("" : "+s"(r)); return (T*)r; }
__device__ __forceinline__ int rfl(int x) { int t = __builtin_amdgcn_readfirstlane(x); asm volatile("" : "+s"(t)); return t; }
namespace pg8 {
__device__ __forceinline__ unsigned cvt_pk_bf16(float lo, float hi) { unsigned r; asm volatile("v_cvt_pk_bf16_f32 %0, %1, %2" : "=v"(r) : "v"(lo), "v"(hi)); return r; }
struct EpiF32 {
    static constexpr bool PERM = false, AFTER_DRAIN = false;
    float* C; int ldc, Mreal, Nreal;
    __device__ __forceinline__ void operator()(const f32x4 (&acc)[2][2][4][2], const Unit& u, int wr, int wc, int fr, int fq) const {
        const int row0 = u.pm * BM + wr * 64 + fr, col0 = u.pn * BM + wc * 32 + 4 * fq;
#pragma unroll
        for (int ai = 0; ai < 2; ++ai)
#pragma unroll
            for (int m = 0; m < 4; ++m) { const int r = row0 + ai * HALF + m * 16; if (r < Mreal) { float* rowp = C + (size_t)r * ldc + col0;
#pragma unroll
                for (int bj = 0; bj < 2; ++bj)
#pragma unroll
                    for (int n = 0; n < 2; ++n) { const int c = col0 + bj * HALF + n * 16; if (c < Nreal) *(f32x4*)(rowp + bj * HALF + n * 16) = acc[ai][bj][m][n]; } } }
    }
};
struct EpiBf16Plain {
    static constexpr bool PERM = true, AFTER_DRAIN = false;
    bf16_t* O; int ldc;
    __device__ __forceinline__ void operator()(const f32x4 (&acc)[2][2][4][2], const Unit& u, int wr, int wc, int fr, int fq) const {
        const int row0 = u.pm * BM + wr * 64 + fr, col0 = u.pn * BM + wc * 32 + 8 * fq;
#pragma unroll
        for (int ai = 0; ai < 2; ++ai)
#pragma unroll
            for (int m = 0; m < 4; ++m) { bf16_t* rowp = O + (size_t)(row0 + ai * HALF + m * 16) * ldc + col0;
#pragma unroll
                for (int bj = 0; bj < 2; ++bj) { const f32x4 v0 = acc[ai][bj][m][0], v1 = acc[ai][bj][m][1]; u32x4 w;
                    w.x = cvt_pk_bf16(v0[0], v0[1]); w.y = cvt_pk_bf16(v0[2], v0[3]); w.z = cvt_pk_bf16(v1[0], v1[1]); w.w = cvt_pk_bf16(v1[2], v1[3]);
                    *(u32x4*)(rowp + bj * HALF) = w; } }
    }
};
struct EpiLru {
    static constexpr bool PERM = false, AFTER_DRAIN = false;
    const float* ba; const float* bx; const float* spl; const float* XC; float* AT; float* BT; int Mreal;
    __device__ __forceinline__ void operator()(const f32x4 (&acc)[2][2][4][2], const Unit& u, int wr, int wc, int fr, int fq) const {
        const int row0 = u.pm * BM + wr * 64 + fr, ch0 = u.pn * 128 + wc * 32 + 4 * fq;
#pragma unroll
        for (int n = 0; n < 2; ++n) { const int c = ch0 + 16 * n; const f32x4 ba4 = *(const f32x4*)(ba + c), bx4 = *(const f32x4*)(bx + c), sp4 = *(const f32x4*)(spl + c);
#pragma unroll
            for (int ai = 0; ai < 2; ++ai)
#pragma unroll
                for (int m = 0; m < 4; ++m) { const int r = row0 + ai * HALF + m * 16; if (r < Mreal) { const f32x4 xc = *(const f32x4*)(XC + (size_t)r * 512 + c); const f32x4 ga = acc[ai][0][m][n] + ba4, gx = acc[ai][1][m][n] + bx4; f32x4 at, bt;
#pragma unroll
                    for (int i = 0; i < 4; ++i) { const float gate_a = 1.f / (1.f + __expf(-ga[i])), gate_x = 1.f / (1.f + __expf(-gx[i])); const float la = gate_a * sp4[i]; at[i] = __expf(la); bt[i] = sqrtf(-expm1f(2.f * la)) * (gate_x * xc[i]); }
                    *(f32x4*)(AT + (size_t)r * 512 + c) = at; *(f32x4*)(BT + (size_t)r * 512 + c) = bt; } } }
    }
};
struct GroupOrder {
    const PG8_LAS Op* tab; int ng, nM, G, c; size_t tsA, tsB;
    __device__ __forceinline__ bool next(int i, Unit& u) const {
        int L = i * G + c, g = 0;
        for (; g < ng; ++g) { const int cnt = nM * (__builtin_amdgcn_readfirstlane(tab[g].i5) >> 8); if (L < cnt) break; L -= cnt; }
        if (g >= ng) return false;
        u.pm = L % nM; u.pn = L / nM; u.grp = g; u.pad_ = 0;
        u.A = (const char*)uni_ptr(tab[g].a) + (size_t)u.pm * tsA; u.B = (const char*)uni_ptr(tab[g].b) + (size_t)u.pn * tsB; return true;
    }
    __device__ __forceinline__ void a_ready(const Unit&) const {}
    __device__ __forceinline__ void done(const Unit&) const {}
};
struct EpiGroup {
    static constexpr bool PERM = true, AFTER_DRAIN = false;
    const PG8_LAS Op* tab; int Mreal;
    __device__ __forceinline__ void operator()(const f32x4 (&acc)[2][2][4][2], const Unit& u, int wr, int wc, int fr, int fq) const {
        const int ldc = rfl(tab[u.grp].i4), Nreal = rfl(tab[u.grp].i0), fl = rfl(tab[u.grp].i6);
        if (fl & 1) { const EpiBf16Plain E{(bf16_t*)uni_ptr(tab[u.grp].o0), ldc}; E(acc, u, wr, wc, fr, fq); return; }
        float* C = uni_ptr(tab[u.grp].o0); const int row0 = u.pm * BM + wr * 64 + fr, col0 = u.pn * BM + wc * 32 + 8 * fq;
#pragma unroll
        for (int ai = 0; ai < 2; ++ai)
#pragma unroll
            for (int m = 0; m < 4; ++m) { const int r = row0 + ai * HALF + m * 16; if (r < Mreal) { float* rowp = C + (size_t)r * ldc + col0;
#pragma unroll
                for (int bj = 0; bj < 2; ++bj) { if (col0 + bj * HALF < Nreal) { *(f32x4*)(rowp + bj * HALF) = acc[ai][bj][m][0]; *(f32x4*)(rowp + bj * HALF + 4) = acc[ai][bj][m][1]; } } } }
    }
};
}

#define XB_TMO      128
#define XB_XCNT(j)  (256  + 64 * (j))
#define XB_XSUB(j)  (1280 + 64 * (j))
#define XB_XGEN(j)  (2304 + 64 * (j))
#define XB_TOP      3328
#define XB_TOPGEN   3392
#define XCD_BAR_WORDS 3456
#define XB_SPIN_CAP (1u << 18)
#define LAS __attribute__((address_space(3)))
__device__ __forceinline__ unsigned xb_ld(unsigned* p)              { return __hip_atomic_load(p, __ATOMIC_RELAXED, __HIP_MEMORY_SCOPE_AGENT); }
__device__ __forceinline__ unsigned xb_add(unsigned* p, unsigned v) { return __hip_atomic_fetch_add(p, v, __ATOMIC_RELAXED, __HIP_MEMORY_SCOPE_AGENT); }
__device__ __forceinline__ unsigned xb_xcc_id() { return (unsigned)__builtin_amdgcn_s_getreg((3 << 11) | 20) & 0xFu; }
#define XB_SPIN(cond, bar) do { unsigned _sp = 0; while (cond) { __builtin_amdgcn_s_sleep(1); \
    if ((++_sp & 255u) == 0u) { if (xb_ld(&(bar)[XB_TMO])) break; if (_sp > XB_SPIN_CAP) { atomicAdd(&(bar)[XB_TMO], 1u); break; } } } } while (0)
struct XcdBarrier { unsigned* bar; unsigned x; volatile LAS unsigned* st; };
__device__ __forceinline__ XcdBarrier xcd_barrier_post(unsigned* bar, volatile LAS unsigned* st) {
    XcdBarrier b; b.bar = bar; b.x = xb_xcc_id(); b.st = st;
    if (threadIdx.x == 0) (void)xb_add(&bar[XB_XCNT(b.x)], 1u);
    return b;
}
__device__ __forceinline__ void xcd_barrier_complete(unsigned* bar, unsigned x, unsigned& nloc, unsigned& nx) {
    const unsigned G = gridDim.x * gridDim.y * gridDim.z;
    unsigned sum, cnt, mine, sp = 0u;
    for (;;) {
        sum = 0u; cnt = 0u; mine = 0u;
#pragma unroll
        for (unsigned j = 0; j < 16; ++j) { const unsigned c = xb_ld(&bar[XB_XCNT(j)]); sum += c; cnt += (c > 0u) ? 1u : 0u; mine = (j == x) ? c : mine; }
        if (sum == G) break;
        __builtin_amdgcn_s_sleep(1);
        if ((++sp & 255u) == 0u) { if (xb_ld(&bar[XB_TMO])) break; if (sp > XB_SPIN_CAP) { atomicAdd(&bar[XB_TMO], 1u); break; } }
    }
    nloc = mine > 0u ? mine : 1u; nx = cnt > 0u ? cnt : 1u;
}
__device__ __forceinline__ void xcd_barrier(const XcdBarrier& b) {
    asm volatile("s_waitcnt vmcnt(0)" ::: "memory");
    __syncthreads();
    if (threadIdx.x == 0) {
        unsigned* bar = b.bar;
        __builtin_amdgcn_s_waitcnt(0);
        unsigned nloc = b.st[0], nx = b.st[1];
        if (nloc == 0u) { xcd_barrier_complete(bar, b.x, nloc, nx); b.st[0] = nloc; b.st[1] = nx; }
        const unsigned old = xb_add(&bar[XB_XSUB(b.x)], 1u);
        const unsigned gen = old / nloc;
        if (old + 1u == (gen + 1u) * nloc) {
            __builtin_amdgcn_fence(__ATOMIC_RELEASE, "agent");
            asm volatile("s_waitcnt vmcnt(0)" ::: "memory");
            const unsigned og = xb_add(&bar[XB_TOP], 1u);
            const unsigned tg = og / nx;
            if (og + 1u == (tg + 1u) * nx) xb_add(&bar[XB_TOPGEN], 1u);
            else XB_SPIN(xb_ld(&bar[XB_TOPGEN]) == tg, bar);
            __builtin_amdgcn_fence(__ATOMIC_ACQUIRE, "agent");
            xb_add(&bar[XB_XGEN(b.x)], 1u);
            asm volatile("s_waitcnt vmcnt(0)" ::: "memory");
        } else {
            XB_SPIN(xb_ld(&bar[XB_XGEN(b.x)]) == gen, bar);
            __builtin_amdgcn_fence(__ATOMIC_ACQUIRE, "agent");
            asm volatile("s_waitcnt vmcnt(0)" ::: "memory");
        }
    }
    __syncthreads();
}

namespace fk {
#define GAS __attribute__((address_space(1)))
typedef unsigned u32x4 __attribute__((ext_vector_type(4)));
typedef unsigned u32x2 __attribute__((ext_vector_type(2)));
typedef float f32x4 __attribute__((ext_vector_type(4)));
typedef float f32x2 __attribute__((ext_vector_type(2)));
typedef __bf16 bf2 __attribute__((ext_vector_type(2)));
typedef unsigned short bf16_t;
__device__ __forceinline__ float bflo(unsigned u) { return __uint_as_float(u << 16); }
__device__ __forceinline__ float bfhi(unsigned u) { return __uint_as_float(u & 0xffff0000u); }
__device__ __forceinline__ float dot2(unsigned a, unsigned b, float c) { return __builtin_amdgcn_fdot2_f32_bf16(__builtin_bit_cast(bf2, a), __builtin_bit_cast(bf2, b), c, false); }
__device__ __forceinline__ unsigned pk_bf16(float lo, float hi) { unsigned r; asm volatile("v_cvt_pk_bf16_f32 %0, %1, %2" : "=v"(r) : "v"(lo), "v"(hi)); return r; }
template <int CTRL> __device__ __forceinline__ float dppf(float v) { return __int_as_float(__builtin_amdgcn_update_dpp(0, __float_as_int(v), CTRL, 0xf, 0xf, true)); }
__device__ __forceinline__ float row_max16(float v) { v = fmaxf(v, dppf<0xB1>(v)); v = fmaxf(v, dppf<0x4E>(v)); v = fmaxf(v, dppf<0x141>(v)); v = fmaxf(v, dppf<0x140>(v)); return v; }
__device__ __forceinline__ float row_sum16(float v) { v += dppf<0xB1>(v); v += dppf<0x4E>(v); v += dppf<0x141>(v); v += dppf<0x140>(v); return v; }
__device__ __forceinline__ float shx(float v, int m, int lane) { return __int_as_float(__builtin_amdgcn_ds_bpermute((lane ^ m) << 2, __float_as_int(v))); }
__device__ __forceinline__ float wave_sum(float v, int lane) { v = row_sum16(v); v += shx(v, 16, lane); v += shx(v, 32, lane); return v; }
__device__ __forceinline__ float gelu_tanh(float x) { return 0.5f * x * (1.f + tanhf(0.7978845608028654f * (x + 0.044715f * x * x * x))); }
#define FK_NEG (-3.0e38f)

template <int CTRL> __device__ __forceinline__ int dppi(int v) { return __builtin_amdgcn_update_dpp(0, v, CTRL, 0xf, 0xf, true); }
__device__ __forceinline__ int row_min16i(int v) { v = min(v, dppi<0xB1>(v)); v = min(v, dppi<0x4E>(v)); v = min(v, dppi<0x141>(v)); v = min(v, dppi<0x140>(v)); return v; }
#define FK_CE(a, b) do { const bool sw_ = v[b] > v[a]; const float tv_ = sw_ ? v[b] : v[a]; v[b] = sw_ ? v[a] : v[b]; v[a] = tv_; const int ti_ = sw_ ? id[b] : id[a]; id[b] = sw_ ? id[a] : id[b]; id[a] = ti_; } while (0)
#define FK_SORT8(v, id) do { FK_CE2(v, id, 0, 1); FK_CE2(v, id, 2, 3); FK_CE2(v, id, 4, 5); FK_CE2(v, id, 6, 7); FK_CE2(v, id, 0, 2); FK_CE2(v, id, 1, 3); FK_CE2(v, id, 4, 6); FK_CE2(v, id, 5, 7); FK_CE2(v, id, 1, 2); FK_CE2(v, id, 5, 6); \
    FK_CE2(v, id, 0, 4); FK_CE2(v, id, 1, 5); FK_CE2(v, id, 2, 6); FK_CE2(v, id, 3, 7); FK_CE2(v, id, 2, 4); FK_CE2(v, id, 3, 5); FK_CE2(v, id, 1, 2); FK_CE2(v, id, 3, 4); FK_CE2(v, id, 5, 6); } while (0)
#define FK_CE2(v, id, a, b) do { const bool sw_ = v[b] > v[a]; const float tv_ = sw_ ? v[b] : v[a]; v[b] = sw_ ? v[a] : v[b]; v[a] = tv_; const int ti_ = sw_ ? id[b] : id[a]; id[b] = sw_ ? id[a] : id[b]; id[a] = ti_; } while (0)
__device__ __forceinline__ void top16_of_128_x2(float (&v)[8], int (&id)[8], float (&u)[8], int (&jd)[8], int lane16, float& rv1, int& ri1, float& rv2, int& ri2) {
    FK_SORT8(v, id); FK_SORT8(u, jd);
    rv1 = FK_NEG; ri1 = 0; rv2 = FK_NEG; ri2 = 0;
#pragma unroll
    for (int r = 0; r < 16; ++r) {
        const float wm = row_max16(v[0]), xm = row_max16(u[0]);
        const int cand = (v[0] == wm) ? id[0] : 0x7fffffff, dand = (u[0] == xm) ? jd[0] : 0x7fffffff;
        const int sel = row_min16i(cand), tel = row_min16i(dand);
        const bool mine = (cand == sel), nine = (dand == tel);
        if (lane16 == r) { rv1 = wm; ri1 = sel; rv2 = xm; ri2 = tel; }
#pragma unroll
        for (int i = 0; i < 7; ++i) { v[i] = mine ? v[i + 1] : v[i]; id[i] = mine ? id[i + 1] : id[i]; u[i] = nine ? u[i + 1] : u[i]; jd[i] = nine ? jd[i + 1] : jd[i]; }
        v[7] = mine ? FK_NEG : v[7]; u[7] = nine ? FK_NEG : u[7];
    }
}
__device__ __forceinline__ int fk_key(float x, int lane16) { int k = __float_as_int(x); k ^= (k >> 31) & 0x7fffffff; return (k & ~15) | (15 - lane16); }
__device__ __forceinline__ float fk_unkey(int k) { k &= ~15; k ^= (k >> 31) & 0x7fffffff; return __int_as_float(k); }
__device__ __forceinline__ int row_max16i(int v) { v = max(v, dppi<0xB1>(v)); v = max(v, dppi<0x4E>(v)); v = max(v, dppi<0x141>(v)); v = max(v, dppi<0x140>(v)); return v; }
__device__ __forceinline__ void topk_phase(const GAS float* __restrict__ SC, const GAS bf16_t* __restrict__ Q, const GAS float* __restrict__ KSUM, GAS float* __restrict__ GATE, GAS int* __restrict__ EIDX, int nitems,
                                           LAS unsigned char* lds, int wid, int lane, int wave_gid, int nwaves) {
    LAS unsigned char* wb = lds + wid * 6144;
    LAS int* IDS1 = (LAS int*)wb; LAS int* IDS2 = (LAS int*)(wb + 2048); LAS int* LC1 = (LAS int*)(wb + 4096); LAS int* LC2 = (LAS int*)(wb + 4352); LAS int* CI = (LAS int*)(wb + 4608);
    LAS float* xv = (LAS float*)(wb + 4864); LAS int* DUMP = (LAS int*)(wb + 5120) + lane; LAS int* WL1 = (LAS int*)(wb + 5376); LAS int* WL2 = (LAS int*)(wb + 5632);
    const int lane16 = lane & 15, rowbase = lane & 48;
    for (int wi = wave_gid; wi * 4 < nitems; wi += nwaves) {
        const int it = wi * 4 + (lane >> 4); const int h = it & 7;
        const GAS u32x4* qp = (const GAS u32x4*)(Q + (size_t)it * 256 + 16 * lane16); const u32x4 qa = qp[0], qb = qp[1];
        float qs = 0.f, qq = 0.f;
#pragma unroll
        for (int i = 0; i < 4; ++i) { const float a = bflo(qa[i]), b = bfhi(qa[i]), c = bflo(qb[i]), d = bfhi(qb[i]); qs += (a + b) + (c + d); qq += (a * a + b * b) + (c * c + d * d); }
        const float mu = row_sum16(qs) * (1.f / 256.f); const float var = fmaxf(row_sum16(qq) * (1.f / 256.f) - mu * mu, 0.f); const float rs = 1.f / sqrtf(var + 1e-5f);
        float v[8], u[8]; int id[8], jd[8];
        { const GAS float* sp = SC + (size_t)it * 256 + 8 * lane16; const GAS float* kp = KSUM + h * 256 + 8 * lane16; const f32x4 s0 = *(const GAS f32x4*)sp, s1 = *(const GAS f32x4*)(sp + 4), k0 = *(const GAS f32x4*)kp, k1 = *(const GAS f32x4*)(kp + 4);
          const f32x4 t0 = *(const GAS f32x4*)(sp + 128), t1 = *(const GAS f32x4*)(sp + 132), m0 = *(const GAS f32x4*)(kp + 128), m1 = *(const GAS f32x4*)(kp + 132);
#pragma unroll
          for (int i = 0; i < 4; ++i) { v[i] = rs * (s0[i] - mu * k0[i]); v[4 + i] = rs * (s1[i] - mu * k1[i]); u[i] = rs * (t0[i] - mu * m0[i]); u[4 + i] = rs * (t1[i] - mu * m1[i]);
              id[i] = 8 * lane16 + i; id[4 + i] = 8 * lane16 + 4 + i; jd[i] = 8 * lane16 + i; jd[4 + i] = 8 * lane16 + 4 + i; } }
        FK_SORT8(v, id); FK_SORT8(u, jd);
#pragma unroll
        for (int i = 0; i < 8; ++i) { IDS1[lane * 8 + i] = id[i]; IDS2[lane * 8 + i] = jd[i]; }
        float rv1 = FK_NEG, rv2 = FK_NEG; int wl1 = 0, wl2 = 0, cn1 = 0, cn2 = 0;
#pragma unroll
        for (int r = 0; r < 16; ++r) {
            const int key1 = fk_key(v[0], lane16), key2 = fk_key(u[0], lane16);
            const int wm1 = row_max16i(key1), wm2 = row_max16i(key2);
            const bool mine = (key1 == wm1), nine = (key2 == wm2);
            if (lane16 == r) { rv1 = fk_unkey(wm1); wl1 = 15 - (wm1 & 15); rv2 = fk_unkey(wm2); wl2 = 15 - (wm2 & 15); }
            *(mine ? LC1 + rowbase + r : DUMP) = cn1; *(nine ? LC2 + rowbase + r : DUMP) = cn2;
#pragma unroll
            for (int i = 0; i < 7; ++i) { v[i] = mine ? v[i + 1] : v[i]; u[i] = nine ? u[i + 1] : u[i]; }
            v[7] = mine ? FK_NEG : v[7]; u[7] = nine ? FK_NEG : u[7]; cn1 += mine ? 1 : 0; cn2 += nine ? 1 : 0;
        }
        xv[lane] = rv2; WL1[lane] = wl1; WL2[lane] = wl2;
        float c[16];
        { const LAS f32x4* xp = (const LAS f32x4*)(xv + rowbase);
#pragma unroll
          for (int q = 0; q < 4; ++q) { const f32x4 t = xp[q]; c[4 * q] = rv1 + t.x; c[4 * q + 1] = rv1 + t.y; c[4 * q + 2] = rv1 + t.z; c[4 * q + 3] = rv1 + t.w; } }
        int p = 0, wli = 0; float sc = FK_NEG;
#pragma unroll
        for (int r = 0; r < 16; ++r) {
            const int key = fk_key(c[0], lane16); const int wm = row_max16i(key); const bool mine = (key == wm);
            if (lane16 == r) { sc = fk_unkey(wm); wli = 15 - (wm & 15); }
            *(mine ? CI + rowbase + r : DUMP) = p;
#pragma unroll
            for (int i = 0; i < 15; ++i) c[i] = mine ? c[i + 1] : c[i];
            c[15] = mine ? FK_NEG : c[15]; p += mine ? 1 : 0;
        }
        const int i1 = wli & 15, j2 = CI[rowbase + lane16] & 15;
        const int e1 = IDS1[(rowbase + (WL1[rowbase + i1] & 15)) * 8 + (LC1[rowbase + i1] & 7)], e2 = IDS2[(rowbase + (WL2[rowbase + j2] & 15)) * 8 + (LC2[rowbase + j2] & 7)];
        const float mx = fk_unkey(row_max16i(fk_key(sc, 0))); const float ex = __expf(sc - mx); const float den = row_sum16(ex);
        GATE[(size_t)it * 16 + lane16] = ex / den; EIDX[(size_t)it * 16 + lane16] = (e1 & 127) * 128 + (e2 & 127);
    }
}

__device__ __forceinline__ f32x2 fp8lo(unsigned w) { return __builtin_amdgcn_cvt_pk_f32_fp8((int)w, false); }
__device__ __forceinline__ f32x2 fp8hi(unsigned w) { return __builtin_amdgcn_cvt_pk_f32_fp8((int)w, true); }
__device__ __forceinline__ void act_phase(const GAS bf16_t* __restrict__ XB, const GAS unsigned char* __restrict__ U8, const GAS float* __restrict__ GATE, const GAS int* __restrict__ EIDX, GAS float* __restrict__ COEF, int nitems,
                                          int lane, int wave_gid, int nwaves) {
    int it = wave_gid; if (it >= nitems) return;
    u32x4 uc[16], un[16], xac, xbc, xan, xbn;
    int evc = EIDX[(size_t)it * 16 + (lane & 15)];
    { const GAS u32x4* xp = (const GAS u32x4*)(XB + (size_t)(it >> 3) * 1024 + 16 * lane); xac = xp[0]; xbc = xp[1]; }
#pragma unroll
    for (int k = 0; k < 16; ++k) uc[k] = *(const GAS u32x4*)(U8 + (size_t)__builtin_amdgcn_readlane(evc, k) * 1024 + 16 * lane);
    int itn = it + nwaves; int evn = (itn < nitems) ? EIDX[(size_t)itn * 16 + (lane & 15)] : 0;
    for (;;) {
        const bool hasn = itn < nitems;
        if (hasn) {
            const GAS u32x4* xp = (const GAS u32x4*)(XB + (size_t)(itn >> 3) * 1024 + 16 * lane); xan = xp[0]; xbn = xp[1];
#pragma unroll
            for (int k = 0; k < 16; ++k) un[k] = *(const GAS u32x4*)(U8 + (size_t)__builtin_amdgcn_readlane(evn, k) * 1024 + 16 * lane);
        }
        const int itnn = itn + nwaves; const int evnn = (itnn < nitems) ? EIDX[(size_t)itnn * 16 + (lane & 15)] : 0;
        const float gt = GATE[(size_t)it * 16 + (lane >> 2)];
        float x[16];
#pragma unroll
        for (int i = 0; i < 4; ++i) { x[2 * i] = bflo(xac[i]); x[2 * i + 1] = bfhi(xac[i]); x[8 + 2 * i] = bflo(xbc[i]); x[8 + 2 * i + 1] = bfhi(xbc[i]); }
        float a[16];
#pragma unroll
        for (int k = 0; k < 16; ++k) { const u32x4 uw = uc[k]; float s = 0.f;
#pragma unroll
            for (int d = 0; d < 4; ++d) { const f32x2 lo = fp8lo(uw[d]), hi = fp8hi(uw[d]); s = fmaf(lo.x, x[4 * d], s); s = fmaf(lo.y, x[4 * d + 1], s); s = fmaf(hi.x, x[4 * d + 2], s); s = fmaf(hi.y, x[4 * d + 3], s); }
            asm volatile("" : "+v"(s)); a[k] = s; }
#pragma unroll
        for (int k = 0; k < 8; ++k) { const bool hi = lane & 32; const float send = hi ? a[k] : a[k + 8], keep = hi ? a[k + 8] : a[k]; a[k] = keep + shx(send, 32, lane); }
#pragma unroll
        for (int k = 0; k < 4; ++k) { const bool hi = lane & 16; const float send = hi ? a[k] : a[k + 4], keep = hi ? a[k + 4] : a[k]; a[k] = keep + shx(send, 16, lane); }
#pragma unroll
        for (int k = 0; k < 2; ++k) { const bool hi = lane & 8; const float send = hi ? a[k] : a[k + 2], keep = hi ? a[k + 2] : a[k]; a[k] = keep + shx(send, 8, lane); }
        { const bool hi = lane & 4; const float send = hi ? a[0] : a[1], keep = hi ? a[1] : a[0]; a[0] = keep + shx(send, 4, lane); }
        float dsum = a[0]; dsum += shx(dsum, 2, lane); dsum += shx(dsum, 1, lane);
        if ((lane & 3) == 0) COEF[(size_t)it * 16 + (lane >> 2)] = gt * gelu_tanh(dsum * (1.f / 128.f));
        if (!hasn) break;
#pragma unroll
        for (int k = 0; k < 16; ++k) uc[k] = un[k];
        xac = xan; xbc = xbn; evc = evn; evn = evnn; it = itn; itn = itnn;
    }
}

__device__ __forceinline__ void outln_phase(const GAS float* COEF, const GAS int* EIDX, const GAS unsigned char* V8,     const GAS float* __restrict__ lg, const GAS float* __restrict__ lb, GAS float* X, GAS bf16_t* XB, int nrows,
                                            int lane, int wave_gid, int nwaves) {
    const float alpha = 1.6817928305074292f;
    int row = wave_gid; if (row >= nrows) return;
    u32x4 vc[16], vn[16];
    float cf0 = COEF[(size_t)row * 128 + lane] * (1.f / 64.f), cf1 = COEF[(size_t)row * 128 + 64 + lane] * (1.f / 64.f); int ev0 = EIDX[(size_t)row * 128 + lane], ev1 = EIDX[(size_t)row * 128 + 64 + lane];
#define OUT_LOADCH(dst, evreg, base) do { _Pragma("unroll") for (int k_ = 0; k_ < 16; ++k_) dst[k_] = *(const GAS u32x4*)(V8 + (size_t)__builtin_amdgcn_readlane(evreg, (base) + k_) * 1024 + 16 * lane); } while (0)
#define OUT_COMPCH(src, cfreg, base) do { _Pragma("unroll") for (int k_ = 0; k_ < 16; ++k_) { const float c_ = __int_as_float(__builtin_amdgcn_readlane(__float_as_int(cfreg), (base) + k_)); const u32x4 vw_ = src[k_]; \
        _Pragma("unroll") for (int d_ = 0; d_ < 4; ++d_) { const f32x2 lo_ = fp8lo(vw_[d_]), hi_ = fp8hi(vw_[d_]); acc[4 * d_] = fmaf(c_, lo_.x, acc[4 * d_]); acc[4 * d_ + 1] = fmaf(c_, lo_.y, acc[4 * d_ + 1]); acc[4 * d_ + 2] = fmaf(c_, hi_.x, acc[4 * d_ + 2]); acc[4 * d_ + 3] = fmaf(c_, hi_.y, acc[4 * d_ + 3]); } \
        _Pragma("unroll") for (int p_ = 0; p_ < 16; ++p_) asm volatile("" : "+v"(acc[p_]));     \
        } } while (0)
    for (;;) {
        OUT_LOADCH(vc, ev0, 0);
        const int rown = row + nwaves; const bool hasn = rown < nrows;
        float ncf0 = 0.f, ncf1 = 0.f; int nev0 = 0, nev1 = 0;
        if (hasn) { ncf0 = COEF[(size_t)rown * 128 + lane] * (1.f / 64.f); ncf1 = COEF[(size_t)rown * 128 + 64 + lane] * (1.f / 64.f); nev0 = EIDX[(size_t)rown * 128 + lane]; nev1 = EIDX[(size_t)rown * 128 + 64 + lane]; }
        float acc[16];
#pragma unroll
        for (int k = 0; k < 16; ++k) acc[k] = 0.f;
#define OUT_FENCE() asm volatile("" ::: "memory")
        OUT_LOADCH(vn, ev0, 16); OUT_FENCE(); OUT_COMPCH(vc, cf0, 0); OUT_FENCE();
        OUT_LOADCH(vc, ev0, 32); OUT_FENCE(); OUT_COMPCH(vn, cf0, 16); OUT_FENCE();
        OUT_LOADCH(vn, ev0, 48); OUT_FENCE(); OUT_COMPCH(vc, cf0, 32); OUT_FENCE();
        OUT_LOADCH(vc, ev1, 0);  OUT_FENCE(); OUT_COMPCH(vn, cf0, 48); OUT_FENCE();
        OUT_LOADCH(vn, ev1, 16); OUT_FENCE(); OUT_COMPCH(vc, cf1, 0); OUT_FENCE();
        OUT_LOADCH(vc, ev1, 32); OUT_FENCE(); OUT_COMPCH(vn, cf1, 16); OUT_FENCE();
        OUT_LOADCH(vn, ev1, 48); OUT_FENCE(); OUT_COMPCH(vc, cf1, 32); OUT_FENCE();
        OUT_COMPCH(vn, cf1, 48); OUT_FENCE();
#undef OUT_FENCE
        GAS float* xr = X + (size_t)row * 1024 + 16 * lane; float t[16];
#pragma unroll
        for (int q = 0; q < 4; ++q) { const f32x4 xv = *(const GAS f32x4*)(xr + 4 * q); t[4 * q] = fmaf(alpha, xv.x, acc[4 * q]); t[4 * q + 1] = fmaf(alpha, xv.y, acc[4 * q + 1]); t[4 * q + 2] = fmaf(alpha, xv.z, acc[4 * q + 2]); t[4 * q + 3] = fmaf(alpha, xv.w, acc[4 * q + 3]); }
        float s = 0.f;
#pragma unroll
        for (int k = 0; k < 16; ++k) s += t[k];
        const float mu = wave_sum(s, lane) * (1.f / 1024.f); float vs = 0.f;
#pragma unroll
        for (int k = 0; k < 16; ++k) { t[k] -= mu; vs = fmaf(t[k], t[k], vs); }
        const float rs = 1.f / sqrtf(wave_sum(vs, lane) * (1.f / 1024.f) + 1e-5f);
        unsigned w[8];
#pragma unroll
        for (int q = 0; q < 4; ++q) { const f32x4 g = *(const GAS f32x4*)(lg + 16 * lane + 4 * q), b = *(const GAS f32x4*)(lb + 16 * lane + 4 * q); f32x4 o;
            o.x = t[4 * q] * rs * g.x + b.x; o.y = t[4 * q + 1] * rs * g.y + b.y; o.z = t[4 * q + 2] * rs * g.z + b.z; o.w = t[4 * q + 3] * rs * g.w + b.w;
            *(GAS f32x4*)(xr + 4 * q) = o; w[2 * q] = pk_bf16(o.x, o.y); w[2 * q + 1] = pk_bf16(o.z, o.w); }
        u32x4 w0, w1; w0.x = w[0]; w0.y = w[1]; w0.z = w[2]; w0.w = w[3]; w1.x = w[4]; w1.y = w[5]; w1.z = w[6]; w1.w = w[7];
        GAS u32x4* xbp = (GAS u32x4*)(XB + (size_t)row * 1024 + 16 * lane); xbp[0] = w0; xbp[1] = w1;
        if (!hasn) break;
        row = rown; cf0 = ncf0; cf1 = ncf1; ev0 = nev0; ev1 = nev1;
    }
#undef OUT_LOADCH
#undef OUT_COMPCH
}

__device__ __forceinline__ void lnres_phase(const GAS bf16_t* __restrict__ Y, const GAS float* __restrict__ lg, const GAS float* __restrict__ lb, GAS float* X, GAS bf16_t* XB, int nrows, int lane, int wave_gid, int nwaves) {
    const float alpha = 1.6817928305074292f;
    for (int row = wave_gid; row < nrows; row += nwaves) {
        GAS float* xr = X + (size_t)row * 1024; const GAS bf16_t* yr = Y + (size_t)row * 1024; float t[16];
#pragma unroll
        for (int q = 0; q < 4; ++q) { const f32x4 xv = *(const GAS f32x4*)(xr + 256 * q + 4 * lane); const u32x2 yw = *(const GAS u32x2*)(yr + 256 * q + 4 * lane);
            t[4 * q] = fmaf(alpha, xv.x, bflo(yw.x)); t[4 * q + 1] = fmaf(alpha, xv.y, bfhi(yw.x)); t[4 * q + 2] = fmaf(alpha, xv.z, bflo(yw.y)); t[4 * q + 3] = fmaf(alpha, xv.w, bfhi(yw.y)); }
        float s = 0.f;
#pragma unroll
        for (int k = 0; k < 16; ++k) s += t[k];
        const float mu = wave_sum(s, lane) * (1.f / 1024.f); float vs = 0.f;
#pragma unroll
        for (int k = 0; k < 16; ++k) { t[k] -= mu; vs = fmaf(t[k], t[k], vs); }
        const float rs = 1.f / sqrtf(wave_sum(vs, lane) * (1.f / 1024.f) + 1e-5f);
#pragma unroll
        for (int q = 0; q < 4; ++q) { const int c = 256 * q + 4 * lane; const f32x4 g = *(const GAS f32x4*)(lg + c), b = *(const GAS f32x4*)(lb + c); f32x4 o;
            o.x = t[4 * q] * rs * g.x + b.x; o.y = t[4 * q + 1] * rs * g.y + b.y; o.z = t[4 * q + 2] * rs * g.z + b.z; o.w = t[4 * q + 3] * rs * g.w + b.w;
            *(GAS f32x4*)(xr + c) = o; u32x2 w; w.x = pk_bf16(o.x, o.y); w.y = pk_bf16(o.z, o.w); *(GAS u32x2*)(XB + (size_t)row * 1024 + c) = w; }
    }
}

__device__ __forceinline__ void glanorm_phase(const GAS float* __restrict__ O, const GAS float* __restrict__ PROJ, const GAS float* __restrict__ gnorm, GAS bf16_t* XB, int nitems, int lane, int wave_gid, int nwaves) {
    const float g0 = gnorm[lane], g1 = gnorm[64 + lane];
    for (int it0 = wave_gid * 4; it0 < nitems; it0 += nwaves * 4) {
        float a0[4], a1[4], r0[4], r1[4];
#pragma unroll
        for (int q = 0; q < 4; ++q) { int it = it0 + q; it = it < nitems ? it : it0; const int row = it >> 2, h = it & 3; const GAS float* o = O + (size_t)row * 512 + h * 128; const GAS float* r = PROJ + (size_t)row * 2576 + 1040 + h * 128;
            a0[q] = o[lane]; a1[q] = o[64 + lane]; r0[q] = r[lane]; r1[q] = r[64 + lane]; }
#pragma unroll
        for (int q = 0; q < 4; ++q) { const int it = it0 + q; const int row = it >> 2, h = it & 3;
            const float rs = 1.f / sqrtf(wave_sum(a0[q] * a0[q] + a1[q] * a1[q], lane) * (1.f / 128.f) + 1e-5f);
            const float y0 = a0[q] * rs * g0 * (r0[q] / (1.f + __expf(-r0[q]))), y1 = a1[q] * rs * g1 * (r1[q] / (1.f + __expf(-r1[q])));
            if (it < nitems) { GAS bf16_t* d = XB + (size_t)row * 1024 + h * 128; d[lane] = (bf16_t)(pk_bf16(y0, 0.f) & 0xffffu); d[64 + lane] = (bf16_t)(pk_bf16(y1, 0.f) & 0xffffu); } }
    }
}

__device__ __forceinline__ float sigm(float x) { return 1.f / (1.f + __expf(-x)); }
__device__ __forceinline__ float softplusf(float x) { return fmaxf(x, 0.f) + log1pf(__expf(-fabsf(x))); }
__device__ __forceinline__ void rwkvprep_phase(const GAS float* __restrict__ w0, const GAS float* __restrict__ a0, const GAS float* __restrict__ v0, const GAS float* __restrict__ k_k, const GAS float* __restrict__ k_a, const GAS float* __restrict__ Vg,
                                               GAS float* K, GAS float* Wd, GAS float* Aa, GAS float* V, GAS float* NKK, GAS float* VFIRST, int has_vres, int nitems, int lane, int wave_gid, int nwaves) {
    for (int it0 = wave_gid * 4; it0 < nitems; it0 += nwaves * 4) {
        float kq[4], wq[4], aq[4], vq[4], gq[4], fq[4];
#pragma unroll
        for (int q = 0; q < 4; ++q) { const int it = it0 + q; const size_t ix = (size_t)(it >> 4) * 1024 + (it & 15) * 64 + lane; kq[q] = K[ix]; wq[q] = Wd[ix]; aq[q] = Aa[ix]; vq[q] = V[ix]; gq[q] = has_vres ? Vg[ix] : 0.f; fq[q] = has_vres ? VFIRST[ix] : 0.f; }
#pragma unroll
        for (int q = 0; q < 4; ++q) { const int it = it0 + q; const int h = it & 15; const size_t ix = (size_t)(it >> 4) * 1024 + h * 64 + lane; const int c = h * 64 + lane;
            const float k0 = kq[q]; const float kv = k0 * k_k[c]; const float inv = 1.f / fmaxf(sqrtf(wave_sum(kv * kv, lane)), 1e-12f);
            const float w = -softplusf(-(w0[c] + wq[q])) - 0.5f; const float dec = __expf(-__expf(w));
            const float a = sigm(a0[c] + aq[q]);
            float v = vq[q]; if (has_vres) v = v + (fq[q] - v) * sigm(v0[c] + gq[q]); else VFIRST[ix] = v;
            const float kk = kv * inv;
            NKK[ix] = -kk; K[ix] = k0 * (1.f + (a - 1.f) * k_a[c]); Wd[ix] = dec; Aa[ix] = kk * a; V[ix] = v; }
    }
}

__device__ __forceinline__ void rwkvpost_phase(const GAS float* __restrict__ Y, const GAS float* __restrict__ R, const GAS float* __restrict__ K2, const GAS float* __restrict__ V, const GAS float* __restrict__ G, const GAS float* __restrict__ r_k,
                                               const GAS float* __restrict__ lnx_g, const GAS float* __restrict__ lnx_b, GAS bf16_t* XB, int nitems, int lane, int wave_gid, int nwaves) {
    for (int it0 = wave_gid * 4; it0 < nitems; it0 += nwaves * 4) {
        float yq[4], rq[4], kq[4], vq[4], gq[4];
#pragma unroll
        for (int q = 0; q < 4; ++q) { const int it = it0 + q; const size_t ix = (size_t)(it >> 4) * 1024 + (it & 15) * 64 + lane; yq[q] = Y[ix]; rq[q] = R[ix]; kq[q] = K2[ix]; vq[q] = V[ix]; gq[q] = G[ix]; }
#pragma unroll
        for (int q = 0; q < 4; ++q) { const int it = it0 + q; const int h = it & 15; const size_t ix = (size_t)(it >> 4) * 1024 + h * 64 + lane; const int c = h * 64 + lane;
            const float y = yq[q]; const float mu = wave_sum(y, lane) * (1.f / 64.f); const float d = y - mu; const float rs = 1.f / sqrtf(wave_sum(d * d, lane) * (1.f / 64.f) + 64e-5f);
            const float bon = wave_sum(rq[q] * kq[q] * r_k[c], lane);
            const float o = (d * rs * lnx_g[c] + lnx_b[c] + bon * vq[q]) * gq[q];
            XB[ix] = (bf16_t)(pk_bf16(o, 0.f) & 0xffffu); }
    }
}

__device__ __forceinline__ void wkv_phase(const GAS float* __restrict__ R, const GAS float* __restrict__ Wd, const GAS float* __restrict__ K2, const GAS float* __restrict__ V, const GAS float* __restrict__ BB, const GAS float* __restrict__ NKK,
                                          const GAS float* __restrict__ SIN, GAS float* __restrict__ Y, GAS float* __restrict__ P, GAS float* __restrict__ SOUT, int B, int T, int DB, int DT, LAS unsigned char* lds, int tid, int bid, int nb) {
    constexpr int TB = 32, NLD = 6, VECB = TB * 1280, VVB = TB * 128, BUF = VECB + 2 * VVB;
    const int rowl = tid >> 4, part = tid & 15;
    const int nprompt = B * 32, nunits = nprompt + DB * 32;
    for (int u = bid; u < nunits; u += nb) {
        const bool smp = u >= nprompt; const int q0_ = smp ? u - nprompt : u; const int q = ((q0_ & 7) << 1 | ((q0_ >> 3) & 1)) + ((q0_ >> 4) << 4);
        const int half = q & 1, pair = q >> 1, sq = pair >> 4, h = pair & 15;
        const int Tu = smp ? DT : T; const int r0 = smp ? B * T + sq * DT : sq * T, vrow = half * 32 + rowl;
        f32x2 S01 = (f32x2){0.f, 0.f}, S23 = (f32x2){0.f, 0.f};
        if (smp) { const f32x4 s4 = *(const GAS f32x4*)(SIN + ((size_t)pair * 64 + vrow) * 64 + part * 4); S01 = (f32x2){s4.x, s4.y}; S23 = (f32x2){s4.z, s4.w};
                   asm volatile("" : "+v"(S01), "+v"(S23)); }
        const int nblk = (Tu + TB - 1) / TB;
        f32x4 ld[NLD];
        const size_t eo_ = (size_t)(r0 + (tid >> 4)) * 1024 + h * 64 + (tid & 15) * 4, ev_ = (size_t)(r0 + ((tid & 255) >> 3)) * 1024 + h * 64 + half * 32 + (tid & 7) * 4;
        const int lo_ = ((tid >> 4) * 320 + (tid & 15) * 4) * 4, lv_ = VECB + (tid & 255) * 16;
#define WKV_LOAD(tb0) do { const size_t bo_ = (size_t)(tb0) * 1024; ld[0] = *(const GAS f32x4*)(Wd + eo_ + bo_); ld[1] = *(const GAS f32x4*)(NKK + eo_ + bo_); ld[2] = *(const GAS f32x4*)(BB + eo_ + bo_); \
            ld[3] = *(const GAS f32x4*)(K2 + eo_ + bo_); ld[4] = *(const GAS f32x4*)(R + eo_ + bo_); ld[5] = *(const GAS f32x4*)(V + ev_ + bo_); } while (0)
#define WKV_STORE(bufp) do { _Pragma("unroll") for (int q_ = 0; q_ < 5; ++q_) *(LAS f32x4*)((bufp) + lo_ + q_ * 256) = ld[q_]; *(LAS f32x4*)((bufp) + lv_) = ld[5]; } while (0)
        WKV_LOAD(0); WKV_STORE(lds); __syncthreads();
        for (int b = 0; b < nblk; ++b) {
            LAS unsigned char* cur = lds + (b & 1) * BUF; LAS unsigned char* nxt = lds + ((b + 1) & 1) * BUF; const int tb0 = b * TB; const int nt = (Tu - tb0) < TB ? (Tu - tb0) : TB;
            if (b + 1 < nblk) WKV_LOAD(tb0 + TB);
            const LAS float* vec = (const LAS float*)cur + part * 4; const LAS float* vv = (const LAS float*)(cur + VECB) + rowl; LAS float* yb = (LAS float*)(cur + VECB + VVB);
            float ykeep0 = 0.f, ykeep1 = 0.f;
#define WKV_STEP(t, keep, tl) do { const LAS f32x2* vp_ = (const LAS f32x2*)(vec + (t) * 320); \
                const f32x2 w01 = vp_[0], w23 = vp_[1], n01 = vp_[32], n23 = vp_[33], b01 = vp_[64], b23 = vp_[65], k01 = vp_[96], k23 = vp_[97], r01 = vp_[128], r23 = vp_[129]; \
                const float v = vv[(t) * 32]; \
                const f32x2 sp = __builtin_elementwise_fma(S23, n23, S01 * n01); const float sa = row_sum16(sp.x + sp.y); const f32x2 sa2 = (f32x2){sa, sa}, v2 = (f32x2){v, v}; \
                S01 = __builtin_elementwise_fma(S01, w01, __builtin_elementwise_fma(b01, sa2, k01 * v2)); S23 = __builtin_elementwise_fma(S23, w23, __builtin_elementwise_fma(b23, sa2, k23 * v2)); \
                const f32x2 yp = __builtin_elementwise_fma(S23, r23, S01 * r01); const float y = row_sum16(yp.x + yp.y); \
                keep = (part == (tl)) ? y : keep; } while (0)
            if (nt == TB) {
#pragma unroll 1
                for (int t = 0; t < 16; t += 8) { WKV_STEP(t, ykeep0, t); WKV_STEP(t + 1, ykeep0, t + 1); WKV_STEP(t + 2, ykeep0, t + 2); WKV_STEP(t + 3, ykeep0, t + 3); WKV_STEP(t + 4, ykeep0, t + 4); WKV_STEP(t + 5, ykeep0, t + 5); WKV_STEP(t + 6, ykeep0, t + 6); WKV_STEP(t + 7, ykeep0, t + 7); }
#pragma unroll 1
                for (int t = 16; t < 32; t += 8) { WKV_STEP(t, ykeep1, t - 16); WKV_STEP(t + 1, ykeep1, t - 15); WKV_STEP(t + 2, ykeep1, t - 14); WKV_STEP(t + 3, ykeep1, t - 13); WKV_STEP(t + 4, ykeep1, t - 12); WKV_STEP(t + 5, ykeep1, t - 11); WKV_STEP(t + 6, ykeep1, t - 10); WKV_STEP(t + 7, ykeep1, t - 9); }
            } else { for (int t = 0; t < nt; ++t) { if (t < 16) WKV_STEP(t, ykeep0, t); else WKV_STEP(t, ykeep1, t - 16); } }
#undef WKV_STEP
            yb[part * 32 + rowl] = ykeep0; yb[(16 + part) * 32 + rowl] = ykeep1;
            if (b + 1 < nblk) WKV_STORE(nxt);
            __syncthreads();
            { const int rl = tid & 31; _Pragma("unroll") for (int t = tid >> 5; t < TB; t += 16) if (t < nt) Y[(size_t)(r0 + tb0 + t) * 1024 + h * 64 + half * 32 + rl] = yb[t * 32 + rl]; }
        }
#undef WKV_LOAD
#undef WKV_STORE
        *(GAS f32x4*)((smp ? SOUT : P) + ((size_t)pair * 64 + vrow) * 64 + part * 4) = (f32x4){S01.x, S01.y, S23.x, S23.y};
        __syncthreads();
    }
}

__device__ __forceinline__ void rwkvpost2_phase(const GAS float* __restrict__ Y, const GAS bf16_t* __restrict__ G, const GAS float* __restrict__ VF, const GAS float* __restrict__ BON, const GAS float* __restrict__ lnx_g, const GAS float* __restrict__ lnx_b,
                                                GAS bf16_t* XB, int nitems, int lane, int wave_gid, int nwaves) {
    for (int it0 = wave_gid * 4; it0 < nitems; it0 += nwaves * 4) {
        float yq[4], gq[4], vq[4], bq[4];
#pragma unroll
        for (int q = 0; q < 4; ++q) { const int it = it0 + q; const size_t ix = (size_t)(it >> 4) * 1024 + (it & 15) * 64 + lane; yq[q] = Y[ix]; gq[q] = __uint_as_float((unsigned)G[ix] << 16); vq[q] = VF[ix]; bq[q] = BON[it]; }
#pragma unroll
        for (int q = 0; q < 4; ++q) { const int it = it0 + q; const int h = it & 15; const size_t ix = (size_t)(it >> 4) * 1024 + h * 64 + lane; const int c = h * 64 + lane;
            const float y = yq[q]; const float mu = wave_sum(y, lane) * (1.f / 64.f); const float d = y - mu; const float rs = 1.f / sqrtf(wave_sum(d * d, lane) * (1.f / 64.f) + 64e-5f);
            const float o = (d * rs * lnx_g[c] + lnx_b[c] + bq[q] * vq[q]) * gq[q];
            XB[ix] = (bf16_t)(pk_bf16(o, 0.f) & 0xffffu); }
    }
}

__device__ __forceinline__ void wkv2_phase(const GAS bf16_t* __restrict__ R, const GAS bf16_t* __restrict__ KR, const GAS bf16_t* __restrict__ WL, const GAS bf16_t* __restrict__ AL, const GAS bf16_t* __restrict__ V, const GAS bf16_t* __restrict__ VG,
                                           const GAS float* VFI, const GAS float* __restrict__ PRM, const GAS float* __restrict__ SIN, GAS float* __restrict__ Y, GAS float* __restrict__ P, GAS float* __restrict__ SOUT, GAS float* VFO, GAS float* __restrict__ BON,
                                           int has_vres, int B, int T, int DB, int DT, LAS unsigned char* lds, int tid, int bid, int nb) {
    constexpr int TB = 32, NLD = 7, VECB = TB * 1280, VVB = TB * 128, BUF = VECB + 2 * VVB;
    const int rowl = tid >> 4, part = tid & 15;
    const int nprompt = B * 32, nunits = nprompt + DB * 32;
    for (int u = bid; u < nunits; u += nb) {
        const bool smp = u >= nprompt; const int q0_ = smp ? u - nprompt : u; const int q = ((q0_ & 7) << 1 | ((q0_ >> 3) & 1)) + ((q0_ >> 4) << 4);
        const int half = q & 1, pair = q >> 1, sq = pair >> 4, h = pair & 15;
        const int Tu = smp ? DT : T; const int r0 = smp ? B * T + sq * DT : sq * T, vrow = half * 32 + rowl;
        f32x2 S01 = (f32x2){0.f, 0.f}, S23 = (f32x2){0.f, 0.f};
        if (smp) { const f32x4 s4 = *(const GAS f32x4*)(SIN + ((size_t)pair * 64 + vrow) * 64 + part * 4); S01 = (f32x2){s4.x, s4.y}; S23 = (f32x2){s4.z, s4.w};
                   asm volatile("" : "+v"(S01), "+v"(S23)); }
        const int nblk = (Tu + TB - 1) / TB;
        u32x2 lk, lw, la, lr, lv, lg = (u32x2){0u, 0u}; f32x4 lf = (f32x4){0.f, 0.f, 0.f, 0.f};
        const size_t eo_ = (size_t)(r0 + (tid >> 4)) * 1024 + h * 64 + (tid & 15) * 4, ev_ = (size_t)(r0 + ((tid & 255) >> 3)) * 1024 + h * 64 + half * 32 + (tid & 7) * 4;
        const int lo_ = ((tid >> 4) * 320 + (tid & 15) * 4) * 4, lv_ = VECB + (tid & 255) * 16;
        const int pc_ = h * 64 + (tid & 15) * 4; const f32x4 w0v = *(const GAS f32x4*)(PRM + pc_), a0v = *(const GAS f32x4*)(PRM + 1024 + pc_), kkp = *(const GAS f32x4*)(PRM + 3072 + pc_), kap = *(const GAS f32x4*)(PRM + 4096 + pc_), rkp = *(const GAS f32x4*)(PRM + 5120 + pc_);
        const f32x4 v0v = *(const GAS f32x4*)(PRM + 2048 + h * 64 + half * 32 + (tid & 7) * 4);
#define WKV_LOAD(tb0) do { const size_t bo_ = (size_t)(tb0) * 1024; lk = *(const GAS u32x2*)(KR + eo_ + bo_); lw = *(const GAS u32x2*)(WL + eo_ + bo_); la = *(const GAS u32x2*)(AL + eo_ + bo_); \
            lr = *(const GAS u32x2*)(R + eo_ + bo_); lv = *(const GAS u32x2*)(V + ev_ + bo_); if (has_vres) { lg = *(const GAS u32x2*)(VG + ev_ + bo_); lf = *(const GAS f32x4*)(VFI + ev_ + bo_); } } while (0)
#define WKV_UNPK(w_) ((f32x4){bflo((w_).x), bfhi((w_).x), bflo((w_).y), bfhi((w_).y)})
#define WKV_STORE(bufp, tb0) do { const f32x4 k4 = WKV_UNPK(lk), wl4 = WKV_UNPK(lw), al4 = WKV_UNPK(la); const f32x4 kv = k4 * kkp; const float ss = row_sum16((kv.x * kv.x + kv.y * kv.y) + (kv.z * kv.z + kv.w * kv.w)); const float inv = 1.f / fmaxf(sqrtf(ss), 1e-12f); \
            f32x4 dec, a4; _Pragma("unroll") for (int i_ = 0; i_ < 4; ++i_) { dec[i_] = __expf(-0.6065306597126334f / (1.f + __expf(-(w0v[i_] + wl4[i_])))); a4[i_] = 1.f / (1.f + __expf(-(a0v[i_] + al4[i_]))); } \
            const f32x4 kk = kv * inv; const f32x4 k2 = k4 * ((a4 - 1.f) * kap + 1.f); const f32x4 r4 = WKV_UNPK(lr); const f32x4 rk = r4 * k2 * rkp; const float bon = row_sum16((rk.x + rk.y) + (rk.z + rk.w)); \
            *(LAS f32x4*)((bufp) + lo_) = dec; *(LAS f32x4*)((bufp) + lo_ + 256) = -kk; *(LAS f32x4*)((bufp) + lo_ + 512) = kk * a4; *(LAS f32x4*)((bufp) + lo_ + 768) = k2; *(LAS f32x4*)((bufp) + lo_ + 1024) = r4; \
            const int tr_ = (tb0) + (tid >> 4); if (half == 0 && (tid & 15) == 0 && tr_ < Tu) BON[(size_t)(r0 + tr_) * 16 + h] = bon; \
            f32x4 v4 = WKV_UNPK(lv); if (has_vres) { const f32x4 g4 = WKV_UNPK(lg); _Pragma("unroll") for (int i_ = 0; i_ < 4; ++i_) v4[i_] = v4[i_] + (lf[i_] - v4[i_]) / (1.f + __expf(-(v0v[i_] + g4[i_]))); } \
            *(LAS f32x4*)((bufp) + lv_) = v4; const int tv_ = (tb0) + ((tid & 255) >> 3); if (tid < 256 && tv_ < Tu) *(GAS f32x4*)(VFO + ev_ + (size_t)(tb0) * 1024) = v4; } while (0)
        WKV_LOAD(0); WKV_STORE(lds, 0); __syncthreads();
        for (int b = 0; b < nblk; ++b) {
            LAS unsigned char* cur = lds + (b & 1) * BUF; LAS unsigned char* nxt = lds + ((b + 1) & 1) * BUF; const int tb0 = b * TB; const int nt = (Tu - tb0) < TB ? (Tu - tb0) : TB;
            if (b + 1 < nblk) WKV_LOAD(tb0 + TB);
            const LAS float* vec = (const LAS float*)cur + part * 4; const LAS float* vv = (const LAS float*)(cur + VECB) + rowl; LAS float* yb = (LAS float*)(cur + VECB + VVB);
            float ykeep0 = 0.f, ykeep1 = 0.f;
            struct StepV { f32x2 w01, w23, n01, n23, b01, b23, k01, k23, r01, r23; float v; };
#define WKV_RD(dst, t) do { const LAS f32x2* vp_ = (const LAS f32x2*)(vec + (t) * 320); dst.w01 = vp_[0]; dst.w23 = vp_[1]; dst.n01 = vp_[32]; dst.n23 = vp_[33]; dst.b01 = vp_[64]; dst.b23 = vp_[65]; \
                dst.k01 = vp_[96]; dst.k23 = vp_[97]; dst.r01 = vp_[128]; dst.r23 = vp_[129]; dst.v = vv[(t) * 32]; } while (0)
#define WKV_CMP(src, keep, tl) do { const f32x2 sp = __builtin_elementwise_fma(S23, src.n23, S01 * src.n01); const float sa = row_sum16(sp.x + sp.y); const f32x2 sa2 = (f32x2){sa, sa}, v2 = (f32x2){src.v, src.v}; \
                S01 = __builtin_elementwise_fma(S01, src.w01, __builtin_elementwise_fma(src.b01, sa2, src.k01 * v2)); S23 = __builtin_elementwise_fma(S23, src.w23, __builtin_elementwise_fma(src.b23, sa2, src.k23 * v2)); \
                const f32x2 yp = __builtin_elementwise_fma(S23, src.r23, S01 * src.r01); const float y = row_sum16(yp.x + yp.y); keep = (part == (tl)) ? y : keep; } while (0)
            if (nt == TB) {
                StepV sA, sB; WKV_RD(sA, 0);
#pragma unroll 1
                for (int t = 0; t < 16; t += 2) { WKV_RD(sB, t + 1); __builtin_amdgcn_sched_barrier(0); WKV_CMP(sA, ykeep0, t); WKV_RD(sA, t + 2); __builtin_amdgcn_sched_barrier(0); WKV_CMP(sB, ykeep0, t + 1); }
#pragma unroll 1
                for (int t = 16; t < 32; t += 2) { WKV_RD(sB, t + 1); __builtin_amdgcn_sched_barrier(0); WKV_CMP(sA, ykeep1, t - 16); WKV_RD(sA, (t + 2) & 31); __builtin_amdgcn_sched_barrier(0); WKV_CMP(sB, ykeep1, t - 15); }
            } else { StepV sA; for (int t = 0; t < nt; ++t) { WKV_RD(sA, t); if (t < 16) WKV_CMP(sA, ykeep0, t); else WKV_CMP(sA, ykeep1, t - 16); } }
#undef WKV_RD
#undef WKV_CMP
            yb[part * 32 + rowl] = ykeep0; yb[(16 + part) * 32 + rowl] = ykeep1;
            if (b + 1 < nblk) WKV_STORE(nxt, tb0 + TB);
            __syncthreads();
            { const int rl = tid & 31; _Pragma("unroll") for (int t = tid >> 5; t < TB; t += 16) if (t < nt) Y[(size_t)(r0 + tb0 + t) * 1024 + h * 64 + half * 32 + rl] = yb[t * 32 + rl]; }
        }
#undef WKV_LOAD
#undef WKV_STORE
#undef WKV_UNPK
        *(GAS f32x4*)((smp ? SOUT : P) + ((size_t)pair * 64 + vrow) * 64 + part * 4) = (f32x4){S01.x, S01.y, S23.x, S23.y};
        __syncthreads();
    }
}

__device__ __forceinline__ void gla_phase(const GAS float* __restrict__ PROJ, const GAS float* __restrict__ LOGA, GAS float* __restrict__ O, GAS float* __restrict__ P, int B, int T, LAS unsigned char* lds, int tid, int bid, int nb) {
    constexpr int TB = 32, NLD = 4, VECB = TB * 768, VVB = TB * 64, BUF = VECB + 3 * VVB;
    const int col = tid >> 5, half = (tid >> 4) & 1, p = tid & 15, dk = half * 32 + p * 2;
    const int nunits = B * 32;
    for (int u = bid; u < nunits; u += nb) {
        const int ug_ = ((u & 7) << 3 | ((u >> 3) & 7)) + ((u >> 6) << 6);
        const int cb = ug_ & 7, pair = ug_ >> 3, s = pair >> 2, h = pair & 3; const int r0 = s * T;
        float S0 = 0.f, S1 = 0.f;
        const int nblk = (T + TB - 1) / TB;
        f32x4 ld[NLD];
        const size_t ea_ = (size_t)(r0 + (tid >> 4)) * 256 + h * 64 + (tid & 15) * 4, ep_ = (size_t)(r0 + (tid >> 4)) * 2576 + h * 64 + (tid & 15) * 4, ev_ = (size_t)(r0 + ((tid & 127) >> 2)) * 2576 + 512 + h * 128 + cb * 16 + (tid & 3) * 4;
        const int lo_ = ((tid >> 4) * 192 + (tid & 15) * 4) * 4, lv_ = VECB + (tid & 127) * 16;
#define GLA_LOAD(tb0) do { ld[0] = *(const GAS f32x4*)(LOGA + ea_ + (size_t)(tb0) * 256); ld[1] = *(const GAS f32x4*)(PROJ + ep_ + 256 + (size_t)(tb0) * 2576); ld[2] = *(const GAS f32x4*)(PROJ + ep_ + (size_t)(tb0) * 2576); ld[3] = *(const GAS f32x4*)(PROJ + ev_ + (size_t)(tb0) * 2576); } while (0)
#define GLA_STORE(bufp) do { *(LAS f32x4*)((bufp) + lo_) = ld[0]; *(LAS f32x4*)((bufp) + lo_ + 256) = ld[1]; *(LAS f32x4*)((bufp) + lo_ + 512) = ld[2] * 0.125f; *(LAS f32x4*)((bufp) + lv_) = ld[3]; } while (0)
        GLA_LOAD(0); GLA_STORE(lds); __syncthreads();
        for (int b = 0; b < nblk; ++b) {
            LAS unsigned char* cur = lds + (b & 1) * BUF; LAS unsigned char* nxt = lds + ((b + 1) & 1) * BUF; const int tb0 = b * TB; const int nt = (T - tb0) < TB ? (T - tb0) : TB;
            if (b + 1 < nblk) GLA_LOAD(tb0 + TB);
            const LAS float* vec = (const LAS float*)cur + dk; const LAS float* vv = (const LAS float*)(cur + VECB) + col; LAS float* ob = (LAS float*)(cur + VECB + VVB);
            float okeep0 = 0.f, okeep1 = 0.f;
#define GLA_STEP(t, keep, tl) do { const f32x2 a2 = *(const LAS f32x2*)(vec + (t) * 192), k2 = *(const LAS f32x2*)(vec + (t) * 192 + 64), q2 = *(const LAS f32x2*)(vec + (t) * 192 + 128); const float v = vv[(t) * 16]; \
                S0 = fmaf(a2.x, S0, k2.x * v); S1 = fmaf(a2.y, S1, k2.y * v); \
                float o = fmaf(q2.x, S0, q2.y * S1); o = row_sum16(o); keep = (p == (tl)) ? o : keep; } while (0)
            if (nt == TB) {
#pragma unroll 1
                for (int t = 0; t < 16; t += 4) { GLA_STEP(t, okeep0, t); GLA_STEP(t + 1, okeep0, t + 1); GLA_STEP(t + 2, okeep0, t + 2); GLA_STEP(t + 3, okeep0, t + 3); }
#pragma unroll 1
                for (int t = 16; t < 32; t += 4) { GLA_STEP(t, okeep1, t - 16); GLA_STEP(t + 1, okeep1, t - 15); GLA_STEP(t + 2, okeep1, t - 14); GLA_STEP(t + 3, okeep1, t - 13); }
            } else { for (int t = 0; t < nt; ++t) { if (t < 16) GLA_STEP(t, okeep0, t); else GLA_STEP(t, okeep1, t - 16); } }
#undef GLA_STEP
            ob[(p * 16 + col) * 2 + half] = okeep0; ob[((16 + p) * 16 + col) * 2 + half] = okeep1;
            if (b + 1 < nblk) GLA_STORE(nxt);
            __syncthreads();
            { const int t = tid >> 4, c = tid & 15; if (t < nt) { const f32x2 o2 = *(const LAS f32x2*)(ob + (t * 16 + c) * 2); O[(size_t)(r0 + tb0 + t) * 512 + h * 128 + cb * 16 + c] = o2.x + o2.y; } }
        }
#undef GLA_LOAD
#undef GLA_STORE
        { GAS float* so = P + ((size_t)pair * 64 + dk) * 128 + cb * 16 + col; so[0] = S0; so[128] = S1; }
        __syncthreads();
    }
}
__device__ __forceinline__ float grp8_sum(float v) { v += dppf<0xB1>(v); v += dppf<0x4E>(v); v += dppf<0x141>(v); return v; }
__device__ __forceinline__ float dot16_fp8_bf16(const u32x4 uw, const float (&x)[16]) { float s = 0.f;
#pragma unroll
    for (int d = 0; d < 4; ++d) { const f32x2 lo = fp8lo(uw[d]), hi = fp8hi(uw[d]); s = fmaf(lo.x, x[4 * d], s); s = fmaf(lo.y, x[4 * d + 1], s); s = fmaf(hi.x, x[4 * d + 2], s); s = fmaf(hi.y, x[4 * d + 3], s); }
    return s; }
__device__ __forceinline__ void pacts_phase(const GAS bf16_t* __restrict__ XB, const GAS unsigned char* U8S, const GAS int* __restrict__ EIDX, GAS float* __restrict__ PART, int M,
                                            int wid, int lane, int bid, int nb) {
    const bool spl = (nb & 7) == 0; const int s0 = spl ? (bid & 7) : 0, s1 = spl ? s0 + 1 : 8, r = spl ? (bid >> 3) : bid, nr = spl ? (nb >> 3) : nb;
    const int g = lane >> 3, ch = lane & 7, h = wid;
    constexpr int NB = 4;
    const int bstep = nr * NB;
#define PA_IDS(row0_, e0_, e1_) do { _Pragma("unroll") for (int q = 0; q < NB; ++q) { int row = (row0_) + nr * q; row = row < M ? row : r; e0_[q] = EIDX[((size_t)row * 8 + h) * 16 + g]; e1_[q] = EIDX[((size_t)row * 8 + h) * 16 + 8 + g]; } } while (0)
#define PA_GATHER(row0_, e0_, e1_, u0_, u1_, xa_, xb_) do { _Pragma("unroll") for (int q = 0; q < NB; ++q) { int row = (row0_) + nr * q; row = row < M ? row : r; u0_[q] = *(const GAS u32x4*)(tb + (size_t)(e0_[q] & 16383) * 128); u1_[q] = *(const GAS u32x4*)(tb + (size_t)(e1_[q] & 16383) * 128); \
        const GAS u32x4* xp = (const GAS u32x4*)(XB + (size_t)row * 1024 + s * 128 + ch * 16); xa_[q] = xp[0]; xb_[q] = xp[1]; } } while (0)
#define PA_COMP(row0_, u0_, u1_, xa_, xb_) do { _Pragma("unroll") for (int q = 0; q < NB; ++q) { const int row = (row0_) + nr * q; float x[16]; \
        _Pragma("unroll") for (int i = 0; i < 4; ++i) { x[2 * i] = bflo(xa_[q][i]); x[2 * i + 1] = bfhi(xa_[q][i]); x[8 + 2 * i] = bflo(xb_[q][i]); x[8 + 2 * i + 1] = bfhi(xb_[q][i]); } \
        float p0 = dot16_fp8_bf16(u0_[q], x), p1 = dot16_fp8_bf16(u1_[q], x); p0 = grp8_sum(p0); p1 = grp8_sum(p1); asm volatile("" : "+v"(p0), "+v"(p1)); \
        if (ch == 0 && row < M) { GAS float* d = po + ((size_t)row * 8 + h) * 16 + g; d[0] = p0; d[8] = p1; } } } while (0)
    for (int s = s0; s < s1; ++s) {
        const GAS unsigned char* tb = U8S + (size_t)s * 16384 * 128 + ch * 16; GAS float* po = PART + (size_t)s * M * 128;
        int ea0[NB], ea1[NB], eb0[NB], eb1[NB]; u32x4 ua0[NB], ua1[NB], xaa[NB], xab[NB], ub0[NB], ub1[NB], xba[NB], xbb[NB];
        PA_IDS(r, ea0, ea1); PA_GATHER(r, ea0, ea1, ua0, ua1, xaa, xab); PA_IDS(r + bstep, eb0, eb1);
        for (int row0 = r; row0 < M; row0 += 2 * bstep) {
            PA_GATHER(row0 + bstep, eb0, eb1, ub0, ub1, xba, xbb); PA_IDS(row0 + 2 * bstep, ea0, ea1);
            asm volatile("" ::: "memory");
            PA_COMP(row0, ua0, ua1, xaa, xab);
            if (row0 + bstep >= M) break;
            PA_GATHER(row0 + 2 * bstep, ea0, ea1, ua0, ua1, xaa, xab); PA_IDS(row0 + 3 * bstep, eb0, eb1);
            asm volatile("" ::: "memory");
            PA_COMP(row0 + bstep, ub0, ub1, xba, xbb);
        }
    }
#undef PA_IDS
#undef PA_GATHER
#undef PA_COMP
}
__device__ __forceinline__ void pouts_phase(const GAS float* __restrict__ COEF, const GAS int* __restrict__ EIDX, const GAS unsigned char* V8S, GAS bf16_t* __restrict__ YBUF, int M,
                                            int wid, int lane, int bid, int nb) {
    const bool spl = (nb & 7) == 0; const int s0 = spl ? (bid & 7) : 0, s1 = spl ? s0 + 1 : 8, r = spl ? (bid >> 3) : bid, nr = spl ? (nb >> 3) : nb;
    const int g = lane >> 3, ch = lane & 7, rstep = nr * 8;
#define PO_LOADCE(rw, c0, c1, v0, v1) do { c0 = COEF[(size_t)(rw) * 128 + lane] * (1.f / 64.f); c1 = COEF[(size_t)(rw) * 128 + 64 + lane] * (1.f / 64.f); v0 = EIDX[(size_t)(rw) * 128 + lane]; v1 = EIDX[(size_t)(rw) * 128 + 64 + lane]; } while (0)
#define PO_GATHER(vv_, vreg) do { _Pragma("unroll") for (int k = 0; k < 8; ++k) { const int e = __builtin_amdgcn_ds_bpermute((8 * k + g) << 2, vreg); vv_[k] = *(const GAS u32x4*)(tb + (size_t)(e & 16383) * 128); } } while (0)
#define PO_COMP(vv_, creg) do { _Pragma("unroll") for (int k = 0; k < 8; ++k) { const float c = __int_as_float(__builtin_amdgcn_ds_bpermute((8 * k + g) << 2, __float_as_int(creg))); const u32x4 w = vv_[k]; \
        _Pragma("unroll") for (int d = 0; d < 4; ++d) { const f32x2 lo = fp8lo(w[d]), hi = fp8hi(w[d]); acc[4 * d] = fmaf(c, lo.x, acc[4 * d]); acc[4 * d + 1] = fmaf(c, lo.y, acc[4 * d + 1]); acc[4 * d + 2] = fmaf(c, hi.x, acc[4 * d + 2]); acc[4 * d + 3] = fmaf(c, hi.y, acc[4 * d + 3]); } \
        _Pragma("unroll") for (int i = 0; i < 16; ++i) asm volatile("" : "+v"(acc[i])); } } while (0)
    for (int s = s0; s < s1; ++s) {
        const GAS unsigned char* tb = V8S + (size_t)s * 16384 * 128 + ch * 16;
        int row = r + nr * wid; if (row >= M) continue;
        float c0c, c1c, c0n = 0.f, c1n = 0.f; int v0c, v1c, v0n = 0, v1n = 0;
        PO_LOADCE(row, c0c, c1c, v0c, v1c);
        u32x4 va[8], vb[8];
        PO_GATHER(va, v0c);
        for (;;) {
            const int rown = row + rstep; const bool hasn = rown < M;
            PO_GATHER(vb, v1c);
            if (hasn) PO_LOADCE(rown, c0n, c1n, v0n, v1n);
            float acc[16];
#pragma unroll
            for (int i = 0; i < 16; ++i) acc[i] = 0.f;
            PO_COMP(va, c0c);
            if (hasn) PO_GATHER(va, v0n);
            PO_COMP(vb, c1c);
#pragma unroll
            for (int i = 0; i < 16; ++i) acc[i] += dppf<0x128>(acc[i]);
#pragma unroll
            for (int i = 0; i < 8; ++i) { const bool hi = lane & 16; const float send = hi ? acc[i] : acc[i + 8], keep = hi ? acc[i + 8] : acc[i]; acc[i] = keep + shx(send, 16, lane); }
#pragma unroll
            for (int i = 0; i < 4; ++i) { const bool hi = lane & 32; const float send = hi ? acc[i] : acc[i + 4], keep = hi ? acc[i + 4] : acc[i]; acc[i] = keep + shx(send, 32, lane); }
            if ((lane & 8) == 0) { u32x2 w_; w_.x = pk_bf16(acc[0], acc[1]); w_.y = pk_bf16(acc[2], acc[3]); *(GAS u32x2*)(YBUF + (size_t)row * 1024 + s * 128 + ch * 16 + ((lane >> 4) & 1) * 8 + ((lane >> 5) & 1) * 4) = w_; }
            if (!hasn) break;
            row = rown; c0c = c0n; c1c = c1n; v0c = v0n; v1c = v1n;
        }
    }
#undef PO_LOADCE
#undef PO_GATHER
#undef PO_COMP
}
}

template <class T> __device__ __forceinline__ __attribute__((address_space(1))) T* gp(T* p) { return (__attribute__((address_space(1))) T*)uni_ptr(p); }
constexpr int MK_THREADS = 512, LDS_BYTES = 163840, LDSCTL_OFF = 131072, TAB_OFF = LDSCTL_OFF + 1024, MAX_OPS = 208;
static_assert(TAB_OFF + MAX_OPS * (int)sizeof(Op) <= LDS_BYTES, "LDS map");
constexpr int MPAD = 17152;
constexpr size_t CTL_BYTES = (size_t)1 << 20;
struct MArgs { const float* in[47]; float* out; char* ws; unsigned long long ws_size; };
__global__ void __launch_bounds__(MK_THREADS, 2) mega_fwd(MArgs a) {
    extern __shared__ __attribute__((aligned(16))) unsigned char lds[];
    volatile LAS unsigned* ctl = (volatile LAS unsigned*)((LAS unsigned char*)lds + LDSCTL_OFF);
    if (threadIdx.x < 64) ctl[threadIdx.x] = 0u;
    __syncthreads();
    (void)xcd_barrier_post((unsigned*)a.ws, ctl + 8);
    const Dm dm = make_dm(1024, 8, 2048, 128, 4);
    Op* tab = (Op*)(lds + TAB_OFF);
    if (threadIdx.x == 0) {
        const float* const* inp_ = (const float* const*)__builtin_amdgcn_kernarg_segment_ptr(); asm volatile("" : "+s"(inp_));
        NvIO io; io.in = inp_; io.out = a.out; io.ws = a.ws + CTL_BYTES; io.ws_size = a.ws_size - CTL_BYTES;
        int n = 0;
        nv_forward(io, dm, [&](const Op& o) __attribute__((always_inline)) { if (n < MAX_OPS) tab[n] = o; ++n; asm volatile("" ::: "memory"); });
        ctl[16] = (unsigned)(n <= MAX_OPS ? n : 0);
    }
    __syncthreads();
    const int nops = (int)ctl[16];
    for (int i = 0; i < nops; ++i) {
        int tid_ = (int)threadIdx.x, bid_ = (int)blockIdx.x, nb_ = (int)gridDim.x;
        asm volatile("" : "+v"(tid_)); asm volatile("" : "+s"(bid_)); asm volatile("" : "+s"(nb_));
        const long long g0 = (long long)bid_ * MK_THREADS + tid_, gs = (long long)nb_ * MK_THREADS;
        const Op& o = tab[i];
        const int rawc = __builtin_amdgcn_readfirstlane(o.code); const int code = rawc & 0xff; const long long n = o.n;
        switch (code) {
        case OP_FGEMM: {
            const int fl = rfl(o.i6);
            pg8::Gemm g{uni_ptr((const pg8::bf16_t*)o.a), uni_ptr((const pg8::bf16_t*)o.b), MPAD, rfl(o.i5), rfl(o.i1), rfl(o.i2), rfl(o.i3)};
            if (rawc & OPF_GROUP) {
                int ng = 1; while (ng < 8 && (rfl(tab[i + ng - 1].code) & OPF_GROUP)) ++ng;
                const PG8_LAS Op* gt = (const PG8_LAS Op*)((PG8_LAS unsigned char*)lds + TAB_OFF) + i;
                pg8::GroupOrder S; S.tab = gt; S.ng = ng; S.nM = MPAD / 256; S.G = nb_; S.c = bid_; S.tsA = (size_t)256 * g.lda * 2; S.tsB = (size_t)256 * g.ldb * 2;
                pg8::EpiGroup E{gt, dm.M};
                pg8::gemm_phase<pg8::EpiGroup, pg8::GroupOrder, true, true>((PG8_LAS unsigned char*)lds, g, S, E);
                i += ng - 1;
            } else {
            pg8::StaticOrder S; S.init(g, nb_, bid_); if (fl & 2) S.acs = 512;
            if (fl & 1) { pg8::EpiBf16Plain E{uni_ptr((pg8::bf16_t*)o.o0), rfl(o.i4)}; pg8::gemm_phase<pg8::EpiBf16Plain, pg8::StaticOrder, true, true>((PG8_LAS unsigned char*)lds, g, S, E); }
            else { pg8::EpiF32 E{uni_ptr(o.o0), rfl(o.i4), dm.M, rfl(o.i0)}; pg8::gemm_phase<pg8::EpiF32, pg8::StaticOrder, true, true>((PG8_LAS unsigned char*)lds, g, S, E); }
            }
        } break;
        case OP_LRUG2: {
            pg8::Gemm g{uni_ptr((const pg8::bf16_t*)o.a), uni_ptr((const pg8::bf16_t*)o.b), MPAD, 1024, 512, 512, 512};
            pg8::StaticOrder S; S.init(g, nb_, bid_);
            pg8::EpiLru E{uni_ptr(o.c), uni_ptr(o.d), uni_ptr(o.e), uni_ptr(o.f), uni_ptr(o.o0), uni_ptr(o.o1), dm.M};
            pg8::gemm_phase<pg8::EpiLru, pg8::StaticOrder, true, true>((PG8_LAS unsigned char*)lds, g, S, E);
        } break;
        case OP_WKVP: fk::wkv2_phase(gp((const fk::bf16_t*)o.a), gp((const fk::bf16_t*)o.b), gp((const fk::bf16_t*)o.c), gp((const fk::bf16_t*)o.d), gp((const fk::bf16_t*)o.e), gp((const fk::bf16_t*)o.f), gp(o.g), gp(o.h), gp((const float*)o.o5), gp(o.o0), gp(o.o1), gp(o.o2), gp(o.o3), gp(o.o4), rfl(o.i0), dm.B, dm.T, dm.DB, dm.DT, (LAS unsigned char*)lds, tid_, bid_, nb_); break;
        case OP_POST2: fk::rwkvpost2_phase(gp(o.a), gp((const fk::bf16_t*)o.b), gp(o.c), gp(o.d), gp(o.e), gp(o.f), gp((fk::bf16_t*)o.o0), dm.M * 16, tid_ & 63, bid_ * 8 + (tid_ >> 6), nb_ * 8); break;
        case OP_GLAF: fk::gla_phase(gp(o.a), gp(o.b), gp(o.o0), gp(o.o1), dm.B, dm.T, (LAS unsigned char*)lds, tid_, bid_, nb_); break;
        case OP_PACTS: fk::pacts_phase(gp((const fk::bf16_t*)o.a), gp((const unsigned char*)o.b), gp((const int*)o.d), gp(o.o0), dm.M, tid_ >> 6, tid_ & 63, bid_, nb_); break;
        case OP_POUTS: fk::pouts_phase(gp(o.a), gp((const int*)o.b), gp((const unsigned char*)o.c), gp((fk::bf16_t*)o.o0), dm.M, tid_ >> 6, tid_ & 63, bid_, nb_); break;
        case OP_TOPK2: fk::topk_phase(gp(o.a), gp((const fk::bf16_t*)o.b), gp(o.c), gp(o.o0), gp((int*)o.o1), dm.M * 8, (LAS unsigned char*)lds, tid_ >> 6, tid_ & 63, bid_ * 8 + (tid_ >> 6), nb_ * 8); break;
        case OP_LNRES: fk::lnres_phase(gp((const fk::bf16_t*)o.a), gp(o.b), gp(o.c), gp(o.o0), gp((fk::bf16_t*)o.o1), dm.M, tid_ & 63, bid_ * 8 + (tid_ >> 6), nb_ * 8); break;
        case OP_GLANORM: fk::glanorm_phase(gp(o.a), gp(o.b), gp(o.c), gp((fk::bf16_t*)o.o0), dm.M * 4, tid_ & 63, bid_ * 8 + (tid_ >> 6), nb_ * 8); break;
#define NVC(c) case c: for (long long g = g0; g < n; g += gs) nv_elem(c, o, dm, g); break;
        NVC(OP_LOGA4) NVC(OP_CONVOUT) NVC(OP_SHIFTOUT) NVC(OP_EMBED4) NVC(OP_YOUT4) NVC(OP_MIX6) NVC(OP_CONV4) NVC(OP_CVT8) NVC(OP_WGATE)
        NVC(OP_WT) NVC(OP_CVTTAB8S) NVC(OP_PRED) NVC(OP_PRM) NVC(OP_KEYS) NVC(OP_GLA3) NVC(OP_LRU1) NVC(OP_LRU2) NVC(OP_LRU3)
#undef NVC
        default: break;
        }
        if (__builtin_amdgcn_readfirstlane(tab[i].code) & OPF_NOBAR) __syncthreads(); else { XcdBarrier bar; bar.bar = (unsigned*)a.ws; bar.x = xb_xcc_id(); bar.st = ctl + 8; xcd_barrier(bar); }
    }
}
extern "C" void kernel_launch(void* const* d_in, const int* in_sizes, int n_in, void* d_out, int out_size, void* d_ws, size_t ws_size, hipStream_t stream) {
    static int grid = 0;
    if (grid == 0) {
        if (n_in != 47 || ws_size < ((size_t)900 << 20)) { fprintf(stderr, "kernel_launch: expected 47 inputs and >= 900 MiB of workspace; got %d, %zu\n", n_in, ws_size); grid = -1; return; }
        int dev = 0, cus = 0, per_cu = 0;
        if (hipGetDevice(&dev) != hipSuccess || hipDeviceGetAttribute(&cus, hipDeviceAttributeMultiprocessorCount, dev) != hipSuccess) { grid = -1; return; }
        if (hipFuncSetAttribute((const void*)mega_fwd, hipFuncAttributeMaxDynamicSharedMemorySize, LDS_BYTES) != hipSuccess) { fprintf(stderr, "kernel_launch: hipFuncSetAttribute failed\n"); grid = -1; return; }
        if (hipOccupancyMaxActiveBlocksPerMultiprocessor(&per_cu, (const void*)mega_fwd, MK_THREADS, LDS_BYTES) != hipSuccess || per_cu < 1) fprintf(stderr, "kernel_launch: occupancy query says %d per CU\n", per_cu);
        (void)hipGetLastError();
        grid = cus;
    }
    if (grid < 0) return;
    if (hipMemsetAsync(d_ws, 0, CTL_BYTES, stream) != hipSuccess) { fprintf(stderr, "kernel_launch: memset failed\n"); return; }
    MArgs a{}; for (int i = 0; i < 47; ++i) a.in[i] = (const float*)d_in[i]; a.out = (float*)d_out; a.ws = (char*)d_ws; a.ws_size = (unsigned long long)ws_size;
    hipLaunchKernelGGL(mega_fwd, dim3(grid), dim3(MK_THREADS), LDS_BYTES, stream, a);
}
```

```cpp
#include <hip/hip_runtime.h>
#include <cstdio>
#include <cmath>
#ifndef HD
#define HD __host__ __device__ __forceinline__
#endif
struct Dm { int D, B, T, DB, DT, M, NSEQ, RH; };
HD Dm make_dm(int D, int B, int SEQ, int DB, int DT) { Dm d; d.D = D; d.B = B; d.T = SEQ + 16; d.DB = DB; d.DT = DT; d.M = B * d.T + DB * DT; d.NSEQ = B + DB; d.RH = D / 64; return d; }
HD int seq_row0(const Dm& d, int s) { return s < d.B ? s * d.T : d.B * d.T + (s - d.B) * d.DT; }
HD int seq_len(const Dm& d, int s) { return s < d.B ? d.T : d.DT; }
HD void row_to_seq(const Dm& d, int row, int& s, int& t) { if (row < d.B * d.T) { s = row / d.T; t = row % d.T; } else { int r = row - d.B * d.T; s = d.B + r / d.DT; t = r % d.DT; } }

constexpr int MIXIN = 2576, C_Q = 0, C_K = 256, C_V = 512, C_GLR = 1024, C_R = 1040, C_XB = 1552, C_GB = 2064;

enum { OP_EMBED = 1, OP_GEMM, OP_LOGA, OP_GLA, OP_GLANORM, OP_CONV, OP_CONVOUT, OP_LRUG, OP_LRUSCAN, OP_LNRES, OP_MIX, OP_SHIFTOUT,
       OP_RWKVPREP, OP_WKV, OP_RWKVPOST, OP_QNORM, OP_SCORES, OP_TOPK, OP_PACT1, OP_PACT2, OP_POUT, OP_YOUT, OP_WT, OP_CVT, OP_FGEMM, OP_CVTTAB, OP_KEYS, OP_TOPK2, OP_PACT, OP_POUTLN, OP_GLA1, OP_GLA2, OP_GLA3, OP_LRU1, OP_LRU2, OP_LRU3, OP_EMBED4, OP_YOUT4, OP_MIX8, OP_CONV4, OP_CVT8, OP_WGATE, OP_LRUG2, OP_WKVF, OP_GLAF, OP_CVTTAB8, OP_CVTTAB8S, OP_PACTS, OP_PRED, OP_POUTS, OP_MIX6, OP_PRM, OP_WKVP, OP_POST2, OP_LOGA4 };

constexpr int OPF_NOBAR = 0x100, OPF_GROUP = 0x200;
struct Op {
    const float *a, *b, *c, *d, *e, *f, *g, *h;
    float *o0, *o1, *o2, *o3, *o4, *o5;
    long long n;
    int code, i0, i1, i2, i3, i4, i5, i6;
};

#if defined(__HIP_DEVICE_COMPILE__)
#define NV_UNI(x) __builtin_amdgcn_readfirstlane(x)
#define NV_LAUNDER(p) asm volatile("" : "+s"(p))
#define NV_FENCE() asm volatile("" ::: "memory")
#else
#define NV_FENCE() do {} while (0)
#define NV_UNI(x) (x)
#define NV_LAUNDER(p) do {} while (0)
#endif
typedef unsigned short nvbf;
HD nvbf nv_f2bf(float f) { unsigned u; __builtin_memcpy(&u, &f, 4); return (nvbf)((u + 0x7fffu + ((u >> 16) & 1u)) >> 16); }
HD float nv_bf2f(nvbf h) { unsigned u = (unsigned)h << 16; float f; __builtin_memcpy(&f, &u, 4); return f; }
HD unsigned nv_f2e4m3(float f) {
    unsigned u; __builtin_memcpy(&u, &f, 4); const unsigned sign = (u >> 24) & 0x80u; const float a = fabsf(f);
    if (!(a < 448.f)) return sign | 0x7Eu;
    if (a < 0.015625f) return sign | (unsigned)rintf(a * 512.f);
    unsigned au = u & 0x7fffffffu; au += 0x7ffffu + ((au >> 20) & 1u);
    const unsigned e = ((au >> 23) & 0xffu) - 120u, m = (au >> 20) & 7u; unsigned code = (e << 3) | m; if (code > 0x7Eu) code = 0x7Eu;
    return sign | code; }
HD float nv_e4m32f(unsigned c) { const unsigned e = (c >> 3) & 15u, m = c & 7u; const float v = e ? ldexpf(1.f + m * 0.125f, (int)e - 7) : m * 0.001953125f; return (c & 0x80u) ? -v : v; }
HD int nv_rup(int x, int m) { return (x + m - 1) / m * m; }
struct alignas(16) NvF4 { float x, y, z, w; };
struct alignas(16) NvU4 { unsigned x, y, z, w; };
struct alignas(8) NvU2 { unsigned x, y; };
HD float nv_sigmoid(float x) { return 1.f / (1.f + expf(-x)); }
HD float nv_softplus(float x) { return fmaxf(x, 0.f) + log1pf(expf(-fabsf(x))); }
HD float nv_gelu(float x) { return 0.5f * x * (1.f + tanhf(0.7978845608028654f * (x + 0.044715f * x * x * x))); }

#define NV_INS16(tv, ti, val, idx) do { float _v = (val); int _i = (idx); _Pragma("unroll") for (int _j = 0; _j < 16; ++_j) { if (_v > tv[_j]) { float _tv = tv[_j]; int _ti = ti[_j]; tv[_j] = _v; ti[_j] = _i; _v = _tv; _i = _ti; } } } while (0)

HD void nv_elem(const int code, const Op& p, const Dm& dm, long long gid) {
    const int D = dm.D; float* const PO1 = p.o1; float* const PO2 = p.o2;
    switch (code) {
    case OP_EMBED: {
        int row = (int)(gid / D), c = (int)(gid % D); float v;
        if (row < dm.B * dm.T) { int bb = row / dm.T, t = row % dm.T; v = t < 16 ? p.c[t * D + c] : p.a[((size_t)bb * (dm.T - 16) + (t - 16)) * D + c]; }
        else v = p.b[(size_t)(row - dm.B * dm.T) * D + c];
        p.o0[gid] = v; ((nvbf*)p.o1)[gid] = nv_f2bf(v); } break;
    case OP_GEMM: {
        int N4 = p.i0 >> 2, K = p.i1; int m = (int)(gid / N4), nn = (int)(gid % N4) * 4; const float* A = p.a + (size_t)m * p.i2; const float* Bw = p.b + nn; float c0 = 0.f, c1 = 0.f, c2 = 0.f, c3 = 0.f;
        for (int k = 0; k < K; ++k) { float av = A[k]; if (p.i5 == 1) av = tanhf(av); else if (p.i5 == 2) av = nv_sigmoid(av); const NvF4 bv = *(const NvF4*)(Bw + (size_t)k * p.i3);
            c0 = fmaf(av, bv.x, c0); c1 = fmaf(av, bv.y, c1); c2 = fmaf(av, bv.z, c2); c3 = fmaf(av, bv.w, c3); }
        float* C = p.o0 + (size_t)m * p.i4 + nn; C[0] = c0; C[1] = c1; C[2] = c2; C[3] = c3; } break;
    case OP_LOGA: {
        int row = (int)(gid / 256), c = (int)(gid % 256); float z = p.c[c];
        for (int r = 0; r < 16; ++r) z = fmaf(p.a[(size_t)row * MIXIN + C_GLR + r], p.b[r * 256 + c], z);
        p.o0[gid] = expf(-nv_softplus(-z) * (1.f / 16.f)); } break;
    case OP_GLAF:
    case OP_GLA: {
        int s = (int)(gid / 512), h = (int)((gid / 128) % 4), col = (int)(gid % 128);
        float S[64];
        const float* sin = (s < dm.B) ? nullptr : p.c + (((size_t)(s - dm.B) * 4 + h) * 64) * 128 + col;
#pragma unroll
        for (int k = 0; k < 64; ++k) S[k] = sin ? sin[(size_t)k * 128] : 0.f;
        int r0 = seq_row0(dm, s), L = seq_len(dm, s);
        for (int t = 0; t < L; ++t) {
            const float* pr = p.a + (size_t)(r0 + t) * MIXIN; const float* la = p.b + (size_t)(r0 + t) * 256 + h * 64;
            float v = pr[C_V + h * 128 + col], o = 0.f;
#pragma unroll
            for (int k = 0; k < 64; ++k) { if ((k & 7) == 0) NV_FENCE(); S[k] = fmaf(la[k], S[k], pr[C_K + h * 64 + k] * v); o = fmaf(pr[C_Q + h * 64 + k] * 0.125f, S[k], o); }
            p.o0[(size_t)(r0 + t) * 512 + h * 128 + col] = o;
        }
        float* so = (s < dm.B) ? PO1 + (((size_t)s * 4 + h) * 64) * 128 + col : PO2 + (((size_t)(s - dm.B) * 4 + h) * 64) * 128 + col;
#pragma unroll
        for (int k = 0; k < 64; ++k) so[(size_t)k * 128] = S[k]; } break;
    case OP_GLA1: {
        const int NC = p.i0; const int u = NV_UNI((int)(gid / 128)), col = (int)(gid % 128); const int s = u / (4 * NC), h = (u / NC) % 4, c = u % NC;
        const int r0 = seq_row0(dm, s) + c * 64; int L = dm.T - c * 64; L = L > 64 ? 64 : L;
        float S[64];
#pragma unroll
        for (int k = 0; k < 64; ++k) S[k] = 0.f;
        float dprod = 1.f;
        for (int t = 0; t < L; ++t) {
            const float* pr = p.a + (size_t)(r0 + t) * MIXIN; const float* la = p.b + (size_t)(r0 + t) * 256 + h * 64; const float v = pr[C_V + h * 128 + col];
            if (col < 64) dprod *= la[col];
#pragma unroll
            for (int k = 0; k < 64; ++k) { if ((k & 7) == 0) NV_FENCE(); S[k] = fmaf(la[k], S[k], pr[C_K + h * 64 + k] * v); }
        }
        float* so = p.o0 + (size_t)u * 8192 + col;
#pragma unroll
        for (int k = 0; k < 64; ++k) so[(size_t)k * 128] = S[k];
        if (col < 64) p.o1[(size_t)u * 64 + col] = dprod; } break;
    case OP_GLA2: {
        const int NC = p.i0; const int pair = (int)(gid / 8192), e = (int)(gid % 8192), dk = e / 128; float S = 0.f;
        for (int c = 0; c < NC; ++c) { const size_t ix = ((size_t)pair * NC + c) * 8192 + e; const float l = p.o0[ix]; p.o0[ix] = S; S = fmaf(p.a[((size_t)pair * NC + c) * 64 + dk], S, l); }
        p.o1[gid] = S; } break;
    case OP_GLA3: {
        const int NC = p.i0; const int NP = dm.B * 4 * NC; const int u = NV_UNI((int)(gid / 128)) + (p.i1 ? NP : 0), col = (int)(gid % 128); int s, h, r0, L; const float* sin; float* sout = nullptr;
        if (u < NP) { s = u / (4 * NC); h = (u / NC) % 4; const int c = u % NC; r0 = seq_row0(dm, s) + c * 64; L = dm.T - c * 64; L = L > 64 ? 64 : L; sin = p.d + (size_t)u * 8192 + col; }
        else { const int q = u - NP; s = dm.B + q / 4; h = q % 4; r0 = seq_row0(dm, s); L = dm.DT; sin = p.c + (((size_t)(s - dm.B) * 4 + h) * 64) * 128 + col; sout = p.o2 + (((size_t)(s - dm.B) * 4 + h) * 64) * 128 + col; }
        float S[64];
#pragma unroll
        for (int k = 0; k < 64; ++k) S[k] = sin[(size_t)k * 128];
        for (int t = 0; t < L; ++t) {
            const float* pr = p.a + (size_t)(r0 + t) * MIXIN; const float* la = p.b + (size_t)(r0 + t) * 256 + h * 64; const float v = pr[C_V + h * 128 + col]; float o = 0.f;
#pragma unroll
            for (int k = 0; k < 64; ++k) { if ((k & 7) == 0) NV_FENCE(); S[k] = fmaf(la[k], S[k], pr[C_K + h * 64 + k] * v); o = fmaf(pr[C_Q + h * 64 + k] * 0.125f, S[k], o); }
            p.o0[(size_t)(r0 + t) * 512 + h * 128 + col] = o;
        }
        if (sout) {
#pragma unroll
            for (int k = 0; k < 64; ++k) sout[(size_t)k * 128] = S[k]; } } break;
    case OP_LRU1: {
        const int NC = p.i0; const int u = (int)(gid / 512), c = (int)(gid % 512); const int s = u / NC, ch = u % NC; const int r0 = seq_row0(dm, s) + ch * 64; int L = dm.T - ch * 64; L = L > 64 ? 64 : L; float hh = 0.f, ap = 1.f;
#pragma unroll 8
        for (int t = 0; t < L; ++t) { const size_t ix = (size_t)(r0 + t) * 512 + c; const float a = p.a[ix]; hh = fmaf(a, hh, p.b[ix]); ap *= a; }
        p.o0[gid] = ap; p.o1[gid] = hh; } break;
    case OP_LRU2: {
        const int NC = p.i0; const int s = (int)(gid / 512), c = (int)(gid % 512); float hh = 0.f;
#pragma unroll 8
        for (int ch = 0; ch < NC; ++ch) { const size_t ix = ((size_t)s * NC + ch) * 512 + c; const float l = p.o0[ix]; p.o0[ix] = hh; hh = fmaf(p.a[ix], hh, l); }
        p.o1[gid] = hh; } break;
    case OP_LRU3: {
        const int NC = p.i0; const int u = (int)(gid / 512), c = (int)(gid % 512); const int NP = dm.B * NC; int r0, L; float hh; float* hout = nullptr;
        if (u < NP) { const int s = u / NC, ch = u % NC; r0 = seq_row0(dm, s) + ch * 64; L = dm.T - ch * 64; L = L > 64 ? 64 : L; hh = p.e[gid]; }
        else { const int q = u - NP; r0 = seq_row0(dm, dm.B + q); L = dm.DT; hh = p.d[(size_t)q * 512 + c]; hout = p.o2 + (size_t)q * 512 + c; }
#pragma unroll 8
        for (int t = 0; t < L; ++t) { const size_t r = (size_t)(r0 + t); hh = fmaf(p.a[r * 512 + c], hh, p.b[r * 512 + c]); ((nvbf*)p.o0)[r * 1024 + 512 + c] = nv_f2bf(hh * nv_gelu(p.c[r * MIXIN + C_GB + c])); }
        if (hout) *hout = hh; } break;
    case OP_EMBED4: {
        const int D4 = D / 4; const int row = (int)(gid / D4), c = (int)(gid % D4) * 4; const float* src;
        if (row < dm.B * dm.T) { const int bb = row / dm.T, t = row % dm.T; src = t < 16 ? p.c + (size_t)t * D + c : p.a + ((size_t)bb * (dm.T - 16) + (t - 16)) * D + c; } else src = p.b + (size_t)(row - dm.B * dm.T) * D + c;
        const NvF4 v = *(const NvF4*)src; *(NvF4*)(p.o0 + (size_t)row * D + c) = v; NvU2 w; w.x = nv_f2bf(v.x) | ((unsigned)nv_f2bf(v.y) << 16); w.y = nv_f2bf(v.z) | ((unsigned)nv_f2bf(v.w) << 16); *(NvU2*)((nvbf*)p.o1 + (size_t)row * D + c) = w; } break;
    case OP_YOUT4: {
        const int D4 = D / 4; const int row = (int)(gid / D4), c = (int)(gid % D4) * 4; const NvF4 v = *(const NvF4*)(p.a + (size_t)row * D + c);
        if (row < dm.B * dm.T) { const int bb = row / dm.T, t = row % dm.T; if (t >= 16) *(NvF4*)(p.o0 + ((size_t)bb * (dm.T - 16) + (t - 16)) * D + c) = v; }
        else *(NvF4*)(p.o0 + ((size_t)dm.B * (dm.T - 16) + (row - dm.B * dm.T)) * D + c) = v; } break;
    case OP_MIX8: {
        const int D8 = D / 8; const int row = (int)(gid / D8), c = (int)(gid % D8) * 8; int s, t; row_to_seq(dm, row, s, t); const float* x = p.a + (size_t)row * D + c; float xp[8];
        if (t > 0) { for (int i = 0; i < 8; ++i) xp[i] = x[i - D]; } else if (s < dm.B) { for (int i = 0; i < 8; ++i) xp[i] = 0.f; } else { for (int i = 0; i < 8; ++i) xp[i] = p.b[(size_t)(s - dm.B) * D + c + i]; }
        unsigned w[4];
#pragma unroll
        for (int i = 0; i < 4; ++i) { const float lo = x[2 * i] + (xp[2 * i] - x[2 * i]) * p.c[c + 2 * i], hi = x[2 * i + 1] + (xp[2 * i + 1] - x[2 * i + 1]) * p.c[c + 2 * i + 1]; w[i] = nv_f2bf(lo) | ((unsigned)nv_f2bf(hi) << 16); }
        NvU4 o; o.x = w[0]; o.y = w[1]; o.z = w[2]; o.w = w[3]; *(NvU4*)((nvbf*)p.o0 + (size_t)row * D + c) = o; } break;
    case OP_MIX6: {
        const int D8 = D / 8; const int row = (int)(gid / D8), c = (int)(gid % D8) * 8; int s, t; row_to_seq(dm, row, s, t); const float* x = p.a + (size_t)row * D + c; float xv[8], dx[8];
        for (int i = 0; i < 8; ++i) xv[i] = x[i];
        if (t > 0) { for (int i = 0; i < 8; ++i) dx[i] = x[i - D] - xv[i]; } else if (s < dm.B) { for (int i = 0; i < 8; ++i) dx[i] = -xv[i]; } else { for (int i = 0; i < 8; ++i) dx[i] = p.b[(size_t)(s - dm.B) * D + c + i] - xv[i]; }
        for (int m = 0; m < 6; ++m) { const float* mu = p.c + (size_t)m * D + c; unsigned w[4];
#pragma unroll
            for (int i = 0; i < 4; ++i) w[i] = nv_f2bf(xv[2 * i] + dx[2 * i] * mu[2 * i]) | ((unsigned)nv_f2bf(xv[2 * i + 1] + dx[2 * i + 1] * mu[2 * i + 1]) << 16);
            NvU4 o; o.x = w[0]; o.y = w[1]; o.z = w[2]; o.w = w[3]; *(NvU4*)((nvbf*)p.o0 + (size_t)m * p.i0 * 0 + (size_t)m * (size_t)p.i1 * 1024 + (size_t)row * D + c) = o; } } break;
    case OP_CONV4: {
        const int row = (int)(gid / 128), c = (int)(gid % 128) * 4; int s, t; row_to_seq(dm, row, s, t); float acc[4];
        for (int q = 0; q < 4; ++q) acc[q] = p.d[c + q];
        for (int i = 0; i < 4; ++i) { const int j = t + i; const float* xv = nullptr;
            if (j < 3) { if (s >= dm.B) xv = p.b + ((size_t)(s - dm.B) * 3 + j) * 512 + c; } else xv = p.a + (size_t)(row - t + (j - 3)) * MIXIN + C_XB + c;
            if (xv) for (int q = 0; q < 4; ++q) acc[q] = fmaf(xv[q], p.c[i * 512 + c + q], acc[q]); }
        NvF4 o; o.x = acc[0]; o.y = acc[1]; o.z = acc[2]; o.w = acc[3]; *(NvF4*)(p.o0 + (size_t)row * 512 + c) = o;
        NvU2 w; w.x = nv_f2bf(acc[0]) | ((unsigned)nv_f2bf(acc[1]) << 16); w.y = nv_f2bf(acc[2]) | ((unsigned)nv_f2bf(acc[3]) << 16); *(NvU2*)((nvbf*)p.o1 + (size_t)row * 512 + c) = w; } break;
    case OP_CVT8: {
        const int K8 = p.i2 / 8; const int row = (int)(gid / K8), k = (int)(gid % K8) * 8; unsigned w[4] = {0u, 0u, 0u, 0u};
        if (row < dm.M && k < p.i0) { const float* sp = p.a + (size_t)row * p.i1 + k;
#pragma unroll
            for (int i = 0; i < 4; ++i) { float lo = sp[2 * i], hi = sp[2 * i + 1]; if (p.i3 == 1) { lo = tanhf(lo); hi = tanhf(hi); } else if (p.i3 == 2) { lo = nv_sigmoid(lo); hi = nv_sigmoid(hi); } w[i] = nv_f2bf(lo) | ((unsigned)nv_f2bf(hi) << 16); } }
        NvU4 o; o.x = w[0]; o.y = w[1]; o.z = w[2]; o.w = w[3]; *(NvU4*)((nvbf*)p.o0 + (size_t)row * p.i2 + k) = o; } break;
    case OP_WGATE: {
        const int n = (int)gid, pn = n >> 8, within = n & 127, isx = (n >> 7) & 1, c = pn * 128 + within, nb = c >> 6, e = c & 63; const float* w = isx ? p.b : p.a; nvbf* dst = (nvbf*)p.o0 + (size_t)n * 512;
        for (int k = 0; k < 512; ++k) dst[k] = ((k >> 6) == nb) ? nv_f2bf(w[((size_t)nb * 64 + (k & 63)) * 64 + e]) : (nvbf)0;
        if (n < 512) p.o1[n] = -8.f * nv_softplus(-p.c[n]); } break;
    case OP_LRUG2: {
        const int row = (int)(gid / 512), c = (int)(gid % 512), pn = c >> 7, within = c & 127; const nvbf* x = (const nvbf*)p.a + (size_t)row * 512; const nvbf* wa_ = (const nvbf*)p.b + (size_t)(pn * 256 + within) * 512; const nvbf* wx_ = wa_ + (size_t)128 * 512; float ga = 0.f, gx = 0.f;
        for (int k = 0; k < 512; ++k) { const float xv = nv_bf2f(x[k]); ga = fmaf(xv, nv_bf2f(wa_[k]), ga); gx = fmaf(xv, nv_bf2f(wx_[k]), gx); }
        const float gate_a = nv_sigmoid(ga + p.c[c]), gate_x = nv_sigmoid(gx + p.d[c]); const float log_at = gate_a * p.e[c];
        p.o0[gid] = expf(log_at); p.o1[gid] = sqrtf(-expm1f(2.f * log_at)) * (gate_x * p.f[gid]); } break;
    case OP_LOGA4: {
        const int row = (int)(gid / 64), c = (int)(gid % 64) * 4; const float* gl = p.a + (size_t)row * MIXIN + C_GLR; NvF4 z = *(const NvF4*)(p.c + c);
#pragma unroll
        for (int r4 = 0; r4 < 4; ++r4) { const NvF4 g = *(const NvF4*)(gl + 4 * r4);
            const NvF4 w0 = *(const NvF4*)(p.b + (4 * r4 + 0) * 256 + c), w1 = *(const NvF4*)(p.b + (4 * r4 + 1) * 256 + c), w2 = *(const NvF4*)(p.b + (4 * r4 + 2) * 256 + c), w3 = *(const NvF4*)(p.b + (4 * r4 + 3) * 256 + c);
            z.x = fmaf(g.x, w0.x, z.x); z.y = fmaf(g.x, w0.y, z.y); z.z = fmaf(g.x, w0.z, z.z); z.w = fmaf(g.x, w0.w, z.w); z.x = fmaf(g.y, w1.x, z.x); z.y = fmaf(g.y, w1.y, z.y); z.z = fmaf(g.y, w1.z, z.z); z.w = fmaf(g.y, w1.w, z.w);
            z.x = fmaf(g.z, w2.x, z.x); z.y = fmaf(g.z, w2.y, z.y); z.z = fmaf(g.z, w2.z, z.z); z.w = fmaf(g.z, w2.w, z.w); z.x = fmaf(g.w, w3.x, z.x); z.y = fmaf(g.w, w3.y, z.y); z.z = fmaf(g.w, w3.z, z.z); z.w = fmaf(g.w, w3.w, z.w); }
        NvF4 o; o.x = expf(-nv_softplus(-z.x) * (1.f / 16.f)); o.y = expf(-nv_softplus(-z.y) * (1.f / 16.f)); o.z = expf(-nv_softplus(-z.z) * (1.f / 16.f)); o.w = expf(-nv_softplus(-z.w) * (1.f / 16.f));
        *(NvF4*)(p.o0 + (size_t)row * 256 + c) = o; } break;
    case OP_GLANORM: {
        int row = (int)(gid / 4), h = (int)(gid % 4); const float* o = p.a + (size_t)row * 512 + h * 128; float ss = 0.f;
        for (int c = 0; c < 128; ++c) ss = fmaf(o[c], o[c], ss);
        float rs = 1.f / sqrtf(ss * (1.f / 128.f) + 1e-5f);
        for (int c = 0; c < 128; ++c) { float r = p.b[(size_t)row * MIXIN + C_R + h * 128 + c]; ((nvbf*)p.o0)[(size_t)row * 1024 + h * 128 + c] = nv_f2bf(o[c] * rs * p.c[c] * (r * nv_sigmoid(r))); } } break;
    case OP_CONV: {
        int row = (int)(gid / 512), c = (int)(gid % 512); int s, t; row_to_seq(dm, row, s, t); float acc = p.d[c];
        for (int i = 0; i < 4; ++i) { int j = t + i; float xv;
            if (j < 3) xv = (s < dm.B) ? 0.f : p.b[((size_t)(s - dm.B) * 3 + j) * 512 + c]; else xv = p.a[(size_t)(row - t + (j - 3)) * MIXIN + C_XB + c];
            acc = fmaf(xv, p.c[i * 512 + c], acc); }
        p.o0[gid] = acc; } break;
    case OP_CONVOUT: {
        int s = (int)(gid / 1536), i = (int)((gid / 512) % 3), c = (int)(gid % 512); int L = seq_len(dm, s), r0 = seq_row0(dm, s); int j = L + i; float xv;
        if (j < 3) xv = (s < dm.B) ? 0.f : p.b[((size_t)(s - dm.B) * 3 + j) * 512 + c]; else xv = p.a[(size_t)(r0 + j - 3) * MIXIN + C_XB + c];
        float* o = (s < dm.B) ? PO1 + ((size_t)s * 3 + i) * 512 + c : PO2 + ((size_t)(s - dm.B) * 3 + i) * 512 + c; *o = xv; } break;
    case OP_LRUG: {
        int row = (int)(gid / 512), c = (int)(gid % 512), nb = c / 64, e = c % 64; const float* x = p.a + (size_t)row * 512 + nb * 64; float ga = p.c[c], gx = p.e[c];
        for (int dd = 0; dd < 64; ++dd) { ga = fmaf(x[dd], p.b[((size_t)nb * 64 + dd) * 64 + e], ga); gx = fmaf(x[dd], p.d[((size_t)nb * 64 + dd) * 64 + e], gx); }
        float gate_a = nv_sigmoid(ga), gate_x = nv_sigmoid(gx); float log_at = -8.f * gate_a * nv_softplus(-p.f[c]);
        p.o0[gid] = expf(log_at); p.o1[gid] = sqrtf(-expm1f(2.f * log_at)) * (gate_x * p.a[(size_t)row * 512 + c]); } break;
    case OP_LRUSCAN: {
        int s = (int)(gid / 512), c = (int)(gid % 512); int r0 = seq_row0(dm, s), L = seq_len(dm, s); float hh = (s < dm.B) ? 0.f : p.d[(size_t)(s - dm.B) * 512 + c];
        for (int t = 0; t < L; ++t) { size_t r = (size_t)(r0 + t); hh = fmaf(p.a[r * 512 + c], hh, p.b[r * 512 + c]); p.o0[r * 1024 + 512 + c] = hh * nv_gelu(p.c[r * MIXIN + C_GB + c]); }
        float* o = (s < dm.B) ? PO1 + (size_t)s * 512 + c : PO2 + (size_t)(s - dm.B) * 512 + c; *o = hh; } break;
    case OP_LNRES: {
        const float alpha = 1.6817928305074292f; float* x = p.o0 + (size_t)gid * D; const nvbf* y = (const nvbf*)p.a + (size_t)gid * D; float mu = 0.f;
        for (int c = 0; c < D; ++c) mu += alpha * x[c] + nv_bf2f(y[c]);
        mu /= D; float var = 0.f;
        for (int c = 0; c < D; ++c) { float v = alpha * x[c] + nv_bf2f(y[c]) - mu; var = fmaf(v, v, var); }
        float rs = 1.f / sqrtf(var / D + 1e-5f);
        for (int c = 0; c < D; ++c) { const float o = (alpha * x[c] + nv_bf2f(y[c]) - mu) * rs * p.b[c] + p.c[c]; x[c] = o; ((nvbf*)p.o1)[(size_t)gid * D + c] = nv_f2bf(o);
            if (p.o2) { unsigned char* f8 = (unsigned char*)p.o2 + (size_t)gid * 2 * D; const float xs = fminf(fmaxf(o * 16.f, -448.f), 448.f); const unsigned hc = nv_f2e4m3(xs); f8[c] = (unsigned char)hc; f8[D + c] = (unsigned char)nv_f2e4m3(xs - nv_e4m32f(hc)); } } } break;
    case OP_MIX: {
        int row = (int)(gid / D), c = (int)(gid % D); int s, t; row_to_seq(dm, row, s, t); float x = p.a[gid];
        float xp = t > 0 ? p.a[gid - D] : ((s < dm.B) ? 0.f : p.b[(size_t)(s - dm.B) * D + c]);
        ((nvbf*)p.o0)[gid] = nv_f2bf(x + (xp - x) * p.c[c]); } break;
    case OP_SHIFTOUT: {
        int s = (int)(gid / D), c = (int)(gid % D); float v = p.a[(size_t)(seq_row0(dm, s) + seq_len(dm, s) - 1) * D + c];
        float* o = (s < dm.B) ? PO1 + (size_t)s * D + c : PO2 + (size_t)(s - dm.B) * D + c; *o = v; } break;
    case OP_RWKVPREP: {
        int row = (int)(gid / dm.RH), h = (int)(gid % dm.RH); size_t base = (size_t)row * D + h * 64; float ss = 0.f;
        for (int k = 0; k < 64; ++k) { float kv = p.o0[base + k] * p.d[h * 64 + k]; ss = fmaf(kv, kv, ss); }
        float inv = 1.f / fmaxf(sqrtf(ss), 1e-12f);
        for (int k = 0; k < 64; ++k) { int c = h * 64 + k; size_t ix = base + k;
            float w = -nv_softplus(-(p.a[c] + p.o1[ix])) - 0.5f; float dec = expf(-expf(w));
            float a = nv_sigmoid(p.b[c] + p.o2[ix]);
            float v = p.o3[ix]; if (p.i0) v = v + (p.o5[ix] - v) * nv_sigmoid(p.c[c] + p.f[ix]); else p.o5[ix] = v;
            float k0 = p.o0[ix]; const float kk = k0 * p.d[c] * inv; p.o4[ix] = -kk; p.o0[ix] = k0 * (1.f + (a - 1.f) * p.e[c]); p.o1[ix] = dec; p.o2[ix] = kk * a; p.o3[ix] = v; } } break;
    case OP_WKVF:
    case OP_WKV: {
        int RH = dm.RH; int s = p.i0 + (int)(gid / (RH * 64)), h = (int)((gid / 64) % RH), vr = (int)(gid % 64); float S[64];
        const float* sin = (s < dm.B) ? nullptr : p.g + (((size_t)(s - dm.B) * RH + h) * 64 + vr) * 64;
#pragma unroll
        for (int k = 0; k < 64; ++k) S[k] = sin ? sin[k] : 0.f;
        int r0 = seq_row0(dm, s), L = seq_len(dm, s);
        for (int t = 0; t < L; ++t) { size_t base = (size_t)(r0 + t) * D + h * 64; float sa = 0.f;
#pragma unroll
            for (int k = 0; k < 64; ++k) { if ((k & 7) == 0) NV_FENCE(); sa = fmaf(S[k], p.f[base + k], sa); }
            float vv = p.d[base + vr], y = 0.f;
#pragma unroll
            for (int k = 0; k < 64; ++k) { if ((k & 7) == 0) NV_FENCE(); S[k] = fmaf(S[k], p.b[base + k], fmaf(sa, p.e[base + k], vv * p.c[base + k])); y = fmaf(S[k], p.a[base + k], y); }
            p.o0[base + vr] = y; }
        float* so = (s < dm.B) ? PO1 + (((size_t)s * RH + h) * 64 + vr) * 64 : PO2 + (((size_t)(s - dm.B) * RH + h) * 64 + vr) * 64;
#pragma unroll
        for (int k = 0; k < 64; ++k) so[k] = S[k]; } break;
    case OP_RWKVPOST: {
        int row = (int)(gid / dm.RH), h = (int)(gid % dm.RH); size_t base = (size_t)row * D + h * 64; float mu = 0.f, bon = 0.f;
        for (int k = 0; k < 64; ++k) { mu += p.a[base + k]; bon = fmaf(p.b[base + k] * p.c[base + k], p.f[h * 64 + k], bon); }
        mu *= (1.f / 64.f); float var = 0.f;
        for (int k = 0; k < 64; ++k) { float dlt = p.a[base + k] - mu; var = fmaf(dlt, dlt, var); }
        float rs = 1.f / sqrtf(var * (1.f / 64.f) + 64e-5f);
        for (int k = 0; k < 64; ++k) { int c = h * 64 + k; float y = (p.a[base + k] - mu) * rs * p.g[c] + p.h[c] + bon * p.d[base + k]; ((nvbf*)p.o0)[base + k] = nv_f2bf(y * p.e[base + k]); } } break;
    case OP_PRM: {
        const int m = (int)(gid / D), c = (int)(gid % D); const float* src = m == 0 ? p.a : m == 1 ? p.b : m == 2 ? p.c : m == 3 ? p.d : m == 4 ? p.e : p.f; p.o0[gid] = src ? src[c] : 0.f; } break;
    case OP_WKVP: {
        const int RH = dm.RH; const int s = (int)(gid / (RH * 64)), h = (int)((gid / 64) % RH), vr = (int)(gid % 64); float S[64];
        const float* sin = (s < dm.B) ? nullptr : p.o5 + (((size_t)(s - dm.B) * RH + h) * 64 + vr) * 64;
        for (int k = 0; k < 64; ++k) S[k] = sin ? sin[k] : 0.f;
        const float* w0 = p.h + h * 64; const float* a0 = p.h + D + h * 64; const float* v0 = p.h + 2 * D + h * 64; const float* k_k = p.h + 3 * D + h * 64; const float* k_a = p.h + 4 * D + h * 64; const float* r_k = p.h + 5 * D + h * 64;
        const int r0 = seq_row0(dm, s), L = seq_len(dm, s); const nvbf* bR = (const nvbf*)p.a; const nvbf* bK = (const nvbf*)p.b; const nvbf* bWL = (const nvbf*)p.c; const nvbf* bAL = (const nvbf*)p.d; const nvbf* bV = (const nvbf*)p.e; const nvbf* bVG = (const nvbf*)p.f;
        for (int t = 0; t < L; ++t) { const size_t base = (size_t)(r0 + t) * D + h * 64; float ss = 0.f;
            for (int k = 0; k < 64; ++k) { const float kv = nv_bf2f(bK[base + k]) * k_k[k]; ss = fmaf(kv, kv, ss); }
            const float inv = 1.f / fmaxf(sqrtf(ss), 1e-12f);
            float vv = nv_bf2f(bV[base + vr]); if (p.i0) vv = vv + (p.g[base + vr] - vv) * nv_sigmoid(v0[vr] + nv_bf2f(bVG[base + vr]));
            float sa = 0.f, bon = 0.f, dec[64], bb[64], k2[64];
            for (int k = 0; k < 64; ++k) { const float k0 = nv_bf2f(bK[base + k]); const float kk = k0 * k_k[k] * inv; const float a = nv_sigmoid(a0[k] + nv_bf2f(bAL[base + k]));
                dec[k] = expf(-0.6065306597126334f * nv_sigmoid(w0[k] + nv_bf2f(bWL[base + k])));
                bb[k] = kk * a; k2[k] = k0 * (1.f + (a - 1.f) * k_a[k]); sa = fmaf(S[k], -kk, sa); bon = fmaf(nv_bf2f(bR[base + k]) * k2[k], r_k[k], bon); }
            float y = 0.f;
            for (int k = 0; k < 64; ++k) { S[k] = fmaf(S[k], dec[k], fmaf(sa, bb[k], vv * k2[k])); y = fmaf(S[k], nv_bf2f(bR[base + k]), y); }
            p.o0[base + vr] = y; p.o3[base + vr] = vv; if (vr == 0) p.o4[(size_t)(r0 + t) * RH + h] = bon; }
        float* so = (s < dm.B) ? PO1 + (((size_t)s * RH + h) * 64 + vr) * 64 : PO2 + (((size_t)(s - dm.B) * RH + h) * 64 + vr) * 64;
        for (int k = 0; k < 64; ++k) so[k] = S[k]; } break;
    case OP_POST2: {
        const int row = (int)(gid / dm.RH), h = (int)(gid % dm.RH); const size_t base = (size_t)row * D + h * 64; float mu = 0.f;
        for (int k = 0; k < 64; ++k) mu += p.a[base + k];
        mu *= (1.f / 64.f); float var = 0.f;
        for (int k = 0; k < 64; ++k) { const float dlt = p.a[base + k] - mu; var = fmaf(dlt, dlt, var); }
        const float rs = 1.f / sqrtf(var * (1.f / 64.f) + 64e-5f), bon = p.d[gid];
        for (int k = 0; k < 64; ++k) { const int c = h * 64 + k; const float y = (p.a[base + k] - mu) * rs * p.e[c] + p.f[c] + bon * p.c[base + k]; ((nvbf*)p.o0)[base + k] = nv_f2bf(y * nv_bf2f(((const nvbf*)p.b)[base + k])); } } break;
    case OP_QNORM: {
        float* q = p.o0 + (size_t)gid * 256; float mu = 0.f;
        for (int c = 0; c < 256; ++c) mu += q[c];
        mu *= (1.f / 256.f); float var = 0.f;
        for (int c = 0; c < 256; ++c) { float dlt = q[c] - mu; var = fmaf(dlt, dlt, var); }
        float rs = 1.f / sqrtf(var * (1.f / 256.f) + 1e-5f);
        for (int c = 0; c < 256; ++c) q[c] = (q[c] - mu) * rs; } break;
    case OP_SCORES: {
        int row = (int)(gid / 2048), r = (int)(gid % 2048), h = r / 256, half = (r / 128) & 1, key = r % 128;
        const float* q = p.a + (size_t)row * 2048 + h * 256 + half * 128; const float* kv = p.b + (((size_t)h * 2 + half) * 128 + key) * 128; float acc = 0.f;
        for (int dd = 0; dd < 128; ++dd) acc = fmaf(q[dd], kv[dd], acc);
        p.o0[gid] = acc; } break;
    case OP_TOPK: {
        const float* sc = p.a + (size_t)gid * 256; float tv[16]; int ti[16]; float* tmpv = p.o2 + (size_t)gid * 32; int* tmpi = (int*)p.o3 + (size_t)gid * 32;
        for (int half = 0; half < 2; ++half) {
#pragma unroll
            for (int j = 0; j < 16; ++j) { tv[j] = -3.0e38f; ti[j] = 0; }
            for (int k = 0; k < 128; ++k) NV_INS16(tv, ti, sc[half * 128 + k], k);
#pragma unroll
            for (int j = 0; j < 16; ++j) { tmpv[half * 16 + j] = tv[j]; tmpi[half * 16 + j] = ti[j]; }
        }
#pragma unroll
        for (int j = 0; j < 16; ++j) { tv[j] = -3.0e38f; ti[j] = 0; }
        for (int i = 0; i < 16; ++i) for (int j = 0; j < 16; ++j) NV_INS16(tv, ti, tmpv[i] + tmpv[16 + j], tmpi[i] * 128 + tmpi[16 + j]);
        float den = 0.f, ev[16];
#pragma unroll
        for (int j = 0; j < 16; ++j) { ev[j] = expf(tv[j] - tv[0]); den += ev[j]; }
        float inv = 1.f / den;
#pragma unroll
        for (int j = 0; j < 16; ++j) { p.o0[(size_t)gid * 16 + j] = ev[j] * inv; ((int*)p.o1)[(size_t)gid * 16 + j] = ti[j]; } } break;
    case OP_PACT1: {
        size_t pr = (size_t)(gid / 16); int part = (int)(gid % 16); int row = (int)(pr / 128); int e = ((const int*)p.d)[pr]; int w = D / 16;
        const float* u = p.b + (size_t)e * D + part * w; const float* x = p.a + (size_t)row * D + part * w; float acc = 0.f;
        for (int c = 0; c < w; ++c) acc = fmaf(u[c], x[c], acc);
        p.o0[gid] = acc; } break;
    case OP_PACT2: {
        float acc = 0.f; for (int i = 0; i < 16; ++i) acc += p.a[(size_t)gid * 16 + i];
        p.o0[gid] = p.c[gid] * nv_gelu(acc); } break;
    case OP_POUT: {
        int row = (int)(gid / D), c = (int)(gid % D); float acc = 0.f;
        for (int i = 0; i < 128; ++i) acc = fmaf(p.a[(size_t)row * 128 + i], p.c[(size_t)((const int*)p.b)[(size_t)row * 128 + i] * D + c], acc);
        p.o0[gid] = acc; } break;
    case OP_YOUT: {
        int row = (int)(gid / D), c = (int)(gid % D);
        if (row < dm.B * dm.T) { int bb = row / dm.T, t = row % dm.T; if (t >= 16) p.o0[((size_t)bb * (dm.T - 16) + (t - 16)) * D + c] = p.a[gid]; }
        else p.o0[((size_t)dm.B * (dm.T - 16) + (row - dm.B * dm.T)) * D + c] = p.a[gid]; } break;
    case OP_WT: {
        const int N = p.i0, K = p.i1, Np = p.i3, Kp = p.i4; const long long per8 = (long long)Np * (Kp / 8); const int bt = (int)(gid / per8); const long long r = gid % per8; const int k0 = (int)(r / Np) * 8, nn = (int)(r % Np);
        unsigned w[4];
#pragma unroll
        for (int i = 0; i < 4; ++i) { float lo = 0.f, hi = 0.f; if (nn < N) { if (k0 + 2 * i < K) lo = p.a[((size_t)bt * K + k0 + 2 * i) * p.i2 + nn]; if (k0 + 2 * i + 1 < K) hi = p.a[((size_t)bt * K + k0 + 2 * i + 1) * p.i2 + nn]; } w[i] = nv_f2bf(lo) | ((unsigned)nv_f2bf(hi) << 16); }
        NvU4 o; o.x = w[0]; o.y = w[1]; o.z = w[2]; o.w = w[3];
        *(NvU4*)((nvbf*)p.o0 + (size_t)bt * Np * Kp + (size_t)nn * Kp + k0) = o; } break;
    case OP_CVT: {
        const int Kp = p.i2; const int row = (int)(gid / Kp), k = (int)(gid % Kp); float v = 0.f;
        if (row < dm.M && k < p.i0) { v = p.a[(size_t)row * p.i1 + k]; if (p.i3 == 1) v = tanhf(v); else if (p.i3 == 2) v = nv_sigmoid(v); }
        ((nvbf*)p.o0)[gid] = nv_f2bf(v); } break;
    case OP_FGEMM: {
        const int N = p.i0; const int m = (int)(gid / N), nn = (int)(gid % N); const nvbf* A = (const nvbf*)p.a + (size_t)m * p.i2 + ((p.i6 & 2) ? (nn / 256) * 256 : 0); const nvbf* Bt = (const nvbf*)p.b + (size_t)nn * p.i3; float acc = 0.f;
        for (int k = 0; k < p.i1; ++k) acc = fmaf(nv_bf2f(A[k]), nv_bf2f(Bt[k]), acc);
        if (p.i6 & 1) ((nvbf*)p.o0)[(size_t)m * p.i4 + nn] = nv_f2bf(acc); else p.o0[(size_t)m * p.i4 + nn] = acc; } break;
    case OP_CVTTAB: {
        const NvF4 v0 = *(const NvF4*)(p.a + gid * 8), v1 = *(const NvF4*)(p.a + gid * 8 + 4); NvU4 o;
        o.x = nv_f2bf(v0.x) | ((unsigned)nv_f2bf(v0.y) << 16); o.y = nv_f2bf(v0.z) | ((unsigned)nv_f2bf(v0.w) << 16); o.z = nv_f2bf(v1.x) | ((unsigned)nv_f2bf(v1.y) << 16); o.w = nv_f2bf(v1.z) | ((unsigned)nv_f2bf(v1.w) << 16);
        *(NvU4*)((nvbf*)p.o0 + gid * 8) = o; } break;
    case OP_CVTTAB8: {
        const float sc = (float)(1 << p.i0); const float* sp = p.a + gid * 16; unsigned w[4];
#pragma unroll
        for (int q = 0; q < 4; ++q) { const NvF4 v = *(const NvF4*)(sp + 4 * q); w[q] = nv_f2e4m3(v.x * sc) | (nv_f2e4m3(v.y * sc) << 8) | (nv_f2e4m3(v.z * sc) << 16) | (nv_f2e4m3(v.w * sc) << 24); }
        NvU4 o; o.x = w[0]; o.y = w[1]; o.z = w[2]; o.w = w[3]; *(NvU4*)((unsigned char*)p.o0 + gid * 16) = o; } break;
    case OP_CVTTAB8S: {
        const float sc = (float)(1 << p.i0); const int per = D / 16; const int e = (int)(gid / per), c0 = (int)(gid % per) * 16; const float* sp = p.a + (size_t)e * D + c0; unsigned w[4];
#pragma unroll
        for (int q = 0; q < 4; ++q) { const NvF4 v = *(const NvF4*)(sp + 4 * q);
#if defined(__HIP_DEVICE_COMPILE__)
            int pk = __builtin_amdgcn_cvt_pk_fp8_f32(v.x * sc, v.y * sc, 0, false); pk = __builtin_amdgcn_cvt_pk_fp8_f32(v.z * sc, v.w * sc, pk, true); w[q] = (unsigned)pk;
#else
            w[q] = nv_f2e4m3(v.x * sc) | (nv_f2e4m3(v.y * sc) << 8) | (nv_f2e4m3(v.z * sc) << 16) | (nv_f2e4m3(v.w * sc) << 24);
#endif
        }
        NvU4 o; o.x = w[0]; o.y = w[1]; o.z = w[2]; o.w = w[3]; *(NvU4*)((unsigned char*)p.o0 + ((size_t)(c0 >> 7) * 16384 + e) * 128 + (c0 & 127)) = o; } break;
    case OP_PACTS: {
        const long long NP = (long long)dm.M * 128; const int sl = (int)(gid / NP); const long long pr = gid % NP; const int row = (int)(pr / 128); const int e = ((const int*)p.d)[pr] & p.i0;
        const unsigned char* u = (const unsigned char*)p.b + ((size_t)sl * 16384 + e) * 128; const unsigned char* x = (const unsigned char*)p.a + (size_t)row * 2 * D + sl * 128; float acc = 0.f;
        for (int c = 0; c < 128; ++c) acc = fmaf(nv_e4m32f(u[c]), nv_e4m32f(x[c]) + nv_e4m32f(x[D + c]), acc);
        p.o0[gid] = acc * (1.f / 16.f); } break;
    case OP_PRED: {
        const long long NP = (long long)dm.M * 128; float acc = 0.f; for (int sl = 0; sl < p.i0; ++sl) acc += p.a[(size_t)sl * NP + gid];
        p.o0[gid] = p.c[gid] * nv_gelu(acc * (1.f / 128.f)); } break;
    case OP_POUTS: {
        const int row = (int)(gid / D), c = (int)(gid % D); const unsigned char* vb = (const unsigned char*)p.c + (size_t)(c >> 7) * 16384 * 128 + (c & 127); float acc = 0.f;
        for (int i = 0; i < 128; ++i) acc = fmaf(p.a[(size_t)row * 128 + i] * (1.f / 64.f), nv_e4m32f(vb[(size_t)((const int*)p.b)[(size_t)row * 128 + i] * 128]), acc);
        ((nvbf*)p.o0)[gid] = nv_f2bf(acc); } break;
    case OP_KEYS: {
        const int h = (int)(gid / 256), nrow = (int)(gid % 256), half = nrow >> 7; const float* src = p.a + (((size_t)h * 2 + half) * 128 + (nrow & 127)) * 128; nvbf* dst = (nvbf*)p.o0 + ((size_t)h * 256 + nrow) * 256; float ks = 0.f;
        for (int k = 0; k < 256; ++k) { nvbf b = 0; if ((k >> 7) == half) { b = nv_f2bf(src[k & 127]); ks += nv_bf2f(b); } dst[k] = b; }
        p.o1[gid] = ks; } break;
    case OP_TOPK2: {
        const int h = (int)(gid % 8); const float* sc = p.a + (size_t)gid * 256; const nvbf* q = (const nvbf*)p.b + (size_t)gid * 256; const float* ksum = p.c + h * 256; float mu = 0.f;
        for (int c = 0; c < 256; ++c) mu += nv_bf2f(q[c]);
        mu *= (1.f / 256.f); float var = 0.f;
        for (int c = 0; c < 256; ++c) { float dlt = nv_bf2f(q[c]) - mu; var = fmaf(dlt, dlt, var); }
        const float rs = 1.f / sqrtf(var * (1.f / 256.f) + 1e-5f);
        float tv[16]; int ti[16]; float* tmpv = p.o2 + (size_t)gid * 32; int* tmpi = (int*)p.o3 + (size_t)gid * 32;
        for (int half = 0; half < 2; ++half) {
#pragma unroll
            for (int j = 0; j < 16; ++j) { tv[j] = -3.0e38f; ti[j] = 0; }
            for (int k = 0; k < 128; ++k) NV_INS16(tv, ti, rs * (sc[half * 128 + k] - mu * ksum[half * 128 + k]), k);
#pragma unroll
            for (int j = 0; j < 16; ++j) { tmpv[half * 16 + j] = tv[j]; tmpi[half * 16 + j] = ti[j]; }
        }
#pragma unroll
        for (int j = 0; j < 16; ++j) { tv[j] = -3.0e38f; ti[j] = 0; }
        for (int i = 0; i < 16; ++i) for (int j = 0; j < 16; ++j) NV_INS16(tv, ti, tmpv[i] + tmpv[16 + j], tmpi[i] * 128 + tmpi[16 + j]);
        float den = 0.f, ev[16];
#pragma unroll
        for (int j = 0; j < 16; ++j) { ev[j] = expf(tv[j] - tv[0]); den += ev[j]; }
        float inv = 1.f / den;
#pragma unroll
        for (int j = 0; j < 16; ++j) { p.o0[(size_t)gid * 16 + j] = ev[j] * inv; ((int*)p.o1)[(size_t)gid * 16 + j] = ti[j]; } } break;
    case OP_PACT: {
        const int row = (int)(gid / 128); const int e = ((const int*)p.d)[gid]; const unsigned char* u = (const unsigned char*)p.b + (size_t)e * D; const nvbf* x = (const nvbf*)p.a + (size_t)row * D; float acc = 0.f;
        for (int c = 0; c < D; ++c) acc = fmaf(nv_e4m32f(u[c]), nv_bf2f(x[c]), acc);
        p.o0[gid] = p.c[gid] * nv_gelu(acc * (1.f / 128.f)); } break;
#if defined(HOST_TEST)
    case OP_POUTLN: {
        const float alpha = 1.6817928305074292f; float* x = p.o0 + (size_t)gid * D; std::vector<float> y(D, 0.f);
        for (int i = 0; i < 128; ++i) { const float cf = p.a[(size_t)gid * 128 + i] * (1.f / 64.f); const unsigned char* v = (const unsigned char*)p.c + (size_t)((const int*)p.b)[(size_t)gid * 128 + i] * D; for (int c = 0; c < D; ++c) y[c] = fmaf(cf, nv_e4m32f(v[c]), y[c]); }
        float mu = 0.f; for (int c = 0; c < D; ++c) { y[c] = alpha * x[c] + y[c]; mu += y[c]; }
        mu /= D; float var = 0.f; for (int c = 0; c < D; ++c) { float dlt = y[c] - mu; var = fmaf(dlt, dlt, var); }
        const float rs = 1.f / sqrtf(var / D + 1e-5f);
        for (int c = 0; c < D; ++c) { const float o = (y[c] - mu) * rs * p.d[c] + p.e[c]; x[c] = o; ((nvbf*)p.o1)[(size_t)gid * D + c] = nv_f2bf(o);
            if (p.o2) { unsigned char* f8 = (unsigned char*)p.o2 + (size_t)gid * 2 * D; const float xs = fminf(fmaxf(o * 16.f, -448.f), 448.f); const unsigned hc = nv_f2e4m3(xs); f8[c] = (unsigned char)hc; f8[D + c] = (unsigned char)nv_f2e4m3(xs - nv_e4m32f(hc)); } } } break;
#endif
    default: break;
    }
}

struct NvIO { const float* const* in; float* out; char* ws; size_t ws_size; };
template <class Launch> HD void nv_forward(const NvIO& io, const Dm& dm, Launch&& launch) {
    const int D = dm.D, M = dm.M, B = dm.B, DB = dm.DB, RH = dm.RH; const size_t MD = (size_t)M * D;
    float* y_prompt = io.out; float* y_sample = y_prompt + (size_t)B * (dm.T - 16) * D; float* p_gla = y_sample + (size_t)DB * dm.DT * D;
    float* p_h = p_gla + (size_t)2 * B * 4 * 64 * 128; float* p_conv = p_h + (size_t)2 * B * 512; float* p_rwkv = p_conv + (size_t)2 * B * 3 * 512;
    float* p_shift = p_rwkv + (size_t)2 * B * RH * 4096; float* s_gla = p_shift + (size_t)2 * B * D; float* s_h = s_gla + (size_t)2 * DB * 4 * 64 * 128;
    float* s_conv = s_h + (size_t)2 * DB * 512; float* s_rwkv = s_conv + (size_t)2 * DB * 3 * 512; float* s_shift = s_rwkv + (size_t)2 * DB * RH * 4096;
    float* w = (float*)io.ws; size_t off = 0; auto take = [&](size_t n) __attribute__((always_inline)) { float* r = w + off; off += (n + 63) & ~(size_t)63; return r; };
    float* X = take(MD); float* VFIRST = take(MD); float* MOUT = take(MD);
    auto mk = [&](int code, long long n) __attribute__((always_inline)) { Op o{}; o.code = code; o.n = n; return o; };
    const int Mp = nv_rup(M, 256), Dp = nv_rup(D, 256), Dk = nv_rup(D, 128);
    auto takeh = [&](size_t n) __attribute__((always_inline)) { return (nvbf*)take((n + 1) / 2); };
    const size_t ABFN = (size_t)Mp * 1024 > (size_t)Mp * Dk ? (size_t)Mp * 1024 : (size_t)Mp * Dk; nvbf* ABF = takeh(ABFN + (size_t)Mp * D);
    const size_t SZ_WIN = (size_t)2816 * Dk, SZ_WOUT = (size_t)Dp * 1024, SZ_DD = (size_t)Dp * Dk, SZ_DN = (size_t)256 * Dk, SZ_UP = (size_t)Dp * 128, SZ_WQ = (size_t)2048 * Dk;
    nvbf* WT_WIN = takeh(2 * SZ_WIN); nvbf* WT_WOUT = takeh(2 * SZ_WOUT); nvbf* WT_WR = takeh(2 * SZ_DD); nvbf* WT_WK = takeh(2 * SZ_DD); nvbf* WT_WV = takeh(2 * SZ_DD); nvbf* WT_WO = takeh(2 * SZ_DD);
    nvbf* WT_W1 = takeh(2 * SZ_DN); nvbf* WT_W2 = takeh(2 * SZ_UP); nvbf* WT_A1 = takeh(2 * SZ_DN); nvbf* WT_A2 = takeh(2 * SZ_UP); nvbf* WT_G1 = takeh(2 * SZ_DN); nvbf* WT_G2 = takeh(2 * SZ_UP);
    nvbf* WT_V1 = takeh(SZ_DN); nvbf* WT_V2 = takeh(SZ_UP); nvbf* WT_WQ = takeh(4 * SZ_WQ); nvbf* WT_WG = takeh((size_t)2 * 1024 * 512); float* SPL = take(2 * 512); float* PRM = take((size_t)2 * 6 * D);
    nvbf* UB = takeh((size_t)16384 * D / 2); nvbf* VB = takeh((size_t)16384 * D / 2); nvbf* KB = takeh((size_t)8 * 256 * 256); float* KSUM = take(8 * 256);
    const size_t scratch0 = off;
    auto nb = [&](Op o) __attribute__((always_inline)) { o.code |= OPF_NOBAR; launch(o); };
    auto wt = [&](const float* W, int K, int N, int batch, nvbf* dst) __attribute__((always_inline)) { const int Np = nv_rup(N, 256), Kp = nv_rup(K, 128); Op o = mk(OP_WT, (long long)batch * Np * (Kp / 8)); o.a = W; o.o0 = (float*)dst; o.i0 = N; o.i1 = K; o.i2 = N; o.i3 = Np; o.i4 = Kp; nb(o); };
    wt(io.in[10], D, MIXIN, 2, WT_WIN); wt(io.in[21], 1024, D, 2, WT_WOUT); wt(io.in[23], D, D, 2, WT_WR); wt(io.in[24], D, D, 2, WT_WK); wt(io.in[25], D, D, 2, WT_WV); wt(io.in[26], D, D, 2, WT_WO);
    wt(io.in[28], D, 64, 2, WT_W1); wt(io.in[29], 64, D, 2, WT_W2); wt(io.in[31], D, 64, 2, WT_A1); wt(io.in[32], 64, D, 2, WT_A2); wt(io.in[36], D, 128, 2, WT_G1); wt(io.in[37], 128, D, 2, WT_G2);
    wt(io.in[34], D, 32, 1, WT_V1); wt(io.in[35], 32, D, 1, WT_V2); wt(io.in[43], D, 2048, 4, WT_WQ);
    for (int jj = 0; jj < 2; ++jj) { Op o = mk(OP_PRM, (long long)6 * D); o.a = io.in[27] + (size_t)jj * D; o.b = io.in[30] + (size_t)jj * D; o.c = jj > 0 ? io.in[33] + (size_t)(jj - 1) * D : nullptr; o.d = io.in[38] + (size_t)jj * D; o.e = io.in[39] + (size_t)jj * D; o.f = io.in[40] + (size_t)jj * RH * 64; o.o0 = PRM + (size_t)jj * 6 * D; nb(o); }
    for (int jj = 0; jj < 2; ++jj) { Op o = mk(OP_WGATE, 1024); o.a = io.in[16] + (size_t)jj * 8 * 64 * 64; o.b = io.in[18] + (size_t)jj * 8 * 64 * 64; o.c = io.in[20] + (size_t)jj * 512; o.o0 = (float*)(WT_WG + (size_t)jj * 1024 * 512); o.o1 = SPL + (size_t)jj * 512; nb(o); }
    auto fgemm = [&](const nvbf* Wt, float* C, int ldc, int N, int K, int bf16out = 0) __attribute__((always_inline)) {
        const int Kp = nv_rup(K, 128), Np = nv_rup(N, 256);
        Op o = mk(OP_FGEMM, (long long)M * N); o.a = (const float*)ABF; o.b = (const float*)Wt; o.o0 = C; o.i0 = N; o.i1 = Kp; o.i2 = Kp; o.i3 = Kp; o.i4 = ldc; o.i5 = Np; o.i6 = bf16out; launch(o); };
    auto gemm = [&](const float* A, int lda, const nvbf* Wt, float* C, int ldc, int N, int K, int act) __attribute__((always_inline)) {
        const int Kp = nv_rup(K, 128);
        { Op o = mk(OP_CVT8, (long long)Mp * (Kp / 8)); o.a = A; o.o0 = (float*)ABF; o.i0 = K; o.i1 = lda; o.i2 = Kp; o.i3 = act; launch(o); }
        fgemm(Wt, C, ldc, N, K); };
    { Op o = mk(OP_EMBED4, (long long)MD / 4); o.a = io.in[0]; o.b = io.in[1]; o.c = io.in[7]; o.o0 = X; o.o1 = (float*)ABF; launch(o); }
    const float* const w_outer = w; float* const out_outer = io.out;
    for (int layer = 0; layer < 4; ++layer) {
        float* wl = (float*)w_outer; float* ol = out_outer; NV_LAUNDER(wl); NV_LAUNDER(ol);
#define NV_RB(T, v) T const v##_rb = (T)((char*)wl + ((const char*)(v) - (const char*)w_outer))
#define NV_RO(v) float* const v##_rb = (float*)((char*)ol + ((const char*)(v) - (const char*)out_outer))
        NV_RB(float*, X); NV_RB(float*, VFIRST); NV_RB(float*, MOUT); NV_RB(nvbf*, ABF); NV_RB(nvbf*, WT_WIN); NV_RB(nvbf*, WT_WOUT); NV_RB(nvbf*, WT_WR); NV_RB(nvbf*, WT_WK); NV_RB(nvbf*, WT_WV); NV_RB(nvbf*, WT_WO);
        NV_RB(nvbf*, WT_W1); NV_RB(nvbf*, WT_W2); NV_RB(nvbf*, WT_A1); NV_RB(nvbf*, WT_A2); NV_RB(nvbf*, WT_G1); NV_RB(nvbf*, WT_G2); NV_RB(nvbf*, WT_V1); NV_RB(nvbf*, WT_V2); NV_RB(nvbf*, WT_WQ); NV_RB(nvbf*, WT_WG);
        NV_RB(float*, SPL); NV_RB(float*, PRM); NV_RB(nvbf*, UB); NV_RB(nvbf*, VB); NV_RB(nvbf*, KB); NV_RB(float*, KSUM);
        NV_RO(p_gla); NV_RO(p_h); NV_RO(p_conv); NV_RO(p_rwkv); NV_RO(p_shift); NV_RO(s_gla); NV_RO(s_h); NV_RO(s_conv); NV_RO(s_rwkv); NV_RO(s_shift);
#undef NV_RB
#undef NV_RO
        { float* const X = X_rb; float* const VFIRST = VFIRST_rb; float* const MOUT = MOUT_rb; nvbf* const ABF = ABF_rb; nvbf* const WT_WIN = WT_WIN_rb; nvbf* const WT_WOUT = WT_WOUT_rb; nvbf* const WT_WR = WT_WR_rb; nvbf* const WT_WK = WT_WK_rb;
          nvbf* const WT_WV = WT_WV_rb; nvbf* const WT_WO = WT_WO_rb; nvbf* const WT_W1 = WT_W1_rb; nvbf* const WT_W2 = WT_W2_rb; nvbf* const WT_A1 = WT_A1_rb; nvbf* const WT_A2 = WT_A2_rb; nvbf* const WT_G1 = WT_G1_rb; nvbf* const WT_G2 = WT_G2_rb;
          nvbf* const WT_V1 = WT_V1_rb; nvbf* const WT_V2 = WT_V2_rb; nvbf* const WT_WQ = WT_WQ_rb; nvbf* const WT_WG = WT_WG_rb; float* const SPL = SPL_rb; float* const PRM = PRM_rb; nvbf* const UB = UB_rb; nvbf* const VB = VB_rb; nvbf* const KB = KB_rb; float* const KSUM = KSUM_rb;
          float* const p_gla = p_gla_rb; float* const p_h = p_h_rb; float* const p_conv = p_conv_rb; float* const p_rwkv = p_rwkv_rb; float* const p_shift = p_shift_rb; float* const s_gla = s_gla_rb; float* const s_h = s_h_rb; float* const s_conv = s_conv_rb;
          float* const s_rwkv = s_rwkv_rb; float* const s_shift = s_shift_rb; float* const w = wl; (void)SPL; (void)WT_WG; (void)VFIRST;
        const int j = layer / 2; off = scratch0;
        { Op o = mk(OP_CVTTAB8S, (long long)16384 * D / 16); o.a = io.in[45] + (size_t)layer * 16384 * D; o.o0 = (float*)UB; o.i0 = 7; nb(o); }
        { Op o = mk(OP_CVTTAB8S, (long long)16384 * D / 16); o.a = io.in[46] + (size_t)layer * 16384 * D; o.o0 = (float*)VB; o.i0 = 6; nb(o); }
        { Op o = mk(OP_KEYS, 8 * 256); o.a = io.in[44] + (size_t)layer * 8 * 2 * 128 * 128; o.o0 = (float*)KB; o.o1 = KSUM; nb(o); }
        if (layer % 2 == 0) {
            float* PROJ = take((size_t)M * MIXIN); float* LOGA = take((size_t)M * 256); float* O = take((size_t)M * 512); float* MIXO = (float*)ABF;
            float* XC = take((size_t)M * 512); nvbf* XCB = takeh((size_t)Mp * 512); float* AT = take((size_t)M * 512); float* BT = take((size_t)M * 512);
            const int NC = (dm.T + 63) / 64; float* LEND = take((size_t)B * 4 * NC * 8192); float* DEC = take((size_t)B * 4 * NC * 64); float* LA = take((size_t)B * NC * 512); float* LB = take((size_t)B * NC * 512);
            fgemm(WT_WIN + (size_t)j * SZ_WIN, PROJ, MIXIN, MIXIN, D);
            { Op o = mk(OP_LOGA4, (long long)M * 64); o.a = PROJ; o.b = io.in[11] + (size_t)j * 16 * 256; o.c = io.in[12] + (size_t)j * 256; o.o0 = LOGA; nb(o); }
            { Op o = mk(OP_CONV4, (long long)M * 128); o.a = PROJ; o.b = io.in[4] + (size_t)j * DB * 3 * 512; o.c = io.in[14] + (size_t)j * 4 * 512; o.d = io.in[15] + (size_t)j * 512; o.o0 = XC; o.o1 = (float*)XCB; nb(o); }
            { Op o = mk(OP_CONVOUT, (long long)dm.NSEQ * 1536); o.a = PROJ; o.b = io.in[4] + (size_t)j * DB * 3 * 512; o.o1 = p_conv + (size_t)j * B * 3 * 512; o.o2 = s_conv + (size_t)j * DB * 3 * 512; launch(o); }
            { Op o = mk(OP_GLAF, (long long)B * 512); o.a = PROJ; o.b = LOGA; o.o0 = O; o.o1 = p_gla + (size_t)j * B * 4 * 64 * 128; nb(o); }
            { Op o = mk(OP_GLA3, (long long)(DB * 4) * 128); o.a = PROJ; o.b = LOGA; o.c = io.in[2] + (size_t)j * DB * 4 * 64 * 128; o.d = LEND; o.o0 = O; o.o2 = s_gla + (size_t)j * DB * 4 * 64 * 128; o.i0 = NC; o.i1 = 1; nb(o); }
            { Op o = mk(OP_LRUG2, (long long)M * 512); o.a = (const float*)XCB; o.b = (const float*)(WT_WG + (size_t)j * 1024 * 512); o.c = io.in[17] + (size_t)j * 512; o.d = io.in[19] + (size_t)j * 512; o.e = SPL + (size_t)j * 512; o.f = XC; o.o0 = AT; o.o1 = BT; launch(o); }
            { Op o = mk(OP_GLANORM, (long long)M * 4); o.a = O; o.b = PROJ; o.c = io.in[13] + (size_t)j * 128; o.o0 = MIXO; nb(o); }
            { Op o = mk(OP_LRU1, (long long)B * NC * 512); o.a = AT; o.b = BT; o.o0 = LA; o.o1 = LB; o.i0 = NC; launch(o); }
            { Op o = mk(OP_LRU2, (long long)B * 512); o.a = LA; o.o0 = LB; o.o1 = p_h + (size_t)j * B * 512; o.i0 = NC; launch(o); }
            { Op o = mk(OP_LRU3, (long long)(B * NC + DB) * 512); o.a = AT; o.b = BT; o.c = PROJ; o.d = io.in[3] + (size_t)j * DB * 512; o.e = LB; o.o0 = MIXO; o.o2 = s_h + (size_t)j * DB * 512; o.i0 = NC; launch(o); }
            fgemm(WT_WOUT + (size_t)j * SZ_WOUT, MOUT, D, D, 1024, 1);
        } else {
            float* Y = take(MD); float* R = take(MD); float* K = take(MD); float* V = take(MD); float* G = take(MD); float* KK = take(MD);
            const size_t XMSZ = (size_t)Mp * D;
            float* WAV = take(3 * MD > 3 * XMSZ ? 3 * MD : 3 * XMSZ); float* Wd = WAV; float* Aa = WAV + MD; float* Vg = WAV + 2 * MD; nvbf* XM6 = (nvbf*)WAV;
            float* BON = take((size_t)M * RH); float* HLw = take((size_t)M * 64); float* HLa = take((size_t)M * 64); float* HLg = take((size_t)M * 128); float* HLv = take((size_t)M * 32);
            nvbf* ABw = takeh((size_t)Mp * 128); nvbf* ABa = takeh((size_t)Mp * 128); nvbf* ABg = takeh((size_t)Mp * 128); nvbf* ABv = takeh((size_t)Mp * 128);
            const float* shin = io.in[6] + (size_t)j * DB * D; const float* mu = io.in[22] + (size_t)j * 6 * D;
            { Op o = mk(OP_SHIFTOUT, (long long)dm.NSEQ * D); o.a = X; o.o1 = p_shift + (size_t)j * B * D; o.o2 = s_shift + (size_t)j * DB * D; nb(o); }
            { Op o = mk(OP_MIX6, (long long)MD / 8); o.a = X; o.b = shin; o.c = mu; o.o0 = (float*)XM6; o.i1 = (int)(XMSZ / 1024); launch(o); }
            auto gg = [&](const nvbf* A, const nvbf* Wt, float* C, int ldc, int N, int K, bool last, int bf16out = 0) __attribute__((always_inline)) { const int Kp = nv_rup(K, 128), Np = nv_rup(N, 256);
                Op o = mk(OP_FGEMM, (long long)M * N); o.a = (const float*)A; o.b = (const float*)Wt; o.o0 = C; o.i0 = N; o.i1 = Kp; o.i2 = Kp; o.i3 = Kp; o.i4 = ldc; o.i5 = Np; o.i6 = bf16out; if (!last) o.code |= OPF_GROUP; launch(o); };
            gg(XM6 + 0 * XMSZ, WT_WR + (size_t)j * SZ_DD, R, D, D, D, false, 1); gg(XM6 + 2 * XMSZ, WT_WK + (size_t)j * SZ_DD, K, D, D, D, false, 1); gg(XM6 + 3 * XMSZ, WT_WV + (size_t)j * SZ_DD, V, D, D, D, false, 1);
            gg(XM6 + 1 * XMSZ, WT_W1 + (size_t)j * SZ_DN, HLw, 64, 64, D, false); gg(XM6 + 4 * XMSZ, WT_A1 + (size_t)j * SZ_DN, HLa, 64, 64, D, false);
            if (j > 0) gg(XM6 + 3 * XMSZ, WT_V1 + (size_t)(j - 1) * SZ_DN, HLv, 32, 32, D, false);
            gg(XM6 + 5 * XMSZ, WT_G1 + (size_t)j * SZ_DN, HLg, 128, 128, D, true);
            auto cv = [&](const float* A, int K, nvbf* dst, int act, bool last) __attribute__((always_inline)) { Op o = mk(OP_CVT8, (long long)Mp * 16); o.a = A; o.o0 = (float*)dst; o.i0 = K; o.i1 = K; o.i2 = 128; o.i3 = act; if (last) launch(o); else nb(o); };
            cv(HLw, 64, ABw, 1, false); cv(HLa, 64, ABa, 0, false); if (j > 0) cv(HLv, 32, ABv, 0, false); cv(HLg, 128, ABg, 2, true);
            gg(ABw, WT_W2 + (size_t)j * SZ_UP, Wd, D, D, 64, false, 1); gg(ABa, WT_A2 + (size_t)j * SZ_UP, Aa, D, D, 64, false, 1); if (j > 0) gg(ABv, WT_V2 + (size_t)(j - 1) * SZ_UP, Vg, D, D, 32, false, 1); gg(ABg, WT_G2 + (size_t)j * SZ_UP, G, D, D, 128, true, 1);
            { Op o = mk(OP_WKVP, (long long)dm.NSEQ * RH * 64); o.a = R; o.b = K; o.c = Wd; o.d = Aa; o.e = V; o.f = Vg; o.g = VFIRST; o.h = PRM + (size_t)j * 6 * D; o.o0 = Y; o.o1 = p_rwkv + (size_t)j * B * RH * 4096; o.o2 = s_rwkv + (size_t)j * DB * RH * 4096;
              o.o3 = j > 0 ? KK : VFIRST; o.o4 = BON; o.o5 = (float*)(io.in[5] + (size_t)j * DB * RH * 4096); o.i0 = j > 0 ? 1 : 0; launch(o); }
            { Op o = mk(OP_POST2, (long long)M * RH); o.a = Y; o.b = G; o.c = j > 0 ? KK : VFIRST; o.d = BON; o.e = io.in[41] + (size_t)j * D; o.f = io.in[42] + (size_t)j * D; o.o0 = (float*)ABF; launch(o); }
            fgemm(WT_WO + (size_t)j * SZ_DD, MOUT, D, D, D, 1);
        }
        { Op o = mk(OP_LNRES, M); o.a = MOUT; o.b = io.in[8] + (size_t)(layer * 2 + 0) * D; o.c = io.in[9] + (size_t)(layer * 2 + 0) * D; o.o0 = X; o.o1 = (float*)ABF; o.o2 = (float*)(ABF + ABFN); launch(o); }
        off = scratch0;
        { nvbf* Q = takeh((size_t)Mp * 2048); float* SC = take((size_t)M * 2048); float* GATE = take((size_t)M * 128); float* EIDX = take((size_t)M * 128); float* TMPV = take((size_t)M * 256); float* TMPI = take((size_t)M * 256);
          float* COEF = take((size_t)M * 128);
          { Op o = mk(OP_FGEMM, (long long)M * 2048); o.a = (const float*)ABF; o.b = (const float*)(WT_WQ + (size_t)layer * SZ_WQ); o.o0 = (float*)Q; o.i0 = 2048; o.i1 = Dk; o.i2 = Dk; o.i3 = Dk; o.i4 = 2048; o.i5 = 2048; o.i6 = 1; launch(o); }
          { Op o = mk(OP_FGEMM, (long long)M * 2048); o.a = (const float*)Q; o.b = (const float*)KB; o.o0 = SC; o.i0 = 2048; o.i1 = 256; o.i2 = 2048; o.i3 = 256; o.i4 = 2048; o.i5 = 2048; o.i6 = 2; launch(o); }
          { Op o = mk(OP_TOPK2, (long long)M * 8); o.a = SC; o.b = (const float*)Q; o.c = KSUM; o.o0 = GATE; o.o1 = EIDX; o.o2 = TMPV; o.o3 = TMPI; launch(o); }
          { const int NS = D / 128; float* PART = take((size_t)NS * M * 128); float* YBUF = take(MD);
            #ifdef PROBE_EMASK
            { Op o = mk(OP_PACTS, (long long)NS * M * 128); o.a = (const float*)(ABF + ABFN); o.b = (const float*)UB; o.d = EIDX; o.o0 = PART; o.i0 = PROBE_EMASK; launch(o); }
#endif
            { Op o = mk(OP_PACTS, (long long)NS * M * 128); o.a = (const float*)(ABF + ABFN); o.b = (const float*)UB; o.d = EIDX; o.o0 = PART; o.i0 = 16383; launch(o); }
            { Op o = mk(OP_PRED, (long long)M * 128); o.a = PART; o.c = GATE; o.o0 = COEF; o.i0 = NS; launch(o); }
            { Op o = mk(OP_POUTS, (long long)MD); o.a = COEF; o.b = EIDX; o.c = (const float*)VB; o.o0 = YBUF; launch(o); }
            { Op o = mk(OP_LNRES, M); o.a = YBUF; o.b = io.in[8] + (size_t)(layer * 2 + 1) * D; o.c = io.in[9] + (size_t)(layer * 2 + 1) * D; o.o0 = X; o.o1 = (float*)ABF; launch(o); } } }
        }
    }
    { Op o = mk(OP_YOUT4, (long long)MD / 4); o.a = X; o.o0 = y_prompt; launch(o); }
    (void)y_sample;
}

#include <cstdint>
namespace pg8 {
#define PG8_LAS __attribute__((address_space(3)))
typedef unsigned short bf16_t;
typedef short bf16x8 __attribute__((ext_vector_type(8)));
typedef float f32x4 __attribute__((ext_vector_type(4)));
typedef unsigned u32x4 __attribute__((ext_vector_type(4)));
constexpr int BM = 256, BK = 64, HALF = 128, HTB = HALF * BK * 2  , STAGE_BYTES = 8 * HTB, NXCD = 8, WGM = 8;

__host__ __device__ __forceinline__ int lds_byte(int r, int c) { const int st = (r >> 4) * 2 + (c >> 5), rr = r & 15, cc = c & 31, ob = rr * 64 + cc * 2; return st * 1024 + (ob ^ (((ob >> 9) & 1) << 5)); }
__host__ __device__ __forceinline__ void stage_rc(int b, int& R, int& C) { const int st = b / 1024, sb = b % 1024, swz = sb ^ (((sb >> 9) & 1) << 5); R = (st >> 1) * 16 + swz / 64; C = (st & 1) * 32 + (swz % 64) / 2; }
__host__ __device__ __forceinline__ int perm32(int rho) { const int n = rho >> 4, i = rho & 15; return 8 * (i >> 2) + 4 * n + (i & 3); }

struct Unit { int pm, pn, grp, pad_; const char* A; const char* B; };
struct Gemm { const bf16_t* A; const bf16_t* Bt; int M, N, K, lda, ldb; };

struct StaticOrder {
    int nM, nN, nwg, G, c; const char* A; const char* B; size_t tsA, tsB, acs;
    __host__ __device__ void init(const Gemm& g, int G_, int c_) { nM = g.M / BM; nN = g.N / BM; nwg = nM * nN; G = G_; c = c_; A = (const char*)g.A; B = (const char*)g.Bt; tsA = (size_t)BM * g.lda * 2; tsB = (size_t)BM * g.ldb * 2; acs = 0; }
    __host__ __device__ bool next(int i, Unit& u) const {
        const long L = (long)i * G + c; if (L >= nwg) return false;
        int wgid = (int)L; { const int q = nwg / NXCD, r = nwg % NXCD, xcd = wgid % NXCD, off = wgid / NXCD; wgid = (xcd < r ? xcd * (q + 1) : r * (q + 1) + (xcd - r) * q) + off; }
        const int nig = WGM * nN, gid = wgid / nig, fm = gid * WGM, gsz = (nM - fm) < WGM ? (nM - fm) : WGM;
        u.pm = fm + ((wgid % nig) % gsz); u.pn = (wgid % nig) / gsz; u.grp = 0; u.pad_ = 0; u.A = A + (size_t)u.pm * tsA + (size_t)u.pn * acs; u.B = B + (size_t)u.pn * tsB; return true;
    }
    __device__ __forceinline__ void a_ready(const Unit&) const {}
    __device__ __forceinline__ void done(const Unit&) const {}
};

template <class Epi, class Sched, bool ALIGN_EPI = false, bool SP2 = false>
__device__ __forceinline__ void gemm_phase(PG8_LAS unsigned char* lds, const Gemm g, const Sched& S, const Epi& E) {
    int tid_raw = threadIdx.x; asm volatile("" : "+v"(tid_raw));
    const int tid = tid_raw, wid = __builtin_amdgcn_readfirstlane(tid >> 6), lane = tid & 63, wr = wid >> 2, wc = wid & 3, fr = lane & 15, fq = lane >> 4;
    const int K = g.K, nt = K / BK;
    unsigned voffA[2], voffB[2];
#pragma unroll
    for (int i = 0; i < 2; ++i) { int R, C; stage_rc(tid * 16 + i * 8192, R, C); const int Rb = Epi::PERM ? ((R & ~31) + perm32(R & 31)) : R;
        voffA[i] = (unsigned)(R * g.lda + C) * 2u; voffB[i] = (unsigned)(Rb * g.ldb + C) * 2u; }
    const size_t kstep = (size_t)(BK * 2);
    const size_t hstepA = (size_t)HALF * g.lda * 2, hstepB = (size_t)HALF * g.ldb * 2;
    const unsigned ldsw = (unsigned)wid * 1024u;
    const int aoff = lds_byte(wr * 64 + fr, fq * 8), boff = lds_byte(wc * 32 + fr, fq * 8);
#define PG8_SA(b, h) (((b) * 2 + (h)) * HTB)
#define PG8_SB(b, h) ((4 + (b) * 2 + (h)) * HTB)
#define PG8_STAGE(bufoff, gbase, voff) do { _Pragma("unroll") for (int _i = 0; _i < 2; ++_i) \
        __builtin_amdgcn_global_load_lds((const unsigned*)((const char*)(gbase) + (voff)[_i]), (PG8_LAS unsigned*)(lds + (bufoff) + ldsw + _i * 8192), 16, 0, 0); } while (0)
#define PG8_LDA(dst, b, h) do { _Pragma("unroll") for (int m = 0; m < 4; ++m) _Pragma("unroll") for (int k = 0; k < 2; ++k) dst[m][k] = *(const PG8_LAS bf16x8*)(lds + PG8_SA(b, h) + aoff + m * 2048 + k * 1024); } while (0)
#define PG8_LDB(dst, b, h) do { _Pragma("unroll") for (int n = 0; n < 2; ++n) _Pragma("unroll") for (int k = 0; k < 2; ++k) dst[n][k] = *(const PG8_LAS bf16x8*)(lds + PG8_SB(b, h) + boff + n * 2048 + k * 1024); } while (0)
#define PG8_MMA(ai, bj, At, Bt) do { __builtin_amdgcn_s_setprio(1); _Pragma("unroll") for (int m = 0; m < 4; ++m) _Pragma("unroll") for (int n = 0; n < 2; ++n) _Pragma("unroll") for (int k = 0; k < 2; ++k) \
        acc[ai][bj][m][n] = __builtin_amdgcn_mfma_f32_16x16x32_bf16(Bt[n][k], At[m][k], acc[ai][bj][m][n], 0, 0, 0); __builtin_amdgcn_s_setprio(0); } while (0)
#define PG8_WAIT_V(n) asm volatile("s_waitcnt vmcnt(" #n ")" ::: "memory")
#define PG8_WAIT_L(n) asm volatile("s_waitcnt lgkmcnt(" #n ")" ::: "memory")
#define PG8_BAR __builtin_amdgcn_s_barrier()
#define PG8_SCHED __builtin_amdgcn_sched_barrier(0)
    Unit cur, nxt; int ui = 0;
    if (!S.next(0, cur)) return;
    f32x4 acc[2][2][4][2];
#pragma unroll
    for (int a = 0; a < 2; ++a)
#pragma unroll
        for (int b = 0; b < 2; ++b)
#pragma unroll
            for (int m = 0; m < 4; ++m)
#pragma unroll
                for (int n = 0; n < 2; ++n) acc[a][b][m][n] = (f32x4){0.f, 0.f, 0.f, 0.f};
    bf16x8 At[4][2], B0[2][2], B1[2][2];
    const char* cA = cur.A; const char* cB = cur.B;
    S.a_ready(cur);
    if constexpr (SP2) {
        PG8_STAGE(PG8_SB(0, 0), cB, voffB); PG8_STAGE(PG8_SB(0, 1), cB + hstepB, voffB); PG8_STAGE(PG8_SA(0, 0), cA, voffA); PG8_STAGE(PG8_SA(0, 1), cA + hstepA, voffA);
        if (wr == 1) PG8_BAR;
        PG8_WAIT_V(2); PG8_BAR;
        PG8_STAGE(PG8_SB(1, 0), cB + kstep, voffB); PG8_STAGE(PG8_SA(1, 0), cA + kstep, voffA); PG8_STAGE(PG8_SB(1, 1), cB + hstepB + kstep, voffB);
        PG8_WAIT_V(6); PG8_BAR;
    } else {
        PG8_STAGE(PG8_SB(0, 0), cB, voffB); PG8_STAGE(PG8_SA(0, 0), cA, voffA); PG8_STAGE(PG8_SB(0, 1), cB + hstepB, voffB); PG8_STAGE(PG8_SA(0, 1), cA + hstepA, voffA);
        if (wr == 1) PG8_BAR;
        PG8_WAIT_V(4); PG8_BAR;
        PG8_STAGE(PG8_SB(1, 0), cB + kstep, voffB); PG8_STAGE(PG8_SA(1, 0), cA + kstep, voffA); PG8_STAGE(PG8_SB(1, 1), cB + hstepB + kstep, voffB);
        PG8_WAIT_V(6); PG8_BAR;
    }
    for (;;) {
        const bool has_next = S.next(ui + 1, nxt);
        const char* nA = has_next ? nxt.A : cA; const char* nB = has_next ? nxt.B : cB;
        for (int t = 0; t < nt; t += 2) {
            const bool last = (t == nt - 2);
            const char* a1 = cA + (size_t)(t + 1) * kstep;
            const char* a2 = last ? nA : cA + (size_t)(t + 2) * kstep; const char* b2 = last ? nB : cB + (size_t)(t + 2) * kstep;
            const char* a3 = a2 + kstep; const char* b3 = b2 + kstep;
            if (last && has_next) S.a_ready(nxt);
            if constexpr (SP2) {
            PG8_LDB(B0, 0, 0); PG8_LDB(B1, 0, 1); PG8_SCHED; PG8_LDA(At, 0, 0); PG8_STAGE(PG8_SA(1, 1), a1 + hstepA, voffA);
            PG8_WAIT_V(8); PG8_WAIT_L(0); PG8_BAR; PG8_MMA(0, 0, At, B0); PG8_MMA(0, 1, At, B1); PG8_BAR; PG8_SCHED;
            PG8_LDA(At, 0, 1); PG8_STAGE(PG8_SB(0, 0), b2, voffB); PG8_STAGE(PG8_SB(0, 1), b2 + hstepB, voffB); PG8_STAGE(PG8_SA(0, 0), a2, voffA);
            PG8_WAIT_V(8); PG8_WAIT_L(0); PG8_BAR; PG8_MMA(1, 0, At, B0); PG8_MMA(1, 1, At, B1); PG8_BAR; PG8_SCHED;
            PG8_LDB(B0, 1, 0); PG8_LDB(B1, 1, 1); PG8_SCHED; PG8_LDA(At, 1, 0); PG8_STAGE(PG8_SA(0, 1), a2 + hstepA, voffA);
            PG8_WAIT_V(8); PG8_WAIT_L(0); PG8_BAR; PG8_MMA(0, 0, At, B0); PG8_MMA(0, 1, At, B1); PG8_BAR; PG8_SCHED;
            PG8_LDA(At, 1, 1); PG8_STAGE(PG8_SB(1, 0), b3, voffB); PG8_STAGE(PG8_SB(1, 1), b3 + hstepB, voffB); PG8_STAGE(PG8_SA(1, 0), a3, voffA);
            PG8_WAIT_V(8); PG8_WAIT_L(0); PG8_BAR; PG8_MMA(1, 0, At, B0); PG8_MMA(1, 1, At, B1); PG8_BAR; PG8_SCHED;
            } else {
            PG8_LDB(B0, 0, 0); PG8_SCHED; PG8_LDA(At, 0, 0); PG8_STAGE(PG8_SA(1, 1), a1 + hstepA, voffA);
            PG8_WAIT_L(8); PG8_BAR; PG8_WAIT_L(0); PG8_MMA(0, 0, At, B0); PG8_BAR; PG8_SCHED;
            PG8_LDB(B1, 0, 1); PG8_STAGE(PG8_SB(0, 0), b2, voffB);
            PG8_BAR; PG8_WAIT_L(0); PG8_MMA(0, 1, At, B1); PG8_BAR;
            PG8_LDA(At, 0, 1); PG8_STAGE(PG8_SA(0, 0), a2, voffA);
            PG8_BAR; PG8_WAIT_L(0); PG8_MMA(1, 0, At, B0); PG8_BAR; PG8_SCHED;
            PG8_STAGE(PG8_SB(0, 1), b2 + hstepB, voffB);
            PG8_WAIT_V(6); PG8_BAR; PG8_MMA(1, 1, At, B1); PG8_BAR;
            PG8_LDB(B0, 1, 0); PG8_SCHED; PG8_LDA(At, 1, 0); PG8_STAGE(PG8_SA(0, 1), a2 + hstepA, voffA);
            PG8_WAIT_L(8); PG8_BAR; PG8_WAIT_L(0); PG8_MMA(0, 0, At, B0); PG8_BAR; PG8_SCHED;
            PG8_LDB(B1, 1, 1); PG8_STAGE(PG8_SB(1, 0), b3, voffB);
            PG8_BAR; PG8_WAIT_L(0); PG8_MMA(0, 1, At, B1); PG8_BAR;
            PG8_LDA(At, 1, 1); PG8_STAGE(PG8_SA(1, 0), a3, voffA);
            PG8_BAR; PG8_WAIT_L(0); PG8_MMA(1, 0, At, B0); PG8_BAR; PG8_SCHED;
            PG8_STAGE(PG8_SB(1, 1), b3 + hstepB, voffB);
            PG8_WAIT_V(6); PG8_BAR; PG8_MMA(1, 1, At, B1); PG8_BAR;
            }
        }
        if constexpr (ALIGN_EPI) { if (wr == 0) PG8_BAR; }
        if constexpr (!Epi::AFTER_DRAIN) { E(acc, cur, wr, wc, fr, fq); S.done(cur); }
        if (!has_next) break;
#pragma unroll
        for (int a = 0; a < 2; ++a)
#pragma unroll
            for (int b = 0; b < 2; ++b)
#pragma unroll
                for (int m = 0; m < 4; ++m)
#pragma unroll
                    for (int n = 0; n < 2; ++n) acc[a][b][m][n] = (f32x4){0.f, 0.f, 0.f, 0.f};
        cur = nxt; cA = nA; cB = nB; ++ui;
        if constexpr (ALIGN_EPI) { if (wr == 1) PG8_BAR; }
    }
    PG8_WAIT_V(0);
    if constexpr (!ALIGN_EPI) { if (wr == 0) PG8_BAR; }
    PG8_BAR;
    if constexpr (Epi::AFTER_DRAIN) { E.fused(acc, cur, wr, wc, fr, fq, lds, wid, lane); S.done(cur); }
#undef PG8_SA
#undef PG8_SB
#undef PG8_STAGE
#undef PG8_LDA
#undef PG8_LDB
#undef PG8_MMA
#undef PG8_WAIT_V
#undef PG8_WAIT_L
#undef PG8_BAR
#undef PG8_SCHED
}
}
template <class T> __device__ __forceinline__ T* uni_ptr(T* p) {
    unsigned long long v = (unsigned long long)p; unsigned lo = __builtin_amdgcn_readfirstlane((unsigned)v), hi = __builtin_amdgcn_readfirstlane((unsigned)(v >> 32));
    unsigned long long r = ((unsigned long long)hi << 32) | lo; asm volatile("" : "+s"(r)); return (T*)r; }
__device__ __forceinline__ int rfl(int x) { int t = __builtin_amdgcn_readfirstlane(x); asm volatile("" : "+s"(t)); return t; }
namespace pg8 {
__device__ __forceinline__ unsigned cvt_pk_bf16(float lo, float hi) { unsigned r; asm volatile("v_cvt_pk_bf16_f32 %0, %1, %2" : "=v"(r) : "v"(lo), "v"(hi)); return r; }
struct EpiF32 {
    static constexpr bool PERM = false, AFTER_DRAIN = false;
    float* C; int ldc, Mreal, Nreal;
    __device__ __forceinline__ void operator()(const f32x4 (&acc)[2][2][4][2], const Unit& u, int wr, int wc, int fr, int fq) const {
        const int row0 = u.pm * BM + wr * 64 + fr, col0 = u.pn * BM + wc * 32 + 4 * fq;
#pragma unroll
        for (int ai = 0; ai < 2; ++ai)
#pragma unroll
            for (int m = 0; m < 4; ++m) { const int r = row0 + ai * HALF + m * 16; if (r < Mreal) { float* rowp = C + (size_t)r * ldc + col0;
#pragma unroll
                for (int bj = 0; bj < 2; ++bj)
#pragma unroll
                    for (int n = 0; n < 2; ++n) { const int c = col0 + bj * HALF + n * 16; if (c < Nreal) *(f32x4*)(rowp + bj * HALF + n * 16) = acc[ai][bj][m][n]; } } }
    }
};
struct EpiBf16Plain {
    static constexpr bool PERM = true, AFTER_DRAIN = false;
    bf16_t* O; int ldc;
    __device__ __forceinline__ void operator()(const f32x4 (&acc)[2][2][4][2], const Unit& u, int wr, int wc, int fr, int fq) const {
        const int row0 = u.pm * BM + wr * 64 + fr, col0 = u.pn * BM + wc * 32 + 8 * fq;
#pragma unroll
        for (int ai = 0; ai < 2; ++ai)
#pragma unroll
            for (int m = 0; m < 4; ++m) { bf16_t* rowp = O + (size_t)(row0 + ai * HALF + m * 16) * ldc + col0;
#pragma unroll
                for (int bj = 0; bj < 2; ++bj) { const f32x4 v0 = acc[ai][bj][m][0], v1 = acc[ai][bj][m][1]; u32x4 w;
                    w.x = cvt_pk_bf16(v0[0], v0[1]); w.y = cvt_pk_bf16(v0[2], v0[3]); w.z = cvt_pk_bf16(v1[0], v1[1]); w.w = cvt_pk_bf16(v1[2], v1[3]);
                    *(u32x4*)(rowp + bj * HALF) = w; } }
    }
};
struct EpiLru {
    static constexpr bool PERM = false, AFTER_DRAIN = false;
    const float* ba; const float* bx; const float* spl; const float* XC; float* AT; float* BT; int Mreal;
    __device__ __forceinline__ void operator()(const f32x4 (&acc)[2][2][4][2], const Unit& u, int wr, int wc, int fr, int fq) const {
        const int row0 = u.pm * BM + wr * 64 + fr, ch0 = u.pn * 128 + wc * 32 + 4 * fq;
#pragma unroll
        for (int n = 0; n < 2; ++n) { const int c = ch0 + 16 * n; const f32x4 ba4 = *(const f32x4*)(ba + c), bx4 = *(const f32x4*)(bx + c), sp4 = *(const f32x4*)(spl + c);
#pragma unroll
            for (int ai = 0; ai < 2; ++ai)
#pragma unroll
                for (int m = 0; m < 4; ++m) { const int r = row0 + ai * HALF + m * 16; if (r < Mreal) { const f32x4 xc = *(const f32x4*)(XC + (size_t)r * 512 + c); const f32x4 ga = acc[ai][0][m][n] + ba4, gx = acc[ai][1][m][n] + bx4; f32x4 at, bt;
#pragma unroll
                    for (int i = 0; i < 4; ++i) { const float gate_a = 1.f / (1.f + __expf(-ga[i])), gate_x = 1.f / (1.f + __expf(-gx[i])); const float la = gate_a * sp4[i]; at[i] = __expf(la); bt[i] = sqrtf(-expm1f(2.f * la)) * (gate_x * xc[i]); }
                    *(f32x4*)(AT + (size_t)r * 512 + c) = at; *(f32x4*)(BT + (size_t)r * 512 + c) = bt; } } }
    }
};
struct GroupOrder {
    const PG8_LAS Op* tab; int ng, nM, G, c; size_t tsA, tsB;
    __device__ __forceinline__ bool next(int i, Unit& u) const {
        int L = i * G + c, g = 0;
        for (; g < ng; ++g) { const int cnt = nM * (__builtin_amdgcn_readfirstlane(tab[g].i5) >> 8); if (L < cnt) break; L -= cnt; }
        if (g >= ng) return false;
        u.pm = L % nM; u.pn = L / nM; u.grp = g; u.pad_ = 0;
        u.A = (const char*)uni_ptr(tab[g].a) + (size_t)u.pm * tsA; u.B = (const char*)uni_ptr(tab[g].b) + (size_t)u.pn * tsB; return true;
    }
    __device__ __forceinline__ void a_ready(const Unit&) const {}
    __device__ __forceinline__ void done(const Unit&) const {}
};
struct EpiGroup {
    static constexpr bool PERM = true, AFTER_DRAIN = false;
    const PG8_LAS Op* tab; int Mreal;
    __device__ __forceinline__ void operator()(const f32x4 (&acc)[2][2][4][2], const Unit& u, int wr, int wc, int fr, int fq) const {
        const int ldc = rfl(tab[u.grp].i4), Nreal = rfl(tab[u.grp].i0), fl = rfl(tab[u.grp].i6);
        if (fl & 1) { const EpiBf16Plain E{(bf16_t*)uni_ptr(tab[u.grp].o0), ldc}; E(acc, u, wr, wc, fr, fq); return; }
        float* C = uni_ptr(tab[u.grp].o0); const int row0 = u.pm * BM + wr * 64 + fr, col0 = u.pn * BM + wc * 32 + 8 * fq;
#pragma unroll
        for (int ai = 0; ai < 2; ++ai)
#pragma unroll
            for (int m = 0; m < 4; ++m) { const int r = row0 + ai * HALF + m * 16; if (r < Mreal) { float* rowp = C + (size_t)r * ldc + col0;
#pragma unroll
                for (int bj = 0; bj < 2; ++bj) { if (col0 + bj * HALF < Nreal) { *(f32x4*)(rowp + bj * HALF) = acc[ai][bj][m][0]; *(f32x4*)(rowp + bj * HALF + 4) = acc[ai][bj][m][1]; } } } }
    }
};
}

#define XB_TMO      128
#define XB_XCNT(j)  (256  + 64 * (j))
#define XB_XSUB(j)  (1280 + 64 * (j))
#define XB_XGEN(j)  (2304 + 64 * (j))
#define XB_TOP      3328
#define XB_TOPGEN   3392
#define XCD_BAR_WORDS 3456
#define XB_SPIN_CAP (1u << 18)
#define LAS __attribute__((address_space(3)))
__device__ __forceinline__ unsigned xb_ld(unsigned* p)              { return __hip_atomic_load(p, __ATOMIC_RELAXED, __HIP_MEMORY_SCOPE_AGENT); }
__device__ __forceinline__ unsigned xb_add(unsigned* p, unsigned v) { return __hip_atomic_fetch_add(p, v, __ATOMIC_RELAXED, __HIP_MEMORY_SCOPE_AGENT); }
__device__ __forceinline__ unsigned xb_xcc_id() { return (unsigned)__builtin_amdgcn_s_getreg((3 << 11) | 20) & 0xFu; }
#define XB_SPIN(cond, bar) do { unsigned _sp = 0; while (cond) { __builtin_amdgcn_s_sleep(1); \
    if ((++_sp & 255u) == 0u) { if (xb_ld(&(bar)[XB_TMO])) break; if (_sp > XB_SPIN_CAP) { atomicAdd(&(bar)[XB_TMO], 1u); break; } } } } while (0)
struct XcdBarrier { unsigned* bar; unsigned x; volatile LAS unsigned* st; };
__device__ __forceinline__ XcdBarrier xcd_barrier_post(unsigned* bar, volatile LAS unsigned* st) {
    XcdBarrier b; b.bar = bar; b.x = xb_xcc_id(); b.st = st;
    if (threadIdx.x == 0) (void)xb_add(&bar[XB_XCNT(b.x)], 1u);
    return b;
}
__device__ __forceinline__ void xcd_barrier_complete(unsigned* bar, unsigned x, unsigned& nloc, unsigned& nx) {
    const unsigned G = gridDim.x * gridDim.y * gridDim.z;
    unsigned sum, cnt, mine, sp = 0u;
    for (;;) {
        sum = 0u; cnt = 0u; mine = 0u;
#pragma unroll
        for (unsigned j = 0; j < 16; ++j) { const unsigned c = xb_ld(&bar[XB_XCNT(j)]); sum += c; cnt += (c > 0u) ? 1u : 0u; mine = (j == x) ? c : mine; }
        if (sum == G) break;
        __builtin_amdgcn_s_sleep(1);
        if ((++sp & 255u) == 0u) { if (xb_ld(&bar[XB_TMO])) break; if (sp > XB_SPIN_CAP) { atomicAdd(&bar[XB_TMO], 1u); break; } }
    }
    nloc = mine > 0u ? mine : 1u; nx = cnt > 0u ? cnt : 1u;
}
__device__ __forceinline__ void xcd_barrier(const XcdBarrier& b) {
    asm volatile("s_waitcnt vmcnt(0)" ::: "memory");
    __syncthreads();
    if (threadIdx.x == 0) {
        unsigned* bar = b.bar;
        __builtin_amdgcn_s_waitcnt(0);
        unsigned nloc = b.st[0], nx = b.st[1];
        if (nloc == 0u) { xcd_barrier_complete(bar, b.x, nloc, nx); b.st[0] = nloc; b.st[1] = nx; }
        const unsigned old = xb_add(&bar[XB_XSUB(b.x)], 1u);
        const unsigned gen = old / nloc;
        if (old + 1u == (gen + 1u) * nloc) {
            __builtin_amdgcn_fence(__ATOMIC_RELEASE, "agent");
            asm volatile("s_waitcnt vmcnt(0)" ::: "memory");
            const unsigned og = xb_add(&bar[XB_TOP], 1u);
            const unsigned tg = og / nx;
            if (og + 1u == (tg + 1u) * nx) xb_add(&bar[XB_TOPGEN], 1u);
            else XB_SPIN(xb_ld(&bar[XB_TOPGEN]) == tg, bar);
            __builtin_amdgcn_fence(__ATOMIC_ACQUIRE, "agent");
            xb_add(&bar[XB_XGEN(b.x)], 1u);
            asm volatile("s_waitcnt vmcnt(0)" ::: "memory");
        } else {
            XB_SPIN(xb_ld(&bar[XB_XGEN(b.x)]) == gen, bar);
            __builtin_amdgcn_fence(__ATOMIC_ACQUIRE, "agent");
            asm volatile("s_waitcnt vmcnt(0)" ::: "memory");
        }
    }
    __syncthreads();
}

namespace fk {
#define GAS __attribute__((address_space(1)))
typedef unsigned u32x4 __attribute__((ext_vector_type(4)));
typedef unsigned u32x2 __attribute__((ext_vector_type(2)));
typedef float f32x4 __attribute__((ext_vector_type(4)));
typedef float f32x2 __attribute__((ext_vector_type(2)));
typedef __bf16 bf2 __attribute__((ext_vector_type(2)));
typedef unsigned short bf16_t;
__device__ __forceinline__ float bflo(unsigned u) { return __uint_as_float(u << 16); }
__device__ __forceinline__ float bfhi(unsigned u) { return __uint_as_float(u & 0xffff0000u); }
__device__ __forceinline__ float dot2(unsigned a, unsigned b, float c) { return __builtin_amdgcn_fdot2_f32_bf16(__builtin_bit_cast(bf2, a), __builtin_bit_cast(bf2, b), c, false); }
__device__ __forceinline__ unsigned pk_bf16(float lo, float hi) { unsigned r; asm volatile("v_cvt_pk_bf16_f32 %0, %1, %2" : "=v"(r) : "v"(lo), "v"(hi)); return r; }
template <int CTRL> __device__ __forceinline__ float dppf(float v) { return __int_as_float(__builtin_amdgcn_update_dpp(0, __float_as_int(v), CTRL, 0xf, 0xf, true)); }
__device__ __forceinline__ float row_max16(float v) { v = fmaxf(v, dppf<0xB1>(v)); v = fmaxf(v, dppf<0x4E>(v)); v = fmaxf(v, dppf<0x141>(v)); v = fmaxf(v, dppf<0x140>(v)); return v; }
__device__ __forceinline__ float row_sum16(float v) { v += dppf<0xB1>(v); v += dppf<0x4E>(v); v += dppf<0x141>(v); v += dppf<0x140>(v); return v; }
__device__ __forceinline__ float shx(float v, int m, int lane) { return __int_as_float(__builtin_amdgcn_ds_bpermute((lane ^ m) << 2, __float_as_int(v))); }
__device__ __forceinline__ float wave_sum(float v, int lane) { v = row_sum16(v); v += shx(v, 16, lane); v += shx(v, 32, lane); return v; }
__device__ __forceinline__ float gelu_tanh(float x) { return 0.5f * x * (1.f + tanhf(0.7978845608028654f * (x + 0.044715f * x * x * x))); }
#define FK_NEG (-3.0e38f)

template <int CTRL> __device__ __forceinline__ int dppi(int v) { return __builtin_amdgcn_update_dpp(0, v, CTRL, 0xf, 0xf, true); }
__device__ __forceinline__ int row_min16i(int v) { v = min(v, dppi<0xB1>(v)); v = min(v, dppi<0x4E>(v)); v = min(v, dppi<0x141>(v)); v = min(v, dppi<0x140>(v)); return v; }
#define FK_CE(a, b) do { const bool sw_ = v[b] > v[a]; const float tv_ = sw_ ? v[b] : v[a]; v[b] = sw_ ? v[a] : v[b]; v[a] = tv_; const int ti_ = sw_ ? id[b] : id[a]; id[b] = sw_ ? id[a] : id[b]; id[a] = ti_; } while (0)
#define FK_SORT8(v, id) do { FK_CE2(v, id, 0, 1); FK_CE2(v, id, 2, 3); FK_CE2(v, id, 4, 5); FK_CE2(v, id, 6, 7); FK_CE2(v, id, 0, 2); FK_CE2(v, id, 1, 3); FK_CE2(v, id, 4, 6); FK_CE2(v, id, 5, 7); FK_CE2(v, id, 1, 2); FK_CE2(v, id, 5, 6); \
    FK_CE2(v, id, 0, 4); FK_CE2(v, id, 1, 5); FK_CE2(v, id, 2, 6); FK_CE2(v, id, 3, 7); FK_CE2(v, id, 2, 4); FK_CE2(v, id, 3, 5); FK_CE2(v, id, 1, 2); FK_CE2(v, id, 3, 4); FK_CE2(v, id, 5, 6); } while (0)
#define FK_CE2(v, id, a, b) do { const bool sw_ = v[b] > v[a]; const float tv_ = sw_ ? v[b] : v[a]; v[b] = sw_ ? v[a] : v[b]; v[a] = tv_; const int ti_ = sw_ ? id[b] : id[a]; id[b] = sw_ ? id[a] : id[b]; id[a] = ti_; } while (0)
__device__ __forceinline__ void top16_of_128_x2(float (&v)[8], int (&id)[8], float (&u)[8], int (&jd)[8], int lane16, float& rv1, int& ri1, float& rv2, int& ri2) {
    FK_SORT8(v, id); FK_SORT8(u, jd);
    rv1 = FK_NEG; ri1 = 0; rv2 = FK_NEG; ri2 = 0;
#pragma unroll
    for (int r = 0; r < 16; ++r) {
        const float wm = row_max16(v[0]), xm = row_max16(u[0]);
        const int cand = (v[0] == wm) ? id[0] : 0x7fffffff, dand = (u[0] == xm) ? jd[0] : 0x7fffffff;
        const int sel = row_min16i(cand), tel = row_min16i(dand);
        const bool mine = (cand == sel), nine = (dand == tel);
        if (lane16 == r) { rv1 = wm; ri1 = sel; rv2 = xm; ri2 = tel; }
#pragma unroll
        for (int i = 0; i < 7; ++i) { v[i] = mine ? v[i + 1] : v[i]; id[i] = mine ? id[i + 1] : id[i]; u[i] = nine ? u[i + 1] : u[i]; jd[i] = nine ? jd[i + 1] : jd[i]; }
        v[7] = mine ? FK_NEG : v[7]; u[7] = nine ? FK_NEG : u[7];
    }
}
__device__ __forceinline__ int fk_key(float x, int lane16) { int k = __float_as_int(x); k ^= (k >> 31) & 0x7fffffff; return (k & ~15) | (15 - lane16); }
__device__ __forceinline__ float fk_unkey(int k) { k &= ~15; k ^= (k >> 31) & 0x7fffffff; return __int_as_float(k); }
__device__ __forceinline__ int row_max16i(int v) { v = max(v, dppi<0xB1>(v)); v = max(v, dppi<0x4E>(v)); v = max(v, dppi<0x141>(v)); v = max(v, dppi<0x140>(v)); return v; }
__device__ __forceinline__ void topk_phase(const GAS float* __restrict__ SC, const GAS bf16_t* __restrict__ Q, const GAS float* __restrict__ KSUM, GAS float* __restrict__ GATE, GAS int* __restrict__ EIDX, int nitems,
                                           LAS unsigned char* lds, int wid, int lane, int wave_gid, int nwaves) {
    LAS unsigned char* wb = lds + wid * 6144;
    LAS int* IDS1 = (LAS int*)wb; LAS int* IDS2 = (LAS int*)(wb + 2048); LAS int* LC1 = (LAS int*)(wb + 4096); LAS int* LC2 = (LAS int*)(wb + 4352); LAS int* CI = (LAS int*)(wb + 4608);
    LAS float* xv = (LAS float*)(wb + 4864); LAS int* DUMP = (LAS int*)(wb + 5120) + lane; LAS int* WL1 = (LAS int*)(wb + 5376); LAS int* WL2 = (LAS int*)(wb + 5632);
    const int lane16 = lane & 15, rowbase = lane & 48;
    for (int wi = wave_gid; wi * 4 < nitems; wi += nwaves) {
        const int it = wi * 4 + (lane >> 4); const int h = it & 7;
        const GAS u32x4* qp = (const GAS u32x4*)(Q + (size_t)it * 256 + 16 * lane16); const u32x4 qa = qp[0], qb = qp[1];
        float qs = 0.f, qq = 0.f;
#pragma unroll
        for (int i = 0; i < 4; ++i) { const float a = bflo(qa[i]), b = bfhi(qa[i]), c = bflo(qb[i]), d = bfhi(qb[i]); qs += (a + b) + (c + d); qq += (a * a + b * b) + (c * c + d * d); }
        const float mu = row_sum16(qs) * (1.f / 256.f); const float var = fmaxf(row_sum16(qq) * (1.f / 256.f) - mu * mu, 0.f); const float rs = 1.f / sqrtf(var + 1e-5f);
        float v[8], u[8]; int id[8], jd[8];
        { const GAS float* sp = SC + (size_t)it * 256 + 8 * lane16; const GAS float* kp = KSUM + h * 256 + 8 * lane16; const f32x4 s0 = *(const GAS f32x4*)sp, s1 = *(const GAS f32x4*)(sp + 4), k0 = *(const GAS f32x4*)kp, k1 = *(const GAS f32x4*)(kp + 4);
          const f32x4 t0 = *(const GAS f32x4*)(sp + 128), t1 = *(const GAS f32x4*)(sp + 132), m0 = *(const GAS f32x4*)(kp + 128), m1 = *(const GAS f32x4*)(kp + 132);
#pragma unroll
          for (int i = 0; i < 4; ++i) { v[i] = rs * (s0[i] - mu * k0[i]); v[4 + i] = rs * (s1[i] - mu * k1[i]); u[i] = rs * (t0[i] - mu * m0[i]); u[4 + i] = rs * (t1[i] - mu * m1[i]);
              id[i] = 8 * lane16 + i; id[4 + i] = 8 * lane16 + 4 + i; jd[i] = 8 * lane16 + i; jd[4 + i] = 8 * lane16 + 4 + i; } }
        FK_SORT8(v, id); FK_SORT8(u, jd);
#pragma unroll
        for (int i = 0; i < 8; ++i) { IDS1[lane * 8 + i] = id[i]; IDS2[lane * 8 + i] = jd[i]; }
        float rv1 = FK_NEG, rv2 = FK_NEG; int wl1 = 0, wl2 = 0, cn1 = 0, cn2 = 0;
#pragma unroll
        for (int r = 0; r < 16; ++r) {
            const int key1 = fk_key(v[0], lane16), key2 = fk_key(u[0], lane16);
            const int wm1 = row_max16i(key1), wm2 = row_max16i(key2);
            const bool mine = (key1 == wm1), nine = (key2 == wm2);
            if (lane16 == r) { rv1 = fk_unkey(wm1); wl1 = 15 - (wm1 & 15); rv2 = fk_unkey(wm2); wl2 = 15 - (wm2 & 15); }
            *(mine ? LC1 + rowbase + r : DUMP) = cn1; *(nine ? LC2 + rowbase + r : DUMP) = cn2;
#pragma unroll
            for (int i = 0; i < 7; ++i) { v[i] = mine ? v[i + 1] : v[i]; u[i] = nine ? u[i + 1] : u[i]; }
            v[7] = mine ? FK_NEG : v[7]; u[7] = nine ? FK_NEG : u[7]; cn1 += mine ? 1 : 0; cn2 += nine ? 1 : 0;
        }
        xv[lane] = rv2; WL1[lane] = wl1; WL2[lane] = wl2;
        float c[16];
        { const LAS f32x4* xp = (const LAS f32x4*)(xv + rowbase);
#pragma unroll
          for (int q = 0; q < 4; ++q) { const f32x4 t = xp[q]; c[4 * q] = rv1 + t.x; c[4 * q + 1] = rv1 + t.y; c[4 * q + 2] = rv1 + t.z; c[4 * q + 3] = rv1 + t.w; } }
        int p = 0, wli = 0; float sc = FK_NEG;
#pragma unroll
        for (int r = 0; r < 16; ++r) {
            const int key = fk_key(c[0], lane16); const int wm = row_max16i(key); const bool mine = (key == wm);
            if (lane16 == r) { sc = fk_unkey(wm); wli = 15 - (wm & 15); }
            *(mine ? CI + rowbase + r : DUMP) = p;
#pragma unroll
            for (int i = 0; i < 15; ++i) c[i] = mine ? c[i + 1] : c[i];
            c[15] = mine ? FK_NEG : c[15]; p += mine ? 1 : 0;
        }
        const int i1 = wli & 15, j2 = CI[rowbase + lane16] & 15;
        const int e1 = IDS1[(rowbase + (WL1[rowbase + i1] & 15)) * 8 + (LC1[rowbase + i1] & 7)], e2 = IDS2[(rowbase + (WL2[rowbase + j2] & 15)) * 8 + (LC2[rowbase + j2] & 7)];
        const float mx = fk_unkey(row_max16i(fk_key(sc, 0))); const float ex = __expf(sc - mx); const float den = row_sum16(ex);
        GATE[(size_t)it * 16 + lane16] = ex / den; EIDX[(size_t)it * 16 + lane16] = (e1 & 127) * 128 + (e2 & 127);
    }
}

__device__ __forceinline__ f32x2 fp8lo(unsigned w) { return __builtin_amdgcn_cvt_pk_f32_fp8((int)w, false); }
__device__ __forceinline__ f32x2 fp8hi(unsigned w) { return __builtin_amdgcn_cvt_pk_f32_fp8((int)w, true); }
__device__ __forceinline__ void act_phase(const GAS bf16_t* __restrict__ XB, const GAS unsigned char* __restrict__ U8, const GAS float* __restrict__ GATE, const GAS int* __restrict__ EIDX, GAS float* __restrict__ COEF, int nitems,
                                          int lane, int wave_gid, int nwaves) {
    int it = wave_gid; if (it >= nitems) return;
    u32x4 uc[16], un[16], xac, xbc, xan, xbn;
    int evc = EIDX[(size_t)it * 16 + (lane & 15)];
    { const GAS u32x4* xp = (const GAS u32x4*)(XB + (size_t)(it >> 3) * 1024 + 16 * lane); xac = xp[0]; xbc = xp[1]; }
#pragma unroll
    for (int k = 0; k < 16; ++k) uc[k] = *(const GAS u32x4*)(U8 + (size_t)__builtin_amdgcn_readlane(evc, k) * 1024 + 16 * lane);
    int itn = it + nwaves; int evn = (itn < nitems) ? EIDX[(size_t)itn * 16 + (lane & 15)] : 0;
    for (;;) {
        const bool hasn = itn < nitems;
        if (hasn) {
            const GAS u32x4* xp = (const GAS u32x4*)(XB + (size_t)(itn >> 3) * 1024 + 16 * lane); xan = xp[0]; xbn = xp[1];
#pragma unroll
            for (int k = 0; k < 16; ++k) un[k] = *(const GAS u32x4*)(U8 + (size_t)__builtin_amdgcn_readlane(evn, k) * 1024 + 16 * lane);
        }
        const int itnn = itn + nwaves; const int evnn = (itnn < nitems) ? EIDX[(size_t)itnn * 16 + (lane & 15)] : 0;
        const float gt = GATE[(size_t)it * 16 + (lane >> 2)];
        float x[16];
#pragma unroll
        for (int i = 0; i < 4; ++i) { x[2 * i] = bflo(xac[i]); x[2 * i + 1] = bfhi(xac[i]); x[8 + 2 * i] = bflo(xbc[i]); x[8 + 2 * i + 1] = bfhi(xbc[i]); }
        float a[16];
#pragma unroll
        for (int k = 0; k < 16; ++k) { const u32x4 uw = uc[k]; float s = 0.f;
#pragma unroll
            for (int d = 0; d < 4; ++d) { const f32x2 lo = fp8lo(uw[d]), hi = fp8hi(uw[d]); s = fmaf(lo.x, x[4 * d], s); s = fmaf(lo.y, x[4 * d + 1], s); s = fmaf(hi.x, x[4 * d + 2], s); s = fmaf(hi.y, x[4 * d + 3], s); }
            asm volatile("" : "+v"(s)); a[k] = s; }
#pragma unroll
        for (int k = 0; k < 8; ++k) { const bool hi = lane & 32; const float send = hi ? a[k] : a[k + 8], keep = hi ? a[k + 8] : a[k]; a[k] = keep + shx(send, 32, lane); }
#pragma unroll
        for (int k = 0; k < 4; ++k) { const bool hi = lane & 16; const float send = hi ? a[k] : a[k + 4], keep = hi ? a[k + 4] : a[k]; a[k] = keep + shx(send, 16, lane); }
#pragma unroll
        for (int k = 0; k < 2; ++k) { const bool hi = lane & 8; const float send = hi ? a[k] : a[k + 2], keep = hi ? a[k + 2] : a[k]; a[k] = keep + shx(send, 8, lane); }
        { const bool hi = lane & 4; const float send = hi ? a[0] : a[1], keep = hi ? a[1] : a[0]; a[0] = keep + shx(send, 4, lane); }
        float dsum = a[0]; dsum += shx(dsum, 2, lane); dsum += shx(dsum, 1, lane);
        if ((lane & 3) == 0) COEF[(size_t)it * 16 + (lane >> 2)] = gt * gelu_tanh(dsum * (1.f / 128.f));
        if (!hasn) break;
#pragma unroll
        for (int k = 0; k < 16; ++k) uc[k] = un[k];
        xac = xan; xbc = xbn; evc = evn; evn = evnn; it = itn; itn = itnn;
    }
}

__device__ __forceinline__ void outln_phase(const GAS float* COEF, const GAS int* EIDX, const GAS unsigned char* V8,     const GAS float* __restrict__ lg, const GAS float* __restrict__ lb, GAS float* X, GAS bf16_t* XB, int nrows,
                                            int lane, int wave_gid, int nwaves) {
    const float alpha = 1.6817928305074292f;
    int row = wave_gid; if (row >= nrows) return;
    u32x4 vc[16], vn[16];
    float cf0 = COEF[(size_t)row * 128 + lane] * (1.f / 64.f), cf1 = COEF[(size_t)row * 128 + 64 + lane] * (1.f / 64.f); int ev0 = EIDX[(size_t)row * 128 + lane], ev1 = EIDX[(size_t)row * 128 + 64 + lane];
#define OUT_LOADCH(dst, evreg, base) do { _Pragma("unroll") for (int k_ = 0; k_ < 16; ++k_) dst[k_] = *(const GAS u32x4*)(V8 + (size_t)__builtin_amdgcn_readlane(evreg, (base) + k_) * 1024 + 16 * lane); } while (0)
#define OUT_COMPCH(src, cfreg, base) do { _Pragma("unroll") for (int k_ = 0; k_ < 16; ++k_) { const float c_ = __int_as_float(__builtin_amdgcn_readlane(__float_as_int(cfreg), (base) + k_)); const u32x4 vw_ = src[k_]; \
        _Pragma("unroll") for (int d_ = 0; d_ < 4; ++d_) { const f32x2 lo_ = fp8lo(vw_[d_]), hi_ = fp8hi(vw_[d_]); acc[4 * d_] = fmaf(c_, lo_.x, acc[4 * d_]); acc[4 * d_ + 1] = fmaf(c_, lo_.y, acc[4 * d_ + 1]); acc[4 * d_ + 2] = fmaf(c_, hi_.x, acc[4 * d_ + 2]); acc[4 * d_ + 3] = fmaf(c_, hi_.y, acc[4 * d_ + 3]); } \
        _Pragma("unroll") for (int p_ = 0; p_ < 16; ++p_) asm volatile("" : "+v"(acc[p_]));     \
        } } while (0)
    for (;;) {
        OUT_LOADCH(vc, ev0, 0);
        const int rown = row + nwaves; const bool hasn = rown < nrows;
        float ncf0 = 0.f, ncf1 = 0.f; int nev0 = 0, nev1 = 0;
        if (hasn) { ncf0 = COEF[(size_t)rown * 128 + lane] * (1.f / 64.f); ncf1 = COEF[(size_t)rown * 128 + 64 + lane] * (1.f / 64.f); nev0 = EIDX[(size_t)rown * 128 + lane]; nev1 = EIDX[(size_t)rown * 128 + 64 + lane]; }
        float acc[16];
#pragma unroll
        for (int k = 0; k < 16; ++k) acc[k] = 0.f;
#define OUT_FENCE() asm volatile("" ::: "memory")
        OUT_LOADCH(vn, ev0, 16); OUT_FENCE(); OUT_COMPCH(vc, cf0, 0); OUT_FENCE();
        OUT_LOADCH(vc, ev0, 32); OUT_FENCE(); OUT_COMPCH(vn, cf0, 16); OUT_FENCE();
        OUT_LOADCH(vn, ev0, 48); OUT_FENCE(); OUT_COMPCH(vc, cf0, 32); OUT_FENCE();
        OUT_LOADCH(vc, ev1, 0);  OUT_FENCE(); OUT_COMPCH(vn, cf0, 48); OUT_FENCE();
        OUT_LOADCH(vn, ev1, 16); OUT_FENCE(); OUT_COMPCH(vc, cf1, 0); OUT_FENCE();
        OUT_LOADCH(vc, ev1, 32); OUT_FENCE(); OUT_COMPCH(vn, cf1, 16); OUT_FENCE();
        OUT_LOADCH(vn, ev1, 48); OUT_FENCE(); OUT_COMPCH(vc, cf1, 32); OUT_FENCE();
        OUT_COMPCH(vn, cf1, 48); OUT_FENCE();
#undef OUT_FENCE
        GAS float* xr = X + (size_t)row * 1024 + 16 * lane; float t[16];
#pragma unroll
        for (int q = 0; q < 4; ++q) { const f32x4 xv = *(const GAS f32x4*)(xr + 4 * q); t[4 * q] = fmaf(alpha, xv.x, acc[4 * q]); t[4 * q + 1] = fmaf(alpha, xv.y, acc[4 * q + 1]); t[4 * q + 2] = fmaf(alpha, xv.z, acc[4 * q + 2]); t[4 * q + 3] = fmaf(alpha, xv.w, acc[4 * q + 3]); }
        float s = 0.f;
#pragma unroll
        for (int k = 0; k < 16; ++k) s += t[k];
        const float mu = wave_sum(s, lane) * (1.f / 1024.f); float vs = 0.f;
#pragma unroll
        for (int k = 0; k < 16; ++k) { t[k] -= mu; vs = fmaf(t[k], t[k], vs); }
        const float rs = 1.f / sqrtf(wave_sum(vs, lane) * (1.f / 1024.f) + 1e-5f);
        unsigned w[8];
#pragma unroll
        for (int q = 0; q < 4; ++q) { const f32x4 g = *(const GAS f32x4*)(lg + 16 * lane + 4 * q), b = *(const GAS f32x4*)(lb + 16 * lane + 4 * q); f32x4 o;
            o.x = t[4 * q] * rs * g.x + b.x; o.y = t[4 * q + 1] * rs * g.y + b.y; o.z = t[4 * q + 2] * rs * g.z + b.z; o.w = t[4 * q + 3] * rs * g.w + b.w;
            *(GAS f32x4*)(xr + 4 * q) = o; w[2 * q] = pk_bf16(o.x, o.y); w[2 * q + 1] = pk_bf16(o.z, o.w); }
        u32x4 w0, w1; w0.x = w[0]; w0.y = w[1]; w0.z = w[2]; w0.w = w[3]; w1.x = w[4]; w1.y = w[5]; w1.z = w[6]; w1.w = w[7];
        GAS u32x4* xbp = (GAS u32x4*)(XB + (size_t)row * 1024 + 16 * lane); xbp[0] = w0; xbp[1] = w1;
        if (!hasn) break;
        row = rown; cf0 = ncf0; cf1 = ncf1; ev0 = nev0; ev1 = nev1;
    }
#undef OUT_LOADCH
#undef OUT_COMPCH
}

__device__ __forceinline__ void lnres_phase(const GAS bf16_t* __restrict__ Y, const GAS float* __restrict__ lg, const GAS float* __restrict__ lb, GAS float* X, GAS bf16_t* XB, GAS unsigned char* XF8, int nrows, int lane, int wave_gid, int nwaves) {
    const float alpha = 1.6817928305074292f;
    for (int row = wave_gid; row < nrows; row += nwaves) {
        GAS float* xr = X + (size_t)row * 1024; const GAS bf16_t* yr = Y + (size_t)row * 1024; float t[16];
#pragma unroll
        for (int q = 0; q < 4; ++q) { const f32x4 xv = *(const GAS f32x4*)(xr + 256 * q + 4 * lane); const u32x2 yw = *(const GAS u32x2*)(yr + 256 * q + 4 * lane);
            t[4 * q] = fmaf(alpha, xv.x, bflo(yw.x)); t[4 * q + 1] = fmaf(alpha, xv.y, bfhi(yw.x)); t[4 * q + 2] = fmaf(alpha, xv.z, bflo(yw.y)); t[4 * q + 3] = fmaf(alpha, xv.w, bfhi(yw.y)); }
        float s = 0.f;
#pragma unroll
        for (int k = 0; k < 16; ++k) s += t[k];
        const float mu = wave_sum(s, lane) * (1.f / 1024.f); float vs = 0.f;
#pragma unroll
        for (int k = 0; k < 16; ++k) { t[k] -= mu; vs = fmaf(t[k], t[k], vs); }
        const float rs = 1.f / sqrtf(wave_sum(vs, lane) * (1.f / 1024.f) + 1e-5f);
#pragma unroll
        for (int q = 0; q < 4; ++q) { const int c = 256 * q + 4 * lane; const f32x4 g = *(const GAS f32x4*)(lg + c), b = *(const GAS f32x4*)(lb + c); f32x4 o;
            o.x = t[4 * q] * rs * g.x + b.x; o.y = t[4 * q + 1] * rs * g.y + b.y; o.z = t[4 * q + 2] * rs * g.z + b.z; o.w = t[4 * q + 3] * rs * g.w + b.w;
            *(GAS f32x4*)(xr + c) = o; u32x2 w; w.x = pk_bf16(o.x, o.y); w.y = pk_bf16(o.z, o.w); *(GAS u32x2*)(XB + (size_t)row * 1024 + c) = w;
            if (XF8) {
                const float s0 = __builtin_amdgcn_fmed3f(o.x * 16.f, -448.f, 448.f), s1 = __builtin_amdgcn_fmed3f(o.y * 16.f, -448.f, 448.f), s2 = __builtin_amdgcn_fmed3f(o.z * 16.f, -448.f, 448.f), s3 = __builtin_amdgcn_fmed3f(o.w * 16.f, -448.f, 448.f);
                int hp = __builtin_amdgcn_cvt_pk_fp8_f32(s0, s1, 0, false); hp = __builtin_amdgcn_cvt_pk_fp8_f32(s2, s3, hp, true);
                const f32x2 d01 = fp8lo((unsigned)hp), d23 = fp8hi((unsigned)hp);
                int lp = __builtin_amdgcn_cvt_pk_fp8_f32(s0 - d01.x, s1 - d01.y, 0, false); lp = __builtin_amdgcn_cvt_pk_fp8_f32(s2 - d23.x, s3 - d23.y, lp, true);
                *(GAS int*)(XF8 + (size_t)row * 2048 + c) = hp; *(GAS int*)(XF8 + (size_t)row * 2048 + 1024 + c) = lp; } }
    }
}

__device__ __forceinline__ void glanorm_phase(const GAS float* __restrict__ O, const GAS float* __restrict__ PROJ, const GAS float* __restrict__ gnorm, GAS bf16_t* XB, int nitems, int lane, int wave_gid, int nwaves) {
    const float g0 = gnorm[lane], g1 = gnorm[64 + lane];
    for (int it0 = wave_gid * 4; it0 < nitems; it0 += nwaves * 4) {
        float a0[4], a1[4], r0[4], r1[4];
#pragma unroll
        for (int q = 0; q < 4; ++q) { int it = it0 + q; it = it < nitems ? it : it0; const int row = it >> 2, h = it & 3; const GAS float* o = O + (size_t)row * 512 + h * 128; const GAS float* r = PROJ + (size_t)row * 2576 + 1040 + h * 128;
            a0[q] = o[lane]; a1[q] = o[64 + lane]; r0[q] = r[lane]; r1[q] = r[64 + lane]; }
#pragma unroll
        for (int q = 0; q < 4; ++q) { const int it = it0 + q; const int row = it >> 2, h = it & 3;
            const float rs = 1.f / sqrtf(wave_sum(a0[q] * a0[q] + a1[q] * a1[q], lane) * (1.f / 128.f) + 1e-5f);
            const float y0 = a0[q] * rs * g0 * (r0[q] / (1.f + __expf(-r0[q]))), y1 = a1[q] * rs * g1 * (r1[q] / (1.f + __expf(-r1[q])));
            if (it < nitems) { GAS bf16_t* d = XB + (size_t)row * 1024 + h * 128; d[lane] = (bf16_t)(pk_bf16(y0, 0.f) & 0xffffu); d[64 + lane] = (bf16_t)(pk_bf16(y1, 0.f) & 0xffffu); } }
    }
}

__device__ __forceinline__ float sigm(float x) { return 1.f / (1.f + __expf(-x)); }
__device__ __forceinline__ float softplusf(float x) { return fmaxf(x, 0.f) + log1pf(__expf(-fabsf(x))); }
__device__ __forceinline__ void rwkvprep_phase(const GAS float* __restrict__ w0, const GAS float* __restrict__ a0, const GAS float* __restrict__ v0, const GAS float* __restrict__ k_k, const GAS float* __restrict__ k_a, const GAS float* __restrict__ Vg,
                                               GAS float* K, GAS float* Wd, GAS float* Aa, GAS float* V, GAS float* NKK, GAS float* VFIRST, int has_vres, int nitems, int lane, int wave_gid, int nwaves) {
    for (int it0 = wave_gid * 4; it0 < nitems; it0 += nwaves * 4) {
        float kq[4], wq[4], aq[4], vq[4], gq[4], fq[4];
#pragma unroll
        for (int q = 0; q < 4; ++q) { const int it = it0 + q; const size_t ix = (size_t)(it >> 4) * 1024 + (it & 15) * 64 + lane; kq[q] = K[ix]; wq[q] = Wd[ix]; aq[q] = Aa[ix]; vq[q] = V[ix]; gq[q] = has_vres ? Vg[ix] : 0.f; fq[q] = has_vres ? VFIRST[ix] : 0.f; }
#pragma unroll
        for (int q = 0; q < 4; ++q) { const int it = it0 + q; const int h = it & 15; const size_t ix = (size_t)(it >> 4) * 1024 + h * 64 + lane; const int c = h * 64 + lane;
            const float k0 = kq[q]; const float kv = k0 * k_k[c]; const float inv = 1.f / fmaxf(sqrtf(wave_sum(kv * kv, lane)), 1e-12f);
            const float w = -softplusf(-(w0[c] + wq[q])) - 0.5f; const float dec = __expf(-__expf(w));
            const float a = sigm(a0[c] + aq[q]);
            float v = vq[q]; if (has_vres) v = v + (fq[q] - v) * sigm(v0[c] + gq[q]); else VFIRST[ix] = v;
            const float kk = kv * inv;
            NKK[ix] = -kk; K[ix] = k0 * (1.f + (a - 1.f) * k_a[c]); Wd[ix] = dec; Aa[ix] = kk * a; V[ix] = v; }
    }
}

__device__ __forceinline__ void rwkvpost_phase(const GAS float* __restrict__ Y, const GAS float* __restrict__ R, const GAS float* __restrict__ K2, const GAS float* __restrict__ V, const GAS float* __restrict__ G, const GAS float* __restrict__ r_k,
                                               const GAS float* __restrict__ lnx_g, const GAS float* __restrict__ lnx_b, GAS bf16_t* XB, int nitems, int lane, int wave_gid, int nwaves) {
    for (int it0 = wave_gid * 4; it0 < nitems; it0 += nwaves * 4) {
        float yq[4], rq[4], kq[4], vq[4], gq[4];
#pragma unroll
        for (int q = 0; q < 4; ++q) { const int it = it0 + q; const size_t ix = (size_t)(it >> 4) * 1024 + (it & 15) * 64 + lane; yq[q] = Y[ix]; rq[q] = R[ix]; kq[q] = K2[ix]; vq[q] = V[ix]; gq[q] = G[ix]; }
#pragma unroll
        for (int q = 0; q < 4; ++q) { const int it = it0 + q; const int h = it & 15; const size_t ix = (size_t)(it >> 4) * 1024 + h * 64 + lane; const int c = h * 64 + lane;
            const float y = yq[q]; const float mu = wave_sum(y, lane) * (1.f / 64.f); const float d = y - mu; const float rs = 1.f / sqrtf(wave_sum(d * d, lane) * (1.f / 64.f) + 64e-5f);
            const float bon = wave_sum(rq[q] * kq[q] * r_k[c], lane);
            const float o = (d * rs * lnx_g[c] + lnx_b[c] + bon * vq[q]) * gq[q];
            XB[ix] = (bf16_t)(pk_bf16(o, 0.f) & 0xffffu); }
    }
}

__device__ __forceinline__ void wkv_phase(const GAS float* __restrict__ R, const GAS float* __restrict__ Wd, const GAS float* __restrict__ K2, const GAS float* __restrict__ V, const GAS float* __restrict__ BB, const GAS float* __restrict__ NKK,
                                          const GAS float* __restrict__ SIN, GAS float* __restrict__ Y, GAS float* __restrict__ P, GAS float* __restrict__ SOUT, int B, int T, int DB, int DT, LAS unsigned char* lds, int tid, int bid, int nb) {
    constexpr int TB = 32, NLD = 6, VECB = TB * 1280, VVB = TB * 128, BUF = VECB + 2 * VVB;
    const int rowl = tid >> 4, part = tid & 15;
    const int nprompt = B * 32, nunits = nprompt + DB * 32;
    for (int u = bid; u < nunits; u += nb) {
        const bool smp = u >= nprompt; const int q0_ = smp ? u - nprompt : u; const int q = ((q0_ & 7) << 1 | ((q0_ >> 3) & 1)) + ((q0_ >> 4) << 4);
        const int half = q & 1, pair = q >> 1, sq = pair >> 4, h = pair & 15;
        const int Tu = smp ? DT : T; const int r0 = smp ? B * T + sq * DT : sq * T, vrow = half * 32 + rowl;
        f32x2 S01 = (f32x2){0.f, 0.f}, S23 = (f32x2){0.f, 0.f};
        if (smp) { const f32x4 s4 = *(const GAS f32x4*)(SIN + ((size_t)pair * 64 + vrow) * 64 + part * 4); S01 = (f32x2){s4.x, s4.y}; S23 = (f32x2){s4.z, s4.w};
                   asm volatile("" : "+v"(S01), "+v"(S23)); }
        const int nblk = (Tu + TB - 1) / TB;
        f32x4 ld[NLD];
        const size_t eo_ = (size_t)(r0 + (tid >> 4)) * 1024 + h * 64 + (tid & 15) * 4, ev_ = (size_t)(r0 + ((tid & 255) >> 3)) * 1024 + h * 64 + half * 32 + (tid & 7) * 4;
        const int lo_ = ((tid >> 4) * 320 + (tid & 15) * 4) * 4, lv_ = VECB + (tid & 255) * 16;
#define WKV_LOAD(tb0) do { const size_t bo_ = (size_t)(tb0) * 1024; ld[0] = *(const GAS f32x4*)(Wd + eo_ + bo_); ld[1] = *(const GAS f32x4*)(NKK + eo_ + bo_); ld[2] = *(const GAS f32x4*)(BB + eo_ + bo_); \
            ld[3] = *(const GAS f32x4*)(K2 + eo_ + bo_); ld[4] = *(const GAS f32x4*)(R + eo_ + bo_); ld[5] = *(const GAS f32x4*)(V + ev_ + bo_); } while (0)
#define WKV_STORE(bufp) do { _Pragma("unroll") for (int q_ = 0; q_ < 5; ++q_) *(LAS f32x4*)((bufp) + lo_ + q_ * 256) = ld[q_]; *(LAS f32x4*)((bufp) + lv_) = ld[5]; } while (0)
        WKV_LOAD(0); WKV_STORE(lds); __syncthreads();
        for (int b = 0; b < nblk; ++b) {
            LAS unsigned char* cur = lds + (b & 1) * BUF; LAS unsigned char* nxt = lds + ((b + 1) & 1) * BUF; const int tb0 = b * TB; const int nt = (Tu - tb0) < TB ? (Tu - tb0) : TB;
            if (b + 1 < nblk) WKV_LOAD(tb0 + TB);
            const LAS float* vec = (const LAS float*)cur + part * 4; const LAS float* vv = (const LAS float*)(cur + VECB) + rowl; LAS float* yb = (LAS float*)(cur + VECB + VVB);
            float ykeep0 = 0.f, ykeep1 = 0.f;
#define WKV_STEP(t, keep, tl) do { const LAS f32x2* vp_ = (const LAS f32x2*)(vec + (t) * 320); \
                const f32x2 w01 = vp_[0], w23 = vp_[1], n01 = vp_[32], n23 = vp_[33], b01 = vp_[64], b23 = vp_[65], k01 = vp_[96], k23 = vp_[97], r01 = vp_[128], r23 = vp_[129]; \
                const float v = vv[(t) * 32]; \
                const f32x2 sp = __builtin_elementwise_fma(S23, n23, S01 * n01); const float sa = row_sum16(sp.x + sp.y); const f32x2 sa2 = (f32x2){sa, sa}, v2 = (f32x2){v, v}; \
                S01 = __builtin_elementwise_fma(S01, w01, __builtin_elementwise_fma(b01, sa2, k01 * v2)); S23 = __builtin_elementwise_fma(S23, w23, __builtin_elementwise_fma(b23, sa2, k23 * v2)); \
                const f32x2 yp = __builtin_elementwise_fma(S23, r23, S01 * r01); const float y = row_sum16(yp.x + yp.y); \
                keep = (part == (tl)) ? y : keep; } while (0)
            if (nt == TB) {
#pragma unroll 1
                for (int t = 0; t < 16; t += 8) { WKV_STEP(t, ykeep0, t); WKV_STEP(t + 1, ykeep0, t + 1); WKV_STEP(t + 2, ykeep0, t + 2); WKV_STEP(t + 3, ykeep0, t + 3); WKV_STEP(t + 4, ykeep0, t + 4); WKV_STEP(t + 5, ykeep0, t + 5); WKV_STEP(t + 6, ykeep0, t + 6); WKV_STEP(t + 7, ykeep0, t + 7); }
#pragma unroll 1
                for (int t = 16; t < 32; t += 8) { WKV_STEP(t, ykeep1, t - 16); WKV_STEP(t + 1, ykeep1, t - 15); WKV_STEP(t + 2, ykeep1, t - 14); WKV_STEP(t + 3, ykeep1, t - 13); WKV_STEP(t + 4, ykeep1, t - 12); WKV_STEP(t + 5, ykeep1, t - 11); WKV_STEP(t + 6, ykeep1, t - 10); WKV_STEP(t + 7, ykeep1, t - 9); }
            } else { for (int t = 0; t < nt; ++t) { if (t < 16) WKV_STEP(t, ykeep0, t); else WKV_STEP(t, ykeep1, t - 16); } }
#undef WKV_STEP
            yb[part * 32 + rowl] = ykeep0; yb[(16 + part) * 32 + rowl] = ykeep1;
            if (b + 1 < nblk) WKV_STORE(nxt);
            __syncthreads();
            { const int rl = tid & 31; _Pragma("unroll") for (int t = tid >> 5; t < TB; t += 16) if (t < nt) Y[(size_t)(r0 + tb0 + t) * 1024 + h * 64 + half * 32 + rl] = yb[t * 32 + rl]; }
        }
#undef WKV_LOAD
#undef WKV_STORE
        *(GAS f32x4*)((smp ? SOUT : P) + ((size_t)pair * 64 + vrow) * 64 + part * 4) = (f32x4){S01.x, S01.y, S23.x, S23.y};
        __syncthreads();
    }
}

__device__ __forceinline__ void rwkvpost2_phase(const GAS float* __restrict__ Y, const GAS bf16_t* __restrict__ G, const GAS float* __restrict__ VF, const GAS float* __restrict__ BON, const GAS float* __restrict__ lnx_g, const GAS float* __restrict__ lnx_b,
                                                GAS bf16_t* XB, int nitems, int lane, int wave_gid, int nwaves) {
    for (int it0 = wave_gid * 4; it0 < nitems; it0 += nwaves * 4) {
        float yq[4], gq[4], vq[4], bq[4];
#pragma unroll
        for (int q = 0; q < 4; ++q) { const int it = it0 + q; const size_t ix = (size_t)(it >> 4) * 1024 + (it & 15) * 64 + lane; yq[q] = Y[ix]; gq[q] = __uint_as_float((unsigned)G[ix] << 16); vq[q] = VF[ix]; bq[q] = BON[it]; }
#pragma unroll
        for (int q = 0; q < 4; ++q) { const int it = it0 + q; const int h = it & 15; const size_t ix = (size_t)(it >> 4) * 1024 + h * 64 + lane; const int c = h * 64 + lane;
            const float y = yq[q]; const float mu = wave_sum(y, lane) * (1.f / 64.f); const float d = y - mu; const float rs = 1.f / sqrtf(wave_sum(d * d, lane) * (1.f / 64.f) + 64e-5f);
            const float o = (d * rs * lnx_g[c] + lnx_b[c] + bq[q] * vq[q]) * gq[q];
            XB[ix] = (bf16_t)(pk_bf16(o, 0.f) & 0xffffu); }
    }
}

__device__ __forceinline__ void wkv2_phase(const GAS bf16_t* __restrict__ R, const GAS bf16_t* __restrict__ KR, const GAS bf16_t* __restrict__ WL, const GAS bf16_t* __restrict__ AL, const GAS bf16_t* __restrict__ V, const GAS bf16_t* __restrict__ VG,
                                           const GAS float* VFI, const GAS float* __restrict__ PRM, const GAS float* __restrict__ SIN, GAS float* __restrict__ Y, GAS float* __restrict__ P, GAS float* __restrict__ SOUT, GAS float* VFO, GAS float* __restrict__ BON,
                                           int has_vres, int B, int T, int DB, int DT, LAS unsigned char* lds, int tid, int bid, int nb) {
    constexpr int TB = 32, NLD = 7, VECB = TB * 1280, VVB = TB * 128, BUF = VECB + 2 * VVB;
    const int rowl = tid >> 4, part = tid & 15;
    const int nprompt = B * 32, nunits = nprompt + DB * 32;
    for (int u = bid; u < nunits; u += nb) {
        const bool smp = u >= nprompt; const int q0_ = smp ? u - nprompt : u; const int q = ((q0_ & 7) << 1 | ((q0_ >> 3) & 1)) + ((q0_ >> 4) << 4);
        const int half = q & 1, pair = q >> 1, sq = pair >> 4, h = pair & 15;
        const int Tu = smp ? DT : T; const int r0 = smp ? B * T + sq * DT : sq * T, vrow = half * 32 + rowl;
        f32x2 S01 = (f32x2){0.f, 0.f}, S23 = (f32x2){0.f, 0.f};
        if (smp) { const f32x4 s4 = *(const GAS f32x4*)(SIN + ((size_t)pair * 64 + vrow) * 64 + part * 4); S01 = (f32x2){s4.x, s4.y}; S23 = (f32x2){s4.z, s4.w};
                   asm volatile("" : "+v"(S01), "+v"(S23)); }
        const int nblk = (Tu + TB - 1) / TB;
        u32x2 lk, lw, la, lr, lv, lg = (u32x2){0u, 0u}; f32x4 lf = (f32x4){0.f, 0.f, 0.f, 0.f};
        const size_t eo_ = (size_t)(r0 + (tid >> 4)) * 1024 + h * 64 + (tid & 15) * 4, ev_ = (size_t)(r0 + ((tid & 255) >> 3)) * 1024 + h * 64 + half * 32 + (tid & 7) * 4;
        const int lo_ = ((tid >> 4) * 320 + (tid & 15) * 4) * 4, lv_ = VECB + (tid & 255) * 16;
        const int pc_ = h * 64 + (tid & 15) * 4; const f32x4 w0v = *(const GAS f32x4*)(PRM + pc_), a0v = *(const GAS f32x4*)(PRM + 1024 + pc_), kkp = *(const GAS f32x4*)(PRM + 3072 + pc_), kap = *(const GAS f32x4*)(PRM + 4096 + pc_), rkp = *(const GAS f32x4*)(PRM + 5120 + pc_);
        const f32x4 v0v = *(const GAS f32x4*)(PRM + 2048 + h * 64 + half * 32 + (tid & 7) * 4);
#define WKV_LOAD(tb0) do { const size_t bo_ = (size_t)(tb0) * 1024; lk = *(const GAS u32x2*)(KR + eo_ + bo_); lw = *(const GAS u32x2*)(WL + eo_ + bo_); la = *(const GAS u32x2*)(AL + eo_ + bo_); \
            lr = *(const GAS u32x2*)(R + eo_ + bo_); lv = *(const GAS u32x2*)(V + ev_ + bo_); if (has_vres) { lg = *(const GAS u32x2*)(VG + ev_ + bo_); lf = *(const GAS f32x4*)(VFI + ev_ + bo_); } } while (0)
#define WKV_UNPK(w_) ((f32x4){bflo((w_).x), bfhi((w_).x), bflo((w_).y), bfhi((w_).y)})
#define WKV_STORE(bufp, tb0) do { const f32x4 k4 = WKV_UNPK(lk), wl4 = WKV_UNPK(lw), al4 = WKV_UNPK(la); const f32x4 kv = k4 * kkp; const float ss = row_sum16((kv.x * kv.x + kv.y * kv.y) + (kv.z * kv.z + kv.w * kv.w)); const float inv = 1.f / fmaxf(sqrtf(ss), 1e-12f); \
            f32x4 dec, a4; _Pragma("unroll") for (int i_ = 0; i_ < 4; ++i_) { dec[i_] = __expf(-0.6065306597126334f / (1.f + __expf(-(w0v[i_] + wl4[i_])))); a4[i_] = 1.f / (1.f + __expf(-(a0v[i_] + al4[i_]))); } \
            const f32x4 kk = kv * inv; const f32x4 k2 = k4 * ((a4 - 1.f) * kap + 1.f); const f32x4 r4 = WKV_UNPK(lr); const f32x4 rk = r4 * k2 * rkp; const float bon = row_sum16((rk.x + rk.y) + (rk.z + rk.w)); \
            *(LAS f32x4*)((bufp) + lo_) = dec; *(LAS f32x4*)((bufp) + lo_ + 256) = -kk; *(LAS f32x4*)((bufp) + lo_ + 512) = kk * a4; *(LAS f32x4*)((bufp) + lo_ + 768) = k2; *(LAS f32x4*)((bufp) + lo_ + 1024) = r4; \
            const int tr_ = (tb0) + (tid >> 4); if (half == 0 && (tid & 15) == 0 && tr_ < Tu) BON[(size_t)(r0 + tr_) * 16 + h] = bon; \
            f32x4 v4 = WKV_UNPK(lv); if (has_vres) { const f32x4 g4 = WKV_UNPK(lg); _Pragma("unroll") for (int i_ = 0; i_ < 4; ++i_) v4[i_] = v4[i_] + (lf[i_] - v4[i_]) / (1.f + __expf(-(v0v[i_] + g4[i_]))); } \
            *(LAS f32x4*)((bufp) + lv_) = v4; const int tv_ = (tb0) + ((tid & 255) >> 3); if (tid < 256 && tv_ < Tu) *(GAS f32x4*)(VFO + ev_ + (size_t)(tb0) * 1024) = v4; } while (0)
        WKV_LOAD(0); WKV_STORE(lds, 0); __syncthreads();
        for (int b = 0; b < nblk; ++b) {
            LAS unsigned char* cur = lds + (b & 1) * BUF; LAS unsigned char* nxt = lds + ((b + 1) & 1) * BUF; const int tb0 = b * TB; const int nt = (Tu - tb0) < TB ? (Tu - tb0) : TB;
            if (b + 1 < nblk) WKV_LOAD(tb0 + TB);
            const LAS float* vec = (const LAS float*)cur + part * 4; const LAS float* vv = (const LAS float*)(cur + VECB) + rowl; LAS float* yb = (LAS float*)(cur + VECB + VVB);
            float ykeep0 = 0.f, ykeep1 = 0.f;
            struct StepV { f32x2 w01, w23, n01, n23, b01, b23, k01, k23, r01, r23; float v; };
#define WKV_RD(dst, t) do { const LAS f32x2* vp_ = (const LAS f32x2*)(vec + (t) * 320); dst.w01 = vp_[0]; dst.w23 = vp_[1]; dst.n01 = vp_[32]; dst.n23 = vp_[33]; dst.b01 = vp_[64]; dst.b23 = vp_[65]; \
                dst.k01 = vp_[96]; dst.k23 = vp_[97]; dst.r01 = vp_[128]; dst.r23 = vp_[129]; dst.v = vv[(t) * 32]; } while (0)
#define WKV_CMP(src, keep, tl) do { const f32x2 sp = __builtin_elementwise_fma(S23, src.n23, S01 * src.n01); const float sa = row_sum16(sp.x + sp.y); const f32x2 sa2 = (f32x2){sa, sa}, v2 = (f32x2){src.v, src.v}; \
                S01 = __builtin_elementwise_fma(S01, src.w01, __builtin_elementwise_fma(src.b01, sa2, src.k01 * v2)); S23 = __builtin_elementwise_fma(S23, src.w23, __builtin_elementwise_fma(src.b23, sa2, src.k23 * v2)); \
                const f32x2 yp = __builtin_elementwise_fma(S23, src.r23, S01 * src.r01); const float y = row_sum16(yp.x + yp.y); keep = (part == (tl)) ? y : keep; } while (0)
            if (nt == TB) {
                StepV sA, sB; WKV_RD(sA, 0);
#pragma unroll 1
                for (int t = 0; t < 16; t += 2) { WKV_RD(sB, t + 1); __builtin_amdgcn_sched_barrier(0); WKV_CMP(sA, ykeep0, t); WKV_RD(sA, t + 2); __builtin_amdgcn_sched_barrier(0); WKV_CMP(sB, ykeep0, t + 1); }
#pragma unroll 1
                for (int t = 16; t < 32; t += 2) { WKV_RD(sB, t + 1); __builtin_amdgcn_sched_barrier(0); WKV_CMP(sA, ykeep1, t - 16); WKV_RD(sA, (t + 2) & 31); __builtin_amdgcn_sched_barrier(0); WKV_CMP(sB, ykeep1, t - 15); }
            } else { StepV sA; for (int t = 0; t < nt; ++t) { WKV_RD(sA, t); if (t < 16) WKV_CMP(sA, ykeep0, t); else WKV_CMP(sA, ykeep1, t - 16); } }
#undef WKV_RD
#undef WKV_CMP
            yb[part * 32 + rowl] = ykeep0; yb[(16 + part) * 32 + rowl] = ykeep1;
            if (b + 1 < nblk) WKV_STORE(nxt, tb0 + TB);
            __syncthreads();
            { const int rl = tid & 31; _Pragma("unroll") for (int t = tid >> 5; t < TB; t += 16) if (t < nt) Y[(size_t)(r0 + tb0 + t) * 1024 + h * 64 + half * 32 + rl] = yb[t * 32 + rl]; }
        }
#undef WKV_LOAD
#undef WKV_STORE
#undef WKV_UNPK
        *(GAS f32x4*)((smp ? SOUT : P) + ((size_t)pair * 64 + vrow) * 64 + part * 4) = (f32x4){S01.x, S01.y, S23.x, S23.y};
        __syncthreads();
    }
}

__device__ __forceinline__ void gla_phase(const GAS float* __restrict__ PROJ, const GAS float* __restrict__ LOGA, GAS float* __restrict__ O, GAS float* __restrict__ P, int B, int T, LAS unsigned char* lds, int tid, int bid, int nb) {
    constexpr int TB = 32, NLD = 4, VECB = TB * 768, VVB = TB * 64, BUF = VECB + 3 * VVB;
    const int col = tid >> 5, half = (tid >> 4) & 1, p = tid & 15, dk = half * 32 + p * 2;
    const int nunits = B * 32;
    for (int u = bid; u < nunits; u += nb) {
        const int ug_ = ((u & 7) << 3 | ((u >> 3) & 7)) + ((u >> 6) << 6);
        const int cb = ug_ & 7, pair = ug_ >> 3, s = pair >> 2, h = pair & 3; const int r0 = s * T;
        float S0 = 0.f, S1 = 0.f;
        const int nblk = (T + TB - 1) / TB;
        f32x4 ld[NLD];
        const size_t ea_ = (size_t)(r0 + (tid >> 4)) * 256 + h * 64 + (tid & 15) * 4, ep_ = (size_t)(r0 + (tid >> 4)) * 2576 + h * 64 + (tid & 15) * 4, ev_ = (size_t)(r0 + ((tid & 127) >> 2)) * 2576 + 512 + h * 128 + cb * 16 + (tid & 3) * 4;
        const int lo_ = ((tid >> 4) * 192 + (tid & 15) * 4) * 4, lv_ = VECB + (tid & 127) * 16;
#define GLA_LOAD(tb0) do { ld[0] = *(const GAS f32x4*)(LOGA + ea_ + (size_t)(tb0) * 256); ld[1] = *(const GAS f32x4*)(PROJ + ep_ + 256 + (size_t)(tb0) * 2576); ld[2] = *(const GAS f32x4*)(PROJ + ep_ + (size_t)(tb0) * 2576); ld[3] = *(const GAS f32x4*)(PROJ + ev_ + (size_t)(tb0) * 2576); } while (0)
#define GLA_STORE(bufp) do { *(LAS f32x4*)((bufp) + lo_) = ld[0]; *(LAS f32x4*)((bufp) + lo_ + 256) = ld[1]; *(LAS f32x4*)((bufp) + lo_ + 512) = ld[2] * 0.125f; *(LAS f32x4*)((bufp) + lv_) = ld[3]; } while (0)
        GLA_LOAD(0); GLA_STORE(lds); __syncthreads();
        for (int b = 0; b < nblk; ++b) {
            LAS unsigned char* cur = lds + (b & 1) * BUF; LAS unsigned char* nxt = lds + ((b + 1) & 1) * BUF; const int tb0 = b * TB; const int nt = (T - tb0) < TB ? (T - tb0) : TB;
            if (b + 1 < nblk) GLA_LOAD(tb0 + TB);
            const LAS float* vec = (const LAS float*)cur + dk; const LAS float* vv = (const LAS float*)(cur + VECB) + col; LAS float* ob = (LAS float*)(cur + VECB + VVB);
            float okeep0 = 0.f, okeep1 = 0.f;
#define GLA_STEP(t, keep, tl) do { const f32x2 a2 = *(const LAS f32x2*)(vec + (t) * 192), k2 = *(const LAS f32x2*)(vec + (t) * 192 + 64), q2 = *(const LAS f32x2*)(vec + (t) * 192 + 128); const float v = vv[(t) * 16]; \
                S0 = fmaf(a2.x, S0, k2.x * v); S1 = fmaf(a2.y, S1, k2.y * v); \
                float o = fmaf(q2.x, S0, q2.y * S1); o = row_sum16(o); keep = (p == (tl)) ? o : keep; } while (0)
            if (nt == TB) {
#pragma unroll 1
                for (int t = 0; t < 16; t += 4) { GLA_STEP(t, okeep0, t); GLA_STEP(t + 1, okeep0, t + 1); GLA_STEP(t + 2, okeep0, t + 2); GLA_STEP(t + 3, okeep0, t + 3); }
#pragma unroll 1
                for (int t = 16; t < 32; t += 4) { GLA_STEP(t, okeep1, t - 16); GLA_STEP(t + 1, okeep1, t - 15); GLA_STEP(t + 2, okeep1, t - 14); GLA_STEP(t + 3, okeep1, t - 13); }
            } else { for (int t = 0; t < nt; ++t) { if (t < 16) GLA_STEP(t, okeep0, t); else GLA_STEP(t, okeep1, t - 16); } }
#undef GLA_STEP
            ob[(p * 16 + col) * 2 + half] = okeep0; ob[((16 + p) * 16 + col) * 2 + half] = okeep1;
            if (b + 1 < nblk) GLA_STORE(nxt);
            __syncthreads();
            { const int t = tid >> 4, c = tid & 15; if (t < nt) { const f32x2 o2 = *(const LAS f32x2*)(ob + (t * 16 + c) * 2); O[(size_t)(r0 + tb0 + t) * 512 + h * 128 + cb * 16 + c] = o2.x + o2.y; } }
        }
#undef GLA_LOAD
#undef GLA_STORE
        { GAS float* so = P + ((size_t)pair * 64 + dk) * 128 + cb * 16 + col; so[0] = S0; so[128] = S1; }
        __syncthreads();
    }
}
__device__ __forceinline__ float grp8_sum(float v) { v += dppf<0xB1>(v); v += dppf<0x4E>(v); v += dppf<0x141>(v); return v; }
__device__ __forceinline__ float dot16_fp8_bf16(const u32x4 uw, const float (&x)[16]) { float s = 0.f;
#pragma unroll
    for (int d = 0; d < 4; ++d) { const f32x2 lo = fp8lo(uw[d]), hi = fp8hi(uw[d]); s = fmaf(lo.x, x[4 * d], s); s = fmaf(lo.y, x[4 * d + 1], s); s = fmaf(hi.x, x[4 * d + 2], s); s = fmaf(hi.y, x[4 * d + 3], s); }
    return s; }
typedef int i32x8 __attribute__((ext_vector_type(8)));
typedef unsigned u32x8 __attribute__((ext_vector_type(8)));
__device__ __forceinline__ void pacts_phase(const GAS unsigned char* XF8, const GAS unsigned char* U8S, const GAS int* EIDX, GAS float* __restrict__ PART, int M, int emask,
                                            LAS unsigned char* lds, int wid, int lane, int bid, int nb) {
    const bool spl = (nb & 7) == 0; const int s0 = spl ? (bid & 7) : 0, s1 = spl ? s0 + 1 : 8, r = spl ? (bid >> 3) : bid, nr = spl ? (nb >> 3) : nb;
    const int g = lane >> 3, c = lane & 7, fg = ((g >> 2) & 1) | (((g >> 1) & 1) << 2);
    const int m16 = lane & 15, kb = lane >> 4, fm = ((m16 >> 2) & 1) | (((m16 >> 1) & 1) << 2);
    LAS unsigned char* const wl = lds + wid * 16384;
    const LAS unsigned char* const ard = wl + m16 * 128 + (((2 * kb) ^ fm) * 16);
    const LAS unsigned char* const xrd = wl + 12288 + (m16 & 1) * 128 + kb * 32;
    const LAS unsigned char* const ird = wl + 13824 + g * 4;
    if (r >= M) return;
    const int ntok = (M - r + nr - 1) / nr;
#define PL_ROW(t_) ({ int rw_ = r + nr * (t_); rw_ < M ? rw_ : r; })
#define PL_IDS(t_, slot_) __builtin_amdgcn_global_load_lds((const GAS unsigned*)(isrc + (size_t)PL_ROW(t_) * 128), (LAS unsigned*)(wl + 13824 + (slot_) * 256), 4, 0, 0)
#define PL_TILE(t_, slot_) do { const int e0 = *(const LAS int*)(ird + (slot_) * 256) & emask, e1 = *(const LAS int*)(ird + (slot_) * 256 + 32) & emask; \
        __builtin_amdgcn_global_load_lds((const GAS unsigned*)(tb + (size_t)e0 * 128), (LAS unsigned*)(wl + (slot_) * 2048), 16, 0, 0); \
        __builtin_amdgcn_global_load_lds((const GAS unsigned*)(tb + (size_t)e1 * 128), (LAS unsigned*)(wl + (slot_) * 2048 + 1024), 16, 0, 0); \
        __builtin_amdgcn_global_load_lds((const GAS unsigned*)(xsrc + (size_t)PL_ROW(t_) * 2048), (LAS unsigned*)(wl + 12288 + (slot_) * 256), 4, 0, 0); } while (0)
#define PL_COMP(t_, slot_) do { const u32x4 a0 = *(const LAS u32x4*)(ard + (slot_) * 2048), a1 = *(const LAS u32x4*)((const LAS unsigned char*)((unsigned)(size_t)ard ^ 16u) + (slot_) * 2048); \
        const u32x4 x0 = *(const LAS u32x4*)(xrd + (slot_) * 256), x1 = *(const LAS u32x4*)(xrd + (slot_) * 256 + 16); \
        const i32x8 av = (i32x8)__builtin_shufflevector(a0, a1, 0, 1, 2, 3, 4, 5, 6, 7), bv = (i32x8)__builtin_shufflevector(x0, x1, 0, 1, 2, 3, 4, 5, 6, 7); const f32x4 z = {0.f, 0.f, 0.f, 0.f}; \
        const f32x4 cc = __builtin_amdgcn_mfma_scale_f32_16x16x128_f8f6f4(av, bv, z, 0, 0, 0, 0, 0, 0); f32x4 o; \
        _Pragma("unroll") for (int i = 0; i < 4; ++i) { float v = cc[i]; v += dppf<0xB1>(v); o[i] = v * (1.f / 16.f); } \
        const int rw = r + nr * (t_); if (m16 == 0 && rw < M) *(GAS f32x4*)(po + (size_t)rw * 128) = o; } while (0)
#define PL_WAIT(n_) asm volatile("s_waitcnt vmcnt(" #n_ ")" ::: "memory")
#define PL_STEP(j_, k_) do { PL_WAIT(16); PL_COMP((j_), (k_)); PL_IDS((j_) + 10, ((k_) + 4) % 6); PL_TILE((j_) + 5, ((k_) + 5) % 6); } while (0)
    for (int s = s0; s < s1; ++s) {
        const GAS unsigned char* tb = U8S + (size_t)s * 16384 * 128 + ((c ^ fg) * 16);
        const GAS unsigned char* xsrc = XF8 + (size_t)(lane >> 5) * 1024 + s * 128 + (lane & 31) * 4;
        const GAS int* isrc = EIDX + wid * 16 + m16;
        GAS float* po = PART + (size_t)s * M * 128 + wid * 16 + kb * 4;
        PL_IDS(0, 0); PL_IDS(1, 1); PL_IDS(2, 2); PL_IDS(3, 3); PL_IDS(4, 4); PL_WAIT(0);
        PL_IDS(5, 5); PL_TILE(0, 0); PL_IDS(6, 0); PL_TILE(1, 1); PL_IDS(7, 1); PL_TILE(2, 2); PL_IDS(8, 2); PL_TILE(3, 3); PL_IDS(9, 3); PL_TILE(4, 4);
        for (int j = 0; j < ntok; j += 6) { PL_STEP(j, 0); PL_STEP(j + 1, 1); PL_STEP(j + 2, 2); PL_STEP(j + 3, 3); PL_STEP(j + 4, 4); PL_STEP(j + 5, 5); }
        PL_WAIT(0);
    }
#undef PL_ROW
#undef PL_IDS
#undef PL_TILE
#undef PL_COMP
#undef PL_WAIT
#undef PL_STEP
}
__device__ __forceinline__ void pouts_phase(const GAS float* __restrict__ COEF, const GAS int* __restrict__ EIDX, const GAS unsigned char* V8S, GAS bf16_t* __restrict__ YBUF, int M,
                                            int wid, int lane, int bid, int nb) {
    const bool spl = (nb & 7) == 0; const int s0 = spl ? (bid & 7) : 0, s1 = spl ? s0 + 1 : 8, r = spl ? (bid >> 3) : bid, nr = spl ? (nb >> 3) : nb;
    const int g = lane >> 3, ch = lane & 7, rstep = nr * 8;
#define PO_LOADCE(rw, c0, c1, v0, v1) do { c0 = COEF[(size_t)(rw) * 128 + lane] * (1.f / 64.f); c1 = COEF[(size_t)(rw) * 128 + 64 + lane] * (1.f / 64.f); v0 = EIDX[(size_t)(rw) * 128 + lane]; v1 = EIDX[(size_t)(rw) * 128 + 64 + lane]; } while (0)
#define PO_GATHER(vv_, vreg) do { _Pragma("unroll") for (int k = 0; k < 8; ++k) { const int e = __builtin_amdgcn_ds_bpermute((8 * k + g) << 2, vreg); vv_[k] = *(const GAS u32x4*)(tb + (size_t)(e & 16383) * 128); } } while (0)
#define PO_COMP(vv_, creg) do { _Pragma("unroll") for (int k = 0; k < 8; ++k) { const float c = __int_as_float(__builtin_amdgcn_ds_bpermute((8 * k + g) << 2, __float_as_int(creg))); const u32x4 w = vv_[k]; \
        _Pragma("unroll") for (int d = 0; d < 4; ++d) { const f32x2 lo = fp8lo(w[d]), hi = fp8hi(w[d]); acc[4 * d] = fmaf(c, lo.x, acc[4 * d]); acc[4 * d + 1] = fmaf(c, lo.y, acc[4 * d + 1]); acc[4 * d + 2] = fmaf(c, hi.x, acc[4 * d + 2]); acc[4 * d + 3] = fmaf(c, hi.y, acc[4 * d + 3]); } \
        _Pragma("unroll") for (int i = 0; i < 16; ++i) asm volatile("" : "+v"(acc[i])); } } while (0)
    for (int s = s0; s < s1; ++s) {
        const GAS unsigned char* tb = V8S + (size_t)s * 16384 * 128 + ch * 16;
        int row = r + nr * wid; if (row >= M) continue;
        float c0c, c1c, c0n = 0.f, c1n = 0.f; int v0c, v1c, v0n = 0, v1n = 0;
        PO_LOADCE(row, c0c, c1c, v0c, v1c);
        u32x4 va[8], vb[8];
        PO_GATHER(va, v0c);
        for (;;) {
            const int rown = row + rstep; const bool hasn = rown < M;
            PO_GATHER(vb, v1c);
            if (hasn) PO_LOADCE(rown, c0n, c1n, v0n, v1n);
            float acc[16];
#pragma unroll
            for (int i = 0; i < 16; ++i) acc[i] = 0.f;
            PO_COMP(va, c0c);
            if (hasn) PO_GATHER(va, v0n);
            PO_COMP(vb, c1c);
#pragma unroll
            for (int i = 0; i < 16; ++i) acc[i] += dppf<0x128>(acc[i]);
#pragma unroll
            for (int i = 0; i < 8; ++i) { const bool hi = lane & 16; const float send = hi ? acc[i] : acc[i + 8], keep = hi ? acc[i + 8] : acc[i]; acc[i] = keep + shx(send, 16, lane); }
#pragma unroll
            for (int i = 0; i < 4; ++i) { const bool hi = lane & 32; const float send = hi ? acc[i] : acc[i + 4], keep = hi ? acc[i + 4] : acc[i]; acc[i] = keep + shx(send, 32, lane); }
            if ((lane & 8) == 0) { u32x2 w_; w_.x = pk_bf16(acc[0], acc[1]); w_.y = pk_bf16(acc[2], acc[3]); *(GAS u32x2*)(YBUF + (size_t)row * 1024 + s * 128 + ch * 16 + ((lane >> 4) & 1) * 8 + ((lane >> 5) & 1) * 4) = w_; }
            if (!hasn) break;
            row = rown; c0c = c0n; c1c = c1n; v0c = v0n; v1c = v1n;
        }
    }
#undef PO_LOADCE
#undef PO_GATHER
#undef PO_COMP
}
}

template <class T> __device__ __forceinline__ __attribute__((address_space(1))) T* gp(T* p) { return (__attribute__((address_space(1))) T*)uni_ptr(p); }
constexpr int MK_THREADS = 512, LDS_BYTES = 163840, LDSCTL_OFF = 131072, TAB_OFF = LDSCTL_OFF + 1024, MAX_OPS = 208;
static_assert(TAB_OFF + MAX_OPS * (int)sizeof(Op) <= LDS_BYTES, "LDS map");
constexpr int MPAD = 17152;
constexpr size_t CTL_BYTES = (size_t)1 << 20;
struct MArgs { const float* in[47]; float* out; char* ws; unsigned long long ws_size; };
__global__ void __launch_bounds__(MK_THREADS, 2) mega_fwd(MArgs a) {
    extern __shared__ __attribute__((aligned(16))) unsigned char lds[];
    volatile LAS unsigned* ctl = (volatile LAS unsigned*)((LAS unsigned char*)lds + LDSCTL_OFF);
    if (threadIdx.x < 64) ctl[threadIdx.x] = 0u;
    __syncthreads();
    (void)xcd_barrier_post((unsigned*)a.ws, ctl + 8);
    const Dm dm = make_dm(1024, 8, 2048, 128, 4);
    Op* tab = (Op*)(lds + TAB_OFF);
    if (threadIdx.x == 0) {
        const float* const* inp_ = (const float* const*)__builtin_amdgcn_kernarg_segment_ptr(); asm volatile("" : "+s"(inp_));
        NvIO io; io.in = inp_; io.out = a.out; io.ws = a.ws + CTL_BYTES; io.ws_size = a.ws_size - CTL_BYTES;
        int n = 0;
        nv_forward(io, dm, [&](const Op& o) __attribute__((always_inline)) { if (n < MAX_OPS) tab[n] = o; ++n; asm volatile("" ::: "memory"); });
        ctl[16] = (unsigned)(n <= MAX_OPS ? n : 0);
    }
    __syncthreads();
    const int nops = (int)ctl[16];
    for (int i = 0; i < nops; ++i) {
        int tid_ = (int)threadIdx.x, bid_ = (int)blockIdx.x, nb_ = (int)gridDim.x;
        asm volatile("" : "+v"(tid_)); asm volatile("" : "+s"(bid_)); asm volatile("" : "+s"(nb_));
        const long long g0 = (long long)bid_ * MK_THREADS + tid_, gs = (long long)nb_ * MK_THREADS;
        const Op& o = tab[i];
        const int rawc = __builtin_amdgcn_readfirstlane(o.code); const int code = rawc & 0xff; const long long n = o.n;
        switch (code) {
        case OP_FGEMM: {
            const int fl = rfl(o.i6);
            pg8::Gemm g{uni_ptr((const pg8::bf16_t*)o.a), uni_ptr((const pg8::bf16_t*)o.b), MPAD, rfl(o.i5), rfl(o.i1), rfl(o.i2), rfl(o.i3)};
            if (rawc & OPF_GROUP) {
                int ng = 1; while (ng < 8 && (rfl(tab[i + ng - 1].code) & OPF_GROUP)) ++ng;
                const PG8_LAS Op* gt = (const PG8_LAS Op*)((PG8_LAS unsigned char*)lds + TAB_OFF) + i;
                pg8::GroupOrder S; S.tab = gt; S.ng = ng; S.nM = MPAD / 256; S.G = nb_; S.c = bid_; S.tsA = (size_t)256 * g.lda * 2; S.tsB = (size_t)256 * g.ldb * 2;
                pg8::EpiGroup E{gt, dm.M};
                pg8::gemm_phase<pg8::EpiGroup, pg8::GroupOrder, true, true>((PG8_LAS unsigned char*)lds, g, S, E);
                i += ng - 1;
            } else {
            pg8::StaticOrder S; S.init(g, nb_, bid_); if (fl & 2) S.acs = 512;
            float* const c0 = uni_ptr(o.o0); const int ldc0 = rfl(o.i4), nreal0 = rfl(o.i0);
            if (fl & 1) { pg8::EpiBf16Plain E{(pg8::bf16_t*)c0, ldc0}; pg8::gemm_phase<pg8::EpiBf16Plain, pg8::StaticOrder, true, true>((PG8_LAS unsigned char*)lds, g, S, E); }
            else { pg8::EpiF32 E{c0, ldc0, dm.M, nreal0}; pg8::gemm_phase<pg8::EpiF32, pg8::StaticOrder, true, true>((PG8_LAS unsigned char*)lds, g, S, E); }
            }
        } break;
        case OP_LRUG2: {
            pg8::Gemm g{uni_ptr((const pg8::bf16_t*)o.a), uni_ptr((const pg8::bf16_t*)o.b), MPAD, 1024, 512, 512, 512};
            pg8::StaticOrder S; S.init(g, nb_, bid_);
            pg8::EpiLru E{uni_ptr(o.c), uni_ptr(o.d), uni_ptr(o.e), uni_ptr(o.f), uni_ptr(o.o0), uni_ptr(o.o1), dm.M};
            pg8::gemm_phase<pg8::EpiLru, pg8::StaticOrder, true, true>((PG8_LAS unsigned char*)lds, g, S, E);
        } break;
        case OP_WKVP: fk::wkv2_phase(gp((const fk::bf16_t*)o.a), gp((const fk::bf16_t*)o.b), gp((const fk::bf16_t*)o.c), gp((const fk::bf16_t*)o.d), gp((const fk::bf16_t*)o.e), gp((const fk::bf16_t*)o.f), gp(o.g), gp(o.h), gp((const float*)o.o5), gp(o.o0), gp(o.o1), gp(o.o2), gp(o.o3), gp(o.o4), rfl(o.i0), dm.B, dm.T, dm.DB, dm.DT, (LAS unsigned char*)lds, tid_, bid_, nb_); break;
        case OP_POST2: fk::rwkvpost2_phase(gp(o.a), gp((const fk::bf16_t*)o.b), gp(o.c), gp(o.d), gp(o.e), gp(o.f), gp((fk::bf16_t*)o.o0), dm.M * 16, tid_ & 63, bid_ * 8 + (tid_ >> 6), nb_ * 8); break;
        case OP_GLAF: fk::gla_phase(gp(o.a), gp(o.b), gp(o.o0), gp(o.o1), dm.B, dm.T, (LAS unsigned char*)lds, tid_, bid_, nb_); break;
        case OP_PACTS: fk::pacts_phase(gp((const unsigned char*)o.a), gp((const unsigned char*)o.b), gp((const int*)o.d), gp(o.o0), dm.M, rfl(o.i0), (LAS unsigned char*)lds, rfl(tid_ >> 6), tid_ & 63, bid_, nb_); break;
        case OP_POUTS: fk::pouts_phase(gp(o.a), gp((const int*)o.b), gp((const unsigned char*)o.c), gp((fk::bf16_t*)o.o0), dm.M, tid_ >> 6, tid_ & 63, bid_, nb_); break;
        case OP_TOPK2: fk::topk_phase(gp(o.a), gp((const fk::bf16_t*)o.b), gp(o.c), gp(o.o0), gp((int*)o.o1), dm.M * 8, (LAS unsigned char*)lds, tid_ >> 6, tid_ & 63, bid_ * 8 + (tid_ >> 6), nb_ * 8); break;
        case OP_LNRES: fk::lnres_phase(gp((const fk::bf16_t*)o.a), gp(o.b), gp(o.c), gp(o.o0), gp((fk::bf16_t*)o.o1), gp((unsigned char*)o.o2), dm.M, tid_ & 63, bid_ * 8 + (tid_ >> 6), nb_ * 8); break;
        case OP_GLANORM: fk::glanorm_phase(gp(o.a), gp(o.b), gp(o.c), gp((fk::bf16_t*)o.o0), dm.M * 4, tid_ & 63, bid_ * 8 + (tid_ >> 6), nb_ * 8); break;
#define NVC(c) case c: for (long long g = g0; g < n; g += gs) nv_elem(c, o, dm, g); break;
        NVC(OP_LOGA4) NVC(OP_CONVOUT) NVC(OP_SHIFTOUT) NVC(OP_EMBED4) NVC(OP_YOUT4) NVC(OP_MIX6) NVC(OP_CONV4) NVC(OP_CVT8) NVC(OP_WGATE)
        NVC(OP_WT) NVC(OP_CVTTAB8S) NVC(OP_PRED) NVC(OP_PRM) NVC(OP_KEYS) NVC(OP_GLA3) NVC(OP_LRU1) NVC(OP_LRU2) NVC(OP_LRU3)
#undef NVC
        default: break;
        }
        if (__builtin_amdgcn_readfirstlane(tab[i].code) & OPF_NOBAR) __syncthreads(); else { XcdBarrier bar; bar.bar = (unsigned*)a.ws; bar.x = xb_xcc_id(); bar.st = ctl + 8; xcd_barrier(bar); }
    }
}
extern "C" void kernel_launch(void* const* d_in, const int* in_sizes, int n_in, void* d_out, int out_size, void* d_ws, size_t ws_size, hipStream_t stream) {
    static int grid = 0;
    if (grid == 0) {
        if (n_in != 47 || ws_size < ((size_t)900 << 20)) { fprintf(stderr, "kernel_launch: expected 47 inputs and >= 900 MiB of workspace; got %d, %zu\n", n_in, ws_size); grid = -1; return; }
        int dev = 0, cus = 0, per_cu = 0;
        if (hipGetDevice(&dev) != hipSuccess || hipDeviceGetAttribute(&cus, hipDeviceAttributeMultiprocessorCount, dev) != hipSuccess) { grid = -1; return; }
        if (hipFuncSetAttribute((const void*)mega_fwd, hipFuncAttributeMaxDynamicSharedMemorySize, LDS_BYTES) != hipSuccess) { fprintf(stderr, "kernel_launch: hipFuncSetAttribute failed\n"); grid = -1; return; }
        if (hipOccupancyMaxActiveBlocksPerMultiprocessor(&per_cu, (const void*)mega_fwd, MK_THREADS, LDS_BYTES) != hipSuccess || per_cu < 1) fprintf(stderr, "kernel_launch: occupancy query says %d per CU\n", per_cu);
        (void)hipGetLastError();
        grid = cus;
    }
    if (grid < 0) return;
    if (hipMemsetAsync(d_ws, 0, CTL_BYTES, stream) != hipSuccess) { fprintf(stderr, "kernel_launch: memset failed\n"); return; }
    MArgs a{}; for (int i = 0; i < 47; ++i) a.in[i] = (const float*)d_in[i]; a.out = (float*)d_out; a.ws = (char*)d_ws; a.ws_size = (unsigned long long)ws_size;
    hipLaunchKernelGGL(mega_fwd, dim3(grid), dim3(MK_THREADS), LDS_BYTES, stream, a);
}
```

```cpp
#include <hip/hip_runtime.h>
#include <cstdio>
#include <cmath>
#ifndef HD
#define HD __host__ __device__ __forceinline__
#endif
struct Dm { int D, B, T, DB, DT, M, NSEQ, RH; };
HD Dm make_dm(int D, int B, int SEQ, int DB, int DT) { Dm d; d.D = D; d.B = B; d.T = SEQ + 16; d.DB = DB; d.DT = DT; d.M = B * d.T + DB * DT; d.NSEQ = B + DB; d.RH = D / 64; return d; }
HD int seq_row0(const Dm& d, int s) { return s < d.B ? s * d.T : d.B * d.T + (s - d.B) * d.DT; }
HD int seq_len(const Dm& d, int s) { return s < d.B ? d.T : d.DT; }
HD void row_to_seq(const Dm& d, int row, int& s, int& t) { if (row < d.B * d.T) { s = row / d.T; t = row % d.T; } else { int r = row - d.B * d.T; s = d.B + r / d.DT; t = r % d.DT; } }

constexpr int MIXIN = 2576, C_Q = 0, C_K = 256, C_V = 512, C_GLR = 1024, C_R = 1040, C_XB = 1552, C_GB = 2064;

enum { OP_EMBED = 1, OP_GEMM, OP_LOGA, OP_GLA, OP_GLANORM, OP_CONV, OP_CONVOUT, OP_LRUG, OP_LRUSCAN, OP_LNRES, OP_MIX, OP_SHIFTOUT,
       OP_RWKVPREP, OP_WKV, OP_RWKVPOST, OP_QNORM, OP_SCORES, OP_TOPK, OP_PACT1, OP_PACT2, OP_POUT, OP_YOUT, OP_WT, OP_CVT, OP_FGEMM, OP_CVTTAB, OP_KEYS, OP_TOPK2, OP_PACT, OP_POUTLN, OP_GLA1, OP_GLA2, OP_GLA3, OP_LRU1, OP_LRU2, OP_LRU3, OP_EMBED4, OP_YOUT4, OP_MIX8, OP_CONV4, OP_CVT8, OP_WGATE, OP_LRUG2, OP_WKVF, OP_GLAF, OP_CVTTAB8, OP_CVTTAB8S, OP_PACTS, OP_PRED, OP_POUTS, OP_MIX6, OP_PRM, OP_WKVP, OP_POST2, OP_LOGA4 };

constexpr int OPF_NOBAR = 0x100, OPF_GROUP = 0x200;
struct Op {
    const float *a, *b, *c, *d, *e, *f, *g, *h;
    float *o0, *o1, *o2, *o3, *o4, *o5;
    long long n;
    int code, i0, i1, i2, i3, i4, i5, i6;
};

#if defined(__HIP_DEVICE_COMPILE__)
#define NV_UNI(x) __builtin_amdgcn_readfirstlane(x)
#define NV_LAUNDER(p) asm volatile("" : "+s"(p))
#define NV_FENCE() asm volatile("" ::: "memory")
#else
#define NV_FENCE() do {} while (0)
#define NV_UNI(x) (x)
#define NV_LAUNDER(p) do {} while (0)
#endif
typedef unsigned short nvbf;
HD nvbf nv_f2bf(float f) { unsigned u; __builtin_memcpy(&u, &f, 4); return (nvbf)((u + 0x7fffu + ((u >> 16) & 1u)) >> 16); }
HD float nv_bf2f(nvbf h) { unsigned u = (unsigned)h << 16; float f; __builtin_memcpy(&f, &u, 4); return f; }
HD unsigned nv_f2e4m3(float f) {
    unsigned u; __builtin_memcpy(&u, &f, 4); const unsigned sign = (u >> 24) & 0x80u; const float a = fabsf(f);
    if (!(a < 448.f)) return sign | 0x7Eu;
    if (a < 0.015625f) return sign | (unsigned)rintf(a * 512.f);
    unsigned au = u & 0x7fffffffu; au += 0x7ffffu + ((au >> 20) & 1u);
    const unsigned e = ((au >> 23) & 0xffu) - 120u, m = (au >> 20) & 7u; unsigned code = (e << 3) | m; if (code > 0x7Eu) code = 0x7Eu;
    return sign | code; }
HD float nv_e4m32f(unsigned c) { const unsigned e = (c >> 3) & 15u, m = c & 7u; const float v = e ? ldexpf(1.f + m * 0.125f, (int)e - 7) : m * 0.001953125f; return (c & 0x80u) ? -v : v; }
HD int nv_rup(int x, int m) { return (x + m - 1) / m * m; }
struct alignas(16) NvF4 { float x, y, z, w; };
struct alignas(16) NvU4 { unsigned x, y, z, w; };
struct alignas(8) NvU2 { unsigned x, y; };
HD float nv_sigmoid(float x) { return 1.f / (1.f + expf(-x)); }
HD float nv_softplus(float x) { return fmaxf(x, 0.f) + log1pf(expf(-fabsf(x))); }
HD float nv_gelu(float x) { return 0.5f * x * (1.f + tanhf(0.7978845608028654f * (x + 0.044715f * x * x * x))); }

#define NV_INS16(tv, ti, val, idx) do { float _v = (val); int _i = (idx); _Pragma("unroll") for (int _j = 0; _j < 16; ++_j) { if (_v > tv[_j]) { float _tv = tv[_j]; int _ti = ti[_j]; tv[_j] = _v; ti[_j] = _i; _v = _tv; _i = _ti; } } } while (0)

HD void nv_elem(const int code, const Op& p, const Dm& dm, long long gid) {
    const int D = dm.D; float* const PO1 = p.o1; float* const PO2 = p.o2;
    switch (code) {
    case OP_EMBED: {
        int row = (int)(gid / D), c = (int)(gid % D); float v;
        if (row < dm.B * dm.T) { int bb = row / dm.T, t = row % dm.T; v = t < 16 ? p.c[t * D + c] : p.a[((size_t)bb * (dm.T - 16) + (t - 16)) * D + c]; }
        else v = p.b[(size_t)(row - dm.B * dm.T) * D + c];
        p.o0[gid] = v; ((nvbf*)p.o1)[gid] = nv_f2bf(v); } break;
    case OP_GEMM: {
        int N4 = p.i0 >> 2, K = p.i1; int m = (int)(gid / N4), nn = (int)(gid % N4) * 4; const float* A = p.a + (size_t)m * p.i2; const float* Bw = p.b + nn; float c0 = 0.f, c1 = 0.f, c2 = 0.f, c3 = 0.f;
        for (int k = 0; k < K; ++k) { float av = A[k]; if (p.i5 == 1) av = tanhf(av); else if (p.i5 == 2) av = nv_sigmoid(av); const NvF4 bv = *(const NvF4*)(Bw + (size_t)k * p.i3);
            c0 = fmaf(av, bv.x, c0); c1 = fmaf(av, bv.y, c1); c2 = fmaf(av, bv.z, c2); c3 = fmaf(av, bv.w, c3); }
        float* C = p.o0 + (size_t)m * p.i4 + nn; C[0] = c0; C[1] = c1; C[2] = c2; C[3] = c3; } break;
    case OP_LOGA: {
        int row = (int)(gid / 256), c = (int)(gid % 256); float z = p.c[c];
        for (int r = 0; r < 16; ++r) z = fmaf(p.a[(size_t)row * MIXIN + C_GLR + r], p.b[r * 256 + c], z);
        p.o0[gid] = expf(-nv_softplus(-z) * (1.f / 16.f)); } break;
    case OP_GLAF:
    case OP_GLA: {
        int s = (int)(gid / 512), h = (int)((gid / 128) % 4), col = (int)(gid % 128);
        float S[64];
        const float* sin = (s < dm.B) ? nullptr : p.c + (((size_t)(s - dm.B) * 4 + h) * 64) * 128 + col;
#pragma unroll
        for (int k = 0; k < 64; ++k) S[k] = sin ? sin[(size_t)k * 128] : 0.f;
        int r0 = seq_row0(dm, s), L = seq_len(dm, s);
        for (int t = 0; t < L; ++t) {
            const float* pr = p.a + (size_t)(r0 + t) * MIXIN; const float* la = p.b + (size_t)(r0 + t) * 256 + h * 64;
            float v = pr[C_V + h * 128 + col], o = 0.f;
#pragma unroll
            for (int k = 0; k < 64; ++k) { if ((k & 7) == 0) NV_FENCE(); S[k] = fmaf(la[k], S[k], pr[C_K + h * 64 + k] * v); o = fmaf(pr[C_Q + h * 64 + k] * 0.125f, S[k], o); }
            p.o0[(size_t)(r0 + t) * 512 + h * 128 + col] = o;
        }
        float* so = (s < dm.B) ? PO1 + (((size_t)s * 4 + h) * 64) * 128 + col : PO2 + (((size_t)(s - dm.B) * 4 + h) * 64) * 128 + col;
#pragma unroll
        for (int k = 0; k < 64; ++k) so[(size_t)k * 128] = S[k]; } break;
    case OP_GLA1: {
        const int NC = p.i0; const int u = NV_UNI((int)(gid / 128)), col = (int)(gid % 128); const int s = u / (4 * NC), h = (u / NC) % 4, c = u % NC;
        const int r0 = seq_row0(dm, s) + c * 64; int L = dm.T - c * 64; L = L > 64 ? 64 : L;
        float S[64];
#pragma unroll
        for (int k = 0; k < 64; ++k) S[k] = 0.f;
        float dprod = 1.f;
        for (int t = 0; t < L; ++t) {
            const float* pr = p.a + (size_t)(r0 + t) * MIXIN; const float* la = p.b + (size_t)(r0 + t) * 256 + h * 64; const float v = pr[C_V + h * 128 + col];
            if (col < 64) dprod *= la[col];
#pragma unroll
            for (int k = 0; k < 64; ++k) { if ((k & 7) == 0) NV_FENCE(); S[k] = fmaf(la[k], S[k], pr[C_K + h * 64 + k] * v); }
        }
        float* so = p.o0 + (size_t)u * 8192 + col;
#pragma unroll
        for (int k = 0; k < 64; ++k) so[(size_t)k * 128] = S[k];
        if (col < 64) p.o1[(size_t)u * 64 + col] = dprod; } break;
    case OP_GLA2: {
        const int NC = p.i0; const int pair = (int)(gid / 8192), e = (int)(gid % 8192), dk = e / 128; float S = 0.f;
        for (int c = 0; c < NC; ++c) { const size_t ix = ((size_t)pair * NC + c) * 8192 + e; const float l = p.o0[ix]; p.o0[ix] = S; S = fmaf(p.a[((size_t)pair * NC + c) * 64 + dk], S, l); }
        p.o1[gid] = S; } break;
    case OP_GLA3: {
        const int NC = p.i0; const int NP = dm.B * 4 * NC; const int u = NV_UNI((int)(gid / 128)) + (p.i1 ? NP : 0), col = (int)(gid % 128); int s, h, r0, L; const float* sin; float* sout = nullptr;
        if (u < NP) { s = u / (4 * NC); h = (u / NC) % 4; const int c = u % NC; r0 = seq_row0(dm, s) + c * 64; L = dm.T - c * 64; L = L > 64 ? 64 : L; sin = p.d + (size_t)u * 8192 + col; }
        else { const int q = u - NP; s = dm.B + q / 4; h = q % 4; r0 = seq_row0(dm, s); L = dm.DT; sin = p.c + (((size_t)(s - dm.B) * 4 + h) * 64) * 128 + col; sout = p.o2 + (((size_t)(s - dm.B) * 4 + h) * 64) * 128 + col; }
        float S[64];
#pragma unroll
        for (int k = 0; k < 64; ++k) S[k] = sin[(size_t)k * 128];
        for (int t = 0; t < L; ++t) {
            const float* pr = p.a + (size_t)(r0 + t) * MIXIN; const float* la = p.b + (size_t)(r0 + t) * 256 + h * 64; const float v = pr[C_V + h * 128 + col]; float o = 0.f;
#pragma unroll
            for (int k = 0; k < 64; ++k) { if ((k & 7) == 0) NV_FENCE(); S[k] = fmaf(la[k], S[k], pr[C_K + h * 64 + k] * v); o = fmaf(pr[C_Q + h * 64 + k] * 0.125f, S[k], o); }
            p.o0[(size_t)(r0 + t) * 512 + h * 128 + col] = o;
        }
        if (sout) {
#pragma unroll
            for (int k = 0; k < 64; ++k) sout[(size_t)k * 128] = S[k]; } } break;
    case OP_LRU1: {
        const int NC = p.i0; const int u = (int)(gid / 512), c = (int)(gid % 512); const int s = u / NC, ch = u % NC; const int r0 = seq_row0(dm, s) + ch * 64; int L = dm.T - ch * 64; L = L > 64 ? 64 : L; float hh = 0.f, ap = 1.f;
#pragma unroll 8
        for (int t = 0; t < L; ++t) { const size_t ix = (size_t)(r0 + t) * 512 + c; const float a = p.a[ix]; hh = fmaf(a, hh, p.b[ix]); ap *= a; }
        p.o0[gid] = ap; p.o1[gid] = hh; } break;
    case OP_LRU2: {
        const int NC = p.i0; const int s = (int)(gid / 512), c = (int)(gid % 512); float hh = 0.f;
#pragma unroll 8
        for (int ch = 0; ch < NC; ++ch) { const size_t ix = ((size_t)s * NC + ch) * 512 + c; const float l = p.o0[ix]; p.o0[ix] = hh; hh = fmaf(p.a[ix], hh, l); }
        p.o1[gid] = hh; } break;
    case OP_LRU3: {
        const int NC = p.i0; const int u = (int)(gid / 512), c = (int)(gid % 512); const int NP = dm.B * NC; int r0, L; float hh; float* hout = nullptr;
        if (u < NP) { const int s = u / NC, ch = u % NC; r0 = seq_row0(dm, s) + ch * 64; L = dm.T - ch * 64; L = L > 64 ? 64 : L; hh = p.e[gid]; }
        else { const int q = u - NP; r0 = seq_row0(dm, dm.B + q); L = dm.DT; hh = p.d[(size_t)q * 512 + c]; hout = p.o2 + (size_t)q * 512 + c; }
#pragma unroll 8
        for (int t = 0; t < L; ++t) { const size_t r = (size_t)(r0 + t); hh = fmaf(p.a[r * 512 + c], hh, p.b[r * 512 + c]); ((nvbf*)p.o0)[r * 1024 + 512 + c] = nv_f2bf(hh * nv_gelu(p.c[r * MIXIN + C_GB + c])); }
        if (hout) *hout = hh; } break;
    case OP_EMBED4: {
        const int D4 = D / 4; const int row = (int)(gid / D4), c = (int)(gid % D4) * 4; const float* src;
        if (row < dm.B * dm.T) { const int bb = row / dm.T, t = row % dm.T; src = t < 16 ? p.c + (size_t)t * D + c : p.a + ((size_t)bb * (dm.T - 16) + (t - 16)) * D + c; } else src = p.b + (size_t)(row - dm.B * dm.T) * D + c;
        const NvF4 v = *(const NvF4*)src; *(NvF4*)(p.o0 + (size_t)row * D + c) = v; NvU2 w; w.x = nv_f2bf(v.x) | ((unsigned)nv_f2bf(v.y) << 16); w.y = nv_f2bf(v.z) | ((unsigned)nv_f2bf(v.w) << 16); *(NvU2*)((nvbf*)p.o1 + (size_t)row * D + c) = w; } break;
    case OP_YOUT4: {
        const int D4 = D / 4; const int row = (int)(gid / D4), c = (int)(gid % D4) * 4; const NvF4 v = *(const NvF4*)(p.a + (size_t)row * D + c);
        if (row < dm.B * dm.T) { const int bb = row / dm.T, t = row % dm.T; if (t >= 16) *(NvF4*)(p.o0 + ((size_t)bb * (dm.T - 16) + (t - 16)) * D + c) = v; }
        else *(NvF4*)(p.o0 + ((size_t)dm.B * (dm.T - 16) + (row - dm.B * dm.T)) * D + c) = v; } break;
    case OP_MIX8: {
        const int D8 = D / 8; const int row = (int)(gid / D8), c = (int)(gid % D8) * 8; int s, t; row_to_seq(dm, row, s, t); const float* x = p.a + (size_t)row * D + c; float xp[8];
        if (t > 0) { for (int i = 0; i < 8; ++i) xp[i] = x[i - D]; } else if (s < dm.B) { for (int i = 0; i < 8; ++i) xp[i] = 0.f; } else { for (int i = 0; i < 8; ++i) xp[i] = p.b[(size_t)(s - dm.B) * D + c + i]; }
        unsigned w[4];
#pragma unroll
        for (int i = 0; i < 4; ++i) { const float lo = x[2 * i] + (xp[2 * i] - x[2 * i]) * p.c[c + 2 * i], hi = x[2 * i + 1] + (xp[2 * i + 1] - x[2 * i + 1]) * p.c[c + 2 * i + 1]; w[i] = nv_f2bf(lo) | ((unsigned)nv_f2bf(hi) << 16); }
        NvU4 o; o.x = w[0]; o.y = w[1]; o.z = w[2]; o.w = w[3]; *(NvU4*)((nvbf*)p.o0 + (size_t)row * D + c) = o; } break;
    case OP_MIX6: {
        const int D8 = D / 8; const int row = (int)(gid / D8), c = (int)(gid % D8) * 8; int s, t; row_to_seq(dm, row, s, t); const float* x = p.a + (size_t)row * D + c; float xv[8], dx[8];
        for (int i = 0; i < 8; ++i) xv[i] = x[i];
        if (t > 0) { for (int i = 0; i < 8; ++i) dx[i] = x[i - D] - xv[i]; } else if (s < dm.B) { for (int i = 0; i < 8; ++i) dx[i] = -xv[i]; } else { for (int i = 0; i < 8; ++i) dx[i] = p.b[(size_t)(s - dm.B) * D + c + i] - xv[i]; }
        for (int m = 0; m < 6; ++m) { const float* mu = p.c + (size_t)m * D + c; unsigned w[4];
#pragma unroll
            for (int i = 0; i < 4; ++i) w[i] = nv_f2bf(xv[2 * i] + dx[2 * i] * mu[2 * i]) | ((unsigned)nv_f2bf(xv[2 * i + 1] + dx[2 * i + 1] * mu[2 * i + 1]) << 16);
            NvU4 o; o.x = w[0]; o.y = w[1]; o.z = w[2]; o.w = w[3]; *(NvU4*)((nvbf*)p.o0 + (size_t)m * p.i0 * 0 + (size_t)m * (size_t)p.i1 * 1024 + (size_t)row * D + c) = o; } } break;
    case OP_CONV4: {
        const int row = (int)(gid / 128), c = (int)(gid % 128) * 4; int s, t; row_to_seq(dm, row, s, t); float acc[4];
        for (int q = 0; q < 4; ++q) acc[q] = p.d[c + q];
        for (int i = 0; i < 4; ++i) { const int j = t + i; const float* xv = nullptr;
            if (j < 3) { if (s >= dm.B) xv = p.b + ((size_t)(s - dm.B) * 3 + j) * 512 + c; } else xv = p.a + (size_t)(row - t + (j - 3)) * MIXIN + C_XB + c;
            if (xv) for (int q = 0; q < 4; ++q) acc[q] = fmaf(xv[q], p.c[i * 512 + c + q], acc[q]); }
        NvF4 o; o.x = acc[0]; o.y = acc[1]; o.z = acc[2]; o.w = acc[3]; *(NvF4*)(p.o0 + (size_t)row * 512 + c) = o;
        NvU2 w; w.x = nv_f2bf(acc[0]) | ((unsigned)nv_f2bf(acc[1]) << 16); w.y = nv_f2bf(acc[2]) | ((unsigned)nv_f2bf(acc[3]) << 16); *(NvU2*)((nvbf*)p.o1 + (size_t)row * 512 + c) = w; } break;
    case OP_CVT8: {
        const int K8 = p.i2 / 8; const int row = (int)(gid / K8), k = (int)(gid % K8) * 8; unsigned w[4] = {0u, 0u, 0u, 0u};
        if (row < dm.M && k < p.i0) { const float* sp = p.a + (size_t)row * p.i1 + k;
#pragma unroll
            for (int i = 0; i < 4; ++i) { float lo = sp[2 * i], hi = sp[2 * i + 1]; if (p.i3 == 1) { lo = tanhf(lo); hi = tanhf(hi); } else if (p.i3 == 2) { lo = nv_sigmoid(lo); hi = nv_sigmoid(hi); } w[i] = nv_f2bf(lo) | ((unsigned)nv_f2bf(hi) << 16); } }
        NvU4 o; o.x = w[0]; o.y = w[1]; o.z = w[2]; o.w = w[3]; *(NvU4*)((nvbf*)p.o0 + (size_t)row * p.i2 + k) = o; } break;
    case OP_WGATE: {
        const int n = (int)gid, pn = n >> 8, within = n & 127, isx = (n >> 7) & 1, c = pn * 128 + within, nb = c >> 6, e = c & 63; const float* w = isx ? p.b : p.a; nvbf* dst = (nvbf*)p.o0 + (size_t)n * 512;
        for (int k = 0; k < 512; ++k) dst[k] = ((k >> 6) == nb) ? nv_f2bf(w[((size_t)nb * 64 + (k & 63)) * 64 + e]) : (nvbf)0;
        if (n < 512) p.o1[n] = -8.f * nv_softplus(-p.c[n]); } break;
    case OP_LRUG2: {
        const int row = (int)(gid / 512), c = (int)(gid % 512), pn = c >> 7, within = c & 127; const nvbf* x = (const nvbf*)p.a + (size_t)row * 512; const nvbf* wa_ = (const nvbf*)p.b + (size_t)(pn * 256 + within) * 512; const nvbf* wx_ = wa_ + (size_t)128 * 512; float ga = 0.f, gx = 0.f;
        for (int k = 0; k < 512; ++k) { const float xv = nv_bf2f(x[k]); ga = fmaf(xv, nv_bf2f(wa_[k]), ga); gx = fmaf(xv, nv_bf2f(wx_[k]), gx); }
        const float gate_a = nv_sigmoid(ga + p.c[c]), gate_x = nv_sigmoid(gx + p.d[c]); const float log_at = gate_a * p.e[c];
        p.o0[gid] = expf(log_at); p.o1[gid] = sqrtf(-expm1f(2.f * log_at)) * (gate_x * p.f[gid]); } break;
    case OP_LOGA4: {
        const int row = (int)(gid / 64), c = (int)(gid % 64) * 4; const float* gl = p.a + (size_t)row * MIXIN + C_GLR; NvF4 z = *(const NvF4*)(p.c + c);
#pragma unroll
        for (int r4 = 0; r4 < 4; ++r4) { const NvF4 g = *(const NvF4*)(gl + 4 * r4);
            const NvF4 w0 = *(const NvF4*)(p.b + (4 * r4 + 0) * 256 + c), w1 = *(const NvF4*)(p.b + (4 * r4 + 1) * 256 + c), w2 = *(const NvF4*)(p.b + (4 * r4 + 2) * 256 + c), w3 = *(const NvF4*)(p.b + (4 * r4 + 3) * 256 + c);
            z.x = fmaf(g.x, w0.x, z.x); z.y = fmaf(g.x, w0.y, z.y); z.z = fmaf(g.x, w0.z, z.z); z.w = fmaf(g.x, w0.w, z.w); z.x = fmaf(g.y, w1.x, z.x); z.y = fmaf(g.y, w1.y, z.y); z.z = fmaf(g.y, w1.z, z.z); z.w = fmaf(g.y, w1.w, z.w);
            z.x = fmaf(g.z, w2.x, z.x); z.y = fmaf(g.z, w2.y, z.y); z.z = fmaf(g.z, w2.z, z.z); z.w = fmaf(g.z, w2.w, z.w); z.x = fmaf(g.w, w3.x, z.x); z.y = fmaf(g.w, w3.y, z.y); z.z = fmaf(g.w, w3.z, z.z); z.w = fmaf(g.w, w3.w, z.w); }
        NvF4 o; o.x = expf(-nv_softplus(-z.x) * (1.f / 16.f)); o.y = expf(-nv_softplus(-z.y) * (1.f / 16.f)); o.z = expf(-nv_softplus(-z.z) * (1.f / 16.f)); o.w = expf(-nv_softplus(-z.w) * (1.f / 16.f));
        *(NvF4*)(p.o0 + (size_t)row * 256 + c) = o; } break;
    case OP_GLANORM: {
        int row = (int)(gid / 4), h = (int)(gid % 4); const float* o = p.a + (size_t)row * 512 + h * 128; float ss = 0.f;
        for (int c = 0; c < 128; ++c) ss = fmaf(o[c], o[c], ss);
        float rs = 1.f / sqrtf(ss * (1.f / 128.f) + 1e-5f);
        for (int c = 0; c < 128; ++c) { float r = p.b[(size_t)row * MIXIN + C_R + h * 128 + c]; ((nvbf*)p.o0)[(size_t)row * 1024 + h * 128 + c] = nv_f2bf(o[c] * rs * p.c[c] * (r * nv_sigmoid(r))); } } break;
    case OP_CONV: {
        int row = (int)(gid / 512), c = (int)(gid % 512); int s, t; row_to_seq(dm, row, s, t); float acc = p.d[c];
        for (int i = 0; i < 4; ++i) { int j = t + i; float xv;
            if (j < 3) xv = (s < dm.B) ? 0.f : p.b[((size_t)(s - dm.B) * 3 + j) * 512 + c]; else xv = p.a[(size_t)(row - t + (j - 3)) * MIXIN + C_XB + c];
            acc = fmaf(xv, p.c[i * 512 + c], acc); }
        p.o0[gid] = acc; } break;
    case OP_CONVOUT: {
        int s = (int)(gid / 1536), i = (int)((gid / 512) % 3), c = (int)(gid % 512); int L = seq_len(dm, s), r0 = seq_row0(dm, s); int j = L + i; float xv;
        if (j < 3) xv = (s < dm.B) ? 0.f : p.b[((size_t)(s - dm.B) * 3 + j) * 512 + c]; else xv = p.a[(size_t)(r0 + j - 3) * MIXIN + C_XB + c];
        float* o = (s < dm.B) ? PO1 + ((size_t)s * 3 + i) * 512 + c : PO2 + ((size_t)(s - dm.B) * 3 + i) * 512 + c; *o = xv; } break;
    case OP_LRUG: {
        int row = (int)(gid / 512), c = (int)(gid % 512), nb = c / 64, e = c % 64; const float* x = p.a + (size_t)row * 512 + nb * 64; float ga = p.c[c], gx = p.e[c];
        for (int dd = 0; dd < 64; ++dd) { ga = fmaf(x[dd], p.b[((size_t)nb * 64 + dd) * 64 + e], ga); gx = fmaf(x[dd], p.d[((size_t)nb * 64 + dd) * 64 + e], gx); }
        float gate_a = nv_sigmoid(ga), gate_x = nv_sigmoid(gx); float log_at = -8.f * gate_a * nv_softplus(-p.f[c]);
        p.o0[gid] = expf(log_at); p.o1[gid] = sqrtf(-expm1f(2.f * log_at)) * (gate_x * p.a[(size_t)row * 512 + c]); } break;
    case OP_LRUSCAN: {
        int s = (int)(gid / 512), c = (int)(gid % 512); int r0 = seq_row0(dm, s), L = seq_len(dm, s); float hh = (s < dm.B) ? 0.f : p.d[(size_t)(s - dm.B) * 512 + c];
        for (int t = 0; t < L; ++t) { size_t r = (size_t)(r0 + t); hh = fmaf(p.a[r * 512 + c], hh, p.b[r * 512 + c]); p.o0[r * 1024 + 512 + c] = hh * nv_gelu(p.c[r * MIXIN + C_GB + c]); }
        float* o = (s < dm.B) ? PO1 + (size_t)s * 512 + c : PO2 + (size_t)(s - dm.B) * 512 + c; *o = hh; } break;
    case OP_LNRES: {
        const float alpha = 1.6817928305074292f; float* x = p.o0 + (size_t)gid * D; const nvbf* y = (const nvbf*)p.a + (size_t)gid * D; float mu = 0.f;
        for (int c = 0; c < D; ++c) mu += alpha * x[c] + nv_bf2f(y[c]);
        mu /= D; float var = 0.f;
        for (int c = 0; c < D; ++c) { float v = alpha * x[c] + nv_bf2f(y[c]) - mu; var = fmaf(v, v, var); }
        float rs = 1.f / sqrtf(var / D + 1e-5f);
        for (int c = 0; c < D; ++c) { const float o = (alpha * x[c] + nv_bf2f(y[c]) - mu) * rs * p.b[c] + p.c[c]; x[c] = o; ((nvbf*)p.o1)[(size_t)gid * D + c] = nv_f2bf(o);
            if (p.o2) { unsigned char* f8 = (unsigned char*)p.o2 + (size_t)gid * 2 * D; const float xs = fminf(fmaxf(o * 16.f, -448.f), 448.f); const unsigned hc = nv_f2e4m3(xs); f8[c] = (unsigned char)hc; f8[D + c] = (unsigned char)nv_f2e4m3(xs - nv_e4m32f(hc)); } } } break;
    case OP_MIX: {
        int row = (int)(gid / D), c = (int)(gid % D); int s, t; row_to_seq(dm, row, s, t); float x = p.a[gid];
        float xp = t > 0 ? p.a[gid - D] : ((s < dm.B) ? 0.f : p.b[(size_t)(s - dm.B) * D + c]);
        ((nvbf*)p.o0)[gid] = nv_f2bf(x + (xp - x) * p.c[c]); } break;
    case OP_SHIFTOUT: {
        int s = (int)(gid / D), c = (int)(gid % D); float v = p.a[(size_t)(seq_row0(dm, s) + seq_len(dm, s) - 1) * D + c];
        float* o = (s < dm.B) ? PO1 + (size_t)s * D + c : PO2 + (size_t)(s - dm.B) * D + c; *o = v; } break;
    case OP_RWKVPREP: {
        int row = (int)(gid / dm.RH), h = (int)(gid % dm.RH); size_t base = (size_t)row * D + h * 64; float ss = 0.f;
        for (int k = 0; k < 64; ++k) { float kv = p.o0[base + k] * p.d[h * 64 + k]; ss = fmaf(kv, kv, ss); }
        float inv = 1.f / fmaxf(sqrtf(ss), 1e-12f);
        for (int k = 0; k < 64; ++k) { int c = h * 64 + k; size_t ix = base + k;
            float w = -nv_softplus(-(p.a[c] + p.o1[ix])) - 0.5f; float dec = expf(-expf(w));
            float a = nv_sigmoid(p.b[c] + p.o2[ix]);
            float v = p.o3[ix]; if (p.i0) v = v + (p.o5[ix] - v) * nv_sigmoid(p.c[c] + p.f[ix]); else p.o5[ix] = v;
            float k0 = p.o0[ix]; const float kk = k0 * p.d[c] * inv; p.o4[ix] = -kk; p.o0[ix] = k0 * (1.f + (a - 1.f) * p.e[c]); p.o1[ix] = dec; p.o2[ix] = kk * a; p.o3[ix] = v; } } break;
    case OP_WKVF:
    case OP_WKV: {
        int RH = dm.RH; int s = p.i0 + (int)(gid / (RH * 64)), h = (int)((gid / 64) % RH), vr = (int)(gid % 64); float S[64];
        const float* sin = (s < dm.B) ? nullptr : p.g + (((size_t)(s - dm.B) * RH + h) * 64 + vr) * 64;
#pragma unroll
        for (int k = 0; k < 64; ++k) S[k] = sin ? sin[k] : 0.f;
        int r0 = seq_row0(dm, s), L = seq_len(dm, s);
        for (int t = 0; t < L; ++t) { size_t base = (size_t)(r0 + t) * D + h * 64; float sa = 0.f;
#pragma unroll
            for (int k = 0; k < 64; ++k) { if ((k & 7) == 0) NV_FENCE(); sa = fmaf(S[k], p.f[base + k], sa); }
            float vv = p.d[base + vr], y = 0.f;
#pragma unroll
            for (int k = 0; k < 64; ++k) { if ((k & 7) == 0) NV_FENCE(); S[k] = fmaf(S[k], p.b[base + k], fmaf(sa, p.e[base + k], vv * p.c[base + k])); y = fmaf(S[k], p.a[base + k], y); }
            p.o0[base + vr] = y; }
        float* so = (s < dm.B) ? PO1 + (((size_t)s * RH + h) * 64 + vr) * 64 : PO2 + (((size_t)(s - dm.B) * RH + h) * 64 + vr) * 64;
#pragma unroll
        for (int k = 0; k < 64; ++k) so[k] = S[k]; } break;
    case OP_RWKVPOST: {
        int row = (int)(gid / dm.RH), h = (int)(gid % dm.RH); size_t base = (size_t)row * D + h * 64; float mu = 0.f, bon = 0.f;
        for (int k = 0; k < 64; ++k) { mu += p.a[base + k]; bon = fmaf(p.b[base + k] * p.c[base + k], p.f[h * 64 + k], bon); }
        mu *= (1.f / 64.f); float var = 0.f;
        for (int k = 0; k < 64; ++k) { float dlt = p.a[base + k] - mu; var = fmaf(dlt, dlt, var); }
        float rs = 1.f / sqrtf(var * (1.f / 64.f) + 64e-5f);
        for (int k = 0; k < 64; ++k) { int c = h * 64 + k; float y = (p.a[base + k] - mu) * rs * p.g[c] + p.h[c] + bon * p.d[base + k]; ((nvbf*)p.o0)[base + k] = nv_f2bf(y * p.e[base + k]); } } break;
    case OP_PRM: {
        const int m = (int)(gid / D), c = (int)(gid % D); const float* src = m == 0 ? p.a : m == 1 ? p.b : m == 2 ? p.c : m == 3 ? p.d : m == 4 ? p.e : p.f; p.o0[gid] = src ? src[c] : 0.f; } break;
    case OP_WKVP: {
        const int RH = dm.RH; const int s = (int)(gid / (RH * 64)), h = (int)((gid / 64) % RH), vr = (int)(gid % 64); float S[64];
        const float* sin = (s < dm.B) ? nullptr : p.o5 + (((size_t)(s - dm.B) * RH + h) * 64 + vr) * 64;
        for (int k = 0; k < 64; ++k) S[k] = sin ? sin[k] : 0.f;
        const float* w0 = p.h + h * 64; const float* a0 = p.h + D + h * 64; const float* v0 = p.h + 2 * D + h * 64; const float* k_k = p.h + 3 * D + h * 64; const float* k_a = p.h + 4 * D + h * 64; const float* r_k = p.h + 5 * D + h * 64;
        const int r0 = seq_row0(dm, s), L = seq_len(dm, s); const nvbf* bR = (const nvbf*)p.a; const nvbf* bK = (const nvbf*)p.b; const nvbf* bWL = (const nvbf*)p.c; const nvbf* bAL = (const nvbf*)p.d; const nvbf* bV = (const nvbf*)p.e; const nvbf* bVG = (const nvbf*)p.f;
        for (int t = 0; t < L; ++t) { const size_t base = (size_t)(r0 + t) * D + h * 64; float ss = 0.f;
            for (int k = 0; k < 64; ++k) { const float kv = nv_bf2f(bK[base + k]) * k_k[k]; ss = fmaf(kv, kv, ss); }
            const float inv = 1.f / fmaxf(sqrtf(ss), 1e-12f);
            float vv = nv_bf2f(bV[base + vr]); if (p.i0) vv = vv + (p.g[base + vr] - vv) * nv_sigmoid(v0[vr] + nv_bf2f(bVG[base + vr]));
            float sa = 0.f, bon = 0.f, dec[64], bb[64], k2[64];
            for (int k = 0; k < 64; ++k) { const float k0 = nv_bf2f(bK[base + k]); const float kk = k0 * k_k[k] * inv; const float a = nv_sigmoid(a0[k] + nv_bf2f(bAL[base + k]));
                dec[k] = expf(-0.6065306597126334f * nv_sigmoid(w0[k] + nv_bf2f(bWL[base + k])));
                bb[k] = kk * a; k2[k] = k0 * (1.f + (a - 1.f) * k_a[k]); sa = fmaf(S[k], -kk, sa); bon = fmaf(nv_bf2f(bR[base + k]) * k2[k], r_k[k], bon); }
            float y = 0.f;
            for (int k = 0; k < 64; ++k) { S[k] = fmaf(S[k], dec[k], fmaf(sa, bb[k], vv * k2[k])); y = fmaf(S[k], nv_bf2f(bR[base + k]), y); }
            p.o0[base + vr] = y; p.o3[base + vr] = vv; if (vr == 0) p.o4[(size_t)(r0 + t) * RH + h] = bon; }
        float* so = (s < dm.B) ? PO1 + (((size_t)s * RH + h) * 64 + vr) * 64 : PO2 + (((size_t)(s - dm.B) * RH + h) * 64 + vr) * 64;
        for (int k = 0; k < 64; ++k) so[k] = S[k]; } break;
    case OP_POST2: {
        const int row = (int)(gid / dm.RH), h = (int)(gid % dm.RH); const size_t base = (size_t)row * D + h * 64; float mu = 0.f;
        for (int k = 0; k < 64; ++k) mu += p.a[base + k];
        mu *= (1.f / 64.f); float var = 0.f;
        for (int k = 0; k < 64; ++k) { const float dlt = p.a[base + k] - mu; var = fmaf(dlt, dlt, var); }
        const float rs = 1.f / sqrtf(var * (1.f / 64.f) + 64e-5f), bon = p.d[gid];
        for (int k = 0; k < 64; ++k) { const int c = h * 64 + k; const float y = (p.a[base + k] - mu) * rs * p.e[c] + p.f[c] + bon * p.c[base + k]; ((nvbf*)p.o0)[base + k] = nv_f2bf(y * nv_bf2f(((const nvbf*)p.b)[base + k])); } } break;
    case OP_QNORM: {
        float* q = p.o0 + (size_t)gid * 256; float mu = 0.f;
        for (int c = 0; c < 256; ++c) mu += q[c];
        mu *= (1.f / 256.f); float var = 0.f;
        for (int c = 0; c < 256; ++c) { float dlt = q[c] - mu; var = fmaf(dlt, dlt, var); }
        float rs = 1.f / sqrtf(var * (1.f / 256.f) + 1e-5f);
        for (int c = 0; c < 256; ++c) q[c] = (q[c] - mu) * rs; } break;
    case OP_SCORES: {
        int row = (int)(gid / 2048), r = (int)(gid % 2048), h = r / 256, half = (r / 128) & 1, key = r % 128;
        const float* q = p.a + (size_t)row * 2048 + h * 256 + half * 128; const float* kv = p.b + (((size_t)h * 2 + half) * 128 + key) * 128; float acc = 0.f;
        for (int dd = 0; dd < 128; ++dd) acc = fmaf(q[dd], kv[dd], acc);
        p.o0[gid] = acc; } break;
    case OP_TOPK: {
        const float* sc = p.a + (size_t)gid * 256; float tv[16]; int ti[16]; float* tmpv = p.o2 + (size_t)gid * 32; int* tmpi = (int*)p.o3 + (size_t)gid * 32;
        for (int half = 0; half < 2; ++half) {
#pragma unroll
            for (int j = 0; j < 16; ++j) { tv[j] = -3.0e38f; ti[j] = 0; }
            for (int k = 0; k < 128; ++k) NV_INS16(tv, ti, sc[half * 128 + k], k);
#pragma unroll
            for (int j = 0; j < 16; ++j) { tmpv[half * 16 + j] = tv[j]; tmpi[half * 16 + j] = ti[j]; }
        }
#pragma unroll
        for (int j = 0; j < 16; ++j) { tv[j] = -3.0e38f; ti[j] = 0; }
        for (int i = 0; i < 16; ++i) for (int j = 0; j < 16; ++j) NV_INS16(tv, ti, tmpv[i] + tmpv[16 + j], tmpi[i] * 128 + tmpi[16 + j]);
        float den = 0.f, ev[16];
#pragma unroll
        for (int j = 0; j < 16; ++j) { ev[j] = expf(tv[j] - tv[0]); den += ev[j]; }
        float inv = 1.f / den;
#pragma unroll
        for (int j = 0; j < 16; ++j) { p.o0[(size_t)gid * 16 + j] = ev[j] * inv; ((int*)p.o1)[(size_t)gid * 16 + j] = ti[j]; } } break;
    case OP_PACT1: {
        size_t pr = (size_t)(gid / 16); int part = (int)(gid % 16); int row = (int)(pr / 128); int e = ((const int*)p.d)[pr]; int w = D / 16;
        const float* u = p.b + (size_t)e * D + part * w; const float* x = p.a + (size_t)row * D + part * w; float acc = 0.f;
        for (int c = 0; c < w; ++c) acc = fmaf(u[c], x[c], acc);
        p.o0[gid] = acc; } break;
    case OP_PACT2: {
        float acc = 0.f; for (int i = 0; i < 16; ++i) acc += p.a[(size_t)gid * 16 + i];
        p.o0[gid] = p.c[gid] * nv_gelu(acc); } break;
    case OP_POUT: {
        int row = (int)(gid / D), c = (int)(gid % D); float acc = 0.f;
        for (int i = 0; i < 128; ++i) acc = fmaf(p.a[(size_t)row * 128 + i], p.c[(size_t)((const int*)p.b)[(size_t)row * 128 + i] * D + c], acc);
        p.o0[gid] = acc; } break;
    case OP_YOUT: {
        int row = (int)(gid / D), c = (int)(gid % D);
        if (row < dm.B * dm.T) { int bb = row / dm.T, t = row % dm.T; if (t >= 16) p.o0[((size_t)bb * (dm.T - 16) + (t - 16)) * D + c] = p.a[gid]; }
        else p.o0[((size_t)dm.B * (dm.T - 16) + (row - dm.B * dm.T)) * D + c] = p.a[gid]; } break;
    case OP_WT: {
        const int N = p.i0, K = p.i1, Np = p.i3, Kp = p.i4; const long long per8 = (long long)Np * (Kp / 8); const int bt = (int)(gid / per8); const long long r = gid % per8; const int k0 = (int)(r / Np) * 8, nn = (int)(r % Np);
        unsigned w[4];
#pragma unroll
        for (int i = 0; i < 4; ++i) { float lo = 0.f, hi = 0.f; if (nn < N) { if (k0 + 2 * i < K) lo = p.a[((size_t)bt * K + k0 + 2 * i) * p.i2 + nn]; if (k0 + 2 * i + 1 < K) hi = p.a[((size_t)bt * K + k0 + 2 * i + 1) * p.i2 + nn]; } w[i] = nv_f2bf(lo) | ((unsigned)nv_f2bf(hi) << 16); }
        NvU4 o; o.x = w[0]; o.y = w[1]; o.z = w[2]; o.w = w[3];
        *(NvU4*)((nvbf*)p.o0 + (size_t)bt * Np * Kp + (size_t)nn * Kp + k0) = o; } break;
    case OP_CVT: {
        const int Kp = p.i2; const int row = (int)(gid / Kp), k = (int)(gid % Kp); float v = 0.f;
        if (row < dm.M && k < p.i0) { v = p.a[(size_t)row * p.i1 + k]; if (p.i3 == 1) v = tanhf(v); else if (p.i3 == 2) v = nv_sigmoid(v); }
        ((nvbf*)p.o0)[gid] = nv_f2bf(v); } break;
    case OP_FGEMM: {
        const int N = p.i0; const int m = (int)(gid / N), nn = (int)(gid % N); const nvbf* A = (const nvbf*)p.a + (size_t)m * p.i2 + ((p.i6 & 2) ? (nn / 256) * 256 : 0); const nvbf* Bt = (const nvbf*)p.b + (size_t)nn * p.i3; float acc = 0.f;
        for (int k = 0; k < p.i1; ++k) acc = fmaf(nv_bf2f(A[k]), nv_bf2f(Bt[k]), acc);
        if (p.i6 & 1) ((nvbf*)p.o0)[(size_t)m * p.i4 + nn] = nv_f2bf(acc); else p.o0[(size_t)m * p.i4 + nn] = acc; } break;
    case OP_CVTTAB: {
        const NvF4 v0 = *(const NvF4*)(p.a + gid * 8), v1 = *(const NvF4*)(p.a + gid * 8 + 4); NvU4 o;
        o.x = nv_f2bf(v0.x) | ((unsigned)nv_f2bf(v0.y) << 16); o.y = nv_f2bf(v0.z) | ((unsigned)nv_f2bf(v0.w) << 16); o.z = nv_f2bf(v1.x) | ((unsigned)nv_f2bf(v1.y) << 16); o.w = nv_f2bf(v1.z) | ((unsigned)nv_f2bf(v1.w) << 16);
        *(NvU4*)((nvbf*)p.o0 + gid * 8) = o; } break;
    case OP_CVTTAB8: {
        const float sc = (float)(1 << p.i0); const float* sp = p.a + gid * 16; unsigned w[4];
#pragma unroll
        for (int q = 0; q < 4; ++q) { const NvF4 v = *(const NvF4*)(sp + 4 * q); w[q] = nv_f2e4m3(v.x * sc) | (nv_f2e4m3(v.y * sc) << 8) | (nv_f2e4m3(v.z * sc) << 16) | (nv_f2e4m3(v.w * sc) << 24); }
        NvU4 o; o.x = w[0]; o.y = w[1]; o.z = w[2]; o.w = w[3]; *(NvU4*)((unsigned char*)p.o0 + gid * 16) = o; } break;
    case OP_CVTTAB8S: {
        const float sc = (float)(1 << p.i0); const int per = D / 16; const int e = (int)(gid / per), c0 = (int)(gid % per) * 16; const float* sp = p.a + (size_t)e * D + c0; unsigned w[4];
#pragma unroll
        for (int q = 0; q < 4; ++q) { const NvF4 v = *(const NvF4*)(sp + 4 * q);
#if defined(__HIP_DEVICE_COMPILE__)
            int pk = __builtin_amdgcn_cvt_pk_fp8_f32(v.x * sc, v.y * sc, 0, false); pk = __builtin_amdgcn_cvt_pk_fp8_f32(v.z * sc, v.w * sc, pk, true); w[q] = (unsigned)pk;
#else
            w[q] = nv_f2e4m3(v.x * sc) | (nv_f2e4m3(v.y * sc) << 8) | (nv_f2e4m3(v.z * sc) << 16) | (nv_f2e4m3(v.w * sc) << 24);
#endif
        }
        NvU4 o; o.x = w[0]; o.y = w[1]; o.z = w[2]; o.w = w[3]; *(NvU4*)((unsigned char*)p.o0 + ((size_t)(c0 >> 7) * 16384 + e) * 128 + (c0 & 127)) = o; } break;
    case OP_PACTS: {
        const long long NP = (long long)dm.M * 128; const int sl = (int)(gid / NP); const long long pr = gid % NP; const int row = (int)(pr / 128); const int e = ((const int*)p.d)[pr] & p.i0;
        const unsigned char* u = (const unsigned char*)p.b + ((size_t)sl * 16384 + e) * 128; const unsigned char* x = (const unsigned char*)p.a + (size_t)row * 2 * D + sl * 128; float acc = 0.f;
        for (int c = 0; c < 128; ++c) acc = fmaf(nv_e4m32f(u[c]), nv_e4m32f(x[c]) + nv_e4m32f(x[D + c]), acc);
        p.o0[gid] = acc * (1.f / 16.f); } break;
    case OP_PRED: {
        const long long NP = (long long)dm.M * 128; float acc = 0.f; for (int sl = 0; sl < p.i0; ++sl) acc += p.a[(size_t)sl * NP + gid];
        p.o0[gid] = p.c[gid] * nv_gelu(acc * (1.f / 128.f)); } break;
    case OP_POUTS: {
        const int row = (int)(gid / D), c = (int)(gid % D); const unsigned char* vb = (const unsigned char*)p.c + (size_t)(c >> 7) * 16384 * 128 + (c & 127); float acc = 0.f;
        for (int i = 0; i < 128; ++i) acc = fmaf(p.a[(size_t)row * 128 + i] * (1.f / 64.f), nv_e4m32f(vb[(size_t)((const int*)p.b)[(size_t)row * 128 + i] * 128]), acc);
        ((nvbf*)p.o0)[gid] = nv_f2bf(acc); } break;
    case OP_KEYS: {
        const int h = (int)(gid / 256), nrow = (int)(gid % 256), half = nrow >> 7; const float* src = p.a + (((size_t)h * 2 + half) * 128 + (nrow & 127)) * 128; nvbf* dst = (nvbf*)p.o0 + ((size_t)h * 256 + nrow) * 256; float ks = 0.f;
        for (int k = 0; k < 256; ++k) { nvbf b = 0; if ((k >> 7) == half) { b = nv_f2bf(src[k & 127]); ks += nv_bf2f(b); } dst[k] = b; }
        p.o1[gid] = ks; } break;
    case OP_TOPK2: {
        const int h = (int)(gid % 8); const float* sc = p.a + (size_t)gid * 256; const nvbf* q = (const nvbf*)p.b + (size_t)gid * 256; const float* ksum = p.c + h * 256; float mu = 0.f;
        for (int c = 0; c < 256; ++c) mu += nv_bf2f(q[c]);
        mu *= (1.f / 256.f); float var = 0.f;
        for (int c = 0; c < 256; ++c) { float dlt = nv_bf2f(q[c]) - mu; var = fmaf(dlt, dlt, var); }
        const float rs = 1.f / sqrtf(var * (1.f / 256.f) + 1e-5f);
        float tv[16]; int ti[16]; float* tmpv = p.o2 + (size_t)gid * 32; int* tmpi = (int*)p.o3 + (size_t)gid * 32;
        for (int half = 0; half < 2; ++half) {
#pragma unroll
            for (int j = 0; j < 16; ++j) { tv[j] = -3.0e38f; ti[j] = 0; }
            for (int k = 0; k < 128; ++k) NV_INS16(tv, ti, rs * (sc[half * 128 + k] - mu * ksum[half * 128 + k]), k);
#pragma unroll
            for (int j = 0; j < 16; ++j) { tmpv[half * 16 + j] = tv[j]; tmpi[half * 16 + j] = ti[j]; }
        }
#pragma unroll
        for (int j = 0; j < 16; ++j) { tv[j] = -3.0e38f; ti[j] = 0; }
        for (int i = 0; i < 16; ++i) for (int j = 0; j < 16; ++j) NV_INS16(tv, ti, tmpv[i] + tmpv[16 + j], tmpi[i] * 128 + tmpi[16 + j]);
        float den = 0.f, ev[16];
#pragma unroll
        for (int j = 0; j < 16; ++j) { ev[j] = expf(tv[j] - tv[0]); den += ev[j]; }
        float inv = 1.f / den;
#pragma unroll
        for (int j = 0; j < 16; ++j) { p.o0[(size_t)gid * 16 + j] = ev[j] * inv; ((int*)p.o1)[(size_t)gid * 16 + j] = ti[j]; } } break;
    case OP_PACT: {
        const int row = (int)(gid / 128); const int e = ((const int*)p.d)[gid]; const unsigned char* u = (const unsigned char*)p.b + (size_t)e * D; const nvbf* x = (const nvbf*)p.a + (size_t)row * D; float acc = 0.f;
        for (int c = 0; c < D; ++c) acc = fmaf(nv_e4m32f(u[c]), nv_bf2f(x[c]), acc);
        p.o0[gid] = p.c[gid] * nv_gelu(acc * (1.f / 128.f)); } break;
#if defined(HOST_TEST)
    case OP_POUTLN: {
        const float alpha = 1.6817928305074292f; float* x = p.o0 + (size_t)gid * D; std::vector<float> y(D, 0.f);
        for (int i = 0; i < 128; ++i) { const float cf = p.a[(size_t)gid * 128 + i] * (1.f / 64.f); const unsigned char* v = (const unsigned char*)p.c + (size_t)((const int*)p.b)[(size_t)gid * 128 + i] * D; for (int c = 0; c < D; ++c) y[c] = fmaf(cf, nv_e4m32f(v[c]), y[c]); }
        float mu = 0.f; for (int c = 0; c < D; ++c) { y[c] = alpha * x[c] + y[c]; mu += y[c]; }
        mu /= D; float var = 0.f; for (int c = 0; c < D; ++c) { float dlt = y[c] - mu; var = fmaf(dlt, dlt, var); }
        const float rs = 1.f / sqrtf(var / D + 1e-5f);
        for (int c = 0; c < D; ++c) { const float o = (y[c] - mu) * rs * p.d[c] + p.e[c]; x[c] = o; ((nvbf*)p.o1)[(size_t)gid * D + c] = nv_f2bf(o);
            if (p.o2) { unsigned char* f8 = (unsigned char*)p.o2 + (size_t)gid * 2 * D; const float xs = fminf(fmaxf(o * 16.f, -448.f), 448.f); const unsigned hc = nv_f2e4m3(xs); f8[c] = (unsigned char)hc; f8[D + c] = (unsigned char)nv_f2e4m3(xs - nv_e4m32f(hc)); } } } break;
#endif
    default: break;
    }
}

struct NvIO { const float* const* in; float* out; char* ws; size_t ws_size; };
template <class Launch> HD void nv_forward(const NvIO& io, const Dm& dm, Launch&& launch) {
    const int D = dm.D, M = dm.M, B = dm.B, DB = dm.DB, RH = dm.RH; const size_t MD = (size_t)M * D;
    float* y_prompt = io.out; float* y_sample = y_prompt + (size_t)B * (dm.T - 16) * D; float* p_gla = y_sample + (size_t)DB * dm.DT * D;
    float* p_h = p_gla + (size_t)2 * B * 4 * 64 * 128; float* p_conv = p_h + (size_t)2 * B * 512; float* p_rwkv = p_conv + (size_t)2 * B * 3 * 512;
    float* p_shift = p_rwkv + (size_t)2 * B * RH * 4096; float* s_gla = p_shift + (size_t)2 * B * D; float* s_h = s_gla + (size_t)2 * DB * 4 * 64 * 128;
    float* s_conv = s_h + (size_t)2 * DB * 512; float* s_rwkv = s_conv + (size_t)2 * DB * 3 * 512; float* s_shift = s_rwkv + (size_t)2 * DB * RH * 4096;
    float* w = (float*)io.ws; size_t off = 0; auto take = [&](size_t n) __attribute__((always_inline)) { float* r = w + off; off += (n + 63) & ~(size_t)63; return r; };
    float* X = take(MD); float* VFIRST = take(MD); float* MOUT = take(MD);
    auto mk = [&](int code, long long n) __attribute__((always_inline)) { Op o{}; o.code = code; o.n = n; return o; };
    const int Mp = nv_rup(M, 256), Dp = nv_rup(D, 256), Dk = nv_rup(D, 128);
    auto takeh = [&](size_t n) __attribute__((always_inline)) { return (nvbf*)take((n + 1) / 2); };
    const size_t ABFN = (size_t)Mp * 1024 > (size_t)Mp * Dk ? (size_t)Mp * 1024 : (size_t)Mp * Dk; nvbf* ABF = takeh(ABFN + (size_t)Mp * D);
    const size_t SZ_WIN = (size_t)2816 * Dk, SZ_WOUT = (size_t)Dp * 1024, SZ_DD = (size_t)Dp * Dk, SZ_DN = (size_t)256 * Dk, SZ_UP = (size_t)Dp * 128, SZ_WQ = (size_t)2048 * Dk;
    nvbf* WT_WIN = takeh(2 * SZ_WIN); nvbf* WT_WOUT = takeh(2 * SZ_WOUT); nvbf* WT_WR = takeh(2 * SZ_DD); nvbf* WT_WK = takeh(2 * SZ_DD); nvbf* WT_WV = takeh(2 * SZ_DD); nvbf* WT_WO = takeh(2 * SZ_DD);
    nvbf* WT_W1 = takeh(2 * SZ_DN); nvbf* WT_W2 = takeh(2 * SZ_UP); nvbf* WT_A1 = takeh(2 * SZ_DN); nvbf* WT_A2 = takeh(2 * SZ_UP); nvbf* WT_G1 = takeh(2 * SZ_DN); nvbf* WT_G2 = takeh(2 * SZ_UP);
    nvbf* WT_V1 = takeh(SZ_DN); nvbf* WT_V2 = takeh(SZ_UP); nvbf* WT_WQ = takeh(4 * SZ_WQ); nvbf* WT_WG = takeh((size_t)2 * 1024 * 512); float* SPL = take(2 * 512); float* PRM = take((size_t)2 * 6 * D);
    nvbf* UB = takeh((size_t)16384 * D / 2); nvbf* VB = takeh((size_t)16384 * D / 2); nvbf* KB = takeh((size_t)8 * 256 * 256); float* KSUM = take(8 * 256);
    const size_t scratch0 = off;
    auto nb = [&](Op o) __attribute__((always_inline)) { o.code |= OPF_NOBAR; launch(o); };
    auto wt = [&](const float* W, int K, int N, int batch, nvbf* dst) __attribute__((always_inline)) { const int Np = nv_rup(N, 256), Kp = nv_rup(K, 128); Op o = mk(OP_WT, (long long)batch * Np * (Kp / 8)); o.a = W; o.o0 = (float*)dst; o.i0 = N; o.i1 = K; o.i2 = N; o.i3 = Np; o.i4 = Kp; nb(o); };
    wt(io.in[10], D, MIXIN, 2, WT_WIN); wt(io.in[21], 1024, D, 2, WT_WOUT); wt(io.in[23], D, D, 2, WT_WR); wt(io.in[24], D, D, 2, WT_WK); wt(io.in[25], D, D, 2, WT_WV); wt(io.in[26], D, D, 2, WT_WO);
    wt(io.in[28], D, 64, 2, WT_W1); wt(io.in[29], 64, D, 2, WT_W2); wt(io.in[31], D, 64, 2, WT_A1); wt(io.in[32], 64, D, 2, WT_A2); wt(io.in[36], D, 128, 2, WT_G1); wt(io.in[37], 128, D, 2, WT_G2);
    wt(io.in[34], D, 32, 1, WT_V1); wt(io.in[35], 32, D, 1, WT_V2); wt(io.in[43], D, 2048, 4, WT_WQ);
    for (int jj = 0; jj < 2; ++jj) { Op o = mk(OP_PRM, (long long)6 * D); o.a = io.in[27] + (size_t)jj * D; o.b = io.in[30] + (size_t)jj * D; o.c = jj > 0 ? io.in[33] + (size_t)(jj - 1) * D : nullptr; o.d = io.in[38] + (size_t)jj * D; o.e = io.in[39] + (size_t)jj * D; o.f = io.in[40] + (size_t)jj * RH * 64; o.o0 = PRM + (size_t)jj * 6 * D; nb(o); }
    for (int jj = 0; jj < 2; ++jj) { Op o = mk(OP_WGATE, 1024); o.a = io.in[16] + (size_t)jj * 8 * 64 * 64; o.b = io.in[18] + (size_t)jj * 8 * 64 * 64; o.c = io.in[20] + (size_t)jj * 512; o.o0 = (float*)(WT_WG + (size_t)jj * 1024 * 512); o.o1 = SPL + (size_t)jj * 512; nb(o); }
    auto fgemm = [&](const nvbf* Wt, float* C, int ldc, int N, int K, int bf16out = 0) __attribute__((always_inline)) {
        const int Kp = nv_rup(K, 128), Np = nv_rup(N, 256);
        Op o = mk(OP_FGEMM, (long long)M * N); o.a = (const float*)ABF; o.b = (const float*)Wt; o.o0 = C; o.i0 = N; o.i1 = Kp; o.i2 = Kp; o.i3 = Kp; o.i4 = ldc; o.i5 = Np; o.i6 = bf16out; launch(o); };
    auto gemm = [&](const float* A, int lda, const nvbf* Wt, float* C, int ldc, int N, int K, int act) __attribute__((always_inline)) {
        const int Kp = nv_rup(K, 128);
        { Op o = mk(OP_CVT8, (long long)Mp * (Kp / 8)); o.a = A; o.o0 = (float*)ABF; o.i0 = K; o.i1 = lda; o.i2 = Kp; o.i3 = act; launch(o); }
        fgemm(Wt, C, ldc, N, K); };
    { Op o = mk(OP_EMBED4, (long long)MD / 4); o.a = io.in[0]; o.b = io.in[1]; o.c = io.in[7]; o.o0 = X; o.o1 = (float*)ABF; launch(o); }
    const float* const w_outer = w; float* const out_outer = io.out;
    for (int layer = 0; layer < 4; ++layer) {
        float* wl = (float*)w_outer; float* ol = out_outer; NV_LAUNDER(wl); NV_LAUNDER(ol);
#define NV_RB(T, v) T const v##_rb = (T)((char*)wl + ((const char*)(v) - (const char*)w_outer))
#define NV_RO(v) float* const v##_rb = (float*)((char*)ol + ((const char*)(v) - (const char*)out_outer))
        NV_RB(float*, X); NV_RB(float*, VFIRST); NV_RB(float*, MOUT); NV_RB(nvbf*, ABF); NV_RB(nvbf*, WT_WIN); NV_RB(nvbf*, WT_WOUT); NV_RB(nvbf*, WT_WR); NV_RB(nvbf*, WT_WK); NV_RB(nvbf*, WT_WV); NV_RB(nvbf*, WT_WO);
        NV_RB(nvbf*, WT_W1); NV_RB(nvbf*, WT_W2); NV_RB(nvbf*, WT_A1); NV_RB(nvbf*, WT_A2); NV_RB(nvbf*, WT_G1); NV_RB(nvbf*, WT_G2); NV_RB(nvbf*, WT_V1); NV_RB(nvbf*, WT_V2); NV_RB(nvbf*, WT_WQ); NV_RB(nvbf*, WT_WG);
        NV_RB(float*, SPL); NV_RB(float*, PRM); NV_RB(nvbf*, UB); NV_RB(nvbf*, VB); NV_RB(nvbf*, KB); NV_RB(float*, KSUM);
        NV_RO(p_gla); NV_RO(p_h); NV_RO(p_conv); NV_RO(p_rwkv); NV_RO(p_shift); NV_RO(s_gla); NV_RO(s_h); NV_RO(s_conv); NV_RO(s_rwkv); NV_RO(s_shift);
#undef NV_RB
#undef NV_RO
        { float* const X = X_rb; float* const VFIRST = VFIRST_rb; float* const MOUT = MOUT_rb; nvbf* const ABF = ABF_rb; nvbf* const WT_WIN = WT_WIN_rb; nvbf* const WT_WOUT = WT_WOUT_rb; nvbf* const WT_WR = WT_WR_rb; nvbf* const WT_WK = WT_WK_rb;
          nvbf* const WT_WV = WT_WV_rb; nvbf* const WT_WO = WT_WO_rb; nvbf* const WT_W1 = WT_W1_rb; nvbf* const WT_W2 = WT_W2_rb; nvbf* const WT_A1 = WT_A1_rb; nvbf* const WT_A2 = WT_A2_rb; nvbf* const WT_G1 = WT_G1_rb; nvbf* const WT_G2 = WT_G2_rb;
          nvbf* const WT_V1 = WT_V1_rb; nvbf* const WT_V2 = WT_V2_rb; nvbf* const WT_WQ = WT_WQ_rb; nvbf* const WT_WG = WT_WG_rb; float* const SPL = SPL_rb; float* const PRM = PRM_rb; nvbf* const UB = UB_rb; nvbf* const VB = VB_rb; nvbf* const KB = KB_rb; float* const KSUM = KSUM_rb;
          float* const p_gla = p_gla_rb; float* const p_h = p_h_rb; float* const p_conv = p_conv_rb; float* const p_rwkv = p_rwkv_rb; float* const p_shift = p_shift_rb; float* const s_gla = s_gla_rb; float* const s_h = s_h_rb; float* const s_conv = s_conv_rb;
          float* const s_rwkv = s_rwkv_rb; float* const s_shift = s_shift_rb; float* const w = wl; (void)SPL; (void)WT_WG; (void)VFIRST;
        const int j = layer / 2; off = scratch0;
        { Op o = mk(OP_CVTTAB8S, (long long)16384 * D / 16); o.a = io.in[45] + (size_t)layer * 16384 * D; o.o0 = (float*)UB; o.i0 = 7; nb(o); }
        { Op o = mk(OP_CVTTAB8S, (long long)16384 * D / 16); o.a = io.in[46] + (size_t)layer * 16384 * D; o.o0 = (float*)VB; o.i0 = 6; nb(o); }
        { Op o = mk(OP_KEYS, 8 * 256); o.a = io.in[44] + (size_t)layer * 8 * 2 * 128 * 128; o.o0 = (float*)KB; o.o1 = KSUM; nb(o); }
        if (layer % 2 == 0) {
            float* PROJ = take((size_t)M * MIXIN); float* LOGA = take((size_t)M * 256); float* O = take((size_t)M * 512); float* MIXO = (float*)ABF;
            float* XC = take((size_t)M * 512); nvbf* XCB = takeh((size_t)Mp * 512); float* AT = take((size_t)M * 512); float* BT = take((size_t)M * 512);
            const int NC = (dm.T + 63) / 64; float* LEND = take((size_t)B * 4 * NC * 8192); float* DEC = take((size_t)B * 4 * NC * 64); float* LA = take((size_t)B * NC * 512); float* LB = take((size_t)B * NC * 512);
            fgemm(WT_WIN + (size_t)j * SZ_WIN, PROJ, MIXIN, MIXIN, D);
            { Op o = mk(OP_LOGA4, (long long)M * 64); o.a = PROJ; o.b = io.in[11] + (size_t)j * 16 * 256; o.c = io.in[12] + (size_t)j * 256; o.o0 = LOGA; nb(o); }
            { Op o = mk(OP_CONV4, (long long)M * 128); o.a = PROJ; o.b = io.in[4] + (size_t)j * DB * 3 * 512; o.c = io.in[14] + (size_t)j * 4 * 512; o.d = io.in[15] + (size_t)j * 512; o.o0 = XC; o.o1 = (float*)XCB; nb(o); }
            { Op o = mk(OP_CONVOUT, (long long)dm.NSEQ * 1536); o.a = PROJ; o.b = io.in[4] + (size_t)j * DB * 3 * 512; o.o1 = p_conv + (size_t)j * B * 3 * 512; o.o2 = s_conv + (size_t)j * DB * 3 * 512; launch(o); }
            { Op o = mk(OP_GLAF, (long long)B * 512); o.a = PROJ; o.b = LOGA; o.o0 = O; o.o1 = p_gla + (size_t)j * B * 4 * 64 * 128; nb(o); }
            { Op o = mk(OP_GLA3, (long long)(DB * 4) * 128); o.a = PROJ; o.b = LOGA; o.c = io.in[2] + (size_t)j * DB * 4 * 64 * 128; o.d = LEND; o.o0 = O; o.o2 = s_gla + (size_t)j * DB * 4 * 64 * 128; o.i0 = NC; o.i1 = 1; nb(o); }
            { Op o = mk(OP_LRUG2, (long long)M * 512); o.a = (const float*)XCB; o.b = (const float*)(WT_WG + (size_t)j * 1024 * 512); o.c = io.in[17] + (size_t)j * 512; o.d = io.in[19] + (size_t)j * 512; o.e = SPL + (size_t)j * 512; o.f = XC; o.o0 = AT; o.o1 = BT; launch(o); }
            { Op o = mk(OP_GLANORM, (long long)M * 4); o.a = O; o.b = PROJ; o.c = io.in[13] + (size_t)j * 128; o.o0 = MIXO; nb(o); }
            { Op o = mk(OP_LRU1, (long long)B * NC * 512); o.a = AT; o.b = BT; o.o0 = LA; o.o1 = LB; o.i0 = NC; launch(o); }
            { Op o = mk(OP_LRU2, (long long)B * 512); o.a = LA; o.o0 = LB; o.o1 = p_h + (size_t)j * B * 512; o.i0 = NC; launch(o); }
            { Op o = mk(OP_LRU3, (long long)(B * NC + DB) * 512); o.a = AT; o.b = BT; o.c = PROJ; o.d = io.in[3] + (size_t)j * DB * 512; o.e = LB; o.o0 = MIXO; o.o2 = s_h + (size_t)j * DB * 512; o.i0 = NC; launch(o); }
            fgemm(WT_WOUT + (size_t)j * SZ_WOUT, MOUT, D, D, 1024, 1);
        } else {
            float* Y = take(MD); float* R = take(MD); float* K = take(MD); float* V = take(MD); float* G = take(MD); float* KK = take(MD);
            const size_t XMSZ = (size_t)Mp * D;
            float* WAV = take(3 * MD > 3 * XMSZ ? 3 * MD : 3 * XMSZ); float* Wd = WAV; float* Aa = WAV + MD; float* Vg = WAV + 2 * MD; nvbf* XM6 = (nvbf*)WAV;
            float* BON = take((size_t)M * RH); float* HLw = take((size_t)M * 64); float* HLa = take((size_t)M * 64); float* HLg = take((size_t)M * 128); float* HLv = take((size_t)M * 32);
            nvbf* ABw = takeh((size_t)Mp * 128); nvbf* ABa = takeh((size_t)Mp * 128); nvbf* ABg = takeh((size_t)Mp * 128); nvbf* ABv = takeh((size_t)Mp * 128);
            const float* shin = io.in[6] + (size_t)j * DB * D; const float* mu = io.in[22] + (size_t)j * 6 * D;
            { Op o = mk(OP_SHIFTOUT, (long long)dm.NSEQ * D); o.a = X; o.o1 = p_shift + (size_t)j * B * D; o.o2 = s_shift + (size_t)j * DB * D; nb(o); }
            { Op o = mk(OP_MIX6, (long long)MD / 8); o.a = X; o.b = shin; o.c = mu; o.o0 = (float*)XM6; o.i1 = (int)(XMSZ / 1024); launch(o); }
            auto gg = [&](const nvbf* A, const nvbf* Wt, float* C, int ldc, int N, int K, bool last, int bf16out = 0) __attribute__((always_inline)) { const int Kp = nv_rup(K, 128), Np = nv_rup(N, 256);
                Op o = mk(OP_FGEMM, (long long)M * N); o.a = (const float*)A; o.b = (const float*)Wt; o.o0 = C; o.i0 = N; o.i1 = Kp; o.i2 = Kp; o.i3 = Kp; o.i4 = ldc; o.i5 = Np; o.i6 = bf16out; if (!last) o.code |= OPF_GROUP; launch(o); };
            gg(XM6 + 0 * XMSZ, WT_WR + (size_t)j * SZ_DD, R, D, D, D, false, 1); gg(XM6 + 2 * XMSZ, WT_WK + (size_t)j * SZ_DD, K, D, D, D, false, 1); gg(XM6 + 3 * XMSZ, WT_WV + (size_t)j * SZ_DD, V, D, D, D, false, 1);
            gg(XM6 + 1 * XMSZ, WT_W1 + (size_t)j * SZ_DN, HLw, 64, 64, D, false); gg(XM6 + 4 * XMSZ, WT_A1 + (size_t)j * SZ_DN, HLa, 64, 64, D, false);
            if (j > 0) gg(XM6 + 3 * XMSZ, WT_V1 + (size_t)(j - 1) * SZ_DN, HLv, 32, 32, D, false);
            gg(XM6 + 5 * XMSZ, WT_G1 + (size_t)j * SZ_DN, HLg, 128, 128, D, true);
            auto cv = [&](const float* A, int K, nvbf* dst, int act, bool last) __attribute__((always_inline)) { Op o = mk(OP_CVT8, (long long)Mp * 16); o.a = A; o.o0 = (float*)dst; o.i0 = K; o.i1 = K; o.i2 = 128; o.i3 = act; if (last) launch(o); else nb(o); };
            cv(HLw, 64, ABw, 1, false); cv(HLa, 64, ABa, 0, false); if (j > 0) cv(HLv, 32, ABv, 0, false); cv(HLg, 128, ABg, 2, true);
            gg(ABw, WT_W2 + (size_t)j * SZ_UP, Wd, D, D, 64, false, 1); gg(ABa, WT_A2 + (size_t)j * SZ_UP, Aa, D, D, 64, false, 1); if (j > 0) gg(ABv, WT_V2 + (size_t)(j - 1) * SZ_UP, Vg, D, D, 32, false, 1); gg(ABg, WT_G2 + (size_t)j * SZ_UP, G, D, D, 128, true, 1);
            { Op o = mk(OP_WKVP, (long long)dm.NSEQ * RH * 64); o.a = R; o.b = K; o.c = Wd; o.d = Aa; o.e = V; o.f = Vg; o.g = VFIRST; o.h = PRM + (size_t)j * 6 * D; o.o0 = Y; o.o1 = p_rwkv + (size_t)j * B * RH * 4096; o.o2 = s_rwkv + (size_t)j * DB * RH * 4096;
              o.o3 = j > 0 ? KK : VFIRST; o.o4 = BON; o.o5 = (float*)(io.in[5] + (size_t)j * DB * RH * 4096); o.i0 = j > 0 ? 1 : 0; launch(o); }
            { Op o = mk(OP_POST2, (long long)M * RH); o.a = Y; o.b = G; o.c = j > 0 ? KK : VFIRST; o.d = BON; o.e = io.in[41] + (size_t)j * D; o.f = io.in[42] + (size_t)j * D; o.o0 = (float*)ABF; launch(o); }
            fgemm(WT_WO + (size_t)j * SZ_DD, MOUT, D, D, D, 1);
        }
        { Op o = mk(OP_LNRES, M); o.a = MOUT; o.b = io.in[8] + (size_t)(layer * 2 + 0) * D; o.c = io.in[9] + (size_t)(layer * 2 + 0) * D; o.o0 = X; o.o1 = (float*)ABF; o.o2 = (float*)(ABF + ABFN); launch(o); }
        off = scratch0;
        { nvbf* Q = takeh((size_t)Mp * 2048); float* SC = take((size_t)M * 2048); float* GATE = take((size_t)M * 128); float* EIDX = take((size_t)M * 128); float* TMPV = take((size_t)M * 256); float* TMPI = take((size_t)M * 256);
          float* COEF = take((size_t)M * 128);
          { Op o = mk(OP_FGEMM, (long long)M * 2048); o.a = (const float*)ABF; o.b = (const float*)(WT_WQ + (size_t)layer * SZ_WQ); o.o0 = (float*)Q; o.i0 = 2048; o.i1 = Dk; o.i2 = Dk; o.i3 = Dk; o.i4 = 2048; o.i5 = 2048; o.i6 = 1; launch(o); }
          { Op o = mk(OP_FGEMM, (long long)M * 2048); o.a = (const float*)Q; o.b = (const float*)KB; o.o0 = SC; o.i0 = 2048; o.i1 = 256; o.i2 = 2048; o.i3 = 256; o.i4 = 2048; o.i5 = 2048; o.i6 = 2; launch(o); }
          { Op o = mk(OP_TOPK2, (long long)M * 8); o.a = SC; o.b = (const float*)Q; o.c = KSUM; o.o0 = GATE; o.o1 = EIDX; o.o2 = TMPV; o.o3 = TMPI; launch(o); }
          { const int NS = D / 128; float* PART = take((size_t)NS * M * 128); float* YBUF = take(MD);
            #ifdef PROBE_EMASK
            { Op o = mk(OP_PACTS, (long long)NS * M * 128); o.a = (const float*)(ABF + ABFN); o.b = (const float*)UB; o.d = EIDX; o.o0 = PART; o.i0 = PROBE_EMASK; launch(o); }
#endif
            { Op o = mk(OP_PACTS, (long long)NS * M * 128); o.a = (const float*)(ABF + ABFN); o.b = (const float*)UB; o.d = EIDX; o.o0 = PART; o.i0 = 16383; launch(o); }
            { Op o = mk(OP_PRED, (long long)M * 128); o.a = PART; o.c = GATE; o.o0 = COEF; o.i0 = NS; launch(o); }
            { Op o = mk(OP_POUTS, (long long)MD); o.a = COEF; o.b = EIDX; o.c = (const float*)VB; o.o0 = YBUF; launch(o); }
            { Op o = mk(OP_LNRES, M); o.a = YBUF; o.b = io.in[8] + (size_t)(layer * 2 + 1) * D; o.c = io.in[9] + (size_t)(layer * 2 + 1) * D; o.o0 = X; o.o1 = (float*)ABF; launch(o); } } }
        }
    }
    { Op o = mk(OP_YOUT4, (long long)MD / 4); o.a = X; o.o0 = y_prompt; launch(o); }
    (void)y_sample;
}

#include <cstdint>
namespace pg8 {
#define PG8_LAS __attribute__((address_space(3)))
typedef unsigned short bf16_t;
typedef short bf16x8 __attribute__((ext_vector_type(8)));
typedef float f32x4 __attribute__((ext_vector_type(4)));
typedef unsigned u32x4 __attribute__((ext_vector_type(4)));
constexpr int BM = 256, BK = 64, HALF = 128, HTB = HALF * BK * 2  , STAGE_BYTES = 8 * HTB, NXCD = 8, WGM = 8;

__host__ __device__ __forceinline__ int lds_byte(int r, int c) { const int st = (r >> 4) * 2 + (c >> 5), rr = r & 15, cc = c & 31, ob = rr * 64 + cc * 2; return st * 1024 + (ob ^ (((ob >> 9) & 1) << 5)); }
__host__ __device__ __forceinline__ void stage_rc(int b, int& R, int& C) { const int st = b / 1024, sb = b % 1024, swz = sb ^ (((sb >> 9) & 1) << 5); R = (st >> 1) * 16 + swz / 64; C = (st & 1) * 32 + (swz % 64) / 2; }
__host__ __device__ __forceinline__ int perm32(int rho) { const int n = rho >> 4, i = rho & 15; return 8 * (i >> 2) + 4 * n + (i & 3); }

struct Unit { int pm, pn, grp, pad_; const char* A; const char* B; };
struct Gemm { const bf16_t* A; const bf16_t* Bt; int M, N, K, lda, ldb; };

struct StaticOrder {
    int nM, nN, nwg, G, c; const char* A; const char* B; size_t tsA, tsB, acs;
    __host__ __device__ void init(const Gemm& g, int G_, int c_) { nM = g.M / BM; nN = g.N / BM; nwg = nM * nN; G = G_; c = c_; A = (const char*)g.A; B = (const char*)g.Bt; tsA = (size_t)BM * g.lda * 2; tsB = (size_t)BM * g.ldb * 2; acs = 0; }
    __host__ __device__ bool next(int i, Unit& u) const {
        const long L = (long)i * G + c; if (L >= nwg) return false;
        int wgid = (int)L; { const int q = nwg / NXCD, r = nwg % NXCD, xcd = wgid % NXCD, off = wgid / NXCD; wgid = (xcd < r ? xcd * (q + 1) : r * (q + 1) + (xcd - r) * q) + off; }
        const int nig = WGM * nN, gid = wgid / nig, fm = gid * WGM, gsz = (nM - fm) < WGM ? (nM - fm) : WGM;
        u.pm = fm + ((wgid % nig) % gsz); u.pn = (wgid % nig) / gsz; u.grp = 0; u.pad_ = 0; u.A = A + (size_t)u.pm * tsA + (size_t)u.pn * acs; u.B = B + (size_t)u.pn * tsB; return true;
    }
    __device__ __forceinline__ void a_ready(const Unit&) const {}
    __device__ __forceinline__ void done(const Unit&) const {}
};

template <class Epi, class Sched, bool ALIGN_EPI = false, bool SP2 = false>
__device__ __forceinline__ void gemm_phase(PG8_LAS unsigned char* lds, const Gemm g, const Sched& S, const Epi& E) {
    int tid_raw = threadIdx.x; asm volatile("" : "+v"(tid_raw));
    const int tid = tid_raw, wid = __builtin_amdgcn_readfirstlane(tid >> 6), lane = tid & 63, wr = wid >> 2, wc = wid & 3, fr = lane & 15, fq = lane >> 4;
    const int K = g.K, nt = K / BK;
    unsigned voffA[2], voffB[2];
#pragma unroll
    for (int i = 0; i < 2; ++i) { int R, C; stage_rc(tid * 16 + i * 8192, R, C); const int Rb = Epi::PERM ? ((R & ~31) + perm32(R & 31)) : R;
        voffA[i] = (unsigned)(R * g.lda + C) * 2u; voffB[i] = (unsigned)(Rb * g.ldb + C) * 2u; }
    const size_t kstep = (size_t)(BK * 2);
    const size_t hstepA = (size_t)HALF * g.lda * 2, hstepB = (size_t)HALF * g.ldb * 2;
    const unsigned ldsw = (unsigned)wid * 1024u;
    const int aoff = lds_byte(wr * 64 + fr, fq * 8), boff = lds_byte(wc * 32 + fr, fq * 8);
#define PG8_SA(b, h) (((b) * 2 + (h)) * HTB)
#define PG8_SB(b, h) ((4 + (b) * 2 + (h)) * HTB)
#define PG8_STAGE(bufoff, gbase, voff) do { _Pragma("unroll") for (int _i = 0; _i < 2; ++_i) \
        __builtin_amdgcn_global_load_lds((const unsigned*)((const char*)(gbase) + (voff)[_i]), (PG8_LAS unsigned*)(lds + (bufoff) + ldsw + _i * 8192), 16, 0, 0); } while (0)
#define PG8_LDA(dst, b, h) do { _Pragma("unroll") for (int m = 0; m < 4; ++m) _Pragma("unroll") for (int k = 0; k < 2; ++k) dst[m][k] = *(const PG8_LAS bf16x8*)(lds + PG8_SA(b, h) + aoff + m * 2048 + k * 1024); } while (0)
#define PG8_LDB(dst, b, h) do { _Pragma("unroll") for (int n = 0; n < 2; ++n) _Pragma("unroll") for (int k = 0; k < 2; ++k) dst[n][k] = *(const PG8_LAS bf16x8*)(lds + PG8_SB(b, h) + boff + n * 2048 + k * 1024); } while (0)
#define PG8_MMA(ai, bj, At, Bt) do { __builtin_amdgcn_s_setprio(1); _Pragma("unroll") for (int m = 0; m < 4; ++m) _Pragma("unroll") for (int n = 0; n < 2; ++n) _Pragma("unroll") for (int k = 0; k < 2; ++k) \
        acc[ai][bj][m][n] = __builtin_amdgcn_mfma_f32_16x16x32_bf16(Bt[n][k], At[m][k], acc[ai][bj][m][n], 0, 0, 0); __builtin_amdgcn_s_setprio(0); } while (0)
#define PG8_WAIT_V(n) asm volatile("s_waitcnt vmcnt(" #n ")" ::: "memory")
#define PG8_WAIT_L(n) asm volatile("s_waitcnt lgkmcnt(" #n ")" ::: "memory")
#define PG8_BAR __builtin_amdgcn_s_barrier()
#define PG8_SCHED __builtin_amdgcn_sched_barrier(0)
    Unit cur, nxt; int ui = 0;
    if (!S.next(0, cur)) return;
    f32x4 acc[2][2][4][2];
#pragma unroll
    for (int a = 0; a < 2; ++a)
#pragma unroll
        for (int b = 0; b < 2; ++b)
#pragma unroll
            for (int m = 0; m < 4; ++m)
#pragma unroll
                for (int n = 0; n < 2; ++n) acc[a][b][m][n] = (f32x4){0.f, 0.f, 0.f, 0.f};
    bf16x8 At[4][2], B0[2][2], B1[2][2];
    const char* cA = cur.A; const char* cB = cur.B;
    S.a_ready(cur);
    if constexpr (SP2) {
        PG8_STAGE(PG8_SB(0, 0), cB, voffB); PG8_STAGE(PG8_SB(0, 1), cB + hstepB, voffB); PG8_STAGE(PG8_SA(0, 0), cA, voffA); PG8_STAGE(PG8_SA(0, 1), cA + hstepA, voffA);
        if (wr == 1) PG8_BAR;
        PG8_WAIT_V(2); PG8_BAR;
        PG8_STAGE(PG8_SB(1, 0), cB + kstep, voffB); PG8_STAGE(PG8_SA(1, 0), cA + kstep, voffA); PG8_STAGE(PG8_SB(1, 1), cB + hstepB + kstep, voffB);
        PG8_WAIT_V(6); PG8_BAR;
    } else {
        PG8_STAGE(PG8_SB(0, 0), cB, voffB); PG8_STAGE(PG8_SA(0, 0), cA, voffA); PG8_STAGE(PG8_SB(0, 1), cB + hstepB, voffB); PG8_STAGE(PG8_SA(0, 1), cA + hstepA, voffA);
        if (wr == 1) PG8_BAR;
        PG8_WAIT_V(4); PG8_BAR;
        PG8_STAGE(PG8_SB(1, 0), cB + kstep, voffB); PG8_STAGE(PG8_SA(1, 0), cA + kstep, voffA); PG8_STAGE(PG8_SB(1, 1), cB + hstepB + kstep, voffB);
        PG8_WAIT_V(6); PG8_BAR;
    }
    for (;;) {
        const bool has_next = S.next(ui + 1, nxt);
        const char* nA = has_next ? nxt.A : cA; const char* nB = has_next ? nxt.B : cB;
        for (int t = 0; t < nt; t += 2) {
            const bool last = (t == nt - 2);
            const char* a1 = cA + (size_t)(t + 1) * kstep;
            const char* a2 = last ? nA : cA + (size_t)(t + 2) * kstep; const char* b2 = last ? nB : cB + (size_t)(t + 2) * kstep;
            const char* a3 = a2 + kstep; const char* b3 = b2 + kstep;
            if (last && has_next) S.a_ready(nxt);
            if constexpr (SP2) {
            PG8_LDB(B0, 0, 0); PG8_LDB(B1, 0, 1); PG8_SCHED; PG8_LDA(At, 0, 0); PG8_STAGE(PG8_SA(1, 1), a1 + hstepA, voffA);
            PG8_WAIT_V(8); PG8_WAIT_L(0); PG8_BAR; PG8_MMA(0, 0, At, B0); PG8_MMA(0, 1, At, B1); PG8_BAR; PG8_SCHED;
            PG8_LDA(At, 0, 1); PG8_STAGE(PG8_SB(0, 0), b2, voffB); PG8_STAGE(PG8_SB(0, 1), b2 + hstepB, voffB); PG8_STAGE(PG8_SA(0, 0), a2, voffA);
            PG8_WAIT_V(8); PG8_WAIT_L(0); PG8_BAR; PG8_MMA(1, 0, At, B0); PG8_MMA(1, 1, At, B1); PG8_BAR; PG8_SCHED;
            PG8_LDB(B0, 1, 0); PG8_LDB(B1, 1, 1); PG8_SCHED; PG8_LDA(At, 1, 0); PG8_STAGE(PG8_SA(0, 1), a2 + hstepA, voffA);
            PG8_WAIT_V(8); PG8_WAIT_L(0); PG8_BAR; PG8_MMA(0, 0, At, B0); PG8_MMA(0, 1, At, B1); PG8_BAR; PG8_SCHED;
            PG8_LDA(At, 1, 1); PG8_STAGE(PG8_SB(1, 0), b3, voffB); PG8_STAGE(PG8_SB(1, 1), b3 + hstepB, voffB); PG8_STAGE(PG8_SA(1, 0), a3, voffA);
            PG8_WAIT_V(8); PG8_WAIT_L(0); PG8_BAR; PG8_MMA(1, 0, At, B0); PG8_MMA(1, 1, At, B1); PG8_BAR; PG8_SCHED;
            } else {
            PG8_LDB(B0, 0, 0); PG8_SCHED; PG8_LDA(At, 0, 0); PG8_STAGE(PG8_SA(1, 1), a1 + hstepA, voffA);
            PG8_WAIT_L(8); PG8_BAR; PG8_WAIT_L(0); PG8_MMA(0, 0, At, B0); PG8_BAR; PG8_SCHED;
            PG8_LDB(B1, 0, 1); PG8_STAGE(PG8_SB(0, 0), b2, voffB);
            PG8_BAR; PG8_WAIT_L(0); PG8_MMA(0, 1, At, B1); PG8_BAR;
            PG8_LDA(At, 0, 1); PG8_STAGE(PG8_SA(0, 0), a2, voffA);
            PG8_BAR; PG8_WAIT_L(0); PG8_MMA(1, 0, At, B0); PG8_BAR; PG8_SCHED;
            PG8_STAGE(PG8_SB(0, 1), b2 + hstepB, voffB);
            PG8_WAIT_V(6); PG8_BAR; PG8_MMA(1, 1, At, B1); PG8_BAR;
            PG8_LDB(B0, 1, 0); PG8_SCHED; PG8_LDA(At, 1, 0); PG8_STAGE(PG8_SA(0, 1), a2 + hstepA, voffA);
            PG8_WAIT_L(8); PG8_BAR; PG8_WAIT_L(0); PG8_MMA(0, 0, At, B0); PG8_BAR; PG8_SCHED;
            PG8_LDB(B1, 1, 1); PG8_STAGE(PG8_SB(1, 0), b3, voffB);
            PG8_BAR; PG8_WAIT_L(0); PG8_MMA(0, 1, At, B1); PG8_BAR;
            PG8_LDA(At, 1, 1); PG8_STAGE(PG8_SA(1, 0), a3, voffA);
            PG8_BAR; PG8_WAIT_L(0); PG8_MMA(1, 0, At, B0); PG8_BAR; PG8_SCHED;
            PG8_STAGE(PG8_SB(1, 1), b3 + hstepB, voffB);
            PG8_WAIT_V(6); PG8_BAR; PG8_MMA(1, 1, At, B1); PG8_BAR;
            }
        }
        if constexpr (ALIGN_EPI) { if (wr == 0) PG8_BAR; }
        if constexpr (!Epi::AFTER_DRAIN) { E(acc, cur, wr, wc, fr, fq); S.done(cur); }
        if (!has_next) break;
#pragma unroll
        for (int a = 0; a < 2; ++a)
#pragma unroll
            for (int b = 0; b < 2; ++b)
#pragma unroll
                for (int m = 0; m < 4; ++m)
#pragma unroll
                    for (int n = 0; n < 2; ++n) acc[a][b][m][n] = (f32x4){0.f, 0.f, 0.f, 0.f};
        cur = nxt; cA = nA; cB = nB; ++ui;
        if constexpr (ALIGN_EPI) { if (wr == 1) PG8_BAR; }
    }
    PG8_WAIT_V(0);
    if constexpr (!ALIGN_EPI) { if (wr == 0) PG8_BAR; }
    PG8_BAR;
    if constexpr (Epi::AFTER_DRAIN) { E.fused(acc, cur, wr, wc, fr, fq, lds, wid, lane); S.done(cur); }
#undef PG8_SA
#undef PG8_SB
#undef PG8_STAGE
#undef PG8_LDA
#undef PG8_LDB
#undef PG8_MMA
#undef PG8_WAIT_V
#undef PG8_WAIT_L
#undef PG8_BAR
#undef PG8_SCHED
}
}
template <class T> __device__ __forceinline__ T* uni_ptr(T* p) {
    unsigned long long v = (unsigned long long)p; unsigned lo = __builtin_amdgcn_readfirstlane((unsigned)v), hi = __builtin_amdgcn_readfirstlane((unsigned)(v >> 32));
    unsigned long long r = ((unsigned long long)hi << 32) | lo; asm volatile("" : "+s"(r)); return (T*)r; }
__device__ __forceinline__ int rfl(int x) { int t = __builtin_amdgcn_readfirstlane(x); asm volatile("" : "+s"(t)); return t; }
namespace pg8 {
__device__ __forceinline__ unsigned cvt_pk_bf16(float lo, float hi) { unsigned r; asm volatile("v_cvt_pk_bf16_f32 %0, %1, %2" : "=v"(r) : "v"(lo), "v"(hi)); return r; }
struct EpiF32 {
    static constexpr bool PERM = false, AFTER_DRAIN = false;
    float* C; int ldc, Mreal, Nreal;
    __device__ __forceinline__ void operator()(const f32x4 (&acc)[2][2][4][2], const Unit& u, int wr, int wc, int fr, int fq) const {
        const int row0 = u.pm * BM + wr * 64 + fr, col0 = u.pn * BM + wc * 32 + 4 * fq;
#pragma unroll
        for (int ai = 0; ai < 2; ++ai)
#pragma unroll
            for (int m = 0; m < 4; ++m) { const int r = row0 + ai * HALF + m * 16; if (r < Mreal) { float* rowp = C + (size_t)r * ldc + col0;
#pragma unroll
                for (int bj = 0; bj < 2; ++bj)
#pragma unroll
                    for (int n = 0; n < 2; ++n) { const int c = col0 + bj * HALF + n * 16; if (c < Nreal) *(f32x4*)(rowp + bj * HALF + n * 16) = acc[ai][bj][m][n]; } } }
    }
};
struct EpiBf16Plain {
    static constexpr bool PERM = true, AFTER_DRAIN = false;
    bf16_t* O; int ldc;
    __device__ __forceinline__ void operator()(const f32x4 (&acc)[2][2][4][2], const Unit& u, int wr, int wc, int fr, int fq) const {
        const int row0 = u.pm * BM + wr * 64 + fr, col0 = u.pn * BM + wc * 32 + 8 * fq;
#pragma unroll
        for (int ai = 0; ai < 2; ++ai)
#pragma unroll
            for (int m = 0; m < 4; ++m) { bf16_t* rowp = O + (size_t)(row0 + ai * HALF + m * 16) * ldc + col0;
#pragma unroll
                for (int bj = 0; bj < 2; ++bj) { const f32x4 v0 = acc[ai][bj][m][0], v1 = acc[ai][bj][m][1]; u32x4 w;
                    w.x = cvt_pk_bf16(v0[0], v0[1]); w.y = cvt_pk_bf16(v0[2], v0[3]); w.z = cvt_pk_bf16(v1[0], v1[1]); w.w = cvt_pk_bf16(v1[2], v1[3]);
                    *(u32x4*)(rowp + bj * HALF) = w; } }
    }
};
struct EpiLru {
    static constexpr bool PERM = false, AFTER_DRAIN = false;
    const float* ba; const float* bx; const float* spl; const float* XC; float* AT; float* BT; int Mreal;
    __device__ __forceinline__ void operator()(const f32x4 (&acc)[2][2][4][2], const Unit& u, int wr, int wc, int fr, int fq) const {
        const int row0 = u.pm * BM + wr * 64 + fr, ch0 = u.pn * 128 + wc * 32 + 4 * fq;
#pragma unroll
        for (int n = 0; n < 2; ++n) { const int c = ch0 + 16 * n; const f32x4 ba4 = *(const f32x4*)(ba + c), bx4 = *(const f32x4*)(bx + c), sp4 = *(const f32x4*)(spl + c);
#pragma unroll
            for (int ai = 0; ai < 2; ++ai)
#pragma unroll
                for (int m = 0; m < 4; ++m) { const int r = row0 + ai * HALF + m * 16; if (r < Mreal) { const f32x4 xc = *(const f32x4*)(XC + (size_t)r * 512 + c); const f32x4 ga = acc[ai][0][m][n] + ba4, gx = acc[ai][1][m][n] + bx4; f32x4 at, bt;
#pragma unroll
                    for (int i = 0; i < 4; ++i) { const float gate_a = 1.f / (1.f + __expf(-ga[i])), gate_x = 1.f / (1.f + __expf(-gx[i])); const float la = gate_a * sp4[i]; at[i] = __expf(la); bt[i] = sqrtf(-expm1f(2.f * la)) * (gate_x * xc[i]); }
                    *(f32x4*)(AT + (size_t)r * 512 + c) = at; *(f32x4*)(BT + (size_t)r * 512 + c) = bt; } } }
    }
};
struct GroupOrder {
    const PG8_LAS Op* tab; int ng, nM, G, c; size_t tsA, tsB;
    __device__ __forceinline__ bool next(int i, Unit& u) const {
        int L = i * G + c, g = 0;
        for (; g < ng; ++g) { const int cnt = nM * (__builtin_amdgcn_readfirstlane(tab[g].i5) >> 8); if (L < cnt) break; L -= cnt; }
        if (g >= ng) return false;
        u.pm = L % nM; u.pn = L / nM; u.grp = g; u.pad_ = 0;
        u.A = (const char*)uni_ptr(tab[g].a) + (size_t)u.pm * tsA; u.B = (const char*)uni_ptr(tab[g].b) + (size_t)u.pn * tsB; return true;
    }
    __device__ __forceinline__ void a_ready(const Unit&) const {}
    __device__ __forceinline__ void done(const Unit&) const {}
};
struct EpiGroup {
    static constexpr bool PERM = true, AFTER_DRAIN = false;
    const PG8_LAS Op* tab; int Mreal;
    __device__ __forceinline__ void operator()(const f32x4 (&acc)[2][2][4][2], const Unit& u, int wr, int wc, int fr, int fq) const {
        const int ldc = rfl(tab[u.grp].i4), Nreal = rfl(tab[u.grp].i0), fl = rfl(tab[u.grp].i6);
        if (fl & 1) { const EpiBf16Plain E{(bf16_t*)uni_ptr(tab[u.grp].o0), ldc}; E(acc, u, wr, wc, fr, fq); return; }
        float* C = uni_ptr(tab[u.grp].o0); const int row0 = u.pm * BM + wr * 64 + fr, col0 = u.pn * BM + wc * 32 + 8 * fq;
#pragma unroll
        for (int ai = 0; ai < 2; ++ai)
#pragma unroll
            for (int m = 0; m < 4; ++m) { const int r = row0 + ai * HALF + m * 16; if (r < Mreal) { float* rowp = C + (size_t)r * ldc + col0;
#pragma unroll
                for (int bj = 0; bj < 2; ++bj) { if (col0 + bj * HALF < Nreal) { *(f32x4*)(rowp + bj * HALF) = acc[ai][bj][m][0]; *(f32x4*)(rowp + bj * HALF + 4) = acc[ai][bj][m][1]; } } } }
    }
};
}

#define XB_TMO      128
#define XB_XCNT(j)  (256  + 64 * (j))
#define XB_XSUB(j)  (1280 + 64 * (j))
#define XB_XGEN(j)  (2304 + 64 * (j))
#define XB_TOP      3328
#define XB_TOPGEN   3392
#define XCD_BAR_WORDS 3456
#define XB_SPIN_CAP (1u << 18)
#define LAS __attribute__((address_space(3)))
__device__ __forceinline__ unsigned xb_ld(unsigned* p)              { return __hip_atomic_load(p, __ATOMIC_RELAXED, __HIP_MEMORY_SCOPE_AGENT); }
__device__ __forceinline__ unsigned xb_add(unsigned* p, unsigned v) { return __hip_atomic_fetch_add(p, v, __ATOMIC_RELAXED, __HIP_MEMORY_SCOPE_AGENT); }
__device__ __forceinline__ unsigned xb_xcc_id() { return (unsigned)__builtin_amdgcn_s_getreg((3 << 11) | 20) & 0xFu; }
#define XB_SPIN(cond, bar) do { unsigned _sp = 0; while (cond) { __builtin_amdgcn_s_sleep(1); \
    if ((++_sp & 255u) == 0u) { if (xb_ld(&(bar)[XB_TMO])) break; if (_sp > XB_SPIN_CAP) { atomicAdd(&(bar)[XB_TMO], 1u); break; } } } } while (0)
struct XcdBarrier { unsigned* bar; unsigned x; volatile LAS unsigned* st; };
__device__ __forceinline__ XcdBarrier xcd_barrier_post(unsigned* bar, volatile LAS unsigned* st) {
    XcdBarrier b; b.bar = bar; b.x = xb_xcc_id(); b.st = st;
    if (threadIdx.x == 0) (void)xb_add(&bar[XB_XCNT(b.x)], 1u);
    return b;
}
__device__ __forceinline__ void xcd_barrier_complete(unsigned* bar, unsigned x, unsigned& nloc, unsigned& nx) {
    const unsigned G = gridDim.x * gridDim.y * gridDim.z;
    unsigned sum, cnt, mine, sp = 0u;
    for (;;) {
        sum = 0u; cnt = 0u; mine = 0u;
#pragma unroll
        for (unsigned j = 0; j < 16; ++j) { const unsigned c = xb_ld(&bar[XB_XCNT(j)]); sum += c; cnt += (c > 0u) ? 1u : 0u; mine = (j == x) ? c : mine; }
        if (sum == G) break;
        __builtin_amdgcn_s_sleep(1);
        if ((++sp & 255u) == 0u) { if (xb_ld(&bar[XB_TMO])) break; if (sp > XB_SPIN_CAP) { atomicAdd(&bar[XB_TMO], 1u); break; } }
    }
    nloc = mine > 0u ? mine : 1u; nx = cnt > 0u ? cnt : 1u;
}
__device__ __forceinline__ void xcd_barrier(const XcdBarrier& b) {
    asm volatile("s_waitcnt vmcnt(0)" ::: "memory");
    __syncthreads();
    if (threadIdx.x == 0) {
        unsigned* bar = b.bar;
        __builtin_amdgcn_s_waitcnt(0);
        unsigned nloc = b.st[0], nx = b.st[1];
        if (nloc == 0u) { xcd_barrier_complete(bar, b.x, nloc, nx); b.st[0] = nloc; b.st[1] = nx; }
        const unsigned old = xb_add(&bar[XB_XSUB(b.x)], 1u);
        const unsigned gen = old / nloc;
        if (old + 1u == (gen + 1u) * nloc) {
            __builtin_amdgcn_fence(__ATOMIC_RELEASE, "agent");
            asm volatile("s_waitcnt vmcnt(0)" ::: "memory");
            const unsigned og = xb_add(&bar[XB_TOP], 1u);
            const unsigned tg = og / nx;
            if (og + 1u == (tg + 1u) * nx) xb_add(&bar[XB_TOPGEN], 1u);
            else XB_SPIN(xb_ld(&bar[XB_TOPGEN]) == tg, bar);
            __builtin_amdgcn_fence(__ATOMIC_ACQUIRE, "agent");
            xb_add(&bar[XB_XGEN(b.x)], 1u);
            asm volatile("s_waitcnt vmcnt(0)" ::: "memory");
        } else {
            XB_SPIN(xb_ld(&bar[XB_XGEN(b.x)]) == gen, bar);
            __builtin_amdgcn_fence(__ATOMIC_ACQUIRE, "agent");
            asm volatile("s_waitcnt vmcnt(0)" ::: "memory");
        }
    }
    __syncthreads();
}

namespace fk {
#define GAS __attribute__((address_space(1)))
typedef unsigned u32x4 __attribute__((ext_vector_type(4)));
typedef unsigned u32x2 __attribute__((ext_vector_type(2)));
typedef float f32x4 __attribute__((ext_vector_type(4)));
typedef float f32x2 __attribute__((ext_vector_type(2)));
typedef __bf16 bf2 __attribute__((ext_vector_type(2)));
typedef unsigned short bf16_t;
__device__ __forceinline__ float bflo(unsigned u) { return __uint_as_float(u << 16); }
__device__ __forceinline__ float bfhi(unsigned u) { return __uint_as_float(u & 0xffff0000u); }
__device__ __forceinline__ float dot2(unsigned a, unsigned b, float c) { return __builtin_amdgcn_fdot2_f32_bf16(__builtin_bit_cast(bf2, a), __builtin_bit_cast(bf2, b), c, false); }
__device__ __forceinline__ unsigned pk_bf16(float lo, float hi) { unsigned r; asm volatile("v_cvt_pk_bf16_f32 %0, %1, %2" : "=v"(r) : "v"(lo), "v"(hi)); return r; }
template <int CTRL> __device__ __forceinline__ float dppf(float v) { return __int_as_float(__builtin_amdgcn_update_dpp(0, __float_as_int(v), CTRL, 0xf, 0xf, true)); }
__device__ __forceinline__ float row_max16(float v) { v = fmaxf(v, dppf<0xB1>(v)); v = fmaxf(v, dppf<0x4E>(v)); v = fmaxf(v, dppf<0x141>(v)); v = fmaxf(v, dppf<0x140>(v)); return v; }
__device__ __forceinline__ float row_sum16(float v) { v += dppf<0xB1>(v); v += dppf<0x4E>(v); v += dppf<0x141>(v); v += dppf<0x140>(v); return v; }
__device__ __forceinline__ float shx(float v, int m, int lane) { return __int_as_float(__builtin_amdgcn_ds_bpermute((lane ^ m) << 2, __float_as_int(v))); }
__device__ __forceinline__ float wave_sum(float v, int lane) { v = row_sum16(v); v += shx(v, 16, lane); v += shx(v, 32, lane); return v; }
__device__ __forceinline__ float gelu_tanh(float x) { return 0.5f * x * (1.f + tanhf(0.7978845608028654f * (x + 0.044715f * x * x * x))); }
#define FK_NEG (-3.0e38f)

template <int CTRL> __device__ __forceinline__ int dppi(int v) { return __builtin_amdgcn_update_dpp(0, v, CTRL, 0xf, 0xf, true); }
__device__ __forceinline__ int row_min16i(int v) { v = min(v, dppi<0xB1>(v)); v = min(v, dppi<0x4E>(v)); v = min(v, dppi<0x141>(v)); v = min(v, dppi<0x140>(v)); return v; }
#define FK_CE(a, b) do { const bool sw_ = v[b] > v[a]; const float tv_ = sw_ ? v[b] : v[a]; v[b] = sw_ ? v[a] : v[b]; v[a] = tv_; const int ti_ = sw_ ? id[b] : id[a]; id[b] = sw_ ? id[a] : id[b]; id[a] = ti_; } while (0)
#define FK_SORT8(v, id) do { FK_CE2(v, id, 0, 1); FK_CE2(v, id, 2, 3); FK_CE2(v, id, 4, 5); FK_CE2(v, id, 6, 7); FK_CE2(v, id, 0, 2); FK_CE2(v, id, 1, 3); FK_CE2(v, id, 4, 6); FK_CE2(v, id, 5, 7); FK_CE2(v, id, 1, 2); FK_CE2(v, id, 5, 6); \
    FK_CE2(v, id, 0, 4); FK_CE2(v, id, 1, 5); FK_CE2(v, id, 2, 6); FK_CE2(v, id, 3, 7); FK_CE2(v, id, 2, 4); FK_CE2(v, id, 3, 5); FK_CE2(v, id, 1, 2); FK_CE2(v, id, 3, 4); FK_CE2(v, id, 5, 6); } while (0)
#define FK_CE2(v, id, a, b) do { const bool sw_ = v[b] > v[a]; const float tv_ = sw_ ? v[b] : v[a]; v[b] = sw_ ? v[a] : v[b]; v[a] = tv_; const int ti_ = sw_ ? id[b] : id[a]; id[b] = sw_ ? id[a] : id[b]; id[a] = ti_; } while (0)
__device__ __forceinline__ void top16_of_128_x2(float (&v)[8], int (&id)[8], float (&u)[8], int (&jd)[8], int lane16, float& rv1, int& ri1, float& rv2, int& ri2) {
    FK_SORT8(v, id); FK_SORT8(u, jd);
    rv1 = FK_NEG; ri1 = 0; rv2 = FK_NEG; ri2 = 0;
#pragma unroll
    for (int r = 0; r < 16; ++r) {
        const float wm = row_max16(v[0]), xm = row_max16(u[0]);
        const int cand = (v[0] == wm) ? id[0] : 0x7fffffff, dand = (u[0] == xm) ? jd[0] : 0x7fffffff;
        const int sel = row_min16i(cand), tel = row_min16i(dand);
        const bool mine = (cand == sel), nine = (dand == tel);
        if (lane16 == r) { rv1 = wm; ri1 = sel; rv2 = xm; ri2 = tel; }
#pragma unroll
        for (int i = 0; i < 7; ++i) { v[i] = mine ? v[i + 1] : v[i]; id[i] = mine ? id[i + 1] : id[i]; u[i] = nine ? u[i + 1] : u[i]; jd[i] = nine ? jd[i + 1] : jd[i]; }
        v[7] = mine ? FK_NEG : v[7]; u[7] = nine ? FK_NEG : u[7];
    }
}
__device__ __forceinline__ int fk_key(float x, int lane16) { int k = __float_as_int(x); k ^= (k >> 31) & 0x7fffffff; return (k & ~15) | (15 - lane16); }
__device__ __forceinline__ float fk_unkey(int k) { k &= ~15; k ^= (k >> 31) & 0x7fffffff; return __int_as_float(k); }
__device__ __forceinline__ int row_max16i(int v) { v = max(v, dppi<0xB1>(v)); v = max(v, dppi<0x4E>(v)); v = max(v, dppi<0x141>(v)); v = max(v, dppi<0x140>(v)); return v; }
__device__ __forceinline__ void topk_phase(const GAS float* __restrict__ SC, const GAS bf16_t* __restrict__ Q, const GAS float* __restrict__ KSUM, GAS float* __restrict__ GATE, GAS int* __restrict__ EIDX, int nitems,
                                           LAS unsigned char* lds, int wid, int lane, int wave_gid, int nwaves) {
    LAS unsigned char* wb = lds + wid * 6144;
    LAS int* IDS1 = (LAS int*)wb; LAS int* IDS2 = (LAS int*)(wb + 2048); LAS int* LC1 = (LAS int*)(wb + 4096); LAS int* LC2 = (LAS int*)(wb + 4352); LAS int* CI = (LAS int*)(wb + 4608);
    LAS float* xv = (LAS float*)(wb + 4864); LAS int* DUMP = (LAS int*)(wb + 5120) + lane; LAS int* WL1 = (LAS int*)(wb + 5376); LAS int* WL2 = (LAS int*)(wb + 5632);
    const int lane16 = lane & 15, rowbase = lane & 48;
    for (int wi = wave_gid; wi * 4 < nitems; wi += nwaves) {
        const int it = wi * 4 + (lane >> 4); const int h = it & 7;
        const GAS u32x4* qp = (const GAS u32x4*)(Q + (size_t)it * 256 + 16 * lane16); const u32x4 qa = qp[0], qb = qp[1];
        float qs = 0.f, qq = 0.f;
#pragma unroll
        for (int i = 0; i < 4; ++i) { const float a = bflo(qa[i]), b = bfhi(qa[i]), c = bflo(qb[i]), d = bfhi(qb[i]); qs += (a + b) + (c + d); qq += (a * a + b * b) + (c * c + d * d); }
        const float mu = row_sum16(qs) * (1.f / 256.f); const float var = fmaxf(row_sum16(qq) * (1.f / 256.f) - mu * mu, 0.f); const float rs = 1.f / sqrtf(var + 1e-5f);
        float v[8], u[8]; int id[8], jd[8];
        { const GAS float* sp = SC + (size_t)it * 256 + 8 * lane16; const GAS float* kp = KSUM + h * 256 + 8 * lane16; const f32x4 s0 = *(const GAS f32x4*)sp, s1 = *(const GAS f32x4*)(sp + 4), k0 = *(const GAS f32x4*)kp, k1 = *(const GAS f32x4*)(kp + 4);
          const f32x4 t0 = *(const GAS f32x4*)(sp + 128), t1 = *(const GAS f32x4*)(sp + 132), m0 = *(const GAS f32x4*)(kp + 128), m1 = *(const GAS f32x4*)(kp + 132);
#pragma unroll
          for (int i = 0; i < 4; ++i) { v[i] = rs * (s0[i] - mu * k0[i]); v[4 + i] = rs * (s1[i] - mu * k1[i]); u[i] = rs * (t0[i] - mu * m0[i]); u[4 + i] = rs * (t1[i] - mu * m1[i]);
              id[i] = 8 * lane16 + i; id[4 + i] = 8 * lane16 + 4 + i; jd[i] = 8 * lane16 + i; jd[4 + i] = 8 * lane16 + 4 + i; } }
        FK_SORT8(v, id); FK_SORT8(u, jd);
#pragma unroll
        for (int i = 0; i < 8; ++i) { IDS1[lane * 8 + i] = id[i]; IDS2[lane * 8 + i] = jd[i]; }
        float rv1 = FK_NEG, rv2 = FK_NEG; int wl1 = 0, wl2 = 0, cn1 = 0, cn2 = 0;
#pragma unroll
        for (int r = 0; r < 16; ++r) {
            const int key1 = fk_key(v[0], lane16), key2 = fk_key(u[0], lane16);
            const int wm1 = row_max16i(key1), wm2 = row_max16i(key2);
            const bool mine = (key1 == wm1), nine = (key2 == wm2);
            if (lane16 == r) { rv1 = fk_unkey(wm1); wl1 = 15 - (wm1 & 15); rv2 = fk_unkey(wm2); wl2 = 15 - (wm2 & 15); }
            *(mine ? LC1 + rowbase + r : DUMP) = cn1; *(nine ? LC2 + rowbase + r : DUMP) = cn2;
#pragma unroll
            for (int i = 0; i < 7; ++i) { v[i] = mine ? v[i + 1] : v[i]; u[i] = nine ? u[i + 1] : u[i]; }
            v[7] = mine ? FK_NEG : v[7]; u[7] = nine ? FK_NEG : u[7]; cn1 += mine ? 1 : 0; cn2 += nine ? 1 : 0;
        }
        xv[lane] = rv2; WL1[lane] = wl1; WL2[lane] = wl2;
        float c[16];
        { const LAS f32x4* xp = (const LAS f32x4*)(xv + rowbase);
#pragma unroll
          for (int q = 0; q < 4; ++q) { const f32x4 t = xp[q]; c[4 * q] = rv1 + t.x; c[4 * q + 1] = rv1 + t.y; c[4 * q + 2] = rv1 + t.z; c[4 * q + 3] = rv1 + t.w; } }
        int p = 0, wli = 0; float sc = FK_NEG;
#pragma unroll
        for (int r = 0; r < 16; ++r) {
            const int key = fk_key(c[0], lane16); const int wm = row_max16i(key); const bool mine = (key == wm);
            if (lane16 == r) { sc = fk_unkey(wm); wli = 15 - (wm & 15); }
            *(mine ? CI + rowbase + r : DUMP) = p;
#pragma unroll
            for (int i = 0; i < 15; ++i) c[i] = mine ? c[i + 1] : c[i];
            c[15] = mine ? FK_NEG : c[15]; p += mine ? 1 : 0;
        }
        const int i1 = wli & 15, j2 = CI[rowbase + lane16] & 15;
        const int e1 = IDS1[(rowbase + (WL1[rowbase + i1] & 15)) * 8 + (LC1[rowbase + i1] & 7)], e2 = IDS2[(rowbase + (WL2[rowbase + j2] & 15)) * 8 + (LC2[rowbase + j2] & 7)];
        const float mx = fk_unkey(row_max16i(fk_key(sc, 0))); const float ex = __expf(sc - mx); const float den = row_sum16(ex);
        GATE[(size_t)it * 16 + lane16] = ex / den; EIDX[(size_t)it * 16 + lane16] = (e1 & 127) * 128 + (e2 & 127);
    }
}

__device__ __forceinline__ f32x2 fp8lo(unsigned w) { return __builtin_amdgcn_cvt_pk_f32_fp8((int)w, false); }
__device__ __forceinline__ f32x2 fp8hi(unsigned w) { return __builtin_amdgcn_cvt_pk_f32_fp8((int)w, true); }
__device__ __forceinline__ void act_phase(const GAS bf16_t* __restrict__ XB, const GAS unsigned char* __restrict__ U8, const GAS float* __restrict__ GATE, const GAS int* __restrict__ EIDX, GAS float* __restrict__ COEF, int nitems,
                                          int lane, int wave_gid, int nwaves) {
    int it = wave_gid; if (it >= nitems) return;
    u32x4 uc[16], un[16], xac, xbc, xan, xbn;
    int evc = EIDX[(size_t)it * 16 + (lane & 15)];
    { const GAS u32x4* xp = (const GAS u32x4*)(XB + (size_t)(it >> 3) * 1024 + 16 * lane); xac = xp[0]; xbc = xp[1]; }
#pragma unroll
    for (int k = 0; k < 16; ++k) uc[k] = *(const GAS u32x4*)(U8 + (size_t)__builtin_amdgcn_readlane(evc, k) * 1024 + 16 * lane);
    int itn = it + nwaves; int evn = (itn < nitems) ? EIDX[(size_t)itn * 16 + (lane & 15)] : 0;
    for (;;) {
        const bool hasn = itn < nitems;
        if (hasn) {
            const GAS u32x4* xp = (const GAS u32x4*)(XB + (size_t)(itn >> 3) * 1024 + 16 * lane); xan = xp[0]; xbn = xp[1];
#pragma unroll
            for (int k = 0; k < 16; ++k) un[k] = *(const GAS u32x4*)(U8 + (size_t)__builtin_amdgcn_readlane(evn, k) * 1024 + 16 * lane);
        }
        const int itnn = itn + nwaves; const int evnn = (itnn < nitems) ? EIDX[(size_t)itnn * 16 + (lane & 15)] : 0;
        const float gt = GATE[(size_t)it * 16 + (lane >> 2)];
        float x[16];
#pragma unroll
        for (int i = 0; i < 4; ++i) { x[2 * i] = bflo(xac[i]); x[2 * i + 1] = bfhi(xac[i]); x[8 + 2 * i] = bflo(xbc[i]); x[8 + 2 * i + 1] = bfhi(xbc[i]); }
        float a[16];
#pragma unroll
        for (int k = 0; k < 16; ++k) { const u32x4 uw = uc[k]; float s = 0.f;
#pragma unroll
            for (int d = 0; d < 4; ++d) { const f32x2 lo = fp8lo(uw[d]), hi = fp8hi(uw[d]); s = fmaf(lo.x, x[4 * d], s); s = fmaf(lo.y, x[4 * d + 1], s); s = fmaf(hi.x, x[4 * d + 2], s); s = fmaf(hi.y, x[4 * d + 3], s); }
            asm volatile("" : "+v"(s)); a[k] = s; }
#pragma unroll
        for (int k = 0; k < 8; ++k) { const bool hi = lane & 32; const float send = hi ? a[k] : a[k + 8], keep = hi ? a[k + 8] : a[k]; a[k] = keep + shx(send, 32, lane); }
#pragma unroll
        for (int k = 0; k < 4; ++k) { const bool hi = lane & 16; const float send = hi ? a[k] : a[k + 4], keep = hi ? a[k + 4] : a[k]; a[k] = keep + shx(send, 16, lane); }
#pragma unroll
        for (int k = 0; k < 2; ++k) { const bool hi = lane & 8; const float send = hi ? a[k] : a[k + 2], keep = hi ? a[k + 2] : a[k]; a[k] = keep + shx(send, 8, lane); }
        { const bool hi = lane & 4; const float send = hi ? a[0] : a[1], keep = hi ? a[1] : a[0]; a[0] = keep + shx(send, 4, lane); }
        float dsum = a[0]; dsum += shx(dsum, 2, lane); dsum += shx(dsum, 1, lane);
        if ((lane & 3) == 0) COEF[(size_t)it * 16 + (lane >> 2)] = gt * gelu_tanh(dsum * (1.f / 128.f));
        if (!hasn) break;
#pragma unroll
        for (int k = 0; k < 16; ++k) uc[k] = un[k];
        xac = xan; xbc = xbn; evc = evn; evn = evnn; it = itn; itn = itnn;
    }
}

__device__ __forceinline__ void outln_phase(const GAS float* COEF, const GAS int* EIDX, const GAS unsigned char* V8,     const GAS float* __restrict__ lg, const GAS float* __restrict__ lb, GAS float* X, GAS bf16_t* XB, int nrows,
                                            int lane, int wave_gid, int nwaves) {
    const float alpha = 1.6817928305074292f;
    int row = wave_gid; if (row >= nrows) return;
    u32x4 vc[16], vn[16];
    float cf0 = COEF[(size_t)row * 128 + lane] * (1.f / 64.f), cf1 = COEF[(size_t)row * 128 + 64 + lane] * (1.f / 64.f); int ev0 = EIDX[(size_t)row * 128 + lane], ev1 = EIDX[(size_t)row * 128 + 64 + lane];
#define OUT_LOADCH(dst, evreg, base) do { _Pragma("unroll") for (int k_ = 0; k_ < 16; ++k_) dst[k_] = *(const GAS u32x4*)(V8 + (size_t)__builtin_amdgcn_readlane(evreg, (base) + k_) * 1024 + 16 * lane); } while (0)
#define OUT_COMPCH(src, cfreg, base) do { _Pragma("unroll") for (int k_ = 0; k_ < 16; ++k_) { const float c_ = __int_as_float(__builtin_amdgcn_readlane(__float_as_int(cfreg), (base) + k_)); const u32x4 vw_ = src[k_]; \
        _Pragma("unroll") for (int d_ = 0; d_ < 4; ++d_) { const f32x2 lo_ = fp8lo(vw_[d_]), hi_ = fp8hi(vw_[d_]); acc[4 * d_] = fmaf(c_, lo_.x, acc[4 * d_]); acc[4 * d_ + 1] = fmaf(c_, lo_.y, acc[4 * d_ + 1]); acc[4 * d_ + 2] = fmaf(c_, hi_.x, acc[4 * d_ + 2]); acc[4 * d_ + 3] = fmaf(c_, hi_.y, acc[4 * d_ + 3]); } \
        _Pragma("unroll") for (int p_ = 0; p_ < 16; ++p_) asm volatile("" : "+v"(acc[p_]));     \
        } } while (0)
    for (;;) {
        OUT_LOADCH(vc, ev0, 0);
        const int rown = row + nwaves; const bool hasn = rown < nrows;
        float ncf0 = 0.f, ncf1 = 0.f; int nev0 = 0, nev1 = 0;
        if (hasn) { ncf0 = COEF[(size_t)rown * 128 + lane] * (1.f / 64.f); ncf1 = COEF[(size_t)rown * 128 + 64 + lane] * (1.f / 64.f); nev0 = EIDX[(size_t)rown * 128 + lane]; nev1 = EIDX[(size_t)rown * 128 + 64 + lane]; }
        float acc[16];
#pragma unroll
        for (int k = 0; k < 16; ++k) acc[k] = 0.f;
#define OUT_FENCE() asm volatile("" ::: "memory")
        OUT_LOADCH(vn, ev0, 16); OUT_FENCE(); OUT_COMPCH(vc, cf0, 0); OUT_FENCE();
        OUT_LOADCH(vc, ev0, 32); OUT_FENCE(); OUT_COMPCH(vn, cf0, 16); OUT_FENCE();
        OUT_LOADCH(vn, ev0, 48); OUT_FENCE(); OUT_COMPCH(vc, cf0, 32); OUT_FENCE();
        OUT_LOADCH(vc, ev1, 0);  OUT_FENCE(); OUT_COMPCH(vn, cf0, 48); OUT_FENCE();
        OUT_LOADCH(vn, ev1, 16); OUT_FENCE(); OUT_COMPCH(vc, cf1, 0); OUT_FENCE();
        OUT_LOADCH(vc, ev1, 32); OUT_FENCE(); OUT_COMPCH(vn, cf1, 16); OUT_FENCE();
        OUT_LOADCH(vn, ev1, 48); OUT_FENCE(); OUT_COMPCH(vc, cf1, 32); OUT_FENCE();
        OUT_COMPCH(vn, cf1, 48); OUT_FENCE();
#undef OUT_FENCE
        GAS float* xr = X + (size_t)row * 1024 + 16 * lane; float t[16];
#pragma unroll
        for (int q = 0; q < 4; ++q) { const f32x4 xv = *(const GAS f32x4*)(xr + 4 * q); t[4 * q] = fmaf(alpha, xv.x, acc[4 * q]); t[4 * q + 1] = fmaf(alpha, xv.y, acc[4 * q + 1]); t[4 * q + 2] = fmaf(alpha, xv.z, acc[4 * q + 2]); t[4 * q + 3] = fmaf(alpha, xv.w, acc[4 * q + 3]); }
        float s = 0.f;
#pragma unroll
        for (int k = 0; k < 16; ++k) s += t[k];
        const float mu = wave_sum(s, lane) * (1.f / 1024.f); float vs = 0.f;
#pragma unroll
        for (int k = 0; k < 16; ++k) { t[k] -= mu; vs = fmaf(t[k], t[k], vs); }
        const float rs = 1.f / sqrtf(wave_sum(vs, lane) * (1.f / 1024.f) + 1e-5f);
        unsigned w[8];
#pragma unroll
        for (int q = 0; q < 4; ++q) { const f32x4 g = *(const GAS f32x4*)(lg + 16 * lane + 4 * q), b = *(const GAS f32x4*)(lb + 16 * lane + 4 * q); f32x4 o;
            o.x = t[4 * q] * rs * g.x + b.x; o.y = t[4 * q + 1] * rs * g.y + b.y; o.z = t[4 * q + 2] * rs * g.z + b.z; o.w = t[4 * q + 3] * rs * g.w + b.w;
            *(GAS f32x4*)(xr + 4 * q) = o; w[2 * q] = pk_bf16(o.x, o.y); w[2 * q + 1] = pk_bf16(o.z, o.w); }
        u32x4 w0, w1; w0.x = w[0]; w0.y = w[1]; w0.z = w[2]; w0.w = w[3]; w1.x = w[4]; w1.y = w[5]; w1.z = w[6]; w1.w = w[7];
        GAS u32x4* xbp = (GAS u32x4*)(XB + (size_t)row * 1024 + 16 * lane); xbp[0] = w0; xbp[1] = w1;
        if (!hasn) break;
        row = rown; cf0 = ncf0; cf1 = ncf1; ev0 = nev0; ev1 = nev1;
    }
#undef OUT_LOADCH
#undef OUT_COMPCH
}

__device__ __forceinline__ void lnres_phase(const GAS bf16_t* __restrict__ Y, const GAS float* __restrict__ lg, const GAS float* __restrict__ lb, GAS float* X, GAS bf16_t* XB, GAS unsigned char* XF8, int nrows, int lane, int wave_gid, int nwaves) {
    const float alpha = 1.6817928305074292f;
    for (int row = wave_gid; row < nrows; row += nwaves) {
        GAS float* xr = X + (size_t)row * 1024; const GAS bf16_t* yr = Y + (size_t)row * 1024; float t[16];
#pragma unroll
        for (int q = 0; q < 4; ++q) { const f32x4 xv = *(const GAS f32x4*)(xr + 256 * q + 4 * lane); const u32x2 yw = *(const GAS u32x2*)(yr + 256 * q + 4 * lane);
            t[4 * q] = fmaf(alpha, xv.x, bflo(yw.x)); t[4 * q + 1] = fmaf(alpha, xv.y, bfhi(yw.x)); t[4 * q + 2] = fmaf(alpha, xv.z, bflo(yw.y)); t[4 * q + 3] = fmaf(alpha, xv.w, bfhi(yw.y)); }
        float s = 0.f;
#pragma unroll
        for (int k = 0; k < 16; ++k) s += t[k];
        const float mu = wave_sum(s, lane) * (1.f / 1024.f); float vs = 0.f;
#pragma unroll
        for (int k = 0; k < 16; ++k) { t[k] -= mu; vs = fmaf(t[k], t[k], vs); }
        const float rs = 1.f / sqrtf(wave_sum(vs, lane) * (1.f / 1024.f) + 1e-5f);
#pragma unroll
        for (int q = 0; q < 4; ++q) { const int c = 256 * q + 4 * lane; const f32x4 g = *(const GAS f32x4*)(lg + c), b = *(const GAS f32x4*)(lb + c); f32x4 o;
            o.x = t[4 * q] * rs * g.x + b.x; o.y = t[4 * q + 1] * rs * g.y + b.y; o.z = t[4 * q + 2] * rs * g.z + b.z; o.w = t[4 * q + 3] * rs * g.w + b.w;
            *(GAS f32x4*)(xr + c) = o; u32x2 w; w.x = pk_bf16(o.x, o.y); w.y = pk_bf16(o.z, o.w); *(GAS u32x2*)(XB + (size_t)row * 1024 + c) = w;
            if (XF8) {
                const float s0 = __builtin_amdgcn_fmed3f(o.x * 16.f, -448.f, 448.f), s1 = __builtin_amdgcn_fmed3f(o.y * 16.f, -448.f, 448.f), s2 = __builtin_amdgcn_fmed3f(o.z * 16.f, -448.f, 448.f), s3 = __builtin_amdgcn_fmed3f(o.w * 16.f, -448.f, 448.f);
                int hp = __builtin_amdgcn_cvt_pk_fp8_f32(s0, s1, 0, false); hp = __builtin_amdgcn_cvt_pk_fp8_f32(s2, s3, hp, true);
                const f32x2 d01 = fp8lo((unsigned)hp), d23 = fp8hi((unsigned)hp);
                int lp = __builtin_amdgcn_cvt_pk_fp8_f32(s0 - d01.x, s1 - d01.y, 0, false); lp = __builtin_amdgcn_cvt_pk_fp8_f32(s2 - d23.x, s3 - d23.y, lp, true);
                *(GAS int*)(XF8 + (size_t)row * 2048 + c) = hp; *(GAS int*)(XF8 + (size_t)row * 2048 + 1024 + c) = lp; } }
    }
}

__device__ __forceinline__ void glanorm_phase(const GAS float* __restrict__ O, const GAS float* __restrict__ PROJ, const GAS float* __restrict__ gnorm, GAS bf16_t* XB, int nitems, int lane, int wave_gid, int nwaves) {
    const float g0 = gnorm[lane], g1 = gnorm[64 + lane];
    for (int it0 = wave_gid * 4; it0 < nitems; it0 += nwaves * 4) {
        float a0[4], a1[4], r0[4], r1[4];
#pragma unroll
        for (int q = 0; q < 4; ++q) { int it = it0 + q; it = it < nitems ? it : it0; const int row = it >> 2, h = it & 3; const GAS float* o = O + (size_t)row * 512 + h * 128; const GAS float* r = PROJ + (size_t)row * 2576 + 1040 + h * 128;
            a0[q] = o[lane]; a1[q] = o[64 + lane]; r0[q] = r[lane]; r1[q] = r[64 + lane]; }
#pragma unroll
        for (int q = 0; q < 4; ++q) { const int it = it0 + q; const int row = it >> 2, h = it & 3;
            const float rs = 1.f / sqrtf(wave_sum(a0[q] * a0[q] + a1[q] * a1[q], lane) * (1.f / 128.f) + 1e-5f);
            const float y0 = a0[q] * rs * g0 * (r0[q] / (1.f + __expf(-r0[q]))), y1 = a1[q] * rs * g1 * (r1[q] / (1.f + __expf(-r1[q])));
            if (it < nitems) { GAS bf16_t* d = XB + (size_t)row * 1024 + h * 128; d[lane] = (bf16_t)(pk_bf16(y0, 0.f) & 0xffffu); d[64 + lane] = (bf16_t)(pk_bf16(y1, 0.f) & 0xffffu); } }
    }
}

__device__ __forceinline__ float sigm(float x) { return 1.f / (1.f + __expf(-x)); }
__device__ __forceinline__ float softplusf(float x) { return fmaxf(x, 0.f) + log1pf(__expf(-fabsf(x))); }
__device__ __forceinline__ void rwkvprep_phase(const GAS float* __restrict__ w0, const GAS float* __restrict__ a0, const GAS float* __restrict__ v0, const GAS float* __restrict__ k_k, const GAS float* __restrict__ k_a, const GAS float* __restrict__ Vg,
                                               GAS float* K, GAS float* Wd, GAS float* Aa, GAS float* V, GAS float* NKK, GAS float* VFIRST, int has_vres, int nitems, int lane, int wave_gid, int nwaves) {
    for (int it0 = wave_gid * 4; it0 < nitems; it0 += nwaves * 4) {
        float kq[4], wq[4], aq[4], vq[4], gq[4], fq[4];
#pragma unroll
        for (int q = 0; q < 4; ++q) { const int it = it0 + q; const size_t ix = (size_t)(it >> 4) * 1024 + (it & 15) * 64 + lane; kq[q] = K[ix]; wq[q] = Wd[ix]; aq[q] = Aa[ix]; vq[q] = V[ix]; gq[q] = has_vres ? Vg[ix] : 0.f; fq[q] = has_vres ? VFIRST[ix] : 0.f; }
#pragma unroll
        for (int q = 0; q < 4; ++q) { const int it = it0 + q; const int h = it & 15; const size_t ix = (size_t)(it >> 4) * 1024 + h * 64 + lane; const int c = h * 64 + lane;
            const float k0 = kq[q]; const float kv = k0 * k_k[c]; const float inv = 1.f / fmaxf(sqrtf(wave_sum(kv * kv, lane)), 1e-12f);
            const float w = -softplusf(-(w0[c] + wq[q])) - 0.5f; const float dec = __expf(-__expf(w));
            const float a = sigm(a0[c] + aq[q]);
            float v = vq[q]; if (has_vres) v = v + (fq[q] - v) * sigm(v0[c] + gq[q]); else VFIRST[ix] = v;
            const float kk = kv * inv;
            NKK[ix] = -kk; K[ix] = k0 * (1.f + (a - 1.f) * k_a[c]); Wd[ix] = dec; Aa[ix] = kk * a; V[ix] = v; }
    }
}

__device__ __forceinline__ void rwkvpost_phase(const GAS float* __restrict__ Y, const GAS float* __restrict__ R, const GAS float* __restrict__ K2, const GAS float* __restrict__ V, const GAS float* __restrict__ G, const GAS float* __restrict__ r_k,
                                               const GAS float* __restrict__ lnx_g, const GAS float* __restrict__ lnx_b, GAS bf16_t* XB, int nitems, int lane, int wave_gid, int nwaves) {
    for (int it0 = wave_gid * 4; it0 < nitems; it0 += nwaves * 4) {
        float yq[4], rq[4], kq[4], vq[4], gq[4];
#pragma unroll
        for (int q = 0; q < 4; ++q) { const int it = it0 + q; const size_t ix = (size_t)(it >> 4) * 1024 + (it & 15) * 64 + lane; yq[q] = Y[ix]; rq[q] = R[ix]; kq[q] = K2[ix]; vq[q] = V[ix]; gq[q] = G[ix]; }
#pragma unroll
        for (int q = 0; q < 4; ++q) { const int it = it0 + q; const int h = it & 15; const size_t ix = (size_t)(it >> 4) * 1024 + h * 64 + lane; const int c = h * 64 + lane;
            const float y = yq[q]; const float mu = wave_sum(y, lane) * (1.f / 64.f); const float d = y - mu; const float rs = 1.f / sqrtf(wave_sum(d * d, lane) * (1.f / 64.f) + 64e-5f);
            const float bon = wave_sum(rq[q] * kq[q] * r_k[c], lane);
            const float o = (d * rs * lnx_g[c] + lnx_b[c] + bon * vq[q]) * gq[q];
            XB[ix] = (bf16_t)(pk_bf16(o, 0.f) & 0xffffu); }
    }
}

__device__ __forceinline__ void wkv_phase(const GAS float* __restrict__ R, const GAS float* __restrict__ Wd, const GAS float* __restrict__ K2, const GAS float* __restrict__ V, const GAS float* __restrict__ BB, const GAS float* __restrict__ NKK,
                                          const GAS float* __restrict__ SIN, GAS float* __restrict__ Y, GAS float* __restrict__ P, GAS float* __restrict__ SOUT, int B, int T, int DB, int DT, LAS unsigned char* lds, int tid, int bid, int nb) {
    constexpr int TB = 32, NLD = 6, VECB = TB * 1280, VVB = TB * 128, BUF = VECB + 2 * VVB;
    const int rowl = tid >> 4, part = tid & 15;
    const int nprompt = B * 32, nunits = nprompt + DB * 32;
    for (int u = bid; u < nunits; u += nb) {
        const bool smp = u >= nprompt; const int q0_ = smp ? u - nprompt : u; const int q = ((q0_ & 7) << 1 | ((q0_ >> 3) & 1)) + ((q0_ >> 4) << 4);
        const int half = q & 1, pair = q >> 1, sq = pair >> 4, h = pair & 15;
        const int Tu = smp ? DT : T; const int r0 = smp ? B * T + sq * DT : sq * T, vrow = half * 32 + rowl;
        f32x2 S01 = (f32x2){0.f, 0.f}, S23 = (f32x2){0.f, 0.f};
        if (smp) { const f32x4 s4 = *(const GAS f32x4*)(SIN + ((size_t)pair * 64 + vrow) * 64 + part * 4); S01 = (f32x2){s4.x, s4.y}; S23 = (f32x2){s4.z, s4.w};
                   asm volatile("" : "+v"(S01), "+v"(S23)); }
        const int nblk = (Tu + TB - 1) / TB;
        f32x4 ld[NLD];
        const size_t eo_ = (size_t)(r0 + (tid >> 4)) * 1024 + h * 64 + (tid & 15) * 4, ev_ = (size_t)(r0 + ((tid & 255) >> 3)) * 1024 + h * 64 + half * 32 + (tid & 7) * 4;
        const int lo_ = ((tid >> 4) * 320 + (tid & 15) * 4) * 4, lv_ = VECB + (tid & 255) * 16;
#define WKV_LOAD(tb0) do { const size_t bo_ = (size_t)(tb0) * 1024; ld[0] = *(const GAS f32x4*)(Wd + eo_ + bo_); ld[1] = *(const GAS f32x4*)(NKK + eo_ + bo_); ld[2] = *(const GAS f32x4*)(BB + eo_ + bo_); \
            ld[3] = *(const GAS f32x4*)(K2 + eo_ + bo_); ld[4] = *(const GAS f32x4*)(R + eo_ + bo_); ld[5] = *(const GAS f32x4*)(V + ev_ + bo_); } while (0)
#define WKV_STORE(bufp) do { _Pragma("unroll") for (int q_ = 0; q_ < 5; ++q_) *(LAS f32x4*)((bufp) + lo_ + q_ * 256) = ld[q_]; *(LAS f32x4*)((bufp) + lv_) = ld[5]; } while (0)
        WKV_LOAD(0); WKV_STORE(lds); __syncthreads();
        for (int b = 0; b < nblk; ++b) {
            LAS unsigned char* cur = lds + (b & 1) * BUF; LAS unsigned char* nxt = lds + ((b + 1) & 1) * BUF; const int tb0 = b * TB; const int nt = (Tu - tb0) < TB ? (Tu - tb0) : TB;
            if (b + 1 < nblk) WKV_LOAD(tb0 + TB);
            const LAS float* vec = (const LAS float*)cur + part * 4; const LAS float* vv = (const LAS float*)(cur + VECB) + rowl; LAS float* yb = (LAS float*)(cur + VECB + VVB);
            float ykeep0 = 0.f, ykeep1 = 0.f;
#define WKV_STEP(t, keep, tl) do { const LAS f32x2* vp_ = (const LAS f32x2*)(vec + (t) * 320); \
                const f32x2 w01 = vp_[0], w23 = vp_[1], n01 = vp_[32], n23 = vp_[33], b01 = vp_[64], b23 = vp_[65], k01 = vp_[96], k23 = vp_[97], r01 = vp_[128], r23 = vp_[129]; \
                const float v = vv[(t) * 32]; \
                const f32x2 sp = __builtin_elementwise_fma(S23, n23, S01 * n01); const float sa = row_sum16(sp.x + sp.y); const f32x2 sa2 = (f32x2){sa, sa}, v2 = (f32x2){v, v}; \
                S01 = __builtin_elementwise_fma(S01, w01, __builtin_elementwise_fma(b01, sa2, k01 * v2)); S23 = __builtin_elementwise_fma(S23, w23, __builtin_elementwise_fma(b23, sa2, k23 * v2)); \
                const f32x2 yp = __builtin_elementwise_fma(S23, r23, S01 * r01); const float y = row_sum16(yp.x + yp.y); \
                keep = (part == (tl)) ? y : keep; } while (0)
            if (nt == TB) {
#pragma unroll 1
                for (int t = 0; t < 16; t += 8) { WKV_STEP(t, ykeep0, t); WKV_STEP(t + 1, ykeep0, t + 1); WKV_STEP(t + 2, ykeep0, t + 2); WKV_STEP(t + 3, ykeep0, t + 3); WKV_STEP(t + 4, ykeep0, t + 4); WKV_STEP(t + 5, ykeep0, t + 5); WKV_STEP(t + 6, ykeep0, t + 6); WKV_STEP(t + 7, ykeep0, t + 7); }
#pragma unroll 1
                for (int t = 16; t < 32; t += 8) { WKV_STEP(t, ykeep1, t - 16); WKV_STEP(t + 1, ykeep1, t - 15); WKV_STEP(t + 2, ykeep1, t - 14); WKV_STEP(t + 3, ykeep1, t - 13); WKV_STEP(t + 4, ykeep1, t - 12); WKV_STEP(t + 5, ykeep1, t - 11); WKV_STEP(t + 6, ykeep1, t - 10); WKV_STEP(t + 7, ykeep1, t - 9); }
            } else { for (int t = 0; t < nt; ++t) { if (t < 16) WKV_STEP(t, ykeep0, t); else WKV_STEP(t, ykeep1, t - 16); } }
#undef WKV_STEP
            yb[part * 32 + rowl] = ykeep0; yb[(16 + part) * 32 + rowl] = ykeep1;
            if (b + 1 < nblk) WKV_STORE(nxt);
            __syncthreads();
            { const int rl = tid & 31; _Pragma("unroll") for (int t = tid >> 5; t < TB; t += 16) if (t < nt) Y[(size_t)(r0 + tb0 + t) * 1024 + h * 64 + half * 32 + rl] = yb[t * 32 + rl]; }
        }
#undef WKV_LOAD
#undef WKV_STORE
        *(GAS f32x4*)((smp ? SOUT : P) + ((size_t)pair * 64 + vrow) * 64 + part * 4) = (f32x4){S01.x, S01.y, S23.x, S23.y};
        __syncthreads();
    }
}

__device__ __forceinline__ void rwkvpost2_phase(const GAS float* __restrict__ Y, const GAS bf16_t* __restrict__ G, const GAS float* __restrict__ VF, const GAS float* __restrict__ BON, const GAS float* __restrict__ lnx_g, const GAS float* __restrict__ lnx_b,
                                                GAS bf16_t* XB, int nitems, int lane, int wave_gid, int nwaves) {
    for (int it0 = wave_gid * 4; it0 < nitems; it0 += nwaves * 4) {
        float yq[4], gq[4], vq[4], bq[4];
#pragma unroll
        for (int q = 0; q < 4; ++q) { const int it = it0 + q; const size_t ix = (size_t)(it >> 4) * 1024 + (it & 15) * 64 + lane; yq[q] = Y[ix]; gq[q] = __uint_as_float((unsigned)G[ix] << 16); vq[q] = VF[ix]; bq[q] = BON[it]; }
#pragma unroll
        for (int q = 0; q < 4; ++q) { const int it = it0 + q; const int h = it & 15; const size_t ix = (size_t)(it >> 4) * 1024 + h * 64 + lane; const int c = h * 64 + lane;
            const float y = yq[q]; const float mu = wave_sum(y, lane) * (1.f / 64.f); const float d = y - mu; const float rs = 1.f / sqrtf(wave_sum(d * d, lane) * (1.f / 64.f) + 64e-5f);
            const float o = (d * rs * lnx_g[c] + lnx_b[c] + bq[q] * vq[q]) * gq[q];
            XB[ix] = (bf16_t)(pk_bf16(o, 0.f) & 0xffffu); }
    }
}

__device__ __forceinline__ void wkv2_phase(const GAS bf16_t* __restrict__ R, const GAS bf16_t* __restrict__ KR, const GAS bf16_t* __restrict__ WL, const GAS bf16_t* __restrict__ AL, const GAS bf16_t* __restrict__ V, const GAS bf16_t* __restrict__ VG,
                                           const GAS float* VFI, const GAS float* __restrict__ PRM, const GAS float* __restrict__ SIN, GAS float* __restrict__ Y, GAS float* __restrict__ P, GAS float* __restrict__ SOUT, GAS float* VFO, GAS float* __restrict__ BON,
                                           int has_vres, int B, int T, int DB, int DT, LAS unsigned char* lds, int tid, int bid, int nb) {
    constexpr int TB = 32, NLD = 7, VECB = TB * 1280, VVB = TB * 128, BUF = VECB + 2 * VVB;
    const int rowl = tid >> 4, part = tid & 15;
    const int nprompt = B * 32, nunits = nprompt + DB * 32;
    for (int u = bid; u < nunits; u += nb) {
        const bool smp = u >= nprompt; const int q0_ = smp ? u - nprompt : u; const int q = ((q0_ & 7) << 1 | ((q0_ >> 3) & 1)) + ((q0_ >> 4) << 4);
        const int half = q & 1, pair = q >> 1, sq = pair >> 4, h = pair & 15;
        const int Tu = smp ? DT : T; const int r0 = smp ? B * T + sq * DT : sq * T, vrow = half * 32 + rowl;
        f32x2 S01 = (f32x2){0.f, 0.f}, S23 = (f32x2){0.f, 0.f};
        if (smp) { const f32x4 s4 = *(const GAS f32x4*)(SIN + ((size_t)pair * 64 + vrow) * 64 + part * 4); S01 = (f32x2){s4.x, s4.y}; S23 = (f32x2){s4.z, s4.w};
                   asm volatile("" : "+v"(S01), "+v"(S23)); }
        const int nblk = (Tu + TB - 1) / TB;
        u32x2 lk, lw, la, lr, lv, lg = (u32x2){0u, 0u}; f32x4 lf = (f32x4){0.f, 0.f, 0.f, 0.f};
        const size_t eo_ = (size_t)(r0 + (tid >> 4)) * 1024 + h * 64 + (tid & 15) * 4, ev_ = (size_t)(r0 + ((tid & 255) >> 3)) * 1024 + h * 64 + half * 32 + (tid & 7) * 4;
        const int lo_ = ((tid >> 4) * 320 + (tid & 15) * 4) * 4, lv_ = VECB + (tid & 255) * 16;
        const int pc_ = h * 64 + (tid & 15) * 4; const f32x4 w0v = *(const GAS f32x4*)(PRM + pc_), a0v = *(const GAS f32x4*)(PRM + 1024 + pc_), kkp = *(const GAS f32x4*)(PRM + 3072 + pc_), kap = *(const GAS f32x4*)(PRM + 4096 + pc_), rkp = *(const GAS f32x4*)(PRM + 5120 + pc_);
        const f32x4 v0v = *(const GAS f32x4*)(PRM + 2048 + h * 64 + half * 32 + (tid & 7) * 4);
#define WKV_LOAD(tb0) do { const size_t bo_ = (size_t)(tb0) * 1024; lk = *(const GAS u32x2*)(KR + eo_ + bo_); lw = *(const GAS u32x2*)(WL + eo_ + bo_); la = *(const GAS u32x2*)(AL + eo_ + bo_); \
            lr = *(const GAS u32x2*)(R + eo_ + bo_); lv = *(const GAS u32x2*)(V + ev_ + bo_); if (has_vres) { lg = *(const GAS u32x2*)(VG + ev_ + bo_); lf = *(const GAS f32x4*)(VFI + ev_ + bo_); } } while (0)
#define WKV_UNPK(w_) ((f32x4){bflo((w_).x), bfhi((w_).x), bflo((w_).y), bfhi((w_).y)})
#define WKV_STORE(bufp, tb0) do { const f32x4 k4 = WKV_UNPK(lk), wl4 = WKV_UNPK(lw), al4 = WKV_UNPK(la); const f32x4 kv = k4 * kkp; const float ss = row_sum16((kv.x * kv.x + kv.y * kv.y) + (kv.z * kv.z + kv.w * kv.w)); const float inv = 1.f / fmaxf(sqrtf(ss), 1e-12f); \
            f32x4 dec, a4; _Pragma("unroll") for (int i_ = 0; i_ < 4; ++i_) { dec[i_] = __expf(-0.6065306597126334f / (1.f + __expf(-(w0v[i_] + wl4[i_])))); a4[i_] = 1.f / (1.f + __expf(-(a0v[i_] + al4[i_]))); } \
            const f32x4 kk = kv * inv; const f32x4 k2 = k4 * ((a4 - 1.f) * kap + 1.f); const f32x4 r4 = WKV_UNPK(lr); const f32x4 rk = r4 * k2 * rkp; const float bon = row_sum16((rk.x + rk.y) + (rk.z + rk.w)); \
            *(LAS f32x4*)((bufp) + lo_) = dec; *(LAS f32x4*)((bufp) + lo_ + 256) = -kk; *(LAS f32x4*)((bufp) + lo_ + 512) = kk * a4; *(LAS f32x4*)((bufp) + lo_ + 768) = k2; *(LAS f32x4*)((bufp) + lo_ + 1024) = r4; \
            const int tr_ = (tb0) + (tid >> 4); if (half == 0 && (tid & 15) == 0 && tr_ < Tu) BON[(size_t)(r0 + tr_) * 16 + h] = bon; \
            f32x4 v4 = WKV_UNPK(lv); if (has_vres) { const f32x4 g4 = WKV_UNPK(lg); _Pragma("unroll") for (int i_ = 0; i_ < 4; ++i_) v4[i_] = v4[i_] + (lf[i_] - v4[i_]) / (1.f + __expf(-(v0v[i_] + g4[i_]))); } \
            *(LAS f32x4*)((bufp) + lv_) = v4; const int tv_ = (tb0) + ((tid & 255) >> 3); if (tid < 256 && tv_ < Tu) *(GAS f32x4*)(VFO + ev_ + (size_t)(tb0) * 1024) = v4; } while (0)
        WKV_LOAD(0); WKV_STORE(lds, 0); __syncthreads();
        for (int b = 0; b < nblk; ++b) {
            LAS unsigned char* cur = lds + (b & 1) * BUF; LAS unsigned char* nxt = lds + ((b + 1) & 1) * BUF; const int tb0 = b * TB; const int nt = (Tu - tb0) < TB ? (Tu - tb0) : TB;
            if (b + 1 < nblk) WKV_LOAD(tb0 + TB);
            const LAS float* vec = (const LAS float*)cur + part * 4; const LAS float* vv = (const LAS float*)(cur + VECB) + rowl; LAS float* yb = (LAS float*)(cur + VECB + VVB);
            float ykeep0 = 0.f, ykeep1 = 0.f;
            struct StepV { f32x2 w01, w23, n01, n23, b01, b23, k01, k23, r01, r23; float v; };
#define WKV_RD(dst, t) do { const LAS f32x2* vp_ = (const LAS f32x2*)(vec + (t) * 320); dst.w01 = vp_[0]; dst.w23 = vp_[1]; dst.n01 = vp_[32]; dst.n23 = vp_[33]; dst.b01 = vp_[64]; dst.b23 = vp_[65]; \
                dst.k01 = vp_[96]; dst.k23 = vp_[97]; dst.r01 = vp_[128]; dst.r23 = vp_[129]; dst.v = vv[(t) * 32]; } while (0)
#define WKV_CMP(src, keep, tl) do { const f32x2 sp = __builtin_elementwise_fma(S23, src.n23, S01 * src.n01); const float sa = row_sum16(sp.x + sp.y); const f32x2 sa2 = (f32x2){sa, sa}, v2 = (f32x2){src.v, src.v}; \
                S01 = __builtin_elementwise_fma(S01, src.w01, __builtin_elementwise_fma(src.b01, sa2, src.k01 * v2)); S23 = __builtin_elementwise_fma(S23, src.w23, __builtin_elementwise_fma(src.b23, sa2, src.k23 * v2)); \
                const f32x2 yp = __builtin_elementwise_fma(S23, src.r23, S01 * src.r01); const float y = row_sum16(yp.x + yp.y); keep = (part == (tl)) ? y : keep; } while (0)
            if (nt == TB) {
                StepV sA, sB; WKV_RD(sA, 0);
#pragma unroll 1
                for (int t = 0; t < 16; t += 2) { WKV_RD(sB, t + 1); __builtin_amdgcn_sched_barrier(0); WKV_CMP(sA, ykeep0, t); WKV_RD(sA, t + 2); __builtin_amdgcn_sched_barrier(0); WKV_CMP(sB, ykeep0, t + 1); }
#pragma unroll 1
                for (int t = 16; t < 32; t += 2) { WKV_RD(sB, t + 1); __builtin_amdgcn_sched_barrier(0); WKV_CMP(sA, ykeep1, t - 16); WKV_RD(sA, (t + 2) & 31); __builtin_amdgcn_sched_barrier(0); WKV_CMP(sB, ykeep1, t - 15); }
            } else { StepV sA; for (int t = 0; t < nt; ++t) { WKV_RD(sA, t); if (t < 16) WKV_CMP(sA, ykeep0, t); else WKV_CMP(sA, ykeep1, t - 16); } }
#undef WKV_RD
#undef WKV_CMP
            yb[part * 32 + rowl] = ykeep0; yb[(16 + part) * 32 + rowl] = ykeep1;
            if (b + 1 < nblk) WKV_STORE(nxt, tb0 + TB);
            __syncthreads();
            { const int rl = tid & 31; _Pragma("unroll") for (int t = tid >> 5; t < TB; t += 16) if (t < nt) Y[(size_t)(r0 + tb0 + t) * 1024 + h * 64 + half * 32 + rl] = yb[t * 32 + rl]; }
        }
#undef WKV_LOAD
#undef WKV_STORE
#undef WKV_UNPK
        *(GAS f32x4*)((smp ? SOUT : P) + ((size_t)pair * 64 + vrow) * 64 + part * 4) = (f32x4){S01.x, S01.y, S23.x, S23.y};
        __syncthreads();
    }
}

__device__ __forceinline__ void gla_phase(const GAS float* __restrict__ PROJ, const GAS float* __restrict__ LOGA, GAS float* __restrict__ O, GAS float* __restrict__ P, int B, int T, LAS unsigned char* lds, int tid, int bid, int nb) {
    constexpr int TB = 32, NLD = 4, VECB = TB * 768, VVB = TB * 64, BUF = VECB + 3 * VVB;
    const int col = tid >> 5, half = (tid >> 4) & 1, p = tid & 15, dk = half * 32 + p * 2;
    const int nunits = B * 32;
    for (int u = bid; u < nunits; u += nb) {
        const int ug_ = ((u & 7) << 3 | ((u >> 3) & 7)) + ((u >> 6) << 6);
        const int cb = ug_ & 7, pair = ug_ >> 3, s = pair >> 2, h = pair & 3; const int r0 = s * T;
        float S0 = 0.f, S1 = 0.f;
        const int nblk = (T + TB - 1) / TB;
        f32x4 ld[NLD];
        const size_t ea_ = (size_t)(r0 + (tid >> 4)) * 256 + h * 64 + (tid & 15) * 4, ep_ = (size_t)(r0 + (tid >> 4)) * 2576 + h * 64 + (tid & 15) * 4, ev_ = (size_t)(r0 + ((tid & 127) >> 2)) * 2576 + 512 + h * 128 + cb * 16 + (tid & 3) * 4;
        const int lo_ = ((tid >> 4) * 192 + (tid & 15) * 4) * 4, lv_ = VECB + (tid & 127) * 16;
#define GLA_LOAD(tb0) do { ld[0] = *(const GAS f32x4*)(LOGA + ea_ + (size_t)(tb0) * 256); ld[1] = *(const GAS f32x4*)(PROJ + ep_ + 256 + (size_t)(tb0) * 2576); ld[2] = *(const GAS f32x4*)(PROJ + ep_ + (size_t)(tb0) * 2576); ld[3] = *(const GAS f32x4*)(PROJ + ev_ + (size_t)(tb0) * 2576); } while (0)
#define GLA_STORE(bufp) do { *(LAS f32x4*)((bufp) + lo_) = ld[0]; *(LAS f32x4*)((bufp) + lo_ + 256) = ld[1]; *(LAS f32x4*)((bufp) + lo_ + 512) = ld[2] * 0.125f; *(LAS f32x4*)((bufp) + lv_) = ld[3]; } while (0)
        GLA_LOAD(0); GLA_STORE(lds); __syncthreads();
        for (int b = 0; b < nblk; ++b) {
            LAS unsigned char* cur = lds + (b & 1) * BUF; LAS unsigned char* nxt = lds + ((b + 1) & 1) * BUF; const int tb0 = b * TB; const int nt = (T - tb0) < TB ? (T - tb0) : TB;
            if (b + 1 < nblk) GLA_LOAD(tb0 + TB);
            const LAS float* vec = (const LAS float*)cur + dk; const LAS float* vv = (const LAS float*)(cur + VECB) + col; LAS float* ob = (LAS float*)(cur + VECB + VVB);
            float okeep0 = 0.f, okeep1 = 0.f;
#define GLA_STEP(t, keep, tl) do { const f32x2 a2 = *(const LAS f32x2*)(vec + (t) * 192), k2 = *(const LAS f32x2*)(vec + (t) * 192 + 64), q2 = *(const LAS f32x2*)(vec + (t) * 192 + 128); const float v = vv[(t) * 16]; \
                S0 = fmaf(a2.x, S0, k2.x * v); S1 = fmaf(a2.y, S1, k2.y * v); \
                float o = fmaf(q2.x, S0, q2.y * S1); o = row_sum16(o); keep = (p == (tl)) ? o : keep; } while (0)
            if (nt == TB) {
#pragma unroll 1
                for (int t = 0; t < 16; t += 4) { GLA_STEP(t, okeep0, t); GLA_STEP(t + 1, okeep0, t + 1); GLA_STEP(t + 2, okeep0, t + 2); GLA_STEP(t + 3, okeep0, t + 3); }
#pragma unroll 1
                for (int t = 16; t < 32; t += 4) { GLA_STEP(t, okeep1, t - 16); GLA_STEP(t + 1, okeep1, t - 15); GLA_STEP(t + 2, okeep1, t - 14); GLA_STEP(t + 3, okeep1, t - 13); }
            } else { for (int t = 0; t < nt; ++t) { if (t < 16) GLA_STEP(t, okeep0, t); else GLA_STEP(t, okeep1, t - 16); } }
#undef GLA_STEP
            ob[(p * 16 + col) * 2 + half] = okeep0; ob[((16 + p) * 16 + col) * 2 + half] = okeep1;
            if (b + 1 < nblk) GLA_STORE(nxt);
            __syncthreads();
            { const int t = tid >> 4, c = tid & 15; if (t < nt) { const f32x2 o2 = *(const LAS f32x2*)(ob + (t * 16 + c) * 2); O[(size_t)(r0 + tb0 + t) * 512 + h * 128 + cb * 16 + c] = o2.x + o2.y; } }
        }
#undef GLA_LOAD
#undef GLA_STORE
        { GAS float* so = P + ((size_t)pair * 64 + dk) * 128 + cb * 16 + col; so[0] = S0; so[128] = S1; }
        __syncthreads();
    }
}
__device__ __forceinline__ float grp8_sum(float v) { v += dppf<0xB1>(v); v += dppf<0x4E>(v); v += dppf<0x141>(v); return v; }
__device__ __forceinline__ float dot16_fp8_bf16(const u32x4 uw, const float (&x)[16]) { float s = 0.f;
#pragma unroll
    for (int d = 0; d < 4; ++d) { const f32x2 lo = fp8lo(uw[d]), hi = fp8hi(uw[d]); s = fmaf(lo.x, x[4 * d], s); s = fmaf(lo.y, x[4 * d + 1], s); s = fmaf(hi.x, x[4 * d + 2], s); s = fmaf(hi.y, x[4 * d + 3], s); }
    return s; }
typedef int i32x8 __attribute__((ext_vector_type(8)));
typedef unsigned u32x8 __attribute__((ext_vector_type(8)));
__device__ __forceinline__ void pacts_phase(const GAS unsigned char* XF8, const GAS unsigned char* U8S, const GAS int* EIDX, GAS float* __restrict__ PART, int M, int emask,
                                            LAS unsigned char* lds, int wid, int lane, int bid, int nb) {
    const bool spl = (nb & 7) == 0; const int s0 = spl ? (bid & 7) : 0, s1 = spl ? s0 + 1 : 8, r = spl ? (bid >> 3) : bid, nr = spl ? (nb >> 3) : nb;
    const int g = lane >> 3, c = lane & 7, fg = ((g >> 2) & 1) | (((g >> 1) & 1) << 2);
    const int m16 = lane & 15, kb = lane >> 4, fm = ((m16 >> 2) & 1) | (((m16 >> 1) & 1) << 2);
    LAS unsigned char* const wl = lds + wid * 16384;
    const LAS unsigned char* const ard = wl + m16 * 128 + (((2 * kb) ^ fm) * 16);
    const LAS unsigned char* const xrd = wl + 12288 + (m16 & 1) * 128 + kb * 32;
    const LAS unsigned char* const ird = wl + 13824 + g * 4;
    if (r >= M) return;
    const int ntok = (M - r + nr - 1) / nr;
#define PL_ROW(t_) ({ int rw_ = r + nr * (t_); rw_ < M ? rw_ : r; })
#define PL_IDS(t_, slot_) __builtin_amdgcn_global_load_lds((const GAS unsigned*)(isrc + (size_t)PL_ROW(t_) * 128), (LAS unsigned*)(wl + 13824 + (slot_) * 256), 4, 0, 0)
#define PL_RDIDS(slot_, e0_, e1_) do { e0_ = *(const LAS int*)(ird + (slot_) * 256); e1_ = *(const LAS int*)(ird + (slot_) * 256 + 32); } while (0)
#define PL_TILE(t_, slot_, e0_, e1_) do { \
        __builtin_amdgcn_global_load_lds((const GAS unsigned*)(tb + (size_t)((e0_) & emask) * 128), (LAS unsigned*)(wl + (slot_) * 2048), 16, 0, 0); \
        __builtin_amdgcn_global_load_lds((const GAS unsigned*)(tb + (size_t)((e1_) & emask) * 128), (LAS unsigned*)(wl + (slot_) * 2048 + 1024), 16, 0, 0); \
        __builtin_amdgcn_global_load_lds((const GAS unsigned*)(xsrc + (size_t)PL_ROW(t_) * 2048), (LAS unsigned*)(wl + 12288 + (slot_) * 256), 4, 0, 0); } while (0)
#define PL_RD(slot_, a0_, a1_, x0_, x1_) do { a0_ = *(const LAS u32x4*)(ard + (slot_) * 2048); a1_ = *(const LAS u32x4*)(ard2 + (slot_) * 2048); x0_ = *(const LAS u32x4*)(xrd + (slot_) * 256); x1_ = *(const LAS u32x4*)(xrd + (slot_) * 256 + 16); } while (0)
#define PL_MMA(cc_, a0_, a1_, x0_, x1_) do { const i32x8 av = (i32x8)__builtin_shufflevector(a0_, a1_, 0, 1, 2, 3, 4, 5, 6, 7), bv = (i32x8)__builtin_shufflevector(x0_, x1_, 0, 1, 2, 3, 4, 5, 6, 7); const f32x4 z = {0.f, 0.f, 0.f, 0.f}; \
        cc_ = __builtin_amdgcn_mfma_scale_f32_16x16x128_f8f6f4(av, bv, z, 0, 0, 0, 0, 0, 0); } while (0)
#define PL_OUT(t_, cc_) do { f32x4 o; _Pragma("unroll") for (int i = 0; i < 4; ++i) { float v = cc_[i]; v += dppf<0xB1>(v); o[i] = v * (1.f / 16.f); } \
        const int rw = r + nr * (t_); if (m16 == 0 && rw < M) *(GAS f32x4*)(po + (size_t)rw * 128) = o; } while (0)
#define PL_WAIT(n_) asm volatile("s_waitcnt vmcnt(" #n_ ")" ::: "memory")
#define PL_STEP(j_, h_) do { PL_WAIT(12); u32x4 a0[3], a1[3], x0[3], x1[3]; int e0[3], e1[3]; f32x4 cc[3]; \
        _Pragma("unroll") for (int k = 0; k < 3; ++k) PL_RD((h_) * 3 + k, a0[k], a1[k], x0[k], x1[k]); \
        _Pragma("unroll") for (int k = 0; k < 3; ++k) PL_RDIDS((h_) * 3 + k, e0[k], e1[k]); \
        _Pragma("unroll") for (int k = 0; k < 3; ++k) PL_MMA(cc[k], a0[k], a1[k], x0[k], x1[k]); \
        _Pragma("unroll") for (int k = 0; k < 3; ++k) PL_TILE((j_) + 6 + k, (h_) * 3 + k, e0[k], e1[k]); \
        _Pragma("unroll") for (int k = 0; k < 3; ++k) PL_IDS((j_) + 12 + k, (h_) * 3 + k); \
        _Pragma("unroll") for (int k = 0; k < 3; ++k) PL_OUT((j_) + k, cc[k]); } while (0)
    const LAS unsigned char* const ard2 = (const LAS unsigned char*)((unsigned)(size_t)ard ^ 16u);
    for (int s = s0; s < s1; ++s) {
        const GAS unsigned char* tb = U8S + (size_t)s * 16384 * 128 + ((c ^ fg) * 16);
        const GAS unsigned char* xsrc = XF8 + (size_t)(lane >> 5) * 1024 + s * 128 + (lane & 31) * 4;
        const GAS int* isrc = EIDX + wid * 16 + m16;
        GAS float* po = PART + (size_t)s * M * 128 + wid * 16 + kb * 4;
        PL_IDS(0, 0); PL_IDS(1, 1); PL_IDS(2, 2); PL_IDS(3, 3); PL_IDS(4, 4); PL_IDS(5, 5); PL_WAIT(0);
        { int e0[6], e1[6];
#pragma unroll
          for (int k = 0; k < 6; ++k) PL_RDIDS(k, e0[k], e1[k]);
#pragma unroll
          for (int k = 0; k < 3; ++k) PL_TILE(k, k, e0[k], e1[k]);
#pragma unroll
          for (int k = 0; k < 3; ++k) PL_IDS(6 + k, k);
#pragma unroll
          for (int k = 3; k < 6; ++k) PL_TILE(k, k, e0[k], e1[k]);
#pragma unroll
          for (int k = 3; k < 6; ++k) PL_IDS(6 + k, k); }
        for (int j = 0; j < ntok; j += 6) { PL_STEP(j, 0); PL_STEP(j + 3, 1); }
        PL_WAIT(0);
    }
#undef PL_ROW
#undef PL_IDS
#undef PL_RDIDS
#undef PL_TILE
#undef PL_RD
#undef PL_MMA
#undef PL_OUT
#undef PL_WAIT
#undef PL_STEP
}
__device__ __forceinline__ void pouts_phase(const GAS float* __restrict__ COEF, const GAS int* __restrict__ EIDX, const GAS unsigned char* V8S, GAS bf16_t* __restrict__ YBUF, int M,
                                            int wid, int lane, int bid, int nb) {
    const bool spl = (nb & 7) == 0; const int s0 = spl ? (bid & 7) : 0, s1 = spl ? s0 + 1 : 8, r = spl ? (bid >> 3) : bid, nr = spl ? (nb >> 3) : nb;
    const int g = lane >> 3, ch = lane & 7, rstep = nr * 8;
#define PO_LOADCE(rw, c0, c1, v0, v1) do { c0 = COEF[(size_t)(rw) * 128 + lane] * (1.f / 64.f); c1 = COEF[(size_t)(rw) * 128 + 64 + lane] * (1.f / 64.f); v0 = EIDX[(size_t)(rw) * 128 + lane]; v1 = EIDX[(size_t)(rw) * 128 + 64 + lane]; } while (0)
#define PO_GATHER(vv_, vreg) do { _Pragma("unroll") for (int k = 0; k < 8; ++k) { const int e = __builtin_amdgcn_ds_bpermute((8 * k + g) << 2, vreg); vv_[k] = *(const GAS u32x4*)(tb + (size_t)(e & 16383) * 128); } } while (0)
#define PO_COMP(vv_, creg) do { _Pragma("unroll") for (int k = 0; k < 8; ++k) { const float c = __int_as_float(__builtin_amdgcn_ds_bpermute((8 * k + g) << 2, __float_as_int(creg))); const u32x4 w = vv_[k]; \
        const f32x2 c2 = (f32x2){c, c}; _Pragma("unroll") for (int d = 0; d < 4; ++d) { ac2[2 * d] = __builtin_elementwise_fma(c2, fp8lo(w[d]), ac2[2 * d]); ac2[2 * d + 1] = __builtin_elementwise_fma(c2, fp8hi(w[d]), ac2[2 * d + 1]); } \
        _Pragma("unroll") for (int i = 0; i < 8; ++i) asm volatile("" : "+v"(ac2[i])); } } while (0)
    for (int s = s0; s < s1; ++s) {
        const GAS unsigned char* tb = V8S + (size_t)s * 16384 * 128 + ch * 16;
        int row = r + nr * wid; if (row >= M) continue;
        float c0c, c1c, c0n = 0.f, c1n = 0.f; int v0c, v1c, v0n = 0, v1n = 0;
        PO_LOADCE(row, c0c, c1c, v0c, v1c);
        u32x4 va[8], vb[8];
        PO_GATHER(va, v0c);
        for (;;) {
            const int rown = row + rstep; const bool hasn = rown < M;
            PO_GATHER(vb, v1c);
            if (hasn) PO_LOADCE(rown, c0n, c1n, v0n, v1n);
            f32x2 ac2[8];
#pragma unroll
            for (int i = 0; i < 8; ++i) ac2[i] = (f32x2){0.f, 0.f};
            PO_COMP(va, c0c);
            if (hasn) PO_GATHER(va, v0n);
            PO_COMP(vb, c1c);
            float acc[16];
#pragma unroll
            for (int i = 0; i < 8; ++i) { acc[2 * i] = ac2[i].x; acc[2 * i + 1] = ac2[i].y; }
#pragma unroll
            for (int i = 0; i < 16; ++i) acc[i] += dppf<0x128>(acc[i]);
#pragma unroll
            for (int i = 0; i < 8; ++i) { const bool hi = lane & 16; const float send = hi ? acc[i] : acc[i + 8], keep = hi ? acc[i + 8] : acc[i]; acc[i] = keep + shx(send, 16, lane); }
#pragma unroll
            for (int i = 0; i < 4; ++i) { const bool hi = lane & 32; const float send = hi ? acc[i] : acc[i + 4], keep = hi ? acc[i + 4] : acc[i]; acc[i] = keep + shx(send, 32, lane); }
            if ((lane & 8) == 0) { u32x2 w_; w_.x = pk_bf16(acc[0], acc[1]); w_.y = pk_bf16(acc[2], acc[3]); *(GAS u32x2*)(YBUF + (size_t)row * 1024 + s * 128 + ch * 16 + ((lane >> 4) & 1) * 8 + ((lane >> 5) & 1) * 4) = w_; }
            if (!hasn) break;
            row = rown; c0c = c0n; c1c = c1n; v0c = v0n; v1c = v1n;
        }
    }
#undef PO_LOADCE
#undef PO_GATHER
#undef PO_COMP
}
}

template <class T> __device__ __forceinline__ __attribute__((address_space(1))) T* gp(T* p) { return (__attribute__((address_space(1))) T*)uni_ptr(p); }
constexpr int MK_THREADS = 512, LDS_BYTES = 163840, LDSCTL_OFF = 131072, TAB_OFF = LDSCTL_OFF + 1024, MAX_OPS = 208;
static_assert(TAB_OFF + MAX_OPS * (int)sizeof(Op) <= LDS_BYTES, "LDS map");
constexpr int MPAD = 17152;
constexpr size_t CTL_BYTES = (size_t)1 << 20;
struct MArgs { const float* in[47]; float* out; char* ws; unsigned long long ws_size; };
__global__ void __launch_bounds__(MK_THREADS, 2) mega_fwd(MArgs a) {
    extern __shared__ __attribute__((aligned(16))) unsigned char lds[];
    volatile LAS unsigned* ctl = (volatile LAS unsigned*)((LAS unsigned char*)lds + LDSCTL_OFF);
    if (threadIdx.x < 64) ctl[threadIdx.x] = 0u;
    __syncthreads();
    (void)xcd_barrier_post((unsigned*)a.ws, ctl + 8);
    const Dm dm = make_dm(1024, 8, 2048, 128, 4);
    Op* tab = (Op*)(lds + TAB_OFF);
    if (threadIdx.x == 0) {
        const float* const* inp_ = (const float* const*)__builtin_amdgcn_kernarg_segment_ptr(); asm volatile("" : "+s"(inp_));
        NvIO io; io.in = inp_; io.out = a.out; io.ws = a.ws + CTL_BYTES; io.ws_size = a.ws_size - CTL_BYTES;
        int n = 0;
        nv_forward(io, dm, [&](const Op& o) __attribute__((always_inline)) { if (n < MAX_OPS) tab[n] = o; ++n; asm volatile("" ::: "memory"); });
        ctl[16] = (unsigned)(n <= MAX_OPS ? n : 0);
    }
    __syncthreads();
    const int nops = (int)ctl[16];
    for (int i = 0; i < nops; ++i) {
        int tid_ = (int)threadIdx.x, bid_ = (int)blockIdx.x, nb_ = (int)gridDim.x;
        asm volatile("" : "+v"(tid_)); asm volatile("" : "+s"(bid_)); asm volatile("" : "+s"(nb_));
        const long long g0 = (long long)bid_ * MK_THREADS + tid_, gs = (long long)nb_ * MK_THREADS;
        const Op& o = tab[i];
        const int rawc = __builtin_amdgcn_readfirstlane(o.code); const int code = rawc & 0xff; const long long n = o.n;
        switch (code) {
        case OP_FGEMM: {
            const int fl = rfl(o.i6);
            pg8::Gemm g{uni_ptr((const pg8::bf16_t*)o.a), uni_ptr((const pg8::bf16_t*)o.b), MPAD, rfl(o.i5), rfl(o.i1), rfl(o.i2), rfl(o.i3)};
            if (rawc & OPF_GROUP) {
                int ng = 1; while (ng < 8 && (rfl(tab[i + ng - 1].code) & OPF_GROUP)) ++ng;
                const PG8_LAS Op* gt = (const PG8_LAS Op*)((PG8_LAS unsigned char*)lds + TAB_OFF) + i;
                pg8::GroupOrder S; S.tab = gt; S.ng = ng; S.nM = MPAD / 256; S.G = nb_; S.c = bid_; S.tsA = (size_t)256 * g.lda * 2; S.tsB = (size_t)256 * g.ldb * 2;
                pg8::EpiGroup E{gt, dm.M};
                pg8::gemm_phase<pg8::EpiGroup, pg8::GroupOrder, true, true>((PG8_LAS unsigned char*)lds, g, S, E);
                i += ng - 1;
            } else {
            pg8::StaticOrder S; S.init(g, nb_, bid_); if (fl & 2) S.acs = 512;
            float* const c0 = uni_ptr(o.o0); const int ldc0 = rfl(o.i4), nreal0 = rfl(o.i0);
            if (fl & 1) { pg8::EpiBf16Plain E{(pg8::bf16_t*)c0, ldc0}; pg8::gemm_phase<pg8::EpiBf16Plain, pg8::StaticOrder, true, true>((PG8_LAS unsigned char*)lds, g, S, E); }
            else { pg8::EpiF32 E{c0, ldc0, dm.M, nreal0}; pg8::gemm_phase<pg8::EpiF32, pg8::StaticOrder, true, true>((PG8_LAS unsigned char*)lds, g, S, E); }
            }
        } break;
        case OP_LRUG2: {
            pg8::Gemm g{uni_ptr((const pg8::bf16_t*)o.a), uni_ptr((const pg8::bf16_t*)o.b), MPAD, 1024, 512, 512, 512};
            pg8::StaticOrder S; S.init(g, nb_, bid_);
            pg8::EpiLru E{uni_ptr(o.c), uni_ptr(o.d), uni_ptr(o.e), uni_ptr(o.f), uni_ptr(o.o0), uni_ptr(o.o1), dm.M};
            pg8::gemm_phase<pg8::EpiLru, pg8::StaticOrder, true, true>((PG8_LAS unsigned char*)lds, g, S, E);
        } break;
        case OP_WKVP: fk::wkv2_phase(gp((const fk::bf16_t*)o.a), gp((const fk::bf16_t*)o.b), gp((const fk::bf16_t*)o.c), gp((const fk::bf16_t*)o.d), gp((const fk::bf16_t*)o.e), gp((const fk::bf16_t*)o.f), gp(o.g), gp(o.h), gp((const float*)o.o5), gp(o.o0), gp(o.o1), gp(o.o2), gp(o.o3), gp(o.o4), rfl(o.i0), dm.B, dm.T, dm.DB, dm.DT, (LAS unsigned char*)lds, tid_, bid_, nb_); break;
        case OP_POST2: fk::rwkvpost2_phase(gp(o.a), gp((const fk::bf16_t*)o.b), gp(o.c), gp(o.d), gp(o.e), gp(o.f), gp((fk::bf16_t*)o.o0), dm.M * 16, tid_ & 63, bid_ * 8 + (tid_ >> 6), nb_ * 8); break;
        case OP_GLAF: fk::gla_phase(gp(o.a), gp(o.b), gp(o.o0), gp(o.o1), dm.B, dm.T, (LAS unsigned char*)lds, tid_, bid_, nb_); break;
        case OP_PACTS: fk::pacts_phase(gp((const unsigned char*)o.a), gp((const unsigned char*)o.b), gp((const int*)o.d), gp(o.o0), dm.M, rfl(o.i0), (LAS unsigned char*)lds, rfl(tid_ >> 6), tid_ & 63, bid_, nb_); break;
        case OP_POUTS: fk::pouts_phase(gp(o.a), gp((const int*)o.b), gp((const unsigned char*)o.c), gp((fk::bf16_t*)o.o0), dm.M, tid_ >> 6, tid_ & 63, bid_, nb_); break;
        case OP_TOPK2: fk::topk_phase(gp(o.a), gp((const fk::bf16_t*)o.b), gp(o.c), gp(o.o0), gp((int*)o.o1), dm.M * 8, (LAS unsigned char*)lds, tid_ >> 6, tid_ & 63, bid_ * 8 + (tid_ >> 6), nb_ * 8); break;
        case OP_LNRES: fk::lnres_phase(gp((const fk::bf16_t*)o.a), gp(o.b), gp(o.c), gp(o.o0), gp((fk::bf16_t*)o.o1), gp((unsigned char*)o.o2), dm.M, tid_ & 63, bid_ * 8 + (tid_ >> 6), nb_ * 8); break;
        case OP_GLANORM: fk::glanorm_phase(gp(o.a), gp(o.b), gp(o.c), gp((fk::bf16_t*)o.o0), dm.M * 4, tid_ & 63, bid_ * 8 + (tid_ >> 6), nb_ * 8); break;
#define NVC(c) case c: for (long long g = g0; g < n; g += gs) nv_elem(c, o, dm, g); break;
        NVC(OP_LOGA4) NVC(OP_CONVOUT) NVC(OP_SHIFTOUT) NVC(OP_EMBED4) NVC(OP_YOUT4) NVC(OP_MIX6) NVC(OP_CONV4) NVC(OP_CVT8) NVC(OP_WGATE)
        NVC(OP_WT) NVC(OP_CVTTAB8S) NVC(OP_PRED) NVC(OP_PRM) NVC(OP_KEYS) NVC(OP_GLA3) NVC(OP_LRU1) NVC(OP_LRU2) NVC(OP_LRU3)
#undef NVC
        default: break;
        }
        if (__builtin_amdgcn_readfirstlane(tab[i].code) & OPF_NOBAR) __syncthreads(); else { XcdBarrier bar; bar.bar = (unsigned*)a.ws; bar.x = xb_xcc_id(); bar.st = ctl + 8; xcd_barrier(bar); }
    }
}
extern "C" void kernel_launch(void* const* d_in, const int* in_sizes, int n_in, void* d_out, int out_size, void* d_ws, size_t ws_size, hipStream_t stream) {
    static int grid = 0;
    if (grid == 0) {
        if (n_in != 47 || ws_size < ((size_t)900 << 20)) { fprintf(stderr, "kernel_launch: expected 47 inputs and >= 900 MiB of workspace; got %d, %zu\n", n_in, ws_size); grid = -1; return; }
        int dev = 0, cus = 0, per_cu = 0;
        if (hipGetDevice(&dev) != hipSuccess || hipDeviceGetAttribute(&cus, hipDeviceAttributeMultiprocessorCount, dev) != hipSuccess) { grid = -1; return; }
        if (hipFuncSetAttribute((const void*)mega_fwd, hipFuncAttributeMaxDynamicSharedMemorySize, LDS_BYTES) != hipSuccess) { fprintf(stderr, "kernel_launch: hipFuncSetAttribute failed\n"); grid = -1; return; }
        if (hipOccupancyMaxActiveBlocksPerMultiprocessor(&per_cu, (const void*)mega_fwd, MK_THREADS, LDS_BYTES) != hipSuccess || per_cu < 1) fprintf(stderr, "kernel_launch: occupancy query says %d per CU\n", per_cu);
        (void)hipGetLastError();
        grid = cus;
    }
    if (grid < 0) return;
    if (hipMemsetAsync(d_ws, 0, CTL_BYTES, stream) != hipSuccess) { fprintf(stderr, "kernel_launch: memset failed\n"); return; }
    MArgs a{}; for (int i = 0; i < 47; ++i) a.in[i] = (const float*)d_in[i]; a.out = (float*)d_out; a.ws = (char*)d_ws; a.ws_size = (unsigned long long)ws_size;
    hipLaunchKernelGGL(mega_fwd, dim3(grid), dim3(MK_THREADS), LDS_BYTES, stream, a);
}
```

```cpp
#include <hip/hip_runtime.h>
#include <cstdio>
#include <cmath>
#ifndef HD
#define HD __host__ __device__ __forceinline__
#endif
struct Dm { int D, B, T, DB, DT, M, NSEQ, RH; };
HD Dm make_dm(int D, int B, int SEQ, int DB, int DT) { Dm d; d.D = D; d.B = B; d.T = SEQ + 16; d.DB = DB; d.DT = DT; d.M = B * d.T + DB * DT; d.NSEQ = B + DB; d.RH = D / 64; return d; }
HD int seq_row0(const Dm& d, int s) { return s < d.B ? s * d.T : d.B * d.T + (s - d.B) * d.DT; }
HD int seq_len(const Dm& d, int s) { return s < d.B ? d.T : d.DT; }
HD void row_to_seq(const Dm& d, int row, int& s, int& t) { if (row < d.B * d.T) { s = row / d.T; t = row % d.T; } else { int r = row - d.B * d.T; s = d.B + r / d.DT; t = r % d.DT; } }

constexpr int MIXIN = 2576, C_Q = 0, C_K = 256, C_V = 512, C_GLR = 1024, C_R = 1040, C_XB = 1552, C_GB = 2064;

enum { OP_EMBED = 1, OP_GEMM, OP_LOGA, OP_GLA, OP_GLANORM, OP_CONV, OP_CONVOUT, OP_LRUG, OP_LRUSCAN, OP_LNRES, OP_MIX, OP_SHIFTOUT,
       OP_RWKVPREP, OP_WKV, OP_RWKVPOST, OP_QNORM, OP_SCORES, OP_TOPK, OP_PACT1, OP_PACT2, OP_POUT, OP_YOUT, OP_WT, OP_CVT, OP_FGEMM, OP_CVTTAB, OP_KEYS, OP_TOPK2, OP_PACT, OP_POUTLN, OP_GLA1, OP_GLA2, OP_GLA3, OP_LRU1, OP_LRU2, OP_LRU3, OP_EMBED4, OP_YOUT4, OP_MIX8, OP_CONV4, OP_CVT8, OP_WGATE, OP_LRUG2, OP_WKVF, OP_GLAF, OP_CVTTAB8, OP_CVTTAB8S, OP_PACTS, OP_PRED, OP_POUTS, OP_MIX6, OP_PRM, OP_WKVP, OP_POST2, OP_LOGA4 };

constexpr int OPF_NOBAR = 0x100, OPF_GROUP = 0x200;
struct Op {
    const float *a, *b, *c, *d, *e, *f, *g, *h;
    float *o0, *o1, *o2, *o3, *o4, *o5;
    long long n;
    int code, i0, i1, i2, i3, i4, i5, i6;
};

#if defined(__HIP_DEVICE_COMPILE__)
#define NV_UNI(x) __builtin_amdgcn_readfirstlane(x)
#define NV_LAUNDER(p) asm volatile("" : "+s"(p))
#define NV_FENCE() asm volatile("" ::: "memory")
#else
#define NV_FENCE() do {} while (0)
#define NV_UNI(x) (x)
#define NV_LAUNDER(p) do {} while (0)
#endif
typedef unsigned short nvbf;
HD nvbf nv_f2bf(float f) { unsigned u; __builtin_memcpy(&u, &f, 4); return (nvbf)((u + 0x7fffu + ((u >> 16) & 1u)) >> 16); }
HD float nv_bf2f(nvbf h) { unsigned u = (unsigned)h << 16; float f; __builtin_memcpy(&f, &u, 4); return f; }
HD unsigned nv_f2e4m3(float f) {
    unsigned u; __builtin_memcpy(&u, &f, 4); const unsigned sign = (u >> 24) & 0x80u; const float a = fabsf(f);
    if (!(a < 448.f)) return sign | 0x7Eu;
    if (a < 0.015625f) return sign | (unsigned)rintf(a * 512.f);
    unsigned au = u & 0x7fffffffu; au += 0x7ffffu + ((au >> 20) & 1u);
    const unsigned e = ((au >> 23) & 0xffu) - 120u, m = (au >> 20) & 7u; unsigned code = (e << 3) | m; if (code > 0x7Eu) code = 0x7Eu;
    return sign | code; }
HD float nv_e4m32f(unsigned c) { const unsigned e = (c >> 3) & 15u, m = c & 7u; const float v = e ? ldexpf(1.f + m * 0.125f, (int)e - 7) : m * 0.001953125f; return (c & 0x80u) ? -v : v; }
HD int nv_rup(int x, int m) { return (x + m - 1) / m * m; }
struct alignas(16) NvF4 { float x, y, z, w; };
struct alignas(16) NvU4 { unsigned x, y, z, w; };
struct alignas(8) NvU2 { unsigned x, y; };
HD float nv_sigmoid(float x) { return 1.f / (1.f + expf(-x)); }
HD float nv_softplus(float x) { return fmaxf(x, 0.f) + log1pf(expf(-fabsf(x))); }
HD float nv_gelu(float x) { return 0.5f * x * (1.f + tanhf(0.7978845608028654f * (x + 0.044715f * x * x * x))); }

#define NV_INS16(tv, ti, val, idx) do { float _v = (val); int _i = (idx); _Pragma("unroll") for (int _j = 0; _j < 16; ++_j) { if (_v > tv[_j]) { float _tv = tv[_j]; int _ti = ti[_j]; tv[_j] = _v; ti[_j] = _i; _v = _tv; _i = _ti; } } } while (0)

HD void nv_elem(const int code, const Op& p, const Dm& dm, long long gid) {
    const int D = dm.D; float* const PO1 = p.o1; float* const PO2 = p.o2;
    switch (code) {
    case OP_EMBED: {
        int row = (int)(gid / D), c = (int)(gid % D); float v;
        if (row < dm.B * dm.T) { int bb = row / dm.T, t = row % dm.T; v = t < 16 ? p.c[t * D + c] : p.a[((size_t)bb * (dm.T - 16) + (t - 16)) * D + c]; }
        else v = p.b[(size_t)(row - dm.B * dm.T) * D + c];
        p.o0[gid] = v; ((nvbf*)p.o1)[gid] = nv_f2bf(v); } break;
    case OP_GEMM: {
        int N4 = p.i0 >> 2, K = p.i1; int m = (int)(gid / N4), nn = (int)(gid % N4) * 4; const float* A = p.a + (size_t)m * p.i2; const float* Bw = p.b + nn; float c0 = 0.f, c1 = 0.f, c2 = 0.f, c3 = 0.f;
        for (int k = 0; k < K; ++k) { float av = A[k]; if (p.i5 == 1) av = tanhf(av); else if (p.i5 == 2) av = nv_sigmoid(av); const NvF4 bv = *(const NvF4*)(Bw + (size_t)k * p.i3);
            c0 = fmaf(av, bv.x, c0); c1 = fmaf(av, bv.y, c1); c2 = fmaf(av, bv.z, c2); c3 = fmaf(av, bv.w, c3); }
        float* C = p.o0 + (size_t)m * p.i4 + nn; C[0] = c0; C[1] = c1; C[2] = c2; C[3] = c3; } break;
    case OP_LOGA: {
        int row = (int)(gid / 256), c = (int)(gid % 256); float z = p.c[c];
        for (int r = 0; r < 16; ++r) z = fmaf(p.a[(size_t)row * MIXIN + C_GLR + r], p.b[r * 256 + c], z);
        p.o0[gid] = expf(-nv_softplus(-z) * (1.f / 16.f)); } break;
    case OP_GLAF:
    case OP_GLA: {
        int s = (int)(gid / 512), h = (int)((gid / 128) % 4), col = (int)(gid % 128);
        float S[64];
        const float* sin = (s < dm.B) ? nullptr : p.c + (((size_t)(s - dm.B) * 4 + h) * 64) * 128 + col;
#pragma unroll
        for (int k = 0; k < 64; ++k) S[k] = sin ? sin[(size_t)k * 128] : 0.f;
        int r0 = seq_row0(dm, s), L = seq_len(dm, s);
        for (int t = 0; t < L; ++t) {
            const float* pr = p.a + (size_t)(r0 + t) * MIXIN; const float* la = p.b + (size_t)(r0 + t) * 256 + h * 64;
            float v = pr[C_V + h * 128 + col], o = 0.f;
#pragma unroll
            for (int k = 0; k < 64; ++k) { if ((k & 7) == 0) NV_FENCE(); S[k] = fmaf(la[k], S[k], pr[C_K + h * 64 + k] * v); o = fmaf(pr[C_Q + h * 64 + k] * 0.125f, S[k], o); }
            p.o0[(size_t)(r0 + t) * 512 + h * 128 + col] = o;
        }
        float* so = (s < dm.B) ? PO1 + (((size_t)s * 4 + h) * 64) * 128 + col : PO2 + (((size_t)(s - dm.B) * 4 + h) * 64) * 128 + col;
#pragma unroll
        for (int k = 0; k < 64; ++k) so[(size_t)k * 128] = S[k]; } break;
    case OP_GLA1: {
        const int NC = p.i0; const int u = NV_UNI((int)(gid / 128)), col = (int)(gid % 128); const int s = u / (4 * NC), h = (u / NC) % 4, c = u % NC;
        const int r0 = seq_row0(dm, s) + c * 64; int L = dm.T - c * 64; L = L > 64 ? 64 : L;
        float S[64];
#pragma unroll
        for (int k = 0; k < 64; ++k) S[k] = 0.f;
        float dprod = 1.f;
        for (int t = 0; t < L; ++t) {
            const float* pr = p.a + (size_t)(r0 + t) * MIXIN; const float* la = p.b + (size_t)(r0 + t) * 256 + h * 64; const float v = pr[C_V + h * 128 + col];
            if (col < 64) dprod *= la[col];
#pragma unroll
            for (int k = 0; k < 64; ++k) { if ((k & 7) == 0) NV_FENCE(); S[k] = fmaf(la[k], S[k], pr[C_K + h * 64 + k] * v); }
        }
        float* so = p.o0 + (size_t)u * 8192 + col;
#pragma unroll
        for (int k = 0; k < 64; ++k) so[(size_t)k * 128] = S[k];
        if (col < 64) p.o1[(size_t)u * 64 + col] = dprod; } break;
    case OP_GLA2: {
        const int NC = p.i0; const int pair = (int)(gid / 8192), e = (int)(gid % 8192), dk = e / 128; float S = 0.f;
        for (int c = 0; c < NC; ++c) { const size_t ix = ((size_t)pair * NC + c) * 8192 + e; const float l = p.o0[ix]; p.o0[ix] = S; S = fmaf(p.a[((size_t)pair * NC + c) * 64 + dk], S, l); }
        p.o1[gid] = S; } break;
    case OP_GLA3: {
        const int NC = p.i0; const int NP = dm.B * 4 * NC; const int u = NV_UNI((int)(gid / 128)) + (p.i1 ? NP : 0), col = (int)(gid % 128); int s, h, r0, L; const float* sin; float* sout = nullptr;
        if (u < NP) { s = u / (4 * NC); h = (u / NC) % 4; const int c = u % NC; r0 = seq_row0(dm, s) + c * 64; L = dm.T - c * 64; L = L > 64 ? 64 : L; sin = p.d + (size_t)u * 8192 + col; }
        else { const int q = u - NP; s = dm.B + q / 4; h = q % 4; r0 = seq_row0(dm, s); L = dm.DT; sin = p.c + (((size_t)(s - dm.B) * 4 + h) * 64) * 128 + col; sout = p.o2 + (((size_t)(s - dm.B) * 4 + h) * 64) * 128 + col; }
        float S[64];
#pragma unroll
        for (int k = 0; k < 64; ++k) S[k] = sin[(size_t)k * 128];
        for (int t = 0; t < L; ++t) {
            const float* pr = p.a + (size_t)(r0 + t) * MIXIN; const float* la = p.b + (size_t)(r0 + t) * 256 + h * 64; const float v = pr[C_V + h * 128 + col]; float o = 0.f;
#pragma unroll
            for (int k = 0; k < 64; ++k) { if ((k & 7) == 0) NV_FENCE(); S[k] = fmaf(la[k], S[k], pr[C_K + h * 64 + k] * v); o = fmaf(pr[C_Q + h * 64 + k] * 0.125f, S[k], o); }
            p.o0[(size_t)(r0 + t) * 512 + h * 128 + col] = o;
        }
        if (sout) {
#pragma unroll
            for (int k = 0; k < 64; ++k) sout[(size_t)k * 128] = S[k]; } } break;
    case OP_LRU1: {
        const int NC = p.i0; const int u = (int)(gid / 512), c = (int)(gid % 512); const int s = u / NC, ch = u % NC; const int r0 = seq_row0(dm, s) + ch * 64; int L = dm.T - ch * 64; L = L > 64 ? 64 : L; float hh = 0.f, ap = 1.f;
#pragma unroll 8
        for (int t = 0; t < L; ++t) { const size_t ix = (size_t)(r0 + t) * 512 + c; const float a = p.a[ix]; hh = fmaf(a, hh, p.b[ix]); ap *= a; }
        p.o0[gid] = ap; p.o1[gid] = hh; } break;
    case OP_LRU2: {
        const int NC = p.i0; const int s = (int)(gid / 512), c = (int)(gid % 512); float hh = 0.f;
#pragma unroll 8
        for (int ch = 0; ch < NC; ++ch) { const size_t ix = ((size_t)s * NC + ch) * 512 + c; const float l = p.o0[ix]; p.o0[ix] = hh; hh = fmaf(p.a[ix], hh, l); }
        p.o1[gid] = hh; } break;
    case OP_LRU3: {
        const int NC = p.i0; const int u = (int)(gid / 512), c = (int)(gid % 512); const int NP = dm.B * NC; int r0, L; float hh; float* hout = nullptr;
        if (u < NP) { const int s = u / NC, ch = u % NC; r0 = seq_row0(dm, s) + ch * 64; L = dm.T - ch * 64; L = L > 64 ? 64 : L; hh = p.e[gid]; }
        else { const int q = u - NP; r0 = seq_row0(dm, dm.B + q); L = dm.DT; hh = p.d[(size_t)q * 512 + c]; hout = p.o2 + (size_t)q * 512 + c; }
#pragma unroll 8
        for (int t = 0; t < L; ++t) { const size_t r = (size_t)(r0 + t); hh = fmaf(p.a[r * 512 + c], hh, p.b[r * 512 + c]); ((nvbf*)p.o0)[r * 1024 + 512 + c] = nv_f2bf(hh * nv_gelu(p.c[r * MIXIN + C_GB + c])); }
        if (hout) *hout = hh; } break;
    case OP_EMBED4: {
        const int D4 = D / 4; const int row = (int)(gid / D4), c = (int)(gid % D4) * 4; const float* src;
        if (row < dm.B * dm.T) { const int bb = row / dm.T, t = row % dm.T; src = t < 16 ? p.c + (size_t)t * D + c : p.a + ((size_t)bb * (dm.T - 16) + (t - 16)) * D + c; } else src = p.b + (size_t)(row - dm.B * dm.T) * D + c;
        const NvF4 v = *(const NvF4*)src; *(NvF4*)(p.o0 + (size_t)row * D + c) = v; NvU2 w; w.x = nv_f2bf(v.x) | ((unsigned)nv_f2bf(v.y) << 16); w.y = nv_f2bf(v.z) | ((unsigned)nv_f2bf(v.w) << 16); *(NvU2*)((nvbf*)p.o1 + (size_t)row * D + c) = w; } break;
    case OP_YOUT4: {
        const int D4 = D / 4; const int row = (int)(gid / D4), c = (int)(gid % D4) * 4; const NvF4 v = *(const NvF4*)(p.a + (size_t)row * D + c);
        if (row < dm.B * dm.T) { const int bb = row / dm.T, t = row % dm.T; if (t >= 16) *(NvF4*)(p.o0 + ((size_t)bb * (dm.T - 16) + (t - 16)) * D + c) = v; }
        else *(NvF4*)(p.o0 + ((size_t)dm.B * (dm.T - 16) + (row - dm.B * dm.T)) * D + c) = v; } break;
    case OP_MIX8: {
        const int D8 = D / 8; const int row = (int)(gid / D8), c = (int)(gid % D8) * 8; int s, t; row_to_seq(dm, row, s, t); const float* x = p.a + (size_t)row * D + c; float xp[8];
        if (t > 0) { for (int i = 0; i < 8; ++i) xp[i] = x[i - D]; } else if (s < dm.B) { for (int i = 0; i < 8; ++i) xp[i] = 0.f; } else { for (int i = 0; i < 8; ++i) xp[i] = p.b[(size_t)(s - dm.B) * D + c + i]; }
        unsigned w[4];
#pragma unroll
        for (int i = 0; i < 4; ++i) { const float lo = x[2 * i] + (xp[2 * i] - x[2 * i]) * p.c[c + 2 * i], hi = x[2 * i + 1] + (xp[2 * i + 1] - x[2 * i + 1]) * p.c[c + 2 * i + 1]; w[i] = nv_f2bf(lo) | ((unsigned)nv_f2bf(hi) << 16); }
        NvU4 o; o.x = w[0]; o.y = w[1]; o.z = w[2]; o.w = w[3]; *(NvU4*)((nvbf*)p.o0 + (size_t)row * D + c) = o; } break;
    case OP_MIX6: {
        const int D8 = D / 8; const int row = (int)(gid / D8), c = (int)(gid % D8) * 8; int s, t; row_to_seq(dm, row, s, t); const float* x = p.a + (size_t)row * D + c; float xv[8], dx[8];
        for (int i = 0; i < 8; ++i) xv[i] = x[i];
        if (t > 0) { for (int i = 0; i < 8; ++i) dx[i] = x[i - D] - xv[i]; } else if (s < dm.B) { for (int i = 0; i < 8; ++i) dx[i] = -xv[i]; } else { for (int i = 0; i < 8; ++i) dx[i] = p.b[(size_t)(s - dm.B) * D + c + i] - xv[i]; }
        for (int m = 0; m < 6; ++m) { const float* mu = p.c + (size_t)m * D + c; unsigned w[4];
#pragma unroll
            for (int i = 0; i < 4; ++i) w[i] = nv_f2bf(xv[2 * i] + dx[2 * i] * mu[2 * i]) | ((unsigned)nv_f2bf(xv[2 * i + 1] + dx[2 * i + 1] * mu[2 * i + 1]) << 16);
            NvU4 o; o.x = w[0]; o.y = w[1]; o.z = w[2]; o.w = w[3]; *(NvU4*)((nvbf*)p.o0 + (size_t)m * p.i0 * 0 + (size_t)m * (size_t)p.i1 * 1024 + (size_t)row * D + c) = o; } } break;
    case OP_CONV4: {
        const int row = (int)(gid / 128), c = (int)(gid % 128) * 4; int s, t; row_to_seq(dm, row, s, t); float acc[4];
        for (int q = 0; q < 4; ++q) acc[q] = p.d[c + q];
        for (int i = 0; i < 4; ++i) { const int j = t + i; const float* xv = nullptr;
            if (j < 3) { if (s >= dm.B) xv = p.b + ((size_t)(s - dm.B) * 3 + j) * 512 + c; } else xv = p.a + (size_t)(row - t + (j - 3)) * MIXIN + C_XB + c;
            if (xv) for (int q = 0; q < 4; ++q) acc[q] = fmaf(xv[q], p.c[i * 512 + c + q], acc[q]); }
        NvF4 o; o.x = acc[0]; o.y = acc[1]; o.z = acc[2]; o.w = acc[3]; *(NvF4*)(p.o0 + (size_t)row * 512 + c) = o;
        NvU2 w; w.x = nv_f2bf(acc[0]) | ((unsigned)nv_f2bf(acc[1]) << 16); w.y = nv_f2bf(acc[2]) | ((unsigned)nv_f2bf(acc[3]) << 16); *(NvU2*)((nvbf*)p.o1 + (size_t)row * 512 + c) = w; } break;
    case OP_CVT8: {
        const int K8 = p.i2 / 8; const int row = (int)(gid / K8), k = (int)(gid % K8) * 8; unsigned w[4] = {0u, 0u, 0u, 0u};
        if (row < dm.M && k < p.i0) { const float* sp = p.a + (size_t)row * p.i1 + k;
#pragma unroll
            for (int i = 0; i < 4; ++i) { float lo = sp[2 * i], hi = sp[2 * i + 1]; if (p.i3 == 1) { lo = tanhf(lo); hi = tanhf(hi); } else if (p.i3 == 2) { lo = nv_sigmoid(lo); hi = nv_sigmoid(hi); } w[i] = nv_f2bf(lo) | ((unsigned)nv_f2bf(hi) << 16); } }
        NvU4 o; o.x = w[0]; o.y = w[1]; o.z = w[2]; o.w = w[3]; *(NvU4*)((nvbf*)p.o0 + (size_t)row * p.i2 + k) = o; } break;
    case OP_WGATE: {
        const int n = (int)gid, pn = n >> 8, within = n & 127, isx = (n >> 7) & 1, c = pn * 128 + within, nb = c >> 6, e = c & 63; const float* w = isx ? p.b : p.a; nvbf* dst = (nvbf*)p.o0 + (size_t)n * 512;
        for (int k = 0; k < 512; ++k) dst[k] = ((k >> 6) == nb) ? nv_f2bf(w[((size_t)nb * 64 + (k & 63)) * 64 + e]) : (nvbf)0;
        if (n < 512) p.o1[n] = -8.f * nv_softplus(-p.c[n]); } break;
    case OP_LRUG2: {
        const int row = (int)(gid / 512), c = (int)(gid % 512), pn = c >> 7, within = c & 127; const nvbf* x = (const nvbf*)p.a + (size_t)row * 512; const nvbf* wa_ = (const nvbf*)p.b + (size_t)(pn * 256 + within) * 512; const nvbf* wx_ = wa_ + (size_t)128 * 512; float ga = 0.f, gx = 0.f;
        for (int k = 0; k < 512; ++k) { const float xv = nv_bf2f(x[k]); ga = fmaf(xv, nv_bf2f(wa_[k]), ga); gx = fmaf(xv, nv_bf2f(wx_[k]), gx); }
        const float gate_a = nv_sigmoid(ga + p.c[c]), gate_x = nv_sigmoid(gx + p.d[c]); const float log_at = gate_a * p.e[c];
        p.o0[gid] = expf(log_at); p.o1[gid] = sqrtf(-expm1f(2.f * log_at)) * (gate_x * p.f[gid]); } break;
    case OP_LOGA4: {
        const int row = (int)(gid / 64), c = (int)(gid % 64) * 4; const float* gl = p.a + (size_t)row * MIXIN + C_GLR; NvF4 z = *(const NvF4*)(p.c + c);
#pragma unroll
        for (int r4 = 0; r4 < 4; ++r4) { const NvF4 g = *(const NvF4*)(gl + 4 * r4);
            const NvF4 w0 = *(const NvF4*)(p.b + (4 * r4 + 0) * 256 + c), w1 = *(const NvF4*)(p.b + (4 * r4 + 1) * 256 + c), w2 = *(const NvF4*)(p.b + (4 * r4 + 2) * 256 + c), w3 = *(const NvF4*)(p.b + (4 * r4 + 3) * 256 + c);
            z.x = fmaf(g.x, w0.x, z.x); z.y = fmaf(g.x, w0.y, z.y); z.z = fmaf(g.x, w0.z, z.z); z.w = fmaf(g.x, w0.w, z.w); z.x = fmaf(g.y, w1.x, z.x); z.y = fmaf(g.y, w1.y, z.y); z.z = fmaf(g.y, w1.z, z.z); z.w = fmaf(g.y, w1.w, z.w);
            z.x = fmaf(g.z, w2.x, z.x); z.y = fmaf(g.z, w2.y, z.y); z.z = fmaf(g.z, w2.z, z.z); z.w = fmaf(g.z, w2.w, z.w); z.x = fmaf(g.w, w3.x, z.x); z.y = fmaf(g.w, w3.y, z.y); z.z = fmaf(g.w, w3.z, z.z); z.w = fmaf(g.w, w3.w, z.w); }
        NvF4 o; o.x = expf(-nv_softplus(-z.x) * (1.f / 16.f)); o.y = expf(-nv_softplus(-z.y) * (1.f / 16.f)); o.z = expf(-nv_softplus(-z.z) * (1.f / 16.f)); o.w = expf(-nv_softplus(-z.w) * (1.f / 16.f));
        *(NvF4*)(p.o0 + (size_t)row * 256 + c) = o; } break;
    case OP_GLANORM: {
        int row = (int)(gid / 4), h = (int)(gid % 4); const float* o = p.a + (size_t)row * 512 + h * 128; float ss = 0.f;
        for (int c = 0; c < 128; ++c) ss = fmaf(o[c], o[c], ss);
        float rs = 1.f / sqrtf(ss * (1.f / 128.f) + 1e-5f);
        for (int c = 0; c < 128; ++c) { float r = p.b[(size_t)row * MIXIN + C_R + h * 128 + c]; ((nvbf*)p.o0)[(size_t)row * 1024 + h * 128 + c] = nv_f2bf(o[c] * rs * p.c[c] * (r * nv_sigmoid(r))); } } break;
    case OP_CONV: {
        int row = (int)(gid / 512), c = (int)(gid % 512); int s, t; row_to_seq(dm, row, s, t); float acc = p.d[c];
        for (int i = 0; i < 4; ++i) { int j = t + i; float xv;
            if (j < 3) xv = (s < dm.B) ? 0.f : p.b[((size_t)(s - dm.B) * 3 + j) * 512 + c]; else xv = p.a[(size_t)(row - t + (j - 3)) * MIXIN + C_XB + c];
            acc = fmaf(xv, p.c[i * 512 + c], acc); }
        p.o0[gid] = acc; } break;
    case OP_CONVOUT: {
        int s = (int)(gid / 1536), i = (int)((gid / 512) % 3), c = (int)(gid % 512); int L = seq_len(dm, s), r0 = seq_row0(dm, s); int j = L + i; float xv;
        if (j < 3) xv = (s < dm.B) ? 0.f : p.b[((size_t)(s - dm.B) * 3 + j) * 512 + c]; else xv = p.a[(size_t)(r0 + j - 3) * MIXIN + C_XB + c];
        float* o = (s < dm.B) ? PO1 + ((size_t)s * 3 + i) * 512 + c : PO2 + ((size_t)(s - dm.B) * 3 + i) * 512 + c; *o = xv; } break;
    case OP_LRUG: {
        int row = (int)(gid / 512), c = (int)(gid % 512), nb = c / 64, e = c % 64; const float* x = p.a + (size_t)row * 512 + nb * 64; float ga = p.c[c], gx = p.e[c];
        for (int dd = 0; dd < 64; ++dd) { ga = fmaf(x[dd], p.b[((size_t)nb * 64 + dd) * 64 + e], ga); gx = fmaf(x[dd], p.d[((size_t)nb * 64 + dd) * 64 + e], gx); }
        float gate_a = nv_sigmoid(ga), gate_x = nv_sigmoid(gx); float log_at = -8.f * gate_a * nv_softplus(-p.f[c]);
        p.o0[gid] = expf(log_at); p.o1[gid] = sqrtf(-expm1f(2.f * log_at)) * (gate_x * p.a[(size_t)row * 512 + c]); } break;
    case OP_LRUSCAN: {
        int s = (int)(gid / 512), c = (int)(gid % 512); int r0 = seq_row0(dm, s), L = seq_len(dm, s); float hh = (s < dm.B) ? 0.f : p.d[(size_t)(s - dm.B) * 512 + c];
        for (int t = 0; t < L; ++t) { size_t r = (size_t)(r0 + t); hh = fmaf(p.a[r * 512 + c], hh, p.b[r * 512 + c]); p.o0[r * 1024 + 512 + c] = hh * nv_gelu(p.c[r * MIXIN + C_GB + c]); }
        float* o = (s < dm.B) ? PO1 + (size_t)s * 512 + c : PO2 + (size_t)(s - dm.B) * 512 + c; *o = hh; } break;
    case OP_LNRES: {
        const float alpha = 1.6817928305074292f; float* x = p.o0 + (size_t)gid * D; const nvbf* y = (const nvbf*)p.a + (size_t)gid * D; float mu = 0.f;
        for (int c = 0; c < D; ++c) mu += alpha * x[c] + nv_bf2f(y[c]);
        mu /= D; float var = 0.f;
        for (int c = 0; c < D; ++c) { float v = alpha * x[c] + nv_bf2f(y[c]) - mu; var = fmaf(v, v, var); }
        float rs = 1.f / sqrtf(var / D + 1e-5f);
        for (int c = 0; c < D; ++c) { const float o = (alpha * x[c] + nv_bf2f(y[c]) - mu) * rs * p.b[c] + p.c[c]; x[c] = o; ((nvbf*)p.o1)[(size_t)gid * D + c] = nv_f2bf(o);
            if (p.o2) { unsigned char* f8 = (unsigned char*)p.o2 + (size_t)gid * 2 * D; const float xs = fminf(fmaxf(o * 16.f, -448.f), 448.f); const unsigned hc = nv_f2e4m3(xs); f8[c] = (unsigned char)hc; f8[D + c] = (unsigned char)nv_f2e4m3(xs - nv_e4m32f(hc)); } } } break;
    case OP_MIX: {
        int row = (int)(gid / D), c = (int)(gid % D); int s, t; row_to_seq(dm, row, s, t); float x = p.a[gid];
        float xp = t > 0 ? p.a[gid - D] : ((s < dm.B) ? 0.f : p.b[(size_t)(s - dm.B) * D + c]);
        ((nvbf*)p.o0)[gid] = nv_f2bf(x + (xp - x) * p.c[c]); } break;
    case OP_SHIFTOUT: {
        int s = (int)(gid / D), c = (int)(gid % D); float v = p.a[(size_t)(seq_row0(dm, s) + seq_len(dm, s) - 1) * D + c];
        float* o = (s < dm.B) ? PO1 + (size_t)s * D + c : PO2 + (size_t)(s - dm.B) * D + c; *o = v; } break;
    case OP_RWKVPREP: {
        int row = (int)(gid / dm.RH), h = (int)(gid % dm.RH); size_t base = (size_t)row * D + h * 64; float ss = 0.f;
        for (int k = 0; k < 64; ++k) { float kv = p.o0[base + k] * p.d[h * 64 + k]; ss = fmaf(kv, kv, ss); }
        float inv = 1.f / fmaxf(sqrtf(ss), 1e-12f);
        for (int k = 0; k < 64; ++k) { int c = h * 64 + k; size_t ix = base + k;
            float w = -nv_softplus(-(p.a[c] + p.o1[ix])) - 0.5f; float dec = expf(-expf(w));
            float a = nv_sigmoid(p.b[c] + p.o2[ix]);
            float v = p.o3[ix]; if (p.i0) v = v + (p.o5[ix] - v) * nv_sigmoid(p.c[c] + p.f[ix]); else p.o5[ix] = v;
            float k0 = p.o0[ix]; const float kk = k0 * p.d[c] * inv; p.o4[ix] = -kk; p.o0[ix] = k0 * (1.f + (a - 1.f) * p.e[c]); p.o1[ix] = dec; p.o2[ix] = kk * a; p.o3[ix] = v; } } break;
    case OP_WKVF:
    case OP_WKV: {
        int RH = dm.RH; int s = p.i0 + (int)(gid / (RH * 64)), h = (int)((gid / 64) % RH), vr = (int)(gid % 64); float S[64];
        const float* sin = (s < dm.B) ? nullptr : p.g + (((size_t)(s - dm.B) * RH + h) * 64 + vr) * 64;
#pragma unroll
        for (int k = 0; k < 64; ++k) S[k] = sin ? sin[k] : 0.f;
        int r0 = seq_row0(dm, s), L = seq_len(dm, s);
        for (int t = 0; t < L; ++t) { size_t base = (size_t)(r0 + t) * D + h * 64; float sa = 0.f;
#pragma unroll
            for (int k = 0; k < 64; ++k) { if ((k & 7) == 0) NV_FENCE(); sa = fmaf(S[k], p.f[base + k], sa); }
            float vv = p.d[base + vr], y = 0.f;
#pragma unroll
            for (int k = 0; k < 64; ++k) { if ((k & 7) == 0) NV_FENCE(); S[k] = fmaf(S[k], p.b[base + k], fmaf(sa, p.e[base + k], vv * p.c[base + k])); y = fmaf(S[k], p.a[base + k], y); }
            p.o0[base + vr] = y; }
        float* so = (s < dm.B) ? PO1 + (((size_t)s * RH + h) * 64 + vr) * 64 : PO2 + (((size_t)(s - dm.B) * RH + h) * 64 + vr) * 64;
#pragma unroll
        for (int k = 0; k < 64; ++k) so[k] = S[k]; } break;
    case OP_RWKVPOST: {
        int row = (int)(gid / dm.RH), h = (int)(gid % dm.RH); size_t base = (size_t)row * D + h * 64; float mu = 0.f, bon = 0.f;
        for (int k = 0; k < 64; ++k) { mu += p.a[base + k]; bon = fmaf(p.b[base + k] * p.c[base + k], p.f[h * 64 + k], bon); }
        mu *= (1.f / 64.f); float var = 0.f;
        for (int k = 0; k < 64; ++k) { float dlt = p.a[base + k] - mu; var = fmaf(dlt, dlt, var); }
        float rs = 1.f / sqrtf(var * (1.f / 64.f) + 64e-5f);
        for (int k = 0; k < 64; ++k) { int c = h * 64 + k; float y = (p.a[base + k] - mu) * rs * p.g[c] + p.h[c] + bon * p.d[base + k]; ((nvbf*)p.o0)[base + k] = nv_f2bf(y * p.e[base + k]); } } break;
    case OP_PRM: {
        const int m = (int)(gid / D), c = (int)(gid % D); const float* src = m == 0 ? p.a : m == 1 ? p.b : m == 2 ? p.c : m == 3 ? p.d : m == 4 ? p.e : p.f; p.o0[gid] = src ? src[c] : 0.f; } break;
    case OP_WKVP: {
        const int RH = dm.RH; const int s = (int)(gid / (RH * 64)), h = (int)((gid / 64) % RH), vr = (int)(gid % 64); float S[64];
        const float* sin = (s < dm.B) ? nullptr : p.o5 + (((size_t)(s - dm.B) * RH + h) * 64 + vr) * 64;
        for (int k = 0; k < 64; ++k) S[k] = sin ? sin[k] : 0.f;
        const float* w0 = p.h + h * 64; const float* a0 = p.h + D + h * 64; const float* v0 = p.h + 2 * D + h * 64; const float* k_k = p.h + 3 * D + h * 64; const float* k_a = p.h + 4 * D + h * 64; const float* r_k = p.h + 5 * D + h * 64;
        const int r0 = seq_row0(dm, s), L = seq_len(dm, s); const nvbf* bR = (const nvbf*)p.a; const nvbf* bK = (const nvbf*)p.b; const nvbf* bWL = (const nvbf*)p.c; const nvbf* bAL = (const nvbf*)p.d; const nvbf* bV = (const nvbf*)p.e; const nvbf* bVG = (const nvbf*)p.f;
        for (int t = 0; t < L; ++t) { const size_t base = (size_t)(r0 + t) * D + h * 64; float ss = 0.f;
            for (int k = 0; k < 64; ++k) { const float kv = nv_bf2f(bK[base + k]) * k_k[k]; ss = fmaf(kv, kv, ss); }
            const float inv = 1.f / fmaxf(sqrtf(ss), 1e-12f);
            float vv = nv_bf2f(bV[base + vr]); if (p.i0) vv = vv + (p.g[base + vr] - vv) * nv_sigmoid(v0[vr] + nv_bf2f(bVG[base + vr]));
            float sa = 0.f, bon = 0.f, dec[64], bb[64], k2[64];
            for (int k = 0; k < 64; ++k) { const float k0 = nv_bf2f(bK[base + k]); const float kk = k0 * k_k[k] * inv; const float a = nv_sigmoid(a0[k] + nv_bf2f(bAL[base + k]));
                dec[k] = expf(-0.6065306597126334f * nv_sigmoid(w0[k] + nv_bf2f(bWL[base + k])));
                bb[k] = kk * a; k2[k] = k0 * (1.f + (a - 1.f) * k_a[k]); sa = fmaf(S[k], -kk, sa); bon = fmaf(nv_bf2f(bR[base + k]) * k2[k], r_k[k], bon); }
            float y = 0.f;
            for (int k = 0; k < 64; ++k) { S[k] = fmaf(S[k], dec[k], fmaf(sa, bb[k], vv * k2[k])); y = fmaf(S[k], nv_bf2f(bR[base + k]), y); }
            p.o0[base + vr] = y; p.o3[base + vr] = vv; if (vr == 0) p.o4[(size_t)(r0 + t) * RH + h] = bon; }
        float* so = (s < dm.B) ? PO1 + (((size_t)s * RH + h) * 64 + vr) * 64 : PO2 + (((size_t)(s - dm.B) * RH + h) * 64 + vr) * 64;
        for (int k = 0; k < 64; ++k) so[k] = S[k]; } break;
    case OP_POST2: {
        const int row = (int)(gid / dm.RH), h = (int)(gid % dm.RH); const size_t base = (size_t)row * D + h * 64; float mu = 0.f;
        for (int k = 0; k < 64; ++k) mu += p.a[base + k];
        mu *= (1.f / 64.f); float var = 0.f;
        for (int k = 0; k < 64; ++k) { const float dlt = p.a[base + k] - mu; var = fmaf(dlt, dlt, var); }
        const float rs = 1.f / sqrtf(var * (1.f / 64.f) + 64e-5f), bon = p.d[gid];
        for (int k = 0; k < 64; ++k) { const int c = h * 64 + k; const float y = (p.a[base + k] - mu) * rs * p.e[c] + p.f[c] + bon * p.c[base + k]; ((nvbf*)p.o0)[base + k] = nv_f2bf(y * nv_bf2f(((const nvbf*)p.b)[base + k])); } } break;
    case OP_QNORM: {
        float* q = p.o0 + (size_t)gid * 256; float mu = 0.f;
        for (int c = 0; c < 256; ++c) mu += q[c];
        mu *= (1.f / 256.f); float var = 0.f;
        for (int c = 0; c < 256; ++c) { float dlt = q[c] - mu; var = fmaf(dlt, dlt, var); }
        float rs = 1.f / sqrtf(var * (1.f / 256.f) + 1e-5f);
        for (int c = 0; c < 256; ++c) q[c] = (q[c] - mu) * rs; } break;
    case OP_SCORES: {
        int row = (int)(gid / 2048), r = (int)(gid % 2048), h = r / 256, half = (r / 128) & 1, key = r % 128;
        const float* q = p.a + (size_t)row * 2048 + h * 256 + half * 128; const float* kv = p.b + (((size_t)h * 2 + half) * 128 + key) * 128; float acc = 0.f;
        for (int dd = 0; dd < 128; ++dd) acc = fmaf(q[dd], kv[dd], acc);
        p.o0[gid] = acc; } break;
    case OP_TOPK: {
        const float* sc = p.a + (size_t)gid * 256; float tv[16]; int ti[16]; float* tmpv = p.o2 + (size_t)gid * 32; int* tmpi = (int*)p.o3 + (size_t)gid * 32;
        for (int half = 0; half < 2; ++half) {
#pragma unroll
            for (int j = 0; j < 16; ++j) { tv[j] = -3.0e38f; ti[j] = 0; }
            for (int k = 0; k < 128; ++k) NV_INS16(tv, ti, sc[half * 128 + k], k);
#pragma unroll
            for (int j = 0; j < 16; ++j) { tmpv[half * 16 + j] = tv[j]; tmpi[half * 16 + j] = ti[j]; }
        }
#pragma unroll
        for (int j = 0; j < 16; ++j) { tv[j] = -3.0e38f; ti[j] = 0; }
        for (int i = 0; i < 16; ++i) for (int j = 0; j < 16; ++j) NV_INS16(tv, ti, tmpv[i] + tmpv[16 + j], tmpi[i] * 128 + tmpi[16 + j]);
        float den = 0.f, ev[16];
#pragma unroll
        for (int j = 0; j < 16; ++j) { ev[j] = expf(tv[j] - tv[0]); den += ev[j]; }
        float inv = 1.f / den;
#pragma unroll
        for (int j = 0; j < 16; ++j) { p.o0[(size_t)gid * 16 + j] = ev[j] * inv; ((int*)p.o1)[(size_t)gid * 16 + j] = ti[j]; } } break;
    case OP_PACT1: {
        size_t pr = (size_t)(gid / 16); int part = (int)(gid % 16); int row = (int)(pr / 128); int e = ((const int*)p.d)[pr]; int w = D / 16;
        const float* u = p.b + (size_t)e * D + part * w; const float* x = p.a + (size_t)row * D + part * w; float acc = 0.f;
        for (int c = 0; c < w; ++c) acc = fmaf(u[c], x[c], acc);
        p.o0[gid] = acc; } break;
    case OP_PACT2: {
        float acc = 0.f; for (int i = 0; i < 16; ++i) acc += p.a[(size_t)gid * 16 + i];
        p.o0[gid] = p.c[gid] * nv_gelu(acc); } break;
    case OP_POUT: {
        int row = (int)(gid / D), c = (int)(gid % D); float acc = 0.f;
        for (int i = 0; i < 128; ++i) acc = fmaf(p.a[(size_t)row * 128 + i], p.c[(size_t)((const int*)p.b)[(size_t)row * 128 + i] * D + c], acc);
        p.o0[gid] = acc; } break;
    case OP_YOUT: {
        int row = (int)(gid / D), c = (int)(gid % D);
        if (row < dm.B * dm.T) { int bb = row / dm.T, t = row % dm.T; if (t >= 16) p.o0[((size_t)bb * (dm.T - 16) + (t - 16)) * D + c] = p.a[gid]; }
        else p.o0[((size_t)dm.B * (dm.T - 16) + (row - dm.B * dm.T)) * D + c] = p.a[gid]; } break;
    case OP_WT: {
        const int N = p.i0, K = p.i1, Np = p.i3, Kp = p.i4; const long long per8 = (long long)Np * (Kp / 8); const int bt = (int)(gid / per8); const long long r = gid % per8; const int k0 = (int)(r / Np) * 8, nn = (int)(r % Np);
        unsigned w[4];
#pragma unroll
        for (int i = 0; i < 4; ++i) { float lo = 0.f, hi = 0.f; if (nn < N) { if (k0 + 2 * i < K) lo = p.a[((size_t)bt * K + k0 + 2 * i) * p.i2 + nn]; if (k0 + 2 * i + 1 < K) hi = p.a[((size_t)bt * K + k0 + 2 * i + 1) * p.i2 + nn]; } w[i] = nv_f2bf(lo) | ((unsigned)nv_f2bf(hi) << 16); }
        NvU4 o; o.x = w[0]; o.y = w[1]; o.z = w[2]; o.w = w[3];
        *(NvU4*)((nvbf*)p.o0 + (size_t)bt * Np * Kp + (size_t)nn * Kp + k0) = o; } break;
    case OP_CVT: {
        const int Kp = p.i2; const int row = (int)(gid / Kp), k = (int)(gid % Kp); float v = 0.f;
        if (row < dm.M && k < p.i0) { v = p.a[(size_t)row * p.i1 + k]; if (p.i3 == 1) v = tanhf(v); else if (p.i3 == 2) v = nv_sigmoid(v); }
        ((nvbf*)p.o0)[gid] = nv_f2bf(v); } break;
    case OP_FGEMM: {
        const int N = p.i0; const int m = (int)(gid / N), nn = (int)(gid % N); const nvbf* A = (const nvbf*)p.a + (size_t)m * p.i2 + ((p.i6 & 2) ? (nn / 256) * 256 : 0); const nvbf* Bt = (const nvbf*)p.b + (size_t)nn * p.i3; float acc = 0.f;
        for (int k = 0; k < p.i1; ++k) acc = fmaf(nv_bf2f(A[k]), nv_bf2f(Bt[k]), acc);
        if (p.i6 & 1) ((nvbf*)p.o0)[(size_t)m * p.i4 + nn] = nv_f2bf(acc); else p.o0[(size_t)m * p.i4 + nn] = acc; } break;
    case OP_CVTTAB: {
        const NvF4 v0 = *(const NvF4*)(p.a + gid * 8), v1 = *(const NvF4*)(p.a + gid * 8 + 4); NvU4 o;
        o.x = nv_f2bf(v0.x) | ((unsigned)nv_f2bf(v0.y) << 16); o.y = nv_f2bf(v0.z) | ((unsigned)nv_f2bf(v0.w) << 16); o.z = nv_f2bf(v1.x) | ((unsigned)nv_f2bf(v1.y) << 16); o.w = nv_f2bf(v1.z) | ((unsigned)nv_f2bf(v1.w) << 16);
        *(NvU4*)((nvbf*)p.o0 + gid * 8) = o; } break;
    case OP_CVTTAB8: {
        const float sc = (float)(1 << p.i0); const float* sp = p.a + gid * 16; unsigned w[4];
#pragma unroll
        for (int q = 0; q < 4; ++q) { const NvF4 v = *(const NvF4*)(sp + 4 * q); w[q] = nv_f2e4m3(v.x * sc) | (nv_f2e4m3(v.y * sc) << 8) | (nv_f2e4m3(v.z * sc) << 16) | (nv_f2e4m3(v.w * sc) << 24); }
        NvU4 o; o.x = w[0]; o.y = w[1]; o.z = w[2]; o.w = w[3]; *(NvU4*)((unsigned char*)p.o0 + gid * 16) = o; } break;
    case OP_CVTTAB8S: {
        const float sc = (float)(1 << p.i0); const int per = D / 16; const int e = (int)(gid / per), c0 = (int)(gid % per) * 16; const float* sp = p.a + (size_t)e * D + c0; unsigned w[4];
#pragma unroll
        for (int q = 0; q < 4; ++q) { const NvF4 v = *(const NvF4*)(sp + 4 * q);
#if defined(__HIP_DEVICE_COMPILE__)
            int pk = __builtin_amdgcn_cvt_pk_fp8_f32(v.x * sc, v.y * sc, 0, false); pk = __builtin_amdgcn_cvt_pk_fp8_f32(v.z * sc, v.w * sc, pk, true); w[q] = (unsigned)pk;
#else
            w[q] = nv_f2e4m3(v.x * sc) | (nv_f2e4m3(v.y * sc) << 8) | (nv_f2e4m3(v.z * sc) << 16) | (nv_f2e4m3(v.w * sc) << 24);
#endif
        }
        NvU4 o; o.x = w[0]; o.y = w[1]; o.z = w[2]; o.w = w[3]; *(NvU4*)((unsigned char*)p.o0 + ((size_t)(c0 >> 7) * 16384 + e) * 128 + (c0 & 127)) = o; } break;
    case OP_PACTS: {
        const long long NP = (long long)dm.M * 128; const int sl = (int)(gid / NP); const long long pr = gid % NP; const int row = (int)(pr / 128); const int e = ((const int*)p.d)[pr] & p.i0;
        const unsigned char* u = (const unsigned char*)p.b + ((size_t)sl * 16384 + e) * 128; const unsigned char* x = (const unsigned char*)p.a + (size_t)row * 2 * D + sl * 128; float acc = 0.f;
        for (int c = 0; c < 128; ++c) acc = fmaf(nv_e4m32f(u[c]), nv_e4m32f(x[c]) + nv_e4m32f(x[D + c]), acc);
        p.o0[gid] = acc * (1.f / 16.f); } break;
    case OP_PRED: {
        const long long NP = (long long)dm.M * 128; float acc = 0.f; for (int sl = 0; sl < p.i0; ++sl) acc += p.a[(size_t)sl * NP + gid];
        p.o0[gid] = p.c[gid] * nv_gelu(acc * (1.f / 128.f)); } break;
    case OP_POUTS: {
        const int row = (int)(gid / D), c = (int)(gid % D); const unsigned char* vb = (const unsigned char*)p.c + (size_t)(c >> 7) * 16384 * 128 + (c & 127); float acc = 0.f;
        for (int i = 0; i < 128; ++i) acc = fmaf(p.a[(size_t)row * 128 + i] * (1.f / 64.f), nv_e4m32f(vb[(size_t)((const int*)p.b)[(size_t)row * 128 + i] * 128]), acc);
        ((nvbf*)p.o0)[gid] = nv_f2bf(acc); } break;
    case OP_KEYS: {
        const int h = (int)(gid / 256), nrow = (int)(gid % 256), half = nrow >> 7; const float* src = p.a + (((size_t)h * 2 + half) * 128 + (nrow & 127)) * 128; nvbf* dst = (nvbf*)p.o0 + ((size_t)h * 256 + nrow) * 256; float ks = 0.f;
        for (int k = 0; k < 256; ++k) { nvbf b = 0; if ((k >> 7) == half) { b = nv_f2bf(src[k & 127]); ks += nv_bf2f(b); } dst[k] = b; }
        p.o1[gid] = ks; } break;
    case OP_TOPK2: {
        const int h = (int)(gid % 8); const float* sc = p.a + (size_t)gid * 256; const nvbf* q = (const nvbf*)p.b + (size_t)gid * 256; const float* ksum = p.c + h * 256; float mu = 0.f;
        for (int c = 0; c < 256; ++c) mu += nv_bf2f(q[c]);
        mu *= (1.f / 256.f); float var = 0.f;
        for (int c = 0; c < 256; ++c) { float dlt = nv_bf2f(q[c]) - mu; var = fmaf(dlt, dlt, var); }
        const float rs = 1.f / sqrtf(var * (1.f / 256.f) + 1e-5f);
        float tv[16]; int ti[16]; float* tmpv = p.o2 + (size_t)gid * 32; int* tmpi = (int*)p.o3 + (size_t)gid * 32;
        for (int half = 0; half < 2; ++half) {
#pragma unroll
            for (int j = 0; j < 16; ++j) { tv[j] = -3.0e38f; ti[j] = 0; }
            for (int k = 0; k < 128; ++k) NV_INS16(tv, ti, rs * (sc[half * 128 + k] - mu * ksum[half * 128 + k]), k);
#pragma unroll
            for (int j = 0; j < 16; ++j) { tmpv[half * 16 + j] = tv[j]; tmpi[half * 16 + j] = ti[j]; }
        }
#pragma unroll
        for (int j = 0; j < 16; ++j) { tv[j] = -3.0e38f; ti[j] = 0; }
        for (int i = 0; i < 16; ++i) for (int j = 0; j < 16; ++j) NV_INS16(tv, ti, tmpv[i] + tmpv[16 + j], tmpi[i] * 128 + tmpi[16 + j]);
        float den = 0.f, ev[16];
#pragma unroll
        for (int j = 0; j < 16; ++j) { ev[j] = expf(tv[j] - tv[0]); den += ev[j]; }
        float inv = 1.f / den;
#pragma unroll
        for (int j = 0; j < 16; ++j) { p.o0[(size_t)gid * 16 + j] = ev[j] * inv; ((int*)p.o1)[(size_t)gid * 16 + j] = ti[j]; } } break;
    case OP_PACT: {
        const int row = (int)(gid / 128); const int e = ((const int*)p.d)[gid]; const unsigned char* u = (const unsigned char*)p.b + (size_t)e * D; const nvbf* x = (const nvbf*)p.a + (size_t)row * D; float acc = 0.f;
        for (int c = 0; c < D; ++c) acc = fmaf(nv_e4m32f(u[c]), nv_bf2f(x[c]), acc);
        p.o0[gid] = p.c[gid] * nv_gelu(acc * (1.f / 128.f)); } break;
#if defined(HOST_TEST)
    case OP_POUTLN: {
        const float alpha = 1.6817928305074292f; float* x = p.o0 + (size_t)gid * D; std::vector<float> y(D, 0.f);
        for (int i = 0; i < 128; ++i) { const float cf = p.a[(size_t)gid * 128 + i] * (1.f / 64.f); const unsigned char* v = (const unsigned char*)p.c + (size_t)((const int*)p.b)[(size_t)gid * 128 + i] * D; for (int c = 0; c < D; ++c) y[c] = fmaf(cf, nv_e4m32f(v[c]), y[c]); }
        float mu = 0.f; for (int c = 0; c < D; ++c) { y[c] = alpha * x[c] + y[c]; mu += y[c]; }
        mu /= D; float var = 0.f; for (int c = 0; c < D; ++c) { float dlt = y[c] - mu; var = fmaf(dlt, dlt, var); }
        const float rs = 1.f / sqrtf(var / D + 1e-5f);
        for (int c = 0; c < D; ++c) { const float o = (y[c] - mu) * rs * p.d[c] + p.e[c]; x[c] = o; ((nvbf*)p.o1)[(size_t)gid * D + c] = nv_f2bf(o);
            if (p.o2) { unsigned char* f8 = (unsigned char*)p.o2 + (size_t)gid * 2 * D; const float xs = fminf(fmaxf(o * 16.f, -448.f), 448.f); const unsigned hc = nv_f2e4m3(xs); f8[c] = (unsigned char)hc; f8[D + c] = (unsigned char)nv_f2e4m3(xs - nv_e4m32f(hc)); } } } break;
#endif
    default: break;
    }
}

struct NvIO { const float* const* in; float* out; char* ws; size_t ws_size; };
template <class Launch> HD void nv_forward(const NvIO& io, const Dm& dm, Launch&& launch) {
    const int D = dm.D, M = dm.M, B = dm.B, DB = dm.DB, RH = dm.RH; const size_t MD = (size_t)M * D;
    float* y_prompt = io.out; float* y_sample = y_prompt + (size_t)B * (dm.T - 16) * D; float* p_gla = y_sample + (size_t)DB * dm.DT * D;
    float* p_h = p_gla + (size_t)2 * B * 4 * 64 * 128; float* p_conv = p_h + (size_t)2 * B * 512; float* p_rwkv = p_conv + (size_t)2 * B * 3 * 512;
    float* p_shift = p_rwkv + (size_t)2 * B * RH * 4096; float* s_gla = p_shift + (size_t)2 * B * D; float* s_h = s_gla + (size_t)2 * DB * 4 * 64 * 128;
    float* s_conv = s_h + (size_t)2 * DB * 512; float* s_rwkv = s_conv + (size_t)2 * DB * 3 * 512; float* s_shift = s_rwkv + (size_t)2 * DB * RH * 4096;
    float* w = (float*)io.ws; size_t off = 0; auto take = [&](size_t n) __attribute__((always_inline)) { float* r = w + off; off += (n + 63) & ~(size_t)63; return r; };
    float* X = take(MD); float* VFIRST = take(MD); float* MOUT = take(MD);
    auto mk = [&](int code, long long n) __attribute__((always_inline)) { Op o{}; o.code = code; o.n = n; return o; };
    const int Mp = nv_rup(M, 256), Dp = nv_rup(D, 256), Dk = nv_rup(D, 128);
    auto takeh = [&](size_t n) __attribute__((always_inline)) { return (nvbf*)take((n + 1) / 2); };
    const size_t ABFN = (size_t)Mp * 1024 > (size_t)Mp * Dk ? (size_t)Mp * 1024 : (size_t)Mp * Dk; nvbf* ABF = takeh(ABFN + (size_t)Mp * D);
    const size_t SZ_WIN = (size_t)2816 * Dk, SZ_WOUT = (size_t)Dp * 1024, SZ_DD = (size_t)Dp * Dk, SZ_DN = (size_t)256 * Dk, SZ_UP = (size_t)Dp * 128, SZ_WQ = (size_t)2048 * Dk;
    nvbf* WT_WIN = takeh(2 * SZ_WIN); nvbf* WT_WOUT = takeh(2 * SZ_WOUT); nvbf* WT_WR = takeh(2 * SZ_DD); nvbf* WT_WK = takeh(2 * SZ_DD); nvbf* WT_WV = takeh(2 * SZ_DD); nvbf* WT_WO = takeh(2 * SZ_DD);
    nvbf* WT_W1 = takeh(2 * SZ_DN); nvbf* WT_W2 = takeh(2 * SZ_UP); nvbf* WT_A1 = takeh(2 * SZ_DN); nvbf* WT_A2 = takeh(2 * SZ_UP); nvbf* WT_G1 = takeh(2 * SZ_DN); nvbf* WT_G2 = takeh(2 * SZ_UP);
    nvbf* WT_V1 = takeh(SZ_DN); nvbf* WT_V2 = takeh(SZ_UP); nvbf* WT_WQ = takeh(4 * SZ_WQ); nvbf* WT_WG = takeh((size_t)2 * 1024 * 512); float* SPL = take(2 * 512); float* PRM = take((size_t)2 * 6 * D);
    nvbf* UB = takeh((size_t)16384 * D / 2); nvbf* VB = takeh((size_t)16384 * D / 2); nvbf* KB = takeh((size_t)8 * 256 * 256); float* KSUM = take(8 * 256);
    const size_t scratch0 = off;
    auto nb = [&](Op o) __attribute__((always_inline)) { o.code |= OPF_NOBAR; launch(o); };
    auto wt = [&](const float* W, int K, int N, int batch, nvbf* dst) __attribute__((always_inline)) { const int Np = nv_rup(N, 256), Kp = nv_rup(K, 128); Op o = mk(OP_WT, (long long)batch * Np * (Kp / 8)); o.a = W; o.o0 = (float*)dst; o.i0 = N; o.i1 = K; o.i2 = N; o.i3 = Np; o.i4 = Kp; nb(o); };
    wt(io.in[10], D, MIXIN, 2, WT_WIN); wt(io.in[21], 1024, D, 2, WT_WOUT); wt(io.in[23], D, D, 2, WT_WR); wt(io.in[24], D, D, 2, WT_WK); wt(io.in[25], D, D, 2, WT_WV); wt(io.in[26], D, D, 2, WT_WO);
    wt(io.in[28], D, 64, 2, WT_W1); wt(io.in[29], 64, D, 2, WT_W2); wt(io.in[31], D, 64, 2, WT_A1); wt(io.in[32], 64, D, 2, WT_A2); wt(io.in[36], D, 128, 2, WT_G1); wt(io.in[37], 128, D, 2, WT_G2);
    wt(io.in[34], D, 32, 1, WT_V1); wt(io.in[35], 32, D, 1, WT_V2); wt(io.in[43], D, 2048, 4, WT_WQ);
    for (int jj = 0; jj < 2; ++jj) { Op o = mk(OP_PRM, (long long)6 * D); o.a = io.in[27] + (size_t)jj * D; o.b = io.in[30] + (size_t)jj * D; o.c = jj > 0 ? io.in[33] + (size_t)(jj - 1) * D : nullptr; o.d = io.in[38] + (size_t)jj * D; o.e = io.in[39] + (size_t)jj * D; o.f = io.in[40] + (size_t)jj * RH * 64; o.o0 = PRM + (size_t)jj * 6 * D; nb(o); }
    for (int jj = 0; jj < 2; ++jj) { Op o = mk(OP_WGATE, 1024); o.a = io.in[16] + (size_t)jj * 8 * 64 * 64; o.b = io.in[18] + (size_t)jj * 8 * 64 * 64; o.c = io.in[20] + (size_t)jj * 512; o.o0 = (float*)(WT_WG + (size_t)jj * 1024 * 512); o.o1 = SPL + (size_t)jj * 512; nb(o); }
    auto fgemm = [&](const nvbf* Wt, float* C, int ldc, int N, int K, int bf16out = 0) __attribute__((always_inline)) {
        const int Kp = nv_rup(K, 128), Np = nv_rup(N, 256);
        Op o = mk(OP_FGEMM, (long long)M * N); o.a = (const float*)ABF; o.b = (const float*)Wt; o.o0 = C; o.i0 = N; o.i1 = Kp; o.i2 = Kp; o.i3 = Kp; o.i4 = ldc; o.i5 = Np; o.i6 = bf16out; launch(o); };
    auto gemm = [&](const float* A, int lda, const nvbf* Wt, float* C, int ldc, int N, int K, int act) __attribute__((always_inline)) {
        const int Kp = nv_rup(K, 128);
        { Op o = mk(OP_CVT8, (long long)Mp * (Kp / 8)); o.a = A; o.o0 = (float*)ABF; o.i0 = K; o.i1 = lda; o.i2 = Kp; o.i3 = act; launch(o); }
        fgemm(Wt, C, ldc, N, K); };
    { Op o = mk(OP_EMBED4, (long long)MD / 4); o.a = io.in[0]; o.b = io.in[1]; o.c = io.in[7]; o.o0 = X; o.o1 = (float*)ABF; launch(o); }
    const float* const w_outer = w; float* const out_outer = io.out;
    for (int layer = 0; layer < 4; ++layer) {
        float* wl = (float*)w_outer; float* ol = out_outer; NV_LAUNDER(wl); NV_LAUNDER(ol);
#define NV_RB(T, v) T const v##_rb = (T)((char*)wl + ((const char*)(v) - (const char*)w_outer))
#define NV_RO(v) float* const v##_rb = (float*)((char*)ol + ((const char*)(v) - (const char*)out_outer))
        NV_RB(float*, X); NV_RB(float*, VFIRST); NV_RB(float*, MOUT); NV_RB(nvbf*, ABF); NV_RB(nvbf*, WT_WIN); NV_RB(nvbf*, WT_WOUT); NV_RB(nvbf*, WT_WR); NV_RB(nvbf*, WT_WK); NV_RB(nvbf*, WT_WV); NV_RB(nvbf*, WT_WO);
        NV_RB(nvbf*, WT_W1); NV_RB(nvbf*, WT_W2); NV_RB(nvbf*, WT_A1); NV_RB(nvbf*, WT_A2); NV_RB(nvbf*, WT_G1); NV_RB(nvbf*, WT_G2); NV_RB(nvbf*, WT_V1); NV_RB(nvbf*, WT_V2); NV_RB(nvbf*, WT_WQ); NV_RB(nvbf*, WT_WG);
        NV_RB(float*, SPL); NV_RB(float*, PRM); NV_RB(nvbf*, UB); NV_RB(nvbf*, VB); NV_RB(nvbf*, KB); NV_RB(float*, KSUM);
        NV_RO(p_gla); NV_RO(p_h); NV_RO(p_conv); NV_RO(p_rwkv); NV_RO(p_shift); NV_RO(s_gla); NV_RO(s_h); NV_RO(s_conv); NV_RO(s_rwkv); NV_RO(s_shift);
#undef NV_RB
#undef NV_RO
        { float* const X = X_rb; float* const VFIRST = VFIRST_rb; float* const MOUT = MOUT_rb; nvbf* const ABF = ABF_rb; nvbf* const WT_WIN = WT_WIN_rb; nvbf* const WT_WOUT = WT_WOUT_rb; nvbf* const WT_WR = WT_WR_rb; nvbf* const WT_WK = WT_WK_rb;
          nvbf* const WT_WV = WT_WV_rb; nvbf* const WT_WO = WT_WO_rb; nvbf* const WT_W1 = WT_W1_rb; nvbf* const WT_W2 = WT_W2_rb; nvbf* const WT_A1 = WT_A1_rb; nvbf* const WT_A2 = WT_A2_rb; nvbf* const WT_G1 = WT_G1_rb; nvbf* const WT_G2 = WT_G2_rb;
          nvbf* const WT_V1 = WT_V1_rb; nvbf* const WT_V2 = WT_V2_rb; nvbf* const WT_WQ = WT_WQ_rb; nvbf* const WT_WG = WT_WG_rb; float* const SPL = SPL_rb; float* const PRM = PRM_rb; nvbf* const UB = UB_rb; nvbf* const VB = VB_rb; nvbf* const KB = KB_rb; float* const KSUM = KSUM_rb;
          float* const p_gla = p_gla_rb; float* const p_h = p_h_rb; float* const p_conv = p_conv_rb; float* const p_rwkv = p_rwkv_rb; float* const p_shift = p_shift_rb; float* const s_gla = s_gla_rb; float* const s_h = s_h_rb; float* const s_conv = s_conv_rb;
          float* const s_rwkv = s_rwkv_rb; float* const s_shift = s_shift_rb; float* const w = wl; (void)SPL; (void)WT_WG; (void)VFIRST;
        const int j = layer / 2; off = scratch0;
        { Op o = mk(OP_CVTTAB8S, (long long)16384 * D / 16); o.a = io.in[45] + (size_t)layer * 16384 * D; o.o0 = (float*)UB; o.i0 = 7; nb(o); }
        { Op o = mk(OP_CVTTAB8S, (long long)16384 * D / 16); o.a = io.in[46] + (size_t)layer * 16384 * D; o.o0 = (float*)VB; o.i0 = 6; nb(o); }
        { Op o = mk(OP_KEYS, 8 * 256); o.a = io.in[44] + (size_t)layer * 8 * 2 * 128 * 128; o.o0 = (float*)KB; o.o1 = KSUM; nb(o); }
        if (layer % 2 == 0) {
            float* PROJ = take((size_t)M * MIXIN); float* LOGA = take((size_t)M * 256); float* O = take((size_t)M * 512); float* MIXO = (float*)ABF;
            float* XC = take((size_t)M * 512); nvbf* XCB = takeh((size_t)Mp * 512); float* AT = take((size_t)M * 512); float* BT = take((size_t)M * 512);
            const int NC = (dm.T + 63) / 64; float* LEND = take((size_t)B * 4 * NC * 8192); float* DEC = take((size_t)B * 4 * NC * 64); float* LA = take((size_t)B * NC * 512); float* LB = take((size_t)B * NC * 512);
            fgemm(WT_WIN + (size_t)j * SZ_WIN, PROJ, MIXIN, MIXIN, D);
            { Op o = mk(OP_LOGA4, (long long)M * 64); o.a = PROJ; o.b = io.in[11] + (size_t)j * 16 * 256; o.c = io.in[12] + (size_t)j * 256; o.o0 = LOGA; nb(o); }
            { Op o = mk(OP_CONV4, (long long)M * 128); o.a = PROJ; o.b = io.in[4] + (size_t)j * DB * 3 * 512; o.c = io.in[14] + (size_t)j * 4 * 512; o.d = io.in[15] + (size_t)j * 512; o.o0 = XC; o.o1 = (float*)XCB; nb(o); }
            { Op o = mk(OP_CONVOUT, (long long)dm.NSEQ * 1536); o.a = PROJ; o.b = io.in[4] + (size_t)j * DB * 3 * 512; o.o1 = p_conv + (size_t)j * B * 3 * 512; o.o2 = s_conv + (size_t)j * DB * 3 * 512; launch(o); }
            { Op o = mk(OP_GLAF, (long long)B * 512); o.a = PROJ; o.b = LOGA; o.o0 = O; o.o1 = p_gla + (size_t)j * B * 4 * 64 * 128; nb(o); }
            { Op o = mk(OP_GLA3, (long long)(DB * 4) * 128); o.a = PROJ; o.b = LOGA; o.c = io.in[2] + (size_t)j * DB * 4 * 64 * 128; o.d = LEND; o.o0 = O; o.o2 = s_gla + (size_t)j * DB * 4 * 64 * 128; o.i0 = NC; o.i1 = 1; nb(o); }
            { Op o = mk(OP_LRUG2, (long long)M * 512); o.a = (const float*)XCB; o.b = (const float*)(WT_WG + (size_t)j * 1024 * 512); o.c = io.in[17] + (size_t)j * 512; o.d = io.in[19] + (size_t)j * 512; o.e = SPL + (size_t)j * 512; o.f = XC; o.o0 = AT; o.o1 = BT; launch(o); }
            { Op o = mk(OP_GLANORM, (long long)M * 4); o.a = O; o.b = PROJ; o.c = io.in[13] + (size_t)j * 128; o.o0 = MIXO; nb(o); }
            { Op o = mk(OP_LRU1, (long long)B * NC * 512); o.a = AT; o.b = BT; o.o0 = LA; o.o1 = LB; o.i0 = NC; launch(o); }
            { Op o = mk(OP_LRU2, (long long)B * 512); o.a = LA; o.o0 = LB; o.o1 = p_h + (size_t)j * B * 512; o.i0 = NC; launch(o); }
            { Op o = mk(OP_LRU3, (long long)(B * NC + DB) * 512); o.a = AT; o.b = BT; o.c = PROJ; o.d = io.in[3] + (size_t)j * DB * 512; o.e = LB; o.o0 = MIXO; o.o2 = s_h + (size_t)j * DB * 512; o.i0 = NC; launch(o); }
            fgemm(WT_WOUT + (size_t)j * SZ_WOUT, MOUT, D, D, 1024, 1);
        } else {
            float* Y = take(MD); float* R = take(MD); float* K = take(MD); float* V = take(MD); float* G = take(MD); float* KK = take(MD);
            const size_t XMSZ = (size_t)Mp * D;
            float* WAV = take(3 * MD > 3 * XMSZ ? 3 * MD : 3 * XMSZ); float* Wd = WAV; float* Aa = WAV + MD; float* Vg = WAV + 2 * MD; nvbf* XM6 = (nvbf*)WAV;
            float* BON = take((size_t)M * RH); float* HLw = take((size_t)M * 64); float* HLa = take((size_t)M * 64); float* HLg = take((size_t)M * 128); float* HLv = take((size_t)M * 32);
            nvbf* ABw = takeh((size_t)Mp * 128); nvbf* ABa = takeh((size_t)Mp * 128); nvbf* ABg = takeh((size_t)Mp * 128); nvbf* ABv = takeh((size_t)Mp * 128);
            const float* shin = io.in[6] + (size_t)j * DB * D; const float* mu = io.in[22] + (size_t)j * 6 * D;
            { Op o = mk(OP_SHIFTOUT, (long long)dm.NSEQ * D); o.a = X; o.o1 = p_shift + (size_t)j * B * D; o.o2 = s_shift + (size_t)j * DB * D; nb(o); }
            { Op o = mk(OP_MIX6, (long long)MD / 8); o.a = X; o.b = shin; o.c = mu; o.o0 = (float*)XM6; o.i1 = (int)(XMSZ / 1024); launch(o); }
            auto gg = [&](const nvbf* A, const nvbf* Wt, float* C, int ldc, int N, int K, bool last, int bf16out = 0) __attribute__((always_inline)) { const int Kp = nv_rup(K, 128), Np = nv_rup(N, 256);
                Op o = mk(OP_FGEMM, (long long)M * N); o.a = (const float*)A; o.b = (const float*)Wt; o.o0 = C; o.i0 = N; o.i1 = Kp; o.i2 = Kp; o.i3 = Kp; o.i4 = ldc; o.i5 = Np; o.i6 = bf16out; if (!last) o.code |= OPF_GROUP; launch(o); };
            gg(XM6 + 0 * XMSZ, WT_WR + (size_t)j * SZ_DD, R, D, D, D, false, 1); gg(XM6 + 2 * XMSZ, WT_WK + (size_t)j * SZ_DD, K, D, D, D, false, 1); gg(XM6 + 3 * XMSZ, WT_WV + (size_t)j * SZ_DD, V, D, D, D, false, 1);
            gg(XM6 + 1 * XMSZ, WT_W1 + (size_t)j * SZ_DN, HLw, 64, 64, D, false); gg(XM6 + 4 * XMSZ, WT_A1 + (size_t)j * SZ_DN, HLa, 64, 64, D, false);
            if (j > 0) gg(XM6 + 3 * XMSZ, WT_V1 + (size_t)(j - 1) * SZ_DN, HLv, 32, 32, D, false);
            gg(XM6 + 5 * XMSZ, WT_G1 + (size_t)j * SZ_DN, HLg, 128, 128, D, true);
            auto cv = [&](const float* A, int K, nvbf* dst, int act, bool last) __attribute__((always_inline)) { Op o = mk(OP_CVT8, (long long)Mp * 16); o.a = A; o.o0 = (float*)dst; o.i0 = K; o.i1 = K; o.i2 = 128; o.i3 = act; if (last) launch(o); else nb(o); };
            cv(HLw, 64, ABw, 1, false); cv(HLa, 64, ABa, 0, false); if (j > 0) cv(HLv, 32, ABv, 0, false); cv(HLg, 128, ABg, 2, true);
            gg(ABw, WT_W2 + (size_t)j * SZ_UP, Wd, D, D, 64, false, 1); gg(ABa, WT_A2 + (size_t)j * SZ_UP, Aa, D, D, 64, false, 1); if (j > 0) gg(ABv, WT_V2 + (size_t)(j - 1) * SZ_UP, Vg, D, D, 32, false, 1); gg(ABg, WT_G2 + (size_t)j * SZ_UP, G, D, D, 128, true, 1);
            { Op o = mk(OP_WKVP, (long long)dm.NSEQ * RH * 64); o.a = R; o.b = K; o.c = Wd; o.d = Aa; o.e = V; o.f = Vg; o.g = VFIRST; o.h = PRM + (size_t)j * 6 * D; o.o0 = Y; o.o1 = p_rwkv + (size_t)j * B * RH * 4096; o.o2 = s_rwkv + (size_t)j * DB * RH * 4096;
              o.o3 = j > 0 ? KK : VFIRST; o.o4 = BON; o.o5 = (float*)(io.in[5] + (size_t)j * DB * RH * 4096); o.i0 = j > 0 ? 1 : 0; launch(o); }
            { Op o = mk(OP_POST2, (long long)M * RH); o.a = Y; o.b = G; o.c = j > 0 ? KK : VFIRST; o.d = BON; o.e = io.in[41] + (size_t)j * D; o.f = io.in[42] + (size_t)j * D; o.o0 = (float*)ABF; launch(o); }
            fgemm(WT_WO + (size_t)j * SZ_DD, MOUT, D, D, D, 1);
        }
        { Op o = mk(OP_LNRES, M); o.a = MOUT; o.b = io.in[8] + (size_t)(layer * 2 + 0) * D; o.c = io.in[9] + (size_t)(layer * 2 + 0) * D; o.o0 = X; o.o1 = (float*)ABF; o.o2 = (float*)(ABF + ABFN); launch(o); }
        off = scratch0;
        { nvbf* Q = takeh((size_t)Mp * 2048); float* SC = take((size_t)M * 2048); float* GATE = take((size_t)M * 128); float* EIDX = take((size_t)M * 128); float* TMPV = take((size_t)M * 256); float* TMPI = take((size_t)M * 256);
          float* COEF = take((size_t)M * 128);
          { Op o = mk(OP_FGEMM, (long long)M * 2048); o.a = (const float*)ABF; o.b = (const float*)(WT_WQ + (size_t)layer * SZ_WQ); o.o0 = (float*)Q; o.i0 = 2048; o.i1 = Dk; o.i2 = Dk; o.i3 = Dk; o.i4 = 2048; o.i5 = 2048; o.i6 = 1; launch(o); }
          { Op o = mk(OP_FGEMM, (long long)M * 2048); o.a = (const float*)Q; o.b = (const float*)KB; o.o0 = SC; o.i0 = 2048; o.i1 = 256; o.i2 = 2048; o.i3 = 256; o.i4 = 2048; o.i5 = 2048; o.i6 = 2; launch(o); }
          { Op o = mk(OP_TOPK2, (long long)M * 8); o.a = SC; o.b = (const float*)Q; o.c = KSUM; o.o0 = GATE; o.o1 = EIDX; o.o2 = TMPV; o.o3 = TMPI; launch(o); }
          { const int NS = D / 128; float* PART = take((size_t)NS * M * 128); float* YBUF = take(MD);
            #ifdef PROBE_EMASK
            { Op o = mk(OP_PACTS, (long long)NS * M * 128); o.a = (const float*)(ABF + ABFN); o.b = (const float*)UB; o.d = EIDX; o.o0 = PART; o.i0 = PROBE_EMASK; launch(o); }
#endif
            { Op o = mk(OP_PACTS, (long long)NS * M * 128); o.a = (const float*)(ABF + ABFN); o.b = (const float*)UB; o.d = EIDX; o.o0 = PART; o.i0 = 16383; launch(o); }
            { Op o = mk(OP_PRED, (long long)M * 128); o.a = PART; o.c = GATE; o.o0 = COEF; o.i0 = NS; launch(o); }
            { Op o = mk(OP_POUTS, (long long)MD); o.a = COEF; o.b = EIDX; o.c = (const float*)VB; o.o0 = YBUF; launch(o); }
            { Op o = mk(OP_LNRES, M); o.a = YBUF; o.b = io.in[8] + (size_t)(layer * 2 + 1) * D; o.c = io.in[9] + (size_t)(layer * 2 + 1) * D; o.o0 = X; o.o1 = (float*)ABF; launch(o); } } }
        }
    }
    { Op o = mk(OP_YOUT4, (long long)MD / 4); o.a = X; o.o0 = y_prompt; launch(o); }
    (void)y_sample;
}

#include <cstdint>
namespace pg8 {
#define PG8_LAS __attribute__((address_space(3)))
typedef unsigned short bf16_t;
typedef short bf16x8 __attribute__((ext_vector_type(8)));
typedef float f32x4 __attribute__((ext_vector_type(4)));
typedef unsigned u32x4 __attribute__((ext_vector_type(4)));
constexpr int BM = 256, BK = 64, HALF = 128, HTB = HALF * BK * 2  , STAGE_BYTES = 8 * HTB, NXCD = 8, WGM = 8;

__host__ __device__ __forceinline__ int lds_byte(int r, int c) { const int st = (r >> 4) * 2 + (c >> 5), rr = r & 15, cc = c & 31, ob = rr * 64 + cc * 2; return st * 1024 + (ob ^ (((ob >> 9) & 1) << 5)); }
__host__ __device__ __forceinline__ void stage_rc(int b, int& R, int& C) { const int st = b / 1024, sb = b % 1024, swz = sb ^ (((sb >> 9) & 1) << 5); R = (st >> 1) * 16 + swz / 64; C = (st & 1) * 32 + (swz % 64) / 2; }
__host__ __device__ __forceinline__ int perm32(int rho) { const int n = rho >> 4, i = rho & 15; return 8 * (i >> 2) + 4 * n + (i & 3); }

struct Unit { int pm, pn, grp, pad_; const char* A; const char* B; };
struct Gemm { const bf16_t* A; const bf16_t* Bt; int M, N, K, lda, ldb; };

struct StaticOrder {
    int nM, nN, nwg, G, c; const char* A; const char* B; size_t tsA, tsB, acs;
    __host__ __device__ void init(const Gemm& g, int G_, int c_) { nM = g.M / BM; nN = g.N / BM; nwg = nM * nN; G = G_; c = c_; A = (const char*)g.A; B = (const char*)g.Bt; tsA = (size_t)BM * g.lda * 2; tsB = (size_t)BM * g.ldb * 2; acs = 0; }
    __host__ __device__ bool next(int i, Unit& u) const {
        const long L = (long)i * G + c; if (L >= nwg) return false;
        int wgid = (int)L; { const int q = nwg / NXCD, r = nwg % NXCD, xcd = wgid % NXCD, off = wgid / NXCD; wgid = (xcd < r ? xcd * (q + 1) : r * (q + 1) + (xcd - r) * q) + off; }
        const int nig = WGM * nN, gid = wgid / nig, fm = gid * WGM, gsz = (nM - fm) < WGM ? (nM - fm) : WGM;
        u.pm = fm + ((wgid % nig) % gsz); u.pn = (wgid % nig) / gsz; u.grp = 0; u.pad_ = 0; u.A = A + (size_t)u.pm * tsA + (size_t)u.pn * acs; u.B = B + (size_t)u.pn * tsB; return true;
    }
    __device__ __forceinline__ void a_ready(const Unit&) const {}
    __device__ __forceinline__ void done(const Unit&) const {}
};

template <class Epi, class Sched, bool ALIGN_EPI = false, bool SP2 = false>
__device__ __forceinline__ void gemm_phase(PG8_LAS unsigned char* lds, const Gemm g, const Sched& S, const Epi& E) {
    int tid_raw = threadIdx.x; asm volatile("" : "+v"(tid_raw));
    const int tid = tid_raw, wid = __builtin_amdgcn_readfirstlane(tid >> 6), lane = tid & 63, wr = wid >> 2, wc = wid & 3, fr = lane & 15, fq = lane >> 4;
    const int K = g.K, nt = K / BK;
    unsigned voffA[2], voffB[2];
#pragma unroll
    for (int i = 0; i < 2; ++i) { int R, C; stage_rc(tid * 16 + i * 8192, R, C); const int Rb = Epi::PERM ? ((R & ~31) + perm32(R & 31)) : R;
        voffA[i] = (unsigned)(R * g.lda + C) * 2u; voffB[i] = (unsigned)(Rb * g.ldb + C) * 2u; }
    const size_t kstep = (size_t)(BK * 2);
    const size_t hstepA = (size_t)HALF * g.lda * 2, hstepB = (size_t)HALF * g.ldb * 2;
    const unsigned ldsw = (unsigned)wid * 1024u;
    const int aoff = lds_byte(wr * 64 + fr, fq * 8), boff = lds_byte(wc * 32 + fr, fq * 8);
#define PG8_SA(b, h) (((b) * 2 + (h)) * HTB)
#define PG8_SB(b, h) ((4 + (b) * 2 + (h)) * HTB)
#define PG8_STAGE(bufoff, gbase, voff) do { _Pragma("unroll") for (int _i = 0; _i < 2; ++_i) \
        __builtin_amdgcn_global_load_lds((const unsigned*)((const char*)(gbase) + (voff)[_i]), (PG8_LAS unsigned*)(lds + (bufoff) + ldsw + _i * 8192), 16, 0, 0); } while (0)
#define PG8_LDA(dst, b, h) do { _Pragma("unroll") for (int m = 0; m < 4; ++m) _Pragma("unroll") for (int k = 0; k < 2; ++k) dst[m][k] = *(const PG8_LAS bf16x8*)(lds + PG8_SA(b, h) + aoff + m * 2048 + k * 1024); } while (0)
#define PG8_LDB(dst, b, h) do { _Pragma("unroll") for (int n = 0; n < 2; ++n) _Pragma("unroll") for (int k = 0; k < 2; ++k) dst[n][k] = *(const PG8_LAS bf16x8*)(lds + PG8_SB(b, h) + boff + n * 2048 + k * 1024); } while (0)
#define PG8_MMA(ai, bj, At, Bt) do { __builtin_amdgcn_s_setprio(1); _Pragma("unroll") for (int m = 0; m < 4; ++m) _Pragma("unroll") for (int n = 0; n < 2; ++n) _Pragma("unroll") for (int k = 0; k < 2; ++k) \
        acc[ai][bj][m][n] = __builtin_amdgcn_mfma_f32_16x16x32_bf16(Bt[n][k], At[m][k], acc[ai][bj][m][n], 0, 0, 0); __builtin_amdgcn_s_setprio(0); } while (0)
#define PG8_WAIT_V(n) asm volatile("s_waitcnt vmcnt(" #n ")" ::: "memory")
#define PG8_WAIT_L(n) asm volatile("s_waitcnt lgkmcnt(" #n ")" ::: "memory")
#define PG8_BAR __builtin_amdgcn_s_barrier()
#define PG8_SCHED __builtin_amdgcn_sched_barrier(0)
    Unit cur, nxt; int ui = 0;
    if (!S.next(0, cur)) return;
    f32x4 acc[2][2][4][2];
#pragma unroll
    for (int a = 0; a < 2; ++a)
#pragma unroll
        for (int b = 0; b < 2; ++b)
#pragma unroll
            for (int m = 0; m < 4; ++m)
#pragma unroll
                for (int n = 0; n < 2; ++n) acc[a][b][m][n] = (f32x4){0.f, 0.f, 0.f, 0.f};
    bf16x8 At[4][2], B0[2][2], B1[2][2];
    const char* cA = cur.A; const char* cB = cur.B;
    S.a_ready(cur);
    if constexpr (SP2) {
        PG8_STAGE(PG8_SB(0, 0), cB, voffB); PG8_STAGE(PG8_SB(0, 1), cB + hstepB, voffB); PG8_STAGE(PG8_SA(0, 0), cA, voffA); PG8_STAGE(PG8_SA(0, 1), cA + hstepA, voffA);
        if (wr == 1) PG8_BAR;
        PG8_WAIT_V(2); PG8_BAR;
        PG8_STAGE(PG8_SB(1, 0), cB + kstep, voffB); PG8_STAGE(PG8_SA(1, 0), cA + kstep, voffA); PG8_STAGE(PG8_SB(1, 1), cB + hstepB + kstep, voffB);
        PG8_WAIT_V(6); PG8_BAR;
    } else {
        PG8_STAGE(PG8_SB(0, 0), cB, voffB); PG8_STAGE(PG8_SA(0, 0), cA, voffA); PG8_STAGE(PG8_SB(0, 1), cB + hstepB, voffB); PG8_STAGE(PG8_SA(0, 1), cA + hstepA, voffA);
        if (wr == 1) PG8_BAR;
        PG8_WAIT_V(4); PG8_BAR;
        PG8_STAGE(PG8_SB(1, 0), cB + kstep, voffB); PG8_STAGE(PG8_SA(1, 0), cA + kstep, voffA); PG8_STAGE(PG8_SB(1, 1), cB + hstepB + kstep, voffB);
        PG8_WAIT_V(6); PG8_BAR;
    }
    for (;;) {
        const bool has_next = S.next(ui + 1, nxt);
        const char* nA = has_next ? nxt.A : cA; const char* nB = has_next ? nxt.B : cB;
        for (int t = 0; t < nt; t += 2) {
            const bool last = (t == nt - 2);
            const char* a1 = cA + (size_t)(t + 1) * kstep;
            const char* a2 = last ? nA : cA + (size_t)(t + 2) * kstep; const char* b2 = last ? nB : cB + (size_t)(t + 2) * kstep;
            const char* a3 = a2 + kstep; const char* b3 = b2 + kstep;
            if (last && has_next) S.a_ready(nxt);
            if constexpr (SP2) {
            PG8_LDB(B0, 0, 0); PG8_LDB(B1, 0, 1); PG8_SCHED; PG8_LDA(At, 0, 0); PG8_STAGE(PG8_SA(1, 1), a1 + hstepA, voffA);
            PG8_WAIT_V(8); PG8_WAIT_L(0); PG8_BAR; PG8_MMA(0, 0, At, B0); PG8_MMA(0, 1, At, B1); PG8_BAR; PG8_SCHED;
            PG8_LDA(At, 0, 1); PG8_STAGE(PG8_SB(0, 0), b2, voffB); PG8_STAGE(PG8_SB(0, 1), b2 + hstepB, voffB); PG8_STAGE(PG8_SA(0, 0), a2, voffA);
            PG8_WAIT_V(8); PG8_WAIT_L(0); PG8_BAR; PG8_MMA(1, 0, At, B0); PG8_MMA(1, 1, At, B1); PG8_BAR; PG8_SCHED;
            PG8_LDB(B0, 1, 0); PG8_LDB(B1, 1, 1); PG8_SCHED; PG8_LDA(At, 1, 0); PG8_STAGE(PG8_SA(0, 1), a2 + hstepA, voffA);
            PG8_WAIT_V(8); PG8_WAIT_L(0); PG8_BAR; PG8_MMA(0, 0, At, B0); PG8_MMA(0, 1, At, B1); PG8_BAR; PG8_SCHED;
            PG8_LDA(At, 1, 1); PG8_STAGE(PG8_SB(1, 0), b3, voffB); PG8_STAGE(PG8_SB(1, 1), b3 + hstepB, voffB); PG8_STAGE(PG8_SA(1, 0), a3, voffA);
            PG8_WAIT_V(8); PG8_WAIT_L(0); PG8_BAR; PG8_MMA(1, 0, At, B0); PG8_MMA(1, 1, At, B1); PG8_BAR; PG8_SCHED;
            } else {
            PG8_LDB(B0, 0, 0); PG8_SCHED; PG8_LDA(At, 0, 0); PG8_STAGE(PG8_SA(1, 1), a1 + hstepA, voffA);
            PG8_WAIT_L(8); PG8_BAR; PG8_WAIT_L(0); PG8_MMA(0, 0, At, B0); PG8_BAR; PG8_SCHED;
            PG8_LDB(B1, 0, 1); PG8_STAGE(PG8_SB(0, 0), b2, voffB);
            PG8_BAR; PG8_WAIT_L(0); PG8_MMA(0, 1, At, B1); PG8_BAR;
            PG8_LDA(At, 0, 1); PG8_STAGE(PG8_SA(0, 0), a2, voffA);
            PG8_BAR; PG8_WAIT_L(0); PG8_MMA(1, 0, At, B0); PG8_BAR; PG8_SCHED;
            PG8_STAGE(PG8_SB(0, 1), b2 + hstepB, voffB);
            PG8_WAIT_V(6); PG8_BAR; PG8_MMA(1, 1, At, B1); PG8_BAR;
            PG8_LDB(B0, 1, 0); PG8_SCHED; PG8_LDA(At, 1, 0); PG8_STAGE(PG8_SA(0, 1), a2 + hstepA, voffA);
            PG8_WAIT_L(8); PG8_BAR; PG8_WAIT_L(0); PG8_MMA(0, 0, At, B0); PG8_BAR; PG8_SCHED;
            PG8_LDB(B1, 1, 1); PG8_STAGE(PG8_SB(1, 0), b3, voffB);
            PG8_BAR; PG8_WAIT_L(0); PG8_MMA(0, 1, At, B1); PG8_BAR;
            PG8_LDA(At, 1, 1); PG8_STAGE(PG8_SA(1, 0), a3, voffA);
            PG8_BAR; PG8_WAIT_L(0); PG8_MMA(1, 0, At, B0); PG8_BAR; PG8_SCHED;
            PG8_STAGE(PG8_SB(1, 1), b3 + hstepB, voffB);
            PG8_WAIT_V(6); PG8_BAR; PG8_MMA(1, 1, At, B1); PG8_BAR;
            }
        }
        if constexpr (ALIGN_EPI) { if (wr == 0) PG8_BAR; }
        if constexpr (!Epi::AFTER_DRAIN) { E(acc, cur, wr, wc, fr, fq); S.done(cur); }
        if (!has_next) break;
#pragma unroll
        for (int a = 0; a < 2; ++a)
#pragma unroll
            for (int b = 0; b < 2; ++b)
#pragma unroll
                for (int m = 0; m < 4; ++m)
#pragma unroll
                    for (int n = 0; n < 2; ++n) acc[a][b][m][n] = (f32x4){0.f, 0.f, 0.f, 0.f};
        cur = nxt; cA = nA; cB = nB; ++ui;
        if constexpr (ALIGN_EPI) { if (wr == 1) PG8_BAR; }
    }
    PG8_WAIT_V(0);
    if constexpr (!ALIGN_EPI) { if (wr == 0) PG8_BAR; }
    PG8_BAR;
    if constexpr (Epi::AFTER_DRAIN) { E.fused(acc, cur, wr, wc, fr, fq, lds, wid, lane); S.done(cur); }
#undef PG8_SA
#undef PG8_SB
#undef PG8_STAGE
#undef PG8_LDA
#undef PG8_LDB
#undef PG8_MMA
#undef PG8_WAIT_V
#undef PG8_WAIT_L
#undef PG8_BAR
#undef PG8_SCHED
}
}
template <class T> __device__ __forceinline__ T* uni_ptr(T* p) {
    unsigned long long v = (unsigned long long)p; unsigned lo = __builtin_amdgcn_readfirstlane((unsigned)v), hi = __builtin_amdgcn_readfirstlane((unsigned)(v >> 32));
    unsigned long long r = ((unsigned long long)hi << 32) | lo; asm volatile("" : "+s"(r)); return (T*)r; }
__device__ __forceinline__ int rfl(int x) { int t = __builtin_amdgcn_readfirstlane(x); asm volatile("" : "+s"(t)); return t; }
namespace pg8 {
__device__ __forceinline__ unsigned cvt_pk_bf16(float lo, float hi) { unsigned r; asm volatile("v_cvt_pk_bf16_f32 %0, %1, %2" : "=v"(r) : "v"(lo), "v"(hi)); return r; }
struct EpiF32 {
    static constexpr bool PERM = false, AFTER_DRAIN = false;
    float* C; int ldc, Mreal, Nreal;
    __device__ __forceinline__ void operator()(const f32x4 (&acc)[2][2][4][2], const Unit& u, int wr, int wc, int fr, int fq) const {
        const int row0 = u.pm * BM + wr * 64 + fr, col0 = u.pn * BM + wc * 32 + 4 * fq;
#pragma unroll
        for (int ai = 0; ai < 2; ++ai)
#pragma unroll
            for (int m = 0; m < 4; ++m) { const int r = row0 + ai * HALF + m * 16; if (r < Mreal) { float* rowp = C + (size_t)r * ldc + col0;
#pragma unroll
                for (int bj = 0; bj < 2; ++bj)
#pragma unroll
                    for (int n = 0; n < 2; ++n) { const int c = col0 + bj * HALF + n * 16; if (c < Nreal) *(f32x4*)(rowp + bj * HALF + n * 16) = acc[ai][bj][m][n]; } } }
    }
};
struct EpiBf16Plain {
    static constexpr bool PERM = true, AFTER_DRAIN = false;
    bf16_t* O; int ldc;
    __device__ __forceinline__ void operator()(const f32x4 (&acc)[2][2][4][2], const Unit& u, int wr, int wc, int fr, int fq) const {
        const int row0 = u.pm * BM + wr * 64 + fr, col0 = u.pn * BM + wc * 32 + 8 * fq;
#pragma unroll
        for (int ai = 0; ai < 2; ++ai)
#pragma unroll
            for (int m = 0; m < 4; ++m) { bf16_t* rowp = O + (size_t)(row0 + ai * HALF + m * 16) * ldc + col0;
#pragma unroll
                for (int bj = 0; bj < 2; ++bj) { const f32x4 v0 = acc[ai][bj][m][0], v1 = acc[ai][bj][m][1]; u32x4 w;
                    w.x = cvt_pk_bf16(v0[0], v0[1]); w.y = cvt_pk_bf16(v0[2], v0[3]); w.z = cvt_pk_bf16(v1[0], v1[1]); w.w = cvt_pk_bf16(v1[2], v1[3]);
                    *(u32x4*)(rowp + bj * HALF) = w; } }
    }
};
struct EpiLru {
    static constexpr bool PERM = false, AFTER_DRAIN = false;
    const float* ba; const float* bx; const float* spl; const float* XC; float* AT; float* BT; int Mreal;
    __device__ __forceinline__ void operator()(const f32x4 (&acc)[2][2][4][2], const Unit& u, int wr, int wc, int fr, int fq) const {
        const int row0 = u.pm * BM + wr * 64 + fr, ch0 = u.pn * 128 + wc * 32 + 4 * fq;
#pragma unroll
        for (int n = 0; n < 2; ++n) { const int c = ch0 + 16 * n; const f32x4 ba4 = *(const f32x4*)(ba + c), bx4 = *(const f32x4*)(bx + c), sp4 = *(const f32x4*)(spl + c);
#pragma unroll
            for (int ai = 0; ai < 2; ++ai)
#pragma unroll
                for (int m = 0; m < 4; ++m) { const int r = row0 + ai * HALF + m * 16; if (r < Mreal) { const f32x4 xc = *(const f32x4*)(XC + (size_t)r * 512 + c); const f32x4 ga = acc[ai][0][m][n] + ba4, gx = acc[ai][1][m][n] + bx4; f32x4 at, bt;
#pragma unroll
                    for (int i = 0; i < 4; ++i) { const float gate_a = 1.f / (1.f + __expf(-ga[i])), gate_x = 1.f / (1.f + __expf(-gx[i])); const float la = gate_a * sp4[i]; at[i] = __expf(la); bt[i] = sqrtf(-expm1f(2.f * la)) * (gate_x * xc[i]); }
                    *(f32x4*)(AT + (size_t)r * 512 + c) = at; *(f32x4*)(BT + (size_t)r * 512 + c) = bt; } } }
    }
};
struct GroupOrder {
    const PG8_LAS Op* tab; int ng, nM, G, c; size_t tsA, tsB;
    __device__ __forceinline__ bool next(int i, Unit& u) const {
        int L = i * G + c, g = 0;
        for (; g < ng; ++g) { const int cnt = nM * (__builtin_amdgcn_readfirstlane(tab[g].i5) >> 8); if (L < cnt) break; L -= cnt; }
        if (g >= ng) return false;
        u.pm = L % nM; u.pn = L / nM; u.grp = g; u.pad_ = 0;
        u.A = (const char*)uni_ptr(tab[g].a) + (size_t)u.pm * tsA; u.B = (const char*)uni_ptr(tab[g].b) + (size_t)u.pn * tsB; return true;
    }
    __device__ __forceinline__ void a_ready(const Unit&) const {}
    __device__ __forceinline__ void done(const Unit&) const {}
};
struct EpiGroup {
    static constexpr bool PERM = true, AFTER_DRAIN = false;
    const PG8_LAS Op* tab; int Mreal;
    __device__ __forceinline__ void operator()(const f32x4 (&acc)[2][2][4][2], const Unit& u, int wr, int wc, int fr, int fq) const {
        const int ldc = rfl(tab[u.grp].i4), Nreal = rfl(tab[u.grp].i0), fl = rfl(tab[u.grp].i6);
        if (fl & 1) { const EpiBf16Plain E{(bf16_t*)uni_ptr(tab[u.grp].o0), ldc}; E(acc, u, wr, wc, fr, fq); return; }
        float* C = uni_ptr(tab[u.grp].o0); const int row0 = u.pm * BM + wr * 64 + fr, col0 = u.pn * BM + wc * 32 + 8 * fq;
#pragma unroll
        for (int ai = 0; ai < 2; ++ai)
#pragma unroll
            for (int m = 0; m < 4; ++m) { const int r = row0 + ai * HALF + m * 16; if (r < Mreal) { float* rowp = C + (size_t)r * ldc + col0;
#pragma unroll
                for (int bj = 0; bj < 2; ++bj) { if (col0 + bj * HALF < Nreal) { *(f32x4*)(rowp + bj * HALF) = acc[ai][bj][m][0]; *(f32x4*)(rowp + bj * HALF + 4) = acc[ai][bj][m][1]; } } } }
    }
};
}

#define XB_TMO      128
#define XB_XCNT(j)  (256  + 64 * (j))
#define XB_XSUB(j)  (1280 + 64 * (j))
#define XB_XGEN(j)  (2304 + 64 * (j))
#define XB_TOP      3328
#define XB_TOPGEN   3392
#define XCD_BAR_WORDS 3456
#define XB_SPIN_CAP (1u << 18)
#define LAS __attribute__((address_space(3)))
__device__ __forceinline__ unsigned xb_ld(unsigned* p)              { return __hip_atomic_load(p, __ATOMIC_RELAXED, __HIP_MEMORY_SCOPE_AGENT); }
__device__ __forceinline__ unsigned xb_add(unsigned* p, unsigned v) { return __hip_atomic_fetch_add(p, v, __ATOMIC_RELAXED, __HIP_MEMORY_SCOPE_AGENT); }
__device__ __forceinline__ unsigned xb_xcc_id() { return (unsigned)__builtin_amdgcn_s_getreg((3 << 11) | 20) & 0xFu; }
#define XB_SPIN(cond, bar) do { unsigned _sp = 0; while (cond) { __builtin_amdgcn_s_sleep(1); \
    if ((++_sp & 255u) == 0u) { if (xb_ld(&(bar)[XB_TMO])) break; if (_sp > XB_SPIN_CAP) { atomicAdd(&(bar)[XB_TMO], 1u); break; } } } } while (0)
struct XcdBarrier { unsigned* bar; unsigned x; volatile LAS unsigned* st; };
__device__ __forceinline__ XcdBarrier xcd_barrier_post(unsigned* bar, volatile LAS unsigned* st) {
    XcdBarrier b; b.bar = bar; b.x = xb_xcc_id(); b.st = st;
    if (threadIdx.x == 0) (void)xb_add(&bar[XB_XCNT(b.x)], 1u);
    return b;
}
__device__ __forceinline__ void xcd_barrier_complete(unsigned* bar, unsigned x, unsigned& nloc, unsigned& nx) {
    const unsigned G = gridDim.x * gridDim.y * gridDim.z;
    unsigned sum, cnt, mine, sp = 0u;
    for (;;) {
        sum = 0u; cnt = 0u; mine = 0u;
#pragma unroll
        for (unsigned j = 0; j < 16; ++j) { const unsigned c = xb_ld(&bar[XB_XCNT(j)]); sum += c; cnt += (c > 0u) ? 1u : 0u; mine = (j == x) ? c : mine; }
        if (sum == G) break;
        __builtin_amdgcn_s_sleep(1);
        if ((++sp & 255u) == 0u) { if (xb_ld(&bar[XB_TMO])) break; if (sp > XB_SPIN_CAP) { atomicAdd(&bar[XB_TMO], 1u); break; } }
    }
    nloc = mine > 0u ? mine : 1u; nx = cnt > 0u ? cnt : 1u;
}
__device__ __forceinline__ void xcd_barrier(const XcdBarrier& b) {
    asm volatile("s_waitcnt vmcnt(0)" ::: "memory");
    __syncthreads();
    if (threadIdx.x == 0) {
        unsigned* bar = b.bar;
        __builtin_amdgcn_s_waitcnt(0);
        unsigned nloc = b.st[0], nx = b.st[1];
        if (nloc == 0u) { xcd_barrier_complete(bar, b.x, nloc, nx); b.st[0] = nloc; b.st[1] = nx; }
        const unsigned old = xb_add(&bar[XB_XSUB(b.x)], 1u);
        const unsigned gen = old / nloc;
        if (old + 1u == (gen + 1u) * nloc) {
            __builtin_amdgcn_fence(__ATOMIC_RELEASE, "agent");
            asm volatile("s_waitcnt vmcnt(0)" ::: "memory");
            const unsigned og = xb_add(&bar[XB_TOP], 1u);
            const unsigned tg = og / nx;
            if (og + 1u == (tg + 1u) * nx) xb_add(&bar[XB_TOPGEN], 1u);
            else XB_SPIN(xb_ld(&bar[XB_TOPGEN]) == tg, bar);
            __builtin_amdgcn_fence(__ATOMIC_ACQUIRE, "agent");
            xb_add(&bar[XB_XGEN(b.x)], 1u);
            asm volatile("s_waitcnt vmcnt(0)" ::: "memory");
        } else {
            XB_SPIN(xb_ld(&bar[XB_XGEN(b.x)]) == gen, bar);
            __builtin_amdgcn_fence(__ATOMIC_ACQUIRE, "agent");
            asm volatile("s_waitcnt vmcnt(0)" ::: "memory");
        }
    }
    __syncthreads();
}

namespace fk {
#define GAS __attribute__((address_space(1)))
typedef unsigned u32x4 __attribute__((ext_vector_type(4)));
typedef unsigned u32x2 __attribute__((ext_vector_type(2)));
typedef float f32x4 __attribute__((ext_vector_type(4)));
typedef float f32x2 __attribute__((ext_vector_type(2)));
typedef __bf16 bf2 __attribute__((ext_vector_type(2)));
typedef unsigned short bf16_t;
__device__ __forceinline__ float bflo(unsigned u) { return __uint_as_float(u << 16); }
__device__ __forceinline__ float bfhi(unsigned u) { return __uint_as_float(u & 0xffff0000u); }
__device__ __forceinline__ float dot2(unsigned a, unsigned b, float c) { return __builtin_amdgcn_fdot2_f32_bf16(__builtin_bit_cast(bf2, a), __builtin_bit_cast(bf2, b), c, false); }
__device__ __forceinline__ unsigned pk_bf16(float lo, float hi) { unsigned r; asm volatile("v_cvt_pk_bf16_f32 %0, %1, %2" : "=v"(r) : "v"(lo), "v"(hi)); return r; }
template <int CTRL> __device__ __forceinline__ float dppf(float v) { return __int_as_float(__builtin_amdgcn_update_dpp(0, __float_as_int(v), CTRL, 0xf, 0xf, true)); }
__device__ __forceinline__ float row_max16(float v) { v = fmaxf(v, dppf<0xB1>(v)); v = fmaxf(v, dppf<0x4E>(v)); v = fmaxf(v, dppf<0x141>(v)); v = fmaxf(v, dppf<0x140>(v)); return v; }
__device__ __forceinline__ float row_sum8(float v) { v += dppf<0xB1>(v); v += dppf<0x4E>(v); v += dppf<0x141>(v); return v; }
__device__ __forceinline__ float row_sum16(float v) { v += dppf<0xB1>(v); v += dppf<0x4E>(v); v += dppf<0x141>(v); v += dppf<0x140>(v); return v; }
__device__ __forceinline__ float shx(float v, int m, int lane) { return __int_as_float(__builtin_amdgcn_ds_bpermute((lane ^ m) << 2, __float_as_int(v))); }
__device__ __forceinline__ float wave_sum(float v, int lane) { v = row_sum16(v); v += shx(v, 16, lane); v += shx(v, 32, lane); return v; }
__device__ __forceinline__ float gelu_tanh(float x) { return 0.5f * x * (1.f + tanhf(0.7978845608028654f * (x + 0.044715f * x * x * x))); }
#define FK_NEG (-3.0e38f)

template <int CTRL> __device__ __forceinline__ int dppi(int v) { return __builtin_amdgcn_update_dpp(0, v, CTRL, 0xf, 0xf, true); }
__device__ __forceinline__ int row_min16i(int v) { v = min(v, dppi<0xB1>(v)); v = min(v, dppi<0x4E>(v)); v = min(v, dppi<0x141>(v)); v = min(v, dppi<0x140>(v)); return v; }
#define FK_CE(a, b) do { const bool sw_ = v[b] > v[a]; const float tv_ = sw_ ? v[b] : v[a]; v[b] = sw_ ? v[a] : v[b]; v[a] = tv_; const int ti_ = sw_ ? id[b] : id[a]; id[b] = sw_ ? id[a] : id[b]; id[a] = ti_; } while (0)
#define FK_SORT8(v, id) do { FK_CE2(v, id, 0, 1); FK_CE2(v, id, 2, 3); FK_CE2(v, id, 4, 5); FK_CE2(v, id, 6, 7); FK_CE2(v, id, 0, 2); FK_CE2(v, id, 1, 3); FK_CE2(v, id, 4, 6); FK_CE2(v, id, 5, 7); FK_CE2(v, id, 1, 2); FK_CE2(v, id, 5, 6); \
    FK_CE2(v, id, 0, 4); FK_CE2(v, id, 1, 5); FK_CE2(v, id, 2, 6); FK_CE2(v, id, 3, 7); FK_CE2(v, id, 2, 4); FK_CE2(v, id, 3, 5); FK_CE2(v, id, 1, 2); FK_CE2(v, id, 3, 4); FK_CE2(v, id, 5, 6); } while (0)
#define FK_CE2(v, id, a, b) do { const bool sw_ = v[b] > v[a]; const float tv_ = sw_ ? v[b] : v[a]; v[b] = sw_ ? v[a] : v[b]; v[a] = tv_; const int ti_ = sw_ ? id[b] : id[a]; id[b] = sw_ ? id[a] : id[b]; id[a] = ti_; } while (0)
__device__ __forceinline__ void top16_of_128_x2(float (&v)[8], int (&id)[8], float (&u)[8], int (&jd)[8], int lane16, float& rv1, int& ri1, float& rv2, int& ri2) {
    FK_SORT8(v, id); FK_SORT8(u, jd);
    rv1 = FK_NEG; ri1 = 0; rv2 = FK_NEG; ri2 = 0;
#pragma unroll
    for (int r = 0; r < 16; ++r) {
        const float wm = row_max16(v[0]), xm = row_max16(u[0]);
        const int cand = (v[0] == wm) ? id[0] : 0x7fffffff, dand = (u[0] == xm) ? jd[0] : 0x7fffffff;
        const int sel = row_min16i(cand), tel = row_min16i(dand);
        const bool mine = (cand == sel), nine = (dand == tel);
        if (lane16 == r) { rv1 = wm; ri1 = sel; rv2 = xm; ri2 = tel; }
#pragma unroll
        for (int i = 0; i < 7; ++i) { v[i] = mine ? v[i + 1] : v[i]; id[i] = mine ? id[i + 1] : id[i]; u[i] = nine ? u[i + 1] : u[i]; jd[i] = nine ? jd[i + 1] : jd[i]; }
        v[7] = mine ? FK_NEG : v[7]; u[7] = nine ? FK_NEG : u[7];
    }
}
__device__ __forceinline__ int fk_key(float x, int lane16) { int k = __float_as_int(x); k ^= (k >> 31) & 0x7fffffff; return (k & ~15) | (15 - lane16); }
__device__ __forceinline__ float fk_unkey(int k) { k &= ~15; k ^= (k >> 31) & 0x7fffffff; return __int_as_float(k); }
__device__ __forceinline__ int row_max16i(int v) { v = max(v, dppi<0xB1>(v)); v = max(v, dppi<0x4E>(v)); v = max(v, dppi<0x141>(v)); v = max(v, dppi<0x140>(v)); return v; }
__device__ __forceinline__ void topk_phase(const GAS float* __restrict__ SC, const GAS bf16_t* __restrict__ Q, const GAS float* __restrict__ KSUM, GAS float* __restrict__ GATE, GAS int* __restrict__ EIDX, int nitems,
                                           LAS unsigned char* lds, int wid, int lane, int wave_gid, int nwaves) {
    LAS unsigned char* wb = lds + wid * 6144;
    LAS int* IDS1 = (LAS int*)wb; LAS int* IDS2 = (LAS int*)(wb + 2048); LAS int* LC1 = (LAS int*)(wb + 4096); LAS int* LC2 = (LAS int*)(wb + 4352); LAS int* CI = (LAS int*)(wb + 4608);
    LAS float* xv = (LAS float*)(wb + 4864); LAS int* DUMP = (LAS int*)(wb + 5120) + lane; LAS int* WL1 = (LAS int*)(wb + 5376); LAS int* WL2 = (LAS int*)(wb + 5632);
    const int lane16 = lane & 15, rowbase = lane & 48;
    for (int wi = wave_gid; wi * 4 < nitems; wi += nwaves) {
        const int it = wi * 4 + (lane >> 4); const int h = it & 7;
        const GAS u32x4* qp = (const GAS u32x4*)(Q + (size_t)it * 256 + 16 * lane16); const u32x4 qa = qp[0], qb = qp[1];
        float qs = 0.f, qq = 0.f;
#pragma unroll
        for (int i = 0; i < 4; ++i) { const float a = bflo(qa[i]), b = bfhi(qa[i]), c = bflo(qb[i]), d = bfhi(qb[i]); qs += (a + b) + (c + d); qq += (a * a + b * b) + (c * c + d * d); }
        const float mu = row_sum16(qs) * (1.f / 256.f); const float var = fmaxf(row_sum16(qq) * (1.f / 256.f) - mu * mu, 0.f); const float rs = 1.f / sqrtf(var + 1e-5f);
        float v[8], u[8]; int id[8], jd[8];
        { const GAS float* sp = SC + (size_t)it * 256 + 8 * lane16; const GAS float* kp = KSUM + h * 256 + 8 * lane16; const f32x4 s0 = *(const GAS f32x4*)sp, s1 = *(const GAS f32x4*)(sp + 4), k0 = *(const GAS f32x4*)kp, k1 = *(const GAS f32x4*)(kp + 4);
          const f32x4 t0 = *(const GAS f32x4*)(sp + 128), t1 = *(const GAS f32x4*)(sp + 132), m0 = *(const GAS f32x4*)(kp + 128), m1 = *(const GAS f32x4*)(kp + 132);
#pragma unroll
          for (int i = 0; i < 4; ++i) { v[i] = rs * (s0[i] - mu * k0[i]); v[4 + i] = rs * (s1[i] - mu * k1[i]); u[i] = rs * (t0[i] - mu * m0[i]); u[4 + i] = rs * (t1[i] - mu * m1[i]);
              id[i] = 8 * lane16 + i; id[4 + i] = 8 * lane16 + 4 + i; jd[i] = 8 * lane16 + i; jd[4 + i] = 8 * lane16 + 4 + i; } }
        FK_SORT8(v, id); FK_SORT8(u, jd);
#pragma unroll
        for (int i = 0; i < 8; ++i) { IDS1[lane * 8 + i] = id[i]; IDS2[lane * 8 + i] = jd[i]; }
        float rv1 = FK_NEG, rv2 = FK_NEG; int wl1 = 0, wl2 = 0, cn1 = 0, cn2 = 0;
#pragma unroll
        for (int r = 0; r < 16; ++r) {
            const int key1 = fk_key(v[0], lane16), key2 = fk_key(u[0], lane16);
            const int wm1 = row_max16i(key1), wm2 = row_max16i(key2);
            const bool mine = (key1 == wm1), nine = (key2 == wm2);
            if (lane16 == r) { rv1 = fk_unkey(wm1); wl1 = 15 - (wm1 & 15); rv2 = fk_unkey(wm2); wl2 = 15 - (wm2 & 15); }
            *(mine ? LC1 + rowbase + r : DUMP) = cn1; *(nine ? LC2 + rowbase + r : DUMP) = cn2;
#pragma unroll
            for (int i = 0; i < 7; ++i) { v[i] = mine ? v[i + 1] : v[i]; u[i] = nine ? u[i + 1] : u[i]; }
            v[7] = mine ? FK_NEG : v[7]; u[7] = nine ? FK_NEG : u[7]; cn1 += mine ? 1 : 0; cn2 += nine ? 1 : 0;
        }
        xv[lane] = rv2; WL1[lane] = wl1; WL2[lane] = wl2;
        float c[16];
        { const LAS f32x4* xp = (const LAS f32x4*)(xv + rowbase);
#pragma unroll
          for (int q = 0; q < 4; ++q) { const f32x4 t = xp[q]; c[4 * q] = rv1 + t.x; c[4 * q + 1] = rv1 + t.y; c[4 * q + 2] = rv1 + t.z; c[4 * q + 3] = rv1 + t.w; } }
        int p = 0, wli = 0; float sc = FK_NEG;
#pragma unroll
        for (int r = 0; r < 16; ++r) {
            const int key = fk_key(c[0], lane16); const int wm = row_max16i(key); const bool mine = (key == wm);
            if (lane16 == r) { sc = fk_unkey(wm); wli = 15 - (wm & 15); }
            *(mine ? CI + rowbase + r : DUMP) = p;
#pragma unroll
            for (int i = 0; i < 15; ++i) c[i] = mine ? c[i + 1] : c[i];
            c[15] = mine ? FK_NEG : c[15]; p += mine ? 1 : 0;
        }
        const int i1 = wli & 15, j2 = CI[rowbase + lane16] & 15;
        const int e1 = IDS1[(rowbase + (WL1[rowbase + i1] & 15)) * 8 + (LC1[rowbase + i1] & 7)], e2 = IDS2[(rowbase + (WL2[rowbase + j2] & 15)) * 8 + (LC2[rowbase + j2] & 7)];
        const float mx = fk_unkey(row_max16i(fk_key(sc, 0))); const float ex = __expf(sc - mx); const float den = row_sum16(ex);
        GATE[(size_t)it * 16 + lane16] = ex / den; EIDX[(size_t)it * 16 + lane16] = (e1 & 127) * 128 + (e2 & 127);
    }
}

__device__ __forceinline__ f32x2 fp8lo(unsigned w) { return __builtin_amdgcn_cvt_pk_f32_fp8((int)w, false); }
__device__ __forceinline__ f32x2 fp8hi(unsigned w) { return __builtin_amdgcn_cvt_pk_f32_fp8((int)w, true); }
__device__ __forceinline__ void act_phase(const GAS bf16_t* __restrict__ XB, const GAS unsigned char* __restrict__ U8, const GAS float* __restrict__ GATE, const GAS int* __restrict__ EIDX, GAS float* __restrict__ COEF, int nitems,
                                          int lane, int wave_gid, int nwaves) {
    int it = wave_gid; if (it >= nitems) return;
    u32x4 uc[16], un[16], xac, xbc, xan, xbn;
    int evc = EIDX[(size_t)it * 16 + (lane & 15)];
    { const GAS u32x4* xp = (const GAS u32x4*)(XB + (size_t)(it >> 3) * 1024 + 16 * lane); xac = xp[0]; xbc = xp[1]; }
#pragma unroll
    for (int k = 0; k < 16; ++k) uc[k] = *(const GAS u32x4*)(U8 + (size_t)__builtin_amdgcn_readlane(evc, k) * 1024 + 16 * lane);
    int itn = it + nwaves; int evn = (itn < nitems) ? EIDX[(size_t)itn * 16 + (lane & 15)] : 0;
    for (;;) {
        const bool hasn = itn < nitems;
        if (hasn) {
            const GAS u32x4* xp = (const GAS u32x4*)(XB + (size_t)(itn >> 3) * 1024 + 16 * lane); xan = xp[0]; xbn = xp[1];
#pragma unroll
            for (int k = 0; k < 16; ++k) un[k] = *(const GAS u32x4*)(U8 + (size_t)__builtin_amdgcn_readlane(evn, k) * 1024 + 16 * lane);
        }
        const int itnn = itn + nwaves; const int evnn = (itnn < nitems) ? EIDX[(size_t)itnn * 16 + (lane & 15)] : 0;
        const float gt = GATE[(size_t)it * 16 + (lane >> 2)];
        float x[16];
#pragma unroll
        for (int i = 0; i < 4; ++i) { x[2 * i] = bflo(xac[i]); x[2 * i + 1] = bfhi(xac[i]); x[8 + 2 * i] = bflo(xbc[i]); x[8 + 2 * i + 1] = bfhi(xbc[i]); }
        float a[16];
#pragma unroll
        for (int k = 0; k < 16; ++k) { const u32x4 uw = uc[k]; float s = 0.f;
#pragma unroll
            for (int d = 0; d < 4; ++d) { const f32x2 lo = fp8lo(uw[d]), hi = fp8hi(uw[d]); s = fmaf(lo.x, x[4 * d], s); s = fmaf(lo.y, x[4 * d + 1], s); s = fmaf(hi.x, x[4 * d + 2], s); s = fmaf(hi.y, x[4 * d + 3], s); }
            asm volatile("" : "+v"(s)); a[k] = s; }
#pragma unroll
        for (int k = 0; k < 8; ++k) { const bool hi = lane & 32; const float send = hi ? a[k] : a[k + 8], keep = hi ? a[k + 8] : a[k]; a[k] = keep + shx(send, 32, lane); }
#pragma unroll
        for (int k = 0; k < 4; ++k) { const bool hi = lane & 16; const float send = hi ? a[k] : a[k + 4], keep = hi ? a[k + 4] : a[k]; a[k] = keep + shx(send, 16, lane); }
#pragma unroll
        for (int k = 0; k < 2; ++k) { const bool hi = lane & 8; const float send = hi ? a[k] : a[k + 2], keep = hi ? a[k + 2] : a[k]; a[k] = keep + shx(send, 8, lane); }
        { const bool hi = lane & 4; const float send = hi ? a[0] : a[1], keep = hi ? a[1] : a[0]; a[0] = keep + shx(send, 4, lane); }
        float dsum = a[0]; dsum += shx(dsum, 2, lane); dsum += shx(dsum, 1, lane);
        if ((lane & 3) == 0) COEF[(size_t)it * 16 + (lane >> 2)] = gt * gelu_tanh(dsum * (1.f / 128.f));
        if (!hasn) break;
#pragma unroll
        for (int k = 0; k < 16; ++k) uc[k] = un[k];
        xac = xan; xbc = xbn; evc = evn; evn = evnn; it = itn; itn = itnn;
    }
}

__device__ __forceinline__ void outln_phase(const GAS float* COEF, const GAS int* EIDX, const GAS unsigned char* V8,     const GAS float* __restrict__ lg, const GAS float* __restrict__ lb, GAS float* X, GAS bf16_t* XB, int nrows,
                                            int lane, int wave_gid, int nwaves) {
    const float alpha = 1.6817928305074292f;
    int row = wave_gid; if (row >= nrows) return;
    u32x4 vc[16], vn[16];
    float cf0 = COEF[(size_t)row * 128 + lane] * (1.f / 64.f), cf1 = COEF[(size_t)row * 128 + 64 + lane] * (1.f / 64.f); int ev0 = EIDX[(size_t)row * 128 + lane], ev1 = EIDX[(size_t)row * 128 + 64 + lane];
#define OUT_LOADCH(dst, evreg, base) do { _Pragma("unroll") for (int k_ = 0; k_ < 16; ++k_) dst[k_] = *(const GAS u32x4*)(V8 + (size_t)__builtin_amdgcn_readlane(evreg, (base) + k_) * 1024 + 16 * lane); } while (0)
#define OUT_COMPCH(src, cfreg, base) do { _Pragma("unroll") for (int k_ = 0; k_ < 16; ++k_) { const float c_ = __int_as_float(__builtin_amdgcn_readlane(__float_as_int(cfreg), (base) + k_)); const u32x4 vw_ = src[k_]; \
        _Pragma("unroll") for (int d_ = 0; d_ < 4; ++d_) { const f32x2 lo_ = fp8lo(vw_[d_]), hi_ = fp8hi(vw_[d_]); acc[4 * d_] = fmaf(c_, lo_.x, acc[4 * d_]); acc[4 * d_ + 1] = fmaf(c_, lo_.y, acc[4 * d_ + 1]); acc[4 * d_ + 2] = fmaf(c_, hi_.x, acc[4 * d_ + 2]); acc[4 * d_ + 3] = fmaf(c_, hi_.y, acc[4 * d_ + 3]); } \
        _Pragma("unroll") for (int p_ = 0; p_ < 16; ++p_) asm volatile("" : "+v"(acc[p_]));     \
        } } while (0)
    for (;;) {
        OUT_LOADCH(vc, ev0, 0);
        const int rown = row + nwaves; const bool hasn = rown < nrows;
        float ncf0 = 0.f, ncf1 = 0.f; int nev0 = 0, nev1 = 0;
        if (hasn) { ncf0 = COEF[(size_t)rown * 128 + lane] * (1.f / 64.f); ncf1 = COEF[(size_t)rown * 128 + 64 + lane] * (1.f / 64.f); nev0 = EIDX[(size_t)rown * 128 + lane]; nev1 = EIDX[(size_t)rown * 128 + 64 + lane]; }
        float acc[16];
#pragma unroll
        for (int k = 0; k < 16; ++k) acc[k] = 0.f;
#define OUT_FENCE() asm volatile("" ::: "memory")
        OUT_LOADCH(vn, ev0, 16); OUT_FENCE(); OUT_COMPCH(vc, cf0, 0); OUT_FENCE();
        OUT_LOADCH(vc, ev0, 32); OUT_FENCE(); OUT_COMPCH(vn, cf0, 16); OUT_FENCE();
        OUT_LOADCH(vn, ev0, 48); OUT_FENCE(); OUT_COMPCH(vc, cf0, 32); OUT_FENCE();
        OUT_LOADCH(vc, ev1, 0);  OUT_FENCE(); OUT_COMPCH(vn, cf0, 48); OUT_FENCE();
        OUT_LOADCH(vn, ev1, 16); OUT_FENCE(); OUT_COMPCH(vc, cf1, 0); OUT_FENCE();
        OUT_LOADCH(vc, ev1, 32); OUT_FENCE(); OUT_COMPCH(vn, cf1, 16); OUT_FENCE();
        OUT_LOADCH(vn, ev1, 48); OUT_FENCE(); OUT_COMPCH(vc, cf1, 32); OUT_FENCE();
        OUT_COMPCH(vn, cf1, 48); OUT_FENCE();
#undef OUT_FENCE
        GAS float* xr = X + (size_t)row * 1024 + 16 * lane; float t[16];
#pragma unroll
        for (int q = 0; q < 4; ++q) { const f32x4 xv = *(const GAS f32x4*)(xr + 4 * q); t[4 * q] = fmaf(alpha, xv.x, acc[4 * q]); t[4 * q + 1] = fmaf(alpha, xv.y, acc[4 * q + 1]); t[4 * q + 2] = fmaf(alpha, xv.z, acc[4 * q + 2]); t[4 * q + 3] = fmaf(alpha, xv.w, acc[4 * q + 3]); }
        float s = 0.f;
#pragma unroll
        for (int k = 0; k < 16; ++k) s += t[k];
        const float mu = wave_sum(s, lane) * (1.f / 1024.f); float vs = 0.f;
#pragma unroll
        for (int k = 0; k < 16; ++k) { t[k] -= mu; vs = fmaf(t[k], t[k], vs); }
        const float rs = 1.f / sqrtf(wave_sum(vs, lane) * (1.f / 1024.f) + 1e-5f);
        unsigned w[8];
#pragma unroll
        for (int q = 0; q < 4; ++q) { const f32x4 g = *(const GAS f32x4*)(lg + 16 * lane + 4 * q), b = *(const GAS f32x4*)(lb + 16 * lane + 4 * q); f32x4 o;
            o.x = t[4 * q] * rs * g.x + b.x; o.y = t[4 * q + 1] * rs * g.y + b.y; o.z = t[4 * q + 2] * rs * g.z + b.z; o.w = t[4 * q + 3] * rs * g.w + b.w;
            *(GAS f32x4*)(xr + 4 * q) = o; w[2 * q] = pk_bf16(o.x, o.y); w[2 * q + 1] = pk_bf16(o.z, o.w); }
        u32x4 w0, w1; w0.x = w[0]; w0.y = w[1]; w0.z = w[2]; w0.w = w[3]; w1.x = w[4]; w1.y = w[5]; w1.z = w[6]; w1.w = w[7];
        GAS u32x4* xbp = (GAS u32x4*)(XB + (size_t)row * 1024 + 16 * lane); xbp[0] = w0; xbp[1] = w1;
        if (!hasn) break;
        row = rown; cf0 = ncf0; cf1 = ncf1; ev0 = nev0; ev1 = nev1;
    }
#undef OUT_LOADCH
#undef OUT_COMPCH
}

__device__ __forceinline__ void lnres_phase(const GAS bf16_t* __restrict__ Y, const GAS float* __restrict__ lg, const GAS float* __restrict__ lb, GAS float* X, GAS bf16_t* XB, GAS unsigned char* XF8, int nrows, int lane, int wave_gid, int nwaves) {
    const float alpha = 1.6817928305074292f;
    for (int row = wave_gid; row < nrows; row += nwaves) {
        GAS float* xr = X + (size_t)row * 1024; const GAS bf16_t* yr = Y + (size_t)row * 1024; float t[16];
#pragma unroll
        for (int q = 0; q < 4; ++q) { const f32x4 xv = *(const GAS f32x4*)(xr + 256 * q + 4 * lane); const u32x2 yw = *(const GAS u32x2*)(yr + 256 * q + 4 * lane);
            t[4 * q] = fmaf(alpha, xv.x, bflo(yw.x)); t[4 * q + 1] = fmaf(alpha, xv.y, bfhi(yw.x)); t[4 * q + 2] = fmaf(alpha, xv.z, bflo(yw.y)); t[4 * q + 3] = fmaf(alpha, xv.w, bfhi(yw.y)); }
        float s = 0.f;
#pragma unroll
        for (int k = 0; k < 16; ++k) s += t[k];
        const float mu = wave_sum(s, lane) * (1.f / 1024.f); float vs = 0.f;
#pragma unroll
        for (int k = 0; k < 16; ++k) { t[k] -= mu; vs = fmaf(t[k], t[k], vs); }
        const float rs = 1.f / sqrtf(wave_sum(vs, lane) * (1.f / 1024.f) + 1e-5f);
#pragma unroll
        for (int q = 0; q < 4; ++q) { const int c = 256 * q + 4 * lane; const f32x4 g = *(const GAS f32x4*)(lg + c), b = *(const GAS f32x4*)(lb + c); f32x4 o;
            o.x = t[4 * q] * rs * g.x + b.x; o.y = t[4 * q + 1] * rs * g.y + b.y; o.z = t[4 * q + 2] * rs * g.z + b.z; o.w = t[4 * q + 3] * rs * g.w + b.w;
            *(GAS f32x4*)(xr + c) = o; u32x2 w; w.x = pk_bf16(o.x, o.y); w.y = pk_bf16(o.z, o.w); *(GAS u32x2*)(XB + (size_t)row * 1024 + c) = w;
            if (XF8) {
                const float s0 = __builtin_amdgcn_fmed3f(o.x * 16.f, -448.f, 448.f), s1 = __builtin_amdgcn_fmed3f(o.y * 16.f, -448.f, 448.f), s2 = __builtin_amdgcn_fmed3f(o.z * 16.f, -448.f, 448.f), s3 = __builtin_amdgcn_fmed3f(o.w * 16.f, -448.f, 448.f);
                int hp = __builtin_amdgcn_cvt_pk_fp8_f32(s0, s1, 0, false); hp = __builtin_amdgcn_cvt_pk_fp8_f32(s2, s3, hp, true);
                const f32x2 d01 = fp8lo((unsigned)hp), d23 = fp8hi((unsigned)hp);
                int lp = __builtin_amdgcn_cvt_pk_fp8_f32(s0 - d01.x, s1 - d01.y, 0, false); lp = __builtin_amdgcn_cvt_pk_fp8_f32(s2 - d23.x, s3 - d23.y, lp, true);
                *(GAS int*)(XF8 + (size_t)row * 2048 + c) = hp; *(GAS int*)(XF8 + (size_t)row * 2048 + 1024 + c) = lp; } }
    }
}

__device__ __forceinline__ void glanorm_phase(const GAS float* __restrict__ O, const GAS float* __restrict__ PROJ, const GAS float* __restrict__ gnorm, GAS bf16_t* XB, int nitems, int lane, int wave_gid, int nwaves) {
    const float g0 = gnorm[lane], g1 = gnorm[64 + lane];
    for (int it0 = wave_gid * 4; it0 < nitems; it0 += nwaves * 4) {
        float a0[4], a1[4], r0[4], r1[4];
#pragma unroll
        for (int q = 0; q < 4; ++q) { int it = it0 + q; it = it < nitems ? it : it0; const int row = it >> 2, h = it & 3; const GAS float* o = O + (size_t)row * 512 + h * 128; const GAS float* r = PROJ + (size_t)row * 2576 + 1040 + h * 128;
            a0[q] = o[lane]; a1[q] = o[64 + lane]; r0[q] = r[lane]; r1[q] = r[64 + lane]; }
#pragma unroll
        for (int q = 0; q < 4; ++q) { const int it = it0 + q; const int row = it >> 2, h = it & 3;
            const float rs = 1.f / sqrtf(wave_sum(a0[q] * a0[q] + a1[q] * a1[q], lane) * (1.f / 128.f) + 1e-5f);
            const float y0 = a0[q] * rs * g0 * (r0[q] / (1.f + __expf(-r0[q]))), y1 = a1[q] * rs * g1 * (r1[q] / (1.f + __expf(-r1[q])));
            if (it < nitems) { GAS bf16_t* d = XB + (size_t)row * 1024 + h * 128; d[lane] = (bf16_t)(pk_bf16(y0, 0.f) & 0xffffu); d[64 + lane] = (bf16_t)(pk_bf16(y1, 0.f) & 0xffffu); } }
    }
}

__device__ __forceinline__ float sigm(float x) { return 1.f / (1.f + __expf(-x)); }
__device__ __forceinline__ float softplusf(float x) { return fmaxf(x, 0.f) + log1pf(__expf(-fabsf(x))); }
__device__ __forceinline__ void rwkvprep_phase(const GAS float* __restrict__ w0, const GAS float* __restrict__ a0, const GAS float* __restrict__ v0, const GAS float* __restrict__ k_k, const GAS float* __restrict__ k_a, const GAS float* __restrict__ Vg,
                                               GAS float* K, GAS float* Wd, GAS float* Aa, GAS float* V, GAS float* NKK, GAS float* VFIRST, int has_vres, int nitems, int lane, int wave_gid, int nwaves) {
    for (int it0 = wave_gid * 4; it0 < nitems; it0 += nwaves * 4) {
        float kq[4], wq[4], aq[4], vq[4], gq[4], fq[4];
#pragma unroll
        for (int q = 0; q < 4; ++q) { const int it = it0 + q; const size_t ix = (size_t)(it >> 4) * 1024 + (it & 15) * 64 + lane; kq[q] = K[ix]; wq[q] = Wd[ix]; aq[q] = Aa[ix]; vq[q] = V[ix]; gq[q] = has_vres ? Vg[ix] : 0.f; fq[q] = has_vres ? VFIRST[ix] : 0.f; }
#pragma unroll
        for (int q = 0; q < 4; ++q) { const int it = it0 + q; const int h = it & 15; const size_t ix = (size_t)(it >> 4) * 1024 + h * 64 + lane; const int c = h * 64 + lane;
            const float k0 = kq[q]; const float kv = k0 * k_k[c]; const float inv = 1.f / fmaxf(sqrtf(wave_sum(kv * kv, lane)), 1e-12f);
            const float w = -softplusf(-(w0[c] + wq[q])) - 0.5f; const float dec = __expf(-__expf(w));
            const float a = sigm(a0[c] + aq[q]);
            float v = vq[q]; if (has_vres) v = v + (fq[q] - v) * sigm(v0[c] + gq[q]); else VFIRST[ix] = v;
            const float kk = kv * inv;
            NKK[ix] = -kk; K[ix] = k0 * (1.f + (a - 1.f) * k_a[c]); Wd[ix] = dec; Aa[ix] = kk * a; V[ix] = v; }
    }
}

__device__ __forceinline__ void rwkvpost_phase(const GAS float* __restrict__ Y, const GAS float* __restrict__ R, const GAS float* __restrict__ K2, const GAS float* __restrict__ V, const GAS float* __restrict__ G, const GAS float* __restrict__ r_k,
                                               const GAS float* __restrict__ lnx_g, const GAS float* __restrict__ lnx_b, GAS bf16_t* XB, int nitems, int lane, int wave_gid, int nwaves) {
    for (int it0 = wave_gid * 4; it0 < nitems; it0 += nwaves * 4) {
        float yq[4], rq[4], kq[4], vq[4], gq[4];
#pragma unroll
        for (int q = 0; q < 4; ++q) { const int it = it0 + q; const size_t ix = (size_t)(it >> 4) * 1024 + (it & 15) * 64 + lane; yq[q] = Y[ix]; rq[q] = R[ix]; kq[q] = K2[ix]; vq[q] = V[ix]; gq[q] = G[ix]; }
#pragma unroll
        for (int q = 0; q < 4; ++q) { const int it = it0 + q; const int h = it & 15; const size_t ix = (size_t)(it >> 4) * 1024 + h * 64 + lane; const int c = h * 64 + lane;
            const float y = yq[q]; const float mu = wave_sum(y, lane) * (1.f / 64.f); const float d = y - mu; const float rs = 1.f / sqrtf(wave_sum(d * d, lane) * (1.f / 64.f) + 64e-5f);
            const float bon = wave_sum(rq[q] * kq[q] * r_k[c], lane);
            const float o = (d * rs * lnx_g[c] + lnx_b[c] + bon * vq[q]) * gq[q];
            XB[ix] = (bf16_t)(pk_bf16(o, 0.f) & 0xffffu); }
    }
}

__device__ __forceinline__ void wkv_phase(const GAS float* __restrict__ R, const GAS float* __restrict__ Wd, const GAS float* __restrict__ K2, const GAS float* __restrict__ V, const GAS float* __restrict__ BB, const GAS float* __restrict__ NKK,
                                          const GAS float* __restrict__ SIN, GAS float* __restrict__ Y, GAS float* __restrict__ P, GAS float* __restrict__ SOUT, int B, int T, int DB, int DT, LAS unsigned char* lds, int tid, int bid, int nb) {
    constexpr int TB = 32, NLD = 6, VECB = TB * 1280, VVB = TB * 128, BUF = VECB + 2 * VVB;
    const int rowl = tid >> 4, part = tid & 15;
    const int nprompt = B * 32, nunits = nprompt + DB * 32;
    for (int u = bid; u < nunits; u += nb) {
        const bool smp = u >= nprompt; const int q0_ = smp ? u - nprompt : u; const int q = ((q0_ & 7) << 1 | ((q0_ >> 3) & 1)) + ((q0_ >> 4) << 4);
        const int half = q & 1, pair = q >> 1, sq = pair >> 4, h = pair & 15;
        const int Tu = smp ? DT : T; const int r0 = smp ? B * T + sq * DT : sq * T, vrow = half * 32 + rowl;
        f32x2 S01 = (f32x2){0.f, 0.f}, S23 = (f32x2){0.f, 0.f};
        if (smp) { const f32x4 s4 = *(const GAS f32x4*)(SIN + ((size_t)pair * 64 + vrow) * 64 + part * 4); S01 = (f32x2){s4.x, s4.y}; S23 = (f32x2){s4.z, s4.w};
                   asm volatile("" : "+v"(S01), "+v"(S23)); }
        const int nblk = (Tu + TB - 1) / TB;
        f32x4 ld[NLD];
        const size_t eo_ = (size_t)(r0 + (tid >> 4)) * 1024 + h * 64 + (tid & 15) * 4, ev_ = (size_t)(r0 + ((tid & 255) >> 3)) * 1024 + h * 64 + half * 32 + (tid & 7) * 4;
        const int lo_ = ((tid >> 4) * 320 + (tid & 15) * 4) * 4, lv_ = VECB + (tid & 255) * 16;
#define WKV_LOAD(tb0) do { const size_t bo_ = (size_t)(tb0) * 1024; ld[0] = *(const GAS f32x4*)(Wd + eo_ + bo_); ld[1] = *(const GAS f32x4*)(NKK + eo_ + bo_); ld[2] = *(const GAS f32x4*)(BB + eo_ + bo_); \
            ld[3] = *(const GAS f32x4*)(K2 + eo_ + bo_); ld[4] = *(const GAS f32x4*)(R + eo_ + bo_); ld[5] = *(const GAS f32x4*)(V + ev_ + bo_); } while (0)
#define WKV_STORE(bufp) do { _Pragma("unroll") for (int q_ = 0; q_ < 5; ++q_) *(LAS f32x4*)((bufp) + lo_ + q_ * 256) = ld[q_]; *(LAS f32x4*)((bufp) + lv_) = ld[5]; } while (0)
        WKV_LOAD(0); WKV_STORE(lds); __syncthreads();
        for (int b = 0; b < nblk; ++b) {
            LAS unsigned char* cur = lds + (b & 1) * BUF; LAS unsigned char* nxt = lds + ((b + 1) & 1) * BUF; const int tb0 = b * TB; const int nt = (Tu - tb0) < TB ? (Tu - tb0) : TB;
            if (b + 1 < nblk) WKV_LOAD(tb0 + TB);
            const LAS float* vec = (const LAS float*)cur + part * 4; const LAS float* vv = (const LAS float*)(cur + VECB) + rowl; LAS float* yb = (LAS float*)(cur + VECB + VVB);
            float ykeep0 = 0.f, ykeep1 = 0.f;
#define WKV_STEP(t, keep, tl) do { const LAS f32x2* vp_ = (const LAS f32x2*)(vec + (t) * 320); \
                const f32x2 w01 = vp_[0], w23 = vp_[1], n01 = vp_[32], n23 = vp_[33], b01 = vp_[64], b23 = vp_[65], k01 = vp_[96], k23 = vp_[97], r01 = vp_[128], r23 = vp_[129]; \
                const float v = vv[(t) * 32]; \
                const f32x2 sp = __builtin_elementwise_fma(S23, n23, S01 * n01); const float sa = row_sum16(sp.x + sp.y); const f32x2 sa2 = (f32x2){sa, sa}, v2 = (f32x2){v, v}; \
                S01 = __builtin_elementwise_fma(S01, w01, __builtin_elementwise_fma(b01, sa2, k01 * v2)); S23 = __builtin_elementwise_fma(S23, w23, __builtin_elementwise_fma(b23, sa2, k23 * v2)); \
                const f32x2 yp = __builtin_elementwise_fma(S23, r23, S01 * r01); const float y = row_sum16(yp.x + yp.y); \
                keep = (part == (tl)) ? y : keep; } while (0)
            if (nt == TB) {
#pragma unroll 1
                for (int t = 0; t < 16; t += 8) { WKV_STEP(t, ykeep0, t); WKV_STEP(t + 1, ykeep0, t + 1); WKV_STEP(t + 2, ykeep0, t + 2); WKV_STEP(t + 3, ykeep0, t + 3); WKV_STEP(t + 4, ykeep0, t + 4); WKV_STEP(t + 5, ykeep0, t + 5); WKV_STEP(t + 6, ykeep0, t + 6); WKV_STEP(t + 7, ykeep0, t + 7); }
#pragma unroll 1
                for (int t = 16; t < 32; t += 8) { WKV_STEP(t, ykeep1, t - 16); WKV_STEP(t + 1, ykeep1, t - 15); WKV_STEP(t + 2, ykeep1, t - 14); WKV_STEP(t + 3, ykeep1, t - 13); WKV_STEP(t + 4, ykeep1, t - 12); WKV_STEP(t + 5, ykeep1, t - 11); WKV_STEP(t + 6, ykeep1, t - 10); WKV_STEP(t + 7, ykeep1, t - 9); }
            } else { for (int t = 0; t < nt; ++t) { if (t < 16) WKV_STEP(t, ykeep0, t); else WKV_STEP(t, ykeep1, t - 16); } }
#undef WKV_STEP
            yb[part * 32 + rowl] = ykeep0; yb[(16 + part) * 32 + rowl] = ykeep1;
            if (b + 1 < nblk) WKV_STORE(nxt);
            __syncthreads();
            { const int rl = tid & 31; _Pragma("unroll") for (int t = tid >> 5; t < TB; t += 16) if (t < nt) Y[(size_t)(r0 + tb0 + t) * 1024 + h * 64 + half * 32 + rl] = yb[t * 32 + rl]; }
        }
#undef WKV_LOAD
#undef WKV_STORE
        *(GAS f32x4*)((smp ? SOUT : P) + ((size_t)pair * 64 + vrow) * 64 + part * 4) = (f32x4){S01.x, S01.y, S23.x, S23.y};
        __syncthreads();
    }
}

__device__ __forceinline__ void rwkvpost2_phase(const GAS float* __restrict__ Y, const GAS bf16_t* __restrict__ G, const GAS float* __restrict__ VF, const GAS float* __restrict__ BON, const GAS float* __restrict__ lnx_g, const GAS float* __restrict__ lnx_b,
                                                GAS bf16_t* XB, int nitems, int lane, int wave_gid, int nwaves) {
    for (int it0 = wave_gid * 4; it0 < nitems; it0 += nwaves * 4) {
        float yq[4], gq[4], vq[4], bq[4];
#pragma unroll
        for (int q = 0; q < 4; ++q) { const int it = it0 + q; const size_t ix = (size_t)(it >> 4) * 1024 + (it & 15) * 64 + lane; yq[q] = Y[ix]; gq[q] = __uint_as_float((unsigned)G[ix] << 16); vq[q] = VF[ix]; bq[q] = BON[it]; }
#pragma unroll
        for (int q = 0; q < 4; ++q) { const int it = it0 + q; const int h = it & 15; const size_t ix = (size_t)(it >> 4) * 1024 + h * 64 + lane; const int c = h * 64 + lane;
            const float y = yq[q]; const float mu = wave_sum(y, lane) * (1.f / 64.f); const float d = y - mu; const float rs = 1.f / sqrtf(wave_sum(d * d, lane) * (1.f / 64.f) + 64e-5f);
            const float o = (d * rs * lnx_g[c] + lnx_b[c] + bq[q] * vq[q]) * gq[q];
            XB[ix] = (bf16_t)(pk_bf16(o, 0.f) & 0xffffu); }
    }
}

__device__ __forceinline__ void wkv2_phase(const GAS bf16_t* __restrict__ R, const GAS bf16_t* __restrict__ KR, const GAS bf16_t* __restrict__ WL, const GAS bf16_t* __restrict__ AL, const GAS bf16_t* __restrict__ V, const GAS bf16_t* __restrict__ VG,
                                           const GAS float* VFI, const GAS float* __restrict__ PRM, const GAS float* __restrict__ SIN, GAS float* __restrict__ Y, GAS float* __restrict__ P, GAS float* __restrict__ SOUT, GAS float* VFO, GAS float* __restrict__ BON,
                                           int has_vres, int B, int T, int DB, int DT, LAS unsigned char* lds, int tid, int bid, int nb) {
    constexpr int TB = 32, VECB = TB * 1280, VVB = TB * 128, BUF = VECB + 2 * VVB;
    const bool scanw = __builtin_amdgcn_readfirstlane(tid) < 256; const int pt = tid & 255;
    const int rowl = pt >> 4, part = pt & 15;
    const int nprompt = B * 32, nunits = nprompt + DB * 32;
    for (int u = bid; u < nunits; u += nb) {
        const bool smp = u >= nprompt; const int q0_ = smp ? u - nprompt : u; const int q = ((q0_ & 7) << 1 | ((q0_ >> 3) & 1)) + ((q0_ >> 4) << 4);
        const int half = q & 1, pair = q >> 1, sq = pair >> 4, h = pair & 15;
        const int Tu = smp ? DT : T; const int r0 = smp ? B * T + sq * DT : sq * T, vrow = half * 32 + rowl;
        const int srow = pt >> 3, sp8 = pt & 7;
        f32x2 S0 = (f32x2){0.f, 0.f}, S1 = (f32x2){0.f, 0.f}, S2 = (f32x2){0.f, 0.f}, S3 = (f32x2){0.f, 0.f};
        if (smp && scanw) { const GAS f32x4* sp_ = (const GAS f32x4*)(SIN + ((size_t)pair * 64 + half * 32 + srow) * 64 + sp8 * 8); const f32x4 sa4 = sp_[0], sb4 = sp_[1];
                   S0 = (f32x2){sa4.x, sa4.y}; S1 = (f32x2){sa4.z, sa4.w}; S2 = (f32x2){sb4.x, sb4.y}; S3 = (f32x2){sb4.z, sb4.w};
                   asm volatile("" : "+v"(S0), "+v"(S1), "+v"(S2), "+v"(S3)); }
        const int nblk = (Tu + TB - 1) / TB;
        u32x2 lk0, lw0, la0, lr0, lk1, lw1, la1, lr1, lv, lg = (u32x2){0u, 0u}; f32x4 lf = (f32x4){0.f, 0.f, 0.f, 0.f};
        const size_t eo_ = (size_t)(r0 + (pt >> 4)) * 1024 + h * 64 + part * 4, ev_ = (size_t)(r0 + (pt >> 3)) * 1024 + h * 64 + half * 32 + (pt & 7) * 4;
        const int lo_ = ((pt >> 4) * 320 + part * 4) * 4, lv_ = VECB + pt * 16;
        const int pc_ = h * 64 + part * 4; const f32x4 w0v = *(const GAS f32x4*)(PRM + pc_), a0v = *(const GAS f32x4*)(PRM + 1024 + pc_), kkp = *(const GAS f32x4*)(PRM + 3072 + pc_), kap = *(const GAS f32x4*)(PRM + 4096 + pc_), rkp = *(const GAS f32x4*)(PRM + 5120 + pc_);
        const f32x4 v0v = *(const GAS f32x4*)(PRM + 2048 + h * 64 + half * 32 + (pt & 7) * 4);
#define WKV_LOAD(tb0) do { const size_t bo_ = (size_t)(tb0) * 1024, b1_ = bo_ + 16 * 1024; lk0 = *(const GAS u32x2*)(KR + eo_ + bo_); lw0 = *(const GAS u32x2*)(WL + eo_ + bo_); la0 = *(const GAS u32x2*)(AL + eo_ + bo_); lr0 = *(const GAS u32x2*)(R + eo_ + bo_); \
            lk1 = *(const GAS u32x2*)(KR + eo_ + b1_); lw1 = *(const GAS u32x2*)(WL + eo_ + b1_); la1 = *(const GAS u32x2*)(AL + eo_ + b1_); lr1 = *(const GAS u32x2*)(R + eo_ + b1_); \
            lv = *(const GAS u32x2*)(V + ev_ + bo_); if (has_vres) { lg = *(const GAS u32x2*)(VG + ev_ + bo_); lf = *(const GAS f32x4*)(VFI + ev_ + bo_); } } while (0)
#define WKV_UNPK(w_) ((f32x4){bflo((w_).x), bfhi((w_).x), bflo((w_).y), bfhi((w_).y)})
#define WKV_ITEM(bufp, tb0, lk, lw, la, lr, ti_) do { const f32x4 k4 = WKV_UNPK(lk), wl4 = WKV_UNPK(lw), al4 = WKV_UNPK(la); const f32x4 kv = k4 * kkp; const float ss = row_sum16((kv.x * kv.x + kv.y * kv.y) + (kv.z * kv.z + kv.w * kv.w)); const float inv = 1.f / fmaxf(sqrtf(ss), 1e-12f); \
            f32x4 dec, a4; _Pragma("unroll") for (int i_ = 0; i_ < 4; ++i_) { dec[i_] = __expf(-0.6065306597126334f / (1.f + __expf(-(w0v[i_] + wl4[i_])))); a4[i_] = 1.f / (1.f + __expf(-(a0v[i_] + al4[i_]))); } \
            const f32x4 kk = kv * inv; const f32x4 k2 = k4 * ((a4 - 1.f) * kap + 1.f); const f32x4 r4 = WKV_UNPK(lr); const f32x4 rk = r4 * k2 * rkp; const float bon = row_sum16((rk.x + rk.y) + (rk.z + rk.w)); \
            LAS unsigned char* d_ = (bufp) + lo_ + (ti_) * 1280; *(LAS f32x4*)(d_) = dec; *(LAS f32x4*)(d_ + 256) = -kk; *(LAS f32x4*)(d_ + 512) = kk * a4; *(LAS f32x4*)(d_ + 768) = k2; *(LAS f32x4*)(d_ + 1024) = r4; \
            const int tr_ = (tb0) + (pt >> 4) + (ti_); if (half == 0 && part == 0 && tr_ < Tu) BON[(size_t)(r0 + tr_) * 16 + h] = bon; } while (0)
#define WKV_STORE(bufp, tb0) do { WKV_ITEM(bufp, tb0, lk0, lw0, la0, lr0, 0); WKV_ITEM(bufp, tb0, lk1, lw1, la1, lr1, 16); \
            f32x4 v4 = WKV_UNPK(lv); if (has_vres) { const f32x4 g4 = WKV_UNPK(lg); _Pragma("unroll") for (int i_ = 0; i_ < 4; ++i_) v4[i_] = v4[i_] + (lf[i_] - v4[i_]) / (1.f + __expf(-(v0v[i_] + g4[i_]))); } \
            *(LAS f32x4*)((bufp) + lv_) = v4; const int tv_ = (tb0) + (pt >> 3); if (tv_ < Tu) *(GAS f32x4*)(VFO + ev_ + (size_t)(tb0) * 1024) = v4; } while (0)
#define WKV_YOUT(bufp, tb0, ntp) do { const LAS float* yb_ = (const LAS float*)((bufp) + VECB + VVB); const int rl = pt & 31; _Pragma("unroll") for (int t = pt >> 5; t < TB; t += 8) if (t < (ntp)) Y[(size_t)(r0 + (tb0) + t) * 1024 + h * 64 + half * 32 + rl] = yb_[t * 32 + rl]; } while (0)
        if (!scanw) { WKV_LOAD(0); WKV_STORE(lds, 0); if (nblk > 1) WKV_LOAD(TB); }
        __syncthreads();
        for (int b = 0; b < nblk; ++b) {
            LAS unsigned char* cur = lds + (b & 1) * BUF; LAS unsigned char* nxt = lds + ((b + 1) & 1) * BUF; const int tb0 = b * TB; const int nt = (Tu - tb0) < TB ? (Tu - tb0) : TB;
            if (scanw) {
                const LAS float* vec = (const LAS float*)cur + sp8 * 8; const LAS float* vv = (const LAS float*)(cur + VECB) + srow; LAS float* yb = (LAS float*)(cur + VECB + VVB);
                float yk0 = 0.f, yk1 = 0.f, yk2 = 0.f, yk3 = 0.f;
                struct StepV { f32x4 w0, w1, n0, n1, b0, b1, k0, k1, r0, r1; float v; };
#define WKV_RD(dst, t) do { const LAS f32x4* vp_ = (const LAS f32x4*)(vec + (t) * 320); dst.w0 = vp_[0]; dst.w1 = vp_[1]; dst.n0 = vp_[16]; dst.n1 = vp_[17]; dst.b0 = vp_[32]; dst.b1 = vp_[33]; \
                dst.k0 = vp_[48]; dst.k1 = vp_[49]; dst.r0 = vp_[64]; dst.r1 = vp_[65]; dst.v = vv[(t) * 32]; } while (0)
#define WKV_LO(q_) ((f32x2){(q_).x, (q_).y})
#define WKV_HI(q_) ((f32x2){(q_).z, (q_).w})
#define WKV_UPD(S, w_, b_, k_) S = __builtin_elementwise_fma(S, w_, __builtin_elementwise_fma(b_, sa2, (k_) * v2))
#define WKV_CMP(src, keep, tl) do { const f32x2 spa = __builtin_elementwise_fma(S1, WKV_HI(src.n0), S0 * WKV_LO(src.n0)), spb = __builtin_elementwise_fma(S3, WKV_HI(src.n1), S2 * WKV_LO(src.n1)); const f32x2 sp = spa + spb; \
                const float sa = row_sum8(sp.x + sp.y); const f32x2 sa2 = (f32x2){sa, sa}, v2 = (f32x2){src.v, src.v}; \
                WKV_UPD(S0, WKV_LO(src.w0), WKV_LO(src.b0), WKV_LO(src.k0)); WKV_UPD(S1, WKV_HI(src.w0), WKV_HI(src.b0), WKV_HI(src.k0)); WKV_UPD(S2, WKV_LO(src.w1), WKV_LO(src.b1), WKV_LO(src.k1)); WKV_UPD(S3, WKV_HI(src.w1), WKV_HI(src.b1), WKV_HI(src.k1)); \
                const f32x2 ypa = __builtin_elementwise_fma(S1, WKV_HI(src.r0), S0 * WKV_LO(src.r0)), ypb = __builtin_elementwise_fma(S3, WKV_HI(src.r1), S2 * WKV_LO(src.r1)); const f32x2 yp = ypa + ypb; \
                const float y = row_sum8(yp.x + yp.y); keep = (sp8 == (tl)) ? y : keep; } while (0)
#define WKV_OCT(t0_, keep) do { _Pragma("unroll 1") for (int t = (t0_); t < (t0_) + 8; t += 2) { WKV_RD(sB, t + 1); __builtin_amdgcn_sched_barrier(0); WKV_CMP(sA, keep, t - (t0_)); WKV_RD(sA, (t + 2) & 31); __builtin_amdgcn_sched_barrier(0); WKV_CMP(sB, keep, t + 1 - (t0_)); } } while (0)
                if (nt == TB) {
                    StepV sA, sB; WKV_RD(sA, 0);
                    WKV_OCT(0, yk0); WKV_OCT(8, yk1); WKV_OCT(16, yk2); WKV_OCT(24, yk3);
                } else { StepV sA; for (int t = 0; t < nt; ++t) { WKV_RD(sA, t); if (t < 8) WKV_CMP(sA, yk0, t); else if (t < 16) WKV_CMP(sA, yk1, t - 8); else if (t < 24) WKV_CMP(sA, yk2, t - 16); else WKV_CMP(sA, yk3, t - 24); } }
#undef WKV_RD
#undef WKV_LO
#undef WKV_HI
#undef WKV_UPD
#undef WKV_CMP
#undef WKV_OCT
                yb[sp8 * 32 + srow] = yk0; yb[(8 + sp8) * 32 + srow] = yk1; yb[(16 + sp8) * 32 + srow] = yk2; yb[(24 + sp8) * 32 + srow] = yk3;
            } else {
                if (b > 0) WKV_YOUT(nxt, tb0 - TB, TB);
                if (b + 1 < nblk) { WKV_STORE(nxt, tb0 + TB); if (b + 2 < nblk) WKV_LOAD(tb0 + 2 * TB); }
            }
            __syncthreads();
        }
        if (!scanw) { const int tbl = (nblk - 1) * TB; WKV_YOUT(lds + ((nblk - 1) & 1) * BUF, tbl, Tu - tbl); }
#undef WKV_LOAD
#undef WKV_STORE
#undef WKV_ITEM
#undef WKV_YOUT
#undef WKV_UNPK
        if (scanw) { GAS float* so = (smp ? SOUT : P) + ((size_t)pair * 64 + half * 32 + srow) * 64 + sp8 * 8; *(GAS f32x4*)so = (f32x4){S0.x, S0.y, S1.x, S1.y}; *(GAS f32x4*)(so + 4) = (f32x4){S2.x, S2.y, S3.x, S3.y}; }
        __syncthreads();
    }
}

__device__ __forceinline__ void gla_phase(const GAS float* __restrict__ PROJ, const GAS float* __restrict__ LOGA, GAS float* __restrict__ O, GAS float* __restrict__ P, int B, int T, LAS unsigned char* lds, int tid, int bid, int nb) {
    constexpr int TB = 32, NLD = 4, VECB = TB * 768, VVB = TB * 64, BUF = VECB + 3 * VVB;
    const int col = tid >> 5, half = (tid >> 4) & 1, p = tid & 15, dk = half * 32 + p * 2;
    const int nunits = B * 32;
    for (int u = bid; u < nunits; u += nb) {
        const int ug_ = ((u & 7) << 3 | ((u >> 3) & 7)) + ((u >> 6) << 6);
        const int cb = ug_ & 7, pair = ug_ >> 3, s = pair >> 2, h = pair & 3; const int r0 = s * T;
        float S0 = 0.f, S1 = 0.f;
        const int nblk = (T + TB - 1) / TB;
        f32x4 ld[NLD];
        const size_t ea_ = (size_t)(r0 + (tid >> 4)) * 256 + h * 64 + (tid & 15) * 4, ep_ = (size_t)(r0 + (tid >> 4)) * 2576 + h * 64 + (tid & 15) * 4, ev_ = (size_t)(r0 + ((tid & 127) >> 2)) * 2576 + 512 + h * 128 + cb * 16 + (tid & 3) * 4;
        const int lo_ = ((tid >> 4) * 192 + (tid & 15) * 4) * 4, lv_ = VECB + (tid & 127) * 16;
#define GLA_LOAD(tb0) do { ld[0] = *(const GAS f32x4*)(LOGA + ea_ + (size_t)(tb0) * 256); ld[1] = *(const GAS f32x4*)(PROJ + ep_ + 256 + (size_t)(tb0) * 2576); ld[2] = *(const GAS f32x4*)(PROJ + ep_ + (size_t)(tb0) * 2576); ld[3] = *(const GAS f32x4*)(PROJ + ev_ + (size_t)(tb0) * 2576); } while (0)
#define GLA_STORE(bufp) do { *(LAS f32x4*)((bufp) + lo_) = ld[0]; *(LAS f32x4*)((bufp) + lo_ + 256) = ld[1]; *(LAS f32x4*)((bufp) + lo_ + 512) = ld[2] * 0.125f; *(LAS f32x4*)((bufp) + lv_) = ld[3]; } while (0)
        GLA_LOAD(0); GLA_STORE(lds); __syncthreads();
        for (int b = 0; b < nblk; ++b) {
            LAS unsigned char* cur = lds + (b & 1) * BUF; LAS unsigned char* nxt = lds + ((b + 1) & 1) * BUF; const int tb0 = b * TB; const int nt = (T - tb0) < TB ? (T - tb0) : TB;
            if (b + 1 < nblk) GLA_LOAD(tb0 + TB);
            const LAS float* vec = (const LAS float*)cur + dk; const LAS float* vv = (const LAS float*)(cur + VECB) + col; LAS float* ob = (LAS float*)(cur + VECB + VVB);
            float okeep0 = 0.f, okeep1 = 0.f;
#define GLA_STEP(t, keep, tl) do { const f32x2 a2 = *(const LAS f32x2*)(vec + (t) * 192), k2 = *(const LAS f32x2*)(vec + (t) * 192 + 64), q2 = *(const LAS f32x2*)(vec + (t) * 192 + 128); const float v = vv[(t) * 16]; \
                S0 = fmaf(a2.x, S0, k2.x * v); S1 = fmaf(a2.y, S1, k2.y * v); \
                float o = fmaf(q2.x, S0, q2.y * S1); o = row_sum16(o); keep = (p == (tl)) ? o : keep; } while (0)
            if (nt == TB) {
#pragma unroll 1
                for (int t = 0; t < 16; t += 4) { GLA_STEP(t, okeep0, t); GLA_STEP(t + 1, okeep0, t + 1); GLA_STEP(t + 2, okeep0, t + 2); GLA_STEP(t + 3, okeep0, t + 3); }
#pragma unroll 1
                for (int t = 16; t < 32; t += 4) { GLA_STEP(t, okeep1, t - 16); GLA_STEP(t + 1, okeep1, t - 15); GLA_STEP(t + 2, okeep1, t - 14); GLA_STEP(t + 3, okeep1, t - 13); }
            } else { for (int t = 0; t < nt; ++t) { if (t < 16) GLA_STEP(t, okeep0, t); else GLA_STEP(t, okeep1, t - 16); } }
#undef GLA_STEP
            ob[(p * 16 + col) * 2 + half] = okeep0; ob[((16 + p) * 16 + col) * 2 + half] = okeep1;
            if (b + 1 < nblk) GLA_STORE(nxt);
            __syncthreads();
            { const int t = tid >> 4, c = tid & 15; if (t < nt) { const f32x2 o2 = *(const LAS f32x2*)(ob + (t * 16 + c) * 2); O[(size_t)(r0 + tb0 + t) * 512 + h * 128 + cb * 16 + c] = o2.x + o2.y; } }
        }
#undef GLA_LOAD
#undef GLA_STORE
        { GAS float* so = P + ((size_t)pair * 64 + dk) * 128 + cb * 16 + col; so[0] = S0; so[128] = S1; }
        __syncthreads();
    }
}
__device__ __forceinline__ float grp8_sum(float v) { v += dppf<0xB1>(v); v += dppf<0x4E>(v); v += dppf<0x141>(v); return v; }
__device__ __forceinline__ float dot16_fp8_bf16(const u32x4 uw, const float (&x)[16]) { float s = 0.f;
#pragma unroll
    for (int d = 0; d < 4; ++d) { const f32x2 lo = fp8lo(uw[d]), hi = fp8hi(uw[d]); s = fmaf(lo.x, x[4 * d], s); s = fmaf(lo.y, x[4 * d + 1], s); s = fmaf(hi.x, x[4 * d + 2], s); s = fmaf(hi.y, x[4 * d + 3], s); }
    return s; }
typedef int i32x8 __attribute__((ext_vector_type(8)));
typedef unsigned u32x8 __attribute__((ext_vector_type(8)));
__device__ __forceinline__ void pacts_phase(const GAS unsigned char* XF8, const GAS unsigned char* U8S, const GAS int* EIDX, GAS float* __restrict__ PART, int M, int emask,
                                            LAS unsigned char* lds, int wid, int lane, int bid, int nb) {
    const bool spl = (nb & 7) == 0; const int s0 = spl ? (bid & 7) : 0, s1 = spl ? s0 + 1 : 8, r = spl ? (bid >> 3) : bid, nr = spl ? (nb >> 3) : nb;
    const int g = lane >> 3, c = lane & 7, fg = ((g >> 2) & 1) | (((g >> 1) & 1) << 2);
    const int m16 = lane & 15, kb = lane >> 4, fm = ((m16 >> 2) & 1) | (((m16 >> 1) & 1) << 2);
    LAS unsigned char* const wl = lds + wid * 16384;
    const LAS unsigned char* const ard = wl + m16 * 128 + (((2 * kb) ^ fm) * 16);
    const LAS unsigned char* const xrd = wl + 12288 + (m16 & 1) * 128 + kb * 32;
    const LAS unsigned char* const ird = wl + 13824 + g * 4;
    if (r >= M) return;
    const int ntok = (M - r + nr - 1) / nr;
#define PL_ROW(t_) ({ int rw_ = r + nr * (t_); rw_ < M ? rw_ : r; })
#define PL_IDS(t_, slot_) __builtin_amdgcn_global_load_lds((const GAS unsigned*)(isrc + (size_t)PL_ROW(t_) * 128), (LAS unsigned*)(wl + 13824 + (slot_) * 256), 4, 0, 0)
#define PL_RDIDS(slot_, e0_, e1_) do { e0_ = *(const LAS int*)(ird + (slot_) * 256); e1_ = *(const LAS int*)(ird + (slot_) * 256 + 32); } while (0)
#define PL_TILE(t_, slot_, e0_, e1_) do { \
        __builtin_amdgcn_global_load_lds((const GAS unsigned*)(tb + (size_t)((e0_) & emask) * 128), (LAS unsigned*)(wl + (slot_) * 2048), 16, 0, 0); \
        __builtin_amdgcn_global_load_lds((const GAS unsigned*)(tb + (size_t)((e1_) & emask) * 128), (LAS unsigned*)(wl + (slot_) * 2048 + 1024), 16, 0, 0); \
        __builtin_amdgcn_global_load_lds((const GAS unsigned*)(xsrc + (size_t)PL_ROW(t_) * 2048), (LAS unsigned*)(wl + 12288 + (slot_) * 256), 4, 0, 0); } while (0)
#define PL_RD(slot_, a0_, a1_, x0_, x1_) do { a0_ = *(const LAS u32x4*)(ard + (slot_) * 2048); a1_ = *(const LAS u32x4*)(ard2 + (slot_) * 2048); x0_ = *(const LAS u32x4*)(xrd + (slot_) * 256); x1_ = *(const LAS u32x4*)(xrd + (slot_) * 256 + 16); } while (0)
#define PL_MMA(cc_, a0_, a1_, x0_, x1_) do { const i32x8 av = (i32x8)__builtin_shufflevector(a0_, a1_, 0, 1, 2, 3, 4, 5, 6, 7), bv = (i32x8)__builtin_shufflevector(x0_, x1_, 0, 1, 2, 3, 4, 5, 6, 7); const f32x4 z = {0.f, 0.f, 0.f, 0.f}; \
        cc_ = __builtin_amdgcn_mfma_scale_f32_16x16x128_f8f6f4(av, bv, z, 0, 0, 0, 0, 0, 0); } while (0)
#define PL_OUT(t_, cc_) do { f32x4 o; _Pragma("unroll") for (int i = 0; i < 4; ++i) { float v = cc_[i]; v += dppf<0xB1>(v); o[i] = v * (1.f / 16.f); } \
        const int rw = r + nr * (t_); if (m16 == 0 && rw < M) *(GAS f32x4*)(po + (size_t)rw * 128) = o; } while (0)
#define PL_WAIT(n_) asm volatile("s_waitcnt vmcnt(" #n_ ")" ::: "memory")
#define PL_STEP(j_, h_) do { PL_WAIT(12); u32x4 a0[3], a1[3], x0[3], x1[3]; int e0[3], e1[3]; f32x4 cc[3]; \
        _Pragma("unroll") for (int k = 0; k < 3; ++k) PL_RD((h_) * 3 + k, a0[k], a1[k], x0[k], x1[k]); \
        _Pragma("unroll") for (int k = 0; k < 3; ++k) PL_RDIDS((h_) * 3 + k, e0[k], e1[k]); \
        _Pragma("unroll") for (int k = 0; k < 3; ++k) PL_MMA(cc[k], a0[k], a1[k], x0[k], x1[k]); \
        _Pragma("unroll") for (int k = 0; k < 3; ++k) PL_TILE((j_) + 6 + k, (h_) * 3 + k, e0[k], e1[k]); \
        _Pragma("unroll") for (int k = 0; k < 3; ++k) PL_IDS((j_) + 12 + k, (h_) * 3 + k); \
        _Pragma("unroll") for (int k = 0; k < 3; ++k) PL_OUT((j_) + k, cc[k]); } while (0)
    const LAS unsigned char* const ard2 = (const LAS unsigned char*)((unsigned)(size_t)ard ^ 16u);
    for (int s = s0; s < s1; ++s) {
        const GAS unsigned char* tb = U8S + (size_t)s * 16384 * 128 + ((c ^ fg) * 16);
        const GAS unsigned char* xsrc = XF8 + (size_t)(lane >> 5) * 1024 + s * 128 + (lane & 31) * 4;
        const GAS int* isrc = EIDX + wid * 16 + m16;
        GAS float* po = PART + (size_t)s * M * 128 + wid * 16 + kb * 4;
        PL_IDS(0, 0); PL_IDS(1, 1); PL_IDS(2, 2); PL_IDS(3, 3); PL_IDS(4, 4); PL_IDS(5, 5); PL_WAIT(0);
        { int e0[6], e1[6];
#pragma unroll
          for (int k = 0; k < 6; ++k) PL_RDIDS(k, e0[k], e1[k]);
#pragma unroll
          for (int k = 0; k < 3; ++k) PL_TILE(k, k, e0[k], e1[k]);
#pragma unroll
          for (int k = 0; k < 3; ++k) PL_IDS(6 + k, k);
#pragma unroll
          for (int k = 3; k < 6; ++k) PL_TILE(k, k, e0[k], e1[k]);
#pragma unroll
          for (int k = 3; k < 6; ++k) PL_IDS(6 + k, k); }
        for (int j = 0; j < ntok; j += 6) { PL_STEP(j, 0); PL_STEP(j + 3, 1); }
        PL_WAIT(0);
    }
#undef PL_ROW
#undef PL_IDS
#undef PL_RDIDS
#undef PL_TILE
#undef PL_RD
#undef PL_MMA
#undef PL_OUT
#undef PL_WAIT
#undef PL_STEP
}
__device__ __forceinline__ void pouts_phase(const GAS float* __restrict__ COEF, const GAS int* __restrict__ EIDX, const GAS unsigned char* V8S, GAS bf16_t* __restrict__ YBUF, int M,
                                            int wid, int lane, int bid, int nb) {
    const bool spl = (nb & 7) == 0; const int s0 = spl ? (bid & 7) : 0, s1 = spl ? s0 + 1 : 8, r = spl ? (bid >> 3) : bid, nr = spl ? (nb >> 3) : nb;
    const int g = lane >> 3, ch = lane & 7, rstep = nr * 8;
#define PO_LOADCE(rw, c0, c1, v0, v1) do { c0 = COEF[(size_t)(rw) * 128 + lane] * (1.f / 64.f); c1 = COEF[(size_t)(rw) * 128 + 64 + lane] * (1.f / 64.f); v0 = EIDX[(size_t)(rw) * 128 + lane]; v1 = EIDX[(size_t)(rw) * 128 + 64 + lane]; } while (0)
#define PO_GATHER(vv_, vreg) do { _Pragma("unroll") for (int k = 0; k < 8; ++k) { const int e = __builtin_amdgcn_ds_bpermute((8 * k + g) << 2, vreg); vv_[k] = *(const GAS u32x4*)(tb + (size_t)(e & 16383) * 128); } } while (0)
#define PO_COMP(vv_, creg) do { _Pragma("unroll") for (int k = 0; k < 8; ++k) { const float c = __int_as_float(__builtin_amdgcn_ds_bpermute((8 * k + g) << 2, __float_as_int(creg))); const u32x4 w = vv_[k]; \
        const f32x2 c2 = (f32x2){c, c}; _Pragma("unroll") for (int d = 0; d < 4; ++d) { ac2[2 * d] = __builtin_elementwise_fma(c2, fp8lo(w[d]), ac2[2 * d]); ac2[2 * d + 1] = __builtin_elementwise_fma(c2, fp8hi(w[d]), ac2[2 * d + 1]); } \
        _Pragma("unroll") for (int i = 0; i < 8; ++i) asm volatile("" : "+v"(ac2[i])); } } while (0)
    for (int s = s0; s < s1; ++s) {
        const GAS unsigned char* tb = V8S + (size_t)s * 16384 * 128 + ch * 16;
        int row = r + nr * wid; if (row >= M) continue;
        float c0c, c1c, c0n = 0.f, c1n = 0.f; int v0c, v1c, v0n = 0, v1n = 0;
        PO_LOADCE(row, c0c, c1c, v0c, v1c);
        u32x4 va[8], vb[8];
        PO_GATHER(va, v0c);
        for (;;) {
            const int rown = row + rstep; const bool hasn = rown < M;
            PO_GATHER(vb, v1c);
            if (hasn) PO_LOADCE(rown, c0n, c1n, v0n, v1n);
            f32x2 ac2[8];
#pragma unroll
            for (int i = 0; i < 8; ++i) ac2[i] = (f32x2){0.f, 0.f};
            PO_COMP(va, c0c);
            if (hasn) PO_GATHER(va, v0n);
            PO_COMP(vb, c1c);
            float acc[16];
#pragma unroll
            for (int i = 0; i < 8; ++i) { acc[2 * i] = ac2[i].x; acc[2 * i + 1] = ac2[i].y; }
#pragma unroll
            for (int i = 0; i < 16; ++i) acc[i] += dppf<0x128>(acc[i]);
#pragma unroll
            for (int i = 0; i < 8; ++i) { const bool hi = lane & 16; const float send = hi ? acc[i] : acc[i + 8], keep = hi ? acc[i + 8] : acc[i]; acc[i] = keep + shx(send, 16, lane); }
#pragma unroll
            for (int i = 0; i < 4; ++i) { const bool hi = lane & 32; const float send = hi ? acc[i] : acc[i + 4], keep = hi ? acc[i + 4] : acc[i]; acc[i] = keep + shx(send, 32, lane); }
            if ((lane & 8) == 0) { u32x2 w_; w_.x = pk_bf16(acc[0], acc[1]); w_.y = pk_bf16(acc[2], acc[3]); *(GAS u32x2*)(YBUF + (size_t)row * 1024 + s * 128 + ch * 16 + ((lane >> 4) & 1) * 8 + ((lane >> 5) & 1) * 4) = w_; }
            if (!hasn) break;
            row = rown; c0c = c0n; c1c = c1n; v0c = v0n; v1c = v1n;
        }
    }
#undef PO_LOADCE
#undef PO_GATHER
#undef PO_COMP
}
}

template <class T> __device__ __forceinline__ __attribute__((address_space(1))) T* gp(T* p) { return (__attribute__((address_space(1))) T*)uni_ptr(p); }
constexpr int MK_THREADS = 512, LDS_BYTES = 163840, LDSCTL_OFF = 131072, TAB_OFF = LDSCTL_OFF + 1024, MAX_OPS = 208;
static_assert(TAB_OFF + MAX_OPS * (int)sizeof(Op) <= LDS_BYTES, "LDS map");
constexpr int MPAD = 17152;
constexpr size_t CTL_BYTES = (size_t)1 << 20;
struct MArgs { const float* in[47]; float* out; char* ws; unsigned long long ws_size; };
__global__ void __launch_bounds__(MK_THREADS, 2) mega_fwd(MArgs a) {
    extern __shared__ __attribute__((aligned(16))) unsigned char lds[];
    volatile LAS unsigned* ctl = (volatile LAS unsigned*)((LAS unsigned char*)lds + LDSCTL_OFF);
    if (threadIdx.x < 64) ctl[threadIdx.x] = 0u;
    __syncthreads();
    (void)xcd_barrier_post((unsigned*)a.ws, ctl + 8);
    const Dm dm = make_dm(1024, 8, 2048, 128, 4);
    Op* tab = (Op*)(lds + TAB_OFF);
    if (threadIdx.x == 0) {
        const float* const* inp_ = (const float* const*)__builtin_amdgcn_kernarg_segment_ptr(); asm volatile("" : "+s"(inp_));
        NvIO io; io.in = inp_; io.out = a.out; io.ws = a.ws + CTL_BYTES; io.ws_size = a.ws_size - CTL_BYTES;
        int n = 0;
        #ifdef PROBE_DUPCODE
        nv_forward(io, dm, [&](const Op& o) __attribute__((always_inline)) { if (n < MAX_OPS) tab[n] = o; ++n; if ((o.code & 0xff) == PROBE_DUPCODE) { if (n < MAX_OPS) tab[n] = o; ++n; } asm volatile("" ::: "memory"); });
#else
        nv_forward(io, dm, [&](const Op& o) __attribute__((always_inline)) { if (n < MAX_OPS) tab[n] = o; ++n; asm volatile("" ::: "memory"); });
#endif
        ctl[16] = (unsigned)(n <= MAX_OPS ? n : 0);
    }
    __syncthreads();
    const int nops = (int)ctl[16];
    for (int i = 0; i < nops; ++i) {
        int tid_ = (int)threadIdx.x, bid_ = (int)blockIdx.x, nb_ = (int)gridDim.x;
        asm volatile("" : "+v"(tid_)); asm volatile("" : "+s"(bid_)); asm volatile("" : "+s"(nb_));
        const long long g0 = (long long)bid_ * MK_THREADS + tid_, gs = (long long)nb_ * MK_THREADS;
        const Op& o = tab[i];
        const int rawc = __builtin_amdgcn_readfirstlane(o.code); const int code = rawc & 0xff; const long long n = o.n;
        switch (code) {
        case OP_FGEMM: {
            const int fl = rfl(o.i6);
            pg8::Gemm g{uni_ptr((const pg8::bf16_t*)o.a), uni_ptr((const pg8::bf16_t*)o.b), MPAD, rfl(o.i5), rfl(o.i1), rfl(o.i2), rfl(o.i3)};
            if (rawc & OPF_GROUP) {
                int ng = 1; while (ng < 8 && (rfl(tab[i + ng - 1].code) & OPF_GROUP)) ++ng;
                const PG8_LAS Op* gt = (const PG8_LAS Op*)((PG8_LAS unsigned char*)lds + TAB_OFF) + i;
                pg8::GroupOrder S; S.tab = gt; S.ng = ng; S.nM = MPAD / 256; S.G = nb_; S.c = bid_; S.tsA = (size_t)256 * g.lda * 2; S.tsB = (size_t)256 * g.ldb * 2;
                pg8::EpiGroup E{gt, dm.M};
                pg8::gemm_phase<pg8::EpiGroup, pg8::GroupOrder, true, true>((PG8_LAS unsigned char*)lds, g, S, E);
                i += ng - 1;
            } else {
            pg8::StaticOrder S; S.init(g, nb_, bid_); if (fl & 2) S.acs = 512;
            float* const c0 = uni_ptr(o.o0); const int ldc0 = rfl(o.i4), nreal0 = rfl(o.i0);
            if (fl & 1) { pg8::EpiBf16Plain E{(pg8::bf16_t*)c0, ldc0}; pg8::gemm_phase<pg8::EpiBf16Plain, pg8::StaticOrder, true, true>((PG8_LAS unsigned char*)lds, g, S, E); }
            else { pg8::EpiF32 E{c0, ldc0, dm.M, nreal0}; pg8::gemm_phase<pg8::EpiF32, pg8::StaticOrder, true, true>((PG8_LAS unsigned char*)lds, g, S, E); }
            }
        } break;
        case OP_LRUG2: {
            pg8::Gemm g{uni_ptr((const pg8::bf16_t*)o.a), uni_ptr((const pg8::bf16_t*)o.b), MPAD, 1024, 512, 512, 512};
            pg8::StaticOrder S; S.init(g, nb_, bid_);
            pg8::EpiLru E{uni_ptr(o.c), uni_ptr(o.d), uni_ptr(o.e), uni_ptr(o.f), uni_ptr(o.o0), uni_ptr(o.o1), dm.M};
            pg8::gemm_phase<pg8::EpiLru, pg8::StaticOrder, true, true>((PG8_LAS unsigned char*)lds, g, S, E);
        } break;
        case OP_WKVP: fk::wkv2_phase(gp((const fk::bf16_t*)o.a), gp((const fk::bf16_t*)o.b), gp((const fk::bf16_t*)o.c), gp((const fk::bf16_t*)o.d), gp((const fk::bf16_t*)o.e), gp((const fk::bf16_t*)o.f), gp(o.g), gp(o.h), gp((const float*)o.o5), gp(o.o0), gp(o.o1), gp(o.o2), gp(o.o3), gp(o.o4), rfl(o.i0), dm.B, dm.T, dm.DB, dm.DT, (LAS unsigned char*)lds, tid_, bid_, nb_); break;
        case OP_POST2: fk::rwkvpost2_phase(gp(o.a), gp((const fk::bf16_t*)o.b), gp(o.c), gp(o.d), gp(o.e), gp(o.f), gp((fk::bf16_t*)o.o0), dm.M * 16, tid_ & 63, bid_ * 8 + (tid_ >> 6), nb_ * 8); break;
        case OP_GLAF: fk::gla_phase(gp(o.a), gp(o.b), gp(o.o0), gp(o.o1), dm.B, dm.T, (LAS unsigned char*)lds, tid_, bid_, nb_); break;
        case OP_PACTS: fk::pacts_phase(gp((const unsigned char*)o.a), gp((const unsigned char*)o.b), gp((const int*)o.d), gp(o.o0), dm.M, rfl(o.i0), (LAS unsigned char*)lds, rfl(tid_ >> 6), tid_ & 63, bid_, nb_); break;
        case OP_POUTS: fk::pouts_phase(gp(o.a), gp((const int*)o.b), gp((const unsigned char*)o.c), gp((fk::bf16_t*)o.o0), dm.M, tid_ >> 6, tid_ & 63, bid_, nb_); break;
        case OP_TOPK2: fk::topk_phase(gp(o.a), gp((const fk::bf16_t*)o.b), gp(o.c), gp(o.o0), gp((int*)o.o1), dm.M * 8, (LAS unsigned char*)lds, tid_ >> 6, tid_ & 63, bid_ * 8 + (tid_ >> 6), nb_ * 8); break;
        case OP_LNRES: fk::lnres_phase(gp((const fk::bf16_t*)o.a), gp(o.b), gp(o.c), gp(o.o0), gp((fk::bf16_t*)o.o1), gp((unsigned char*)o.o2), dm.M, tid_ & 63, bid_ * 8 + (tid_ >> 6), nb_ * 8); break;
        case OP_GLANORM: fk::glanorm_phase(gp(o.a), gp(o.b), gp(o.c), gp((fk::bf16_t*)o.o0), dm.M * 4, tid_ & 63, bid_ * 8 + (tid_ >> 6), nb_ * 8); break;
#define NVC(c) case c: for (long long g = g0; g < n; g += gs) nv_elem(c, o, dm, g); break;
        NVC(OP_LOGA4) NVC(OP_CONVOUT) NVC(OP_SHIFTOUT) NVC(OP_EMBED4) NVC(OP_YOUT4) NVC(OP_MIX6) NVC(OP_CONV4) NVC(OP_CVT8) NVC(OP_WGATE)
        NVC(OP_WT) NVC(OP_CVTTAB8S) NVC(OP_PRED) NVC(OP_PRM) NVC(OP_KEYS) NVC(OP_GLA3) NVC(OP_LRU1) NVC(OP_LRU2) NVC(OP_LRU3)
#undef NVC
        default: break;
        }
        if (__builtin_amdgcn_readfirstlane(tab[i].code) & OPF_NOBAR) __syncthreads(); else { XcdBarrier bar; bar.bar = (unsigned*)a.ws; bar.x = xb_xcc_id(); bar.st = ctl + 8; xcd_barrier(bar); }
    }
}
extern "C" void kernel_launch(void* const* d_in, const int* in_sizes, int n_in, void* d_out, int out_size, void* d_ws, size_t ws_size, hipStream_t stream) {
    static int grid = 0;
    if (grid == 0) {
        if (n_in != 47 || ws_size < ((size_t)900 << 20)) { fprintf(stderr, "kernel_launch: expected 47 inputs and >= 900 MiB of workspace; got %d, %zu\n", n_in, ws_size); grid = -1; return; }
        int dev = 0, cus = 0, per_cu = 0;
        if (hipGetDevice(&dev) != hipSuccess || hipDeviceGetAttribute(&cus, hipDeviceAttributeMultiprocessorCount, dev) != hipSuccess) { grid = -1; return; }
        if (hipFuncSetAttribute((const void*)mega_fwd, hipFuncAttributeMaxDynamicSharedMemorySize, LDS_BYTES) != hipSuccess) { fprintf(stderr, "kernel_launch: hipFuncSetAttribute failed\n"); grid = -1; return; }
        if (hipOccupancyMaxActiveBlocksPerMultiprocessor(&per_cu, (const void*)mega_fwd, MK_THREADS, LDS_BYTES) != hipSuccess || per_cu < 1) fprintf(stderr, "kernel_launch: occupancy query says %d per CU\n", per_cu);
        (void)hipGetLastError();
        grid = cus;
    }
    if (grid < 0) return;
    if (hipMemsetAsync(d_ws, 0, CTL_BYTES, stream) != hipSuccess) { fprintf(stderr, "kernel_launch: memset failed\n"); return; }
    MArgs a{}; for (int i = 0; i < 47; ++i) a.in[i] = (const float*)d_in[i]; a.out = (float*)d_out; a.ws = (char*)d_ws; a.ws_size = (unsigned long long)ws_size;
    hipLaunchKernelGGL(mega_fwd, dim3(grid), dim3(MK_THREADS), LDS_BYTES, stream, a);
}
```

```cpp
#include <hip/hip_runtime.h>
#include <cstdio>
#include <cmath>
#ifndef HD
#define HD __host__ __device__ __forceinline__
#endif
struct Dm { int D, B, T, DB, DT, M, NSEQ, RH; };
HD Dm make_dm(int D, int B, int SEQ, int DB, int DT) { Dm d; d.D = D; d.B = B; d.T = SEQ + 16; d.DB = DB; d.DT = DT; d.M = B * d.T + DB * DT; d.NSEQ = B + DB; d.RH = D / 64; return d; }
HD int seq_row0(const Dm& d, int s) { return s < d.B ? s * d.T : d.B * d.T + (s - d.B) * d.DT; }
HD int seq_len(const Dm& d, int s) { return s < d.B ? d.T : d.DT; }
HD void row_to_seq(const Dm& d, int row, int& s, int& t) { if (row < d.B * d.T) { s = row / d.T; t = row % d.T; } else { int r = row - d.B * d.T; s = d.B + r / d.DT; t = r % d.DT; } }

constexpr int MIXIN = 2576, C_Q = 0, C_K = 256, C_V = 512, C_GLR = 1024, C_R = 1040, C_XB = 1552, C_GB = 2064;

enum { OP_EMBED = 1, OP_GEMM, OP_LOGA, OP_GLA, OP_GLANORM, OP_CONV, OP_CONVOUT, OP_LRUG, OP_LRUSCAN, OP_LNRES, OP_MIX, OP_SHIFTOUT,
       OP_RWKVPREP, OP_WKV, OP_RWKVPOST, OP_QNORM, OP_SCORES, OP_TOPK, OP_PACT1, OP_PACT2, OP_POUT, OP_YOUT, OP_WT, OP_CVT, OP_FGEMM, OP_CVTTAB, OP_KEYS, OP_TOPK2, OP_PACT, OP_POUTLN, OP_GLA1, OP_GLA2, OP_GLA3, OP_LRU1, OP_LRU2, OP_LRU3, OP_EMBED4, OP_YOUT4, OP_MIX8, OP_CONV4, OP_CVT8, OP_WGATE, OP_LRUG2, OP_WKVF, OP_GLAF, OP_CVTTAB8, OP_CVTTAB8S, OP_PACTS, OP_PRED, OP_POUTS, OP_MIX6, OP_PRM, OP_WKVP, OP_POST2, OP_LOGA4 };

constexpr int OPF_NOBAR = 0x100, OPF_GROUP = 0x200;
struct Op {
    const float *a, *b, *c, *d, *e, *f, *g, *h;
    float *o0, *o1, *o2, *o3, *o4, *o5;
    long long n;
    int code, i0, i1, i2, i3, i4, i5, i6;
};

#if defined(__HIP_DEVICE_COMPILE__)
#define NV_UNI(x) __builtin_amdgcn_readfirstlane(x)
#define NV_LAUNDER(p) asm volatile("" : "+s"(p))
#define NV_FENCE() asm volatile("" ::: "memory")
#else
#define NV_FENCE() do {} while (0)
#define NV_UNI(x) (x)
#define NV_LAUNDER(p) do {} while (0)
#endif
typedef unsigned short nvbf;
HD nvbf nv_f2bf(float f) { unsigned u; __builtin_memcpy(&u, &f, 4); return (nvbf)((u + 0x7fffu + ((u >> 16) & 1u)) >> 16); }
HD float nv_bf2f(nvbf h) { unsigned u = (unsigned)h << 16; float f; __builtin_memcpy(&f, &u, 4); return f; }
HD unsigned nv_f2e4m3(float f) {
    unsigned u; __builtin_memcpy(&u, &f, 4); const unsigned sign = (u >> 24) & 0x80u; const float a = fabsf(f);
    if (!(a < 448.f)) return sign | 0x7Eu;
    if (a < 0.015625f) return sign | (unsigned)rintf(a * 512.f);
    unsigned au = u & 0x7fffffffu; au += 0x7ffffu + ((au >> 20) & 1u);
    const unsigned e = ((au >> 23) & 0xffu) - 120u, m = (au >> 20) & 7u; unsigned code = (e << 3) | m; if (code > 0x7Eu) code = 0x7Eu;
    return sign | code; }
HD float nv_e4m32f(unsigned c) { const unsigned e = (c >> 3) & 15u, m = c & 7u; const float v = e ? ldexpf(1.f + m * 0.125f, (int)e - 7) : m * 0.001953125f; return (c & 0x80u) ? -v : v; }
HD int nv_rup(int x, int m) { return (x + m - 1) / m * m; }
struct alignas(16) NvF4 { float x, y, z, w; };
struct alignas(16) NvU4 { unsigned x, y, z, w; };
struct alignas(8) NvU2 { unsigned x, y; };
#if defined(__HIP_DEVICE_COMPILE__)
#define NV_EXP(x) __expf(x)
#define NV_TANH(x) (1.f - 2.f * __builtin_amdgcn_rcpf(1.f + __expf(2.f * (x))))
HD float nv_sigmoid(float x) { return __builtin_amdgcn_rcpf(1.f + __expf(-x)); }
HD float nv_softplus(float x) { return fmaxf(x, 0.f) + __logf(1.f + __expf(-fabsf(x))); }
HD float nv_gelu(float x) { return x * __builtin_amdgcn_rcpf(1.f + __expf(-1.5957691216057308f * (x + 0.044715f * x * x * x))); }
#else
#define NV_EXP(x) expf(x)
#define NV_TANH(x) tanhf(x)
HD float nv_sigmoid(float x) { return 1.f / (1.f + expf(-x)); }
HD float nv_softplus(float x) { return fmaxf(x, 0.f) + log1pf(expf(-fabsf(x))); }
HD float nv_gelu(float x) { return 0.5f * x * (1.f + tanhf(0.7978845608028654f * (x + 0.044715f * x * x * x))); }
#endif

#define NV_INS16(tv, ti, val, idx) do { float _v = (val); int _i = (idx); _Pragma("unroll") for (int _j = 0; _j < 16; ++_j) { if (_v > tv[_j]) { float _tv = tv[_j]; int _ti = ti[_j]; tv[_j] = _v; ti[_j] = _i; _v = _tv; _i = _ti; } } } while (0)

HD void nv_elem(const int code, const Op& p, const Dm& dm, long long gid) {
    const int D = dm.D; float* const PO1 = p.o1; float* const PO2 = p.o2;
    switch (code) {
    case OP_EMBED: {
        int row = (int)(gid / D), c = (int)(gid % D); float v;
        if (row < dm.B * dm.T) { int bb = row / dm.T, t = row % dm.T; v = t < 16 ? p.c[t * D + c] : p.a[((size_t)bb * (dm.T - 16) + (t - 16)) * D + c]; }
        else v = p.b[(size_t)(row - dm.B * dm.T) * D + c];
        p.o0[gid] = v; ((nvbf*)p.o1)[gid] = nv_f2bf(v); } break;
    case OP_GEMM: {
        int N4 = p.i0 >> 2, K = p.i1; int m = (int)(gid / N4), nn = (int)(gid % N4) * 4; const float* A = p.a + (size_t)m * p.i2; const float* Bw = p.b + nn; float c0 = 0.f, c1 = 0.f, c2 = 0.f, c3 = 0.f;
        for (int k = 0; k < K; ++k) { float av = A[k]; if (p.i5 == 1) av = NV_TANH(av); else if (p.i5 == 2) av = nv_sigmoid(av); const NvF4 bv = *(const NvF4*)(Bw + (size_t)k * p.i3);
            c0 = fmaf(av, bv.x, c0); c1 = fmaf(av, bv.y, c1); c2 = fmaf(av, bv.z, c2); c3 = fmaf(av, bv.w, c3); }
        float* C = p.o0 + (size_t)m * p.i4 + nn; C[0] = c0; C[1] = c1; C[2] = c2; C[3] = c3; } break;
    case OP_LOGA: {
        int row = (int)(gid / 256), c = (int)(gid % 256); float z = p.c[c];
        for (int r = 0; r < 16; ++r) z = fmaf(p.a[(size_t)row * MIXIN + C_GLR + r], p.b[r * 256 + c], z);
        p.o0[gid] = NV_EXP(-nv_softplus(-z) * (1.f / 16.f)); } break;
    case OP_GLAF:
    case OP_GLA: {
        int s = (int)(gid / 512), h = (int)((gid / 128) % 4), col = (int)(gid % 128);
        float S[64];
        const float* sin = (s < dm.B) ? nullptr : p.c + (((size_t)(s - dm.B) * 4 + h) * 64) * 128 + col;
#pragma unroll
        for (int k = 0; k < 64; ++k) S[k] = sin ? sin[(size_t)k * 128] : 0.f;
        int r0 = seq_row0(dm, s), L = seq_len(dm, s);
        for (int t = 0; t < L; ++t) {
            const float* pr = p.a + (size_t)(r0 + t) * MIXIN; const float* la = p.b + (size_t)(r0 + t) * 256 + h * 64;
            float v = pr[C_V + h * 128 + col], o = 0.f;
#pragma unroll
            for (int k = 0; k < 64; ++k) { if ((k & 7) == 0) NV_FENCE(); S[k] = fmaf(la[k], S[k], pr[C_K + h * 64 + k] * v); o = fmaf(pr[C_Q + h * 64 + k] * 0.125f, S[k], o); }
            p.o0[(size_t)(r0 + t) * 512 + h * 128 + col] = o;
        }
        float* so = (s < dm.B) ? PO1 + (((size_t)s * 4 + h) * 64) * 128 + col : PO2 + (((size_t)(s - dm.B) * 4 + h) * 64) * 128 + col;
#pragma unroll
        for (int k = 0; k < 64; ++k) so[(size_t)k * 128] = S[k]; } break;
    case OP_GLA1: {
        const int NC = p.i0; const int u = NV_UNI((int)(gid / 128)), col = (int)(gid % 128); const int s = u / (4 * NC), h = (u / NC) % 4, c = u % NC;
        const int r0 = seq_row0(dm, s) + c * 64; int L = dm.T - c * 64; L = L > 64 ? 64 : L;
        float S[64];
#pragma unroll
        for (int k = 0; k < 64; ++k) S[k] = 0.f;
        float dprod = 1.f;
        for (int t = 0; t < L; ++t) {
            const float* pr = p.a + (size_t)(r0 + t) * MIXIN; const float* la = p.b + (size_t)(r0 + t) * 256 + h * 64; const float v = pr[C_V + h * 128 + col];
            if (col < 64) dprod *= la[col];
#pragma unroll
            for (int k = 0; k < 64; ++k) { if ((k & 7) == 0) NV_FENCE(); S[k] = fmaf(la[k], S[k], pr[C_K + h * 64 + k] * v); }
        }
        float* so = p.o0 + (size_t)u * 8192 + col;
#pragma unroll
        for (int k = 0; k < 64; ++k) so[(size_t)k * 128] = S[k];
        if (col < 64) p.o1[(size_t)u * 64 + col] = dprod; } break;
    case OP_GLA2: {
        const int NC = p.i0; const int pair = (int)(gid / 8192), e = (int)(gid % 8192), dk = e / 128; float S = 0.f;
        for (int c = 0; c < NC; ++c) { const size_t ix = ((size_t)pair * NC + c) * 8192 + e; const float l = p.o0[ix]; p.o0[ix] = S; S = fmaf(p.a[((size_t)pair * NC + c) * 64 + dk], S, l); }
        p.o1[gid] = S; } break;
    case OP_GLA3: {
        const int NC = p.i0; const int NP = dm.B * 4 * NC; const int u = NV_UNI((int)(gid / 128)) + (p.i1 ? NP : 0), col = (int)(gid % 128); int s, h, r0, L; const float* sin; float* sout = nullptr;
        if (u < NP) { s = u / (4 * NC); h = (u / NC) % 4; const int c = u % NC; r0 = seq_row0(dm, s) + c * 64; L = dm.T - c * 64; L = L > 64 ? 64 : L; sin = p.d + (size_t)u * 8192 + col; }
        else { const int q = u - NP; s = dm.B + q / 4; h = q % 4; r0 = seq_row0(dm, s); L = dm.DT; sin = p.c + (((size_t)(s - dm.B) * 4 + h) * 64) * 128 + col; sout = p.o2 + (((size_t)(s - dm.B) * 4 + h) * 64) * 128 + col; }
        float S[64];
#pragma unroll
        for (int k = 0; k < 64; ++k) S[k] = sin[(size_t)k * 128];
        for (int t = 0; t < L; ++t) {
            const float* pr = p.a + (size_t)(r0 + t) * MIXIN; const float* la = p.b + (size_t)(r0 + t) * 256 + h * 64; const float v = pr[C_V + h * 128 + col]; float o = 0.f;
#pragma unroll
            for (int k = 0; k < 64; ++k) { if ((k & 7) == 0) NV_FENCE(); S[k] = fmaf(la[k], S[k], pr[C_K + h * 64 + k] * v); o = fmaf(pr[C_Q + h * 64 + k] * 0.125f, S[k], o); }
            p.o0[(size_t)(r0 + t) * 512 + h * 128 + col] = o;
        }
        if (sout) {
#pragma unroll
            for (int k = 0; k < 64; ++k) sout[(size_t)k * 128] = S[k]; } } break;
    case OP_LRU1: {
        const int NC = p.i0; const int u = (int)(gid / 512), c = (int)(gid % 512); const int s = u / NC, ch = u % NC; const int r0 = seq_row0(dm, s) + ch * 64; int L = dm.T - ch * 64; L = L > 64 ? 64 : L; float hh = 0.f, ap = 1.f;
#pragma unroll 8
        for (int t = 0; t < L; ++t) { const size_t ix = (size_t)(r0 + t) * 512 + c; const float a = p.a[ix]; hh = fmaf(a, hh, p.b[ix]); ap *= a; }
        p.o0[gid] = ap; p.o1[gid] = hh; } break;
    case OP_LRU2: {
        const int NC = p.i0; const int s = (int)(gid / 512), c = (int)(gid % 512); float hh = 0.f;
#pragma unroll 8
        for (int ch = 0; ch < NC; ++ch) { const size_t ix = ((size_t)s * NC + ch) * 512 + c; const float l = p.o0[ix]; p.o0[ix] = hh; hh = fmaf(p.a[ix], hh, l); }
        p.o1[gid] = hh; } break;
    case OP_LRU3: {
        const int NC = p.i0; const int u = (int)(gid / 512), c = (int)(gid % 512); const int NP = dm.B * NC; int r0, L; float hh; float* hout = nullptr;
        if (u < NP) { const int s = u / NC, ch = u % NC; r0 = seq_row0(dm, s) + ch * 64; L = dm.T - ch * 64; L = L > 64 ? 64 : L; hh = p.e[gid]; }
        else { const int q = u - NP; r0 = seq_row0(dm, dm.B + q); L = dm.DT; hh = p.d[(size_t)q * 512 + c]; hout = p.o2 + (size_t)q * 512 + c; }
#pragma unroll 8
        for (int t = 0; t < L; ++t) { const size_t r = (size_t)(r0 + t); hh = fmaf(p.a[r * 512 + c], hh, p.b[r * 512 + c]); ((nvbf*)p.o0)[r * 1024 + 512 + c] = nv_f2bf(hh * nv_gelu(p.c[r * MIXIN + C_GB + c])); }
        if (hout) *hout = hh; } break;
    case OP_EMBED4: {
        const int D4 = D / 4; const int row = (int)(gid / D4), c = (int)(gid % D4) * 4; const float* src;
        if (row < dm.B * dm.T) { const int bb = row / dm.T, t = row % dm.T; src = t < 16 ? p.c + (size_t)t * D + c : p.a + ((size_t)bb * (dm.T - 16) + (t - 16)) * D + c; } else src = p.b + (size_t)(row - dm.B * dm.T) * D + c;
        const NvF4 v = *(const NvF4*)src; *(NvF4*)(p.o0 + (size_t)row * D + c) = v; NvU2 w; w.x = nv_f2bf(v.x) | ((unsigned)nv_f2bf(v.y) << 16); w.y = nv_f2bf(v.z) | ((unsigned)nv_f2bf(v.w) << 16); *(NvU2*)((nvbf*)p.o1 + (size_t)row * D + c) = w; } break;
    case OP_YOUT4: {
        const int D4 = D / 4; const int row = (int)(gid / D4), c = (int)(gid % D4) * 4; const NvF4 v = *(const NvF4*)(p.a + (size_t)row * D + c);
        if (row < dm.B * dm.T) { const int bb = row / dm.T, t = row % dm.T; if (t >= 16) *(NvF4*)(p.o0 + ((size_t)bb * (dm.T - 16) + (t - 16)) * D + c) = v; }
        else *(NvF4*)(p.o0 + ((size_t)dm.B * (dm.T - 16) + (row - dm.B * dm.T)) * D + c) = v; } break;
    case OP_MIX8: {
        const int D8 = D / 8; const int row = (int)(gid / D8), c = (int)(gid % D8) * 8; int s, t; row_to_seq(dm, row, s, t); const float* x = p.a + (size_t)row * D + c; float xp[8];
        if (t > 0) { for (int i = 0; i < 8; ++i) xp[i] = x[i - D]; } else if (s < dm.B) { for (int i = 0; i < 8; ++i) xp[i] = 0.f; } else { for (int i = 0; i < 8; ++i) xp[i] = p.b[(size_t)(s - dm.B) * D + c + i]; }
        unsigned w[4];
#pragma unroll
        for (int i = 0; i < 4; ++i) { const float lo = x[2 * i] + (xp[2 * i] - x[2 * i]) * p.c[c + 2 * i], hi = x[2 * i + 1] + (xp[2 * i + 1] - x[2 * i + 1]) * p.c[c + 2 * i + 1]; w[i] = nv_f2bf(lo) | ((unsigned)nv_f2bf(hi) << 16); }
        NvU4 o; o.x = w[0]; o.y = w[1]; o.z = w[2]; o.w = w[3]; *(NvU4*)((nvbf*)p.o0 + (size_t)row * D + c) = o; } break;
    case OP_MIX6: {
        const int D8 = D / 8; const int row = (int)(gid / D8), c = (int)(gid % D8) * 8; int s, t; row_to_seq(dm, row, s, t); const float* x = p.a + (size_t)row * D + c; float xv[8], dx[8];
        for (int i = 0; i < 8; ++i) xv[i] = x[i];
        if (t > 0) { for (int i = 0; i < 8; ++i) dx[i] = x[i - D] - xv[i]; } else if (s < dm.B) { for (int i = 0; i < 8; ++i) dx[i] = -xv[i]; } else { for (int i = 0; i < 8; ++i) dx[i] = p.b[(size_t)(s - dm.B) * D + c + i] - xv[i]; }
        for (int m = 0; m < 6; ++m) { const float* mu = p.c + (size_t)m * D + c; unsigned w[4];
#pragma unroll
            for (int i = 0; i < 4; ++i) w[i] = nv_f2bf(xv[2 * i] + dx[2 * i] * mu[2 * i]) | ((unsigned)nv_f2bf(xv[2 * i + 1] + dx[2 * i + 1] * mu[2 * i + 1]) << 16);
            NvU4 o; o.x = w[0]; o.y = w[1]; o.z = w[2]; o.w = w[3]; *(NvU4*)((nvbf*)p.o0 + (size_t)m * p.i0 * 0 + (size_t)m * (size_t)p.i1 * 1024 + (size_t)row * D + c) = o; } } break;
    case OP_CONV4: {
        const int row = (int)(gid / 128), c = (int)(gid % 128) * 4; int s, t; row_to_seq(dm, row, s, t); float acc[4];
        for (int q = 0; q < 4; ++q) acc[q] = p.d[c + q];
        for (int i = 0; i < 4; ++i) { const int j = t + i; const float* xv = nullptr;
            if (j < 3) { if (s >= dm.B) xv = p.b + ((size_t)(s - dm.B) * 3 + j) * 512 + c; } else xv = p.a + (size_t)(row - t + (j - 3)) * MIXIN + C_XB + c;
            if (xv) for (int q = 0; q < 4; ++q) acc[q] = fmaf(xv[q], p.c[i * 512 + c + q], acc[q]); }
        NvF4 o; o.x = acc[0]; o.y = acc[1]; o.z = acc[2]; o.w = acc[3]; *(NvF4*)(p.o0 + (size_t)row * 512 + c) = o;
        NvU2 w; w.x = nv_f2bf(acc[0]) | ((unsigned)nv_f2bf(acc[1]) << 16); w.y = nv_f2bf(acc[2]) | ((unsigned)nv_f2bf(acc[3]) << 16); *(NvU2*)((nvbf*)p.o1 + (size_t)row * 512 + c) = w; } break;
    case OP_CVT8: {
        const int K8 = p.i2 / 8; const int row = (int)(gid / K8), k = (int)(gid % K8) * 8; unsigned w[4] = {0u, 0u, 0u, 0u};
        if (row < dm.M && k < p.i0) { const float* sp = p.a + (size_t)row * p.i1 + k;
#pragma unroll
            for (int i = 0; i < 4; ++i) { float lo = sp[2 * i], hi = sp[2 * i + 1]; if (p.i3 == 1) { lo = NV_TANH(lo); hi = NV_TANH(hi); } else if (p.i3 == 2) { lo = nv_sigmoid(lo); hi = nv_sigmoid(hi); } w[i] = nv_f2bf(lo) | ((unsigned)nv_f2bf(hi) << 16); } }
        NvU4 o; o.x = w[0]; o.y = w[1]; o.z = w[2]; o.w = w[3]; *(NvU4*)((nvbf*)p.o0 + (size_t)row * p.i2 + k) = o; } break;
    case OP_WGATE: {
        const int n = (int)gid, pn = n >> 8, within = n & 127, isx = (n >> 7) & 1, c = pn * 128 + within, nb = c >> 6, e = c & 63; const float* w = isx ? p.b : p.a; nvbf* dst = (nvbf*)p.o0 + (size_t)n * 512;
        for (int k = 0; k < 512; ++k) dst[k] = ((k >> 6) == nb) ? nv_f2bf(w[((size_t)nb * 64 + (k & 63)) * 64 + e]) : (nvbf)0;
        if (n < 512) p.o1[n] = -8.f * nv_softplus(-p.c[n]); } break;
    case OP_LRUG2: {
        const int row = (int)(gid / 512), c = (int)(gid % 512), pn = c >> 7, within = c & 127; const nvbf* x = (const nvbf*)p.a + (size_t)row * 512; const nvbf* wa_ = (const nvbf*)p.b + (size_t)(pn * 256 + within) * 512; const nvbf* wx_ = wa_ + (size_t)128 * 512; float ga = 0.f, gx = 0.f;
        for (int k = 0; k < 512; ++k) { const float xv = nv_bf2f(x[k]); ga = fmaf(xv, nv_bf2f(wa_[k]), ga); gx = fmaf(xv, nv_bf2f(wx_[k]), gx); }
        const float gate_a = nv_sigmoid(ga + p.c[c]), gate_x = nv_sigmoid(gx + p.d[c]); const float log_at = gate_a * p.e[c];
        p.o0[gid] = NV_EXP(log_at); p.o1[gid] = sqrtf(-expm1f(2.f * log_at)) * (gate_x * p.f[gid]); } break;
    case OP_LOGA4: {
        const int row = (int)(gid / 64), c = (int)(gid % 64) * 4; const float* gl = p.a + (size_t)row * MIXIN + C_GLR; NvF4 z = *(const NvF4*)(p.c + c);
#pragma unroll
        for (int r4 = 0; r4 < 4; ++r4) { const NvF4 g = *(const NvF4*)(gl + 4 * r4);
            const NvF4 w0 = *(const NvF4*)(p.b + (4 * r4 + 0) * 256 + c), w1 = *(const NvF4*)(p.b + (4 * r4 + 1) * 256 + c), w2 = *(const NvF4*)(p.b + (4 * r4 + 2) * 256 + c), w3 = *(const NvF4*)(p.b + (4 * r4 + 3) * 256 + c);
            z.x = fmaf(g.x, w0.x, z.x); z.y = fmaf(g.x, w0.y, z.y); z.z = fmaf(g.x, w0.z, z.z); z.w = fmaf(g.x, w0.w, z.w); z.x = fmaf(g.y, w1.x, z.x); z.y = fmaf(g.y, w1.y, z.y); z.z = fmaf(g.y, w1.z, z.z); z.w = fmaf(g.y, w1.w, z.w);
            z.x = fmaf(g.z, w2.x, z.x); z.y = fmaf(g.z, w2.y, z.y); z.z = fmaf(g.z, w2.z, z.z); z.w = fmaf(g.z, w2.w, z.w); z.x = fmaf(g.w, w3.x, z.x); z.y = fmaf(g.w, w3.y, z.y); z.z = fmaf(g.w, w3.z, z.z); z.w = fmaf(g.w, w3.w, z.w); }
        NvF4 o; o.x = NV_EXP(-nv_softplus(-z.x) * (1.f / 16.f)); o.y = NV_EXP(-nv_softplus(-z.y) * (1.f / 16.f)); o.z = NV_EXP(-nv_softplus(-z.z) * (1.f / 16.f)); o.w = NV_EXP(-nv_softplus(-z.w) * (1.f / 16.f));
        *(NvF4*)(p.o0 + (size_t)row * 256 + c) = o; } break;
    case OP_GLANORM: {
        int row = (int)(gid / 4), h = (int)(gid % 4); const float* o = p.a + (size_t)row * 512 + h * 128; float ss = 0.f;
        for (int c = 0; c < 128; ++c) ss = fmaf(o[c], o[c], ss);
        float rs = 1.f / sqrtf(ss * (1.f / 128.f) + 1e-5f);
        for (int c = 0; c < 128; ++c) { float r = p.b[(size_t)row * MIXIN + C_R + h * 128 + c]; ((nvbf*)p.o0)[(size_t)row * 1024 + h * 128 + c] = nv_f2bf(o[c] * rs * p.c[c] * (r * nv_sigmoid(r))); } } break;
    case OP_CONV: {
        int row = (int)(gid / 512), c = (int)(gid % 512); int s, t; row_to_seq(dm, row, s, t); float acc = p.d[c];
        for (int i = 0; i < 4; ++i) { int j = t + i; float xv;
            if (j < 3) xv = (s < dm.B) ? 0.f : p.b[((size_t)(s - dm.B) * 3 + j) * 512 + c]; else xv = p.a[(size_t)(row - t + (j - 3)) * MIXIN + C_XB + c];
            acc = fmaf(xv, p.c[i * 512 + c], acc); }
        p.o0[gid] = acc; } break;
    case OP_CONVOUT: {
        int s = (int)(gid / 1536), i = (int)((gid / 512) % 3), c = (int)(gid % 512); int L = seq_len(dm, s), r0 = seq_row0(dm, s); int j = L + i; float xv;
        if (j < 3) xv = (s < dm.B) ? 0.f : p.b[((size_t)(s - dm.B) * 3 + j) * 512 + c]; else xv = p.a[(size_t)(r0 + j - 3) * MIXIN + C_XB + c];
        float* o = (s < dm.B) ? PO1 + ((size_t)s * 3 + i) * 512 + c : PO2 + ((size_t)(s - dm.B) * 3 + i) * 512 + c; *o = xv; } break;
    case OP_LRUG: {
        int row = (int)(gid / 512), c = (int)(gid % 512), nb = c / 64, e = c % 64; const float* x = p.a + (size_t)row * 512 + nb * 64; float ga = p.c[c], gx = p.e[c];
        for (int dd = 0; dd < 64; ++dd) { ga = fmaf(x[dd], p.b[((size_t)nb * 64 + dd) * 64 + e], ga); gx = fmaf(x[dd], p.d[((size_t)nb * 64 + dd) * 64 + e], gx); }
        float gate_a = nv_sigmoid(ga), gate_x = nv_sigmoid(gx); float log_at = -8.f * gate_a * nv_softplus(-p.f[c]);
        p.o0[gid] = NV_EXP(log_at); p.o1[gid] = sqrtf(-expm1f(2.f * log_at)) * (gate_x * p.a[(size_t)row * 512 + c]); } break;
    case OP_LRUSCAN: {
        int s = (int)(gid / 512), c = (int)(gid % 512); int r0 = seq_row0(dm, s), L = seq_len(dm, s); float hh = (s < dm.B) ? 0.f : p.d[(size_t)(s - dm.B) * 512 + c];
        for (int t = 0; t < L; ++t) { size_t r = (size_t)(r0 + t); hh = fmaf(p.a[r * 512 + c], hh, p.b[r * 512 + c]); p.o0[r * 1024 + 512 + c] = hh * nv_gelu(p.c[r * MIXIN + C_GB + c]); }
        float* o = (s < dm.B) ? PO1 + (size_t)s * 512 + c : PO2 + (size_t)(s - dm.B) * 512 + c; *o = hh; } break;
    case OP_LNRES: {
        const float alpha = 1.6817928305074292f; float* x = p.o0 + (size_t)gid * D; const nvbf* y = (const nvbf*)p.a + (size_t)gid * D; float mu = 0.f;
        for (int c = 0; c < D; ++c) mu += alpha * x[c] + nv_bf2f(y[c]);
        mu /= D; float var = 0.f;
        for (int c = 0; c < D; ++c) { float v = alpha * x[c] + nv_bf2f(y[c]) - mu; var = fmaf(v, v, var); }
        float rs = 1.f / sqrtf(var / D + 1e-5f);
        for (int c = 0; c < D; ++c) { const float o = (alpha * x[c] + nv_bf2f(y[c]) - mu) * rs * p.b[c] + p.c[c]; x[c] = o; ((nvbf*)p.o1)[(size_t)gid * D + c] = nv_f2bf(o);
            if (p.o2) { unsigned char* f8 = (unsigned char*)p.o2 + (size_t)gid * 2 * D; const float xs = fminf(fmaxf(o * 16.f, -448.f), 448.f); const unsigned hc = nv_f2e4m3(xs); f8[c] = (unsigned char)hc; f8[D + c] = (unsigned char)nv_f2e4m3(xs - nv_e4m32f(hc)); } } } break;
    case OP_MIX: {
        int row = (int)(gid / D), c = (int)(gid % D); int s, t; row_to_seq(dm, row, s, t); float x = p.a[gid];
        float xp = t > 0 ? p.a[gid - D] : ((s < dm.B) ? 0.f : p.b[(size_t)(s - dm.B) * D + c]);
        ((nvbf*)p.o0)[gid] = nv_f2bf(x + (xp - x) * p.c[c]); } break;
    case OP_SHIFTOUT: {
        int s = (int)(gid / D), c = (int)(gid % D); float v = p.a[(size_t)(seq_row0(dm, s) + seq_len(dm, s) - 1) * D + c];
        float* o = (s < dm.B) ? PO1 + (size_t)s * D + c : PO2 + (size_t)(s - dm.B) * D + c; *o = v; } break;
    case OP_RWKVPREP: {
        int row = (int)(gid / dm.RH), h = (int)(gid % dm.RH); size_t base = (size_t)row * D + h * 64; float ss = 0.f;
        for (int k = 0; k < 64; ++k) { float kv = p.o0[base + k] * p.d[h * 64 + k]; ss = fmaf(kv, kv, ss); }
        float inv = 1.f / fmaxf(sqrtf(ss), 1e-12f);
        for (int k = 0; k < 64; ++k) { int c = h * 64 + k; size_t ix = base + k;
            float w = -nv_softplus(-(p.a[c] + p.o1[ix])) - 0.5f; float dec = NV_EXP(-NV_EXP(w));
            float a = nv_sigmoid(p.b[c] + p.o2[ix]);
            float v = p.o3[ix]; if (p.i0) v = v + (p.o5[ix] - v) * nv_sigmoid(p.c[c] + p.f[ix]); else p.o5[ix] = v;
            float k0 = p.o0[ix]; const float kk = k0 * p.d[c] * inv; p.o4[ix] = -kk; p.o0[ix] = k0 * (1.f + (a - 1.f) * p.e[c]); p.o1[ix] = dec; p.o2[ix] = kk * a; p.o3[ix] = v; } } break;
    case OP_WKVF:
    case OP_WKV: {
        int RH = dm.RH; int s = p.i0 + (int)(gid / (RH * 64)), h = (int)((gid / 64) % RH), vr = (int)(gid % 64); float S[64];
        const float* sin = (s < dm.B) ? nullptr : p.g + (((size_t)(s - dm.B) * RH + h) * 64 + vr) * 64;
#pragma unroll
        for (int k = 0; k < 64; ++k) S[k] = sin ? sin[k] : 0.f;
        int r0 = seq_row0(dm, s), L = seq_len(dm, s);
        for (int t = 0; t < L; ++t) { size_t base = (size_t)(r0 + t) * D + h * 64; float sa = 0.f;
#pragma unroll
            for (int k = 0; k < 64; ++k) { if ((k & 7) == 0) NV_FENCE(); sa = fmaf(S[k], p.f[base + k], sa); }
            float vv = p.d[base + vr], y = 0.f;
#pragma unroll
            for (int k = 0; k < 64; ++k) { if ((k & 7) == 0) NV_FENCE(); S[k] = fmaf(S[k], p.b[base + k], fmaf(sa, p.e[base + k], vv * p.c[base + k])); y = fmaf(S[k], p.a[base + k], y); }
            p.o0[base + vr] = y; }
        float* so = (s < dm.B) ? PO1 + (((size_t)s * RH + h) * 64 + vr) * 64 : PO2 + (((size_t)(s - dm.B) * RH + h) * 64 + vr) * 64;
#pragma unroll
        for (int k = 0; k < 64; ++k) so[k] = S[k]; } break;
    case OP_RWKVPOST: {
        int row = (int)(gid / dm.RH), h = (int)(gid % dm.RH); size_t base = (size_t)row * D + h * 64; float mu = 0.f, bon = 0.f;
        for (int k = 0; k < 64; ++k) { mu += p.a[base + k]; bon = fmaf(p.b[base + k] * p.c[base + k], p.f[h * 64 + k], bon); }
        mu *= (1.f / 64.f); float var = 0.f;
        for (int k = 0; k < 64; ++k) { float dlt = p.a[base + k] - mu; var = fmaf(dlt, dlt, var); }
        float rs = 1.f / sqrtf(var * (1.f / 64.f) + 64e-5f);
        for (int k = 0; k < 64; ++k) { int c = h * 64 + k; float y = (p.a[base + k] - mu) * rs * p.g[c] + p.h[c] + bon * p.d[base + k]; ((nvbf*)p.o0)[base + k] = nv_f2bf(y * p.e[base + k]); } } break;
    case OP_PRM: {
        const int m = (int)(gid / D), c = (int)(gid % D); const float* src = m == 0 ? p.a : m == 1 ? p.b : m == 2 ? p.c : m == 3 ? p.d : m == 4 ? p.e : p.f; p.o0[gid] = src ? src[c] : 0.f; } break;
    case OP_WKVP: {
        const int RH = dm.RH; const int s = (int)(gid / (RH * 64)), h = (int)((gid / 64) % RH), vr = (int)(gid % 64); float S[64];
        const float* sin = (s < dm.B) ? nullptr : p.o5 + (((size_t)(s - dm.B) * RH + h) * 64 + vr) * 64;
        for (int k = 0; k < 64; ++k) S[k] = sin ? sin[k] : 0.f;
        const float* w0 = p.h + h * 64; const float* a0 = p.h + D + h * 64; const float* v0 = p.h + 2 * D + h * 64; const float* k_k = p.h + 3 * D + h * 64; const float* k_a = p.h + 4 * D + h * 64; const float* r_k = p.h + 5 * D + h * 64;
        const int r0 = seq_row0(dm, s), L = seq_len(dm, s); const nvbf* bR = (const nvbf*)p.a; const nvbf* bK = (const nvbf*)p.b; const nvbf* bWL = (const nvbf*)p.c; const nvbf* bAL = (const nvbf*)p.d; const nvbf* bV = (const nvbf*)p.e; const nvbf* bVG = (const nvbf*)p.f;
        for (int t = 0; t < L; ++t) { const size_t base = (size_t)(r0 + t) * D + h * 64; float ss = 0.f;
            for (int k = 0; k < 64; ++k) { const float kv = nv_bf2f(bK[base + k]) * k_k[k]; ss = fmaf(kv, kv, ss); }
            const float inv = 1.f / fmaxf(sqrtf(ss), 1e-12f);
            float vv = nv_bf2f(bV[base + vr]); if (p.i0) vv = vv + (p.g[base + vr] - vv) * nv_sigmoid(v0[vr] + nv_bf2f(bVG[base + vr]));
            float sa = 0.f, bon = 0.f, dec[64], bb[64], k2[64];
            for (int k = 0; k < 64; ++k) { const float k0 = nv_bf2f(bK[base + k]); const float kk = k0 * k_k[k] * inv; const float a = nv_sigmoid(a0[k] + nv_bf2f(bAL[base + k]));
                dec[k] = NV_EXP(-0.6065306597126334f * nv_sigmoid(w0[k] + nv_bf2f(bWL[base + k])));
                bb[k] = kk * a; k2[k] = k0 * (1.f + (a - 1.f) * k_a[k]); sa = fmaf(S[k], -kk, sa); bon = fmaf(nv_bf2f(bR[base + k]) * k2[k], r_k[k], bon); }
            float y = 0.f;
            for (int k = 0; k < 64; ++k) { S[k] = fmaf(S[k], dec[k], fmaf(sa, bb[k], vv * k2[k])); y = fmaf(S[k], nv_bf2f(bR[base + k]), y); }
            p.o0[base + vr] = y; p.o3[base + vr] = vv; if (vr == 0) p.o4[(size_t)(r0 + t) * RH + h] = bon; }
        float* so = (s < dm.B) ? PO1 + (((size_t)s * RH + h) * 64 + vr) * 64 : PO2 + (((size_t)(s - dm.B) * RH + h) * 64 + vr) * 64;
        for (int k = 0; k < 64; ++k) so[k] = S[k]; } break;
    case OP_POST2: {
        const int row = (int)(gid / dm.RH), h = (int)(gid % dm.RH); const size_t base = (size_t)row * D + h * 64; float mu = 0.f;
        for (int k = 0; k < 64; ++k) mu += p.a[base + k];
        mu *= (1.f / 64.f); float var = 0.f;
        for (int k = 0; k < 64; ++k) { const float dlt = p.a[base + k] - mu; var = fmaf(dlt, dlt, var); }
        const float rs = 1.f / sqrtf(var * (1.f / 64.f) + 64e-5f), bon = p.d[gid];
        for (int k = 0; k < 64; ++k) { const int c = h * 64 + k; const float y = (p.a[base + k] - mu) * rs * p.e[c] + p.f[c] + bon * p.c[base + k]; ((nvbf*)p.o0)[base + k] = nv_f2bf(y * nv_bf2f(((const nvbf*)p.b)[base + k])); } } break;
    case OP_QNORM: {
        float* q = p.o0 + (size_t)gid * 256; float mu = 0.f;
        for (int c = 0; c < 256; ++c) mu += q[c];
        mu *= (1.f / 256.f); float var = 0.f;
        for (int c = 0; c < 256; ++c) { float dlt = q[c] - mu; var = fmaf(dlt, dlt, var); }
        float rs = 1.f / sqrtf(var * (1.f / 256.f) + 1e-5f);
        for (int c = 0; c < 256; ++c) q[c] = (q[c] - mu) * rs; } break;
    case OP_SCORES: {
        int row = (int)(gid / 2048), r = (int)(gid % 2048), h = r / 256, half = (r / 128) & 1, key = r % 128;
        const float* q = p.a + (size_t)row * 2048 + h * 256 + half * 128; const float* kv = p.b + (((size_t)h * 2 + half) * 128 + key) * 128; float acc = 0.f;
        for (int dd = 0; dd < 128; ++dd) acc = fmaf(q[dd], kv[dd], acc);
        p.o0[gid] = acc; } break;
    case OP_TOPK: {
        const float* sc = p.a + (size_t)gid * 256; float tv[16]; int ti[16]; float* tmpv = p.o2 + (size_t)gid * 32; int* tmpi = (int*)p.o3 + (size_t)gid * 32;
        for (int half = 0; half < 2; ++half) {
#pragma unroll
            for (int j = 0; j < 16; ++j) { tv[j] = -3.0e38f; ti[j] = 0; }
            for (int k = 0; k < 128; ++k) NV_INS16(tv, ti, sc[half * 128 + k], k);
#pragma unroll
            for (int j = 0; j < 16; ++j) { tmpv[half * 16 + j] = tv[j]; tmpi[half * 16 + j] = ti[j]; }
        }
#pragma unroll
        for (int j = 0; j < 16; ++j) { tv[j] = -3.0e38f; ti[j] = 0; }
        for (int i = 0; i < 16; ++i) for (int j = 0; j < 16; ++j) NV_INS16(tv, ti, tmpv[i] + tmpv[16 + j], tmpi[i] * 128 + tmpi[16 + j]);
        float den = 0.f, ev[16];
#pragma unroll
        for (int j = 0; j < 16; ++j) { ev[j] = NV_EXP(tv[j] - tv[0]); den += ev[j]; }
        float inv = 1.f / den;
#pragma unroll
        for (int j = 0; j < 16; ++j) { p.o0[(size_t)gid * 16 + j] = ev[j] * inv; ((int*)p.o1)[(size_t)gid * 16 + j] = ti[j]; } } break;
    case OP_PACT1: {
        size_t pr = (size_t)(gid / 16); int part = (int)(gid % 16); int row = (int)(pr / 128); int e = ((const int*)p.d)[pr]; int w = D / 16;
        const float* u = p.b + (size_t)e * D + part * w; const float* x = p.a + (size_t)row * D + part * w; float acc = 0.f;
        for (int c = 0; c < w; ++c) acc = fmaf(u[c], x[c], acc);
        p.o0[gid] = acc; } break;
    case OP_PACT2: {
        float acc = 0.f; for (int i = 0; i < 16; ++i) acc += p.a[(size_t)gid * 16 + i];
        p.o0[gid] = p.c[gid] * nv_gelu(acc); } break;
    case OP_POUT: {
        int row = (int)(gid / D), c = (int)(gid % D); float acc = 0.f;
        for (int i = 0; i < 128; ++i) acc = fmaf(p.a[(size_t)row * 128 + i], p.c[(size_t)((const int*)p.b)[(size_t)row * 128 + i] * D + c], acc);
        p.o0[gid] = acc; } break;
    case OP_YOUT: {
        int row = (int)(gid / D), c = (int)(gid % D);
        if (row < dm.B * dm.T) { int bb = row / dm.T, t = row % dm.T; if (t >= 16) p.o0[((size_t)bb * (dm.T - 16) + (t - 16)) * D + c] = p.a[gid]; }
        else p.o0[((size_t)dm.B * (dm.T - 16) + (row - dm.B * dm.T)) * D + c] = p.a[gid]; } break;
    case OP_WT: {
        const int N = p.i0, K = p.i1, Np = p.i3, Kp = p.i4; const long long per8 = (long long)Np * (Kp / 8); const int bt = (int)(gid / per8); const long long r = gid % per8; const int k0 = (int)(r / Np) * 8, nn = (int)(r % Np);
        unsigned w[4];
#pragma unroll
        for (int i = 0; i < 4; ++i) { float lo = 0.f, hi = 0.f; if (nn < N) { if (k0 + 2 * i < K) lo = p.a[((size_t)bt * K + k0 + 2 * i) * p.i2 + nn]; if (k0 + 2 * i + 1 < K) hi = p.a[((size_t)bt * K + k0 + 2 * i + 1) * p.i2 + nn]; } w[i] = nv_f2bf(lo) | ((unsigned)nv_f2bf(hi) << 16); }
        NvU4 o; o.x = w[0]; o.y = w[1]; o.z = w[2]; o.w = w[3];
        *(NvU4*)((nvbf*)p.o0 + (size_t)bt * Np * Kp + (size_t)nn * Kp + k0) = o; } break;
    case OP_CVT: {
        const int Kp = p.i2; const int row = (int)(gid / Kp), k = (int)(gid % Kp); float v = 0.f;
        if (row < dm.M && k < p.i0) { v = p.a[(size_t)row * p.i1 + k]; if (p.i3 == 1) v = NV_TANH(v); else if (p.i3 == 2) v = nv_sigmoid(v); }
        ((nvbf*)p.o0)[gid] = nv_f2bf(v); } break;
    case OP_FGEMM: {
        const int N = p.i0; const int m = (int)(gid / N), nn = (int)(gid % N); const nvbf* A = (const nvbf*)p.a + (size_t)m * p.i2 + ((p.i6 & 2) ? (nn / 256) * 256 : 0); const nvbf* Bt = (const nvbf*)p.b + (size_t)nn * p.i3; float acc = 0.f;
        for (int k = 0; k < p.i1; ++k) acc = fmaf(nv_bf2f(A[k]), nv_bf2f(Bt[k]), acc);
        if (p.i6 & 1) ((nvbf*)p.o0)[(size_t)m * p.i4 + nn] = nv_f2bf(acc); else p.o0[(size_t)m * p.i4 + nn] = acc; } break;
    case OP_CVTTAB: {
        const NvF4 v0 = *(const NvF4*)(p.a + gid * 8), v1 = *(const NvF4*)(p.a + gid * 8 + 4); NvU4 o;
        o.x = nv_f2bf(v0.x) | ((unsigned)nv_f2bf(v0.y) << 16); o.y = nv_f2bf(v0.z) | ((unsigned)nv_f2bf(v0.w) << 16); o.z = nv_f2bf(v1.x) | ((unsigned)nv_f2bf(v1.y) << 16); o.w = nv_f2bf(v1.z) | ((unsigned)nv_f2bf(v1.w) << 16);
        *(NvU4*)((nvbf*)p.o0 + gid * 8) = o; } break;
    case OP_CVTTAB8: {
        const float sc = (float)(1 << p.i0); const float* sp = p.a + gid * 16; unsigned w[4];
#pragma unroll
        for (int q = 0; q < 4; ++q) { const NvF4 v = *(const NvF4*)(sp + 4 * q); w[q] = nv_f2e4m3(v.x * sc) | (nv_f2e4m3(v.y * sc) << 8) | (nv_f2e4m3(v.z * sc) << 16) | (nv_f2e4m3(v.w * sc) << 24); }
        NvU4 o; o.x = w[0]; o.y = w[1]; o.z = w[2]; o.w = w[3]; *(NvU4*)((unsigned char*)p.o0 + gid * 16) = o; } break;
    case OP_CVTTAB8S: {
        const float sc = (float)(1 << p.i0); const int per = D / 16; const int e = (int)(gid / per), c0 = (int)(gid % per) * 16; const float* sp = p.a + (size_t)e * D + c0; unsigned w[4];
#pragma unroll
        for (int q = 0; q < 4; ++q) { const NvF4 v = *(const NvF4*)(sp + 4 * q);
#if defined(__HIP_DEVICE_COMPILE__)
            int pk = __builtin_amdgcn_cvt_pk_fp8_f32(v.x * sc, v.y * sc, 0, false); pk = __builtin_amdgcn_cvt_pk_fp8_f32(v.z * sc, v.w * sc, pk, true); w[q] = (unsigned)pk;
#else
            w[q] = nv_f2e4m3(v.x * sc) | (nv_f2e4m3(v.y * sc) << 8) | (nv_f2e4m3(v.z * sc) << 16) | (nv_f2e4m3(v.w * sc) << 24);
#endif
        }
        NvU4 o; o.x = w[0]; o.y = w[1]; o.z = w[2]; o.w = w[3]; *(NvU4*)((unsigned char*)p.o0 + ((size_t)(c0 >> 7) * 16384 + e) * 128 + (c0 & 127)) = o; } break;
    case OP_PACTS: {
        const long long NP = (long long)dm.M * 128; const int sl = (int)(gid / NP); const long long pr = gid % NP; const int row = (int)(pr / 128); const int e = ((const int*)p.d)[pr] & p.i0;
        const unsigned char* u = (const unsigned char*)p.b + ((size_t)sl * 16384 + e) * 128; const unsigned char* x = (const unsigned char*)p.a + (size_t)row * 2 * D + sl * 128; float acc = 0.f;
        for (int c = 0; c < 128; ++c) acc = fmaf(nv_e4m32f(u[c]), nv_e4m32f(x[c]) + nv_e4m32f(x[D + c]), acc);
        p.o0[gid] = acc * (1.f / 16.f); } break;
    case OP_PRED: {
        const long long NP = (long long)dm.M * 128; float acc = 0.f; for (int sl = 0; sl < p.i0; ++sl) acc += p.a[(size_t)sl * NP + gid];
        p.o0[gid] = p.c[gid] * nv_gelu(acc * (1.f / 128.f)); } break;
    case OP_POUTS: {
        const int row = (int)(gid / D), c = (int)(gid % D); const unsigned char* vb = (const unsigned char*)p.c + (size_t)(c >> 7) * 16384 * 128 + (c & 127); float acc = 0.f;
        for (int i = 0; i < 128; ++i) acc = fmaf(p.a[(size_t)row * 128 + i] * (1.f / 64.f), nv_e4m32f(vb[(size_t)((const int*)p.b)[(size_t)row * 128 + i] * 128]), acc);
        ((nvbf*)p.o0)[gid] = nv_f2bf(acc); } break;
    case OP_KEYS: {
        const int h = (int)(gid / 256), nrow = (int)(gid % 256), half = nrow >> 7; const float* src = p.a + (((size_t)h * 2 + half) * 128 + (nrow & 127)) * 128; nvbf* dst = (nvbf*)p.o0 + ((size_t)h * 256 + nrow) * 256; float ks = 0.f;
        for (int k = 0; k < 256; ++k) { nvbf b = 0; if ((k >> 7) == half) { b = nv_f2bf(src[k & 127]); ks += nv_bf2f(b); } dst[k] = b; }
        p.o1[gid] = ks; } break;
    case OP_TOPK2: {
        const int h = (int)(gid % 8); const float* sc = p.a + (size_t)gid * 256; const nvbf* q = (const nvbf*)p.b + (size_t)gid * 256; const float* ksum = p.c + h * 256; float mu = 0.f;
        for (int c = 0; c < 256; ++c) mu += nv_bf2f(q[c]);
        mu *= (1.f / 256.f); float var = 0.f;
        for (int c = 0; c < 256; ++c) { float dlt = nv_bf2f(q[c]) - mu; var = fmaf(dlt, dlt, var); }
        const float rs = 1.f / sqrtf(var * (1.f / 256.f) + 1e-5f);
        float tv[16]; int ti[16]; float* tmpv = p.o2 + (size_t)gid * 32; int* tmpi = (int*)p.o3 + (size_t)gid * 32;
        for (int half = 0; half < 2; ++half) {
#pragma unroll
            for (int j = 0; j < 16; ++j) { tv[j] = -3.0e38f; ti[j] = 0; }
            for (int k = 0; k < 128; ++k) NV_INS16(tv, ti, rs * (sc[half * 128 + k] - mu * ksum[half * 128 + k]), k);
#pragma unroll
            for (int j = 0; j < 16; ++j) { tmpv[half * 16 + j] = tv[j]; tmpi[half * 16 + j] = ti[j]; }
        }
#pragma unroll
        for (int j = 0; j < 16; ++j) { tv[j] = -3.0e38f; ti[j] = 0; }
        for (int i = 0; i < 16; ++i) for (int j = 0; j < 16; ++j) NV_INS16(tv, ti, tmpv[i] + tmpv[16 + j], tmpi[i] * 128 + tmpi[16 + j]);
        float den = 0.f, ev[16];
#pragma unroll
        for (int j = 0; j < 16; ++j) { ev[j] = NV_EXP(tv[j] - tv[0]); den += ev[j]; }
        float inv = 1.f / den;
#pragma unroll
        for (int j = 0; j < 16; ++j) { p.o0[(size_t)gid * 16 + j] = ev[j] * inv; ((int*)p.o1)[(size_t)gid * 16 + j] = ti[j]; } } break;
    case OP_PACT: {
        const int row = (int)(gid / 128); const int e = ((const int*)p.d)[gid]; const unsigned char* u = (const unsigned char*)p.b + (size_t)e * D; const nvbf* x = (const nvbf*)p.a + (size_t)row * D; float acc = 0.f;
        for (int c = 0; c < D; ++c) acc = fmaf(nv_e4m32f(u[c]), nv_bf2f(x[c]), acc);
        p.o0[gid] = p.c[gid] * nv_gelu(acc * (1.f / 128.f)); } break;
#if defined(HOST_TEST)
    case OP_POUTLN: {
        const float alpha = 1.6817928305074292f; float* x = p.o0 + (size_t)gid * D; std::vector<float> y(D, 0.f);
        for (int i = 0; i < 128; ++i) { const float cf = p.a[(size_t)gid * 128 + i] * (1.f / 64.f); const unsigned char* v = (const unsigned char*)p.c + (size_t)((const int*)p.b)[(size_t)gid * 128 + i] * D; for (int c = 0; c < D; ++c) y[c] = fmaf(cf, nv_e4m32f(v[c]), y[c]); }
        float mu = 0.f; for (int c = 0; c < D; ++c) { y[c] = alpha * x[c] + y[c]; mu += y[c]; }
        mu /= D; float var = 0.f; for (int c = 0; c < D; ++c) { float dlt = y[c] - mu; var = fmaf(dlt, dlt, var); }
        const float rs = 1.f / sqrtf(var / D + 1e-5f);
        for (int c = 0; c < D; ++c) { const float o = (y[c] - mu) * rs * p.d[c] + p.e[c]; x[c] = o; ((nvbf*)p.o1)[(size_t)gid * D + c] = nv_f2bf(o);
            if (p.o2) { unsigned char* f8 = (unsigned char*)p.o2 + (size_t)gid * 2 * D; const float xs = fminf(fmaxf(o * 16.f, -448.f), 448.f); const unsigned hc = nv_f2e4m3(xs); f8[c] = (unsigned char)hc; f8[D + c] = (unsigned char)nv_f2e4m3(xs - nv_e4m32f(hc)); } } } break;
#endif
    default: break;
    }
}

struct NvIO { const float* const* in; float* out; char* ws; size_t ws_size; };
template <class Launch> HD void nv_forward(const NvIO& io, const Dm& dm, Launch&& launch) {
    const int D = dm.D, M = dm.M, B = dm.B, DB = dm.DB, RH = dm.RH; const size_t MD = (size_t)M * D;
    float* y_prompt = io.out; float* y_sample = y_prompt + (size_t)B * (dm.T - 16) * D; float* p_gla = y_sample + (size_t)DB * dm.DT * D;
    float* p_h = p_gla + (size_t)2 * B * 4 * 64 * 128; float* p_conv = p_h + (size_t)2 * B * 512; float* p_rwkv = p_conv + (size_t)2 * B * 3 * 512;
    float* p_shift = p_rwkv + (size_t)2 * B * RH * 4096; float* s_gla = p_shift + (size_t)2 * B * D; float* s_h = s_gla + (size_t)2 * DB * 4 * 64 * 128;
    float* s_conv = s_h + (size_t)2 * DB * 512; float* s_rwkv = s_conv + (size_t)2 * DB * 3 * 512; float* s_shift = s_rwkv + (size_t)2 * DB * RH * 4096;
    float* w = (float*)io.ws; size_t off = 0; auto take = [&](size_t n) __attribute__((always_inline)) { float* r = w + off; off += (n + 63) & ~(size_t)63; return r; };
    float* X = take(MD); float* VFIRST = take(MD); float* MOUT = take(MD);
    auto mk = [&](int code, long long n) __attribute__((always_inline)) { Op o{}; o.code = code; o.n = n; return o; };
    const int Mp = nv_rup(M, 256), Dp = nv_rup(D, 256), Dk = nv_rup(D, 128);
    auto takeh = [&](size_t n) __attribute__((always_inline)) { return (nvbf*)take((n + 1) / 2); };
    const size_t ABFN = (size_t)Mp * 1024 > (size_t)Mp * Dk ? (size_t)Mp * 1024 : (size_t)Mp * Dk; nvbf* ABF = takeh(ABFN + (size_t)Mp * D);
    const size_t SZ_WIN = (size_t)2816 * Dk, SZ_WOUT = (size_t)Dp * 1024, SZ_DD = (size_t)Dp * Dk, SZ_DN = (size_t)256 * Dk, SZ_UP = (size_t)Dp * 128, SZ_WQ = (size_t)2048 * Dk;
    nvbf* WT_WIN = takeh(2 * SZ_WIN); nvbf* WT_WOUT = takeh(2 * SZ_WOUT); nvbf* WT_WR = takeh(2 * SZ_DD); nvbf* WT_WK = takeh(2 * SZ_DD); nvbf* WT_WV = takeh(2 * SZ_DD); nvbf* WT_WO = takeh(2 * SZ_DD);
    nvbf* WT_W1 = takeh(2 * SZ_DN); nvbf* WT_W2 = takeh(2 * SZ_UP); nvbf* WT_A1 = takeh(2 * SZ_DN); nvbf* WT_A2 = takeh(2 * SZ_UP); nvbf* WT_G1 = takeh(2 * SZ_DN); nvbf* WT_G2 = takeh(2 * SZ_UP);
    nvbf* WT_V1 = takeh(SZ_DN); nvbf* WT_V2 = takeh(SZ_UP); nvbf* WT_WQ = takeh(4 * SZ_WQ); nvbf* WT_WG = takeh((size_t)2 * 1024 * 512); float* SPL = take(2 * 512); float* PRM = take((size_t)2 * 6 * D);
    nvbf* UB = takeh((size_t)16384 * D / 2); nvbf* VB = takeh((size_t)16384 * D / 2); nvbf* KB = takeh((size_t)8 * 256 * 256); float* KSUM = take(8 * 256);
    const size_t scratch0 = off;
    auto nb = [&](Op o) __attribute__((always_inline)) { o.code |= OPF_NOBAR; launch(o); };
    auto wt = [&](const float* W, int K, int N, int batch, nvbf* dst) __attribute__((always_inline)) { const int Np = nv_rup(N, 256), Kp = nv_rup(K, 128); Op o = mk(OP_WT, (long long)batch * Np * (Kp / 8)); o.a = W; o.o0 = (float*)dst; o.i0 = N; o.i1 = K; o.i2 = N; o.i3 = Np; o.i4 = Kp; nb(o); };
    wt(io.in[10], D, MIXIN, 2, WT_WIN); wt(io.in[21], 1024, D, 2, WT_WOUT); wt(io.in[23], D, D, 2, WT_WR); wt(io.in[24], D, D, 2, WT_WK); wt(io.in[25], D, D, 2, WT_WV); wt(io.in[26], D, D, 2, WT_WO);
    wt(io.in[28], D, 64, 2, WT_W1); wt(io.in[29], 64, D, 2, WT_W2); wt(io.in[31], D, 64, 2, WT_A1); wt(io.in[32], 64, D, 2, WT_A2); wt(io.in[36], D, 128, 2, WT_G1); wt(io.in[37], 128, D, 2, WT_G2);
    wt(io.in[34], D, 32, 1, WT_V1); wt(io.in[35], 32, D, 1, WT_V2); wt(io.in[43], D, 2048, 4, WT_WQ);
    for (int jj = 0; jj < 2; ++jj) { Op o = mk(OP_PRM, (long long)6 * D); o.a = io.in[27] + (size_t)jj * D; o.b = io.in[30] + (size_t)jj * D; o.c = jj > 0 ? io.in[33] + (size_t)(jj - 1) * D : nullptr; o.d = io.in[38] + (size_t)jj * D; o.e = io.in[39] + (size_t)jj * D; o.f = io.in[40] + (size_t)jj * RH * 64; o.o0 = PRM + (size_t)jj * 6 * D; nb(o); }
    for (int jj = 0; jj < 2; ++jj) { Op o = mk(OP_WGATE, 1024); o.a = io.in[16] + (size_t)jj * 8 * 64 * 64; o.b = io.in[18] + (size_t)jj * 8 * 64 * 64; o.c = io.in[20] + (size_t)jj * 512; o.o0 = (float*)(WT_WG + (size_t)jj * 1024 * 512); o.o1 = SPL + (size_t)jj * 512; nb(o); }
    auto fgemm = [&](const nvbf* Wt, float* C, int ldc, int N, int K, int bf16out = 0) __attribute__((always_inline)) {
        const int Kp = nv_rup(K, 128), Np = nv_rup(N, 256);
        Op o = mk(OP_FGEMM, (long long)M * N); o.a = (const float*)ABF; o.b = (const float*)Wt; o.o0 = C; o.i0 = N; o.i1 = Kp; o.i2 = Kp; o.i3 = Kp; o.i4 = ldc; o.i5 = Np; o.i6 = bf16out; launch(o); };
    auto gemm = [&](const float* A, int lda, const nvbf* Wt, float* C, int ldc, int N, int K, int act) __attribute__((always_inline)) {
        const int Kp = nv_rup(K, 128);
        { Op o = mk(OP_CVT8, (long long)Mp * (Kp / 8)); o.a = A; o.o0 = (float*)ABF; o.i0 = K; o.i1 = lda; o.i2 = Kp; o.i3 = act; launch(o); }
        fgemm(Wt, C, ldc, N, K); };
    { Op o = mk(OP_EMBED4, (long long)MD / 4); o.a = io.in[0]; o.b = io.in[1]; o.c = io.in[7]; o.o0 = X; o.o1 = (float*)ABF; launch(o); }
    const float* const w_outer = w; float* const out_outer = io.out;
    for (int layer = 0; layer < 4; ++layer) {
        float* wl = (float*)w_outer; float* ol = out_outer; NV_LAUNDER(wl); NV_LAUNDER(ol);
#define NV_RB(T, v) T const v##_rb = (T)((char*)wl + ((const char*)(v) - (const char*)w_outer))
#define NV_RO(v) float* const v##_rb = (float*)((char*)ol + ((const char*)(v) - (const char*)out_outer))
        NV_RB(float*, X); NV_RB(float*, VFIRST); NV_RB(float*, MOUT); NV_RB(nvbf*, ABF); NV_RB(nvbf*, WT_WIN); NV_RB(nvbf*, WT_WOUT); NV_RB(nvbf*, WT_WR); NV_RB(nvbf*, WT_WK); NV_RB(nvbf*, WT_WV); NV_RB(nvbf*, WT_WO);
        NV_RB(nvbf*, WT_W1); NV_RB(nvbf*, WT_W2); NV_RB(nvbf*, WT_A1); NV_RB(nvbf*, WT_A2); NV_RB(nvbf*, WT_G1); NV_RB(nvbf*, WT_G2); NV_RB(nvbf*, WT_V1); NV_RB(nvbf*, WT_V2); NV_RB(nvbf*, WT_WQ); NV_RB(nvbf*, WT_WG);
        NV_RB(float*, SPL); NV_RB(float*, PRM); NV_RB(nvbf*, UB); NV_RB(nvbf*, VB); NV_RB(nvbf*, KB); NV_RB(float*, KSUM);
        NV_RO(p_gla); NV_RO(p_h); NV_RO(p_conv); NV_RO(p_rwkv); NV_RO(p_shift); NV_RO(s_gla); NV_RO(s_h); NV_RO(s_conv); NV_RO(s_rwkv); NV_RO(s_shift);
#undef NV_RB
#undef NV_RO
        { float* const X = X_rb; float* const VFIRST = VFIRST_rb; float* const MOUT = MOUT_rb; nvbf* const ABF = ABF_rb; nvbf* const WT_WIN = WT_WIN_rb; nvbf* const WT_WOUT = WT_WOUT_rb; nvbf* const WT_WR = WT_WR_rb; nvbf* const WT_WK = WT_WK_rb;
          nvbf* const WT_WV = WT_WV_rb; nvbf* const WT_WO = WT_WO_rb; nvbf* const WT_W1 = WT_W1_rb; nvbf* const WT_W2 = WT_W2_rb; nvbf* const WT_A1 = WT_A1_rb; nvbf* const WT_A2 = WT_A2_rb; nvbf* const WT_G1 = WT_G1_rb; nvbf* const WT_G2 = WT_G2_rb;
          nvbf* const WT_V1 = WT_V1_rb; nvbf* const WT_V2 = WT_V2_rb; nvbf* const WT_WQ = WT_WQ_rb; nvbf* const WT_WG = WT_WG_rb; float* const SPL = SPL_rb; float* const PRM = PRM_rb; nvbf* const UB = UB_rb; nvbf* const VB = VB_rb; nvbf* const KB = KB_rb; float* const KSUM = KSUM_rb;
          float* const p_gla = p_gla_rb; float* const p_h = p_h_rb; float* const p_conv = p_conv_rb; float* const p_rwkv = p_rwkv_rb; float* const p_shift = p_shift_rb; float* const s_gla = s_gla_rb; float* const s_h = s_h_rb; float* const s_conv = s_conv_rb;
          float* const s_rwkv = s_rwkv_rb; float* const s_shift = s_shift_rb; float* const w = wl; (void)SPL; (void)WT_WG; (void)VFIRST;
        const int j = layer / 2; off = scratch0;
        { Op o = mk(OP_CVTTAB8S, (long long)16384 * D / 16); o.a = io.in[45] + (size_t)layer * 16384 * D; o.o0 = (float*)UB; o.i0 = 7; nb(o); }
        { Op o = mk(OP_CVTTAB8S, (long long)16384 * D / 16); o.a = io.in[46] + (size_t)layer * 16384 * D; o.o0 = (float*)VB; o.i0 = 6; nb(o); }
        { Op o = mk(OP_KEYS, 8 * 256); o.a = io.in[44] + (size_t)layer * 8 * 2 * 128 * 128; o.o0 = (float*)KB; o.o1 = KSUM; nb(o); }
        if (layer % 2 == 0) {
            float* PROJ = take((size_t)M * MIXIN); float* LOGA = take((size_t)M * 256); float* O = take((size_t)M * 512); float* MIXO = (float*)ABF;
            float* XC = take((size_t)M * 512); nvbf* XCB = takeh((size_t)Mp * 512); float* AT = take((size_t)M * 512); float* BT = take((size_t)M * 512);
            const int NC = (dm.T + 63) / 64; float* LEND = take((size_t)B * 4 * NC * 8192); float* DEC = take((size_t)B * 4 * NC * 64); float* LA = take((size_t)B * NC * 512); float* LB = take((size_t)B * NC * 512);
            fgemm(WT_WIN + (size_t)j * SZ_WIN, PROJ, MIXIN, MIXIN, D);
            { Op o = mk(OP_LOGA4, (long long)M * 64); o.a = PROJ; o.b = io.in[11] + (size_t)j * 16 * 256; o.c = io.in[12] + (size_t)j * 256; o.o0 = LOGA; nb(o); }
            { Op o = mk(OP_CONV4, (long long)M * 128); o.a = PROJ; o.b = io.in[4] + (size_t)j * DB * 3 * 512; o.c = io.in[14] + (size_t)j * 4 * 512; o.d = io.in[15] + (size_t)j * 512; o.o0 = XC; o.o1 = (float*)XCB; nb(o); }
            { Op o = mk(OP_CONVOUT, (long long)dm.NSEQ * 1536); o.a = PROJ; o.b = io.in[4] + (size_t)j * DB * 3 * 512; o.o1 = p_conv + (size_t)j * B * 3 * 512; o.o2 = s_conv + (size_t)j * DB * 3 * 512; launch(o); }
            { Op o = mk(OP_GLAF, (long long)B * 512); o.a = PROJ; o.b = LOGA; o.o0 = O; o.o1 = p_gla + (size_t)j * B * 4 * 64 * 128; nb(o); }
            { Op o = mk(OP_GLA3, (long long)(DB * 4) * 128); o.a = PROJ; o.b = LOGA; o.c = io.in[2] + (size_t)j * DB * 4 * 64 * 128; o.d = LEND; o.o0 = O; o.o2 = s_gla + (size_t)j * DB * 4 * 64 * 128; o.i0 = NC; o.i1 = 1; nb(o); }
            { Op o = mk(OP_LRUG2, (long long)M * 512); o.a = (const float*)XCB; o.b = (const float*)(WT_WG + (size_t)j * 1024 * 512); o.c = io.in[17] + (size_t)j * 512; o.d = io.in[19] + (size_t)j * 512; o.e = SPL + (size_t)j * 512; o.f = XC; o.o0 = AT; o.o1 = BT; launch(o); }
            { Op o = mk(OP_GLANORM, (long long)M * 4); o.a = O; o.b = PROJ; o.c = io.in[13] + (size_t)j * 128; o.o0 = MIXO; nb(o); }
            { Op o = mk(OP_LRU1, (long long)B * NC * 512); o.a = AT; o.b = BT; o.o0 = LA; o.o1 = LB; o.i0 = NC; launch(o); }
            { Op o = mk(OP_LRU2, (long long)B * 512); o.a = LA; o.o0 = LB; o.o1 = p_h + (size_t)j * B * 512; o.i0 = NC; launch(o); }
            { Op o = mk(OP_LRU3, (long long)(B * NC + DB) * 512); o.a = AT; o.b = BT; o.c = PROJ; o.d = io.in[3] + (size_t)j * DB * 512; o.e = LB; o.o0 = MIXO; o.o2 = s_h + (size_t)j * DB * 512; o.i0 = NC; launch(o); }
            fgemm(WT_WOUT + (size_t)j * SZ_WOUT, MOUT, D, D, 1024, 1);
        } else {
            float* Y = take(MD); float* R = take(MD); float* K = take(MD); float* V = take(MD); float* G = take(MD); float* KK = take(MD);
            const size_t XMSZ = (size_t)Mp * D;
            float* WAV = take(3 * MD > 3 * XMSZ ? 3 * MD : 3 * XMSZ); float* Wd = WAV; float* Aa = WAV + MD; float* Vg = WAV + 2 * MD; nvbf* XM6 = (nvbf*)WAV;
            float* BON = take((size_t)M * RH); float* HLw = take((size_t)M * 64); float* HLa = take((size_t)M * 64); float* HLg = take((size_t)M * 128); float* HLv = take((size_t)M * 32);
            nvbf* ABw = takeh((size_t)Mp * 128); nvbf* ABa = takeh((size_t)Mp * 128); nvbf* ABg = takeh((size_t)Mp * 128); nvbf* ABv = takeh((size_t)Mp * 128);
            const float* shin = io.in[6] + (size_t)j * DB * D; const float* mu = io.in[22] + (size_t)j * 6 * D;
            { Op o = mk(OP_SHIFTOUT, (long long)dm.NSEQ * D); o.a = X; o.o1 = p_shift + (size_t)j * B * D; o.o2 = s_shift + (size_t)j * DB * D; nb(o); }
            { Op o = mk(OP_MIX6, (long long)MD / 8); o.a = X; o.b = shin; o.c = mu; o.o0 = (float*)XM6; o.i1 = (int)(XMSZ / 1024); launch(o); }
            auto gg = [&](const nvbf* A, const nvbf* Wt, float* C, int ldc, int N, int K, bool last, int bf16out = 0) __attribute__((always_inline)) { const int Kp = nv_rup(K, 128), Np = nv_rup(N, 256);
                Op o = mk(OP_FGEMM, (long long)M * N); o.a = (const float*)A; o.b = (const float*)Wt; o.o0 = C; o.i0 = N; o.i1 = Kp; o.i2 = Kp; o.i3 = Kp; o.i4 = ldc; o.i5 = Np; o.i6 = bf16out; if (!last) o.code |= OPF_GROUP; launch(o); };
            gg(XM6 + 0 * XMSZ, WT_WR + (size_t)j * SZ_DD, R, D, D, D, false, 1); gg(XM6 + 2 * XMSZ, WT_WK + (size_t)j * SZ_DD, K, D, D, D, false, 1); gg(XM6 + 3 * XMSZ, WT_WV + (size_t)j * SZ_DD, V, D, D, D, false, 1);
            gg(XM6 + 1 * XMSZ, WT_W1 + (size_t)j * SZ_DN, HLw, 64, 64, D, false); gg(XM6 + 4 * XMSZ, WT_A1 + (size_t)j * SZ_DN, HLa, 64, 64, D, false);
            if (j > 0) gg(XM6 + 3 * XMSZ, WT_V1 + (size_t)(j - 1) * SZ_DN, HLv, 32, 32, D, false);
            gg(XM6 + 5 * XMSZ, WT_G1 + (size_t)j * SZ_DN, HLg, 128, 128, D, true);
            auto cv = [&](const float* A, int K, nvbf* dst, int act, bool last) __attribute__((always_inline)) { Op o = mk(OP_CVT8, (long long)Mp * 16); o.a = A; o.o0 = (float*)dst; o.i0 = K; o.i1 = K; o.i2 = 128; o.i3 = act; if (last) launch(o); else nb(o); };
            cv(HLw, 64, ABw, 1, false); cv(HLa, 64, ABa, 0, false); if (j > 0) cv(HLv, 32, ABv, 0, false); cv(HLg, 128, ABg, 2, true);
            gg(ABw, WT_W2 + (size_t)j * SZ_UP, Wd, D, D, 64, false, 1); gg(ABa, WT_A2 + (size_t)j * SZ_UP, Aa, D, D, 64, false, 1); if (j > 0) gg(ABv, WT_V2 + (size_t)(j - 1) * SZ_UP, Vg, D, D, 32, false, 1); gg(ABg, WT_G2 + (size_t)j * SZ_UP, G, D, D, 128, true, 1);
            { Op o = mk(OP_WKVP, (long long)dm.NSEQ * RH * 64); o.a = R; o.b = K; o.c = Wd; o.d = Aa; o.e = V; o.f = Vg; o.g = VFIRST; o.h = PRM + (size_t)j * 6 * D; o.o0 = Y; o.o1 = p_rwkv + (size_t)j * B * RH * 4096; o.o2 = s_rwkv + (size_t)j * DB * RH * 4096;
              o.o3 = j > 0 ? KK : VFIRST; o.o4 = BON; o.o5 = (float*)(io.in[5] + (size_t)j * DB * RH * 4096); o.i0 = j > 0 ? 1 : 0; launch(o); }
            { Op o = mk(OP_POST2, (long long)M * RH); o.a = Y; o.b = G; o.c = j > 0 ? KK : VFIRST; o.d = BON; o.e = io.in[41] + (size_t)j * D; o.f = io.in[42] + (size_t)j * D; o.o0 = (float*)ABF; launch(o); }
            fgemm(WT_WO + (size_t)j * SZ_DD, MOUT, D, D, D, 1);
        }
        { Op o = mk(OP_LNRES, M); o.a = MOUT; o.b = io.in[8] + (size_t)(layer * 2 + 0) * D; o.c = io.in[9] + (size_t)(layer * 2 + 0) * D; o.o0 = X; o.o1 = (float*)ABF; o.o2 = (float*)(ABF + ABFN); launch(o); }
        off = scratch0;
        { nvbf* Q = takeh((size_t)Mp * 2048); float* SC = take((size_t)M * 2048); float* GATE = take((size_t)M * 128); float* EIDX = take((size_t)M * 128); float* TMPV = take((size_t)M * 256); float* TMPI = take((size_t)M * 256);
          float* COEF = take((size_t)M * 128);
          { Op o = mk(OP_FGEMM, (long long)M * 2048); o.a = (const float*)ABF; o.b = (const float*)(WT_WQ + (size_t)layer * SZ_WQ); o.o0 = (float*)Q; o.i0 = 2048; o.i1 = Dk; o.i2 = Dk; o.i3 = Dk; o.i4 = 2048; o.i5 = 2048; o.i6 = 1; launch(o); }
          { Op o = mk(OP_FGEMM, (long long)M * 2048); o.a = (const float*)Q; o.b = (const float*)KB; o.o0 = SC; o.i0 = 2048; o.i1 = 256; o.i2 = 2048; o.i3 = 256; o.i4 = 2048; o.i5 = 2048; o.i6 = 2; launch(o); }
          { Op o = mk(OP_TOPK2, (long long)M * 8); o.a = SC; o.b = (const float*)Q; o.c = KSUM; o.o0 = GATE; o.o1 = EIDX; o.o2 = TMPV; o.o3 = TMPI; launch(o); }
          { const int NS = D / 128; float* PART = take((size_t)NS * M * 128); float* YBUF = take(MD);
            #ifdef PROBE_EMASK
            { Op o = mk(OP_PACTS, (long long)NS * M * 128); o.a = (const float*)(ABF + ABFN); o.b = (const float*)UB; o.d = EIDX; o.o0 = PART; o.i0 = PROBE_EMASK; launch(o); }
#endif
            { Op o = mk(OP_PACTS, (long long)NS * M * 128); o.a = (const float*)(ABF + ABFN); o.b = (const float*)UB; o.d = EIDX; o.o0 = PART; o.i0 = 16383; launch(o); }
            { Op o = mk(OP_PRED, (long long)M * 128); o.a = PART; o.c = GATE; o.o0 = COEF; o.i0 = NS; launch(o); }
            { Op o = mk(OP_POUTS, (long long)MD); o.a = COEF; o.b = EIDX; o.c = (const float*)VB; o.o0 = YBUF; launch(o); }
            { Op o = mk(OP_LNRES, M); o.a = YBUF; o.b = io.in[8] + (size_t)(layer * 2 + 1) * D; o.c = io.in[9] + (size_t)(layer * 2 + 1) * D; o.o0 = X; o.o1 = (float*)ABF; launch(o); } } }
        }
    }
    { Op o = mk(OP_YOUT4, (long long)MD / 4); o.a = X; o.o0 = y_prompt; launch(o); }
    (void)y_sample;
}

#include <cstdint>
namespace pg8 {
#define PG8_LAS __attribute__((address_space(3)))
typedef unsigned short bf16_t;
typedef short bf16x8 __attribute__((ext_vector_type(8)));
typedef float f32x4 __attribute__((ext_vector_type(4)));
typedef unsigned u32x4 __attribute__((ext_vector_type(4)));
constexpr int BM = 256, BK = 64, HALF = 128, HTB = HALF * BK * 2  , STAGE_BYTES = 8 * HTB, NXCD = 8, WGM = 8;

__host__ __device__ __forceinline__ int lds_byte(int r, int c) { const int st = (r >> 4) * 2 + (c >> 5), rr = r & 15, cc = c & 31, ob = rr * 64 + cc * 2; return st * 1024 + (ob ^ (((ob >> 9) & 1) << 5)); }
__host__ __device__ __forceinline__ void stage_rc(int b, int& R, int& C) { const int st = b / 1024, sb = b % 1024, swz = sb ^ (((sb >> 9) & 1) << 5); R = (st >> 1) * 16 + swz / 64; C = (st & 1) * 32 + (swz % 64) / 2; }
__host__ __device__ __forceinline__ int perm32(int rho) { const int n = rho >> 4, i = rho & 15; return 8 * (i >> 2) + 4 * n + (i & 3); }

struct Unit { int pm, pn, grp, pad_; const char* A; const char* B; };
struct Gemm { const bf16_t* A; const bf16_t* Bt; int M, N, K, lda, ldb; };

struct StaticOrder {
    int nM, nN, nwg, G, c; const char* A; const char* B; size_t tsA, tsB, acs;
    __host__ __device__ void init(const Gemm& g, int G_, int c_) { nM = g.M / BM; nN = g.N / BM; nwg = nM * nN; G = G_; c = c_; A = (const char*)g.A; B = (const char*)g.Bt; tsA = (size_t)BM * g.lda * 2; tsB = (size_t)BM * g.ldb * 2; acs = 0; }
    __host__ __device__ bool next(int i, Unit& u) const {
        const long L = (long)i * G + c; if (L >= nwg) return false;
        int wgid = (int)L; { const int q = nwg / NXCD, r = nwg % NXCD, xcd = wgid % NXCD, off = wgid / NXCD; wgid = (xcd < r ? xcd * (q + 1) : r * (q + 1) + (xcd - r) * q) + off; }
        const int nig = WGM * nN, gid = wgid / nig, fm = gid * WGM, gsz = (nM - fm) < WGM ? (nM - fm) : WGM;
        u.pm = fm + ((wgid % nig) % gsz); u.pn = (wgid % nig) / gsz; u.grp = 0; u.pad_ = 0; u.A = A + (size_t)u.pm * tsA + (size_t)u.pn * acs; u.B = B + (size_t)u.pn * tsB; return true;
    }
    __device__ __forceinline__ void a_ready(const Unit&) const {}
    __device__ __forceinline__ void done(const Unit&) const {}
};

template <class Epi, class Sched, bool ALIGN_EPI = false, bool SP2 = false>
__device__ __forceinline__ void gemm_phase(PG8_LAS unsigned char* lds, const Gemm g, const Sched& S, const Epi& E) {
    int tid_raw = threadIdx.x; asm volatile("" : "+v"(tid_raw));
    const int tid = tid_raw, wid = __builtin_amdgcn_readfirstlane(tid >> 6), lane = tid & 63, wr = wid >> 2, wc = wid & 3, fr = lane & 15, fq = lane >> 4;
    const int K = g.K, nt = K / BK;
    unsigned voffA[2], voffB[2];
#pragma unroll
    for (int i = 0; i < 2; ++i) { int R, C; stage_rc(tid * 16 + i * 8192, R, C); const int Rb = Epi::PERM ? ((R & ~31) + perm32(R & 31)) : R;
        voffA[i] = (unsigned)(R * g.lda + C) * 2u; voffB[i] = (unsigned)(Rb * g.ldb + C) * 2u; }
    const size_t kstep = (size_t)(BK * 2);
    const size_t hstepA = (size_t)HALF * g.lda * 2, hstepB = (size_t)HALF * g.ldb * 2;
    const unsigned ldsw = (unsigned)wid * 1024u;
    const int aoff = lds_byte(wr * 64 + fr, fq * 8), boff = lds_byte(wc * 32 + fr, fq * 8);
#define PG8_SA(b, h) (((b) * 2 + (h)) * HTB)
#define PG8_SB(b, h) ((4 + (b) * 2 + (h)) * HTB)
#define PG8_STAGE(bufoff, gbase, voff) do { _Pragma("unroll") for (int _i = 0; _i < 2; ++_i) \
        __builtin_amdgcn_global_load_lds((const unsigned*)((const char*)(gbase) + (voff)[_i]), (PG8_LAS unsigned*)(lds + (bufoff) + ldsw + _i * 8192), 16, 0, 0); } while (0)
#define PG8_LDA(dst, b, h) do { _Pragma("unroll") for (int m = 0; m < 4; ++m) _Pragma("unroll") for (int k = 0; k < 2; ++k) dst[m][k] = *(const PG8_LAS bf16x8*)(lds + PG8_SA(b, h) + aoff + m * 2048 + k * 1024); } while (0)
#define PG8_LDB(dst, b, h) do { _Pragma("unroll") for (int n = 0; n < 2; ++n) _Pragma("unroll") for (int k = 0; k < 2; ++k) dst[n][k] = *(const PG8_LAS bf16x8*)(lds + PG8_SB(b, h) + boff + n * 2048 + k * 1024); } while (0)
#define PG8_MMA(ai, bj, At, Bt) do { __builtin_amdgcn_s_setprio(1); _Pragma("unroll") for (int m = 0; m < 4; ++m) _Pragma("unroll") for (int n = 0; n < 2; ++n) _Pragma("unroll") for (int k = 0; k < 2; ++k) \
        acc[ai][bj][m][n] = __builtin_amdgcn_mfma_f32_16x16x32_bf16(Bt[n][k], At[m][k], acc[ai][bj][m][n], 0, 0, 0); __builtin_amdgcn_s_setprio(0); } while (0)
#define PG8_WAIT_V(n) asm volatile("s_waitcnt vmcnt(" #n ")" ::: "memory")
#define PG8_WAIT_L(n) asm volatile("s_waitcnt lgkmcnt(" #n ")" ::: "memory")
#define PG8_BAR __builtin_amdgcn_s_barrier()
#define PG8_SCHED __builtin_amdgcn_sched_barrier(0)
    Unit cur, nxt; int ui = 0;
    if (!S.next(0, cur)) return;
    f32x4 acc[2][2][4][2];
#pragma unroll
    for (int a = 0; a < 2; ++a)
#pragma unroll
        for (int b = 0; b < 2; ++b)
#pragma unroll
            for (int m = 0; m < 4; ++m)
#pragma unroll
                for (int n = 0; n < 2; ++n) acc[a][b][m][n] = (f32x4){0.f, 0.f, 0.f, 0.f};
    bf16x8 At[4][2], B0[2][2], B1[2][2];
    const char* cA = cur.A; const char* cB = cur.B;
    S.a_ready(cur);
    if constexpr (SP2) {
        PG8_STAGE(PG8_SB(0, 0), cB, voffB); PG8_STAGE(PG8_SB(0, 1), cB + hstepB, voffB); PG8_STAGE(PG8_SA(0, 0), cA, voffA); PG8_STAGE(PG8_SA(0, 1), cA + hstepA, voffA);
        if (wr == 1) PG8_BAR;
        PG8_WAIT_V(2); PG8_BAR;
        PG8_STAGE(PG8_SB(1, 0), cB + kstep, voffB); PG8_STAGE(PG8_SA(1, 0), cA + kstep, voffA); PG8_STAGE(PG8_SB(1, 1), cB + hstepB + kstep, voffB);
        PG8_WAIT_V(6); PG8_BAR;
    } else {
        PG8_STAGE(PG8_SB(0, 0), cB, voffB); PG8_STAGE(PG8_SA(0, 0), cA, voffA); PG8_STAGE(PG8_SB(0, 1), cB + hstepB, voffB); PG8_STAGE(PG8_SA(0, 1), cA + hstepA, voffA);
        if (wr == 1) PG8_BAR;
        PG8_WAIT_V(4); PG8_BAR;
        PG8_STAGE(PG8_SB(1, 0), cB + kstep, voffB); PG8_STAGE(PG8_SA(1, 0), cA + kstep, voffA); PG8_STAGE(PG8_SB(1, 1), cB + hstepB + kstep, voffB);
        PG8_WAIT_V(6); PG8_BAR;
    }
    for (;;) {
        const bool has_next = S.next(ui + 1, nxt);
        const char* nA = has_next ? nxt.A : cA; const char* nB = has_next ? nxt.B : cB;
        for (int t = 0; t < nt; t += 2) {
            const bool last = (t == nt - 2);
            const char* a1 = cA + (size_t)(t + 1) * kstep;
            const char* a2 = last ? nA : cA + (size_t)(t + 2) * kstep; const char* b2 = last ? nB : cB + (size_t)(t + 2) * kstep;
            const char* a3 = a2 + kstep; const char* b3 = b2 + kstep;
            if (last && has_next) S.a_ready(nxt);
            if constexpr (SP2) {
            PG8_LDB(B0, 0, 0); PG8_LDB(B1, 0, 1); PG8_SCHED; PG8_LDA(At, 0, 0); PG8_STAGE(PG8_SA(1, 1), a1 + hstepA, voffA);
            PG8_WAIT_V(8); PG8_WAIT_L(0); PG8_BAR; PG8_MMA(0, 0, At, B0); PG8_MMA(0, 1, At, B1); PG8_BAR; PG8_SCHED;
            PG8_LDA(At, 0, 1); PG8_STAGE(PG8_SB(0, 0), b2, voffB); PG8_STAGE(PG8_SB(0, 1), b2 + hstepB, voffB); PG8_STAGE(PG8_SA(0, 0), a2, voffA);
            PG8_WAIT_V(8); PG8_WAIT_L(0); PG8_BAR; PG8_MMA(1, 0, At, B0); PG8_MMA(1, 1, At, B1); PG8_BAR; PG8_SCHED;
            PG8_LDB(B0, 1, 0); PG8_LDB(B1, 1, 1); PG8_SCHED; PG8_LDA(At, 1, 0); PG8_STAGE(PG8_SA(0, 1), a2 + hstepA, voffA);
            PG8_WAIT_V(8); PG8_WAIT_L(0); PG8_BAR; PG8_MMA(0, 0, At, B0); PG8_MMA(0, 1, At, B1); PG8_BAR; PG8_SCHED;
            PG8_LDA(At, 1, 1); PG8_STAGE(PG8_SB(1, 0), b3, voffB); PG8_STAGE(PG8_SB(1, 1), b3 + hstepB, voffB); PG8_STAGE(PG8_SA(1, 0), a3, voffA);
            PG8_WAIT_V(8); PG8_WAIT_L(0); PG8_BAR; PG8_MMA(1, 0, At, B0); PG8_MMA(1, 1, At, B1); PG8_BAR; PG8_SCHED;
            } else {
            PG8_LDB(B0, 0, 0); PG8_SCHED; PG8_LDA(At, 0, 0); PG8_STAGE(PG8_SA(1, 1), a1 + hstepA, voffA);
            PG8_WAIT_L(8); PG8_BAR; PG8_WAIT_L(0); PG8_MMA(0, 0, At, B0); PG8_BAR; PG8_SCHED;
            PG8_LDB(B1, 0, 1); PG8_STAGE(PG8_SB(0, 0), b2, voffB);
            PG8_BAR; PG8_WAIT_L(0); PG8_MMA(0, 1, At, B1); PG8_BAR;
            PG8_LDA(At, 0, 1); PG8_STAGE(PG8_SA(0, 0), a2, voffA);
            PG8_BAR; PG8_WAIT_L(0); PG8_MMA(1, 0, At, B0); PG8_BAR; PG8_SCHED;
            PG8_STAGE(PG8_SB(0, 1), b2 + hstepB, voffB);
            PG8_WAIT_V(6); PG8_BAR; PG8_MMA(1, 1, At, B1); PG8_BAR;
            PG8_LDB(B0, 1, 0); PG8_SCHED; PG8_LDA(At, 1, 0); PG8_STAGE(PG8_SA(0, 1), a2 + hstepA, voffA);
            PG8_WAIT_L(8); PG8_BAR; PG8_WAIT_L(0); PG8_MMA(0, 0, At, B0); PG8_BAR; PG8_SCHED;
            PG8_LDB(B1, 1, 1); PG8_STAGE(PG8_SB(1, 0), b3, voffB);
            PG8_BAR; PG8_WAIT_L(0); PG8_MMA(0, 1, At, B1); PG8_BAR;
            PG8_LDA(At, 1, 1); PG8_STAGE(PG8_SA(1, 0), a3, voffA);
            PG8_BAR; PG8_WAIT_L(0); PG8_MMA(1, 0, At, B0); PG8_BAR; PG8_SCHED;
            PG8_STAGE(PG8_SB(1, 1), b3 + hstepB, voffB);
            PG8_WAIT_V(6); PG8_BAR; PG8_MMA(1, 1, At, B1); PG8_BAR;
            }
        }
        if constexpr (ALIGN_EPI) { if (wr == 0) PG8_BAR; }
        if constexpr (!Epi::AFTER_DRAIN) { E(acc, cur, wr, wc, fr, fq); S.done(cur); }
        if (!has_next) break;
#pragma unroll
        for (int a = 0; a < 2; ++a)
#pragma unroll
            for (int b = 0; b < 2; ++b)
#pragma unroll
                for (int m = 0; m < 4; ++m)
#pragma unroll
                    for (int n = 0; n < 2; ++n) acc[a][b][m][n] = (f32x4){0.f, 0.f, 0.f, 0.f};
        cur = nxt; cA = nA; cB = nB; ++ui;
        if constexpr (ALIGN_EPI) { if (wr == 1) PG8_BAR; }
    }
    PG8_WAIT_V(0);
    if constexpr (!ALIGN_EPI) { if (wr == 0) PG8_BAR; }
    PG8_BAR;
    if constexpr (Epi::AFTER_DRAIN) { E.fused(acc, cur, wr, wc, fr, fq, lds, wid, lane); S.done(cur); }
#undef PG8_SA
#undef PG8_SB
#undef PG8_STAGE
#undef PG8_LDA
#undef PG8_LDB
#undef PG8_MMA
#undef PG8_WAIT_V
#undef PG8_WAIT_L
#undef PG8_BAR
#undef PG8_SCHED
}
}
template <class T> __device__ __forceinline__ T* uni_ptr(T* p) {
    unsigned long long v = (unsigned long long)p; unsigned lo = __builtin_amdgcn_readfirstlane((unsigned)v), hi = __builtin_amdgcn_readfirstlane((unsigned)(v >> 32));
    unsigned long long r = ((unsigned long long)hi << 32) | lo; asm volatile("" : "+s"(r)); return (T*)r; }
__device__ __forceinline__ int rfl(int x) { int t = __builtin_amdgcn_readfirstlane(x); asm volatile("" : "+s"(t)); return t; }
namespace pg8 {
__device__ __forceinline__ unsigned cvt_pk_bf16(float lo, float hi) { unsigned r; asm volatile("v_cvt_pk_bf16_f32 %0, %1, %2" : "=v"(r) : "v"(lo), "v"(hi)); return r; }
struct EpiF32 {
    static constexpr bool PERM = false, AFTER_DRAIN = false;
    float* C; int ldc, Mreal, Nreal;
    __device__ __forceinline__ void operator()(const f32x4 (&acc)[2][2][4][2], const Unit& u, int wr, int wc, int fr, int fq) const {
        const int row0 = u.pm * BM + wr * 64 + fr, col0 = u.pn * BM + wc * 32 + 4 * fq;
#pragma unroll
        for (int ai = 0; ai < 2; ++ai)
#pragma unroll
            for (int m = 0; m < 4; ++m) { const int r = row0 + ai * HALF + m * 16; if (r < Mreal) { float* rowp = C + (size_t)r * ldc + col0;
#pragma unroll
                for (int bj = 0; bj < 2; ++bj)
#pragma unroll
                    for (int n = 0; n < 2; ++n) { const int c = col0 + bj * HALF + n * 16; if (c < Nreal) *(f32x4*)(rowp + bj * HALF + n * 16) = acc[ai][bj][m][n]; } } }
    }
};
struct EpiBf16Plain {
    static constexpr bool PERM = true, AFTER_DRAIN = false;
    bf16_t* O; int ldc;
    __device__ __forceinline__ void operator()(const f32x4 (&acc)[2][2][4][2], const Unit& u, int wr, int wc, int fr, int fq) const {
        const int row0 = u.pm * BM + wr * 64 + fr, col0 = u.pn * BM + wc * 32 + 8 * fq;
#pragma unroll
        for (int ai = 0; ai < 2; ++ai)
#pragma unroll
            for (int m = 0; m < 4; ++m) { bf16_t* rowp = O + (size_t)(row0 + ai * HALF + m * 16) * ldc + col0;
#pragma unroll
                for (int bj = 0; bj < 2; ++bj) { const f32x4 v0 = acc[ai][bj][m][0], v1 = acc[ai][bj][m][1]; u32x4 w;
                    w.x = cvt_pk_bf16(v0[0], v0[1]); w.y = cvt_pk_bf16(v0[2], v0[3]); w.z = cvt_pk_bf16(v1[0], v1[1]); w.w = cvt_pk_bf16(v1[2], v1[3]);
                    *(u32x4*)(rowp + bj * HALF) = w; } }
    }
};
struct EpiLru {
    static constexpr bool PERM = false, AFTER_DRAIN = false;
    const float* ba; const float* bx; const float* spl; const float* XC; float* AT; float* BT; int Mreal;
    __device__ __forceinline__ void operator()(const f32x4 (&acc)[2][2][4][2], const Unit& u, int wr, int wc, int fr, int fq) const {
        const int row0 = u.pm * BM + wr * 64 + fr, ch0 = u.pn * 128 + wc * 32 + 4 * fq;
#pragma unroll
        for (int n = 0; n < 2; ++n) { const int c = ch0 + 16 * n; const f32x4 ba4 = *(const f32x4*)(ba + c), bx4 = *(const f32x4*)(bx + c), sp4 = *(const f32x4*)(spl + c);
#pragma unroll
            for (int ai = 0; ai < 2; ++ai)
#pragma unroll
                for (int m = 0; m < 4; ++m) { const int r = row0 + ai * HALF + m * 16; if (r < Mreal) { const f32x4 xc = *(const f32x4*)(XC + (size_t)r * 512 + c); const f32x4 ga = acc[ai][0][m][n] + ba4, gx = acc[ai][1][m][n] + bx4; f32x4 at, bt;
#pragma unroll
                    for (int i = 0; i < 4; ++i) { const float gate_a = __builtin_amdgcn_rcpf(1.f + __expf(-ga[i])), gate_x = __builtin_amdgcn_rcpf(1.f + __expf(-gx[i])); const float la = gate_a * sp4[i]; at[i] = __expf(la); bt[i] = sqrtf(-expm1f(2.f * la)) * (gate_x * xc[i]); }
                    *(f32x4*)(AT + (size_t)r * 512 + c) = at; *(f32x4*)(BT + (size_t)r * 512 + c) = bt; } } }
    }
};
struct GroupOrder {
    const PG8_LAS Op* tab; int ng, nM, G, c; size_t tsA, tsB;
    __device__ __forceinline__ bool next(int i, Unit& u) const {
        int L = i * G + c, g = 0;
        for (; g < ng; ++g) { const int cnt = nM * (__builtin_amdgcn_readfirstlane(tab[g].i5) >> 8); if (L < cnt) break; L -= cnt; }
        if (g >= ng) return false;
        u.pm = L % nM; u.pn = L / nM; u.grp = g; u.pad_ = 0;
        u.A = (const char*)uni_ptr(tab[g].a) + (size_t)u.pm * tsA; u.B = (const char*)uni_ptr(tab[g].b) + (size_t)u.pn * tsB; return true;
    }
    __device__ __forceinline__ void a_ready(const Unit&) const {}
    __device__ __forceinline__ void done(const Unit&) const {}
};
struct EpiGroup {
    static constexpr bool PERM = true, AFTER_DRAIN = false;
    const PG8_LAS Op* tab; int Mreal;
    __device__ __forceinline__ void operator()(const f32x4 (&acc)[2][2][4][2], const Unit& u, int wr, int wc, int fr, int fq) const {
        const int ldc = rfl(tab[u.grp].i4), Nreal = rfl(tab[u.grp].i0), fl = rfl(tab[u.grp].i6);
        if (fl & 1) { const EpiBf16Plain E{(bf16_t*)uni_ptr(tab[u.grp].o0), ldc}; E(acc, u, wr, wc, fr, fq); return; }
        float* C = uni_ptr(tab[u.grp].o0); const int row0 = u.pm * BM + wr * 64 + fr, col0 = u.pn * BM + wc * 32 + 8 * fq;
#pragma unroll
        for (int ai = 0; ai < 2; ++ai)
#pragma unroll
            for (int m = 0; m < 4; ++m) { const int r = row0 + ai * HALF + m * 16; if (r < Mreal) { float* rowp = C + (size_t)r * ldc + col0;
#pragma unroll
                for (int bj = 0; bj < 2; ++bj) { if (col0 + bj * HALF < Nreal) { *(f32x4*)(rowp + bj * HALF) = acc[ai][bj][m][0]; *(f32x4*)(rowp + bj * HALF + 4) = acc[ai][bj][m][1]; } } } }
    }
};
}

#define XB_TMO      128
#define XB_XCNT(j)  (256  + 64 * (j))
#define XB_XSUB(j)  (1280 + 64 * (j))
#define XB_XGEN(j)  (2304 + 64 * (j))
#define XB_TOP      3328
#define XB_TOPGEN   3392
#define XCD_BAR_WORDS 3456
#define XB_SPIN_CAP (1u << 18)
#define LAS __attribute__((address_space(3)))
__device__ __forceinline__ unsigned xb_ld(unsigned* p)              { return __hip_atomic_load(p, __ATOMIC_RELAXED, __HIP_MEMORY_SCOPE_AGENT); }
__device__ __forceinline__ unsigned xb_add(unsigned* p, unsigned v) { return __hip_atomic_fetch_add(p, v, __ATOMIC_RELAXED, __HIP_MEMORY_SCOPE_AGENT); }
__device__ __forceinline__ unsigned xb_xcc_id() { return (unsigned)__builtin_amdgcn_s_getreg((3 << 11) | 20) & 0xFu; }
#define XB_SPIN(cond, bar) do { unsigned _sp = 0; while (cond) { __builtin_amdgcn_s_sleep(1); \
    if ((++_sp & 255u) == 0u) { if (xb_ld(&(bar)[XB_TMO])) break; if (_sp > XB_SPIN_CAP) { atomicAdd(&(bar)[XB_TMO], 1u); break; } } } } while (0)
struct XcdBarrier { unsigned* bar; unsigned x; volatile LAS unsigned* st; };
__device__ __forceinline__ XcdBarrier xcd_barrier_post(unsigned* bar, volatile LAS unsigned* st) {
    XcdBarrier b; b.bar = bar; b.x = xb_xcc_id(); b.st = st;
    if (threadIdx.x == 0) (void)xb_add(&bar[XB_XCNT(b.x)], 1u);
    return b;
}
__device__ __forceinline__ void xcd_barrier_complete(unsigned* bar, unsigned x, unsigned& nloc, unsigned& nx) {
    const unsigned G = gridDim.x * gridDim.y * gridDim.z;
    unsigned sum, cnt, mine, sp = 0u;
    for (;;) {
        sum = 0u; cnt = 0u; mine = 0u;
#pragma unroll
        for (unsigned j = 0; j < 16; ++j) { const unsigned c = xb_ld(&bar[XB_XCNT(j)]); sum += c; cnt += (c > 0u) ? 1u : 0u; mine = (j == x) ? c : mine; }
        if (sum == G) break;
        __builtin_amdgcn_s_sleep(1);
        if ((++sp & 255u) == 0u) { if (xb_ld(&bar[XB_TMO])) break; if (sp > XB_SPIN_CAP) { atomicAdd(&bar[XB_TMO], 1u); break; } }
    }
    nloc = mine > 0u ? mine : 1u; nx = cnt > 0u ? cnt : 1u;
}
__device__ __forceinline__ void xcd_barrier(const XcdBarrier& b) {
    asm volatile("s_waitcnt vmcnt(0)" ::: "memory");
    __syncthreads();
    if (threadIdx.x == 0) {
        unsigned* bar = b.bar;
        __builtin_amdgcn_s_waitcnt(0);
        unsigned nloc = b.st[0], nx = b.st[1];
        if (nloc == 0u) { xcd_barrier_complete(bar, b.x, nloc, nx); b.st[0] = nloc; b.st[1] = nx; }
        const unsigned old = xb_add(&bar[XB_XSUB(b.x)], 1u);
        const unsigned gen = old / nloc;
        if (old + 1u == (gen + 1u) * nloc) {
            __builtin_amdgcn_fence(__ATOMIC_RELEASE, "agent");
            asm volatile("s_waitcnt vmcnt(0)" ::: "memory");
            const unsigned og = xb_add(&bar[XB_TOP], 1u);
            const unsigned tg = og / nx;
            if (og + 1u == (tg + 1u) * nx) xb_add(&bar[XB_TOPGEN], 1u);
            else XB_SPIN(xb_ld(&bar[XB_TOPGEN]) == tg, bar);
            __builtin_amdgcn_fence(__ATOMIC_ACQUIRE, "agent");
            xb_add(&bar[XB_XGEN(b.x)], 1u);
            asm volatile("s_waitcnt vmcnt(0)" ::: "memory");
        } else {
            XB_SPIN(xb_ld(&bar[XB_XGEN(b.x)]) == gen, bar);
            __builtin_amdgcn_fence(__ATOMIC_ACQUIRE, "agent");
            asm volatile("s_waitcnt vmcnt(0)" ::: "memory");
        }
    }
    __syncthreads();
}

namespace fk {
#define GAS __attribute__((address_space(1)))
typedef unsigned u32x4 __attribute__((ext_vector_type(4)));
typedef unsigned u32x2 __attribute__((ext_vector_type(2)));
typedef float f32x4 __attribute__((ext_vector_type(4)));
typedef float f32x2 __attribute__((ext_vector_type(2)));
typedef __bf16 bf2 __attribute__((ext_vector_type(2)));
typedef unsigned short bf16_t;
__device__ __forceinline__ float bflo(unsigned u) { return __uint_as_float(u << 16); }
__device__ __forceinline__ float bfhi(unsigned u) { return __uint_as_float(u & 0xffff0000u); }
__device__ __forceinline__ float dot2(unsigned a, unsigned b, float c) { return __builtin_amdgcn_fdot2_f32_bf16(__builtin_bit_cast(bf2, a), __builtin_bit_cast(bf2, b), c, false); }
__device__ __forceinline__ unsigned pk_bf16(float lo, float hi) { unsigned r; asm volatile("v_cvt_pk_bf16_f32 %0, %1, %2" : "=v"(r) : "v"(lo), "v"(hi)); return r; }
template <int CTRL> __device__ __forceinline__ float dppf(float v) { return __int_as_float(__builtin_amdgcn_update_dpp(0, __float_as_int(v), CTRL, 0xf, 0xf, true)); }
__device__ __forceinline__ float row_max16(float v) { v = fmaxf(v, dppf<0xB1>(v)); v = fmaxf(v, dppf<0x4E>(v)); v = fmaxf(v, dppf<0x141>(v)); v = fmaxf(v, dppf<0x140>(v)); return v; }
__device__ __forceinline__ float frcp(float x) { return __builtin_amdgcn_rcpf(x); }
__device__ __forceinline__ float fsqrt(float x) { return __builtin_amdgcn_sqrtf(x); }
__device__ __forceinline__ float row_sum8(float v) { v += dppf<0xB1>(v); v += dppf<0x4E>(v); v += dppf<0x141>(v); return v; }
__device__ __forceinline__ float row_sum16(float v) { v += dppf<0xB1>(v); v += dppf<0x4E>(v); v += dppf<0x141>(v); v += dppf<0x140>(v); return v; }
__device__ __forceinline__ float shx(float v, int m, int lane) { return __int_as_float(__builtin_amdgcn_ds_bpermute((lane ^ m) << 2, __float_as_int(v))); }
__device__ __forceinline__ float wave_sum(float v, int lane) { v = row_sum16(v); v += shx(v, 16, lane); v += shx(v, 32, lane); return v; }
__device__ __forceinline__ float gelu_tanh(float x) { return 0.5f * x * (1.f + tanhf(0.7978845608028654f * (x + 0.044715f * x * x * x))); }
#define FK_NEG (-3.0e38f)

template <int CTRL> __device__ __forceinline__ int dppi(int v) { return __builtin_amdgcn_update_dpp(0, v, CTRL, 0xf, 0xf, true); }
__device__ __forceinline__ int row_min16i(int v) { v = min(v, dppi<0xB1>(v)); v = min(v, dppi<0x4E>(v)); v = min(v, dppi<0x141>(v)); v = min(v, dppi<0x140>(v)); return v; }
#define FK_CE(a, b) do { const bool sw_ = v[b] > v[a]; const float tv_ = sw_ ? v[b] : v[a]; v[b] = sw_ ? v[a] : v[b]; v[a] = tv_; const int ti_ = sw_ ? id[b] : id[a]; id[b] = sw_ ? id[a] : id[b]; id[a] = ti_; } while (0)
#define FK_SORT8(v, id) do { FK_CE2(v, id, 0, 1); FK_CE2(v, id, 2, 3); FK_CE2(v, id, 4, 5); FK_CE2(v, id, 6, 7); FK_CE2(v, id, 0, 2); FK_CE2(v, id, 1, 3); FK_CE2(v, id, 4, 6); FK_CE2(v, id, 5, 7); FK_CE2(v, id, 1, 2); FK_CE2(v, id, 5, 6); \
    FK_CE2(v, id, 0, 4); FK_CE2(v, id, 1, 5); FK_CE2(v, id, 2, 6); FK_CE2(v, id, 3, 7); FK_CE2(v, id, 2, 4); FK_CE2(v, id, 3, 5); FK_CE2(v, id, 1, 2); FK_CE2(v, id, 3, 4); FK_CE2(v, id, 5, 6); } while (0)
#define FK_CE2(v, id, a, b) do { const bool sw_ = v[b] > v[a]; const float tv_ = sw_ ? v[b] : v[a]; v[b] = sw_ ? v[a] : v[b]; v[a] = tv_; const int ti_ = sw_ ? id[b] : id[a]; id[b] = sw_ ? id[a] : id[b]; id[a] = ti_; } while (0)
__device__ __forceinline__ void top16_of_128_x2(float (&v)[8], int (&id)[8], float (&u)[8], int (&jd)[8], int lane16, float& rv1, int& ri1, float& rv2, int& ri2) {
    FK_SORT8(v, id); FK_SORT8(u, jd);
    rv1 = FK_NEG; ri1 = 0; rv2 = FK_NEG; ri2 = 0;
#pragma unroll
    for (int r = 0; r < 16; ++r) {
        const float wm = row_max16(v[0]), xm = row_max16(u[0]);
        const int cand = (v[0] == wm) ? id[0] : 0x7fffffff, dand = (u[0] == xm) ? jd[0] : 0x7fffffff;
        const int sel = row_min16i(cand), tel = row_min16i(dand);
        const bool mine = (cand == sel), nine = (dand == tel);
        if (lane16 == r) { rv1 = wm; ri1 = sel; rv2 = xm; ri2 = tel; }
#pragma unroll
        for (int i = 0; i < 7; ++i) { v[i] = mine ? v[i + 1] : v[i]; id[i] = mine ? id[i + 1] : id[i]; u[i] = nine ? u[i + 1] : u[i]; jd[i] = nine ? jd[i + 1] : jd[i]; }
        v[7] = mine ? FK_NEG : v[7]; u[7] = nine ? FK_NEG : u[7];
    }
}
__device__ __forceinline__ int fk_key(float x, int lane16) { int k = __float_as_int(x); k ^= (k >> 31) & 0x7fffffff; return (k & ~15) | (15 - lane16); }
__device__ __forceinline__ float fk_unkey(int k) { k &= ~15; k ^= (k >> 31) & 0x7fffffff; return __int_as_float(k); }
__device__ __forceinline__ int row_max16i(int v) { v = max(v, dppi<0xB1>(v)); v = max(v, dppi<0x4E>(v)); v = max(v, dppi<0x141>(v)); v = max(v, dppi<0x140>(v)); return v; }
__device__ __forceinline__ void topk_phase(const GAS float* __restrict__ SC, const GAS bf16_t* __restrict__ Q, const GAS float* __restrict__ KSUM, GAS float* __restrict__ GATE, GAS int* __restrict__ EIDX, int nitems,
                                           LAS unsigned char* lds, int wid, int lane, int wave_gid, int nwaves) {
    LAS unsigned char* wb = lds + wid * 6144;
    LAS int* IDS1 = (LAS int*)wb; LAS int* IDS2 = (LAS int*)(wb + 2048); LAS int* LC1 = (LAS int*)(wb + 4096); LAS int* LC2 = (LAS int*)(wb + 4352); LAS int* CI = (LAS int*)(wb + 4608);
    LAS float* xv = (LAS float*)(wb + 4864); LAS int* DUMP = (LAS int*)(wb + 5120) + lane; LAS int* WL1 = (LAS int*)(wb + 5376); LAS int* WL2 = (LAS int*)(wb + 5632);
    const int lane16 = lane & 15, rowbase = lane & 48;
    u32x4 nqa, nqb; f32x4 ns0, ns1, nt0, nt1;
#define TK_LOAD(wi_) do { int it_ = (wi_) * 4 + (lane >> 4); it_ = it_ < nitems ? it_ : nitems - 1; const GAS u32x4* qp_ = (const GAS u32x4*)(Q + (size_t)it_ * 256 + 16 * lane16); nqa = qp_[0]; nqb = qp_[1]; \
        const GAS float* sp_ = SC + (size_t)it_ * 256 + 8 * lane16; ns0 = *(const GAS f32x4*)sp_; ns1 = *(const GAS f32x4*)(sp_ + 4); nt0 = *(const GAS f32x4*)(sp_ + 128); nt1 = *(const GAS f32x4*)(sp_ + 132); } while (0)
    TK_LOAD(wave_gid);
    const GAS float* kp = KSUM + ((wave_gid * 4 + (lane >> 4)) & 7) * 256 + 8 * lane16; const f32x4 k0 = *(const GAS f32x4*)kp, k1 = *(const GAS f32x4*)(kp + 4), m0 = *(const GAS f32x4*)(kp + 128), m1 = *(const GAS f32x4*)(kp + 132);
    for (int wi = wave_gid; wi * 4 < nitems; wi += nwaves) {
        const int it = wi * 4 + (lane >> 4);
        const u32x4 qa = nqa, qb = nqb; const f32x4 s0 = ns0, s1 = ns1, t0 = nt0, t1 = nt1;
        TK_LOAD(wi + nwaves);
        float qs = 0.f, qq = 0.f;
#pragma unroll
        for (int i = 0; i < 4; ++i) { const float a = bflo(qa[i]), b = bfhi(qa[i]), c = bflo(qb[i]), d = bfhi(qb[i]); qs += (a + b) + (c + d); qq += (a * a + b * b) + (c * c + d * d); }
        const float mu = row_sum16(qs) * (1.f / 256.f); const float var = fmaxf(row_sum16(qq) * (1.f / 256.f) - mu * mu, 0.f); const float rs = 1.f / sqrtf(var + 1e-5f);
        float v[8], u[8]; int id[8], jd[8];
        {
#pragma unroll
          for (int i = 0; i < 4; ++i) { v[i] = rs * (s0[i] - mu * k0[i]); v[4 + i] = rs * (s1[i] - mu * k1[i]); u[i] = rs * (t0[i] - mu * m0[i]); u[4 + i] = rs * (t1[i] - mu * m1[i]);
              id[i] = 8 * lane16 + i; id[4 + i] = 8 * lane16 + 4 + i; jd[i] = 8 * lane16 + i; jd[4 + i] = 8 * lane16 + 4 + i; } }
        FK_SORT8(v, id); FK_SORT8(u, jd);
#pragma unroll
        for (int i = 0; i < 8; ++i) { IDS1[lane * 8 + i] = id[i]; IDS2[lane * 8 + i] = jd[i]; }
        float rv1 = FK_NEG, rv2 = FK_NEG; int wl1 = 0, wl2 = 0, cn1 = 0, cn2 = 0;
#pragma unroll
        for (int r = 0; r < 16; ++r) {
            const int key1 = fk_key(v[0], lane16), key2 = fk_key(u[0], lane16);
            const int wm1 = row_max16i(key1), wm2 = row_max16i(key2);
            const bool mine = (key1 == wm1), nine = (key2 == wm2);
            if (lane16 == r) { rv1 = fk_unkey(wm1); wl1 = 15 - (wm1 & 15); rv2 = fk_unkey(wm2); wl2 = 15 - (wm2 & 15); }
            *(mine ? LC1 + rowbase + r : DUMP) = cn1; *(nine ? LC2 + rowbase + r : DUMP) = cn2;
#pragma unroll
            for (int i = 0; i < 7; ++i) { v[i] = mine ? v[i + 1] : v[i]; u[i] = nine ? u[i + 1] : u[i]; }
            v[7] = mine ? FK_NEG : v[7]; u[7] = nine ? FK_NEG : u[7]; cn1 += mine ? 1 : 0; cn2 += nine ? 1 : 0;
        }
        xv[lane] = rv2; WL1[lane] = wl1; WL2[lane] = wl2;
        float c[16];
        { const LAS f32x4* xp = (const LAS f32x4*)(xv + rowbase);
#pragma unroll
          for (int q = 0; q < 4; ++q) { const f32x4 t = xp[q]; c[4 * q] = rv1 + t.x; c[4 * q + 1] = rv1 + t.y; c[4 * q + 2] = rv1 + t.z; c[4 * q + 3] = rv1 + t.w; } }
        int p = 0, wli = 0; float sc = FK_NEG;
#pragma unroll
        for (int r = 0; r < 16; ++r) {
            const int key = fk_key(c[0], lane16); const int wm = row_max16i(key); const bool mine = (key == wm);
            if (lane16 == r) { sc = fk_unkey(wm); wli = 15 - (wm & 15); }
            *(mine ? CI + rowbase + r : DUMP) = p;
#pragma unroll
            for (int i = 0; i < 15; ++i) c[i] = mine ? c[i + 1] : c[i];
            c[15] = mine ? FK_NEG : c[15]; p += mine ? 1 : 0;
        }
        const int i1 = wli & 15, j2 = CI[rowbase + lane16] & 15;
        const int e1 = IDS1[(rowbase + (WL1[rowbase + i1] & 15)) * 8 + (LC1[rowbase + i1] & 7)], e2 = IDS2[(rowbase + (WL2[rowbase + j2] & 15)) * 8 + (LC2[rowbase + j2] & 7)];
        const float mx = fk_unkey(row_max16i(fk_key(sc, 0))); const float ex = __expf(sc - mx); const float den = row_sum16(ex);
        GATE[(size_t)it * 16 + lane16] = ex / den; EIDX[(size_t)it * 16 + lane16] = (e1 & 127) * 128 + (e2 & 127);
    }
#undef TK_LOAD
}

__device__ __forceinline__ f32x2 fp8lo(unsigned w) { return __builtin_amdgcn_cvt_pk_f32_fp8((int)w, false); }
__device__ __forceinline__ f32x2 fp8hi(unsigned w) { return __builtin_amdgcn_cvt_pk_f32_fp8((int)w, true); }
__device__ __forceinline__ void act_phase(const GAS bf16_t* __restrict__ XB, const GAS unsigned char* __restrict__ U8, const GAS float* __restrict__ GATE, const GAS int* __restrict__ EIDX, GAS float* __restrict__ COEF, int nitems,
                                          int lane, int wave_gid, int nwaves) {
    int it = wave_gid; if (it >= nitems) return;
    u32x4 uc[16], un[16], xac, xbc, xan, xbn;
    int evc = EIDX[(size_t)it * 16 + (lane & 15)];
    { const GAS u32x4* xp = (const GAS u32x4*)(XB + (size_t)(it >> 3) * 1024 + 16 * lane); xac = xp[0]; xbc = xp[1]; }
#pragma unroll
    for (int k = 0; k < 16; ++k) uc[k] = *(const GAS u32x4*)(U8 + (size_t)__builtin_amdgcn_readlane(evc, k) * 1024 + 16 * lane);
    int itn = it + nwaves; int evn = (itn < nitems) ? EIDX[(size_t)itn * 16 + (lane & 15)] : 0;
    for (;;) {
        const bool hasn = itn < nitems;
        if (hasn) {
            const GAS u32x4* xp = (const GAS u32x4*)(XB + (size_t)(itn >> 3) * 1024 + 16 * lane); xan = xp[0]; xbn = xp[1];
#pragma unroll
            for (int k = 0; k < 16; ++k) un[k] = *(const GAS u32x4*)(U8 + (size_t)__builtin_amdgcn_readlane(evn, k) * 1024 + 16 * lane);
        }
        const int itnn = itn + nwaves; const int evnn = (itnn < nitems) ? EIDX[(size_t)itnn * 16 + (lane & 15)] : 0;
        const float gt = GATE[(size_t)it * 16 + (lane >> 2)];
        float x[16];
#pragma unroll
        for (int i = 0; i < 4; ++i) { x[2 * i] = bflo(xac[i]); x[2 * i + 1] = bfhi(xac[i]); x[8 + 2 * i] = bflo(xbc[i]); x[8 + 2 * i + 1] = bfhi(xbc[i]); }
        float a[16];
#pragma unroll
        for (int k = 0; k < 16; ++k) { const u32x4 uw = uc[k]; float s = 0.f;
#pragma unroll
            for (int d = 0; d < 4; ++d) { const f32x2 lo = fp8lo(uw[d]), hi = fp8hi(uw[d]); s = fmaf(lo.x, x[4 * d], s); s = fmaf(lo.y, x[4 * d + 1], s); s = fmaf(hi.x, x[4 * d + 2], s); s = fmaf(hi.y, x[4 * d + 3], s); }
            asm volatile("" : "+v"(s)); a[k] = s; }
#pragma unroll
        for (int k = 0; k < 8; ++k) { const bool hi = lane & 32; const float send = hi ? a[k] : a[k + 8], keep = hi ? a[k + 8] : a[k]; a[k] = keep + shx(send, 32, lane); }
#pragma unroll
        for (int k = 0; k < 4; ++k) { const bool hi = lane & 16; const float send = hi ? a[k] : a[k + 4], keep = hi ? a[k + 4] : a[k]; a[k] = keep + shx(send, 16, lane); }
#pragma unroll
        for (int k = 0; k < 2; ++k) { const bool hi = lane & 8; const float send = hi ? a[k] : a[k + 2], keep = hi ? a[k + 2] : a[k]; a[k] = keep + shx(send, 8, lane); }
        { const bool hi = lane & 4; const float send = hi ? a[0] : a[1], keep = hi ? a[1] : a[0]; a[0] = keep + shx(send, 4, lane); }
        float dsum = a[0]; dsum += shx(dsum, 2, lane); dsum += shx(dsum, 1, lane);
        if ((lane & 3) == 0) COEF[(size_t)it * 16 + (lane >> 2)] = gt * gelu_tanh(dsum * (1.f / 128.f));
        if (!hasn) break;
#pragma unroll
        for (int k = 0; k < 16; ++k) uc[k] = un[k];
        xac = xan; xbc = xbn; evc = evn; evn = evnn; it = itn; itn = itnn;
    }
}

__device__ __forceinline__ void outln_phase(const GAS float* COEF, const GAS int* EIDX, const GAS unsigned char* V8,     const GAS float* __restrict__ lg, const GAS float* __restrict__ lb, GAS float* X, GAS bf16_t* XB, int nrows,
                                            int lane, int wave_gid, int nwaves) {
    const float alpha = 1.6817928305074292f;
    int row = wave_gid; if (row >= nrows) return;
    u32x4 vc[16], vn[16];
    float cf0 = COEF[(size_t)row * 128 + lane] * (1.f / 64.f), cf1 = COEF[(size_t)row * 128 + 64 + lane] * (1.f / 64.f); int ev0 = EIDX[(size_t)row * 128 + lane], ev1 = EIDX[(size_t)row * 128 + 64 + lane];
#define OUT_LOADCH(dst, evreg, base) do { _Pragma("unroll") for (int k_ = 0; k_ < 16; ++k_) dst[k_] = *(const GAS u32x4*)(V8 + (size_t)__builtin_amdgcn_readlane(evreg, (base) + k_) * 1024 + 16 * lane); } while (0)
#define OUT_COMPCH(src, cfreg, base) do { _Pragma("unroll") for (int k_ = 0; k_ < 16; ++k_) { const float c_ = __int_as_float(__builtin_amdgcn_readlane(__float_as_int(cfreg), (base) + k_)); const u32x4 vw_ = src[k_]; \
        _Pragma("unroll") for (int d_ = 0; d_ < 4; ++d_) { const f32x2 lo_ = fp8lo(vw_[d_]), hi_ = fp8hi(vw_[d_]); acc[4 * d_] = fmaf(c_, lo_.x, acc[4 * d_]); acc[4 * d_ + 1] = fmaf(c_, lo_.y, acc[4 * d_ + 1]); acc[4 * d_ + 2] = fmaf(c_, hi_.x, acc[4 * d_ + 2]); acc[4 * d_ + 3] = fmaf(c_, hi_.y, acc[4 * d_ + 3]); } \
        _Pragma("unroll") for (int p_ = 0; p_ < 16; ++p_) asm volatile("" : "+v"(acc[p_]));     \
        } } while (0)
    for (;;) {
        OUT_LOADCH(vc, ev0, 0);
        const int rown = row + nwaves; const bool hasn = rown < nrows;
        float ncf0 = 0.f, ncf1 = 0.f; int nev0 = 0, nev1 = 0;
        if (hasn) { ncf0 = COEF[(size_t)rown * 128 + lane] * (1.f / 64.f); ncf1 = COEF[(size_t)rown * 128 + 64 + lane] * (1.f / 64.f); nev0 = EIDX[(size_t)rown * 128 + lane]; nev1 = EIDX[(size_t)rown * 128 + 64 + lane]; }
        float acc[16];
#pragma unroll
        for (int k = 0; k < 16; ++k) acc[k] = 0.f;
#define OUT_FENCE() asm volatile("" ::: "memory")
        OUT_LOADCH(vn, ev0, 16); OUT_FENCE(); OUT_COMPCH(vc, cf0, 0); OUT_FENCE();
        OUT_LOADCH(vc, ev0, 32); OUT_FENCE(); OUT_COMPCH(vn, cf0, 16); OUT_FENCE();
        OUT_LOADCH(vn, ev0, 48); OUT_FENCE(); OUT_COMPCH(vc, cf0, 32); OUT_FENCE();
        OUT_LOADCH(vc, ev1, 0);  OUT_FENCE(); OUT_COMPCH(vn, cf0, 48); OUT_FENCE();
        OUT_LOADCH(vn, ev1, 16); OUT_FENCE(); OUT_COMPCH(vc, cf1, 0); OUT_FENCE();
        OUT_LOADCH(vc, ev1, 32); OUT_FENCE(); OUT_COMPCH(vn, cf1, 16); OUT_FENCE();
        OUT_LOADCH(vn, ev1, 48); OUT_FENCE(); OUT_COMPCH(vc, cf1, 32); OUT_FENCE();
        OUT_COMPCH(vn, cf1, 48); OUT_FENCE();
#undef OUT_FENCE
        GAS float* xr = X + (size_t)row * 1024 + 16 * lane; float t[16];
#pragma unroll
        for (int q = 0; q < 4; ++q) { const f32x4 xv = *(const GAS f32x4*)(xr + 4 * q); t[4 * q] = fmaf(alpha, xv.x, acc[4 * q]); t[4 * q + 1] = fmaf(alpha, xv.y, acc[4 * q + 1]); t[4 * q + 2] = fmaf(alpha, xv.z, acc[4 * q + 2]); t[4 * q + 3] = fmaf(alpha, xv.w, acc[4 * q + 3]); }
        float s = 0.f;
#pragma unroll
        for (int k = 0; k < 16; ++k) s += t[k];
        const float mu = wave_sum(s, lane) * (1.f / 1024.f); float vs = 0.f;
#pragma unroll
        for (int k = 0; k < 16; ++k) { t[k] -= mu; vs = fmaf(t[k], t[k], vs); }
        const float rs = 1.f / sqrtf(wave_sum(vs, lane) * (1.f / 1024.f) + 1e-5f);
        unsigned w[8];
#pragma unroll
        for (int q = 0; q < 4; ++q) { const f32x4 g = *(const GAS f32x4*)(lg + 16 * lane + 4 * q), b = *(const GAS f32x4*)(lb + 16 * lane + 4 * q); f32x4 o;
            o.x = t[4 * q] * rs * g.x + b.x; o.y = t[4 * q + 1] * rs * g.y + b.y; o.z = t[4 * q + 2] * rs * g.z + b.z; o.w = t[4 * q + 3] * rs * g.w + b.w;
            *(GAS f32x4*)(xr + 4 * q) = o; w[2 * q] = pk_bf16(o.x, o.y); w[2 * q + 1] = pk_bf16(o.z, o.w); }
        u32x4 w0, w1; w0.x = w[0]; w0.y = w[1]; w0.z = w[2]; w0.w = w[3]; w1.x = w[4]; w1.y = w[5]; w1.z = w[6]; w1.w = w[7];
        GAS u32x4* xbp = (GAS u32x4*)(XB + (size_t)row * 1024 + 16 * lane); xbp[0] = w0; xbp[1] = w1;
        if (!hasn) break;
        row = rown; cf0 = ncf0; cf1 = ncf1; ev0 = nev0; ev1 = nev1;
    }
#undef OUT_LOADCH
#undef OUT_COMPCH
}

__device__ __forceinline__ void lnres_phase(const GAS bf16_t* __restrict__ Y, const GAS float* __restrict__ lg, const GAS float* __restrict__ lb, GAS float* X, GAS bf16_t* XB, GAS unsigned char* XF8, int nrows, int lane, int wave_gid, int nwaves) {
    const float alpha = 1.6817928305074292f;
    for (int row = wave_gid; row < nrows; row += nwaves) {
        GAS float* xr = X + (size_t)row * 1024; const GAS bf16_t* yr = Y + (size_t)row * 1024; float t[16];
#pragma unroll
        for (int q = 0; q < 4; ++q) { const f32x4 xv = *(const GAS f32x4*)(xr + 256 * q + 4 * lane); const u32x2 yw = *(const GAS u32x2*)(yr + 256 * q + 4 * lane);
            t[4 * q] = fmaf(alpha, xv.x, bflo(yw.x)); t[4 * q + 1] = fmaf(alpha, xv.y, bfhi(yw.x)); t[4 * q + 2] = fmaf(alpha, xv.z, bflo(yw.y)); t[4 * q + 3] = fmaf(alpha, xv.w, bfhi(yw.y)); }
        float s = 0.f;
#pragma unroll
        for (int k = 0; k < 16; ++k) s += t[k];
        const float mu = wave_sum(s, lane) * (1.f / 1024.f); float vs = 0.f;
#pragma unroll
        for (int k = 0; k < 16; ++k) { t[k] -= mu; vs = fmaf(t[k], t[k], vs); }
        const float rs = 1.f / sqrtf(wave_sum(vs, lane) * (1.f / 1024.f) + 1e-5f);
#pragma unroll
        for (int q = 0; q < 4; ++q) { const int c = 256 * q + 4 * lane; const f32x4 g = *(const GAS f32x4*)(lg + c), b = *(const GAS f32x4*)(lb + c); f32x4 o;
            o.x = t[4 * q] * rs * g.x + b.x; o.y = t[4 * q + 1] * rs * g.y + b.y; o.z = t[4 * q + 2] * rs * g.z + b.z; o.w = t[4 * q + 3] * rs * g.w + b.w;
            *(GAS f32x4*)(xr + c) = o; u32x2 w; w.x = pk_bf16(o.x, o.y); w.y = pk_bf16(o.z, o.w); *(GAS u32x2*)(XB + (size_t)row * 1024 + c) = w;
            if (XF8) {
                const float s0 = __builtin_amdgcn_fmed3f(o.x * 16.f, -448.f, 448.f), s1 = __builtin_amdgcn_fmed3f(o.y * 16.f, -448.f, 448.f), s2 = __builtin_amdgcn_fmed3f(o.z * 16.f, -448.f, 448.f), s3 = __builtin_amdgcn_fmed3f(o.w * 16.f, -448.f, 448.f);
                int hp = __builtin_amdgcn_cvt_pk_fp8_f32(s0, s1, 0, false); hp = __builtin_amdgcn_cvt_pk_fp8_f32(s2, s3, hp, true);
                const f32x2 d01 = fp8lo((unsigned)hp), d23 = fp8hi((unsigned)hp);
                int lp = __builtin_amdgcn_cvt_pk_fp8_f32(s0 - d01.x, s1 - d01.y, 0, false); lp = __builtin_amdgcn_cvt_pk_fp8_f32(s2 - d23.x, s3 - d23.y, lp, true);
                *(GAS int*)(XF8 + (size_t)row * 2048 + c) = hp; *(GAS int*)(XF8 + (size_t)row * 2048 + 1024 + c) = lp; } }
    }
}

__device__ __forceinline__ void glanorm_phase(const GAS float* __restrict__ O, const GAS float* __restrict__ PROJ, const GAS float* __restrict__ gnorm, GAS bf16_t* XB, int nitems, int lane, int wave_gid, int nwaves) {
    const float g0 = gnorm[lane], g1 = gnorm[64 + lane];
    for (int it0 = wave_gid * 4; it0 < nitems; it0 += nwaves * 4) {
        float a0[4], a1[4], r0[4], r1[4];
#pragma unroll
        for (int q = 0; q < 4; ++q) { int it = it0 + q; it = it < nitems ? it : it0; const int row = it >> 2, h = it & 3; const GAS float* o = O + (size_t)row * 512 + h * 128; const GAS float* r = PROJ + (size_t)row * 2576 + 1040 + h * 128;
            a0[q] = o[lane]; a1[q] = o[64 + lane]; r0[q] = r[lane]; r1[q] = r[64 + lane]; }
#pragma unroll
        for (int q = 0; q < 4; ++q) { const int it = it0 + q; const int row = it >> 2, h = it & 3;
            const float rs = 1.f / sqrtf(wave_sum(a0[q] * a0[q] + a1[q] * a1[q], lane) * (1.f / 128.f) + 1e-5f);
            const float y0 = a0[q] * rs * g0 * (r0[q] * frcp(1.f + __expf(-r0[q]))), y1 = a1[q] * rs * g1 * (r1[q] * frcp(1.f + __expf(-r1[q])));
            if (it < nitems) { GAS bf16_t* d = XB + (size_t)row * 1024 + h * 128; d[lane] = (bf16_t)(pk_bf16(y0, 0.f) & 0xffffu); d[64 + lane] = (bf16_t)(pk_bf16(y1, 0.f) & 0xffffu); } }
    }
}

__device__ __forceinline__ float sigm(float x) { return frcp(1.f + __expf(-x)); }
__device__ __forceinline__ float softplusf(float x) { return fmaxf(x, 0.f) + log1pf(__expf(-fabsf(x))); }
__device__ __forceinline__ void rwkvprep_phase(const GAS float* __restrict__ w0, const GAS float* __restrict__ a0, const GAS float* __restrict__ v0, const GAS float* __restrict__ k_k, const GAS float* __restrict__ k_a, const GAS float* __restrict__ Vg,
                                               GAS float* K, GAS float* Wd, GAS float* Aa, GAS float* V, GAS float* NKK, GAS float* VFIRST, int has_vres, int nitems, int lane, int wave_gid, int nwaves) {
    for (int it0 = wave_gid * 4; it0 < nitems; it0 += nwaves * 4) {
        float kq[4], wq[4], aq[4], vq[4], gq[4], fq[4];
#pragma unroll
        for (int q = 0; q < 4; ++q) { const int it = it0 + q; const size_t ix = (size_t)(it >> 4) * 1024 + (it & 15) * 64 + lane; kq[q] = K[ix]; wq[q] = Wd[ix]; aq[q] = Aa[ix]; vq[q] = V[ix]; gq[q] = has_vres ? Vg[ix] : 0.f; fq[q] = has_vres ? VFIRST[ix] : 0.f; }
#pragma unroll
        for (int q = 0; q < 4; ++q) { const int it = it0 + q; const int h = it & 15; const size_t ix = (size_t)(it >> 4) * 1024 + h * 64 + lane; const int c = h * 64 + lane;
            const float k0 = kq[q]; const float kv = k0 * k_k[c]; const float inv = 1.f / fmaxf(sqrtf(wave_sum(kv * kv, lane)), 1e-12f);
            const float w = -softplusf(-(w0[c] + wq[q])) - 0.5f; const float dec = __expf(-__expf(w));
            const float a = sigm(a0[c] + aq[q]);
            float v = vq[q]; if (has_vres) v = v + (fq[q] - v) * sigm(v0[c] + gq[q]); else VFIRST[ix] = v;
            const float kk = kv * inv;
            NKK[ix] = -kk; K[ix] = k0 * (1.f + (a - 1.f) * k_a[c]); Wd[ix] = dec; Aa[ix] = kk * a; V[ix] = v; }
    }
}

__device__ __forceinline__ void rwkvpost_phase(const GAS float* __restrict__ Y, const GAS float* __restrict__ R, const GAS float* __restrict__ K2, const GAS float* __restrict__ V, const GAS float* __restrict__ G, const GAS float* __restrict__ r_k,
                                               const GAS float* __restrict__ lnx_g, const GAS float* __restrict__ lnx_b, GAS bf16_t* XB, int nitems, int lane, int wave_gid, int nwaves) {
    for (int it0 = wave_gid * 4; it0 < nitems; it0 += nwaves * 4) {
        float yq[4], rq[4], kq[4], vq[4], gq[4];
#pragma unroll
        for (int q = 0; q < 4; ++q) { const int it = it0 + q; const size_t ix = (size_t)(it >> 4) * 1024 + (it & 15) * 64 + lane; yq[q] = Y[ix]; rq[q] = R[ix]; kq[q] = K2[ix]; vq[q] = V[ix]; gq[q] = G[ix]; }
#pragma unroll
        for (int q = 0; q < 4; ++q) { const int it = it0 + q; const int h = it & 15; const size_t ix = (size_t)(it >> 4) * 1024 + h * 64 + lane; const int c = h * 64 + lane;
            const float y = yq[q]; const float mu = wave_sum(y, lane) * (1.f / 64.f); const float d = y - mu; const float rs = 1.f / sqrtf(wave_sum(d * d, lane) * (1.f / 64.f) + 64e-5f);
            const float bon = wave_sum(rq[q] * kq[q] * r_k[c], lane);
            const float o = (d * rs * lnx_g[c] + lnx_b[c] + bon * vq[q]) * gq[q];
            XB[ix] = (bf16_t)(pk_bf16(o, 0.f) & 0xffffu); }
    }
}

__device__ __forceinline__ void wkv_phase(const GAS float* __restrict__ R, const GAS float* __restrict__ Wd, const GAS float* __restrict__ K2, const GAS float* __restrict__ V, const GAS float* __restrict__ BB, const GAS float* __restrict__ NKK,
                                          const GAS float* __restrict__ SIN, GAS float* __restrict__ Y, GAS float* __restrict__ P, GAS float* __restrict__ SOUT, int B, int T, int DB, int DT, LAS unsigned char* lds, int tid, int bid, int nb) {
    constexpr int TB = 32, NLD = 6, VECB = TB * 1280, VVB = TB * 128, BUF = VECB + 2 * VVB;
    const int rowl = tid >> 4, part = tid & 15;
    const int nprompt = B * 32, nunits = nprompt + DB * 32;
    for (int u = bid; u < nunits; u += nb) {
        const bool smp = u >= nprompt; const int q0_ = smp ? u - nprompt : u; const int q = ((q0_ & 7) << 1 | ((q0_ >> 3) & 1)) + ((q0_ >> 4) << 4);
        const int half = q & 1, pair = q >> 1, sq = pair >> 4, h = pair & 15;
        const int Tu = smp ? DT : T; const int r0 = smp ? B * T + sq * DT : sq * T, vrow = half * 32 + rowl;
        f32x2 S01 = (f32x2){0.f, 0.f}, S23 = (f32x2){0.f, 0.f};
        if (smp) { const f32x4 s4 = *(const GAS f32x4*)(SIN + ((size_t)pair * 64 + vrow) * 64 + part * 4); S01 = (f32x2){s4.x, s4.y}; S23 = (f32x2){s4.z, s4.w};
                   asm volatile("" : "+v"(S01), "+v"(S23)); }
        const int nblk = (Tu + TB - 1) / TB;
        f32x4 ld[NLD];
        const size_t eo_ = (size_t)(r0 + (tid >> 4)) * 1024 + h * 64 + (tid & 15) * 4, ev_ = (size_t)(r0 + ((tid & 255) >> 3)) * 1024 + h * 64 + half * 32 + (tid & 7) * 4;
        const int lo_ = ((tid >> 4) * 320 + (tid & 15) * 4) * 4, lv_ = VECB + (tid & 255) * 16;
#define WKV_LOAD(tb0) do { const size_t bo_ = (size_t)(tb0) * 1024; ld[0] = *(const GAS f32x4*)(Wd + eo_ + bo_); ld[1] = *(const GAS f32x4*)(NKK + eo_ + bo_); ld[2] = *(const GAS f32x4*)(BB + eo_ + bo_); \
            ld[3] = *(const GAS f32x4*)(K2 + eo_ + bo_); ld[4] = *(const GAS f32x4*)(R + eo_ + bo_); ld[5] = *(const GAS f32x4*)(V + ev_ + bo_); } while (0)
#define WKV_STORE(bufp) do { _Pragma("unroll") for (int q_ = 0; q_ < 5; ++q_) *(LAS f32x4*)((bufp) + lo_ + q_ * 256) = ld[q_]; *(LAS f32x4*)((bufp) + lv_) = ld[5]; } while (0)
        WKV_LOAD(0); WKV_STORE(lds); __syncthreads();
        for (int b = 0; b < nblk; ++b) {
            LAS unsigned char* cur = lds + (b & 1) * BUF; LAS unsigned char* nxt = lds + ((b + 1) & 1) * BUF; const int tb0 = b * TB; const int nt = (Tu - tb0) < TB ? (Tu - tb0) : TB;
            if (b + 1 < nblk) WKV_LOAD(tb0 + TB);
            const LAS float* vec = (const LAS float*)cur + part * 4; const LAS float* vv = (const LAS float*)(cur + VECB) + rowl; LAS float* yb = (LAS float*)(cur + VECB + VVB);
            float ykeep0 = 0.f, ykeep1 = 0.f;
#define WKV_STEP(t, keep, tl) do { const LAS f32x2* vp_ = (const LAS f32x2*)(vec + (t) * 320); \
                const f32x2 w01 = vp_[0], w23 = vp_[1], n01 = vp_[32], n23 = vp_[33], b01 = vp_[64], b23 = vp_[65], k01 = vp_[96], k23 = vp_[97], r01 = vp_[128], r23 = vp_[129]; \
                const float v = vv[(t) * 32]; \
                const f32x2 sp = __builtin_elementwise_fma(S23, n23, S01 * n01); const float sa = row_sum16(sp.x + sp.y); const f32x2 sa2 = (f32x2){sa, sa}, v2 = (f32x2){v, v}; \
                S01 = __builtin_elementwise_fma(S01, w01, __builtin_elementwise_fma(b01, sa2, k01 * v2)); S23 = __builtin_elementwise_fma(S23, w23, __builtin_elementwise_fma(b23, sa2, k23 * v2)); \
                const f32x2 yp = __builtin_elementwise_fma(S23, r23, S01 * r01); const float y = row_sum16(yp.x + yp.y); \
                keep = (part == (tl)) ? y : keep; } while (0)
            if (nt == TB) {
#pragma unroll 1
                for (int t = 0; t < 16; t += 8) { WKV_STEP(t, ykeep0, t); WKV_STEP(t + 1, ykeep0, t + 1); WKV_STEP(t + 2, ykeep0, t + 2); WKV_STEP(t + 3, ykeep0, t + 3); WKV_STEP(t + 4, ykeep0, t + 4); WKV_STEP(t + 5, ykeep0, t + 5); WKV_STEP(t + 6, ykeep0, t + 6); WKV_STEP(t + 7, ykeep0, t + 7); }
#pragma unroll 1
                for (int t = 16; t < 32; t += 8) { WKV_STEP(t, ykeep1, t - 16); WKV_STEP(t + 1, ykeep1, t - 15); WKV_STEP(t + 2, ykeep1, t - 14); WKV_STEP(t + 3, ykeep1, t - 13); WKV_STEP(t + 4, ykeep1, t - 12); WKV_STEP(t + 5, ykeep1, t - 11); WKV_STEP(t + 6, ykeep1, t - 10); WKV_STEP(t + 7, ykeep1, t - 9); }
            } else { for (int t = 0; t < nt; ++t) { if (t < 16) WKV_STEP(t, ykeep0, t); else WKV_STEP(t, ykeep1, t - 16); } }
#undef WKV_STEP
            yb[part * 32 + rowl] = ykeep0; yb[(16 + part) * 32 + rowl] = ykeep1;
            if (b + 1 < nblk) WKV_STORE(nxt);
            __syncthreads();
            { const int rl = tid & 31; _Pragma("unroll") for (int t = tid >> 5; t < TB; t += 16) if (t < nt) Y[(size_t)(r0 + tb0 + t) * 1024 + h * 64 + half * 32 + rl] = yb[t * 32 + rl]; }
        }
#undef WKV_LOAD
#undef WKV_STORE
        *(GAS f32x4*)((smp ? SOUT : P) + ((size_t)pair * 64 + vrow) * 64 + part * 4) = (f32x4){S01.x, S01.y, S23.x, S23.y};
        __syncthreads();
    }
}

__device__ __forceinline__ void rwkvpost2_phase(const GAS float* __restrict__ Y, const GAS bf16_t* __restrict__ G, const GAS float* __restrict__ VF, const GAS float* __restrict__ BON, const GAS float* __restrict__ lnx_g, const GAS float* __restrict__ lnx_b,
                                                GAS bf16_t* XB, int nitems, int lane, int wave_gid, int nwaves) {
    for (int it0 = wave_gid * 4; it0 < nitems; it0 += nwaves * 4) {
        float yq[4], gq[4], vq[4], bq[4];
#pragma unroll
        for (int q = 0; q < 4; ++q) { const int it = it0 + q; const size_t ix = (size_t)(it >> 4) * 1024 + (it & 15) * 64 + lane; yq[q] = Y[ix]; gq[q] = __uint_as_float((unsigned)G[ix] << 16); vq[q] = VF[ix]; bq[q] = BON[it]; }
#pragma unroll
        for (int q = 0; q < 4; ++q) { const int it = it0 + q; const int h = it & 15; const size_t ix = (size_t)(it >> 4) * 1024 + h * 64 + lane; const int c = h * 64 + lane;
            const float y = yq[q]; const float mu = wave_sum(y, lane) * (1.f / 64.f); const float d = y - mu; const float rs = 1.f / sqrtf(wave_sum(d * d, lane) * (1.f / 64.f) + 64e-5f);
            const float o = (d * rs * lnx_g[c] + lnx_b[c] + bq[q] * vq[q]) * gq[q];
            XB[ix] = (bf16_t)(pk_bf16(o, 0.f) & 0xffffu); }
    }
}

__device__ __forceinline__ void wkv2_phase(const GAS bf16_t* __restrict__ R, const GAS bf16_t* __restrict__ KR, const GAS bf16_t* __restrict__ WL, const GAS bf16_t* __restrict__ AL, const GAS bf16_t* __restrict__ V, const GAS bf16_t* __restrict__ VG,
                                           const GAS float* VFI, const GAS float* __restrict__ PRM, const GAS float* __restrict__ SIN, GAS float* __restrict__ Y, GAS float* __restrict__ P, GAS float* __restrict__ SOUT, GAS float* VFO, GAS float* __restrict__ BON,
                                           int has_vres, int B, int T, int DB, int DT, LAS unsigned char* lds, int tid, int bid, int nb) {
    constexpr int TB = 32, VECB = TB * 1280, VVB = TB * 128, BUF = VECB + 2 * VVB;
    const bool scanw = __builtin_amdgcn_readfirstlane(tid) < 256; const int pt = tid & 255;
    const int rowl = pt >> 4, part = pt & 15;
    const int nprompt = B * 32, nunits = nprompt + DB * 32;
    for (int u = bid; u < nunits; u += nb) {
        const bool smp = u >= nprompt; const int q0_ = smp ? u - nprompt : u; const int q = ((q0_ & 7) << 1 | ((q0_ >> 3) & 1)) + ((q0_ >> 4) << 4);
        const int half = q & 1, pair = q >> 1, sq = pair >> 4, h = pair & 15;
        const int Tu = smp ? DT : T; const int r0 = smp ? B * T + sq * DT : sq * T, vrow = half * 32 + rowl;
        const int srow = pt >> 3, sp8 = pt & 7;
        f32x2 S0 = (f32x2){0.f, 0.f}, S1 = (f32x2){0.f, 0.f}, S2 = (f32x2){0.f, 0.f}, S3 = (f32x2){0.f, 0.f};
        if (smp && scanw) { const GAS f32x4* sp_ = (const GAS f32x4*)(SIN + ((size_t)pair * 64 + half * 32 + srow) * 64 + sp8 * 8); const f32x4 sa4 = sp_[0], sb4 = sp_[1];
                   S0 = (f32x2){sa4.x, sa4.y}; S1 = (f32x2){sa4.z, sa4.w}; S2 = (f32x2){sb4.x, sb4.y}; S3 = (f32x2){sb4.z, sb4.w};
                   asm volatile("" : "+v"(S0), "+v"(S1), "+v"(S2), "+v"(S3)); }
        const int nblk = (Tu + TB - 1) / TB;
        u32x2 lk0, lw0, la0, lr0, lk1, lw1, la1, lr1, lv, lg = (u32x2){0u, 0u}; f32x4 lf = (f32x4){0.f, 0.f, 0.f, 0.f};
        const size_t eo_ = (size_t)(r0 + (pt >> 4)) * 1024 + h * 64 + part * 4, ev_ = (size_t)(r0 + (pt >> 3)) * 1024 + h * 64 + half * 32 + (pt & 7) * 4;
        const int lo_ = ((pt >> 4) * 320 + part * 4) * 4, lv_ = VECB + pt * 16;
        const int pc_ = h * 64 + part * 4; const f32x4 w0v = *(const GAS f32x4*)(PRM + pc_), a0v = *(const GAS f32x4*)(PRM + 1024 + pc_), kkp = *(const GAS f32x4*)(PRM + 3072 + pc_), kap = *(const GAS f32x4*)(PRM + 4096 + pc_), rkp = *(const GAS f32x4*)(PRM + 5120 + pc_);
        const f32x4 v0v = *(const GAS f32x4*)(PRM + 2048 + h * 64 + half * 32 + (pt & 7) * 4);
#define WKV_LOAD(tb0) do { const size_t bo_ = (size_t)(tb0) * 1024, b1_ = bo_ + 16 * 1024; lk0 = *(const GAS u32x2*)(KR + eo_ + bo_); lw0 = *(const GAS u32x2*)(WL + eo_ + bo_); la0 = *(const GAS u32x2*)(AL + eo_ + bo_); lr0 = *(const GAS u32x2*)(R + eo_ + bo_); \
            lk1 = *(const GAS u32x2*)(KR + eo_ + b1_); lw1 = *(const GAS u32x2*)(WL + eo_ + b1_); la1 = *(const GAS u32x2*)(AL + eo_ + b1_); lr1 = *(const GAS u32x2*)(R + eo_ + b1_); \
            lv = *(const GAS u32x2*)(V + ev_ + bo_); if (has_vres) { lg = *(const GAS u32x2*)(VG + ev_ + bo_); lf = *(const GAS f32x4*)(VFI + ev_ + bo_); } } while (0)
#define WKV_UNPK(w_) ((f32x4){bflo((w_).x), bfhi((w_).x), bflo((w_).y), bfhi((w_).y)})
#define WKV_ITEM(bufp, tb0, lk, lw, la, lr, ti_) do { const f32x4 k4 = WKV_UNPK(lk), wl4 = WKV_UNPK(lw), al4 = WKV_UNPK(la); const f32x4 kv = k4 * kkp; const float ss = row_sum16((kv.x * kv.x + kv.y * kv.y) + (kv.z * kv.z + kv.w * kv.w)); const float inv = frcp(fmaxf(fsqrt(ss), 1e-12f)); \
            f32x4 dec, a4; _Pragma("unroll") for (int i_ = 0; i_ < 4; ++i_) { dec[i_] = __expf(-0.6065306597126334f * frcp(1.f + __expf(-(w0v[i_] + wl4[i_])))); a4[i_] = frcp(1.f + __expf(-(a0v[i_] + al4[i_]))); } \
            const f32x4 kk = kv * inv; const f32x4 k2 = k4 * ((a4 - 1.f) * kap + 1.f); const f32x4 r4 = WKV_UNPK(lr); const f32x4 rk = r4 * k2 * rkp; const float bon = row_sum16((rk.x + rk.y) + (rk.z + rk.w)); \
            LAS unsigned char* d_ = (bufp) + lo_ + (ti_) * 1280; *(LAS f32x4*)(d_) = dec; *(LAS f32x4*)(d_ + 256) = -kk; *(LAS f32x4*)(d_ + 512) = kk * a4; *(LAS f32x4*)(d_ + 768) = k2; *(LAS f32x4*)(d_ + 1024) = r4; \
            const int tr_ = (tb0) + (pt >> 4) + (ti_); if (half == 0 && part == 0 && tr_ < Tu) BON[(size_t)(r0 + tr_) * 16 + h] = bon; } while (0)
#define WKV_STORE(bufp, tb0) do { WKV_ITEM(bufp, tb0, lk0, lw0, la0, lr0, 0); if ((tb0) + 16 < Tu) WKV_ITEM(bufp, tb0, lk1, lw1, la1, lr1, 16); \
            f32x4 v4 = WKV_UNPK(lv); if (has_vres) { const f32x4 g4 = WKV_UNPK(lg); _Pragma("unroll") for (int i_ = 0; i_ < 4; ++i_) v4[i_] = v4[i_] + (lf[i_] - v4[i_]) * frcp(1.f + __expf(-(v0v[i_] + g4[i_]))); } \
            *(LAS f32x4*)((bufp) + lv_) = v4; const int tv_ = (tb0) + (pt >> 3); if (tv_ < Tu) *(GAS f32x4*)(VFO + ev_ + (size_t)(tb0) * 1024) = v4; } while (0)
#define WKV_YOUT(bufp, tb0, ntp) do { const LAS float* yb_ = (const LAS float*)((bufp) + VECB + VVB); const int rl = pt & 31; _Pragma("unroll") for (int t = pt >> 5; t < TB; t += 8) if (t < (ntp)) Y[(size_t)(r0 + (tb0) + t) * 1024 + h * 64 + half * 32 + rl] = yb_[t * 32 + rl]; } while (0)
        if (!scanw) { WKV_LOAD(0); WKV_STORE(lds, 0); if (nblk > 1) WKV_LOAD(TB); }
        __syncthreads();
        for (int b = 0; b < nblk; ++b) {
            LAS unsigned char* cur = lds + (b & 1) * BUF; LAS unsigned char* nxt = lds + ((b + 1) & 1) * BUF; const int tb0 = b * TB; const int nt = (Tu - tb0) < TB ? (Tu - tb0) : TB;
            if (scanw) {
                const LAS float* vec = (const LAS float*)cur + sp8 * 8; const LAS float* vv = (const LAS float*)(cur + VECB) + srow; LAS float* yb = (LAS float*)(cur + VECB + VVB);
                LAS float* ybl = yb + srow;
                struct StepV { f32x4 w0, w1, n0, n1, b0, b1, k0, k1, r0, r1; float v; };
#define WKV_RD(dst, t) do { const LAS f32x4* vp_ = (const LAS f32x4*)(vec + (t) * 320); dst.w0 = vp_[0]; dst.w1 = vp_[1]; dst.n0 = vp_[16]; dst.n1 = vp_[17]; dst.b0 = vp_[32]; dst.b1 = vp_[33]; \
                dst.k0 = vp_[48]; dst.k1 = vp_[49]; dst.r0 = vp_[64]; dst.r1 = vp_[65]; dst.v = vv[(t) * 32]; } while (0)
#define WKV_LO(q_) ((f32x2){(q_).x, (q_).y})
#define WKV_HI(q_) ((f32x2){(q_).z, (q_).w})
#define WKV_UPD(S, w_, b_, k_) S = __builtin_elementwise_fma(S, w_, __builtin_elementwise_fma(b_, sa2, (k_) * v2))
#define WKV_CMP(src, t_) do { const f32x2 spa = __builtin_elementwise_fma(S1, WKV_HI(src.n0), S0 * WKV_LO(src.n0)), spb = __builtin_elementwise_fma(S3, WKV_HI(src.n1), S2 * WKV_LO(src.n1)); const f32x2 sp = spa + spb; \
                const float sa = row_sum8(sp.x + sp.y); const f32x2 sa2 = (f32x2){sa, sa}, v2 = (f32x2){src.v, src.v}; \
                WKV_UPD(S0, WKV_LO(src.w0), WKV_LO(src.b0), WKV_LO(src.k0)); WKV_UPD(S1, WKV_HI(src.w0), WKV_HI(src.b0), WKV_HI(src.k0)); WKV_UPD(S2, WKV_LO(src.w1), WKV_LO(src.b1), WKV_LO(src.k1)); WKV_UPD(S3, WKV_HI(src.w1), WKV_HI(src.b1), WKV_HI(src.k1)); \
                const f32x2 ypa = __builtin_elementwise_fma(S1, WKV_HI(src.r0), S0 * WKV_LO(src.r0)), ypb = __builtin_elementwise_fma(S3, WKV_HI(src.r1), S2 * WKV_LO(src.r1)); const f32x2 yp = ypa + ypb; \
                ybl[(t_) * 32] = row_sum8(yp.x + yp.y); } while (0)
#define WKV_ST(t_, cur_, nx2_) do { WKV_RD(nx2_, ((t_) + 2) & 31); __builtin_amdgcn_sched_barrier(0); WKV_CMP(cur_, t_); } while (0)
                if (nt == TB) {
                    StepV sA, sB, sC; WKV_RD(sA, 0); WKV_RD(sB, 1);
#pragma unroll 1
                    for (int t = 0; t < 30; t += 3) { WKV_ST(t, sA, sC); WKV_ST(t + 1, sB, sA); WKV_ST(t + 2, sC, sB); }
                    WKV_ST(30, sA, sC); WKV_ST(31, sB, sA);
                } else { StepV sA; for (int t = 0; t < nt; ++t) { WKV_RD(sA, t); WKV_CMP(sA, t); } }
#undef WKV_RD
#undef WKV_LO
#undef WKV_HI
#undef WKV_UPD
#undef WKV_CMP
#undef WKV_ST
            } else {
                if (b > 0) WKV_YOUT(nxt, tb0 - TB, TB);
                if (b + 1 < nblk) { WKV_STORE(nxt, tb0 + TB); if (b + 2 < nblk) WKV_LOAD(tb0 + 2 * TB); }
            }
            __syncthreads();
        }
        if (!scanw) { const int tbl = (nblk - 1) * TB; WKV_YOUT(lds + ((nblk - 1) & 1) * BUF, tbl, Tu - tbl); }
#undef WKV_LOAD
#undef WKV_STORE
#undef WKV_ITEM
#undef WKV_YOUT
#undef WKV_UNPK
        if (scanw) { GAS float* so = (smp ? SOUT : P) + ((size_t)pair * 64 + half * 32 + srow) * 64 + sp8 * 8; *(GAS f32x4*)so = (f32x4){S0.x, S0.y, S1.x, S1.y}; *(GAS f32x4*)(so + 4) = (f32x4){S2.x, S2.y, S3.x, S3.y}; }
        __syncthreads();
    }
}

__device__ __forceinline__ void gla_phase(const GAS float* __restrict__ PROJ, const GAS float* __restrict__ LOGA, GAS float* __restrict__ O, GAS float* __restrict__ P, int B, int T, LAS unsigned char* lds, int tid, int bid, int nb) {
    constexpr int TB = 32, NLD = 4, VECB = TB * 768, VVB = TB * 64, BUF = VECB + 3 * VVB;
    const int col = tid >> 5, half = (tid >> 4) & 1, p = tid & 15, dk = half * 32 + p * 2;
    const int nunits = B * 32;
    for (int u = bid; u < nunits; u += nb) {
        const int ug_ = ((u & 7) << 3 | ((u >> 3) & 7)) + ((u >> 6) << 6);
        const int cb = ug_ & 7, pair = ug_ >> 3, s = pair >> 2, h = pair & 3; const int r0 = s * T;
        float S0 = 0.f, S1 = 0.f;
        const int nblk = (T + TB - 1) / TB;
        f32x4 ld[NLD];
        const size_t ea_ = (size_t)(r0 + (tid >> 4)) * 256 + h * 64 + (tid & 15) * 4, ep_ = (size_t)(r0 + (tid >> 4)) * 2576 + h * 64 + (tid & 15) * 4, ev_ = (size_t)(r0 + ((tid & 127) >> 2)) * 2576 + 512 + h * 128 + cb * 16 + (tid & 3) * 4;
        const int lo_ = ((tid >> 4) * 192 + (tid & 15) * 4) * 4, lv_ = VECB + (tid & 127) * 16;
#define GLA_LOAD(tb0) do { ld[0] = *(const GAS f32x4*)(LOGA + ea_ + (size_t)(tb0) * 256); ld[1] = *(const GAS f32x4*)(PROJ + ep_ + 256 + (size_t)(tb0) * 2576); ld[2] = *(const GAS f32x4*)(PROJ + ep_ + (size_t)(tb0) * 2576); ld[3] = *(const GAS f32x4*)(PROJ + ev_ + (size_t)(tb0) * 2576); } while (0)
#define GLA_STORE(bufp) do { *(LAS f32x4*)((bufp) + lo_) = ld[0]; *(LAS f32x4*)((bufp) + lo_ + 256) = ld[1]; *(LAS f32x4*)((bufp) + lo_ + 512) = ld[2] * 0.125f; *(LAS f32x4*)((bufp) + lv_) = ld[3]; } while (0)
        GLA_LOAD(0); GLA_STORE(lds); __syncthreads();
        for (int b = 0; b < nblk; ++b) {
            LAS unsigned char* cur = lds + (b & 1) * BUF; LAS unsigned char* nxt = lds + ((b + 1) & 1) * BUF; const int tb0 = b * TB; const int nt = (T - tb0) < TB ? (T - tb0) : TB;
            if (b + 1 < nblk) GLA_LOAD(tb0 + TB);
            const LAS float* vec = (const LAS float*)cur + dk; const LAS float* vv = (const LAS float*)(cur + VECB) + col; LAS float* ob = (LAS float*)(cur + VECB + VVB);
            float okeep0 = 0.f, okeep1 = 0.f;
#define GLA_STEP(t, keep, tl) do { const f32x2 a2 = *(const LAS f32x2*)(vec + (t) * 192), k2 = *(const LAS f32x2*)(vec + (t) * 192 + 64), q2 = *(const LAS f32x2*)(vec + (t) * 192 + 128); const float v = vv[(t) * 16]; \
                S0 = fmaf(a2.x, S0, k2.x * v); S1 = fmaf(a2.y, S1, k2.y * v); \
                float o = fmaf(q2.x, S0, q2.y * S1); o = row_sum16(o); keep = (p == (tl)) ? o : keep; } while (0)
            if (nt == TB) {
#pragma unroll 1
                for (int t = 0; t < 16; t += 4) { GLA_STEP(t, okeep0, t); GLA_STEP(t + 1, okeep0, t + 1); GLA_STEP(t + 2, okeep0, t + 2); GLA_STEP(t + 3, okeep0, t + 3); }
#pragma unroll 1
                for (int t = 16; t < 32; t += 4) { GLA_STEP(t, okeep1, t - 16); GLA_STEP(t + 1, okeep1, t - 15); GLA_STEP(t + 2, okeep1, t - 14); GLA_STEP(t + 3, okeep1, t - 13); }
            } else { for (int t = 0; t < nt; ++t) { if (t < 16) GLA_STEP(t, okeep0, t); else GLA_STEP(t, okeep1, t - 16); } }
#undef GLA_STEP
            ob[(p * 16 + col) * 2 + half] = okeep0; ob[((16 + p) * 16 + col) * 2 + half] = okeep1;
            if (b + 1 < nblk) GLA_STORE(nxt);
            __syncthreads();
            { const int t = tid >> 4, c = tid & 15; if (t < nt) { const f32x2 o2 = *(const LAS f32x2*)(ob + (t * 16 + c) * 2); O[(size_t)(r0 + tb0 + t) * 512 + h * 128 + cb * 16 + c] = o2.x + o2.y; } }
        }
#undef GLA_LOAD
#undef GLA_STORE
        { GAS float* so = P + ((size_t)pair * 64 + dk) * 128 + cb * 16 + col; so[0] = S0; so[128] = S1; }
        __syncthreads();
    }
}
__device__ __forceinline__ float grp8_sum(float v) { v += dppf<0xB1>(v); v += dppf<0x4E>(v); v += dppf<0x141>(v); return v; }
__device__ __forceinline__ float dot16_fp8_bf16(const u32x4 uw, const float (&x)[16]) { float s = 0.f;
#pragma unroll
    for (int d = 0; d < 4; ++d) { const f32x2 lo = fp8lo(uw[d]), hi = fp8hi(uw[d]); s = fmaf(lo.x, x[4 * d], s); s = fmaf(lo.y, x[4 * d + 1], s); s = fmaf(hi.x, x[4 * d + 2], s); s = fmaf(hi.y, x[4 * d + 3], s); }
    return s; }
typedef int i32x8 __attribute__((ext_vector_type(8)));
typedef unsigned u32x8 __attribute__((ext_vector_type(8)));
__device__ __forceinline__ void pacts_phase(const GAS unsigned char* XF8, const GAS unsigned char* U8S, const GAS int* EIDX, GAS float* __restrict__ PART, int M, int emask,
                                            LAS unsigned char* lds, int wid, int lane, int bid, int nb) {
    const bool spl = (nb & 7) == 0; const int s0 = spl ? (bid & 7) : 0, s1 = spl ? s0 + 1 : 8, r = spl ? (bid >> 3) : bid, nr = spl ? (nb >> 3) : nb;
    const int g = lane >> 3, c = lane & 7, fg = ((g >> 2) & 1) | (((g >> 1) & 1) << 2);
    const int m16 = lane & 15, kb = lane >> 4, fm = ((m16 >> 2) & 1) | (((m16 >> 1) & 1) << 2);
    LAS unsigned char* const wl = lds + wid * 16384;
    const LAS unsigned char* const ard = wl + m16 * 128 + (((2 * kb) ^ fm) * 16);
    const LAS unsigned char* const xrd = wl + 12288 + (m16 & 1) * 128 + kb * 32;
    const LAS unsigned char* const ird = wl + 13824 + g * 4;
    if (r >= M) return;
    const int ntok = (M - r + nr - 1) / nr;
#define PL_ROW(t_) ({ int rw_ = r + nr * (t_); rw_ < M ? rw_ : r; })
#define PL_IDS(t_, slot_) __builtin_amdgcn_global_load_lds((const GAS unsigned*)(isrc + (size_t)PL_ROW(t_) * 128), (LAS unsigned*)(wl + 13824 + (slot_) * 256), 4, 0, 0)
#define PL_RDIDS(slot_, e0_, e1_) do { e0_ = *(const LAS int*)(ird + (slot_) * 256); e1_ = *(const LAS int*)(ird + (slot_) * 256 + 32); } while (0)
#define PL_TILE(t_, slot_, e0_, e1_) do { \
        __builtin_amdgcn_global_load_lds((const GAS unsigned*)(tb + (size_t)((e0_) & emask) * 128), (LAS unsigned*)(wl + (slot_) * 2048), 16, 0, 0); \
        __builtin_amdgcn_global_load_lds((const GAS unsigned*)(tb + (size_t)((e1_) & emask) * 128), (LAS unsigned*)(wl + (slot_) * 2048 + 1024), 16, 0, 0); \
        __builtin_amdgcn_global_load_lds((const GAS unsigned*)(xsrc + (size_t)PL_ROW(t_) * 2048), (LAS unsigned*)(wl + 12288 + (slot_) * 256), 4, 0, 0); } while (0)
#define PL_RD(slot_, a0_, a1_, x0_, x1_) do { a0_ = *(const LAS u32x4*)(ard + (slot_) * 2048); a1_ = *(const LAS u32x4*)(ard2 + (slot_) * 2048); x0_ = *(const LAS u32x4*)(xrd + (slot_) * 256); x1_ = *(const LAS u32x4*)(xrd + (slot_) * 256 + 16); } while (0)
#define PL_MMA(cc_, a0_, a1_, x0_, x1_) do { const i32x8 av = (i32x8)__builtin_shufflevector(a0_, a1_, 0, 1, 2, 3, 4, 5, 6, 7), bv = (i32x8)__builtin_shufflevector(x0_, x1_, 0, 1, 2, 3, 4, 5, 6, 7); const f32x4 z = {0.f, 0.f, 0.f, 0.f}; \
        cc_ = __builtin_amdgcn_mfma_scale_f32_16x16x128_f8f6f4(av, bv, z, 0, 0, 0, 0, 0, 0); } while (0)
#define PL_OUT(t_, cc_) do { f32x4 o; _Pragma("unroll") for (int i = 0; i < 4; ++i) { float v = cc_[i]; v += dppf<0xB1>(v); o[i] = v * (1.f / 16.f); } \
        const int rw = r + nr * (t_); if (m16 == 0 && rw < M) *(GAS f32x4*)(po + (size_t)rw * 128) = o; } while (0)
#define PL_WAIT(n_) asm volatile("s_waitcnt vmcnt(" #n_ ")" ::: "memory")
#define PL_STEP(j_, h_) do { PL_WAIT(12); u32x4 a0[3], a1[3], x0[3], x1[3]; int e0[3], e1[3]; f32x4 cc[3]; \
        _Pragma("unroll") for (int k = 0; k < 3; ++k) PL_RD((h_) * 3 + k, a0[k], a1[k], x0[k], x1[k]); \
        _Pragma("unroll") for (int k = 0; k < 3; ++k) PL_RDIDS((h_) * 3 + k, e0[k], e1[k]); \
        _Pragma("unroll") for (int k = 0; k < 3; ++k) PL_MMA(cc[k], a0[k], a1[k], x0[k], x1[k]); \
        _Pragma("unroll") for (int k = 0; k < 3; ++k) PL_TILE((j_) + 6 + k, (h_) * 3 + k, e0[k], e1[k]); \
        _Pragma("unroll") for (int k = 0; k < 3; ++k) PL_IDS((j_) + 12 + k, (h_) * 3 + k); \
        _Pragma("unroll") for (int k = 0; k < 3; ++k) PL_OUT((j_) + k, cc[k]); } while (0)
    const LAS unsigned char* const ard2 = (const LAS unsigned char*)((unsigned)(size_t)ard ^ 16u);
    for (int s = s0; s < s1; ++s) {
        const GAS unsigned char* tb = U8S + (size_t)s * 16384 * 128 + ((c ^ fg) * 16);
        const GAS unsigned char* xsrc = XF8 + (size_t)(lane >> 5) * 1024 + s * 128 + (lane & 31) * 4;
        const GAS int* isrc = EIDX + wid * 16 + m16;
        GAS float* po = PART + (size_t)s * M * 128 + wid * 16 + kb * 4;
        PL_IDS(0, 0); PL_IDS(1, 1); PL_IDS(2, 2); PL_IDS(3, 3); PL_IDS(4, 4); PL_IDS(5, 5); PL_WAIT(0);
        { int e0[6], e1[6];
#pragma unroll
          for (int k = 0; k < 6; ++k) PL_RDIDS(k, e0[k], e1[k]);
#pragma unroll
          for (int k = 0; k < 3; ++k) PL_TILE(k, k, e0[k], e1[k]);
#pragma unroll
          for (int k = 0; k < 3; ++k) PL_IDS(6 + k, k);
#pragma unroll
          for (int k = 3; k < 6; ++k) PL_TILE(k, k, e0[k], e1[k]);
#pragma unroll
          for (int k = 3; k < 6; ++k) PL_IDS(6 + k, k); }
        for (int j = 0; j < ntok; j += 6) { PL_STEP(j, 0); PL_STEP(j + 3, 1); }
        PL_WAIT(0);
    }
#undef PL_ROW
#undef PL_IDS
#undef PL_RDIDS
#undef PL_TILE
#undef PL_RD
#undef PL_MMA
#undef PL_OUT
#undef PL_WAIT
#undef PL_STEP
}
__device__ __forceinline__ void pouts_phase(const GAS float* __restrict__ COEF, const GAS int* __restrict__ EIDX, const GAS unsigned char* V8S, GAS bf16_t* __restrict__ YBUF, int M,
                                            int wid, int lane, int bid, int nb) {
    const bool spl = (nb & 7) == 0; const int s0 = spl ? (bid & 7) : 0, s1 = spl ? s0 + 1 : 8, r = spl ? (bid >> 3) : bid, nr = spl ? (nb >> 3) : nb;
    const int g = lane >> 3, ch = lane & 7, rstep = nr * 8;
#define PO_LOADCE(rw, c0, c1, v0, v1) do { c0 = COEF[(size_t)(rw) * 128 + lane] * (1.f / 64.f); c1 = COEF[(size_t)(rw) * 128 + 64 + lane] * (1.f / 64.f); v0 = EIDX[(size_t)(rw) * 128 + lane]; v1 = EIDX[(size_t)(rw) * 128 + 64 + lane]; } while (0)
#define PO_GATHER(vv_, vreg) do { _Pragma("unroll") for (int k = 0; k < 8; ++k) { const int e = __builtin_amdgcn_ds_bpermute((8 * k + g) << 2, vreg); vv_[k] = *(const GAS u32x4*)(tb + (size_t)(e & 16383) * 128); } } while (0)
#define PO_COMP(vv_, creg) do { _Pragma("unroll") for (int k = 0; k < 8; ++k) { const float c = __int_as_float(__builtin_amdgcn_ds_bpermute((8 * k + g) << 2, __float_as_int(creg))); const u32x4 w = vv_[k]; \
        const f32x2 c2 = (f32x2){c, c}; _Pragma("unroll") for (int d = 0; d < 4; ++d) { ac2[2 * d] = __builtin_elementwise_fma(c2, fp8lo(w[d]), ac2[2 * d]); ac2[2 * d + 1] = __builtin_elementwise_fma(c2, fp8hi(w[d]), ac2[2 * d + 1]); } \
        _Pragma("unroll") for (int i = 0; i < 8; ++i) asm volatile("" : "+v"(ac2[i])); } } while (0)
    for (int s = s0; s < s1; ++s) {
        const GAS unsigned char* tb = V8S + (size_t)s * 16384 * 128 + ch * 16;
        int row = r + nr * wid; if (row >= M) continue;
        float c0c, c1c, c0n = 0.f, c1n = 0.f; int v0c, v1c, v0n = 0, v1n = 0;
        PO_LOADCE(row, c0c, c1c, v0c, v1c);
        u32x4 va[8], vb[8];
        PO_GATHER(va, v0c);
        for (;;) {
            const int rown = row + rstep; const bool hasn = rown < M;
            PO_GATHER(vb, v1c);
            if (hasn) PO_LOADCE(rown, c0n, c1n, v0n, v1n);
            f32x2 ac2[8];
#pragma unroll
            for (int i = 0; i < 8; ++i) ac2[i] = (f32x2){0.f, 0.f};
            PO_COMP(va, c0c);
            if (hasn) PO_GATHER(va, v0n);
            PO_COMP(vb, c1c);
            float acc[16];
#pragma unroll
            for (int i = 0; i < 8; ++i) { acc[2 * i] = ac2[i].x; acc[2 * i + 1] = ac2[i].y; }
#pragma unroll
            for (int i = 0; i < 16; ++i) acc[i] += dppf<0x128>(acc[i]);
#pragma unroll
            for (int i = 0; i < 8; ++i) { const bool hi = lane & 16; const float send = hi ? acc[i] : acc[i + 8], keep = hi ? acc[i + 8] : acc[i]; acc[i] = keep + shx(send, 16, lane); }
#pragma unroll
            for (int i = 0; i < 4; ++i) { const bool hi = lane & 32; const float send = hi ? acc[i] : acc[i + 4], keep = hi ? acc[i + 4] : acc[i]; acc[i] = keep + shx(send, 32, lane); }
            if ((lane & 8) == 0) { u32x2 w_; w_.x = pk_bf16(acc[0], acc[1]); w_.y = pk_bf16(acc[2], acc[3]); *(GAS u32x2*)(YBUF + (size_t)row * 1024 + s * 128 + ch * 16 + ((lane >> 4) & 1) * 8 + ((lane >> 5) & 1) * 4) = w_; }
            if (!hasn) break;
            row = rown; c0c = c0n; c1c = c1n; v0c = v0n; v1c = v1n;
        }
    }
#undef PO_LOADCE
#undef PO_GATHER
#undef PO_COMP
}
}

template <class T> __device__ __forceinline__ __attribute__((address_space(1))) T* gp(T* p) { return (__attribute__((address_space(1))) T*)uni_ptr(p); }
constexpr int MK_THREADS = 512, LDS_BYTES = 163840, LDSCTL_OFF = 131072, TAB_OFF = LDSCTL_OFF + 1024, MAX_OPS = 208;
static_assert(TAB_OFF + MAX_OPS * (int)sizeof(Op) <= LDS_BYTES, "LDS map");
constexpr int MPAD = 17152;
constexpr size_t CTL_BYTES = (size_t)1 << 20;
struct MArgs { const float* in[47]; float* out; char* ws; unsigned long long ws_size; };
__global__ void __launch_bounds__(MK_THREADS, 2) mega_fwd(MArgs a) {
    extern __shared__ __attribute__((aligned(16))) unsigned char lds[];
    volatile LAS unsigned* ctl = (volatile LAS unsigned*)((LAS unsigned char*)lds + LDSCTL_OFF);
    if (threadIdx.x < 64) ctl[threadIdx.x] = 0u;
    __syncthreads();
    (void)xcd_barrier_post((unsigned*)a.ws, ctl + 8);
    const Dm dm = make_dm(1024, 8, 2048, 128, 4);
    Op* tab = (Op*)(lds + TAB_OFF);
    if (threadIdx.x == 0) {
        const float* const* inp_ = (const float* const*)__builtin_amdgcn_kernarg_segment_ptr(); asm volatile("" : "+s"(inp_));
        NvIO io; io.in = inp_; io.out = a.out; io.ws = a.ws + CTL_BYTES; io.ws_size = a.ws_size - CTL_BYTES;
        int n = 0;
        #ifdef PROBE_DUPCODE
        nv_forward(io, dm, [&](const Op& o) __attribute__((always_inline)) { if (n < MAX_OPS) tab[n] = o; ++n; if ((o.code & 0xff) == PROBE_DUPCODE) { if (n < MAX_OPS) tab[n] = o; ++n; } asm volatile("" ::: "memory"); });
#else
        nv_forward(io, dm, [&](const Op& o) __attribute__((always_inline)) { if (n < MAX_OPS) tab[n] = o; ++n; asm volatile("" ::: "memory"); });
#endif
        ctl[16] = (unsigned)(n <= MAX_OPS ? n : 0);
    }
    __syncthreads();
    const int nops = (int)ctl[16];
    for (int i = 0; i < nops; ++i) {
        int tid_ = (int)threadIdx.x, bid_ = (int)blockIdx.x, nb_ = (int)gridDim.x;
        asm volatile("" : "+v"(tid_)); asm volatile("" : "+s"(bid_)); asm volatile("" : "+s"(nb_));
        const long long g0 = (long long)bid_ * MK_THREADS + tid_, gs = (long long)nb_ * MK_THREADS;
        const Op& o = tab[i];
        const int rawc = __builtin_amdgcn_readfirstlane(o.code); const int code = rawc & 0xff; const long long n = o.n;
        switch (code) {
        case OP_FGEMM: {
            const int fl = rfl(o.i6);
            pg8::Gemm g{uni_ptr((const pg8::bf16_t*)o.a), uni_ptr((const pg8::bf16_t*)o.b), MPAD, rfl(o.i5), rfl(o.i1), rfl(o.i2), rfl(o.i3)};
            if (rawc & OPF_GROUP) {
                int ng = 1; while (ng < 8 && (rfl(tab[i + ng - 1].code) & OPF_GROUP)) ++ng;
                const PG8_LAS Op* gt = (const PG8_LAS Op*)((PG8_LAS unsigned char*)lds + TAB_OFF) + i;
                pg8::GroupOrder S; S.tab = gt; S.ng = ng; S.nM = MPAD / 256; S.G = nb_; S.c = bid_; S.tsA = (size_t)256 * g.lda * 2; S.tsB = (size_t)256 * g.ldb * 2;
                pg8::EpiGroup E{gt, dm.M};
                pg8::gemm_phase<pg8::EpiGroup, pg8::GroupOrder, true, true>((PG8_LAS unsigned char*)lds, g, S, E);
                i += ng - 1;
            } else {
            pg8::StaticOrder S; S.init(g, nb_, bid_); if (fl & 2) S.acs = 512;
            float* const c0 = uni_ptr(o.o0); const int ldc0 = rfl(o.i4), nreal0 = rfl(o.i0);
            if (fl & 1) { pg8::EpiBf16Plain E{(pg8::bf16_t*)c0, ldc0}; pg8::gemm_phase<pg8::EpiBf16Plain, pg8::StaticOrder, true, true>((PG8_LAS unsigned char*)lds, g, S, E); }
            else { pg8::EpiF32 E{c0, ldc0, dm.M, nreal0}; pg8::gemm_phase<pg8::EpiF32, pg8::StaticOrder, true, true>((PG8_LAS unsigned char*)lds, g, S, E); }
            }
        } break;
        case OP_LRUG2: {
            pg8::Gemm g{uni_ptr((const pg8::bf16_t*)o.a), uni_ptr((const pg8::bf16_t*)o.b), MPAD, 1024, 512, 512, 512};
            pg8::StaticOrder S; S.init(g, nb_, bid_);
            pg8::EpiLru E{uni_ptr(o.c), uni_ptr(o.d), uni_ptr(o.e), uni_ptr(o.f), uni_ptr(o.o0), uni_ptr(o.o1), dm.M};
            pg8::gemm_phase<pg8::EpiLru, pg8::StaticOrder, true, true>((PG8_LAS unsigned char*)lds, g, S, E);
        } break;
        case OP_WKVP: fk::wkv2_phase(gp((const fk::bf16_t*)o.a), gp((const fk::bf16_t*)o.b), gp((const fk::bf16_t*)o.c), gp((const fk::bf16_t*)o.d), gp((const fk::bf16_t*)o.e), gp((const fk::bf16_t*)o.f), gp(o.g), gp(o.h), gp((const float*)o.o5), gp(o.o0), gp(o.o1), gp(o.o2), gp(o.o3), gp(o.o4), rfl(o.i0), dm.B, dm.T, dm.DB, dm.DT, (LAS unsigned char*)lds, tid_, bid_, nb_); break;
        case OP_POST2: fk::rwkvpost2_phase(gp(o.a), gp((const fk::bf16_t*)o.b), gp(o.c), gp(o.d), gp(o.e), gp(o.f), gp((fk::bf16_t*)o.o0), dm.M * 16, tid_ & 63, bid_ * 8 + (tid_ >> 6), nb_ * 8); break;
        case OP_GLAF: fk::gla_phase(gp(o.a), gp(o.b), gp(o.o0), gp(o.o1), dm.B, dm.T, (LAS unsigned char*)lds, tid_, bid_, nb_); break;
        case OP_PACTS: fk::pacts_phase(gp((const unsigned char*)o.a), gp((const unsigned char*)o.b), gp((const int*)o.d), gp(o.o0), dm.M, rfl(o.i0), (LAS unsigned char*)lds, rfl(tid_ >> 6), tid_ & 63, bid_, nb_); break;
        case OP_POUTS: fk::pouts_phase(gp(o.a), gp((const int*)o.b), gp((const unsigned char*)o.c), gp((fk::bf16_t*)o.o0), dm.M, tid_ >> 6, tid_ & 63, bid_, nb_); break;
        case OP_TOPK2: fk::topk_phase(gp(o.a), gp((const fk::bf16_t*)o.b), gp(o.c), gp(o.o0), gp((int*)o.o1), dm.M * 8, (LAS unsigned char*)lds, tid_ >> 6, tid_ & 63, bid_ * 8 + (tid_ >> 6), nb_ * 8); break;
        case OP_LNRES: fk::lnres_phase(gp((const fk::bf16_t*)o.a), gp(o.b), gp(o.c), gp(o.o0), gp((fk::bf16_t*)o.o1), gp((unsigned char*)o.o2), dm.M, tid_ & 63, bid_ * 8 + (tid_ >> 6), nb_ * 8); break;
        case OP_GLANORM: fk::glanorm_phase(gp(o.a), gp(o.b), gp(o.c), gp((fk::bf16_t*)o.o0), dm.M * 4, tid_ & 63, bid_ * 8 + (tid_ >> 6), nb_ * 8); break;
#define NVC(c) case c: for (long long g = g0; g < n; g += gs) nv_elem(c, o, dm, g); break;
        NVC(OP_LOGA4) NVC(OP_CONVOUT) NVC(OP_SHIFTOUT) NVC(OP_EMBED4) NVC(OP_YOUT4) NVC(OP_MIX6) NVC(OP_CONV4) NVC(OP_CVT8) NVC(OP_WGATE)
        NVC(OP_WT) NVC(OP_CVTTAB8S) NVC(OP_PRED) NVC(OP_PRM) NVC(OP_KEYS) NVC(OP_GLA3) NVC(OP_LRU1) NVC(OP_LRU2) NVC(OP_LRU3)
#undef NVC
        default: break;
        }
        if (__builtin_amdgcn_readfirstlane(tab[i].code) & OPF_NOBAR) __syncthreads(); else { XcdBarrier bar; bar.bar = (unsigned*)a.ws; bar.x = xb_xcc_id(); bar.st = ctl + 8; xcd_barrier(bar); }
    }
}
extern "C" void kernel_launch(void* const* d_in, const int* in_sizes, int n_in, void* d_out, int out_size, void* d_ws, size_t ws_size, hipStream_t stream) {
    static int grid = 0;
    if (grid == 0) {
        if (n_in != 47 || ws_size < ((size_t)900 << 20)) { fprintf(stderr, "kernel_launch: expected 47 inputs and >= 900 MiB of workspace; got %d, %zu\n", n_in, ws_size); grid = -1; return; }
        int dev = 0, cus = 0, per_cu = 0;
        if (hipGetDevice(&dev) != hipSuccess || hipDeviceGetAttribute(&cus, hipDeviceAttributeMultiprocessorCount, dev) != hipSuccess) { grid = -1; return; }
        if (hipFuncSetAttribute((const void*)mega_fwd, hipFuncAttributeMaxDynamicSharedMemorySize, LDS_BYTES) != hipSuccess) { fprintf(stderr, "kernel_launch: hipFuncSetAttribute failed\n"); grid = -1; return; }
        if (hipOccupancyMaxActiveBlocksPerMultiprocessor(&per_cu, (const void*)mega_fwd, MK_THREADS, LDS_BYTES) != hipSuccess || per_cu < 1) fprintf(stderr, "kernel_launch: occupancy query says %d per CU\n", per_cu);
        (void)hipGetLastError();
        grid = cus;
    }
    if (grid < 0) return;
    if (hipMemsetAsync(d_ws, 0, CTL_BYTES, stream) != hipSuccess) { fprintf(stderr, "kernel_launch: memset failed\n"); return; }
    MArgs a{}; for (int i = 0; i < 47; ++i) a.in[i] = (const float*)d_in[i]; a.out = (float*)d_out; a.ws = (char*)d_ws; a.ws_size = (unsigned long long)ws_size;
    hipLaunchKernelGGL(mega_fwd, dim3(grid), dim3(MK_THREADS), LDS_BYTES, stream, a);
}
```

```cpp
#include <hip/hip_runtime.h>
#include <cstdio>
#include <cmath>
#ifndef HD
#define HD __host__ __device__ __forceinline__
#endif
struct Dm { int D, B, T, DB, DT, M, NSEQ, RH; };
HD Dm make_dm(int D, int B, int SEQ, int DB, int DT) { Dm d; d.D = D; d.B = B; d.T = SEQ + 16; d.DB = DB; d.DT = DT; d.M = B * d.T + DB * DT; d.NSEQ = B + DB; d.RH = D / 64; return d; }
HD int seq_row0(const Dm& d, int s) { return s < d.B ? s * d.T : d.B * d.T + (s - d.B) * d.DT; }
HD int seq_len(const Dm& d, int s) { return s < d.B ? d.T : d.DT; }
HD void row_to_seq(const Dm& d, int row, int& s, int& t) { if (row < d.B * d.T) { s = row / d.T; t = row % d.T; } else { int r = row - d.B * d.T; s = d.B + r / d.DT; t = r % d.DT; } }

constexpr int MIXIN = 2576, C_Q = 0, C_K = 256, C_V = 512, C_GLR = 1024, C_R = 1040, C_XB = 1552, C_GB = 2064;

enum { OP_EMBED = 1, OP_GEMM, OP_LOGA, OP_GLA, OP_GLANORM, OP_CONV, OP_CONVOUT, OP_LRUG, OP_LRUSCAN, OP_LNRES, OP_MIX, OP_SHIFTOUT,
       OP_RWKVPREP, OP_WKV, OP_RWKVPOST, OP_QNORM, OP_SCORES, OP_TOPK, OP_PACT1, OP_PACT2, OP_POUT, OP_YOUT, OP_WT, OP_CVT, OP_FGEMM, OP_CVTTAB, OP_KEYS, OP_TOPK2, OP_PACT, OP_POUTLN, OP_GLA1, OP_GLA2, OP_GLA3, OP_LRU1, OP_LRU2, OP_LRU3, OP_EMBED4, OP_YOUT4, OP_MIX8, OP_CONV4, OP_CVT8, OP_WGATE, OP_LRUG2, OP_WKVF, OP_GLAF, OP_CVTTAB8, OP_CVTTAB8S, OP_PACTS, OP_PRED, OP_POUTS, OP_MIX6, OP_PRM, OP_WKVP, OP_POST2, OP_LOGA4 };

constexpr int OPF_NOBAR = 0x100, OPF_GROUP = 0x200;
struct Op {
    const float *a, *b, *c, *d, *e, *f, *g, *h;
    float *o0, *o1, *o2, *o3, *o4, *o5;
    long long n;
    int code, i0, i1, i2, i3, i4, i5, i6;
};

#if defined(__HIP_DEVICE_COMPILE__)
#define NV_UNI(x) __builtin_amdgcn_readfirstlane(x)
#define NV_LAUNDER(p) asm volatile("" : "+s"(p))
#define NV_FENCE() asm volatile("" ::: "memory")
#else
#define NV_FENCE() do {} while (0)
#define NV_UNI(x) (x)
#define NV_LAUNDER(p) do {} while (0)
#endif
typedef unsigned short nvbf;
HD nvbf nv_f2bf(float f) { unsigned u; __builtin_memcpy(&u, &f, 4); return (nvbf)((u + 0x7fffu + ((u >> 16) & 1u)) >> 16); }
HD float nv_bf2f(nvbf h) { unsigned u = (unsigned)h << 16; float f; __builtin_memcpy(&f, &u, 4); return f; }
HD unsigned nv_f2e4m3(float f) {
    unsigned u; __builtin_memcpy(&u, &f, 4); const unsigned sign = (u >> 24) & 0x80u; const float a = fabsf(f);
    if (!(a < 448.f)) return sign | 0x7Eu;
    if (a < 0.015625f) return sign | (unsigned)rintf(a * 512.f);
    unsigned au = u & 0x7fffffffu; au += 0x7ffffu + ((au >> 20) & 1u);
    const unsigned e = ((au >> 23) & 0xffu) - 120u, m = (au >> 20) & 7u; unsigned code = (e << 3) | m; if (code > 0x7Eu) code = 0x7Eu;
    return sign | code; }
HD float nv_e4m32f(unsigned c) { const unsigned e = (c >> 3) & 15u, m = c & 7u; const float v = e ? ldexpf(1.f + m * 0.125f, (int)e - 7) : m * 0.001953125f; return (c & 0x80u) ? -v : v; }
HD int nv_rup(int x, int m) { return (x + m - 1) / m * m; }
struct alignas(16) NvF4 { float x, y, z, w; };
struct alignas(16) NvU4 { unsigned x, y, z, w; };
struct alignas(8) NvU2 { unsigned x, y; };
#if defined(__HIP_DEVICE_COMPILE__)
#define NV_EXP(x) __expf(x)
#define NV_TANH(x) (1.f - 2.f * __builtin_amdgcn_rcpf(1.f + __expf(2.f * (x))))
HD float nv_sigmoid(float x) { return __builtin_amdgcn_rcpf(1.f + __expf(-x)); }
HD float nv_softplus(float x) { return fmaxf(x, 0.f) + __logf(1.f + __expf(-fabsf(x))); }
HD float nv_gelu(float x) { return x * __builtin_amdgcn_rcpf(1.f + __expf(-1.5957691216057308f * (x + 0.044715f * x * x * x))); }
#else
#define NV_EXP(x) expf(x)
#define NV_TANH(x) tanhf(x)
HD float nv_sigmoid(float x) { return 1.f / (1.f + expf(-x)); }
HD float nv_softplus(float x) { return fmaxf(x, 0.f) + log1pf(expf(-fabsf(x))); }
HD float nv_gelu(float x) { return 0.5f * x * (1.f + tanhf(0.7978845608028654f * (x + 0.044715f * x * x * x))); }
#endif

#define NV_INS16(tv, ti, val, idx) do { float _v = (val); int _i = (idx); _Pragma("unroll") for (int _j = 0; _j < 16; ++_j) { if (_v > tv[_j]) { float _tv = tv[_j]; int _ti = ti[_j]; tv[_j] = _v; ti[_j] = _i; _v = _tv; _i = _ti; } } } while (0)

HD void nv_elem(const int code, const Op& p, const Dm& dm, long long gid) {
    const int D = dm.D; float* const PO1 = p.o1; float* const PO2 = p.o2;
    switch (code) {
    case OP_EMBED: {
        int row = (int)(gid / D), c = (int)(gid % D); float v;
        if (row < dm.B * dm.T) { int bb = row / dm.T, t = row % dm.T; v = t < 16 ? p.c[t * D + c] : p.a[((size_t)bb * (dm.T - 16) + (t - 16)) * D + c]; }
        else v = p.b[(size_t)(row - dm.B * dm.T) * D + c];
        p.o0[gid] = v; ((nvbf*)p.o1)[gid] = nv_f2bf(v); } break;
    case OP_GEMM: {
        int N4 = p.i0 >> 2, K = p.i1; int m = (int)(gid / N4), nn = (int)(gid % N4) * 4; const float* A = p.a + (size_t)m * p.i2; const float* Bw = p.b + nn; float c0 = 0.f, c1 = 0.f, c2 = 0.f, c3 = 0.f;
        for (int k = 0; k < K; ++k) { float av = A[k]; if (p.i5 == 1) av = NV_TANH(av); else if (p.i5 == 2) av = nv_sigmoid(av); const NvF4 bv = *(const NvF4*)(Bw + (size_t)k * p.i3);
            c0 = fmaf(av, bv.x, c0); c1 = fmaf(av, bv.y, c1); c2 = fmaf(av, bv.z, c2); c3 = fmaf(av, bv.w, c3); }
        float* C = p.o0 + (size_t)m * p.i4 + nn; C[0] = c0; C[1] = c1; C[2] = c2; C[3] = c3; } break;
    case OP_LOGA: {
        int row = (int)(gid / 256), c = (int)(gid % 256); float z = p.c[c];
        for (int r = 0; r < 16; ++r) z = fmaf(p.a[(size_t)row * MIXIN + C_GLR + r], p.b[r * 256 + c], z);
        p.o0[gid] = NV_EXP(-nv_softplus(-z) * (1.f / 16.f)); } break;
    case OP_GLAF:
    case OP_GLA: {
        int s = (int)(gid / 512), h = (int)((gid / 128) % 4), col = (int)(gid % 128);
        float S[64];
        const float* sin = (s < dm.B) ? nullptr : p.c + (((size_t)(s - dm.B) * 4 + h) * 64) * 128 + col;
#pragma unroll
        for (int k = 0; k < 64; ++k) S[k] = sin ? sin[(size_t)k * 128] : 0.f;
        int r0 = seq_row0(dm, s), L = seq_len(dm, s);
        for (int t = 0; t < L; ++t) {
            const float* pr = p.a + (size_t)(r0 + t) * MIXIN; const float* la = p.b + (size_t)(r0 + t) * 256 + h * 64;
            float v = pr[C_V + h * 128 + col], o = 0.f;
#pragma unroll
            for (int k = 0; k < 64; ++k) { if ((k & 7) == 0) NV_FENCE(); S[k] = fmaf(la[k], S[k], pr[C_K + h * 64 + k] * v); o = fmaf(pr[C_Q + h * 64 + k] * 0.125f, S[k], o); }
            p.o0[(size_t)(r0 + t) * 512 + h * 128 + col] = o;
        }
        float* so = (s < dm.B) ? PO1 + (((size_t)s * 4 + h) * 64) * 128 + col : PO2 + (((size_t)(s - dm.B) * 4 + h) * 64) * 128 + col;
#pragma unroll
        for (int k = 0; k < 64; ++k) so[(size_t)k * 128] = S[k]; } break;
    case OP_GLA1: {
        const int NC = p.i0; const int u = NV_UNI((int)(gid / 128)), col = (int)(gid % 128); const int s = u / (4 * NC), h = (u / NC) % 4, c = u % NC;
        const int r0 = seq_row0(dm, s) + c * 64; int L = dm.T - c * 64; L = L > 64 ? 64 : L;
        float S[64];
#pragma unroll
        for (int k = 0; k < 64; ++k) S[k] = 0.f;
        float dprod = 1.f;
        for (int t = 0; t < L; ++t) {
            const float* pr = p.a + (size_t)(r0 + t) * MIXIN; const float* la = p.b + (size_t)(r0 + t) * 256 + h * 64; const float v = pr[C_V + h * 128 + col];
            if (col < 64) dprod *= la[col];
#pragma unroll
            for (int k = 0; k < 64; ++k) { if ((k & 7) == 0) NV_FENCE(); S[k] = fmaf(la[k], S[k], pr[C_K + h * 64 + k] * v); }
        }
        float* so = p.o0 + (size_t)u * 8192 + col;
#pragma unroll
        for (int k = 0; k < 64; ++k) so[(size_t)k * 128] = S[k];
        if (col < 64) p.o1[(size_t)u * 64 + col] = dprod; } break;
    case OP_GLA2: {
        const int NC = p.i0; const int pair = (int)(gid / 8192), e = (int)(gid % 8192), dk = e / 128; float S = 0.f;
        for (int c = 0; c < NC; ++c) { const size_t ix = ((size_t)pair * NC + c) * 8192 + e; const float l = p.o0[ix]; p.o0[ix] = S; S = fmaf(p.a[((size_t)pair * NC + c) * 64 + dk], S, l); }
        p.o1[gid] = S; } break;
    case OP_GLA3: {
        const int NC = p.i0; const int NP = dm.B * 4 * NC; const int u = NV_UNI((int)(gid / 128)) + (p.i1 ? NP : 0), col = (int)(gid % 128); int s, h, r0, L; const float* sin; float* sout = nullptr;
        if (u < NP) { s = u / (4 * NC); h = (u / NC) % 4; const int c = u % NC; r0 = seq_row0(dm, s) + c * 64; L = dm.T - c * 64; L = L > 64 ? 64 : L; sin = p.d + (size_t)u * 8192 + col; }
        else { const int q = u - NP; s = dm.B + q / 4; h = q % 4; r0 = seq_row0(dm, s); L = dm.DT; sin = p.c + (((size_t)(s - dm.B) * 4 + h) * 64) * 128 + col; sout = p.o2 + (((size_t)(s - dm.B) * 4 + h) * 64) * 128 + col; }
        float S[64];
#pragma unroll
        for (int k = 0; k < 64; ++k) S[k] = sin[(size_t)k * 128];
        for (int t = 0; t < L; ++t) {
            const float* pr = p.a + (size_t)(r0 + t) * MIXIN; const float* la = p.b + (size_t)(r0 + t) * 256 + h * 64; const float v = pr[C_V + h * 128 + col]; float o = 0.f;
#pragma unroll
            for (int k = 0; k < 64; ++k) { if ((k & 7) == 0) NV_FENCE(); S[k] = fmaf(la[k], S[k], pr[C_K + h * 64 + k] * v); o = fmaf(pr[C_Q + h * 64 + k] * 0.125f, S[k], o); }
            p.o0[(size_t)(r0 + t) * 512 + h * 128 + col] = o;
        }
        if (sout) {
#pragma unroll
            for (int k = 0; k < 64; ++k) sout[(size_t)k * 128] = S[k]; } } break;
    case OP_LRU1: {
        const int NC = p.i0; const int u = (int)(gid / 512), c = (int)(gid % 512); const int s = u / NC, ch = u % NC; const int r0 = seq_row0(dm, s) + ch * 64; int L = dm.T - ch * 64; L = L > 64 ? 64 : L; float hh = 0.f, ap = 1.f;
#pragma unroll 8
        for (int t = 0; t < L; ++t) { const size_t ix = (size_t)(r0 + t) * 512 + c; const float a = p.a[ix]; hh = fmaf(a, hh, p.b[ix]); ap *= a; }
        p.o0[gid] = ap; p.o1[gid] = hh; } break;
    case OP_LRU2: {
        const int NC = p.i0; const int s = (int)(gid / 512), c = (int)(gid % 512); float hh = 0.f;
#pragma unroll 8
        for (int ch = 0; ch < NC; ++ch) { const size_t ix = ((size_t)s * NC + ch) * 512 + c; const float l = p.o0[ix]; p.o0[ix] = hh; hh = fmaf(p.a[ix], hh, l); }
        p.o1[gid] = hh; } break;
    case OP_LRU3: {
        const int NC = p.i0; const int u = (int)(gid / 512), c = (int)(gid % 512); const int NP = dm.B * NC; int r0, L; float hh; float* hout = nullptr;
        if (u < NP) { const int s = u / NC, ch = u % NC; r0 = seq_row0(dm, s) + ch * 64; L = dm.T - ch * 64; L = L > 64 ? 64 : L; hh = p.e[gid]; }
        else { const int q = u - NP; r0 = seq_row0(dm, dm.B + q); L = dm.DT; hh = p.d[(size_t)q * 512 + c]; hout = p.o2 + (size_t)q * 512 + c; }
        for (int t0 = 0; t0 < L; t0 += 8) {
            float av[8], bv[8], gv[8];
#pragma unroll
            for (int k = 0; k < 8; ++k) { int t = t0 + k; t = t < L ? t : L - 1; const size_t r = (size_t)(r0 + t); av[k] = p.a[r * 512 + c]; bv[k] = p.b[r * 512 + c]; gv[k] = p.c[r * MIXIN + C_GB + c]; }
#pragma unroll
            for (int k = 0; k < 8; ++k) if (t0 + k < L) { const size_t r = (size_t)(r0 + t0 + k); hh = fmaf(av[k], hh, bv[k]); ((nvbf*)p.o0)[r * 1024 + 512 + c] = nv_f2bf(hh * nv_gelu(gv[k])); } }
        if (hout) *hout = hh; } break;
    case OP_EMBED4: {
        const int D4 = D / 4; const int row = (int)(gid / D4), c = (int)(gid % D4) * 4; const float* src;
        if (row < dm.B * dm.T) { const int bb = row / dm.T, t = row % dm.T; src = t < 16 ? p.c + (size_t)t * D + c : p.a + ((size_t)bb * (dm.T - 16) + (t - 16)) * D + c; } else src = p.b + (size_t)(row - dm.B * dm.T) * D + c;
        const NvF4 v = *(const NvF4*)src; *(NvF4*)(p.o0 + (size_t)row * D + c) = v; NvU2 w; w.x = nv_f2bf(v.x) | ((unsigned)nv_f2bf(v.y) << 16); w.y = nv_f2bf(v.z) | ((unsigned)nv_f2bf(v.w) << 16); *(NvU2*)((nvbf*)p.o1 + (size_t)row * D + c) = w; } break;
    case OP_YOUT4: {
        const int D4 = D / 4; const int row = (int)(gid / D4), c = (int)(gid % D4) * 4; const NvF4 v = *(const NvF4*)(p.a + (size_t)row * D + c);
        if (row < dm.B * dm.T) { const int bb = row / dm.T, t = row % dm.T; if (t >= 16) *(NvF4*)(p.o0 + ((size_t)bb * (dm.T - 16) + (t - 16)) * D + c) = v; }
        else *(NvF4*)(p.o0 + ((size_t)dm.B * (dm.T - 16) + (row - dm.B * dm.T)) * D + c) = v; } break;
    case OP_MIX8: {
        const int D8 = D / 8; const int row = (int)(gid / D8), c = (int)(gid % D8) * 8; int s, t; row_to_seq(dm, row, s, t); const float* x = p.a + (size_t)row * D + c; float xp[8];
        if (t > 0) { for (int i = 0; i < 8; ++i) xp[i] = x[i - D]; } else if (s < dm.B) { for (int i = 0; i < 8; ++i) xp[i] = 0.f; } else { for (int i = 0; i < 8; ++i) xp[i] = p.b[(size_t)(s - dm.B) * D + c + i]; }
        unsigned w[4];
#pragma unroll
        for (int i = 0; i < 4; ++i) { const float lo = x[2 * i] + (xp[2 * i] - x[2 * i]) * p.c[c + 2 * i], hi = x[2 * i + 1] + (xp[2 * i + 1] - x[2 * i + 1]) * p.c[c + 2 * i + 1]; w[i] = nv_f2bf(lo) | ((unsigned)nv_f2bf(hi) << 16); }
        NvU4 o; o.x = w[0]; o.y = w[1]; o.z = w[2]; o.w = w[3]; *(NvU4*)((nvbf*)p.o0 + (size_t)row * D + c) = o; } break;
    case OP_MIX6: {
        const int D8 = D / 8; const int row = (int)(gid / D8), c = (int)(gid % D8) * 8; int s, t; row_to_seq(dm, row, s, t); const float* x = p.a + (size_t)row * D + c; float xv[8], dx[8];
        for (int i = 0; i < 8; ++i) xv[i] = x[i];
        if (t > 0) { for (int i = 0; i < 8; ++i) dx[i] = x[i - D] - xv[i]; } else if (s < dm.B) { for (int i = 0; i < 8; ++i) dx[i] = -xv[i]; } else { for (int i = 0; i < 8; ++i) dx[i] = p.b[(size_t)(s - dm.B) * D + c + i] - xv[i]; }
        for (int m = 0; m < 6; ++m) { const float* mu = p.c + (size_t)m * D + c; unsigned w[4];
#pragma unroll
            for (int i = 0; i < 4; ++i) w[i] = nv_f2bf(xv[2 * i] + dx[2 * i] * mu[2 * i]) | ((unsigned)nv_f2bf(xv[2 * i + 1] + dx[2 * i + 1] * mu[2 * i + 1]) << 16);
            NvU4 o; o.x = w[0]; o.y = w[1]; o.z = w[2]; o.w = w[3]; *(NvU4*)((nvbf*)p.o0 + (size_t)m * p.i0 * 0 + (size_t)m * (size_t)p.i1 * 1024 + (size_t)row * D + c) = o; } } break;
    case OP_CONV4: {
        const int row = (int)(gid / 128), c = (int)(gid % 128) * 4; int s, t; row_to_seq(dm, row, s, t); float acc[4];
        for (int q = 0; q < 4; ++q) acc[q] = p.d[c + q];
        for (int i = 0; i < 4; ++i) { const int j = t + i; const float* xv = nullptr;
            if (j < 3) { if (s >= dm.B) xv = p.b + ((size_t)(s - dm.B) * 3 + j) * 512 + c; } else xv = p.a + (size_t)(row - t + (j - 3)) * MIXIN + C_XB + c;
            if (xv) for (int q = 0; q < 4; ++q) acc[q] = fmaf(xv[q], p.c[i * 512 + c + q], acc[q]); }
        NvF4 o; o.x = acc[0]; o.y = acc[1]; o.z = acc[2]; o.w = acc[3]; *(NvF4*)(p.o0 + (size_t)row * 512 + c) = o;
        NvU2 w; w.x = nv_f2bf(acc[0]) | ((unsigned)nv_f2bf(acc[1]) << 16); w.y = nv_f2bf(acc[2]) | ((unsigned)nv_f2bf(acc[3]) << 16); *(NvU2*)((nvbf*)p.o1 + (size_t)row * 512 + c) = w; } break;
    case OP_CVT8: {
        const int K8 = p.i2 / 8; const int row = (int)(gid / K8), k = (int)(gid % K8) * 8; unsigned w[4] = {0u, 0u, 0u, 0u};
        if (row < dm.M && k < p.i0) { const float* sp = p.a + (size_t)row * p.i1 + k;
#pragma unroll
            for (int i = 0; i < 4; ++i) { float lo = sp[2 * i], hi = sp[2 * i + 1]; if (p.i3 == 1) { lo = NV_TANH(lo); hi = NV_TANH(hi); } else if (p.i3 == 2) { lo = nv_sigmoid(lo); hi = nv_sigmoid(hi); } w[i] = nv_f2bf(lo) | ((unsigned)nv_f2bf(hi) << 16); } }
        NvU4 o; o.x = w[0]; o.y = w[1]; o.z = w[2]; o.w = w[3]; *(NvU4*)((nvbf*)p.o0 + (size_t)row * p.i2 + k) = o; } break;
    case OP_WGATE: {
        const int n = (int)gid, pn = n >> 8, within = n & 127, isx = (n >> 7) & 1, c = pn * 128 + within, nb = c >> 6, e = c & 63; const float* w = isx ? p.b : p.a; nvbf* dst = (nvbf*)p.o0 + (size_t)n * 512;
        for (int k = 0; k < 512; ++k) dst[k] = ((k >> 6) == nb) ? nv_f2bf(w[((size_t)nb * 64 + (k & 63)) * 64 + e]) : (nvbf)0;
        if (n < 512) p.o1[n] = -8.f * nv_softplus(-p.c[n]); } break;
    case OP_LRUG2: {
        const int row = (int)(gid / 512), c = (int)(gid % 512), pn = c >> 7, within = c & 127; const nvbf* x = (const nvbf*)p.a + (size_t)row * 512; const nvbf* wa_ = (const nvbf*)p.b + (size_t)(pn * 256 + within) * 512; const nvbf* wx_ = wa_ + (size_t)128 * 512; float ga = 0.f, gx = 0.f;
        for (int k = 0; k < 512; ++k) { const float xv = nv_bf2f(x[k]); ga = fmaf(xv, nv_bf2f(wa_[k]), ga); gx = fmaf(xv, nv_bf2f(wx_[k]), gx); }
        const float gate_a = nv_sigmoid(ga + p.c[c]), gate_x = nv_sigmoid(gx + p.d[c]); const float log_at = gate_a * p.e[c];
        p.o0[gid] = NV_EXP(log_at); p.o1[gid] = sqrtf(-expm1f(2.f * log_at)) * (gate_x * p.f[gid]); } break;
    case OP_LOGA4: {
        const int row = (int)(gid / 64), c = (int)(gid % 64) * 4; const float* gl = p.a + (size_t)row * MIXIN + C_GLR; NvF4 z = *(const NvF4*)(p.c + c);
#pragma unroll
        for (int r4 = 0; r4 < 4; ++r4) { const NvF4 g = *(const NvF4*)(gl + 4 * r4);
            const NvF4 w0 = *(const NvF4*)(p.b + (4 * r4 + 0) * 256 + c), w1 = *(const NvF4*)(p.b + (4 * r4 + 1) * 256 + c), w2 = *(const NvF4*)(p.b + (4 * r4 + 2) * 256 + c), w3 = *(const NvF4*)(p.b + (4 * r4 + 3) * 256 + c);
            z.x = fmaf(g.x, w0.x, z.x); z.y = fmaf(g.x, w0.y, z.y); z.z = fmaf(g.x, w0.z, z.z); z.w = fmaf(g.x, w0.w, z.w); z.x = fmaf(g.y, w1.x, z.x); z.y = fmaf(g.y, w1.y, z.y); z.z = fmaf(g.y, w1.z, z.z); z.w = fmaf(g.y, w1.w, z.w);
            z.x = fmaf(g.z, w2.x, z.x); z.y = fmaf(g.z, w2.y, z.y); z.z = fmaf(g.z, w2.z, z.z); z.w = fmaf(g.z, w2.w, z.w); z.x = fmaf(g.w, w3.x, z.x); z.y = fmaf(g.w, w3.y, z.y); z.z = fmaf(g.w, w3.z, z.z); z.w = fmaf(g.w, w3.w, z.w); }
        NvF4 o; o.x = NV_EXP(-nv_softplus(-z.x) * (1.f / 16.f)); o.y = NV_EXP(-nv_softplus(-z.y) * (1.f / 16.f)); o.z = NV_EXP(-nv_softplus(-z.z) * (1.f / 16.f)); o.w = NV_EXP(-nv_softplus(-z.w) * (1.f / 16.f));
        *(NvF4*)(p.o0 + (size_t)row * 256 + c) = o; } break;
    case OP_GLANORM: {
        int row = (int)(gid / 4), h = (int)(gid % 4); const float* o = p.a + (size_t)row * 512 + h * 128; float ss = 0.f;
        for (int c = 0; c < 128; ++c) ss = fmaf(o[c], o[c], ss);
        float rs = 1.f / sqrtf(ss * (1.f / 128.f) + 1e-5f);
        for (int c = 0; c < 128; ++c) { float r = p.b[(size_t)row * MIXIN + C_R + h * 128 + c]; ((nvbf*)p.o0)[(size_t)row * 1024 + h * 128 + c] = nv_f2bf(o[c] * rs * p.c[c] * (r * nv_sigmoid(r))); } } break;
    case OP_CONV: {
        int row = (int)(gid / 512), c = (int)(gid % 512); int s, t; row_to_seq(dm, row, s, t); float acc = p.d[c];
        for (int i = 0; i < 4; ++i) { int j = t + i; float xv;
            if (j < 3) xv = (s < dm.B) ? 0.f : p.b[((size_t)(s - dm.B) * 3 + j) * 512 + c]; else xv = p.a[(size_t)(row - t + (j - 3)) * MIXIN + C_XB + c];
            acc = fmaf(xv, p.c[i * 512 + c], acc); }
        p.o0[gid] = acc; } break;
    case OP_CONVOUT: {
        int s = (int)(gid / 1536), i = (int)((gid / 512) % 3), c = (int)(gid % 512); int L = seq_len(dm, s), r0 = seq_row0(dm, s); int j = L + i; float xv;
        if (j < 3) xv = (s < dm.B) ? 0.f : p.b[((size_t)(s - dm.B) * 3 + j) * 512 + c]; else xv = p.a[(size_t)(r0 + j - 3) * MIXIN + C_XB + c];
        float* o = (s < dm.B) ? PO1 + ((size_t)s * 3 + i) * 512 + c : PO2 + ((size_t)(s - dm.B) * 3 + i) * 512 + c; *o = xv; } break;
    case OP_LRUG: {
        int row = (int)(gid / 512), c = (int)(gid % 512), nb = c / 64, e = c % 64; const float* x = p.a + (size_t)row * 512 + nb * 64; float ga = p.c[c], gx = p.e[c];
        for (int dd = 0; dd < 64; ++dd) { ga = fmaf(x[dd], p.b[((size_t)nb * 64 + dd) * 64 + e], ga); gx = fmaf(x[dd], p.d[((size_t)nb * 64 + dd) * 64 + e], gx); }
        float gate_a = nv_sigmoid(ga), gate_x = nv_sigmoid(gx); float log_at = -8.f * gate_a * nv_softplus(-p.f[c]);
        p.o0[gid] = NV_EXP(log_at); p.o1[gid] = sqrtf(-expm1f(2.f * log_at)) * (gate_x * p.a[(size_t)row * 512 + c]); } break;
    case OP_LRUSCAN: {
        int s = (int)(gid / 512), c = (int)(gid % 512); int r0 = seq_row0(dm, s), L = seq_len(dm, s); float hh = (s < dm.B) ? 0.f : p.d[(size_t)(s - dm.B) * 512 + c];
        for (int t = 0; t < L; ++t) { size_t r = (size_t)(r0 + t); hh = fmaf(p.a[r * 512 + c], hh, p.b[r * 512 + c]); p.o0[r * 1024 + 512 + c] = hh * nv_gelu(p.c[r * MIXIN + C_GB + c]); }
        float* o = (s < dm.B) ? PO1 + (size_t)s * 512 + c : PO2 + (size_t)(s - dm.B) * 512 + c; *o = hh; } break;
    case OP_LNRES: {
        const float alpha = 1.6817928305074292f; float* x = p.o0 + (size_t)gid * D; const nvbf* y = (const nvbf*)p.a + (size_t)gid * D; float mu = 0.f;
        for (int c = 0; c < D; ++c) mu += alpha * x[c] + nv_bf2f(y[c]);
        mu /= D; float var = 0.f;
        for (int c = 0; c < D; ++c) { float v = alpha * x[c] + nv_bf2f(y[c]) - mu; var = fmaf(v, v, var); }
        float rs = 1.f / sqrtf(var / D + 1e-5f);
        for (int c = 0; c < D; ++c) { const float o = (alpha * x[c] + nv_bf2f(y[c]) - mu) * rs * p.b[c] + p.c[c]; x[c] = o; ((nvbf*)p.o1)[(size_t)gid * D + c] = nv_f2bf(o);
            if (p.o2) { unsigned char* f8 = (unsigned char*)p.o2 + (size_t)gid * 2 * D; const float xs = fminf(fmaxf(o * 16.f, -448.f), 448.f); const unsigned hc = nv_f2e4m3(xs); f8[c] = (unsigned char)hc; f8[D + c] = (unsigned char)nv_f2e4m3(xs - nv_e4m32f(hc)); } } } break;
    case OP_MIX: {
        int row = (int)(gid / D), c = (int)(gid % D); int s, t; row_to_seq(dm, row, s, t); float x = p.a[gid];
        float xp = t > 0 ? p.a[gid - D] : ((s < dm.B) ? 0.f : p.b[(size_t)(s - dm.B) * D + c]);
        ((nvbf*)p.o0)[gid] = nv_f2bf(x + (xp - x) * p.c[c]); } break;
    case OP_SHIFTOUT: {
        int s = (int)(gid / D), c = (int)(gid % D); float v = p.a[(size_t)(seq_row0(dm, s) + seq_len(dm, s) - 1) * D + c];
        float* o = (s < dm.B) ? PO1 + (size_t)s * D + c : PO2 + (size_t)(s - dm.B) * D + c; *o = v; } break;
    case OP_RWKVPREP: {
        int row = (int)(gid / dm.RH), h = (int)(gid % dm.RH); size_t base = (size_t)row * D + h * 64; float ss = 0.f;
        for (int k = 0; k < 64; ++k) { float kv = p.o0[base + k] * p.d[h * 64 + k]; ss = fmaf(kv, kv, ss); }
        float inv = 1.f / fmaxf(sqrtf(ss), 1e-12f);
        for (int k = 0; k < 64; ++k) { int c = h * 64 + k; size_t ix = base + k;
            float w = -nv_softplus(-(p.a[c] + p.o1[ix])) - 0.5f; float dec = NV_EXP(-NV_EXP(w));
            float a = nv_sigmoid(p.b[c] + p.o2[ix]);
            float v = p.o3[ix]; if (p.i0) v = v + (p.o5[ix] - v) * nv_sigmoid(p.c[c] + p.f[ix]); else p.o5[ix] = v;
            float k0 = p.o0[ix]; const float kk = k0 * p.d[c] * inv; p.o4[ix] = -kk; p.o0[ix] = k0 * (1.f + (a - 1.f) * p.e[c]); p.o1[ix] = dec; p.o2[ix] = kk * a; p.o3[ix] = v; } } break;
    case OP_WKVF:
    case OP_WKV: {
        int RH = dm.RH; int s = p.i0 + (int)(gid / (RH * 64)), h = (int)((gid / 64) % RH), vr = (int)(gid % 64); float S[64];
        const float* sin = (s < dm.B) ? nullptr : p.g + (((size_t)(s - dm.B) * RH + h) * 64 + vr) * 64;
#pragma unroll
        for (int k = 0; k < 64; ++k) S[k] = sin ? sin[k] : 0.f;
        int r0 = seq_row0(dm, s), L = seq_len(dm, s);
        for (int t = 0; t < L; ++t) { size_t base = (size_t)(r0 + t) * D + h * 64; float sa = 0.f;
#pragma unroll
            for (int k = 0; k < 64; ++k) { if ((k & 7) == 0) NV_FENCE(); sa = fmaf(S[k], p.f[base + k], sa); }
            float vv = p.d[base + vr], y = 0.f;
#pragma unroll
            for (int k = 0; k < 64; ++k) { if ((k & 7) == 0) NV_FENCE(); S[k] = fmaf(S[k], p.b[base + k], fmaf(sa, p.e[base + k], vv * p.c[base + k])); y = fmaf(S[k], p.a[base + k], y); }
            p.o0[base + vr] = y; }
        float* so = (s < dm.B) ? PO1 + (((size_t)s * RH + h) * 64 + vr) * 64 : PO2 + (((size_t)(s - dm.B) * RH + h) * 64 + vr) * 64;
#pragma unroll
        for (int k = 0; k < 64; ++k) so[k] = S[k]; } break;
    case OP_RWKVPOST: {
        int row = (int)(gid / dm.RH), h = (int)(gid % dm.RH); size_t base = (size_t)row * D + h * 64; float mu = 0.f, bon = 0.f;
        for (int k = 0; k < 64; ++k) { mu += p.a[base + k]; bon = fmaf(p.b[base + k] * p.c[base + k], p.f[h * 64 + k], bon); }
        mu *= (1.f / 64.f); float var = 0.f;
        for (int k = 0; k < 64; ++k) { float dlt = p.a[base + k] - mu; var = fmaf(dlt, dlt, var); }
        float rs = 1.f / sqrtf(var * (1.f / 64.f) + 64e-5f);
        for (int k = 0; k < 64; ++k) { int c = h * 64 + k; float y = (p.a[base + k] - mu) * rs * p.g[c] + p.h[c] + bon * p.d[base + k]; ((nvbf*)p.o0)[base + k] = nv_f2bf(y * p.e[base + k]); } } break;
    case OP_PRM: {
        const int m = (int)(gid / D), c = (int)(gid % D); const float* src = m == 0 ? p.a : m == 1 ? p.b : m == 2 ? p.c : m == 3 ? p.d : m == 4 ? p.e : p.f; p.o0[gid] = src ? src[c] : 0.f; } break;
    case OP_WKVP: {
        const int RH = dm.RH; const int s = (int)(gid / (RH * 64)), h = (int)((gid / 64) % RH), vr = (int)(gid % 64); float S[64];
        const float* sin = (s < dm.B) ? nullptr : p.o5 + (((size_t)(s - dm.B) * RH + h) * 64 + vr) * 64;
        for (int k = 0; k < 64; ++k) S[k] = sin ? sin[k] : 0.f;
        const float* w0 = p.h + h * 64; const float* a0 = p.h + D + h * 64; const float* v0 = p.h + 2 * D + h * 64; const float* k_k = p.h + 3 * D + h * 64; const float* k_a = p.h + 4 * D + h * 64; const float* r_k = p.h + 5 * D + h * 64;
        const int r0 = seq_row0(dm, s), L = seq_len(dm, s); const nvbf* bR = (const nvbf*)p.a; const nvbf* bK = (const nvbf*)p.b; const nvbf* bWL = (const nvbf*)p.c; const nvbf* bAL = (const nvbf*)p.d; const nvbf* bV = (const nvbf*)p.e; const nvbf* bVG = (const nvbf*)p.f;
        for (int t = 0; t < L; ++t) { const size_t base = (size_t)(r0 + t) * D + h * 64; float ss = 0.f;
            for (int k = 0; k < 64; ++k) { const float kv = nv_bf2f(bK[base + k]) * k_k[k]; ss = fmaf(kv, kv, ss); }
            const float inv = 1.f / fmaxf(sqrtf(ss), 1e-12f);
            float vv = nv_bf2f(bV[base + vr]); if (p.i0) vv = vv + (p.g[base + vr] - vv) * nv_sigmoid(v0[vr] + nv_bf2f(bVG[base + vr]));
            float sa = 0.f, bon = 0.f, dec[64], bb[64], k2[64];
            for (int k = 0; k < 64; ++k) { const float k0 = nv_bf2f(bK[base + k]); const float kk = k0 * k_k[k] * inv; const float a = nv_sigmoid(a0[k] + nv_bf2f(bAL[base + k]));
                dec[k] = NV_EXP(-0.6065306597126334f * nv_sigmoid(w0[k] + nv_bf2f(bWL[base + k])));
                bb[k] = kk * a; k2[k] = k0 * (1.f + (a - 1.f) * k_a[k]); sa = fmaf(S[k], -kk, sa); bon = fmaf(nv_bf2f(bR[base + k]) * k2[k], r_k[k], bon); }
            float y = 0.f;
            for (int k = 0; k < 64; ++k) { S[k] = fmaf(S[k], dec[k], fmaf(sa, bb[k], vv * k2[k])); y = fmaf(S[k], nv_bf2f(bR[base + k]), y); }
            p.o0[base + vr] = y; p.o3[base + vr] = vv; if (vr == 0) p.o4[(size_t)(r0 + t) * RH + h] = bon; }
        float* so = (s < dm.B) ? PO1 + (((size_t)s * RH + h) * 64 + vr) * 64 : PO2 + (((size_t)(s - dm.B) * RH + h) * 64 + vr) * 64;
        for (int k = 0; k < 64; ++k) so[k] = S[k]; } break;
    case OP_POST2: {
        const int row = (int)(gid / dm.RH), h = (int)(gid % dm.RH); const size_t base = (size_t)row * D + h * 64; float mu = 0.f;
        for (int k = 0; k < 64; ++k) mu += p.a[base + k];
        mu *= (1.f / 64.f); float var = 0.f;
        for (int k = 0; k < 64; ++k) { const float dlt = p.a[base + k] - mu; var = fmaf(dlt, dlt, var); }
        const float rs = 1.f / sqrtf(var * (1.f / 64.f) + 64e-5f), bon = p.d[gid];
        for (int k = 0; k < 64; ++k) { const int c = h * 64 + k; const float y = (p.a[base + k] - mu) * rs * p.e[c] + p.f[c] + bon * p.c[base + k]; ((nvbf*)p.o0)[base + k] = nv_f2bf(y * nv_bf2f(((const nvbf*)p.b)[base + k])); } } break;
    case OP_QNORM: {
        float* q = p.o0 + (size_t)gid * 256; float mu = 0.f;
        for (int c = 0; c < 256; ++c) mu += q[c];
        mu *= (1.f / 256.f); float var = 0.f;
        for (int c = 0; c < 256; ++c) { float dlt = q[c] - mu; var = fmaf(dlt, dlt, var); }
        float rs = 1.f / sqrtf(var * (1.f / 256.f) + 1e-5f);
        for (int c = 0; c < 256; ++c) q[c] = (q[c] - mu) * rs; } break;
    case OP_SCORES: {
        int row = (int)(gid / 2048), r = (int)(gid % 2048), h = r / 256, half = (r / 128) & 1, key = r % 128;
        const float* q = p.a + (size_t)row * 2048 + h * 256 + half * 128; const float* kv = p.b + (((size_t)h * 2 + half) * 128 + key) * 128; float acc = 0.f;
        for (int dd = 0; dd < 128; ++dd) acc = fmaf(q[dd], kv[dd], acc);
        p.o0[gid] = acc; } break;
    case OP_TOPK: {
        const float* sc = p.a + (size_t)gid * 256; float tv[16]; int ti[16]; float* tmpv = p.o2 + (size_t)gid * 32; int* tmpi = (int*)p.o3 + (size_t)gid * 32;
        for (int half = 0; half < 2; ++half) {
#pragma unroll
            for (int j = 0; j < 16; ++j) { tv[j] = -3.0e38f; ti[j] = 0; }
            for (int k = 0; k < 128; ++k) NV_INS16(tv, ti, sc[half * 128 + k], k);
#pragma unroll
            for (int j = 0; j < 16; ++j) { tmpv[half * 16 + j] = tv[j]; tmpi[half * 16 + j] = ti[j]; }
        }
#pragma unroll
        for (int j = 0; j < 16; ++j) { tv[j] = -3.0e38f; ti[j] = 0; }
        for (int i = 0; i < 16; ++i) for (int j = 0; j < 16; ++j) NV_INS16(tv, ti, tmpv[i] + tmpv[16 + j], tmpi[i] * 128 + tmpi[16 + j]);
        float den = 0.f, ev[16];
#pragma unroll
        for (int j = 0; j < 16; ++j) { ev[j] = NV_EXP(tv[j] - tv[0]); den += ev[j]; }
        float inv = 1.f / den;
#pragma unroll
        for (int j = 0; j < 16; ++j) { p.o0[(size_t)gid * 16 + j] = ev[j] * inv; ((int*)p.o1)[(size_t)gid * 16 + j] = ti[j]; } } break;
    case OP_PACT1: {
        size_t pr = (size_t)(gid / 16); int part = (int)(gid % 16); int row = (int)(pr / 128); int e = ((const int*)p.d)[pr]; int w = D / 16;
        const float* u = p.b + (size_t)e * D + part * w; const float* x = p.a + (size_t)row * D + part * w; float acc = 0.f;
        for (int c = 0; c < w; ++c) acc = fmaf(u[c], x[c], acc);
        p.o0[gid] = acc; } break;
    case OP_PACT2: {
        float acc = 0.f; for (int i = 0; i < 16; ++i) acc += p.a[(size_t)gid * 16 + i];
        p.o0[gid] = p.c[gid] * nv_gelu(acc); } break;
    case OP_POUT: {
        int row = (int)(gid / D), c = (int)(gid % D); float acc = 0.f;
        for (int i = 0; i < 128; ++i) acc = fmaf(p.a[(size_t)row * 128 + i], p.c[(size_t)((const int*)p.b)[(size_t)row * 128 + i] * D + c], acc);
        p.o0[gid] = acc; } break;
    case OP_YOUT: {
        int row = (int)(gid / D), c = (int)(gid % D);
        if (row < dm.B * dm.T) { int bb = row / dm.T, t = row % dm.T; if (t >= 16) p.o0[((size_t)bb * (dm.T - 16) + (t - 16)) * D + c] = p.a[gid]; }
        else p.o0[((size_t)dm.B * (dm.T - 16) + (row - dm.B * dm.T)) * D + c] = p.a[gid]; } break;
    case OP_WT: {
        const int N = p.i0, K = p.i1, Np = p.i3, Kp = p.i4; const long long per8 = (long long)Np * (Kp / 8); const int bt = (int)(gid / per8); const long long r = gid % per8; const int k0 = (int)(r / Np) * 8, nn = (int)(r % Np);
        unsigned w[4];
#pragma unroll
        for (int i = 0; i < 4; ++i) { float lo = 0.f, hi = 0.f; if (nn < N) { if (k0 + 2 * i < K) lo = p.a[((size_t)bt * K + k0 + 2 * i) * p.i2 + nn]; if (k0 + 2 * i + 1 < K) hi = p.a[((size_t)bt * K + k0 + 2 * i + 1) * p.i2 + nn]; } w[i] = nv_f2bf(lo) | ((unsigned)nv_f2bf(hi) << 16); }
        NvU4 o; o.x = w[0]; o.y = w[1]; o.z = w[2]; o.w = w[3];
        *(NvU4*)((nvbf*)p.o0 + (size_t)bt * Np * Kp + (size_t)nn * Kp + k0) = o; } break;
    case OP_CVT: {
        const int Kp = p.i2; const int row = (int)(gid / Kp), k = (int)(gid % Kp); float v = 0.f;
        if (row < dm.M && k < p.i0) { v = p.a[(size_t)row * p.i1 + k]; if (p.i3 == 1) v = NV_TANH(v); else if (p.i3 == 2) v = nv_sigmoid(v); }
        ((nvbf*)p.o0)[gid] = nv_f2bf(v); } break;
    case OP_FGEMM: {
        const int N = p.i0; const int m = (int)(gid / N), nn = (int)(gid % N); const nvbf* A = (const nvbf*)p.a + (size_t)m * p.i2 + ((p.i6 & 2) ? (nn / 256) * 256 : 0); const nvbf* Bt = (const nvbf*)p.b + (size_t)nn * p.i3; float acc = 0.f;
        for (int k = 0; k < p.i1; ++k) acc = fmaf(nv_bf2f(A[k]), nv_bf2f(Bt[k]), acc);
        if (p.i6 & 1) ((nvbf*)p.o0)[(size_t)m * p.i4 + nn] = nv_f2bf(acc); else p.o0[(size_t)m * p.i4 + nn] = acc; } break;
    case OP_CVTTAB: {
        const NvF4 v0 = *(const NvF4*)(p.a + gid * 8), v1 = *(const NvF4*)(p.a + gid * 8 + 4); NvU4 o;
        o.x = nv_f2bf(v0.x) | ((unsigned)nv_f2bf(v0.y) << 16); o.y = nv_f2bf(v0.z) | ((unsigned)nv_f2bf(v0.w) << 16); o.z = nv_f2bf(v1.x) | ((unsigned)nv_f2bf(v1.y) << 16); o.w = nv_f2bf(v1.z) | ((unsigned)nv_f2bf(v1.w) << 16);
        *(NvU4*)((nvbf*)p.o0 + gid * 8) = o; } break;
    case OP_CVTTAB8: {
        const float sc = (float)(1 << p.i0); const float* sp = p.a + gid * 16; unsigned w[4];
#pragma unroll
        for (int q = 0; q < 4; ++q) { const NvF4 v = *(const NvF4*)(sp + 4 * q); w[q] = nv_f2e4m3(v.x * sc) | (nv_f2e4m3(v.y * sc) << 8) | (nv_f2e4m3(v.z * sc) << 16) | (nv_f2e4m3(v.w * sc) << 24); }
        NvU4 o; o.x = w[0]; o.y = w[1]; o.z = w[2]; o.w = w[3]; *(NvU4*)((unsigned char*)p.o0 + gid * 16) = o; } break;
    case OP_CVTTAB8S: {
        const float sc = (float)(1 << p.i0); const int per = D / 16; const int e = (int)(gid / per), c0 = (int)(gid % per) * 16; const float* sp = p.a + (size_t)e * D + c0; unsigned w[4];
#pragma unroll
        for (int q = 0; q < 4; ++q) { const NvF4 v = *(const NvF4*)(sp + 4 * q);
#if defined(__HIP_DEVICE_COMPILE__)
            int pk = __builtin_amdgcn_cvt_pk_fp8_f32(v.x * sc, v.y * sc, 0, false); pk = __builtin_amdgcn_cvt_pk_fp8_f32(v.z * sc, v.w * sc, pk, true); w[q] = (unsigned)pk;
#else
            w[q] = nv_f2e4m3(v.x * sc) | (nv_f2e4m3(v.y * sc) << 8) | (nv_f2e4m3(v.z * sc) << 16) | (nv_f2e4m3(v.w * sc) << 24);
#endif
        }
        NvU4 o; o.x = w[0]; o.y = w[1]; o.z = w[2]; o.w = w[3]; *(NvU4*)((unsigned char*)p.o0 + ((size_t)(c0 >> 7) * 16384 + e) * 128 + (c0 & 127)) = o; } break;
    case OP_PACTS: {
        const long long NP = (long long)dm.M * 128; const int sl = (int)(gid / NP); const long long pr = gid % NP; const int row = (int)(pr / 128); const int e = ((const int*)p.d)[pr] & p.i0;
        const unsigned char* u = (const unsigned char*)p.b + ((size_t)sl * 16384 + e) * 128; const unsigned char* x = (const unsigned char*)p.a + (size_t)row * 2 * D + sl * 128; float acc = 0.f;
        for (int c = 0; c < 128; ++c) acc = fmaf(nv_e4m32f(u[c]), nv_e4m32f(x[c]) + nv_e4m32f(x[D + c]), acc);
        ((nvbf*)p.o0)[gid] = nv_f2bf(acc * (1.f / 16.f)); } break;
    case OP_PRED: {
        const long long NP = (long long)dm.M * 128; const size_t e0 = (size_t)gid * 4; float a0 = 0.f, a1 = 0.f, a2 = 0.f, a3 = 0.f;
#pragma unroll 8
        for (int sl = 0; sl < p.i0; ++sl) { const NvU2 w = *(const NvU2*)((const nvbf*)p.a + (size_t)sl * NP + e0); a0 += nv_bf2f((nvbf)(w.x & 0xffffu)); a1 += nv_bf2f((nvbf)(w.x >> 16)); a2 += nv_bf2f((nvbf)(w.y & 0xffffu)); a3 += nv_bf2f((nvbf)(w.y >> 16)); }
        const NvF4 g = *(const NvF4*)(p.c + e0); NvF4 o; o.x = g.x * nv_gelu(a0 * (1.f / 128.f)); o.y = g.y * nv_gelu(a1 * (1.f / 128.f)); o.z = g.z * nv_gelu(a2 * (1.f / 128.f)); o.w = g.w * nv_gelu(a3 * (1.f / 128.f));
        *(NvF4*)(p.o0 + e0) = o; } break;
    case OP_POUTS: {
        const int row = (int)(gid / D), c = (int)(gid % D); const unsigned char* vb = (const unsigned char*)p.c + (size_t)(c >> 7) * 16384 * 128 + (c & 127); float acc = 0.f;
        for (int i = 0; i < 128; ++i) acc = fmaf(p.a[(size_t)row * 128 + i] * (1.f / 64.f), nv_e4m32f(vb[(size_t)((const int*)p.b)[(size_t)row * 128 + i] * 128]), acc);
        ((nvbf*)p.o0)[gid] = nv_f2bf(acc); } break;
    case OP_KEYS: {
        const int h = (int)(gid / 256), nrow = (int)(gid % 256), half = nrow >> 7; const float* src = p.a + (((size_t)h * 2 + half) * 128 + (nrow & 127)) * 128; nvbf* dst = (nvbf*)p.o0 + ((size_t)h * 256 + nrow) * 256; float ks = 0.f;
        for (int k = 0; k < 256; ++k) { nvbf b = 0; if ((k >> 7) == half) { b = nv_f2bf(src[k & 127]); ks += nv_bf2f(b); } dst[k] = b; }
        p.o1[gid] = ks; } break;
    case OP_TOPK2: {
        const int h = (int)(gid % 8); const float* sc = p.a + (size_t)gid * 256; const nvbf* q = (const nvbf*)p.b + (size_t)gid * 256; const float* ksum = p.c + h * 256; float mu = 0.f;
        for (int c = 0; c < 256; ++c) mu += nv_bf2f(q[c]);
        mu *= (1.f / 256.f); float var = 0.f;
        for (int c = 0; c < 256; ++c) { float dlt = nv_bf2f(q[c]) - mu; var = fmaf(dlt, dlt, var); }
        const float rs = 1.f / sqrtf(var * (1.f / 256.f) + 1e-5f);
        float tv[16]; int ti[16]; float* tmpv = p.o2 + (size_t)gid * 32; int* tmpi = (int*)p.o3 + (size_t)gid * 32;
        for (int half = 0; half < 2; ++half) {
#pragma unroll
            for (int j = 0; j < 16; ++j) { tv[j] = -3.0e38f; ti[j] = 0; }
            for (int k = 0; k < 128; ++k) NV_INS16(tv, ti, rs * (sc[half * 128 + k] - mu * ksum[half * 128 + k]), k);
#pragma unroll
            for (int j = 0; j < 16; ++j) { tmpv[half * 16 + j] = tv[j]; tmpi[half * 16 + j] = ti[j]; }
        }
#pragma unroll
        for (int j = 0; j < 16; ++j) { tv[j] = -3.0e38f; ti[j] = 0; }
        for (int i = 0; i < 16; ++i) for (int j = 0; j < 16; ++j) NV_INS16(tv, ti, tmpv[i] + tmpv[16 + j], tmpi[i] * 128 + tmpi[16 + j]);
        float den = 0.f, ev[16];
#pragma unroll
        for (int j = 0; j < 16; ++j) { ev[j] = NV_EXP(tv[j] - tv[0]); den += ev[j]; }
        float inv = 1.f / den;
#pragma unroll
        for (int j = 0; j < 16; ++j) { p.o0[(size_t)gid * 16 + j] = ev[j] * inv; ((int*)p.o1)[(size_t)gid * 16 + j] = ti[j]; } } break;
    case OP_PACT: {
        const int row = (int)(gid / 128); const int e = ((const int*)p.d)[gid]; const unsigned char* u = (const unsigned char*)p.b + (size_t)e * D; const nvbf* x = (const nvbf*)p.a + (size_t)row * D; float acc = 0.f;
        for (int c = 0; c < D; ++c) acc = fmaf(nv_e4m32f(u[c]), nv_bf2f(x[c]), acc);
        p.o0[gid] = p.c[gid] * nv_gelu(acc * (1.f / 128.f)); } break;
#if defined(HOST_TEST)
    case OP_POUTLN: {
        const float alpha = 1.6817928305074292f; float* x = p.o0 + (size_t)gid * D; std::vector<float> y(D, 0.f);
        for (int i = 0; i < 128; ++i) { const float cf = p.a[(size_t)gid * 128 + i] * (1.f / 64.f); const unsigned char* v = (const unsigned char*)p.c + (size_t)((const int*)p.b)[(size_t)gid * 128 + i] * D; for (int c = 0; c < D; ++c) y[c] = fmaf(cf, nv_e4m32f(v[c]), y[c]); }
        float mu = 0.f; for (int c = 0; c < D; ++c) { y[c] = alpha * x[c] + y[c]; mu += y[c]; }
        mu /= D; float var = 0.f; for (int c = 0; c < D; ++c) { float dlt = y[c] - mu; var = fmaf(dlt, dlt, var); }
        const float rs = 1.f / sqrtf(var / D + 1e-5f);
        for (int c = 0; c < D; ++c) { const float o = (y[c] - mu) * rs * p.d[c] + p.e[c]; x[c] = o; ((nvbf*)p.o1)[(size_t)gid * D + c] = nv_f2bf(o);
            if (p.o2) { unsigned char* f8 = (unsigned char*)p.o2 + (size_t)gid * 2 * D; const float xs = fminf(fmaxf(o * 16.f, -448.f), 448.f); const unsigned hc = nv_f2e4m3(xs); f8[c] = (unsigned char)hc; f8[D + c] = (unsigned char)nv_f2e4m3(xs - nv_e4m32f(hc)); } } } break;
#endif
    default: break;
    }
}

struct NvIO { const float* const* in; float* out; char* ws; size_t ws_size; };
template <class Launch> HD void nv_forward(const NvIO& io, const Dm& dm, Launch&& launch) {
    const int D = dm.D, M = dm.M, B = dm.B, DB = dm.DB, RH = dm.RH; const size_t MD = (size_t)M * D;
    float* y_prompt = io.out; float* y_sample = y_prompt + (size_t)B * (dm.T - 16) * D; float* p_gla = y_sample + (size_t)DB * dm.DT * D;
    float* p_h = p_gla + (size_t)2 * B * 4 * 64 * 128; float* p_conv = p_h + (size_t)2 * B * 512; float* p_rwkv = p_conv + (size_t)2 * B * 3 * 512;
    float* p_shift = p_rwkv + (size_t)2 * B * RH * 4096; float* s_gla = p_shift + (size_t)2 * B * D; float* s_h = s_gla + (size_t)2 * DB * 4 * 64 * 128;
    float* s_conv = s_h + (size_t)2 * DB * 512; float* s_rwkv = s_conv + (size_t)2 * DB * 3 * 512; float* s_shift = s_rwkv + (size_t)2 * DB * RH * 4096;
    float* w = (float*)io.ws; size_t off = 0; auto take = [&](size_t n) __attribute__((always_inline)) { float* r = w + off; off += (n + 63) & ~(size_t)63; return r; };
    float* X = take(MD); float* VFIRST = take(MD); float* MOUT = take(MD);
    auto mk = [&](int code, long long n) __attribute__((always_inline)) { Op o{}; o.code = code; o.n = n; return o; };
    const int Mp = nv_rup(M, 256), Dp = nv_rup(D, 256), Dk = nv_rup(D, 128);
    auto takeh = [&](size_t n) __attribute__((always_inline)) { return (nvbf*)take((n + 1) / 2); };
    const size_t ABFN = (size_t)Mp * 1024 > (size_t)Mp * Dk ? (size_t)Mp * 1024 : (size_t)Mp * Dk; nvbf* ABF = takeh(ABFN + (size_t)Mp * D);
    const size_t SZ_WIN = (size_t)2816 * Dk, SZ_WOUT = (size_t)Dp * 1024, SZ_DD = (size_t)Dp * Dk, SZ_DN = (size_t)256 * Dk, SZ_UP = (size_t)Dp * 128, SZ_WQ = (size_t)2048 * Dk;
    nvbf* WT_WIN = takeh(2 * SZ_WIN); nvbf* WT_WOUT = takeh(2 * SZ_WOUT); nvbf* WT_WR = takeh(2 * SZ_DD); nvbf* WT_WK = takeh(2 * SZ_DD); nvbf* WT_WV = takeh(2 * SZ_DD); nvbf* WT_WO = takeh(2 * SZ_DD);
    nvbf* WT_W1 = takeh(2 * SZ_DN); nvbf* WT_W2 = takeh(2 * SZ_UP); nvbf* WT_A1 = takeh(2 * SZ_DN); nvbf* WT_A2 = takeh(2 * SZ_UP); nvbf* WT_G1 = takeh(2 * SZ_DN); nvbf* WT_G2 = takeh(2 * SZ_UP);
    nvbf* WT_V1 = takeh(SZ_DN); nvbf* WT_V2 = takeh(SZ_UP); nvbf* WT_WQ = takeh(4 * SZ_WQ); nvbf* WT_WG = takeh((size_t)2 * 1024 * 512); float* SPL = take(2 * 512); float* PRM = take((size_t)2 * 6 * D);
    nvbf* UB = takeh((size_t)16384 * D / 2); nvbf* VB = takeh((size_t)16384 * D / 2); nvbf* KB = takeh((size_t)8 * 256 * 256); float* KSUM = take(8 * 256);
    const size_t scratch0 = off;
    auto nb = [&](Op o) __attribute__((always_inline)) { o.code |= OPF_NOBAR; launch(o); };
    auto wt = [&](const float* W, int K, int N, int batch, nvbf* dst) __attribute__((always_inline)) { const int Np = nv_rup(N, 256), Kp = nv_rup(K, 128); Op o = mk(OP_WT, (long long)batch * Np * (Kp / 8)); o.a = W; o.o0 = (float*)dst; o.i0 = N; o.i1 = K; o.i2 = N; o.i3 = Np; o.i4 = Kp; nb(o); };
    wt(io.in[10], D, MIXIN, 2, WT_WIN); wt(io.in[21], 1024, D, 2, WT_WOUT); wt(io.in[23], D, D, 2, WT_WR); wt(io.in[24], D, D, 2, WT_WK); wt(io.in[25], D, D, 2, WT_WV); wt(io.in[26], D, D, 2, WT_WO);
    wt(io.in[28], D, 64, 2, WT_W1); wt(io.in[29], 64, D, 2, WT_W2); wt(io.in[31], D, 64, 2, WT_A1); wt(io.in[32], 64, D, 2, WT_A2); wt(io.in[36], D, 128, 2, WT_G1); wt(io.in[37], 128, D, 2, WT_G2);
    wt(io.in[34], D, 32, 1, WT_V1); wt(io.in[35], 32, D, 1, WT_V2); wt(io.in[43], D, 2048, 4, WT_WQ);
    for (int jj = 0; jj < 2; ++jj) { Op o = mk(OP_PRM, (long long)6 * D); o.a = io.in[27] + (size_t)jj * D; o.b = io.in[30] + (size_t)jj * D; o.c = jj > 0 ? io.in[33] + (size_t)(jj - 1) * D : nullptr; o.d = io.in[38] + (size_t)jj * D; o.e = io.in[39] + (size_t)jj * D; o.f = io.in[40] + (size_t)jj * RH * 64; o.o0 = PRM + (size_t)jj * 6 * D; nb(o); }
    for (int jj = 0; jj < 2; ++jj) { Op o = mk(OP_WGATE, 1024); o.a = io.in[16] + (size_t)jj * 8 * 64 * 64; o.b = io.in[18] + (size_t)jj * 8 * 64 * 64; o.c = io.in[20] + (size_t)jj * 512; o.o0 = (float*)(WT_WG + (size_t)jj * 1024 * 512); o.o1 = SPL + (size_t)jj * 512; nb(o); }
    auto fgemm = [&](const nvbf* Wt, float* C, int ldc, int N, int K, int bf16out = 0) __attribute__((always_inline)) {
        const int Kp = nv_rup(K, 128), Np = nv_rup(N, 256);
        Op o = mk(OP_FGEMM, (long long)M * N); o.a = (const float*)ABF; o.b = (const float*)Wt; o.o0 = C; o.i0 = N; o.i1 = Kp; o.i2 = Kp; o.i3 = Kp; o.i4 = ldc; o.i5 = Np; o.i6 = bf16out; launch(o); };
    auto gemm = [&](const float* A, int lda, const nvbf* Wt, float* C, int ldc, int N, int K, int act) __attribute__((always_inline)) {
        const int Kp = nv_rup(K, 128);
        { Op o = mk(OP_CVT8, (long long)Mp * (Kp / 8)); o.a = A; o.o0 = (float*)ABF; o.i0 = K; o.i1 = lda; o.i2 = Kp; o.i3 = act; launch(o); }
        fgemm(Wt, C, ldc, N, K); };
    { Op o = mk(OP_EMBED4, (long long)MD / 4); o.a = io.in[0]; o.b = io.in[1]; o.c = io.in[7]; o.o0 = X; o.o1 = (float*)ABF; launch(o); }
    const float* const w_outer = w; float* const out_outer = io.out;
    for (int layer = 0; layer < 4; ++layer) {
        float* wl = (float*)w_outer; float* ol = out_outer; NV_LAUNDER(wl); NV_LAUNDER(ol);
#define NV_RB(T, v) T const v##_rb = (T)((char*)wl + ((const char*)(v) - (const char*)w_outer))
#define NV_RO(v) float* const v##_rb = (float*)((char*)ol + ((const char*)(v) - (const char*)out_outer))
        NV_RB(float*, X); NV_RB(float*, VFIRST); NV_RB(float*, MOUT); NV_RB(nvbf*, ABF); NV_RB(nvbf*, WT_WIN); NV_RB(nvbf*, WT_WOUT); NV_RB(nvbf*, WT_WR); NV_RB(nvbf*, WT_WK); NV_RB(nvbf*, WT_WV); NV_RB(nvbf*, WT_WO);
        NV_RB(nvbf*, WT_W1); NV_RB(nvbf*, WT_W2); NV_RB(nvbf*, WT_A1); NV_RB(nvbf*, WT_A2); NV_RB(nvbf*, WT_G1); NV_RB(nvbf*, WT_G2); NV_RB(nvbf*, WT_V1); NV_RB(nvbf*, WT_V2); NV_RB(nvbf*, WT_WQ); NV_RB(nvbf*, WT_WG);
        NV_RB(float*, SPL); NV_RB(float*, PRM); NV_RB(nvbf*, UB); NV_RB(nvbf*, VB); NV_RB(nvbf*, KB); NV_RB(float*, KSUM);
        NV_RO(p_gla); NV_RO(p_h); NV_RO(p_conv); NV_RO(p_rwkv); NV_RO(p_shift); NV_RO(s_gla); NV_RO(s_h); NV_RO(s_conv); NV_RO(s_rwkv); NV_RO(s_shift);
#undef NV_RB
#undef NV_RO
        { float* const X = X_rb; float* const VFIRST = VFIRST_rb; float* const MOUT = MOUT_rb; nvbf* const ABF = ABF_rb; nvbf* const WT_WIN = WT_WIN_rb; nvbf* const WT_WOUT = WT_WOUT_rb; nvbf* const WT_WR = WT_WR_rb; nvbf* const WT_WK = WT_WK_rb;
          nvbf* const WT_WV = WT_WV_rb; nvbf* const WT_WO = WT_WO_rb; nvbf* const WT_W1 = WT_W1_rb; nvbf* const WT_W2 = WT_W2_rb; nvbf* const WT_A1 = WT_A1_rb; nvbf* const WT_A2 = WT_A2_rb; nvbf* const WT_G1 = WT_G1_rb; nvbf* const WT_G2 = WT_G2_rb;
          nvbf* const WT_V1 = WT_V1_rb; nvbf* const WT_V2 = WT_V2_rb; nvbf* const WT_WQ = WT_WQ_rb; nvbf* const WT_WG = WT_WG_rb; float* const SPL = SPL_rb; float* const PRM = PRM_rb; nvbf* const UB = UB_rb; nvbf* const VB = VB_rb; nvbf* const KB = KB_rb; float* const KSUM = KSUM_rb;
          float* const p_gla = p_gla_rb; float* const p_h = p_h_rb; float* const p_conv = p_conv_rb; float* const p_rwkv = p_rwkv_rb; float* const p_shift = p_shift_rb; float* const s_gla = s_gla_rb; float* const s_h = s_h_rb; float* const s_conv = s_conv_rb;
          float* const s_rwkv = s_rwkv_rb; float* const s_shift = s_shift_rb; float* const w = wl; (void)SPL; (void)WT_WG; (void)VFIRST;
        const int j = layer / 2; off = scratch0;
        { Op o = mk(OP_CVTTAB8S, (long long)16384 * D / 16); o.a = io.in[45] + (size_t)layer * 16384 * D; o.o0 = (float*)UB; o.i0 = 7; nb(o); }
        { Op o = mk(OP_CVTTAB8S, (long long)16384 * D / 16); o.a = io.in[46] + (size_t)layer * 16384 * D; o.o0 = (float*)VB; o.i0 = 6; nb(o); }
        { Op o = mk(OP_KEYS, 8 * 256); o.a = io.in[44] + (size_t)layer * 8 * 2 * 128 * 128; o.o0 = (float*)KB; o.o1 = KSUM; nb(o); }
        if (layer % 2 == 0) {
            float* PROJ = take((size_t)M * MIXIN); float* LOGA = take((size_t)M * 256); float* O = take((size_t)M * 512); float* MIXO = (float*)ABF;
            float* XC = take((size_t)M * 512); nvbf* XCB = takeh((size_t)Mp * 512); float* AT = take((size_t)M * 512); float* BT = take((size_t)M * 512);
            const int NC = (dm.T + 63) / 64; float* LEND = take((size_t)B * 4 * NC * 8192); float* DEC = take((size_t)B * 4 * NC * 64); float* LA = take((size_t)B * NC * 512); float* LB = take((size_t)B * NC * 512);
            fgemm(WT_WIN + (size_t)j * SZ_WIN, PROJ, MIXIN, MIXIN, D);
            { Op o = mk(OP_LOGA4, (long long)M * 64); o.a = PROJ; o.b = io.in[11] + (size_t)j * 16 * 256; o.c = io.in[12] + (size_t)j * 256; o.o0 = LOGA; nb(o); }
            { Op o = mk(OP_CONV4, (long long)M * 128); o.a = PROJ; o.b = io.in[4] + (size_t)j * DB * 3 * 512; o.c = io.in[14] + (size_t)j * 4 * 512; o.d = io.in[15] + (size_t)j * 512; o.o0 = XC; o.o1 = (float*)XCB; nb(o); }
            { Op o = mk(OP_CONVOUT, (long long)dm.NSEQ * 1536); o.a = PROJ; o.b = io.in[4] + (size_t)j * DB * 3 * 512; o.o1 = p_conv + (size_t)j * B * 3 * 512; o.o2 = s_conv + (size_t)j * DB * 3 * 512; launch(o); }
            { Op o = mk(OP_GLAF, (long long)B * 512); o.a = PROJ; o.b = LOGA; o.o0 = O; o.o1 = p_gla + (size_t)j * B * 4 * 64 * 128; nb(o); }
            { Op o = mk(OP_GLA3, (long long)(DB * 4) * 128); o.a = PROJ; o.b = LOGA; o.c = io.in[2] + (size_t)j * DB * 4 * 64 * 128; o.d = LEND; o.o0 = O; o.o2 = s_gla + (size_t)j * DB * 4 * 64 * 128; o.i0 = NC; o.i1 = 1; nb(o); }
            { Op o = mk(OP_LRUG2, (long long)M * 512); o.a = (const float*)XCB; o.b = (const float*)(WT_WG + (size_t)j * 1024 * 512); o.c = io.in[17] + (size_t)j * 512; o.d = io.in[19] + (size_t)j * 512; o.e = SPL + (size_t)j * 512; o.f = XC; o.o0 = AT; o.o1 = BT; launch(o); }
            { Op o = mk(OP_GLANORM, (long long)M * 4); o.a = O; o.b = PROJ; o.c = io.in[13] + (size_t)j * 128; o.o0 = MIXO; nb(o); }
            { Op o = mk(OP_LRU1, (long long)B * NC * 512); o.a = AT; o.b = BT; o.o0 = LA; o.o1 = LB; o.i0 = NC; launch(o); }
            { Op o = mk(OP_LRU2, (long long)B * 512); o.a = LA; o.o0 = LB; o.o1 = p_h + (size_t)j * B * 512; o.i0 = NC; launch(o); }
            { Op o = mk(OP_LRU3, (long long)(B * NC + DB) * 512); o.a = AT; o.b = BT; o.c = PROJ; o.d = io.in[3] + (size_t)j * DB * 512; o.e = LB; o.o0 = MIXO; o.o2 = s_h + (size_t)j * DB * 512; o.i0 = NC; launch(o); }
            fgemm(WT_WOUT + (size_t)j * SZ_WOUT, MOUT, D, D, 1024, 1);
        } else {
            float* Y = take(MD); float* R = take(MD); float* K = take(MD); float* V = take(MD); float* G = take(MD); float* KK = take(MD);
            const size_t XMSZ = (size_t)Mp * D;
            float* WAV = take(3 * MD > 3 * XMSZ ? 3 * MD : 3 * XMSZ); float* Wd = WAV; float* Aa = WAV + MD; float* Vg = WAV + 2 * MD; nvbf* XM6 = (nvbf*)WAV;
            float* BON = take((size_t)M * RH); float* HLw = take((size_t)M * 64); float* HLa = take((size_t)M * 64); float* HLg = take((size_t)M * 128); float* HLv = take((size_t)M * 32);
            nvbf* ABw = takeh((size_t)Mp * 128); nvbf* ABa = takeh((size_t)Mp * 128); nvbf* ABg = takeh((size_t)Mp * 128); nvbf* ABv = takeh((size_t)Mp * 128);
            const float* shin = io.in[6] + (size_t)j * DB * D; const float* mu = io.in[22] + (size_t)j * 6 * D;
            { Op o = mk(OP_SHIFTOUT, (long long)dm.NSEQ * D); o.a = X; o.o1 = p_shift + (size_t)j * B * D; o.o2 = s_shift + (size_t)j * DB * D; nb(o); }
            { Op o = mk(OP_MIX6, (long long)MD / 8); o.a = X; o.b = shin; o.c = mu; o.o0 = (float*)XM6; o.i1 = (int)(XMSZ / 1024); launch(o); }
            auto gg = [&](const nvbf* A, const nvbf* Wt, float* C, int ldc, int N, int K, bool last, int bf16out = 0) __attribute__((always_inline)) { const int Kp = nv_rup(K, 128), Np = nv_rup(N, 256);
                Op o = mk(OP_FGEMM, (long long)M * N); o.a = (const float*)A; o.b = (const float*)Wt; o.o0 = C; o.i0 = N; o.i1 = Kp; o.i2 = Kp; o.i3 = Kp; o.i4 = ldc; o.i5 = Np; o.i6 = bf16out; if (!last) o.code |= OPF_GROUP; launch(o); };
            gg(XM6 + 0 * XMSZ, WT_WR + (size_t)j * SZ_DD, R, D, D, D, false, 1); gg(XM6 + 2 * XMSZ, WT_WK + (size_t)j * SZ_DD, K, D, D, D, false, 1); gg(XM6 + 3 * XMSZ, WT_WV + (size_t)j * SZ_DD, V, D, D, D, false, 1);
            gg(XM6 + 1 * XMSZ, WT_W1 + (size_t)j * SZ_DN, HLw, 64, 64, D, false); gg(XM6 + 4 * XMSZ, WT_A1 + (size_t)j * SZ_DN, HLa, 64, 64, D, false);
            if (j > 0) gg(XM6 + 3 * XMSZ, WT_V1 + (size_t)(j - 1) * SZ_DN, HLv, 32, 32, D, false);
            gg(XM6 + 5 * XMSZ, WT_G1 + (size_t)j * SZ_DN, HLg, 128, 128, D, true);
            auto cv = [&](const float* A, int K, nvbf* dst, int act, bool last) __attribute__((always_inline)) { Op o = mk(OP_CVT8, (long long)Mp * 16); o.a = A; o.o0 = (float*)dst; o.i0 = K; o.i1 = K; o.i2 = 128; o.i3 = act; if (last) launch(o); else nb(o); };
            cv(HLw, 64, ABw, 1, false); cv(HLa, 64, ABa, 0, false); if (j > 0) cv(HLv, 32, ABv, 0, false); cv(HLg, 128, ABg, 2, true);
            gg(ABw, WT_W2 + (size_t)j * SZ_UP, Wd, D, D, 64, false, 1); gg(ABa, WT_A2 + (size_t)j * SZ_UP, Aa, D, D, 64, false, 1); if (j > 0) gg(ABv, WT_V2 + (size_t)(j - 1) * SZ_UP, Vg, D, D, 32, false, 1); gg(ABg, WT_G2 + (size_t)j * SZ_UP, G, D, D, 128, true, 1);
            { Op o = mk(OP_WKVP, (long long)dm.NSEQ * RH * 64); o.a = R; o.b = K; o.c = Wd; o.d = Aa; o.e = V; o.f = Vg; o.g = VFIRST; o.h = PRM + (size_t)j * 6 * D; o.o0 = Y; o.o1 = p_rwkv + (size_t)j * B * RH * 4096; o.o2 = s_rwkv + (size_t)j * DB * RH * 4096;
              o.o3 = j > 0 ? KK : VFIRST; o.o4 = BON; o.o5 = (float*)(io.in[5] + (size_t)j * DB * RH * 4096); o.i0 = j > 0 ? 1 : 0; launch(o); }
            { Op o = mk(OP_POST2, (long long)M * RH); o.a = Y; o.b = G; o.c = j > 0 ? KK : VFIRST; o.d = BON; o.e = io.in[41] + (size_t)j * D; o.f = io.in[42] + (size_t)j * D; o.o0 = (float*)ABF; launch(o); }
            fgemm(WT_WO + (size_t)j * SZ_DD, MOUT, D, D, D, 1);
        }
        { Op o = mk(OP_LNRES, M); o.a = MOUT; o.b = io.in[8] + (size_t)(layer * 2 + 0) * D; o.c = io.in[9] + (size_t)(layer * 2 + 0) * D; o.o0 = X; o.o1 = (float*)ABF; o.o2 = (float*)(ABF + ABFN); launch(o); }
        off = scratch0;
        { nvbf* Q = takeh((size_t)Mp * 2048); float* SC = take((size_t)M * 2048); float* GATE = take((size_t)M * 128); float* EIDX = take((size_t)M * 128); float* TMPV = take((size_t)M * 256); float* TMPI = take((size_t)M * 256);
          float* COEF = take((size_t)M * 128);
          { Op o = mk(OP_FGEMM, (long long)M * 2048); o.a = (const float*)ABF; o.b = (const float*)(WT_WQ + (size_t)layer * SZ_WQ); o.o0 = (float*)Q; o.i0 = 2048; o.i1 = Dk; o.i2 = Dk; o.i3 = Dk; o.i4 = 2048; o.i5 = 2048; o.i6 = 1; launch(o); }
          { Op o = mk(OP_FGEMM, (long long)M * 2048); o.a = (const float*)Q; o.b = (const float*)KB; o.o0 = SC; o.i0 = 2048; o.i1 = 256; o.i2 = 2048; o.i3 = 256; o.i4 = 2048; o.i5 = 2048; o.i6 = 2; launch(o); }
          { Op o = mk(OP_TOPK2, (long long)M * 8); o.a = SC; o.b = (const float*)Q; o.c = KSUM; o.o0 = GATE; o.o1 = EIDX; o.o2 = TMPV; o.o3 = TMPI; launch(o); }
          { const int NS = D / 128; float* PART = take((size_t)NS * M * 128); float* YBUF = take(MD);
            #ifdef PROBE_EMASK
            { Op o = mk(OP_PACTS, (long long)NS * M * 128); o.a = (const float*)(ABF + ABFN); o.b = (const float*)UB; o.d = EIDX; o.o0 = PART; o.i0 = PROBE_EMASK; launch(o); }
#endif
            { Op o = mk(OP_PACTS, (long long)NS * M * 128); o.a = (const float*)(ABF + ABFN); o.b = (const float*)UB; o.d = EIDX; o.o0 = PART; o.i0 = 16383; launch(o); }
            { Op o = mk(OP_PRED, (long long)M * 32); o.a = PART; o.c = GATE; o.o0 = COEF; o.i0 = NS; launch(o); }
            { Op o = mk(OP_POUTS, (long long)MD); o.a = COEF; o.b = EIDX; o.c = (const float*)VB; o.o0 = YBUF; launch(o); }
            { Op o = mk(OP_LNRES, M); o.a = YBUF; o.b = io.in[8] + (size_t)(layer * 2 + 1) * D; o.c = io.in[9] + (size_t)(layer * 2 + 1) * D; o.o0 = X; o.o1 = (float*)ABF; launch(o); } } }
        }
    }
    { Op o = mk(OP_YOUT4, (long long)MD / 4); o.a = X; o.o0 = y_prompt; launch(o); }
    (void)y_sample;
}

#include <cstdint>
namespace pg8 {
#define PG8_LAS __attribute__((address_space(3)))
typedef unsigned short bf16_t;
typedef short bf16x8 __attribute__((ext_vector_type(8)));
typedef float f32x4 __attribute__((ext_vector_type(4)));
typedef unsigned u32x4 __attribute__((ext_vector_type(4)));
constexpr int BM = 256, BK = 64, HALF = 128, HTB = HALF * BK * 2  , STAGE_BYTES = 8 * HTB, NXCD = 8, WGM = 8;

__host__ __device__ __forceinline__ int lds_byte(int r, int c) { const int st = (r >> 4) * 2 + (c >> 5), rr = r & 15, cc = c & 31, ob = rr * 64 + cc * 2; return st * 1024 + (ob ^ (((ob >> 9) & 1) << 5)); }
__host__ __device__ __forceinline__ void stage_rc(int b, int& R, int& C) { const int st = b / 1024, sb = b % 1024, swz = sb ^ (((sb >> 9) & 1) << 5); R = (st >> 1) * 16 + swz / 64; C = (st & 1) * 32 + (swz % 64) / 2; }
__host__ __device__ __forceinline__ int perm32(int rho) { const int n = rho >> 4, i = rho & 15; return 8 * (i >> 2) + 4 * n + (i & 3); }

struct Unit { int pm, pn, grp, pad_; const char* A; const char* B; };
struct Gemm { const bf16_t* A; const bf16_t* Bt; int M, N, K, lda, ldb; };

struct StaticOrder {
    int nM, nN, nwg, G, c; const char* A; const char* B; size_t tsA, tsB, acs;
    __host__ __device__ void init(const Gemm& g, int G_, int c_) { nM = g.M / BM; nN = g.N / BM; nwg = nM * nN; G = G_; c = c_; A = (const char*)g.A; B = (const char*)g.Bt; tsA = (size_t)BM * g.lda * 2; tsB = (size_t)BM * g.ldb * 2; acs = 0; }
    __host__ __device__ bool next(int i, Unit& u) const {
        const long L = (long)i * G + c; if (L >= nwg) return false;
        int wgid = (int)L; { const int q = nwg / NXCD, r = nwg % NXCD, xcd = wgid % NXCD, off = wgid / NXCD; wgid = (xcd < r ? xcd * (q + 1) : r * (q + 1) + (xcd - r) * q) + off; }
        const int nig = WGM * nN, gid = wgid / nig, fm = gid * WGM, gsz = (nM - fm) < WGM ? (nM - fm) : WGM;
        u.pm = fm + ((wgid % nig) % gsz); u.pn = (wgid % nig) / gsz; u.grp = 0; u.pad_ = 0; u.A = A + (size_t)u.pm * tsA + (size_t)u.pn * acs; u.B = B + (size_t)u.pn * tsB; return true;
    }
    __device__ __forceinline__ void a_ready(const Unit&) const {}
    __device__ __forceinline__ void done(const Unit&) const {}
};

template <class Epi, class Sched, bool ALIGN_EPI = false, bool SP2 = false>
__device__ __forceinline__ void gemm_phase(PG8_LAS unsigned char* lds, const Gemm g, const Sched& S, const Epi& E) {
    int tid_raw = threadIdx.x; asm volatile("" : "+v"(tid_raw));
    const int tid = tid_raw, wid = __builtin_amdgcn_readfirstlane(tid >> 6), lane = tid & 63, wr = wid >> 2, wc = wid & 3, fr = lane & 15, fq = lane >> 4;
    const int K = g.K, nt = K / BK;
    unsigned voffA[2], voffB[2];
#pragma unroll
    for (int i = 0; i < 2; ++i) { int R, C; stage_rc(tid * 16 + i * 8192, R, C); const int Rb = Epi::PERM ? ((R & ~31) + perm32(R & 31)) : R;
        voffA[i] = (unsigned)(R * g.lda + C) * 2u; voffB[i] = (unsigned)(Rb * g.ldb + C) * 2u; }
    const size_t kstep = (size_t)(BK * 2);
    const size_t hstepA = (size_t)HALF * g.lda * 2, hstepB = (size_t)HALF * g.ldb * 2;
    const unsigned ldsw = (unsigned)wid * 1024u;
    const int aoff = lds_byte(wr * 64 + fr, fq * 8), boff = lds_byte(wc * 32 + fr, fq * 8);
#define PG8_SA(b, h) (((b) * 2 + (h)) * HTB)
#define PG8_SB(b, h) ((4 + (b) * 2 + (h)) * HTB)
#define PG8_STAGE(bufoff, gbase, voff) do { _Pragma("unroll") for (int _i = 0; _i < 2; ++_i) \
        __builtin_amdgcn_global_load_lds((const unsigned*)((const char*)(gbase) + (voff)[_i]), (PG8_LAS unsigned*)(lds + (bufoff) + ldsw + _i * 8192), 16, 0, 0); } while (0)
#define PG8_LDA(dst, b, h) do { _Pragma("unroll") for (int m = 0; m < 4; ++m) _Pragma("unroll") for (int k = 0; k < 2; ++k) dst[m][k] = *(const PG8_LAS bf16x8*)(lds + PG8_SA(b, h) + aoff + m * 2048 + k * 1024); } while (0)
#define PG8_LDB(dst, b, h) do { _Pragma("unroll") for (int n = 0; n < 2; ++n) _Pragma("unroll") for (int k = 0; k < 2; ++k) dst[n][k] = *(const PG8_LAS bf16x8*)(lds + PG8_SB(b, h) + boff + n * 2048 + k * 1024); } while (0)
#define PG8_MMA(ai, bj, At, Bt) do { __builtin_amdgcn_s_setprio(1); _Pragma("unroll") for (int m = 0; m < 4; ++m) _Pragma("unroll") for (int n = 0; n < 2; ++n) _Pragma("unroll") for (int k = 0; k < 2; ++k) \
        acc[ai][bj][m][n] = __builtin_amdgcn_mfma_f32_16x16x32_bf16(Bt[n][k], At[m][k], acc[ai][bj][m][n], 0, 0, 0); __builtin_amdgcn_s_setprio(0); } while (0)
#define PG8_WAIT_V(n) asm volatile("s_waitcnt vmcnt(" #n ")" ::: "memory")
#define PG8_WAIT_L(n) asm volatile("s_waitcnt lgkmcnt(" #n ")" ::: "memory")
#define PG8_BAR __builtin_amdgcn_s_barrier()
#define PG8_SCHED __builtin_amdgcn_sched_barrier(0)
    Unit cur, nxt; int ui = 0;
    if (!S.next(0, cur)) return;
    f32x4 acc[2][2][4][2];
#pragma unroll
    for (int a = 0; a < 2; ++a)
#pragma unroll
        for (int b = 0; b < 2; ++b)
#pragma unroll
            for (int m = 0; m < 4; ++m)
#pragma unroll
                for (int n = 0; n < 2; ++n) acc[a][b][m][n] = (f32x4){0.f, 0.f, 0.f, 0.f};
    bf16x8 At[4][2], B0[2][2], B1[2][2];
    const char* cA = cur.A; const char* cB = cur.B;
    S.a_ready(cur);
    if constexpr (SP2) {
        PG8_STAGE(PG8_SB(0, 0), cB, voffB); PG8_STAGE(PG8_SB(0, 1), cB + hstepB, voffB); PG8_STAGE(PG8_SA(0, 0), cA, voffA); PG8_STAGE(PG8_SA(0, 1), cA + hstepA, voffA);
        if (wr == 1) PG8_BAR;
        PG8_WAIT_V(2); PG8_BAR;
        PG8_STAGE(PG8_SB(1, 0), cB + kstep, voffB); PG8_STAGE(PG8_SA(1, 0), cA + kstep, voffA); PG8_STAGE(PG8_SB(1, 1), cB + hstepB + kstep, voffB);
        PG8_WAIT_V(6); PG8_BAR;
    } else {
        PG8_STAGE(PG8_SB(0, 0), cB, voffB); PG8_STAGE(PG8_SA(0, 0), cA, voffA); PG8_STAGE(PG8_SB(0, 1), cB + hstepB, voffB); PG8_STAGE(PG8_SA(0, 1), cA + hstepA, voffA);
        if (wr == 1) PG8_BAR;
        PG8_WAIT_V(4); PG8_BAR;
        PG8_STAGE(PG8_SB(1, 0), cB + kstep, voffB); PG8_STAGE(PG8_SA(1, 0), cA + kstep, voffA); PG8_STAGE(PG8_SB(1, 1), cB + hstepB + kstep, voffB);
        PG8_WAIT_V(6); PG8_BAR;
    }
    for (;;) {
        const bool has_next = S.next(ui + 1, nxt);
        const char* nA = has_next ? nxt.A : cA; const char* nB = has_next ? nxt.B : cB;
        for (int t = 0; t < nt; t += 2) {
            const bool last = (t == nt - 2);
            const char* a1 = cA + (size_t)(t + 1) * kstep;
            const char* a2 = last ? nA : cA + (size_t)(t + 2) * kstep; const char* b2 = last ? nB : cB + (size_t)(t + 2) * kstep;
            const char* a3 = a2 + kstep; const char* b3 = b2 + kstep;
            if (last && has_next) S.a_ready(nxt);
            if constexpr (SP2) {
            PG8_LDB(B0, 0, 0); PG8_LDB(B1, 0, 1); PG8_SCHED; PG8_LDA(At, 0, 0); PG8_STAGE(PG8_SA(1, 1), a1 + hstepA, voffA);
            PG8_WAIT_V(8); PG8_WAIT_L(0); PG8_BAR; PG8_MMA(0, 0, At, B0); PG8_MMA(0, 1, At, B1); PG8_BAR; PG8_SCHED;
            PG8_LDA(At, 0, 1); PG8_STAGE(PG8_SB(0, 0), b2, voffB); PG8_STAGE(PG8_SB(0, 1), b2 + hstepB, voffB); PG8_STAGE(PG8_SA(0, 0), a2, voffA);
            PG8_WAIT_V(8); PG8_WAIT_L(0); PG8_BAR; PG8_MMA(1, 0, At, B0); PG8_MMA(1, 1, At, B1); PG8_BAR; PG8_SCHED;
            PG8_LDB(B0, 1, 0); PG8_LDB(B1, 1, 1); PG8_SCHED; PG8_LDA(At, 1, 0); PG8_STAGE(PG8_SA(0, 1), a2 + hstepA, voffA);
            PG8_WAIT_V(8); PG8_WAIT_L(0); PG8_BAR; PG8_MMA(0, 0, At, B0); PG8_MMA(0, 1, At, B1); PG8_BAR; PG8_SCHED;
            PG8_LDA(At, 1, 1); PG8_STAGE(PG8_SB(1, 0), b3, voffB); PG8_STAGE(PG8_SB(1, 1), b3 + hstepB, voffB); PG8_STAGE(PG8_SA(1, 0), a3, voffA);
            PG8_WAIT_V(8); PG8_WAIT_L(0); PG8_BAR; PG8_MMA(1, 0, At, B0); PG8_MMA(1, 1, At, B1); PG8_BAR; PG8_SCHED;
            } else {
            PG8_LDB(B0, 0, 0); PG8_SCHED; PG8_LDA(At, 0, 0); PG8_STAGE(PG8_SA(1, 1), a1 + hstepA, voffA);
            PG8_WAIT_L(8); PG8_BAR; PG8_WAIT_L(0); PG8_MMA(0, 0, At, B0); PG8_BAR; PG8_SCHED;
            PG8_LDB(B1, 0, 1); PG8_STAGE(PG8_SB(0, 0), b2, voffB);
            PG8_BAR; PG8_WAIT_L(0); PG8_MMA(0, 1, At, B1); PG8_BAR;
            PG8_LDA(At, 0, 1); PG8_STAGE(PG8_SA(0, 0), a2, voffA);
            PG8_BAR; PG8_WAIT_L(0); PG8_MMA(1, 0, At, B0); PG8_BAR; PG8_SCHED;
            PG8_STAGE(PG8_SB(0, 1), b2 + hstepB, voffB);
            PG8_WAIT_V(6); PG8_BAR; PG8_MMA(1, 1, At, B1); PG8_BAR;
            PG8_LDB(B0, 1, 0); PG8_SCHED; PG8_LDA(At, 1, 0); PG8_STAGE(PG8_SA(0, 1), a2 + hstepA, voffA);
            PG8_WAIT_L(8); PG8_BAR; PG8_WAIT_L(0); PG8_MMA(0, 0, At, B0); PG8_BAR; PG8_SCHED;
            PG8_LDB(B1, 1, 1); PG8_STAGE(PG8_SB(1, 0), b3, voffB);
            PG8_BAR; PG8_WAIT_L(0); PG8_MMA(0, 1, At, B1); PG8_BAR;
            PG8_LDA(At, 1, 1); PG8_STAGE(PG8_SA(1, 0), a3, voffA);
            PG8_BAR; PG8_WAIT_L(0); PG8_MMA(1, 0, At, B0); PG8_BAR; PG8_SCHED;
            PG8_STAGE(PG8_SB(1, 1), b3 + hstepB, voffB);
            PG8_WAIT_V(6); PG8_BAR; PG8_MMA(1, 1, At, B1); PG8_BAR;
            }
        }
        if constexpr (ALIGN_EPI) { if (wr == 0) PG8_BAR; }
        if constexpr (!Epi::AFTER_DRAIN) { E(acc, cur, wr, wc, fr, fq); S.done(cur); }
        if (!has_next) break;
#pragma unroll
        for (int a = 0; a < 2; ++a)
#pragma unroll
            for (int b = 0; b < 2; ++b)
#pragma unroll
                for (int m = 0; m < 4; ++m)
#pragma unroll
                    for (int n = 0; n < 2; ++n) acc[a][b][m][n] = (f32x4){0.f, 0.f, 0.f, 0.f};
        cur = nxt; cA = nA; cB = nB; ++ui;
        if constexpr (ALIGN_EPI) { if (wr == 1) PG8_BAR; }
    }
    PG8_WAIT_V(0);
    if constexpr (!ALIGN_EPI) { if (wr == 0) PG8_BAR; }
    PG8_BAR;
    if constexpr (Epi::AFTER_DRAIN) { E.fused(acc, cur, wr, wc, fr, fq, lds, wid, lane); S.done(cur); }
#undef PG8_SA
#undef PG8_SB
#undef PG8_STAGE
#undef PG8_LDA
#undef PG8_LDB
#undef PG8_MMA
#undef PG8_WAIT_V
#undef PG8_WAIT_L
#undef PG8_BAR
#undef PG8_SCHED
}
}
template <class T> __device__ __forceinline__ T* uni_ptr(T* p) {
    unsigned long long v = (unsigned long long)p; unsigned lo = __builtin_amdgcn_readfirstlane((unsigned)v), hi = __builtin_amdgcn_readfirstlane((unsigned)(v >> 32));
    unsigned long long r = ((unsigned long long)hi << 32) | lo; asm volatile("" : "+s"(r)); return (T*)r; }
__device__ __forceinline__ int rfl(int x) { int t = __builtin_amdgcn_readfirstlane(x); asm volatile("" : "+s"(t)); return t; }
namespace pg8 {
__device__ __forceinline__ unsigned cvt_pk_bf16(float lo, float hi) { unsigned r; asm volatile("v_cvt_pk_bf16_f32 %0, %1, %2" : "=v"(r) : "v"(lo), "v"(hi)); return r; }
struct EpiF32 {
    static constexpr bool PERM = false, AFTER_DRAIN = false;
    float* C; int ldc, Mreal, Nreal;
    __device__ __forceinline__ void operator()(const f32x4 (&acc)[2][2][4][2], const Unit& u, int wr, int wc, int fr, int fq) const {
        const int row0 = u.pm * BM + wr * 64 + fr, col0 = u.pn * BM + wc * 32 + 4 * fq;
#pragma unroll
        for (int ai = 0; ai < 2; ++ai)
#pragma unroll
            for (int m = 0; m < 4; ++m) { const int r = row0 + ai * HALF + m * 16; if (r < Mreal) { float* rowp = C + (size_t)r * ldc + col0;
#pragma unroll
                for (int bj = 0; bj < 2; ++bj)
#pragma unroll
                    for (int n = 0; n < 2; ++n) { const int c = col0 + bj * HALF + n * 16; if (c < Nreal) *(f32x4*)(rowp + bj * HALF + n * 16) = acc[ai][bj][m][n]; } } }
    }
};
struct EpiBf16Plain {
    static constexpr bool PERM = true, AFTER_DRAIN = false;
    bf16_t* O; int ldc;
    __device__ __forceinline__ void operator()(const f32x4 (&acc)[2][2][4][2], const Unit& u, int wr, int wc, int fr, int fq) const {
        const int row0 = u.pm * BM + wr * 64 + fr, col0 = u.pn * BM + wc * 32 + 8 * fq;
#pragma unroll
        for (int ai = 0; ai < 2; ++ai)
#pragma unroll
            for (int m = 0; m < 4; ++m) { bf16_t* rowp = O + (size_t)(row0 + ai * HALF + m * 16) * ldc + col0;
#pragma unroll
                for (int bj = 0; bj < 2; ++bj) { const f32x4 v0 = acc[ai][bj][m][0], v1 = acc[ai][bj][m][1]; u32x4 w;
                    w.x = cvt_pk_bf16(v0[0], v0[1]); w.y = cvt_pk_bf16(v0[2], v0[3]); w.z = cvt_pk_bf16(v1[0], v1[1]); w.w = cvt_pk_bf16(v1[2], v1[3]);
                    *(u32x4*)(rowp + bj * HALF) = w; } }
    }
};
struct EpiLru {
    static constexpr bool PERM = false, AFTER_DRAIN = false;
    const float* ba; const float* bx; const float* spl; const float* XC; float* AT; float* BT; int Mreal;
    __device__ __forceinline__ void operator()(const f32x4 (&acc)[2][2][4][2], const Unit& u, int wr, int wc, int fr, int fq) const {
        const int row0 = u.pm * BM + wr * 64 + fr, ch0 = u.pn * 128 + wc * 32 + 4 * fq;
#pragma unroll
        for (int n = 0; n < 2; ++n) { const int c = ch0 + 16 * n; const f32x4 ba4 = *(const f32x4*)(ba + c), bx4 = *(const f32x4*)(bx + c), sp4 = *(const f32x4*)(spl + c);
#pragma unroll
            for (int ai = 0; ai < 2; ++ai)
#pragma unroll
                for (int m = 0; m < 4; ++m) { const int r = row0 + ai * HALF + m * 16; if (r < Mreal) { const f32x4 xc = *(const f32x4*)(XC + (size_t)r * 512 + c); const f32x4 ga = acc[ai][0][m][n] + ba4, gx = acc[ai][1][m][n] + bx4; f32x4 at, bt;
#pragma unroll
                    for (int i = 0; i < 4; ++i) { const float gate_a = __builtin_amdgcn_rcpf(1.f + __expf(-ga[i])), gate_x = __builtin_amdgcn_rcpf(1.f + __expf(-gx[i])); const float la = gate_a * sp4[i]; at[i] = __expf(la); bt[i] = sqrtf(-expm1f(2.f * la)) * (gate_x * xc[i]); }
                    *(f32x4*)(AT + (size_t)r * 512 + c) = at; *(f32x4*)(BT + (size_t)r * 512 + c) = bt; } } }
    }
};
struct GroupOrder {
    const PG8_LAS Op* tab; int ng, nM, G, c; size_t tsA, tsB;
    __device__ __forceinline__ bool next(int i, Unit& u) const {
        int L = i * G + c, g = 0;
        for (; g < ng; ++g) { const int cnt = nM * (__builtin_amdgcn_readfirstlane(tab[g].i5) >> 8); if (L < cnt) break; L -= cnt; }
        if (g >= ng) return false;
        u.pm = L % nM; u.pn = L / nM; u.grp = g; u.pad_ = 0;
        u.A = (const char*)uni_ptr(tab[g].a) + (size_t)u.pm * tsA; u.B = (const char*)uni_ptr(tab[g].b) + (size_t)u.pn * tsB; return true;
    }
    __device__ __forceinline__ void a_ready(const Unit&) const {}
    __device__ __forceinline__ void done(const Unit&) const {}
};
struct EpiGroup {
    static constexpr bool PERM = true, AFTER_DRAIN = false;
    const PG8_LAS Op* tab; int Mreal;
    __device__ __forceinline__ void operator()(const f32x4 (&acc)[2][2][4][2], const Unit& u, int wr, int wc, int fr, int fq) const {
        const int ldc = rfl(tab[u.grp].i4), Nreal = rfl(tab[u.grp].i0), fl = rfl(tab[u.grp].i6);
        if (fl & 1) { const EpiBf16Plain E{(bf16_t*)uni_ptr(tab[u.grp].o0), ldc}; E(acc, u, wr, wc, fr, fq); return; }
        float* C = uni_ptr(tab[u.grp].o0); const int row0 = u.pm * BM + wr * 64 + fr, col0 = u.pn * BM + wc * 32 + 8 * fq;
#pragma unroll
        for (int ai = 0; ai < 2; ++ai)
#pragma unroll
            for (int m = 0; m < 4; ++m) { const int r = row0 + ai * HALF + m * 16; if (r < Mreal) { float* rowp = C + (size_t)r * ldc + col0;
#pragma unroll
                for (int bj = 0; bj < 2; ++bj) { if (col0 + bj * HALF < Nreal) { *(f32x4*)(rowp + bj * HALF) = acc[ai][bj][m][0]; *(f32x4*)(rowp + bj * HALF + 4) = acc[ai][bj][m][1]; } } } }
    }
};
}

#define XB_TMO      128
#define XB_XCNT(j)  (256  + 64 * (j))
#define XB_XSUB(j)  (1280 + 64 * (j))
#define XB_XGEN(j)  (2304 + 64 * (j))
#define XB_TOP      3328
#define XB_TOPGEN   3392
#define XCD_BAR_WORDS 3456
#define XB_SPIN_CAP (1u << 18)
#define LAS __attribute__((address_space(3)))
__device__ __forceinline__ unsigned xb_ld(unsigned* p)              { return __hip_atomic_load(p, __ATOMIC_RELAXED, __HIP_MEMORY_SCOPE_AGENT); }
__device__ __forceinline__ unsigned xb_add(unsigned* p, unsigned v) { return __hip_atomic_fetch_add(p, v, __ATOMIC_RELAXED, __HIP_MEMORY_SCOPE_AGENT); }
__device__ __forceinline__ unsigned xb_xcc_id() { return (unsigned)__builtin_amdgcn_s_getreg((3 << 11) | 20) & 0xFu; }
#define XB_SPIN(cond, bar) do { unsigned _sp = 0; while (cond) { __builtin_amdgcn_s_sleep(1); \
    if ((++_sp & 255u) == 0u) { if (xb_ld(&(bar)[XB_TMO])) break; if (_sp > XB_SPIN_CAP) { atomicAdd(&(bar)[XB_TMO], 1u); break; } } } } while (0)
struct XcdBarrier { unsigned* bar; unsigned x; volatile LAS unsigned* st; };
__device__ __forceinline__ XcdBarrier xcd_barrier_post(unsigned* bar, volatile LAS unsigned* st) {
    XcdBarrier b; b.bar = bar; b.x = xb_xcc_id(); b.st = st;
    if (threadIdx.x == 0) (void)xb_add(&bar[XB_XCNT(b.x)], 1u);
    return b;
}
__device__ __forceinline__ void xcd_barrier_complete(unsigned* bar, unsigned x, unsigned& nloc, unsigned& nx) {
    const unsigned G = gridDim.x * gridDim.y * gridDim.z;
    unsigned sum, cnt, mine, sp = 0u;
    for (;;) {
        sum = 0u; cnt = 0u; mine = 0u;
#pragma unroll
        for (unsigned j = 0; j < 16; ++j) { const unsigned c = xb_ld(&bar[XB_XCNT(j)]); sum += c; cnt += (c > 0u) ? 1u : 0u; mine = (j == x) ? c : mine; }
        if (sum == G) break;
        __builtin_amdgcn_s_sleep(1);
        if ((++sp & 255u) == 0u) { if (xb_ld(&bar[XB_TMO])) break; if (sp > XB_SPIN_CAP) { atomicAdd(&bar[XB_TMO], 1u); break; } }
    }
    nloc = mine > 0u ? mine : 1u; nx = cnt > 0u ? cnt : 1u;
}
__device__ __forceinline__ void xcd_barrier(const XcdBarrier& b) {
    asm volatile("s_waitcnt vmcnt(0)" ::: "memory");
    __syncthreads();
    if (threadIdx.x == 0) {
        unsigned* bar = b.bar;
        __builtin_amdgcn_s_waitcnt(0);
        unsigned nloc = b.st[0], nx = b.st[1];
        if (nloc == 0u) { xcd_barrier_complete(bar, b.x, nloc, nx); b.st[0] = nloc; b.st[1] = nx; }
        const unsigned old = xb_add(&bar[XB_XSUB(b.x)], 1u);
        const unsigned gen = old / nloc;
        if (old + 1u == (gen + 1u) * nloc) {
            __builtin_amdgcn_fence(__ATOMIC_RELEASE, "agent");
            asm volatile("s_waitcnt vmcnt(0)" ::: "memory");
            const unsigned og = xb_add(&bar[XB_TOP], 1u);
            const unsigned tg = og / nx;
            if (og + 1u == (tg + 1u) * nx) xb_add(&bar[XB_TOPGEN], 1u);
            else XB_SPIN(xb_ld(&bar[XB_TOPGEN]) == tg, bar);
            __builtin_amdgcn_fence(__ATOMIC_ACQUIRE, "agent");
            xb_add(&bar[XB_XGEN(b.x)], 1u);
            asm volatile("s_waitcnt vmcnt(0)" ::: "memory");
        } else {
            XB_SPIN(xb_ld(&bar[XB_XGEN(b.x)]) == gen, bar);
            __builtin_amdgcn_fence(__ATOMIC_ACQUIRE, "agent");
            asm volatile("s_waitcnt vmcnt(0)" ::: "memory");
        }
    }
    __syncthreads();
}

namespace fk {
#define GAS __attribute__((address_space(1)))
typedef unsigned u32x4 __attribute__((ext_vector_type(4)));
typedef unsigned u32x2 __attribute__((ext_vector_type(2)));
typedef float f32x4 __attribute__((ext_vector_type(4)));
typedef float f32x2 __attribute__((ext_vector_type(2)));
typedef __bf16 bf2 __attribute__((ext_vector_type(2)));
typedef unsigned short bf16_t;
__device__ __forceinline__ float bflo(unsigned u) { return __uint_as_float(u << 16); }
__device__ __forceinline__ float bfhi(unsigned u) { return __uint_as_float(u & 0xffff0000u); }
__device__ __forceinline__ float dot2(unsigned a, unsigned b, float c) { return __builtin_amdgcn_fdot2_f32_bf16(__builtin_bit_cast(bf2, a), __builtin_bit_cast(bf2, b), c, false); }
__device__ __forceinline__ unsigned pk_bf16(float lo, float hi) { unsigned r; asm volatile("v_cvt_pk_bf16_f32 %0, %1, %2" : "=v"(r) : "v"(lo), "v"(hi)); return r; }
template <int CTRL> __device__ __forceinline__ float dppf(float v) { return __int_as_float(__builtin_amdgcn_update_dpp(0, __float_as_int(v), CTRL, 0xf, 0xf, true)); }
__device__ __forceinline__ float row_max16(float v) { v = fmaxf(v, dppf<0xB1>(v)); v = fmaxf(v, dppf<0x4E>(v)); v = fmaxf(v, dppf<0x141>(v)); v = fmaxf(v, dppf<0x140>(v)); return v; }
__device__ __forceinline__ float frcp(float x) { return __builtin_amdgcn_rcpf(x); }
__device__ __forceinline__ float fsqrt(float x) { return __builtin_amdgcn_sqrtf(x); }
__device__ __forceinline__ float row_sum8(float v) { v += dppf<0xB1>(v); v += dppf<0x4E>(v); v += dppf<0x141>(v); return v; }
__device__ __forceinline__ float row_sum16(float v) { v += dppf<0xB1>(v); v += dppf<0x4E>(v); v += dppf<0x141>(v); v += dppf<0x140>(v); return v; }
__device__ __forceinline__ float shx(float v, int m, int lane) { return __int_as_float(__builtin_amdgcn_ds_bpermute((lane ^ m) << 2, __float_as_int(v))); }
__device__ __forceinline__ float wave_sum(float v, int lane) { v = row_sum16(v); v += shx(v, 16, lane); v += shx(v, 32, lane); return v; }
__device__ __forceinline__ float gelu_tanh(float x) { return 0.5f * x * (1.f + tanhf(0.7978845608028654f * (x + 0.044715f * x * x * x))); }
#define FK_NEG (-3.0e38f)

template <int CTRL> __device__ __forceinline__ int dppi(int v) { return __builtin_amdgcn_update_dpp(0, v, CTRL, 0xf, 0xf, true); }
__device__ __forceinline__ int row_min16i(int v) { v = min(v, dppi<0xB1>(v)); v = min(v, dppi<0x4E>(v)); v = min(v, dppi<0x141>(v)); v = min(v, dppi<0x140>(v)); return v; }
#define FK_CE(a, b) do { const bool sw_ = v[b] > v[a]; const float tv_ = sw_ ? v[b] : v[a]; v[b] = sw_ ? v[a] : v[b]; v[a] = tv_; const int ti_ = sw_ ? id[b] : id[a]; id[b] = sw_ ? id[a] : id[b]; id[a] = ti_; } while (0)
#define FK_SORT8(v, id) do { FK_CE2(v, id, 0, 1); FK_CE2(v, id, 2, 3); FK_CE2(v, id, 4, 5); FK_CE2(v, id, 6, 7); FK_CE2(v, id, 0, 2); FK_CE2(v, id, 1, 3); FK_CE2(v, id, 4, 6); FK_CE2(v, id, 5, 7); FK_CE2(v, id, 1, 2); FK_CE2(v, id, 5, 6); \
    FK_CE2(v, id, 0, 4); FK_CE2(v, id, 1, 5); FK_CE2(v, id, 2, 6); FK_CE2(v, id, 3, 7); FK_CE2(v, id, 2, 4); FK_CE2(v, id, 3, 5); FK_CE2(v, id, 1, 2); FK_CE2(v, id, 3, 4); FK_CE2(v, id, 5, 6); } while (0)
#define FK_CE2(v, id, a, b) do { const bool sw_ = v[b] > v[a]; const float tv_ = sw_ ? v[b] : v[a]; v[b] = sw_ ? v[a] : v[b]; v[a] = tv_; const int ti_ = sw_ ? id[b] : id[a]; id[b] = sw_ ? id[a] : id[b]; id[a] = ti_; } while (0)
__device__ __forceinline__ void top16_of_128_x2(float (&v)[8], int (&id)[8], float (&u)[8], int (&jd)[8], int lane16, float& rv1, int& ri1, float& rv2, int& ri2) {
    FK_SORT8(v, id); FK_SORT8(u, jd);
    rv1 = FK_NEG; ri1 = 0; rv2 = FK_NEG; ri2 = 0;
#pragma unroll
    for (int r = 0; r < 16; ++r) {
        const float wm = row_max16(v[0]), xm = row_max16(u[0]);
        const int cand = (v[0] == wm) ? id[0] : 0x7fffffff, dand = (u[0] == xm) ? jd[0] : 0x7fffffff;
        const int sel = row_min16i(cand), tel = row_min16i(dand);
        const bool mine = (cand == sel), nine = (dand == tel);
        if (lane16 == r) { rv1 = wm; ri1 = sel; rv2 = xm; ri2 = tel; }
#pragma unroll
        for (int i = 0; i < 7; ++i) { v[i] = mine ? v[i + 1] : v[i]; id[i] = mine ? id[i + 1] : id[i]; u[i] = nine ? u[i + 1] : u[i]; jd[i] = nine ? jd[i + 1] : jd[i]; }
        v[7] = mine ? FK_NEG : v[7]; u[7] = nine ? FK_NEG : u[7];
    }
}
__device__ __forceinline__ int fk_key(float x, int lane16) { int k = __float_as_int(x); k ^= (k >> 31) & 0x7fffffff; return (k & ~15) | (15 - lane16); }
__device__ __forceinline__ float fk_unkey(int k) { k &= ~15; k ^= (k >> 31) & 0x7fffffff; return __int_as_float(k); }
__device__ __forceinline__ int row_max16i(int v) { v = max(v, dppi<0xB1>(v)); v = max(v, dppi<0x4E>(v)); v = max(v, dppi<0x141>(v)); v = max(v, dppi<0x140>(v)); return v; }
__device__ __forceinline__ void topk_phase(const GAS float* __restrict__ SC, const GAS bf16_t* __restrict__ Q, const GAS float* __restrict__ KSUM, GAS float* __restrict__ GATE, GAS int* __restrict__ EIDX, int nitems,
                                           LAS unsigned char* lds, int wid, int lane, int wave_gid, int nwaves) {
    LAS unsigned char* wb = lds + wid * 6144;
    LAS int* IDS1 = (LAS int*)wb; LAS int* IDS2 = (LAS int*)(wb + 2048); LAS int* LC1 = (LAS int*)(wb + 4096); LAS int* LC2 = (LAS int*)(wb + 4352); LAS int* CI = (LAS int*)(wb + 4608);
    LAS float* xv = (LAS float*)(wb + 4864); LAS int* DUMP = (LAS int*)(wb + 5120) + lane; LAS int* WL1 = (LAS int*)(wb + 5376); LAS int* WL2 = (LAS int*)(wb + 5632);
    const int lane16 = lane & 15, rowbase = lane & 48;
    u32x4 nqa, nqb; f32x4 ns0, ns1, nt0, nt1;
#define TK_LOAD(wi_) do { int it_ = (wi_) * 4 + (lane >> 4); it_ = it_ < nitems ? it_ : nitems - 1; const GAS u32x4* qp_ = (const GAS u32x4*)(Q + (size_t)it_ * 256 + 16 * lane16); nqa = qp_[0]; nqb = qp_[1]; \
        const GAS float* sp_ = SC + (size_t)it_ * 256 + 8 * lane16; ns0 = *(const GAS f32x4*)sp_; ns1 = *(const GAS f32x4*)(sp_ + 4); nt0 = *(const GAS f32x4*)(sp_ + 128); nt1 = *(const GAS f32x4*)(sp_ + 132); } while (0)
    TK_LOAD(wave_gid);
    const GAS float* kp = KSUM + ((wave_gid * 4 + (lane >> 4)) & 7) * 256 + 8 * lane16; const f32x4 k0 = *(const GAS f32x4*)kp, k1 = *(const GAS f32x4*)(kp + 4), m0 = *(const GAS f32x4*)(kp + 128), m1 = *(const GAS f32x4*)(kp + 132);
    for (int wi = wave_gid; wi * 4 < nitems; wi += nwaves) {
        const int it = wi * 4 + (lane >> 4);
        const u32x4 qa = nqa, qb = nqb; const f32x4 s0 = ns0, s1 = ns1, t0 = nt0, t1 = nt1;
        TK_LOAD(wi + nwaves);
        float qs = 0.f, qq = 0.f;
#pragma unroll
        for (int i = 0; i < 4; ++i) { const float a = bflo(qa[i]), b = bfhi(qa[i]), c = bflo(qb[i]), d = bfhi(qb[i]); qs += (a + b) + (c + d); qq += (a * a + b * b) + (c * c + d * d); }
        const float mu = row_sum16(qs) * (1.f / 256.f); const float var = fmaxf(row_sum16(qq) * (1.f / 256.f) - mu * mu, 0.f); const float rs = 1.f / sqrtf(var + 1e-5f);
        float v[8], u[8]; int id[8], jd[8];
        {
#pragma unroll
          for (int i = 0; i < 4; ++i) { v[i] = rs * (s0[i] - mu * k0[i]); v[4 + i] = rs * (s1[i] - mu * k1[i]); u[i] = rs * (t0[i] - mu * m0[i]); u[4 + i] = rs * (t1[i] - mu * m1[i]);
              id[i] = 8 * lane16 + i; id[4 + i] = 8 * lane16 + 4 + i; jd[i] = 8 * lane16 + i; jd[4 + i] = 8 * lane16 + 4 + i; } }
        FK_SORT8(v, id); FK_SORT8(u, jd);
#pragma unroll
        for (int i = 0; i < 8; ++i) { IDS1[lane * 8 + i] = id[i]; IDS2[lane * 8 + i] = jd[i]; }
        float rv1 = FK_NEG, rv2 = FK_NEG; int wl1 = 0, wl2 = 0, cn1 = 0, cn2 = 0;
#pragma unroll
        for (int r = 0; r < 16; ++r) {
            const int key1 = fk_key(v[0], lane16), key2 = fk_key(u[0], lane16);
            const int wm1 = row_max16i(key1), wm2 = row_max16i(key2);
            const bool mine = (key1 == wm1), nine = (key2 == wm2);
            if (lane16 == r) { rv1 = fk_unkey(wm1); wl1 = 15 - (wm1 & 15); rv2 = fk_unkey(wm2); wl2 = 15 - (wm2 & 15); }
            *(mine ? LC1 + rowbase + r : DUMP) = cn1; *(nine ? LC2 + rowbase + r : DUMP) = cn2;
#pragma unroll
            for (int i = 0; i < 7; ++i) { v[i] = mine ? v[i + 1] : v[i]; u[i] = nine ? u[i + 1] : u[i]; }
            v[7] = mine ? FK_NEG : v[7]; u[7] = nine ? FK_NEG : u[7]; cn1 += mine ? 1 : 0; cn2 += nine ? 1 : 0;
        }
        xv[lane] = rv2; WL1[lane] = wl1; WL2[lane] = wl2;
        float c[16];
        { const LAS f32x4* xp = (const LAS f32x4*)(xv + rowbase);
#pragma unroll
          for (int q = 0; q < 4; ++q) { const f32x4 t = xp[q]; c[4 * q] = rv1 + t.x; c[4 * q + 1] = rv1 + t.y; c[4 * q + 2] = rv1 + t.z; c[4 * q + 3] = rv1 + t.w; } }
        int p = 0, wli = 0; float sc = FK_NEG;
#pragma unroll
        for (int r = 0; r < 16; ++r) {
            const int key = fk_key(c[0], lane16); const int wm = row_max16i(key); const bool mine = (key == wm);
            if (lane16 == r) { sc = fk_unkey(wm); wli = 15 - (wm & 15); }
            *(mine ? CI + rowbase + r : DUMP) = p;
#pragma unroll
            for (int i = 0; i < 15; ++i) c[i] = mine ? c[i + 1] : c[i];
            c[15] = mine ? FK_NEG : c[15]; p += mine ? 1 : 0;
        }
        const int i1 = wli & 15, j2 = CI[rowbase + lane16] & 15;
        const int e1 = IDS1[(rowbase + (WL1[rowbase + i1] & 15)) * 8 + (LC1[rowbase + i1] & 7)], e2 = IDS2[(rowbase + (WL2[rowbase + j2] & 15)) * 8 + (LC2[rowbase + j2] & 7)];
        const float mx = fk_unkey(row_max16i(fk_key(sc, 0))); const float ex = __expf(sc - mx); const float den = row_sum16(ex);
        GATE[(size_t)it * 16 + lane16] = ex / den; EIDX[(size_t)it * 16 + lane16] = (e1 & 127) * 128 + (e2 & 127);
    }
#undef TK_LOAD
}

__device__ __forceinline__ f32x2 fp8lo(unsigned w) { return __builtin_amdgcn_cvt_pk_f32_fp8((int)w, false); }
__device__ __forceinline__ f32x2 fp8hi(unsigned w) { return __builtin_amdgcn_cvt_pk_f32_fp8((int)w, true); }
__device__ __forceinline__ void act_phase(const GAS bf16_t* __restrict__ XB, const GAS unsigned char* __restrict__ U8, const GAS float* __restrict__ GATE, const GAS int* __restrict__ EIDX, GAS float* __restrict__ COEF, int nitems,
                                          int lane, int wave_gid, int nwaves) {
    int it = wave_gid; if (it >= nitems) return;
    u32x4 uc[16], un[16], xac, xbc, xan, xbn;
    int evc = EIDX[(size_t)it * 16 + (lane & 15)];
    { const GAS u32x4* xp = (const GAS u32x4*)(XB + (size_t)(it >> 3) * 1024 + 16 * lane); xac = xp[0]; xbc = xp[1]; }
#pragma unroll
    for (int k = 0; k < 16; ++k) uc[k] = *(const GAS u32x4*)(U8 + (size_t)__builtin_amdgcn_readlane(evc, k) * 1024 + 16 * lane);
    int itn = it + nwaves; int evn = (itn < nitems) ? EIDX[(size_t)itn * 16 + (lane & 15)] : 0;
    for (;;) {
        const bool hasn = itn < nitems;
        if (hasn) {
            const GAS u32x4* xp = (const GAS u32x4*)(XB + (size_t)(itn >> 3) * 1024 + 16 * lane); xan = xp[0]; xbn = xp[1];
#pragma unroll
            for (int k = 0; k < 16; ++k) un[k] = *(const GAS u32x4*)(U8 + (size_t)__builtin_amdgcn_readlane(evn, k) * 1024 + 16 * lane);
        }
        const int itnn = itn + nwaves; const int evnn = (itnn < nitems) ? EIDX[(size_t)itnn * 16 + (lane & 15)] : 0;
        const float gt = GATE[(size_t)it * 16 + (lane >> 2)];
        float x[16];
#pragma unroll
        for (int i = 0; i < 4; ++i) { x[2 * i] = bflo(xac[i]); x[2 * i + 1] = bfhi(xac[i]); x[8 + 2 * i] = bflo(xbc[i]); x[8 + 2 * i + 1] = bfhi(xbc[i]); }
        float a[16];
#pragma unroll
        for (int k = 0; k < 16; ++k) { const u32x4 uw = uc[k]; float s = 0.f;
#pragma unroll
            for (int d = 0; d < 4; ++d) { const f32x2 lo = fp8lo(uw[d]), hi = fp8hi(uw[d]); s = fmaf(lo.x, x[4 * d], s); s = fmaf(lo.y, x[4 * d + 1], s); s = fmaf(hi.x, x[4 * d + 2], s); s = fmaf(hi.y, x[4 * d + 3], s); }
            asm volatile("" : "+v"(s)); a[k] = s; }
#pragma unroll
        for (int k = 0; k < 8; ++k) { const bool hi = lane & 32; const float send = hi ? a[k] : a[k + 8], keep = hi ? a[k + 8] : a[k]; a[k] = keep + shx(send, 32, lane); }
#pragma unroll
        for (int k = 0; k < 4; ++k) { const bool hi = lane & 16; const float send = hi ? a[k] : a[k + 4], keep = hi ? a[k + 4] : a[k]; a[k] = keep + shx(send, 16, lane); }
#pragma unroll
        for (int k = 0; k < 2; ++k) { const bool hi = lane & 8; const float send = hi ? a[k] : a[k + 2], keep = hi ? a[k + 2] : a[k]; a[k] = keep + shx(send, 8, lane); }
        { const bool hi = lane & 4; const float send = hi ? a[0] : a[1], keep = hi ? a[1] : a[0]; a[0] = keep + shx(send, 4, lane); }
        float dsum = a[0]; dsum += shx(dsum, 2, lane); dsum += shx(dsum, 1, lane);
        if ((lane & 3) == 0) COEF[(size_t)it * 16 + (lane >> 2)] = gt * gelu_tanh(dsum * (1.f / 128.f));
        if (!hasn) break;
#pragma unroll
        for (int k = 0; k < 16; ++k) uc[k] = un[k];
        xac = xan; xbc = xbn; evc = evn; evn = evnn; it = itn; itn = itnn;
    }
}

__device__ __forceinline__ void outln_phase(const GAS float* COEF, const GAS int* EIDX, const GAS unsigned char* V8,     const GAS float* __restrict__ lg, const GAS float* __restrict__ lb, GAS float* X, GAS bf16_t* XB, int nrows,
                                            int lane, int wave_gid, int nwaves) {
    const float alpha = 1.6817928305074292f;
    int row = wave_gid; if (row >= nrows) return;
    u32x4 vc[16], vn[16];
    float cf0 = COEF[(size_t)row * 128 + lane] * (1.f / 64.f), cf1 = COEF[(size_t)row * 128 + 64 + lane] * (1.f / 64.f); int ev0 = EIDX[(size_t)row * 128 + lane], ev1 = EIDX[(size_t)row * 128 + 64 + lane];
#define OUT_LOADCH(dst, evreg, base) do { _Pragma("unroll") for (int k_ = 0; k_ < 16; ++k_) dst[k_] = *(const GAS u32x4*)(V8 + (size_t)__builtin_amdgcn_readlane(evreg, (base) + k_) * 1024 + 16 * lane); } while (0)
#define OUT_COMPCH(src, cfreg, base) do { _Pragma("unroll") for (int k_ = 0; k_ < 16; ++k_) { const float c_ = __int_as_float(__builtin_amdgcn_readlane(__float_as_int(cfreg), (base) + k_)); const u32x4 vw_ = src[k_]; \
        _Pragma("unroll") for (int d_ = 0; d_ < 4; ++d_) { const f32x2 lo_ = fp8lo(vw_[d_]), hi_ = fp8hi(vw_[d_]); acc[4 * d_] = fmaf(c_, lo_.x, acc[4 * d_]); acc[4 * d_ + 1] = fmaf(c_, lo_.y, acc[4 * d_ + 1]); acc[4 * d_ + 2] = fmaf(c_, hi_.x, acc[4 * d_ + 2]); acc[4 * d_ + 3] = fmaf(c_, hi_.y, acc[4 * d_ + 3]); } \
        _Pragma("unroll") for (int p_ = 0; p_ < 16; ++p_) asm volatile("" : "+v"(acc[p_]));     \
        } } while (0)
    for (;;) {
        OUT_LOADCH(vc, ev0, 0);
        const int rown = row + nwaves; const bool hasn = rown < nrows;
        float ncf0 = 0.f, ncf1 = 0.f; int nev0 = 0, nev1 = 0;
        if (hasn) { ncf0 = COEF[(size_t)rown * 128 + lane] * (1.f / 64.f); ncf1 = COEF[(size_t)rown * 128 + 64 + lane] * (1.f / 64.f); nev0 = EIDX[(size_t)rown * 128 + lane]; nev1 = EIDX[(size_t)rown * 128 + 64 + lane]; }
        float acc[16];
#pragma unroll
        for (int k = 0; k < 16; ++k) acc[k] = 0.f;
#define OUT_FENCE() asm volatile("" ::: "memory")
        OUT_LOADCH(vn, ev0, 16); OUT_FENCE(); OUT_COMPCH(vc, cf0, 0); OUT_FENCE();
        OUT_LOADCH(vc, ev0, 32); OUT_FENCE(); OUT_COMPCH(vn, cf0, 16); OUT_FENCE();
        OUT_LOADCH(vn, ev0, 48); OUT_FENCE(); OUT_COMPCH(vc, cf0, 32); OUT_FENCE();
        OUT_LOADCH(vc, ev1, 0);  OUT_FENCE(); OUT_COMPCH(vn, cf0, 48); OUT_FENCE();
        OUT_LOADCH(vn, ev1, 16); OUT_FENCE(); OUT_COMPCH(vc, cf1, 0); OUT_FENCE();
        OUT_LOADCH(vc, ev1, 32); OUT_FENCE(); OUT_COMPCH(vn, cf1, 16); OUT_FENCE();
        OUT_LOADCH(vn, ev1, 48); OUT_FENCE(); OUT_COMPCH(vc, cf1, 32); OUT_FENCE();
        OUT_COMPCH(vn, cf1, 48); OUT_FENCE();
#undef OUT_FENCE
        GAS float* xr = X + (size_t)row * 1024 + 16 * lane; float t[16];
#pragma unroll
        for (int q = 0; q < 4; ++q) { const f32x4 xv = *(const GAS f32x4*)(xr + 4 * q); t[4 * q] = fmaf(alpha, xv.x, acc[4 * q]); t[4 * q + 1] = fmaf(alpha, xv.y, acc[4 * q + 1]); t[4 * q + 2] = fmaf(alpha, xv.z, acc[4 * q + 2]); t[4 * q + 3] = fmaf(alpha, xv.w, acc[4 * q + 3]); }
        float s = 0.f;
#pragma unroll
        for (int k = 0; k < 16; ++k) s += t[k];
        const float mu = wave_sum(s, lane) * (1.f / 1024.f); float vs = 0.f;
#pragma unroll
        for (int k = 0; k < 16; ++k) { t[k] -= mu; vs = fmaf(t[k], t[k], vs); }
        const float rs = 1.f / sqrtf(wave_sum(vs, lane) * (1.f / 1024.f) + 1e-5f);
        unsigned w[8];
#pragma unroll
        for (int q = 0; q < 4; ++q) { const f32x4 g = *(const GAS f32x4*)(lg + 16 * lane + 4 * q), b = *(const GAS f32x4*)(lb + 16 * lane + 4 * q); f32x4 o;
            o.x = t[4 * q] * rs * g.x + b.x; o.y = t[4 * q + 1] * rs * g.y + b.y; o.z = t[4 * q + 2] * rs * g.z + b.z; o.w = t[4 * q + 3] * rs * g.w + b.w;
            *(GAS f32x4*)(xr + 4 * q) = o; w[2 * q] = pk_bf16(o.x, o.y); w[2 * q + 1] = pk_bf16(o.z, o.w); }
        u32x4 w0, w1; w0.x = w[0]; w0.y = w[1]; w0.z = w[2]; w0.w = w[3]; w1.x = w[4]; w1.y = w[5]; w1.z = w[6]; w1.w = w[7];
        GAS u32x4* xbp = (GAS u32x4*)(XB + (size_t)row * 1024 + 16 * lane); xbp[0] = w0; xbp[1] = w1;
        if (!hasn) break;
        row = rown; cf0 = ncf0; cf1 = ncf1; ev0 = nev0; ev1 = nev1;
    }
#undef OUT_LOADCH
#undef OUT_COMPCH
}

__device__ __forceinline__ void lnres_phase(const GAS bf16_t* __restrict__ Y, const GAS float* __restrict__ lg, const GAS float* __restrict__ lb, GAS float* X, GAS bf16_t* XB, GAS unsigned char* XF8, int nrows, int lane, int wave_gid, int nwaves) {
    const float alpha = 1.6817928305074292f;
    for (int row = wave_gid; row < nrows; row += nwaves) {
        GAS float* xr = X + (size_t)row * 1024; const GAS bf16_t* yr = Y + (size_t)row * 1024; float t[16];
#pragma unroll
        for (int q = 0; q < 4; ++q) { const f32x4 xv = *(const GAS f32x4*)(xr + 256 * q + 4 * lane); const u32x2 yw = *(const GAS u32x2*)(yr + 256 * q + 4 * lane);
            t[4 * q] = fmaf(alpha, xv.x, bflo(yw.x)); t[4 * q + 1] = fmaf(alpha, xv.y, bfhi(yw.x)); t[4 * q + 2] = fmaf(alpha, xv.z, bflo(yw.y)); t[4 * q + 3] = fmaf(alpha, xv.w, bfhi(yw.y)); }
        float s = 0.f;
#pragma unroll
        for (int k = 0; k < 16; ++k) s += t[k];
        const float mu = wave_sum(s, lane) * (1.f / 1024.f); float vs = 0.f;
#pragma unroll
        for (int k = 0; k < 16; ++k) { t[k] -= mu; vs = fmaf(t[k], t[k], vs); }
        const float rs = 1.f / sqrtf(wave_sum(vs, lane) * (1.f / 1024.f) + 1e-5f);
#pragma unroll
        for (int q = 0; q < 4; ++q) { const int c = 256 * q + 4 * lane; const f32x4 g = *(const GAS f32x4*)(lg + c), b = *(const GAS f32x4*)(lb + c); f32x4 o;
            o.x = t[4 * q] * rs * g.x + b.x; o.y = t[4 * q + 1] * rs * g.y + b.y; o.z = t[4 * q + 2] * rs * g.z + b.z; o.w = t[4 * q + 3] * rs * g.w + b.w;
            *(GAS f32x4*)(xr + c) = o; u32x2 w; w.x = pk_bf16(o.x, o.y); w.y = pk_bf16(o.z, o.w); *(GAS u32x2*)(XB + (size_t)row * 1024 + c) = w;
            if (XF8) {
                const float s0 = __builtin_amdgcn_fmed3f(o.x * 16.f, -448.f, 448.f), s1 = __builtin_amdgcn_fmed3f(o.y * 16.f, -448.f, 448.f), s2 = __builtin_amdgcn_fmed3f(o.z * 16.f, -448.f, 448.f), s3 = __builtin_amdgcn_fmed3f(o.w * 16.f, -448.f, 448.f);
                int hp = __builtin_amdgcn_cvt_pk_fp8_f32(s0, s1, 0, false); hp = __builtin_amdgcn_cvt_pk_fp8_f32(s2, s3, hp, true);
                const f32x2 d01 = fp8lo((unsigned)hp), d23 = fp8hi((unsigned)hp);
                int lp = __builtin_amdgcn_cvt_pk_fp8_f32(s0 - d01.x, s1 - d01.y, 0, false); lp = __builtin_amdgcn_cvt_pk_fp8_f32(s2 - d23.x, s3 - d23.y, lp, true);
                *(GAS int*)(XF8 + (size_t)row * 2048 + c) = hp; *(GAS int*)(XF8 + (size_t)row * 2048 + 1024 + c) = lp; } }
    }
}

__device__ __forceinline__ void glanorm_phase(const GAS float* __restrict__ O, const GAS float* __restrict__ PROJ, const GAS float* __restrict__ gnorm, GAS bf16_t* XB, int nitems, int lane, int wave_gid, int nwaves) {
    const float g0 = gnorm[lane], g1 = gnorm[64 + lane];
    for (int it0 = wave_gid * 4; it0 < nitems; it0 += nwaves * 4) {
        float a0[4], a1[4], r0[4], r1[4];
#pragma unroll
        for (int q = 0; q < 4; ++q) { int it = it0 + q; it = it < nitems ? it : it0; const int row = it >> 2, h = it & 3; const GAS float* o = O + (size_t)row * 512 + h * 128; const GAS float* r = PROJ + (size_t)row * 2576 + 1040 + h * 128;
            a0[q] = o[lane]; a1[q] = o[64 + lane]; r0[q] = r[lane]; r1[q] = r[64 + lane]; }
#pragma unroll
        for (int q = 0; q < 4; ++q) { const int it = it0 + q; const int row = it >> 2, h = it & 3;
            const float rs = 1.f / sqrtf(wave_sum(a0[q] * a0[q] + a1[q] * a1[q], lane) * (1.f / 128.f) + 1e-5f);
            const float y0 = a0[q] * rs * g0 * (r0[q] * frcp(1.f + __expf(-r0[q]))), y1 = a1[q] * rs * g1 * (r1[q] * frcp(1.f + __expf(-r1[q])));
            if (it < nitems) { GAS bf16_t* d = XB + (size_t)row * 1024 + h * 128; d[lane] = (bf16_t)(pk_bf16(y0, 0.f) & 0xffffu); d[64 + lane] = (bf16_t)(pk_bf16(y1, 0.f) & 0xffffu); } }
    }
}

__device__ __forceinline__ float sigm(float x) { return frcp(1.f + __expf(-x)); }
__device__ __forceinline__ float softplusf(float x) { return fmaxf(x, 0.f) + log1pf(__expf(-fabsf(x))); }
__device__ __forceinline__ void rwkvprep_phase(const GAS float* __restrict__ w0, const GAS float* __restrict__ a0, const GAS float* __restrict__ v0, const GAS float* __restrict__ k_k, const GAS float* __restrict__ k_a, const GAS float* __restrict__ Vg,
                                               GAS float* K, GAS float* Wd, GAS float* Aa, GAS float* V, GAS float* NKK, GAS float* VFIRST, int has_vres, int nitems, int lane, int wave_gid, int nwaves) {
    for (int it0 = wave_gid * 4; it0 < nitems; it0 += nwaves * 4) {
        float kq[4], wq[4], aq[4], vq[4], gq[4], fq[4];
#pragma unroll
        for (int q = 0; q < 4; ++q) { const int it = it0 + q; const size_t ix = (size_t)(it >> 4) * 1024 + (it & 15) * 64 + lane; kq[q] = K[ix]; wq[q] = Wd[ix]; aq[q] = Aa[ix]; vq[q] = V[ix]; gq[q] = has_vres ? Vg[ix] : 0.f; fq[q] = has_vres ? VFIRST[ix] : 0.f; }
#pragma unroll
        for (int q = 0; q < 4; ++q) { const int it = it0 + q; const int h = it & 15; const size_t ix = (size_t)(it >> 4) * 1024 + h * 64 + lane; const int c = h * 64 + lane;
            const float k0 = kq[q]; const float kv = k0 * k_k[c]; const float inv = 1.f / fmaxf(sqrtf(wave_sum(kv * kv, lane)), 1e-12f);
            const float w = -softplusf(-(w0[c] + wq[q])) - 0.5f; const float dec = __expf(-__expf(w));
            const float a = sigm(a0[c] + aq[q]);
            float v = vq[q]; if (has_vres) v = v + (fq[q] - v) * sigm(v0[c] + gq[q]); else VFIRST[ix] = v;
            const float kk = kv * inv;
            NKK[ix] = -kk; K[ix] = k0 * (1.f + (a - 1.f) * k_a[c]); Wd[ix] = dec; Aa[ix] = kk * a; V[ix] = v; }
    }
}

__device__ __forceinline__ void rwkvpost_phase(const GAS float* __restrict__ Y, const GAS float* __restrict__ R, const GAS float* __restrict__ K2, const GAS float* __restrict__ V, const GAS float* __restrict__ G, const GAS float* __restrict__ r_k,
                                               const GAS float* __restrict__ lnx_g, const GAS float* __restrict__ lnx_b, GAS bf16_t* XB, int nitems, int lane, int wave_gid, int nwaves) {
    for (int it0 = wave_gid * 4; it0 < nitems; it0 += nwaves * 4) {
        float yq[4], rq[4], kq[4], vq[4], gq[4];
#pragma unroll
        for (int q = 0; q < 4; ++q) { const int it = it0 + q; const size_t ix = (size_t)(it >> 4) * 1024 + (it & 15) * 64 + lane; yq[q] = Y[ix]; rq[q] = R[ix]; kq[q] = K2[ix]; vq[q] = V[ix]; gq[q] = G[ix]; }
#pragma unroll
        for (int q = 0; q < 4; ++q) { const int it = it0 + q; const int h = it & 15; const size_t ix = (size_t)(it >> 4) * 1024 + h * 64 + lane; const int c = h * 64 + lane;
            const float y = yq[q]; const float mu = wave_sum(y, lane) * (1.f / 64.f); const float d = y - mu; const float rs = 1.f / sqrtf(wave_sum(d * d, lane) * (1.f / 64.f) + 64e-5f);
            const float bon = wave_sum(rq[q] * kq[q] * r_k[c], lane);
            const float o = (d * rs * lnx_g[c] + lnx_b[c] + bon * vq[q]) * gq[q];
            XB[ix] = (bf16_t)(pk_bf16(o, 0.f) & 0xffffu); }
    }
}

__device__ __forceinline__ void wkv_phase(const GAS float* __restrict__ R, const GAS float* __restrict__ Wd, const GAS float* __restrict__ K2, const GAS float* __restrict__ V, const GAS float* __restrict__ BB, const GAS float* __restrict__ NKK,
                                          const GAS float* __restrict__ SIN, GAS float* __restrict__ Y, GAS float* __restrict__ P, GAS float* __restrict__ SOUT, int B, int T, int DB, int DT, LAS unsigned char* lds, int tid, int bid, int nb) {
    constexpr int TB = 32, NLD = 6, VECB = TB * 1280, VVB = TB * 128, BUF = VECB + 2 * VVB;
    const int rowl = tid >> 4, part = tid & 15;
    const int nprompt = B * 32, nunits = nprompt + DB * 32;
    for (int u = bid; u < nunits; u += nb) {
        const bool smp = u >= nprompt; const int q0_ = smp ? u - nprompt : u; const int q = ((q0_ & 7) << 1 | ((q0_ >> 3) & 1)) + ((q0_ >> 4) << 4);
        const int half = q & 1, pair = q >> 1, sq = pair >> 4, h = pair & 15;
        const int Tu = smp ? DT : T; const int r0 = smp ? B * T + sq * DT : sq * T, vrow = half * 32 + rowl;
        f32x2 S01 = (f32x2){0.f, 0.f}, S23 = (f32x2){0.f, 0.f};
        if (smp) { const f32x4 s4 = *(const GAS f32x4*)(SIN + ((size_t)pair * 64 + vrow) * 64 + part * 4); S01 = (f32x2){s4.x, s4.y}; S23 = (f32x2){s4.z, s4.w};
                   asm volatile("" : "+v"(S01), "+v"(S23)); }
        const int nblk = (Tu + TB - 1) / TB;
        f32x4 ld[NLD];
        const size_t eo_ = (size_t)(r0 + (tid >> 4)) * 1024 + h * 64 + (tid & 15) * 4, ev_ = (size_t)(r0 + ((tid & 255) >> 3)) * 1024 + h * 64 + half * 32 + (tid & 7) * 4;
        const int lo_ = ((tid >> 4) * 320 + (tid & 15) * 4) * 4, lv_ = VECB + (tid & 255) * 16;
#define WKV_LOAD(tb0) do { const size_t bo_ = (size_t)(tb0) * 1024; ld[0] = *(const GAS f32x4*)(Wd + eo_ + bo_); ld[1] = *(const GAS f32x4*)(NKK + eo_ + bo_); ld[2] = *(const GAS f32x4*)(BB + eo_ + bo_); \
            ld[3] = *(const GAS f32x4*)(K2 + eo_ + bo_); ld[4] = *(const GAS f32x4*)(R + eo_ + bo_); ld[5] = *(const GAS f32x4*)(V + ev_ + bo_); } while (0)
#define WKV_STORE(bufp) do { _Pragma("unroll") for (int q_ = 0; q_ < 5; ++q_) *(LAS f32x4*)((bufp) + lo_ + q_ * 256) = ld[q_]; *(LAS f32x4*)((bufp) + lv_) = ld[5]; } while (0)
        WKV_LOAD(0); WKV_STORE(lds); __syncthreads();
        for (int b = 0; b < nblk; ++b) {
            LAS unsigned char* cur = lds + (b & 1) * BUF; LAS unsigned char* nxt = lds + ((b + 1) & 1) * BUF; const int tb0 = b * TB; const int nt = (Tu - tb0) < TB ? (Tu - tb0) : TB;
            if (b + 1 < nblk) WKV_LOAD(tb0 + TB);
            const LAS float* vec = (const LAS float*)cur + part * 4; const LAS float* vv = (const LAS float*)(cur + VECB) + rowl; LAS float* yb = (LAS float*)(cur + VECB + VVB);
            float ykeep0 = 0.f, ykeep1 = 0.f;
#define WKV_STEP(t, keep, tl) do { const LAS f32x2* vp_ = (const LAS f32x2*)(vec + (t) * 320); \
                const f32x2 w01 = vp_[0], w23 = vp_[1], n01 = vp_[32], n23 = vp_[33], b01 = vp_[64], b23 = vp_[65], k01 = vp_[96], k23 = vp_[97], r01 = vp_[128], r23 = vp_[129]; \
                const float v = vv[(t) * 32]; \
                const f32x2 sp = __builtin_elementwise_fma(S23, n23, S01 * n01); const float sa = row_sum16(sp.x + sp.y); const f32x2 sa2 = (f32x2){sa, sa}, v2 = (f32x2){v, v}; \
                S01 = __builtin_elementwise_fma(S01, w01, __builtin_elementwise_fma(b01, sa2, k01 * v2)); S23 = __builtin_elementwise_fma(S23, w23, __builtin_elementwise_fma(b23, sa2, k23 * v2)); \
                const f32x2 yp = __builtin_elementwise_fma(S23, r23, S01 * r01); const float y = row_sum16(yp.x + yp.y); \
                keep = (part == (tl)) ? y : keep; } while (0)
            if (nt == TB) {
#pragma unroll 1
                for (int t = 0; t < 16; t += 8) { WKV_STEP(t, ykeep0, t); WKV_STEP(t + 1, ykeep0, t + 1); WKV_STEP(t + 2, ykeep0, t + 2); WKV_STEP(t + 3, ykeep0, t + 3); WKV_STEP(t + 4, ykeep0, t + 4); WKV_STEP(t + 5, ykeep0, t + 5); WKV_STEP(t + 6, ykeep0, t + 6); WKV_STEP(t + 7, ykeep0, t + 7); }
#pragma unroll 1
                for (int t = 16; t < 32; t += 8) { WKV_STEP(t, ykeep1, t - 16); WKV_STEP(t + 1, ykeep1, t - 15); WKV_STEP(t + 2, ykeep1, t - 14); WKV_STEP(t + 3, ykeep1, t - 13); WKV_STEP(t + 4, ykeep1, t - 12); WKV_STEP(t + 5, ykeep1, t - 11); WKV_STEP(t + 6, ykeep1, t - 10); WKV_STEP(t + 7, ykeep1, t - 9); }
            } else { for (int t = 0; t < nt; ++t) { if (t < 16) WKV_STEP(t, ykeep0, t); else WKV_STEP(t, ykeep1, t - 16); } }
#undef WKV_STEP
            yb[part * 32 + rowl] = ykeep0; yb[(16 + part) * 32 + rowl] = ykeep1;
            if (b + 1 < nblk) WKV_STORE(nxt);
            __syncthreads();
            { const int rl = tid & 31; _Pragma("unroll") for (int t = tid >> 5; t < TB; t += 16) if (t < nt) Y[(size_t)(r0 + tb0 + t) * 1024 + h * 64 + half * 32 + rl] = yb[t * 32 + rl]; }
        }
#undef WKV_LOAD
#undef WKV_STORE
        *(GAS f32x4*)((smp ? SOUT : P) + ((size_t)pair * 64 + vrow) * 64 + part * 4) = (f32x4){S01.x, S01.y, S23.x, S23.y};
        __syncthreads();
    }
}

__device__ __forceinline__ void rwkvpost2_phase(const GAS float* __restrict__ Y, const GAS bf16_t* __restrict__ G, const GAS float* __restrict__ VF, const GAS float* __restrict__ BON, const GAS float* __restrict__ lnx_g, const GAS float* __restrict__ lnx_b,
                                                GAS bf16_t* XB, int nitems, int lane, int wave_gid, int nwaves) {
    const int nit4 = nitems >> 2, hg = wave_gid & 3, cofs = hg * 256 + 4 * lane; const f32x4 lg = *(const GAS f32x4*)(lnx_g + cofs), lb = *(const GAS f32x4*)(lnx_b + cofs);
    for (int it0 = wave_gid; it0 < nit4; it0 += nwaves * 4) {
        f32x4 yq[4], vq[4]; u32x2 gq[4]; float bq[4];
#pragma unroll
        for (int q = 0; q < 4; ++q) { int it = it0 + q * nwaves; it = it < nit4 ? it : it0; const int row = it >> 2; const size_t ix = (size_t)row * 1024 + cofs;
            yq[q] = *(const GAS f32x4*)(Y + ix); vq[q] = *(const GAS f32x4*)(VF + ix); gq[q] = *(const GAS u32x2*)(G + ix); bq[q] = BON[row * 16 + hg * 4 + (lane >> 4)]; }
#pragma unroll
        for (int q = 0; q < 4; ++q) { const int it = it0 + q * nwaves; const int row = it >> 2; const f32x4 y = yq[q];
            const float mu = row_sum16((y.x + y.y) + (y.z + y.w)) * (1.f / 64.f); const f32x4 d = y - mu; const float rs = __builtin_amdgcn_rsqf(row_sum16((d.x * d.x + d.y * d.y) + (d.z * d.z + d.w * d.w)) * (1.f / 64.f) + 64e-5f);
            const f32x4 gg = (f32x4){bflo(gq[q].x), bfhi(gq[q].x), bflo(gq[q].y), bfhi(gq[q].y)}; const f32x4 o = (d * rs * lg + lb + bq[q] * vq[q]) * gg;
            if (it < nit4) { u32x2 w_; w_.x = pk_bf16(o.x, o.y); w_.y = pk_bf16(o.z, o.w); *(GAS u32x2*)(XB + (size_t)row * 1024 + cofs) = w_; } }
    }
}

__device__ __forceinline__ void wkv2_phase(const GAS bf16_t* __restrict__ R, const GAS bf16_t* __restrict__ KR, const GAS bf16_t* __restrict__ WL, const GAS bf16_t* __restrict__ AL, const GAS bf16_t* __restrict__ V, const GAS bf16_t* __restrict__ VG,
                                           const GAS float* VFI, const GAS float* __restrict__ PRM, const GAS float* __restrict__ SIN, GAS float* __restrict__ Y, GAS float* __restrict__ P, GAS float* __restrict__ SOUT, GAS float* VFO, GAS float* __restrict__ BON,
                                           int has_vres, int B, int T, int DB, int DT, LAS unsigned char* lds, int tid, int bid, int nb) {
    constexpr int TB = 32, VECB = TB * 1280, VVB = TB * 128, BUF = VECB + 2 * VVB;
    const bool scanw = __builtin_amdgcn_readfirstlane(tid) < 256; const int pt = tid & 255;
    const int rowl = pt >> 4, part = pt & 15;
    const int nprompt = B * 32, nunits = nprompt + DB * 32;
    for (int u = bid; u < nunits; u += nb) {
        const bool smp = u >= nprompt; const int q0_ = smp ? u - nprompt : u; const int q = ((q0_ & 7) << 1 | ((q0_ >> 3) & 1)) + ((q0_ >> 4) << 4);
        const int half = q & 1, pair = q >> 1, sq = pair >> 4, h = pair & 15;
        const int Tu = smp ? DT : T; const int r0 = smp ? B * T + sq * DT : sq * T, vrow = half * 32 + rowl;
        const int srow = pt >> 3, sp8 = pt & 7;
        f32x2 S0 = (f32x2){0.f, 0.f}, S1 = (f32x2){0.f, 0.f}, S2 = (f32x2){0.f, 0.f}, S3 = (f32x2){0.f, 0.f};
        if (smp && scanw) { const GAS f32x4* sp_ = (const GAS f32x4*)(SIN + ((size_t)pair * 64 + half * 32 + srow) * 64 + sp8 * 8); const f32x4 sa4 = sp_[0], sb4 = sp_[1];
                   S0 = (f32x2){sa4.x, sa4.y}; S1 = (f32x2){sa4.z, sa4.w}; S2 = (f32x2){sb4.x, sb4.y}; S3 = (f32x2){sb4.z, sb4.w};
                   asm volatile("" : "+v"(S0), "+v"(S1), "+v"(S2), "+v"(S3)); }
        const int nblk = (Tu + TB - 1) / TB;
        u32x2 lk0, lw0, la0, lr0, lk1, lw1, la1, lr1, lv, lg = (u32x2){0u, 0u}; f32x4 lf = (f32x4){0.f, 0.f, 0.f, 0.f};
        const size_t eo_ = (size_t)(r0 + (pt >> 4)) * 1024 + h * 64 + part * 4, ev_ = (size_t)(r0 + (pt >> 3)) * 1024 + h * 64 + half * 32 + (pt & 7) * 4;
        const int lo_ = ((pt >> 4) * 320 + part * 4) * 4, lv_ = VECB + pt * 16;
        const int pc_ = h * 64 + part * 4; const f32x4 w0v = *(const GAS f32x4*)(PRM + pc_), a0v = *(const GAS f32x4*)(PRM + 1024 + pc_), kkp = *(const GAS f32x4*)(PRM + 3072 + pc_), kap = *(const GAS f32x4*)(PRM + 4096 + pc_), rkp = *(const GAS f32x4*)(PRM + 5120 + pc_);
        const f32x4 v0v = *(const GAS f32x4*)(PRM + 2048 + h * 64 + half * 32 + (pt & 7) * 4);
#define WKV_LOAD(tb0) do { const size_t bo_ = (size_t)(tb0) * 1024, b1_ = bo_ + 16 * 1024; lk0 = *(const GAS u32x2*)(KR + eo_ + bo_); lw0 = *(const GAS u32x2*)(WL + eo_ + bo_); la0 = *(const GAS u32x2*)(AL + eo_ + bo_); lr0 = *(const GAS u32x2*)(R + eo_ + bo_); \
            lk1 = *(const GAS u32x2*)(KR + eo_ + b1_); lw1 = *(const GAS u32x2*)(WL + eo_ + b1_); la1 = *(const GAS u32x2*)(AL + eo_ + b1_); lr1 = *(const GAS u32x2*)(R + eo_ + b1_); \
            lv = *(const GAS u32x2*)(V + ev_ + bo_); if (has_vres) { lg = *(const GAS u32x2*)(VG + ev_ + bo_); lf = *(const GAS f32x4*)(VFI + ev_ + bo_); } } while (0)
#define WKV_UNPK(w_) ((f32x4){bflo((w_).x), bfhi((w_).x), bflo((w_).y), bfhi((w_).y)})
#define WKV_ITEM(bufp, tb0, lk, lw, la, lr, ti_) do { const f32x4 k4 = WKV_UNPK(lk), wl4 = WKV_UNPK(lw), al4 = WKV_UNPK(la); const f32x4 kv = k4 * kkp; const float ss = row_sum16((kv.x * kv.x + kv.y * kv.y) + (kv.z * kv.z + kv.w * kv.w)); const float inv = frcp(fmaxf(fsqrt(ss), 1e-12f)); \
            f32x4 dec, a4; _Pragma("unroll") for (int i_ = 0; i_ < 4; ++i_) { dec[i_] = __expf(-0.6065306597126334f * frcp(1.f + __expf(-(w0v[i_] + wl4[i_])))); a4[i_] = frcp(1.f + __expf(-(a0v[i_] + al4[i_]))); } \
            const f32x4 kk = kv * inv; const f32x4 k2 = k4 * ((a4 - 1.f) * kap + 1.f); const f32x4 r4 = WKV_UNPK(lr); const f32x4 rk = r4 * k2 * rkp; const float bon = row_sum16((rk.x + rk.y) + (rk.z + rk.w)); \
            LAS unsigned char* d_ = (bufp) + lo_ + (ti_) * 1280; *(LAS f32x4*)(d_) = dec; *(LAS f32x4*)(d_ + 256) = -kk; *(LAS f32x4*)(d_ + 512) = kk * a4; *(LAS f32x4*)(d_ + 768) = k2; *(LAS f32x4*)(d_ + 1024) = r4; \
            const int tr_ = (tb0) + (pt >> 4) + (ti_); if (half == 0 && part == 0 && tr_ < Tu) BON[(size_t)(r0 + tr_) * 16 + h] = bon; } while (0)
#define WKV_STORE(bufp, tb0) do { WKV_ITEM(bufp, tb0, lk0, lw0, la0, lr0, 0); if ((tb0) + 16 < Tu) WKV_ITEM(bufp, tb0, lk1, lw1, la1, lr1, 16); \
            f32x4 v4 = WKV_UNPK(lv); if (has_vres) { const f32x4 g4 = WKV_UNPK(lg); _Pragma("unroll") for (int i_ = 0; i_ < 4; ++i_) v4[i_] = v4[i_] + (lf[i_] - v4[i_]) * frcp(1.f + __expf(-(v0v[i_] + g4[i_]))); } \
            *(LAS f32x4*)((bufp) + lv_) = v4; const int tv_ = (tb0) + (pt >> 3); if (tv_ < Tu) *(GAS f32x4*)(VFO + ev_ + (size_t)(tb0) * 1024) = v4; } while (0)
#define WKV_YOUT(bufp, tb0, ntp) do { const LAS float* yb_ = (const LAS float*)((bufp) + VECB + VVB); const int rl = pt & 31; _Pragma("unroll") for (int t = pt >> 5; t < TB; t += 8) if (t < (ntp)) Y[(size_t)(r0 + (tb0) + t) * 1024 + h * 64 + half * 32 + rl] = yb_[t * 32 + rl]; } while (0)
        if (!scanw) { WKV_LOAD(0); WKV_STORE(lds, 0); if (nblk > 1) WKV_LOAD(TB); }
        __syncthreads();
        for (int b = 0; b < nblk; ++b) {
            LAS unsigned char* cur = lds + (b & 1) * BUF; LAS unsigned char* nxt = lds + ((b + 1) & 1) * BUF; const int tb0 = b * TB; const int nt = (Tu - tb0) < TB ? (Tu - tb0) : TB;
            if (scanw) {
                const LAS float* vec = (const LAS float*)cur + sp8 * 8; const LAS float* vv = (const LAS float*)(cur + VECB) + srow; LAS float* yb = (LAS float*)(cur + VECB + VVB);
                LAS float* ybl = yb + srow;
                struct StepV { f32x4 w0, w1, n0, n1, b0, b1, k0, k1, r0, r1; float v; };
#define WKV_RD(dst, t) do { const LAS f32x4* vp_ = (const LAS f32x4*)(vec + (t) * 320); dst.w0 = vp_[0]; dst.w1 = vp_[1]; dst.n0 = vp_[16]; dst.n1 = vp_[17]; dst.b0 = vp_[32]; dst.b1 = vp_[33]; \
                dst.k0 = vp_[48]; dst.k1 = vp_[49]; dst.r0 = vp_[64]; dst.r1 = vp_[65]; dst.v = vv[(t) * 32]; } while (0)
#define WKV_LO(q_) ((f32x2){(q_).x, (q_).y})
#define WKV_HI(q_) ((f32x2){(q_).z, (q_).w})
#define WKV_UPD(S, w_, b_, k_) S = __builtin_elementwise_fma(S, w_, __builtin_elementwise_fma(b_, sa2, (k_) * v2))
#define WKV_CMP(src, t_) do { const f32x2 spa = __builtin_elementwise_fma(S1, WKV_HI(src.n0), S0 * WKV_LO(src.n0)), spb = __builtin_elementwise_fma(S3, WKV_HI(src.n1), S2 * WKV_LO(src.n1)); const f32x2 sp = spa + spb; \
                const float sa = row_sum8(sp.x + sp.y); const f32x2 sa2 = (f32x2){sa, sa}, v2 = (f32x2){src.v, src.v}; \
                WKV_UPD(S0, WKV_LO(src.w0), WKV_LO(src.b0), WKV_LO(src.k0)); WKV_UPD(S1, WKV_HI(src.w0), WKV_HI(src.b0), WKV_HI(src.k0)); WKV_UPD(S2, WKV_LO(src.w1), WKV_LO(src.b1), WKV_LO(src.k1)); WKV_UPD(S3, WKV_HI(src.w1), WKV_HI(src.b1), WKV_HI(src.k1)); \
                const f32x2 ypa = __builtin_elementwise_fma(S1, WKV_HI(src.r0), S0 * WKV_LO(src.r0)), ypb = __builtin_elementwise_fma(S3, WKV_HI(src.r1), S2 * WKV_LO(src.r1)); const f32x2 yp = ypa + ypb; \
                ybl[(t_) * 32] = row_sum8(yp.x + yp.y); } while (0)
#define WKV_ST(t_, cur_, nx2_) do { WKV_RD(nx2_, ((t_) + 2) & 31); __builtin_amdgcn_sched_barrier(0); WKV_CMP(cur_, t_); } while (0)
                if (nt == TB) {
                    StepV sA, sB, sC; WKV_RD(sA, 0); WKV_RD(sB, 1);
#pragma unroll 1
                    for (int t = 0; t < 30; t += 3) { WKV_ST(t, sA, sC); WKV_ST(t + 1, sB, sA); WKV_ST(t + 2, sC, sB); }
                    WKV_ST(30, sA, sC); WKV_ST(31, sB, sA);
                } else { StepV sA; for (int t = 0; t < nt; ++t) { WKV_RD(sA, t); WKV_CMP(sA, t); } }
#undef WKV_RD
#undef WKV_LO
#undef WKV_HI
#undef WKV_UPD
#undef WKV_CMP
#undef WKV_ST
            } else {
                if (b > 0) WKV_YOUT(nxt, tb0 - TB, TB);
                if (b + 1 < nblk) { WKV_STORE(nxt, tb0 + TB); if (b + 2 < nblk) WKV_LOAD(tb0 + 2 * TB); }
            }
            __syncthreads();
        }
        if (!scanw) { const int tbl = (nblk - 1) * TB; WKV_YOUT(lds + ((nblk - 1) & 1) * BUF, tbl, Tu - tbl); }
#undef WKV_LOAD
#undef WKV_STORE
#undef WKV_ITEM
#undef WKV_YOUT
#undef WKV_UNPK
        if (scanw) { GAS float* so = (smp ? SOUT : P) + ((size_t)pair * 64 + half * 32 + srow) * 64 + sp8 * 8; *(GAS f32x4*)so = (f32x4){S0.x, S0.y, S1.x, S1.y}; *(GAS f32x4*)(so + 4) = (f32x4){S2.x, S2.y, S3.x, S3.y}; }
        __syncthreads();
    }
}

__device__ __forceinline__ void gla_phase(const GAS float* __restrict__ PROJ, const GAS float* __restrict__ LOGA, GAS float* __restrict__ O, GAS float* __restrict__ P, int B, int T, LAS unsigned char* lds, int tid, int bid, int nb) {
    constexpr int TB = 32, NLD = 4, VECB = TB * 768, VVB = TB * 64, BUF = VECB + 3 * VVB;
    const int col = tid >> 5, half = (tid >> 4) & 1, p = tid & 15, dk = half * 32 + p * 2;
    const int nunits = B * 32;
    for (int u = bid; u < nunits; u += nb) {
        const int ug_ = ((u & 7) << 3 | ((u >> 3) & 7)) + ((u >> 6) << 6);
        const int cb = ug_ & 7, pair = ug_ >> 3, s = pair >> 2, h = pair & 3; const int r0 = s * T;
        float S0 = 0.f, S1 = 0.f;
        const int nblk = (T + TB - 1) / TB;
        f32x4 ld[NLD];
        const size_t ea_ = (size_t)(r0 + (tid >> 4)) * 256 + h * 64 + (tid & 15) * 4, ep_ = (size_t)(r0 + (tid >> 4)) * 2576 + h * 64 + (tid & 15) * 4, ev_ = (size_t)(r0 + ((tid & 127) >> 2)) * 2576 + 512 + h * 128 + cb * 16 + (tid & 3) * 4;
        const int lo_ = ((tid >> 4) * 192 + (tid & 15) * 4) * 4, lv_ = VECB + (tid & 127) * 16;
#define GLA_LOAD(tb0) do { ld[0] = *(const GAS f32x4*)(LOGA + ea_ + (size_t)(tb0) * 256); ld[1] = *(const GAS f32x4*)(PROJ + ep_ + 256 + (size_t)(tb0) * 2576); ld[2] = *(const GAS f32x4*)(PROJ + ep_ + (size_t)(tb0) * 2576); ld[3] = *(const GAS f32x4*)(PROJ + ev_ + (size_t)(tb0) * 2576); } while (0)
#define GLA_STORE(bufp) do { *(LAS f32x4*)((bufp) + lo_) = ld[0]; *(LAS f32x4*)((bufp) + lo_ + 256) = ld[1]; *(LAS f32x4*)((bufp) + lo_ + 512) = ld[2] * 0.125f; *(LAS f32x4*)((bufp) + lv_) = ld[3]; } while (0)
        GLA_LOAD(0); GLA_STORE(lds); __syncthreads();
        for (int b = 0; b < nblk; ++b) {
            LAS unsigned char* cur = lds + (b & 1) * BUF; LAS unsigned char* nxt = lds + ((b + 1) & 1) * BUF; const int tb0 = b * TB; const int nt = (T - tb0) < TB ? (T - tb0) : TB;
            if (b + 1 < nblk) GLA_LOAD(tb0 + TB);
            const LAS float* vec = (const LAS float*)cur + dk; const LAS float* vv = (const LAS float*)(cur + VECB) + col; LAS float* ob = (LAS float*)(cur + VECB + VVB);
            float okeep0 = 0.f, okeep1 = 0.f;
#define GLA_STEP(t, keep, tl) do { const f32x2 a2 = *(const LAS f32x2*)(vec + (t) * 192), k2 = *(const LAS f32x2*)(vec + (t) * 192 + 64), q2 = *(const LAS f32x2*)(vec + (t) * 192 + 128); const float v = vv[(t) * 16]; \
                S0 = fmaf(a2.x, S0, k2.x * v); S1 = fmaf(a2.y, S1, k2.y * v); \
                float o = fmaf(q2.x, S0, q2.y * S1); o = row_sum16(o); keep = (p == (tl)) ? o : keep; } while (0)
            if (nt == TB) {
#pragma unroll 1
                for (int t = 0; t < 16; t += 4) { GLA_STEP(t, okeep0, t); GLA_STEP(t + 1, okeep0, t + 1); GLA_STEP(t + 2, okeep0, t + 2); GLA_STEP(t + 3, okeep0, t + 3); }
#pragma unroll 1
                for (int t = 16; t < 32; t += 4) { GLA_STEP(t, okeep1, t - 16); GLA_STEP(t + 1, okeep1, t - 15); GLA_STEP(t + 2, okeep1, t - 14); GLA_STEP(t + 3, okeep1, t - 13); }
            } else { for (int t = 0; t < nt; ++t) { if (t < 16) GLA_STEP(t, okeep0, t); else GLA_STEP(t, okeep1, t - 16); } }
#undef GLA_STEP
            ob[(p * 16 + col) * 2 + half] = okeep0; ob[((16 + p) * 16 + col) * 2 + half] = okeep1;
            if (b + 1 < nblk) GLA_STORE(nxt);
            __syncthreads();
            { const int t = tid >> 4, c = tid & 15; if (t < nt) { const f32x2 o2 = *(const LAS f32x2*)(ob + (t * 16 + c) * 2); O[(size_t)(r0 + tb0 + t) * 512 + h * 128 + cb * 16 + c] = o2.x + o2.y; } }
        }
#undef GLA_LOAD
#undef GLA_STORE
        { GAS float* so = P + ((size_t)pair * 64 + dk) * 128 + cb * 16 + col; so[0] = S0; so[128] = S1; }
        __syncthreads();
    }
}
__device__ __forceinline__ float grp8_sum(float v) { v += dppf<0xB1>(v); v += dppf<0x4E>(v); v += dppf<0x141>(v); return v; }
__device__ __forceinline__ float dot16_fp8_bf16(const u32x4 uw, const float (&x)[16]) { float s = 0.f;
#pragma unroll
    for (int d = 0; d < 4; ++d) { const f32x2 lo = fp8lo(uw[d]), hi = fp8hi(uw[d]); s = fmaf(lo.x, x[4 * d], s); s = fmaf(lo.y, x[4 * d + 1], s); s = fmaf(hi.x, x[4 * d + 2], s); s = fmaf(hi.y, x[4 * d + 3], s); }
    return s; }
typedef int i32x8 __attribute__((ext_vector_type(8)));
typedef unsigned u32x8 __attribute__((ext_vector_type(8)));
__device__ __forceinline__ void pacts_phase(const GAS unsigned char* XF8, const GAS unsigned char* U8S, const GAS int* EIDX, GAS bf16_t* __restrict__ PART, int M, int emask,
                                            LAS unsigned char* lds, int wid, int lane, int bid, int nb) {
    const bool spl = (nb & 7) == 0; const int s0 = spl ? (bid & 7) : 0, s1 = spl ? s0 + 1 : 8, r = spl ? (bid >> 3) : bid, nr = spl ? (nb >> 3) : nb;
    const int g = lane >> 3, c = lane & 7, fg = ((g >> 2) & 1) | (((g >> 1) & 1) << 2);
    const int m16 = lane & 15, kb = lane >> 4, fm = ((m16 >> 2) & 1) | (((m16 >> 1) & 1) << 2);
    LAS unsigned char* const wl = lds + wid * 16384;
    const LAS unsigned char* const ard = wl + m16 * 128 + (((2 * kb) ^ fm) * 16);
    const LAS unsigned char* const xrd = wl + 12288 + (m16 & 1) * 128 + kb * 32;
    const LAS unsigned char* const ird = wl + 13824 + g * 4;
    if (r >= M) return;
    const int ntok = (M - r + nr - 1) / nr;
#define PL_ROW(t_) ({ int rw_ = r + nr * (t_); rw_ < M ? rw_ : r; })
#define PL_IDS(t_, slot_) __builtin_amdgcn_global_load_lds((const GAS unsigned*)(isrc + (size_t)PL_ROW(t_) * 128), (LAS unsigned*)(wl + 13824 + (slot_) * 256), 4, 0, 0)
#define PL_RDIDS(slot_, e0_, e1_) do { e0_ = *(const LAS int*)(ird + (slot_) * 256); e1_ = *(const LAS int*)(ird + (slot_) * 256 + 32); } while (0)
#define PL_TILE(t_, slot_, e0_, e1_) do { \
        __builtin_amdgcn_global_load_lds((const GAS unsigned*)(tb + (size_t)((e0_) & emask) * 128), (LAS unsigned*)(wl + (slot_) * 2048), 16, 0, 0); \
        __builtin_amdgcn_global_load_lds((const GAS unsigned*)(tb + (size_t)((e1_) & emask) * 128), (LAS unsigned*)(wl + (slot_) * 2048 + 1024), 16, 0, 0); \
        __builtin_amdgcn_global_load_lds((const GAS unsigned*)(xsrc + (size_t)PL_ROW(t_) * 2048), (LAS unsigned*)(wl + 12288 + (slot_) * 256), 4, 0, 0); } while (0)
#define PL_RD(slot_, a0_, a1_, x0_, x1_) do { a0_ = *(const LAS u32x4*)(ard + (slot_) * 2048); a1_ = *(const LAS u32x4*)(ard2 + (slot_) * 2048); x0_ = *(const LAS u32x4*)(xrd + (slot_) * 256); x1_ = *(const LAS u32x4*)(xrd + (slot_) * 256 + 16); } while (0)
#define PL_MMA(cc_, a0_, a1_, x0_, x1_) do { const i32x8 av = (i32x8)__builtin_shufflevector(a0_, a1_, 0, 1, 2, 3, 4, 5, 6, 7), bv = (i32x8)__builtin_shufflevector(x0_, x1_, 0, 1, 2, 3, 4, 5, 6, 7); const f32x4 z = {0.f, 0.f, 0.f, 0.f}; \
        cc_ = __builtin_amdgcn_mfma_scale_f32_16x16x128_f8f6f4(av, bv, z, 0, 0, 0, 0, 0, 0); } while (0)
#define PL_OUT(t_, cc_) do { f32x4 o; _Pragma("unroll") for (int i = 0; i < 4; ++i) { float v = cc_[i]; v += dppf<0xB1>(v); o[i] = v * (1.f / 16.f); } \
        const int rw = r + nr * (t_); if (m16 == 0 && rw < M) { u32x2 w_; w_.x = pk_bf16(o[0], o[1]); w_.y = pk_bf16(o[2], o[3]); *(GAS u32x2*)(po + (size_t)rw * 128) = w_; } } while (0)
#define PL_WAIT(n_) asm volatile("s_waitcnt vmcnt(" #n_ ")" ::: "memory")
#define PL_STEP(j_, h_) do { PL_WAIT(12); u32x4 a0[3], a1[3], x0[3], x1[3]; int e0[3], e1[3]; f32x4 cc[3]; \
        _Pragma("unroll") for (int k = 0; k < 3; ++k) PL_RD((h_) * 3 + k, a0[k], a1[k], x0[k], x1[k]); \
        _Pragma("unroll") for (int k = 0; k < 3; ++k) PL_RDIDS((h_) * 3 + k, e0[k], e1[k]); \
        _Pragma("unroll") for (int k = 0; k < 3; ++k) PL_MMA(cc[k], a0[k], a1[k], x0[k], x1[k]); \
        _Pragma("unroll") for (int k = 0; k < 3; ++k) PL_TILE((j_) + 6 + k, (h_) * 3 + k, e0[k], e1[k]); \
        _Pragma("unroll") for (int k = 0; k < 3; ++k) PL_IDS((j_) + 12 + k, (h_) * 3 + k); \
        _Pragma("unroll") for (int k = 0; k < 3; ++k) PL_OUT((j_) + k, cc[k]); } while (0)
    const LAS unsigned char* const ard2 = (const LAS unsigned char*)((unsigned)(size_t)ard ^ 16u);
    for (int s = s0; s < s1; ++s) {
        const GAS unsigned char* tb = U8S + (size_t)s * 16384 * 128 + ((c ^ fg) * 16);
        const GAS unsigned char* xsrc = XF8 + (size_t)(lane >> 5) * 1024 + s * 128 + (lane & 31) * 4;
        const GAS int* isrc = EIDX + wid * 16 + m16;
        GAS bf16_t* po = PART + (size_t)s * M * 128 + wid * 16 + kb * 4;
        PL_IDS(0, 0); PL_IDS(1, 1); PL_IDS(2, 2); PL_IDS(3, 3); PL_IDS(4, 4); PL_IDS(5, 5); PL_WAIT(0);
        { int e0[6], e1[6];
#pragma unroll
          for (int k = 0; k < 6; ++k) PL_RDIDS(k, e0[k], e1[k]);
#pragma unroll
          for (int k = 0; k < 3; ++k) PL_TILE(k, k, e0[k], e1[k]);
#pragma unroll
          for (int k = 0; k < 3; ++k) PL_IDS(6 + k, k);
#pragma unroll
          for (int k = 3; k < 6; ++k) PL_TILE(k, k, e0[k], e1[k]);
#pragma unroll
          for (int k = 3; k < 6; ++k) PL_IDS(6 + k, k); }
        for (int j = 0; j < ntok; j += 6) { PL_STEP(j, 0); PL_STEP(j + 3, 1); }
        PL_WAIT(0);
    }
#undef PL_ROW
#undef PL_IDS
#undef PL_RDIDS
#undef PL_TILE
#undef PL_RD
#undef PL_MMA
#undef PL_OUT
#undef PL_WAIT
#undef PL_STEP
}
__device__ __forceinline__ void pouts_phase(const GAS float* __restrict__ COEF, const GAS int* __restrict__ EIDX, const GAS unsigned char* V8S, GAS bf16_t* __restrict__ YBUF, int M,
                                            int wid, int lane, int bid, int nb) {
    const bool spl = (nb & 7) == 0; const int s0 = spl ? (bid & 7) : 0, s1 = spl ? s0 + 1 : 8, r = spl ? (bid >> 3) : bid, nr = spl ? (nb >> 3) : nb;
    const int g = lane >> 3, ch = lane & 7, rstep = nr * 8;
#define PO_LOADCE(rw, c0, c1, v0, v1) do { c0 = COEF[(size_t)(rw) * 128 + lane] * (1.f / 64.f); c1 = COEF[(size_t)(rw) * 128 + 64 + lane] * (1.f / 64.f); v0 = EIDX[(size_t)(rw) * 128 + lane]; v1 = EIDX[(size_t)(rw) * 128 + 64 + lane]; } while (0)
#define PO_GATHER(vv_, vreg) do { _Pragma("unroll") for (int k = 0; k < 8; ++k) { const int e = __builtin_amdgcn_ds_bpermute((8 * k + g) << 2, vreg); vv_[k] = *(const GAS u32x4*)(tb + (size_t)(e & 16383) * 128); } } while (0)
#define PO_COMP(vv_, creg) do { _Pragma("unroll") for (int k = 0; k < 8; ++k) { const float c = __int_as_float(__builtin_amdgcn_ds_bpermute((8 * k + g) << 2, __float_as_int(creg))); const u32x4 w = vv_[k]; \
        const f32x2 c2 = (f32x2){c, c}; _Pragma("unroll") for (int d = 0; d < 4; ++d) { ac2[2 * d] = __builtin_elementwise_fma(c2, fp8lo(w[d]), ac2[2 * d]); ac2[2 * d + 1] = __builtin_elementwise_fma(c2, fp8hi(w[d]), ac2[2 * d + 1]); } \
        _Pragma("unroll") for (int i = 0; i < 8; ++i) asm volatile("" : "+v"(ac2[i])); } } while (0)
    for (int s = s0; s < s1; ++s) {
        const GAS unsigned char* tb = V8S + (size_t)s * 16384 * 128 + ch * 16;
        int row = r + nr * wid; if (row >= M) continue;
        float c0c, c1c, c0n = 0.f, c1n = 0.f; int v0c, v1c, v0n = 0, v1n = 0;
        PO_LOADCE(row, c0c, c1c, v0c, v1c);
        u32x4 va[8], vb[8];
        PO_GATHER(va, v0c);
        for (;;) {
            const int rown = row + rstep; const bool hasn = rown < M;
            PO_GATHER(vb, v1c);
            if (hasn) PO_LOADCE(rown, c0n, c1n, v0n, v1n);
            f32x2 ac2[8];
#pragma unroll
            for (int i = 0; i < 8; ++i) ac2[i] = (f32x2){0.f, 0.f};
            PO_COMP(va, c0c);
            if (hasn) PO_GATHER(va, v0n);
            PO_COMP(vb, c1c);
            float acc[16];
#pragma unroll
            for (int i = 0; i < 8; ++i) { acc[2 * i] = ac2[i].x; acc[2 * i + 1] = ac2[i].y; }
#pragma unroll
            for (int i = 0; i < 16; ++i) acc[i] += dppf<0x128>(acc[i]);
#pragma unroll
            for (int i = 0; i < 8; ++i) { const bool hi = lane & 16; const float send = hi ? acc[i] : acc[i + 8], keep = hi ? acc[i + 8] : acc[i]; acc[i] = keep + shx(send, 16, lane); }
#pragma unroll
            for (int i = 0; i < 4; ++i) { const bool hi = lane & 32; const float send = hi ? acc[i] : acc[i + 4], keep = hi ? acc[i + 4] : acc[i]; acc[i] = keep + shx(send, 32, lane); }
            if ((lane & 8) == 0) { u32x2 w_; w_.x = pk_bf16(acc[0], acc[1]); w_.y = pk_bf16(acc[2], acc[3]); *(GAS u32x2*)(YBUF + (size_t)row * 1024 + s * 128 + ch * 16 + ((lane >> 4) & 1) * 8 + ((lane >> 5) & 1) * 4) = w_; }
            if (!hasn) break;
            row = rown; c0c = c0n; c1c = c1n; v0c = v0n; v1c = v1n;
        }
    }
#undef PO_LOADCE
#undef PO_GATHER
#undef PO_COMP
}
}

template <class T> __device__ __forceinline__ __attribute__((address_space(1))) T* gp(T* p) { return (__attribute__((address_space(1))) T*)uni_ptr(p); }
constexpr int MK_THREADS = 512, LDS_BYTES = 163840, LDSCTL_OFF = 131072, TAB_OFF = LDSCTL_OFF + 1024, MAX_OPS = 208;
static_assert(TAB_OFF + MAX_OPS * (int)sizeof(Op) <= LDS_BYTES, "LDS map");
constexpr int MPAD = 17152;
constexpr size_t CTL_BYTES = (size_t)1 << 20;
struct MArgs { const float* in[47]; float* out; char* ws; unsigned long long ws_size; };
__global__ void __launch_bounds__(MK_THREADS, 2) mega_fwd(MArgs a) {
    extern __shared__ __attribute__((aligned(16))) unsigned char lds[];
    volatile LAS unsigned* ctl = (volatile LAS unsigned*)((LAS unsigned char*)lds + LDSCTL_OFF);
    if (threadIdx.x < 64) ctl[threadIdx.x] = 0u;
    __syncthreads();
    (void)xcd_barrier_post((unsigned*)a.ws, ctl + 8);
    const Dm dm = make_dm(1024, 8, 2048, 128, 4);
    Op* tab = (Op*)(lds + TAB_OFF);
    if (threadIdx.x == 0) {
        const float* const* inp_ = (const float* const*)__builtin_amdgcn_kernarg_segment_ptr(); asm volatile("" : "+s"(inp_));
        NvIO io; io.in = inp_; io.out = a.out; io.ws = a.ws + CTL_BYTES; io.ws_size = a.ws_size - CTL_BYTES;
        int n = 0;
        #ifdef PROBE_DUPCODE
        nv_forward(io, dm, [&](const Op& o) __attribute__((always_inline)) { if (n < MAX_OPS) tab[n] = o; ++n; if ((o.code & 0xff) == PROBE_DUPCODE) { if (n < MAX_OPS) tab[n] = o; ++n; } asm volatile("" ::: "memory"); });
#else
        nv_forward(io, dm, [&](const Op& o) __attribute__((always_inline)) { if (n < MAX_OPS) tab[n] = o; ++n; asm volatile("" ::: "memory"); });
#endif
        ctl[16] = (unsigned)(n <= MAX_OPS ? n : 0);
    }
    __syncthreads();
    const int nops = (int)ctl[16];
    for (int i = 0; i < nops; ++i) {
        int tid_ = (int)threadIdx.x, bid_ = (int)blockIdx.x, nb_ = (int)gridDim.x;
        asm volatile("" : "+v"(tid_)); asm volatile("" : "+s"(bid_)); asm volatile("" : "+s"(nb_));
        const long long g0 = (long long)bid_ * MK_THREADS + tid_, gs = (long long)nb_ * MK_THREADS;
        const Op& o = tab[i];
        const int rawc = __builtin_amdgcn_readfirstlane(o.code); const int code = rawc & 0xff; const long long n = o.n;
        switch (code) {
        case OP_FGEMM: {
            const int fl = rfl(o.i6);
            pg8::Gemm g{uni_ptr((const pg8::bf16_t*)o.a), uni_ptr((const pg8::bf16_t*)o.b), MPAD, rfl(o.i5), rfl(o.i1), rfl(o.i2), rfl(o.i3)};
            if (rawc & OPF_GROUP) {
                int ng = 1; while (ng < 8 && (rfl(tab[i + ng - 1].code) & OPF_GROUP)) ++ng;
                const PG8_LAS Op* gt = (const PG8_LAS Op*)((PG8_LAS unsigned char*)lds + TAB_OFF) + i;
                pg8::GroupOrder S; S.tab = gt; S.ng = ng; S.nM = MPAD / 256; S.G = nb_; S.c = bid_; S.tsA = (size_t)256 * g.lda * 2; S.tsB = (size_t)256 * g.ldb * 2;
                pg8::EpiGroup E{gt, dm.M};
                pg8::gemm_phase<pg8::EpiGroup, pg8::GroupOrder, true, true>((PG8_LAS unsigned char*)lds, g, S, E);
                i += ng - 1;
            } else {
            pg8::StaticOrder S; S.init(g, nb_, bid_); if (fl & 2) S.acs = 512;
            float* const c0 = uni_ptr(o.o0); const int ldc0 = rfl(o.i4), nreal0 = rfl(o.i0);
            if (fl & 1) { pg8::EpiBf16Plain E{(pg8::bf16_t*)c0, ldc0}; pg8::gemm_phase<pg8::EpiBf16Plain, pg8::StaticOrder, true, true>((PG8_LAS unsigned char*)lds, g, S, E); }
            else { pg8::EpiF32 E{c0, ldc0, dm.M, nreal0}; pg8::gemm_phase<pg8::EpiF32, pg8::StaticOrder, true, true>((PG8_LAS unsigned char*)lds, g, S, E); }
            }
        } break;
        case OP_LRUG2: {
            pg8::Gemm g{uni_ptr((const pg8::bf16_t*)o.a), uni_ptr((const pg8::bf16_t*)o.b), MPAD, 1024, 512, 512, 512};
            pg8::StaticOrder S; S.init(g, nb_, bid_);
            pg8::EpiLru E{uni_ptr(o.c), uni_ptr(o.d), uni_ptr(o.e), uni_ptr(o.f), uni_ptr(o.o0), uni_ptr(o.o1), dm.M};
            pg8::gemm_phase<pg8::EpiLru, pg8::StaticOrder, true, true>((PG8_LAS unsigned char*)lds, g, S, E);
        } break;
        case OP_WKVP: fk::wkv2_phase(gp((const fk::bf16_t*)o.a), gp((const fk::bf16_t*)o.b), gp((const fk::bf16_t*)o.c), gp((const fk::bf16_t*)o.d), gp((const fk::bf16_t*)o.e), gp((const fk::bf16_t*)o.f), gp(o.g), gp(o.h), gp((const float*)o.o5), gp(o.o0), gp(o.o1), gp(o.o2), gp(o.o3), gp(o.o4), rfl(o.i0), dm.B, dm.T, dm.DB, dm.DT, (LAS unsigned char*)lds, tid_, bid_, nb_); break;
        case OP_POST2: fk::rwkvpost2_phase(gp(o.a), gp((const fk::bf16_t*)o.b), gp(o.c), gp(o.d), gp(o.e), gp(o.f), gp((fk::bf16_t*)o.o0), dm.M * 16, tid_ & 63, bid_ * 8 + (tid_ >> 6), nb_ * 8); break;
        case OP_GLAF: fk::gla_phase(gp(o.a), gp(o.b), gp(o.o0), gp(o.o1), dm.B, dm.T, (LAS unsigned char*)lds, tid_, bid_, nb_); break;
        case OP_PACTS: fk::pacts_phase(gp((const unsigned char*)o.a), gp((const unsigned char*)o.b), gp((const int*)o.d), gp((fk::bf16_t*)o.o0), dm.M, rfl(o.i0), (LAS unsigned char*)lds, rfl(tid_ >> 6), tid_ & 63, bid_, nb_); break;
        case OP_POUTS: fk::pouts_phase(gp(o.a), gp((const int*)o.b), gp((const unsigned char*)o.c), gp((fk::bf16_t*)o.o0), dm.M, tid_ >> 6, tid_ & 63, bid_, nb_); break;
        case OP_TOPK2: fk::topk_phase(gp(o.a), gp((const fk::bf16_t*)o.b), gp(o.c), gp(o.o0), gp((int*)o.o1), dm.M * 8, (LAS unsigned char*)lds, tid_ >> 6, tid_ & 63, bid_ * 8 + (tid_ >> 6), nb_ * 8); break;
        case OP_LNRES: fk::lnres_phase(gp((const fk::bf16_t*)o.a), gp(o.b), gp(o.c), gp(o.o0), gp((fk::bf16_t*)o.o1), gp((unsigned char*)o.o2), dm.M, tid_ & 63, bid_ * 8 + (tid_ >> 6), nb_ * 8); break;
        case OP_GLANORM: fk::glanorm_phase(gp(o.a), gp(o.b), gp(o.c), gp((fk::bf16_t*)o.o0), dm.M * 4, tid_ & 63, bid_ * 8 + (tid_ >> 6), nb_ * 8); break;
#define NVC(c) case c: for (long long g = g0; g < n; g += gs) nv_elem(c, o, dm, g); break;
        NVC(OP_LOGA4) NVC(OP_CONVOUT) NVC(OP_SHIFTOUT) NVC(OP_EMBED4) NVC(OP_YOUT4) NVC(OP_MIX6) NVC(OP_CONV4) NVC(OP_CVT8) NVC(OP_WGATE)
        NVC(OP_WT) NVC(OP_CVTTAB8S) NVC(OP_PRED) NVC(OP_PRM) NVC(OP_KEYS) NVC(OP_GLA3) NVC(OP_LRU1) NVC(OP_LRU2) NVC(OP_LRU3)
#undef NVC
        default: break;
        }
        if (__builtin_amdgcn_readfirstlane(tab[i].code) & OPF_NOBAR) __syncthreads(); else { XcdBarrier bar; bar.bar = (unsigned*)a.ws; bar.x = xb_xcc_id(); bar.st = ctl + 8; xcd_barrier(bar); }
    }
}
extern "C" void kernel_launch(void* const* d_in, const int* in_sizes, int n_in, void* d_out, int out_size, void* d_ws, size_t ws_size, hipStream_t stream) {
    static int grid = 0;
    if (grid == 0) {
        if (n_in != 47 || ws_size < ((size_t)900 << 20)) { fprintf(stderr, "kernel_launch: expected 47 inputs and >= 900 MiB of workspace; got %d, %zu\n", n_in, ws_size); grid = -1; return; }
        int dev = 0, cus = 0, per_cu = 0;
        if (hipGetDevice(&dev) != hipSuccess || hipDeviceGetAttribute(&cus, hipDeviceAttributeMultiprocessorCount, dev) != hipSuccess) { grid = -1; return; }
        if (hipFuncSetAttribute((const void*)mega_fwd, hipFuncAttributeMaxDynamicSharedMemorySize, LDS_BYTES) != hipSuccess) { fprintf(stderr, "kernel_launch: hipFuncSetAttribute failed\n"); grid = -1; return; }
        if (hipOccupancyMaxActiveBlocksPerMultiprocessor(&per_cu, (const void*)mega_fwd, MK_THREADS, LDS_BYTES) != hipSuccess || per_cu < 1) fprintf(stderr, "kernel_launch: occupancy query says %d per CU\n", per_cu);
        (void)hipGetLastError();
        grid = cus;
    }
    if (grid < 0) return;
    if (hipMemsetAsync(d_ws, 0, CTL_BYTES, stream) != hipSuccess) { fprintf(stderr, "kernel_launch: memset failed\n"); return; }
    MArgs a{}; for (int i = 0; i < 47; ++i) a.in[i] = (const float*)d_in[i]; a.out = (float*)d_out; a.ws = (char*)d_ws; a.ws_size = (unsigned long long)ws_size;
    hipLaunchKernelGGL(mega_fwd, dim3(grid), dim3(MK_THREADS), LDS_BYTES, stream, a);
}
```

```cpp
#include <hip/hip_runtime.h>
#include <cstdio>
#include <cmath>
#ifndef HD
#define HD __host__ __device__ __forceinline__
#endif
struct Dm { int D, B, T, DB, DT, M, NSEQ, RH; };
HD Dm make_dm(int D, int B, int SEQ, int DB, int DT) { Dm d; d.D = D; d.B = B; d.T = SEQ + 16; d.DB = DB; d.DT = DT; d.M = B * d.T + DB * DT; d.NSEQ = B + DB; d.RH = D / 64; return d; }
HD int seq_row0(const Dm& d, int s) { return s < d.B ? s * d.T : d.B * d.T + (s - d.B) * d.DT; }
HD int seq_len(const Dm& d, int s) { return s < d.B ? d.T : d.DT; }
HD void row_to_seq(const Dm& d, int row, int& s, int& t) { if (row < d.B * d.T) { s = row / d.T; t = row % d.T; } else { int r = row - d.B * d.T; s = d.B + r / d.DT; t = r % d.DT; } }

constexpr int MIXIN = 2576, C_Q = 0, C_K = 256, C_V = 512, C_GLR = 1024, C_R = 1040, C_XB = 1552, C_GB = 2064;

enum { OP_EMBED = 1, OP_GEMM, OP_LOGA, OP_GLA, OP_GLANORM, OP_CONV, OP_CONVOUT, OP_LRUG, OP_LRUSCAN, OP_LNRES, OP_MIX, OP_SHIFTOUT,
       OP_RWKVPREP, OP_WKV, OP_RWKVPOST, OP_QNORM, OP_SCORES, OP_TOPK, OP_PACT1, OP_PACT2, OP_POUT, OP_YOUT, OP_WT, OP_CVT, OP_FGEMM, OP_CVTTAB, OP_KEYS, OP_TOPK2, OP_PACT, OP_POUTLN, OP_GLA1, OP_GLA2, OP_GLA3, OP_LRU1, OP_LRU2, OP_LRU3, OP_EMBED4, OP_YOUT4, OP_MIX8, OP_CONV4, OP_CVT8, OP_WGATE, OP_LRUG2, OP_WKVF, OP_GLAF, OP_CVTTAB8, OP_CVTTAB8S, OP_PACTS, OP_PRED, OP_POUTS, OP_MIX6, OP_PRM, OP_WKVP, OP_POST2, OP_LOGA4 };

constexpr int OPF_NOBAR = 0x100, OPF_GROUP = 0x200;
struct Op {
    const float *a, *b, *c, *d, *e, *f, *g, *h;
    float *o0, *o1, *o2, *o3, *o4, *o5;
    long long n;
    int code, i0, i1, i2, i3, i4, i5, i6;
};

#if defined(__HIP_DEVICE_COMPILE__)
#define NV_UNI(x) __builtin_amdgcn_readfirstlane(x)
#define NV_LAUNDER(p) asm volatile("" : "+s"(p))
#define NV_FENCE() asm volatile("" ::: "memory")
#else
#define NV_FENCE() do {} while (0)
#define NV_UNI(x) (x)
#define NV_LAUNDER(p) do {} while (0)
#endif
typedef unsigned short nvbf;
HD nvbf nv_f2bf(float f) { unsigned u; __builtin_memcpy(&u, &f, 4); return (nvbf)((u + 0x7fffu + ((u >> 16) & 1u)) >> 16); }
HD float nv_bf2f(nvbf h) { unsigned u = (unsigned)h << 16; float f; __builtin_memcpy(&f, &u, 4); return f; }
HD unsigned nv_f2e4m3(float f) {
    unsigned u; __builtin_memcpy(&u, &f, 4); const unsigned sign = (u >> 24) & 0x80u; const float a = fabsf(f);
    if (!(a < 448.f)) return sign | 0x7Eu;
    if (a < 0.015625f) return sign | (unsigned)rintf(a * 512.f);
    unsigned au = u & 0x7fffffffu; au += 0x7ffffu + ((au >> 20) & 1u);
    const unsigned e = ((au >> 23) & 0xffu) - 120u, m = (au >> 20) & 7u; unsigned code = (e << 3) | m; if (code > 0x7Eu) code = 0x7Eu;
    return sign | code; }
HD float nv_e4m32f(unsigned c) { const unsigned e = (c >> 3) & 15u, m = c & 7u; const float v = e ? ldexpf(1.f + m * 0.125f, (int)e - 7) : m * 0.001953125f; return (c & 0x80u) ? -v : v; }
HD int nv_rup(int x, int m) { return (x + m - 1) / m * m; }
struct alignas(16) NvF4 { float x, y, z, w; };
struct alignas(16) NvU4 { unsigned x, y, z, w; };
struct alignas(8) NvU2 { unsigned x, y; };
#if defined(__HIP_DEVICE_COMPILE__)
#define NV_EXP(x) __expf(x)
#define NV_TANH(x) (1.f - 2.f * __builtin_amdgcn_rcpf(1.f + __expf(2.f * (x))))
HD float nv_sigmoid(float x) { return __builtin_amdgcn_rcpf(1.f + __expf(-x)); }
HD float nv_softplus(float x) { return fmaxf(x, 0.f) + __logf(1.f + __expf(-fabsf(x))); }
HD float nv_gelu(float x) { return x * __builtin_amdgcn_rcpf(1.f + __expf(-1.5957691216057308f * (x + 0.044715f * x * x * x))); }
#else
#define NV_EXP(x) expf(x)
#define NV_TANH(x) tanhf(x)
HD float nv_sigmoid(float x) { return 1.f / (1.f + expf(-x)); }
HD float nv_softplus(float x) { return fmaxf(x, 0.f) + log1pf(expf(-fabsf(x))); }
HD float nv_gelu(float x) { return 0.5f * x * (1.f + tanhf(0.7978845608028654f * (x + 0.044715f * x * x * x))); }
#endif

#define NV_INS16(tv, ti, val, idx) do { float _v = (val); int _i = (idx); _Pragma("unroll") for (int _j = 0; _j < 16; ++_j) { if (_v > tv[_j]) { float _tv = tv[_j]; int _ti = ti[_j]; tv[_j] = _v; ti[_j] = _i; _v = _tv; _i = _ti; } } } while (0)

HD void nv_elem(const int code, const Op& p, const Dm& dm, long long gid) {
    const int D = dm.D; float* const PO1 = p.o1; float* const PO2 = p.o2;
    switch (code) {
    case OP_EMBED: {
        int row = (int)(gid / D), c = (int)(gid % D); float v;
        if (row < dm.B * dm.T) { int bb = row / dm.T, t = row % dm.T; v = t < 16 ? p.c[t * D + c] : p.a[((size_t)bb * (dm.T - 16) + (t - 16)) * D + c]; }
        else v = p.b[(size_t)(row - dm.B * dm.T) * D + c];
        p.o0[gid] = v; ((nvbf*)p.o1)[gid] = nv_f2bf(v); } break;
    case OP_GEMM: {
        int N4 = p.i0 >> 2, K = p.i1; int m = (int)(gid / N4), nn = (int)(gid % N4) * 4; const float* A = p.a + (size_t)m * p.i2; const float* Bw = p.b + nn; float c0 = 0.f, c1 = 0.f, c2 = 0.f, c3 = 0.f;
        for (int k = 0; k < K; ++k) { float av = A[k]; if (p.i5 == 1) av = NV_TANH(av); else if (p.i5 == 2) av = nv_sigmoid(av); const NvF4 bv = *(const NvF4*)(Bw + (size_t)k * p.i3);
            c0 = fmaf(av, bv.x, c0); c1 = fmaf(av, bv.y, c1); c2 = fmaf(av, bv.z, c2); c3 = fmaf(av, bv.w, c3); }
        float* C = p.o0 + (size_t)m * p.i4 + nn; C[0] = c0; C[1] = c1; C[2] = c2; C[3] = c3; } break;
    case OP_LOGA: {
        int row = (int)(gid / 256), c = (int)(gid % 256); float z = p.c[c];
        for (int r = 0; r < 16; ++r) z = fmaf(p.a[(size_t)row * MIXIN + C_GLR + r], p.b[r * 256 + c], z);
        p.o0[gid] = NV_EXP(-nv_softplus(-z) * (1.f / 16.f)); } break;
    case OP_GLAF:
    case OP_GLA: {
        int s = (int)(gid / 512), h = (int)((gid / 128) % 4), col = (int)(gid % 128);
        float S[64];
        const float* sin = (s < dm.B) ? nullptr : p.c + (((size_t)(s - dm.B) * 4 + h) * 64) * 128 + col;
#pragma unroll
        for (int k = 0; k < 64; ++k) S[k] = sin ? sin[(size_t)k * 128] : 0.f;
        int r0 = seq_row0(dm, s), L = seq_len(dm, s);
        for (int t = 0; t < L; ++t) {
            const float* pr = p.a + (size_t)(r0 + t) * MIXIN; const float* la = p.b + (size_t)(r0 + t) * 256 + h * 64;
            float v = pr[C_V + h * 128 + col], o = 0.f;
#pragma unroll
            for (int k = 0; k < 64; ++k) { if ((k & 7) == 0) NV_FENCE(); S[k] = fmaf(la[k], S[k], pr[C_K + h * 64 + k] * v); o = fmaf(pr[C_Q + h * 64 + k] * 0.125f, S[k], o); }
            p.o0[(size_t)(r0 + t) * 512 + h * 128 + col] = o;
        }
        float* so = (s < dm.B) ? PO1 + (((size_t)s * 4 + h) * 64) * 128 + col : PO2 + (((size_t)(s - dm.B) * 4 + h) * 64) * 128 + col;
#pragma unroll
        for (int k = 0; k < 64; ++k) so[(size_t)k * 128] = S[k]; } break;
    case OP_GLA1: {
        const int NC = p.i0; const int u = NV_UNI((int)(gid / 128)), col = (int)(gid % 128); const int s = u / (4 * NC), h = (u / NC) % 4, c = u % NC;
        const int r0 = seq_row0(dm, s) + c * 64; int L = dm.T - c * 64; L = L > 64 ? 64 : L;
        float S[64];
#pragma unroll
        for (int k = 0; k < 64; ++k) S[k] = 0.f;
        float dprod = 1.f;
        for (int t = 0; t < L; ++t) {
            const float* pr = p.a + (size_t)(r0 + t) * MIXIN; const float* la = p.b + (size_t)(r0 + t) * 256 + h * 64; const float v = pr[C_V + h * 128 + col];
            if (col < 64) dprod *= la[col];
#pragma unroll
            for (int k = 0; k < 64; ++k) { if ((k & 7) == 0) NV_FENCE(); S[k] = fmaf(la[k], S[k], pr[C_K + h * 64 + k] * v); }
        }
        float* so = p.o0 + (size_t)u * 8192 + col;
#pragma unroll
        for (int k = 0; k < 64; ++k) so[(size_t)k * 128] = S[k];
        if (col < 64) p.o1[(size_t)u * 64 + col] = dprod; } break;
    case OP_GLA2: {
        const int NC = p.i0; const int pair = (int)(gid / 8192), e = (int)(gid % 8192), dk = e / 128; float S = 0.f;
        for (int c = 0; c < NC; ++c) { const size_t ix = ((size_t)pair * NC + c) * 8192 + e; const float l = p.o0[ix]; p.o0[ix] = S; S = fmaf(p.a[((size_t)pair * NC + c) * 64 + dk], S, l); }
        p.o1[gid] = S; } break;
    case OP_GLA3: {
        const int NC = p.i0; const int NP = dm.B * 4 * NC; const int u = NV_UNI((int)(gid / 128)) + (p.i1 ? NP : 0), col = (int)(gid % 128); int s, h, r0, L; const float* sin; float* sout = nullptr;
        if (u < NP) { s = u / (4 * NC); h = (u / NC) % 4; const int c = u % NC; r0 = seq_row0(dm, s) + c * 64; L = dm.T - c * 64; L = L > 64 ? 64 : L; sin = p.d + (size_t)u * 8192 + col; }
        else { const int q = u - NP; s = dm.B + q / 4; h = q % 4; r0 = seq_row0(dm, s); L = dm.DT; sin = p.c + (((size_t)(s - dm.B) * 4 + h) * 64) * 128 + col; sout = p.o2 + (((size_t)(s - dm.B) * 4 + h) * 64) * 128 + col; }
        float S[64];
#pragma unroll
        for (int k = 0; k < 64; ++k) S[k] = sin[(size_t)k * 128];
        for (int t = 0; t < L; ++t) {
            const float* pr = p.a + (size_t)(r0 + t) * MIXIN; const float* la = p.b + (size_t)(r0 + t) * 256 + h * 64; const float v = pr[C_V + h * 128 + col]; float o = 0.f;
#pragma unroll
            for (int k = 0; k < 64; ++k) { if ((k & 7) == 0) NV_FENCE(); S[k] = fmaf(la[k], S[k], pr[C_K + h * 64 + k] * v); o = fmaf(pr[C_Q + h * 64 + k] * 0.125f, S[k], o); }
            p.o0[(size_t)(r0 + t) * 512 + h * 128 + col] = o;
        }
        if (sout) {
#pragma unroll
            for (int k = 0; k < 64; ++k) sout[(size_t)k * 128] = S[k]; } } break;
    case OP_LRU1: {
        const int NC = p.i0; const int u = (int)(gid / 512), c = (int)(gid % 512); const int s = u / NC, ch = u % NC; const int r0 = seq_row0(dm, s) + ch * 64; int L = dm.T - ch * 64; L = L > 64 ? 64 : L; float hh = 0.f, ap = 1.f;
#pragma unroll 8
        for (int t = 0; t < L; ++t) { const size_t ix = (size_t)(r0 + t) * 512 + c; const float a = p.a[ix]; hh = fmaf(a, hh, p.b[ix]); ap *= a; }
        p.o0[gid] = ap; p.o1[gid] = hh; } break;
    case OP_LRU2: {
        const int NC = p.i0; const int s = (int)(gid / 512), c = (int)(gid % 512); float hh = 0.f;
#pragma unroll 8
        for (int ch = 0; ch < NC; ++ch) { const size_t ix = ((size_t)s * NC + ch) * 512 + c; const float l = p.o0[ix]; p.o0[ix] = hh; hh = fmaf(p.a[ix], hh, l); }
        p.o1[gid] = hh; } break;
    case OP_LRU3: {
        const int NC = p.i0; const int u = (int)(gid / 512), c = (int)(gid % 512); const int NP = dm.B * NC; int r0, L; float hh; float* hout = nullptr;
        if (u < NP) { const int s = u / NC, ch = u % NC; r0 = seq_row0(dm, s) + ch * 64; L = dm.T - ch * 64; L = L > 64 ? 64 : L; hh = p.e[gid]; }
        else { const int q = u - NP; r0 = seq_row0(dm, dm.B + q); L = dm.DT; hh = p.d[(size_t)q * 512 + c]; hout = p.o2 + (size_t)q * 512 + c; }
        for (int t0 = 0; t0 < L; t0 += 8) {
            float av[8], bv[8], gv[8];
#pragma unroll
            for (int k = 0; k < 8; ++k) { int t = t0 + k; t = t < L ? t : L - 1; const size_t r = (size_t)(r0 + t); av[k] = p.a[r * 512 + c]; bv[k] = p.b[r * 512 + c]; gv[k] = p.c[r * MIXIN + C_GB + c]; }
#pragma unroll
            for (int k = 0; k < 8; ++k) if (t0 + k < L) { const size_t r = (size_t)(r0 + t0 + k); hh = fmaf(av[k], hh, bv[k]); ((nvbf*)p.o0)[r * 1024 + 512 + c] = nv_f2bf(hh * nv_gelu(gv[k])); } }
        if (hout) *hout = hh; } break;
    case OP_EMBED4: {
        const int D4 = D / 4; const int row = (int)(gid / D4), c = (int)(gid % D4) * 4; const float* src;
        if (row < dm.B * dm.T) { const int bb = row / dm.T, t = row % dm.T; src = t < 16 ? p.c + (size_t)t * D + c : p.a + ((size_t)bb * (dm.T - 16) + (t - 16)) * D + c; } else src = p.b + (size_t)(row - dm.B * dm.T) * D + c;
        const NvF4 v = *(const NvF4*)src; NvU2 w; w.x = nv_f2bf(v.x) | ((unsigned)nv_f2bf(v.y) << 16); w.y = nv_f2bf(v.z) | ((unsigned)nv_f2bf(v.w) << 16); *(NvU2*)((nvbf*)p.o1 + (size_t)row * D + c) = w; } break;
    case OP_YOUT4: {
        const int D4 = D / 4; const int row = (int)(gid / D4), c = (int)(gid % D4) * 4; const NvU2 w_ = *(const NvU2*)((const nvbf*)p.a + (size_t)row * D + c); NvF4 v; v.x = nv_bf2f((nvbf)(w_.x & 0xffffu)); v.y = nv_bf2f((nvbf)(w_.x >> 16)); v.z = nv_bf2f((nvbf)(w_.y & 0xffffu)); v.w = nv_bf2f((nvbf)(w_.y >> 16));
        if (row < dm.B * dm.T) { const int bb = row / dm.T, t = row % dm.T; if (t >= 16) *(NvF4*)(p.o0 + ((size_t)bb * (dm.T - 16) + (t - 16)) * D + c) = v; }
        else *(NvF4*)(p.o0 + ((size_t)dm.B * (dm.T - 16) + (row - dm.B * dm.T)) * D + c) = v; } break;
    case OP_MIX8: {
        const int D8 = D / 8; const int row = (int)(gid / D8), c = (int)(gid % D8) * 8; int s, t; row_to_seq(dm, row, s, t); const float* x = p.a + (size_t)row * D + c; float xp[8];
        if (t > 0) { for (int i = 0; i < 8; ++i) xp[i] = x[i - D]; } else if (s < dm.B) { for (int i = 0; i < 8; ++i) xp[i] = 0.f; } else { for (int i = 0; i < 8; ++i) xp[i] = p.b[(size_t)(s - dm.B) * D + c + i]; }
        unsigned w[4];
#pragma unroll
        for (int i = 0; i < 4; ++i) { const float lo = x[2 * i] + (xp[2 * i] - x[2 * i]) * p.c[c + 2 * i], hi = x[2 * i + 1] + (xp[2 * i + 1] - x[2 * i + 1]) * p.c[c + 2 * i + 1]; w[i] = nv_f2bf(lo) | ((unsigned)nv_f2bf(hi) << 16); }
        NvU4 o; o.x = w[0]; o.y = w[1]; o.z = w[2]; o.w = w[3]; *(NvU4*)((nvbf*)p.o0 + (size_t)row * D + c) = o; } break;
    case OP_MIX6: {
        const int D8 = D / 8; const int row = (int)(gid / D8), c = (int)(gid % D8) * 8; int s, t; row_to_seq(dm, row, s, t); const nvbf* x = (const nvbf*)p.a + (size_t)row * D + c; float xv[8], dx[8];
        { const NvU4 w_ = *(const NvU4*)x; xv[0] = nv_bf2f((nvbf)(w_.x & 0xffffu)); xv[1] = nv_bf2f((nvbf)(w_.x >> 16)); xv[2] = nv_bf2f((nvbf)(w_.y & 0xffffu)); xv[3] = nv_bf2f((nvbf)(w_.y >> 16));
          xv[4] = nv_bf2f((nvbf)(w_.z & 0xffffu)); xv[5] = nv_bf2f((nvbf)(w_.z >> 16)); xv[6] = nv_bf2f((nvbf)(w_.w & 0xffffu)); xv[7] = nv_bf2f((nvbf)(w_.w >> 16)); }
        if (t > 0) { const NvU4 w_ = *(const NvU4*)(x - D); dx[0] = nv_bf2f((nvbf)(w_.x & 0xffffu)) - xv[0]; dx[1] = nv_bf2f((nvbf)(w_.x >> 16)) - xv[1]; dx[2] = nv_bf2f((nvbf)(w_.y & 0xffffu)) - xv[2]; dx[3] = nv_bf2f((nvbf)(w_.y >> 16)) - xv[3];
            dx[4] = nv_bf2f((nvbf)(w_.z & 0xffffu)) - xv[4]; dx[5] = nv_bf2f((nvbf)(w_.z >> 16)) - xv[5]; dx[6] = nv_bf2f((nvbf)(w_.w & 0xffffu)) - xv[6]; dx[7] = nv_bf2f((nvbf)(w_.w >> 16)) - xv[7]; } else if (s < dm.B) { for (int i = 0; i < 8; ++i) dx[i] = -xv[i]; } else { for (int i = 0; i < 8; ++i) dx[i] = p.b[(size_t)(s - dm.B) * D + c + i] - xv[i]; }
        for (int m = 0; m < 6; ++m) { const float* mu = p.c + (size_t)m * D + c; unsigned w[4];
#pragma unroll
            for (int i = 0; i < 4; ++i) w[i] = nv_f2bf(xv[2 * i] + dx[2 * i] * mu[2 * i]) | ((unsigned)nv_f2bf(xv[2 * i + 1] + dx[2 * i + 1] * mu[2 * i + 1]) << 16);
            NvU4 o; o.x = w[0]; o.y = w[1]; o.z = w[2]; o.w = w[3]; *(NvU4*)((nvbf*)p.o0 + (size_t)m * p.i0 * 0 + (size_t)m * (size_t)p.i1 * 1024 + (size_t)row * D + c) = o; } } break;
    case OP_CONV4: {
        const int row = (int)(gid / 128), c = (int)(gid % 128) * 4; int s, t; row_to_seq(dm, row, s, t); float acc[4];
        for (int q = 0; q < 4; ++q) acc[q] = p.d[c + q];
        for (int i = 0; i < 4; ++i) { const int j = t + i; const float* xv = nullptr;
            if (j < 3) { if (s >= dm.B) xv = p.b + ((size_t)(s - dm.B) * 3 + j) * 512 + c; } else xv = p.a + (size_t)(row - t + (j - 3)) * MIXIN + C_XB + c;
            if (xv) for (int q = 0; q < 4; ++q) acc[q] = fmaf(xv[q], p.c[i * 512 + c + q], acc[q]); }
        NvF4 o; o.x = acc[0]; o.y = acc[1]; o.z = acc[2]; o.w = acc[3]; *(NvF4*)(p.o0 + (size_t)row * 512 + c) = o;
        NvU2 w; w.x = nv_f2bf(acc[0]) | ((unsigned)nv_f2bf(acc[1]) << 16); w.y = nv_f2bf(acc[2]) | ((unsigned)nv_f2bf(acc[3]) << 16); *(NvU2*)((nvbf*)p.o1 + (size_t)row * 512 + c) = w; } break;
    case OP_CVT8: {
        const int K8 = p.i2 / 8; const int row = (int)(gid / K8), k = (int)(gid % K8) * 8; unsigned w[4] = {0u, 0u, 0u, 0u};
        if (row < dm.M && k < p.i0) { const float* sp = p.a + (size_t)row * p.i1 + k;
#pragma unroll
            for (int i = 0; i < 4; ++i) { float lo = sp[2 * i], hi = sp[2 * i + 1]; if (p.i3 == 1) { lo = NV_TANH(lo); hi = NV_TANH(hi); } else if (p.i3 == 2) { lo = nv_sigmoid(lo); hi = nv_sigmoid(hi); } w[i] = nv_f2bf(lo) | ((unsigned)nv_f2bf(hi) << 16); } }
        NvU4 o; o.x = w[0]; o.y = w[1]; o.z = w[2]; o.w = w[3]; *(NvU4*)((nvbf*)p.o0 + (size_t)row * p.i2 + k) = o; } break;
    case OP_WGATE: {
        const int n = (int)gid, pn = n >> 8, within = n & 127, isx = (n >> 7) & 1, c = pn * 128 + within, nb = c >> 6, e = c & 63; const float* w = isx ? p.b : p.a; nvbf* dst = (nvbf*)p.o0 + (size_t)n * 512;
        for (int k = 0; k < 512; ++k) dst[k] = ((k >> 6) == nb) ? nv_f2bf(w[((size_t)nb * 64 + (k & 63)) * 64 + e]) : (nvbf)0;
        if (n < 512) p.o1[n] = -8.f * nv_softplus(-p.c[n]); } break;
    case OP_LRUG2: {
        const int row = (int)(gid / 512), c = (int)(gid % 512), pn = c >> 7, within = c & 127; const nvbf* x = (const nvbf*)p.a + (size_t)row * 512; const nvbf* wa_ = (const nvbf*)p.b + (size_t)(pn * 256 + within) * 512; const nvbf* wx_ = wa_ + (size_t)128 * 512; float ga = 0.f, gx = 0.f;
        for (int k = 0; k < 512; ++k) { const float xv = nv_bf2f(x[k]); ga = fmaf(xv, nv_bf2f(wa_[k]), ga); gx = fmaf(xv, nv_bf2f(wx_[k]), gx); }
        const float gate_a = nv_sigmoid(ga + p.c[c]), gate_x = nv_sigmoid(gx + p.d[c]); const float log_at = gate_a * p.e[c];
        p.o0[gid] = NV_EXP(log_at); p.o1[gid] = sqrtf(-expm1f(2.f * log_at)) * (gate_x * p.f[gid]); } break;
    case OP_LOGA4: {
        const int row = (int)(gid / 64), c = (int)(gid % 64) * 4; const float* gl = p.a + (size_t)row * MIXIN + C_GLR; NvF4 z = *(const NvF4*)(p.c + c);
#pragma unroll
        for (int r4 = 0; r4 < 4; ++r4) { const NvF4 g = *(const NvF4*)(gl + 4 * r4);
            const NvF4 w0 = *(const NvF4*)(p.b + (4 * r4 + 0) * 256 + c), w1 = *(const NvF4*)(p.b + (4 * r4 + 1) * 256 + c), w2 = *(const NvF4*)(p.b + (4 * r4 + 2) * 256 + c), w3 = *(const NvF4*)(p.b + (4 * r4 + 3) * 256 + c);
            z.x = fmaf(g.x, w0.x, z.x); z.y = fmaf(g.x, w0.y, z.y); z.z = fmaf(g.x, w0.z, z.z); z.w = fmaf(g.x, w0.w, z.w); z.x = fmaf(g.y, w1.x, z.x); z.y = fmaf(g.y, w1.y, z.y); z.z = fmaf(g.y, w1.z, z.z); z.w = fmaf(g.y, w1.w, z.w);
            z.x = fmaf(g.z, w2.x, z.x); z.y = fmaf(g.z, w2.y, z.y); z.z = fmaf(g.z, w2.z, z.z); z.w = fmaf(g.z, w2.w, z.w); z.x = fmaf(g.w, w3.x, z.x); z.y = fmaf(g.w, w3.y, z.y); z.z = fmaf(g.w, w3.z, z.z); z.w = fmaf(g.w, w3.w, z.w); }
        NvF4 o; o.x = NV_EXP(-nv_softplus(-z.x) * (1.f / 16.f)); o.y = NV_EXP(-nv_softplus(-z.y) * (1.f / 16.f)); o.z = NV_EXP(-nv_softplus(-z.z) * (1.f / 16.f)); o.w = NV_EXP(-nv_softplus(-z.w) * (1.f / 16.f));
        *(NvF4*)(p.o0 + (size_t)row * 256 + c) = o; } break;
    case OP_GLANORM: {
        int row = (int)(gid / 4), h = (int)(gid % 4); const float* o = p.a + (size_t)row * 512 + h * 128; float ss = 0.f;
        for (int c = 0; c < 128; ++c) ss = fmaf(o[c], o[c], ss);
        float rs = 1.f / sqrtf(ss * (1.f / 128.f) + 1e-5f);
        for (int c = 0; c < 128; ++c) { float r = p.b[(size_t)row * MIXIN + C_R + h * 128 + c]; ((nvbf*)p.o0)[(size_t)row * 1024 + h * 128 + c] = nv_f2bf(o[c] * rs * p.c[c] * (r * nv_sigmoid(r))); } } break;
    case OP_CONV: {
        int row = (int)(gid / 512), c = (int)(gid % 512); int s, t; row_to_seq(dm, row, s, t); float acc = p.d[c];
        for (int i = 0; i < 4; ++i) { int j = t + i; float xv;
            if (j < 3) xv = (s < dm.B) ? 0.f : p.b[((size_t)(s - dm.B) * 3 + j) * 512 + c]; else xv = p.a[(size_t)(row - t + (j - 3)) * MIXIN + C_XB + c];
            acc = fmaf(xv, p.c[i * 512 + c], acc); }
        p.o0[gid] = acc; } break;
    case OP_CONVOUT: {
        int s = (int)(gid / 1536), i = (int)((gid / 512) % 3), c = (int)(gid % 512); int L = seq_len(dm, s), r0 = seq_row0(dm, s); int j = L + i; float xv;
        if (j < 3) xv = (s < dm.B) ? 0.f : p.b[((size_t)(s - dm.B) * 3 + j) * 512 + c]; else xv = p.a[(size_t)(r0 + j - 3) * MIXIN + C_XB + c];
        float* o = (s < dm.B) ? PO1 + ((size_t)s * 3 + i) * 512 + c : PO2 + ((size_t)(s - dm.B) * 3 + i) * 512 + c; *o = xv; } break;
    case OP_LRUG: {
        int row = (int)(gid / 512), c = (int)(gid % 512), nb = c / 64, e = c % 64; const float* x = p.a + (size_t)row * 512 + nb * 64; float ga = p.c[c], gx = p.e[c];
        for (int dd = 0; dd < 64; ++dd) { ga = fmaf(x[dd], p.b[((size_t)nb * 64 + dd) * 64 + e], ga); gx = fmaf(x[dd], p.d[((size_t)nb * 64 + dd) * 64 + e], gx); }
        float gate_a = nv_sigmoid(ga), gate_x = nv_sigmoid(gx); float log_at = -8.f * gate_a * nv_softplus(-p.f[c]);
        p.o0[gid] = NV_EXP(log_at); p.o1[gid] = sqrtf(-expm1f(2.f * log_at)) * (gate_x * p.a[(size_t)row * 512 + c]); } break;
    case OP_LRUSCAN: {
        int s = (int)(gid / 512), c = (int)(gid % 512); int r0 = seq_row0(dm, s), L = seq_len(dm, s); float hh = (s < dm.B) ? 0.f : p.d[(size_t)(s - dm.B) * 512 + c];
        for (int t = 0; t < L; ++t) { size_t r = (size_t)(r0 + t); hh = fmaf(p.a[r * 512 + c], hh, p.b[r * 512 + c]); p.o0[r * 1024 + 512 + c] = hh * nv_gelu(p.c[r * MIXIN + C_GB + c]); }
        float* o = (s < dm.B) ? PO1 + (size_t)s * 512 + c : PO2 + (size_t)(s - dm.B) * 512 + c; *o = hh; } break;
    case OP_LNRES: {
        const float alpha = 1.6817928305074292f; nvbf* x = (nvbf*)p.o1 + (size_t)gid * D; const nvbf* y = (const nvbf*)p.a + (size_t)gid * D; float mu = 0.f;
        for (int c = 0; c < D; ++c) mu += alpha * nv_bf2f(x[c]) + nv_bf2f(y[c]);
        mu /= D; float var = 0.f;
        for (int c = 0; c < D; ++c) { float v = alpha * nv_bf2f(x[c]) + nv_bf2f(y[c]) - mu; var = fmaf(v, v, var); }
        float rs = 1.f / sqrtf(var / D + 1e-5f);
        for (int c = 0; c < D; ++c) { const float o = (alpha * nv_bf2f(x[c]) + nv_bf2f(y[c]) - mu) * rs * p.b[c] + p.c[c]; x[c] = nv_f2bf(o);
            if (p.o2) { unsigned char* f8 = (unsigned char*)p.o2 + (size_t)gid * 2 * D; const float xs = fminf(fmaxf(o * 16.f, -448.f), 448.f); const unsigned hc = nv_f2e4m3(xs); f8[c] = (unsigned char)hc; f8[D + c] = (unsigned char)nv_f2e4m3(xs - nv_e4m32f(hc)); } } } break;
    case OP_MIX: {
        int row = (int)(gid / D), c = (int)(gid % D); int s, t; row_to_seq(dm, row, s, t); float x = p.a[gid];
        float xp = t > 0 ? p.a[gid - D] : ((s < dm.B) ? 0.f : p.b[(size_t)(s - dm.B) * D + c]);
        ((nvbf*)p.o0)[gid] = nv_f2bf(x + (xp - x) * p.c[c]); } break;
    case OP_SHIFTOUT: {
        int s = (int)(gid / D), c = (int)(gid % D); float v = nv_bf2f(((const nvbf*)p.a)[(size_t)(seq_row0(dm, s) + seq_len(dm, s) - 1) * D + c]);
        float* o = (s < dm.B) ? PO1 + (size_t)s * D + c : PO2 + (size_t)(s - dm.B) * D + c; *o = v; } break;
    case OP_RWKVPREP: {
        int row = (int)(gid / dm.RH), h = (int)(gid % dm.RH); size_t base = (size_t)row * D + h * 64; float ss = 0.f;
        for (int k = 0; k < 64; ++k) { float kv = p.o0[base + k] * p.d[h * 64 + k]; ss = fmaf(kv, kv, ss); }
        float inv = 1.f / fmaxf(sqrtf(ss), 1e-12f);
        for (int k = 0; k < 64; ++k) { int c = h * 64 + k; size_t ix = base + k;
            float w = -nv_softplus(-(p.a[c] + p.o1[ix])) - 0.5f; float dec = NV_EXP(-NV_EXP(w));
            float a = nv_sigmoid(p.b[c] + p.o2[ix]);
            float v = p.o3[ix]; if (p.i0) v = v + (p.o5[ix] - v) * nv_sigmoid(p.c[c] + p.f[ix]); else p.o5[ix] = v;
            float k0 = p.o0[ix]; const float kk = k0 * p.d[c] * inv; p.o4[ix] = -kk; p.o0[ix] = k0 * (1.f + (a - 1.f) * p.e[c]); p.o1[ix] = dec; p.o2[ix] = kk * a; p.o3[ix] = v; } } break;
    case OP_WKVF:
    case OP_WKV: {
        int RH = dm.RH; int s = p.i0 + (int)(gid / (RH * 64)), h = (int)((gid / 64) % RH), vr = (int)(gid % 64); float S[64];
        const float* sin = (s < dm.B) ? nullptr : p.g + (((size_t)(s - dm.B) * RH + h) * 64 + vr) * 64;
#pragma unroll
        for (int k = 0; k < 64; ++k) S[k] = sin ? sin[k] : 0.f;
        int r0 = seq_row0(dm, s), L = seq_len(dm, s);
        for (int t = 0; t < L; ++t) { size_t base = (size_t)(r0 + t) * D + h * 64; float sa = 0.f;
#pragma unroll
            for (int k = 0; k < 64; ++k) { if ((k & 7) == 0) NV_FENCE(); sa = fmaf(S[k], p.f[base + k], sa); }
            float vv = p.d[base + vr], y = 0.f;
#pragma unroll
            for (int k = 0; k < 64; ++k) { if ((k & 7) == 0) NV_FENCE(); S[k] = fmaf(S[k], p.b[base + k], fmaf(sa, p.e[base + k], vv * p.c[base + k])); y = fmaf(S[k], p.a[base + k], y); }
            p.o0[base + vr] = y; }
        float* so = (s < dm.B) ? PO1 + (((size_t)s * RH + h) * 64 + vr) * 64 : PO2 + (((size_t)(s - dm.B) * RH + h) * 64 + vr) * 64;
#pragma unroll
        for (int k = 0; k < 64; ++k) so[k] = S[k]; } break;
    case OP_RWKVPOST: {
        int row = (int)(gid / dm.RH), h = (int)(gid % dm.RH); size_t base = (size_t)row * D + h * 64; float mu = 0.f, bon = 0.f;
        for (int k = 0; k < 64; ++k) { mu += p.a[base + k]; bon = fmaf(p.b[base + k] * p.c[base + k], p.f[h * 64 + k], bon); }
        mu *= (1.f / 64.f); float var = 0.f;
        for (int k = 0; k < 64; ++k) { float dlt = p.a[base + k] - mu; var = fmaf(dlt, dlt, var); }
        float rs = 1.f / sqrtf(var * (1.f / 64.f) + 64e-5f);
        for (int k = 0; k < 64; ++k) { int c = h * 64 + k; float y = (p.a[base + k] - mu) * rs * p.g[c] + p.h[c] + bon * p.d[base + k]; ((nvbf*)p.o0)[base + k] = nv_f2bf(y * p.e[base + k]); } } break;
    case OP_PRM: {
        const int m = (int)(gid / D), c = (int)(gid % D); const float* src = m == 0 ? p.a : m == 1 ? p.b : m == 2 ? p.c : m == 3 ? p.d : m == 4 ? p.e : p.f; p.o0[gid] = src ? src[c] : 0.f; } break;
    case OP_WKVP: {
        const int RH = dm.RH; const int s = (int)(gid / (RH * 64)), h = (int)((gid / 64) % RH), vr = (int)(gid % 64); float S[64];
        const float* sin = (s < dm.B) ? nullptr : p.o5 + (((size_t)(s - dm.B) * RH + h) * 64 + vr) * 64;
        for (int k = 0; k < 64; ++k) S[k] = sin ? sin[k] : 0.f;
        const float* w0 = p.h + h * 64; const float* a0 = p.h + D + h * 64; const float* v0 = p.h + 2 * D + h * 64; const float* k_k = p.h + 3 * D + h * 64; const float* k_a = p.h + 4 * D + h * 64; const float* r_k = p.h + 5 * D + h * 64;
        const int r0 = seq_row0(dm, s), L = seq_len(dm, s); const nvbf* bR = (const nvbf*)p.a; const nvbf* bK = (const nvbf*)p.b; const nvbf* bWL = (const nvbf*)p.c; const nvbf* bAL = (const nvbf*)p.d; const nvbf* bV = (const nvbf*)p.e; const nvbf* bVG = (const nvbf*)p.f;
        for (int t = 0; t < L; ++t) { const size_t base = (size_t)(r0 + t) * D + h * 64; float ss = 0.f;
            for (int k = 0; k < 64; ++k) { const float kv = nv_bf2f(bK[base + k]) * k_k[k]; ss = fmaf(kv, kv, ss); }
            const float inv = 1.f / fmaxf(sqrtf(ss), 1e-12f);
            float vv = nv_bf2f(bV[base + vr]); if (p.i0) vv = vv + (p.g[base + vr] - vv) * nv_sigmoid(v0[vr] + nv_bf2f(bVG[base + vr]));
            float sa = 0.f, bon = 0.f, dec[64], bb[64], k2[64];
            for (int k = 0; k < 64; ++k) { const float k0 = nv_bf2f(bK[base + k]); const float kk = k0 * k_k[k] * inv; const float a = nv_sigmoid(a0[k] + nv_bf2f(bAL[base + k]));
                dec[k] = NV_EXP(-0.6065306597126334f * nv_sigmoid(w0[k] + nv_bf2f(bWL[base + k])));
                bb[k] = kk * a; k2[k] = k0 * (1.f + (a - 1.f) * k_a[k]); sa = fmaf(S[k], -kk, sa); bon = fmaf(nv_bf2f(bR[base + k]) * k2[k], r_k[k], bon); }
            float y = 0.f;
            for (int k = 0; k < 64; ++k) { S[k] = fmaf(S[k], dec[k], fmaf(sa, bb[k], vv * k2[k])); y = fmaf(S[k], nv_bf2f(bR[base + k]), y); }
            p.o0[base + vr] = y; p.o3[base + vr] = vv; if (vr == 0) p.o4[(size_t)(r0 + t) * RH + h] = bon; }
        float* so = (s < dm.B) ? PO1 + (((size_t)s * RH + h) * 64 + vr) * 64 : PO2 + (((size_t)(s - dm.B) * RH + h) * 64 + vr) * 64;
        for (int k = 0; k < 64; ++k) so[k] = S[k]; } break;
    case OP_POST2: {
        const int row = (int)(gid / dm.RH), h = (int)(gid % dm.RH); const size_t base = (size_t)row * D + h * 64; float mu = 0.f;
        for (int k = 0; k < 64; ++k) mu += p.a[base + k];
        mu *= (1.f / 64.f); float var = 0.f;
        for (int k = 0; k < 64; ++k) { const float dlt = p.a[base + k] - mu; var = fmaf(dlt, dlt, var); }
        const float rs = 1.f / sqrtf(var * (1.f / 64.f) + 64e-5f), bon = p.d[gid];
        for (int k = 0; k < 64; ++k) { const int c = h * 64 + k; const float y = (p.a[base + k] - mu) * rs * p.e[c] + p.f[c] + bon * p.c[base + k]; ((nvbf*)p.o0)[base + k] = nv_f2bf(y * nv_bf2f(((const nvbf*)p.b)[base + k])); } } break;
    case OP_QNORM: {
        float* q = p.o0 + (size_t)gid * 256; float mu = 0.f;
        for (int c = 0; c < 256; ++c) mu += q[c];
        mu *= (1.f / 256.f); float var = 0.f;
        for (int c = 0; c < 256; ++c) { float dlt = q[c] - mu; var = fmaf(dlt, dlt, var); }
        float rs = 1.f / sqrtf(var * (1.f / 256.f) + 1e-5f);
        for (int c = 0; c < 256; ++c) q[c] = (q[c] - mu) * rs; } break;
    case OP_SCORES: {
        int row = (int)(gid / 2048), r = (int)(gid % 2048), h = r / 256, half = (r / 128) & 1, key = r % 128;
        const float* q = p.a + (size_t)row * 2048 + h * 256 + half * 128; const float* kv = p.b + (((size_t)h * 2 + half) * 128 + key) * 128; float acc = 0.f;
        for (int dd = 0; dd < 128; ++dd) acc = fmaf(q[dd], kv[dd], acc);
        p.o0[gid] = acc; } break;
    case OP_TOPK: {
        const float* sc = p.a + (size_t)gid * 256; float tv[16]; int ti[16]; float* tmpv = p.o2 + (size_t)gid * 32; int* tmpi = (int*)p.o3 + (size_t)gid * 32;
        for (int half = 0; half < 2; ++half) {
#pragma unroll
            for (int j = 0; j < 16; ++j) { tv[j] = -3.0e38f; ti[j] = 0; }
            for (int k = 0; k < 128; ++k) NV_INS16(tv, ti, sc[half * 128 + k], k);
#pragma unroll
            for (int j = 0; j < 16; ++j) { tmpv[half * 16 + j] = tv[j]; tmpi[half * 16 + j] = ti[j]; }
        }
#pragma unroll
        for (int j = 0; j < 16; ++j) { tv[j] = -3.0e38f; ti[j] = 0; }
        for (int i = 0; i < 16; ++i) for (int j = 0; j < 16; ++j) NV_INS16(tv, ti, tmpv[i] + tmpv[16 + j], tmpi[i] * 128 + tmpi[16 + j]);
        float den = 0.f, ev[16];
#pragma unroll
        for (int j = 0; j < 16; ++j) { ev[j] = NV_EXP(tv[j] - tv[0]); den += ev[j]; }
        float inv = 1.f / den;
#pragma unroll
        for (int j = 0; j < 16; ++j) { p.o0[(size_t)gid * 16 + j] = ev[j] * inv; ((int*)p.o1)[(size_t)gid * 16 + j] = ti[j]; } } break;
    case OP_PACT1: {
        size_t pr = (size_t)(gid / 16); int part = (int)(gid % 16); int row = (int)(pr / 128); int e = ((const int*)p.d)[pr]; int w = D / 16;
        const float* u = p.b + (size_t)e * D + part * w; const float* x = p.a + (size_t)row * D + part * w; float acc = 0.f;
        for (int c = 0; c < w; ++c) acc = fmaf(u[c], x[c], acc);
        p.o0[gid] = acc; } break;
    case OP_PACT2: {
        float acc = 0.f; for (int i = 0; i < 16; ++i) acc += p.a[(size_t)gid * 16 + i];
        p.o0[gid] = p.c[gid] * nv_gelu(acc); } break;
    case OP_POUT: {
        int row = (int)(gid / D), c = (int)(gid % D); float acc = 0.f;
        for (int i = 0; i < 128; ++i) acc = fmaf(p.a[(size_t)row * 128 + i], p.c[(size_t)((const int*)p.b)[(size_t)row * 128 + i] * D + c], acc);
        p.o0[gid] = acc; } break;
    case OP_YOUT: {
        int row = (int)(gid / D), c = (int)(gid % D);
        if (row < dm.B * dm.T) { int bb = row / dm.T, t = row % dm.T; if (t >= 16) p.o0[((size_t)bb * (dm.T - 16) + (t - 16)) * D + c] = p.a[gid]; }
        else p.o0[((size_t)dm.B * (dm.T - 16) + (row - dm.B * dm.T)) * D + c] = p.a[gid]; } break;
    case OP_WT: {
        const int N = p.i0, K = p.i1, Np = p.i3, Kp = p.i4; const long long per8 = (long long)Np * (Kp / 8); const int bt = (int)(gid / per8); const long long r = gid % per8; const int k0 = (int)(r / Np) * 8, nn = (int)(r % Np);
        unsigned w[4];
#pragma unroll
        for (int i = 0; i < 4; ++i) { float lo = 0.f, hi = 0.f; if (nn < N) { if (k0 + 2 * i < K) lo = p.a[((size_t)bt * K + k0 + 2 * i) * p.i2 + nn]; if (k0 + 2 * i + 1 < K) hi = p.a[((size_t)bt * K + k0 + 2 * i + 1) * p.i2 + nn]; } w[i] = nv_f2bf(lo) | ((unsigned)nv_f2bf(hi) << 16); }
        NvU4 o; o.x = w[0]; o.y = w[1]; o.z = w[2]; o.w = w[3];
        *(NvU4*)((nvbf*)p.o0 + (size_t)bt * Np * Kp + (size_t)nn * Kp + k0) = o; } break;
    case OP_CVT: {
        const int Kp = p.i2; const int row = (int)(gid / Kp), k = (int)(gid % Kp); float v = 0.f;
        if (row < dm.M && k < p.i0) { v = p.a[(size_t)row * p.i1 + k]; if (p.i3 == 1) v = NV_TANH(v); else if (p.i3 == 2) v = nv_sigmoid(v); }
        ((nvbf*)p.o0)[gid] = nv_f2bf(v); } break;
    case OP_FGEMM: {
        const int N = p.i0; const int m = (int)(gid / N), nn = (int)(gid % N); const nvbf* A = (const nvbf*)p.a + (size_t)m * p.i2 + ((p.i6 & 2) ? (nn / 256) * 256 : 0); const nvbf* Bt = (const nvbf*)p.b + (size_t)nn * p.i3; float acc = 0.f;
        for (int k = 0; k < p.i1; ++k) acc = fmaf(nv_bf2f(A[k]), nv_bf2f(Bt[k]), acc);
        if (p.i6 & 1) ((nvbf*)p.o0)[(size_t)m * p.i4 + nn] = nv_f2bf(acc); else p.o0[(size_t)m * p.i4 + nn] = acc; } break;
    case OP_CVTTAB: {
        const NvF4 v0 = *(const NvF4*)(p.a + gid * 8), v1 = *(const NvF4*)(p.a + gid * 8 + 4); NvU4 o;
        o.x = nv_f2bf(v0.x) | ((unsigned)nv_f2bf(v0.y) << 16); o.y = nv_f2bf(v0.z) | ((unsigned)nv_f2bf(v0.w) << 16); o.z = nv_f2bf(v1.x) | ((unsigned)nv_f2bf(v1.y) << 16); o.w = nv_f2bf(v1.z) | ((unsigned)nv_f2bf(v1.w) << 16);
        *(NvU4*)((nvbf*)p.o0 + gid * 8) = o; } break;
    case OP_CVTTAB8: {
        const float sc = (float)(1 << p.i0); const float* sp = p.a + gid * 16; unsigned w[4];
#pragma unroll
        for (int q = 0; q < 4; ++q) { const NvF4 v = *(const NvF4*)(sp + 4 * q); w[q] = nv_f2e4m3(v.x * sc) | (nv_f2e4m3(v.y * sc) << 8) | (nv_f2e4m3(v.z * sc) << 16) | (nv_f2e4m3(v.w * sc) << 24); }
        NvU4 o; o.x = w[0]; o.y = w[1]; o.z = w[2]; o.w = w[3]; *(NvU4*)((unsigned char*)p.o0 + gid * 16) = o; } break;
    case OP_CVTTAB8S: {
        const float sc = (float)(1 << p.i0); const int per = D / 16; const int e = (int)(gid / per), c0 = (int)(gid % per) * 16; const float* sp = p.a + (size_t)e * D + c0; unsigned w[4];
#pragma unroll
        for (int q = 0; q < 4; ++q) { const NvF4 v = *(const NvF4*)(sp + 4 * q);
#if defined(__HIP_DEVICE_COMPILE__)
            int pk = __builtin_amdgcn_cvt_pk_fp8_f32(v.x * sc, v.y * sc, 0, false); pk = __builtin_amdgcn_cvt_pk_fp8_f32(v.z * sc, v.w * sc, pk, true); w[q] = (unsigned)pk;
#else
            w[q] = nv_f2e4m3(v.x * sc) | (nv_f2e4m3(v.y * sc) << 8) | (nv_f2e4m3(v.z * sc) << 16) | (nv_f2e4m3(v.w * sc) << 24);
#endif
        }
        NvU4 o; o.x = w[0]; o.y = w[1]; o.z = w[2]; o.w = w[3]; *(NvU4*)((unsigned char*)p.o0 + ((size_t)(c0 >> 7) * 16384 + e) * 128 + (c0 & 127)) = o; } break;
    case OP_PACTS: {
        const long long NP = (long long)dm.M * 128; const int sl = (int)(gid / NP); const long long pr = gid % NP; const int row = (int)(pr / 128); const int e = ((const int*)p.d)[pr] & p.i0;
        const unsigned char* u = (const unsigned char*)p.b + ((size_t)sl * 16384 + e) * 128; const unsigned char* x = (const unsigned char*)p.a + (size_t)row * 2 * D + sl * 128; float acc = 0.f;
        for (int c = 0; c < 128; ++c) acc = fmaf(nv_e4m32f(u[c]), nv_e4m32f(x[c]) + nv_e4m32f(x[D + c]), acc);
        ((nvbf*)p.o0)[gid] = nv_f2bf(acc * (1.f / 16.f)); } break;
    case OP_PRED: {
        const long long NP = (long long)dm.M * 128; const size_t e0 = (size_t)gid * 4; float a0 = 0.f, a1 = 0.f, a2 = 0.f, a3 = 0.f;
#pragma unroll 8
        for (int sl = 0; sl < p.i0; ++sl) { const NvU2 w = *(const NvU2*)((const nvbf*)p.a + (size_t)sl * NP + e0); a0 += nv_bf2f((nvbf)(w.x & 0xffffu)); a1 += nv_bf2f((nvbf)(w.x >> 16)); a2 += nv_bf2f((nvbf)(w.y & 0xffffu)); a3 += nv_bf2f((nvbf)(w.y >> 16)); }
        const NvF4 g = *(const NvF4*)(p.c + e0); NvF4 o; o.x = g.x * nv_gelu(a0 * (1.f / 128.f)); o.y = g.y * nv_gelu(a1 * (1.f / 128.f)); o.z = g.z * nv_gelu(a2 * (1.f / 128.f)); o.w = g.w * nv_gelu(a3 * (1.f / 128.f));
        *(NvF4*)(p.o0 + e0) = o; } break;
    case OP_POUTS: {
        const int row = (int)(gid / D), c = (int)(gid % D); const unsigned char* vb = (const unsigned char*)p.c + (size_t)(c >> 7) * 16384 * 128 + (c & 127); float acc = 0.f;
        for (int i = 0; i < 128; ++i) acc = fmaf(p.a[(size_t)row * 128 + i] * (1.f / 64.f), nv_e4m32f(vb[(size_t)((const int*)p.b)[(size_t)row * 128 + i] * 128]), acc);
        ((nvbf*)p.o0)[gid] = nv_f2bf(acc); } break;
    case OP_KEYS: {
        const int h = (int)(gid / 256), nrow = (int)(gid % 256), half = nrow >> 7; const float* src = p.a + (((size_t)h * 2 + half) * 128 + (nrow & 127)) * 128; nvbf* dst = (nvbf*)p.o0 + ((size_t)h * 256 + nrow) * 256; float ks = 0.f;
        for (int k = 0; k < 256; ++k) { nvbf b = 0; if ((k >> 7) == half) { b = nv_f2bf(src[k & 127]); ks += nv_bf2f(b); } dst[k] = b; }
        p.o1[gid] = ks; } break;
    case OP_TOPK2: {
        const int h = (int)(gid % 8); const float* sc = p.a + (size_t)gid * 256; const nvbf* q = (const nvbf*)p.b + (size_t)gid * 256; const float* ksum = p.c + h * 256; float mu = 0.f;
        for (int c = 0; c < 256; ++c) mu += nv_bf2f(q[c]);
        mu *= (1.f / 256.f); float var = 0.f;
        for (int c = 0; c < 256; ++c) { float dlt = nv_bf2f(q[c]) - mu; var = fmaf(dlt, dlt, var); }
        const float rs = 1.f / sqrtf(var * (1.f / 256.f) + 1e-5f);
        float tv[16]; int ti[16]; float* tmpv = p.o2 + (size_t)gid * 32; int* tmpi = (int*)p.o3 + (size_t)gid * 32;
        for (int half = 0; half < 2; ++half) {
#pragma unroll
            for (int j = 0; j < 16; ++j) { tv[j] = -3.0e38f; ti[j] = 0; }
            for (int k = 0; k < 128; ++k) NV_INS16(tv, ti, rs * (sc[half * 128 + k] - mu * ksum[half * 128 + k]), k);
#pragma unroll
            for (int j = 0; j < 16; ++j) { tmpv[half * 16 + j] = tv[j]; tmpi[half * 16 + j] = ti[j]; }
        }
#pragma unroll
        for (int j = 0; j < 16; ++j) { tv[j] = -3.0e38f; ti[j] = 0; }
        for (int i = 0; i < 16; ++i) for (int j = 0; j < 16; ++j) NV_INS16(tv, ti, tmpv[i] + tmpv[16 + j], tmpi[i] * 128 + tmpi[16 + j]);
        float den = 0.f, ev[16];
#pragma unroll
        for (int j = 0; j < 16; ++j) { ev[j] = NV_EXP(tv[j] - tv[0]); den += ev[j]; }
        float inv = 1.f / den;
#pragma unroll
        for (int j = 0; j < 16; ++j) { p.o0[(size_t)gid * 16 + j] = ev[j] * inv; ((int*)p.o1)[(size_t)gid * 16 + j] = ti[j]; } } break;
    case OP_PACT: {
        const int row = (int)(gid / 128); const int e = ((const int*)p.d)[gid]; const unsigned char* u = (const unsigned char*)p.b + (size_t)e * D; const nvbf* x = (const nvbf*)p.a + (size_t)row * D; float acc = 0.f;
        for (int c = 0; c < D; ++c) acc = fmaf(nv_e4m32f(u[c]), nv_bf2f(x[c]), acc);
        p.o0[gid] = p.c[gid] * nv_gelu(acc * (1.f / 128.f)); } break;
#if defined(HOST_TEST)
    case OP_POUTLN: {
        const float alpha = 1.6817928305074292f; float* x = p.o0 + (size_t)gid * D; std::vector<float> y(D, 0.f);
        for (int i = 0; i < 128; ++i) { const float cf = p.a[(size_t)gid * 128 + i] * (1.f / 64.f); const unsigned char* v = (const unsigned char*)p.c + (size_t)((const int*)p.b)[(size_t)gid * 128 + i] * D; for (int c = 0; c < D; ++c) y[c] = fmaf(cf, nv_e4m32f(v[c]), y[c]); }
        float mu = 0.f; for (int c = 0; c < D; ++c) { y[c] = alpha * x[c] + y[c]; mu += y[c]; }
        mu /= D; float var = 0.f; for (int c = 0; c < D; ++c) { float dlt = y[c] - mu; var = fmaf(dlt, dlt, var); }
        const float rs = 1.f / sqrtf(var / D + 1e-5f);
        for (int c = 0; c < D; ++c) { const float o = (y[c] - mu) * rs * p.d[c] + p.e[c]; x[c] = o; ((nvbf*)p.o1)[(size_t)gid * D + c] = nv_f2bf(o);
            if (p.o2) { unsigned char* f8 = (unsigned char*)p.o2 + (size_t)gid * 2 * D; const float xs = fminf(fmaxf(o * 16.f, -448.f), 448.f); const unsigned hc = nv_f2e4m3(xs); f8[c] = (unsigned char)hc; f8[D + c] = (unsigned char)nv_f2e4m3(xs - nv_e4m32f(hc)); } } } break;
#endif
    default: break;
    }
}

struct NvIO { const float* const* in; float* out; char* ws; size_t ws_size; };
template <class Launch> HD void nv_forward(const NvIO& io, const Dm& dm, Launch&& launch) {
    const int D = dm.D, M = dm.M, B = dm.B, DB = dm.DB, RH = dm.RH; const size_t MD = (size_t)M * D;
    float* y_prompt = io.out; float* y_sample = y_prompt + (size_t)B * (dm.T - 16) * D; float* p_gla = y_sample + (size_t)DB * dm.DT * D;
    float* p_h = p_gla + (size_t)2 * B * 4 * 64 * 128; float* p_conv = p_h + (size_t)2 * B * 512; float* p_rwkv = p_conv + (size_t)2 * B * 3 * 512;
    float* p_shift = p_rwkv + (size_t)2 * B * RH * 4096; float* s_gla = p_shift + (size_t)2 * B * D; float* s_h = s_gla + (size_t)2 * DB * 4 * 64 * 128;
    float* s_conv = s_h + (size_t)2 * DB * 512; float* s_rwkv = s_conv + (size_t)2 * DB * 3 * 512; float* s_shift = s_rwkv + (size_t)2 * DB * RH * 4096;
    float* w = (float*)io.ws; size_t off = 0; auto take = [&](size_t n) __attribute__((always_inline)) { float* r = w + off; off += (n + 63) & ~(size_t)63; return r; };
    float* X = take(MD > (size_t)nv_rup(M, 256) * 512 ? MD : (size_t)nv_rup(M, 256) * 512); float* VFIRST = take(MD); float* MOUT = take(MD);
    auto mk = [&](int code, long long n) __attribute__((always_inline)) { Op o{}; o.code = code; o.n = n; return o; };
    const int Mp = nv_rup(M, 256), Dp = nv_rup(D, 256), Dk = nv_rup(D, 128);
    auto takeh = [&](size_t n) __attribute__((always_inline)) { return (nvbf*)take((n + 1) / 2); };
    const size_t ABFN = (size_t)Mp * 1024 > (size_t)Mp * Dk ? (size_t)Mp * 1024 : (size_t)Mp * Dk; nvbf* ABF = takeh(ABFN + (size_t)Mp * D);
    const size_t SZ_WIN = (size_t)2816 * Dk, SZ_WOUT = (size_t)Dp * 1024, SZ_DD = (size_t)Dp * Dk, SZ_DN = (size_t)256 * Dk, SZ_UP = (size_t)Dp * 128, SZ_WQ = (size_t)2048 * Dk;
    nvbf* WT_WIN = takeh(2 * SZ_WIN); nvbf* WT_WOUT = takeh(2 * SZ_WOUT); nvbf* WT_WR = takeh(2 * SZ_DD); nvbf* WT_WK = takeh(2 * SZ_DD); nvbf* WT_WV = takeh(2 * SZ_DD); nvbf* WT_WO = takeh(2 * SZ_DD);
    nvbf* WT_W1 = takeh(2 * SZ_DN); nvbf* WT_W2 = takeh(2 * SZ_UP); nvbf* WT_A1 = takeh(2 * SZ_DN); nvbf* WT_A2 = takeh(2 * SZ_UP); nvbf* WT_G1 = takeh(2 * SZ_DN); nvbf* WT_G2 = takeh(2 * SZ_UP);
    nvbf* WT_V1 = takeh(SZ_DN); nvbf* WT_V2 = takeh(SZ_UP); nvbf* WT_WQ = takeh(4 * SZ_WQ); nvbf* WT_WG = takeh((size_t)2 * 1024 * 512); float* SPL = take(2 * 512); float* PRM = take((size_t)2 * 6 * D);
    nvbf* UB = takeh((size_t)16384 * D / 2); nvbf* VB = takeh((size_t)16384 * D / 2); nvbf* KB = takeh((size_t)8 * 256 * 256); float* KSUM = take(8 * 256);
    const size_t scratch0 = off;
    auto nb = [&](Op o) __attribute__((always_inline)) { o.code |= OPF_NOBAR; launch(o); };
    auto wt = [&](const float* W, int K, int N, int batch, nvbf* dst) __attribute__((always_inline)) { const int Np = nv_rup(N, 256), Kp = nv_rup(K, 128); Op o = mk(OP_WT, (long long)batch * Np * (Kp / 8)); o.a = W; o.o0 = (float*)dst; o.i0 = N; o.i1 = K; o.i2 = N; o.i3 = Np; o.i4 = Kp; nb(o); };
    wt(io.in[10], D, MIXIN, 2, WT_WIN); wt(io.in[21], 1024, D, 2, WT_WOUT); wt(io.in[23], D, D, 2, WT_WR); wt(io.in[24], D, D, 2, WT_WK); wt(io.in[25], D, D, 2, WT_WV); wt(io.in[26], D, D, 2, WT_WO);
    wt(io.in[28], D, 64, 2, WT_W1); wt(io.in[29], 64, D, 2, WT_W2); wt(io.in[31], D, 64, 2, WT_A1); wt(io.in[32], 64, D, 2, WT_A2); wt(io.in[36], D, 128, 2, WT_G1); wt(io.in[37], 128, D, 2, WT_G2);
    wt(io.in[34], D, 32, 1, WT_V1); wt(io.in[35], 32, D, 1, WT_V2); wt(io.in[43], D, 2048, 4, WT_WQ);
    for (int jj = 0; jj < 2; ++jj) { Op o = mk(OP_PRM, (long long)6 * D); o.a = io.in[27] + (size_t)jj * D; o.b = io.in[30] + (size_t)jj * D; o.c = jj > 0 ? io.in[33] + (size_t)(jj - 1) * D : nullptr; o.d = io.in[38] + (size_t)jj * D; o.e = io.in[39] + (size_t)jj * D; o.f = io.in[40] + (size_t)jj * RH * 64; o.o0 = PRM + (size_t)jj * 6 * D; nb(o); }
    for (int jj = 0; jj < 2; ++jj) { Op o = mk(OP_WGATE, 1024); o.a = io.in[16] + (size_t)jj * 8 * 64 * 64; o.b = io.in[18] + (size_t)jj * 8 * 64 * 64; o.c = io.in[20] + (size_t)jj * 512; o.o0 = (float*)(WT_WG + (size_t)jj * 1024 * 512); o.o1 = SPL + (size_t)jj * 512; nb(o); }
    auto fgemm = [&](const nvbf* Wt, float* C, int ldc, int N, int K, int bf16out = 0, const float* Aop = nullptr) __attribute__((always_inline)) {
        const int Kp = nv_rup(K, 128), Np = nv_rup(N, 256);
        Op o = mk(OP_FGEMM, (long long)M * N); o.a = Aop ? Aop : (const float*)ABF; o.b = (const float*)Wt; o.o0 = C; o.i0 = N; o.i1 = Kp; o.i2 = Kp; o.i3 = Kp; o.i4 = ldc; o.i5 = Np; o.i6 = bf16out; launch(o); };
    auto gemm = [&](const float* A, int lda, const nvbf* Wt, float* C, int ldc, int N, int K, int act) __attribute__((always_inline)) {
        const int Kp = nv_rup(K, 128);
        { Op o = mk(OP_CVT8, (long long)Mp * (Kp / 8)); o.a = A; o.o0 = (float*)ABF; o.i0 = K; o.i1 = lda; o.i2 = Kp; o.i3 = act; launch(o); }
        fgemm(Wt, C, ldc, N, K); };
    { Op o = mk(OP_EMBED4, (long long)MD / 4); o.a = io.in[0]; o.b = io.in[1]; o.c = io.in[7]; o.o0 = X; o.o1 = (float*)ABF; launch(o); }
    const float* const w_outer = w; float* const out_outer = io.out;
    for (int layer = 0; layer < 4; ++layer) {
        float* wl = (float*)w_outer; float* ol = out_outer; NV_LAUNDER(wl); NV_LAUNDER(ol);
#define NV_RB(T, v) T const v##_rb = (T)((char*)wl + ((const char*)(v) - (const char*)w_outer))
#define NV_RO(v) float* const v##_rb = (float*)((char*)ol + ((const char*)(v) - (const char*)out_outer))
        NV_RB(float*, X); NV_RB(float*, VFIRST); NV_RB(float*, MOUT); NV_RB(nvbf*, ABF); NV_RB(nvbf*, WT_WIN); NV_RB(nvbf*, WT_WOUT); NV_RB(nvbf*, WT_WR); NV_RB(nvbf*, WT_WK); NV_RB(nvbf*, WT_WV); NV_RB(nvbf*, WT_WO);
        NV_RB(nvbf*, WT_W1); NV_RB(nvbf*, WT_W2); NV_RB(nvbf*, WT_A1); NV_RB(nvbf*, WT_A2); NV_RB(nvbf*, WT_G1); NV_RB(nvbf*, WT_G2); NV_RB(nvbf*, WT_V1); NV_RB(nvbf*, WT_V2); NV_RB(nvbf*, WT_WQ); NV_RB(nvbf*, WT_WG);
        NV_RB(float*, SPL); NV_RB(float*, PRM); NV_RB(nvbf*, UB); NV_RB(nvbf*, VB); NV_RB(nvbf*, KB); NV_RB(float*, KSUM);
        NV_RO(p_gla); NV_RO(p_h); NV_RO(p_conv); NV_RO(p_rwkv); NV_RO(p_shift); NV_RO(s_gla); NV_RO(s_h); NV_RO(s_conv); NV_RO(s_rwkv); NV_RO(s_shift);
#undef NV_RB
#undef NV_RO
        { float* const X = X_rb; float* const VFIRST = VFIRST_rb; float* const MOUT = MOUT_rb; nvbf* const ABF = ABF_rb; nvbf* const WT_WIN = WT_WIN_rb; nvbf* const WT_WOUT = WT_WOUT_rb; nvbf* const WT_WR = WT_WR_rb; nvbf* const WT_WK = WT_WK_rb;
          nvbf* const WT_WV = WT_WV_rb; nvbf* const WT_WO = WT_WO_rb; nvbf* const WT_W1 = WT_W1_rb; nvbf* const WT_W2 = WT_W2_rb; nvbf* const WT_A1 = WT_A1_rb; nvbf* const WT_A2 = WT_A2_rb; nvbf* const WT_G1 = WT_G1_rb; nvbf* const WT_G2 = WT_G2_rb;
          nvbf* const WT_V1 = WT_V1_rb; nvbf* const WT_V2 = WT_V2_rb; nvbf* const WT_WQ = WT_WQ_rb; nvbf* const WT_WG = WT_WG_rb; float* const SPL = SPL_rb; float* const PRM = PRM_rb; nvbf* const UB = UB_rb; nvbf* const VB = VB_rb; nvbf* const KB = KB_rb; float* const KSUM = KSUM_rb;
          float* const p_gla = p_gla_rb; float* const p_h = p_h_rb; float* const p_conv = p_conv_rb; float* const p_rwkv = p_rwkv_rb; float* const p_shift = p_shift_rb; float* const s_gla = s_gla_rb; float* const s_h = s_h_rb; float* const s_conv = s_conv_rb;
          float* const s_rwkv = s_rwkv_rb; float* const s_shift = s_shift_rb; float* const w = wl; (void)SPL; (void)WT_WG; (void)VFIRST;
        const int j = layer / 2; off = scratch0;
        { Op o = mk(OP_CVTTAB8S, (long long)16384 * D / 16); o.a = io.in[45] + (size_t)layer * 16384 * D; o.o0 = (float*)UB; o.i0 = 7; nb(o); }
        { Op o = mk(OP_CVTTAB8S, (long long)16384 * D / 16); o.a = io.in[46] + (size_t)layer * 16384 * D; o.o0 = (float*)VB; o.i0 = 6; nb(o); }
        { Op o = mk(OP_KEYS, 8 * 256); o.a = io.in[44] + (size_t)layer * 8 * 2 * 128 * 128; o.o0 = (float*)KB; o.o1 = KSUM; nb(o); }
        if (layer % 2 == 0) {
            float* PROJ = take((size_t)M * MIXIN); float* LOGA = take((size_t)M * 256); float* O = take((size_t)M * 512); float* MIXO = X;
            float* XC = take((size_t)M * 512); nvbf* XCB = takeh((size_t)Mp * 512); float* AT = take((size_t)M * 512); float* BT = take((size_t)M * 512);
            const int NC = (dm.T + 63) / 64; float* LEND = take((size_t)B * 4 * NC * 8192); float* DEC = take((size_t)B * 4 * NC * 64); float* LA = take((size_t)B * NC * 512); float* LB = take((size_t)B * NC * 512);
            fgemm(WT_WIN + (size_t)j * SZ_WIN, PROJ, MIXIN, MIXIN, D);
            { Op o = mk(OP_LOGA4, (long long)M * 64); o.a = PROJ; o.b = io.in[11] + (size_t)j * 16 * 256; o.c = io.in[12] + (size_t)j * 256; o.o0 = LOGA; nb(o); }
            { Op o = mk(OP_CONV4, (long long)M * 128); o.a = PROJ; o.b = io.in[4] + (size_t)j * DB * 3 * 512; o.c = io.in[14] + (size_t)j * 4 * 512; o.d = io.in[15] + (size_t)j * 512; o.o0 = XC; o.o1 = (float*)XCB; nb(o); }
            { Op o = mk(OP_CONVOUT, (long long)dm.NSEQ * 1536); o.a = PROJ; o.b = io.in[4] + (size_t)j * DB * 3 * 512; o.o1 = p_conv + (size_t)j * B * 3 * 512; o.o2 = s_conv + (size_t)j * DB * 3 * 512; launch(o); }
            { Op o = mk(OP_GLAF, (long long)B * 512); o.a = PROJ; o.b = LOGA; o.o0 = O; o.o1 = p_gla + (size_t)j * B * 4 * 64 * 128; nb(o); }
            { Op o = mk(OP_GLA3, (long long)(DB * 4) * 128); o.a = PROJ; o.b = LOGA; o.c = io.in[2] + (size_t)j * DB * 4 * 64 * 128; o.d = LEND; o.o0 = O; o.o2 = s_gla + (size_t)j * DB * 4 * 64 * 128; o.i0 = NC; o.i1 = 1; nb(o); }
            { Op o = mk(OP_LRUG2, (long long)M * 512); o.a = (const float*)XCB; o.b = (const float*)(WT_WG + (size_t)j * 1024 * 512); o.c = io.in[17] + (size_t)j * 512; o.d = io.in[19] + (size_t)j * 512; o.e = SPL + (size_t)j * 512; o.f = XC; o.o0 = AT; o.o1 = BT; launch(o); }
            { Op o = mk(OP_GLANORM, (long long)M * 4); o.a = O; o.b = PROJ; o.c = io.in[13] + (size_t)j * 128; o.o0 = MIXO; nb(o); }
            { Op o = mk(OP_LRU1, (long long)B * NC * 512); o.a = AT; o.b = BT; o.o0 = LA; o.o1 = LB; o.i0 = NC; launch(o); }
            { Op o = mk(OP_LRU2, (long long)B * 512); o.a = LA; o.o0 = LB; o.o1 = p_h + (size_t)j * B * 512; o.i0 = NC; launch(o); }
            { Op o = mk(OP_LRU3, (long long)(B * NC + DB) * 512); o.a = AT; o.b = BT; o.c = PROJ; o.d = io.in[3] + (size_t)j * DB * 512; o.e = LB; o.o0 = MIXO; o.o2 = s_h + (size_t)j * DB * 512; o.i0 = NC; launch(o); }
            fgemm(WT_WOUT + (size_t)j * SZ_WOUT, MOUT, D, D, 1024, 1, X);
        } else {
            float* Y = take(MD); float* R = take(MD); float* K = take(MD); float* V = take(MD); float* G = take(MD); float* KK = take(MD);
            const size_t XMSZ = (size_t)Mp * D;
            float* WAV = take(3 * MD > 3 * XMSZ ? 3 * MD : 3 * XMSZ); float* Wd = WAV; float* Aa = WAV + MD; float* Vg = WAV + 2 * MD; nvbf* XM6 = (nvbf*)WAV;
            float* BON = take((size_t)M * RH); float* HLw = take((size_t)M * 64); float* HLa = take((size_t)M * 64); float* HLg = take((size_t)M * 128); float* HLv = take((size_t)M * 32);
            nvbf* ABw = takeh((size_t)Mp * 128); nvbf* ABa = takeh((size_t)Mp * 128); nvbf* ABg = takeh((size_t)Mp * 128); nvbf* ABv = takeh((size_t)Mp * 128);
            const float* shin = io.in[6] + (size_t)j * DB * D; const float* mu = io.in[22] + (size_t)j * 6 * D;
            { Op o = mk(OP_SHIFTOUT, (long long)dm.NSEQ * D); o.a = (const float*)ABF; o.o1 = p_shift + (size_t)j * B * D; o.o2 = s_shift + (size_t)j * DB * D; nb(o); }
            { Op o = mk(OP_MIX6, (long long)MD / 8); o.a = (const float*)ABF; o.b = shin; o.c = mu; o.o0 = (float*)XM6; o.i1 = (int)(XMSZ / 1024); launch(o); }
            auto gg = [&](const nvbf* A, const nvbf* Wt, float* C, int ldc, int N, int K, bool last, int bf16out = 0) __attribute__((always_inline)) { const int Kp = nv_rup(K, 128), Np = nv_rup(N, 256);
                Op o = mk(OP_FGEMM, (long long)M * N); o.a = (const float*)A; o.b = (const float*)Wt; o.o0 = C; o.i0 = N; o.i1 = Kp; o.i2 = Kp; o.i3 = Kp; o.i4 = ldc; o.i5 = Np; o.i6 = bf16out; if (!last) o.code |= OPF_GROUP; launch(o); };
            gg(XM6 + 0 * XMSZ, WT_WR + (size_t)j * SZ_DD, R, D, D, D, false, 1); gg(XM6 + 2 * XMSZ, WT_WK + (size_t)j * SZ_DD, K, D, D, D, false, 1); gg(XM6 + 3 * XMSZ, WT_WV + (size_t)j * SZ_DD, V, D, D, D, false, 1);
            gg(XM6 + 1 * XMSZ, WT_W1 + (size_t)j * SZ_DN, HLw, 64, 64, D, false); gg(XM6 + 4 * XMSZ, WT_A1 + (size_t)j * SZ_DN, HLa, 64, 64, D, false);
            if (j > 0) gg(XM6 + 3 * XMSZ, WT_V1 + (size_t)(j - 1) * SZ_DN, HLv, 32, 32, D, false);
            gg(XM6 + 5 * XMSZ, WT_G1 + (size_t)j * SZ_DN, HLg, 128, 128, D, true);
            auto cv = [&](const float* A, int K, nvbf* dst, int act, bool last) __attribute__((always_inline)) { Op o = mk(OP_CVT8, (long long)Mp * 16); o.a = A; o.o0 = (float*)dst; o.i0 = K; o.i1 = K; o.i2 = 128; o.i3 = act; if (last) launch(o); else nb(o); };
            cv(HLw, 64, ABw, 1, false); cv(HLa, 64, ABa, 0, false); if (j > 0) cv(HLv, 32, ABv, 0, false); cv(HLg, 128, ABg, 2, true);
            gg(ABw, WT_W2 + (size_t)j * SZ_UP, Wd, D, D, 64, false, 1); gg(ABa, WT_A2 + (size_t)j * SZ_UP, Aa, D, D, 64, false, 1); if (j > 0) gg(ABv, WT_V2 + (size_t)(j - 1) * SZ_UP, Vg, D, D, 32, false, 1); gg(ABg, WT_G2 + (size_t)j * SZ_UP, G, D, D, 128, true, 1);
            { Op o = mk(OP_WKVP, (long long)dm.NSEQ * RH * 64); o.a = R; o.b = K; o.c = Wd; o.d = Aa; o.e = V; o.f = Vg; o.g = VFIRST; o.h = PRM + (size_t)j * 6 * D; o.o0 = Y; o.o1 = p_rwkv + (size_t)j * B * RH * 4096; o.o2 = s_rwkv + (size_t)j * DB * RH * 4096;
              o.o3 = j > 0 ? KK : VFIRST; o.o4 = BON; o.o5 = (float*)(io.in[5] + (size_t)j * DB * RH * 4096); o.i0 = j > 0 ? 1 : 0; launch(o); }
            { Op o = mk(OP_POST2, (long long)M * RH); o.a = Y; o.b = G; o.c = j > 0 ? KK : VFIRST; o.d = BON; o.e = io.in[41] + (size_t)j * D; o.f = io.in[42] + (size_t)j * D; o.o0 = X; launch(o); }
            fgemm(WT_WO + (size_t)j * SZ_DD, MOUT, D, D, D, 1, X);
        }
        { Op o = mk(OP_LNRES, M); o.a = MOUT; o.b = io.in[8] + (size_t)(layer * 2 + 0) * D; o.c = io.in[9] + (size_t)(layer * 2 + 0) * D; o.o0 = X; o.o1 = (float*)ABF; o.o2 = (float*)(ABF + ABFN); launch(o); }
        off = scratch0;
        { nvbf* Q = takeh((size_t)Mp * 2048); float* SC = take((size_t)M * 2048); float* GATE = take((size_t)M * 128); float* EIDX = take((size_t)M * 128); float* TMPV = take((size_t)M * 256); float* TMPI = take((size_t)M * 256);
          float* COEF = take((size_t)M * 128);
          { Op o = mk(OP_FGEMM, (long long)M * 2048); o.a = (const float*)ABF; o.b = (const float*)(WT_WQ + (size_t)layer * SZ_WQ); o.o0 = (float*)Q; o.i0 = 2048; o.i1 = Dk; o.i2 = Dk; o.i3 = Dk; o.i4 = 2048; o.i5 = 2048; o.i6 = 1; launch(o); }
          { Op o = mk(OP_FGEMM, (long long)M * 2048); o.a = (const float*)Q; o.b = (const float*)KB; o.o0 = SC; o.i0 = 2048; o.i1 = 256; o.i2 = 2048; o.i3 = 256; o.i4 = 2048; o.i5 = 2048; o.i6 = 2; launch(o); }
          { Op o = mk(OP_TOPK2, (long long)M * 8); o.a = SC; o.b = (const float*)Q; o.c = KSUM; o.o0 = GATE; o.o1 = EIDX; o.o2 = TMPV; o.o3 = TMPI; launch(o); }
          { const int NS = D / 128; float* PART = take((size_t)NS * M * 128); float* YBUF = take(MD);
            #ifdef PROBE_EMASK
            { Op o = mk(OP_PACTS, (long long)NS * M * 128); o.a = (const float*)(ABF + ABFN); o.b = (const float*)UB; o.d = EIDX; o.o0 = PART; o.i0 = PROBE_EMASK; launch(o); }
#endif
            { Op o = mk(OP_PACTS, (long long)NS * M * 128); o.a = (const float*)(ABF + ABFN); o.b = (const float*)UB; o.d = EIDX; o.o0 = PART; o.i0 = 16383; launch(o); }
            { Op o = mk(OP_PRED, (long long)M * 32); o.a = PART; o.c = GATE; o.o0 = COEF; o.i0 = NS; launch(o); }
            { Op o = mk(OP_POUTS, (long long)MD); o.a = COEF; o.b = EIDX; o.c = (const float*)VB; o.o0 = YBUF; launch(o); }
            { Op o = mk(OP_LNRES, M); o.a = YBUF; o.b = io.in[8] + (size_t)(layer * 2 + 1) * D; o.c = io.in[9] + (size_t)(layer * 2 + 1) * D; o.o0 = X; o.o1 = (float*)ABF; launch(o); } } }
        }
    }
    { Op o = mk(OP_YOUT4, (long long)MD / 4); o.a = (const float*)ABF; o.o0 = y_prompt; launch(o); }
    (void)y_sample;
}

#include <cstdint>
namespace pg8 {
#define PG8_LAS __attribute__((address_space(3)))
typedef unsigned short bf16_t;
typedef short bf16x8 __attribute__((ext_vector_type(8)));
typedef float f32x4 __attribute__((ext_vector_type(4)));
typedef unsigned u32x4 __attribute__((ext_vector_type(4)));
constexpr int BM = 256, BK = 64, HALF = 128, HTB = HALF * BK * 2  , STAGE_BYTES = 8 * HTB, NXCD = 8, WGM = 8;

__host__ __device__ __forceinline__ int lds_byte(int r, int c) { const int st = (r >> 4) * 2 + (c >> 5), rr = r & 15, cc = c & 31, ob = rr * 64 + cc * 2; return st * 1024 + (ob ^ (((ob >> 9) & 1) << 5)); }
__host__ __device__ __forceinline__ void stage_rc(int b, int& R, int& C) { const int st = b / 1024, sb = b % 1024, swz = sb ^ (((sb >> 9) & 1) << 5); R = (st >> 1) * 16 + swz / 64; C = (st & 1) * 32 + (swz % 64) / 2; }
__host__ __device__ __forceinline__ int perm32(int rho) { const int n = rho >> 4, i = rho & 15; return 8 * (i >> 2) + 4 * n + (i & 3); }

struct Unit { int pm, pn, grp, pad_; const char* A; const char* B; };
struct Gemm { const bf16_t* A; const bf16_t* Bt; int M, N, K, lda, ldb; };

struct StaticOrder {
    int nM, nN, nwg, G, c; const char* A; const char* B; size_t tsA, tsB, acs;
    __host__ __device__ void init(const Gemm& g, int G_, int c_) { nM = g.M / BM; nN = g.N / BM; nwg = nM * nN; G = G_; c = c_; A = (const char*)g.A; B = (const char*)g.Bt; tsA = (size_t)BM * g.lda * 2; tsB = (size_t)BM * g.ldb * 2; acs = 0; }
    __host__ __device__ bool next(int i, Unit& u) const {
        const long L = (long)i * G + c; if (L >= nwg) return false;
        int wgid = (int)L; { const int q = nwg / NXCD, r = nwg % NXCD, xcd = wgid % NXCD, off = wgid / NXCD; wgid = (xcd < r ? xcd * (q + 1) : r * (q + 1) + (xcd - r) * q) + off; }
        const int nig = WGM * nN, gid = wgid / nig, fm = gid * WGM, gsz = (nM - fm) < WGM ? (nM - fm) : WGM;
        u.pm = fm + ((wgid % nig) % gsz); u.pn = (wgid % nig) / gsz; u.grp = 0; u.pad_ = 0; u.A = A + (size_t)u.pm * tsA + (size_t)u.pn * acs; u.B = B + (size_t)u.pn * tsB; return true;
    }
    __device__ __forceinline__ void a_ready(const Unit&) const {}
    __device__ __forceinline__ void done(const Unit&) const {}
};

template <class Epi, class Sched, bool ALIGN_EPI = false, bool SP2 = false>
__device__ __forceinline__ void gemm_phase(PG8_LAS unsigned char* lds, const Gemm g, const Sched& S, const Epi& E) {
    int tid_raw = threadIdx.x; asm volatile("" : "+v"(tid_raw));
    const int tid = tid_raw, wid = __builtin_amdgcn_readfirstlane(tid >> 6), lane = tid & 63, wr = wid >> 2, wc = wid & 3, fr = lane & 15, fq = lane >> 4;
    const int K = g.K, nt = K / BK;
    unsigned voffA[2], voffB[2];
#pragma unroll
    for (int i = 0; i < 2; ++i) { int R, C; stage_rc(tid * 16 + i * 8192, R, C); const int Rb = Epi::PERM ? ((R & ~31) + perm32(R & 31)) : R;
        voffA[i] = (unsigned)(R * g.lda + C) * 2u; voffB[i] = (unsigned)(Rb * g.ldb + C) * 2u; }
    const size_t kstep = (size_t)(BK * 2);
    const size_t hstepA = (size_t)HALF * g.lda * 2, hstepB = (size_t)HALF * g.ldb * 2;
    const unsigned ldsw = (unsigned)wid * 1024u;
    const int aoff = lds_byte(wr * 64 + fr, fq * 8), boff = lds_byte(wc * 32 + fr, fq * 8);
#define PG8_SA(b, h) (((b) * 2 + (h)) * HTB)
#define PG8_SB(b, h) ((4 + (b) * 2 + (h)) * HTB)
#define PG8_STAGE(bufoff, gbase, voff) do { _Pragma("unroll") for (int _i = 0; _i < 2; ++_i) \
        __builtin_amdgcn_global_load_lds((const unsigned*)((const char*)(gbase) + (voff)[_i]), (PG8_LAS unsigned*)(lds + (bufoff) + ldsw + _i * 8192), 16, 0, 0); } while (0)
#define PG8_LDA(dst, b, h) do { _Pragma("unroll") for (int m = 0; m < 4; ++m) _Pragma("unroll") for (int k = 0; k < 2; ++k) dst[m][k] = *(const PG8_LAS bf16x8*)(lds + PG8_SA(b, h) + aoff + m * 2048 + k * 1024); } while (0)
#define PG8_LDB(dst, b, h) do { _Pragma("unroll") for (int n = 0; n < 2; ++n) _Pragma("unroll") for (int k = 0; k < 2; ++k) dst[n][k] = *(const PG8_LAS bf16x8*)(lds + PG8_SB(b, h) + boff + n * 2048 + k * 1024); } while (0)
#define PG8_MMA(ai, bj, At, Bt) do { __builtin_amdgcn_s_setprio(1); _Pragma("unroll") for (int m = 0; m < 4; ++m) _Pragma("unroll") for (int n = 0; n < 2; ++n) _Pragma("unroll") for (int k = 0; k < 2; ++k) \
        acc[ai][bj][m][n] = __builtin_amdgcn_mfma_f32_16x16x32_bf16(Bt[n][k], At[m][k], acc[ai][bj][m][n], 0, 0, 0); __builtin_amdgcn_s_setprio(0); } while (0)
#define PG8_WAIT_V(n) asm volatile("s_waitcnt vmcnt(" #n ")" ::: "memory")
#define PG8_WAIT_L(n) asm volatile("s_waitcnt lgkmcnt(" #n ")" ::: "memory")
#define PG8_BAR __builtin_amdgcn_s_barrier()
#define PG8_SCHED __builtin_amdgcn_sched_barrier(0)
    Unit cur, nxt; int ui = 0;
    if (!S.next(0, cur)) return;
    f32x4 acc[2][2][4][2];
#pragma unroll
    for (int a = 0; a < 2; ++a)
#pragma unroll
        for (int b = 0; b < 2; ++b)
#pragma unroll
            for (int m = 0; m < 4; ++m)
#pragma unroll
                for (int n = 0; n < 2; ++n) acc[a][b][m][n] = (f32x4){0.f, 0.f, 0.f, 0.f};
    bf16x8 At[4][2], B0[2][2], B1[2][2];
    const char* cA = cur.A; const char* cB = cur.B;
    S.a_ready(cur);
    if constexpr (SP2) {
        PG8_STAGE(PG8_SB(0, 0), cB, voffB); PG8_STAGE(PG8_SB(0, 1), cB + hstepB, voffB); PG8_STAGE(PG8_SA(0, 0), cA, voffA); PG8_STAGE(PG8_SA(0, 1), cA + hstepA, voffA);
        if (wr == 1) PG8_BAR;
        PG8_WAIT_V(2); PG8_BAR;
        PG8_STAGE(PG8_SB(1, 0), cB + kstep, voffB); PG8_STAGE(PG8_SA(1, 0), cA + kstep, voffA); PG8_STAGE(PG8_SB(1, 1), cB + hstepB + kstep, voffB);
        PG8_WAIT_V(6); PG8_BAR;
    } else {
        PG8_STAGE(PG8_SB(0, 0), cB, voffB); PG8_STAGE(PG8_SA(0, 0), cA, voffA); PG8_STAGE(PG8_SB(0, 1), cB + hstepB, voffB); PG8_STAGE(PG8_SA(0, 1), cA + hstepA, voffA);
        if (wr == 1) PG8_BAR;
        PG8_WAIT_V(4); PG8_BAR;
        PG8_STAGE(PG8_SB(1, 0), cB + kstep, voffB); PG8_STAGE(PG8_SA(1, 0), cA + kstep, voffA); PG8_STAGE(PG8_SB(1, 1), cB + hstepB + kstep, voffB);
        PG8_WAIT_V(6); PG8_BAR;
    }
    for (;;) {
        const bool has_next = S.next(ui + 1, nxt);
        const char* nA = has_next ? nxt.A : cA; const char* nB = has_next ? nxt.B : cB;
        for (int t = 0; t < nt; t += 2) {
            const bool last = (t == nt - 2);
            const char* a1 = cA + (size_t)(t + 1) * kstep;
            const char* a2 = last ? nA : cA + (size_t)(t + 2) * kstep; const char* b2 = last ? nB : cB + (size_t)(t + 2) * kstep;
            const char* a3 = a2 + kstep; const char* b3 = b2 + kstep;
            if (last && has_next) S.a_ready(nxt);
            if constexpr (SP2) {
            PG8_LDB(B0, 0, 0); PG8_LDB(B1, 0, 1); PG8_SCHED; PG8_LDA(At, 0, 0); PG8_STAGE(PG8_SA(1, 1), a1 + hstepA, voffA);
            PG8_WAIT_V(8); PG8_WAIT_L(0); PG8_BAR; PG8_MMA(0, 0, At, B0); PG8_MMA(0, 1, At, B1); PG8_BAR; PG8_SCHED;
            PG8_LDA(At, 0, 1); PG8_STAGE(PG8_SB(0, 0), b2, voffB); PG8_STAGE(PG8_SB(0, 1), b2 + hstepB, voffB); PG8_STAGE(PG8_SA(0, 0), a2, voffA);
            PG8_WAIT_V(8); PG8_WAIT_L(0); PG8_BAR; PG8_MMA(1, 0, At, B0); PG8_MMA(1, 1, At, B1); PG8_BAR; PG8_SCHED;
            PG8_LDB(B0, 1, 0); PG8_LDB(B1, 1, 1); PG8_SCHED; PG8_LDA(At, 1, 0); PG8_STAGE(PG8_SA(0, 1), a2 + hstepA, voffA);
            PG8_WAIT_V(8); PG8_WAIT_L(0); PG8_BAR; PG8_MMA(0, 0, At, B0); PG8_MMA(0, 1, At, B1); PG8_BAR; PG8_SCHED;
            PG8_LDA(At, 1, 1); PG8_STAGE(PG8_SB(1, 0), b3, voffB); PG8_STAGE(PG8_SB(1, 1), b3 + hstepB, voffB); PG8_STAGE(PG8_SA(1, 0), a3, voffA);
            PG8_WAIT_V(8); PG8_WAIT_L(0); PG8_BAR; PG8_MMA(1, 0, At, B0); PG8_MMA(1, 1, At, B1); PG8_BAR; PG8_SCHED;
            } else {
            PG8_LDB(B0, 0, 0); PG8_SCHED; PG8_LDA(At, 0, 0); PG8_STAGE(PG8_SA(1, 1), a1 + hstepA, voffA);
            PG8_WAIT_L(8); PG8_BAR; PG8_WAIT_L(0); PG8_MMA(0, 0, At, B0); PG8_BAR; PG8_SCHED;
            PG8_LDB(B1, 0, 1); PG8_STAGE(PG8_SB(0, 0), b2, voffB);
            PG8_BAR; PG8_WAIT_L(0); PG8_MMA(0, 1, At, B1); PG8_BAR;
            PG8_LDA(At, 0, 1); PG8_STAGE(PG8_SA(0, 0), a2, voffA);
            PG8_BAR; PG8_WAIT_L(0); PG8_MMA(1, 0, At, B0); PG8_BAR; PG8_SCHED;
            PG8_STAGE(PG8_SB(0, 1), b2 + hstepB, voffB);
            PG8_WAIT_V(6); PG8_BAR; PG8_MMA(1, 1, At, B1); PG8_BAR;
            PG8_LDB(B0, 1, 0); PG8_SCHED; PG8_LDA(At, 1, 0); PG8_STAGE(PG8_SA(0, 1), a2 + hstepA, voffA);
            PG8_WAIT_L(8); PG8_BAR; PG8_WAIT_L(0); PG8_MMA(0, 0, At, B0); PG8_BAR; PG8_SCHED;
            PG8_LDB(B1, 1, 1); PG8_STAGE(PG8_SB(1, 0), b3, voffB);
            PG8_BAR; PG8_WAIT_L(0); PG8_MMA(0, 1, At, B1); PG8_BAR;
            PG8_LDA(At, 1, 1); PG8_STAGE(PG8_SA(1, 0), a3, voffA);
            PG8_BAR; PG8_WAIT_L(0); PG8_MMA(1, 0, At, B0); PG8_BAR; PG8_SCHED;
            PG8_STAGE(PG8_SB(1, 1), b3 + hstepB, voffB);
            PG8_WAIT_V(6); PG8_BAR; PG8_MMA(1, 1, At, B1); PG8_BAR;
            }
        }
        if constexpr (ALIGN_EPI) { if (wr == 0) PG8_BAR; }
        if constexpr (!Epi::AFTER_DRAIN) { E(acc, cur, wr, wc, fr, fq); S.done(cur); }
        if (!has_next) break;
#pragma unroll
        for (int a = 0; a < 2; ++a)
#pragma unroll
            for (int b = 0; b < 2; ++b)
#pragma unroll
                for (int m = 0; m < 4; ++m)
#pragma unroll
                    for (int n = 0; n < 2; ++n) acc[a][b][m][n] = (f32x4){0.f, 0.f, 0.f, 0.f};
        cur = nxt; cA = nA; cB = nB; ++ui;
        if constexpr (ALIGN_EPI) { if (wr == 1) PG8_BAR; }
    }
    PG8_WAIT_V(0);
    if constexpr (!ALIGN_EPI) { if (wr == 0) PG8_BAR; }
    PG8_BAR;
    if constexpr (Epi::AFTER_DRAIN) { E.fused(acc, cur, wr, wc, fr, fq, lds, wid, lane); S.done(cur); }
#undef PG8_SA
#undef PG8_SB
#undef PG8_STAGE
#undef PG8_LDA
#undef PG8_LDB
#undef PG8_MMA
#undef PG8_WAIT_V
#undef PG8_WAIT_L
#undef PG8_BAR
#undef PG8_SCHED
}
}
template <class T> __device__ __forceinline__ T* uni_ptr(T* p) {
    unsigned long long v = (unsigned long long)p; unsigned lo = __builtin_amdgcn_readfirstlane((unsigned)v), hi = __builtin_amdgcn_readfirstlane((unsigned)(v >> 32));
    unsigned long long r = ((unsigned long long)hi << 32) | lo; asm volatile("" : "+s"(r)); return (T*)r; }
__device__ __forceinline__ int rfl(int x) { int t = __builtin_amdgcn_readfirstlane(x); asm volatile("" : "+s"(t)); return t; }
namespace pg8 {
__device__ __forceinline__ unsigned cvt_pk_bf16(float lo, float hi) { unsigned r; asm volatile("v_cvt_pk_bf16_f32 %0, %1, %2" : "=v"(r) : "v"(lo), "v"(hi)); return r; }
struct EpiF32 {
    static constexpr bool PERM = false, AFTER_DRAIN = false;
    float* C; int ldc, Mreal, Nreal;
    __device__ __forceinline__ void operator()(const f32x4 (&acc)[2][2][4][2], const Unit& u, int wr, int wc, int fr, int fq) const {
        const int row0 = u.pm * BM + wr * 64 + fr, col0 = u.pn * BM + wc * 32 + 4 * fq;
#pragma unroll
        for (int ai = 0; ai < 2; ++ai)
#pragma unroll
            for (int m = 0; m < 4; ++m) { const int r = row0 + ai * HALF + m * 16; if (r < Mreal) { float* rowp = C + (size_t)r * ldc + col0;
#pragma unroll
                for (int bj = 0; bj < 2; ++bj)
#pragma unroll
                    for (int n = 0; n < 2; ++n) { const int c = col0 + bj * HALF + n * 16; if (c < Nreal) *(f32x4*)(rowp + bj * HALF + n * 16) = acc[ai][bj][m][n]; } } }
    }
};
struct EpiBf16Plain {
    static constexpr bool PERM = true, AFTER_DRAIN = false;
    bf16_t* O; int ldc;
    __device__ __forceinline__ void operator()(const f32x4 (&acc)[2][2][4][2], const Unit& u, int wr, int wc, int fr, int fq) const {
        const int row0 = u.pm * BM + wr * 64 + fr, col0 = u.pn * BM + wc * 32 + 8 * fq;
#pragma unroll
        for (int ai = 0; ai < 2; ++ai)
#pragma unroll
            for (int m = 0; m < 4; ++m) { bf16_t* rowp = O + (size_t)(row0 + ai * HALF + m * 16) * ldc + col0;
#pragma unroll
                for (int bj = 0; bj < 2; ++bj) { const f32x4 v0 = acc[ai][bj][m][0], v1 = acc[ai][bj][m][1]; u32x4 w;
                    w.x = cvt_pk_bf16(v0[0], v0[1]); w.y = cvt_pk_bf16(v0[2], v0[3]); w.z = cvt_pk_bf16(v1[0], v1[1]); w.w = cvt_pk_bf16(v1[2], v1[3]);
                    *(u32x4*)(rowp + bj * HALF) = w; } }
    }
};
struct EpiLru {
    static constexpr bool PERM = false, AFTER_DRAIN = false;
    const float* ba; const float* bx; const float* spl; const float* XC; float* AT; float* BT; int Mreal;
    __device__ __forceinline__ void operator()(const f32x4 (&acc)[2][2][4][2], const Unit& u, int wr, int wc, int fr, int fq) const {
        const int row0 = u.pm * BM + wr * 64 + fr, ch0 = u.pn * 128 + wc * 32 + 4 * fq;
#pragma unroll
        for (int n = 0; n < 2; ++n) { const int c = ch0 + 16 * n; const f32x4 ba4 = *(const f32x4*)(ba + c), bx4 = *(const f32x4*)(bx + c), sp4 = *(const f32x4*)(spl + c);
#pragma unroll
            for (int ai = 0; ai < 2; ++ai)
#pragma unroll
                for (int m = 0; m < 4; ++m) { const int r = row0 + ai * HALF + m * 16; if (r < Mreal) { const f32x4 xc = *(const f32x4*)(XC + (size_t)r * 512 + c); const f32x4 ga = acc[ai][0][m][n] + ba4, gx = acc[ai][1][m][n] + bx4; f32x4 at, bt;
#pragma unroll
                    for (int i = 0; i < 4; ++i) { const float gate_a = __builtin_amdgcn_rcpf(1.f + __expf(-ga[i])), gate_x = __builtin_amdgcn_rcpf(1.f + __expf(-gx[i])); const float la = gate_a * sp4[i]; at[i] = __expf(la); bt[i] = sqrtf(-expm1f(2.f * la)) * (gate_x * xc[i]); }
                    *(f32x4*)(AT + (size_t)r * 512 + c) = at; *(f32x4*)(BT + (size_t)r * 512 + c) = bt; } } }
    }
};
struct GroupOrder {
    const PG8_LAS Op* tab; int ng, nM, G, c; size_t tsA, tsB;
    __device__ __forceinline__ bool next(int i, Unit& u) const {
        int L = i * G + c, g = 0;
        for (; g < ng; ++g) { const int cnt = nM * (__builtin_amdgcn_readfirstlane(tab[g].i5) >> 8); if (L < cnt) break; L -= cnt; }
        if (g >= ng) return false;
        u.pm = L % nM; u.pn = L / nM; u.grp = g; u.pad_ = 0;
        u.A = (const char*)uni_ptr(tab[g].a) + (size_t)u.pm * tsA; u.B = (const char*)uni_ptr(tab[g].b) + (size_t)u.pn * tsB; return true;
    }
    __device__ __forceinline__ void a_ready(const Unit&) const {}
    __device__ __forceinline__ void done(const Unit&) const {}
};
struct EpiGroup {
    static constexpr bool PERM = true, AFTER_DRAIN = false;
    const PG8_LAS Op* tab; int Mreal;
    __device__ __forceinline__ void operator()(const f32x4 (&acc)[2][2][4][2], const Unit& u, int wr, int wc, int fr, int fq) const {
        const int ldc = rfl(tab[u.grp].i4), Nreal = rfl(tab[u.grp].i0), fl = rfl(tab[u.grp].i6);
        if (fl & 1) { const EpiBf16Plain E{(bf16_t*)uni_ptr(tab[u.grp].o0), ldc}; E(acc, u, wr, wc, fr, fq); return; }
        float* C = uni_ptr(tab[u.grp].o0); const int row0 = u.pm * BM + wr * 64 + fr, col0 = u.pn * BM + wc * 32 + 8 * fq;
#pragma unroll
        for (int ai = 0; ai < 2; ++ai)
#pragma unroll
            for (int m = 0; m < 4; ++m) { const int r = row0 + ai * HALF + m * 16; if (r < Mreal) { float* rowp = C + (size_t)r * ldc + col0;
#pragma unroll
                for (int bj = 0; bj < 2; ++bj) { if (col0 + bj * HALF < Nreal) { *(f32x4*)(rowp + bj * HALF) = acc[ai][bj][m][0]; *(f32x4*)(rowp + bj * HALF + 4) = acc[ai][bj][m][1]; } } } }
    }
};
}

#define XB_TMO      128
#define XB_XCNT(j)  (256  + 64 * (j))
#define XB_XSUB(j)  (1280 + 64 * (j))
#define XB_XGEN(j)  (2304 + 64 * (j))
#define XB_TOP      3328
#define XB_TOPGEN   3392
#define XCD_BAR_WORDS 3456
#define XB_SPIN_CAP (1u << 18)
#define LAS __attribute__((address_space(3)))
__device__ __forceinline__ unsigned xb_ld(unsigned* p)              { return __hip_atomic_load(p, __ATOMIC_RELAXED, __HIP_MEMORY_SCOPE_AGENT); }
__device__ __forceinline__ unsigned xb_add(unsigned* p, unsigned v) { return __hip_atomic_fetch_add(p, v, __ATOMIC_RELAXED, __HIP_MEMORY_SCOPE_AGENT); }
__device__ __forceinline__ unsigned xb_xcc_id() { return (unsigned)__builtin_amdgcn_s_getreg((3 << 11) | 20) & 0xFu; }
#define XB_SPIN(cond, bar) do { unsigned _sp = 0; while (cond) { __builtin_amdgcn_s_sleep(1); \
    if ((++_sp & 255u) == 0u) { if (xb_ld(&(bar)[XB_TMO])) break; if (_sp > XB_SPIN_CAP) { atomicAdd(&(bar)[XB_TMO], 1u); break; } } } } while (0)
struct XcdBarrier { unsigned* bar; unsigned x; volatile LAS unsigned* st; };
__device__ __forceinline__ XcdBarrier xcd_barrier_post(unsigned* bar, volatile LAS unsigned* st) {
    XcdBarrier b; b.bar = bar; b.x = xb_xcc_id(); b.st = st;
    if (threadIdx.x == 0) (void)xb_add(&bar[XB_XCNT(b.x)], 1u);
    return b;
}
__device__ __forceinline__ void xcd_barrier_complete(unsigned* bar, unsigned x, unsigned& nloc, unsigned& nx) {
    const unsigned G = gridDim.x * gridDim.y * gridDim.z;
    unsigned sum, cnt, mine, sp = 0u;
    for (;;) {
        sum = 0u; cnt = 0u; mine = 0u;
#pragma unroll
        for (unsigned j = 0; j < 16; ++j) { const unsigned c = xb_ld(&bar[XB_XCNT(j)]); sum += c; cnt += (c > 0u) ? 1u : 0u; mine = (j == x) ? c : mine; }
        if (sum == G) break;
        __builtin_amdgcn_s_sleep(1);
        if ((++sp & 255u) == 0u) { if (xb_ld(&bar[XB_TMO])) break; if (sp > XB_SPIN_CAP) { atomicAdd(&bar[XB_TMO], 1u); break; } }
    }
    nloc = mine > 0u ? mine : 1u; nx = cnt > 0u ? cnt : 1u;
}
__device__ __forceinline__ void xcd_barrier(const XcdBarrier& b) {
    asm volatile("s_waitcnt vmcnt(0)" ::: "memory");
    __syncthreads();
    if (threadIdx.x == 0) {
        unsigned* bar = b.bar;
        __builtin_amdgcn_s_waitcnt(0);
        unsigned nloc = b.st[0], nx = b.st[1];
        if (nloc == 0u) { xcd_barrier_complete(bar, b.x, nloc, nx); b.st[0] = nloc; b.st[1] = nx; }
        const unsigned old = xb_add(&bar[XB_XSUB(b.x)], 1u);
        const unsigned gen = old / nloc;
        if (old + 1u == (gen + 1u) * nloc) {
            __builtin_amdgcn_fence(__ATOMIC_RELEASE, "agent");
            asm volatile("s_waitcnt vmcnt(0)" ::: "memory");
            const unsigned og = xb_add(&bar[XB_TOP], 1u);
            const unsigned tg = og / nx;
            if (og + 1u == (tg + 1u) * nx) xb_add(&bar[XB_TOPGEN], 1u);
            else XB_SPIN(xb_ld(&bar[XB_TOPGEN]) == tg, bar);
            __builtin_amdgcn_fence(__ATOMIC_ACQUIRE, "agent");
            xb_add(&bar[XB_XGEN(b.x)], 1u);
            asm volatile("s_waitcnt vmcnt(0)" ::: "memory");
        } else {
            XB_SPIN(xb_ld(&bar[XB_XGEN(b.x)]) == gen, bar);
            __builtin_amdgcn_fence(__ATOMIC_ACQUIRE, "agent");
            asm volatile("s_waitcnt vmcnt(0)" ::: "memory");
        }
    }
    __syncthreads();
}

namespace fk {
#define GAS __attribute__((address_space(1)))
typedef unsigned u32x4 __attribute__((ext_vector_type(4)));
typedef unsigned u32x2 __attribute__((ext_vector_type(2)));
typedef float f32x4 __attribute__((ext_vector_type(4)));
typedef float f32x2 __attribute__((ext_vector_type(2)));
typedef __bf16 bf2 __attribute__((ext_vector_type(2)));
typedef unsigned short bf16_t;
__device__ __forceinline__ float bflo(unsigned u) { return __uint_as_float(u << 16); }
__device__ __forceinline__ float bfhi(unsigned u) { return __uint_as_float(u & 0xffff0000u); }
__device__ __forceinline__ float dot2(unsigned a, unsigned b, float c) { return __builtin_amdgcn_fdot2_f32_bf16(__builtin_bit_cast(bf2, a), __builtin_bit_cast(bf2, b), c, false); }
__device__ __forceinline__ unsigned pk_bf16(float lo, float hi) { unsigned r; asm volatile("v_cvt_pk_bf16_f32 %0, %1, %2" : "=v"(r) : "v"(lo), "v"(hi)); return r; }
template <int CTRL> __device__ __forceinline__ float dppf(float v) { return __int_as_float(__builtin_amdgcn_update_dpp(0, __float_as_int(v), CTRL, 0xf, 0xf, true)); }
__device__ __forceinline__ float row_max16(float v) { v = fmaxf(v, dppf<0xB1>(v)); v = fmaxf(v, dppf<0x4E>(v)); v = fmaxf(v, dppf<0x141>(v)); v = fmaxf(v, dppf<0x140>(v)); return v; }
__device__ __forceinline__ float frcp(float x) { return __builtin_amdgcn_rcpf(x); }
__device__ __forceinline__ float fsqrt(float x) { return __builtin_amdgcn_sqrtf(x); }
__device__ __forceinline__ float row_sum8(float v) { v += dppf<0xB1>(v); v += dppf<0x4E>(v); v += dppf<0x141>(v); return v; }
__device__ __forceinline__ float row_sum16(float v) { v += dppf<0xB1>(v); v += dppf<0x4E>(v); v += dppf<0x141>(v); v += dppf<0x140>(v); return v; }
__device__ __forceinline__ float shx(float v, int m, int lane) { return __int_as_float(__builtin_amdgcn_ds_bpermute((lane ^ m) << 2, __float_as_int(v))); }
__device__ __forceinline__ float wave_sum(float v, int lane) { v = row_sum16(v); v += shx(v, 16, lane); v += shx(v, 32, lane); return v; }
__device__ __forceinline__ float gelu_tanh(float x) { return 0.5f * x * (1.f + tanhf(0.7978845608028654f * (x + 0.044715f * x * x * x))); }
#define FK_NEG (-3.0e38f)

template <int CTRL> __device__ __forceinline__ int dppi(int v) { return __builtin_amdgcn_update_dpp(0, v, CTRL, 0xf, 0xf, true); }
__device__ __forceinline__ int row_min16i(int v) { v = min(v, dppi<0xB1>(v)); v = min(v, dppi<0x4E>(v)); v = min(v, dppi<0x141>(v)); v = min(v, dppi<0x140>(v)); return v; }
#define FK_CE(a, b) do { const bool sw_ = v[b] > v[a]; const float tv_ = sw_ ? v[b] : v[a]; v[b] = sw_ ? v[a] : v[b]; v[a] = tv_; const int ti_ = sw_ ? id[b] : id[a]; id[b] = sw_ ? id[a] : id[b]; id[a] = ti_; } while (0)
#define FK_SORT8(v, id) do { FK_CE2(v, id, 0, 1); FK_CE2(v, id, 2, 3); FK_CE2(v, id, 4, 5); FK_CE2(v, id, 6, 7); FK_CE2(v, id, 0, 2); FK_CE2(v, id, 1, 3); FK_CE2(v, id, 4, 6); FK_CE2(v, id, 5, 7); FK_CE2(v, id, 1, 2); FK_CE2(v, id, 5, 6); \
    FK_CE2(v, id, 0, 4); FK_CE2(v, id, 1, 5); FK_CE2(v, id, 2, 6); FK_CE2(v, id, 3, 7); FK_CE2(v, id, 2, 4); FK_CE2(v, id, 3, 5); FK_CE2(v, id, 1, 2); FK_CE2(v, id, 3, 4); FK_CE2(v, id, 5, 6); } while (0)
#define FK_CE2(v, id, a, b) do { const bool sw_ = v[b] > v[a]; const float tv_ = sw_ ? v[b] : v[a]; v[b] = sw_ ? v[a] : v[b]; v[a] = tv_; const int ti_ = sw_ ? id[b] : id[a]; id[b] = sw_ ? id[a] : id[b]; id[a] = ti_; } while (0)
__device__ __forceinline__ void top16_of_128_x2(float (&v)[8], int (&id)[8], float (&u)[8], int (&jd)[8], int lane16, float& rv1, int& ri1, float& rv2, int& ri2) {
    FK_SORT8(v, id); FK_SORT8(u, jd);
    rv1 = FK_NEG; ri1 = 0; rv2 = FK_NEG; ri2 = 0;
#pragma unroll
    for (int r = 0; r < 16; ++r) {
        const float wm = row_max16(v[0]), xm = row_max16(u[0]);
        const int cand = (v[0] == wm) ? id[0] : 0x7fffffff, dand = (u[0] == xm) ? jd[0] : 0x7fffffff;
        const int sel = row_min16i(cand), tel = row_min16i(dand);
        const bool mine = (cand == sel), nine = (dand == tel);
        if (lane16 == r) { rv1 = wm; ri1 = sel; rv2 = xm; ri2 = tel; }
#pragma unroll
        for (int i = 0; i < 7; ++i) { v[i] = mine ? v[i + 1] : v[i]; id[i] = mine ? id[i + 1] : id[i]; u[i] = nine ? u[i + 1] : u[i]; jd[i] = nine ? jd[i + 1] : jd[i]; }
        v[7] = mine ? FK_NEG : v[7]; u[7] = nine ? FK_NEG : u[7];
    }
}
__device__ __forceinline__ int fk_key(float x, int lane16) { int k = __float_as_int(x); k ^= (k >> 31) & 0x7fffffff; return (k & ~15) | (15 - lane16); }
__device__ __forceinline__ float fk_unkey(int k) { k &= ~15; k ^= (k >> 31) & 0x7fffffff; return __int_as_float(k); }
__device__ __forceinline__ int row_max16i(int v) { v = max(v, dppi<0xB1>(v)); v = max(v, dppi<0x4E>(v)); v = max(v, dppi<0x141>(v)); v = max(v, dppi<0x140>(v)); return v; }
__device__ __forceinline__ void topk_phase(const GAS float* __restrict__ SC, const GAS bf16_t* __restrict__ Q, const GAS float* __restrict__ KSUM, GAS float* __restrict__ GATE, GAS int* __restrict__ EIDX, int nitems,
                                           LAS unsigned char* lds, int wid, int lane, int wave_gid, int nwaves) {
    LAS unsigned char* wb = lds + wid * 6144;
    LAS int* IDS1 = (LAS int*)wb; LAS int* IDS2 = (LAS int*)(wb + 2048); LAS int* LC1 = (LAS int*)(wb + 4096); LAS int* LC2 = (LAS int*)(wb + 4352); LAS int* CI = (LAS int*)(wb + 4608);
    LAS float* xv = (LAS float*)(wb + 4864); LAS int* DUMP = (LAS int*)(wb + 5120) + lane; LAS int* WL1 = (LAS int*)(wb + 5376); LAS int* WL2 = (LAS int*)(wb + 5632);
    const int lane16 = lane & 15, rowbase = lane & 48;
    u32x4 nqa, nqb; f32x4 ns0, ns1, nt0, nt1;
#define TK_LOAD(wi_) do { int it_ = (wi_) * 4 + (lane >> 4); it_ = it_ < nitems ? it_ : nitems - 1; const GAS u32x4* qp_ = (const GAS u32x4*)(Q + (size_t)it_ * 256 + 16 * lane16); nqa = qp_[0]; nqb = qp_[1]; \
        const GAS float* sp_ = SC + (size_t)it_ * 256 + 8 * lane16; ns0 = *(const GAS f32x4*)sp_; ns1 = *(const GAS f32x4*)(sp_ + 4); nt0 = *(const GAS f32x4*)(sp_ + 128); nt1 = *(const GAS f32x4*)(sp_ + 132); } while (0)
    TK_LOAD(wave_gid);
    const GAS float* kp = KSUM + ((wave_gid * 4 + (lane >> 4)) & 7) * 256 + 8 * lane16; const f32x4 k0 = *(const GAS f32x4*)kp, k1 = *(const GAS f32x4*)(kp + 4), m0 = *(const GAS f32x4*)(kp + 128), m1 = *(const GAS f32x4*)(kp + 132);
    for (int wi = wave_gid; wi * 4 < nitems; wi += nwaves) {
        const int it = wi * 4 + (lane >> 4);
        const u32x4 qa = nqa, qb = nqb; const f32x4 s0 = ns0, s1 = ns1, t0 = nt0, t1 = nt1;
        TK_LOAD(wi + nwaves);
        float qs = 0.f, qq = 0.f;
#pragma unroll
        for (int i = 0; i < 4; ++i) { const float a = bflo(qa[i]), b = bfhi(qa[i]), c = bflo(qb[i]), d = bfhi(qb[i]); qs += (a + b) + (c + d); qq += (a * a + b * b) + (c * c + d * d); }
        const float mu = row_sum16(qs) * (1.f / 256.f); const float var = fmaxf(row_sum16(qq) * (1.f / 256.f) - mu * mu, 0.f); const float rs = 1.f / sqrtf(var + 1e-5f);
        float v[8], u[8]; int id[8], jd[8];
        {
#pragma unroll
          for (int i = 0; i < 4; ++i) { v[i] = rs * (s0[i] - mu * k0[i]); v[4 + i] = rs * (s1[i] - mu * k1[i]); u[i] = rs * (t0[i] - mu * m0[i]); u[4 + i] = rs * (t1[i] - mu * m1[i]);
              id[i] = 8 * lane16 + i; id[4 + i] = 8 * lane16 + 4 + i; jd[i] = 8 * lane16 + i; jd[4 + i] = 8 * lane16 + 4 + i; } }
        FK_SORT8(v, id); FK_SORT8(u, jd);
#pragma unroll
        for (int i = 0; i < 8; ++i) { IDS1[lane * 8 + i] = id[i]; IDS2[lane * 8 + i] = jd[i]; }
        float rv1 = FK_NEG, rv2 = FK_NEG; int wl1 = 0, wl2 = 0, cn1 = 0, cn2 = 0;
#pragma unroll
        for (int r = 0; r < 16; ++r) {
            const int key1 = fk_key(v[0], lane16), key2 = fk_key(u[0], lane16);
            const int wm1 = row_max16i(key1), wm2 = row_max16i(key2);
            const bool mine = (key1 == wm1), nine = (key2 == wm2);
            if (lane16 == r) { rv1 = fk_unkey(wm1); wl1 = 15 - (wm1 & 15); rv2 = fk_unkey(wm2); wl2 = 15 - (wm2 & 15); }
            *(mine ? LC1 + rowbase + r : DUMP) = cn1; *(nine ? LC2 + rowbase + r : DUMP) = cn2;
#pragma unroll
            for (int i = 0; i < 7; ++i) { v[i] = mine ? v[i + 1] : v[i]; u[i] = nine ? u[i + 1] : u[i]; }
            v[7] = mine ? FK_NEG : v[7]; u[7] = nine ? FK_NEG : u[7]; cn1 += mine ? 1 : 0; cn2 += nine ? 1 : 0;
        }
        xv[lane] = rv2; WL1[lane] = wl1; WL2[lane] = wl2;
        float c[16];
        { const LAS f32x4* xp = (const LAS f32x4*)(xv + rowbase);
#pragma unroll
          for (int q = 0; q < 4; ++q) { const f32x4 t = xp[q]; c[4 * q] = rv1 + t.x; c[4 * q + 1] = rv1 + t.y; c[4 * q + 2] = rv1 + t.z; c[4 * q + 3] = rv1 + t.w; } }
        int p = 0, wli = 0; float sc = FK_NEG;
#pragma unroll
        for (int r = 0; r < 16; ++r) {
            const int key = fk_key(c[0], lane16); const int wm = row_max16i(key); const bool mine = (key == wm);
            if (lane16 == r) { sc = fk_unkey(wm); wli = 15 - (wm & 15); }
            *(mine ? CI + rowbase + r : DUMP) = p;
#pragma unroll
            for (int i = 0; i < 15; ++i) c[i] = mine ? c[i + 1] : c[i];
            c[15] = mine ? FK_NEG : c[15]; p += mine ? 1 : 0;
        }
        const int i1 = wli & 15, j2 = CI[rowbase + lane16] & 15;
        const int e1 = IDS1[(rowbase + (WL1[rowbase + i1] & 15)) * 8 + (LC1[rowbase + i1] & 7)], e2 = IDS2[(rowbase + (WL2[rowbase + j2] & 15)) * 8 + (LC2[rowbase + j2] & 7)];
        const float mx = fk_unkey(row_max16i(fk_key(sc, 0))); const float ex = __expf(sc - mx); const float den = row_sum16(ex);
        GATE[(size_t)it * 16 + lane16] = ex / den; EIDX[(size_t)it * 16 + lane16] = (e1 & 127) * 128 + (e2 & 127);
    }
#undef TK_LOAD
}

__device__ __forceinline__ f32x2 fp8lo(unsigned w) { return __builtin_amdgcn_cvt_pk_f32_fp8((int)w, false); }
__device__ __forceinline__ f32x2 fp8hi(unsigned w) { return __builtin_amdgcn_cvt_pk_f32_fp8((int)w, true); }
__device__ __forceinline__ void act_phase(const GAS bf16_t* __restrict__ XB, const GAS unsigned char* __restrict__ U8, const GAS float* __restrict__ GATE, const GAS int* __restrict__ EIDX, GAS float* __restrict__ COEF, int nitems,
                                          int lane, int wave_gid, int nwaves) {
    int it = wave_gid; if (it >= nitems) return;
    u32x4 uc[16], un[16], xac, xbc, xan, xbn;
    int evc = EIDX[(size_t)it * 16 + (lane & 15)];
    { const GAS u32x4* xp = (const GAS u32x4*)(XB + (size_t)(it >> 3) * 1024 + 16 * lane); xac = xp[0]; xbc = xp[1]; }
#pragma unroll
    for (int k = 0; k < 16; ++k) uc[k] = *(const GAS u32x4*)(U8 + (size_t)__builtin_amdgcn_readlane(evc, k) * 1024 + 16 * lane);
    int itn = it + nwaves; int evn = (itn < nitems) ? EIDX[(size_t)itn * 16 + (lane & 15)] : 0;
    for (;;) {
        const bool hasn = itn < nitems;
        if (hasn) {
            const GAS u32x4* xp = (const GAS u32x4*)(XB + (size_t)(itn >> 3) * 1024 + 16 * lane); xan = xp[0]; xbn = xp[1];
#pragma unroll
            for (int k = 0; k < 16; ++k) un[k] = *(const GAS u32x4*)(U8 + (size_t)__builtin_amdgcn_readlane(evn, k) * 1024 + 16 * lane);
        }
        const int itnn = itn + nwaves; const int evnn = (itnn < nitems) ? EIDX[(size_t)itnn * 16 + (lane & 15)] : 0;
        const float gt = GATE[(size_t)it * 16 + (lane >> 2)];
        float x[16];
#pragma unroll
        for (int i = 0; i < 4; ++i) { x[2 * i] = bflo(xac[i]); x[2 * i + 1] = bfhi(xac[i]); x[8 + 2 * i] = bflo(xbc[i]); x[8 + 2 * i + 1] = bfhi(xbc[i]); }
        float a[16];
#pragma unroll
        for (int k = 0; k < 16; ++k) { const u32x4 uw = uc[k]; float s = 0.f;
#pragma unroll
            for (int d = 0; d < 4; ++d) { const f32x2 lo = fp8lo(uw[d]), hi = fp8hi(uw[d]); s = fmaf(lo.x, x[4 * d], s); s = fmaf(lo.y, x[4 * d + 1], s); s = fmaf(hi.x, x[4 * d + 2], s); s = fmaf(hi.y, x[4 * d + 3], s); }
            asm volatile("" : "+v"(s)); a[k] = s; }
#pragma unroll
        for (int k = 0; k < 8; ++k) { const bool hi = lane & 32; const float send = hi ? a[k] : a[k + 8], keep = hi ? a[k + 8] : a[k]; a[k] = keep + shx(send, 32, lane); }
#pragma unroll
        for (int k = 0; k < 4; ++k) { const bool hi = lane & 16; const float send = hi ? a[k] : a[k + 4], keep = hi ? a[k + 4] : a[k]; a[k] = keep + shx(send, 16, lane); }
#pragma unroll
        for (int k = 0; k < 2; ++k) { const bool hi = lane & 8; const float send = hi ? a[k] : a[k + 2], keep = hi ? a[k + 2] : a[k]; a[k] = keep + shx(send, 8, lane); }
        { const bool hi = lane & 4; const float send = hi ? a[0] : a[1], keep = hi ? a[1] : a[0]; a[0] = keep + shx(send, 4, lane); }
        float dsum = a[0]; dsum += shx(dsum, 2, lane); dsum += shx(dsum, 1, lane);
        if ((lane & 3) == 0) COEF[(size_t)it * 16 + (lane >> 2)] = gt * gelu_tanh(dsum * (1.f / 128.f));
        if (!hasn) break;
#pragma unroll
        for (int k = 0; k < 16; ++k) uc[k] = un[k];
        xac = xan; xbc = xbn; evc = evn; evn = evnn; it = itn; itn = itnn;
    }
}

__device__ __forceinline__ void outln_phase(const GAS float* COEF, const GAS int* EIDX, const GAS unsigned char* V8,     const GAS float* __restrict__ lg, const GAS float* __restrict__ lb, GAS float* X, GAS bf16_t* XB, int nrows,
                                            int lane, int wave_gid, int nwaves) {
    const float alpha = 1.6817928305074292f;
    int row = wave_gid; if (row >= nrows) return;
    u32x4 vc[16], vn[16];
    float cf0 = COEF[(size_t)row * 128 + lane] * (1.f / 64.f), cf1 = COEF[(size_t)row * 128 + 64 + lane] * (1.f / 64.f); int ev0 = EIDX[(size_t)row * 128 + lane], ev1 = EIDX[(size_t)row * 128 + 64 + lane];
#define OUT_LOADCH(dst, evreg, base) do { _Pragma("unroll") for (int k_ = 0; k_ < 16; ++k_) dst[k_] = *(const GAS u32x4*)(V8 + (size_t)__builtin_amdgcn_readlane(evreg, (base) + k_) * 1024 + 16 * lane); } while (0)
#define OUT_COMPCH(src, cfreg, base) do { _Pragma("unroll") for (int k_ = 0; k_ < 16; ++k_) { const float c_ = __int_as_float(__builtin_amdgcn_readlane(__float_as_int(cfreg), (base) + k_)); const u32x4 vw_ = src[k_]; \
        _Pragma("unroll") for (int d_ = 0; d_ < 4; ++d_) { const f32x2 lo_ = fp8lo(vw_[d_]), hi_ = fp8hi(vw_[d_]); acc[4 * d_] = fmaf(c_, lo_.x, acc[4 * d_]); acc[4 * d_ + 1] = fmaf(c_, lo_.y, acc[4 * d_ + 1]); acc[4 * d_ + 2] = fmaf(c_, hi_.x, acc[4 * d_ + 2]); acc[4 * d_ + 3] = fmaf(c_, hi_.y, acc[4 * d_ + 3]); } \
        _Pragma("unroll") for (int p_ = 0; p_ < 16; ++p_) asm volatile("" : "+v"(acc[p_]));     \
        } } while (0)
    for (;;) {
        OUT_LOADCH(vc, ev0, 0);
        const int rown = row + nwaves; const bool hasn = rown < nrows;
        float ncf0 = 0.f, ncf1 = 0.f; int nev0 = 0, nev1 = 0;
        if (hasn) { ncf0 = COEF[(size_t)rown * 128 + lane] * (1.f / 64.f); ncf1 = COEF[(size_t)rown * 128 + 64 + lane] * (1.f / 64.f); nev0 = EIDX[(size_t)rown * 128 + lane]; nev1 = EIDX[(size_t)rown * 128 + 64 + lane]; }
        float acc[16];
#pragma unroll
        for (int k = 0; k < 16; ++k) acc[k] = 0.f;
#define OUT_FENCE() asm volatile("" ::: "memory")
        OUT_LOADCH(vn, ev0, 16); OUT_FENCE(); OUT_COMPCH(vc, cf0, 0); OUT_FENCE();
        OUT_LOADCH(vc, ev0, 32); OUT_FENCE(); OUT_COMPCH(vn, cf0, 16); OUT_FENCE();
        OUT_LOADCH(vn, ev0, 48); OUT_FENCE(); OUT_COMPCH(vc, cf0, 32); OUT_FENCE();
        OUT_LOADCH(vc, ev1, 0);  OUT_FENCE(); OUT_COMPCH(vn, cf0, 48); OUT_FENCE();
        OUT_LOADCH(vn, ev1, 16); OUT_FENCE(); OUT_COMPCH(vc, cf1, 0); OUT_FENCE();
        OUT_LOADCH(vc, ev1, 32); OUT_FENCE(); OUT_COMPCH(vn, cf1, 16); OUT_FENCE();
        OUT_LOADCH(vn, ev1, 48); OUT_FENCE(); OUT_COMPCH(vc, cf1, 32); OUT_FENCE();
        OUT_COMPCH(vn, cf1, 48); OUT_FENCE();
#undef OUT_FENCE
        GAS float* xr = X + (size_t)row * 1024 + 16 * lane; float t[16];
#pragma unroll
        for (int q = 0; q < 4; ++q) { const f32x4 xv = *(const GAS f32x4*)(xr + 4 * q); t[4 * q] = fmaf(alpha, xv.x, acc[4 * q]); t[4 * q + 1] = fmaf(alpha, xv.y, acc[4 * q + 1]); t[4 * q + 2] = fmaf(alpha, xv.z, acc[4 * q + 2]); t[4 * q + 3] = fmaf(alpha, xv.w, acc[4 * q + 3]); }
        float s = 0.f;
#pragma unroll
        for (int k = 0; k < 16; ++k) s += t[k];
        const float mu = wave_sum(s, lane) * (1.f / 1024.f); float vs = 0.f;
#pragma unroll
        for (int k = 0; k < 16; ++k) { t[k] -= mu; vs = fmaf(t[k], t[k], vs); }
        const float rs = 1.f / sqrtf(wave_sum(vs, lane) * (1.f / 1024.f) + 1e-5f);
        unsigned w[8];
#pragma unroll
        for (int q = 0; q < 4; ++q) { const f32x4 g = *(const GAS f32x4*)(lg + 16 * lane + 4 * q), b = *(const GAS f32x4*)(lb + 16 * lane + 4 * q); f32x4 o;
            o.x = t[4 * q] * rs * g.x + b.x; o.y = t[4 * q + 1] * rs * g.y + b.y; o.z = t[4 * q + 2] * rs * g.z + b.z; o.w = t[4 * q + 3] * rs * g.w + b.w;
            *(GAS f32x4*)(xr + 4 * q) = o; w[2 * q] = pk_bf16(o.x, o.y); w[2 * q + 1] = pk_bf16(o.z, o.w); }
        u32x4 w0, w1; w0.x = w[0]; w0.y = w[1]; w0.z = w[2]; w0.w = w[3]; w1.x = w[4]; w1.y = w[5]; w1.z = w[6]; w1.w = w[7];
        GAS u32x4* xbp = (GAS u32x4*)(XB + (size_t)row * 1024 + 16 * lane); xbp[0] = w0; xbp[1] = w1;
        if (!hasn) break;
        row = rown; cf0 = ncf0; cf1 = ncf1; ev0 = nev0; ev1 = nev1;
    }
#undef OUT_LOADCH
#undef OUT_COMPCH
}

__device__ __forceinline__ void lnres_phase(const GAS bf16_t* __restrict__ Y, const GAS float* __restrict__ lg, const GAS float* __restrict__ lb, GAS float* X, GAS bf16_t* XB, GAS unsigned char* XF8, int nrows, int lane, int wave_gid, int nwaves) {
    const float alpha = 1.6817928305074292f; (void)X;
    for (int row = wave_gid; row < nrows; row += nwaves) {
        GAS bf16_t* xr = XB + (size_t)row * 1024; const GAS bf16_t* yr = Y + (size_t)row * 1024; float t[16];
#pragma unroll
        for (int q = 0; q < 4; ++q) { const u32x2 xw = *(const GAS u32x2*)(xr + 256 * q + 4 * lane); const u32x2 yw = *(const GAS u32x2*)(yr + 256 * q + 4 * lane);
            t[4 * q] = fmaf(alpha, bflo(xw.x), bflo(yw.x)); t[4 * q + 1] = fmaf(alpha, bfhi(xw.x), bfhi(yw.x)); t[4 * q + 2] = fmaf(alpha, bflo(xw.y), bflo(yw.y)); t[4 * q + 3] = fmaf(alpha, bfhi(xw.y), bfhi(yw.y)); }
        float s = 0.f;
#pragma unroll
        for (int k = 0; k < 16; ++k) s += t[k];
        const float mu = wave_sum(s, lane) * (1.f / 1024.f); float vs = 0.f;
#pragma unroll
        for (int k = 0; k < 16; ++k) { t[k] -= mu; vs = fmaf(t[k], t[k], vs); }
        const float rs = 1.f / sqrtf(wave_sum(vs, lane) * (1.f / 1024.f) + 1e-5f);
#pragma unroll
        for (int q = 0; q < 4; ++q) { const int c = 256 * q + 4 * lane; const f32x4 g = *(const GAS f32x4*)(lg + c), b = *(const GAS f32x4*)(lb + c); f32x4 o;
            o.x = t[4 * q] * rs * g.x + b.x; o.y = t[4 * q + 1] * rs * g.y + b.y; o.z = t[4 * q + 2] * rs * g.z + b.z; o.w = t[4 * q + 3] * rs * g.w + b.w;
            u32x2 w; w.x = pk_bf16(o.x, o.y); w.y = pk_bf16(o.z, o.w); *(GAS u32x2*)(xr + c) = w;
            if (XF8) {
                const float s0 = __builtin_amdgcn_fmed3f(o.x * 16.f, -448.f, 448.f), s1 = __builtin_amdgcn_fmed3f(o.y * 16.f, -448.f, 448.f), s2 = __builtin_amdgcn_fmed3f(o.z * 16.f, -448.f, 448.f), s3 = __builtin_amdgcn_fmed3f(o.w * 16.f, -448.f, 448.f);
                int hp = __builtin_amdgcn_cvt_pk_fp8_f32(s0, s1, 0, false); hp = __builtin_amdgcn_cvt_pk_fp8_f32(s2, s3, hp, true);
                const f32x2 d01 = fp8lo((unsigned)hp), d23 = fp8hi((unsigned)hp);
                int lp = __builtin_amdgcn_cvt_pk_fp8_f32(s0 - d01.x, s1 - d01.y, 0, false); lp = __builtin_amdgcn_cvt_pk_fp8_f32(s2 - d23.x, s3 - d23.y, lp, true);
                *(GAS int*)(XF8 + (size_t)row * 2048 + c) = hp; *(GAS int*)(XF8 + (size_t)row * 2048 + 1024 + c) = lp; } }
    }
}

__device__ __forceinline__ void glanorm_phase(const GAS float* __restrict__ O, const GAS float* __restrict__ PROJ, const GAS float* __restrict__ gnorm, GAS bf16_t* XB, int nitems, int lane, int wave_gid, int nwaves) {
    const float g0 = gnorm[lane], g1 = gnorm[64 + lane];
    for (int it0 = wave_gid * 4; it0 < nitems; it0 += nwaves * 4) {
        float a0[4], a1[4], r0[4], r1[4];
#pragma unroll
        for (int q = 0; q < 4; ++q) { int it = it0 + q; it = it < nitems ? it : it0; const int row = it >> 2, h = it & 3; const GAS float* o = O + (size_t)row * 512 + h * 128; const GAS float* r = PROJ + (size_t)row * 2576 + 1040 + h * 128;
            a0[q] = o[lane]; a1[q] = o[64 + lane]; r0[q] = r[lane]; r1[q] = r[64 + lane]; }
#pragma unroll
        for (int q = 0; q < 4; ++q) { const int it = it0 + q; const int row = it >> 2, h = it & 3;
            const float rs = 1.f / sqrtf(wave_sum(a0[q] * a0[q] + a1[q] * a1[q], lane) * (1.f / 128.f) + 1e-5f);
            const float y0 = a0[q] * rs * g0 * (r0[q] * frcp(1.f + __expf(-r0[q]))), y1 = a1[q] * rs * g1 * (r1[q] * frcp(1.f + __expf(-r1[q])));
            if (it < nitems) { GAS bf16_t* d = XB + (size_t)row * 1024 + h * 128; d[lane] = (bf16_t)(pk_bf16(y0, 0.f) & 0xffffu); d[64 + lane] = (bf16_t)(pk_bf16(y1, 0.f) & 0xffffu); } }
    }
}

__device__ __forceinline__ float sigm(float x) { return frcp(1.f + __expf(-x)); }
__device__ __forceinline__ float softplusf(float x) { return fmaxf(x, 0.f) + log1pf(__expf(-fabsf(x))); }
__device__ __forceinline__ void rwkvprep_phase(const GAS float* __restrict__ w0, const GAS float* __restrict__ a0, const GAS float* __restrict__ v0, const GAS float* __restrict__ k_k, const GAS float* __restrict__ k_a, const GAS float* __restrict__ Vg,
                                               GAS float* K, GAS float* Wd, GAS float* Aa, GAS float* V, GAS float* NKK, GAS float* VFIRST, int has_vres, int nitems, int lane, int wave_gid, int nwaves) {
    for (int it0 = wave_gid * 4; it0 < nitems; it0 += nwaves * 4) {
        float kq[4], wq[4], aq[4], vq[4], gq[4], fq[4];
#pragma unroll
        for (int q = 0; q < 4; ++q) { const int it = it0 + q; const size_t ix = (size_t)(it >> 4) * 1024 + (it & 15) * 64 + lane; kq[q] = K[ix]; wq[q] = Wd[ix]; aq[q] = Aa[ix]; vq[q] = V[ix]; gq[q] = has_vres ? Vg[ix] : 0.f; fq[q] = has_vres ? VFIRST[ix] : 0.f; }
#pragma unroll
        for (int q = 0; q < 4; ++q) { const int it = it0 + q; const int h = it & 15; const size_t ix = (size_t)(it >> 4) * 1024 + h * 64 + lane; const int c = h * 64 + lane;
            const float k0 = kq[q]; const float kv = k0 * k_k[c]; const float inv = 1.f / fmaxf(sqrtf(wave_sum(kv * kv, lane)), 1e-12f);
            const float w = -softplusf(-(w0[c] + wq[q])) - 0.5f; const float dec = __expf(-__expf(w));
            const float a = sigm(a0[c] + aq[q]);
            float v = vq[q]; if (has_vres) v = v + (fq[q] - v) * sigm(v0[c] + gq[q]); else VFIRST[ix] = v;
            const float kk = kv * inv;
            NKK[ix] = -kk; K[ix] = k0 * (1.f + (a - 1.f) * k_a[c]); Wd[ix] = dec; Aa[ix] = kk * a; V[ix] = v; }
    }
}

__device__ __forceinline__ void rwkvpost_phase(const GAS float* __restrict__ Y, const GAS float* __restrict__ R, const GAS float* __restrict__ K2, const GAS float* __restrict__ V, const GAS float* __restrict__ G, const GAS float* __restrict__ r_k,
                                               const GAS float* __restrict__ lnx_g, const GAS float* __restrict__ lnx_b, GAS bf16_t* XB, int nitems, int lane, int wave_gid, int nwaves) {
    for (int it0 = wave_gid * 4; it0 < nitems; it0 += nwaves * 4) {
        float yq[4], rq[4], kq[4], vq[4], gq[4];
#pragma unroll
        for (int q = 0; q < 4; ++q) { const int it = it0 + q; const size_t ix = (size_t)(it >> 4) * 1024 + (it & 15) * 64 + lane; yq[q] = Y[ix]; rq[q] = R[ix]; kq[q] = K2[ix]; vq[q] = V[ix]; gq[q] = G[ix]; }
#pragma unroll
        for (int q = 0; q < 4; ++q) { const int it = it0 + q; const int h = it & 15; const size_t ix = (size_t)(it >> 4) * 1024 + h * 64 + lane; const int c = h * 64 + lane;
            const float y = yq[q]; const float mu = wave_sum(y, lane) * (1.f / 64.f); const float d = y - mu; const float rs = 1.f / sqrtf(wave_sum(d * d, lane) * (1.f / 64.f) + 64e-5f);
            const float bon = wave_sum(rq[q] * kq[q] * r_k[c], lane);
            const float o = (d * rs * lnx_g[c] + lnx_b[c] + bon * vq[q]) * gq[q];
            XB[ix] = (bf16_t)(pk_bf16(o, 0.f) & 0xffffu); }
    }
}

__device__ __forceinline__ void wkv_phase(const GAS float* __restrict__ R, const GAS float* __restrict__ Wd, const GAS float* __restrict__ K2, const GAS float* __restrict__ V, const GAS float* __restrict__ BB, const GAS float* __restrict__ NKK,
                                          const GAS float* __restrict__ SIN, GAS float* __restrict__ Y, GAS float* __restrict__ P, GAS float* __restrict__ SOUT, int B, int T, int DB, int DT, LAS unsigned char* lds, int tid, int bid, int nb) {
    constexpr int TB = 32, NLD = 6, VECB = TB * 1280, VVB = TB * 128, BUF = VECB + 2 * VVB;
    const int rowl = tid >> 4, part = tid & 15;
    const int nprompt = B * 32, nunits = nprompt + DB * 32;
    for (int u = bid; u < nunits; u += nb) {
        const bool smp = u >= nprompt; const int q0_ = smp ? u - nprompt : u; const int q = ((q0_ & 7) << 1 | ((q0_ >> 3) & 1)) + ((q0_ >> 4) << 4);
        const int half = q & 1, pair = q >> 1, sq = pair >> 4, h = pair & 15;
        const int Tu = smp ? DT : T; const int r0 = smp ? B * T + sq * DT : sq * T, vrow = half * 32 + rowl;
        f32x2 S01 = (f32x2){0.f, 0.f}, S23 = (f32x2){0.f, 0.f};
        if (smp) { const f32x4 s4 = *(const GAS f32x4*)(SIN + ((size_t)pair * 64 + vrow) * 64 + part * 4); S01 = (f32x2){s4.x, s4.y}; S23 = (f32x2){s4.z, s4.w};
                   asm volatile("" : "+v"(S01), "+v"(S23)); }
        const int nblk = (Tu + TB - 1) / TB;
        f32x4 ld[NLD];
        const size_t eo_ = (size_t)(r0 + (tid >> 4)) * 1024 + h * 64 + (tid & 15) * 4, ev_ = (size_t)(r0 + ((tid & 255) >> 3)) * 1024 + h * 64 + half * 32 + (tid & 7) * 4;
        const int lo_ = ((tid >> 4) * 320 + (tid & 15) * 4) * 4, lv_ = VECB + (tid & 255) * 16;
#define WKV_LOAD(tb0) do { const size_t bo_ = (size_t)(tb0) * 1024; ld[0] = *(const GAS f32x4*)(Wd + eo_ + bo_); ld[1] = *(const GAS f32x4*)(NKK + eo_ + bo_); ld[2] = *(const GAS f32x4*)(BB + eo_ + bo_); \
            ld[3] = *(const GAS f32x4*)(K2 + eo_ + bo_); ld[4] = *(const GAS f32x4*)(R + eo_ + bo_); ld[5] = *(const GAS f32x4*)(V + ev_ + bo_); } while (0)
#define WKV_STORE(bufp) do { _Pragma("unroll") for (int q_ = 0; q_ < 5; ++q_) *(LAS f32x4*)((bufp) + lo_ + q_ * 256) = ld[q_]; *(LAS f32x4*)((bufp) + lv_) = ld[5]; } while (0)
        WKV_LOAD(0); WKV_STORE(lds); __syncthreads();
        for (int b = 0; b < nblk; ++b) {
            LAS unsigned char* cur = lds + (b & 1) * BUF; LAS unsigned char* nxt = lds + ((b + 1) & 1) * BUF; const int tb0 = b * TB; const int nt = (Tu - tb0) < TB ? (Tu - tb0) : TB;
            if (b + 1 < nblk) WKV_LOAD(tb0 + TB);
            const LAS float* vec = (const LAS float*)cur + part * 4; const LAS float* vv = (const LAS float*)(cur + VECB) + rowl; LAS float* yb = (LAS float*)(cur + VECB + VVB);
            float ykeep0 = 0.f, ykeep1 = 0.f;
#define WKV_STEP(t, keep, tl) do { const LAS f32x2* vp_ = (const LAS f32x2*)(vec + (t) * 320); \
                const f32x2 w01 = vp_[0], w23 = vp_[1], n01 = vp_[32], n23 = vp_[33], b01 = vp_[64], b23 = vp_[65], k01 = vp_[96], k23 = vp_[97], r01 = vp_[128], r23 = vp_[129]; \
                const float v = vv[(t) * 32]; \
                const f32x2 sp = __builtin_elementwise_fma(S23, n23, S01 * n01); const float sa = row_sum16(sp.x + sp.y); const f32x2 sa2 = (f32x2){sa, sa}, v2 = (f32x2){v, v}; \
                S01 = __builtin_elementwise_fma(S01, w01, __builtin_elementwise_fma(b01, sa2, k01 * v2)); S23 = __builtin_elementwise_fma(S23, w23, __builtin_elementwise_fma(b23, sa2, k23 * v2)); \
                const f32x2 yp = __builtin_elementwise_fma(S23, r23, S01 * r01); const float y = row_sum16(yp.x + yp.y); \
                keep = (part == (tl)) ? y : keep; } while (0)
            if (nt == TB) {
#pragma unroll 1
                for (int t = 0; t < 16; t += 8) { WKV_STEP(t, ykeep0, t); WKV_STEP(t + 1, ykeep0, t + 1); WKV_STEP(t + 2, ykeep0, t + 2); WKV_STEP(t + 3, ykeep0, t + 3); WKV_STEP(t + 4, ykeep0, t + 4); WKV_STEP(t + 5, ykeep0, t + 5); WKV_STEP(t + 6, ykeep0, t + 6); WKV_STEP(t + 7, ykeep0, t + 7); }
#pragma unroll 1
                for (int t = 16; t < 32; t += 8) { WKV_STEP(t, ykeep1, t - 16); WKV_STEP(t + 1, ykeep1, t - 15); WKV_STEP(t + 2, ykeep1, t - 14); WKV_STEP(t + 3, ykeep1, t - 13); WKV_STEP(t + 4, ykeep1, t - 12); WKV_STEP(t + 5, ykeep1, t - 11); WKV_STEP(t + 6, ykeep1, t - 10); WKV_STEP(t + 7, ykeep1, t - 9); }
            } else { for (int t = 0; t < nt; ++t) { if (t < 16) WKV_STEP(t, ykeep0, t); else WKV_STEP(t, ykeep1, t - 16); } }
#undef WKV_STEP
            yb[part * 32 + rowl] = ykeep0; yb[(16 + part) * 32 + rowl] = ykeep1;
            if (b + 1 < nblk) WKV_STORE(nxt);
            __syncthreads();
            { const int rl = tid & 31; _Pragma("unroll") for (int t = tid >> 5; t < TB; t += 16) if (t < nt) Y[(size_t)(r0 + tb0 + t) * 1024 + h * 64 + half * 32 + rl] = yb[t * 32 + rl]; }
        }
#undef WKV_LOAD
#undef WKV_STORE
        *(GAS f32x4*)((smp ? SOUT : P) + ((size_t)pair * 64 + vrow) * 64 + part * 4) = (f32x4){S01.x, S01.y, S23.x, S23.y};
        __syncthreads();
    }
}

__device__ __forceinline__ void rwkvpost2_phase(const GAS float* __restrict__ Y, const GAS bf16_t* __restrict__ G, const GAS float* __restrict__ VF, const GAS float* __restrict__ BON, const GAS float* __restrict__ lnx_g, const GAS float* __restrict__ lnx_b,
                                                GAS bf16_t* XB, int nitems, int lane, int wave_gid, int nwaves) {
    const int nit4 = nitems >> 2, hg = wave_gid & 3, cofs = hg * 256 + 4 * lane; const f32x4 lg = *(const GAS f32x4*)(lnx_g + cofs), lb = *(const GAS f32x4*)(lnx_b + cofs);
    for (int it0 = wave_gid; it0 < nit4; it0 += nwaves * 4) {
        f32x4 yq[4], vq[4]; u32x2 gq[4]; float bq[4];
#pragma unroll
        for (int q = 0; q < 4; ++q) { int it = it0 + q * nwaves; it = it < nit4 ? it : it0; const int row = it >> 2; const size_t ix = (size_t)row * 1024 + cofs;
            yq[q] = *(const GAS f32x4*)(Y + ix); vq[q] = *(const GAS f32x4*)(VF + ix); gq[q] = *(const GAS u32x2*)(G + ix); bq[q] = BON[row * 16 + hg * 4 + (lane >> 4)]; }
#pragma unroll
        for (int q = 0; q < 4; ++q) { const int it = it0 + q * nwaves; const int row = it >> 2; const f32x4 y = yq[q];
            const float mu = row_sum16((y.x + y.y) + (y.z + y.w)) * (1.f / 64.f); const f32x4 d = y - mu; const float rs = __builtin_amdgcn_rsqf(row_sum16((d.x * d.x + d.y * d.y) + (d.z * d.z + d.w * d.w)) * (1.f / 64.f) + 64e-5f);
            const f32x4 gg = (f32x4){bflo(gq[q].x), bfhi(gq[q].x), bflo(gq[q].y), bfhi(gq[q].y)}; const f32x4 o = (d * rs * lg + lb + bq[q] * vq[q]) * gg;
            if (it < nit4) { u32x2 w_; w_.x = pk_bf16(o.x, o.y); w_.y = pk_bf16(o.z, o.w); *(GAS u32x2*)(XB + (size_t)row * 1024 + cofs) = w_; } }
    }
}

__device__ __forceinline__ void wkv2_phase(const GAS bf16_t* __restrict__ R, const GAS bf16_t* __restrict__ KR, const GAS bf16_t* __restrict__ WL, const GAS bf16_t* __restrict__ AL, const GAS bf16_t* __restrict__ V, const GAS bf16_t* __restrict__ VG,
                                           const GAS float* VFI, const GAS float* __restrict__ PRM, const GAS float* __restrict__ SIN, GAS float* __restrict__ Y, GAS float* __restrict__ P, GAS float* __restrict__ SOUT, GAS float* VFO, GAS float* __restrict__ BON,
                                           int has_vres, int B, int T, int DB, int DT, LAS unsigned char* lds, int tid, int bid, int nb) {
    constexpr int TB = 32, VECB = TB * 1280, VVB = TB * 128, BUF = VECB + 2 * VVB;
    const bool scanw = __builtin_amdgcn_readfirstlane(tid) < 256; const int pt = tid & 255;
    const int rowl = pt >> 4, part = pt & 15;
    const int nprompt = B * 32, nunits = nprompt + DB * 32;
    for (int u = bid; u < nunits; u += nb) {
        const bool smp = u >= nprompt; const int q0_ = smp ? u - nprompt : u; const int q = ((q0_ & 7) << 1 | ((q0_ >> 3) & 1)) + ((q0_ >> 4) << 4);
        const int half = q & 1, pair = q >> 1, sq = pair >> 4, h = pair & 15;
        const int Tu = smp ? DT : T; const int r0 = smp ? B * T + sq * DT : sq * T, vrow = half * 32 + rowl;
        const int srow = pt >> 3, sp8 = pt & 7;
        f32x2 S0 = (f32x2){0.f, 0.f}, S1 = (f32x2){0.f, 0.f}, S2 = (f32x2){0.f, 0.f}, S3 = (f32x2){0.f, 0.f};
        if (smp && scanw) { const GAS f32x4* sp_ = (const GAS f32x4*)(SIN + ((size_t)pair * 64 + half * 32 + srow) * 64 + sp8 * 8); const f32x4 sa4 = sp_[0], sb4 = sp_[1];
                   S0 = (f32x2){sa4.x, sa4.y}; S1 = (f32x2){sa4.z, sa4.w}; S2 = (f32x2){sb4.x, sb4.y}; S3 = (f32x2){sb4.z, sb4.w};
                   asm volatile("" : "+v"(S0), "+v"(S1), "+v"(S2), "+v"(S3)); }
        const int nblk = (Tu + TB - 1) / TB;
        u32x2 lk0, lw0, la0, lr0, lk1, lw1, la1, lr1, lv, lg = (u32x2){0u, 0u}; f32x4 lf = (f32x4){0.f, 0.f, 0.f, 0.f};
        const size_t eo_ = (size_t)(r0 + (pt >> 4)) * 1024 + h * 64 + part * 4, ev_ = (size_t)(r0 + (pt >> 3)) * 1024 + h * 64 + half * 32 + (pt & 7) * 4;
        const int lo_ = ((pt >> 4) * 320 + part * 4) * 4, lv_ = VECB + pt * 16;
        const int pc_ = h * 64 + part * 4; const f32x4 w0v = *(const GAS f32x4*)(PRM + pc_), a0v = *(const GAS f32x4*)(PRM + 1024 + pc_), kkp = *(const GAS f32x4*)(PRM + 3072 + pc_), kap = *(const GAS f32x4*)(PRM + 4096 + pc_), rkp = *(const GAS f32x4*)(PRM + 5120 + pc_);
        const f32x4 v0v = *(const GAS f32x4*)(PRM + 2048 + h * 64 + half * 32 + (pt & 7) * 4);
#define WKV_LOAD(tb0) do { const size_t bo_ = (size_t)(tb0) * 1024, b1_ = bo_ + 16 * 1024; lk0 = *(const GAS u32x2*)(KR + eo_ + bo_); lw0 = *(const GAS u32x2*)(WL + eo_ + bo_); la0 = *(const GAS u32x2*)(AL + eo_ + bo_); lr0 = *(const GAS u32x2*)(R + eo_ + bo_); \
            lk1 = *(const GAS u32x2*)(KR + eo_ + b1_); lw1 = *(const GAS u32x2*)(WL + eo_ + b1_); la1 = *(const GAS u32x2*)(AL + eo_ + b1_); lr1 = *(const GAS u32x2*)(R + eo_ + b1_); \
            lv = *(const GAS u32x2*)(V + ev_ + bo_); if (has_vres) { lg = *(const GAS u32x2*)(VG + ev_ + bo_); lf = *(const GAS f32x4*)(VFI + ev_ + bo_); } } while (0)
#define WKV_UNPK(w_) ((f32x4){bflo((w_).x), bfhi((w_).x), bflo((w_).y), bfhi((w_).y)})
#define WKV_ITEM(bufp, tb0, lk, lw, la, lr, ti_) do { const f32x4 k4 = WKV_UNPK(lk), wl4 = WKV_UNPK(lw), al4 = WKV_UNPK(la); const f32x4 kv = k4 * kkp; const float ss = row_sum16((kv.x * kv.x + kv.y * kv.y) + (kv.z * kv.z + kv.w * kv.w)); const float inv = frcp(fmaxf(fsqrt(ss), 1e-12f)); \
            f32x4 dec, a4; _Pragma("unroll") for (int i_ = 0; i_ < 4; ++i_) { dec[i_] = __expf(-0.6065306597126334f * frcp(1.f + __expf(-(w0v[i_] + wl4[i_])))); a4[i_] = frcp(1.f + __expf(-(a0v[i_] + al4[i_]))); } \
            const f32x4 kk = kv * inv; const f32x4 k2 = k4 * ((a4 - 1.f) * kap + 1.f); const f32x4 r4 = WKV_UNPK(lr); const f32x4 rk = r4 * k2 * rkp; const float bon = row_sum16((rk.x + rk.y) + (rk.z + rk.w)); \
            LAS unsigned char* d_ = (bufp) + lo_ + (ti_) * 1280; *(LAS f32x4*)(d_) = dec; *(LAS f32x4*)(d_ + 256) = -kk; *(LAS f32x4*)(d_ + 512) = kk * a4; *(LAS f32x4*)(d_ + 768) = k2; *(LAS f32x4*)(d_ + 1024) = r4; \
            const int tr_ = (tb0) + (pt >> 4) + (ti_); if (half == 0 && part == 0 && tr_ < Tu) BON[(size_t)(r0 + tr_) * 16 + h] = bon; } while (0)
#define WKV_STORE(bufp, tb0) do { WKV_ITEM(bufp, tb0, lk0, lw0, la0, lr0, 0); if ((tb0) + 16 < Tu) WKV_ITEM(bufp, tb0, lk1, lw1, la1, lr1, 16); \
            f32x4 v4 = WKV_UNPK(lv); if (has_vres) { const f32x4 g4 = WKV_UNPK(lg); _Pragma("unroll") for (int i_ = 0; i_ < 4; ++i_) v4[i_] = v4[i_] + (lf[i_] - v4[i_]) * frcp(1.f + __expf(-(v0v[i_] + g4[i_]))); } \
            *(LAS f32x4*)((bufp) + lv_) = v4; const int tv_ = (tb0) + (pt >> 3); if (tv_ < Tu) *(GAS f32x4*)(VFO + ev_ + (size_t)(tb0) * 1024) = v4; } while (0)
#define WKV_YOUT(bufp, tb0, ntp) do { const LAS float* yb_ = (const LAS float*)((bufp) + VECB + VVB); const int rl = pt & 31; _Pragma("unroll") for (int t = pt >> 5; t < TB; t += 8) if (t < (ntp)) Y[(size_t)(r0 + (tb0) + t) * 1024 + h * 64 + half * 32 + rl] = yb_[t * 32 + rl]; } while (0)
        if (!scanw) { WKV_LOAD(0); WKV_STORE(lds, 0); if (nblk > 1) WKV_LOAD(TB); }
        __syncthreads();
        for (int b = 0; b < nblk; ++b) {
            LAS unsigned char* cur = lds + (b & 1) * BUF; LAS unsigned char* nxt = lds + ((b + 1) & 1) * BUF; const int tb0 = b * TB; const int nt = (Tu - tb0) < TB ? (Tu - tb0) : TB;
            if (scanw) {
                const LAS float* vec = (const LAS float*)cur + sp8 * 8; const LAS float* vv = (const LAS float*)(cur + VECB) + srow; LAS float* yb = (LAS float*)(cur + VECB + VVB);
                LAS float* ybl = yb + srow;
                struct StepV { f32x4 w0, w1, n0, n1, b0, b1, k0, k1, r0, r1; float v; };
#define WKV_RD(dst, t) do { const LAS f32x4* vp_ = (const LAS f32x4*)(vec + (t) * 320); dst.w0 = vp_[0]; dst.w1 = vp_[1]; dst.n0 = vp_[16]; dst.n1 = vp_[17]; dst.b0 = vp_[32]; dst.b1 = vp_[33]; \
                dst.k0 = vp_[48]; dst.k1 = vp_[49]; dst.r0 = vp_[64]; dst.r1 = vp_[65]; dst.v = vv[(t) * 32]; } while (0)
#define WKV_LO(q_) ((f32x2){(q_).x, (q_).y})
#define WKV_HI(q_) ((f32x2){(q_).z, (q_).w})
#define WKV_UPD(S, w_, b_, k_) S = __builtin_elementwise_fma(S, w_, __builtin_elementwise_fma(b_, sa2, (k_) * v2))
#define WKV_CMP(src, t_) do { const f32x2 spa = __builtin_elementwise_fma(S1, WKV_HI(src.n0), S0 * WKV_LO(src.n0)), spb = __builtin_elementwise_fma(S3, WKV_HI(src.n1), S2 * WKV_LO(src.n1)); const f32x2 sp = spa + spb; \
                const float sa = row_sum8(sp.x + sp.y); const f32x2 sa2 = (f32x2){sa, sa}, v2 = (f32x2){src.v, src.v}; \
                WKV_UPD(S0, WKV_LO(src.w0), WKV_LO(src.b0), WKV_LO(src.k0)); WKV_UPD(S1, WKV_HI(src.w0), WKV_HI(src.b0), WKV_HI(src.k0)); WKV_UPD(S2, WKV_LO(src.w1), WKV_LO(src.b1), WKV_LO(src.k1)); WKV_UPD(S3, WKV_HI(src.w1), WKV_HI(src.b1), WKV_HI(src.k1)); \
                const f32x2 ypa = __builtin_elementwise_fma(S1, WKV_HI(src.r0), S0 * WKV_LO(src.r0)), ypb = __builtin_elementwise_fma(S3, WKV_HI(src.r1), S2 * WKV_LO(src.r1)); const f32x2 yp = ypa + ypb; \
                ybl[(t_) * 32] = row_sum8(yp.x + yp.y); } while (0)
#define WKV_ST(t_, cur_, nx2_) do { WKV_RD(nx2_, ((t_) + 2) & 31); __builtin_amdgcn_sched_barrier(0); WKV_CMP(cur_, t_); } while (0)
                if (nt == TB) {
                    StepV sA, sB, sC; WKV_RD(sA, 0); WKV_RD(sB, 1);
#pragma unroll 1
                    for (int t = 0; t < 30; t += 3) { WKV_ST(t, sA, sC); WKV_ST(t + 1, sB, sA); WKV_ST(t + 2, sC, sB); }
                    WKV_ST(30, sA, sC); WKV_ST(31, sB, sA);
                } else { StepV sA; for (int t = 0; t < nt; ++t) { WKV_RD(sA, t); WKV_CMP(sA, t); } }
#undef WKV_RD
#undef WKV_LO
#undef WKV_HI
#undef WKV_UPD
#undef WKV_CMP
#undef WKV_ST
            } else {
                if (b > 0) WKV_YOUT(nxt, tb0 - TB, TB);
                if (b + 1 < nblk) { WKV_STORE(nxt, tb0 + TB); if (b + 2 < nblk) WKV_LOAD(tb0 + 2 * TB); }
            }
            __syncthreads();
        }
        if (!scanw) { const int tbl = (nblk - 1) * TB; WKV_YOUT(lds + ((nblk - 1) & 1) * BUF, tbl, Tu - tbl); }
#undef WKV_LOAD
#undef WKV_STORE
#undef WKV_ITEM
#undef WKV_YOUT
#undef WKV_UNPK
        if (scanw) { GAS float* so = (smp ? SOUT : P) + ((size_t)pair * 64 + half * 32 + srow) * 64 + sp8 * 8; *(GAS f32x4*)so = (f32x4){S0.x, S0.y, S1.x, S1.y}; *(GAS f32x4*)(so + 4) = (f32x4){S2.x, S2.y, S3.x, S3.y}; }
        __syncthreads();
    }
}

__device__ __forceinline__ void gla_phase(const GAS float* __restrict__ PROJ, const GAS float* __restrict__ LOGA, GAS float* __restrict__ O, GAS float* __restrict__ P, int B, int T, LAS unsigned char* lds, int tid, int bid, int nb) {
    constexpr int TB = 32, OA = 0, OK = 8192, OQ = 16384, OV = 24576, BUF = 26624;
    const int wv = __builtin_amdgcn_readfirstlane(tid) >> 6; const bool scanw = wv < 4; const int pt = tid & 255, lane = tid & 63;
    const int col = pt >> 4, p = pt & 15, dk = p * 4;
    const int nunits = B * 32;
#define GLA_WAITV(n_) asm volatile("s_waitcnt vmcnt(" #n_ ")" ::: "memory")
#define GLA_BAR() do { asm volatile("s_waitcnt lgkmcnt(0)" ::: "memory"); __builtin_amdgcn_s_barrier(); asm volatile("" ::: "memory"); } while (0)
    for (int u = bid; u < nunits; u += nb) {
        const int ug_ = ((u & 7) << 3 | ((u >> 3) & 7)) + ((u >> 6) << 6);
        const int cb = ug_ & 7, pair = ug_ >> 3, s = pair >> 2, h = pair & 3; const int r0 = s * T;
        f32x2 S01 = (f32x2){0.f, 0.f}, S23 = (f32x2){0.f, 0.f};
        const int nblk = (T + TB - 1) / TB;
        const GAS unsigned char* gsrc; size_t gins, gblk; int ldst;
        if (wv == 4) { gsrc = (const GAS unsigned char*)(LOGA + (size_t)(r0 + (lane >> 4)) * 256 + h * 64 + (lane & 15) * 4); gins = (size_t)4 * 256 * 4; gblk = (size_t)TB * 256 * 4; ldst = OA; }
        else if (wv == 7) { gsrc = (const GAS unsigned char*)(PROJ + (size_t)(r0 + (lane >> 2)) * 2576 + 512 + h * 128 + cb * 16 + (lane & 3) * 4); gins = (size_t)16 * 2576 * 4; gblk = (size_t)TB * 2576 * 4; ldst = OV; }
        else { gsrc = (const GAS unsigned char*)(PROJ + (size_t)(r0 + (lane >> 4)) * 2576 + (wv == 5 ? 256 : 0) + h * 64 + (lane & 15) * 4); gins = (size_t)4 * 2576 * 4; gblk = (size_t)TB * 2576 * 4; ldst = wv == 5 ? OK : OQ; }
#define GLA_DMA(blk_) do { const GAS unsigned char* s_ = gsrc + (size_t)(blk_) * gblk; LAS unsigned char* d_ = lds + ((blk_) % 3) * BUF + ldst; \
            if (wv == 7) { __builtin_amdgcn_global_load_lds((const GAS unsigned*)s_, (LAS unsigned*)d_, 16, 0, 0); __builtin_amdgcn_global_load_lds((const GAS unsigned*)(s_ + gins), (LAS unsigned*)(d_ + 1024), 16, 0, 0); } \
            else { _Pragma("unroll") for (int i_ = 0; i_ < 8; ++i_) __builtin_amdgcn_global_load_lds((const GAS unsigned*)(s_ + i_ * gins), (LAS unsigned*)(d_ + i_ * 1024), 16, 0, 0); } } while (0)
        if (!scanw) { GLA_DMA(0); if (nblk > 1) { GLA_DMA(1); if (wv == 7) GLA_WAITV(2); else GLA_WAITV(8); } else GLA_WAITV(0); }
        GLA_BAR();
        for (int b = 0; b < nblk; ++b) {
            const int tb0 = b * TB; const int nt = (T - tb0) < TB ? (T - tb0) : TB;
            if (scanw) {
                const LAS unsigned char* cur = lds + (b % 3) * BUF; const LAS float* vec = (const LAS float*)cur + dk; const LAS float* vv = (const LAS float*)(cur + OV) + col;
                float okeep0 = 0.f, okeep1 = 0.f;
                struct G4 { f32x4 a[4], k[4], q[4]; float v[4]; };
#define GLA_RD4(dst, t0_) do { _Pragma("unroll") for (int i_ = 0; i_ < 4; ++i_) { const LAS float* vp_ = vec + ((t0_) + i_) * 64; dst.a[i_] = *(const LAS f32x4*)vp_; dst.k[i_] = *(const LAS f32x4*)(vp_ + OK / 4); dst.q[i_] = *(const LAS f32x4*)(vp_ + OQ / 4); dst.v[i_] = vv[((t0_) + i_) * 16]; } } while (0)
#define GLA_ONE(src, i_, keep, tl) do { const f32x4 a4 = src.a[i_], k4 = src.k[i_], q4 = src.q[i_]; const f32x2 v2 = (f32x2){src.v[i_], src.v[i_]}; \
                S01 = __builtin_elementwise_fma((f32x2){a4.x, a4.y}, S01, (f32x2){k4.x, k4.y} * v2); S23 = __builtin_elementwise_fma((f32x2){a4.z, a4.w}, S23, (f32x2){k4.z, k4.w} * v2); \
                const f32x2 o2 = __builtin_elementwise_fma((f32x2){q4.z, q4.w}, S23, (f32x2){q4.x, q4.y} * S01); const float o = row_sum16(o2.x + o2.y); keep = (p == (tl)) ? o : keep; } while (0)
#define GLA_CMP4(src, keep, tl0) do { GLA_ONE(src, 0, keep, tl0); GLA_ONE(src, 1, keep, (tl0) + 1); GLA_ONE(src, 2, keep, (tl0) + 2); GLA_ONE(src, 3, keep, (tl0) + 3); } while (0)
                if (nt == TB) {
                    G4 gA, gB; GLA_RD4(gA, 0);
                    GLA_RD4(gB, 4); __builtin_amdgcn_sched_barrier(0); GLA_CMP4(gA, okeep0, 0); GLA_RD4(gA, 8); __builtin_amdgcn_sched_barrier(0); GLA_CMP4(gB, okeep0, 4);
                    GLA_RD4(gB, 12); __builtin_amdgcn_sched_barrier(0); GLA_CMP4(gA, okeep0, 8); GLA_RD4(gA, 16); __builtin_amdgcn_sched_barrier(0); GLA_CMP4(gB, okeep0, 12);
                    GLA_RD4(gB, 20); __builtin_amdgcn_sched_barrier(0); GLA_CMP4(gA, okeep1, 0); GLA_RD4(gA, 24); __builtin_amdgcn_sched_barrier(0); GLA_CMP4(gB, okeep1, 4);
                    GLA_RD4(gB, 28); __builtin_amdgcn_sched_barrier(0); GLA_CMP4(gA, okeep1, 8); __builtin_amdgcn_sched_barrier(0); GLA_CMP4(gB, okeep1, 12);
                } else { G4 g1; for (int t = 0; t < nt; ++t) { const LAS float* vp_ = vec + t * 64; g1.a[0] = *(const LAS f32x4*)vp_; g1.k[0] = *(const LAS f32x4*)(vp_ + OK / 4); g1.q[0] = *(const LAS f32x4*)(vp_ + OQ / 4); g1.v[0] = vv[t * 16];
                    if (t < 16) GLA_ONE(g1, 0, okeep0, t); else GLA_ONE(g1, 0, okeep1, t - 16); } }
#undef GLA_RD4
#undef GLA_ONE
#undef GLA_CMP4
                { int pt_ = pt; asm volatile("" : "+v"(pt_)); const int p_ = pt_ & 15; GAS float* od = O + (size_t)(r0 + tb0 + p_) * 512 + h * 128 + cb * 16 + (pt_ >> 4);
                  if (p_ < nt) od[0] = okeep0 * 0.125f; if (16 + p_ < nt) od[(size_t)16 * 512] = okeep1 * 0.125f; }
            } else {
                if (b + 2 < nblk) { GLA_DMA(b + 2); if (wv == 7) GLA_WAITV(2); else GLA_WAITV(8); } else GLA_WAITV(0);
            }
            GLA_BAR();
        }
#undef GLA_DMA
        if (scanw) { int pt_ = pt; asm volatile("" : "+v"(pt_));
                     GAS float* so = P + ((size_t)pair * 64 + (pt_ & 15) * 4) * 128 + cb * 16 + (pt_ >> 4); so[0] = S01.x; so[128] = S01.y; so[256] = S23.x; so[384] = S23.y; }
        GLA_BAR();
    }
#undef GLA_WAITV
#undef GLA_BAR
}
__device__ __forceinline__ float grp8_sum(float v) { v += dppf<0xB1>(v); v += dppf<0x4E>(v); v += dppf<0x141>(v); return v; }
__device__ __forceinline__ float dot16_fp8_bf16(const u32x4 uw, const float (&x)[16]) { float s = 0.f;
#pragma unroll
    for (int d = 0; d < 4; ++d) { const f32x2 lo = fp8lo(uw[d]), hi = fp8hi(uw[d]); s = fmaf(lo.x, x[4 * d], s); s = fmaf(lo.y, x[4 * d + 1], s); s = fmaf(hi.x, x[4 * d + 2], s); s = fmaf(hi.y, x[4 * d + 3], s); }
    return s; }
typedef int i32x8 __attribute__((ext_vector_type(8)));
typedef unsigned u32x8 __attribute__((ext_vector_type(8)));
__device__ __forceinline__ void pacts_phase(const GAS unsigned char* XF8, const GAS unsigned char* U8S, const GAS int* EIDX, GAS bf16_t* __restrict__ PART, int M, int emask,
                                            LAS unsigned char* lds, int wid, int lane, int bid, int nb) {
    const bool spl = (nb & 7) == 0; const int s0 = spl ? (bid & 7) : 0, s1 = spl ? s0 + 1 : 8, r = spl ? (bid >> 3) : bid, nr = spl ? (nb >> 3) : nb;
    const int g = lane >> 3, c = lane & 7, fg = ((g >> 2) & 1) | (((g >> 1) & 1) << 2);
    const int m16 = lane & 15, kb = lane >> 4, fm = ((m16 >> 2) & 1) | (((m16 >> 1) & 1) << 2);
    LAS unsigned char* const wl = lds + wid * 16384;
    const LAS unsigned char* const ard = wl + m16 * 128 + (((2 * kb) ^ fm) * 16);
    const LAS unsigned char* const xrd = wl + 12288 + (m16 & 1) * 128 + kb * 32;
    const LAS unsigned char* const ird = wl + 13824 + g * 4;
    if (r >= M) return;
    const int ntok = (M - r + nr - 1) / nr;
#define PL_ROW(t_) ({ int rw_ = r + nr * (t_); rw_ < M ? rw_ : r; })
#define PL_IDS(t_, slot_) __builtin_amdgcn_global_load_lds((const GAS unsigned*)(isrc + (size_t)PL_ROW(t_) * 128), (LAS unsigned*)(wl + 13824 + (slot_) * 256), 4, 0, 0)
#define PL_RDIDS(slot_, e0_, e1_) do { e0_ = *(const LAS int*)(ird + (slot_) * 256); e1_ = *(const LAS int*)(ird + (slot_) * 256 + 32); } while (0)
#define PL_TILE(t_, slot_, e0_, e1_) do { \
        __builtin_amdgcn_global_load_lds((const GAS unsigned*)(tb + (size_t)((e0_) & emask) * 128), (LAS unsigned*)(wl + (slot_) * 2048), 16, 0, 0); \
        __builtin_amdgcn_global_load_lds((const GAS unsigned*)(tb + (size_t)((e1_) & emask) * 128), (LAS unsigned*)(wl + (slot_) * 2048 + 1024), 16, 0, 0); \
        __builtin_amdgcn_global_load_lds((const GAS unsigned*)(xsrc + (size_t)PL_ROW(t_) * 2048), (LAS unsigned*)(wl + 12288 + (slot_) * 256), 4, 0, 0); } while (0)
#define PL_RD(slot_, a0_, a1_, x0_, x1_) do { a0_ = *(const LAS u32x4*)(ard + (slot_) * 2048); a1_ = *(const LAS u32x4*)(ard2 + (slot_) * 2048); x0_ = *(const LAS u32x4*)(xrd + (slot_) * 256); x1_ = *(const LAS u32x4*)(xrd + (slot_) * 256 + 16); } while (0)
#define PL_MMA(cc_, a0_, a1_, x0_, x1_) do { const i32x8 av = (i32x8)__builtin_shufflevector(a0_, a1_, 0, 1, 2, 3, 4, 5, 6, 7), bv = (i32x8)__builtin_shufflevector(x0_, x1_, 0, 1, 2, 3, 4, 5, 6, 7); const f32x4 z = {0.f, 0.f, 0.f, 0.f}; \
        cc_ = __builtin_amdgcn_mfma_scale_f32_16x16x128_f8f6f4(av, bv, z, 0, 0, 0, 0, 0, 0); } while (0)
#define PL_OUT(t_, cc_) do { f32x4 o; _Pragma("unroll") for (int i = 0; i < 4; ++i) { float v = cc_[i]; v += dppf<0xB1>(v); o[i] = v * (1.f / 16.f); } \
        const int rw = r + nr * (t_); if (m16 == 0 && rw < M) { u32x2 w_; w_.x = pk_bf16(o[0], o[1]); w_.y = pk_bf16(o[2], o[3]); *(GAS u32x2*)(po + (size_t)rw * 128) = w_; } } while (0)
#define PL_WAIT(n_) asm volatile("s_waitcnt vmcnt(" #n_ ")" ::: "memory")
#define PL_STEP(j_, h_) do { PL_WAIT(12); u32x4 a0[3], a1[3], x0[3], x1[3]; int e0[3], e1[3]; f32x4 cc[3]; \
        _Pragma("unroll") for (int k = 0; k < 3; ++k) PL_RD((h_) * 3 + k, a0[k], a1[k], x0[k], x1[k]); \
        _Pragma("unroll") for (int k = 0; k < 3; ++k) PL_RDIDS((h_) * 3 + k, e0[k], e1[k]); \
        _Pragma("unroll") for (int k = 0; k < 3; ++k) PL_MMA(cc[k], a0[k], a1[k], x0[k], x1[k]); \
        _Pragma("unroll") for (int k = 0; k < 3; ++k) PL_TILE((j_) + 6 + k, (h_) * 3 + k, e0[k], e1[k]); \
        _Pragma("unroll") for (int k = 0; k < 3; ++k) PL_IDS((j_) + 12 + k, (h_) * 3 + k); \
        _Pragma("unroll") for (int k = 0; k < 3; ++k) PL_OUT((j_) + k, cc[k]); } while (0)
    const LAS unsigned char* const ard2 = (const LAS unsigned char*)((unsigned)(size_t)ard ^ 16u);
    for (int s = s0; s < s1; ++s) {
        const GAS unsigned char* tb = U8S + (size_t)s * 16384 * 128 + ((c ^ fg) * 16);
        const GAS unsigned char* xsrc = XF8 + (size_t)(lane >> 5) * 1024 + s * 128 + (lane & 31) * 4;
        const GAS int* isrc = EIDX + wid * 16 + m16;
        GAS bf16_t* po = PART + (size_t)s * M * 128 + wid * 16 + kb * 4;
        PL_IDS(0, 0); PL_IDS(1, 1); PL_IDS(2, 2); PL_IDS(3, 3); PL_IDS(4, 4); PL_IDS(5, 5); PL_WAIT(0);
        { int e0[6], e1[6];
#pragma unroll
          for (int k = 0; k < 6; ++k) PL_RDIDS(k, e0[k], e1[k]);
#pragma unroll
          for (int k = 0; k < 3; ++k) PL_TILE(k, k, e0[k], e1[k]);
#pragma unroll
          for (int k = 0; k < 3; ++k) PL_IDS(6 + k, k);
#pragma unroll
          for (int k = 3; k < 6; ++k) PL_TILE(k, k, e0[k], e1[k]);
#pragma unroll
          for (int k = 3; k < 6; ++k) PL_IDS(6 + k, k); }
        for (int j = 0; j < ntok; j += 6) { PL_STEP(j, 0); PL_STEP(j + 3, 1); }
        PL_WAIT(0);
    }
#undef PL_ROW
#undef PL_IDS
#undef PL_RDIDS
#undef PL_TILE
#undef PL_RD
#undef PL_MMA
#undef PL_OUT
#undef PL_WAIT
#undef PL_STEP
}
__device__ __forceinline__ void pouts_phase(const GAS float* __restrict__ COEF, const GAS int* __restrict__ EIDX, const GAS unsigned char* V8S, GAS bf16_t* __restrict__ YBUF, int M,
                                            int wid, int lane, int bid, int nb) {
    const bool spl = (nb & 7) == 0; const int s0 = spl ? (bid & 7) : 0, s1 = spl ? s0 + 1 : 8, r = spl ? (bid >> 3) : bid, nr = spl ? (nb >> 3) : nb;
    const int g = lane >> 3, ch = lane & 7, rstep = nr * 8;
#define PO_LOADCE(rw, c0, c1, v0, v1) do { c0 = COEF[(size_t)(rw) * 128 + lane] * (1.f / 64.f); c1 = COEF[(size_t)(rw) * 128 + 64 + lane] * (1.f / 64.f); v0 = EIDX[(size_t)(rw) * 128 + lane]; v1 = EIDX[(size_t)(rw) * 128 + 64 + lane]; } while (0)
#define PO_GATHER(vv_, vreg) do { _Pragma("unroll") for (int k = 0; k < 8; ++k) { const int e = __builtin_amdgcn_ds_bpermute((8 * k + g) << 2, vreg); vv_[k] = *(const GAS u32x4*)(tb + (size_t)(e & 16383) * 128); } } while (0)
#define PO_COMP(vv_, creg) do { _Pragma("unroll") for (int k = 0; k < 8; ++k) { const float c = __int_as_float(__builtin_amdgcn_ds_bpermute((8 * k + g) << 2, __float_as_int(creg))); const u32x4 w = vv_[k]; \
        const f32x2 c2 = (f32x2){c, c}; _Pragma("unroll") for (int d = 0; d < 4; ++d) { ac2[2 * d] = __builtin_elementwise_fma(c2, fp8lo(w[d]), ac2[2 * d]); ac2[2 * d + 1] = __builtin_elementwise_fma(c2, fp8hi(w[d]), ac2[2 * d + 1]); } \
        _Pragma("unroll") for (int i = 0; i < 8; ++i) asm volatile("" : "+v"(ac2[i])); } } while (0)
    for (int s = s0; s < s1; ++s) {
        const GAS unsigned char* tb = V8S + (size_t)s * 16384 * 128 + ch * 16;
        int row = r + nr * wid; if (row >= M) continue;
        float c0c, c1c, c0n = 0.f, c1n = 0.f; int v0c, v1c, v0n = 0, v1n = 0;
        PO_LOADCE(row, c0c, c1c, v0c, v1c);
        u32x4 va[8], vb[8];
        PO_GATHER(va, v0c);
        for (;;) {
            const int rown = row + rstep; const bool hasn = rown < M;
            PO_GATHER(vb, v1c);
            if (hasn) PO_LOADCE(rown, c0n, c1n, v0n, v1n);
            f32x2 ac2[8];
#pragma unroll
            for (int i = 0; i < 8; ++i) ac2[i] = (f32x2){0.f, 0.f};
            PO_COMP(va, c0c);
            if (hasn) PO_GATHER(va, v0n);
            PO_COMP(vb, c1c);
            float acc[16];
#pragma unroll
            for (int i = 0; i < 8; ++i) { acc[2 * i] = ac2[i].x; acc[2 * i + 1] = ac2[i].y; }
#pragma unroll
            for (int i = 0; i < 16; ++i) acc[i] += dppf<0x128>(acc[i]);
#pragma unroll
            for (int i = 0; i < 8; ++i) { const bool hi = lane & 16; const float send = hi ? acc[i] : acc[i + 8], keep = hi ? acc[i + 8] : acc[i]; acc[i] = keep + shx(send, 16, lane); }
#pragma unroll
            for (int i = 0; i < 4; ++i) { const bool hi = lane & 32; const float send = hi ? acc[i] : acc[i + 4], keep = hi ? acc[i + 4] : acc[i]; acc[i] = keep + shx(send, 32, lane); }
            if ((lane & 8) == 0) { u32x2 w_; w_.x = pk_bf16(acc[0], acc[1]); w_.y = pk_bf16(acc[2], acc[3]); *(GAS u32x2*)(YBUF + (size_t)row * 1024 + s * 128 + ch * 16 + ((lane >> 4) & 1) * 8 + ((lane >> 5) & 1) * 4) = w_; }
            if (!hasn) break;
            row = rown; c0c = c0n; c1c = c1n; v0c = v0n; v1c = v1n;
        }
    }
#undef PO_LOADCE
#undef PO_GATHER
#undef PO_COMP
}
}

template <class T> __device__ __forceinline__ __attribute__((address_space(1))) T* gp(T* p) { return (__attribute__((address_space(1))) T*)uni_ptr(p); }
constexpr int MK_THREADS = 512, LDS_BYTES = 163840, LDSCTL_OFF = 131072, TAB_OFF = LDSCTL_OFF + 1024, MAX_OPS = 208;
static_assert(TAB_OFF + MAX_OPS * (int)sizeof(Op) <= LDS_BYTES, "LDS map");
constexpr int MPAD = 17152;
constexpr size_t CTL_BYTES = (size_t)1 << 20;
struct MArgs { const float* in[47]; float* out; char* ws; unsigned long long ws_size; };
__global__ void __launch_bounds__(MK_THREADS, 2) mega_fwd(MArgs a) {
    extern __shared__ __attribute__((aligned(16))) unsigned char lds[];
    volatile LAS unsigned* ctl = (volatile LAS unsigned*)((LAS unsigned char*)lds + LDSCTL_OFF);
    if (threadIdx.x < 64) ctl[threadIdx.x] = 0u;
    __syncthreads();
    (void)xcd_barrier_post((unsigned*)a.ws, ctl + 8);
    const Dm dm = make_dm(1024, 8, 2048, 128, 4);
    Op* tab = (Op*)(lds + TAB_OFF);
    if (threadIdx.x == 0) {
        const float* const* inp_ = (const float* const*)__builtin_amdgcn_kernarg_segment_ptr(); asm volatile("" : "+s"(inp_));
        NvIO io; io.in = inp_; io.out = a.out; io.ws = a.ws + CTL_BYTES; io.ws_size = a.ws_size - CTL_BYTES;
        int n = 0;
        #ifdef PROBE_DUPCODE
        nv_forward(io, dm, [&](const Op& o) __attribute__((always_inline)) { if (n < MAX_OPS) tab[n] = o; ++n; if ((o.code & 0xff) == PROBE_DUPCODE) { if (n < MAX_OPS) tab[n] = o; ++n; } asm volatile("" ::: "memory"); });
#else
        nv_forward(io, dm, [&](const Op& o) __attribute__((always_inline)) { if (n < MAX_OPS) tab[n] = o; ++n; asm volatile("" ::: "memory"); });
#endif
        ctl[16] = (unsigned)(n <= MAX_OPS ? n : 0);
    }
    __syncthreads();
    const int nops = (int)ctl[16];
    for (int i = 0; i < nops; ++i) {
        int tid_ = (int)threadIdx.x, bid_ = (int)blockIdx.x, nb_ = (int)gridDim.x;
        asm volatile("" : "+v"(tid_)); asm volatile("" : "+s"(bid_)); asm volatile("" : "+s"(nb_));
        const long long g0 = (long long)bid_ * MK_THREADS + tid_, gs = (long long)nb_ * MK_THREADS;
        const Op& o = tab[i];
        const int rawc = __builtin_amdgcn_readfirstlane(o.code); const int code = rawc & 0xff; const long long n = o.n;
        switch (code) {
        case OP_FGEMM: {
            const int fl = rfl(o.i6);
            pg8::Gemm g{uni_ptr((const pg8::bf16_t*)o.a), uni_ptr((const pg8::bf16_t*)o.b), MPAD, rfl(o.i5), rfl(o.i1), rfl(o.i2), rfl(o.i3)};
            if (rawc & OPF_GROUP) {
                int ng = 1; while (ng < 8 && (rfl(tab[i + ng - 1].code) & OPF_GROUP)) ++ng;
                const PG8_LAS Op* gt = (const PG8_LAS Op*)((PG8_LAS unsigned char*)lds + TAB_OFF) + i;
                pg8::GroupOrder S; S.tab = gt; S.ng = ng; S.nM = MPAD / 256; S.G = nb_; S.c = bid_; S.tsA = (size_t)256 * g.lda * 2; S.tsB = (size_t)256 * g.ldb * 2;
                pg8::EpiGroup E{gt, dm.M};
                pg8::gemm_phase<pg8::EpiGroup, pg8::GroupOrder, true, true>((PG8_LAS unsigned char*)lds, g, S, E);
                i += ng - 1;
            } else {
            pg8::StaticOrder S; S.init(g, nb_, bid_); if (fl & 2) S.acs = 512;
            float* const c0 = uni_ptr(o.o0); const int ldc0 = rfl(o.i4), nreal0 = rfl(o.i0);
            if (fl & 1) { pg8::EpiBf16Plain E{(pg8::bf16_t*)c0, ldc0}; pg8::gemm_phase<pg8::EpiBf16Plain, pg8::StaticOrder, true, true>((PG8_LAS unsigned char*)lds, g, S, E); }
            else { pg8::EpiF32 E{c0, ldc0, dm.M, nreal0}; pg8::gemm_phase<pg8::EpiF32, pg8::StaticOrder, true, true>((PG8_LAS unsigned char*)lds, g, S, E); }
            }
        } break;
        case OP_LRUG2: {
            pg8::Gemm g{uni_ptr((const pg8::bf16_t*)o.a), uni_ptr((const pg8::bf16_t*)o.b), MPAD, 1024, 512, 512, 512};
            pg8::StaticOrder S; S.init(g, nb_, bid_);
            pg8::EpiLru E{uni_ptr(o.c), uni_ptr(o.d), uni_ptr(o.e), uni_ptr(o.f), uni_ptr(o.o0), uni_ptr(o.o1), dm.M};
            pg8::gemm_phase<pg8::EpiLru, pg8::StaticOrder, true, true>((PG8_LAS unsigned char*)lds, g, S, E);
        } break;
        case OP_WKVP: fk::wkv2_phase(gp((const fk::bf16_t*)o.a), gp((const fk::bf16_t*)o.b), gp((const fk::bf16_t*)o.c), gp((const fk::bf16_t*)o.d), gp((const fk::bf16_t*)o.e), gp((const fk::bf16_t*)o.f), gp(o.g), gp(o.h), gp((const float*)o.o5), gp(o.o0), gp(o.o1), gp(o.o2), gp(o.o3), gp(o.o4), rfl(o.i0), dm.B, dm.T, dm.DB, dm.DT, (LAS unsigned char*)lds, tid_, bid_, nb_); break;
        case OP_POST2: fk::rwkvpost2_phase(gp(o.a), gp((const fk::bf16_t*)o.b), gp(o.c), gp(o.d), gp(o.e), gp(o.f), gp((fk::bf16_t*)o.o0), dm.M * 16, tid_ & 63, bid_ * 8 + (tid_ >> 6), nb_ * 8); break;
        case OP_GLAF: fk::gla_phase(gp(o.a), gp(o.b), gp(o.o0), gp(o.o1), dm.B, dm.T, (LAS unsigned char*)lds, tid_, bid_, nb_); break;
        case OP_PACTS: fk::pacts_phase(gp((const unsigned char*)o.a), gp((const unsigned char*)o.b), gp((const int*)o.d), gp((fk::bf16_t*)o.o0), dm.M, rfl(o.i0), (LAS unsigned char*)lds, rfl(tid_ >> 6), tid_ & 63, bid_, nb_); break;
        case OP_POUTS: fk::pouts_phase(gp(o.a), gp((const int*)o.b), gp((const unsigned char*)o.c), gp((fk::bf16_t*)o.o0), dm.M, tid_ >> 6, tid_ & 63, bid_, nb_); break;
        case OP_TOPK2: fk::topk_phase(gp(o.a), gp((const fk::bf16_t*)o.b), gp(o.c), gp(o.o0), gp((int*)o.o1), dm.M * 8, (LAS unsigned char*)lds, tid_ >> 6, tid_ & 63, bid_ * 8 + (tid_ >> 6), nb_ * 8); break;
        case OP_LNRES: fk::lnres_phase(gp((const fk::bf16_t*)o.a), gp(o.b), gp(o.c), gp(o.o0), gp((fk::bf16_t*)o.o1), gp((unsigned char*)o.o2), dm.M, tid_ & 63, bid_ * 8 + (tid_ >> 6), nb_ * 8); break;
        case OP_GLANORM: fk::glanorm_phase(gp(o.a), gp(o.b), gp(o.c), gp((fk::bf16_t*)o.o0), dm.M * 4, tid_ & 63, bid_ * 8 + (tid_ >> 6), nb_ * 8); break;
#define NVC(c) case c: for (long long g = g0; g < n; g += gs) nv_elem(c, o, dm, g); break;
        NVC(OP_LOGA4) NVC(OP_CONVOUT) NVC(OP_SHIFTOUT) NVC(OP_EMBED4) NVC(OP_YOUT4) NVC(OP_MIX6) NVC(OP_CONV4) NVC(OP_CVT8) NVC(OP_WGATE)
        NVC(OP_WT) NVC(OP_CVTTAB8S) NVC(OP_PRED) NVC(OP_PRM) NVC(OP_KEYS) NVC(OP_GLA3) NVC(OP_LRU1) NVC(OP_LRU2) NVC(OP_LRU3)
#undef NVC
        default: break;
        }
        if (__builtin_amdgcn_readfirstlane(tab[i].code) & OPF_NOBAR) __syncthreads(); else { XcdBarrier bar; bar.bar = (unsigned*)a.ws; bar.x = xb_xcc_id(); bar.st = ctl + 8; xcd_barrier(bar); }
    }
}
extern "C" void kernel_launch(void* const* d_in, const int* in_sizes, int n_in, void* d_out, int out_size, void* d_ws, size_t ws_size, hipStream_t stream) {
    static int grid = 0;
    if (grid == 0) {
        if (n_in != 47 || ws_size < ((size_t)900 << 20)) { fprintf(stderr, "kernel_launch: expected 47 inputs and >= 900 MiB of workspace; got %d, %zu\n", n_in, ws_size); grid = -1; return; }
        int dev = 0, cus = 0, per_cu = 0;
        if (hipGetDevice(&dev) != hipSuccess || hipDeviceGetAttribute(&cus, hipDeviceAttributeMultiprocessorCount, dev) != hipSuccess) { grid = -1; return; }
        if (hipFuncSetAttribute((const void*)mega_fwd, hipFuncAttributeMaxDynamicSharedMemorySize, LDS_BYTES) != hipSuccess) { fprintf(stderr, "kernel_launch: hipFuncSetAttribute failed\n"); grid = -1; return; }
        if (hipOccupancyMaxActiveBlocksPerMultiprocessor(&per_cu, (const void*)mega_fwd, MK_THREADS, LDS_BYTES) != hipSuccess || per_cu < 1) fprintf(stderr, "kernel_launch: occupancy query says %d per CU\n", per_cu);
        (void)hipGetLastError();
        grid = cus;
    }
    if (grid < 0) return;
    if (hipMemsetAsync(d_ws, 0, CTL_BYTES, stream) != hipSuccess) { fprintf(stderr, "kernel_launch: memset failed\n"); return; }
    MArgs a{}; for (int i = 0; i < 47; ++i) a.in[i] = (const float*)d_in[i]; a.out = (float*)d_out; a.ws = (char*)d_ws; a.ws_size = (unsigned long long)ws_size;
    hipLaunchKernelGGL(mega_fwd, dim3(grid), dim3(MK_THREADS), LDS_BYTES, stream, a);
}
```

```cpp
#include <hip/hip_runtime.h>
#include <cstdio>
#include <cmath>
#ifndef HD
#define HD __host__ __device__ __forceinline__
#endif
struct Dm { int D, B, T, DB, DT, M, NSEQ, RH; };
HD Dm make_dm(int D, int B, int SEQ, int DB, int DT) { Dm d; d.D = D; d.B = B; d.T = SEQ + 16; d.DB = DB; d.DT = DT; d.M = B * d.T + DB * DT; d.NSEQ = B + DB; d.RH = D / 64; return d; }
HD int seq_row0(const Dm& d, int s) { return s < d.B ? s * d.T : d.B * d.T + (s - d.B) * d.DT; }
HD int seq_len(const Dm& d, int s) { return s < d.B ? d.T : d.DT; }
HD void row_to_seq(const Dm& d, int row, int& s, int& t) { if (row < d.B * d.T) { s = row / d.T; t = row % d.T; } else { int r = row - d.B * d.T; s = d.B + r / d.DT; t = r % d.DT; } }

constexpr int MIXIN = 2576, C_Q = 0, C_K = 256, C_V = 512, C_GLR = 1024, C_R = 1040, C_XB = 1552, C_GB = 2064;

enum { OP_EMBED = 1, OP_GEMM, OP_LOGA, OP_GLA, OP_GLANORM, OP_CONV, OP_CONVOUT, OP_LRUG, OP_LRUSCAN, OP_LNRES, OP_MIX, OP_SHIFTOUT,
       OP_RWKVPREP, OP_WKV, OP_RWKVPOST, OP_QNORM, OP_SCORES, OP_TOPK, OP_PACT1, OP_PACT2, OP_POUT, OP_YOUT, OP_WT, OP_CVT, OP_FGEMM, OP_CVTTAB, OP_KEYS, OP_TOPK2, OP_PACT, OP_POUTLN, OP_GLA1, OP_GLA2, OP_GLA3, OP_LRU1, OP_LRU2, OP_LRU3, OP_EMBED4, OP_YOUT4, OP_MIX8, OP_CONV4, OP_CVT8, OP_WGATE, OP_LRUG2, OP_WKVF, OP_GLAF, OP_CVTTAB8, OP_CVTTAB8S, OP_PACTS, OP_PRED, OP_POUTS, OP_MIX6, OP_PRM, OP_WKVP, OP_POST2, OP_LOGA4 };

constexpr int OPF_NOBAR = 0x100, OPF_GROUP = 0x200;
struct Op {
    const float *a, *b, *c, *d, *e, *f, *g, *h;
    float *o0, *o1, *o2, *o3, *o4, *o5;
    long long n;
    int code, i0, i1, i2, i3, i4, i5, i6;
};

#if defined(__HIP_DEVICE_COMPILE__)
#define NV_UNI(x) __builtin_amdgcn_readfirstlane(x)
#define NV_LAUNDER(p) asm volatile("" : "+s"(p))
#define NV_FENCE() asm volatile("" ::: "memory")
#else
#define NV_FENCE() do {} while (0)
#define NV_UNI(x) (x)
#define NV_LAUNDER(p) do {} while (0)
#endif
typedef unsigned short nvbf;
HD nvbf nv_f2bf(float f) { unsigned u; __builtin_memcpy(&u, &f, 4); return (nvbf)((u + 0x7fffu + ((u >> 16) & 1u)) >> 16); }
HD float nv_bf2f(nvbf h) { unsigned u = (unsigned)h << 16; float f; __builtin_memcpy(&f, &u, 4); return f; }
HD unsigned nv_f2e4m3(float f) {
    unsigned u; __builtin_memcpy(&u, &f, 4); const unsigned sign = (u >> 24) & 0x80u; const float a = fabsf(f);
    if (!(a < 448.f)) return sign | 0x7Eu;
    if (a < 0.015625f) return sign | (unsigned)rintf(a * 512.f);
    unsigned au = u & 0x7fffffffu; au += 0x7ffffu + ((au >> 20) & 1u);
    const unsigned e = ((au >> 23) & 0xffu) - 120u, m = (au >> 20) & 7u; unsigned code = (e << 3) | m; if (code > 0x7Eu) code = 0x7Eu;
    return sign | code; }
HD float nv_e4m32f(unsigned c) { const unsigned e = (c >> 3) & 15u, m = c & 7u; const float v = e ? ldexpf(1.f + m * 0.125f, (int)e - 7) : m * 0.001953125f; return (c & 0x80u) ? -v : v; }
HD int nv_rup(int x, int m) { return (x + m - 1) / m * m; }
struct alignas(16) NvF4 { float x, y, z, w; };
struct alignas(16) NvU4 { unsigned x, y, z, w; };
struct alignas(8) NvU2 { unsigned x, y; };
#if defined(__HIP_DEVICE_COMPILE__)
#define NV_EXP(x) __expf(x)
#define NV_TANH(x) (1.f - 2.f * __builtin_amdgcn_rcpf(1.f + __expf(2.f * (x))))
HD float nv_sigmoid(float x) { return __builtin_amdgcn_rcpf(1.f + __expf(-x)); }
HD float nv_softplus(float x) { return fmaxf(x, 0.f) + __logf(1.f + __expf(-fabsf(x))); }
HD float nv_gelu(float x) { return x * __builtin_amdgcn_rcpf(1.f + __expf(-1.5957691216057308f * (x + 0.044715f * x * x * x))); }
#else
#define NV_EXP(x) expf(x)
#define NV_TANH(x) tanhf(x)
HD float nv_sigmoid(float x) { return 1.f / (1.f + expf(-x)); }
HD float nv_softplus(float x) { return fmaxf(x, 0.f) + log1pf(expf(-fabsf(x))); }
HD float nv_gelu(float x) { return 0.5f * x * (1.f + tanhf(0.7978845608028654f * (x + 0.044715f * x * x * x))); }
#endif

#define NV_INS16(tv, ti, val, idx) do { float _v = (val); int _i = (idx); _Pragma("unroll") for (int _j = 0; _j < 16; ++_j) { if (_v > tv[_j]) { float _tv = tv[_j]; int _ti = ti[_j]; tv[_j] = _v; ti[_j] = _i; _v = _tv; _i = _ti; } } } while (0)

HD void nv_elem(const int code, const Op& p, const Dm& dm, long long gid) {
    const int D = dm.D; float* const PO1 = p.o1; float* const PO2 = p.o2;
    switch (code) {
    case OP_EMBED: {
        int row = (int)(gid / D), c = (int)(gid % D); float v;
        if (row < dm.B * dm.T) { int bb = row / dm.T, t = row % dm.T; v = t < 16 ? p.c[t * D + c] : p.a[((size_t)bb * (dm.T - 16) + (t - 16)) * D + c]; }
        else v = p.b[(size_t)(row - dm.B * dm.T) * D + c];
        p.o0[gid] = v; ((nvbf*)p.o1)[gid] = nv_f2bf(v); } break;
    case OP_GEMM: {
        int N4 = p.i0 >> 2, K = p.i1; int m = (int)(gid / N4), nn = (int)(gid % N4) * 4; const float* A = p.a + (size_t)m * p.i2; const float* Bw = p.b + nn; float c0 = 0.f, c1 = 0.f, c2 = 0.f, c3 = 0.f;
        for (int k = 0; k < K; ++k) { float av = A[k]; if (p.i5 == 1) av = NV_TANH(av); else if (p.i5 == 2) av = nv_sigmoid(av); const NvF4 bv = *(const NvF4*)(Bw + (size_t)k * p.i3);
            c0 = fmaf(av, bv.x, c0); c1 = fmaf(av, bv.y, c1); c2 = fmaf(av, bv.z, c2); c3 = fmaf(av, bv.w, c3); }
        float* C = p.o0 + (size_t)m * p.i4 + nn; C[0] = c0; C[1] = c1; C[2] = c2; C[3] = c3; } break;
    case OP_LOGA: {
        int row = (int)(gid / 256), c = (int)(gid % 256); float z = p.c[c];
        for (int r = 0; r < 16; ++r) z = fmaf(p.a[(size_t)row * MIXIN + C_GLR + r], p.b[r * 256 + c], z);
        p.o0[gid] = NV_EXP(-nv_softplus(-z) * (1.f / 16.f)); } break;
    case OP_GLAF:
    case OP_GLA: {
        int s = (int)(gid / 512), h = (int)((gid / 128) % 4), col = (int)(gid % 128);
        float S[64];
        const float* sin = (s < dm.B) ? nullptr : p.c + (((size_t)(s - dm.B) * 4 + h) * 64) * 128 + col;
#pragma unroll
        for (int k = 0; k < 64; ++k) S[k] = sin ? sin[(size_t)k * 128] : 0.f;
        int r0 = seq_row0(dm, s), L = seq_len(dm, s);
        for (int t = 0; t < L; ++t) {
            const float* pr = p.a + (size_t)(r0 + t) * MIXIN; const float* la = p.b + (size_t)(r0 + t) * 256 + h * 64;
            float v = pr[C_V + h * 128 + col], o = 0.f;
#pragma unroll
            for (int k = 0; k < 64; ++k) { if ((k & 7) == 0) NV_FENCE(); S[k] = fmaf(la[k], S[k], pr[C_K + h * 64 + k] * v); o = fmaf(pr[C_Q + h * 64 + k] * 0.125f, S[k], o); }
            p.o0[(size_t)(r0 + t) * 512 + h * 128 + col] = o;
        }
        float* so = (s < dm.B) ? PO1 + (((size_t)s * 4 + h) * 64) * 128 + col : PO2 + (((size_t)(s - dm.B) * 4 + h) * 64) * 128 + col;
#pragma unroll
        for (int k = 0; k < 64; ++k) so[(size_t)k * 128] = S[k]; } break;
    case OP_GLA1: {
        const int NC = p.i0; const int u = NV_UNI((int)(gid / 128)), col = (int)(gid % 128); const int s = u / (4 * NC), h = (u / NC) % 4, c = u % NC;
        const int r0 = seq_row0(dm, s) + c * 64; int L = dm.T - c * 64; L = L > 64 ? 64 : L;
        float S[64];
#pragma unroll
        for (int k = 0; k < 64; ++k) S[k] = 0.f;
        float dprod = 1.f;
        for (int t = 0; t < L; ++t) {
            const float* pr = p.a + (size_t)(r0 + t) * MIXIN; const float* la = p.b + (size_t)(r0 + t) * 256 + h * 64; const float v = pr[C_V + h * 128 + col];
            if (col < 64) dprod *= la[col];
#pragma unroll
            for (int k = 0; k < 64; ++k) { if ((k & 7) == 0) NV_FENCE(); S[k] = fmaf(la[k], S[k], pr[C_K + h * 64 + k] * v); }
        }
        float* so = p.o0 + (size_t)u * 8192 + col;
#pragma unroll
        for (int k = 0; k < 64; ++k) so[(size_t)k * 128] = S[k];
        if (col < 64) p.o1[(size_t)u * 64 + col] = dprod; } break;
    case OP_GLA2: {
        const int NC = p.i0; const int pair = (int)(gid / 8192), e = (int)(gid % 8192), dk = e / 128; float S = 0.f;
        for (int c = 0; c < NC; ++c) { const size_t ix = ((size_t)pair * NC + c) * 8192 + e; const float l = p.o0[ix]; p.o0[ix] = S; S = fmaf(p.a[((size_t)pair * NC + c) * 64 + dk], S, l); }
        p.o1[gid] = S; } break;
    case OP_GLA3: {
        const int NC = p.i0; const int NP = dm.B * 4 * NC; const int u = NV_UNI((int)(gid / 128)) + (p.i1 ? NP : 0), col = (int)(gid % 128); int s, h, r0, L; const float* sin; float* sout = nullptr;
        if (u < NP) { s = u / (4 * NC); h = (u / NC) % 4; const int c = u % NC; r0 = seq_row0(dm, s) + c * 64; L = dm.T - c * 64; L = L > 64 ? 64 : L; sin = p.d + (size_t)u * 8192 + col; }
        else { const int q = u - NP; s = dm.B + q / 4; h = q % 4; r0 = seq_row0(dm, s); L = dm.DT; sin = p.c + (((size_t)(s - dm.B) * 4 + h) * 64) * 128 + col; sout = p.o2 + (((size_t)(s - dm.B) * 4 + h) * 64) * 128 + col; }
        float S[64];
#pragma unroll
        for (int k = 0; k < 64; ++k) S[k] = sin[(size_t)k * 128];
        for (int t = 0; t < L; ++t) {
            const float* pr = p.a + (size_t)(r0 + t) * MIXIN; const float* la = p.b + (size_t)(r0 + t) * 256 + h * 64; const float v = pr[C_V + h * 128 + col]; float o = 0.f;
#pragma unroll
            for (int k = 0; k < 64; ++k) { if ((k & 7) == 0) NV_FENCE(); S[k] = fmaf(la[k], S[k], pr[C_K + h * 64 + k] * v); o = fmaf(pr[C_Q + h * 64 + k] * 0.125f, S[k], o); }
            p.o0[(size_t)(r0 + t) * 512 + h * 128 + col] = o;
        }
        if (sout) {
#pragma unroll
            for (int k = 0; k < 64; ++k) sout[(size_t)k * 128] = S[k]; } } break;
    case OP_LRU1: {
        const int NC = p.i0; const int u = (int)(gid / 512), c = (int)(gid % 512); const int s = u / NC, ch = u % NC; const int r0 = seq_row0(dm, s) + ch * 64; int L = dm.T - ch * 64; L = L > 64 ? 64 : L; float hh = 0.f, ap = 1.f;
#pragma unroll 16
        for (int t = 0; t < L; ++t) { const size_t ix = (size_t)(r0 + t) * 512 + c; const float a = p.a[ix]; hh = fmaf(a, hh, p.b[ix]); ap *= a; }
        p.o0[gid] = ap; p.o1[gid] = hh; } break;
    case OP_LRU2: {
        const int NC = p.i0; const int s = (int)(gid / 512), c = (int)(gid % 512); float hh = 0.f;
#pragma unroll 8
        for (int ch = 0; ch < NC; ++ch) { const size_t ix = ((size_t)s * NC + ch) * 512 + c; const float l = p.o0[ix]; p.o0[ix] = hh; hh = fmaf(p.a[ix], hh, l); }
        p.o1[gid] = hh; } break;
    case OP_LRU3: {
        const int NC = p.i0; const int u = (int)(gid / 512), c = (int)(gid % 512); const int NP = dm.B * NC; int r0, L; float hh; float* hout = nullptr;
        if (u < NP) { const int s = u / NC, ch = u % NC; r0 = seq_row0(dm, s) + ch * 64; L = dm.T - ch * 64; L = L > 64 ? 64 : L; hh = p.e[gid]; }
        else { const int q = u - NP; r0 = seq_row0(dm, dm.B + q); L = dm.DT; hh = p.d[(size_t)q * 512 + c]; hout = p.o2 + (size_t)q * 512 + c; }
        for (int t0 = 0; t0 < L; t0 += 16) {
            float av[16], bv[16], gv[16];
#pragma unroll
            for (int k = 0; k < 16; ++k) { int t = t0 + k; t = t < L ? t : L - 1; const size_t r = (size_t)(r0 + t); av[k] = p.a[r * 512 + c]; bv[k] = p.b[r * 512 + c]; gv[k] = p.c[r * MIXIN + C_GB + c]; }
#pragma unroll
            for (int k = 0; k < 16; ++k) if (t0 + k < L) { const size_t r = (size_t)(r0 + t0 + k); hh = fmaf(av[k], hh, bv[k]); ((nvbf*)p.o0)[r * 1024 + 512 + c] = nv_f2bf(hh * nv_gelu(gv[k])); } }
        if (hout) *hout = hh; } break;
    case OP_EMBED4: {
        const int D4 = D / 4; const int row = (int)(gid / D4), c = (int)(gid % D4) * 4; const float* src;
        if (row < dm.B * dm.T) { const int bb = row / dm.T, t = row % dm.T; src = t < 16 ? p.c + (size_t)t * D + c : p.a + ((size_t)bb * (dm.T - 16) + (t - 16)) * D + c; } else src = p.b + (size_t)(row - dm.B * dm.T) * D + c;
        const NvF4 v = *(const NvF4*)src; NvU2 w; w.x = nv_f2bf(v.x) | ((unsigned)nv_f2bf(v.y) << 16); w.y = nv_f2bf(v.z) | ((unsigned)nv_f2bf(v.w) << 16); *(NvU2*)((nvbf*)p.o1 + (size_t)row * D + c) = w; } break;
    case OP_YOUT4: {
        const int D4 = D / 4; const int row = (int)(gid / D4), c = (int)(gid % D4) * 4; const NvU2 w_ = *(const NvU2*)((const nvbf*)p.a + (size_t)row * D + c); NvF4 v; v.x = nv_bf2f((nvbf)(w_.x & 0xffffu)); v.y = nv_bf2f((nvbf)(w_.x >> 16)); v.z = nv_bf2f((nvbf)(w_.y & 0xffffu)); v.w = nv_bf2f((nvbf)(w_.y >> 16));
        if (row < dm.B * dm.T) { const int bb = row / dm.T, t = row % dm.T; if (t >= 16) *(NvF4*)(p.o0 + ((size_t)bb * (dm.T - 16) + (t - 16)) * D + c) = v; }
        else *(NvF4*)(p.o0 + ((size_t)dm.B * (dm.T - 16) + (row - dm.B * dm.T)) * D + c) = v; } break;
    case OP_MIX8: {
        const int D8 = D / 8; const int row = (int)(gid / D8), c = (int)(gid % D8) * 8; int s, t; row_to_seq(dm, row, s, t); const float* x = p.a + (size_t)row * D + c; float xp[8];
        if (t > 0) { for (int i = 0; i < 8; ++i) xp[i] = x[i - D]; } else if (s < dm.B) { for (int i = 0; i < 8; ++i) xp[i] = 0.f; } else { for (int i = 0; i < 8; ++i) xp[i] = p.b[(size_t)(s - dm.B) * D + c + i]; }
        unsigned w[4];
#pragma unroll
        for (int i = 0; i < 4; ++i) { const float lo = x[2 * i] + (xp[2 * i] - x[2 * i]) * p.c[c + 2 * i], hi = x[2 * i + 1] + (xp[2 * i + 1] - x[2 * i + 1]) * p.c[c + 2 * i + 1]; w[i] = nv_f2bf(lo) | ((unsigned)nv_f2bf(hi) << 16); }
        NvU4 o; o.x = w[0]; o.y = w[1]; o.z = w[2]; o.w = w[3]; *(NvU4*)((nvbf*)p.o0 + (size_t)row * D + c) = o; } break;
    case OP_MIX6: {
        const int D8 = D / 8, Q = (dm.M + 3) / 4; const int row0 = (int)(gid / D8), c = (int)(gid % D8) * 8; NvU4 xw[4], pw[4]; NvF4 sh0[4], sh1[4]; int kind[4];
#pragma unroll
        for (int q = 0; q < 4; ++q) { int row = row0 + q * Q; row = row < dm.M ? row : row0; int s, t; row_to_seq(dm, row, s, t); const nvbf* x = (const nvbf*)p.a + (size_t)row * D + c;
            kind[q] = t > 0 ? 0 : (s < dm.B ? 1 : 2); xw[q] = *(const NvU4*)x; pw[q] = *(const NvU4*)(x - (t > 0 ? D : 0));
            const float* sp = p.b + (size_t)(s >= dm.B ? s - dm.B : 0) * D + c; sh0[q] = *(const NvF4*)sp; sh1[q] = *(const NvF4*)(sp + 4); }
        NvF4 mu0[6], mu1[6];
#pragma unroll
        for (int m = 0; m < 6; ++m) { mu0[m] = *(const NvF4*)(p.c + (size_t)m * D + c); mu1[m] = *(const NvF4*)(p.c + (size_t)m * D + c + 4); }
#pragma unroll
        for (int q = 0; q < 4; ++q) { const int row = row0 + q * Q; if (row < dm.M) { float xv[8], dx[8]; const unsigned xs[4] = {xw[q].x, xw[q].y, xw[q].z, xw[q].w}, ps[4] = {pw[q].x, pw[q].y, pw[q].z, pw[q].w};
            const float shv[8] = {sh0[q].x, sh0[q].y, sh0[q].z, sh0[q].w, sh1[q].x, sh1[q].y, sh1[q].z, sh1[q].w};
#pragma unroll
            for (int i = 0; i < 4; ++i) { xv[2 * i] = nv_bf2f((nvbf)(xs[i] & 0xffffu)); xv[2 * i + 1] = nv_bf2f((nvbf)(xs[i] >> 16)); const float p0 = nv_bf2f((nvbf)(ps[i] & 0xffffu)), p1 = nv_bf2f((nvbf)(ps[i] >> 16));
                const float q0 = kind[q] == 0 ? p0 : (kind[q] == 1 ? 0.f : shv[2 * i]), q1 = kind[q] == 0 ? p1 : (kind[q] == 1 ? 0.f : shv[2 * i + 1]); dx[2 * i] = q0 - xv[2 * i]; dx[2 * i + 1] = q1 - xv[2 * i + 1]; }
#pragma unroll
            for (int m = 0; m < 6; ++m) { const float mv[8] = {mu0[m].x, mu0[m].y, mu0[m].z, mu0[m].w, mu1[m].x, mu1[m].y, mu1[m].z, mu1[m].w}; unsigned w[4];
#pragma unroll
                for (int i = 0; i < 4; ++i) w[i] = nv_f2bf(xv[2 * i] + dx[2 * i] * mv[2 * i]) | ((unsigned)nv_f2bf(xv[2 * i + 1] + dx[2 * i + 1] * mv[2 * i + 1]) << 16);
                NvU4 o; o.x = w[0]; o.y = w[1]; o.z = w[2]; o.w = w[3]; *(NvU4*)((nvbf*)p.o0 + (size_t)m * (size_t)p.i1 * 1024 + (size_t)row * D + c) = o; } } } } break;
    case OP_CONV4: {
        const int Q = (dm.M + 3) / 4; const int row0 = (int)(gid / 128), c = (int)(gid % 128) * 4; const NvF4 bias = *(const NvF4*)(p.d + c); NvF4 wt[4]; for (int i = 0; i < 4; ++i) wt[i] = *(const NvF4*)(p.c + i * 512 + c);
        NvF4 xv[4][4]; int ok[4];
#pragma unroll
        for (int q = 0; q < 4; ++q) { int row = row0 + q * Q; ok[q] = row < dm.M; row = ok[q] ? row : row0; int s, t; row_to_seq(dm, row, s, t);
#pragma unroll
            for (int i = 0; i < 4; ++i) { const int j = t + i; const int sb = s >= dm.B ? s - dm.B : 0, jb = j < 3 ? j : 0;
                const float* src = j >= 3 ? p.a + (size_t)(row - t + (j - 3)) * MIXIN + C_XB + c : p.b + ((size_t)sb * 3 + jb) * 512 + c; const float msk = (j >= 3 || s >= dm.B) ? 1.f : 0.f;
                const NvF4 v = *(const NvF4*)src; xv[q][i].x = v.x * msk; xv[q][i].y = v.y * msk; xv[q][i].z = v.z * msk; xv[q][i].w = v.w * msk; } }
#pragma unroll
        for (int q = 0; q < 4; ++q) if (ok[q]) { const int row = row0 + q * Q; NvF4 o = bias;
#pragma unroll
            for (int i = 0; i < 4; ++i) { o.x = fmaf(xv[q][i].x, wt[i].x, o.x); o.y = fmaf(xv[q][i].y, wt[i].y, o.y); o.z = fmaf(xv[q][i].z, wt[i].z, o.z); o.w = fmaf(xv[q][i].w, wt[i].w, o.w); }
            *(NvF4*)(p.o0 + (size_t)row * 512 + c) = o; NvU2 w; w.x = nv_f2bf(o.x) | ((unsigned)nv_f2bf(o.y) << 16); w.y = nv_f2bf(o.z) | ((unsigned)nv_f2bf(o.w) << 16); *(NvU2*)((nvbf*)p.o1 + (size_t)row * 512 + c) = w; } } break;
    case OP_CVT8: {
        const int K8 = p.i2 / 8; const int row = (int)(gid / K8), k = (int)(gid % K8) * 8; unsigned w[4] = {0u, 0u, 0u, 0u};
        if (row < dm.M && k < p.i0) { const float* sp = p.a + (size_t)row * p.i1 + k;
#pragma unroll
            for (int i = 0; i < 4; ++i) { float lo = sp[2 * i], hi = sp[2 * i + 1]; if (p.i3 == 1) { lo = NV_TANH(lo); hi = NV_TANH(hi); } else if (p.i3 == 2) { lo = nv_sigmoid(lo); hi = nv_sigmoid(hi); } w[i] = nv_f2bf(lo) | ((unsigned)nv_f2bf(hi) << 16); } }
        NvU4 o; o.x = w[0]; o.y = w[1]; o.z = w[2]; o.w = w[3]; *(NvU4*)((nvbf*)p.o0 + (size_t)row * p.i2 + k) = o; } break;
    case OP_WGATE: {
        const int n = (int)gid, pn = n >> 8, within = n & 127, isx = (n >> 7) & 1, c = pn * 128 + within, nb = c >> 6, e = c & 63; const float* w = isx ? p.b : p.a; nvbf* dst = (nvbf*)p.o0 + (size_t)n * 512;
        for (int k = 0; k < 512; ++k) dst[k] = ((k >> 6) == nb) ? nv_f2bf(w[((size_t)nb * 64 + (k & 63)) * 64 + e]) : (nvbf)0;
        if (n < 512) p.o1[n] = -8.f * nv_softplus(-p.c[n]); } break;
    case OP_LRUG2: {
        const int row = (int)(gid / 512), c = (int)(gid % 512), pn = c >> 7, within = c & 127; const nvbf* x = (const nvbf*)p.a + (size_t)row * 512; const nvbf* wa_ = (const nvbf*)p.b + (size_t)(pn * 256 + within) * 512; const nvbf* wx_ = wa_ + (size_t)128 * 512; float ga = 0.f, gx = 0.f;
        for (int k = 0; k < 512; ++k) { const float xv = nv_bf2f(x[k]); ga = fmaf(xv, nv_bf2f(wa_[k]), ga); gx = fmaf(xv, nv_bf2f(wx_[k]), gx); }
        const float gate_a = nv_sigmoid(ga + p.c[c]), gate_x = nv_sigmoid(gx + p.d[c]); const float log_at = gate_a * p.e[c];
        p.o0[gid] = NV_EXP(log_at); p.o1[gid] = sqrtf(-expm1f(2.f * log_at)) * (gate_x * p.f[gid]); } break;
    case OP_LOGA4: {
        const int row = (int)(gid / 64), c = (int)(gid % 64) * 4; const float* gl = p.a + (size_t)row * MIXIN + C_GLR; NvF4 z = *(const NvF4*)(p.c + c);
#pragma unroll
        for (int r4 = 0; r4 < 4; ++r4) { const NvF4 g = *(const NvF4*)(gl + 4 * r4);
            const NvF4 w0 = *(const NvF4*)(p.b + (4 * r4 + 0) * 256 + c), w1 = *(const NvF4*)(p.b + (4 * r4 + 1) * 256 + c), w2 = *(const NvF4*)(p.b + (4 * r4 + 2) * 256 + c), w3 = *(const NvF4*)(p.b + (4 * r4 + 3) * 256 + c);
            z.x = fmaf(g.x, w0.x, z.x); z.y = fmaf(g.x, w0.y, z.y); z.z = fmaf(g.x, w0.z, z.z); z.w = fmaf(g.x, w0.w, z.w); z.x = fmaf(g.y, w1.x, z.x); z.y = fmaf(g.y, w1.y, z.y); z.z = fmaf(g.y, w1.z, z.z); z.w = fmaf(g.y, w1.w, z.w);
            z.x = fmaf(g.z, w2.x, z.x); z.y = fmaf(g.z, w2.y, z.y); z.z = fmaf(g.z, w2.z, z.z); z.w = fmaf(g.z, w2.w, z.w); z.x = fmaf(g.w, w3.x, z.x); z.y = fmaf(g.w, w3.y, z.y); z.z = fmaf(g.w, w3.z, z.z); z.w = fmaf(g.w, w3.w, z.w); }
        NvF4 o; o.x = NV_EXP(-nv_softplus(-z.x) * (1.f / 16.f)); o.y = NV_EXP(-nv_softplus(-z.y) * (1.f / 16.f)); o.z = NV_EXP(-nv_softplus(-z.z) * (1.f / 16.f)); o.w = NV_EXP(-nv_softplus(-z.w) * (1.f / 16.f));
        *(NvF4*)(p.o0 + (size_t)row * 256 + c) = o; } break;
    case OP_GLANORM: {
        int row = (int)(gid / 4), h = (int)(gid % 4); const float* o = p.a + (size_t)row * 512 + h * 128; float ss = 0.f;
        for (int c = 0; c < 128; ++c) ss = fmaf(o[c], o[c], ss);
        float rs = 1.f / sqrtf(ss * (1.f / 128.f) + 1e-5f);
        for (int c = 0; c < 128; ++c) { float r = p.b[(size_t)row * MIXIN + C_R + h * 128 + c]; ((nvbf*)p.o0)[(size_t)row * 1024 + h * 128 + c] = nv_f2bf(o[c] * rs * p.c[c] * (r * nv_sigmoid(r))); } } break;
    case OP_CONV: {
        int row = (int)(gid / 512), c = (int)(gid % 512); int s, t; row_to_seq(dm, row, s, t); float acc = p.d[c];
        for (int i = 0; i < 4; ++i) { int j = t + i; float xv;
            if (j < 3) xv = (s < dm.B) ? 0.f : p.b[((size_t)(s - dm.B) * 3 + j) * 512 + c]; else xv = p.a[(size_t)(row - t + (j - 3)) * MIXIN + C_XB + c];
            acc = fmaf(xv, p.c[i * 512 + c], acc); }
        p.o0[gid] = acc; } break;
    case OP_CONVOUT: {
        int s = (int)(gid / 1536), i = (int)((gid / 512) % 3), c = (int)(gid % 512); int L = seq_len(dm, s), r0 = seq_row0(dm, s); int j = L + i; float xv;
        if (j < 3) xv = (s < dm.B) ? 0.f : p.b[((size_t)(s - dm.B) * 3 + j) * 512 + c]; else xv = p.a[(size_t)(r0 + j - 3) * MIXIN + C_XB + c];
        float* o = (s < dm.B) ? PO1 + ((size_t)s * 3 + i) * 512 + c : PO2 + ((size_t)(s - dm.B) * 3 + i) * 512 + c; *o = xv; } break;
    case OP_LRUG: {
        int row = (int)(gid / 512), c = (int)(gid % 512), nb = c / 64, e = c % 64; const float* x = p.a + (size_t)row * 512 + nb * 64; float ga = p.c[c], gx = p.e[c];
        for (int dd = 0; dd < 64; ++dd) { ga = fmaf(x[dd], p.b[((size_t)nb * 64 + dd) * 64 + e], ga); gx = fmaf(x[dd], p.d[((size_t)nb * 64 + dd) * 64 + e], gx); }
        float gate_a = nv_sigmoid(ga), gate_x = nv_sigmoid(gx); float log_at = -8.f * gate_a * nv_softplus(-p.f[c]);
        p.o0[gid] = NV_EXP(log_at); p.o1[gid] = sqrtf(-expm1f(2.f * log_at)) * (gate_x * p.a[(size_t)row * 512 + c]); } break;
    case OP_LRUSCAN: {
        int s = (int)(gid / 512), c = (int)(gid % 512); int r0 = seq_row0(dm, s), L = seq_len(dm, s); float hh = (s < dm.B) ? 0.f : p.d[(size_t)(s - dm.B) * 512 + c];
        for (int t = 0; t < L; ++t) { size_t r = (size_t)(r0 + t); hh = fmaf(p.a[r * 512 + c], hh, p.b[r * 512 + c]); p.o0[r * 1024 + 512 + c] = hh * nv_gelu(p.c[r * MIXIN + C_GB + c]); }
        float* o = (s < dm.B) ? PO1 + (size_t)s * 512 + c : PO2 + (size_t)(s - dm.B) * 512 + c; *o = hh; } break;
    case OP_LNRES: {
        const float alpha = 1.6817928305074292f; nvbf* x = (nvbf*)p.o1 + (size_t)gid * D; const nvbf* y = (const nvbf*)p.a + (size_t)gid * D; float mu = 0.f;
        for (int c = 0; c < D; ++c) mu += alpha * nv_bf2f(x[c]) + nv_bf2f(y[c]);
        mu /= D; float var = 0.f;
        for (int c = 0; c < D; ++c) { float v = alpha * nv_bf2f(x[c]) + nv_bf2f(y[c]) - mu; var = fmaf(v, v, var); }
        float rs = 1.f / sqrtf(var / D + 1e-5f);
        for (int c = 0; c < D; ++c) { const float o = (alpha * nv_bf2f(x[c]) + nv_bf2f(y[c]) - mu) * rs * p.b[c] + p.c[c]; x[c] = nv_f2bf(o);
            if (p.o2) { unsigned char* f8 = (unsigned char*)p.o2 + (size_t)gid * 2 * D; const float xs = fminf(fmaxf(o * 16.f, -448.f), 448.f); const unsigned hc = nv_f2e4m3(xs); f8[c] = (unsigned char)hc; f8[D + c] = (unsigned char)nv_f2e4m3(xs - nv_e4m32f(hc)); } } } break;
    case OP_MIX: {
        int row = (int)(gid / D), c = (int)(gid % D); int s, t; row_to_seq(dm, row, s, t); float x = p.a[gid];
        float xp = t > 0 ? p.a[gid - D] : ((s < dm.B) ? 0.f : p.b[(size_t)(s - dm.B) * D + c]);
        ((nvbf*)p.o0)[gid] = nv_f2bf(x + (xp - x) * p.c[c]); } break;
    case OP_SHIFTOUT: {
        int s = (int)(gid / D), c = (int)(gid % D); float v = nv_bf2f(((const nvbf*)p.a)[(size_t)(seq_row0(dm, s) + seq_len(dm, s) - 1) * D + c]);
        float* o = (s < dm.B) ? PO1 + (size_t)s * D + c : PO2 + (size_t)(s - dm.B) * D + c; *o = v; } break;
    case OP_RWKVPREP: {
        int row = (int)(gid / dm.RH), h = (int)(gid % dm.RH); size_t base = (size_t)row * D + h * 64; float ss = 0.f;
        for (int k = 0; k < 64; ++k) { float kv = p.o0[base + k] * p.d[h * 64 + k]; ss = fmaf(kv, kv, ss); }
        float inv = 1.f / fmaxf(sqrtf(ss), 1e-12f);
        for (int k = 0; k < 64; ++k) { int c = h * 64 + k; size_t ix = base + k;
            float w = -nv_softplus(-(p.a[c] + p.o1[ix])) - 0.5f; float dec = NV_EXP(-NV_EXP(w));
            float a = nv_sigmoid(p.b[c] + p.o2[ix]);
            float v = p.o3[ix]; if (p.i0) v = v + (p.o5[ix] - v) * nv_sigmoid(p.c[c] + p.f[ix]); else p.o5[ix] = v;
            float k0 = p.o0[ix]; const float kk = k0 * p.d[c] * inv; p.o4[ix] = -kk; p.o0[ix] = k0 * (1.f + (a - 1.f) * p.e[c]); p.o1[ix] = dec; p.o2[ix] = kk * a; p.o3[ix] = v; } } break;
    case OP_WKVF:
    case OP_WKV: {
        int RH = dm.RH; int s = p.i0 + (int)(gid / (RH * 64)), h = (int)((gid / 64) % RH), vr = (int)(gid % 64); float S[64];
        const float* sin = (s < dm.B) ? nullptr : p.g + (((size_t)(s - dm.B) * RH + h) * 64 + vr) * 64;
#pragma unroll
        for (int k = 0; k < 64; ++k) S[k] = sin ? sin[k] : 0.f;
        int r0 = seq_row0(dm, s), L = seq_len(dm, s);
        for (int t = 0; t < L; ++t) { size_t base = (size_t)(r0 + t) * D + h * 64; float sa = 0.f;
#pragma unroll
            for (int k = 0; k < 64; ++k) { if ((k & 7) == 0) NV_FENCE(); sa = fmaf(S[k], p.f[base + k], sa); }
            float vv = p.d[base + vr], y = 0.f;
#pragma unroll
            for (int k = 0; k < 64; ++k) { if ((k & 7) == 0) NV_FENCE(); S[k] = fmaf(S[k], p.b[base + k], fmaf(sa, p.e[base + k], vv * p.c[base + k])); y = fmaf(S[k], p.a[base + k], y); }
            p.o0[base + vr] = y; }
        float* so = (s < dm.B) ? PO1 + (((size_t)s * RH + h) * 64 + vr) * 64 : PO2 + (((size_t)(s - dm.B) * RH + h) * 64 + vr) * 64;
#pragma unroll
        for (int k = 0; k < 64; ++k) so[k] = S[k]; } break;
    case OP_RWKVPOST: {
        int row = (int)(gid / dm.RH), h = (int)(gid % dm.RH); size_t base = (size_t)row * D + h * 64; float mu = 0.f, bon = 0.f;
        for (int k = 0; k < 64; ++k) { mu += p.a[base + k]; bon = fmaf(p.b[base + k] * p.c[base + k], p.f[h * 64 + k], bon); }
        mu *= (1.f / 64.f); float var = 0.f;
        for (int k = 0; k < 64; ++k) { float dlt = p.a[base + k] - mu; var = fmaf(dlt, dlt, var); }
        float rs = 1.f / sqrtf(var * (1.f / 64.f) + 64e-5f);
        for (int k = 0; k < 64; ++k) { int c = h * 64 + k; float y = (p.a[base + k] - mu) * rs * p.g[c] + p.h[c] + bon * p.d[base + k]; ((nvbf*)p.o0)[base + k] = nv_f2bf(y * p.e[base + k]); } } break;
    case OP_PRM: {
        const int m = (int)(gid / D), c = (int)(gid % D); const float* src = m == 0 ? p.a : m == 1 ? p.b : m == 2 ? p.c : m == 3 ? p.d : m == 4 ? p.e : p.f; p.o0[gid] = src ? src[c] : 0.f; } break;
    case OP_WKVP: {
        const int RH = dm.RH; const int s = (int)(gid / (RH * 64)), h = (int)((gid / 64) % RH), vr = (int)(gid % 64); float S[64];
        const float* sin = (s < dm.B) ? nullptr : p.o5 + (((size_t)(s - dm.B) * RH + h) * 64 + vr) * 64;
        for (int k = 0; k < 64; ++k) S[k] = sin ? sin[k] : 0.f;
        const float* w0 = p.h + h * 64; const float* a0 = p.h + D + h * 64; const float* v0 = p.h + 2 * D + h * 64; const float* k_k = p.h + 3 * D + h * 64; const float* k_a = p.h + 4 * D + h * 64; const float* r_k = p.h + 5 * D + h * 64;
        const int r0 = seq_row0(dm, s), L = seq_len(dm, s); const nvbf* bR = (const nvbf*)p.a; const nvbf* bK = (const nvbf*)p.b; const nvbf* bWL = (const nvbf*)p.c; const nvbf* bAL = (const nvbf*)p.d; const nvbf* bV = (const nvbf*)p.e; const nvbf* bVG = (const nvbf*)p.f;
        for (int t = 0; t < L; ++t) { const size_t base = (size_t)(r0 + t) * D + h * 64; float ss = 0.f;
            for (int k = 0; k < 64; ++k) { const float kv = nv_bf2f(bK[base + k]) * k_k[k]; ss = fmaf(kv, kv, ss); }
            const float inv = 1.f / fmaxf(sqrtf(ss), 1e-12f);
            float vv = nv_bf2f(bV[base + vr]); if (p.i0) vv = vv + (p.g[base + vr] - vv) * nv_sigmoid(v0[vr] + nv_bf2f(bVG[base + vr]));
            float sa = 0.f, bon = 0.f, dec[64], bb[64], k2[64];
            for (int k = 0; k < 64; ++k) { const float k0 = nv_bf2f(bK[base + k]); const float kk = k0 * k_k[k] * inv; const float a = nv_sigmoid(a0[k] + nv_bf2f(bAL[base + k]));
                dec[k] = NV_EXP(-0.6065306597126334f * nv_sigmoid(w0[k] + nv_bf2f(bWL[base + k])));
                bb[k] = kk * a; k2[k] = k0 * (1.f + (a - 1.f) * k_a[k]); sa = fmaf(S[k], -kk, sa); bon = fmaf(nv_bf2f(bR[base + k]) * k2[k], r_k[k], bon); }
            float y = 0.f;
            for (int k = 0; k < 64; ++k) { S[k] = fmaf(S[k], dec[k], fmaf(sa, bb[k], vv * k2[k])); y = fmaf(S[k], nv_bf2f(bR[base + k]), y); }
            p.o0[base + vr] = y; p.o3[base + vr] = vv; if (vr == 0) p.o4[(size_t)(r0 + t) * RH + h] = bon; }
        float* so = (s < dm.B) ? PO1 + (((size_t)s * RH + h) * 64 + vr) * 64 : PO2 + (((size_t)(s - dm.B) * RH + h) * 64 + vr) * 64;
        for (int k = 0; k < 64; ++k) so[k] = S[k]; } break;
    case OP_POST2: {
        const int row = (int)(gid / dm.RH), h = (int)(gid % dm.RH); const size_t base = (size_t)row * D + h * 64; float mu = 0.f;
        for (int k = 0; k < 64; ++k) mu += p.a[base + k];
        mu *= (1.f / 64.f); float var = 0.f;
        for (int k = 0; k < 64; ++k) { const float dlt = p.a[base + k] - mu; var = fmaf(dlt, dlt, var); }
        const float rs = 1.f / sqrtf(var * (1.f / 64.f) + 64e-5f), bon = p.d[gid];
        for (int k = 0; k < 64; ++k) { const int c = h * 64 + k; const float y = (p.a[base + k] - mu) * rs * p.e[c] + p.f[c] + bon * p.c[base + k]; ((nvbf*)p.o0)[base + k] = nv_f2bf(y * nv_bf2f(((const nvbf*)p.b)[base + k])); } } break;
    case OP_QNORM: {
        float* q = p.o0 + (size_t)gid * 256; float mu = 0.f;
        for (int c = 0; c < 256; ++c) mu += q[c];
        mu *= (1.f / 256.f); float var = 0.f;
        for (int c = 0; c < 256; ++c) { float dlt = q[c] - mu; var = fmaf(dlt, dlt, var); }
        float rs = 1.f / sqrtf(var * (1.f / 256.f) + 1e-5f);
        for (int c = 0; c < 256; ++c) q[c] = (q[c] - mu) * rs; } break;
    case OP_SCORES: {
        int row = (int)(gid / 2048), r = (int)(gid % 2048), h = r / 256, half = (r / 128) & 1, key = r % 128;
        const float* q = p.a + (size_t)row * 2048 + h * 256 + half * 128; const float* kv = p.b + (((size_t)h * 2 + half) * 128 + key) * 128; float acc = 0.f;
        for (int dd = 0; dd < 128; ++dd) acc = fmaf(q[dd], kv[dd], acc);
        p.o0[gid] = acc; } break;
    case OP_TOPK: {
        const float* sc = p.a + (size_t)gid * 256; float tv[16]; int ti[16]; float* tmpv = p.o2 + (size_t)gid * 32; int* tmpi = (int*)p.o3 + (size_t)gid * 32;
        for (int half = 0; half < 2; ++half) {
#pragma unroll
            for (int j = 0; j < 16; ++j) { tv[j] = -3.0e38f; ti[j] = 0; }
            for (int k = 0; k < 128; ++k) NV_INS16(tv, ti, sc[half * 128 + k], k);
#pragma unroll
            for (int j = 0; j < 16; ++j) { tmpv[half * 16 + j] = tv[j]; tmpi[half * 16 + j] = ti[j]; }
        }
#pragma unroll
        for (int j = 0; j < 16; ++j) { tv[j] = -3.0e38f; ti[j] = 0; }
        for (int i = 0; i < 16; ++i) for (int j = 0; j < 16; ++j) NV_INS16(tv, ti, tmpv[i] + tmpv[16 + j], tmpi[i] * 128 + tmpi[16 + j]);
        float den = 0.f, ev[16];
#pragma unroll
        for (int j = 0; j < 16; ++j) { ev[j] = NV_EXP(tv[j] - tv[0]); den += ev[j]; }
        float inv = 1.f / den;
#pragma unroll
        for (int j = 0; j < 16; ++j) { p.o0[(size_t)gid * 16 + j] = ev[j] * inv; ((int*)p.o1)[(size_t)gid * 16 + j] = ti[j]; } } break;
    case OP_PACT1: {
        size_t pr = (size_t)(gid / 16); int part = (int)(gid % 16); int row = (int)(pr / 128); int e = ((const int*)p.d)[pr]; int w = D / 16;
        const float* u = p.b + (size_t)e * D + part * w; const float* x = p.a + (size_t)row * D + part * w; float acc = 0.f;
        for (int c = 0; c < w; ++c) acc = fmaf(u[c], x[c], acc);
        p.o0[gid] = acc; } break;
    case OP_PACT2: {
        float acc = 0.f; for (int i = 0; i < 16; ++i) acc += p.a[(size_t)gid * 16 + i];
        p.o0[gid] = p.c[gid] * nv_gelu(acc); } break;
    case OP_POUT: {
        int row = (int)(gid / D), c = (int)(gid % D); float acc = 0.f;
        for (int i = 0; i < 128; ++i) acc = fmaf(p.a[(size_t)row * 128 + i], p.c[(size_t)((const int*)p.b)[(size_t)row * 128 + i] * D + c], acc);
        p.o0[gid] = acc; } break;
    case OP_YOUT: {
        int row = (int)(gid / D), c = (int)(gid % D);
        if (row < dm.B * dm.T) { int bb = row / dm.T, t = row % dm.T; if (t >= 16) p.o0[((size_t)bb * (dm.T - 16) + (t - 16)) * D + c] = p.a[gid]; }
        else p.o0[((size_t)dm.B * (dm.T - 16) + (row - dm.B * dm.T)) * D + c] = p.a[gid]; } break;
    case OP_WT: {
        const int N = p.i0, K = p.i1, Np = p.i3, Kp = p.i4; const long long per8 = (long long)Np * (Kp / 8); const int bt = (int)(gid / per8); const long long r = gid % per8; const int k0 = (int)(r / Np) * 8, nn = (int)(r % Np);
        unsigned w[4];
#pragma unroll
        for (int i = 0; i < 4; ++i) { float lo = 0.f, hi = 0.f; if (nn < N) { if (k0 + 2 * i < K) lo = p.a[((size_t)bt * K + k0 + 2 * i) * p.i2 + nn]; if (k0 + 2 * i + 1 < K) hi = p.a[((size_t)bt * K + k0 + 2 * i + 1) * p.i2 + nn]; } w[i] = nv_f2bf(lo) | ((unsigned)nv_f2bf(hi) << 16); }
        NvU4 o; o.x = w[0]; o.y = w[1]; o.z = w[2]; o.w = w[3];
        *(NvU4*)((nvbf*)p.o0 + (size_t)bt * Np * Kp + (size_t)nn * Kp + k0) = o; } break;
    case OP_CVT: {
        const int Kp = p.i2; const int row = (int)(gid / Kp), k = (int)(gid % Kp); float v = 0.f;
        if (row < dm.M && k < p.i0) { v = p.a[(size_t)row * p.i1 + k]; if (p.i3 == 1) v = NV_TANH(v); else if (p.i3 == 2) v = nv_sigmoid(v); }
        ((nvbf*)p.o0)[gid] = nv_f2bf(v); } break;
    case OP_FGEMM: {
        const int N = p.i0; const int m = (int)(gid / N), nn = (int)(gid % N); const nvbf* A = (const nvbf*)p.a + (size_t)m * p.i2 + ((p.i6 & 2) ? (nn / 256) * 256 : 0); const nvbf* Bt = (const nvbf*)p.b + (size_t)nn * p.i3; float acc = 0.f;
        for (int k = 0; k < p.i1; ++k) acc = fmaf(nv_bf2f(A[k]), nv_bf2f(Bt[k]), acc);
        if (p.i6 & 1) ((nvbf*)p.o0)[(size_t)m * p.i4 + nn] = nv_f2bf(acc); else p.o0[(size_t)m * p.i4 + nn] = acc; } break;
    case OP_CVTTAB: {
        const NvF4 v0 = *(const NvF4*)(p.a + gid * 8), v1 = *(const NvF4*)(p.a + gid * 8 + 4); NvU4 o;
        o.x = nv_f2bf(v0.x) | ((unsigned)nv_f2bf(v0.y) << 16); o.y = nv_f2bf(v0.z) | ((unsigned)nv_f2bf(v0.w) << 16); o.z = nv_f2bf(v1.x) | ((unsigned)nv_f2bf(v1.y) << 16); o.w = nv_f2bf(v1.z) | ((unsigned)nv_f2bf(v1.w) << 16);
        *(NvU4*)((nvbf*)p.o0 + gid * 8) = o; } break;
    case OP_CVTTAB8: {
        const float sc = (float)(1 << p.i0); const float* sp = p.a + gid * 16; unsigned w[4];
#pragma unroll
        for (int q = 0; q < 4; ++q) { const NvF4 v = *(const NvF4*)(sp + 4 * q); w[q] = nv_f2e4m3(v.x * sc) | (nv_f2e4m3(v.y * sc) << 8) | (nv_f2e4m3(v.z * sc) << 16) | (nv_f2e4m3(v.w * sc) << 24); }
        NvU4 o; o.x = w[0]; o.y = w[1]; o.z = w[2]; o.w = w[3]; *(NvU4*)((unsigned char*)p.o0 + gid * 16) = o; } break;
    case OP_CVTTAB8S: {
        const float sc = (float)(1 << p.i0); const int per = D / 16; const int e = (int)(gid / per), c0 = (int)(gid % per) * 16; const float* sp = p.a + (size_t)e * D + c0; unsigned w[4];
#pragma unroll
        for (int q = 0; q < 4; ++q) { const NvF4 v = *(const NvF4*)(sp + 4 * q);
#if defined(__HIP_DEVICE_COMPILE__)
            int pk = __builtin_amdgcn_cvt_pk_fp8_f32(v.x * sc, v.y * sc, 0, false); pk = __builtin_amdgcn_cvt_pk_fp8_f32(v.z * sc, v.w * sc, pk, true); w[q] = (unsigned)pk;
#else
            w[q] = nv_f2e4m3(v.x * sc) | (nv_f2e4m3(v.y * sc) << 8) | (nv_f2e4m3(v.z * sc) << 16) | (nv_f2e4m3(v.w * sc) << 24);
#endif
        }
        NvU4 o; o.x = w[0]; o.y = w[1]; o.z = w[2]; o.w = w[3]; *(NvU4*)((unsigned char*)p.o0 + ((size_t)(c0 >> 7) * 16384 + e) * 128 + (c0 & 127)) = o; } break;
    case OP_PACTS: {
        const long long NP = (long long)dm.M * 128; const int sl = (int)(gid / NP); const long long pr = gid % NP; const int row = (int)(pr / 128); const int e = ((const int*)p.d)[pr] & p.i0;
        const unsigned char* u = (const unsigned char*)p.b + ((size_t)sl * 16384 + e) * 128; const unsigned char* x = (const unsigned char*)p.a + (size_t)row * 2 * D + sl * 128; float acc = 0.f;
        for (int c = 0; c < 128; ++c) acc = fmaf(nv_e4m32f(u[c]), nv_e4m32f(x[c]) + nv_e4m32f(x[D + c]), acc);
        ((nvbf*)p.o0)[gid] = nv_f2bf(acc * (1.f / 16.f)); } break;
    case OP_PRED: {
        const long long NP = (long long)dm.M * 128; const size_t e0 = (size_t)gid * 4; float a0 = 0.f, a1 = 0.f, a2 = 0.f, a3 = 0.f;
#pragma unroll 8
        for (int sl = 0; sl < p.i0; ++sl) { const NvU2 w = *(const NvU2*)((const nvbf*)p.a + (size_t)sl * NP + e0); a0 += nv_bf2f((nvbf)(w.x & 0xffffu)); a1 += nv_bf2f((nvbf)(w.x >> 16)); a2 += nv_bf2f((nvbf)(w.y & 0xffffu)); a3 += nv_bf2f((nvbf)(w.y >> 16)); }
        const NvF4 g = *(const NvF4*)(p.c + e0); NvF4 o; o.x = g.x * nv_gelu(a0 * (1.f / 128.f)); o.y = g.y * nv_gelu(a1 * (1.f / 128.f)); o.z = g.z * nv_gelu(a2 * (1.f / 128.f)); o.w = g.w * nv_gelu(a3 * (1.f / 128.f));
        *(NvF4*)(p.o0 + e0) = o; } break;
    case OP_POUTS: {
        const int row = (int)(gid / D), c = (int)(gid % D); const unsigned char* vb = (const unsigned char*)p.c + (size_t)(c >> 7) * 16384 * 128 + (c & 127); float acc = 0.f;
        for (int i = 0; i < 128; ++i) acc = fmaf(p.a[(size_t)row * 128 + i] * (1.f / 64.f), nv_e4m32f(vb[(size_t)((const int*)p.b)[(size_t)row * 128 + i] * 128]), acc);
        ((nvbf*)p.o0)[gid] = nv_f2bf(acc); } break;
    case OP_KEYS: {
        const int h = (int)(gid / 256), nrow = (int)(gid % 256), half = nrow >> 7; const float* src = p.a + (((size_t)h * 2 + half) * 128 + (nrow & 127)) * 128; nvbf* dst = (nvbf*)p.o0 + ((size_t)h * 256 + nrow) * 256; float ks = 0.f;
        for (int k = 0; k < 256; ++k) { nvbf b = 0; if ((k >> 7) == half) { b = nv_f2bf(src[k & 127]); ks += nv_bf2f(b); } dst[k] = b; }
        p.o1[gid] = ks; } break;
    case OP_TOPK2: {
        const int h = (int)(gid % 8); const nvbf* sc = (const nvbf*)p.a + (size_t)gid * 256; const nvbf* q = (const nvbf*)p.b + (size_t)gid * 256; const float* ksum = p.c + h * 256; float mu = 0.f;
        for (int c = 0; c < 256; ++c) mu += nv_bf2f(q[c]);
        mu *= (1.f / 256.f); float var = 0.f;
        for (int c = 0; c < 256; ++c) { float dlt = nv_bf2f(q[c]) - mu; var = fmaf(dlt, dlt, var); }
        const float rs = 1.f / sqrtf(var * (1.f / 256.f) + 1e-5f);
        float tv[16]; int ti[16]; float* tmpv = p.o2 + (size_t)gid * 32; int* tmpi = (int*)p.o3 + (size_t)gid * 32;
        for (int half = 0; half < 2; ++half) {
#pragma unroll
            for (int j = 0; j < 16; ++j) { tv[j] = -3.0e38f; ti[j] = 0; }
            for (int k = 0; k < 128; ++k) NV_INS16(tv, ti, rs * (nv_bf2f(sc[half * 128 + k]) - mu * ksum[half * 128 + k]), k);
#pragma unroll
            for (int j = 0; j < 16; ++j) { tmpv[half * 16 + j] = tv[j]; tmpi[half * 16 + j] = ti[j]; }
        }
#pragma unroll
        for (int j = 0; j < 16; ++j) { tv[j] = -3.0e38f; ti[j] = 0; }
        for (int i = 0; i < 16; ++i) for (int j = 0; j < 16; ++j) NV_INS16(tv, ti, tmpv[i] + tmpv[16 + j], tmpi[i] * 128 + tmpi[16 + j]);
        float den = 0.f, ev[16];
#pragma unroll
        for (int j = 0; j < 16; ++j) { ev[j] = NV_EXP(tv[j] - tv[0]); den += ev[j]; }
        float inv = 1.f / den;
#pragma unroll
        for (int j = 0; j < 16; ++j) { p.o0[(size_t)gid * 16 + j] = ev[j] * inv; ((int*)p.o1)[(size_t)gid * 16 + j] = ti[j]; } } break;
    case OP_PACT: {
        const int row = (int)(gid / 128); const int e = ((const int*)p.d)[gid]; const unsigned char* u = (const unsigned char*)p.b + (size_t)e * D; const nvbf* x = (const nvbf*)p.a + (size_t)row * D; float acc = 0.f;
        for (int c = 0; c < D; ++c) acc = fmaf(nv_e4m32f(u[c]), nv_bf2f(x[c]), acc);
        p.o0[gid] = p.c[gid] * nv_gelu(acc * (1.f / 128.f)); } break;
#if defined(HOST_TEST)
    case OP_POUTLN: {
        const float alpha = 1.6817928305074292f; float* x = p.o0 + (size_t)gid * D; std::vector<float> y(D, 0.f);
        for (int i = 0; i < 128; ++i) { const float cf = p.a[(size_t)gid * 128 + i] * (1.f / 64.f); const unsigned char* v = (const unsigned char*)p.c + (size_t)((const int*)p.b)[(size_t)gid * 128 + i] * D; for (int c = 0; c < D; ++c) y[c] = fmaf(cf, nv_e4m32f(v[c]), y[c]); }
        float mu = 0.f; for (int c = 0; c < D; ++c) { y[c] = alpha * x[c] + y[c]; mu += y[c]; }
        mu /= D; float var = 0.f; for (int c = 0; c < D; ++c) { float dlt = y[c] - mu; var = fmaf(dlt, dlt, var); }
        const float rs = 1.f / sqrtf(var / D + 1e-5f);
        for (int c = 0; c < D; ++c) { const float o = (y[c] - mu) * rs * p.d[c] + p.e[c]; x[c] = o; ((nvbf*)p.o1)[(size_t)gid * D + c] = nv_f2bf(o);
            if (p.o2) { unsigned char* f8 = (unsigned char*)p.o2 + (size_t)gid * 2 * D; const float xs = fminf(fmaxf(o * 16.f, -448.f), 448.f); const unsigned hc = nv_f2e4m3(xs); f8[c] = (unsigned char)hc; f8[D + c] = (unsigned char)nv_f2e4m3(xs - nv_e4m32f(hc)); } } } break;
#endif
    default: break;
    }
}

struct NvIO { const float* const* in; float* out; char* ws; size_t ws_size; };
template <class Launch> HD void nv_forward(const NvIO& io, const Dm& dm, Launch&& launch) {
    const int D = dm.D, M = dm.M, B = dm.B, DB = dm.DB, RH = dm.RH; const size_t MD = (size_t)M * D;
    float* y_prompt = io.out; float* y_sample = y_prompt + (size_t)B * (dm.T - 16) * D; float* p_gla = y_sample + (size_t)DB * dm.DT * D;
    float* p_h = p_gla + (size_t)2 * B * 4 * 64 * 128; float* p_conv = p_h + (size_t)2 * B * 512; float* p_rwkv = p_conv + (size_t)2 * B * 3 * 512;
    float* p_shift = p_rwkv + (size_t)2 * B * RH * 4096; float* s_gla = p_shift + (size_t)2 * B * D; float* s_h = s_gla + (size_t)2 * DB * 4 * 64 * 128;
    float* s_conv = s_h + (size_t)2 * DB * 512; float* s_rwkv = s_conv + (size_t)2 * DB * 3 * 512; float* s_shift = s_rwkv + (size_t)2 * DB * RH * 4096;
    float* w = (float*)io.ws; size_t off = 0; auto take = [&](size_t n) __attribute__((always_inline)) { float* r = w + off; off += (n + 63) & ~(size_t)63; return r; };
    float* X = take(MD > (size_t)nv_rup(M, 256) * 512 ? MD : (size_t)nv_rup(M, 256) * 512); float* VFIRST = take(MD); float* MOUT = take(MD);
    auto mk = [&](int code, long long n) __attribute__((always_inline)) { Op o{}; o.code = code; o.n = n; return o; };
    const int Mp = nv_rup(M, 256), Dp = nv_rup(D, 256), Dk = nv_rup(D, 128);
    auto takeh = [&](size_t n) __attribute__((always_inline)) { return (nvbf*)take((n + 1) / 2); };
    const size_t ABFN = (size_t)Mp * 1024 > (size_t)Mp * Dk ? (size_t)Mp * 1024 : (size_t)Mp * Dk; nvbf* ABF = takeh(ABFN + (size_t)Mp * D);
    const size_t SZ_WIN = (size_t)2816 * Dk, SZ_WOUT = (size_t)Dp * 1024, SZ_DD = (size_t)Dp * Dk, SZ_DN = (size_t)256 * Dk, SZ_UP = (size_t)Dp * 128, SZ_WQ = (size_t)2048 * Dk;
    nvbf* WT_WIN = takeh(2 * SZ_WIN); nvbf* WT_WOUT = takeh(2 * SZ_WOUT); nvbf* WT_WR = takeh(2 * SZ_DD); nvbf* WT_WK = takeh(2 * SZ_DD); nvbf* WT_WV = takeh(2 * SZ_DD); nvbf* WT_WO = takeh(2 * SZ_DD);
    nvbf* WT_W1 = takeh(2 * SZ_DN); nvbf* WT_W2 = takeh(2 * SZ_UP); nvbf* WT_A1 = takeh(2 * SZ_DN); nvbf* WT_A2 = takeh(2 * SZ_UP); nvbf* WT_G1 = takeh(2 * SZ_DN); nvbf* WT_G2 = takeh(2 * SZ_UP);
    nvbf* WT_V1 = takeh(SZ_DN); nvbf* WT_V2 = takeh(SZ_UP); nvbf* WT_WQ = takeh(4 * SZ_WQ); nvbf* WT_WG = takeh((size_t)2 * 1024 * 512); float* SPL = take(2 * 512); float* PRM = take((size_t)2 * 6 * D);
    nvbf* UB = takeh((size_t)16384 * D / 2); nvbf* VB = takeh((size_t)16384 * D / 2); nvbf* KB = takeh((size_t)8 * 256 * 256); float* KSUM = take(8 * 256);
    const size_t scratch0 = off;
    auto nb = [&](Op o) __attribute__((always_inline)) { o.code |= OPF_NOBAR; launch(o); };
    auto wt = [&](const float* W, int K, int N, int batch, nvbf* dst) __attribute__((always_inline)) { const int Np = nv_rup(N, 256), Kp = nv_rup(K, 128); Op o = mk(OP_WT, (long long)batch * Np * (Kp / 8)); o.a = W; o.o0 = (float*)dst; o.i0 = N; o.i1 = K; o.i2 = N; o.i3 = Np; o.i4 = Kp; nb(o); };
    wt(io.in[10], D, MIXIN, 2, WT_WIN); wt(io.in[21], 1024, D, 2, WT_WOUT); wt(io.in[23], D, D, 2, WT_WR); wt(io.in[24], D, D, 2, WT_WK); wt(io.in[25], D, D, 2, WT_WV); wt(io.in[26], D, D, 2, WT_WO);
    wt(io.in[28], D, 64, 2, WT_W1); wt(io.in[29], 64, D, 2, WT_W2); wt(io.in[31], D, 64, 2, WT_A1); wt(io.in[32], 64, D, 2, WT_A2); wt(io.in[36], D, 128, 2, WT_G1); wt(io.in[37], 128, D, 2, WT_G2);
    wt(io.in[34], D, 32, 1, WT_V1); wt(io.in[35], 32, D, 1, WT_V2); wt(io.in[43], D, 2048, 4, WT_WQ);
    for (int jj = 0; jj < 2; ++jj) { Op o = mk(OP_PRM, (long long)6 * D); o.a = io.in[27] + (size_t)jj * D; o.b = io.in[30] + (size_t)jj * D; o.c = jj > 0 ? io.in[33] + (size_t)(jj - 1) * D : nullptr; o.d = io.in[38] + (size_t)jj * D; o.e = io.in[39] + (size_t)jj * D; o.f = io.in[40] + (size_t)jj * RH * 64; o.o0 = PRM + (size_t)jj * 6 * D; nb(o); }
    for (int jj = 0; jj < 2; ++jj) { Op o = mk(OP_WGATE, 1024); o.a = io.in[16] + (size_t)jj * 8 * 64 * 64; o.b = io.in[18] + (size_t)jj * 8 * 64 * 64; o.c = io.in[20] + (size_t)jj * 512; o.o0 = (float*)(WT_WG + (size_t)jj * 1024 * 512); o.o1 = SPL + (size_t)jj * 512; nb(o); }
    auto fgemm = [&](const nvbf* Wt, float* C, int ldc, int N, int K, int bf16out = 0, const float* Aop = nullptr) __attribute__((always_inline)) {
        const int Kp = nv_rup(K, 128), Np = nv_rup(N, 256);
        Op o = mk(OP_FGEMM, (long long)M * N); o.a = Aop ? Aop : (const float*)ABF; o.b = (const float*)Wt; o.o0 = C; o.i0 = N; o.i1 = Kp; o.i2 = Kp; o.i3 = Kp; o.i4 = ldc; o.i5 = Np; o.i6 = bf16out; launch(o); };
    auto gemm = [&](const float* A, int lda, const nvbf* Wt, float* C, int ldc, int N, int K, int act) __attribute__((always_inline)) {
        const int Kp = nv_rup(K, 128);
        { Op o = mk(OP_CVT8, (long long)Mp * (Kp / 8)); o.a = A; o.o0 = (float*)ABF; o.i0 = K; o.i1 = lda; o.i2 = Kp; o.i3 = act; launch(o); }
        fgemm(Wt, C, ldc, N, K); };
    { Op o = mk(OP_EMBED4, (long long)MD / 4); o.a = io.in[0]; o.b = io.in[1]; o.c = io.in[7]; o.o0 = X; o.o1 = (float*)ABF; launch(o); }
    const float* const w_outer = w; float* const out_outer = io.out;
    for (int layer = 0; layer < 4; ++layer) {
        float* wl = (float*)w_outer; float* ol = out_outer; NV_LAUNDER(wl); NV_LAUNDER(ol);
#define NV_RB(T, v) T const v##_rb = (T)((char*)wl + ((const char*)(v) - (const char*)w_outer))
#define NV_RO(v) float* const v##_rb = (float*)((char*)ol + ((const char*)(v) - (const char*)out_outer))
        NV_RB(float*, X); NV_RB(float*, VFIRST); NV_RB(float*, MOUT); NV_RB(nvbf*, ABF); NV_RB(nvbf*, WT_WIN); NV_RB(nvbf*, WT_WOUT); NV_RB(nvbf*, WT_WR); NV_RB(nvbf*, WT_WK); NV_RB(nvbf*, WT_WV); NV_RB(nvbf*, WT_WO);
        NV_RB(nvbf*, WT_W1); NV_RB(nvbf*, WT_W2); NV_RB(nvbf*, WT_A1); NV_RB(nvbf*, WT_A2); NV_RB(nvbf*, WT_G1); NV_RB(nvbf*, WT_G2); NV_RB(nvbf*, WT_V1); NV_RB(nvbf*, WT_V2); NV_RB(nvbf*, WT_WQ); NV_RB(nvbf*, WT_WG);
        NV_RB(float*, SPL); NV_RB(float*, PRM); NV_RB(nvbf*, UB); NV_RB(nvbf*, VB); NV_RB(nvbf*, KB); NV_RB(float*, KSUM);
        NV_RO(p_gla); NV_RO(p_h); NV_RO(p_conv); NV_RO(p_rwkv); NV_RO(p_shift); NV_RO(s_gla); NV_RO(s_h); NV_RO(s_conv); NV_RO(s_rwkv); NV_RO(s_shift);
#undef NV_RB
#undef NV_RO
        { float* const X = X_rb; float* const VFIRST = VFIRST_rb; float* const MOUT = MOUT_rb; nvbf* const ABF = ABF_rb; nvbf* const WT_WIN = WT_WIN_rb; nvbf* const WT_WOUT = WT_WOUT_rb; nvbf* const WT_WR = WT_WR_rb; nvbf* const WT_WK = WT_WK_rb;
          nvbf* const WT_WV = WT_WV_rb; nvbf* const WT_WO = WT_WO_rb; nvbf* const WT_W1 = WT_W1_rb; nvbf* const WT_W2 = WT_W2_rb; nvbf* const WT_A1 = WT_A1_rb; nvbf* const WT_A2 = WT_A2_rb; nvbf* const WT_G1 = WT_G1_rb; nvbf* const WT_G2 = WT_G2_rb;
          nvbf* const WT_V1 = WT_V1_rb; nvbf* const WT_V2 = WT_V2_rb; nvbf* const WT_WQ = WT_WQ_rb; nvbf* const WT_WG = WT_WG_rb; float* const SPL = SPL_rb; float* const PRM = PRM_rb; nvbf* const UB = UB_rb; nvbf* const VB = VB_rb; nvbf* const KB = KB_rb; float* const KSUM = KSUM_rb;
          float* const p_gla = p_gla_rb; float* const p_h = p_h_rb; float* const p_conv = p_conv_rb; float* const p_rwkv = p_rwkv_rb; float* const p_shift = p_shift_rb; float* const s_gla = s_gla_rb; float* const s_h = s_h_rb; float* const s_conv = s_conv_rb;
          float* const s_rwkv = s_rwkv_rb; float* const s_shift = s_shift_rb; float* const w = wl; (void)SPL; (void)WT_WG; (void)VFIRST;
        const int j = layer / 2; off = scratch0;
        { Op o = mk(OP_CVTTAB8S, (long long)16384 * D / 16); o.a = io.in[45] + (size_t)layer * 16384 * D; o.o0 = (float*)UB; o.i0 = 7; nb(o); }
        { Op o = mk(OP_CVTTAB8S, (long long)16384 * D / 16); o.a = io.in[46] + (size_t)layer * 16384 * D; o.o0 = (float*)VB; o.i0 = 6; nb(o); }
        { Op o = mk(OP_KEYS, 8 * 256); o.a = io.in[44] + (size_t)layer * 8 * 2 * 128 * 128; o.o0 = (float*)KB; o.o1 = KSUM; nb(o); }
        if (layer % 2 == 0) {
            float* PROJ = take((size_t)M * MIXIN); float* LOGA = take((size_t)M * 256); float* O = take((size_t)M * 512); float* MIXO = X;
            float* XC = take((size_t)M * 512); nvbf* XCB = takeh((size_t)Mp * 512); float* AT = take((size_t)M * 512); float* BT = take((size_t)M * 512);
            const int NC = (dm.T + 63) / 64; float* LEND = take((size_t)B * 4 * NC * 8192); float* DEC = take((size_t)B * 4 * NC * 64); float* LA = take((size_t)B * NC * 512); float* LB = take((size_t)B * NC * 512);
            fgemm(WT_WIN + (size_t)j * SZ_WIN, PROJ, MIXIN, MIXIN, D);
            { Op o = mk(OP_LOGA4, (long long)M * 64); o.a = PROJ; o.b = io.in[11] + (size_t)j * 16 * 256; o.c = io.in[12] + (size_t)j * 256; o.o0 = LOGA; nb(o); }
            { Op o = mk(OP_CONV4, (long long)((M + 3) / 4) * 128); o.a = PROJ; o.b = io.in[4] + (size_t)j * DB * 3 * 512; o.c = io.in[14] + (size_t)j * 4 * 512; o.d = io.in[15] + (size_t)j * 512; o.o0 = XC; o.o1 = (float*)XCB; nb(o); }
            { Op o = mk(OP_CONVOUT, (long long)dm.NSEQ * 1536); o.a = PROJ; o.b = io.in[4] + (size_t)j * DB * 3 * 512; o.o1 = p_conv + (size_t)j * B * 3 * 512; o.o2 = s_conv + (size_t)j * DB * 3 * 512; launch(o); }
            { Op o = mk(OP_GLAF, (long long)B * 512); o.a = PROJ; o.b = LOGA; o.o0 = O; o.o1 = p_gla + (size_t)j * B * 4 * 64 * 128; nb(o); }
            { Op o = mk(OP_GLA3, (long long)(DB * 4) * 128); o.a = PROJ; o.b = LOGA; o.c = io.in[2] + (size_t)j * DB * 4 * 64 * 128; o.d = LEND; o.o0 = O; o.o2 = s_gla + (size_t)j * DB * 4 * 64 * 128; o.i0 = NC; o.i1 = 1; nb(o); }
            { Op o = mk(OP_LRUG2, (long long)M * 512); o.a = (const float*)XCB; o.b = (const float*)(WT_WG + (size_t)j * 1024 * 512); o.c = io.in[17] + (size_t)j * 512; o.d = io.in[19] + (size_t)j * 512; o.e = SPL + (size_t)j * 512; o.f = XC; o.o0 = AT; o.o1 = BT; launch(o); }
            { Op o = mk(OP_GLANORM, (long long)M * 4); o.a = O; o.b = PROJ; o.c = io.in[13] + (size_t)j * 128; o.o0 = MIXO; nb(o); }
            { Op o = mk(OP_LRU1, (long long)B * NC * 512); o.a = AT; o.b = BT; o.o0 = LA; o.o1 = LB; o.i0 = NC; launch(o); }
            { Op o = mk(OP_LRU2, (long long)B * 512); o.a = LA; o.o0 = LB; o.o1 = p_h + (size_t)j * B * 512; o.i0 = NC; launch(o); }
            { Op o = mk(OP_LRU3, (long long)(B * NC + DB) * 512); o.a = AT; o.b = BT; o.c = PROJ; o.d = io.in[3] + (size_t)j * DB * 512; o.e = LB; o.o0 = MIXO; o.o2 = s_h + (size_t)j * DB * 512; o.i0 = NC; launch(o); }
            fgemm(WT_WOUT + (size_t)j * SZ_WOUT, MOUT, D, D, 1024, 1, X);
        } else {
            float* Y = take(MD); float* R = take(MD); float* K = take(MD); float* V = take(MD); float* G = take(MD); float* KK = take(MD);
            const size_t XMSZ = (size_t)Mp * D;
            float* WAV = take(3 * MD > 3 * XMSZ ? 3 * MD : 3 * XMSZ); float* Wd = WAV; float* Aa = WAV + MD; float* Vg = WAV + 2 * MD; nvbf* XM6 = (nvbf*)WAV;
            float* BON = take((size_t)M * RH); float* HLw = take((size_t)M * 64); float* HLa = take((size_t)M * 64); float* HLg = take((size_t)M * 128); float* HLv = take((size_t)M * 32);
            nvbf* ABw = takeh((size_t)Mp * 128); nvbf* ABa = takeh((size_t)Mp * 128); nvbf* ABg = takeh((size_t)Mp * 128); nvbf* ABv = takeh((size_t)Mp * 128);
            const float* shin = io.in[6] + (size_t)j * DB * D; const float* mu = io.in[22] + (size_t)j * 6 * D;
            { Op o = mk(OP_SHIFTOUT, (long long)dm.NSEQ * D); o.a = (const float*)ABF; o.o1 = p_shift + (size_t)j * B * D; o.o2 = s_shift + (size_t)j * DB * D; nb(o); }
            { Op o = mk(OP_MIX6, (long long)((M + 3) / 4) * (D / 8)); o.a = (const float*)ABF; o.b = shin; o.c = mu; o.o0 = (float*)XM6; o.i1 = (int)(XMSZ / 1024); launch(o); }
            auto gg = [&](const nvbf* A, const nvbf* Wt, float* C, int ldc, int N, int K, bool last, int bf16out = 0) __attribute__((always_inline)) { const int Kp = nv_rup(K, 128), Np = nv_rup(N, 256);
                Op o = mk(OP_FGEMM, (long long)M * N); o.a = (const float*)A; o.b = (const float*)Wt; o.o0 = C; o.i0 = N; o.i1 = Kp; o.i2 = Kp; o.i3 = Kp; o.i4 = ldc; o.i5 = Np; o.i6 = bf16out; if (!last) o.code |= OPF_GROUP; launch(o); };
            gg(XM6 + 0 * XMSZ, WT_WR + (size_t)j * SZ_DD, R, D, D, D, false, 1); gg(XM6 + 2 * XMSZ, WT_WK + (size_t)j * SZ_DD, K, D, D, D, false, 1); gg(XM6 + 3 * XMSZ, WT_WV + (size_t)j * SZ_DD, V, D, D, D, false, 1);
            gg(XM6 + 1 * XMSZ, WT_W1 + (size_t)j * SZ_DN, HLw, 64, 64, D, false); gg(XM6 + 4 * XMSZ, WT_A1 + (size_t)j * SZ_DN, HLa, 64, 64, D, false);
            if (j > 0) gg(XM6 + 3 * XMSZ, WT_V1 + (size_t)(j - 1) * SZ_DN, HLv, 32, 32, D, false);
            gg(XM6 + 5 * XMSZ, WT_G1 + (size_t)j * SZ_DN, HLg, 128, 128, D, true);
            auto cv = [&](const float* A, int K, nvbf* dst, int act, bool last) __attribute__((always_inline)) { Op o = mk(OP_CVT8, (long long)Mp * 16); o.a = A; o.o0 = (float*)dst; o.i0 = K; o.i1 = K; o.i2 = 128; o.i3 = act; if (last) launch(o); else nb(o); };
            cv(HLw, 64, ABw, 1, false); cv(HLa, 64, ABa, 0, false); if (j > 0) cv(HLv, 32, ABv, 0, false); cv(HLg, 128, ABg, 2, true);
            gg(ABw, WT_W2 + (size_t)j * SZ_UP, Wd, D, D, 64, false, 1); gg(ABa, WT_A2 + (size_t)j * SZ_UP, Aa, D, D, 64, false, 1); if (j > 0) gg(ABv, WT_V2 + (size_t)(j - 1) * SZ_UP, Vg, D, D, 32, false, 1); gg(ABg, WT_G2 + (size_t)j * SZ_UP, G, D, D, 128, true, 1);
            { Op o = mk(OP_WKVP, (long long)dm.NSEQ * RH * 64); o.a = R; o.b = K; o.c = Wd; o.d = Aa; o.e = V; o.f = Vg; o.g = VFIRST; o.h = PRM + (size_t)j * 6 * D; o.o0 = Y; o.o1 = p_rwkv + (size_t)j * B * RH * 4096; o.o2 = s_rwkv + (size_t)j * DB * RH * 4096;
              o.o3 = j > 0 ? KK : VFIRST; o.o4 = BON; o.o5 = (float*)(io.in[5] + (size_t)j * DB * RH * 4096); o.i0 = j > 0 ? 1 : 0; launch(o); }
            { Op o = mk(OP_POST2, (long long)M * RH); o.a = Y; o.b = G; o.c = j > 0 ? KK : VFIRST; o.d = BON; o.e = io.in[41] + (size_t)j * D; o.f = io.in[42] + (size_t)j * D; o.o0 = X; launch(o); }
            fgemm(WT_WO + (size_t)j * SZ_DD, MOUT, D, D, D, 1, X);
        }
        { Op o = mk(OP_LNRES, M); o.a = MOUT; o.b = io.in[8] + (size_t)(layer * 2 + 0) * D; o.c = io.in[9] + (size_t)(layer * 2 + 0) * D; o.o0 = X; o.o1 = (float*)ABF; o.o2 = (float*)(ABF + ABFN); launch(o); }
        off = scratch0;
        { nvbf* Q = takeh((size_t)Mp * 2048); float* SC = take((size_t)M * 2048); float* GATE = take((size_t)M * 128); float* EIDX = take((size_t)M * 128); float* TMPV = take((size_t)M * 256); float* TMPI = take((size_t)M * 256);
          float* COEF = take((size_t)M * 128);
          { Op o = mk(OP_FGEMM, (long long)M * 2048); o.a = (const float*)ABF; o.b = (const float*)(WT_WQ + (size_t)layer * SZ_WQ); o.o0 = (float*)Q; o.i0 = 2048; o.i1 = Dk; o.i2 = Dk; o.i3 = Dk; o.i4 = 2048; o.i5 = 2048; o.i6 = 1; launch(o); }
          { Op o = mk(OP_FGEMM, (long long)M * 2048); o.a = (const float*)Q; o.b = (const float*)KB; o.o0 = SC; o.i0 = 2048; o.i1 = 256; o.i2 = 2048; o.i3 = 256; o.i4 = 2048; o.i5 = 2048; o.i6 = 3; launch(o); }
          { Op o = mk(OP_TOPK2, (long long)M * 8); o.a = SC; o.b = (const float*)Q; o.c = KSUM; o.o0 = GATE; o.o1 = EIDX; o.o2 = TMPV; o.o3 = TMPI; launch(o); }
          { const int NS = D / 128; float* PART = take((size_t)NS * M * 128); float* YBUF = take(MD);
            #ifdef PROBE_EMASK
            { Op o = mk(OP_PACTS, (long long)NS * M * 128); o.a = (const float*)(ABF + ABFN); o.b = (const float*)UB; o.d = EIDX; o.o0 = PART; o.i0 = PROBE_EMASK; launch(o); }
#endif
            { Op o = mk(OP_PACTS, (long long)NS * M * 128); o.a = (const float*)(ABF + ABFN); o.b = (const float*)UB; o.d = EIDX; o.o0 = PART; o.i0 = 16383; launch(o); }
            { Op o = mk(OP_PRED, (long long)M * 32); o.a = PART; o.c = GATE; o.o0 = COEF; o.i0 = NS; launch(o); }
            { Op o = mk(OP_POUTS, (long long)MD); o.a = COEF; o.b = EIDX; o.c = (const float*)VB; o.o0 = YBUF; launch(o); }
            { Op o = mk(OP_LNRES, M); o.a = YBUF; o.b = io.in[8] + (size_t)(layer * 2 + 1) * D; o.c = io.in[9] + (size_t)(layer * 2 + 1) * D; o.o0 = X; o.o1 = (float*)ABF; launch(o); } } }
        }
    }
    { Op o = mk(OP_YOUT4, (long long)MD / 4); o.a = (const float*)ABF; o.o0 = y_prompt; launch(o); }
    (void)y_sample;
}

#include <cstdint>
namespace pg8 {
#define PG8_LAS __attribute__((address_space(3)))
typedef unsigned short bf16_t;
typedef short bf16x8 __attribute__((ext_vector_type(8)));
typedef float f32x4 __attribute__((ext_vector_type(4)));
typedef unsigned u32x4 __attribute__((ext_vector_type(4)));
constexpr int BM = 256, BK = 64, HALF = 128, HTB = HALF * BK * 2  , STAGE_BYTES = 8 * HTB, NXCD = 8, WGM = 8;

__host__ __device__ __forceinline__ int lds_byte(int r, int c) { const int st = (r >> 4) * 2 + (c >> 5), rr = r & 15, cc = c & 31, ob = rr * 64 + cc * 2; return st * 1024 + (ob ^ (((ob >> 9) & 1) << 5)); }
__host__ __device__ __forceinline__ void stage_rc(int b, int& R, int& C) { const int st = b / 1024, sb = b % 1024, swz = sb ^ (((sb >> 9) & 1) << 5); R = (st >> 1) * 16 + swz / 64; C = (st & 1) * 32 + (swz % 64) / 2; }
__host__ __device__ __forceinline__ int perm32(int rho) { const int n = rho >> 4, i = rho & 15; return 8 * (i >> 2) + 4 * n + (i & 3); }

struct Unit { int pm, pn, grp, pad_; const char* A; const char* B; };
struct Gemm { const bf16_t* A; const bf16_t* Bt; int M, N, K, lda, ldb; };

struct StaticOrder {
    int nM, nN, nwg, G, c; const char* A; const char* B; size_t tsA, tsB, acs;
    __host__ __device__ void init(const Gemm& g, int G_, int c_) { nM = g.M / BM; nN = g.N / BM; nwg = nM * nN; G = G_; c = c_; A = (const char*)g.A; B = (const char*)g.Bt; tsA = (size_t)BM * g.lda * 2; tsB = (size_t)BM * g.ldb * 2; acs = 0; }
    __host__ __device__ bool next(int i, Unit& u) const {
        const long L = (long)i * G + c; if (L >= nwg) return false;
        int wgid = (int)L; { const int q = nwg / NXCD, r = nwg % NXCD, xcd = wgid % NXCD, off = wgid / NXCD; wgid = (xcd < r ? xcd * (q + 1) : r * (q + 1) + (xcd - r) * q) + off; }
        const int nig = WGM * nN, gid = wgid / nig, fm = gid * WGM, gsz = (nM - fm) < WGM ? (nM - fm) : WGM;
        u.pm = fm + ((wgid % nig) % gsz); u.pn = (wgid % nig) / gsz; u.grp = 0; u.pad_ = 0; u.A = A + (size_t)u.pm * tsA + (size_t)u.pn * acs; u.B = B + (size_t)u.pn * tsB; return true;
    }
    __device__ __forceinline__ void a_ready(const Unit&) const {}
    __device__ __forceinline__ void done(const Unit&) const {}
};

template <class Epi, class Sched, bool ALIGN_EPI = false, bool SP2 = false>
__device__ __forceinline__ void gemm_phase(PG8_LAS unsigned char* lds, const Gemm g, const Sched& S, const Epi& E) {
    int tid_raw = threadIdx.x; asm volatile("" : "+v"(tid_raw));
    const int tid = tid_raw, wid = __builtin_amdgcn_readfirstlane(tid >> 6), lane = tid & 63, wr = wid >> 2, wc = wid & 3, fr = lane & 15, fq = lane >> 4;
    const int K = g.K, nt = K / BK;
    unsigned voffA[2], voffB[2];
#pragma unroll
    for (int i = 0; i < 2; ++i) { int R, C; stage_rc(tid * 16 + i * 8192, R, C); const int Rb = Epi::PERM ? ((R & ~31) + perm32(R & 31)) : R;
        voffA[i] = (unsigned)(R * g.lda + C) * 2u; voffB[i] = (unsigned)(Rb * g.ldb + C) * 2u; }
    const size_t kstep = (size_t)(BK * 2);
    const size_t hstepA = (size_t)HALF * g.lda * 2, hstepB = (size_t)HALF * g.ldb * 2;
    const unsigned ldsw = (unsigned)wid * 1024u;
    const int aoff = lds_byte(wr * 64 + fr, fq * 8), boff = lds_byte(wc * 32 + fr, fq * 8);
#define PG8_SA(b, h) (((b) * 2 + (h)) * HTB)
#define PG8_SB(b, h) ((4 + (b) * 2 + (h)) * HTB)
#define PG8_STAGE(bufoff, gbase, voff) do { _Pragma("unroll") for (int _i = 0; _i < 2; ++_i) \
        __builtin_amdgcn_global_load_lds((const unsigned*)((const char*)(gbase) + (voff)[_i]), (PG8_LAS unsigned*)(lds + (bufoff) + ldsw + _i * 8192), 16, 0, 0); } while (0)
#define PG8_LDA(dst, b, h) do { _Pragma("unroll") for (int m = 0; m < 4; ++m) _Pragma("unroll") for (int k = 0; k < 2; ++k) dst[m][k] = *(const PG8_LAS bf16x8*)(lds + PG8_SA(b, h) + aoff + m * 2048 + k * 1024); } while (0)
#define PG8_LDB(dst, b, h) do { _Pragma("unroll") for (int n = 0; n < 2; ++n) _Pragma("unroll") for (int k = 0; k < 2; ++k) dst[n][k] = *(const PG8_LAS bf16x8*)(lds + PG8_SB(b, h) + boff + n * 2048 + k * 1024); } while (0)
#define PG8_MMA(ai, bj, At, Bt) do { __builtin_amdgcn_s_setprio(1); _Pragma("unroll") for (int m = 0; m < 4; ++m) _Pragma("unroll") for (int n = 0; n < 2; ++n) _Pragma("unroll") for (int k = 0; k < 2; ++k) \
        acc[ai][bj][m][n] = __builtin_amdgcn_mfma_f32_16x16x32_bf16(Bt[n][k], At[m][k], acc[ai][bj][m][n], 0, 0, 0); __builtin_amdgcn_s_setprio(0); } while (0)
#define PG8_WAIT_V(n) asm volatile("s_waitcnt vmcnt(" #n ")" ::: "memory")
#define PG8_WAIT_L(n) asm volatile("s_waitcnt lgkmcnt(" #n ")" ::: "memory")
#define PG8_BAR __builtin_amdgcn_s_barrier()
#define PG8_SCHED __builtin_amdgcn_sched_barrier(0)
    Unit cur, nxt; int ui = 0;
    if (!S.next(0, cur)) return;
    f32x4 acc[2][2][4][2];
#pragma unroll
    for (int a = 0; a < 2; ++a)
#pragma unroll
        for (int b = 0; b < 2; ++b)
#pragma unroll
            for (int m = 0; m < 4; ++m)
#pragma unroll
                for (int n = 0; n < 2; ++n) acc[a][b][m][n] = (f32x4){0.f, 0.f, 0.f, 0.f};
    bf16x8 At[4][2], B0[2][2], B1[2][2];
    const char* cA = cur.A; const char* cB = cur.B;
    S.a_ready(cur);
    if constexpr (SP2) {
        PG8_STAGE(PG8_SB(0, 0), cB, voffB); PG8_STAGE(PG8_SB(0, 1), cB + hstepB, voffB); PG8_STAGE(PG8_SA(0, 0), cA, voffA); PG8_STAGE(PG8_SA(0, 1), cA + hstepA, voffA);
        if (wr == 1) PG8_BAR;
        PG8_WAIT_V(2); PG8_BAR;
        PG8_STAGE(PG8_SB(1, 0), cB + kstep, voffB); PG8_STAGE(PG8_SA(1, 0), cA + kstep, voffA); PG8_STAGE(PG8_SB(1, 1), cB + hstepB + kstep, voffB);
        PG8_WAIT_V(6); PG8_BAR;
    } else {
        PG8_STAGE(PG8_SB(0, 0), cB, voffB); PG8_STAGE(PG8_SA(0, 0), cA, voffA); PG8_STAGE(PG8_SB(0, 1), cB + hstepB, voffB); PG8_STAGE(PG8_SA(0, 1), cA + hstepA, voffA);
        if (wr == 1) PG8_BAR;
        PG8_WAIT_V(4); PG8_BAR;
        PG8_STAGE(PG8_SB(1, 0), cB + kstep, voffB); PG8_STAGE(PG8_SA(1, 0), cA + kstep, voffA); PG8_STAGE(PG8_SB(1, 1), cB + hstepB + kstep, voffB);
        PG8_WAIT_V(6); PG8_BAR;
    }
    for (;;) {
        const bool has_next = S.next(ui + 1, nxt);
        const char* nA = has_next ? nxt.A : cA; const char* nB = has_next ? nxt.B : cB;
        for (int t = 0; t < nt; t += 2) {
            const bool last = (t == nt - 2);
            const char* a1 = cA + (size_t)(t + 1) * kstep;
            const char* a2 = last ? nA : cA + (size_t)(t + 2) * kstep; const char* b2 = last ? nB : cB + (size_t)(t + 2) * kstep;
            const char* a3 = a2 + kstep; const char* b3 = b2 + kstep;
            if (last && has_next) S.a_ready(nxt);
            if constexpr (SP2) {
            PG8_LDB(B0, 0, 0); PG8_LDB(B1, 0, 1); PG8_SCHED; PG8_LDA(At, 0, 0); PG8_STAGE(PG8_SA(1, 1), a1 + hstepA, voffA);
            PG8_WAIT_V(8); PG8_WAIT_L(0); PG8_BAR; PG8_MMA(0, 0, At, B0); PG8_MMA(0, 1, At, B1); PG8_BAR; PG8_SCHED;
            PG8_LDA(At, 0, 1); PG8_STAGE(PG8_SB(0, 0), b2, voffB); PG8_STAGE(PG8_SB(0, 1), b2 + hstepB, voffB); PG8_STAGE(PG8_SA(0, 0), a2, voffA);
            PG8_WAIT_V(8); PG8_WAIT_L(0); PG8_BAR; PG8_MMA(1, 0, At, B0); PG8_MMA(1, 1, At, B1); PG8_BAR; PG8_SCHED;
            PG8_LDB(B0, 1, 0); PG8_LDB(B1, 1, 1); PG8_SCHED; PG8_LDA(At, 1, 0); PG8_STAGE(PG8_SA(0, 1), a2 + hstepA, voffA);
            PG8_WAIT_V(8); PG8_WAIT_L(0); PG8_BAR; PG8_MMA(0, 0, At, B0); PG8_MMA(0, 1, At, B1); PG8_BAR; PG8_SCHED;
            PG8_LDA(At, 1, 1); PG8_STAGE(PG8_SB(1, 0), b3, voffB); PG8_STAGE(PG8_SB(1, 1), b3 + hstepB, voffB); PG8_STAGE(PG8_SA(1, 0), a3, voffA);
            PG8_WAIT_V(8); PG8_WAIT_L(0); PG8_BAR; PG8_MMA(1, 0, At, B0); PG8_MMA(1, 1, At, B1); PG8_BAR; PG8_SCHED;
            } else {
            PG8_LDB(B0, 0, 0); PG8_SCHED; PG8_LDA(At, 0, 0); PG8_STAGE(PG8_SA(1, 1), a1 + hstepA, voffA);
            PG8_WAIT_L(8); PG8_BAR; PG8_WAIT_L(0); PG8_MMA(0, 0, At, B0); PG8_BAR; PG8_SCHED;
            PG8_LDB(B1, 0, 1); PG8_STAGE(PG8_SB(0, 0), b2, voffB);
            PG8_BAR; PG8_WAIT_L(0); PG8_MMA(0, 1, At, B1); PG8_BAR;
            PG8_LDA(At, 0, 1); PG8_STAGE(PG8_SA(0, 0), a2, voffA);
            PG8_BAR; PG8_WAIT_L(0); PG8_MMA(1, 0, At, B0); PG8_BAR; PG8_SCHED;
            PG8_STAGE(PG8_SB(0, 1), b2 + hstepB, voffB);
            PG8_WAIT_V(6); PG8_BAR; PG8_MMA(1, 1, At, B1); PG8_BAR;
            PG8_LDB(B0, 1, 0); PG8_SCHED; PG8_LDA(At, 1, 0); PG8_STAGE(PG8_SA(0, 1), a2 + hstepA, voffA);
            PG8_WAIT_L(8); PG8_BAR; PG8_WAIT_L(0); PG8_MMA(0, 0, At, B0); PG8_BAR; PG8_SCHED;
            PG8_LDB(B1, 1, 1); PG8_STAGE(PG8_SB(1, 0), b3, voffB);
            PG8_BAR; PG8_WAIT_L(0); PG8_MMA(0, 1, At, B1); PG8_BAR;
            PG8_LDA(At, 1, 1); PG8_STAGE(PG8_SA(1, 0), a3, voffA);
            PG8_BAR; PG8_WAIT_L(0); PG8_MMA(1, 0, At, B0); PG8_BAR; PG8_SCHED;
            PG8_STAGE(PG8_SB(1, 1), b3 + hstepB, voffB);
            PG8_WAIT_V(6); PG8_BAR; PG8_MMA(1, 1, At, B1); PG8_BAR;
            }
        }
        if constexpr (ALIGN_EPI) { if (wr == 0) PG8_BAR; }
        if constexpr (!Epi::AFTER_DRAIN) { E(acc, cur, wr, wc, fr, fq); S.done(cur); }
        if (!has_next) break;
#pragma unroll
        for (int a = 0; a < 2; ++a)
#pragma unroll
            for (int b = 0; b < 2; ++b)
#pragma unroll
                for (int m = 0; m < 4; ++m)
#pragma unroll
                    for (int n = 0; n < 2; ++n) acc[a][b][m][n] = (f32x4){0.f, 0.f, 0.f, 0.f};
        cur = nxt; cA = nA; cB = nB; ++ui;
        if constexpr (ALIGN_EPI) { if (wr == 1) PG8_BAR; }
    }
    PG8_WAIT_V(0);
    if constexpr (!ALIGN_EPI) { if (wr == 0) PG8_BAR; }
    PG8_BAR;
    if constexpr (Epi::AFTER_DRAIN) { E.fused(acc, cur, wr, wc, fr, fq, lds, wid, lane); S.done(cur); }
#undef PG8_SA
#undef PG8_SB
#undef PG8_STAGE
#undef PG8_LDA
#undef PG8_LDB
#undef PG8_MMA
#undef PG8_WAIT_V
#undef PG8_WAIT_L
#undef PG8_BAR
#undef PG8_SCHED
}
}
template <class T> __device__ __forceinline__ T* uni_ptr(T* p) {
    unsigned long long v = (unsigned long long)p; unsigned lo = __builtin_amdgcn_readfirstlane((unsigned)v), hi = __builtin_amdgcn_readfirstlane((unsigned)(v >> 32));
    unsigned long long r = ((unsigned long long)hi << 32) | lo; asm volatile("" : "+s"(r)); return (T*)r; }
__device__ __forceinline__ int rfl(int x) { int t = __builtin_amdgcn_readfirstlane(x); asm volatile("" : "+s"(t)); return t; }
namespace pg8 {
__device__ __forceinline__ unsigned cvt_pk_bf16(float lo, float hi) { unsigned r; asm volatile("v_cvt_pk_bf16_f32 %0, %1, %2" : "=v"(r) : "v"(lo), "v"(hi)); return r; }
struct EpiF32 {
    static constexpr bool PERM = false, AFTER_DRAIN = false;
    float* C; int ldc, Mreal, Nreal;
    __device__ __forceinline__ void operator()(const f32x4 (&acc)[2][2][4][2], const Unit& u, int wr, int wc, int fr, int fq) const {
        const int row0 = u.pm * BM + wr * 64 + fr, col0 = u.pn * BM + wc * 32 + 4 * fq;
#pragma unroll
        for (int ai = 0; ai < 2; ++ai)
#pragma unroll
            for (int m = 0; m < 4; ++m) { const int r = row0 + ai * HALF + m * 16; if (r < Mreal) { float* rowp = C + (size_t)r * ldc + col0;
#pragma unroll
                for (int bj = 0; bj < 2; ++bj)
#pragma unroll
                    for (int n = 0; n < 2; ++n) { const int c = col0 + bj * HALF + n * 16; if (c < Nreal) *(f32x4*)(rowp + bj * HALF + n * 16) = acc[ai][bj][m][n]; } } }
    }
};
struct EpiBf16Plain {
    static constexpr bool PERM = true, AFTER_DRAIN = false;
    bf16_t* O; int ldc;
    __device__ __forceinline__ void operator()(const f32x4 (&acc)[2][2][4][2], const Unit& u, int wr, int wc, int fr, int fq) const {
        const int row0 = u.pm * BM + wr * 64 + fr, col0 = u.pn * BM + wc * 32 + 8 * fq;
#pragma unroll
        for (int ai = 0; ai < 2; ++ai)
#pragma unroll
            for (int m = 0; m < 4; ++m) { bf16_t* rowp = O + (size_t)(row0 + ai * HALF + m * 16) * ldc + col0;
#pragma unroll
                for (int bj = 0; bj < 2; ++bj) { const f32x4 v0 = acc[ai][bj][m][0], v1 = acc[ai][bj][m][1]; u32x4 w;
                    w.x = cvt_pk_bf16(v0[0], v0[1]); w.y = cvt_pk_bf16(v0[2], v0[3]); w.z = cvt_pk_bf16(v1[0], v1[1]); w.w = cvt_pk_bf16(v1[2], v1[3]);
                    *(u32x4*)(rowp + bj * HALF) = w; } }
    }
};
struct EpiLru {
    static constexpr bool PERM = false, AFTER_DRAIN = false;
    const float* ba; const float* bx; const float* spl; const float* XC; float* AT; float* BT; int Mreal;
    __device__ __forceinline__ void operator()(const f32x4 (&acc)[2][2][4][2], const Unit& u, int wr, int wc, int fr, int fq) const {
        const int row0 = u.pm * BM + wr * 64 + fr, ch0 = u.pn * 128 + wc * 32 + 4 * fq;
#pragma unroll
        for (int n = 0; n < 2; ++n) { const int c = ch0 + 16 * n; const f32x4 ba4 = *(const f32x4*)(ba + c), bx4 = *(const f32x4*)(bx + c), sp4 = *(const f32x4*)(spl + c);
#pragma unroll
            for (int ai = 0; ai < 2; ++ai)
#pragma unroll
                for (int m = 0; m < 4; ++m) { const int r = row0 + ai * HALF + m * 16; if (r < Mreal) { const f32x4 xc = *(const f32x4*)(XC + (size_t)r * 512 + c); const f32x4 ga = acc[ai][0][m][n] + ba4, gx = acc[ai][1][m][n] + bx4; f32x4 at, bt;
#pragma unroll
                    for (int i = 0; i < 4; ++i) { const float gate_a = __builtin_amdgcn_rcpf(1.f + __expf(-ga[i])), gate_x = __builtin_amdgcn_rcpf(1.f + __expf(-gx[i])); const float la = gate_a * sp4[i]; at[i] = __expf(la); bt[i] = sqrtf(-expm1f(2.f * la)) * (gate_x * xc[i]); }
                    *(f32x4*)(AT + (size_t)r * 512 + c) = at; *(f32x4*)(BT + (size_t)r * 512 + c) = bt; } } }
    }
};
struct GroupOrder {
    const PG8_LAS Op* tab; int ng, nM, G, c; size_t tsA, tsB;
    __device__ __forceinline__ bool next(int i, Unit& u) const {
        int L = i * G + c, g = 0;
        for (; g < ng; ++g) { const int cnt = nM * (__builtin_amdgcn_readfirstlane(tab[g].i5) >> 8); if (L < cnt) break; L -= cnt; }
        if (g >= ng) return false;
        u.pm = L % nM; u.pn = L / nM; u.grp = g; u.pad_ = 0;
        u.A = (const char*)uni_ptr(tab[g].a) + (size_t)u.pm * tsA; u.B = (const char*)uni_ptr(tab[g].b) + (size_t)u.pn * tsB; return true;
    }
    __device__ __forceinline__ void a_ready(const Unit&) const {}
    __device__ __forceinline__ void done(const Unit&) const {}
};
struct EpiGroup {
    static constexpr bool PERM = true, AFTER_DRAIN = false;
    const PG8_LAS Op* tab; int Mreal;
    __device__ __forceinline__ void operator()(const f32x4 (&acc)[2][2][4][2], const Unit& u, int wr, int wc, int fr, int fq) const {
        const int ldc = rfl(tab[u.grp].i4), Nreal = rfl(tab[u.grp].i0), fl = rfl(tab[u.grp].i6);
        if (fl & 1) { const EpiBf16Plain E{(bf16_t*)uni_ptr(tab[u.grp].o0), ldc}; E(acc, u, wr, wc, fr, fq); return; }
        float* C = uni_ptr(tab[u.grp].o0); const int row0 = u.pm * BM + wr * 64 + fr, col0 = u.pn * BM + wc * 32 + 8 * fq;
#pragma unroll
        for (int ai = 0; ai < 2; ++ai)
#pragma unroll
            for (int m = 0; m < 4; ++m) { const int r = row0 + ai * HALF + m * 16; if (r < Mreal) { float* rowp = C + (size_t)r * ldc + col0;
#pragma unroll
                for (int bj = 0; bj < 2; ++bj) { if (col0 + bj * HALF < Nreal) { *(f32x4*)(rowp + bj * HALF) = acc[ai][bj][m][0]; *(f32x4*)(rowp + bj * HALF + 4) = acc[ai][bj][m][1]; } } } }
    }
};
}

#define XB_TMO      128
#define XB_XCNT(j)  (256  + 64 * (j))
#define XB_XSUB(j)  (1280 + 64 * (j))
#define XB_XGEN(j)  (2304 + 64 * (j))
#define XB_TOP      3328
#define XB_TOPGEN   3392
#define XCD_BAR_WORDS 3456
#define XB_SPIN_CAP (1u << 18)
#define LAS __attribute__((address_space(3)))
__device__ __forceinline__ unsigned xb_ld(unsigned* p)              { return __hip_atomic_load(p, __ATOMIC_RELAXED, __HIP_MEMORY_SCOPE_AGENT); }
__device__ __forceinline__ unsigned xb_add(unsigned* p, unsigned v) { return __hip_atomic_fetch_add(p, v, __ATOMIC_RELAXED, __HIP_MEMORY_SCOPE_AGENT); }
__device__ __forceinline__ unsigned xb_xcc_id() { return (unsigned)__builtin_amdgcn_s_getreg((3 << 11) | 20) & 0xFu; }
#define XB_SPIN(cond, bar) do { unsigned _sp = 0; while (cond) { __builtin_amdgcn_s_sleep(1); \
    if ((++_sp & 255u) == 0u) { if (xb_ld(&(bar)[XB_TMO])) break; if (_sp > XB_SPIN_CAP) { atomicAdd(&(bar)[XB_TMO], 1u); break; } } } } while (0)
struct XcdBarrier { unsigned* bar; unsigned x; volatile LAS unsigned* st; };
__device__ __forceinline__ XcdBarrier xcd_barrier_post(unsigned* bar, volatile LAS unsigned* st) {
    XcdBarrier b; b.bar = bar; b.x = xb_xcc_id(); b.st = st;
    if (threadIdx.x == 0) (void)xb_add(&bar[XB_XCNT(b.x)], 1u);
    return b;
}
__device__ __forceinline__ void xcd_barrier_complete(unsigned* bar, unsigned x, unsigned& nloc, unsigned& nx) {
    const unsigned G = gridDim.x * gridDim.y * gridDim.z;
    unsigned sum, cnt, mine, sp = 0u;
    for (;;) {
        sum = 0u; cnt = 0u; mine = 0u;
#pragma unroll
        for (unsigned j = 0; j < 16; ++j) { const unsigned c = xb_ld(&bar[XB_XCNT(j)]); sum += c; cnt += (c > 0u) ? 1u : 0u; mine = (j == x) ? c : mine; }
        if (sum == G) break;
        __builtin_amdgcn_s_sleep(1);
        if ((++sp & 255u) == 0u) { if (xb_ld(&bar[XB_TMO])) break; if (sp > XB_SPIN_CAP) { atomicAdd(&bar[XB_TMO], 1u); break; } }
    }
    nloc = mine > 0u ? mine : 1u; nx = cnt > 0u ? cnt : 1u;
}
__device__ __forceinline__ void xcd_barrier(const XcdBarrier& b) {
    asm volatile("s_waitcnt vmcnt(0)" ::: "memory");
    __syncthreads();
    if (threadIdx.x == 0) {
        unsigned* bar = b.bar;
        __builtin_amdgcn_s_waitcnt(0);
        unsigned nloc = b.st[0], nx = b.st[1];
        if (nloc == 0u) { xcd_barrier_complete(bar, b.x, nloc, nx); b.st[0] = nloc; b.st[1] = nx; }
        const unsigned old = xb_add(&bar[XB_XSUB(b.x)], 1u);
        const unsigned gen = old / nloc;
        if (old + 1u == (gen + 1u) * nloc) {
            __builtin_amdgcn_fence(__ATOMIC_RELEASE, "agent");
            asm volatile("s_waitcnt vmcnt(0)" ::: "memory");
            const unsigned og = xb_add(&bar[XB_TOP], 1u);
            const unsigned tg = og / nx;
            if (og + 1u == (tg + 1u) * nx) xb_add(&bar[XB_TOPGEN], 1u);
            else XB_SPIN(xb_ld(&bar[XB_TOPGEN]) == tg, bar);
            __builtin_amdgcn_fence(__ATOMIC_ACQUIRE, "agent");
            xb_add(&bar[XB_XGEN(b.x)], 1u);
            asm volatile("s_waitcnt vmcnt(0)" ::: "memory");
        } else {
            XB_SPIN(xb_ld(&bar[XB_XGEN(b.x)]) == gen, bar);
            __builtin_amdgcn_fence(__ATOMIC_ACQUIRE, "agent");
            asm volatile("s_waitcnt vmcnt(0)" ::: "memory");
        }
    }
    __syncthreads();
}

namespace fk {
#define GAS __attribute__((address_space(1)))
typedef unsigned u32x4 __attribute__((ext_vector_type(4)));
typedef unsigned u32x2 __attribute__((ext_vector_type(2)));
typedef float f32x4 __attribute__((ext_vector_type(4)));
typedef float f32x2 __attribute__((ext_vector_type(2)));
typedef __bf16 bf2 __attribute__((ext_vector_type(2)));
typedef unsigned short bf16_t;
__device__ __forceinline__ float bflo(unsigned u) { return __uint_as_float(u << 16); }
__device__ __forceinline__ float bfhi(unsigned u) { return __uint_as_float(u & 0xffff0000u); }
__device__ __forceinline__ float dot2(unsigned a, unsigned b, float c) { return __builtin_amdgcn_fdot2_f32_bf16(__builtin_bit_cast(bf2, a), __builtin_bit_cast(bf2, b), c, false); }
__device__ __forceinline__ unsigned pk_bf16(float lo, float hi) { unsigned r; asm volatile("v_cvt_pk_bf16_f32 %0, %1, %2" : "=v"(r) : "v"(lo), "v"(hi)); return r; }
template <int CTRL> __device__ __forceinline__ float dppf(float v) { return __int_as_float(__builtin_amdgcn_update_dpp(0, __float_as_int(v), CTRL, 0xf, 0xf, true)); }
__device__ __forceinline__ float row_max16(float v) { v = fmaxf(v, dppf<0xB1>(v)); v = fmaxf(v, dppf<0x4E>(v)); v = fmaxf(v, dppf<0x141>(v)); v = fmaxf(v, dppf<0x140>(v)); return v; }
__device__ __forceinline__ float frcp(float x) { return __builtin_amdgcn_rcpf(x); }
__device__ __forceinline__ float fsqrt(float x) { return __builtin_amdgcn_sqrtf(x); }
__device__ __forceinline__ float row_sum8(float v) { v += dppf<0xB1>(v); v += dppf<0x4E>(v); v += dppf<0x141>(v); return v; }
__device__ __forceinline__ float row_sum16(float v) { v += dppf<0xB1>(v); v += dppf<0x4E>(v); v += dppf<0x141>(v); v += dppf<0x140>(v); return v; }
__device__ __forceinline__ float shx(float v, int m, int lane) { return __int_as_float(__builtin_amdgcn_ds_bpermute((lane ^ m) << 2, __float_as_int(v))); }
__device__ __forceinline__ float wave_sum(float v, int lane) { v = row_sum16(v); v += shx(v, 16, lane); v += shx(v, 32, lane); return v; }
__device__ __forceinline__ float gelu_tanh(float x) { return 0.5f * x * (1.f + tanhf(0.7978845608028654f * (x + 0.044715f * x * x * x))); }
#define FK_NEG (-3.0e38f)

template <int CTRL> __device__ __forceinline__ int dppi(int v) { return __builtin_amdgcn_update_dpp(0, v, CTRL, 0xf, 0xf, true); }
__device__ __forceinline__ int row_min16i(int v) { v = min(v, dppi<0xB1>(v)); v = min(v, dppi<0x4E>(v)); v = min(v, dppi<0x141>(v)); v = min(v, dppi<0x140>(v)); return v; }
#define FK_CE(a, b) do { const bool sw_ = v[b] > v[a]; const float tv_ = sw_ ? v[b] : v[a]; v[b] = sw_ ? v[a] : v[b]; v[a] = tv_; const int ti_ = sw_ ? id[b] : id[a]; id[b] = sw_ ? id[a] : id[b]; id[a] = ti_; } while (0)
#define FK_SORT8(v, id) do { FK_CE2(v, id, 0, 1); FK_CE2(v, id, 2, 3); FK_CE2(v, id, 4, 5); FK_CE2(v, id, 6, 7); FK_CE2(v, id, 0, 2); FK_CE2(v, id, 1, 3); FK_CE2(v, id, 4, 6); FK_CE2(v, id, 5, 7); FK_CE2(v, id, 1, 2); FK_CE2(v, id, 5, 6); \
    FK_CE2(v, id, 0, 4); FK_CE2(v, id, 1, 5); FK_CE2(v, id, 2, 6); FK_CE2(v, id, 3, 7); FK_CE2(v, id, 2, 4); FK_CE2(v, id, 3, 5); FK_CE2(v, id, 1, 2); FK_CE2(v, id, 3, 4); FK_CE2(v, id, 5, 6); } while (0)
#define FK_CE2(v, id, a, b) do { const bool sw_ = v[b] > v[a]; const float tv_ = sw_ ? v[b] : v[a]; v[b] = sw_ ? v[a] : v[b]; v[a] = tv_; const int ti_ = sw_ ? id[b] : id[a]; id[b] = sw_ ? id[a] : id[b]; id[a] = ti_; } while (0)
__device__ __forceinline__ void top16_of_128_x2(float (&v)[8], int (&id)[8], float (&u)[8], int (&jd)[8], int lane16, float& rv1, int& ri1, float& rv2, int& ri2) {
    FK_SORT8(v, id); FK_SORT8(u, jd);
    rv1 = FK_NEG; ri1 = 0; rv2 = FK_NEG; ri2 = 0;
#pragma unroll
    for (int r = 0; r < 16; ++r) {
        const float wm = row_max16(v[0]), xm = row_max16(u[0]);
        const int cand = (v[0] == wm) ? id[0] : 0x7fffffff, dand = (u[0] == xm) ? jd[0] : 0x7fffffff;
        const int sel = row_min16i(cand), tel = row_min16i(dand);
        const bool mine = (cand == sel), nine = (dand == tel);
        if (lane16 == r) { rv1 = wm; ri1 = sel; rv2 = xm; ri2 = tel; }
#pragma unroll
        for (int i = 0; i < 7; ++i) { v[i] = mine ? v[i + 1] : v[i]; id[i] = mine ? id[i + 1] : id[i]; u[i] = nine ? u[i + 1] : u[i]; jd[i] = nine ? jd[i + 1] : jd[i]; }
        v[7] = mine ? FK_NEG : v[7]; u[7] = nine ? FK_NEG : u[7];
    }
}
__device__ __forceinline__ int fk_key(float x, int lane16) { int k = __float_as_int(x); k ^= (k >> 31) & 0x7fffffff; return (k & ~15) | (15 - lane16); }
__device__ __forceinline__ float fk_unkey(int k) { k &= ~15; k ^= (k >> 31) & 0x7fffffff; return __int_as_float(k); }
__device__ __forceinline__ int row_max16i(int v) { v = max(v, dppi<0xB1>(v)); v = max(v, dppi<0x4E>(v)); v = max(v, dppi<0x141>(v)); v = max(v, dppi<0x140>(v)); return v; }
__device__ __forceinline__ void topk_phase(const GAS bf16_t* __restrict__ SC, const GAS bf16_t* __restrict__ Q, const GAS float* __restrict__ KSUM, GAS float* __restrict__ GATE, GAS int* __restrict__ EIDX, int nitems,
                                           LAS unsigned char* lds, int wid, int lane, int wave_gid, int nwaves) {
    LAS unsigned char* wb = lds + wid * 6144;
    LAS int* IDS1 = (LAS int*)wb; LAS int* IDS2 = (LAS int*)(wb + 2048); LAS int* LC1 = (LAS int*)(wb + 4096); LAS int* LC2 = (LAS int*)(wb + 4352); LAS int* CI = (LAS int*)(wb + 4608);
    LAS float* xv = (LAS float*)(wb + 4864); LAS int* DUMP = (LAS int*)(wb + 5120) + lane; LAS int* WL1 = (LAS int*)(wb + 5376); LAS int* WL2 = (LAS int*)(wb + 5632);
    const int lane16 = lane & 15, rowbase = lane & 48;
    u32x4 nqa, nqb, nsw, ntw;
#define TK_LOAD(wi_) do { int it_ = (wi_) * 4 + (lane >> 4); it_ = it_ < nitems ? it_ : nitems - 1; const GAS u32x4* qp_ = (const GAS u32x4*)(Q + (size_t)it_ * 256 + 16 * lane16); nqa = qp_[0]; nqb = qp_[1]; \
        const GAS bf16_t* sp_ = SC + (size_t)it_ * 256 + 8 * lane16; nsw = *(const GAS u32x4*)sp_; ntw = *(const GAS u32x4*)(sp_ + 128); } while (0)
    TK_LOAD(wave_gid);
    const GAS float* kp = KSUM + ((wave_gid * 4 + (lane >> 4)) & 7) * 256 + 8 * lane16; const f32x4 k0 = *(const GAS f32x4*)kp, k1 = *(const GAS f32x4*)(kp + 4), m0 = *(const GAS f32x4*)(kp + 128), m1 = *(const GAS f32x4*)(kp + 132);
    for (int wi = wave_gid; wi * 4 < nitems; wi += nwaves) {
        const int it = wi * 4 + (lane >> 4);
        const u32x4 qa = nqa, qb = nqb; const f32x4 s0 = (f32x4){bflo(nsw[0]), bfhi(nsw[0]), bflo(nsw[1]), bfhi(nsw[1])}, s1 = (f32x4){bflo(nsw[2]), bfhi(nsw[2]), bflo(nsw[3]), bfhi(nsw[3])},
                    t0 = (f32x4){bflo(ntw[0]), bfhi(ntw[0]), bflo(ntw[1]), bfhi(ntw[1])}, t1 = (f32x4){bflo(ntw[2]), bfhi(ntw[2]), bflo(ntw[3]), bfhi(ntw[3])};
        TK_LOAD(wi + nwaves);
        float qs = 0.f, qq = 0.f;
#pragma unroll
        for (int i = 0; i < 4; ++i) { const float a = bflo(qa[i]), b = bfhi(qa[i]), c = bflo(qb[i]), d = bfhi(qb[i]); qs += (a + b) + (c + d); qq += (a * a + b * b) + (c * c + d * d); }
        const float mu = row_sum16(qs) * (1.f / 256.f); const float var = fmaxf(row_sum16(qq) * (1.f / 256.f) - mu * mu, 0.f); const float rs = 1.f / sqrtf(var + 1e-5f);
        float v[8], u[8]; int id[8], jd[8];
        {
#pragma unroll
          for (int i = 0; i < 4; ++i) { v[i] = rs * (s0[i] - mu * k0[i]); v[4 + i] = rs * (s1[i] - mu * k1[i]); u[i] = rs * (t0[i] - mu * m0[i]); u[4 + i] = rs * (t1[i] - mu * m1[i]);
              id[i] = 8 * lane16 + i; id[4 + i] = 8 * lane16 + 4 + i; jd[i] = 8 * lane16 + i; jd[4 + i] = 8 * lane16 + 4 + i; } }
        FK_SORT8(v, id); FK_SORT8(u, jd);
#pragma unroll
        for (int i = 0; i < 8; ++i) { IDS1[lane * 8 + i] = id[i]; IDS2[lane * 8 + i] = jd[i]; }
        float rv1 = FK_NEG, rv2 = FK_NEG; int wl1 = 0, wl2 = 0, cn1 = 0, cn2 = 0;
#pragma unroll
        for (int r = 0; r < 16; ++r) {
            const int key1 = fk_key(v[0], lane16), key2 = fk_key(u[0], lane16);
            const int wm1 = row_max16i(key1), wm2 = row_max16i(key2);
            const bool mine = (key1 == wm1), nine = (key2 == wm2);
            if (lane16 == r) { rv1 = fk_unkey(wm1); wl1 = 15 - (wm1 & 15); rv2 = fk_unkey(wm2); wl2 = 15 - (wm2 & 15); }
            *(mine ? LC1 + rowbase + r : DUMP) = cn1; *(nine ? LC2 + rowbase + r : DUMP) = cn2;
#pragma unroll
            for (int i = 0; i < 7; ++i) { v[i] = mine ? v[i + 1] : v[i]; u[i] = nine ? u[i + 1] : u[i]; }
            v[7] = mine ? FK_NEG : v[7]; u[7] = nine ? FK_NEG : u[7]; cn1 += mine ? 1 : 0; cn2 += nine ? 1 : 0;
        }
        xv[lane] = rv2; WL1[lane] = wl1; WL2[lane] = wl2;
        float c[16];
        { const LAS f32x4* xp = (const LAS f32x4*)(xv + rowbase);
#pragma unroll
          for (int q = 0; q < 4; ++q) { const f32x4 t = xp[q]; c[4 * q] = rv1 + t.x; c[4 * q + 1] = rv1 + t.y; c[4 * q + 2] = rv1 + t.z; c[4 * q + 3] = rv1 + t.w; } }
        int p = 0, wli = 0; float sc = FK_NEG;
#pragma unroll
        for (int r = 0; r < 16; ++r) {
            const int key = fk_key(c[0], lane16); const int wm = row_max16i(key); const bool mine = (key == wm);
            if (lane16 == r) { sc = fk_unkey(wm); wli = 15 - (wm & 15); }
            *(mine ? CI + rowbase + r : DUMP) = p;
#pragma unroll
            for (int i = 0; i < 15; ++i) c[i] = mine ? c[i + 1] : c[i];
            c[15] = mine ? FK_NEG : c[15]; p += mine ? 1 : 0;
        }
        const int i1 = wli & 15, j2 = CI[rowbase + lane16] & 15;
        const int e1 = IDS1[(rowbase + (WL1[rowbase + i1] & 15)) * 8 + (LC1[rowbase + i1] & 7)], e2 = IDS2[(rowbase + (WL2[rowbase + j2] & 15)) * 8 + (LC2[rowbase + j2] & 7)];
        const float mx = fk_unkey(row_max16i(fk_key(sc, 0))); const float ex = __expf(sc - mx); const float den = row_sum16(ex);
        GATE[(size_t)it * 16 + lane16] = ex / den; EIDX[(size_t)it * 16 + lane16] = (e1 & 127) * 128 + (e2 & 127);
    }
#undef TK_LOAD
}

__device__ __forceinline__ f32x2 fp8lo(unsigned w) { return __builtin_amdgcn_cvt_pk_f32_fp8((int)w, false); }
__device__ __forceinline__ f32x2 fp8hi(unsigned w) { return __builtin_amdgcn_cvt_pk_f32_fp8((int)w, true); }
__device__ __forceinline__ void act_phase(const GAS bf16_t* __restrict__ XB, const GAS unsigned char* __restrict__ U8, const GAS float* __restrict__ GATE, const GAS int* __restrict__ EIDX, GAS float* __restrict__ COEF, int nitems,
                                          int lane, int wave_gid, int nwaves) {
    int it = wave_gid; if (it >= nitems) return;
    u32x4 uc[16], un[16], xac, xbc, xan, xbn;
    int evc = EIDX[(size_t)it * 16 + (lane & 15)];
    { const GAS u32x4* xp = (const GAS u32x4*)(XB + (size_t)(it >> 3) * 1024 + 16 * lane); xac = xp[0]; xbc = xp[1]; }
#pragma unroll
    for (int k = 0; k < 16; ++k) uc[k] = *(const GAS u32x4*)(U8 + (size_t)__builtin_amdgcn_readlane(evc, k) * 1024 + 16 * lane);
    int itn = it + nwaves; int evn = (itn < nitems) ? EIDX[(size_t)itn * 16 + (lane & 15)] : 0;
    for (;;) {
        const bool hasn = itn < nitems;
        if (hasn) {
            const GAS u32x4* xp = (const GAS u32x4*)(XB + (size_t)(itn >> 3) * 1024 + 16 * lane); xan = xp[0]; xbn = xp[1];
#pragma unroll
            for (int k = 0; k < 16; ++k) un[k] = *(const GAS u32x4*)(U8 + (size_t)__builtin_amdgcn_readlane(evn, k) * 1024 + 16 * lane);
        }
        const int itnn = itn + nwaves; const int evnn = (itnn < nitems) ? EIDX[(size_t)itnn * 16 + (lane & 15)] : 0;
        const float gt = GATE[(size_t)it * 16 + (lane >> 2)];
        float x[16];
#pragma unroll
        for (int i = 0; i < 4; ++i) { x[2 * i] = bflo(xac[i]); x[2 * i + 1] = bfhi(xac[i]); x[8 + 2 * i] = bflo(xbc[i]); x[8 + 2 * i + 1] = bfhi(xbc[i]); }
        float a[16];
#pragma unroll
        for (int k = 0; k < 16; ++k) { const u32x4 uw = uc[k]; float s = 0.f;
#pragma unroll
            for (int d = 0; d < 4; ++d) { const f32x2 lo = fp8lo(uw[d]), hi = fp8hi(uw[d]); s = fmaf(lo.x, x[4 * d], s); s = fmaf(lo.y, x[4 * d + 1], s); s = fmaf(hi.x, x[4 * d + 2], s); s = fmaf(hi.y, x[4 * d + 3], s); }
            asm volatile("" : "+v"(s)); a[k] = s; }
#pragma unroll
        for (int k = 0; k < 8; ++k) { const bool hi = lane & 32; const float send = hi ? a[k] : a[k + 8], keep = hi ? a[k + 8] : a[k]; a[k] = keep + shx(send, 32, lane); }
#pragma unroll
        for (int k = 0; k < 4; ++k) { const bool hi = lane & 16; const float send = hi ? a[k] : a[k + 4], keep = hi ? a[k + 4] : a[k]; a[k] = keep + shx(send, 16, lane); }
#pragma unroll
        for (int k = 0; k < 2; ++k) { const bool hi = lane & 8; const float send = hi ? a[k] : a[k + 2], keep = hi ? a[k + 2] : a[k]; a[k] = keep + shx(send, 8, lane); }
        { const bool hi = lane & 4; const float send = hi ? a[0] : a[1], keep = hi ? a[1] : a[0]; a[0] = keep + shx(send, 4, lane); }
        float dsum = a[0]; dsum += shx(dsum, 2, lane); dsum += shx(dsum, 1, lane);
        if ((lane & 3) == 0) COEF[(size_t)it * 16 + (lane >> 2)] = gt * gelu_tanh(dsum * (1.f / 128.f));
        if (!hasn) break;
#pragma unroll
        for (int k = 0; k < 16; ++k) uc[k] = un[k];
        xac = xan; xbc = xbn; evc = evn; evn = evnn; it = itn; itn = itnn;
    }
}

__device__ __forceinline__ void outln_phase(const GAS float* COEF, const GAS int* EIDX, const GAS unsigned char* V8,     const GAS float* __restrict__ lg, const GAS float* __restrict__ lb, GAS float* X, GAS bf16_t* XB, int nrows,
                                            int lane, int wave_gid, int nwaves) {
    const float alpha = 1.6817928305074292f;
    int row = wave_gid; if (row >= nrows) return;
    u32x4 vc[16], vn[16];
    float cf0 = COEF[(size_t)row * 128 + lane] * (1.f / 64.f), cf1 = COEF[(size_t)row * 128 + 64 + lane] * (1.f / 64.f); int ev0 = EIDX[(size_t)row * 128 + lane], ev1 = EIDX[(size_t)row * 128 + 64 + lane];
#define OUT_LOADCH(dst, evreg, base) do { _Pragma("unroll") for (int k_ = 0; k_ < 16; ++k_) dst[k_] = *(const GAS u32x4*)(V8 + (size_t)__builtin_amdgcn_readlane(evreg, (base) + k_) * 1024 + 16 * lane); } while (0)
#define OUT_COMPCH(src, cfreg, base) do { _Pragma("unroll") for (int k_ = 0; k_ < 16; ++k_) { const float c_ = __int_as_float(__builtin_amdgcn_readlane(__float_as_int(cfreg), (base) + k_)); const u32x4 vw_ = src[k_]; \
        _Pragma("unroll") for (int d_ = 0; d_ < 4; ++d_) { const f32x2 lo_ = fp8lo(vw_[d_]), hi_ = fp8hi(vw_[d_]); acc[4 * d_] = fmaf(c_, lo_.x, acc[4 * d_]); acc[4 * d_ + 1] = fmaf(c_, lo_.y, acc[4 * d_ + 1]); acc[4 * d_ + 2] = fmaf(c_, hi_.x, acc[4 * d_ + 2]); acc[4 * d_ + 3] = fmaf(c_, hi_.y, acc[4 * d_ + 3]); } \
        _Pragma("unroll") for (int p_ = 0; p_ < 16; ++p_) asm volatile("" : "+v"(acc[p_]));     \
        } } while (0)
    for (;;) {
        OUT_LOADCH(vc, ev0, 0);
        const int rown = row + nwaves; const bool hasn = rown < nrows;
        float ncf0 = 0.f, ncf1 = 0.f; int nev0 = 0, nev1 = 0;
        if (hasn) { ncf0 = COEF[(size_t)rown * 128 + lane] * (1.f / 64.f); ncf1 = COEF[(size_t)rown * 128 + 64 + lane] * (1.f / 64.f); nev0 = EIDX[(size_t)rown * 128 + lane]; nev1 = EIDX[(size_t)rown * 128 + 64 + lane]; }
        float acc[16];
#pragma unroll
        for (int k = 0; k < 16; ++k) acc[k] = 0.f;
#define OUT_FENCE() asm volatile("" ::: "memory")
        OUT_LOADCH(vn, ev0, 16); OUT_FENCE(); OUT_COMPCH(vc, cf0, 0); OUT_FENCE();
        OUT_LOADCH(vc, ev0, 32); OUT_FENCE(); OUT_COMPCH(vn, cf0, 16); OUT_FENCE();
        OUT_LOADCH(vn, ev0, 48); OUT_FENCE(); OUT_COMPCH(vc, cf0, 32); OUT_FENCE();
        OUT_LOADCH(vc, ev1, 0);  OUT_FENCE(); OUT_COMPCH(vn, cf0, 48); OUT_FENCE();
        OUT_LOADCH(vn, ev1, 16); OUT_FENCE(); OUT_COMPCH(vc, cf1, 0); OUT_FENCE();
        OUT_LOADCH(vc, ev1, 32); OUT_FENCE(); OUT_COMPCH(vn, cf1, 16); OUT_FENCE();
        OUT_LOADCH(vn, ev1, 48); OUT_FENCE(); OUT_COMPCH(vc, cf1, 32); OUT_FENCE();
        OUT_COMPCH(vn, cf1, 48); OUT_FENCE();
#undef OUT_FENCE
        GAS float* xr = X + (size_t)row * 1024 + 16 * lane; float t[16];
#pragma unroll
        for (int q = 0; q < 4; ++q) { const f32x4 xv = *(const GAS f32x4*)(xr + 4 * q); t[4 * q] = fmaf(alpha, xv.x, acc[4 * q]); t[4 * q + 1] = fmaf(alpha, xv.y, acc[4 * q + 1]); t[4 * q + 2] = fmaf(alpha, xv.z, acc[4 * q + 2]); t[4 * q + 3] = fmaf(alpha, xv.w, acc[4 * q + 3]); }
        float s = 0.f;
#pragma unroll
        for (int k = 0; k < 16; ++k) s += t[k];
        const float mu = wave_sum(s, lane) * (1.f / 1024.f); float vs = 0.f;
#pragma unroll
        for (int k = 0; k < 16; ++k) { t[k] -= mu; vs = fmaf(t[k], t[k], vs); }
        const float rs = 1.f / sqrtf(wave_sum(vs, lane) * (1.f / 1024.f) + 1e-5f);
        unsigned w[8];
#pragma unroll
        for (int q = 0; q < 4; ++q) { const f32x4 g = *(const GAS f32x4*)(lg + 16 * lane + 4 * q), b = *(const GAS f32x4*)(lb + 16 * lane + 4 * q); f32x4 o;
            o.x = t[4 * q] * rs * g.x + b.x; o.y = t[4 * q + 1] * rs * g.y + b.y; o.z = t[4 * q + 2] * rs * g.z + b.z; o.w = t[4 * q + 3] * rs * g.w + b.w;
            *(GAS f32x4*)(xr + 4 * q) = o; w[2 * q] = pk_bf16(o.x, o.y); w[2 * q + 1] = pk_bf16(o.z, o.w); }
        u32x4 w0, w1; w0.x = w[0]; w0.y = w[1]; w0.z = w[2]; w0.w = w[3]; w1.x = w[4]; w1.y = w[5]; w1.z = w[6]; w1.w = w[7];
        GAS u32x4* xbp = (GAS u32x4*)(XB + (size_t)row * 1024 + 16 * lane); xbp[0] = w0; xbp[1] = w1;
        if (!hasn) break;
        row = rown; cf0 = ncf0; cf1 = ncf1; ev0 = nev0; ev1 = nev1;
    }
#undef OUT_LOADCH
#undef OUT_COMPCH
}

__device__ __forceinline__ void lnres_phase(const GAS bf16_t* __restrict__ Y, const GAS float* __restrict__ lg, const GAS float* __restrict__ lb, GAS float* X, GAS bf16_t* XB, GAS unsigned char* XF8, int nrows, int lane, int wave_gid, int nwaves) {
    const float alpha = 1.6817928305074292f; (void)X;
    for (int row = wave_gid; row < nrows; row += nwaves) {
        GAS bf16_t* xr = XB + (size_t)row * 1024; const GAS bf16_t* yr = Y + (size_t)row * 1024; float t[16];
#pragma unroll
        for (int q = 0; q < 4; ++q) { const u32x2 xw = *(const GAS u32x2*)(xr + 256 * q + 4 * lane); const u32x2 yw = *(const GAS u32x2*)(yr + 256 * q + 4 * lane);
            t[4 * q] = fmaf(alpha, bflo(xw.x), bflo(yw.x)); t[4 * q + 1] = fmaf(alpha, bfhi(xw.x), bfhi(yw.x)); t[4 * q + 2] = fmaf(alpha, bflo(xw.y), bflo(yw.y)); t[4 * q + 3] = fmaf(alpha, bfhi(xw.y), bfhi(yw.y)); }
        float s = 0.f;
#pragma unroll
        for (int k = 0; k < 16; ++k) s += t[k];
        const float mu = wave_sum(s, lane) * (1.f / 1024.f); float vs = 0.f;
#pragma unroll
        for (int k = 0; k < 16; ++k) { t[k] -= mu; vs = fmaf(t[k], t[k], vs); }
        const float rs = 1.f / sqrtf(wave_sum(vs, lane) * (1.f / 1024.f) + 1e-5f);
#pragma unroll
        for (int q = 0; q < 4; ++q) { const int c = 256 * q + 4 * lane; const f32x4 g = *(const GAS f32x4*)(lg + c), b = *(const GAS f32x4*)(lb + c); f32x4 o;
            o.x = t[4 * q] * rs * g.x + b.x; o.y = t[4 * q + 1] * rs * g.y + b.y; o.z = t[4 * q + 2] * rs * g.z + b.z; o.w = t[4 * q + 3] * rs * g.w + b.w;
            u32x2 w; w.x = pk_bf16(o.x, o.y); w.y = pk_bf16(o.z, o.w); *(GAS u32x2*)(xr + c) = w;
            if (XF8) {
                const float s0 = __builtin_amdgcn_fmed3f(o.x * 16.f, -448.f, 448.f), s1 = __builtin_amdgcn_fmed3f(o.y * 16.f, -448.f, 448.f), s2 = __builtin_amdgcn_fmed3f(o.z * 16.f, -448.f, 448.f), s3 = __builtin_amdgcn_fmed3f(o.w * 16.f, -448.f, 448.f);
                int hp = __builtin_amdgcn_cvt_pk_fp8_f32(s0, s1, 0, false); hp = __builtin_amdgcn_cvt_pk_fp8_f32(s2, s3, hp, true);
                const f32x2 d01 = fp8lo((unsigned)hp), d23 = fp8hi((unsigned)hp);
                int lp = __builtin_amdgcn_cvt_pk_fp8_f32(s0 - d01.x, s1 - d01.y, 0, false); lp = __builtin_amdgcn_cvt_pk_fp8_f32(s2 - d23.x, s3 - d23.y, lp, true);
                *(GAS int*)(XF8 + (size_t)row * 2048 + c) = hp; *(GAS int*)(XF8 + (size_t)row * 2048 + 1024 + c) = lp; } }
    }
}

__device__ __forceinline__ void glanorm_phase(const GAS float* __restrict__ O, const GAS float* __restrict__ PROJ, const GAS float* __restrict__ gnorm, GAS bf16_t* XB, int nitems, int lane, int wave_gid, int nwaves) {
    const float g0 = gnorm[lane], g1 = gnorm[64 + lane];
    for (int it0 = wave_gid * 8; it0 < nitems; it0 += nwaves * 8) {
        float a0[8], a1[8], r0[8], r1[8];
#pragma unroll
        for (int q = 0; q < 8; ++q) { int it = it0 + q; it = it < nitems ? it : it0; const int row = it >> 2, h = it & 3; const GAS float* o = O + (size_t)row * 512 + h * 128; const GAS float* r = PROJ + (size_t)row * 2576 + 1040 + h * 128;
            a0[q] = o[lane]; a1[q] = o[64 + lane]; r0[q] = r[lane]; r1[q] = r[64 + lane]; }
#pragma unroll
        for (int q = 0; q < 8; ++q) { const int it = it0 + q; const int row = it >> 2, h = it & 3;
            const float rs = 1.f / sqrtf(wave_sum(a0[q] * a0[q] + a1[q] * a1[q], lane) * (1.f / 128.f) + 1e-5f);
            const float y0 = a0[q] * rs * g0 * (r0[q] * frcp(1.f + __expf(-r0[q]))), y1 = a1[q] * rs * g1 * (r1[q] * frcp(1.f + __expf(-r1[q])));
            if (it < nitems) { GAS bf16_t* d = XB + (size_t)row * 1024 + h * 128; d[lane] = (bf16_t)(pk_bf16(y0, 0.f) & 0xffffu); d[64 + lane] = (bf16_t)(pk_bf16(y1, 0.f) & 0xffffu); } }
    }
}

__device__ __forceinline__ float sigm(float x) { return frcp(1.f + __expf(-x)); }
__device__ __forceinline__ float softplusf(float x) { return fmaxf(x, 0.f) + log1pf(__expf(-fabsf(x))); }
__device__ __forceinline__ void rwkvprep_phase(const GAS float* __restrict__ w0, const GAS float* __restrict__ a0, const GAS float* __restrict__ v0, const GAS float* __restrict__ k_k, const GAS float* __restrict__ k_a, const GAS float* __restrict__ Vg,
                                               GAS float* K, GAS float* Wd, GAS float* Aa, GAS float* V, GAS float* NKK, GAS float* VFIRST, int has_vres, int nitems, int lane, int wave_gid, int nwaves) {
    for (int it0 = wave_gid * 4; it0 < nitems; it0 += nwaves * 4) {
        float kq[4], wq[4], aq[4], vq[4], gq[4], fq[4];
#pragma unroll
        for (int q = 0; q < 4; ++q) { const int it = it0 + q; const size_t ix = (size_t)(it >> 4) * 1024 + (it & 15) * 64 + lane; kq[q] = K[ix]; wq[q] = Wd[ix]; aq[q] = Aa[ix]; vq[q] = V[ix]; gq[q] = has_vres ? Vg[ix] : 0.f; fq[q] = has_vres ? VFIRST[ix] : 0.f; }
#pragma unroll
        for (int q = 0; q < 4; ++q) { const int it = it0 + q; const int h = it & 15; const size_t ix = (size_t)(it >> 4) * 1024 + h * 64 + lane; const int c = h * 64 + lane;
            const float k0 = kq[q]; const float kv = k0 * k_k[c]; const float inv = 1.f / fmaxf(sqrtf(wave_sum(kv * kv, lane)), 1e-12f);
            const float w = -softplusf(-(w0[c] + wq[q])) - 0.5f; const float dec = __expf(-__expf(w));
            const float a = sigm(a0[c] + aq[q]);
            float v = vq[q]; if (has_vres) v = v + (fq[q] - v) * sigm(v0[c] + gq[q]); else VFIRST[ix] = v;
            const float kk = kv * inv;
            NKK[ix] = -kk; K[ix] = k0 * (1.f + (a - 1.f) * k_a[c]); Wd[ix] = dec; Aa[ix] = kk * a; V[ix] = v; }
    }
}

__device__ __forceinline__ void rwkvpost_phase(const GAS float* __restrict__ Y, const GAS float* __restrict__ R, const GAS float* __restrict__ K2, const GAS float* __restrict__ V, const GAS float* __restrict__ G, const GAS float* __restrict__ r_k,
                                               const GAS float* __restrict__ lnx_g, const GAS float* __restrict__ lnx_b, GAS bf16_t* XB, int nitems, int lane, int wave_gid, int nwaves) {
    for (int it0 = wave_gid * 4; it0 < nitems; it0 += nwaves * 4) {
        float yq[4], rq[4], kq[4], vq[4], gq[4];
#pragma unroll
        for (int q = 0; q < 4; ++q) { const int it = it0 + q; const size_t ix = (size_t)(it >> 4) * 1024 + (it & 15) * 64 + lane; yq[q] = Y[ix]; rq[q] = R[ix]; kq[q] = K2[ix]; vq[q] = V[ix]; gq[q] = G[ix]; }
#pragma unroll
        for (int q = 0; q < 4; ++q) { const int it = it0 + q; const int h = it & 15; const size_t ix = (size_t)(it >> 4) * 1024 + h * 64 + lane; const int c = h * 64 + lane;
            const float y = yq[q]; const float mu = wave_sum(y, lane) * (1.f / 64.f); const float d = y - mu; const float rs = 1.f / sqrtf(wave_sum(d * d, lane) * (1.f / 64.f) + 64e-5f);
            const float bon = wave_sum(rq[q] * kq[q] * r_k[c], lane);
            const float o = (d * rs * lnx_g[c] + lnx_b[c] + bon * vq[q]) * gq[q];
            XB[ix] = (bf16_t)(pk_bf16(o, 0.f) & 0xffffu); }
    }
}

__device__ __forceinline__ void wkv_phase(const GAS float* __restrict__ R, const GAS float* __restrict__ Wd, const GAS float* __restrict__ K2, const GAS float* __restrict__ V, const GAS float* __restrict__ BB, const GAS float* __restrict__ NKK,
                                          const GAS float* __restrict__ SIN, GAS float* __restrict__ Y, GAS float* __restrict__ P, GAS float* __restrict__ SOUT, int B, int T, int DB, int DT, LAS unsigned char* lds, int tid, int bid, int nb) {
    constexpr int TB = 32, NLD = 6, VECB = TB * 1280, VVB = TB * 128, BUF = VECB + 2 * VVB;
    const int rowl = tid >> 4, part = tid & 15;
    const int nprompt = B * 32, nunits = nprompt + DB * 32;
    for (int u = bid; u < nunits; u += nb) {
        const bool smp = u >= nprompt; const int q0_ = smp ? u - nprompt : u; const int q = ((q0_ & 7) << 1 | ((q0_ >> 3) & 1)) + ((q0_ >> 4) << 4);
        const int half = q & 1, pair = q >> 1, sq = pair >> 4, h = pair & 15;
        const int Tu = smp ? DT : T; const int r0 = smp ? B * T + sq * DT : sq * T, vrow = half * 32 + rowl;
        f32x2 S01 = (f32x2){0.f, 0.f}, S23 = (f32x2){0.f, 0.f};
        if (smp) { const f32x4 s4 = *(const GAS f32x4*)(SIN + ((size_t)pair * 64 + vrow) * 64 + part * 4); S01 = (f32x2){s4.x, s4.y}; S23 = (f32x2){s4.z, s4.w};
                   asm volatile("" : "+v"(S01), "+v"(S23)); }
        const int nblk = (Tu + TB - 1) / TB;
        f32x4 ld[NLD];
        const size_t eo_ = (size_t)(r0 + (tid >> 4)) * 1024 + h * 64 + (tid & 15) * 4, ev_ = (size_t)(r0 + ((tid & 255) >> 3)) * 1024 + h * 64 + half * 32 + (tid & 7) * 4;
        const int lo_ = ((tid >> 4) * 320 + (tid & 15) * 4) * 4, lv_ = VECB + (tid & 255) * 16;
#define WKV_LOAD(tb0) do { const size_t bo_ = (size_t)(tb0) * 1024; ld[0] = *(const GAS f32x4*)(Wd + eo_ + bo_); ld[1] = *(const GAS f32x4*)(NKK + eo_ + bo_); ld[2] = *(const GAS f32x4*)(BB + eo_ + bo_); \
            ld[3] = *(const GAS f32x4*)(K2 + eo_ + bo_); ld[4] = *(const GAS f32x4*)(R + eo_ + bo_); ld[5] = *(const GAS f32x4*)(V + ev_ + bo_); } while (0)
#define WKV_STORE(bufp) do { _Pragma("unroll") for (int q_ = 0; q_ < 5; ++q_) *(LAS f32x4*)((bufp) + lo_ + q_ * 256) = ld[q_]; *(LAS f32x4*)((bufp) + lv_) = ld[5]; } while (0)
        WKV_LOAD(0); WKV_STORE(lds); __syncthreads();
        for (int b = 0; b < nblk; ++b) {
            LAS unsigned char* cur = lds + (b & 1) * BUF; LAS unsigned char* nxt = lds + ((b + 1) & 1) * BUF; const int tb0 = b * TB; const int nt = (Tu - tb0) < TB ? (Tu - tb0) : TB;
            if (b + 1 < nblk) WKV_LOAD(tb0 + TB);
            const LAS float* vec = (const LAS float*)cur + part * 4; const LAS float* vv = (const LAS float*)(cur + VECB) + rowl; LAS float* yb = (LAS float*)(cur + VECB + VVB);
            float ykeep0 = 0.f, ykeep1 = 0.f;
#define WKV_STEP(t, keep, tl) do { const LAS f32x2* vp_ = (const LAS f32x2*)(vec + (t) * 320); \
                const f32x2 w01 = vp_[0], w23 = vp_[1], n01 = vp_[32], n23 = vp_[33], b01 = vp_[64], b23 = vp_[65], k01 = vp_[96], k23 = vp_[97], r01 = vp_[128], r23 = vp_[129]; \
                const float v = vv[(t) * 32]; \
                const f32x2 sp = __builtin_elementwise_fma(S23, n23, S01 * n01); const float sa = row_sum16(sp.x + sp.y); const f32x2 sa2 = (f32x2){sa, sa}, v2 = (f32x2){v, v}; \
                S01 = __builtin_elementwise_fma(S01, w01, __builtin_elementwise_fma(b01, sa2, k01 * v2)); S23 = __builtin_elementwise_fma(S23, w23, __builtin_elementwise_fma(b23, sa2, k23 * v2)); \
                const f32x2 yp = __builtin_elementwise_fma(S23, r23, S01 * r01); const float y = row_sum16(yp.x + yp.y); \
                keep = (part == (tl)) ? y : keep; } while (0)
            if (nt == TB) {
#pragma unroll 1
                for (int t = 0; t < 16; t += 8) { WKV_STEP(t, ykeep0, t); WKV_STEP(t + 1, ykeep0, t + 1); WKV_STEP(t + 2, ykeep0, t + 2); WKV_STEP(t + 3, ykeep0, t + 3); WKV_STEP(t + 4, ykeep0, t + 4); WKV_STEP(t + 5, ykeep0, t + 5); WKV_STEP(t + 6, ykeep0, t + 6); WKV_STEP(t + 7, ykeep0, t + 7); }
#pragma unroll 1
                for (int t = 16; t < 32; t += 8) { WKV_STEP(t, ykeep1, t - 16); WKV_STEP(t + 1, ykeep1, t - 15); WKV_STEP(t + 2, ykeep1, t - 14); WKV_STEP(t + 3, ykeep1, t - 13); WKV_STEP(t + 4, ykeep1, t - 12); WKV_STEP(t + 5, ykeep1, t - 11); WKV_STEP(t + 6, ykeep1, t - 10); WKV_STEP(t + 7, ykeep1, t - 9); }
            } else { for (int t = 0; t < nt; ++t) { if (t < 16) WKV_STEP(t, ykeep0, t); else WKV_STEP(t, ykeep1, t - 16); } }
#undef WKV_STEP
            yb[part * 32 + rowl] = ykeep0; yb[(16 + part) * 32 + rowl] = ykeep1;
            if (b + 1 < nblk) WKV_STORE(nxt);
            __syncthreads();
            { const int rl = tid & 31; _Pragma("unroll") for (int t = tid >> 5; t < TB; t += 16) if (t < nt) Y[(size_t)(r0 + tb0 + t) * 1024 + h * 64 + half * 32 + rl] = yb[t * 32 + rl]; }
        }
#undef WKV_LOAD
#undef WKV_STORE
        *(GAS f32x4*)((smp ? SOUT : P) + ((size_t)pair * 64 + vrow) * 64 + part * 4) = (f32x4){S01.x, S01.y, S23.x, S23.y};
        __syncthreads();
    }
}

__device__ __forceinline__ void rwkvpost2_phase(const GAS float* __restrict__ Y, const GAS bf16_t* __restrict__ G, const GAS float* __restrict__ VF, const GAS float* __restrict__ BON, const GAS float* __restrict__ lnx_g, const GAS float* __restrict__ lnx_b,
                                                GAS bf16_t* XB, int nitems, int lane, int wave_gid, int nwaves) {
    const int nit4 = nitems >> 2, hg = wave_gid & 3, cofs = hg * 256 + 4 * lane; const f32x4 lg = *(const GAS f32x4*)(lnx_g + cofs), lb = *(const GAS f32x4*)(lnx_b + cofs);
    for (int it0 = wave_gid; it0 < nit4; it0 += nwaves * 4) {
        f32x4 yq[4], vq[4]; u32x2 gq[4]; float bq[4];
#pragma unroll
        for (int q = 0; q < 4; ++q) { int it = it0 + q * nwaves; it = it < nit4 ? it : it0; const int row = it >> 2; const size_t ix = (size_t)row * 1024 + cofs;
            yq[q] = *(const GAS f32x4*)(Y + ix); vq[q] = *(const GAS f32x4*)(VF + ix); gq[q] = *(const GAS u32x2*)(G + ix); bq[q] = BON[row * 16 + hg * 4 + (lane >> 4)]; }
#pragma unroll
        for (int q = 0; q < 4; ++q) { const int it = it0 + q * nwaves; const int row = it >> 2; const f32x4 y = yq[q];
            const float mu = row_sum16((y.x + y.y) + (y.z + y.w)) * (1.f / 64.f); const f32x4 d = y - mu; const float rs = __builtin_amdgcn_rsqf(row_sum16((d.x * d.x + d.y * d.y) + (d.z * d.z + d.w * d.w)) * (1.f / 64.f) + 64e-5f);
            const f32x4 gg = (f32x4){bflo(gq[q].x), bfhi(gq[q].x), bflo(gq[q].y), bfhi(gq[q].y)}; const f32x4 o = (d * rs * lg + lb + bq[q] * vq[q]) * gg;
            if (it < nit4) { u32x2 w_; w_.x = pk_bf16(o.x, o.y); w_.y = pk_bf16(o.z, o.w); *(GAS u32x2*)(XB + (size_t)row * 1024 + cofs) = w_; } }
    }
}

__device__ __forceinline__ void wkv2_phase(const GAS bf16_t* __restrict__ R, const GAS bf16_t* __restrict__ KR, const GAS bf16_t* __restrict__ WL, const GAS bf16_t* __restrict__ AL, const GAS bf16_t* __restrict__ V, const GAS bf16_t* __restrict__ VG,
                                           const GAS float* VFI, const GAS float* __restrict__ PRM, const GAS float* __restrict__ SIN, GAS float* __restrict__ Y, GAS float* __restrict__ P, GAS float* __restrict__ SOUT, GAS float* VFO, GAS float* __restrict__ BON,
                                           int has_vres, int B, int T, int DB, int DT, LAS unsigned char* lds, int tid, int bid, int nb) {
    constexpr int TB = 32, VECB = TB * 1280, VVB = TB * 128, BUF = VECB + 2 * VVB;
    const bool scanw = __builtin_amdgcn_readfirstlane(tid) < 256; const int pt = tid & 255;
    const int rowl = pt >> 4, part = pt & 15;
    const int nprompt = B * 32, nunits = nprompt + DB * 32;
    for (int u = bid; u < nunits; u += nb) {
        const bool smp = u >= nprompt; const int q0_ = smp ? u - nprompt : u; const int q = ((q0_ & 7) << 1 | ((q0_ >> 3) & 1)) + ((q0_ >> 4) << 4);
        const int half = q & 1, pair = q >> 1, sq = pair >> 4, h = pair & 15;
        const int Tu = smp ? DT : T; const int r0 = smp ? B * T + sq * DT : sq * T, vrow = half * 32 + rowl;
        const int srow = pt >> 3, sp8 = pt & 7;
        f32x2 S0 = (f32x2){0.f, 0.f}, S1 = (f32x2){0.f, 0.f}, S2 = (f32x2){0.f, 0.f}, S3 = (f32x2){0.f, 0.f};
        if (smp && scanw) { const GAS f32x4* sp_ = (const GAS f32x4*)(SIN + ((size_t)pair * 64 + half * 32 + srow) * 64 + sp8 * 8); const f32x4 sa4 = sp_[0], sb4 = sp_[1];
                   S0 = (f32x2){sa4.x, sa4.y}; S1 = (f32x2){sa4.z, sa4.w}; S2 = (f32x2){sb4.x, sb4.y}; S3 = (f32x2){sb4.z, sb4.w};
                   asm volatile("" : "+v"(S0), "+v"(S1), "+v"(S2), "+v"(S3)); }
        const int nblk = (Tu + TB - 1) / TB;
        u32x2 lk0, lw0, la0, lr0, lk1, lw1, la1, lr1, lv, lg = (u32x2){0u, 0u}; f32x4 lf = (f32x4){0.f, 0.f, 0.f, 0.f};
        const size_t eo_ = (size_t)(r0 + (pt >> 4)) * 1024 + h * 64 + part * 4, ev_ = (size_t)(r0 + (pt >> 3)) * 1024 + h * 64 + half * 32 + (pt & 7) * 4;
        const int lo_ = ((pt >> 4) * 320 + part * 4) * 4, lv_ = VECB + pt * 16;
        const int pc_ = h * 64 + part * 4; const f32x4 w0v = *(const GAS f32x4*)(PRM + pc_), a0v = *(const GAS f32x4*)(PRM + 1024 + pc_), kkp = *(const GAS f32x4*)(PRM + 3072 + pc_), kap = *(const GAS f32x4*)(PRM + 4096 + pc_), rkp = *(const GAS f32x4*)(PRM + 5120 + pc_);
        const f32x4 v0v = *(const GAS f32x4*)(PRM + 2048 + h * 64 + half * 32 + (pt & 7) * 4);
#define WKV_LOAD(tb0) do { const size_t bo_ = (size_t)(tb0) * 1024, b1_ = bo_ + 16 * 1024; lk0 = *(const GAS u32x2*)(KR + eo_ + bo_); lw0 = *(const GAS u32x2*)(WL + eo_ + bo_); la0 = *(const GAS u32x2*)(AL + eo_ + bo_); lr0 = *(const GAS u32x2*)(R + eo_ + bo_); \
            lk1 = *(const GAS u32x2*)(KR + eo_ + b1_); lw1 = *(const GAS u32x2*)(WL + eo_ + b1_); la1 = *(const GAS u32x2*)(AL + eo_ + b1_); lr1 = *(const GAS u32x2*)(R + eo_ + b1_); \
            lv = *(const GAS u32x2*)(V + ev_ + bo_); if (has_vres) { lg = *(const GAS u32x2*)(VG + ev_ + bo_); lf = *(const GAS f32x4*)(VFI + ev_ + bo_); } } while (0)
#define WKV_UNPK(w_) ((f32x4){bflo((w_).x), bfhi((w_).x), bflo((w_).y), bfhi((w_).y)})
#define WKV_ITEM(bufp, tb0, lk, lw, la, lr, ti_) do { const f32x4 k4 = WKV_UNPK(lk), wl4 = WKV_UNPK(lw), al4 = WKV_UNPK(la); const f32x4 kv = k4 * kkp; const float ss = row_sum16((kv.x * kv.x + kv.y * kv.y) + (kv.z * kv.z + kv.w * kv.w)); const float inv = frcp(fmaxf(fsqrt(ss), 1e-12f)); \
            f32x4 dec, a4; _Pragma("unroll") for (int i_ = 0; i_ < 4; ++i_) { dec[i_] = __expf(-0.6065306597126334f * frcp(1.f + __expf(-(w0v[i_] + wl4[i_])))); a4[i_] = frcp(1.f + __expf(-(a0v[i_] + al4[i_]))); } \
            const f32x4 kk = kv * inv; const f32x4 k2 = k4 * ((a4 - 1.f) * kap + 1.f); const f32x4 r4 = WKV_UNPK(lr); const f32x4 rk = r4 * k2 * rkp; const float bon = row_sum16((rk.x + rk.y) + (rk.z + rk.w)); \
            LAS unsigned char* d_ = (bufp) + lo_ + (ti_) * 1280; *(LAS f32x4*)(d_) = dec; *(LAS f32x4*)(d_ + 256) = -kk; *(LAS f32x4*)(d_ + 512) = kk * a4; *(LAS f32x4*)(d_ + 768) = k2; *(LAS f32x4*)(d_ + 1024) = r4; \
            const int tr_ = (tb0) + (pt >> 4) + (ti_); if (half == 0 && part == 0 && tr_ < Tu) BON[(size_t)(r0 + tr_) * 16 + h] = bon; } while (0)
#define WKV_STORE(bufp, tb0) do { WKV_ITEM(bufp, tb0, lk0, lw0, la0, lr0, 0); if ((tb0) + 16 < Tu) WKV_ITEM(bufp, tb0, lk1, lw1, la1, lr1, 16); \
            f32x4 v4 = WKV_UNPK(lv); if (has_vres) { const f32x4 g4 = WKV_UNPK(lg); _Pragma("unroll") for (int i_ = 0; i_ < 4; ++i_) v4[i_] = v4[i_] + (lf[i_] - v4[i_]) * frcp(1.f + __expf(-(v0v[i_] + g4[i_]))); } \
            *(LAS f32x4*)((bufp) + lv_) = v4; const int tv_ = (tb0) + (pt >> 3); if (tv_ < Tu) *(GAS f32x4*)(VFO + ev_ + (size_t)(tb0) * 1024) = v4; } while (0)
#define WKV_YOUT(bufp, tb0, ntp) do { const LAS float* yb_ = (const LAS float*)((bufp) + VECB + VVB); const int rl = pt & 31; _Pragma("unroll") for (int t = pt >> 5; t < TB; t += 8) if (t < (ntp)) Y[(size_t)(r0 + (tb0) + t) * 1024 + h * 64 + half * 32 + rl] = yb_[t * 32 + rl]; } while (0)
        if (!scanw) { WKV_LOAD(0); WKV_STORE(lds, 0); if (nblk > 1) WKV_LOAD(TB); }
        __syncthreads();
        for (int b = 0; b < nblk; ++b) {
            LAS unsigned char* cur = lds + (b & 1) * BUF; LAS unsigned char* nxt = lds + ((b + 1) & 1) * BUF; const int tb0 = b * TB; const int nt = (Tu - tb0) < TB ? (Tu - tb0) : TB;
            if (scanw) {
                const LAS float* vec = (const LAS float*)cur + sp8 * 8; const LAS float* vv = (const LAS float*)(cur + VECB) + srow; LAS float* yb = (LAS float*)(cur + VECB + VVB);
                LAS float* ybl = yb + srow;
                struct StepV { f32x4 w0, w1, n0, n1, b0, b1, k0, k1, r0, r1; float v; };
#define WKV_RD(dst, t) do { const LAS f32x4* vp_ = (const LAS f32x4*)(vec + (t) * 320); dst.w0 = vp_[0]; dst.w1 = vp_[1]; dst.n0 = vp_[16]; dst.n1 = vp_[17]; dst.b0 = vp_[32]; dst.b1 = vp_[33]; \
                dst.k0 = vp_[48]; dst.k1 = vp_[49]; dst.r0 = vp_[64]; dst.r1 = vp_[65]; dst.v = vv[(t) * 32]; } while (0)
#define WKV_LO(q_) ((f32x2){(q_).x, (q_).y})
#define WKV_HI(q_) ((f32x2){(q_).z, (q_).w})
#define WKV_UPD(S, w_, b_, k_) S = __builtin_elementwise_fma(S, w_, __builtin_elementwise_fma(b_, sa2, (k_) * v2))
#define WKV_CMP(src, t_) do { const f32x2 spa = __builtin_elementwise_fma(S1, WKV_HI(src.n0), S0 * WKV_LO(src.n0)), spb = __builtin_elementwise_fma(S3, WKV_HI(src.n1), S2 * WKV_LO(src.n1)); const f32x2 sp = spa + spb; \
                const float sa = row_sum8(sp.x + sp.y); const f32x2 sa2 = (f32x2){sa, sa}, v2 = (f32x2){src.v, src.v}; \
                WKV_UPD(S0, WKV_LO(src.w0), WKV_LO(src.b0), WKV_LO(src.k0)); WKV_UPD(S1, WKV_HI(src.w0), WKV_HI(src.b0), WKV_HI(src.k0)); WKV_UPD(S2, WKV_LO(src.w1), WKV_LO(src.b1), WKV_LO(src.k1)); WKV_UPD(S3, WKV_HI(src.w1), WKV_HI(src.b1), WKV_HI(src.k1)); \
                const f32x2 ypa = __builtin_elementwise_fma(S1, WKV_HI(src.r0), S0 * WKV_LO(src.r0)), ypb = __builtin_elementwise_fma(S3, WKV_HI(src.r1), S2 * WKV_LO(src.r1)); const f32x2 yp = ypa + ypb; \
                ybl[(t_) * 32] = row_sum8(yp.x + yp.y); } while (0)
#define WKV_ST(t_, cur_, nx2_) do { WKV_RD(nx2_, ((t_) + 2) & 31); __builtin_amdgcn_sched_barrier(0); WKV_CMP(cur_, t_); } while (0)
                if (nt == TB) {
                    StepV sA, sB, sC; WKV_RD(sA, 0); WKV_RD(sB, 1);
#pragma unroll 1
                    for (int t = 0; t < 30; t += 3) { WKV_ST(t, sA, sC); WKV_ST(t + 1, sB, sA); WKV_ST(t + 2, sC, sB); }
                    WKV_ST(30, sA, sC); WKV_ST(31, sB, sA);
                } else { StepV sA; for (int t = 0; t < nt; ++t) { WKV_RD(sA, t); WKV_CMP(sA, t); } }
#undef WKV_RD
#undef WKV_LO
#undef WKV_HI
#undef WKV_UPD
#undef WKV_CMP
#undef WKV_ST
            } else {
                if (b > 0) WKV_YOUT(nxt, tb0 - TB, TB);
                if (b + 1 < nblk) { WKV_STORE(nxt, tb0 + TB); if (b + 2 < nblk) WKV_LOAD(tb0 + 2 * TB); }
            }
            __syncthreads();
        }
        if (!scanw) { const int tbl = (nblk - 1) * TB; WKV_YOUT(lds + ((nblk - 1) & 1) * BUF, tbl, Tu - tbl); }
#undef WKV_LOAD
#undef WKV_STORE
#undef WKV_ITEM
#undef WKV_YOUT
#undef WKV_UNPK
        if (scanw) { GAS float* so = (smp ? SOUT : P) + ((size_t)pair * 64 + half * 32 + srow) * 64 + sp8 * 8; *(GAS f32x4*)so = (f32x4){S0.x, S0.y, S1.x, S1.y}; *(GAS f32x4*)(so + 4) = (f32x4){S2.x, S2.y, S3.x, S3.y}; }
        __syncthreads();
    }
}

__device__ __forceinline__ void gla_phase(const GAS float* __restrict__ PROJ, const GAS float* __restrict__ LOGA, GAS float* __restrict__ O, GAS float* __restrict__ P, int B, int T, LAS unsigned char* lds, int tid, int bid, int nb) {
    constexpr int TB = 32, OA = 0, OK = 8192, OQ = 16384, OV = 24576, BUF = 26624;
    const int wv = __builtin_amdgcn_readfirstlane(tid) >> 6; const bool scanw = wv < 4; const int pt = tid & 255, lane = tid & 63;
    const int col = pt >> 4, p = pt & 15, dk = p * 4;
    const int nunits = B * 32;
#define GLA_WAITV(n_) asm volatile("s_waitcnt vmcnt(" #n_ ")" ::: "memory")
#define GLA_BAR() do { asm volatile("s_waitcnt lgkmcnt(0)" ::: "memory"); __builtin_amdgcn_s_barrier(); asm volatile("" ::: "memory"); } while (0)
    for (int u = bid; u < nunits; u += nb) {
        const int ug_ = ((u & 7) << 3 | ((u >> 3) & 7)) + ((u >> 6) << 6);
        const int cb = ug_ & 7, pair = ug_ >> 3, s = pair >> 2, h = pair & 3; const int r0 = s * T;
        f32x2 S01 = (f32x2){0.f, 0.f}, S23 = (f32x2){0.f, 0.f};
        const int nblk = (T + TB - 1) / TB;
        const GAS unsigned char* gsrc; size_t gins, gblk; int ldst;
        if (wv == 4) { gsrc = (const GAS unsigned char*)(LOGA + (size_t)(r0 + (lane >> 4)) * 256 + h * 64 + (lane & 15) * 4); gins = (size_t)4 * 256 * 4; gblk = (size_t)TB * 256 * 4; ldst = OA; }
        else if (wv == 7) { gsrc = (const GAS unsigned char*)(PROJ + (size_t)(r0 + (lane >> 2)) * 2576 + 512 + h * 128 + cb * 16 + (lane & 3) * 4); gins = (size_t)16 * 2576 * 4; gblk = (size_t)TB * 2576 * 4; ldst = OV; }
        else { gsrc = (const GAS unsigned char*)(PROJ + (size_t)(r0 + (lane >> 4)) * 2576 + (wv == 5 ? 256 : 0) + h * 64 + (lane & 15) * 4); gins = (size_t)4 * 2576 * 4; gblk = (size_t)TB * 2576 * 4; ldst = wv == 5 ? OK : OQ; }
#define GLA_DMA(blk_) do { const GAS unsigned char* s_ = gsrc + (size_t)(blk_) * gblk; LAS unsigned char* d_ = lds + ((blk_) % 3) * BUF + ldst; \
            if (wv == 7) { __builtin_amdgcn_global_load_lds((const GAS unsigned*)s_, (LAS unsigned*)d_, 16, 0, 0); __builtin_amdgcn_global_load_lds((const GAS unsigned*)(s_ + gins), (LAS unsigned*)(d_ + 1024), 16, 0, 0); } \
            else { _Pragma("unroll") for (int i_ = 0; i_ < 8; ++i_) __builtin_amdgcn_global_load_lds((const GAS unsigned*)(s_ + i_ * gins), (LAS unsigned*)(d_ + i_ * 1024), 16, 0, 0); } } while (0)
        if (!scanw) { GLA_DMA(0); if (nblk > 1) { GLA_DMA(1); if (wv == 7) GLA_WAITV(2); else GLA_WAITV(8); } else GLA_WAITV(0); }
        GLA_BAR();
        for (int b = 0; b < nblk; ++b) {
            const int tb0 = b * TB; const int nt = (T - tb0) < TB ? (T - tb0) : TB;
            if (scanw) {
                const LAS unsigned char* cur = lds + (b % 3) * BUF; const LAS float* vec = (const LAS float*)cur + dk; const LAS float* vv = (const LAS float*)(cur + OV) + col;
                float okeep0 = 0.f, okeep1 = 0.f;
                struct G4 { f32x4 a[4], k[4], q[4]; float v[4]; };
#define GLA_RD4(dst, t0_) do { _Pragma("unroll") for (int i_ = 0; i_ < 4; ++i_) { const LAS float* vp_ = vec + ((t0_) + i_) * 64; dst.a[i_] = *(const LAS f32x4*)vp_; dst.k[i_] = *(const LAS f32x4*)(vp_ + OK / 4); dst.q[i_] = *(const LAS f32x4*)(vp_ + OQ / 4); dst.v[i_] = vv[((t0_) + i_) * 16]; } } while (0)
#define GLA_ONE(src, i_, keep, tl) do { const f32x4 a4 = src.a[i_], k4 = src.k[i_], q4 = src.q[i_]; const f32x2 v2 = (f32x2){src.v[i_], src.v[i_]}; \
                S01 = __builtin_elementwise_fma((f32x2){a4.x, a4.y}, S01, (f32x2){k4.x, k4.y} * v2); S23 = __builtin_elementwise_fma((f32x2){a4.z, a4.w}, S23, (f32x2){k4.z, k4.w} * v2); \
                const f32x2 o2 = __builtin_elementwise_fma((f32x2){q4.z, q4.w}, S23, (f32x2){q4.x, q4.y} * S01); const float o = row_sum16(o2.x + o2.y); keep = (p == (tl)) ? o : keep; } while (0)
#define GLA_CMP4(src, keep, tl0) do { GLA_ONE(src, 0, keep, tl0); GLA_ONE(src, 1, keep, (tl0) + 1); GLA_ONE(src, 2, keep, (tl0) + 2); GLA_ONE(src, 3, keep, (tl0) + 3); } while (0)
                if (nt == TB) {
                    G4 gA, gB; GLA_RD4(gA, 0);
                    GLA_RD4(gB, 4); __builtin_amdgcn_sched_barrier(0); GLA_CMP4(gA, okeep0, 0); GLA_RD4(gA, 8); __builtin_amdgcn_sched_barrier(0); GLA_CMP4(gB, okeep0, 4);
                    GLA_RD4(gB, 12); __builtin_amdgcn_sched_barrier(0); GLA_CMP4(gA, okeep0, 8); GLA_RD4(gA, 16); __builtin_amdgcn_sched_barrier(0); GLA_CMP4(gB, okeep0, 12);
                    GLA_RD4(gB, 20); __builtin_amdgcn_sched_barrier(0); GLA_CMP4(gA, okeep1, 0); GLA_RD4(gA, 24); __builtin_amdgcn_sched_barrier(0); GLA_CMP4(gB, okeep1, 4);
                    GLA_RD4(gB, 28); __builtin_amdgcn_sched_barrier(0); GLA_CMP4(gA, okeep1, 8); __builtin_amdgcn_sched_barrier(0); GLA_CMP4(gB, okeep1, 12);
                } else { G4 g1; for (int t = 0; t < nt; ++t) { const LAS float* vp_ = vec + t * 64; g1.a[0] = *(const LAS f32x4*)vp_; g1.k[0] = *(const LAS f32x4*)(vp_ + OK / 4); g1.q[0] = *(const LAS f32x4*)(vp_ + OQ / 4); g1.v[0] = vv[t * 16];
                    if (t < 16) GLA_ONE(g1, 0, okeep0, t); else GLA_ONE(g1, 0, okeep1, t - 16); } }
#undef GLA_RD4
#undef GLA_ONE
#undef GLA_CMP4
                { int pt_ = pt; asm volatile("" : "+v"(pt_)); const int p_ = pt_ & 15; GAS float* od = O + (size_t)(r0 + tb0 + p_) * 512 + h * 128 + cb * 16 + (pt_ >> 4);
                  if (p_ < nt) od[0] = okeep0 * 0.125f; if (16 + p_ < nt) od[(size_t)16 * 512] = okeep1 * 0.125f; }
            } else {
                if (b + 2 < nblk) { GLA_DMA(b + 2); if (wv == 7) GLA_WAITV(2); else GLA_WAITV(8); } else GLA_WAITV(0);
            }
            GLA_BAR();
        }
#undef GLA_DMA
        if (scanw) { int pt_ = pt; asm volatile("" : "+v"(pt_));
                     GAS float* so = P + ((size_t)pair * 64 + (pt_ & 15) * 4) * 128 + cb * 16 + (pt_ >> 4); so[0] = S01.x; so[128] = S01.y; so[256] = S23.x; so[384] = S23.y; }
        GLA_BAR();
    }
#undef GLA_WAITV
#undef GLA_BAR
}
__device__ __forceinline__ float grp8_sum(float v) { v += dppf<0xB1>(v); v += dppf<0x4E>(v); v += dppf<0x141>(v); return v; }
__device__ __forceinline__ float dot16_fp8_bf16(const u32x4 uw, const float (&x)[16]) { float s = 0.f;
#pragma unroll
    for (int d = 0; d < 4; ++d) { const f32x2 lo = fp8lo(uw[d]), hi = fp8hi(uw[d]); s = fmaf(lo.x, x[4 * d], s); s = fmaf(lo.y, x[4 * d + 1], s); s = fmaf(hi.x, x[4 * d + 2], s); s = fmaf(hi.y, x[4 * d + 3], s); }
    return s; }
typedef int i32x8 __attribute__((ext_vector_type(8)));
typedef unsigned u32x8 __attribute__((ext_vector_type(8)));
__device__ __forceinline__ void pacts_phase(const GAS unsigned char* XF8, const GAS unsigned char* U8S, const GAS int* EIDX, GAS bf16_t* __restrict__ PART, int M, int emask,
                                            LAS unsigned char* lds, int wid, int lane, int bid, int nb) {
    const bool spl = (nb & 7) == 0; const int s0 = spl ? (bid & 7) : 0, s1 = spl ? s0 + 1 : 8, r = spl ? (bid >> 3) : bid, nr = spl ? (nb >> 3) : nb;
    const int g = lane >> 3, c = lane & 7, fg = ((g >> 2) & 1) | (((g >> 1) & 1) << 2);
    const int m16 = lane & 15, kb = lane >> 4, fm = ((m16 >> 2) & 1) | (((m16 >> 1) & 1) << 2);
    LAS unsigned char* const wl = lds + wid * 16384;
    const LAS unsigned char* const ard = wl + m16 * 128 + (((2 * kb) ^ fm) * 16);
    const LAS unsigned char* const xrd = wl + 12288 + (m16 & 1) * 128 + kb * 32;
    const LAS unsigned char* const ird = wl + 13824 + g * 4;
    if (r >= M) return;
    const int ntok = (M - r + nr - 1) / nr;
#define PL_ROW(t_) ({ int rw_ = r + nr * (t_); rw_ < M ? rw_ : r; })
#define PL_IDS(t_, slot_) __builtin_amdgcn_global_load_lds((const GAS unsigned*)(isrc + (size_t)PL_ROW(t_) * 128), (LAS unsigned*)(wl + 13824 + (slot_) * 256), 4, 0, 0)
#define PL_RDIDS(slot_, e0_, e1_) do { e0_ = *(const LAS int*)(ird + (slot_) * 256); e1_ = *(const LAS int*)(ird + (slot_) * 256 + 32); } while (0)
#define PL_TILE(t_, slot_, e0_, e1_) do { \
        __builtin_amdgcn_global_load_lds((const GAS unsigned*)(tb + (size_t)((e0_) & emask) * 128), (LAS unsigned*)(wl + (slot_) * 2048), 16, 0, 0); \
        __builtin_amdgcn_global_load_lds((const GAS unsigned*)(tb + (size_t)((e1_) & emask) * 128), (LAS unsigned*)(wl + (slot_) * 2048 + 1024), 16, 0, 0); \
        __builtin_amdgcn_global_load_lds((const GAS unsigned*)(xsrc + (size_t)PL_ROW(t_) * 2048), (LAS unsigned*)(wl + 12288 + (slot_) * 256), 4, 0, 0); } while (0)
#define PL_RD(slot_, a0_, a1_, x0_, x1_) do { a0_ = *(const LAS u32x4*)(ard + (slot_) * 2048); a1_ = *(const LAS u32x4*)(ard2 + (slot_) * 2048); x0_ = *(const LAS u32x4*)(xrd + (slot_) * 256); x1_ = *(const LAS u32x4*)(xrd + (slot_) * 256 + 16); } while (0)
#define PL_MMA(cc_, a0_, a1_, x0_, x1_) do { const i32x8 av = (i32x8)__builtin_shufflevector(a0_, a1_, 0, 1, 2, 3, 4, 5, 6, 7), bv = (i32x8)__builtin_shufflevector(x0_, x1_, 0, 1, 2, 3, 4, 5, 6, 7); const f32x4 z = {0.f, 0.f, 0.f, 0.f}; \
        cc_ = __builtin_amdgcn_mfma_scale_f32_16x16x128_f8f6f4(av, bv, z, 0, 0, 0, 0, 0, 0); } while (0)
#define PL_OUT(t_, cc_) do { f32x4 o; _Pragma("unroll") for (int i = 0; i < 4; ++i) { float v = cc_[i]; v += dppf<0xB1>(v); o[i] = v * (1.f / 16.f); } \
        const int rw = r + nr * (t_); if (m16 == 0 && rw < M) { u32x2 w_; w_.x = pk_bf16(o[0], o[1]); w_.y = pk_bf16(o[2], o[3]); *(GAS u32x2*)(po + (size_t)rw * 128) = w_; } } while (0)
#define PL_WAIT(n_) asm volatile("s_waitcnt vmcnt(" #n_ ")" ::: "memory")
#define PL_STEP(j_, h_) do { PL_WAIT(12); u32x4 a0[3], a1[3], x0[3], x1[3]; int e0[3], e1[3]; f32x4 cc[3]; \
        _Pragma("unroll") for (int k = 0; k < 3; ++k) PL_RD((h_) * 3 + k, a0[k], a1[k], x0[k], x1[k]); \
        _Pragma("unroll") for (int k = 0; k < 3; ++k) PL_RDIDS((h_) * 3 + k, e0[k], e1[k]); \
        _Pragma("unroll") for (int k = 0; k < 3; ++k) PL_MMA(cc[k], a0[k], a1[k], x0[k], x1[k]); \
        _Pragma("unroll") for (int k = 0; k < 3; ++k) PL_TILE((j_) + 6 + k, (h_) * 3 + k, e0[k], e1[k]); \
        _Pragma("unroll") for (int k = 0; k < 3; ++k) PL_IDS((j_) + 12 + k, (h_) * 3 + k); \
        _Pragma("unroll") for (int k = 0; k < 3; ++k) PL_OUT((j_) + k, cc[k]); } while (0)
    const LAS unsigned char* const ard2 = (const LAS unsigned char*)((unsigned)(size_t)ard ^ 16u);
    for (int s = s0; s < s1; ++s) {
        const GAS unsigned char* tb = U8S + (size_t)s * 16384 * 128 + ((c ^ fg) * 16);
        const GAS unsigned char* xsrc = XF8 + (size_t)(lane >> 5) * 1024 + s * 128 + (lane & 31) * 4;
        const GAS int* isrc = EIDX + wid * 16 + m16;
        GAS bf16_t* po = PART + (size_t)s * M * 128 + wid * 16 + kb * 4;
        PL_IDS(0, 0); PL_IDS(1, 1); PL_IDS(2, 2); PL_IDS(3, 3); PL_IDS(4, 4); PL_IDS(5, 5); PL_WAIT(0);
        { int e0[6], e1[6];
#pragma unroll
          for (int k = 0; k < 6; ++k) PL_RDIDS(k, e0[k], e1[k]);
#pragma unroll
          for (int k = 0; k < 3; ++k) PL_TILE(k, k, e0[k], e1[k]);
#pragma unroll
          for (int k = 0; k < 3; ++k) PL_IDS(6 + k, k);
#pragma unroll
          for (int k = 3; k < 6; ++k) PL_TILE(k, k, e0[k], e1[k]);
#pragma unroll
          for (int k = 3; k < 6; ++k) PL_IDS(6 + k, k); }
        for (int j = 0; j < ntok; j += 6) { PL_STEP(j, 0); PL_STEP(j + 3, 1); }
        PL_WAIT(0);
    }
#undef PL_ROW
#undef PL_IDS
#undef PL_RDIDS
#undef PL_TILE
#undef PL_RD
#undef PL_MMA
#undef PL_OUT
#undef PL_WAIT
#undef PL_STEP
}
__device__ __forceinline__ void pouts_phase(const GAS float* __restrict__ COEF, const GAS int* __restrict__ EIDX, const GAS unsigned char* V8S, GAS bf16_t* __restrict__ YBUF, int M,
                                            int wid, int lane, int bid, int nb) {
    const bool spl = (nb & 7) == 0; const int s0 = spl ? (bid & 7) : 0, s1 = spl ? s0 + 1 : 8, r = spl ? (bid >> 3) : bid, nr = spl ? (nb >> 3) : nb;
    const int g = lane >> 3, ch = lane & 7, rstep = nr * 8;
#define PO_LOADCE(rw, c0, c1, v0, v1) do { c0 = COEF[(size_t)(rw) * 128 + lane] * (1.f / 64.f); c1 = COEF[(size_t)(rw) * 128 + 64 + lane] * (1.f / 64.f); v0 = EIDX[(size_t)(rw) * 128 + lane]; v1 = EIDX[(size_t)(rw) * 128 + 64 + lane]; } while (0)
#define PO_GATHER(vv_, vreg) do { _Pragma("unroll") for (int k = 0; k < 8; ++k) { const int e = __builtin_amdgcn_ds_bpermute((8 * k + g) << 2, vreg); vv_[k] = *(const GAS u32x4*)(tb + (size_t)(e & 16383) * 128); } } while (0)
#define PO_COMP(vv_, creg) do { _Pragma("unroll") for (int k = 0; k < 8; ++k) { const float c = __int_as_float(__builtin_amdgcn_ds_bpermute((8 * k + g) << 2, __float_as_int(creg))); const u32x4 w = vv_[k]; \
        const f32x2 c2 = (f32x2){c, c}; _Pragma("unroll") for (int d = 0; d < 4; ++d) { ac2[2 * d] = __builtin_elementwise_fma(c2, fp8lo(w[d]), ac2[2 * d]); ac2[2 * d + 1] = __builtin_elementwise_fma(c2, fp8hi(w[d]), ac2[2 * d + 1]); } \
        _Pragma("unroll") for (int i = 0; i < 8; ++i) asm volatile("" : "+v"(ac2[i])); } } while (0)
    for (int s = s0; s < s1; ++s) {
        const GAS unsigned char* tb = V8S + (size_t)s * 16384 * 128 + ch * 16;
        int row = r + nr * wid; if (row >= M) continue;
        float c0c, c1c, c0n = 0.f, c1n = 0.f; int v0c, v1c, v0n = 0, v1n = 0;
        PO_LOADCE(row, c0c, c1c, v0c, v1c);
        u32x4 va[8], vb[8];
        PO_GATHER(va, v0c);
        for (;;) {
            const int rown = row + rstep; const bool hasn = rown < M;
            PO_GATHER(vb, v1c);
            if (hasn) PO_LOADCE(rown, c0n, c1n, v0n, v1n);
            f32x2 ac2[8];
#pragma unroll
            for (int i = 0; i < 8; ++i) ac2[i] = (f32x2){0.f, 0.f};
            PO_COMP(va, c0c);
            if (hasn) PO_GATHER(va, v0n);
            PO_COMP(vb, c1c);
            float acc[16];
#pragma unroll
            for (int i = 0; i < 8; ++i) { acc[2 * i] = ac2[i].x; acc[2 * i + 1] = ac2[i].y; }
#pragma unroll
            for (int i = 0; i < 16; ++i) acc[i] += dppf<0x128>(acc[i]);
#pragma unroll
            for (int i = 0; i < 8; ++i) { const bool hi = lane & 16; const float send = hi ? acc[i] : acc[i + 8], keep = hi ? acc[i + 8] : acc[i]; acc[i] = keep + shx(send, 16, lane); }
#pragma unroll
            for (int i = 0; i < 4; ++i) { const bool hi = lane & 32; const float send = hi ? acc[i] : acc[i + 4], keep = hi ? acc[i + 4] : acc[i]; acc[i] = keep + shx(send, 32, lane); }
            if ((lane & 8) == 0) { u32x2 w_; w_.x = pk_bf16(acc[0], acc[1]); w_.y = pk_bf16(acc[2], acc[3]); *(GAS u32x2*)(YBUF + (size_t)row * 1024 + s * 128 + ch * 16 + ((lane >> 4) & 1) * 8 + ((lane >> 5) & 1) * 4) = w_; }
            if (!hasn) break;
            row = rown; c0c = c0n; c1c = c1n; v0c = v0n; v1c = v1n;
        }
    }
#undef PO_LOADCE
#undef PO_GATHER
#undef PO_COMP
}
}

template <class T> __device__ __forceinline__ __attribute__((address_space(1))) T* gp(T* p) { return (__attribute__((address_space(1))) T*)uni_ptr(p); }
constexpr int MK_THREADS = 512, LDS_BYTES = 163840, LDSCTL_OFF = 131072, TAB_OFF = LDSCTL_OFF + 1024, MAX_OPS = 208;
static_assert(TAB_OFF + MAX_OPS * (int)sizeof(Op) <= LDS_BYTES, "LDS map");
constexpr int MPAD = 17152;
constexpr size_t CTL_BYTES = (size_t)1 << 20;
struct MArgs { const float* in[47]; float* out; char* ws; unsigned long long ws_size; };
__global__ void __launch_bounds__(MK_THREADS, 2) mega_fwd(MArgs a) {
    extern __shared__ __attribute__((aligned(16))) unsigned char lds[];
    volatile LAS unsigned* ctl = (volatile LAS unsigned*)((LAS unsigned char*)lds + LDSCTL_OFF);
    if (threadIdx.x < 64) ctl[threadIdx.x] = 0u;
    __syncthreads();
    (void)xcd_barrier_post((unsigned*)a.ws, ctl + 8);
    const Dm dm = make_dm(1024, 8, 2048, 128, 4);
    Op* tab = (Op*)(lds + TAB_OFF);
    if (threadIdx.x == 0) {
        const float* const* inp_ = (const float* const*)__builtin_amdgcn_kernarg_segment_ptr(); asm volatile("" : "+s"(inp_));
        NvIO io; io.in = inp_; io.out = a.out; io.ws = a.ws + CTL_BYTES; io.ws_size = a.ws_size - CTL_BYTES;
        int n = 0;
        #ifdef PROBE_DUPCODE
        nv_forward(io, dm, [&](const Op& o) __attribute__((always_inline)) { if (n < MAX_OPS) tab[n] = o; ++n; if ((o.code & 0xff) == PROBE_DUPCODE) { if (n < MAX_OPS) tab[n] = o; ++n; } asm volatile("" ::: "memory"); });
#else
        nv_forward(io, dm, [&](const Op& o) __attribute__((always_inline)) { if (n < MAX_OPS) tab[n] = o; ++n; asm volatile("" ::: "memory"); });
#endif
        ctl[16] = (unsigned)(n <= MAX_OPS ? n : 0);
    }
    __syncthreads();
    const int nops = (int)ctl[16];
    for (int i = 0; i < nops; ++i) {
        int tid_ = (int)threadIdx.x, bid_ = (int)blockIdx.x, nb_ = (int)gridDim.x;
        asm volatile("" : "+v"(tid_)); asm volatile("" : "+s"(bid_)); asm volatile("" : "+s"(nb_));
        const long long g0 = (long long)bid_ * MK_THREADS + tid_, gs = (long long)nb_ * MK_THREADS;
        const Op& o = tab[i];
        const int rawc = __builtin_amdgcn_readfirstlane(o.code); const int code = rawc & 0xff; const long long n = o.n;
        switch (code) {
        case OP_FGEMM: {
            const int fl = rfl(o.i6);
            pg8::Gemm g{uni_ptr((const pg8::bf16_t*)o.a), uni_ptr((const pg8::bf16_t*)o.b), MPAD, rfl(o.i5), rfl(o.i1), rfl(o.i2), rfl(o.i3)};
            if (rawc & OPF_GROUP) {
                int ng = 1; while (ng < 8 && (rfl(tab[i + ng - 1].code) & OPF_GROUP)) ++ng;
                const PG8_LAS Op* gt = (const PG8_LAS Op*)((PG8_LAS unsigned char*)lds + TAB_OFF) + i;
                pg8::GroupOrder S; S.tab = gt; S.ng = ng; S.nM = MPAD / 256; S.G = nb_; S.c = bid_; S.tsA = (size_t)256 * g.lda * 2; S.tsB = (size_t)256 * g.ldb * 2;
                pg8::EpiGroup E{gt, dm.M};
                pg8::gemm_phase<pg8::EpiGroup, pg8::GroupOrder, true, true>((PG8_LAS unsigned char*)lds, g, S, E);
                i += ng - 1;
            } else {
            pg8::StaticOrder S; S.init(g, nb_, bid_); if (fl & 2) S.acs = 512;
            float* const c0 = uni_ptr(o.o0); const int ldc0 = rfl(o.i4), nreal0 = rfl(o.i0);
            if (fl & 1) { pg8::EpiBf16Plain E{(pg8::bf16_t*)c0, ldc0}; pg8::gemm_phase<pg8::EpiBf16Plain, pg8::StaticOrder, true, true>((PG8_LAS unsigned char*)lds, g, S, E); }
            else { pg8::EpiF32 E{c0, ldc0, dm.M, nreal0}; pg8::gemm_phase<pg8::EpiF32, pg8::StaticOrder, true, true>((PG8_LAS unsigned char*)lds, g, S, E); }
            }
        } break;
        case OP_LRUG2: {
            pg8::Gemm g{uni_ptr((const pg8::bf16_t*)o.a), uni_ptr((const pg8::bf16_t*)o.b), MPAD, 1024, 512, 512, 512};
            pg8::StaticOrder S; S.init(g, nb_, bid_);
            pg8::EpiLru E{uni_ptr(o.c), uni_ptr(o.d), uni_ptr(o.e), uni_ptr(o.f), uni_ptr(o.o0), uni_ptr(o.o1), dm.M};
            pg8::gemm_phase<pg8::EpiLru, pg8::StaticOrder, true, true>((PG8_LAS unsigned char*)lds, g, S, E);
        } break;
        case OP_WKVP: fk::wkv2_phase(gp((const fk::bf16_t*)o.a), gp((const fk::bf16_t*)o.b), gp((const fk::bf16_t*)o.c), gp((const fk::bf16_t*)o.d), gp((const fk::bf16_t*)o.e), gp((const fk::bf16_t*)o.f), gp(o.g), gp(o.h), gp((const float*)o.o5), gp(o.o0), gp(o.o1), gp(o.o2), gp(o.o3), gp(o.o4), rfl(o.i0), dm.B, dm.T, dm.DB, dm.DT, (LAS unsigned char*)lds, tid_, bid_, nb_); break;
        case OP_POST2: fk::rwkvpost2_phase(gp(o.a), gp((const fk::bf16_t*)o.b), gp(o.c), gp(o.d), gp(o.e), gp(o.f), gp((fk::bf16_t*)o.o0), dm.M * 16, tid_ & 63, bid_ * 8 + (tid_ >> 6), nb_ * 8); break;
        case OP_GLAF: fk::gla_phase(gp(o.a), gp(o.b), gp(o.o0), gp(o.o1), dm.B, dm.T, (LAS unsigned char*)lds, tid_, bid_, nb_); break;
        case OP_PACTS: fk::pacts_phase(gp((const unsigned char*)o.a), gp((const unsigned char*)o.b), gp((const int*)o.d), gp((fk::bf16_t*)o.o0), dm.M, rfl(o.i0), (LAS unsigned char*)lds, rfl(tid_ >> 6), tid_ & 63, bid_, nb_); break;
        case OP_POUTS: fk::pouts_phase(gp(o.a), gp((const int*)o.b), gp((const unsigned char*)o.c), gp((fk::bf16_t*)o.o0), dm.M, tid_ >> 6, tid_ & 63, bid_, nb_); break;
        case OP_TOPK2: fk::topk_phase(gp((const fk::bf16_t*)o.a), gp((const fk::bf16_t*)o.b), gp(o.c), gp(o.o0), gp((int*)o.o1), dm.M * 8, (LAS unsigned char*)lds, tid_ >> 6, tid_ & 63, bid_ * 8 + (tid_ >> 6), nb_ * 8); break;
        case OP_LNRES: fk::lnres_phase(gp((const fk::bf16_t*)o.a), gp(o.b), gp(o.c), gp(o.o0), gp((fk::bf16_t*)o.o1), gp((unsigned char*)o.o2), dm.M, tid_ & 63, bid_ * 8 + (tid_ >> 6), nb_ * 8); break;
        case OP_GLANORM: fk::glanorm_phase(gp(o.a), gp(o.b), gp(o.c), gp((fk::bf16_t*)o.o0), dm.M * 4, tid_ & 63, bid_ * 8 + (tid_ >> 6), nb_ * 8); break;
#define NVC(c) case c: for (long long g = g0; g < n; g += gs) nv_elem(c, o, dm, g); break;
        NVC(OP_LOGA4) NVC(OP_CONVOUT) NVC(OP_SHIFTOUT) NVC(OP_EMBED4) NVC(OP_YOUT4) NVC(OP_MIX6) NVC(OP_CONV4) NVC(OP_CVT8) NVC(OP_WGATE)
        NVC(OP_WT) NVC(OP_CVTTAB8S) NVC(OP_PRED) NVC(OP_PRM) NVC(OP_KEYS) NVC(OP_GLA3) NVC(OP_LRU1) NVC(OP_LRU2) NVC(OP_LRU3)
#undef NVC
        default: break;
        }
        if (__builtin_amdgcn_readfirstlane(tab[i].code) & OPF_NOBAR) __syncthreads(); else { XcdBarrier bar; bar.bar = (unsigned*)a.ws; bar.x = xb_xcc_id(); bar.st = ctl + 8; xcd_barrier(bar); }
    }
}
extern "C" void kernel_launch(void* const* d_in, const int* in_sizes, int n_in, void* d_out, int out_size, void* d_ws, size_t ws_size, hipStream_t stream) {
    static int grid = 0;
    if (grid == 0) {
        if (n_in != 47 || ws_size < ((size_t)900 << 20)) { fprintf(stderr, "kernel_launch: expected 47 inputs and >= 900 MiB of workspace; got %d, %zu\n", n_in, ws_size); grid = -1; return; }
        int dev = 0, cus = 0, per_cu = 0;
        if (hipGetDevice(&dev) != hipSuccess || hipDeviceGetAttribute(&cus, hipDeviceAttributeMultiprocessorCount, dev) != hipSuccess) { grid = -1; return; }
        if (hipFuncSetAttribute((const void*)mega_fwd, hipFuncAttributeMaxDynamicSharedMemorySize, LDS_BYTES) != hipSuccess) { fprintf(stderr, "kernel_launch: hipFuncSetAttribute failed\n"); grid = -1; return; }
        if (hipOccupancyMaxActiveBlocksPerMultiprocessor(&per_cu, (const void*)mega_fwd, MK_THREADS, LDS_BYTES) != hipSuccess || per_cu < 1) fprintf(stderr, "kernel_launch: occupancy query says %d per CU\n", per_cu);
        (void)hipGetLastError();
        grid = cus;
    }
    if (grid < 0) return;
    if (hipMemsetAsync(d_ws, 0, CTL_BYTES, stream) != hipSuccess) { fprintf(stderr, "kernel_launch: memset failed\n"); return; }
    MArgs a{}; for (int i = 0; i < 47; ++i) a.in[i] = (const float*)d_in[i]; a.out = (float*)d_out; a.ws = (char*)d_ws; a.ws_size = (unsigned long long)ws_size;
    hipLaunchKernelGGL(mega_fwd, dim3(grid), dim3(MK_THREADS), LDS_BYTES, stream, a);
}
```

```cpp
#include <hip/hip_runtime.h>
#include <cstdio>
#include <cmath>
#ifndef HD
#define HD __host__ __device__ __forceinline__
#endif
struct Dm { int D, B, T, DB, DT, M, NSEQ, RH; };
HD Dm make_dm(int D, int B, int SEQ, int DB, int DT) { Dm d; d.D = D; d.B = B; d.T = SEQ + 16; d.DB = DB; d.DT = DT; d.M = B * d.T + DB * DT; d.NSEQ = B + DB; d.RH = D / 64; return d; }
HD int seq_row0(const Dm& d, int s) { return s < d.B ? s * d.T : d.B * d.T + (s - d.B) * d.DT; }
HD int seq_len(const Dm& d, int s) { return s < d.B ? d.T : d.DT; }
HD void row_to_seq(const Dm& d, int row, int& s, int& t) { if (row < d.B * d.T) { s = row / d.T; t = row % d.T; } else { int r = row - d.B * d.T; s = d.B + r / d.DT; t = r % d.DT; } }

constexpr int MIXIN = 2576, C_Q = 0, C_K = 256, C_V = 512, C_GLR = 1024, C_R = 1040, C_XB = 1552, C_GB = 2064;

enum { OP_EMBED = 1, OP_GEMM, OP_LOGA, OP_GLA, OP_GLANORM, OP_CONV, OP_CONVOUT, OP_LRUG, OP_LRUSCAN, OP_LNRES, OP_MIX, OP_SHIFTOUT,
       OP_RWKVPREP, OP_WKV, OP_RWKVPOST, OP_QNORM, OP_SCORES, OP_TOPK, OP_PACT1, OP_PACT2, OP_POUT, OP_YOUT, OP_WT, OP_CVT, OP_FGEMM, OP_CVTTAB, OP_KEYS, OP_TOPK2, OP_PACT, OP_POUTLN, OP_GLA1, OP_GLA2, OP_GLA3, OP_LRU1, OP_LRU2, OP_LRU3, OP_EMBED4, OP_YOUT4, OP_MIX8, OP_CONV4, OP_CVT8, OP_WGATE, OP_LRUG2, OP_WKVF, OP_GLAF, OP_CVTTAB8, OP_CVTTAB8S, OP_PACTS, OP_PRED, OP_POUTS, OP_MIX6, OP_PRM, OP_WKVP, OP_POST2, OP_LOGA4 };

constexpr int OPF_NOBAR = 0x100, OPF_GROUP = 0x200;
struct Op {
    const float *a, *b, *c, *d, *e, *f, *g, *h;
    float *o0, *o1, *o2, *o3, *o4, *o5;
    long long n;
    int code, i0, i1, i2, i3, i4, i5, i6;
};

#if defined(__HIP_DEVICE_COMPILE__)
#define NV_UNI(x) __builtin_amdgcn_readfirstlane(x)
#define NV_LAUNDER(p) asm volatile("" : "+s"(p))
#define NV_FENCE() asm volatile("" ::: "memory")
#else
#define NV_FENCE() do {} while (0)
#define NV_UNI(x) (x)
#define NV_LAUNDER(p) do {} while (0)
#endif
typedef unsigned short nvbf;
HD nvbf nv_f2bf(float f) { unsigned u; __builtin_memcpy(&u, &f, 4); return (nvbf)((u + 0x7fffu + ((u >> 16) & 1u)) >> 16); }
HD float nv_bf2f(nvbf h) { unsigned u = (unsigned)h << 16; float f; __builtin_memcpy(&f, &u, 4); return f; }
HD unsigned nv_f2e4m3(float f) {
    unsigned u; __builtin_memcpy(&u, &f, 4); const unsigned sign = (u >> 24) & 0x80u; const float a = fabsf(f);
    if (!(a < 448.f)) return sign | 0x7Eu;
    if (a < 0.015625f) return sign | (unsigned)rintf(a * 512.f);
    unsigned au = u & 0x7fffffffu; au += 0x7ffffu + ((au >> 20) & 1u);
    const unsigned e = ((au >> 23) & 0xffu) - 120u, m = (au >> 20) & 7u; unsigned code = (e << 3) | m; if (code > 0x7Eu) code = 0x7Eu;
    return sign | code; }
HD float nv_e4m32f(unsigned c) { const unsigned e = (c >> 3) & 15u, m = c & 7u; const float v = e ? ldexpf(1.f + m * 0.125f, (int)e - 7) : m * 0.001953125f; return (c & 0x80u) ? -v : v; }
HD int nv_rup(int x, int m) { return (x + m - 1) / m * m; }
struct alignas(16) NvF4 { float x, y, z, w; };
struct alignas(16) NvU4 { unsigned x, y, z, w; };
struct alignas(8) NvU2 { unsigned x, y; };
#if defined(__HIP_DEVICE_COMPILE__)
#define NV_EXP(x) __expf(x)
#define NV_TANH(x) (1.f - 2.f * __builtin_amdgcn_rcpf(1.f + __expf(2.f * (x))))
HD float nv_sigmoid(float x) { return __builtin_amdgcn_rcpf(1.f + __expf(-x)); }
HD float nv_softplus(float x) { return fmaxf(x, 0.f) + __logf(1.f + __expf(-fabsf(x))); }
HD float nv_gelu(float x) { return x * __builtin_amdgcn_rcpf(1.f + __expf(-1.5957691216057308f * (x + 0.044715f * x * x * x))); }
#else
#define NV_EXP(x) expf(x)
#define NV_TANH(x) tanhf(x)
HD float nv_sigmoid(float x) { return 1.f / (1.f + expf(-x)); }
HD float nv_softplus(float x) { return fmaxf(x, 0.f) + log1pf(expf(-fabsf(x))); }
HD float nv_gelu(float x) { return 0.5f * x * (1.f + tanhf(0.7978845608028654f * (x + 0.044715f * x * x * x))); }
#endif

#define NV_INS16(tv, ti, val, idx) do { float _v = (val); int _i = (idx); _Pragma("unroll") for (int _j = 0; _j < 16; ++_j) { if (_v > tv[_j]) { float _tv = tv[_j]; int _ti = ti[_j]; tv[_j] = _v; ti[_j] = _i; _v = _tv; _i = _ti; } } } while (0)

HD void nv_elem(const int code, const Op& p, const Dm& dm, long long gid) {
    const int D = dm.D; float* const PO1 = p.o1; float* const PO2 = p.o2;
    switch (code) {
    case OP_EMBED: {
        int row = (int)(gid / D), c = (int)(gid % D); float v;
        if (row < dm.B * dm.T) { int bb = row / dm.T, t = row % dm.T; v = t < 16 ? p.c[t * D + c] : p.a[((size_t)bb * (dm.T - 16) + (t - 16)) * D + c]; }
        else v = p.b[(size_t)(row - dm.B * dm.T) * D + c];
        p.o0[gid] = v; ((nvbf*)p.o1)[gid] = nv_f2bf(v); } break;
    case OP_GEMM: {
        int N4 = p.i0 >> 2, K = p.i1; int m = (int)(gid / N4), nn = (int)(gid % N4) * 4; const float* A = p.a + (size_t)m * p.i2; const float* Bw = p.b + nn; float c0 = 0.f, c1 = 0.f, c2 = 0.f, c3 = 0.f;
        for (int k = 0; k < K; ++k) { float av = A[k]; if (p.i5 == 1) av = NV_TANH(av); else if (p.i5 == 2) av = nv_sigmoid(av); const NvF4 bv = *(const NvF4*)(Bw + (size_t)k * p.i3);
            c0 = fmaf(av, bv.x, c0); c1 = fmaf(av, bv.y, c1); c2 = fmaf(av, bv.z, c2); c3 = fmaf(av, bv.w, c3); }
        float* C = p.o0 + (size_t)m * p.i4 + nn; C[0] = c0; C[1] = c1; C[2] = c2; C[3] = c3; } break;
    case OP_LOGA: {
        int row = (int)(gid / 256), c = (int)(gid % 256); float z = p.c[c];
        for (int r = 0; r < 16; ++r) z = fmaf(p.a[(size_t)row * MIXIN + C_GLR + r], p.b[r * 256 + c], z);
        p.o0[gid] = NV_EXP(-nv_softplus(-z) * (1.f / 16.f)); } break;
    case OP_GLAF:
    case OP_GLA: {
        int s = (int)(gid / 512), h = (int)((gid / 128) % 4), col = (int)(gid % 128);
        float S[64];
        const float* sin = (s < dm.B) ? nullptr : p.c + (((size_t)(s - dm.B) * 4 + h) * 64) * 128 + col;
#pragma unroll
        for (int k = 0; k < 64; ++k) S[k] = sin ? sin[(size_t)k * 128] : 0.f;
        int r0 = seq_row0(dm, s), L = seq_len(dm, s);
        for (int t = 0; t < L; ++t) {
            const float* pr = p.a + (size_t)(r0 + t) * MIXIN; const float* la = p.b + (size_t)(r0 + t) * 256 + h * 64;
            float v = pr[C_V + h * 128 + col], o = 0.f;
#pragma unroll
            for (int k = 0; k < 64; ++k) { if ((k & 7) == 0) NV_FENCE(); S[k] = fmaf(la[k], S[k], pr[C_K + h * 64 + k] * v); o = fmaf(pr[C_Q + h * 64 + k] * 0.125f, S[k], o); }
            p.o0[(size_t)(r0 + t) * 512 + h * 128 + col] = o;
        }
        float* so = (s < dm.B) ? PO1 + (((size_t)s * 4 + h) * 64) * 128 + col : PO2 + (((size_t)(s - dm.B) * 4 + h) * 64) * 128 + col;
#pragma unroll
        for (int k = 0; k < 64; ++k) so[(size_t)k * 128] = S[k]; } break;
    case OP_GLA1: {
        const int NC = p.i0; const int u = NV_UNI((int)(gid / 128)), col = (int)(gid % 128); const int s = u / (4 * NC), h = (u / NC) % 4, c = u % NC;
        const int r0 = seq_row0(dm, s) + c * 64; int L = dm.T - c * 64; L = L > 64 ? 64 : L;
        float S[64];
#pragma unroll
        for (int k = 0; k < 64; ++k) S[k] = 0.f;
        float dprod = 1.f;
        for (int t = 0; t < L; ++t) {
            const float* pr = p.a + (size_t)(r0 + t) * MIXIN; const float* la = p.b + (size_t)(r0 + t) * 256 + h * 64; const float v = pr[C_V + h * 128 + col];
            if (col < 64) dprod *= la[col];
#pragma unroll
            for (int k = 0; k < 64; ++k) { if ((k & 7) == 0) NV_FENCE(); S[k] = fmaf(la[k], S[k], pr[C_K + h * 64 + k] * v); }
        }
        float* so = p.o0 + (size_t)u * 8192 + col;
#pragma unroll
        for (int k = 0; k < 64; ++k) so[(size_t)k * 128] = S[k];
        if (col < 64) p.o1[(size_t)u * 64 + col] = dprod; } break;
    case OP_GLA2: {
        const int NC = p.i0; const int pair = (int)(gid / 8192), e = (int)(gid % 8192), dk = e / 128; float S = 0.f;
        for (int c = 0; c < NC; ++c) { const size_t ix = ((size_t)pair * NC + c) * 8192 + e; const float l = p.o0[ix]; p.o0[ix] = S; S = fmaf(p.a[((size_t)pair * NC + c) * 64 + dk], S, l); }
        p.o1[gid] = S; } break;
    case OP_GLA3: {
        const int NC = p.i0; const int NP = dm.B * 4 * NC; const int u = NV_UNI((int)(gid / 128)) + (p.i1 ? NP : 0), col = (int)(gid % 128); int s, h, r0, L; const float* sin; float* sout = nullptr;
        if (u < NP) { s = u / (4 * NC); h = (u / NC) % 4; const int c = u % NC; r0 = seq_row0(dm, s) + c * 64; L = dm.T - c * 64; L = L > 64 ? 64 : L; sin = p.d + (size_t)u * 8192 + col; }
        else { const int q = u - NP; s = dm.B + q / 4; h = q % 4; r0 = seq_row0(dm, s); L = dm.DT; sin = p.c + (((size_t)(s - dm.B) * 4 + h) * 64) * 128 + col; sout = p.o2 + (((size_t)(s - dm.B) * 4 + h) * 64) * 128 + col; }
        float S[64];
#pragma unroll
        for (int k = 0; k < 64; ++k) S[k] = sin[(size_t)k * 128];
        for (int t = 0; t < L; ++t) {
            const float* pr = p.a + (size_t)(r0 + t) * MIXIN; const float* la = p.b + (size_t)(r0 + t) * 256 + h * 64; const float v = pr[C_V + h * 128 + col]; float o = 0.f;
#pragma unroll
            for (int k = 0; k < 64; ++k) { if ((k & 7) == 0) NV_FENCE(); S[k] = fmaf(la[k], S[k], pr[C_K + h * 64 + k] * v); o = fmaf(pr[C_Q + h * 64 + k] * 0.125f, S[k], o); }
            p.o0[(size_t)(r0 + t) * 512 + h * 128 + col] = o;
        }
        if (sout) {
#pragma unroll
            for (int k = 0; k < 64; ++k) sout[(size_t)k * 128] = S[k]; } } break;
    case OP_LRU1: {
        const int NC = p.i0; const int u = (int)(gid / 512), c = (int)(gid % 512); const int s = u / NC, ch = u % NC; const int r0 = seq_row0(dm, s) + ch * 64; int L = dm.T - ch * 64; L = L > 64 ? 64 : L; float hh = 0.f, ap = 1.f;
#pragma unroll 16
        for (int t = 0; t < L; ++t) { const size_t ix = (size_t)(r0 + t) * 512 + c; const float a = p.a[ix]; hh = fmaf(a, hh, p.b[ix]); ap *= a; }
        p.o0[gid] = ap; p.o1[gid] = hh; } break;
    case OP_LRU2: {
        const int NC = p.i0; const int s = (int)(gid / 512), c = (int)(gid % 512); float hh = 0.f;
#pragma unroll 8
        for (int ch = 0; ch < NC; ++ch) { const size_t ix = ((size_t)s * NC + ch) * 512 + c; const float l = p.o0[ix]; p.o0[ix] = hh; hh = fmaf(p.a[ix], hh, l); }
        p.o1[gid] = hh; } break;
    case OP_LRU3: {
        const int NC = p.i0; const int u = (int)(gid / 512), c = (int)(gid % 512); const int NP = dm.B * NC; int r0, L; float hh; float* hout = nullptr;
        if (u < NP) { const int s = u / NC, ch = u % NC; r0 = seq_row0(dm, s) + ch * 64; L = dm.T - ch * 64; L = L > 64 ? 64 : L; hh = 0.f;
            for (int k0 = 0; k0 < ch; k0 += 16) { float la[16], lb[16];
#pragma unroll
                for (int k = 0; k < 16; ++k) { int kk = k0 + k; kk = kk < ch ? kk : ch - 1; const size_t ix = ((size_t)s * NC + kk) * 512 + c; la[k] = p.f[ix]; lb[k] = p.e[ix]; }
#pragma unroll
                for (int k = 0; k < 16; ++k) if (k0 + k < ch) hh = fmaf(la[k], hh, lb[k]); }
            if (ch == NC - 1) hout = p.o1 + (size_t)s * 512 + c; }
        else { const int q = u - NP; r0 = seq_row0(dm, dm.B + q); L = dm.DT; hh = p.d[(size_t)q * 512 + c]; hout = p.o2 + (size_t)q * 512 + c; }
        for (int t0 = 0; t0 < L; t0 += 16) {
            float av[16], bv[16], gv[16];
#pragma unroll
            for (int k = 0; k < 16; ++k) { int t = t0 + k; t = t < L ? t : L - 1; const size_t r = (size_t)(r0 + t); av[k] = p.a[r * 512 + c]; bv[k] = p.b[r * 512 + c]; gv[k] = p.c[r * MIXIN + C_GB + c]; }
#pragma unroll
            for (int k = 0; k < 16; ++k) if (t0 + k < L) { const size_t r = (size_t)(r0 + t0 + k); hh = fmaf(av[k], hh, bv[k]); ((nvbf*)p.o0)[r * 1024 + 512 + c] = nv_f2bf(hh * nv_gelu(gv[k])); } }
        if (hout) *hout = hh; } break;
    case OP_EMBED4: {
        const int D4 = D / 4; const int row = (int)(gid / D4), c = (int)(gid % D4) * 4; const float* src;
        if (row < dm.B * dm.T) { const int bb = row / dm.T, t = row % dm.T; src = t < 16 ? p.c + (size_t)t * D + c : p.a + ((size_t)bb * (dm.T - 16) + (t - 16)) * D + c; } else src = p.b + (size_t)(row - dm.B * dm.T) * D + c;
        const NvF4 v = *(const NvF4*)src; NvU2 w; w.x = nv_f2bf(v.x) | ((unsigned)nv_f2bf(v.y) << 16); w.y = nv_f2bf(v.z) | ((unsigned)nv_f2bf(v.w) << 16); *(NvU2*)((nvbf*)p.o1 + (size_t)row * D + c) = w; } break;
    case OP_YOUT4: {
        const int D4 = D / 4; const int row = (int)(gid / D4), c = (int)(gid % D4) * 4; const NvU2 w_ = *(const NvU2*)((const nvbf*)p.a + (size_t)row * D + c); NvF4 v; v.x = nv_bf2f((nvbf)(w_.x & 0xffffu)); v.y = nv_bf2f((nvbf)(w_.x >> 16)); v.z = nv_bf2f((nvbf)(w_.y & 0xffffu)); v.w = nv_bf2f((nvbf)(w_.y >> 16));
        if (row < dm.B * dm.T) { const int bb = row / dm.T, t = row % dm.T; if (t >= 16) *(NvF4*)(p.o0 + ((size_t)bb * (dm.T - 16) + (t - 16)) * D + c) = v; }
        else *(NvF4*)(p.o0 + ((size_t)dm.B * (dm.T - 16) + (row - dm.B * dm.T)) * D + c) = v; } break;
    case OP_MIX8: {
        const int D8 = D / 8; const int row = (int)(gid / D8), c = (int)(gid % D8) * 8; int s, t; row_to_seq(dm, row, s, t); const float* x = p.a + (size_t)row * D + c; float xp[8];
        if (t > 0) { for (int i = 0; i < 8; ++i) xp[i] = x[i - D]; } else if (s < dm.B) { for (int i = 0; i < 8; ++i) xp[i] = 0.f; } else { for (int i = 0; i < 8; ++i) xp[i] = p.b[(size_t)(s - dm.B) * D + c + i]; }
        unsigned w[4];
#pragma unroll
        for (int i = 0; i < 4; ++i) { const float lo = x[2 * i] + (xp[2 * i] - x[2 * i]) * p.c[c + 2 * i], hi = x[2 * i + 1] + (xp[2 * i + 1] - x[2 * i + 1]) * p.c[c + 2 * i + 1]; w[i] = nv_f2bf(lo) | ((unsigned)nv_f2bf(hi) << 16); }
        NvU4 o; o.x = w[0]; o.y = w[1]; o.z = w[2]; o.w = w[3]; *(NvU4*)((nvbf*)p.o0 + (size_t)row * D + c) = o; } break;
    case OP_MIX6: {
        const int D8 = D / 8, Q = (dm.M + 3) / 4; const int row0 = (int)(gid / D8), c = (int)(gid % D8) * 8; NvU4 xw[4], pw[4]; NvF4 sh0[4], sh1[4]; int kind[4];
#pragma unroll
        for (int q = 0; q < 4; ++q) { int row = row0 + q * Q; row = row < dm.M ? row : row0; int s, t; row_to_seq(dm, row, s, t); const nvbf* x = (const nvbf*)p.a + (size_t)row * D + c;
            kind[q] = t > 0 ? 0 : (s < dm.B ? 1 : 2); xw[q] = *(const NvU4*)x; pw[q] = *(const NvU4*)(x - (t > 0 ? D : 0));
            const float* sp = p.b + (size_t)(s >= dm.B ? s - dm.B : 0) * D + c; sh0[q] = *(const NvF4*)sp; sh1[q] = *(const NvF4*)(sp + 4); }
        NvF4 mu0[6], mu1[6];
#pragma unroll
        for (int m = 0; m < 6; ++m) { mu0[m] = *(const NvF4*)(p.c + (size_t)m * D + c); mu1[m] = *(const NvF4*)(p.c + (size_t)m * D + c + 4); }
#pragma unroll
        for (int q = 0; q < 4; ++q) { const int row = row0 + q * Q; if (row < dm.M) { float xv[8], dx[8]; const unsigned xs[4] = {xw[q].x, xw[q].y, xw[q].z, xw[q].w}, ps[4] = {pw[q].x, pw[q].y, pw[q].z, pw[q].w};
            const float shv[8] = {sh0[q].x, sh0[q].y, sh0[q].z, sh0[q].w, sh1[q].x, sh1[q].y, sh1[q].z, sh1[q].w};
#pragma unroll
            for (int i = 0; i < 4; ++i) { xv[2 * i] = nv_bf2f((nvbf)(xs[i] & 0xffffu)); xv[2 * i + 1] = nv_bf2f((nvbf)(xs[i] >> 16)); const float p0 = nv_bf2f((nvbf)(ps[i] & 0xffffu)), p1 = nv_bf2f((nvbf)(ps[i] >> 16));
                const float q0 = kind[q] == 0 ? p0 : (kind[q] == 1 ? 0.f : shv[2 * i]), q1 = kind[q] == 0 ? p1 : (kind[q] == 1 ? 0.f : shv[2 * i + 1]); dx[2 * i] = q0 - xv[2 * i]; dx[2 * i + 1] = q1 - xv[2 * i + 1]; }
#pragma unroll
            for (int m = 0; m < 6; ++m) { const float mv[8] = {mu0[m].x, mu0[m].y, mu0[m].z, mu0[m].w, mu1[m].x, mu1[m].y, mu1[m].z, mu1[m].w}; unsigned w[4];
#pragma unroll
                for (int i = 0; i < 4; ++i) w[i] = nv_f2bf(xv[2 * i] + dx[2 * i] * mv[2 * i]) | ((unsigned)nv_f2bf(xv[2 * i + 1] + dx[2 * i + 1] * mv[2 * i + 1]) << 16);
                NvU4 o; o.x = w[0]; o.y = w[1]; o.z = w[2]; o.w = w[3]; *(NvU4*)((nvbf*)p.o0 + (size_t)m * (size_t)p.i1 * 1024 + (size_t)row * D + c) = o; } } } } break;
    case OP_CONV4: {
        const int Q = (dm.M + 3) / 4; const int row0 = (int)(gid / 128), c = (int)(gid % 128) * 4; const NvF4 bias = *(const NvF4*)(p.d + c); NvF4 wt[4]; for (int i = 0; i < 4; ++i) wt[i] = *(const NvF4*)(p.c + i * 512 + c);
        NvF4 xv[4][4]; int ok[4];
#pragma unroll
        for (int q = 0; q < 4; ++q) { int row = row0 + q * Q; ok[q] = row < dm.M; row = ok[q] ? row : row0; int s, t; row_to_seq(dm, row, s, t);
#pragma unroll
            for (int i = 0; i < 4; ++i) { const int j = t + i; const int sb = s >= dm.B ? s - dm.B : 0, jb = j < 3 ? j : 0;
                const float* src = j >= 3 ? p.a + (size_t)(row - t + (j - 3)) * MIXIN + C_XB + c : p.b + ((size_t)sb * 3 + jb) * 512 + c; const float msk = (j >= 3 || s >= dm.B) ? 1.f : 0.f;
                const NvF4 v = *(const NvF4*)src; xv[q][i].x = v.x * msk; xv[q][i].y = v.y * msk; xv[q][i].z = v.z * msk; xv[q][i].w = v.w * msk; } }
#pragma unroll
        for (int q = 0; q < 4; ++q) if (ok[q]) { const int row = row0 + q * Q; NvF4 o = bias;
#pragma unroll
            for (int i = 0; i < 4; ++i) { o.x = fmaf(xv[q][i].x, wt[i].x, o.x); o.y = fmaf(xv[q][i].y, wt[i].y, o.y); o.z = fmaf(xv[q][i].z, wt[i].z, o.z); o.w = fmaf(xv[q][i].w, wt[i].w, o.w); }
            NvU2 w; w.x = nv_f2bf(o.x) | ((unsigned)nv_f2bf(o.y) << 16); w.y = nv_f2bf(o.z) | ((unsigned)nv_f2bf(o.w) << 16); *(NvU2*)((nvbf*)p.o1 + (size_t)row * 512 + c) = w; } } break;
    case OP_CVT8: {
        const int K8 = p.i2 / 8; const int row = (int)(gid / K8), k = (int)(gid % K8) * 8; unsigned w[4] = {0u, 0u, 0u, 0u};
        if (row < dm.M && k < p.i0) { const float* sp = p.a + (size_t)row * p.i1 + k;
#pragma unroll
            for (int i = 0; i < 4; ++i) { float lo = sp[2 * i], hi = sp[2 * i + 1]; if (p.i3 == 1) { lo = NV_TANH(lo); hi = NV_TANH(hi); } else if (p.i3 == 2) { lo = nv_sigmoid(lo); hi = nv_sigmoid(hi); } w[i] = nv_f2bf(lo) | ((unsigned)nv_f2bf(hi) << 16); } }
        NvU4 o; o.x = w[0]; o.y = w[1]; o.z = w[2]; o.w = w[3]; *(NvU4*)((nvbf*)p.o0 + (size_t)row * p.i2 + k) = o; } break;
    case OP_WGATE: {
        const int n = (int)gid, pn = n >> 8, within = n & 127, isx = (n >> 7) & 1, c = pn * 128 + within, nb = c >> 6, e = c & 63; const float* w = isx ? p.b : p.a; nvbf* dst = (nvbf*)p.o0 + (size_t)n * 512;
        for (int k = 0; k < 512; ++k) dst[k] = ((k >> 6) == nb) ? nv_f2bf(w[((size_t)nb * 64 + (k & 63)) * 64 + e]) : (nvbf)0;
        if (n < 512) p.o1[n] = -8.f * nv_softplus(-p.c[n]); } break;
    case OP_LRUG2: {
        const int row = (int)(gid / 512), c = (int)(gid % 512), pn = c >> 7, within = c & 127; const nvbf* x = (const nvbf*)p.a + (size_t)row * 512; const nvbf* wa_ = (const nvbf*)p.b + (size_t)(pn * 256 + within) * 512; const nvbf* wx_ = wa_ + (size_t)128 * 512; float ga = 0.f, gx = 0.f;
        for (int k = 0; k < 512; ++k) { const float xv = nv_bf2f(x[k]); ga = fmaf(xv, nv_bf2f(wa_[k]), ga); gx = fmaf(xv, nv_bf2f(wx_[k]), gx); }
        const float gate_a = nv_sigmoid(ga + p.c[c]), gate_x = nv_sigmoid(gx + p.d[c]); const float log_at = gate_a * p.e[c];
        p.o0[gid] = NV_EXP(log_at); p.o1[gid] = sqrtf(-expm1f(2.f * log_at)) * (gate_x * nv_bf2f(((const nvbf*)p.f)[gid])); } break;
    case OP_LOGA4: {
        const int row = (int)(gid / 64), c = (int)(gid % 64) * 4; const float* gl = p.a + (size_t)row * MIXIN + C_GLR; NvF4 z = *(const NvF4*)(p.c + c);
#pragma unroll
        for (int r4 = 0; r4 < 4; ++r4) { const NvF4 g = *(const NvF4*)(gl + 4 * r4);
            const NvF4 w0 = *(const NvF4*)(p.b + (4 * r4 + 0) * 256 + c), w1 = *(const NvF4*)(p.b + (4 * r4 + 1) * 256 + c), w2 = *(const NvF4*)(p.b + (4 * r4 + 2) * 256 + c), w3 = *(const NvF4*)(p.b + (4 * r4 + 3) * 256 + c);
            z.x = fmaf(g.x, w0.x, z.x); z.y = fmaf(g.x, w0.y, z.y); z.z = fmaf(g.x, w0.z, z.z); z.w = fmaf(g.x, w0.w, z.w); z.x = fmaf(g.y, w1.x, z.x); z.y = fmaf(g.y, w1.y, z.y); z.z = fmaf(g.y, w1.z, z.z); z.w = fmaf(g.y, w1.w, z.w);
            z.x = fmaf(g.z, w2.x, z.x); z.y = fmaf(g.z, w2.y, z.y); z.z = fmaf(g.z, w2.z, z.z); z.w = fmaf(g.z, w2.w, z.w); z.x = fmaf(g.w, w3.x, z.x); z.y = fmaf(g.w, w3.y, z.y); z.z = fmaf(g.w, w3.z, z.z); z.w = fmaf(g.w, w3.w, z.w); }
        NvF4 o; o.x = NV_EXP(-nv_softplus(-z.x) * (1.f / 16.f)); o.y = NV_EXP(-nv_softplus(-z.y) * (1.f / 16.f)); o.z = NV_EXP(-nv_softplus(-z.z) * (1.f / 16.f)); o.w = NV_EXP(-nv_softplus(-z.w) * (1.f / 16.f));
        *(NvF4*)(p.o0 + (size_t)row * 256 + c) = o; } break;
    case OP_GLANORM: {
        int row = (int)(gid / 4), h = (int)(gid % 4); const float* o = p.a + (size_t)row * 512 + h * 128; float ss = 0.f;
        for (int c = 0; c < 128; ++c) ss = fmaf(o[c], o[c], ss);
        float rs = 1.f / sqrtf(ss * (1.f / 128.f) + 1e-5f);
        for (int c = 0; c < 128; ++c) { float r = p.b[(size_t)row * MIXIN + C_R + h * 128 + c]; ((nvbf*)p.o0)[(size_t)row * 1024 + h * 128 + c] = nv_f2bf(o[c] * rs * p.c[c] * (r * nv_sigmoid(r))); } } break;
    case OP_CONV: {
        int row = (int)(gid / 512), c = (int)(gid % 512); int s, t; row_to_seq(dm, row, s, t); float acc = p.d[c];
        for (int i = 0; i < 4; ++i) { int j = t + i; float xv;
            if (j < 3) xv = (s < dm.B) ? 0.f : p.b[((size_t)(s - dm.B) * 3 + j) * 512 + c]; else xv = p.a[(size_t)(row - t + (j - 3)) * MIXIN + C_XB + c];
            acc = fmaf(xv, p.c[i * 512 + c], acc); }
        p.o0[gid] = acc; } break;
    case OP_CONVOUT: {
        int s = (int)(gid / 1536), i = (int)((gid / 512) % 3), c = (int)(gid % 512); int L = seq_len(dm, s), r0 = seq_row0(dm, s); int j = L + i; float xv;
        if (j < 3) xv = (s < dm.B) ? 0.f : p.b[((size_t)(s - dm.B) * 3 + j) * 512 + c]; else xv = p.a[(size_t)(r0 + j - 3) * MIXIN + C_XB + c];
        float* o = (s < dm.B) ? PO1 + ((size_t)s * 3 + i) * 512 + c : PO2 + ((size_t)(s - dm.B) * 3 + i) * 512 + c; *o = xv; } break;
    case OP_LRUG: {
        int row = (int)(gid / 512), c = (int)(gid % 512), nb = c / 64, e = c % 64; const float* x = p.a + (size_t)row * 512 + nb * 64; float ga = p.c[c], gx = p.e[c];
        for (int dd = 0; dd < 64; ++dd) { ga = fmaf(x[dd], p.b[((size_t)nb * 64 + dd) * 64 + e], ga); gx = fmaf(x[dd], p.d[((size_t)nb * 64 + dd) * 64 + e], gx); }
        float gate_a = nv_sigmoid(ga), gate_x = nv_sigmoid(gx); float log_at = -8.f * gate_a * nv_softplus(-p.f[c]);
        p.o0[gid] = NV_EXP(log_at); p.o1[gid] = sqrtf(-expm1f(2.f * log_at)) * (gate_x * p.a[(size_t)row * 512 + c]); } break;
    case OP_LRUSCAN: {
        int s = (int)(gid / 512), c = (int)(gid % 512); int r0 = seq_row0(dm, s), L = seq_len(dm, s); float hh = (s < dm.B) ? 0.f : p.d[(size_t)(s - dm.B) * 512 + c];
        for (int t = 0; t < L; ++t) { size_t r = (size_t)(r0 + t); hh = fmaf(p.a[r * 512 + c], hh, p.b[r * 512 + c]); p.o0[r * 1024 + 512 + c] = hh * nv_gelu(p.c[r * MIXIN + C_GB + c]); }
        float* o = (s < dm.B) ? PO1 + (size_t)s * 512 + c : PO2 + (size_t)(s - dm.B) * 512 + c; *o = hh; } break;
    case OP_LNRES: {
        const float alpha = 1.6817928305074292f; nvbf* x = (nvbf*)p.o1 + (size_t)gid * D; const nvbf* y = (const nvbf*)p.a + (size_t)gid * D; float mu = 0.f;
        for (int c = 0; c < D; ++c) mu += alpha * nv_bf2f(x[c]) + nv_bf2f(y[c]);
        mu /= D; float var = 0.f;
        for (int c = 0; c < D; ++c) { float v = alpha * nv_bf2f(x[c]) + nv_bf2f(y[c]) - mu; var = fmaf(v, v, var); }
        float rs = 1.f / sqrtf(var / D + 1e-5f);
        for (int c = 0; c < D; ++c) { const float o = (alpha * nv_bf2f(x[c]) + nv_bf2f(y[c]) - mu) * rs * p.b[c] + p.c[c]; x[c] = nv_f2bf(o);
            if (p.o2) { unsigned char* f8 = (unsigned char*)p.o2 + (size_t)gid * 2 * D; const float xs = fminf(fmaxf(o * 16.f, -448.f), 448.f); const unsigned hc = nv_f2e4m3(xs); f8[c] = (unsigned char)hc; f8[D + c] = (unsigned char)nv_f2e4m3(xs - nv_e4m32f(hc)); } } } break;
    case OP_MIX: {
        int row = (int)(gid / D), c = (int)(gid % D); int s, t; row_to_seq(dm, row, s, t); float x = p.a[gid];
        float xp = t > 0 ? p.a[gid - D] : ((s < dm.B) ? 0.f : p.b[(size_t)(s - dm.B) * D + c]);
        ((nvbf*)p.o0)[gid] = nv_f2bf(x + (xp - x) * p.c[c]); } break;
    case OP_SHIFTOUT: {
        int s = (int)(gid / D), c = (int)(gid % D); float v = nv_bf2f(((const nvbf*)p.a)[(size_t)(seq_row0(dm, s) + seq_len(dm, s) - 1) * D + c]);
        float* o = (s < dm.B) ? PO1 + (size_t)s * D + c : PO2 + (size_t)(s - dm.B) * D + c; *o = v; } break;
    case OP_RWKVPREP: {
        int row = (int)(gid / dm.RH), h = (int)(gid % dm.RH); size_t base = (size_t)row * D + h * 64; float ss = 0.f;
        for (int k = 0; k < 64; ++k) { float kv = p.o0[base + k] * p.d[h * 64 + k]; ss = fmaf(kv, kv, ss); }
        float inv = 1.f / fmaxf(sqrtf(ss), 1e-12f);
        for (int k = 0; k < 64; ++k) { int c = h * 64 + k; size_t ix = base + k;
            float w = -nv_softplus(-(p.a[c] + p.o1[ix])) - 0.5f; float dec = NV_EXP(-NV_EXP(w));
            float a = nv_sigmoid(p.b[c] + p.o2[ix]);
            float v = p.o3[ix]; if (p.i0) v = v + (p.o5[ix] - v) * nv_sigmoid(p.c[c] + p.f[ix]); else p.o5[ix] = v;
            float k0 = p.o0[ix]; const float kk = k0 * p.d[c] * inv; p.o4[ix] = -kk; p.o0[ix] = k0 * (1.f + (a - 1.f) * p.e[c]); p.o1[ix] = dec; p.o2[ix] = kk * a; p.o3[ix] = v; } } break;
    case OP_WKVF:
    case OP_WKV: {
        int RH = dm.RH; int s = p.i0 + (int)(gid / (RH * 64)), h = (int)((gid / 64) % RH), vr = (int)(gid % 64); float S[64];
        const float* sin = (s < dm.B) ? nullptr : p.g + (((size_t)(s - dm.B) * RH + h) * 64 + vr) * 64;
#pragma unroll
        for (int k = 0; k < 64; ++k) S[k] = sin ? sin[k] : 0.f;
        int r0 = seq_row0(dm, s), L = seq_len(dm, s);
        for (int t = 0; t < L; ++t) { size_t base = (size_t)(r0 + t) * D + h * 64; float sa = 0.f;
#pragma unroll
            for (int k = 0; k < 64; ++k) { if ((k & 7) == 0) NV_FENCE(); sa = fmaf(S[k], p.f[base + k], sa); }
            float vv = p.d[base + vr], y = 0.f;
#pragma unroll
            for (int k = 0; k < 64; ++k) { if ((k & 7) == 0) NV_FENCE(); S[k] = fmaf(S[k], p.b[base + k], fmaf(sa, p.e[base + k], vv * p.c[base + k])); y = fmaf(S[k], p.a[base + k], y); }
            p.o0[base + vr] = y; }
        float* so = (s < dm.B) ? PO1 + (((size_t)s * RH + h) * 64 + vr) * 64 : PO2 + (((size_t)(s - dm.B) * RH + h) * 64 + vr) * 64;
#pragma unroll
        for (int k = 0; k < 64; ++k) so[k] = S[k]; } break;
    case OP_RWKVPOST: {
        int row = (int)(gid / dm.RH), h = (int)(gid % dm.RH); size_t base = (size_t)row * D + h * 64; float mu = 0.f, bon = 0.f;
        for (int k = 0; k < 64; ++k) { mu += p.a[base + k]; bon = fmaf(p.b[base + k] * p.c[base + k], p.f[h * 64 + k], bon); }
        mu *= (1.f / 64.f); float var = 0.f;
        for (int k = 0; k < 64; ++k) { float dlt = p.a[base + k] - mu; var = fmaf(dlt, dlt, var); }
        float rs = 1.f / sqrtf(var * (1.f / 64.f) + 64e-5f);
        for (int k = 0; k < 64; ++k) { int c = h * 64 + k; float y = (p.a[base + k] - mu) * rs * p.g[c] + p.h[c] + bon * p.d[base + k]; ((nvbf*)p.o0)[base + k] = nv_f2bf(y * p.e[base + k]); } } break;
    case OP_PRM: {
        const int m = (int)(gid / D), c = (int)(gid % D); const float* src = m == 0 ? p.a : m == 1 ? p.b : m == 2 ? p.c : m == 3 ? p.d : m == 4 ? p.e : p.f; p.o0[gid] = src ? src[c] : 0.f; } break;
    case OP_WKVP: {
        const int RH = dm.RH; const int s = (int)(gid / (RH * 64)), h = (int)((gid / 64) % RH), vr = (int)(gid % 64); float S[64];
        const float* sin = (s < dm.B) ? nullptr : p.o5 + (((size_t)(s - dm.B) * RH + h) * 64 + vr) * 64;
        for (int k = 0; k < 64; ++k) S[k] = sin ? sin[k] : 0.f;
        const float* w0 = p.h + h * 64; const float* a0 = p.h + D + h * 64; const float* v0 = p.h + 2 * D + h * 64; const float* k_k = p.h + 3 * D + h * 64; const float* k_a = p.h + 4 * D + h * 64; const float* r_k = p.h + 5 * D + h * 64;
        const int r0 = seq_row0(dm, s), L = seq_len(dm, s); const nvbf* bR = (const nvbf*)p.a; const nvbf* bK = (const nvbf*)p.b; const nvbf* bWL = (const nvbf*)p.c; const nvbf* bAL = (const nvbf*)p.d; const nvbf* bV = (const nvbf*)p.e; const nvbf* bVG = (const nvbf*)p.f;
        for (int t = 0; t < L; ++t) { const size_t base = (size_t)(r0 + t) * D + h * 64; float ss = 0.f;
            for (int k = 0; k < 64; ++k) { const float kv = nv_bf2f(bK[base + k]) * k_k[k]; ss = fmaf(kv, kv, ss); }
            const float inv = 1.f / fmaxf(sqrtf(ss), 1e-12f);
            float vv = nv_bf2f(bV[base + vr]); if (p.i0) vv = vv + (nv_bf2f(((const nvbf*)p.g)[base + vr]) - vv) * nv_sigmoid(v0[vr] + nv_bf2f(bVG[base + vr]));
            float sa = 0.f, bon = 0.f, dec[64], bb[64], k2[64];
            for (int k = 0; k < 64; ++k) { const float k0 = nv_bf2f(bK[base + k]); const float kk = k0 * k_k[k] * inv; const float a = nv_sigmoid(a0[k] + nv_bf2f(bAL[base + k]));
                dec[k] = NV_EXP(-0.6065306597126334f * nv_sigmoid(w0[k] + nv_bf2f(bWL[base + k])));
                bb[k] = kk * a; k2[k] = k0 * (1.f + (a - 1.f) * k_a[k]); sa = fmaf(S[k], -kk, sa); bon = fmaf(nv_bf2f(bR[base + k]) * k2[k], r_k[k], bon); }
            float y = 0.f;
            for (int k = 0; k < 64; ++k) { S[k] = fmaf(S[k], dec[k], fmaf(sa, bb[k], vv * k2[k])); y = fmaf(S[k], nv_bf2f(bR[base + k]), y); }
            ((nvbf*)p.o0)[base + vr] = nv_f2bf(y); ((nvbf*)p.o3)[base + vr] = nv_f2bf(vv); if (vr == 0) p.o4[(size_t)(r0 + t) * RH + h] = bon; }
        float* so = (s < dm.B) ? PO1 + (((size_t)s * RH + h) * 64 + vr) * 64 : PO2 + (((size_t)(s - dm.B) * RH + h) * 64 + vr) * 64;
        for (int k = 0; k < 64; ++k) so[k] = S[k]; } break;
    case OP_POST2: {
        const int row = (int)(gid / dm.RH), h = (int)(gid % dm.RH); const size_t base = (size_t)row * D + h * 64; const nvbf* ya = (const nvbf*)p.a; const nvbf* vf = (const nvbf*)p.c; float mu = 0.f;
        for (int k = 0; k < 64; ++k) mu += nv_bf2f(ya[base + k]);
        mu *= (1.f / 64.f); float var = 0.f;
        for (int k = 0; k < 64; ++k) { const float dlt = nv_bf2f(ya[base + k]) - mu; var = fmaf(dlt, dlt, var); }
        const float rs = 1.f / sqrtf(var * (1.f / 64.f) + 64e-5f), bon = p.d[gid];
        for (int k = 0; k < 64; ++k) { const int c = h * 64 + k; const float y = (nv_bf2f(ya[base + k]) - mu) * rs * p.e[c] + p.f[c] + bon * nv_bf2f(vf[base + k]); ((nvbf*)p.o0)[base + k] = nv_f2bf(y * nv_bf2f(((const nvbf*)p.b)[base + k])); } } break;
    case OP_QNORM: {
        float* q = p.o0 + (size_t)gid * 256; float mu = 0.f;
        for (int c = 0; c < 256; ++c) mu += q[c];
        mu *= (1.f / 256.f); float var = 0.f;
        for (int c = 0; c < 256; ++c) { float dlt = q[c] - mu; var = fmaf(dlt, dlt, var); }
        float rs = 1.f / sqrtf(var * (1.f / 256.f) + 1e-5f);
        for (int c = 0; c < 256; ++c) q[c] = (q[c] - mu) * rs; } break;
    case OP_SCORES: {
        int row = (int)(gid / 2048), r = (int)(gid % 2048), h = r / 256, half = (r / 128) & 1, key = r % 128;
        const float* q = p.a + (size_t)row * 2048 + h * 256 + half * 128; const float* kv = p.b + (((size_t)h * 2 + half) * 128 + key) * 128; float acc = 0.f;
        for (int dd = 0; dd < 128; ++dd) acc = fmaf(q[dd], kv[dd], acc);
        p.o0[gid] = acc; } break;
    case OP_TOPK: {
        const float* sc = p.a + (size_t)gid * 256; float tv[16]; int ti[16]; float* tmpv = p.o2 + (size_t)gid * 32; int* tmpi = (int*)p.o3 + (size_t)gid * 32;
        for (int half = 0; half < 2; ++half) {
#pragma unroll
            for (int j = 0; j < 16; ++j) { tv[j] = -3.0e38f; ti[j] = 0; }
            for (int k = 0; k < 128; ++k) NV_INS16(tv, ti, sc[half * 128 + k], k);
#pragma unroll
            for (int j = 0; j < 16; ++j) { tmpv[half * 16 + j] = tv[j]; tmpi[half * 16 + j] = ti[j]; }
        }
#pragma unroll
        for (int j = 0; j < 16; ++j) { tv[j] = -3.0e38f; ti[j] = 0; }
        for (int i = 0; i < 16; ++i) for (int j = 0; j < 16; ++j) NV_INS16(tv, ti, tmpv[i] + tmpv[16 + j], tmpi[i] * 128 + tmpi[16 + j]);
        float den = 0.f, ev[16];
#pragma unroll
        for (int j = 0; j < 16; ++j) { ev[j] = NV_EXP(tv[j] - tv[0]); den += ev[j]; }
        float inv = 1.f / den;
#pragma unroll
        for (int j = 0; j < 16; ++j) { p.o0[(size_t)gid * 16 + j] = ev[j] * inv; ((int*)p.o1)[(size_t)gid * 16 + j] = ti[j]; } } break;
    case OP_PACT1: {
        size_t pr = (size_t)(gid / 16); int part = (int)(gid % 16); int row = (int)(pr / 128); int e = ((const int*)p.d)[pr]; int w = D / 16;
        const float* u = p.b + (size_t)e * D + part * w; const float* x = p.a + (size_t)row * D + part * w; float acc = 0.f;
        for (int c = 0; c < w; ++c) acc = fmaf(u[c], x[c], acc);
        p.o0[gid] = acc; } break;
    case OP_PACT2: {
        float acc = 0.f; for (int i = 0; i < 16; ++i) acc += p.a[(size_t)gid * 16 + i];
        p.o0[gid] = p.c[gid] * nv_gelu(acc); } break;
    case OP_POUT: {
        int row = (int)(gid / D), c = (int)(gid % D); float acc = 0.f;
        for (int i = 0; i < 128; ++i) acc = fmaf(p.a[(size_t)row * 128 + i], p.c[(size_t)((const int*)p.b)[(size_t)row * 128 + i] * D + c], acc);
        p.o0[gid] = acc; } break;
    case OP_YOUT: {
        int row = (int)(gid / D), c = (int)(gid % D);
        if (row < dm.B * dm.T) { int bb = row / dm.T, t = row % dm.T; if (t >= 16) p.o0[((size_t)bb * (dm.T - 16) + (t - 16)) * D + c] = p.a[gid]; }
        else p.o0[((size_t)dm.B * (dm.T - 16) + (row - dm.B * dm.T)) * D + c] = p.a[gid]; } break;
    case OP_WT: {
        const int N = p.i0, K = p.i1, Np = p.i3, Kp = p.i4; const long long per8 = (long long)Np * (Kp / 8); const int bt = (int)(gid / per8); const long long r = gid % per8; const int k0 = (int)(r / Np) * 8, nn = (int)(r % Np);
        unsigned w[4];
#pragma unroll
        for (int i = 0; i < 4; ++i) { float lo = 0.f, hi = 0.f; if (nn < N) { if (k0 + 2 * i < K) lo = p.a[((size_t)bt * K + k0 + 2 * i) * p.i2 + nn]; if (k0 + 2 * i + 1 < K) hi = p.a[((size_t)bt * K + k0 + 2 * i + 1) * p.i2 + nn]; } w[i] = nv_f2bf(lo) | ((unsigned)nv_f2bf(hi) << 16); }
        NvU4 o; o.x = w[0]; o.y = w[1]; o.z = w[2]; o.w = w[3];
        *(NvU4*)((nvbf*)p.o0 + (size_t)bt * Np * Kp + (size_t)nn * Kp + k0) = o; } break;
    case OP_CVT: {
        const int Kp = p.i2; const int row = (int)(gid / Kp), k = (int)(gid % Kp); float v = 0.f;
        if (row < dm.M && k < p.i0) { v = p.a[(size_t)row * p.i1 + k]; if (p.i3 == 1) v = NV_TANH(v); else if (p.i3 == 2) v = nv_sigmoid(v); }
        ((nvbf*)p.o0)[gid] = nv_f2bf(v); } break;
    case OP_FGEMM: {
        const int N = p.i0; const int m = (int)(gid / N), nn = (int)(gid % N); const nvbf* A = (const nvbf*)p.a + (size_t)m * p.i2 + ((p.i6 & 2) ? (nn / 256) * 256 : 0); const nvbf* Bt = (const nvbf*)p.b + (size_t)nn * p.i3; float acc = 0.f;
        for (int k = 0; k < p.i1; ++k) acc = fmaf(nv_bf2f(A[k]), nv_bf2f(Bt[k]), acc);
        if (p.i6 & 1) ((nvbf*)p.o0)[(size_t)m * p.i4 + nn] = nv_f2bf(acc); else p.o0[(size_t)m * p.i4 + nn] = acc; } break;
    case OP_CVTTAB: {
        const NvF4 v0 = *(const NvF4*)(p.a + gid * 8), v1 = *(const NvF4*)(p.a + gid * 8 + 4); NvU4 o;
        o.x = nv_f2bf(v0.x) | ((unsigned)nv_f2bf(v0.y) << 16); o.y = nv_f2bf(v0.z) | ((unsigned)nv_f2bf(v0.w) << 16); o.z = nv_f2bf(v1.x) | ((unsigned)nv_f2bf(v1.y) << 16); o.w = nv_f2bf(v1.z) | ((unsigned)nv_f2bf(v1.w) << 16);
        *(NvU4*)((nvbf*)p.o0 + gid * 8) = o; } break;
    case OP_CVTTAB8: {
        const float sc = (float)(1 << p.i0); const float* sp = p.a + gid * 16; unsigned w[4];
#pragma unroll
        for (int q = 0; q < 4; ++q) { const NvF4 v = *(const NvF4*)(sp + 4 * q); w[q] = nv_f2e4m3(v.x * sc) | (nv_f2e4m3(v.y * sc) << 8) | (nv_f2e4m3(v.z * sc) << 16) | (nv_f2e4m3(v.w * sc) << 24); }
        NvU4 o; o.x = w[0]; o.y = w[1]; o.z = w[2]; o.w = w[3]; *(NvU4*)((unsigned char*)p.o0 + gid * 16) = o; } break;
    case OP_CVTTAB8S: {
        const float sc = (float)(1 << p.i0); const int per = D / 16; const int e = (int)(gid / per), c0 = (int)(gid % per) * 16; const float* sp = p.a + (size_t)e * D + c0; unsigned w[4];
#pragma unroll
        for (int q = 0; q < 4; ++q) { const NvF4 v = *(const NvF4*)(sp + 4 * q);
#if defined(__HIP_DEVICE_COMPILE__)
            int pk = __builtin_amdgcn_cvt_pk_fp8_f32(v.x * sc, v.y * sc, 0, false); pk = __builtin_amdgcn_cvt_pk_fp8_f32(v.z * sc, v.w * sc, pk, true); w[q] = (unsigned)pk;
#else
            w[q] = nv_f2e4m3(v.x * sc) | (nv_f2e4m3(v.y * sc) << 8) | (nv_f2e4m3(v.z * sc) << 16) | (nv_f2e4m3(v.w * sc) << 24);
#endif
        }
        NvU4 o; o.x = w[0]; o.y = w[1]; o.z = w[2]; o.w = w[3]; *(NvU4*)((unsigned char*)p.o0 + ((size_t)(c0 >> 7) * 16384 + e) * 128 + (c0 & 127)) = o; } break;
    case OP_PACTS: {
        const long long NP = (long long)dm.M * 128; const int sl = (int)(gid / NP); const long long pr = gid % NP; const int row = (int)(pr / 128); const int e = ((const int*)p.d)[pr] & p.i0;
        const unsigned char* u = (const unsigned char*)p.b + ((size_t)sl * 16384 + e) * 128; const unsigned char* x = (const unsigned char*)p.a + (size_t)row * 2 * D + sl * 128; float acc = 0.f;
        for (int c = 0; c < 128; ++c) acc = fmaf(nv_e4m32f(u[c]), nv_e4m32f(x[c]) + nv_e4m32f(x[D + c]), acc);
        ((nvbf*)p.o0)[gid] = nv_f2bf(acc * (1.f / 16.f)); } break;
    case OP_PRED: {
        const long long NP = (long long)dm.M * 128; const size_t e0 = (size_t)gid * 4; float a0 = 0.f, a1 = 0.f, a2 = 0.f, a3 = 0.f;
#pragma unroll 8
        for (int sl = 0; sl < p.i0; ++sl) { const NvU2 w = *(const NvU2*)((const nvbf*)p.a + (size_t)sl * NP + e0); a0 += nv_bf2f((nvbf)(w.x & 0xffffu)); a1 += nv_bf2f((nvbf)(w.x >> 16)); a2 += nv_bf2f((nvbf)(w.y & 0xffffu)); a3 += nv_bf2f((nvbf)(w.y >> 16)); }
        const NvF4 g = *(const NvF4*)(p.c + e0); NvF4 o; o.x = g.x * nv_gelu(a0 * (1.f / 128.f)); o.y = g.y * nv_gelu(a1 * (1.f / 128.f)); o.z = g.z * nv_gelu(a2 * (1.f / 128.f)); o.w = g.w * nv_gelu(a3 * (1.f / 128.f));
        *(NvF4*)(p.o0 + e0) = o; } break;
    case OP_POUTS: {
        const int row = (int)(gid / D), c = (int)(gid % D); const unsigned char* vb = (const unsigned char*)p.c + (size_t)(c >> 7) * 16384 * 128 + (c & 127); float acc = 0.f;
        for (int i = 0; i < 128; ++i) acc = fmaf(p.a[(size_t)row * 128 + i] * (1.f / 64.f), nv_e4m32f(vb[(size_t)((const int*)p.b)[(size_t)row * 128 + i] * 128]), acc);
        ((nvbf*)p.o0)[gid] = nv_f2bf(acc); } break;
    case OP_KEYS: {
        const int h = (int)(gid / 256), nrow = (int)(gid % 256), half = nrow >> 7; const float* src = p.a + (((size_t)h * 2 + half) * 128 + (nrow & 127)) * 128; nvbf* dst = (nvbf*)p.o0 + ((size_t)h * 256 + nrow) * 256; float ks = 0.f;
        for (int k = 0; k < 256; ++k) { nvbf b = 0; if ((k >> 7) == half) { b = nv_f2bf(src[k & 127]); ks += nv_bf2f(b); } dst[k] = b; }
        p.o1[gid] = ks; } break;
    case OP_TOPK2: {
        const int h = (int)(gid % 8); const nvbf* sc = (const nvbf*)p.a + (size_t)gid * 256; const nvbf* q = (const nvbf*)p.b + (size_t)gid * 256; const float* ksum = p.c + h * 256; float mu = 0.f;
        for (int c = 0; c < 256; ++c) mu += nv_bf2f(q[c]);
        mu *= (1.f / 256.f); float var = 0.f;
        for (int c = 0; c < 256; ++c) { float dlt = nv_bf2f(q[c]) - mu; var = fmaf(dlt, dlt, var); }
        const float rs = 1.f / sqrtf(var * (1.f / 256.f) + 1e-5f);
        float tv[16]; int ti[16]; float* tmpv = p.o2 + (size_t)gid * 32; int* tmpi = (int*)p.o3 + (size_t)gid * 32;
        for (int half = 0; half < 2; ++half) {
#pragma unroll
            for (int j = 0; j < 16; ++j) { tv[j] = -3.0e38f; ti[j] = 0; }
            for (int k = 0; k < 128; ++k) NV_INS16(tv, ti, rs * (nv_bf2f(sc[half * 128 + k]) - mu * ksum[half * 128 + k]), k);
#pragma unroll
            for (int j = 0; j < 16; ++j) { tmpv[half * 16 + j] = tv[j]; tmpi[half * 16 + j] = ti[j]; }
        }
#pragma unroll
        for (int j = 0; j < 16; ++j) { tv[j] = -3.0e38f; ti[j] = 0; }
        for (int i = 0; i < 16; ++i) for (int j = 0; j < 16; ++j) NV_INS16(tv, ti, tmpv[i] + tmpv[16 + j], tmpi[i] * 128 + tmpi[16 + j]);
        float den = 0.f, ev[16];
#pragma unroll
        for (int j = 0; j < 16; ++j) { ev[j] = NV_EXP(tv[j] - tv[0]); den += ev[j]; }
        float inv = 1.f / den;
#pragma unroll
        for (int j = 0; j < 16; ++j) { p.o0[(size_t)gid * 16 + j] = ev[j] * inv; ((int*)p.o1)[(size_t)gid * 16 + j] = ti[j]; } } break;
    case OP_PACT: {
        const int row = (int)(gid / 128); const int e = ((const int*)p.d)[gid]; const unsigned char* u = (const unsigned char*)p.b + (size_t)e * D; const nvbf* x = (const nvbf*)p.a + (size_t)row * D; float acc = 0.f;
        for (int c = 0; c < D; ++c) acc = fmaf(nv_e4m32f(u[c]), nv_bf2f(x[c]), acc);
        p.o0[gid] = p.c[gid] * nv_gelu(acc * (1.f / 128.f)); } break;
#if defined(HOST_TEST)
    case OP_POUTLN: {
        const float alpha = 1.6817928305074292f; float* x = p.o0 + (size_t)gid * D; std::vector<float> y(D, 0.f);
        for (int i = 0; i < 128; ++i) { const float cf = p.a[(size_t)gid * 128 + i] * (1.f / 64.f); const unsigned char* v = (const unsigned char*)p.c + (size_t)((const int*)p.b)[(size_t)gid * 128 + i] * D; for (int c = 0; c < D; ++c) y[c] = fmaf(cf, nv_e4m32f(v[c]), y[c]); }
        float mu = 0.f; for (int c = 0; c < D; ++c) { y[c] = alpha * x[c] + y[c]; mu += y[c]; }
        mu /= D; float var = 0.f; for (int c = 0; c < D; ++c) { float dlt = y[c] - mu; var = fmaf(dlt, dlt, var); }
        const float rs = 1.f / sqrtf(var / D + 1e-5f);
        for (int c = 0; c < D; ++c) { const float o = (y[c] - mu) * rs * p.d[c] + p.e[c]; x[c] = o; ((nvbf*)p.o1)[(size_t)gid * D + c] = nv_f2bf(o);
            if (p.o2) { unsigned char* f8 = (unsigned char*)p.o2 + (size_t)gid * 2 * D; const float xs = fminf(fmaxf(o * 16.f, -448.f), 448.f); const unsigned hc = nv_f2e4m3(xs); f8[c] = (unsigned char)hc; f8[D + c] = (unsigned char)nv_f2e4m3(xs - nv_e4m32f(hc)); } } } break;
#endif
    default: break;
    }
}

struct NvIO { const float* const* in; float* out; char* ws; size_t ws_size; };
template <class Launch> HD void nv_forward(const NvIO& io, const Dm& dm, Launch&& launch) {
    const int D = dm.D, M = dm.M, B = dm.B, DB = dm.DB, RH = dm.RH; const size_t MD = (size_t)M * D;
    float* y_prompt = io.out; float* y_sample = y_prompt + (size_t)B * (dm.T - 16) * D; float* p_gla = y_sample + (size_t)DB * dm.DT * D;
    float* p_h = p_gla + (size_t)2 * B * 4 * 64 * 128; float* p_conv = p_h + (size_t)2 * B * 512; float* p_rwkv = p_conv + (size_t)2 * B * 3 * 512;
    float* p_shift = p_rwkv + (size_t)2 * B * RH * 4096; float* s_gla = p_shift + (size_t)2 * B * D; float* s_h = s_gla + (size_t)2 * DB * 4 * 64 * 128;
    float* s_conv = s_h + (size_t)2 * DB * 512; float* s_rwkv = s_conv + (size_t)2 * DB * 3 * 512; float* s_shift = s_rwkv + (size_t)2 * DB * RH * 4096;
    float* w = (float*)io.ws; size_t off = 0; auto take = [&](size_t n) __attribute__((always_inline)) { float* r = w + off; off += (n + 63) & ~(size_t)63; return r; };
    float* X = take(MD > (size_t)nv_rup(M, 256) * 512 ? MD : (size_t)nv_rup(M, 256) * 512); float* VFIRST = take(MD); float* MOUT = take(MD);
    auto mk = [&](int code, long long n) __attribute__((always_inline)) { Op o{}; o.code = code; o.n = n; return o; };
    const int Mp = nv_rup(M, 256), Dp = nv_rup(D, 256), Dk = nv_rup(D, 128);
    auto takeh = [&](size_t n) __attribute__((always_inline)) { return (nvbf*)take((n + 1) / 2); };
    const size_t ABFN = (size_t)Mp * 1024 > (size_t)Mp * Dk ? (size_t)Mp * 1024 : (size_t)Mp * Dk; nvbf* ABF = takeh(ABFN + (size_t)Mp * D);
    const size_t SZ_WIN = (size_t)2816 * Dk, SZ_WOUT = (size_t)Dp * 1024, SZ_DD = (size_t)Dp * Dk, SZ_DN = (size_t)256 * Dk, SZ_UP = (size_t)Dp * 128, SZ_WQ = (size_t)2048 * Dk;
    nvbf* WT_WIN = takeh(2 * SZ_WIN); nvbf* WT_WOUT = takeh(2 * SZ_WOUT); nvbf* WT_WR = takeh(2 * SZ_DD); nvbf* WT_WK = takeh(2 * SZ_DD); nvbf* WT_WV = takeh(2 * SZ_DD); nvbf* WT_WO = takeh(2 * SZ_DD);
    nvbf* WT_W1 = takeh(2 * SZ_DN); nvbf* WT_W2 = takeh(2 * SZ_UP); nvbf* WT_A1 = takeh(2 * SZ_DN); nvbf* WT_A2 = takeh(2 * SZ_UP); nvbf* WT_G1 = takeh(2 * SZ_DN); nvbf* WT_G2 = takeh(2 * SZ_UP);
    nvbf* WT_V1 = takeh(SZ_DN); nvbf* WT_V2 = takeh(SZ_UP); nvbf* WT_WQ = takeh(4 * SZ_WQ); nvbf* WT_WG = takeh((size_t)2 * 1024 * 512); float* SPL = take(2 * 512); float* PRM = take((size_t)2 * 6 * D);
    nvbf* UB = takeh((size_t)16384 * D / 2); nvbf* VB = takeh((size_t)16384 * D / 2); nvbf* KB = takeh((size_t)8 * 256 * 256); float* KSUM = take(8 * 256);
    const size_t scratch0 = off;
    auto nb = [&](Op o) __attribute__((always_inline)) { o.code |= OPF_NOBAR; launch(o); };
    auto wt = [&](const float* W, int K, int N, int batch, nvbf* dst) __attribute__((always_inline)) { const int Np = nv_rup(N, 256), Kp = nv_rup(K, 128); Op o = mk(OP_WT, (long long)batch * Np * (Kp / 8)); o.a = W; o.o0 = (float*)dst; o.i0 = N; o.i1 = K; o.i2 = N; o.i3 = Np; o.i4 = Kp; nb(o); };
    wt(io.in[10], D, MIXIN, 2, WT_WIN); wt(io.in[21], 1024, D, 2, WT_WOUT); wt(io.in[23], D, D, 2, WT_WR); wt(io.in[24], D, D, 2, WT_WK); wt(io.in[25], D, D, 2, WT_WV); wt(io.in[26], D, D, 2, WT_WO);
    wt(io.in[28], D, 64, 2, WT_W1); wt(io.in[29], 64, D, 2, WT_W2); wt(io.in[31], D, 64, 2, WT_A1); wt(io.in[32], 64, D, 2, WT_A2); wt(io.in[36], D, 128, 2, WT_G1); wt(io.in[37], 128, D, 2, WT_G2);
    wt(io.in[34], D, 32, 1, WT_V1); wt(io.in[35], 32, D, 1, WT_V2); wt(io.in[43], D, 2048, 4, WT_WQ);
    for (int jj = 0; jj < 2; ++jj) { Op o = mk(OP_PRM, (long long)6 * D); o.a = io.in[27] + (size_t)jj * D; o.b = io.in[30] + (size_t)jj * D; o.c = jj > 0 ? io.in[33] + (size_t)(jj - 1) * D : nullptr; o.d = io.in[38] + (size_t)jj * D; o.e = io.in[39] + (size_t)jj * D; o.f = io.in[40] + (size_t)jj * RH * 64; o.o0 = PRM + (size_t)jj * 6 * D; nb(o); }
    for (int jj = 0; jj < 2; ++jj) { Op o = mk(OP_WGATE, 1024); o.a = io.in[16] + (size_t)jj * 8 * 64 * 64; o.b = io.in[18] + (size_t)jj * 8 * 64 * 64; o.c = io.in[20] + (size_t)jj * 512; o.o0 = (float*)(WT_WG + (size_t)jj * 1024 * 512); o.o1 = SPL + (size_t)jj * 512; nb(o); }
    auto fgemm = [&](const nvbf* Wt, float* C, int ldc, int N, int K, int bf16out = 0, const float* Aop = nullptr, bool nobar_ = false) __attribute__((always_inline)) {
        const int Kp = nv_rup(K, 128), Np = nv_rup(N, 256);
        Op o = mk(OP_FGEMM, (long long)M * N); o.a = Aop ? Aop : (const float*)ABF; o.b = (const float*)Wt; o.o0 = C; o.i0 = N; o.i1 = Kp; o.i2 = Kp; o.i3 = Kp; o.i4 = ldc; o.i5 = Np; o.i6 = bf16out; if (nobar_) nb(o); else launch(o); };
    auto gemm = [&](const float* A, int lda, const nvbf* Wt, float* C, int ldc, int N, int K, int act) __attribute__((always_inline)) {
        const int Kp = nv_rup(K, 128);
        { Op o = mk(OP_CVT8, (long long)Mp * (Kp / 8)); o.a = A; o.o0 = (float*)ABF; o.i0 = K; o.i1 = lda; o.i2 = Kp; o.i3 = act; launch(o); }
        fgemm(Wt, C, ldc, N, K); };
    { Op o = mk(OP_EMBED4, (long long)MD / 4); o.a = io.in[0]; o.b = io.in[1]; o.c = io.in[7]; o.o0 = X; o.o1 = (float*)ABF; launch(o); }
    const float* const w_outer = w; float* const out_outer = io.out;
    for (int layer = 0; layer < 4; ++layer) {
        float* wl = (float*)w_outer; float* ol = out_outer; NV_LAUNDER(wl); NV_LAUNDER(ol);
#define NV_RB(T, v) T const v##_rb = (T)((char*)wl + ((const char*)(v) - (const char*)w_outer))
#define NV_RO(v) float* const v##_rb = (float*)((char*)ol + ((const char*)(v) - (const char*)out_outer))
        NV_RB(float*, X); NV_RB(float*, VFIRST); NV_RB(float*, MOUT); NV_RB(nvbf*, ABF); NV_RB(nvbf*, WT_WIN); NV_RB(nvbf*, WT_WOUT); NV_RB(nvbf*, WT_WR); NV_RB(nvbf*, WT_WK); NV_RB(nvbf*, WT_WV); NV_RB(nvbf*, WT_WO);
        NV_RB(nvbf*, WT_W1); NV_RB(nvbf*, WT_W2); NV_RB(nvbf*, WT_A1); NV_RB(nvbf*, WT_A2); NV_RB(nvbf*, WT_G1); NV_RB(nvbf*, WT_G2); NV_RB(nvbf*, WT_V1); NV_RB(nvbf*, WT_V2); NV_RB(nvbf*, WT_WQ); NV_RB(nvbf*, WT_WG);
        NV_RB(float*, SPL); NV_RB(float*, PRM); NV_RB(nvbf*, UB); NV_RB(nvbf*, VB); NV_RB(nvbf*, KB); NV_RB(float*, KSUM);
        NV_RO(p_gla); NV_RO(p_h); NV_RO(p_conv); NV_RO(p_rwkv); NV_RO(p_shift); NV_RO(s_gla); NV_RO(s_h); NV_RO(s_conv); NV_RO(s_rwkv); NV_RO(s_shift);
#undef NV_RB
#undef NV_RO
        { float* const X = X_rb; float* const VFIRST = VFIRST_rb; float* const MOUT = MOUT_rb; nvbf* const ABF = ABF_rb; nvbf* const WT_WIN = WT_WIN_rb; nvbf* const WT_WOUT = WT_WOUT_rb; nvbf* const WT_WR = WT_WR_rb; nvbf* const WT_WK = WT_WK_rb;
          nvbf* const WT_WV = WT_WV_rb; nvbf* const WT_WO = WT_WO_rb; nvbf* const WT_W1 = WT_W1_rb; nvbf* const WT_W2 = WT_W2_rb; nvbf* const WT_A1 = WT_A1_rb; nvbf* const WT_A2 = WT_A2_rb; nvbf* const WT_G1 = WT_G1_rb; nvbf* const WT_G2 = WT_G2_rb;
          nvbf* const WT_V1 = WT_V1_rb; nvbf* const WT_V2 = WT_V2_rb; nvbf* const WT_WQ = WT_WQ_rb; nvbf* const WT_WG = WT_WG_rb; float* const SPL = SPL_rb; float* const PRM = PRM_rb; nvbf* const UB = UB_rb; nvbf* const VB = VB_rb; nvbf* const KB = KB_rb; float* const KSUM = KSUM_rb;
          float* const p_gla = p_gla_rb; float* const p_h = p_h_rb; float* const p_conv = p_conv_rb; float* const p_rwkv = p_rwkv_rb; float* const p_shift = p_shift_rb; float* const s_gla = s_gla_rb; float* const s_h = s_h_rb; float* const s_conv = s_conv_rb;
          float* const s_rwkv = s_rwkv_rb; float* const s_shift = s_shift_rb; float* const w = wl; (void)SPL; (void)WT_WG; (void)VFIRST;
        const int j = layer / 2; off = scratch0;
        if (layer % 2 == 0) {
            float* PROJ = take((size_t)M * MIXIN); float* LOGA = take((size_t)M * 256); float* O = take((size_t)M * 512); float* MIXO = X;
            float* XC = take((size_t)M * 512); nvbf* XCB = takeh((size_t)Mp * 512); float* AT = take((size_t)M * 512); float* BT = take((size_t)M * 512);
            const int NC = (dm.T + 63) / 64; float* LEND = take((size_t)B * 4 * NC * 8192); float* DEC = take((size_t)B * 4 * NC * 64); float* LA = take((size_t)B * NC * 512); float* LB = take((size_t)B * NC * 512);
            fgemm(WT_WIN + (size_t)j * SZ_WIN, PROJ, MIXIN, MIXIN, D);
            { Op o = mk(OP_LOGA4, (long long)M * 64); o.a = PROJ; o.b = io.in[11] + (size_t)j * 16 * 256; o.c = io.in[12] + (size_t)j * 256; o.o0 = LOGA; nb(o); }
            { Op o = mk(OP_CONV4, (long long)((M + 3) / 4) * 128); o.a = PROJ; o.b = io.in[4] + (size_t)j * DB * 3 * 512; o.c = io.in[14] + (size_t)j * 4 * 512; o.d = io.in[15] + (size_t)j * 512; o.o0 = XC; o.o1 = (float*)XCB; nb(o); }
            { Op o = mk(OP_CONVOUT, (long long)dm.NSEQ * 1536); o.a = PROJ; o.b = io.in[4] + (size_t)j * DB * 3 * 512; o.o1 = p_conv + (size_t)j * B * 3 * 512; o.o2 = s_conv + (size_t)j * DB * 3 * 512; launch(o); }
            { Op o = mk(OP_GLAF, (long long)B * 512); o.a = PROJ; o.b = LOGA; o.o0 = O; o.o1 = p_gla + (size_t)j * B * 4 * 64 * 128; nb(o); }
            { Op o = mk(OP_GLA3, (long long)(DB * 4) * 128); o.a = PROJ; o.b = LOGA; o.c = io.in[2] + (size_t)j * DB * 4 * 64 * 128; o.d = LEND; o.o0 = O; o.o2 = s_gla + (size_t)j * DB * 4 * 64 * 128; o.i0 = NC; o.i1 = 1; nb(o); }
            { Op o = mk(OP_LRUG2, (long long)M * 512); o.a = (const float*)XCB; o.b = (const float*)(WT_WG + (size_t)j * 1024 * 512); o.c = io.in[17] + (size_t)j * 512; o.d = io.in[19] + (size_t)j * 512; o.e = SPL + (size_t)j * 512; o.f = (const float*)XCB; o.o0 = AT; o.o1 = BT; launch(o); }
            { Op o = mk(OP_GLANORM, (long long)M * 4); o.a = O; o.b = PROJ; o.c = io.in[13] + (size_t)j * 128; o.o0 = MIXO; nb(o); }
            { Op o = mk(OP_LRU1, (long long)B * NC * 512); o.a = AT; o.b = BT; o.o0 = LA; o.o1 = LB; o.i0 = NC; launch(o); }
            { Op o = mk(OP_LRU3, (long long)(B * NC + DB) * 512); o.a = AT; o.b = BT; o.c = PROJ; o.d = io.in[3] + (size_t)j * DB * 512; o.e = LB; o.f = LA; o.o0 = MIXO; o.o1 = p_h + (size_t)j * B * 512; o.o2 = s_h + (size_t)j * DB * 512; o.i0 = NC; launch(o); }
            fgemm(WT_WOUT + (size_t)j * SZ_WOUT, MOUT, D, D, 1024, 1, X, true);
        } else {
            float* Y = take(MD); float* R = take(MD); float* K = take(MD); float* V = take(MD); float* G = take(MD); float* KK = take(MD);
            const size_t XMSZ = (size_t)Mp * D;
            float* WAV = take(3 * MD > 3 * XMSZ ? 3 * MD : 3 * XMSZ); float* Wd = WAV; float* Aa = WAV + MD; float* Vg = WAV + 2 * MD; nvbf* XM6 = (nvbf*)WAV;
            float* BON = take((size_t)M * RH); float* HLw = take((size_t)M * 64); float* HLa = take((size_t)M * 64); float* HLg = take((size_t)M * 128); float* HLv = take((size_t)M * 32);
            nvbf* ABw = takeh((size_t)Mp * 128); nvbf* ABa = takeh((size_t)Mp * 128); nvbf* ABg = takeh((size_t)Mp * 128); nvbf* ABv = takeh((size_t)Mp * 128);
            const float* shin = io.in[6] + (size_t)j * DB * D; const float* mu = io.in[22] + (size_t)j * 6 * D;
            { Op o = mk(OP_SHIFTOUT, (long long)dm.NSEQ * D); o.a = (const float*)ABF; o.o1 = p_shift + (size_t)j * B * D; o.o2 = s_shift + (size_t)j * DB * D; nb(o); }
            { Op o = mk(OP_MIX6, (long long)((M + 3) / 4) * (D / 8)); o.a = (const float*)ABF; o.b = shin; o.c = mu; o.o0 = (float*)XM6; o.i1 = (int)(XMSZ / 1024); launch(o); }
            auto gg = [&](const nvbf* A, const nvbf* Wt, float* C, int ldc, int N, int K, bool last, int bf16out = 0) __attribute__((always_inline)) { const int Kp = nv_rup(K, 128), Np = nv_rup(N, 256);
                Op o = mk(OP_FGEMM, (long long)M * N); o.a = (const float*)A; o.b = (const float*)Wt; o.o0 = C; o.i0 = N; o.i1 = Kp; o.i2 = Kp; o.i3 = Kp; o.i4 = ldc; o.i5 = Np; o.i6 = bf16out; if (!last) o.code |= OPF_GROUP; launch(o); };
            gg(XM6 + 0 * XMSZ, WT_WR + (size_t)j * SZ_DD, R, D, D, D, false, 1); gg(XM6 + 2 * XMSZ, WT_WK + (size_t)j * SZ_DD, K, D, D, D, false, 1); gg(XM6 + 3 * XMSZ, WT_WV + (size_t)j * SZ_DD, V, D, D, D, false, 1);
            gg(XM6 + 1 * XMSZ, WT_W1 + (size_t)j * SZ_DN, HLw, 64, 64, D, false); gg(XM6 + 4 * XMSZ, WT_A1 + (size_t)j * SZ_DN, HLa, 64, 64, D, false);
            if (j > 0) gg(XM6 + 3 * XMSZ, WT_V1 + (size_t)(j - 1) * SZ_DN, HLv, 32, 32, D, false);
            gg(XM6 + 5 * XMSZ, WT_G1 + (size_t)j * SZ_DN, HLg, 128, 128, D, true);
            auto cv = [&](const float* A, int K, nvbf* dst, int act, bool last) __attribute__((always_inline)) { Op o = mk(OP_CVT8, (long long)Mp * 16); o.a = A; o.o0 = (float*)dst; o.i0 = K; o.i1 = K; o.i2 = 128; o.i3 = act; if (last) launch(o); else nb(o); };
            cv(HLw, 64, ABw, 1, false); cv(HLa, 64, ABa, 0, false); if (j > 0) cv(HLv, 32, ABv, 0, false); cv(HLg, 128, ABg, 2, true);
            gg(ABw, WT_W2 + (size_t)j * SZ_UP, Wd, D, D, 64, false, 1); gg(ABa, WT_A2 + (size_t)j * SZ_UP, Aa, D, D, 64, false, 1); if (j > 0) gg(ABv, WT_V2 + (size_t)(j - 1) * SZ_UP, Vg, D, D, 32, false, 1); gg(ABg, WT_G2 + (size_t)j * SZ_UP, G, D, D, 128, true, 1);
            { Op o = mk(OP_WKVP, (long long)dm.NSEQ * RH * 64); o.a = R; o.b = K; o.c = Wd; o.d = Aa; o.e = V; o.f = Vg; o.g = VFIRST; o.h = PRM + (size_t)j * 6 * D; o.o0 = Y; o.o1 = p_rwkv + (size_t)j * B * RH * 4096; o.o2 = s_rwkv + (size_t)j * DB * RH * 4096;
              o.o3 = j > 0 ? KK : VFIRST; o.o4 = BON; o.o5 = (float*)(io.in[5] + (size_t)j * DB * RH * 4096); o.i0 = j > 0 ? 1 : 0; launch(o); }
            { Op o = mk(OP_POST2, (long long)M * RH); o.a = Y; o.b = G; o.c = j > 0 ? KK : VFIRST; o.d = BON; o.e = io.in[41] + (size_t)j * D; o.f = io.in[42] + (size_t)j * D; o.o0 = X; launch(o); }
            fgemm(WT_WO + (size_t)j * SZ_DD, MOUT, D, D, D, 1, X, true);
        }
        { Op o = mk(OP_CVTTAB8S, (long long)16384 * D / 16); o.a = io.in[45] + (size_t)layer * 16384 * D; o.o0 = (float*)UB; o.i0 = 7; o.i6 = (Mp / 256) * (nv_rup(D, 256) / 256); launch(o); }
        { Op o = mk(OP_LNRES, M); o.a = MOUT; o.b = io.in[8] + (size_t)(layer * 2 + 0) * D; o.c = io.in[9] + (size_t)(layer * 2 + 0) * D; o.o0 = X; o.o1 = (float*)ABF; o.o2 = (float*)(ABF + ABFN); launch(o); }
        off = scratch0;
        { nvbf* Q = takeh((size_t)Mp * 2048); float* SC = take((size_t)M * 2048); float* GATE = take((size_t)M * 128); float* EIDX = take((size_t)M * 128); float* TMPV = take((size_t)M * 256); float* TMPI = take((size_t)M * 256);
          float* COEF = take((size_t)M * 128);
          { Op o = mk(OP_FGEMM, (long long)M * 2048); o.a = (const float*)ABF; o.b = (const float*)(WT_WQ + (size_t)layer * SZ_WQ); o.o0 = (float*)Q; o.i0 = 2048; o.i1 = Dk; o.i2 = Dk; o.i3 = Dk; o.i4 = 2048; o.i5 = 2048; o.i6 = 1; nb(o); }
          { Op o = mk(OP_CVTTAB8S, (long long)16384 * D / 16); o.a = io.in[46] + (size_t)layer * 16384 * D; o.o0 = (float*)VB; o.i0 = 6; o.i6 = (Mp / 256) * 8; nb(o); }
          { Op o = mk(OP_KEYS, 8 * 256); o.a = io.in[44] + (size_t)layer * 8 * 2 * 128 * 128; o.o0 = (float*)KB; o.o1 = KSUM; launch(o); }
          { Op o = mk(OP_FGEMM, (long long)M * 2048); o.a = (const float*)Q; o.b = (const float*)KB; o.o0 = SC; o.i0 = 2048; o.i1 = 256; o.i2 = 2048; o.i3 = 256; o.i4 = 2048; o.i5 = 2048; o.i6 = 3; launch(o); }
          { Op o = mk(OP_TOPK2, (long long)M * 8); o.a = SC; o.b = (const float*)Q; o.c = KSUM; o.o0 = GATE; o.o1 = EIDX; o.o2 = TMPV; o.o3 = TMPI; launch(o); }
          { const int NS = D / 128; float* PART = take((size_t)NS * M * 128); float* YBUF = take(MD);
            #ifdef PROBE_EMASK
            { Op o = mk(OP_PACTS, (long long)NS * M * 128); o.a = (const float*)(ABF + ABFN); o.b = (const float*)UB; o.d = EIDX; o.o0 = PART; o.i0 = PROBE_EMASK; launch(o); }
#endif
            { Op o = mk(OP_PACTS, (long long)NS * M * 128); o.a = (const float*)(ABF + ABFN); o.b = (const float*)UB; o.d = EIDX; o.o0 = PART; o.i0 = 16383; launch(o); }
            { Op o = mk(OP_PRED, (long long)M * 32); o.a = PART; o.c = GATE; o.o0 = COEF; o.i0 = NS; launch(o); }
            { Op o = mk(OP_POUTS, (long long)MD); o.a = COEF; o.b = EIDX; o.c = (const float*)VB; o.o0 = YBUF; launch(o); }
            { Op o = mk(OP_LNRES, M); o.a = YBUF; o.b = io.in[8] + (size_t)(layer * 2 + 1) * D; o.c = io.in[9] + (size_t)(layer * 2 + 1) * D; o.o0 = X; o.o1 = (float*)ABF; launch(o); } } }
        }
    }
    { Op o = mk(OP_YOUT4, (long long)MD / 4); o.a = (const float*)ABF; o.o0 = y_prompt; launch(o); }
    (void)y_sample;
}

#include <cstdint>
namespace pg8 {
#define PG8_LAS __attribute__((address_space(3)))
typedef unsigned short bf16_t;
typedef short bf16x8 __attribute__((ext_vector_type(8)));
typedef float f32x4 __attribute__((ext_vector_type(4)));
typedef unsigned u32x4 __attribute__((ext_vector_type(4)));
constexpr int BM = 256, BK = 64, HALF = 128, HTB = HALF * BK * 2  , STAGE_BYTES = 8 * HTB, NXCD = 8, WGM = 8;

__host__ __device__ __forceinline__ int lds_byte(int r, int c) { const int st = (r >> 4) * 2 + (c >> 5), rr = r & 15, cc = c & 31, ob = rr * 64 + cc * 2; return st * 1024 + (ob ^ (((ob >> 9) & 1) << 5)); }
__host__ __device__ __forceinline__ void stage_rc(int b, int& R, int& C) { const int st = b / 1024, sb = b % 1024, swz = sb ^ (((sb >> 9) & 1) << 5); R = (st >> 1) * 16 + swz / 64; C = (st & 1) * 32 + (swz % 64) / 2; }
__host__ __device__ __forceinline__ int perm32(int rho) { const int n = rho >> 4, i = rho & 15; return 8 * (i >> 2) + 4 * n + (i & 3); }

struct Unit { int pm, pn, grp, pad_; const char* A; const char* B; };
struct Gemm { const bf16_t* A; const bf16_t* Bt; int M, N, K, lda, ldb; };

struct StaticOrder {
    int nM, nN, nwg, G, c; const char* A; const char* B; size_t tsA, tsB, acs;
    __host__ __device__ void init(const Gemm& g, int G_, int c_) { nM = g.M / BM; nN = g.N / BM; nwg = nM * nN; G = G_; c = c_; A = (const char*)g.A; B = (const char*)g.Bt; tsA = (size_t)BM * g.lda * 2; tsB = (size_t)BM * g.ldb * 2; acs = 0; }
    __host__ __device__ bool next(int i, Unit& u) const {
        const long L = (long)i * G + c; if (L >= nwg) return false;
        int wgid = (int)L; { const int q = nwg / NXCD, r = nwg % NXCD, xcd = wgid % NXCD, off = wgid / NXCD; wgid = (xcd < r ? xcd * (q + 1) : r * (q + 1) + (xcd - r) * q) + off; }
        const int nig = WGM * nN, gid = wgid / nig, fm = gid * WGM, gsz = (nM - fm) < WGM ? (nM - fm) : WGM;
        u.pm = fm + ((wgid % nig) % gsz); u.pn = (wgid % nig) / gsz; u.grp = 0; u.pad_ = 0; u.A = A + (size_t)u.pm * tsA + (size_t)u.pn * acs; u.B = B + (size_t)u.pn * tsB; return true;
    }
    __device__ __forceinline__ void a_ready(const Unit&) const {}
    __device__ __forceinline__ void done(const Unit&) const {}
};

template <class Epi, class Sched, bool ALIGN_EPI = false, bool SP2 = false>
__device__ __forceinline__ void gemm_phase(PG8_LAS unsigned char* lds, const Gemm g, const Sched& S, const Epi& E) {
    int tid_raw = threadIdx.x; asm volatile("" : "+v"(tid_raw));
    const int tid = tid_raw, wid = __builtin_amdgcn_readfirstlane(tid >> 6), lane = tid & 63, wr = wid >> 2, wc = wid & 3, fr = lane & 15, fq = lane >> 4;
    const int K = g.K, nt = K / BK;
    unsigned voffA[2], voffB[2];
#pragma unroll
    for (int i = 0; i < 2; ++i) { int R, C; stage_rc(tid * 16 + i * 8192, R, C); const int Rb = Epi::PERM ? ((R & ~31) + perm32(R & 31)) : R;
        voffA[i] = (unsigned)(R * g.lda + C) * 2u; voffB[i] = (unsigned)(Rb * g.ldb + C) * 2u; }
    const size_t kstep = (size_t)(BK * 2);
    const size_t hstepA = (size_t)HALF * g.lda * 2, hstepB = (size_t)HALF * g.ldb * 2;
    const unsigned ldsw = (unsigned)wid * 1024u;
    const int aoff = lds_byte(wr * 64 + fr, fq * 8), boff = lds_byte(wc * 32 + fr, fq * 8);
#define PG8_SA(b, h) (((b) * 2 + (h)) * HTB)
#define PG8_SB(b, h) ((4 + (b) * 2 + (h)) * HTB)
#define PG8_STAGE(bufoff, gbase, voff) do { _Pragma("unroll") for (int _i = 0; _i < 2; ++_i) \
        __builtin_amdgcn_global_load_lds((const unsigned*)((const char*)(gbase) + (voff)[_i]), (PG8_LAS unsigned*)(lds + (bufoff) + ldsw + _i * 8192), 16, 0, 0); } while (0)
#define PG8_LDA(dst, b, h) do { _Pragma("unroll") for (int m = 0; m < 4; ++m) _Pragma("unroll") for (int k = 0; k < 2; ++k) dst[m][k] = *(const PG8_LAS bf16x8*)(lds + PG8_SA(b, h) + aoff + m * 2048 + k * 1024); } while (0)
#define PG8_LDB(dst, b, h) do { _Pragma("unroll") for (int n = 0; n < 2; ++n) _Pragma("unroll") for (int k = 0; k < 2; ++k) dst[n][k] = *(const PG8_LAS bf16x8*)(lds + PG8_SB(b, h) + boff + n * 2048 + k * 1024); } while (0)
#define PG8_MMA(ai, bj, At, Bt) do { __builtin_amdgcn_s_setprio(1); _Pragma("unroll") for (int m = 0; m < 4; ++m) _Pragma("unroll") for (int n = 0; n < 2; ++n) _Pragma("unroll") for (int k = 0; k < 2; ++k) \
        acc[ai][bj][m][n] = __builtin_amdgcn_mfma_f32_16x16x32_bf16(Bt[n][k], At[m][k], acc[ai][bj][m][n], 0, 0, 0); __builtin_amdgcn_s_setprio(0); } while (0)
#define PG8_WAIT_V(n) asm volatile("s_waitcnt vmcnt(" #n ")" ::: "memory")
#define PG8_WAIT_L(n) asm volatile("s_waitcnt lgkmcnt(" #n ")" ::: "memory")
#define PG8_BAR __builtin_amdgcn_s_barrier()
#define PG8_SCHED __builtin_amdgcn_sched_barrier(0)
    Unit cur, nxt; int ui = 0;
    if (!S.next(0, cur)) return;
    f32x4 acc[2][2][4][2];
#pragma unroll
    for (int a = 0; a < 2; ++a)
#pragma unroll
        for (int b = 0; b < 2; ++b)
#pragma unroll
            for (int m = 0; m < 4; ++m)
#pragma unroll
                for (int n = 0; n < 2; ++n) acc[a][b][m][n] = (f32x4){0.f, 0.f, 0.f, 0.f};
    bf16x8 At[4][2], B0[2][2], B1[2][2];
    const char* cA = cur.A; const char* cB = cur.B;
    S.a_ready(cur);
    if constexpr (SP2) {
        PG8_STAGE(PG8_SB(0, 0), cB, voffB); PG8_STAGE(PG8_SB(0, 1), cB + hstepB, voffB); PG8_STAGE(PG8_SA(0, 0), cA, voffA); PG8_STAGE(PG8_SA(0, 1), cA + hstepA, voffA);
        if (wr == 1) PG8_BAR;
        PG8_WAIT_V(2); PG8_BAR;
        PG8_STAGE(PG8_SB(1, 0), cB + kstep, voffB); PG8_STAGE(PG8_SA(1, 0), cA + kstep, voffA); PG8_STAGE(PG8_SB(1, 1), cB + hstepB + kstep, voffB);
        PG8_WAIT_V(6); PG8_BAR;
    } else {
        PG8_STAGE(PG8_SB(0, 0), cB, voffB); PG8_STAGE(PG8_SA(0, 0), cA, voffA); PG8_STAGE(PG8_SB(0, 1), cB + hstepB, voffB); PG8_STAGE(PG8_SA(0, 1), cA + hstepA, voffA);
        if (wr == 1) PG8_BAR;
        PG8_WAIT_V(4); PG8_BAR;
        PG8_STAGE(PG8_SB(1, 0), cB + kstep, voffB); PG8_STAGE(PG8_SA(1, 0), cA + kstep, voffA); PG8_STAGE(PG8_SB(1, 1), cB + hstepB + kstep, voffB);
        PG8_WAIT_V(6); PG8_BAR;
    }
    for (;;) {
        const bool has_next = S.next(ui + 1, nxt);
        const char* nA = has_next ? nxt.A : cA; const char* nB = has_next ? nxt.B : cB;
        for (int t = 0; t < nt; t += 2) {
            const bool last = (t == nt - 2);
            const char* a1 = cA + (size_t)(t + 1) * kstep;
            const char* a2 = last ? nA : cA + (size_t)(t + 2) * kstep; const char* b2 = last ? nB : cB + (size_t)(t + 2) * kstep;
            const char* a3 = a2 + kstep; const char* b3 = b2 + kstep;
            if (last && has_next) S.a_ready(nxt);
            if constexpr (SP2) {
            PG8_LDB(B0, 0, 0); PG8_LDB(B1, 0, 1); PG8_SCHED; PG8_LDA(At, 0, 0); PG8_STAGE(PG8_SA(1, 1), a1 + hstepA, voffA);
            PG8_WAIT_V(8); PG8_WAIT_L(0); PG8_BAR; PG8_MMA(0, 0, At, B0); PG8_MMA(0, 1, At, B1); PG8_BAR; PG8_SCHED;
            PG8_LDA(At, 0, 1); PG8_STAGE(PG8_SB(0, 0), b2, voffB); PG8_STAGE(PG8_SB(0, 1), b2 + hstepB, voffB); PG8_STAGE(PG8_SA(0, 0), a2, voffA);
            PG8_WAIT_V(8); PG8_WAIT_L(0); PG8_BAR; PG8_MMA(1, 0, At, B0); PG8_MMA(1, 1, At, B1); PG8_BAR; PG8_SCHED;
            PG8_LDB(B0, 1, 0); PG8_LDB(B1, 1, 1); PG8_SCHED; PG8_LDA(At, 1, 0); PG8_STAGE(PG8_SA(0, 1), a2 + hstepA, voffA);
            PG8_WAIT_V(8); PG8_WAIT_L(0); PG8_BAR; PG8_MMA(0, 0, At, B0); PG8_MMA(0, 1, At, B1); PG8_BAR; PG8_SCHED;
            PG8_LDA(At, 1, 1); PG8_STAGE(PG8_SB(1, 0), b3, voffB); PG8_STAGE(PG8_SB(1, 1), b3 + hstepB, voffB); PG8_STAGE(PG8_SA(1, 0), a3, voffA);
            PG8_WAIT_V(8); PG8_WAIT_L(0); PG8_BAR; PG8_MMA(1, 0, At, B0); PG8_MMA(1, 1, At, B1); PG8_BAR; PG8_SCHED;
            } else {
            PG8_LDB(B0, 0, 0); PG8_SCHED; PG8_LDA(At, 0, 0); PG8_STAGE(PG8_SA(1, 1), a1 + hstepA, voffA);
            PG8_WAIT_L(8); PG8_BAR; PG8_WAIT_L(0); PG8_MMA(0, 0, At, B0); PG8_BAR; PG8_SCHED;
            PG8_LDB(B1, 0, 1); PG8_STAGE(PG8_SB(0, 0), b2, voffB);
            PG8_BAR; PG8_WAIT_L(0); PG8_MMA(0, 1, At, B1); PG8_BAR;
            PG8_LDA(At, 0, 1); PG8_STAGE(PG8_SA(0, 0), a2, voffA);
            PG8_BAR; PG8_WAIT_L(0); PG8_MMA(1, 0, At, B0); PG8_BAR; PG8_SCHED;
            PG8_STAGE(PG8_SB(0, 1), b2 + hstepB, voffB);
            PG8_WAIT_V(6); PG8_BAR; PG8_MMA(1, 1, At, B1); PG8_BAR;
            PG8_LDB(B0, 1, 0); PG8_SCHED; PG8_LDA(At, 1, 0); PG8_STAGE(PG8_SA(0, 1), a2 + hstepA, voffA);
            PG8_WAIT_L(8); PG8_BAR; PG8_WAIT_L(0); PG8_MMA(0, 0, At, B0); PG8_BAR; PG8_SCHED;
            PG8_LDB(B1, 1, 1); PG8_STAGE(PG8_SB(1, 0), b3, voffB);
            PG8_BAR; PG8_WAIT_L(0); PG8_MMA(0, 1, At, B1); PG8_BAR;
            PG8_LDA(At, 1, 1); PG8_STAGE(PG8_SA(1, 0), a3, voffA);
            PG8_BAR; PG8_WAIT_L(0); PG8_MMA(1, 0, At, B0); PG8_BAR; PG8_SCHED;
            PG8_STAGE(PG8_SB(1, 1), b3 + hstepB, voffB);
            PG8_WAIT_V(6); PG8_BAR; PG8_MMA(1, 1, At, B1); PG8_BAR;
            }
        }
        if constexpr (ALIGN_EPI) { if (wr == 0) PG8_BAR; }
        if constexpr (!Epi::AFTER_DRAIN) { E(acc, cur, wr, wc, fr, fq); S.done(cur); }
        if (!has_next) break;
#pragma unroll
        for (int a = 0; a < 2; ++a)
#pragma unroll
            for (int b = 0; b < 2; ++b)
#pragma unroll
                for (int m = 0; m < 4; ++m)
#pragma unroll
                    for (int n = 0; n < 2; ++n) acc[a][b][m][n] = (f32x4){0.f, 0.f, 0.f, 0.f};
        cur = nxt; cA = nA; cB = nB; ++ui;
        if constexpr (ALIGN_EPI) { if (wr == 1) PG8_BAR; }
    }
    PG8_WAIT_V(0);
    if constexpr (!ALIGN_EPI) { if (wr == 0) PG8_BAR; }
    PG8_BAR;
    if constexpr (Epi::AFTER_DRAIN) { E.fused(acc, cur, wr, wc, fr, fq, lds, wid, lane); S.done(cur); }
#undef PG8_SA
#undef PG8_SB
#undef PG8_STAGE
#undef PG8_LDA
#undef PG8_LDB
#undef PG8_MMA
#undef PG8_WAIT_V
#undef PG8_WAIT_L
#undef PG8_BAR
#undef PG8_SCHED
}
}
template <class T> __device__ __forceinline__ T* uni_ptr(T* p) {
    unsigned long long v = (unsigned long long)p; unsigned lo = __builtin_amdgcn_readfirstlane((unsigned)v), hi = __builtin_amdgcn_readfirstlane((unsigned)(v >> 32));
    unsigned long long r = ((unsigned long long)hi << 32) | lo; asm volatile("" : "+s"(r)); return (T*)r; }
__device__ __forceinline__ int rfl(int x) { int t = __builtin_amdgcn_readfirstlane(x); asm volatile("" : "+s"(t)); return t; }
namespace pg8 {
__device__ __forceinline__ unsigned cvt_pk_bf16(float lo, float hi) { unsigned r; asm volatile("v_cvt_pk_bf16_f32 %0, %1, %2" : "=v"(r) : "v"(lo), "v"(hi)); return r; }
struct EpiF32 {
    static constexpr bool PERM = false, AFTER_DRAIN = false;
    float* C; int ldc, Mreal, Nreal;
    __device__ __forceinline__ void operator()(const f32x4 (&acc)[2][2][4][2], const Unit& u, int wr, int wc, int fr, int fq) const {
        const int row0 = u.pm * BM + wr * 64 + fr, col0 = u.pn * BM + wc * 32 + 4 * fq;
#pragma unroll
        for (int ai = 0; ai < 2; ++ai)
#pragma unroll
            for (int m = 0; m < 4; ++m) { const int r = row0 + ai * HALF + m * 16; if (r < Mreal) { float* rowp = C + (size_t)r * ldc + col0;
#pragma unroll
                for (int bj = 0; bj < 2; ++bj)
#pragma unroll
                    for (int n = 0; n < 2; ++n) { const int c = col0 + bj * HALF + n * 16; if (c < Nreal) *(f32x4*)(rowp + bj * HALF + n * 16) = acc[ai][bj][m][n]; } } }
    }
};
struct EpiBf16Plain {
    static constexpr bool PERM = true, AFTER_DRAIN = false;
    bf16_t* O; int ldc;
    __device__ __forceinline__ void operator()(const f32x4 (&acc)[2][2][4][2], const Unit& u, int wr, int wc, int fr, int fq) const {
        const int row0 = u.pm * BM + wr * 64 + fr, col0 = u.pn * BM + wc * 32 + 8 * fq;
#pragma unroll
        for (int ai = 0; ai < 2; ++ai)
#pragma unroll
            for (int m = 0; m < 4; ++m) { bf16_t* rowp = O + (size_t)(row0 + ai * HALF + m * 16) * ldc + col0;
#pragma unroll
                for (int bj = 0; bj < 2; ++bj) { const f32x4 v0 = acc[ai][bj][m][0], v1 = acc[ai][bj][m][1]; u32x4 w;
                    w.x = cvt_pk_bf16(v0[0], v0[1]); w.y = cvt_pk_bf16(v0[2], v0[3]); w.z = cvt_pk_bf16(v1[0], v1[1]); w.w = cvt_pk_bf16(v1[2], v1[3]);
                    *(u32x4*)(rowp + bj * HALF) = w; } }
    }
};
struct EpiLru {
    static constexpr bool PERM = false, AFTER_DRAIN = false;
    const float* ba; const float* bx; const float* spl; const bf16_t* XC; float* AT; float* BT; int Mreal;
    __device__ __forceinline__ void operator()(const f32x4 (&acc)[2][2][4][2], const Unit& u, int wr, int wc, int fr, int fq) const {
        const int row0 = u.pm * BM + wr * 64 + fr, ch0 = u.pn * 128 + wc * 32 + 4 * fq;
#pragma unroll
        for (int n = 0; n < 2; ++n) { const int c = ch0 + 16 * n; const f32x4 ba4 = *(const f32x4*)(ba + c), bx4 = *(const f32x4*)(bx + c), sp4 = *(const f32x4*)(spl + c);
#pragma unroll
            for (int ai = 0; ai < 2; ++ai)
#pragma unroll
                for (int m = 0; m < 4; ++m) { const int r = row0 + ai * HALF + m * 16; if (r < Mreal) { const unsigned long long xw_ = *(const unsigned long long*)(XC + (size_t)r * 512 + c); const unsigned xl_ = (unsigned)xw_, xh_ = (unsigned)(xw_ >> 32); const f32x4 xc = {__uint_as_float(xl_ << 16), __uint_as_float(xl_ & 0xffff0000u), __uint_as_float(xh_ << 16), __uint_as_float(xh_ & 0xffff0000u)}; const f32x4 ga = acc[ai][0][m][n] + ba4, gx = acc[ai][1][m][n] + bx4; f32x4 at, bt;
#pragma unroll
                    for (int i = 0; i < 4; ++i) { const float gate_a = __builtin_amdgcn_rcpf(1.f + __expf(-ga[i])), gate_x = __builtin_amdgcn_rcpf(1.f + __expf(-gx[i])); const float la = gate_a * sp4[i]; at[i] = __expf(la); bt[i] = sqrtf(-expm1f(2.f * la)) * (gate_x * xc[i]); }
                    *(f32x4*)(AT + (size_t)r * 512 + c) = at; *(f32x4*)(BT + (size_t)r * 512 + c) = bt; } } }
    }
};
struct GroupOrder {
    const PG8_LAS Op* tab; int ng, nM, G, c; size_t tsA, tsB;
    __device__ __forceinline__ bool next(int i, Unit& u) const {
        int L = i * G + c, g = 0;
        for (; g < ng; ++g) { const int cnt = nM * (__builtin_amdgcn_readfirstlane(tab[g].i5) >> 8); if (L < cnt) break; L -= cnt; }
        if (g >= ng) return false;
        u.pm = L % nM; u.pn = L / nM; u.grp = g; u.pad_ = 0;
        u.A = (const char*)uni_ptr(tab[g].a) + (size_t)u.pm * tsA; u.B = (const char*)uni_ptr(tab[g].b) + (size_t)u.pn * tsB; return true;
    }
    __device__ __forceinline__ void a_ready(const Unit&) const {}
    __device__ __forceinline__ void done(const Unit&) const {}
};
struct EpiGroup {
    static constexpr bool PERM = true, AFTER_DRAIN = false;
    const PG8_LAS Op* tab; int Mreal;
    __device__ __forceinline__ void operator()(const f32x4 (&acc)[2][2][4][2], const Unit& u, int wr, int wc, int fr, int fq) const {
        const int ldc = rfl(tab[u.grp].i4), Nreal = rfl(tab[u.grp].i0), fl = rfl(tab[u.grp].i6);
        if (fl & 1) { const EpiBf16Plain E{(bf16_t*)uni_ptr(tab[u.grp].o0), ldc}; E(acc, u, wr, wc, fr, fq); return; }
        float* C = uni_ptr(tab[u.grp].o0); const int row0 = u.pm * BM + wr * 64 + fr, col0 = u.pn * BM + wc * 32 + 8 * fq;
#pragma unroll
        for (int ai = 0; ai < 2; ++ai)
#pragma unroll
            for (int m = 0; m < 4; ++m) { const int r = row0 + ai * HALF + m * 16; if (r < Mreal) { float* rowp = C + (size_t)r * ldc + col0;
#pragma unroll
                for (int bj = 0; bj < 2; ++bj) { if (col0 + bj * HALF < Nreal) { *(f32x4*)(rowp + bj * HALF) = acc[ai][bj][m][0]; *(f32x4*)(rowp + bj * HALF + 4) = acc[ai][bj][m][1]; } } } }
    }
};
}

#define XB_TMO      128
#define XB_XCNT(j)  (256  + 64 * (j))
#define XB_XSUB(j)  (1280 + 64 * (j))
#define XB_XGEN(j)  (2304 + 64 * (j))
#define XB_TOP      3328
#define XB_TOPGEN   3392
#define XCD_BAR_WORDS 3456
#define XB_SPIN_CAP (1u << 18)
#define LAS __attribute__((address_space(3)))
__device__ __forceinline__ unsigned xb_ld(unsigned* p)              { return __hip_atomic_load(p, __ATOMIC_RELAXED, __HIP_MEMORY_SCOPE_AGENT); }
__device__ __forceinline__ unsigned xb_add(unsigned* p, unsigned v) { return __hip_atomic_fetch_add(p, v, __ATOMIC_RELAXED, __HIP_MEMORY_SCOPE_AGENT); }
__device__ __forceinline__ unsigned xb_xcc_id() { return (unsigned)__builtin_amdgcn_s_getreg((3 << 11) | 20) & 0xFu; }
#define XB_SPIN(cond, bar) do { unsigned _sp = 0; while (cond) { __builtin_amdgcn_s_sleep(1); \
    if ((++_sp & 255u) == 0u) { if (xb_ld(&(bar)[XB_TMO])) break; if (_sp > XB_SPIN_CAP) { atomicAdd(&(bar)[XB_TMO], 1u); break; } } } } while (0)
struct XcdBarrier { unsigned* bar; unsigned x; volatile LAS unsigned* st; };
__device__ __forceinline__ XcdBarrier xcd_barrier_post(unsigned* bar, volatile LAS unsigned* st) {
    XcdBarrier b; b.bar = bar; b.x = xb_xcc_id(); b.st = st;
    if (threadIdx.x == 0) (void)xb_add(&bar[XB_XCNT(b.x)], 1u);
    return b;
}
__device__ __forceinline__ void xcd_barrier_complete(unsigned* bar, unsigned x, unsigned& nloc, unsigned& nx) {
    const unsigned G = gridDim.x * gridDim.y * gridDim.z;
    unsigned sum, cnt, mine, sp = 0u;
    for (;;) {
        sum = 0u; cnt = 0u; mine = 0u;
#pragma unroll
        for (unsigned j = 0; j < 16; ++j) { const unsigned c = xb_ld(&bar[XB_XCNT(j)]); sum += c; cnt += (c > 0u) ? 1u : 0u; mine = (j == x) ? c : mine; }
        if (sum == G) break;
        __builtin_amdgcn_s_sleep(1);
        if ((++sp & 255u) == 0u) { if (xb_ld(&bar[XB_TMO])) break; if (sp > XB_SPIN_CAP) { atomicAdd(&bar[XB_TMO], 1u); break; } }
    }
    nloc = mine > 0u ? mine : 1u; nx = cnt > 0u ? cnt : 1u;
}
__device__ __forceinline__ void xcd_barrier(const XcdBarrier& b) {
    asm volatile("s_waitcnt vmcnt(0)" ::: "memory");
    __syncthreads();
    if (threadIdx.x == 0) {
        unsigned* bar = b.bar;
        __builtin_amdgcn_s_waitcnt(0);
        unsigned nloc = b.st[0], nx = b.st[1];
        if (nloc == 0u) { xcd_barrier_complete(bar, b.x, nloc, nx); b.st[0] = nloc; b.st[1] = nx; }
        const unsigned old = xb_add(&bar[XB_XSUB(b.x)], 1u);
        const unsigned gen = old / nloc;
        if (old + 1u == (gen + 1u) * nloc) {
            __builtin_amdgcn_fence(__ATOMIC_RELEASE, "agent");
            asm volatile("s_waitcnt vmcnt(0)" ::: "memory");
            const unsigned og = xb_add(&bar[XB_TOP], 1u);
            const unsigned tg = og / nx;
            if (og + 1u == (tg + 1u) * nx) xb_add(&bar[XB_TOPGEN], 1u);
            else XB_SPIN(xb_ld(&bar[XB_TOPGEN]) == tg, bar);
            __builtin_amdgcn_fence(__ATOMIC_ACQUIRE, "agent");
            xb_add(&bar[XB_XGEN(b.x)], 1u);
            asm volatile("s_waitcnt vmcnt(0)" ::: "memory");
        } else {
            XB_SPIN(xb_ld(&bar[XB_XGEN(b.x)]) == gen, bar);
            __builtin_amdgcn_fence(__ATOMIC_ACQUIRE, "agent");
            asm volatile("s_waitcnt vmcnt(0)" ::: "memory");
        }
    }
    __syncthreads();
}

namespace fk {
#define GAS __attribute__((address_space(1)))
typedef unsigned u32x4 __attribute__((ext_vector_type(4)));
typedef unsigned u32x2 __attribute__((ext_vector_type(2)));
typedef float f32x4 __attribute__((ext_vector_type(4)));
typedef float f32x2 __attribute__((ext_vector_type(2)));
typedef __bf16 bf2 __attribute__((ext_vector_type(2)));
typedef unsigned short bf16_t;
__device__ __forceinline__ float bflo(unsigned u) { return __uint_as_float(u << 16); }
__device__ __forceinline__ float bfhi(unsigned u) { return __uint_as_float(u & 0xffff0000u); }
__device__ __forceinline__ float dot2(unsigned a, unsigned b, float c) { return __builtin_amdgcn_fdot2_f32_bf16(__builtin_bit_cast(bf2, a), __builtin_bit_cast(bf2, b), c, false); }
__device__ __forceinline__ unsigned pk_bf16(float lo, float hi) { unsigned r; asm volatile("v_cvt_pk_bf16_f32 %0, %1, %2" : "=v"(r) : "v"(lo), "v"(hi)); return r; }
template <int CTRL> __device__ __forceinline__ float dppf(float v) { return __int_as_float(__builtin_amdgcn_update_dpp(0, __float_as_int(v), CTRL, 0xf, 0xf, true)); }
__device__ __forceinline__ float row_max16(float v) { v = fmaxf(v, dppf<0xB1>(v)); v = fmaxf(v, dppf<0x4E>(v)); v = fmaxf(v, dppf<0x141>(v)); v = fmaxf(v, dppf<0x140>(v)); return v; }
__device__ __forceinline__ float frcp(float x) { return __builtin_amdgcn_rcpf(x); }
__device__ __forceinline__ float fsqrt(float x) { return __builtin_amdgcn_sqrtf(x); }
__device__ __forceinline__ float row_sum8(float v) { v += dppf<0xB1>(v); v += dppf<0x4E>(v); v += dppf<0x141>(v); return v; }
__device__ __forceinline__ float row_sum16(float v) { v += dppf<0xB1>(v); v += dppf<0x4E>(v); v += dppf<0x141>(v); v += dppf<0x140>(v); return v; }
__device__ __forceinline__ float shx(float v, int m, int lane) { return __int_as_float(__builtin_amdgcn_ds_bpermute((lane ^ m) << 2, __float_as_int(v))); }
__device__ __forceinline__ float wave_sum(float v, int lane) { v = row_sum16(v); v += shx(v, 16, lane); v += shx(v, 32, lane); return v; }
__device__ __forceinline__ float gelu_tanh(float x) { return 0.5f * x * (1.f + tanhf(0.7978845608028654f * (x + 0.044715f * x * x * x))); }
#define FK_NEG (-3.0e38f)

template <int CTRL> __device__ __forceinline__ int dppi(int v) { return __builtin_amdgcn_update_dpp(0, v, CTRL, 0xf, 0xf, true); }
__device__ __forceinline__ int row_min16i(int v) { v = min(v, dppi<0xB1>(v)); v = min(v, dppi<0x4E>(v)); v = min(v, dppi<0x141>(v)); v = min(v, dppi<0x140>(v)); return v; }
#define FK_CE(a, b) do { const bool sw_ = v[b] > v[a]; const float tv_ = sw_ ? v[b] : v[a]; v[b] = sw_ ? v[a] : v[b]; v[a] = tv_; const int ti_ = sw_ ? id[b] : id[a]; id[b] = sw_ ? id[a] : id[b]; id[a] = ti_; } while (0)
#define FK_SORT8(v, id) do { FK_CE2(v, id, 0, 1); FK_CE2(v, id, 2, 3); FK_CE2(v, id, 4, 5); FK_CE2(v, id, 6, 7); FK_CE2(v, id, 0, 2); FK_CE2(v, id, 1, 3); FK_CE2(v, id, 4, 6); FK_CE2(v, id, 5, 7); FK_CE2(v, id, 1, 2); FK_CE2(v, id, 5, 6); \
    FK_CE2(v, id, 0, 4); FK_CE2(v, id, 1, 5); FK_CE2(v, id, 2, 6); FK_CE2(v, id, 3, 7); FK_CE2(v, id, 2, 4); FK_CE2(v, id, 3, 5); FK_CE2(v, id, 1, 2); FK_CE2(v, id, 3, 4); FK_CE2(v, id, 5, 6); } while (0)
#define FK_CE2(v, id, a, b) do { const bool sw_ = v[b] > v[a]; const float tv_ = sw_ ? v[b] : v[a]; v[b] = sw_ ? v[a] : v[b]; v[a] = tv_; const int ti_ = sw_ ? id[b] : id[a]; id[b] = sw_ ? id[a] : id[b]; id[a] = ti_; } while (0)
__device__ __forceinline__ void top16_of_128_x2(float (&v)[8], int (&id)[8], float (&u)[8], int (&jd)[8], int lane16, float& rv1, int& ri1, float& rv2, int& ri2) {
    FK_SORT8(v, id); FK_SORT8(u, jd);
    rv1 = FK_NEG; ri1 = 0; rv2 = FK_NEG; ri2 = 0;
#pragma unroll
    for (int r = 0; r < 16; ++r) {
        const float wm = row_max16(v[0]), xm = row_max16(u[0]);
        const int cand = (v[0] == wm) ? id[0] : 0x7fffffff, dand = (u[0] == xm) ? jd[0] : 0x7fffffff;
        const int sel = row_min16i(cand), tel = row_min16i(dand);
        const bool mine = (cand == sel), nine = (dand == tel);
        if (lane16 == r) { rv1 = wm; ri1 = sel; rv2 = xm; ri2 = tel; }
#pragma unroll
        for (int i = 0; i < 7; ++i) { v[i] = mine ? v[i + 1] : v[i]; id[i] = mine ? id[i + 1] : id[i]; u[i] = nine ? u[i + 1] : u[i]; jd[i] = nine ? jd[i + 1] : jd[i]; }
        v[7] = mine ? FK_NEG : v[7]; u[7] = nine ? FK_NEG : u[7];
    }
}
__device__ __forceinline__ int fk_key(float x, int lane16) { int k = __float_as_int(x); k ^= (k >> 31) & 0x7fffffff; return (k & ~15) | (15 - lane16); }
__device__ __forceinline__ float fk_unkey(int k) { k &= ~15; k ^= (k >> 31) & 0x7fffffff; return __int_as_float(k); }
__device__ __forceinline__ int row_max16i(int v) { v = max(v, dppi<0xB1>(v)); v = max(v, dppi<0x4E>(v)); v = max(v, dppi<0x141>(v)); v = max(v, dppi<0x140>(v)); return v; }
__device__ __forceinline__ void topk_phase(const GAS bf16_t* __restrict__ SC, const GAS bf16_t* __restrict__ Q, const GAS float* __restrict__ KSUM, GAS float* __restrict__ GATE, GAS int* __restrict__ EIDX, int nitems,
                                           LAS unsigned char* lds, int wid, int lane, int wave_gid, int nwaves) {
    LAS unsigned char* wb = lds + wid * 6144;
    LAS int* IDS1 = (LAS int*)wb; LAS int* IDS2 = (LAS int*)(wb + 2048); LAS int* LC1 = (LAS int*)(wb + 4096); LAS int* LC2 = (LAS int*)(wb + 4352); LAS int* CI = (LAS int*)(wb + 4608);
    LAS float* xv = (LAS float*)(wb + 4864); LAS int* DUMP = (LAS int*)(wb + 5120) + lane; LAS int* WL1 = (LAS int*)(wb + 5376); LAS int* WL2 = (LAS int*)(wb + 5632);
    const int lane16 = lane & 15, rowbase = lane & 48;
    u32x4 nqa, nqb, nsw, ntw;
#define TK_LOAD(wi_) do { int it_ = (wi_) * 4 + (lane >> 4); it_ = it_ < nitems ? it_ : nitems - 1; const GAS u32x4* qp_ = (const GAS u32x4*)(Q + (size_t)it_ * 256 + 16 * lane16); nqa = qp_[0]; nqb = qp_[1]; \
        const GAS bf16_t* sp_ = SC + (size_t)it_ * 256 + 8 * lane16; nsw = *(const GAS u32x4*)sp_; ntw = *(const GAS u32x4*)(sp_ + 128); } while (0)
    TK_LOAD(wave_gid);
    const GAS float* kp = KSUM + ((wave_gid * 4 + (lane >> 4)) & 7) * 256 + 8 * lane16; const f32x4 k0 = *(const GAS f32x4*)kp, k1 = *(const GAS f32x4*)(kp + 4), m0 = *(const GAS f32x4*)(kp + 128), m1 = *(const GAS f32x4*)(kp + 132);
    for (int wi = wave_gid; wi * 4 < nitems; wi += nwaves) {
        const int it = wi * 4 + (lane >> 4);
        const u32x4 qa = nqa, qb = nqb; const f32x4 s0 = (f32x4){bflo(nsw[0]), bfhi(nsw[0]), bflo(nsw[1]), bfhi(nsw[1])}, s1 = (f32x4){bflo(nsw[2]), bfhi(nsw[2]), bflo(nsw[3]), bfhi(nsw[3])},
                    t0 = (f32x4){bflo(ntw[0]), bfhi(ntw[0]), bflo(ntw[1]), bfhi(ntw[1])}, t1 = (f32x4){bflo(ntw[2]), bfhi(ntw[2]), bflo(ntw[3]), bfhi(ntw[3])};
        TK_LOAD(wi + nwaves);
        float qs = 0.f, qq = 0.f;
#pragma unroll
        for (int i = 0; i < 4; ++i) { const float a = bflo(qa[i]), b = bfhi(qa[i]), c = bflo(qb[i]), d = bfhi(qb[i]); qs += (a + b) + (c + d); qq += (a * a + b * b) + (c * c + d * d); }
        const float mu = row_sum16(qs) * (1.f / 256.f); const float var = fmaxf(row_sum16(qq) * (1.f / 256.f) - mu * mu, 0.f); const float rs = 1.f / sqrtf(var + 1e-5f);
        float v[8], u[8]; int id[8], jd[8];
        {
#pragma unroll
          for (int i = 0; i < 4; ++i) { v[i] = rs * (s0[i] - mu * k0[i]); v[4 + i] = rs * (s1[i] - mu * k1[i]); u[i] = rs * (t0[i] - mu * m0[i]); u[4 + i] = rs * (t1[i] - mu * m1[i]);
              id[i] = 8 * lane16 + i; id[4 + i] = 8 * lane16 + 4 + i; jd[i] = 8 * lane16 + i; jd[4 + i] = 8 * lane16 + 4 + i; } }
        FK_SORT8(v, id); FK_SORT8(u, jd);
#pragma unroll
        for (int i = 0; i < 8; ++i) { IDS1[lane * 8 + i] = id[i]; IDS2[lane * 8 + i] = jd[i]; }
        float rv1 = FK_NEG, rv2 = FK_NEG; int wl1 = 0, wl2 = 0, cn1 = 0, cn2 = 0;
#pragma unroll
        for (int r = 0; r < 16; ++r) {
            const int key1 = fk_key(v[0], lane16), key2 = fk_key(u[0], lane16);
            const int wm1 = row_max16i(key1), wm2 = row_max16i(key2);
            const bool mine = (key1 == wm1), nine = (key2 == wm2);
            if (lane16 == r) { rv1 = fk_unkey(wm1); wl1 = 15 - (wm1 & 15); rv2 = fk_unkey(wm2); wl2 = 15 - (wm2 & 15); }
            *(mine ? LC1 + rowbase + r : DUMP) = cn1; *(nine ? LC2 + rowbase + r : DUMP) = cn2;
#pragma unroll
            for (int i = 0; i < 7; ++i) { v[i] = mine ? v[i + 1] : v[i]; u[i] = nine ? u[i + 1] : u[i]; }
            v[7] = mine ? FK_NEG : v[7]; u[7] = nine ? FK_NEG : u[7]; cn1 += mine ? 1 : 0; cn2 += nine ? 1 : 0;
        }
        xv[lane] = rv2; WL1[lane] = wl1; WL2[lane] = wl2;
        float c[16];
        { const LAS f32x4* xp = (const LAS f32x4*)(xv + rowbase);
#pragma unroll
          for (int q = 0; q < 4; ++q) { const f32x4 t = xp[q]; c[4 * q] = rv1 + t.x; c[4 * q + 1] = rv1 + t.y; c[4 * q + 2] = rv1 + t.z; c[4 * q + 3] = rv1 + t.w; } }
        int p = 0, wli = 0; float sc = FK_NEG;
#pragma unroll
        for (int r = 0; r < 16; ++r) {
            const int key = fk_key(c[0], lane16); const int wm = row_max16i(key); const bool mine = (key == wm);
            if (lane16 == r) { sc = fk_unkey(wm); wli = 15 - (wm & 15); }
            *(mine ? CI + rowbase + r : DUMP) = p;
#pragma unroll
            for (int i = 0; i < 15; ++i) c[i] = mine ? c[i + 1] : c[i];
            c[15] = mine ? FK_NEG : c[15]; p += mine ? 1 : 0;
        }
        const int i1 = wli & 15, j2 = CI[rowbase + lane16] & 15;
        const int e1 = IDS1[(rowbase + (WL1[rowbase + i1] & 15)) * 8 + (LC1[rowbase + i1] & 7)], e2 = IDS2[(rowbase + (WL2[rowbase + j2] & 15)) * 8 + (LC2[rowbase + j2] & 7)];
        const float mx = fk_unkey(row_max16i(fk_key(sc, 0))); const float ex = __expf(sc - mx); const float den = row_sum16(ex);
        GATE[(size_t)it * 16 + lane16] = ex / den; EIDX[(size_t)it * 16 + lane16] = (e1 & 127) * 128 + (e2 & 127);
    }
#undef TK_LOAD
}

__device__ __forceinline__ f32x2 fp8lo(unsigned w) { return __builtin_amdgcn_cvt_pk_f32_fp8((int)w, false); }
__device__ __forceinline__ f32x2 fp8hi(unsigned w) { return __builtin_amdgcn_cvt_pk_f32_fp8((int)w, true); }
__device__ __forceinline__ void act_phase(const GAS bf16_t* __restrict__ XB, const GAS unsigned char* __restrict__ U8, const GAS float* __restrict__ GATE, const GAS int* __restrict__ EIDX, GAS float* __restrict__ COEF, int nitems,
                                          int lane, int wave_gid, int nwaves) {
    int it = wave_gid; if (it >= nitems) return;
    u32x4 uc[16], un[16], xac, xbc, xan, xbn;
    int evc = EIDX[(size_t)it * 16 + (lane & 15)];
    { const GAS u32x4* xp = (const GAS u32x4*)(XB + (size_t)(it >> 3) * 1024 + 16 * lane); xac = xp[0]; xbc = xp[1]; }
#pragma unroll
    for (int k = 0; k < 16; ++k) uc[k] = *(const GAS u32x4*)(U8 + (size_t)__builtin_amdgcn_readlane(evc, k) * 1024 + 16 * lane);
    int itn = it + nwaves; int evn = (itn < nitems) ? EIDX[(size_t)itn * 16 + (lane & 15)] : 0;
    for (;;) {
        const bool hasn = itn < nitems;
        if (hasn) {
            const GAS u32x4* xp = (const GAS u32x4*)(XB + (size_t)(itn >> 3) * 1024 + 16 * lane); xan = xp[0]; xbn = xp[1];
#pragma unroll
            for (int k = 0; k < 16; ++k) un[k] = *(const GAS u32x4*)(U8 + (size_t)__builtin_amdgcn_readlane(evn, k) * 1024 + 16 * lane);
        }
        const int itnn = itn + nwaves; const int evnn = (itnn < nitems) ? EIDX[(size_t)itnn * 16 + (lane & 15)] : 0;
        const float gt = GATE[(size_t)it * 16 + (lane >> 2)];
        float x[16];
#pragma unroll
        for (int i = 0; i < 4; ++i) { x[2 * i] = bflo(xac[i]); x[2 * i + 1] = bfhi(xac[i]); x[8 + 2 * i] = bflo(xbc[i]); x[8 + 2 * i + 1] = bfhi(xbc[i]); }
        float a[16];
#pragma unroll
        for (int k = 0; k < 16; ++k) { const u32x4 uw = uc[k]; float s = 0.f;
#pragma unroll
            for (int d = 0; d < 4; ++d) { const f32x2 lo = fp8lo(uw[d]), hi = fp8hi(uw[d]); s = fmaf(lo.x, x[4 * d], s); s = fmaf(lo.y, x[4 * d + 1], s); s = fmaf(hi.x, x[4 * d + 2], s); s = fmaf(hi.y, x[4 * d + 3], s); }
            asm volatile("" : "+v"(s)); a[k] = s; }
#pragma unroll
        for (int k = 0; k < 8; ++k) { const bool hi = lane & 32; const float send = hi ? a[k] : a[k + 8], keep = hi ? a[k + 8] : a[k]; a[k] = keep + shx(send, 32, lane); }
#pragma unroll
        for (int k = 0; k < 4; ++k) { const bool hi = lane & 16; const float send = hi ? a[k] : a[k + 4], keep = hi ? a[k + 4] : a[k]; a[k] = keep + shx(send, 16, lane); }
#pragma unroll
        for (int k = 0; k < 2; ++k) { const bool hi = lane & 8; const float send = hi ? a[k] : a[k + 2], keep = hi ? a[k + 2] : a[k]; a[k] = keep + shx(send, 8, lane); }
        { const bool hi = lane & 4; const float send = hi ? a[0] : a[1], keep = hi ? a[1] : a[0]; a[0] = keep + shx(send, 4, lane); }
        float dsum = a[0]; dsum += shx(dsum, 2, lane); dsum += shx(dsum, 1, lane);
        if ((lane & 3) == 0) COEF[(size_t)it * 16 + (lane >> 2)] = gt * gelu_tanh(dsum * (1.f / 128.f));
        if (!hasn) break;
#pragma unroll
        for (int k = 0; k < 16; ++k) uc[k] = un[k];
        xac = xan; xbc = xbn; evc = evn; evn = evnn; it = itn; itn = itnn;
    }
}

__device__ __forceinline__ void outln_phase(const GAS float* COEF, const GAS int* EIDX, const GAS unsigned char* V8,     const GAS float* __restrict__ lg, const GAS float* __restrict__ lb, GAS float* X, GAS bf16_t* XB, int nrows,
                                            int lane, int wave_gid, int nwaves) {
    const float alpha = 1.6817928305074292f;
    int row = wave_gid; if (row >= nrows) return;
    u32x4 vc[16], vn[16];
    float cf0 = COEF[(size_t)row * 128 + lane] * (1.f / 64.f), cf1 = COEF[(size_t)row * 128 + 64 + lane] * (1.f / 64.f); int ev0 = EIDX[(size_t)row * 128 + lane], ev1 = EIDX[(size_t)row * 128 + 64 + lane];
#define OUT_LOADCH(dst, evreg, base) do { _Pragma("unroll") for (int k_ = 0; k_ < 16; ++k_) dst[k_] = *(const GAS u32x4*)(V8 + (size_t)__builtin_amdgcn_readlane(evreg, (base) + k_) * 1024 + 16 * lane); } while (0)
#define OUT_COMPCH(src, cfreg, base) do { _Pragma("unroll") for (int k_ = 0; k_ < 16; ++k_) { const float c_ = __int_as_float(__builtin_amdgcn_readlane(__float_as_int(cfreg), (base) + k_)); const u32x4 vw_ = src[k_]; \
        _Pragma("unroll") for (int d_ = 0; d_ < 4; ++d_) { const f32x2 lo_ = fp8lo(vw_[d_]), hi_ = fp8hi(vw_[d_]); acc[4 * d_] = fmaf(c_, lo_.x, acc[4 * d_]); acc[4 * d_ + 1] = fmaf(c_, lo_.y, acc[4 * d_ + 1]); acc[4 * d_ + 2] = fmaf(c_, hi_.x, acc[4 * d_ + 2]); acc[4 * d_ + 3] = fmaf(c_, hi_.y, acc[4 * d_ + 3]); } \
        _Pragma("unroll") for (int p_ = 0; p_ < 16; ++p_) asm volatile("" : "+v"(acc[p_]));     \
        } } while (0)
    for (;;) {
        OUT_LOADCH(vc, ev0, 0);
        const int rown = row + nwaves; const bool hasn = rown < nrows;
        float ncf0 = 0.f, ncf1 = 0.f; int nev0 = 0, nev1 = 0;
        if (hasn) { ncf0 = COEF[(size_t)rown * 128 + lane] * (1.f / 64.f); ncf1 = COEF[(size_t)rown * 128 + 64 + lane] * (1.f / 64.f); nev0 = EIDX[(size_t)rown * 128 + lane]; nev1 = EIDX[(size_t)rown * 128 + 64 + lane]; }
        float acc[16];
#pragma unroll
        for (int k = 0; k < 16; ++k) acc[k] = 0.f;
#define OUT_FENCE() asm volatile("" ::: "memory")
        OUT_LOADCH(vn, ev0, 16); OUT_FENCE(); OUT_COMPCH(vc, cf0, 0); OUT_FENCE();
        OUT_LOADCH(vc, ev0, 32); OUT_FENCE(); OUT_COMPCH(vn, cf0, 16); OUT_FENCE();
        OUT_LOADCH(vn, ev0, 48); OUT_FENCE(); OUT_COMPCH(vc, cf0, 32); OUT_FENCE();
        OUT_LOADCH(vc, ev1, 0);  OUT_FENCE(); OUT_COMPCH(vn, cf0, 48); OUT_FENCE();
        OUT_LOADCH(vn, ev1, 16); OUT_FENCE(); OUT_COMPCH(vc, cf1, 0); OUT_FENCE();
        OUT_LOADCH(vc, ev1, 32); OUT_FENCE(); OUT_COMPCH(vn, cf1, 16); OUT_FENCE();
        OUT_LOADCH(vn, ev1, 48); OUT_FENCE(); OUT_COMPCH(vc, cf1, 32); OUT_FENCE();
        OUT_COMPCH(vn, cf1, 48); OUT_FENCE();
#undef OUT_FENCE
        GAS float* xr = X + (size_t)row * 1024 + 16 * lane; float t[16];
#pragma unroll
        for (int q = 0; q < 4; ++q) { const f32x4 xv = *(const GAS f32x4*)(xr + 4 * q); t[4 * q] = fmaf(alpha, xv.x, acc[4 * q]); t[4 * q + 1] = fmaf(alpha, xv.y, acc[4 * q + 1]); t[4 * q + 2] = fmaf(alpha, xv.z, acc[4 * q + 2]); t[4 * q + 3] = fmaf(alpha, xv.w, acc[4 * q + 3]); }
        float s = 0.f;
#pragma unroll
        for (int k = 0; k < 16; ++k) s += t[k];
        const float mu = wave_sum(s, lane) * (1.f / 1024.f); float vs = 0.f;
#pragma unroll
        for (int k = 0; k < 16; ++k) { t[k] -= mu; vs = fmaf(t[k], t[k], vs); }
        const float rs = 1.f / sqrtf(wave_sum(vs, lane) * (1.f / 1024.f) + 1e-5f);
        unsigned w[8];
#pragma unroll
        for (int q = 0; q < 4; ++q) { const f32x4 g = *(const GAS f32x4*)(lg + 16 * lane + 4 * q), b = *(const GAS f32x4*)(lb + 16 * lane + 4 * q); f32x4 o;
            o.x = t[4 * q] * rs * g.x + b.x; o.y = t[4 * q + 1] * rs * g.y + b.y; o.z = t[4 * q + 2] * rs * g.z + b.z; o.w = t[4 * q + 3] * rs * g.w + b.w;
            *(GAS f32x4*)(xr + 4 * q) = o; w[2 * q] = pk_bf16(o.x, o.y); w[2 * q + 1] = pk_bf16(o.z, o.w); }
        u32x4 w0, w1; w0.x = w[0]; w0.y = w[1]; w0.z = w[2]; w0.w = w[3]; w1.x = w[4]; w1.y = w[5]; w1.z = w[6]; w1.w = w[7];
        GAS u32x4* xbp = (GAS u32x4*)(XB + (size_t)row * 1024 + 16 * lane); xbp[0] = w0; xbp[1] = w1;
        if (!hasn) break;
        row = rown; cf0 = ncf0; cf1 = ncf1; ev0 = nev0; ev1 = nev1;
    }
#undef OUT_LOADCH
#undef OUT_COMPCH
}

__device__ __forceinline__ void lnres_phase(const GAS bf16_t* __restrict__ Y, const GAS float* __restrict__ lg, const GAS float* __restrict__ lb, GAS float* X, GAS bf16_t* XB, GAS unsigned char* XF8, int nrows, int lane, int wave_gid, int nwaves) {
    const float alpha = 1.6817928305074292f; (void)X;
    for (int row = wave_gid; row < nrows; row += nwaves) {
        GAS bf16_t* xr = XB + (size_t)row * 1024; const GAS bf16_t* yr = Y + (size_t)row * 1024; float t[16];
#pragma unroll
        for (int q = 0; q < 4; ++q) { const u32x2 xw = *(const GAS u32x2*)(xr + 256 * q + 4 * lane); const u32x2 yw = *(const GAS u32x2*)(yr + 256 * q + 4 * lane);
            t[4 * q] = fmaf(alpha, bflo(xw.x), bflo(yw.x)); t[4 * q + 1] = fmaf(alpha, bfhi(xw.x), bfhi(yw.x)); t[4 * q + 2] = fmaf(alpha, bflo(xw.y), bflo(yw.y)); t[4 * q + 3] = fmaf(alpha, bfhi(xw.y), bfhi(yw.y)); }
        float s = 0.f;
#pragma unroll
        for (int k = 0; k < 16; ++k) s += t[k];
        const float mu = wave_sum(s, lane) * (1.f / 1024.f); float vs = 0.f;
#pragma unroll
        for (int k = 0; k < 16; ++k) { t[k] -= mu; vs = fmaf(t[k], t[k], vs); }
        const float rs = 1.f / sqrtf(wave_sum(vs, lane) * (1.f / 1024.f) + 1e-5f);
#pragma unroll
        for (int q = 0; q < 4; ++q) { const int c = 256 * q + 4 * lane; const f32x4 g = *(const GAS f32x4*)(lg + c), b = *(const GAS f32x4*)(lb + c); f32x4 o;
            o.x = t[4 * q] * rs * g.x + b.x; o.y = t[4 * q + 1] * rs * g.y + b.y; o.z = t[4 * q + 2] * rs * g.z + b.z; o.w = t[4 * q + 3] * rs * g.w + b.w;
            u32x2 w; w.x = pk_bf16(o.x, o.y); w.y = pk_bf16(o.z, o.w); *(GAS u32x2*)(xr + c) = w;
            if (XF8) {
                const float s0 = __builtin_amdgcn_fmed3f(o.x * 16.f, -448.f, 448.f), s1 = __builtin_amdgcn_fmed3f(o.y * 16.f, -448.f, 448.f), s2 = __builtin_amdgcn_fmed3f(o.z * 16.f, -448.f, 448.f), s3 = __builtin_amdgcn_fmed3f(o.w * 16.f, -448.f, 448.f);
                int hp = __builtin_amdgcn_cvt_pk_fp8_f32(s0, s1, 0, false); hp = __builtin_amdgcn_cvt_pk_fp8_f32(s2, s3, hp, true);
                const f32x2 d01 = fp8lo((unsigned)hp), d23 = fp8hi((unsigned)hp);
                int lp = __builtin_amdgcn_cvt_pk_fp8_f32(s0 - d01.x, s1 - d01.y, 0, false); lp = __builtin_amdgcn_cvt_pk_fp8_f32(s2 - d23.x, s3 - d23.y, lp, true);
                *(GAS int*)(XF8 + (size_t)row * 2048 + c) = hp; *(GAS int*)(XF8 + (size_t)row * 2048 + 1024 + c) = lp; } }
    }
}

__device__ __forceinline__ void glanorm_phase(const GAS float* __restrict__ O, const GAS float* __restrict__ PROJ, const GAS float* __restrict__ gnorm, GAS bf16_t* XB, int nitems, int lane, int wave_gid, int nwaves) {
    const float g0 = gnorm[lane], g1 = gnorm[64 + lane];
    for (int it0 = wave_gid * 8; it0 < nitems; it0 += nwaves * 8) {
        float a0[8], a1[8], r0[8], r1[8];
#pragma unroll
        for (int q = 0; q < 8; ++q) { int it = it0 + q; it = it < nitems ? it : it0; const int row = it >> 2, h = it & 3; const GAS float* o = O + (size_t)row * 512 + h * 128; const GAS float* r = PROJ + (size_t)row * 2576 + 1040 + h * 128;
            a0[q] = o[lane]; a1[q] = o[64 + lane]; r0[q] = r[lane]; r1[q] = r[64 + lane]; }
#pragma unroll
        for (int q = 0; q < 8; ++q) { const int it = it0 + q; const int row = it >> 2, h = it & 3;
            const float rs = 1.f / sqrtf(wave_sum(a0[q] * a0[q] + a1[q] * a1[q], lane) * (1.f / 128.f) + 1e-5f);
            const float y0 = a0[q] * rs * g0 * (r0[q] * frcp(1.f + __expf(-r0[q]))), y1 = a1[q] * rs * g1 * (r1[q] * frcp(1.f + __expf(-r1[q])));
            if (it < nitems) { GAS bf16_t* d = XB + (size_t)row * 1024 + h * 128; d[lane] = (bf16_t)(pk_bf16(y0, 0.f) & 0xffffu); d[64 + lane] = (bf16_t)(pk_bf16(y1, 0.f) & 0xffffu); } }
    }
}

__device__ __forceinline__ float sigm(float x) { return frcp(1.f + __expf(-x)); }
__device__ __forceinline__ float softplusf(float x) { return fmaxf(x, 0.f) + log1pf(__expf(-fabsf(x))); }
__device__ __forceinline__ void rwkvprep_phase(const GAS float* __restrict__ w0, const GAS float* __restrict__ a0, const GAS float* __restrict__ v0, const GAS float* __restrict__ k_k, const GAS float* __restrict__ k_a, const GAS float* __restrict__ Vg,
                                               GAS float* K, GAS float* Wd, GAS float* Aa, GAS float* V, GAS float* NKK, GAS float* VFIRST, int has_vres, int nitems, int lane, int wave_gid, int nwaves) {
    for (int it0 = wave_gid * 4; it0 < nitems; it0 += nwaves * 4) {
        float kq[4], wq[4], aq[4], vq[4], gq[4], fq[4];
#pragma unroll
        for (int q = 0; q < 4; ++q) { const int it = it0 + q; const size_t ix = (size_t)(it >> 4) * 1024 + (it & 15) * 64 + lane; kq[q] = K[ix]; wq[q] = Wd[ix]; aq[q] = Aa[ix]; vq[q] = V[ix]; gq[q] = has_vres ? Vg[ix] : 0.f; fq[q] = has_vres ? VFIRST[ix] : 0.f; }
#pragma unroll
        for (int q = 0; q < 4; ++q) { const int it = it0 + q; const int h = it & 15; const size_t ix = (size_t)(it >> 4) * 1024 + h * 64 + lane; const int c = h * 64 + lane;
            const float k0 = kq[q]; const float kv = k0 * k_k[c]; const float inv = 1.f / fmaxf(sqrtf(wave_sum(kv * kv, lane)), 1e-12f);
            const float w = -softplusf(-(w0[c] + wq[q])) - 0.5f; const float dec = __expf(-__expf(w));
            const float a = sigm(a0[c] + aq[q]);
            float v = vq[q]; if (has_vres) v = v + (fq[q] - v) * sigm(v0[c] + gq[q]); else VFIRST[ix] = v;
            const float kk = kv * inv;
            NKK[ix] = -kk; K[ix] = k0 * (1.f + (a - 1.f) * k_a[c]); Wd[ix] = dec; Aa[ix] = kk * a; V[ix] = v; }
    }
}

__device__ __forceinline__ void rwkvpost_phase(const GAS float* __restrict__ Y, const GAS float* __restrict__ R, const GAS float* __restrict__ K2, const GAS float* __restrict__ V, const GAS float* __restrict__ G, const GAS float* __restrict__ r_k,
                                               const GAS float* __restrict__ lnx_g, const GAS float* __restrict__ lnx_b, GAS bf16_t* XB, int nitems, int lane, int wave_gid, int nwaves) {
    for (int it0 = wave_gid * 4; it0 < nitems; it0 += nwaves * 4) {
        float yq[4], rq[4], kq[4], vq[4], gq[4];
#pragma unroll
        for (int q = 0; q < 4; ++q) { const int it = it0 + q; const size_t ix = (size_t)(it >> 4) * 1024 + (it & 15) * 64 + lane; yq[q] = Y[ix]; rq[q] = R[ix]; kq[q] = K2[ix]; vq[q] = V[ix]; gq[q] = G[ix]; }
#pragma unroll
        for (int q = 0; q < 4; ++q) { const int it = it0 + q; const int h = it & 15; const size_t ix = (size_t)(it >> 4) * 1024 + h * 64 + lane; const int c = h * 64 + lane;
            const float y = yq[q]; const float mu = wave_sum(y, lane) * (1.f / 64.f); const float d = y - mu; const float rs = 1.f / sqrtf(wave_sum(d * d, lane) * (1.f / 64.f) + 64e-5f);
            const float bon = wave_sum(rq[q] * kq[q] * r_k[c], lane);
            const float o = (d * rs * lnx_g[c] + lnx_b[c] + bon * vq[q]) * gq[q];
            XB[ix] = (bf16_t)(pk_bf16(o, 0.f) & 0xffffu); }
    }
}

__device__ __forceinline__ void wkv_phase(const GAS float* __restrict__ R, const GAS float* __restrict__ Wd, const GAS float* __restrict__ K2, const GAS float* __restrict__ V, const GAS float* __restrict__ BB, const GAS float* __restrict__ NKK,
                                          const GAS float* __restrict__ SIN, GAS float* __restrict__ Y, GAS float* __restrict__ P, GAS float* __restrict__ SOUT, int B, int T, int DB, int DT, LAS unsigned char* lds, int tid, int bid, int nb) {
    constexpr int TB = 32, NLD = 6, VECB = TB * 1280, VVB = TB * 128, BUF = VECB + 2 * VVB;
    const int rowl = tid >> 4, part = tid & 15;
    const int nprompt = B * 32, nunits = nprompt + DB * 32;
    for (int u = bid; u < nunits; u += nb) {
        const bool smp = u >= nprompt; const int q0_ = smp ? u - nprompt : u; const int q = ((q0_ & 7) << 1 | ((q0_ >> 3) & 1)) + ((q0_ >> 4) << 4);
        const int half = q & 1, pair = q >> 1, sq = pair >> 4, h = pair & 15;
        const int Tu = smp ? DT : T; const int r0 = smp ? B * T + sq * DT : sq * T, vrow = half * 32 + rowl;
        f32x2 S01 = (f32x2){0.f, 0.f}, S23 = (f32x2){0.f, 0.f};
        if (smp) { const f32x4 s4 = *(const GAS f32x4*)(SIN + ((size_t)pair * 64 + vrow) * 64 + part * 4); S01 = (f32x2){s4.x, s4.y}; S23 = (f32x2){s4.z, s4.w};
                   asm volatile("" : "+v"(S01), "+v"(S23)); }
        const int nblk = (Tu + TB - 1) / TB;
        f32x4 ld[NLD];
        const size_t eo_ = (size_t)(r0 + (tid >> 4)) * 1024 + h * 64 + (tid & 15) * 4, ev_ = (size_t)(r0 + ((tid & 255) >> 3)) * 1024 + h * 64 + half * 32 + (tid & 7) * 4;
        const int lo_ = ((tid >> 4) * 320 + (tid & 15) * 4) * 4, lv_ = VECB + (tid & 255) * 16;
#define WKV_LOAD(tb0) do { const size_t bo_ = (size_t)(tb0) * 1024; ld[0] = *(const GAS f32x4*)(Wd + eo_ + bo_); ld[1] = *(const GAS f32x4*)(NKK + eo_ + bo_); ld[2] = *(const GAS f32x4*)(BB + eo_ + bo_); \
            ld[3] = *(const GAS f32x4*)(K2 + eo_ + bo_); ld[4] = *(const GAS f32x4*)(R + eo_ + bo_); ld[5] = *(const GAS f32x4*)(V + ev_ + bo_); } while (0)
#define WKV_STORE(bufp) do { _Pragma("unroll") for (int q_ = 0; q_ < 5; ++q_) *(LAS f32x4*)((bufp) + lo_ + q_ * 256) = ld[q_]; *(LAS f32x4*)((bufp) + lv_) = ld[5]; } while (0)
        WKV_LOAD(0); WKV_STORE(lds); __syncthreads();
        for (int b = 0; b < nblk; ++b) {
            LAS unsigned char* cur = lds + (b & 1) * BUF; LAS unsigned char* nxt = lds + ((b + 1) & 1) * BUF; const int tb0 = b * TB; const int nt = (Tu - tb0) < TB ? (Tu - tb0) : TB;
            if (b + 1 < nblk) WKV_LOAD(tb0 + TB);
            const LAS float* vec = (const LAS float*)cur + part * 4; const LAS float* vv = (const LAS float*)(cur + VECB) + rowl; LAS float* yb = (LAS float*)(cur + VECB + VVB);
            float ykeep0 = 0.f, ykeep1 = 0.f;
#define WKV_STEP(t, keep, tl) do { const LAS f32x2* vp_ = (const LAS f32x2*)(vec + (t) * 320); \
                const f32x2 w01 = vp_[0], w23 = vp_[1], n01 = vp_[32], n23 = vp_[33], b01 = vp_[64], b23 = vp_[65], k01 = vp_[96], k23 = vp_[97], r01 = vp_[128], r23 = vp_[129]; \
                const float v = vv[(t) * 32]; \
                const f32x2 sp = __builtin_elementwise_fma(S23, n23, S01 * n01); const float sa = row_sum16(sp.x + sp.y); const f32x2 sa2 = (f32x2){sa, sa}, v2 = (f32x2){v, v}; \
                S01 = __builtin_elementwise_fma(S01, w01, __builtin_elementwise_fma(b01, sa2, k01 * v2)); S23 = __builtin_elementwise_fma(S23, w23, __builtin_elementwise_fma(b23, sa2, k23 * v2)); \
                const f32x2 yp = __builtin_elementwise_fma(S23, r23, S01 * r01); const float y = row_sum16(yp.x + yp.y); \
                keep = (part == (tl)) ? y : keep; } while (0)
            if (nt == TB) {
#pragma unroll 1
                for (int t = 0; t < 16; t += 8) { WKV_STEP(t, ykeep0, t); WKV_STEP(t + 1, ykeep0, t + 1); WKV_STEP(t + 2, ykeep0, t + 2); WKV_STEP(t + 3, ykeep0, t + 3); WKV_STEP(t + 4, ykeep0, t + 4); WKV_STEP(t + 5, ykeep0, t + 5); WKV_STEP(t + 6, ykeep0, t + 6); WKV_STEP(t + 7, ykeep0, t + 7); }
#pragma unroll 1
                for (int t = 16; t < 32; t += 8) { WKV_STEP(t, ykeep1, t - 16); WKV_STEP(t + 1, ykeep1, t - 15); WKV_STEP(t + 2, ykeep1, t - 14); WKV_STEP(t + 3, ykeep1, t - 13); WKV_STEP(t + 4, ykeep1, t - 12); WKV_STEP(t + 5, ykeep1, t - 11); WKV_STEP(t + 6, ykeep1, t - 10); WKV_STEP(t + 7, ykeep1, t - 9); }
            } else { for (int t = 0; t < nt; ++t) { if (t < 16) WKV_STEP(t, ykeep0, t); else WKV_STEP(t, ykeep1, t - 16); } }
#undef WKV_STEP
            yb[part * 32 + rowl] = ykeep0; yb[(16 + part) * 32 + rowl] = ykeep1;
            if (b + 1 < nblk) WKV_STORE(nxt);
            __syncthreads();
            { const int rl = tid & 31; _Pragma("unroll") for (int t = tid >> 5; t < TB; t += 16) if (t < nt) Y[(size_t)(r0 + tb0 + t) * 1024 + h * 64 + half * 32 + rl] = yb[t * 32 + rl]; }
        }
#undef WKV_LOAD
#undef WKV_STORE
        *(GAS f32x4*)((smp ? SOUT : P) + ((size_t)pair * 64 + vrow) * 64 + part * 4) = (f32x4){S01.x, S01.y, S23.x, S23.y};
        __syncthreads();
    }
}

__device__ __forceinline__ void rwkvpost2_phase(const GAS bf16_t* __restrict__ Y, const GAS bf16_t* __restrict__ G, const GAS bf16_t* __restrict__ VF, const GAS float* __restrict__ BON, const GAS float* __restrict__ lnx_g, const GAS float* __restrict__ lnx_b,
                                                GAS bf16_t* XB, int nitems, int lane, int wave_gid, int nwaves) {
    const int nit4 = nitems >> 2, hg = wave_gid & 3, cofs = hg * 256 + 4 * lane; const f32x4 lg = *(const GAS f32x4*)(lnx_g + cofs), lb = *(const GAS f32x4*)(lnx_b + cofs);
    for (int it0 = wave_gid; it0 < nit4; it0 += nwaves * 4) {
        u32x2 yq[4], vq[4], gq[4]; float bq[4];
#pragma unroll
        for (int q = 0; q < 4; ++q) { int it = it0 + q * nwaves; it = it < nit4 ? it : it0; const int row = it >> 2; const size_t ix = (size_t)row * 1024 + cofs;
            yq[q] = *(const GAS u32x2*)(Y + ix); vq[q] = *(const GAS u32x2*)(VF + ix); gq[q] = *(const GAS u32x2*)(G + ix); bq[q] = BON[row * 16 + hg * 4 + (lane >> 4)]; }
#pragma unroll
        for (int q = 0; q < 4; ++q) { const int it = it0 + q * nwaves; const int row = it >> 2; const f32x4 y = (f32x4){bflo(yq[q].x), bfhi(yq[q].x), bflo(yq[q].y), bfhi(yq[q].y)}, vv4 = (f32x4){bflo(vq[q].x), bfhi(vq[q].x), bflo(vq[q].y), bfhi(vq[q].y)};
            const float mu = row_sum16((y.x + y.y) + (y.z + y.w)) * (1.f / 64.f); const f32x4 d = y - mu; const float rs = __builtin_amdgcn_rsqf(row_sum16((d.x * d.x + d.y * d.y) + (d.z * d.z + d.w * d.w)) * (1.f / 64.f) + 64e-5f);
            const f32x4 gg = (f32x4){bflo(gq[q].x), bfhi(gq[q].x), bflo(gq[q].y), bfhi(gq[q].y)}; const f32x4 o = (d * rs * lg + lb + bq[q] * vv4) * gg;
            if (it < nit4) { u32x2 w_; w_.x = pk_bf16(o.x, o.y); w_.y = pk_bf16(o.z, o.w); *(GAS u32x2*)(XB + (size_t)row * 1024 + cofs) = w_; } }
    }
}

__device__ __forceinline__ void wkv2_phase(const GAS bf16_t* __restrict__ R, const GAS bf16_t* __restrict__ KR, const GAS bf16_t* __restrict__ WL, const GAS bf16_t* __restrict__ AL, const GAS bf16_t* __restrict__ V, const GAS bf16_t* __restrict__ VG,
                                           const GAS bf16_t* VFI, const GAS float* __restrict__ PRM, const GAS float* __restrict__ SIN, GAS bf16_t* __restrict__ Y, GAS float* __restrict__ P, GAS float* __restrict__ SOUT, GAS bf16_t* VFO, GAS float* __restrict__ BON,
                                           int has_vres, int B, int T, int DB, int DT, LAS unsigned char* lds, int tid, int bid, int nb) {
    constexpr int TB = 32, VECB = TB * 1280, VVB = TB * 128, BUF = VECB + 2 * VVB;
    const bool scanw = __builtin_amdgcn_readfirstlane(tid) < 256; const int pt = tid & 255;
    const int rowl = pt >> 4, part = pt & 15;
    const int nprompt = B * 32, nunits = nprompt + DB * 32;
    for (int u = bid; u < nunits; u += nb) {
        const bool smp = u >= nprompt; const int q0_ = smp ? u - nprompt : u; const int q = ((q0_ & 7) << 1 | ((q0_ >> 3) & 1)) + ((q0_ >> 4) << 4);
        const int half = q & 1, pair = q >> 1, sq = pair >> 4, h = pair & 15;
        const int Tu = smp ? DT : T; const int r0 = smp ? B * T + sq * DT : sq * T, vrow = half * 32 + rowl;
        const int srow = pt >> 3, sp8 = pt & 7;
        f32x2 S0 = (f32x2){0.f, 0.f}, S1 = (f32x2){0.f, 0.f}, S2 = (f32x2){0.f, 0.f}, S3 = (f32x2){0.f, 0.f};
        if (smp && scanw) { const GAS f32x4* sp_ = (const GAS f32x4*)(SIN + ((size_t)pair * 64 + half * 32 + srow) * 64 + sp8 * 8); const f32x4 sa4 = sp_[0], sb4 = sp_[1];
                   S0 = (f32x2){sa4.x, sa4.y}; S1 = (f32x2){sa4.z, sa4.w}; S2 = (f32x2){sb4.x, sb4.y}; S3 = (f32x2){sb4.z, sb4.w};
                   asm volatile("" : "+v"(S0), "+v"(S1), "+v"(S2), "+v"(S3)); }
        const int nblk = (Tu + TB - 1) / TB;
        u32x2 lk0, lw0, la0, lr0, lk1, lw1, la1, lr1, lv, lg = (u32x2){0u, 0u}, lf = (u32x2){0u, 0u};
        const size_t eo_ = (size_t)(r0 + (pt >> 4)) * 1024 + h * 64 + part * 4, ev_ = (size_t)(r0 + (pt >> 3)) * 1024 + h * 64 + half * 32 + (pt & 7) * 4;
        const int lo_ = ((pt >> 4) * 320 + part * 4) * 4, lv_ = VECB + pt * 16;
        const int pc_ = h * 64 + part * 4; const f32x4 w0v = *(const GAS f32x4*)(PRM + pc_), a0v = *(const GAS f32x4*)(PRM + 1024 + pc_), kkp = *(const GAS f32x4*)(PRM + 3072 + pc_), kap = *(const GAS f32x4*)(PRM + 4096 + pc_), rkp = *(const GAS f32x4*)(PRM + 5120 + pc_);
        const f32x4 v0v = *(const GAS f32x4*)(PRM + 2048 + h * 64 + half * 32 + (pt & 7) * 4);
#define WKV_LOAD(tb0) do { const size_t bo_ = (size_t)(tb0) * 1024, b1_ = bo_ + 16 * 1024; lk0 = *(const GAS u32x2*)(KR + eo_ + bo_); lw0 = *(const GAS u32x2*)(WL + eo_ + bo_); la0 = *(const GAS u32x2*)(AL + eo_ + bo_); lr0 = *(const GAS u32x2*)(R + eo_ + bo_); \
            lk1 = *(const GAS u32x2*)(KR + eo_ + b1_); lw1 = *(const GAS u32x2*)(WL + eo_ + b1_); la1 = *(const GAS u32x2*)(AL + eo_ + b1_); lr1 = *(const GAS u32x2*)(R + eo_ + b1_); \
            lv = *(const GAS u32x2*)(V + ev_ + bo_); if (has_vres) { lg = *(const GAS u32x2*)(VG + ev_ + bo_); lf = *(const GAS u32x2*)(VFI + ev_ + bo_); } } while (0)
#define WKV_UNPK(w_) ((f32x4){bflo((w_).x), bfhi((w_).x), bflo((w_).y), bfhi((w_).y)})
#define WKV_ITEM(bufp, tb0, lk, lw, la, lr, ti_) do { const f32x4 k4 = WKV_UNPK(lk), wl4 = WKV_UNPK(lw), al4 = WKV_UNPK(la); const f32x4 kv = k4 * kkp; const float ss = row_sum16((kv.x * kv.x + kv.y * kv.y) + (kv.z * kv.z + kv.w * kv.w)); const float inv = frcp(fmaxf(fsqrt(ss), 1e-12f)); \
            f32x4 dec, a4; _Pragma("unroll") for (int i_ = 0; i_ < 4; ++i_) { dec[i_] = __expf(-0.6065306597126334f * frcp(1.f + __expf(-(w0v[i_] + wl4[i_])))); a4[i_] = frcp(1.f + __expf(-(a0v[i_] + al4[i_]))); } \
            const f32x4 kk = kv * inv; const f32x4 k2 = k4 * ((a4 - 1.f) * kap + 1.f); const f32x4 r4 = WKV_UNPK(lr); const f32x4 rk = r4 * k2 * rkp; const float bon = row_sum16((rk.x + rk.y) + (rk.z + rk.w)); \
            LAS unsigned char* d_ = (bufp) + lo_ + (ti_) * 1280; *(LAS f32x4*)(d_) = dec; *(LAS f32x4*)(d_ + 256) = -kk; *(LAS f32x4*)(d_ + 512) = kk * a4; *(LAS f32x4*)(d_ + 768) = k2; *(LAS f32x4*)(d_ + 1024) = r4; \
            const int tr_ = (tb0) + (pt >> 4) + (ti_); if (half == 0 && part == 0 && tr_ < Tu) BON[(size_t)(r0 + tr_) * 16 + h] = bon; } while (0)
#define WKV_STORE(bufp, tb0) do { WKV_ITEM(bufp, tb0, lk0, lw0, la0, lr0, 0); if ((tb0) + 16 < Tu) WKV_ITEM(bufp, tb0, lk1, lw1, la1, lr1, 16); \
            f32x4 v4 = WKV_UNPK(lv); if (has_vres) { const f32x4 g4 = WKV_UNPK(lg), f4 = WKV_UNPK(lf); _Pragma("unroll") for (int i_ = 0; i_ < 4; ++i_) v4[i_] = v4[i_] + (f4[i_] - v4[i_]) * frcp(1.f + __expf(-(v0v[i_] + g4[i_]))); } \
            *(LAS f32x4*)((bufp) + lv_) = v4; const int tv_ = (tb0) + (pt >> 3); if (tv_ < Tu) { u32x2 w_; w_.x = pk_bf16(v4.x, v4.y); w_.y = pk_bf16(v4.z, v4.w); *(GAS u32x2*)(VFO + ev_ + (size_t)(tb0) * 1024) = w_; } } while (0)
#define WKV_YOUT(bufp, tb0, ntp) do { const LAS float* yb_ = (const LAS float*)((bufp) + VECB + VVB); const int rl = (pt & 15) * 2; _Pragma("unroll") for (int t = pt >> 4; t < TB; t += 16) if (t < (ntp)) { const f32x2 y2 = *(const LAS f32x2*)(yb_ + t * 32 + rl); \
            *(GAS unsigned*)(Y + (size_t)(r0 + (tb0) + t) * 1024 + h * 64 + half * 32 + rl) = pk_bf16(y2.x, y2.y); } } while (0)
        if (!scanw) { WKV_LOAD(0); WKV_STORE(lds, 0); if (nblk > 1) WKV_LOAD(TB); }
        __syncthreads();
        for (int b = 0; b < nblk; ++b) {
            LAS unsigned char* cur = lds + (b & 1) * BUF; LAS unsigned char* nxt = lds + ((b + 1) & 1) * BUF; const int tb0 = b * TB; const int nt = (Tu - tb0) < TB ? (Tu - tb0) : TB;
            if (scanw) {
                const LAS float* vec = (const LAS float*)cur + sp8 * 8; const LAS float* vv = (const LAS float*)(cur + VECB) + srow; LAS float* yb = (LAS float*)(cur + VECB + VVB);
                LAS float* ybl = yb + srow;
                struct StepV { f32x4 w0, w1, n0, n1, b0, b1, k0, k1, r0, r1; float v; };
#define WKV_RD(dst, t) do { const LAS f32x4* vp_ = (const LAS f32x4*)(vec + (t) * 320); dst.w0 = vp_[0]; dst.w1 = vp_[1]; dst.n0 = vp_[16]; dst.n1 = vp_[17]; dst.b0 = vp_[32]; dst.b1 = vp_[33]; \
                dst.k0 = vp_[48]; dst.k1 = vp_[49]; dst.r0 = vp_[64]; dst.r1 = vp_[65]; dst.v = vv[(t) * 32]; } while (0)
#define WKV_LO(q_) ((f32x2){(q_).x, (q_).y})
#define WKV_HI(q_) ((f32x2){(q_).z, (q_).w})
#define WKV_UPD(S, w_, b_, k_) S = __builtin_elementwise_fma(S, w_, __builtin_elementwise_fma(b_, sa2, (k_) * v2))
#define WKV_CMP(src, t_) do { const f32x2 spa = __builtin_elementwise_fma(S1, WKV_HI(src.n0), S0 * WKV_LO(src.n0)), spb = __builtin_elementwise_fma(S3, WKV_HI(src.n1), S2 * WKV_LO(src.n1)); const f32x2 sp = spa + spb; \
                const float sa = row_sum8(sp.x + sp.y); const f32x2 sa2 = (f32x2){sa, sa}, v2 = (f32x2){src.v, src.v}; \
                WKV_UPD(S0, WKV_LO(src.w0), WKV_LO(src.b0), WKV_LO(src.k0)); WKV_UPD(S1, WKV_HI(src.w0), WKV_HI(src.b0), WKV_HI(src.k0)); WKV_UPD(S2, WKV_LO(src.w1), WKV_LO(src.b1), WKV_LO(src.k1)); WKV_UPD(S3, WKV_HI(src.w1), WKV_HI(src.b1), WKV_HI(src.k1)); \
                const f32x2 ypa = __builtin_elementwise_fma(S1, WKV_HI(src.r0), S0 * WKV_LO(src.r0)), ypb = __builtin_elementwise_fma(S3, WKV_HI(src.r1), S2 * WKV_LO(src.r1)); const f32x2 yp = ypa + ypb; \
                ybl[(t_) * 32] = row_sum8(yp.x + yp.y); } while (0)
#define WKV_ST(t_, cur_, nx2_) do { WKV_RD(nx2_, ((t_) + 2) & 31); __builtin_amdgcn_sched_barrier(0); WKV_CMP(cur_, t_); } while (0)
                if (nt == TB) {
                    StepV sA, sB, sC; WKV_RD(sA, 0); WKV_RD(sB, 1);
#pragma unroll 1
                    for (int t = 0; t < 30; t += 3) { WKV_ST(t, sA, sC); WKV_ST(t + 1, sB, sA); WKV_ST(t + 2, sC, sB); }
                    WKV_ST(30, sA, sC); WKV_ST(31, sB, sA);
                } else { StepV sA; for (int t = 0; t < nt; ++t) { WKV_RD(sA, t); WKV_CMP(sA, t); } }
#undef WKV_RD
#undef WKV_LO
#undef WKV_HI
#undef WKV_UPD
#undef WKV_CMP
#undef WKV_ST
            } else {
                if (b > 0) WKV_YOUT(nxt, tb0 - TB, TB);
                if (b + 1 < nblk) { WKV_STORE(nxt, tb0 + TB); if (b + 2 < nblk) WKV_LOAD(tb0 + 2 * TB); }
            }
            __syncthreads();
        }
        if (!scanw) { const int tbl = (nblk - 1) * TB; WKV_YOUT(lds + ((nblk - 1) & 1) * BUF, tbl, Tu - tbl); }
#undef WKV_LOAD
#undef WKV_STORE
#undef WKV_ITEM
#undef WKV_YOUT
#undef WKV_UNPK
        if (scanw) { GAS float* so = (smp ? SOUT : P) + ((size_t)pair * 64 + half * 32 + srow) * 64 + sp8 * 8; *(GAS f32x4*)so = (f32x4){S0.x, S0.y, S1.x, S1.y}; *(GAS f32x4*)(so + 4) = (f32x4){S2.x, S2.y, S3.x, S3.y}; }
        __syncthreads();
    }
}

__device__ __forceinline__ void gla_phase(const GAS float* __restrict__ PROJ, const GAS float* __restrict__ LOGA, GAS float* __restrict__ O, GAS float* __restrict__ P, int B, int T, LAS unsigned char* lds, int tid, int bid, int nb) {
    constexpr int TB = 32, OA = 0, OK = 8192, OQ = 16384, OV = 24576, BUF = 26624;
    const int wv = __builtin_amdgcn_readfirstlane(tid) >> 6; const bool scanw = wv < 4; const int pt = tid & 255, lane = tid & 63;
    const int col = pt >> 4, p = pt & 15, dk = p * 4;
    const int nunits = B * 32;
#define GLA_WAITV(n_) asm volatile("s_waitcnt vmcnt(" #n_ ")" ::: "memory")
#define GLA_BAR() do { asm volatile("s_waitcnt lgkmcnt(0)" ::: "memory"); __builtin_amdgcn_s_barrier(); asm volatile("" ::: "memory"); } while (0)
    for (int u = bid; u < nunits; u += nb) {
        const int ug_ = ((u & 7) << 3 | ((u >> 3) & 7)) + ((u >> 6) << 6);
        const int cb = ug_ & 7, pair = ug_ >> 3, s = pair >> 2, h = pair & 3; const int r0 = s * T;
        f32x2 S01 = (f32x2){0.f, 0.f}, S23 = (f32x2){0.f, 0.f};
        const int nblk = (T + TB - 1) / TB;
        const GAS unsigned char* gsrc; size_t gins, gblk; int ldst;
        if (wv == 4) { gsrc = (const GAS unsigned char*)(LOGA + (size_t)(r0 + (lane >> 4)) * 256 + h * 64 + (lane & 15) * 4); gins = (size_t)4 * 256 * 4; gblk = (size_t)TB * 256 * 4; ldst = OA; }
        else if (wv == 7) { gsrc = (const GAS unsigned char*)(PROJ + (size_t)(r0 + (lane >> 2)) * 2576 + 512 + h * 128 + cb * 16 + (lane & 3) * 4); gins = (size_t)16 * 2576 * 4; gblk = (size_t)TB * 2576 * 4; ldst = OV; }
        else { gsrc = (const GAS unsigned char*)(PROJ + (size_t)(r0 + (lane >> 4)) * 2576 + (wv == 5 ? 256 : 0) + h * 64 + (lane & 15) * 4); gins = (size_t)4 * 2576 * 4; gblk = (size_t)TB * 2576 * 4; ldst = wv == 5 ? OK : OQ; }
#define GLA_DMA(blk_) do { const GAS unsigned char* s_ = gsrc + (size_t)(blk_) * gblk; LAS unsigned char* d_ = lds + ((blk_) % 3) * BUF + ldst; \
            if (wv == 7) { __builtin_amdgcn_global_load_lds((const GAS unsigned*)s_, (LAS unsigned*)d_, 16, 0, 0); __builtin_amdgcn_global_load_lds((const GAS unsigned*)(s_ + gins), (LAS unsigned*)(d_ + 1024), 16, 0, 0); } \
            else { _Pragma("unroll") for (int i_ = 0; i_ < 8; ++i_) __builtin_amdgcn_global_load_lds((const GAS unsigned*)(s_ + i_ * gins), (LAS unsigned*)(d_ + i_ * 1024), 16, 0, 0); } } while (0)
        if (!scanw) { GLA_DMA(0); if (nblk > 1) { GLA_DMA(1); if (wv == 7) GLA_WAITV(2); else GLA_WAITV(8); } else GLA_WAITV(0); }
        GLA_BAR();
        for (int b = 0; b < nblk; ++b) {
            const int tb0 = b * TB; const int nt = (T - tb0) < TB ? (T - tb0) : TB;
            if (scanw) {
                const LAS unsigned char* cur = lds + (b % 3) * BUF; const LAS float* vec = (const LAS float*)cur + dk; const LAS float* vv = (const LAS float*)(cur + OV) + col;
                float okeep0 = 0.f, okeep1 = 0.f;
                struct G4 { f32x4 a[4], k[4], q[4]; float v[4]; };
#define GLA_RD4(dst, t0_) do { _Pragma("unroll") for (int i_ = 0; i_ < 4; ++i_) { const LAS float* vp_ = vec + ((t0_) + i_) * 64; dst.a[i_] = *(const LAS f32x4*)vp_; dst.k[i_] = *(const LAS f32x4*)(vp_ + OK / 4); dst.q[i_] = *(const LAS f32x4*)(vp_ + OQ / 4); dst.v[i_] = vv[((t0_) + i_) * 16]; } } while (0)
#define GLA_ONE(src, i_, keep, tl) do { const f32x4 a4 = src.a[i_], k4 = src.k[i_], q4 = src.q[i_]; const f32x2 v2 = (f32x2){src.v[i_], src.v[i_]}; \
                S01 = __builtin_elementwise_fma((f32x2){a4.x, a4.y}, S01, (f32x2){k4.x, k4.y} * v2); S23 = __builtin_elementwise_fma((f32x2){a4.z, a4.w}, S23, (f32x2){k4.z, k4.w} * v2); \
                const f32x2 o2 = __builtin_elementwise_fma((f32x2){q4.z, q4.w}, S23, (f32x2){q4.x, q4.y} * S01); const float o = row_sum16(o2.x + o2.y); keep = (p == (tl)) ? o : keep; } while (0)
#define GLA_CMP4(src, keep, tl0) do { GLA_ONE(src, 0, keep, tl0); GLA_ONE(src, 1, keep, (tl0) + 1); GLA_ONE(src, 2, keep, (tl0) + 2); GLA_ONE(src, 3, keep, (tl0) + 3); } while (0)
                if (nt == TB) {
                    G4 gA, gB; GLA_RD4(gA, 0);
                    GLA_RD4(gB, 4); __builtin_amdgcn_sched_barrier(0); GLA_CMP4(gA, okeep0, 0); GLA_RD4(gA, 8); __builtin_amdgcn_sched_barrier(0); GLA_CMP4(gB, okeep0, 4);
                    GLA_RD4(gB, 12); __builtin_amdgcn_sched_barrier(0); GLA_CMP4(gA, okeep0, 8); GLA_RD4(gA, 16); __builtin_amdgcn_sched_barrier(0); GLA_CMP4(gB, okeep0, 12);
                    GLA_RD4(gB, 20); __builtin_amdgcn_sched_barrier(0); GLA_CMP4(gA, okeep1, 0); GLA_RD4(gA, 24); __builtin_amdgcn_sched_barrier(0); GLA_CMP4(gB, okeep1, 4);
                    GLA_RD4(gB, 28); __builtin_amdgcn_sched_barrier(0); GLA_CMP4(gA, okeep1, 8); __builtin_amdgcn_sched_barrier(0); GLA_CMP4(gB, okeep1, 12);
                } else { G4 g1; for (int t = 0; t < nt; ++t) { const LAS float* vp_ = vec + t * 64; g1.a[0] = *(const LAS f32x4*)vp_; g1.k[0] = *(const LAS f32x4*)(vp_ + OK / 4); g1.q[0] = *(const LAS f32x4*)(vp_ + OQ / 4); g1.v[0] = vv[t * 16];
                    if (t < 16) GLA_ONE(g1, 0, okeep0, t); else GLA_ONE(g1, 0, okeep1, t - 16); } }
#undef GLA_RD4
#undef GLA_ONE
#undef GLA_CMP4
                { int pt_ = pt; asm volatile("" : "+v"(pt_)); const int p_ = pt_ & 15; GAS float* od = O + (size_t)(r0 + tb0 + p_) * 512 + h * 128 + cb * 16 + (pt_ >> 4);
                  if (p_ < nt) od[0] = okeep0 * 0.125f; if (16 + p_ < nt) od[(size_t)16 * 512] = okeep1 * 0.125f; }
            } else {
                if (b + 2 < nblk) { GLA_DMA(b + 2); if (wv == 7) GLA_WAITV(2); else GLA_WAITV(8); } else GLA_WAITV(0);
            }
            GLA_BAR();
        }
#undef GLA_DMA
        if (scanw) { int pt_ = pt; asm volatile("" : "+v"(pt_));
                     GAS float* so = P + ((size_t)pair * 64 + (pt_ & 15) * 4) * 128 + cb * 16 + (pt_ >> 4); so[0] = S01.x; so[128] = S01.y; so[256] = S23.x; so[384] = S23.y; }
        GLA_BAR();
    }
#undef GLA_WAITV
#undef GLA_BAR
}
__device__ __forceinline__ float grp8_sum(float v) { v += dppf<0xB1>(v); v += dppf<0x4E>(v); v += dppf<0x141>(v); return v; }
__device__ __forceinline__ float dot16_fp8_bf16(const u32x4 uw, const float (&x)[16]) { float s = 0.f;
#pragma unroll
    for (int d = 0; d < 4; ++d) { const f32x2 lo = fp8lo(uw[d]), hi = fp8hi(uw[d]); s = fmaf(lo.x, x[4 * d], s); s = fmaf(lo.y, x[4 * d + 1], s); s = fmaf(hi.x, x[4 * d + 2], s); s = fmaf(hi.y, x[4 * d + 3], s); }
    return s; }
typedef int i32x8 __attribute__((ext_vector_type(8)));
typedef unsigned u32x8 __attribute__((ext_vector_type(8)));
__device__ __forceinline__ void pacts_phase(const GAS unsigned char* XF8, const GAS unsigned char* U8S, const GAS int* EIDX, GAS bf16_t* __restrict__ PART, int M, int emask,
                                            LAS unsigned char* lds, int wid, int lane, int bid, int nb) {
    const bool spl = (nb & 7) == 0; const int s0 = spl ? (bid & 7) : 0, s1 = spl ? s0 + 1 : 8, r = spl ? (bid >> 3) : bid, nr = spl ? (nb >> 3) : nb;
    const int g = lane >> 3, c = lane & 7, fg = ((g >> 2) & 1) | (((g >> 1) & 1) << 2);
    const int m16 = lane & 15, kb = lane >> 4, fm = ((m16 >> 2) & 1) | (((m16 >> 1) & 1) << 2);
    LAS unsigned char* const wl = lds + wid * 16384;
    const LAS unsigned char* const ard = wl + m16 * 128 + (((2 * kb) ^ fm) * 16);
    const LAS unsigned char* const xrd = wl + 12288 + (m16 & 1) * 128 + kb * 32;
    const LAS unsigned char* const ird = wl + 13824 + g * 4;
    if (r >= M) return;
    const int ntok = (M - r + nr - 1) / nr;
#define PL_ROW(t_) ({ int rw_ = r + nr * (t_); rw_ < M ? rw_ : r; })
#define PL_IDS(t_, slot_) __builtin_amdgcn_global_load_lds((const GAS unsigned*)(isrc + (size_t)PL_ROW(t_) * 128), (LAS unsigned*)(wl + 13824 + (slot_) * 256), 4, 0, 0)
#define PL_RDIDS(slot_, e0_, e1_) do { e0_ = *(const LAS int*)(ird + (slot_) * 256); e1_ = *(const LAS int*)(ird + (slot_) * 256 + 32); } while (0)
#define PL_TILE(t_, slot_, e0_, e1_) do { \
        __builtin_amdgcn_global_load_lds((const GAS unsigned*)(tb + (size_t)((e0_) & emask) * 128), (LAS unsigned*)(wl + (slot_) * 2048), 16, 0, 0); \
        __builtin_amdgcn_global_load_lds((const GAS unsigned*)(tb + (size_t)((e1_) & emask) * 128), (LAS unsigned*)(wl + (slot_) * 2048 + 1024), 16, 0, 0); \
        __builtin_amdgcn_global_load_lds((const GAS unsigned*)(xsrc + (size_t)PL_ROW(t_) * 2048), (LAS unsigned*)(wl + 12288 + (slot_) * 256), 4, 0, 0); } while (0)
#define PL_RD(slot_, a0_, a1_, x0_, x1_) do { a0_ = *(const LAS u32x4*)(ard + (slot_) * 2048); a1_ = *(const LAS u32x4*)(ard2 + (slot_) * 2048); x0_ = *(const LAS u32x4*)(xrd + (slot_) * 256); x1_ = *(const LAS u32x4*)(xrd + (slot_) * 256 + 16); } while (0)
#define PL_MMA(cc_, a0_, a1_, x0_, x1_) do { const i32x8 av = (i32x8)__builtin_shufflevector(a0_, a1_, 0, 1, 2, 3, 4, 5, 6, 7), bv = (i32x8)__builtin_shufflevector(x0_, x1_, 0, 1, 2, 3, 4, 5, 6, 7); const f32x4 z = {0.f, 0.f, 0.f, 0.f}; \
        cc_ = __builtin_amdgcn_mfma_scale_f32_16x16x128_f8f6f4(av, bv, z, 0, 0, 0, 0, 0, 0); } while (0)
#define PL_OUT(t_, cc_) do { f32x4 o; _Pragma("unroll") for (int i = 0; i < 4; ++i) { float v = cc_[i]; v += dppf<0xB1>(v); o[i] = v * (1.f / 16.f); } \
        const int rw = r + nr * (t_); if (m16 == 0 && rw < M) { u32x2 w_; w_.x = pk_bf16(o[0], o[1]); w_.y = pk_bf16(o[2], o[3]); *(GAS u32x2*)(po + (size_t)rw * 128) = w_; } } while (0)
#define PL_WAIT(n_) asm volatile("s_waitcnt vmcnt(" #n_ ")" ::: "memory")
#define PL_STEP(j_, h_) do { PL_WAIT(12); u32x4 a0[3], a1[3], x0[3], x1[3]; int e0[3], e1[3]; f32x4 cc[3]; \
        _Pragma("unroll") for (int k = 0; k < 3; ++k) PL_RD((h_) * 3 + k, a0[k], a1[k], x0[k], x1[k]); \
        _Pragma("unroll") for (int k = 0; k < 3; ++k) PL_RDIDS((h_) * 3 + k, e0[k], e1[k]); \
        _Pragma("unroll") for (int k = 0; k < 3; ++k) PL_MMA(cc[k], a0[k], a1[k], x0[k], x1[k]); \
        _Pragma("unroll") for (int k = 0; k < 3; ++k) PL_TILE((j_) + 6 + k, (h_) * 3 + k, e0[k], e1[k]); \
        _Pragma("unroll") for (int k = 0; k < 3; ++k) PL_IDS((j_) + 12 + k, (h_) * 3 + k); \
        _Pragma("unroll") for (int k = 0; k < 3; ++k) PL_OUT((j_) + k, cc[k]); } while (0)
    const LAS unsigned char* const ard2 = (const LAS unsigned char*)((unsigned)(size_t)ard ^ 16u);
    for (int s = s0; s < s1; ++s) {
        const GAS unsigned char* tb = U8S + (size_t)s * 16384 * 128 + ((c ^ fg) * 16);
        const GAS unsigned char* xsrc = XF8 + (size_t)(lane >> 5) * 1024 + s * 128 + (lane & 31) * 4;
        const GAS int* isrc = EIDX + wid * 16 + m16;
        GAS bf16_t* po = PART + (size_t)s * M * 128 + wid * 16 + kb * 4;
        PL_IDS(0, 0); PL_IDS(1, 1); PL_IDS(2, 2); PL_IDS(3, 3); PL_IDS(4, 4); PL_IDS(5, 5); PL_WAIT(0);
        { int e0[6], e1[6];
#pragma unroll
          for (int k = 0; k < 6; ++k) PL_RDIDS(k, e0[k], e1[k]);
#pragma unroll
          for (int k = 0; k < 3; ++k) PL_TILE(k, k, e0[k], e1[k]);
#pragma unroll
          for (int k = 0; k < 3; ++k) PL_IDS(6 + k, k);
#pragma unroll
          for (int k = 3; k < 6; ++k) PL_TILE(k, k, e0[k], e1[k]);
#pragma unroll
          for (int k = 3; k < 6; ++k) PL_IDS(6 + k, k); }
        for (int j = 0; j < ntok; j += 6) { PL_STEP(j, 0); PL_STEP(j + 3, 1); }
        PL_WAIT(0);
    }
#undef PL_ROW
#undef PL_IDS
#undef PL_RDIDS
#undef PL_TILE
#undef PL_RD
#undef PL_MMA
#undef PL_OUT
#undef PL_WAIT
#undef PL_STEP
}
__device__ __forceinline__ void pouts_phase(const GAS float* __restrict__ COEF, const GAS int* __restrict__ EIDX, const GAS unsigned char* V8S, GAS bf16_t* __restrict__ YBUF, int M,
                                            int wid, int lane, int bid, int nb) {
    const bool spl = (nb & 7) == 0; const int s0 = spl ? (bid & 7) : 0, s1 = spl ? s0 + 1 : 8, r = spl ? (bid >> 3) : bid, nr = spl ? (nb >> 3) : nb;
    const int g = lane >> 3, ch = lane & 7, rstep = nr * 8;
#define PO_LOADCE(rw, c0, c1, v0, v1) do { c0 = COEF[(size_t)(rw) * 128 + lane] * (1.f / 64.f); c1 = COEF[(size_t)(rw) * 128 + 64 + lane] * (1.f / 64.f); v0 = EIDX[(size_t)(rw) * 128 + lane]; v1 = EIDX[(size_t)(rw) * 128 + 64 + lane]; } while (0)
#define PO_GATHER(vv_, vreg) do { _Pragma("unroll") for (int k = 0; k < 8; ++k) { const int e = __builtin_amdgcn_ds_bpermute((8 * k + g) << 2, vreg); vv_[k] = *(const GAS u32x4*)(tb + (size_t)(e & 16383) * 128); } } while (0)
#define PO_COMP(vv_, creg) do { _Pragma("unroll") for (int k = 0; k < 8; ++k) { const float c = __int_as_float(__builtin_amdgcn_ds_bpermute((8 * k + g) << 2, __float_as_int(creg))); const u32x4 w = vv_[k]; \
        const f32x2 c2 = (f32x2){c, c}; _Pragma("unroll") for (int d = 0; d < 4; ++d) { ac2[2 * d] = __builtin_elementwise_fma(c2, fp8lo(w[d]), ac2[2 * d]); ac2[2 * d + 1] = __builtin_elementwise_fma(c2, fp8hi(w[d]), ac2[2 * d + 1]); } \
        _Pragma("unroll") for (int i = 0; i < 8; ++i) asm volatile("" : "+v"(ac2[i])); } } while (0)
    for (int s = s0; s < s1; ++s) {
        const GAS unsigned char* tb = V8S + (size_t)s * 16384 * 128 + ch * 16;
        int row = r + nr * wid; if (row >= M) continue;
        float c0c, c1c, c0n = 0.f, c1n = 0.f; int v0c, v1c, v0n = 0, v1n = 0;
        PO_LOADCE(row, c0c, c1c, v0c, v1c);
        u32x4 va[8], vb[8];
        PO_GATHER(va, v0c);
        for (;;) {
            const int rown = row + rstep; const bool hasn = rown < M;
            PO_GATHER(vb, v1c);
            if (hasn) PO_LOADCE(rown, c0n, c1n, v0n, v1n);
            f32x2 ac2[8];
#pragma unroll
            for (int i = 0; i < 8; ++i) ac2[i] = (f32x2){0.f, 0.f};
            PO_COMP(va, c0c);
            if (hasn) PO_GATHER(va, v0n);
            PO_COMP(vb, c1c);
            float acc[16];
#pragma unroll
            for (int i = 0; i < 8; ++i) { acc[2 * i] = ac2[i].x; acc[2 * i + 1] = ac2[i].y; }
#pragma unroll
            for (int i = 0; i < 16; ++i) acc[i] += dppf<0x128>(acc[i]);
#pragma unroll
            for (int i = 0; i < 8; ++i) { const bool hi = lane & 16; const float send = hi ? acc[i] : acc[i + 8], keep = hi ? acc[i + 8] : acc[i]; acc[i] = keep + shx(send, 16, lane); }
#pragma unroll
            for (int i = 0; i < 4; ++i) { const bool hi = lane & 32; const float send = hi ? acc[i] : acc[i + 4], keep = hi ? acc[i + 4] : acc[i]; acc[i] = keep + shx(send, 32, lane); }
            if ((lane & 8) == 0) { u32x2 w_; w_.x = pk_bf16(acc[0], acc[1]); w_.y = pk_bf16(acc[2], acc[3]); *(GAS u32x2*)(YBUF + (size_t)row * 1024 + s * 128 + ch * 16 + ((lane >> 4) & 1) * 8 + ((lane >> 5) & 1) * 4) = w_; }
            if (!hasn) break;
            row = rown; c0c = c0n; c1c = c1n; v0c = v0n; v1c = v1n;
        }
    }
#undef PO_LOADCE
#undef PO_GATHER
#undef PO_COMP
}
}

template <class T> __device__ __forceinline__ __attribute__((address_space(1))) T* gp(T* p) { return (__attribute__((address_space(1))) T*)uni_ptr(p); }
constexpr int MK_THREADS = 512, LDS_BYTES = 163840, LDSCTL_OFF = 131072, TAB_OFF = LDSCTL_OFF + 1024, MAX_OPS = 208;
static_assert(TAB_OFF + MAX_OPS * (int)sizeof(Op) <= LDS_BYTES, "LDS map");
constexpr int MPAD = 17152;
constexpr size_t CTL_BYTES = (size_t)1 << 20;
struct MArgs { const float* in[47]; float* out; char* ws; unsigned long long ws_size; };
__global__ void __launch_bounds__(MK_THREADS, 2) mega_fwd(MArgs a) {
    extern __shared__ __attribute__((aligned(16))) unsigned char lds[];
    volatile LAS unsigned* ctl = (volatile LAS unsigned*)((LAS unsigned char*)lds + LDSCTL_OFF);
    if (threadIdx.x < 64) ctl[threadIdx.x] = 0u;
    __syncthreads();
    (void)xcd_barrier_post((unsigned*)a.ws, ctl + 8);
    const Dm dm = make_dm(1024, 8, 2048, 128, 4);
    Op* tab = (Op*)(lds + TAB_OFF);
    if (threadIdx.x == 0) {
        const float* const* inp_ = (const float* const*)__builtin_amdgcn_kernarg_segment_ptr(); asm volatile("" : "+s"(inp_));
        NvIO io; io.in = inp_; io.out = a.out; io.ws = a.ws + CTL_BYTES; io.ws_size = a.ws_size - CTL_BYTES;
        int n = 0;
        #ifdef PROBE_DUPCODE
        nv_forward(io, dm, [&](const Op& o) __attribute__((always_inline)) { if (n < MAX_OPS) tab[n] = o; ++n; if ((o.code & 0xff) == PROBE_DUPCODE) { if (n < MAX_OPS) tab[n] = o; ++n; } asm volatile("" ::: "memory"); });
#else
        nv_forward(io, dm, [&](const Op& o) __attribute__((always_inline)) { if (n < MAX_OPS) tab[n] = o; ++n; asm volatile("" ::: "memory"); });
#endif
        ctl[16] = (unsigned)(n <= MAX_OPS ? n : 0);
    }
    __syncthreads();
    const int nops = (int)ctl[16];
    for (int i = 0; i < nops; ++i) {
        int tid_ = (int)threadIdx.x, bid_ = (int)blockIdx.x, nb_ = (int)gridDim.x;
        asm volatile("" : "+v"(tid_)); asm volatile("" : "+s"(bid_)); asm volatile("" : "+s"(nb_));
        const long long g0 = (long long)bid_ * MK_THREADS + tid_, gs = (long long)nb_ * MK_THREADS;
        const Op& o = tab[i];
        const int rawc = __builtin_amdgcn_readfirstlane(o.code); const int code = rawc & 0xff; const long long n = o.n;
        switch (code) {
        case OP_FGEMM: {
            const int fl = rfl(o.i6);
            pg8::Gemm g{uni_ptr((const pg8::bf16_t*)o.a), uni_ptr((const pg8::bf16_t*)o.b), MPAD, rfl(o.i5), rfl(o.i1), rfl(o.i2), rfl(o.i3)};
            if (rawc & OPF_GROUP) {
                int ng = 1; while (ng < 8 && (rfl(tab[i + ng - 1].code) & OPF_GROUP)) ++ng;
                const PG8_LAS Op* gt = (const PG8_LAS Op*)((PG8_LAS unsigned char*)lds + TAB_OFF) + i;
                pg8::GroupOrder S; S.tab = gt; S.ng = ng; S.nM = MPAD / 256; S.G = nb_; S.c = bid_; S.tsA = (size_t)256 * g.lda * 2; S.tsB = (size_t)256 * g.ldb * 2;
                pg8::EpiGroup E{gt, dm.M};
                pg8::gemm_phase<pg8::EpiGroup, pg8::GroupOrder, true, true>((PG8_LAS unsigned char*)lds, g, S, E);
                i += ng - 1;
            } else {
            pg8::StaticOrder S; S.init(g, nb_, bid_); if (fl & 2) S.acs = 512;
            float* const c0 = uni_ptr(o.o0); const int ldc0 = rfl(o.i4), nreal0 = rfl(o.i0);
            if (fl & 1) { pg8::EpiBf16Plain E{(pg8::bf16_t*)c0, ldc0}; pg8::gemm_phase<pg8::EpiBf16Plain, pg8::StaticOrder, true, true>((PG8_LAS unsigned char*)lds, g, S, E); }
            else { pg8::EpiF32 E{c0, ldc0, dm.M, nreal0}; pg8::gemm_phase<pg8::EpiF32, pg8::StaticOrder, true, true>((PG8_LAS unsigned char*)lds, g, S, E); }
            }
        } break;
        case OP_LRUG2: {
            pg8::Gemm g{uni_ptr((const pg8::bf16_t*)o.a), uni_ptr((const pg8::bf16_t*)o.b), MPAD, 1024, 512, 512, 512};
            pg8::StaticOrder S; S.init(g, nb_, bid_);
            pg8::EpiLru E{uni_ptr(o.c), uni_ptr(o.d), uni_ptr(o.e), uni_ptr((const pg8::bf16_t*)o.f), uni_ptr(o.o0), uni_ptr(o.o1), dm.M};
            pg8::gemm_phase<pg8::EpiLru, pg8::StaticOrder, true, true>((PG8_LAS unsigned char*)lds, g, S, E);
        } break;
        case OP_WKVP: fk::wkv2_phase(gp((const fk::bf16_t*)o.a), gp((const fk::bf16_t*)o.b), gp((const fk::bf16_t*)o.c), gp((const fk::bf16_t*)o.d), gp((const fk::bf16_t*)o.e), gp((const fk::bf16_t*)o.f), gp((const fk::bf16_t*)o.g), gp(o.h), gp((const float*)o.o5), gp((fk::bf16_t*)o.o0), gp(o.o1), gp(o.o2), gp((fk::bf16_t*)o.o3), gp(o.o4), rfl(o.i0), dm.B, dm.T, dm.DB, dm.DT, (LAS unsigned char*)lds, tid_, bid_, nb_); break;
        case OP_POST2: fk::rwkvpost2_phase(gp((const fk::bf16_t*)o.a), gp((const fk::bf16_t*)o.b), gp((const fk::bf16_t*)o.c), gp(o.d), gp(o.e), gp(o.f), gp((fk::bf16_t*)o.o0), dm.M * 16, tid_ & 63, bid_ * 8 + (tid_ >> 6), nb_ * 8); break;
        case OP_GLAF: fk::gla_phase(gp(o.a), gp(o.b), gp(o.o0), gp(o.o1), dm.B, dm.T, (LAS unsigned char*)lds, tid_, bid_, nb_); break;
        case OP_PACTS: fk::pacts_phase(gp((const unsigned char*)o.a), gp((const unsigned char*)o.b), gp((const int*)o.d), gp((fk::bf16_t*)o.o0), dm.M, rfl(o.i0), (LAS unsigned char*)lds, rfl(tid_ >> 6), tid_ & 63, bid_, nb_); break;
        case OP_POUTS: fk::pouts_phase(gp(o.a), gp((const int*)o.b), gp((const unsigned char*)o.c), gp((fk::bf16_t*)o.o0), dm.M, tid_ >> 6, tid_ & 63, bid_, nb_); break;
        case OP_TOPK2: fk::topk_phase(gp((const fk::bf16_t*)o.a), gp((const fk::bf16_t*)o.b), gp(o.c), gp(o.o0), gp((int*)o.o1), dm.M * 8, (LAS unsigned char*)lds, tid_ >> 6, tid_ & 63, bid_ * 8 + (tid_ >> 6), nb_ * 8); break;
        case OP_LNRES: fk::lnres_phase(gp((const fk::bf16_t*)o.a), gp(o.b), gp(o.c), gp(o.o0), gp((fk::bf16_t*)o.o1), gp((unsigned char*)o.o2), dm.M, tid_ & 63, bid_ * 8 + (tid_ >> 6), nb_ * 8); break;
        case OP_GLANORM: fk::glanorm_phase(gp(o.a), gp(o.b), gp(o.c), gp((fk::bf16_t*)o.o0), dm.M * 4, tid_ & 63, bid_ * 8 + (tid_ >> 6), nb_ * 8); break;
        case OP_CVTTAB8S: {
            int X = rfl(o.i6) % nb_; X = (X < nb_ - 1) ? X : 0;
            if (bid_ >= X) { const long long gs2 = (long long)(nb_ - X) * MK_THREADS; for (long long g = (long long)(bid_ - X) * MK_THREADS + tid_; g < n; g += gs2) nv_elem(OP_CVTTAB8S, o, dm, g); } } break;
#define NVC(c) case c: for (long long g = g0; g < n; g += gs) nv_elem(c, o, dm, g); break;
        NVC(OP_LOGA4) NVC(OP_CONVOUT) NVC(OP_SHIFTOUT) NVC(OP_EMBED4) NVC(OP_YOUT4) NVC(OP_MIX6) NVC(OP_CONV4) NVC(OP_CVT8) NVC(OP_WGATE)
        NVC(OP_WT) NVC(OP_PRED) NVC(OP_PRM) NVC(OP_KEYS) NVC(OP_GLA3) NVC(OP_LRU1) NVC(OP_LRU3)
#undef NVC
        default: break;
        }
        if (__builtin_amdgcn_readfirstlane(tab[i].code) & OPF_NOBAR) __syncthreads(); else { XcdBarrier bar; bar.bar = (unsigned*)a.ws; bar.x = xb_xcc_id(); bar.st = ctl + 8; xcd_barrier(bar); }
    }
}
extern "C" void kernel_launch(void* const* d_in, const int* in_sizes, int n_in, void* d_out, int out_size, void* d_ws, size_t ws_size, hipStream_t stream) {
    static int grid = 0;
    if (grid == 0) {
        if (n_in != 47 || ws_size < ((size_t)900 << 20)) { fprintf(stderr, "kernel_launch: expected 47 inputs and >= 900 MiB of workspace; got %d, %zu\n", n_in, ws_size); grid = -1; return; }
        int dev = 0, cus = 0, per_cu = 0;
        if (hipGetDevice(&dev) != hipSuccess || hipDeviceGetAttribute(&cus, hipDeviceAttributeMultiprocessorCount, dev) != hipSuccess) { grid = -1; return; }
        if (hipFuncSetAttribute((const void*)mega_fwd, hipFuncAttributeMaxDynamicSharedMemorySize, LDS_BYTES) != hipSuccess) { fprintf(stderr, "kernel_launch: hipFuncSetAttribute failed\n"); grid = -1; return; }
        if (hipOccupancyMaxActiveBlocksPerMultiprocessor(&per_cu, (const void*)mega_fwd, MK_THREADS, LDS_BYTES) != hipSuccess || per_cu < 1) fprintf(stderr, "kernel_launch: occupancy query says %d per CU\n", per_cu);
        (void)hipGetLastError();
        grid = cus;
    }
    if (grid < 0) return;
    if (hipMemsetAsync(d_ws, 0, CTL_BYTES, stream) != hipSuccess) { fprintf(stderr, "kernel_launch: memset failed\n"); return; }
    MArgs a{}; for (int i = 0; i < 47; ++i) a.in[i] = (const float*)d_in[i]; a.out = (float*)d_out; a.ws = (char*)d_ws; a.ws_size = (unsigned long long)ws_size;
    hipLaunchKernelGGL(mega_fwd, dim3(grid), dim3(MK_THREADS), LDS_BYTES, stream, a);
}
```

```cpp
#include <hip/hip_runtime.h>
#include <cstdio>
#include <cmath>
#ifndef HD
#define HD __host__ __device__ __forceinline__
#endif
struct Dm { int D, B, T, DB, DT, M, NSEQ, RH; };
HD Dm make_dm(int D, int B, int SEQ, int DB, int DT) { Dm d; d.D = D; d.B = B; d.T = SEQ + 16; d.DB = DB; d.DT = DT; d.M = B * d.T + DB * DT; d.NSEQ = B + DB; d.RH = D / 64; return d; }
HD int seq_row0(const Dm& d, int s) { return s < d.B ? s * d.T : d.B * d.T + (s - d.B) * d.DT; }
HD int seq_len(const Dm& d, int s) { return s < d.B ? d.T : d.DT; }
HD void row_to_seq(const Dm& d, int row, int& s, int& t) { if (row < d.B * d.T) { s = row / d.T; t = row % d.T; } else { int r = row - d.B * d.T; s = d.B + r / d.DT; t = r % d.DT; } }

constexpr int MIXIN = 2576, C_Q = 0, C_K = 256, C_V = 512, C_GLR = 1024, C_R = 1040, C_XB = 1552, C_GB = 2064;

enum { OP_EMBED = 1, OP_GEMM, OP_LOGA, OP_GLA, OP_GLANORM, OP_CONV, OP_CONVOUT, OP_LRUG, OP_LRUSCAN, OP_LNRES, OP_MIX, OP_SHIFTOUT,
       OP_RWKVPREP, OP_WKV, OP_RWKVPOST, OP_QNORM, OP_SCORES, OP_TOPK, OP_PACT1, OP_PACT2, OP_POUT, OP_YOUT, OP_WT, OP_CVT, OP_FGEMM, OP_CVTTAB, OP_KEYS, OP_TOPK2, OP_PACT, OP_POUTLN, OP_GLA1, OP_GLA2, OP_GLA3, OP_LRU1, OP_LRU2, OP_LRU3, OP_EMBED4, OP_YOUT4, OP_MIX8, OP_CONV4, OP_CVT8, OP_WGATE, OP_LRUG2, OP_WKVF, OP_GLAF, OP_CVTTAB8, OP_CVTTAB8S, OP_PACTS, OP_PRED, OP_POUTS, OP_MIX6, OP_PRM, OP_WKVP, OP_POST2, OP_LOGA4 };

constexpr int OPF_NOBAR = 0x100, OPF_GROUP = 0x200;
struct Op {
    const float *a, *b, *c, *d, *e, *f, *g, *h;
    float *o0, *o1, *o2, *o3, *o4, *o5;
    long long n;
    int code, i0, i1, i2, i3, i4, i5, i6;
};

#if defined(__HIP_DEVICE_COMPILE__)
#define NV_UNI(x) __builtin_amdgcn_readfirstlane(x)
#define NV_LAUNDER(p) asm volatile("" : "+s"(p))
#define NV_FENCE() asm volatile("" ::: "memory")
#else
#define NV_FENCE() do {} while (0)
#define NV_UNI(x) (x)
#define NV_LAUNDER(p) do {} while (0)
#endif
typedef unsigned short nvbf;
HD nvbf nv_f2bf(float f) { unsigned u; __builtin_memcpy(&u, &f, 4); return (nvbf)((u + 0x7fffu + ((u >> 16) & 1u)) >> 16); }
HD float nv_bf2f(nvbf h) { unsigned u = (unsigned)h << 16; float f; __builtin_memcpy(&f, &u, 4); return f; }
HD unsigned nv_f2e4m3(float f) {
    unsigned u; __builtin_memcpy(&u, &f, 4); const unsigned sign = (u >> 24) & 0x80u; const float a = fabsf(f);
    if (!(a < 448.f)) return sign | 0x7Eu;
    if (a < 0.015625f) return sign | (unsigned)rintf(a * 512.f);
    unsigned au = u & 0x7fffffffu; au += 0x7ffffu + ((au >> 20) & 1u);
    const unsigned e = ((au >> 23) & 0xffu) - 120u, m = (au >> 20) & 7u; unsigned code = (e << 3) | m; if (code > 0x7Eu) code = 0x7Eu;
    return sign | code; }
HD float nv_e4m32f(unsigned c) { const unsigned e = (c >> 3) & 15u, m = c & 7u; const float v = e ? ldexpf(1.f + m * 0.125f, (int)e - 7) : m * 0.001953125f; return (c & 0x80u) ? -v : v; }
HD int nv_rup(int x, int m) { return (x + m - 1) / m * m; }
struct alignas(16) NvF4 { float x, y, z, w; };
struct alignas(16) NvU4 { unsigned x, y, z, w; };
struct alignas(8) NvU2 { unsigned x, y; };
#if defined(__HIP_DEVICE_COMPILE__)
#define NV_EXP(x) __expf(x)
#define NV_TANH(x) (1.f - 2.f * __builtin_amdgcn_rcpf(1.f + __expf(2.f * (x))))
HD float nv_sigmoid(float x) { return __builtin_amdgcn_rcpf(1.f + __expf(-x)); }
HD float nv_softplus(float x) { return fmaxf(x, 0.f) + __logf(1.f + __expf(-fabsf(x))); }
HD float nv_gelu(float x) { return x * __builtin_amdgcn_rcpf(1.f + __expf(-1.5957691216057308f * (x + 0.044715f * x * x * x))); }
#else
#define NV_EXP(x) expf(x)
#define NV_TANH(x) tanhf(x)
HD float nv_sigmoid(float x) { return 1.f / (1.f + expf(-x)); }
HD float nv_softplus(float x) { return fmaxf(x, 0.f) + log1pf(expf(-fabsf(x))); }
HD float nv_gelu(float x) { return 0.5f * x * (1.f + tanhf(0.7978845608028654f * (x + 0.044715f * x * x * x))); }
#endif

#define NV_INS16(tv, ti, val, idx) do { float _v = (val); int _i = (idx); _Pragma("unroll") for (int _j = 0; _j < 16; ++_j) { if (_v > tv[_j]) { float _tv = tv[_j]; int _ti = ti[_j]; tv[_j] = _v; ti[_j] = _i; _v = _tv; _i = _ti; } } } while (0)

HD void nv_elem(const int code, const Op& p, const Dm& dm, long long gid) {
    const int D = dm.D; float* const PO1 = p.o1; float* const PO2 = p.o2;
    switch (code) {
    case OP_EMBED: {
        int row = (int)(gid / D), c = (int)(gid % D); float v;
        if (row < dm.B * dm.T) { int bb = row / dm.T, t = row % dm.T; v = t < 16 ? p.c[t * D + c] : p.a[((size_t)bb * (dm.T - 16) + (t - 16)) * D + c]; }
        else v = p.b[(size_t)(row - dm.B * dm.T) * D + c];
        p.o0[gid] = v; ((nvbf*)p.o1)[gid] = nv_f2bf(v); } break;
    case OP_GEMM: {
        int N4 = p.i0 >> 2, K = p.i1; int m = (int)(gid / N4), nn = (int)(gid % N4) * 4; const float* A = p.a + (size_t)m * p.i2; const float* Bw = p.b + nn; float c0 = 0.f, c1 = 0.f, c2 = 0.f, c3 = 0.f;
        for (int k = 0; k < K; ++k) { float av = A[k]; if (p.i5 == 1) av = NV_TANH(av); else if (p.i5 == 2) av = nv_sigmoid(av); const NvF4 bv = *(const NvF4*)(Bw + (size_t)k * p.i3);
            c0 = fmaf(av, bv.x, c0); c1 = fmaf(av, bv.y, c1); c2 = fmaf(av, bv.z, c2); c3 = fmaf(av, bv.w, c3); }
        float* C = p.o0 + (size_t)m * p.i4 + nn; C[0] = c0; C[1] = c1; C[2] = c2; C[3] = c3; } break;
    case OP_LOGA: {
        int row = (int)(gid / 256), c = (int)(gid % 256); float z = p.c[c];
        for (int r = 0; r < 16; ++r) z = fmaf(p.a[(size_t)row * MIXIN + C_GLR + r], p.b[r * 256 + c], z);
        p.o0[gid] = NV_EXP(-nv_softplus(-z) * (1.f / 16.f)); } break;
    case OP_GLAF:
    case OP_GLA: {
        int s = (int)(gid / 512), h = (int)((gid / 128) % 4), col = (int)(gid % 128);
        float S[64];
        const float* sin = (s < dm.B) ? nullptr : p.c + (((size_t)(s - dm.B) * 4 + h) * 64) * 128 + col;
#pragma unroll
        for (int k = 0; k < 64; ++k) S[k] = sin ? sin[(size_t)k * 128] : 0.f;
        int r0 = seq_row0(dm, s), L = seq_len(dm, s);
        for (int t = 0; t < L; ++t) {
            const float* pr = p.a + (size_t)(r0 + t) * MIXIN; const float* la = p.b + (size_t)(r0 + t) * 256 + h * 64;
            float v = pr[C_V + h * 128 + col], o = 0.f;
#pragma unroll
            for (int k = 0; k < 64; ++k) { if ((k & 7) == 0) NV_FENCE(); S[k] = fmaf(la[k], S[k], pr[C_K + h * 64 + k] * v); o = fmaf(pr[C_Q + h * 64 + k] * 0.125f, S[k], o); }
            p.o0[(size_t)(r0 + t) * 512 + h * 128 + col] = o;
        }
        float* so = (s < dm.B) ? PO1 + (((size_t)s * 4 + h) * 64) * 128 + col : PO2 + (((size_t)(s - dm.B) * 4 + h) * 64) * 128 + col;
#pragma unroll
        for (int k = 0; k < 64; ++k) so[(size_t)k * 128] = S[k]; } break;
    case OP_GLA1: {
        const int NC = p.i0; const int u = NV_UNI((int)(gid / 128)), col = (int)(gid % 128); const int s = u / (4 * NC), h = (u / NC) % 4, c = u % NC;
        const int r0 = seq_row0(dm, s) + c * 64; int L = dm.T - c * 64; L = L > 64 ? 64 : L;
        float S[64];
#pragma unroll
        for (int k = 0; k < 64; ++k) S[k] = 0.f;
        float dprod = 1.f;
        for (int t = 0; t < L; ++t) {
            const float* pr = p.a + (size_t)(r0 + t) * MIXIN; const float* la = p.b + (size_t)(r0 + t) * 256 + h * 64; const float v = pr[C_V + h * 128 + col];
            if (col < 64) dprod *= la[col];
#pragma unroll
            for (int k = 0; k < 64; ++k) { if ((k & 7) == 0) NV_FENCE(); S[k] = fmaf(la[k], S[k], pr[C_K + h * 64 + k] * v); }
        }
        float* so = p.o0 + (size_t)u * 8192 + col;
#pragma unroll
        for (int k = 0; k < 64; ++k) so[(size_t)k * 128] = S[k];
        if (col < 64) p.o1[(size_t)u * 64 + col] = dprod; } break;
    case OP_GLA2: {
        const int NC = p.i0; const int pair = (int)(gid / 8192), e = (int)(gid % 8192), dk = e / 128; float S = 0.f;
        for (int c = 0; c < NC; ++c) { const size_t ix = ((size_t)pair * NC + c) * 8192 + e; const float l = p.o0[ix]; p.o0[ix] = S; S = fmaf(p.a[((size_t)pair * NC + c) * 64 + dk], S, l); }
        p.o1[gid] = S; } break;
    case OP_GLA3: {
        const int NC = p.i0; const int NP = dm.B * 4 * NC; const int u = NV_UNI((int)(gid / 128)) + (p.i1 ? NP : 0), col = (int)(gid % 128); int s, h, r0, L; const float* sin; float* sout = nullptr;
        if (u < NP) { s = u / (4 * NC); h = (u / NC) % 4; const int c = u % NC; r0 = seq_row0(dm, s) + c * 64; L = dm.T - c * 64; L = L > 64 ? 64 : L; sin = p.d + (size_t)u * 8192 + col; }
        else { const int q = u - NP; s = dm.B + q / 4; h = q % 4; r0 = seq_row0(dm, s); L = dm.DT; sin = p.c + (((size_t)(s - dm.B) * 4 + h) * 64) * 128 + col; sout = p.o2 + (((size_t)(s - dm.B) * 4 + h) * 64) * 128 + col; }
        float S[64];
#pragma unroll
        for (int k = 0; k < 64; ++k) S[k] = sin[(size_t)k * 128];
        for (int t = 0; t < L; ++t) {
            const float* pr = p.a + (size_t)(r0 + t) * MIXIN; const float* la = p.b + (size_t)(r0 + t) * 256 + h * 64; const float v = pr[C_V + h * 128 + col]; float o = 0.f;
#pragma unroll
            for (int k = 0; k < 64; ++k) { if ((k & 7) == 0) NV_FENCE(); S[k] = fmaf(la[k], S[k], pr[C_K + h * 64 + k] * v); o = fmaf(pr[C_Q + h * 64 + k] * 0.125f, S[k], o); }
            p.o0[(size_t)(r0 + t) * 512 + h * 128 + col] = o;
        }
        if (sout) {
#pragma unroll
            for (int k = 0; k < 64; ++k) sout[(size_t)k * 128] = S[k]; } } break;
    case OP_LRU1: {
        const int NC = p.i0; const int u = (int)(gid / 512), c = (int)(gid % 512); const int s = u / NC, ch = u % NC; const int r0 = seq_row0(dm, s) + ch * 64; int L = dm.T - ch * 64; L = L > 64 ? 64 : L; float hh = 0.f, ap = 1.f;
#pragma unroll 16
        for (int t = 0; t < L; ++t) { const size_t ix = (size_t)(r0 + t) * 512 + c; const float a = p.a[ix]; hh = fmaf(a, hh, p.b[ix]); ap *= a; }
        p.o0[gid] = ap; p.o1[gid] = hh; } break;
    case OP_LRU2: {
        const int NC = p.i0; const int s = (int)(gid / 512), c = (int)(gid % 512); float hh = 0.f;
#pragma unroll 8
        for (int ch = 0; ch < NC; ++ch) { const size_t ix = ((size_t)s * NC + ch) * 512 + c; const float l = p.o0[ix]; p.o0[ix] = hh; hh = fmaf(p.a[ix], hh, l); }
        p.o1[gid] = hh; } break;
    case OP_LRU3: {
        const int NC = p.i0; const int u = (int)(gid / 512), c = (int)(gid % 512); const int NP = dm.B * NC; int r0, L; float hh; float* hout = nullptr;
        if (u < NP) { const int s = u / NC, ch = u % NC; r0 = seq_row0(dm, s) + ch * 64; L = dm.T - ch * 64; L = L > 64 ? 64 : L; hh = 0.f;
            for (int k0 = 0; k0 < ch; k0 += 16) { float la[16], lb[16];
#pragma unroll
                for (int k = 0; k < 16; ++k) { int kk = k0 + k; kk = kk < ch ? kk : ch - 1; const size_t ix = ((size_t)s * NC + kk) * 512 + c; la[k] = p.f[ix]; lb[k] = p.e[ix]; }
#pragma unroll
                for (int k = 0; k < 16; ++k) if (k0 + k < ch) hh = fmaf(la[k], hh, lb[k]); }
            if (ch == NC - 1) hout = p.o1 + (size_t)s * 512 + c; }
        else { const int q = u - NP; r0 = seq_row0(dm, dm.B + q); L = dm.DT; hh = p.d[(size_t)q * 512 + c]; hout = p.o2 + (size_t)q * 512 + c; }
        for (int t0 = 0; t0 < L; t0 += 16) {
            float av[16], bv[16], gv[16];
#pragma unroll
            for (int k = 0; k < 16; ++k) { int t = t0 + k; t = t < L ? t : L - 1; const size_t r = (size_t)(r0 + t); av[k] = p.a[r * 512 + c]; bv[k] = p.b[r * 512 + c]; gv[k] = p.c[r * MIXIN + C_GB + c]; }
#pragma unroll
            for (int k = 0; k < 16; ++k) if (t0 + k < L) { const size_t r = (size_t)(r0 + t0 + k); hh = fmaf(av[k], hh, bv[k]); ((nvbf*)p.o0)[r * 1024 + 512 + c] = nv_f2bf(hh * nv_gelu(gv[k])); } }
        if (hout) *hout = hh; } break;
    case OP_EMBED4: {
        const int D4 = D / 4; const int row = (int)(gid / D4), c = (int)(gid % D4) * 4; const float* src;
        if (row < dm.B * dm.T) { const int bb = row / dm.T, t = row % dm.T; src = t < 16 ? p.c + (size_t)t * D + c : p.a + ((size_t)bb * (dm.T - 16) + (t - 16)) * D + c; } else src = p.b + (size_t)(row - dm.B * dm.T) * D + c;
        const NvF4 v = *(const NvF4*)src; NvU2 w; w.x = nv_f2bf(v.x) | ((unsigned)nv_f2bf(v.y) << 16); w.y = nv_f2bf(v.z) | ((unsigned)nv_f2bf(v.w) << 16); *(NvU2*)((nvbf*)p.o1 + (size_t)row * D + c) = w; } break;
    case OP_YOUT4: {
        const int D4 = D / 4; const int row = (int)(gid / D4), c = (int)(gid % D4) * 4; const NvU2 w_ = *(const NvU2*)((const nvbf*)p.a + (size_t)row * D + c); NvF4 v; v.x = nv_bf2f((nvbf)(w_.x & 0xffffu)); v.y = nv_bf2f((nvbf)(w_.x >> 16)); v.z = nv_bf2f((nvbf)(w_.y & 0xffffu)); v.w = nv_bf2f((nvbf)(w_.y >> 16));
        if (row < dm.B * dm.T) { const int bb = row / dm.T, t = row % dm.T; if (t >= 16) *(NvF4*)(p.o0 + ((size_t)bb * (dm.T - 16) + (t - 16)) * D + c) = v; }
        else *(NvF4*)(p.o0 + ((size_t)dm.B * (dm.T - 16) + (row - dm.B * dm.T)) * D + c) = v; } break;
    case OP_MIX8: {
        const int D8 = D / 8; const int row = (int)(gid / D8), c = (int)(gid % D8) * 8; int s, t; row_to_seq(dm, row, s, t); const float* x = p.a + (size_t)row * D + c; float xp[8];
        if (t > 0) { for (int i = 0; i < 8; ++i) xp[i] = x[i - D]; } else if (s < dm.B) { for (int i = 0; i < 8; ++i) xp[i] = 0.f; } else { for (int i = 0; i < 8; ++i) xp[i] = p.b[(size_t)(s - dm.B) * D + c + i]; }
        unsigned w[4];
#pragma unroll
        for (int i = 0; i < 4; ++i) { const float lo = x[2 * i] + (xp[2 * i] - x[2 * i]) * p.c[c + 2 * i], hi = x[2 * i + 1] + (xp[2 * i + 1] - x[2 * i + 1]) * p.c[c + 2 * i + 1]; w[i] = nv_f2bf(lo) | ((unsigned)nv_f2bf(hi) << 16); }
        NvU4 o; o.x = w[0]; o.y = w[1]; o.z = w[2]; o.w = w[3]; *(NvU4*)((nvbf*)p.o0 + (size_t)row * D + c) = o; } break;
    case OP_MIX6: {
        const int D8 = D / 8, Q = (dm.M + 3) / 4; const int row0 = (int)(gid / D8), c = (int)(gid % D8) * 8; NvU4 xw[4], pw[4]; NvF4 sh0[4], sh1[4]; int kind[4];
#pragma unroll
        for (int q = 0; q < 4; ++q) { int row = row0 + q * Q; row = row < dm.M ? row : row0; int s, t; row_to_seq(dm, row, s, t); const nvbf* x = (const nvbf*)p.a + (size_t)row * D + c;
            kind[q] = t > 0 ? 0 : (s < dm.B ? 1 : 2); xw[q] = *(const NvU4*)x; pw[q] = *(const NvU4*)(x - (t > 0 ? D : 0));
            const float* sp = p.b + (size_t)(s >= dm.B ? s - dm.B : 0) * D + c; sh0[q] = *(const NvF4*)sp; sh1[q] = *(const NvF4*)(sp + 4); }
        NvF4 mu0[6], mu1[6];
#pragma unroll
        for (int m = 0; m < 6; ++m) { mu0[m] = *(const NvF4*)(p.c + (size_t)m * D + c); mu1[m] = *(const NvF4*)(p.c + (size_t)m * D + c + 4); }
#pragma unroll
        for (int q = 0; q < 4; ++q) { const int row = row0 + q * Q; if (row < dm.M) { float xv[8], dx[8]; const unsigned xs[4] = {xw[q].x, xw[q].y, xw[q].z, xw[q].w}, ps[4] = {pw[q].x, pw[q].y, pw[q].z, pw[q].w};
            const float shv[8] = {sh0[q].x, sh0[q].y, sh0[q].z, sh0[q].w, sh1[q].x, sh1[q].y, sh1[q].z, sh1[q].w};
#pragma unroll
            for (int i = 0; i < 4; ++i) { xv[2 * i] = nv_bf2f((nvbf)(xs[i] & 0xffffu)); xv[2 * i + 1] = nv_bf2f((nvbf)(xs[i] >> 16)); const float p0 = nv_bf2f((nvbf)(ps[i] & 0xffffu)), p1 = nv_bf2f((nvbf)(ps[i] >> 16));
                const float q0 = kind[q] == 0 ? p0 : (kind[q] == 1 ? 0.f : shv[2 * i]), q1 = kind[q] == 0 ? p1 : (kind[q] == 1 ? 0.f : shv[2 * i + 1]); dx[2 * i] = q0 - xv[2 * i]; dx[2 * i + 1] = q1 - xv[2 * i + 1]; }
#pragma unroll
            for (int m = 0; m < 6; ++m) { const float mv[8] = {mu0[m].x, mu0[m].y, mu0[m].z, mu0[m].w, mu1[m].x, mu1[m].y, mu1[m].z, mu1[m].w}; unsigned w[4];
#pragma unroll
                for (int i = 0; i < 4; ++i) w[i] = nv_f2bf(xv[2 * i] + dx[2 * i] * mv[2 * i]) | ((unsigned)nv_f2bf(xv[2 * i + 1] + dx[2 * i + 1] * mv[2 * i + 1]) << 16);
                NvU4 o; o.x = w[0]; o.y = w[1]; o.z = w[2]; o.w = w[3]; *(NvU4*)((nvbf*)p.o0 + (size_t)m * (size_t)p.i1 * 1024 + (size_t)row * D + c) = o; } } } } break;
    case OP_CONV4: {
        const int Q = (dm.M + 3) / 4; const int row0 = (int)(gid / 128), c = (int)(gid % 128) * 4; const NvF4 bias = *(const NvF4*)(p.d + c); NvF4 wt[4]; for (int i = 0; i < 4; ++i) wt[i] = *(const NvF4*)(p.c + i * 512 + c);
        NvF4 xv[4][4]; int ok[4];
#pragma unroll
        for (int q = 0; q < 4; ++q) { int row = row0 + q * Q; ok[q] = row < dm.M; row = ok[q] ? row : row0; int s, t; row_to_seq(dm, row, s, t);
#pragma unroll
            for (int i = 0; i < 4; ++i) { const int j = t + i; const int sb = s >= dm.B ? s - dm.B : 0, jb = j < 3 ? j : 0;
                const float* src = j >= 3 ? p.a + (size_t)(row - t + (j - 3)) * MIXIN + C_XB + c : p.b + ((size_t)sb * 3 + jb) * 512 + c; const float msk = (j >= 3 || s >= dm.B) ? 1.f : 0.f;
                const NvF4 v = *(const NvF4*)src; xv[q][i].x = v.x * msk; xv[q][i].y = v.y * msk; xv[q][i].z = v.z * msk; xv[q][i].w = v.w * msk; } }
#pragma unroll
        for (int q = 0; q < 4; ++q) if (ok[q]) { const int row = row0 + q * Q; NvF4 o = bias;
#pragma unroll
            for (int i = 0; i < 4; ++i) { o.x = fmaf(xv[q][i].x, wt[i].x, o.x); o.y = fmaf(xv[q][i].y, wt[i].y, o.y); o.z = fmaf(xv[q][i].z, wt[i].z, o.z); o.w = fmaf(xv[q][i].w, wt[i].w, o.w); }
            NvU2 w; w.x = nv_f2bf(o.x) | ((unsigned)nv_f2bf(o.y) << 16); w.y = nv_f2bf(o.z) | ((unsigned)nv_f2bf(o.w) << 16); *(NvU2*)((nvbf*)p.o1 + (size_t)row * 512 + c) = w; } } break;
    case OP_CVT8: {
        const int K8 = p.i2 / 8; const int row = (int)(gid / K8), k = (int)(gid % K8) * 8; unsigned w[4] = {0u, 0u, 0u, 0u};
        if (row < dm.M && k < p.i0) { const float* sp = p.a + (size_t)row * p.i1 + k;
#pragma unroll
            for (int i = 0; i < 4; ++i) { float lo = sp[2 * i], hi = sp[2 * i + 1]; if (p.i3 == 1) { lo = NV_TANH(lo); hi = NV_TANH(hi); } else if (p.i3 == 2) { lo = nv_sigmoid(lo); hi = nv_sigmoid(hi); } w[i] = nv_f2bf(lo) | ((unsigned)nv_f2bf(hi) << 16); } }
        NvU4 o; o.x = w[0]; o.y = w[1]; o.z = w[2]; o.w = w[3]; *(NvU4*)((nvbf*)p.o0 + (size_t)row * p.i2 + k) = o; } break;
    case OP_WGATE: {
        const int n = (int)gid, pn = n >> 8, within = n & 127, isx = (n >> 7) & 1, c = pn * 128 + within, nb = c >> 6, e = c & 63; const float* w = isx ? p.b : p.a; nvbf* dst = (nvbf*)p.o0 + (size_t)n * 512;
        for (int k = 0; k < 512; ++k) dst[k] = ((k >> 6) == nb) ? nv_f2bf(w[((size_t)nb * 64 + (k & 63)) * 64 + e]) : (nvbf)0;
        if (n < 512) p.o1[n] = -8.f * nv_softplus(-p.c[n]); } break;
    case OP_LRUG2: {
        const int row = (int)(gid / 512), c = (int)(gid % 512), pn = c >> 7, within = c & 127; const nvbf* x = (const nvbf*)p.a + (size_t)row * 512; const nvbf* wa_ = (const nvbf*)p.b + (size_t)(pn * 256 + within) * 512; const nvbf* wx_ = wa_ + (size_t)128 * 512; float ga = 0.f, gx = 0.f;
        for (int k = 0; k < 512; ++k) { const float xv = nv_bf2f(x[k]); ga = fmaf(xv, nv_bf2f(wa_[k]), ga); gx = fmaf(xv, nv_bf2f(wx_[k]), gx); }
        const float gate_a = nv_sigmoid(ga + p.c[c]), gate_x = nv_sigmoid(gx + p.d[c]); const float log_at = gate_a * p.e[c];
        p.o0[gid] = NV_EXP(log_at); p.o1[gid] = sqrtf(-expm1f(2.f * log_at)) * (gate_x * nv_bf2f(((const nvbf*)p.f)[gid])); } break;
    case OP_LOGA4: {
        const int row = (int)(gid / 64), c = (int)(gid % 64) * 4; const float* gl = p.a + (size_t)row * MIXIN + C_GLR; NvF4 z = *(const NvF4*)(p.c + c);
#pragma unroll
        for (int r4 = 0; r4 < 4; ++r4) { const NvF4 g = *(const NvF4*)(gl + 4 * r4);
            const NvF4 w0 = *(const NvF4*)(p.b + (4 * r4 + 0) * 256 + c), w1 = *(const NvF4*)(p.b + (4 * r4 + 1) * 256 + c), w2 = *(const NvF4*)(p.b + (4 * r4 + 2) * 256 + c), w3 = *(const NvF4*)(p.b + (4 * r4 + 3) * 256 + c);
            z.x = fmaf(g.x, w0.x, z.x); z.y = fmaf(g.x, w0.y, z.y); z.z = fmaf(g.x, w0.z, z.z); z.w = fmaf(g.x, w0.w, z.w); z.x = fmaf(g.y, w1.x, z.x); z.y = fmaf(g.y, w1.y, z.y); z.z = fmaf(g.y, w1.z, z.z); z.w = fmaf(g.y, w1.w, z.w);
            z.x = fmaf(g.z, w2.x, z.x); z.y = fmaf(g.z, w2.y, z.y); z.z = fmaf(g.z, w2.z, z.z); z.w = fmaf(g.z, w2.w, z.w); z.x = fmaf(g.w, w3.x, z.x); z.y = fmaf(g.w, w3.y, z.y); z.z = fmaf(g.w, w3.z, z.z); z.w = fmaf(g.w, w3.w, z.w); }
        NvF4 o; o.x = NV_EXP(-nv_softplus(-z.x) * (1.f / 16.f)); o.y = NV_EXP(-nv_softplus(-z.y) * (1.f / 16.f)); o.z = NV_EXP(-nv_softplus(-z.z) * (1.f / 16.f)); o.w = NV_EXP(-nv_softplus(-z.w) * (1.f / 16.f));
        *(NvF4*)(p.o0 + (size_t)row * 256 + c) = o; } break;
    case OP_GLANORM: {
        int row = (int)(gid / 4), h = (int)(gid % 4); const float* o = p.a + (size_t)row * 512 + h * 128; float ss = 0.f;
        for (int c = 0; c < 128; ++c) ss = fmaf(o[c], o[c], ss);
        float rs = 1.f / sqrtf(ss * (1.f / 128.f) + 1e-5f);
        for (int c = 0; c < 128; ++c) { float r = p.b[(size_t)row * MIXIN + C_R + h * 128 + c]; ((nvbf*)p.o0)[(size_t)row * 1024 + h * 128 + c] = nv_f2bf(o[c] * rs * p.c[c] * (r * nv_sigmoid(r))); } } break;
    case OP_CONV: {
        int row = (int)(gid / 512), c = (int)(gid % 512); int s, t; row_to_seq(dm, row, s, t); float acc = p.d[c];
        for (int i = 0; i < 4; ++i) { int j = t + i; float xv;
            if (j < 3) xv = (s < dm.B) ? 0.f : p.b[((size_t)(s - dm.B) * 3 + j) * 512 + c]; else xv = p.a[(size_t)(row - t + (j - 3)) * MIXIN + C_XB + c];
            acc = fmaf(xv, p.c[i * 512 + c], acc); }
        p.o0[gid] = acc; } break;
    case OP_CONVOUT: {
        int s = (int)(gid / 1536), i = (int)((gid / 512) % 3), c = (int)(gid % 512); int L = seq_len(dm, s), r0 = seq_row0(dm, s); int j = L + i; float xv;
        if (j < 3) xv = (s < dm.B) ? 0.f : p.b[((size_t)(s - dm.B) * 3 + j) * 512 + c]; else xv = p.a[(size_t)(r0 + j - 3) * MIXIN + C_XB + c];
        float* o = (s < dm.B) ? PO1 + ((size_t)s * 3 + i) * 512 + c : PO2 + ((size_t)(s - dm.B) * 3 + i) * 512 + c; *o = xv; } break;
    case OP_LRUG: {
        int row = (int)(gid / 512), c = (int)(gid % 512), nb = c / 64, e = c % 64; const float* x = p.a + (size_t)row * 512 + nb * 64; float ga = p.c[c], gx = p.e[c];
        for (int dd = 0; dd < 64; ++dd) { ga = fmaf(x[dd], p.b[((size_t)nb * 64 + dd) * 64 + e], ga); gx = fmaf(x[dd], p.d[((size_t)nb * 64 + dd) * 64 + e], gx); }
        float gate_a = nv_sigmoid(ga), gate_x = nv_sigmoid(gx); float log_at = -8.f * gate_a * nv_softplus(-p.f[c]);
        p.o0[gid] = NV_EXP(log_at); p.o1[gid] = sqrtf(-expm1f(2.f * log_at)) * (gate_x * p.a[(size_t)row * 512 + c]); } break;
    case OP_LRUSCAN: {
        int s = (int)(gid / 512), c = (int)(gid % 512); int r0 = seq_row0(dm, s), L = seq_len(dm, s); float hh = (s < dm.B) ? 0.f : p.d[(size_t)(s - dm.B) * 512 + c];
        for (int t = 0; t < L; ++t) { size_t r = (size_t)(r0 + t); hh = fmaf(p.a[r * 512 + c], hh, p.b[r * 512 + c]); p.o0[r * 1024 + 512 + c] = hh * nv_gelu(p.c[r * MIXIN + C_GB + c]); }
        float* o = (s < dm.B) ? PO1 + (size_t)s * 512 + c : PO2 + (size_t)(s - dm.B) * 512 + c; *o = hh; } break;
    case OP_LNRES: {
        const float alpha = 1.6817928305074292f; nvbf* x = (nvbf*)p.o1 + (size_t)gid * D; const nvbf* y = (const nvbf*)p.a + (size_t)gid * D; float mu = 0.f;
        for (int c = 0; c < D; ++c) mu += alpha * nv_bf2f(x[c]) + nv_bf2f(y[c]);
        mu /= D; float var = 0.f;
        for (int c = 0; c < D; ++c) { float v = alpha * nv_bf2f(x[c]) + nv_bf2f(y[c]) - mu; var = fmaf(v, v, var); }
        float rs = 1.f / sqrtf(var / D + 1e-5f);
        for (int c = 0; c < D; ++c) { const float o = (alpha * nv_bf2f(x[c]) + nv_bf2f(y[c]) - mu) * rs * p.b[c] + p.c[c]; x[c] = nv_f2bf(o);
            if (p.o2) { unsigned char* f8 = (unsigned char*)p.o2 + (size_t)gid * 2 * D; const float xs = fminf(fmaxf(o * 16.f, -448.f), 448.f); const unsigned hc = nv_f2e4m3(xs); f8[c] = (unsigned char)hc; f8[D + c] = (unsigned char)nv_f2e4m3(xs - nv_e4m32f(hc)); } } } break;
    case OP_MIX: {
        int row = (int)(gid / D), c = (int)(gid % D); int s, t; row_to_seq(dm, row, s, t); float x = p.a[gid];
        float xp = t > 0 ? p.a[gid - D] : ((s < dm.B) ? 0.f : p.b[(size_t)(s - dm.B) * D + c]);
        ((nvbf*)p.o0)[gid] = nv_f2bf(x + (xp - x) * p.c[c]); } break;
    case OP_SHIFTOUT: {
        int s = (int)(gid / D), c = (int)(gid % D); float v = nv_bf2f(((const nvbf*)p.a)[(size_t)(seq_row0(dm, s) + seq_len(dm, s) - 1) * D + c]);
        float* o = (s < dm.B) ? PO1 + (size_t)s * D + c : PO2 + (size_t)(s - dm.B) * D + c; *o = v; } break;
    case OP_RWKVPREP: {
        int row = (int)(gid / dm.RH), h = (int)(gid % dm.RH); size_t base = (size_t)row * D + h * 64; float ss = 0.f;
        for (int k = 0; k < 64; ++k) { float kv = p.o0[base + k] * p.d[h * 64 + k]; ss = fmaf(kv, kv, ss); }
        float inv = 1.f / fmaxf(sqrtf(ss), 1e-12f);
        for (int k = 0; k < 64; ++k) { int c = h * 64 + k; size_t ix = base + k;
            float w = -nv_softplus(-(p.a[c] + p.o1[ix])) - 0.5f; float dec = NV_EXP(-NV_EXP(w));
            float a = nv_sigmoid(p.b[c] + p.o2[ix]);
            float v = p.o3[ix]; if (p.i0) v = v + (p.o5[ix] - v) * nv_sigmoid(p.c[c] + p.f[ix]); else p.o5[ix] = v;
            float k0 = p.o0[ix]; const float kk = k0 * p.d[c] * inv; p.o4[ix] = -kk; p.o0[ix] = k0 * (1.f + (a - 1.f) * p.e[c]); p.o1[ix] = dec; p.o2[ix] = kk * a; p.o3[ix] = v; } } break;
    case OP_WKVF:
    case OP_WKV: {
        int RH = dm.RH; int s = p.i0 + (int)(gid / (RH * 64)), h = (int)((gid / 64) % RH), vr = (int)(gid % 64); float S[64];
        const float* sin = (s < dm.B) ? nullptr : p.g + (((size_t)(s - dm.B) * RH + h) * 64 + vr) * 64;
#pragma unroll
        for (int k = 0; k < 64; ++k) S[k] = sin ? sin[k] : 0.f;
        int r0 = seq_row0(dm, s), L = seq_len(dm, s);
        for (int t = 0; t < L; ++t) { size_t base = (size_t)(r0 + t) * D + h * 64; float sa = 0.f;
#pragma unroll
            for (int k = 0; k < 64; ++k) { if ((k & 7) == 0) NV_FENCE(); sa = fmaf(S[k], p.f[base + k], sa); }
            float vv = p.d[base + vr], y = 0.f;
#pragma unroll
            for (int k = 0; k < 64; ++k) { if ((k & 7) == 0) NV_FENCE(); S[k] = fmaf(S[k], p.b[base + k], fmaf(sa, p.e[base + k], vv * p.c[base + k])); y = fmaf(S[k], p.a[base + k], y); }
            p.o0[base + vr] = y; }
        float* so = (s < dm.B) ? PO1 + (((size_t)s * RH + h) * 64 + vr) * 64 : PO2 + (((size_t)(s - dm.B) * RH + h) * 64 + vr) * 64;
#pragma unroll
        for (int k = 0; k < 64; ++k) so[k] = S[k]; } break;
    case OP_RWKVPOST: {
        int row = (int)(gid / dm.RH), h = (int)(gid % dm.RH); size_t base = (size_t)row * D + h * 64; float mu = 0.f, bon = 0.f;
        for (int k = 0; k < 64; ++k) { mu += p.a[base + k]; bon = fmaf(p.b[base + k] * p.c[base + k], p.f[h * 64 + k], bon); }
        mu *= (1.f / 64.f); float var = 0.f;
        for (int k = 0; k < 64; ++k) { float dlt = p.a[base + k] - mu; var = fmaf(dlt, dlt, var); }
        float rs = 1.f / sqrtf(var * (1.f / 64.f) + 64e-5f);
        for (int k = 0; k < 64; ++k) { int c = h * 64 + k; float y = (p.a[base + k] - mu) * rs * p.g[c] + p.h[c] + bon * p.d[base + k]; ((nvbf*)p.o0)[base + k] = nv_f2bf(y * p.e[base + k]); } } break;
    case OP_PRM: {
        const int m = (int)(gid / D), c = (int)(gid % D); const float* src = m == 0 ? p.a : m == 1 ? p.b : m == 2 ? p.c : m == 3 ? p.d : m == 4 ? p.e : p.f; p.o0[gid] = src ? src[c] : 0.f; } break;
    case OP_WKVP: {
        const int RH = dm.RH; const int s = (int)(gid / (RH * 64)), h = (int)((gid / 64) % RH), vr = (int)(gid % 64); float S[64];
        const float* sin = (s < dm.B) ? nullptr : p.o5 + (((size_t)(s - dm.B) * RH + h) * 64 + vr) * 64;
        for (int k = 0; k < 64; ++k) S[k] = sin ? sin[k] : 0.f;
        const float* w0 = p.h + h * 64; const float* a0 = p.h + D + h * 64; const float* v0 = p.h + 2 * D + h * 64; const float* k_k = p.h + 3 * D + h * 64; const float* k_a = p.h + 4 * D + h * 64; const float* r_k = p.h + 5 * D + h * 64;
        const int r0 = seq_row0(dm, s), L = seq_len(dm, s); const nvbf* bR = (const nvbf*)p.a; const nvbf* bK = (const nvbf*)p.b; const nvbf* bWL = (const nvbf*)p.c; const nvbf* bAL = (const nvbf*)p.d; const nvbf* bV = (const nvbf*)p.e; const nvbf* bVG = (const nvbf*)p.f;
        for (int t = 0; t < L; ++t) { const size_t base = (size_t)(r0 + t) * D + h * 64; float ss = 0.f;
            for (int k = 0; k < 64; ++k) { const float kv = nv_bf2f(bK[base + k]) * k_k[k]; ss = fmaf(kv, kv, ss); }
            const float inv = 1.f / fmaxf(sqrtf(ss), 1e-12f);
            float vv = nv_bf2f(bV[base + vr]); if (p.i0) vv = vv + (nv_bf2f(((const nvbf*)p.g)[base + vr]) - vv) * nv_sigmoid(v0[vr] + nv_bf2f(bVG[base + vr]));
            float sa = 0.f, bon = 0.f, dec[64], bb[64], k2[64];
            for (int k = 0; k < 64; ++k) { const float k0 = nv_bf2f(bK[base + k]); const float kk = k0 * k_k[k] * inv; const float a = nv_sigmoid(a0[k] + nv_bf2f(bAL[base + k]));
                dec[k] = NV_EXP(-0.6065306597126334f * nv_sigmoid(w0[k] + nv_bf2f(bWL[base + k])));
                bb[k] = kk * a; k2[k] = k0 * (1.f + (a - 1.f) * k_a[k]); sa = fmaf(S[k], -kk, sa); bon = fmaf(nv_bf2f(bR[base + k]) * k2[k], r_k[k], bon); }
            float y = 0.f;
            for (int k = 0; k < 64; ++k) { S[k] = fmaf(S[k], dec[k], fmaf(sa, bb[k], vv * k2[k])); y = fmaf(S[k], nv_bf2f(bR[base + k]), y); }
            ((nvbf*)p.o0)[base + vr] = nv_f2bf(y); ((nvbf*)p.o3)[base + vr] = nv_f2bf(vv); if (vr == 0) p.o4[(size_t)(r0 + t) * RH + h] = bon; }
        float* so = (s < dm.B) ? PO1 + (((size_t)s * RH + h) * 64 + vr) * 64 : PO2 + (((size_t)(s - dm.B) * RH + h) * 64 + vr) * 64;
        for (int k = 0; k < 64; ++k) so[k] = S[k]; } break;
    case OP_POST2: {
        const int row = (int)(gid / dm.RH), h = (int)(gid % dm.RH); const size_t base = (size_t)row * D + h * 64; const nvbf* ya = (const nvbf*)p.a; const nvbf* vf = (const nvbf*)p.c; float mu = 0.f;
        for (int k = 0; k < 64; ++k) mu += nv_bf2f(ya[base + k]);
        mu *= (1.f / 64.f); float var = 0.f;
        for (int k = 0; k < 64; ++k) { const float dlt = nv_bf2f(ya[base + k]) - mu; var = fmaf(dlt, dlt, var); }
        const float rs = 1.f / sqrtf(var * (1.f / 64.f) + 64e-5f), bon = p.d[gid];
        for (int k = 0; k < 64; ++k) { const int c = h * 64 + k; const float y = (nv_bf2f(ya[base + k]) - mu) * rs * p.e[c] + p.f[c] + bon * nv_bf2f(vf[base + k]); ((nvbf*)p.o0)[base + k] = nv_f2bf(y * nv_bf2f(((const nvbf*)p.b)[base + k])); } } break;
    case OP_QNORM: {
        float* q = p.o0 + (size_t)gid * 256; float mu = 0.f;
        for (int c = 0; c < 256; ++c) mu += q[c];
        mu *= (1.f / 256.f); float var = 0.f;
        for (int c = 0; c < 256; ++c) { float dlt = q[c] - mu; var = fmaf(dlt, dlt, var); }
        float rs = 1.f / sqrtf(var * (1.f / 256.f) + 1e-5f);
        for (int c = 0; c < 256; ++c) q[c] = (q[c] - mu) * rs; } break;
    case OP_SCORES: {
        int row = (int)(gid / 2048), r = (int)(gid % 2048), h = r / 256, half = (r / 128) & 1, key = r % 128;
        const float* q = p.a + (size_t)row * 2048 + h * 256 + half * 128; const float* kv = p.b + (((size_t)h * 2 + half) * 128 + key) * 128; float acc = 0.f;
        for (int dd = 0; dd < 128; ++dd) acc = fmaf(q[dd], kv[dd], acc);
        p.o0[gid] = acc; } break;
    case OP_TOPK: {
        const float* sc = p.a + (size_t)gid * 256; float tv[16]; int ti[16]; float* tmpv = p.o2 + (size_t)gid * 32; int* tmpi = (int*)p.o3 + (size_t)gid * 32;
        for (int half = 0; half < 2; ++half) {
#pragma unroll
            for (int j = 0; j < 16; ++j) { tv[j] = -3.0e38f; ti[j] = 0; }
            for (int k = 0; k < 128; ++k) NV_INS16(tv, ti, sc[half * 128 + k], k);
#pragma unroll
            for (int j = 0; j < 16; ++j) { tmpv[half * 16 + j] = tv[j]; tmpi[half * 16 + j] = ti[j]; }
        }
#pragma unroll
        for (int j = 0; j < 16; ++j) { tv[j] = -3.0e38f; ti[j] = 0; }
        for (int i = 0; i < 16; ++i) for (int j = 0; j < 16; ++j) NV_INS16(tv, ti, tmpv[i] + tmpv[16 + j], tmpi[i] * 128 + tmpi[16 + j]);
        float den = 0.f, ev[16];
#pragma unroll
        for (int j = 0; j < 16; ++j) { ev[j] = NV_EXP(tv[j] - tv[0]); den += ev[j]; }
        float inv = 1.f / den;
#pragma unroll
        for (int j = 0; j < 16; ++j) { p.o0[(size_t)gid * 16 + j] = ev[j] * inv; ((int*)p.o1)[(size_t)gid * 16 + j] = ti[j]; } } break;
    case OP_PACT1: {
        size_t pr = (size_t)(gid / 16); int part = (int)(gid % 16); int row = (int)(pr / 128); int e = ((const int*)p.d)[pr]; int w = D / 16;
        const float* u = p.b + (size_t)e * D + part * w; const float* x = p.a + (size_t)row * D + part * w; float acc = 0.f;
        for (int c = 0; c < w; ++c) acc = fmaf(u[c], x[c], acc);
        p.o0[gid] = acc; } break;
    case OP_PACT2: {
        float acc = 0.f; for (int i = 0; i < 16; ++i) acc += p.a[(size_t)gid * 16 + i];
        p.o0[gid] = p.c[gid] * nv_gelu(acc); } break;
    case OP_POUT: {
        int row = (int)(gid / D), c = (int)(gid % D); float acc = 0.f;
        for (int i = 0; i < 128; ++i) acc = fmaf(p.a[(size_t)row * 128 + i], p.c[(size_t)((const int*)p.b)[(size_t)row * 128 + i] * D + c], acc);
        p.o0[gid] = acc; } break;
    case OP_YOUT: {
        int row = (int)(gid / D), c = (int)(gid % D);
        if (row < dm.B * dm.T) { int bb = row / dm.T, t = row % dm.T; if (t >= 16) p.o0[((size_t)bb * (dm.T - 16) + (t - 16)) * D + c] = p.a[gid]; }
        else p.o0[((size_t)dm.B * (dm.T - 16) + (row - dm.B * dm.T)) * D + c] = p.a[gid]; } break;
    case OP_WT: {
        const int N = p.i0, K = p.i1, Np = p.i3, Kp = p.i4; const long long per8 = (long long)Np * (Kp / 8); const int bt = (int)(gid / per8); const long long r = gid % per8; const int k0 = (int)(r / Np) * 8, nn = (int)(r % Np);
        unsigned w[4];
#pragma unroll
        for (int i = 0; i < 4; ++i) { float lo = 0.f, hi = 0.f; if (nn < N) { if (k0 + 2 * i < K) lo = p.a[((size_t)bt * K + k0 + 2 * i) * p.i2 + nn]; if (k0 + 2 * i + 1 < K) hi = p.a[((size_t)bt * K + k0 + 2 * i + 1) * p.i2 + nn]; } w[i] = nv_f2bf(lo) | ((unsigned)nv_f2bf(hi) << 16); }
        NvU4 o; o.x = w[0]; o.y = w[1]; o.z = w[2]; o.w = w[3];
        *(NvU4*)((nvbf*)p.o0 + (size_t)bt * Np * Kp + (size_t)nn * Kp + k0) = o; } break;
    case OP_CVT: {
        const int Kp = p.i2; const int row = (int)(gid / Kp), k = (int)(gid % Kp); float v = 0.f;
        if (row < dm.M && k < p.i0) { v = p.a[(size_t)row * p.i1 + k]; if (p.i3 == 1) v = NV_TANH(v); else if (p.i3 == 2) v = nv_sigmoid(v); }
        ((nvbf*)p.o0)[gid] = nv_f2bf(v); } break;
    case OP_FGEMM: {
        const int N = p.i0; const int m = (int)(gid / N), nn = (int)(gid % N); const nvbf* A = (const nvbf*)p.a + (size_t)m * p.i2 + ((p.i6 & 2) ? (nn / 256) * 256 : 0); const nvbf* Bt = (const nvbf*)p.b + (size_t)nn * p.i3; float acc = 0.f;
        for (int k = 0; k < p.i1; ++k) acc = fmaf(nv_bf2f(A[k]), nv_bf2f(Bt[k]), acc);
        if (p.i6 & 1) ((nvbf*)p.o0)[(size_t)m * p.i4 + nn] = nv_f2bf(acc); else p.o0[(size_t)m * p.i4 + nn] = acc; } break;
    case OP_CVTTAB: {
        const NvF4 v0 = *(const NvF4*)(p.a + gid * 8), v1 = *(const NvF4*)(p.a + gid * 8 + 4); NvU4 o;
        o.x = nv_f2bf(v0.x) | ((unsigned)nv_f2bf(v0.y) << 16); o.y = nv_f2bf(v0.z) | ((unsigned)nv_f2bf(v0.w) << 16); o.z = nv_f2bf(v1.x) | ((unsigned)nv_f2bf(v1.y) << 16); o.w = nv_f2bf(v1.z) | ((unsigned)nv_f2bf(v1.w) << 16);
        *(NvU4*)((nvbf*)p.o0 + gid * 8) = o; } break;
    case OP_CVTTAB8: {
        const float sc = (float)(1 << p.i0); const float* sp = p.a + gid * 16; unsigned w[4];
#pragma unroll
        for (int q = 0; q < 4; ++q) { const NvF4 v = *(const NvF4*)(sp + 4 * q); w[q] = nv_f2e4m3(v.x * sc) | (nv_f2e4m3(v.y * sc) << 8) | (nv_f2e4m3(v.z * sc) << 16) | (nv_f2e4m3(v.w * sc) << 24); }
        NvU4 o; o.x = w[0]; o.y = w[1]; o.z = w[2]; o.w = w[3]; *(NvU4*)((unsigned char*)p.o0 + gid * 16) = o; } break;
    case OP_CVTTAB8S: {
        const float sc = (float)(1 << p.i0); const int per = D / 16; const int e = (int)(gid / per), c0 = (int)(gid % per) * 16; const float* sp = p.a + (size_t)e * D + c0; unsigned w[4];
#pragma unroll
        for (int q = 0; q < 4; ++q) { const NvF4 v = *(const NvF4*)(sp + 4 * q);
#if defined(__HIP_DEVICE_COMPILE__)
            int pk = __builtin_amdgcn_cvt_pk_fp8_f32(v.x * sc, v.y * sc, 0, false); pk = __builtin_amdgcn_cvt_pk_fp8_f32(v.z * sc, v.w * sc, pk, true); w[q] = (unsigned)pk;
#else
            w[q] = nv_f2e4m3(v.x * sc) | (nv_f2e4m3(v.y * sc) << 8) | (nv_f2e4m3(v.z * sc) << 16) | (nv_f2e4m3(v.w * sc) << 24);
#endif
        }
        NvU4 o; o.x = w[0]; o.y = w[1]; o.z = w[2]; o.w = w[3]; *(NvU4*)((unsigned char*)p.o0 + ((size_t)(c0 >> 7) * 16384 + e) * 128 + (c0 & 127)) = o; } break;
    case OP_PACTS: {
        const long long NP = (long long)dm.M * 128; const int sl = (int)(gid / NP); const long long pr = gid % NP; const int row = (int)(pr / 128); const int e = ((const int*)p.d)[pr] & p.i0;
        const unsigned char* u = (const unsigned char*)p.b + ((size_t)sl * 16384 + e) * 128; const unsigned char* x = (const unsigned char*)p.a + (size_t)row * 2 * D + sl * 128; float acc = 0.f;
        for (int c = 0; c < 128; ++c) acc = fmaf(nv_e4m32f(u[c]), nv_e4m32f(x[c]) + nv_e4m32f(x[D + c]), acc);
        ((nvbf*)p.o0)[gid] = nv_f2bf(acc * (1.f / 16.f)); } break;
    case OP_PRED: {
        const long long NP = (long long)dm.M * 128; const size_t e0 = (size_t)gid * 4; float a0 = 0.f, a1 = 0.f, a2 = 0.f, a3 = 0.f;
#pragma unroll 8
        for (int sl = 0; sl < p.i0; ++sl) { const NvU2 w = *(const NvU2*)((const nvbf*)p.a + (size_t)sl * NP + e0); a0 += nv_bf2f((nvbf)(w.x & 0xffffu)); a1 += nv_bf2f((nvbf)(w.x >> 16)); a2 += nv_bf2f((nvbf)(w.y & 0xffffu)); a3 += nv_bf2f((nvbf)(w.y >> 16)); }
        const NvF4 g = *(const NvF4*)(p.c + e0); NvF4 o; o.x = g.x * nv_gelu(a0 * (1.f / 128.f)); o.y = g.y * nv_gelu(a1 * (1.f / 128.f)); o.z = g.z * nv_gelu(a2 * (1.f / 128.f)); o.w = g.w * nv_gelu(a3 * (1.f / 128.f));
        *(NvF4*)(p.o0 + e0) = o; } break;
    case OP_POUTS: {
        const int row = (int)(gid / D), c = (int)(gid % D); const unsigned char* vb = (const unsigned char*)p.c + (size_t)(c >> 7) * 16384 * 128 + (c & 127); float acc = 0.f;
        for (int i = 0; i < 128; ++i) acc = fmaf(p.a[(size_t)row * 128 + i] * (1.f / 64.f), nv_e4m32f(vb[(size_t)((const int*)p.b)[(size_t)row * 128 + i] * 128]), acc);
        ((nvbf*)p.o0)[gid] = nv_f2bf(acc); } break;
    case OP_KEYS: {
        const int ch = (int)(gid % 32), hr = (int)(gid / 32), h = hr / 256, nrow = hr % 256, half = nrow >> 7, k0 = ch * 8; const float* src = p.a + (((size_t)h * 2 + half) * 128 + (nrow & 127)) * 128;
        NvU4 o; o.x = o.y = o.z = o.w = 0u;
        if ((k0 >> 7) == half) { const NvF4 v0 = *(const NvF4*)(src + (k0 & 127)), v1 = *(const NvF4*)(src + (k0 & 127) + 4);
            o.x = nv_f2bf(v0.x) | ((unsigned)nv_f2bf(v0.y) << 16); o.y = nv_f2bf(v0.z) | ((unsigned)nv_f2bf(v0.w) << 16); o.z = nv_f2bf(v1.x) | ((unsigned)nv_f2bf(v1.y) << 16); o.w = nv_f2bf(v1.z) | ((unsigned)nv_f2bf(v1.w) << 16); }
        *(NvU4*)((nvbf*)p.o0 + ((size_t)h * 256 + nrow) * 256 + k0) = o;
        if (ch == 0) { float ks = 0.f;
#pragma unroll 8
            for (int k = 0; k < 128; k += 4) { const NvF4 v = *(const NvF4*)(src + k); ks += (nv_bf2f(nv_f2bf(v.x)) + nv_bf2f(nv_f2bf(v.y))) + (nv_bf2f(nv_f2bf(v.z)) + nv_bf2f(nv_f2bf(v.w))); }
            p.o1[hr] = ks; } } break;
    case OP_TOPK2: {
        const int h = (int)(gid % 8); const nvbf* sc = (const nvbf*)p.a + (size_t)gid * 256; const nvbf* q = (const nvbf*)p.b + (size_t)gid * 256; const float* ksum = p.c + h * 256; float mu = 0.f;
        for (int c = 0; c < 256; ++c) mu += nv_bf2f(q[c]);
        mu *= (1.f / 256.f); float var = 0.f;
        for (int c = 0; c < 256; ++c) { float dlt = nv_bf2f(q[c]) - mu; var = fmaf(dlt, dlt, var); }
        const float rs = 1.f / sqrtf(var * (1.f / 256.f) + 1e-5f);
        float tv[16]; int ti[16]; float* tmpv = p.o2 + (size_t)gid * 32; int* tmpi = (int*)p.o3 + (size_t)gid * 32;
        for (int half = 0; half < 2; ++half) {
#pragma unroll
            for (int j = 0; j < 16; ++j) { tv[j] = -3.0e38f; ti[j] = 0; }
            for (int k = 0; k < 128; ++k) NV_INS16(tv, ti, rs * (nv_bf2f(sc[half * 128 + k]) - mu * ksum[half * 128 + k]), k);
#pragma unroll
            for (int j = 0; j < 16; ++j) { tmpv[half * 16 + j] = tv[j]; tmpi[half * 16 + j] = ti[j]; }
        }
#pragma unroll
        for (int j = 0; j < 16; ++j) { tv[j] = -3.0e38f; ti[j] = 0; }
        for (int i = 0; i < 16; ++i) for (int j = 0; j < 16; ++j) NV_INS16(tv, ti, tmpv[i] + tmpv[16 + j], tmpi[i] * 128 + tmpi[16 + j]);
        float den = 0.f, ev[16];
#pragma unroll
        for (int j = 0; j < 16; ++j) { ev[j] = NV_EXP(tv[j] - tv[0]); den += ev[j]; }
        float inv = 1.f / den;
#pragma unroll
        for (int j = 0; j < 16; ++j) { p.o0[(size_t)gid * 16 + j] = ev[j] * inv; ((int*)p.o1)[(size_t)gid * 16 + j] = ti[j]; } } break;
    case OP_PACT: {
        const int row = (int)(gid / 128); const int e = ((const int*)p.d)[gid]; const unsigned char* u = (const unsigned char*)p.b + (size_t)e * D; const nvbf* x = (const nvbf*)p.a + (size_t)row * D; float acc = 0.f;
        for (int c = 0; c < D; ++c) acc = fmaf(nv_e4m32f(u[c]), nv_bf2f(x[c]), acc);
        p.o0[gid] = p.c[gid] * nv_gelu(acc * (1.f / 128.f)); } break;
#if defined(HOST_TEST)
    case OP_POUTLN: {
        const float alpha = 1.6817928305074292f; float* x = p.o0 + (size_t)gid * D; std::vector<float> y(D, 0.f);
        for (int i = 0; i < 128; ++i) { const float cf = p.a[(size_t)gid * 128 + i] * (1.f / 64.f); const unsigned char* v = (const unsigned char*)p.c + (size_t)((const int*)p.b)[(size_t)gid * 128 + i] * D; for (int c = 0; c < D; ++c) y[c] = fmaf(cf, nv_e4m32f(v[c]), y[c]); }
        float mu = 0.f; for (int c = 0; c < D; ++c) { y[c] = alpha * x[c] + y[c]; mu += y[c]; }
        mu /= D; float var = 0.f; for (int c = 0; c < D; ++c) { float dlt = y[c] - mu; var = fmaf(dlt, dlt, var); }
        const float rs = 1.f / sqrtf(var / D + 1e-5f);
        for (int c = 0; c < D; ++c) { const float o = (y[c] - mu) * rs * p.d[c] + p.e[c]; x[c] = o; ((nvbf*)p.o1)[(size_t)gid * D + c] = nv_f2bf(o);
            if (p.o2) { unsigned char* f8 = (unsigned char*)p.o2 + (size_t)gid * 2 * D; const float xs = fminf(fmaxf(o * 16.f, -448.f), 448.f); const unsigned hc = nv_f2e4m3(xs); f8[c] = (unsigned char)hc; f8[D + c] = (unsigned char)nv_f2e4m3(xs - nv_e4m32f(hc)); } } } break;
#endif
    default: break;
    }
}

struct NvIO { const float* const* in; float* out; char* ws; size_t ws_size; };
template <class Launch> HD void nv_forward(const NvIO& io, const Dm& dm, Launch&& launch) {
    const int D = dm.D, M = dm.M, B = dm.B, DB = dm.DB, RH = dm.RH; const size_t MD = (size_t)M * D;
    float* y_prompt = io.out; float* y_sample = y_prompt + (size_t)B * (dm.T - 16) * D; float* p_gla = y_sample + (size_t)DB * dm.DT * D;
    float* p_h = p_gla + (size_t)2 * B * 4 * 64 * 128; float* p_conv = p_h + (size_t)2 * B * 512; float* p_rwkv = p_conv + (size_t)2 * B * 3 * 512;
    float* p_shift = p_rwkv + (size_t)2 * B * RH * 4096; float* s_gla = p_shift + (size_t)2 * B * D; float* s_h = s_gla + (size_t)2 * DB * 4 * 64 * 128;
    float* s_conv = s_h + (size_t)2 * DB * 512; float* s_rwkv = s_conv + (size_t)2 * DB * 3 * 512; float* s_shift = s_rwkv + (size_t)2 * DB * RH * 4096;
    float* w = (float*)io.ws; size_t off = 0; auto take = [&](size_t n) __attribute__((always_inline)) { float* r = w + off; off += (n + 63) & ~(size_t)63; return r; };
    float* X = take(MD > (size_t)nv_rup(M, 256) * 512 ? MD : (size_t)nv_rup(M, 256) * 512); float* VFIRST = take(MD); float* MOUT = take(MD);
    auto mk = [&](int code, long long n) __attribute__((always_inline)) { Op o{}; o.code = code; o.n = n; return o; };
    const int Mp = nv_rup(M, 256), Dp = nv_rup(D, 256), Dk = nv_rup(D, 128);
    auto takeh = [&](size_t n) __attribute__((always_inline)) { return (nvbf*)take((n + 1) / 2); };
    const size_t ABFN = (size_t)Mp * 1024 > (size_t)Mp * Dk ? (size_t)Mp * 1024 : (size_t)Mp * Dk; nvbf* ABF = takeh(ABFN + (size_t)Mp * D);
    const size_t SZ_WIN = (size_t)2816 * Dk, SZ_WOUT = (size_t)Dp * 1024, SZ_DD = (size_t)Dp * Dk, SZ_DN = (size_t)256 * Dk, SZ_UP = (size_t)Dp * 128, SZ_WQ = (size_t)2048 * Dk;
    nvbf* WT_WIN = takeh(2 * SZ_WIN); nvbf* WT_WOUT = takeh(2 * SZ_WOUT); nvbf* WT_WR = takeh(2 * SZ_DD); nvbf* WT_WK = takeh(2 * SZ_DD); nvbf* WT_WV = takeh(2 * SZ_DD); nvbf* WT_WO = takeh(2 * SZ_DD);
    nvbf* WT_W1 = takeh(2 * SZ_DN); nvbf* WT_W2 = takeh(2 * SZ_UP); nvbf* WT_A1 = takeh(2 * SZ_DN); nvbf* WT_A2 = takeh(2 * SZ_UP); nvbf* WT_G1 = takeh(2 * SZ_DN); nvbf* WT_G2 = takeh(2 * SZ_UP);
    nvbf* WT_V1 = takeh(SZ_DN); nvbf* WT_V2 = takeh(SZ_UP); nvbf* WT_WQ = takeh(4 * SZ_WQ); nvbf* WT_WG = takeh((size_t)2 * 1024 * 512); float* SPL = take(2 * 512); float* PRM = take((size_t)2 * 6 * D);
    nvbf* UB = takeh((size_t)16384 * D / 2); nvbf* VB = takeh((size_t)16384 * D / 2); nvbf* KB = takeh((size_t)8 * 256 * 256); float* KSUM = take(8 * 256);
    const size_t scratch0 = off;
    auto nb = [&](Op o) __attribute__((always_inline)) { o.code |= OPF_NOBAR; launch(o); };
    auto wt = [&](const float* W, int K, int N, int batch, nvbf* dst) __attribute__((always_inline)) { const int Np = nv_rup(N, 256), Kp = nv_rup(K, 128); Op o = mk(OP_WT, (long long)batch * Np * (Kp / 8)); o.a = W; o.o0 = (float*)dst; o.i0 = N; o.i1 = K; o.i2 = N; o.i3 = Np; o.i4 = Kp; nb(o); };
    wt(io.in[10], D, MIXIN, 2, WT_WIN); wt(io.in[21], 1024, D, 2, WT_WOUT); wt(io.in[23], D, D, 2, WT_WR); wt(io.in[24], D, D, 2, WT_WK); wt(io.in[25], D, D, 2, WT_WV); wt(io.in[26], D, D, 2, WT_WO);
    wt(io.in[28], D, 64, 2, WT_W1); wt(io.in[29], 64, D, 2, WT_W2); wt(io.in[31], D, 64, 2, WT_A1); wt(io.in[32], 64, D, 2, WT_A2); wt(io.in[36], D, 128, 2, WT_G1); wt(io.in[37], 128, D, 2, WT_G2);
    wt(io.in[34], D, 32, 1, WT_V1); wt(io.in[35], 32, D, 1, WT_V2); wt(io.in[43], D, 2048, 4, WT_WQ);
    for (int jj = 0; jj < 2; ++jj) { Op o = mk(OP_PRM, (long long)6 * D); o.a = io.in[27] + (size_t)jj * D; o.b = io.in[30] + (size_t)jj * D; o.c = jj > 0 ? io.in[33] + (size_t)(jj - 1) * D : nullptr; o.d = io.in[38] + (size_t)jj * D; o.e = io.in[39] + (size_t)jj * D; o.f = io.in[40] + (size_t)jj * RH * 64; o.o0 = PRM + (size_t)jj * 6 * D; nb(o); }
    for (int jj = 0; jj < 2; ++jj) { Op o = mk(OP_WGATE, 1024); o.a = io.in[16] + (size_t)jj * 8 * 64 * 64; o.b = io.in[18] + (size_t)jj * 8 * 64 * 64; o.c = io.in[20] + (size_t)jj * 512; o.o0 = (float*)(WT_WG + (size_t)jj * 1024 * 512); o.o1 = SPL + (size_t)jj * 512; nb(o); }
    auto fgemm = [&](const nvbf* Wt, float* C, int ldc, int N, int K, int bf16out = 0, const float* Aop = nullptr, bool nobar_ = false) __attribute__((always_inline)) {
        const int Kp = nv_rup(K, 128), Np = nv_rup(N, 256);
        Op o = mk(OP_FGEMM, (long long)M * N); o.a = Aop ? Aop : (const float*)ABF; o.b = (const float*)Wt; o.o0 = C; o.i0 = N; o.i1 = Kp; o.i2 = Kp; o.i3 = Kp; o.i4 = ldc; o.i5 = Np; o.i6 = bf16out; if (nobar_) nb(o); else launch(o); };
    auto gemm = [&](const float* A, int lda, const nvbf* Wt, float* C, int ldc, int N, int K, int act) __attribute__((always_inline)) {
        const int Kp = nv_rup(K, 128);
        { Op o = mk(OP_CVT8, (long long)Mp * (Kp / 8)); o.a = A; o.o0 = (float*)ABF; o.i0 = K; o.i1 = lda; o.i2 = Kp; o.i3 = act; launch(o); }
        fgemm(Wt, C, ldc, N, K); };
    { Op o = mk(OP_EMBED4, (long long)MD / 4); o.a = io.in[0]; o.b = io.in[1]; o.c = io.in[7]; o.o0 = X; o.o1 = (float*)ABF; launch(o); }
    const float* const w_outer = w; float* const out_outer = io.out;
    for (int layer = 0; layer < 4; ++layer) {
        float* wl = (float*)w_outer; float* ol = out_outer; NV_LAUNDER(wl); NV_LAUNDER(ol);
#define NV_RB(T, v) T const v##_rb = (T)((char*)wl + ((const char*)(v) - (const char*)w_outer))
#define NV_RO(v) float* const v##_rb = (float*)((char*)ol + ((const char*)(v) - (const char*)out_outer))
        NV_RB(float*, X); NV_RB(float*, VFIRST); NV_RB(float*, MOUT); NV_RB(nvbf*, ABF); NV_RB(nvbf*, WT_WIN); NV_RB(nvbf*, WT_WOUT); NV_RB(nvbf*, WT_WR); NV_RB(nvbf*, WT_WK); NV_RB(nvbf*, WT_WV); NV_RB(nvbf*, WT_WO);
        NV_RB(nvbf*, WT_W1); NV_RB(nvbf*, WT_W2); NV_RB(nvbf*, WT_A1); NV_RB(nvbf*, WT_A2); NV_RB(nvbf*, WT_G1); NV_RB(nvbf*, WT_G2); NV_RB(nvbf*, WT_V1); NV_RB(nvbf*, WT_V2); NV_RB(nvbf*, WT_WQ); NV_RB(nvbf*, WT_WG);
        NV_RB(float*, SPL); NV_RB(float*, PRM); NV_RB(nvbf*, UB); NV_RB(nvbf*, VB); NV_RB(nvbf*, KB); NV_RB(float*, KSUM);
        NV_RO(p_gla); NV_RO(p_h); NV_RO(p_conv); NV_RO(p_rwkv); NV_RO(p_shift); NV_RO(s_gla); NV_RO(s_h); NV_RO(s_conv); NV_RO(s_rwkv); NV_RO(s_shift);
#undef NV_RB
#undef NV_RO
        { float* const X = X_rb; float* const VFIRST = VFIRST_rb; float* const MOUT = MOUT_rb; nvbf* const ABF = ABF_rb; nvbf* const WT_WIN = WT_WIN_rb; nvbf* const WT_WOUT = WT_WOUT_rb; nvbf* const WT_WR = WT_WR_rb; nvbf* const WT_WK = WT_WK_rb;
          nvbf* const WT_WV = WT_WV_rb; nvbf* const WT_WO = WT_WO_rb; nvbf* const WT_W1 = WT_W1_rb; nvbf* const WT_W2 = WT_W2_rb; nvbf* const WT_A1 = WT_A1_rb; nvbf* const WT_A2 = WT_A2_rb; nvbf* const WT_G1 = WT_G1_rb; nvbf* const WT_G2 = WT_G2_rb;
          nvbf* const WT_V1 = WT_V1_rb; nvbf* const WT_V2 = WT_V2_rb; nvbf* const WT_WQ = WT_WQ_rb; nvbf* const WT_WG = WT_WG_rb; float* const SPL = SPL_rb; float* const PRM = PRM_rb; nvbf* const UB = UB_rb; nvbf* const VB = VB_rb; nvbf* const KB = KB_rb; float* const KSUM = KSUM_rb;
          float* const p_gla = p_gla_rb; float* const p_h = p_h_rb; float* const p_conv = p_conv_rb; float* const p_rwkv = p_rwkv_rb; float* const p_shift = p_shift_rb; float* const s_gla = s_gla_rb; float* const s_h = s_h_rb; float* const s_conv = s_conv_rb;
          float* const s_rwkv = s_rwkv_rb; float* const s_shift = s_shift_rb; float* const w = wl; (void)SPL; (void)WT_WG; (void)VFIRST;
        const int j = layer / 2; off = scratch0;
        if (layer % 2 == 0) {
            float* PROJ = take((size_t)M * MIXIN); float* LOGA = take((size_t)M * 256); float* O = take((size_t)M * 512); float* MIXO = X;
            float* XC = take((size_t)M * 512); nvbf* XCB = takeh((size_t)Mp * 512); float* AT = take((size_t)M * 512); float* BT = take((size_t)M * 512);
            const int NC = (dm.T + 63) / 64; float* LEND = take((size_t)B * 4 * NC * 8192); float* DEC = take((size_t)B * 4 * NC * 64); float* LA = take((size_t)B * NC * 512); float* LB = take((size_t)B * NC * 512);
            fgemm(WT_WIN + (size_t)j * SZ_WIN, PROJ, MIXIN, MIXIN, D);
            { Op o = mk(OP_LOGA4, (long long)M * 64); o.a = PROJ; o.b = io.in[11] + (size_t)j * 16 * 256; o.c = io.in[12] + (size_t)j * 256; o.o0 = LOGA; nb(o); }
            { Op o = mk(OP_CONV4, (long long)((M + 3) / 4) * 128); o.a = PROJ; o.b = io.in[4] + (size_t)j * DB * 3 * 512; o.c = io.in[14] + (size_t)j * 4 * 512; o.d = io.in[15] + (size_t)j * 512; o.o0 = XC; o.o1 = (float*)XCB; nb(o); }
            { Op o = mk(OP_CONVOUT, (long long)dm.NSEQ * 1536); o.a = PROJ; o.b = io.in[4] + (size_t)j * DB * 3 * 512; o.o1 = p_conv + (size_t)j * B * 3 * 512; o.o2 = s_conv + (size_t)j * DB * 3 * 512; launch(o); }
            { Op o = mk(OP_GLAF, (long long)B * 512); o.a = PROJ; o.b = LOGA; o.o0 = O; o.o1 = p_gla + (size_t)j * B * 4 * 64 * 128; nb(o); }
            { Op o = mk(OP_GLA3, (long long)(DB * 4) * 128); o.a = PROJ; o.b = LOGA; o.c = io.in[2] + (size_t)j * DB * 4 * 64 * 128; o.d = LEND; o.o0 = O; o.o2 = s_gla + (size_t)j * DB * 4 * 64 * 128; o.i0 = NC; o.i1 = 1; nb(o); }
            { Op o = mk(OP_LRUG2, (long long)M * 512); o.a = (const float*)XCB; o.b = (const float*)(WT_WG + (size_t)j * 1024 * 512); o.c = io.in[17] + (size_t)j * 512; o.d = io.in[19] + (size_t)j * 512; o.e = SPL + (size_t)j * 512; o.f = (const float*)XCB; o.o0 = AT; o.o1 = BT; launch(o); }
            { Op o = mk(OP_GLANORM, (long long)M * 4); o.a = O; o.b = PROJ; o.c = io.in[13] + (size_t)j * 128; o.o0 = MIXO; nb(o); }
            { Op o = mk(OP_LRU1, (long long)B * NC * 512); o.a = AT; o.b = BT; o.o0 = LA; o.o1 = LB; o.i0 = NC; launch(o); }
            { Op o = mk(OP_LRU3, (long long)(B * NC + DB) * 512); o.a = AT; o.b = BT; o.c = PROJ; o.d = io.in[3] + (size_t)j * DB * 512; o.e = LB; o.f = LA; o.o0 = MIXO; o.o1 = p_h + (size_t)j * B * 512; o.o2 = s_h + (size_t)j * DB * 512; o.i0 = NC; launch(o); }
            fgemm(WT_WOUT + (size_t)j * SZ_WOUT, MOUT, D, D, 1024, 1, X, true);
        } else {
            float* Y = take(MD); float* R = take(MD); float* K = take(MD); float* V = take(MD); float* G = take(MD); float* KK = take(MD);
            const size_t XMSZ = (size_t)Mp * D;
            float* WAV = take(3 * MD > 3 * XMSZ ? 3 * MD : 3 * XMSZ); float* Wd = WAV; float* Aa = WAV + MD; float* Vg = WAV + 2 * MD; nvbf* XM6 = (nvbf*)WAV;
            float* BON = take((size_t)M * RH); float* HLw = take((size_t)M * 64); float* HLa = take((size_t)M * 64); float* HLg = take((size_t)M * 128); float* HLv = take((size_t)M * 32);
            nvbf* ABw = takeh((size_t)Mp * 128); nvbf* ABa = takeh((size_t)Mp * 128); nvbf* ABg = takeh((size_t)Mp * 128); nvbf* ABv = takeh((size_t)Mp * 128);
            const float* shin = io.in[6] + (size_t)j * DB * D; const float* mu = io.in[22] + (size_t)j * 6 * D;
            { Op o = mk(OP_SHIFTOUT, (long long)dm.NSEQ * D); o.a = (const float*)ABF; o.o1 = p_shift + (size_t)j * B * D; o.o2 = s_shift + (size_t)j * DB * D; nb(o); }
            { Op o = mk(OP_MIX6, (long long)((M + 3) / 4) * (D / 8)); o.a = (const float*)ABF; o.b = shin; o.c = mu; o.o0 = (float*)XM6; o.i1 = (int)(XMSZ / 1024); launch(o); }
            auto gg = [&](const nvbf* A, const nvbf* Wt, float* C, int ldc, int N, int K, bool last, int bf16out = 0) __attribute__((always_inline)) { const int Kp = nv_rup(K, 128), Np = nv_rup(N, 256);
                Op o = mk(OP_FGEMM, (long long)M * N); o.a = (const float*)A; o.b = (const float*)Wt; o.o0 = C; o.i0 = N; o.i1 = Kp; o.i2 = Kp; o.i3 = Kp; o.i4 = ldc; o.i5 = Np; o.i6 = bf16out; if (!last) o.code |= OPF_GROUP; launch(o); };
            gg(XM6 + 0 * XMSZ, WT_WR + (size_t)j * SZ_DD, R, D, D, D, false, 1); gg(XM6 + 2 * XMSZ, WT_WK + (size_t)j * SZ_DD, K, D, D, D, false, 1); gg(XM6 + 3 * XMSZ, WT_WV + (size_t)j * SZ_DD, V, D, D, D, false, 1);
            gg(XM6 + 1 * XMSZ, WT_W1 + (size_t)j * SZ_DN, HLw, 64, 64, D, false); gg(XM6 + 4 * XMSZ, WT_A1 + (size_t)j * SZ_DN, HLa, 64, 64, D, false);
            if (j > 0) gg(XM6 + 3 * XMSZ, WT_V1 + (size_t)(j - 1) * SZ_DN, HLv, 32, 32, D, false);
            gg(XM6 + 5 * XMSZ, WT_G1 + (size_t)j * SZ_DN, HLg, 128, 128, D, true);
            auto cv = [&](const float* A, int K, nvbf* dst, int act, bool last) __attribute__((always_inline)) { Op o = mk(OP_CVT8, (long long)Mp * 16); o.a = A; o.o0 = (float*)dst; o.i0 = K; o.i1 = K; o.i2 = 128; o.i3 = act; if (last) launch(o); else nb(o); };
            cv(HLw, 64, ABw, 1, false); cv(HLa, 64, ABa, 0, false); if (j > 0) cv(HLv, 32, ABv, 0, false); cv(HLg, 128, ABg, 2, true);
            gg(ABw, WT_W2 + (size_t)j * SZ_UP, Wd, D, D, 64, false, 1); gg(ABa, WT_A2 + (size_t)j * SZ_UP, Aa, D, D, 64, false, 1); if (j > 0) gg(ABv, WT_V2 + (size_t)(j - 1) * SZ_UP, Vg, D, D, 32, false, 1); gg(ABg, WT_G2 + (size_t)j * SZ_UP, G, D, D, 128, true, 1);
            { Op o = mk(OP_WKVP, (long long)dm.NSEQ * RH * 64); o.a = R; o.b = K; o.c = Wd; o.d = Aa; o.e = V; o.f = Vg; o.g = VFIRST; o.h = PRM + (size_t)j * 6 * D; o.o0 = Y; o.o1 = p_rwkv + (size_t)j * B * RH * 4096; o.o2 = s_rwkv + (size_t)j * DB * RH * 4096;
              o.o3 = j > 0 ? KK : VFIRST; o.o4 = BON; o.o5 = (float*)(io.in[5] + (size_t)j * DB * RH * 4096); o.i0 = j > 0 ? 1 : 0; launch(o); }
            { Op o = mk(OP_POST2, (long long)M * RH); o.a = Y; o.b = G; o.c = j > 0 ? KK : VFIRST; o.d = BON; o.e = io.in[41] + (size_t)j * D; o.f = io.in[42] + (size_t)j * D; o.o0 = X; launch(o); }
            fgemm(WT_WO + (size_t)j * SZ_DD, MOUT, D, D, D, 1, X, true);
        }
        { Op o = mk(OP_CVTTAB8S, (long long)16384 * D / 16); o.a = io.in[45] + (size_t)layer * 16384 * D; o.o0 = (float*)UB; o.i0 = 7; o.i6 = (Mp / 256) * (nv_rup(D, 256) / 256); launch(o); }
        { Op o = mk(OP_LNRES, M); o.a = MOUT; o.b = io.in[8] + (size_t)(layer * 2 + 0) * D; o.c = io.in[9] + (size_t)(layer * 2 + 0) * D; o.o0 = X; o.o1 = (float*)ABF; o.o2 = (float*)(ABF + ABFN); launch(o); }
        off = scratch0;
        { nvbf* Q = takeh((size_t)Mp * 2048); float* SC = take((size_t)M * 2048); float* GATE = take((size_t)M * 128); float* EIDX = take((size_t)M * 128); float* TMPV = take((size_t)M * 256); float* TMPI = take((size_t)M * 256);
          float* COEF = take((size_t)M * 128);
          { Op o = mk(OP_FGEMM, (long long)M * 2048); o.a = (const float*)ABF; o.b = (const float*)(WT_WQ + (size_t)layer * SZ_WQ); o.o0 = (float*)Q; o.i0 = 2048; o.i1 = Dk; o.i2 = Dk; o.i3 = Dk; o.i4 = 2048; o.i5 = 2048; o.i6 = 1; nb(o); }
          { Op o = mk(OP_CVTTAB8S, (long long)16384 * D / 16); o.a = io.in[46] + (size_t)layer * 16384 * D; o.o0 = (float*)VB; o.i0 = 6; o.i6 = (Mp / 256) * 8; nb(o); }
          { Op o = mk(OP_KEYS, 8 * 256 * 32); o.a = io.in[44] + (size_t)layer * 8 * 2 * 128 * 128; o.o0 = (float*)KB; o.o1 = KSUM; launch(o); }
          { Op o = mk(OP_FGEMM, (long long)M * 2048); o.a = (const float*)Q; o.b = (const float*)KB; o.o0 = SC; o.i0 = 2048; o.i1 = 256; o.i2 = 2048; o.i3 = 256; o.i4 = 2048; o.i5 = 2048; o.i6 = 3; launch(o); }
          { Op o = mk(OP_TOPK2, (long long)M * 8); o.a = SC; o.b = (const float*)Q; o.c = KSUM; o.o0 = GATE; o.o1 = EIDX; o.o2 = TMPV; o.o3 = TMPI; launch(o); }
          { const int NS = D / 128; float* PART = take((size_t)NS * M * 128); float* YBUF = take(MD);
            #ifdef PROBE_EMASK
            { Op o = mk(OP_PACTS, (long long)NS * M * 128); o.a = (const float*)(ABF + ABFN); o.b = (const float*)UB; o.d = EIDX; o.o0 = PART; o.i0 = PROBE_EMASK; launch(o); }
#endif
            { Op o = mk(OP_PACTS, (long long)NS * M * 128); o.a = (const float*)(ABF + ABFN); o.b = (const float*)UB; o.d = EIDX; o.o0 = PART; o.i0 = 16383; launch(o); }
            { Op o = mk(OP_PRED, (long long)M * 32); o.a = PART; o.c = GATE; o.o0 = COEF; o.i0 = NS; launch(o); }
            { Op o = mk(OP_POUTS, (long long)MD); o.a = COEF; o.b = EIDX; o.c = (const float*)VB; o.o0 = YBUF; launch(o); }
            { Op o = mk(OP_LNRES, M); o.a = YBUF; o.b = io.in[8] + (size_t)(layer * 2 + 1) * D; o.c = io.in[9] + (size_t)(layer * 2 + 1) * D; o.o0 = X; o.o1 = (float*)ABF; launch(o); } } }
        }
    }
    { Op o = mk(OP_YOUT4, (long long)MD / 4); o.a = (const float*)ABF; o.o0 = y_prompt; launch(o); }
    (void)y_sample;
}

#include <cstdint>
namespace pg8 {
#define PG8_LAS __attribute__((address_space(3)))
typedef unsigned short bf16_t;
typedef short bf16x8 __attribute__((ext_vector_type(8)));
typedef float f32x4 __attribute__((ext_vector_type(4)));
typedef unsigned u32x4 __attribute__((ext_vector_type(4)));
constexpr int BM = 256, BK = 64, HALF = 128, HTB = HALF * BK * 2  , STAGE_BYTES = 8 * HTB, NXCD = 8, WGM = 8;

__host__ __device__ __forceinline__ int lds_byte(int r, int c) { const int st = (r >> 4) * 2 + (c >> 5), rr = r & 15, cc = c & 31, ob = rr * 64 + cc * 2; return st * 1024 + (ob ^ (((ob >> 9) & 1) << 5)); }
__host__ __device__ __forceinline__ void stage_rc(int b, int& R, int& C) { const int st = b / 1024, sb = b % 1024, swz = sb ^ (((sb >> 9) & 1) << 5); R = (st >> 1) * 16 + swz / 64; C = (st & 1) * 32 + (swz % 64) / 2; }
__host__ __device__ __forceinline__ int perm32(int rho) { const int n = rho >> 4, i = rho & 15; return 8 * (i >> 2) + 4 * n + (i & 3); }

struct Unit { int pm, pn, grp, pad_; const char* A; const char* B; };
struct Gemm { const bf16_t* A; const bf16_t* Bt; int M, N, K, lda, ldb; };

struct StaticOrder {
    int nM, nN, nwg, G, c; const char* A; const char* B; size_t tsA, tsB, acs;
    __host__ __device__ void init(const Gemm& g, int G_, int c_) { nM = g.M / BM; nN = g.N / BM; nwg = nM * nN; G = G_; c = c_; A = (const char*)g.A; B = (const char*)g.Bt; tsA = (size_t)BM * g.lda * 2; tsB = (size_t)BM * g.ldb * 2; acs = 0; }
    __host__ __device__ bool next(int i, Unit& u) const {
        const long L = (long)i * G + c; if (L >= nwg) return false;
        int wgid = (int)L; { const int q = nwg / NXCD, r = nwg % NXCD, xcd = wgid % NXCD, off = wgid / NXCD; wgid = (xcd < r ? xcd * (q + 1) : r * (q + 1) + (xcd - r) * q) + off; }
        const int nig = WGM * nN, gid = wgid / nig, fm = gid * WGM, gsz = (nM - fm) < WGM ? (nM - fm) : WGM;
        u.pm = fm + ((wgid % nig) % gsz); u.pn = (wgid % nig) / gsz; u.grp = 0; u.pad_ = 0; u.A = A + (size_t)u.pm * tsA + (size_t)u.pn * acs; u.B = B + (size_t)u.pn * tsB; return true;
    }
    __device__ __forceinline__ void a_ready(const Unit&) const {}
    __device__ __forceinline__ void done(const Unit&) const {}
};

template <class Epi, class Sched, bool ALIGN_EPI = false, bool SP2 = false>
__device__ __forceinline__ void gemm_phase(PG8_LAS unsigned char* lds, const Gemm g, const Sched& S, const Epi& E) {
    int tid_raw = threadIdx.x; asm volatile("" : "+v"(tid_raw));
    const int tid = tid_raw, wid = __builtin_amdgcn_readfirstlane(tid >> 6), lane = tid & 63, wr = wid >> 2, wc = wid & 3, fr = lane & 15, fq = lane >> 4;
    const int K = g.K, nt = K / BK;
    unsigned voffA[2], voffB[2];
#pragma unroll
    for (int i = 0; i < 2; ++i) { int R, C; stage_rc(tid * 16 + i * 8192, R, C); const int Rb = Epi::PERM ? ((R & ~31) + perm32(R & 31)) : R;
        voffA[i] = (unsigned)(R * g.lda + C) * 2u; voffB[i] = (unsigned)(Rb * g.ldb + C) * 2u; }
    const size_t kstep = (size_t)(BK * 2);
    const size_t hstepA = (size_t)HALF * g.lda * 2, hstepB = (size_t)HALF * g.ldb * 2;
    const unsigned ldsw = (unsigned)wid * 1024u;
    const int aoff = lds_byte(wr * 64 + fr, fq * 8), boff = lds_byte(wc * 32 + fr, fq * 8);
#define PG8_SA(b, h) (((b) * 2 + (h)) * HTB)
#define PG8_SB(b, h) ((4 + (b) * 2 + (h)) * HTB)
#define PG8_STAGE(bufoff, gbase, voff) do { _Pragma("unroll") for (int _i = 0; _i < 2; ++_i) \
        __builtin_amdgcn_global_load_lds((const unsigned*)((const char*)(gbase) + (voff)[_i]), (PG8_LAS unsigned*)(lds + (bufoff) + ldsw + _i * 8192), 16, 0, 0); } while (0)
#define PG8_LDA(dst, b, h) do { _Pragma("unroll") for (int m = 0; m < 4; ++m) _Pragma("unroll") for (int k = 0; k < 2; ++k) dst[m][k] = *(const PG8_LAS bf16x8*)(lds + PG8_SA(b, h) + aoff + m * 2048 + k * 1024); } while (0)
#define PG8_LDB(dst, b, h) do { _Pragma("unroll") for (int n = 0; n < 2; ++n) _Pragma("unroll") for (int k = 0; k < 2; ++k) dst[n][k] = *(const PG8_LAS bf16x8*)(lds + PG8_SB(b, h) + boff + n * 2048 + k * 1024); } while (0)
#define PG8_MMA(ai, bj, At, Bt) do { __builtin_amdgcn_s_setprio(1); _Pragma("unroll") for (int m = 0; m < 4; ++m) _Pragma("unroll") for (int n = 0; n < 2; ++n) _Pragma("unroll") for (int k = 0; k < 2; ++k) \
        acc[ai][bj][m][n] = __builtin_amdgcn_mfma_f32_16x16x32_bf16(Bt[n][k], At[m][k], acc[ai][bj][m][n], 0, 0, 0); __builtin_amdgcn_s_setprio(0); } while (0)
#define PG8_WAIT_V(n) asm volatile("s_waitcnt vmcnt(" #n ")" ::: "memory")
#define PG8_WAIT_L(n) asm volatile("s_waitcnt lgkmcnt(" #n ")" ::: "memory")
#define PG8_BAR __builtin_amdgcn_s_barrier()
#define PG8_SCHED __builtin_amdgcn_sched_barrier(0)
    Unit cur, nxt; int ui = 0;
    if (!S.next(0, cur)) return;
    f32x4 acc[2][2][4][2];
#pragma unroll
    for (int a = 0; a < 2; ++a)
#pragma unroll
        for (int b = 0; b < 2; ++b)
#pragma unroll
            for (int m = 0; m < 4; ++m)
#pragma unroll
                for (int n = 0; n < 2; ++n) acc[a][b][m][n] = (f32x4){0.f, 0.f, 0.f, 0.f};
    bf16x8 At[4][2], B0[2][2], B1[2][2];
    const char* cA = cur.A; const char* cB = cur.B;
    S.a_ready(cur);
    if constexpr (SP2) {
        PG8_STAGE(PG8_SB(0, 0), cB, voffB); PG8_STAGE(PG8_SB(0, 1), cB + hstepB, voffB); PG8_STAGE(PG8_SA(0, 0), cA, voffA); PG8_STAGE(PG8_SA(0, 1), cA + hstepA, voffA);
        if (wr == 1) PG8_BAR;
        PG8_WAIT_V(2); PG8_BAR;
        PG8_STAGE(PG8_SB(1, 0), cB + kstep, voffB); PG8_STAGE(PG8_SA(1, 0), cA + kstep, voffA); PG8_STAGE(PG8_SB(1, 1), cB + hstepB + kstep, voffB);
        PG8_WAIT_V(6); PG8_BAR;
    } else {
        PG8_STAGE(PG8_SB(0, 0), cB, voffB); PG8_STAGE(PG8_SA(0, 0), cA, voffA); PG8_STAGE(PG8_SB(0, 1), cB + hstepB, voffB); PG8_STAGE(PG8_SA(0, 1), cA + hstepA, voffA);
        if (wr == 1) PG8_BAR;
        PG8_WAIT_V(4); PG8_BAR;
        PG8_STAGE(PG8_SB(1, 0), cB + kstep, voffB); PG8_STAGE(PG8_SA(1, 0), cA + kstep, voffA); PG8_STAGE(PG8_SB(1, 1), cB + hstepB + kstep, voffB);
        PG8_WAIT_V(6); PG8_BAR;
    }
    for (;;) {
        const bool has_next = S.next(ui + 1, nxt);
        const char* nA = has_next ? nxt.A : cA; const char* nB = has_next ? nxt.B : cB;
        for (int t = 0; t < nt; t += 2) {
            const bool last = (t == nt - 2);
            const char* a1 = cA + (size_t)(t + 1) * kstep;
            const char* a2 = last ? nA : cA + (size_t)(t + 2) * kstep; const char* b2 = last ? nB : cB + (size_t)(t + 2) * kstep;
            const char* a3 = a2 + kstep; const char* b3 = b2 + kstep;
            if (last && has_next) S.a_ready(nxt);
            if constexpr (SP2) {
            PG8_LDB(B0, 0, 0); PG8_LDB(B1, 0, 1); PG8_SCHED; PG8_LDA(At, 0, 0); PG8_STAGE(PG8_SA(1, 1), a1 + hstepA, voffA);
            PG8_WAIT_V(8); PG8_WAIT_L(0); PG8_BAR; PG8_MMA(0, 0, At, B0); PG8_MMA(0, 1, At, B1); PG8_BAR; PG8_SCHED;
            PG8_LDA(At, 0, 1); PG8_STAGE(PG8_SB(0, 0), b2, voffB); PG8_STAGE(PG8_SB(0, 1), b2 + hstepB, voffB); PG8_STAGE(PG8_SA(0, 0), a2, voffA);
            PG8_WAIT_V(8); PG8_WAIT_L(0); PG8_BAR; PG8_MMA(1, 0, At, B0); PG8_MMA(1, 1, At, B1); PG8_BAR; PG8_SCHED;
            PG8_LDB(B0, 1, 0); PG8_LDB(B1, 1, 1); PG8_SCHED; PG8_LDA(At, 1, 0); PG8_STAGE(PG8_SA(0, 1), a2 + hstepA, voffA);
            PG8_WAIT_V(8); PG8_WAIT_L(0); PG8_BAR; PG8_MMA(0, 0, At, B0); PG8_MMA(0, 1, At, B1); PG8_BAR; PG8_SCHED;
            PG8_LDA(At, 1, 1); PG8_STAGE(PG8_SB(1, 0), b3, voffB); PG8_STAGE(PG8_SB(1, 1), b3 + hstepB, voffB); PG8_STAGE(PG8_SA(1, 0), a3, voffA);
            PG8_WAIT_V(8); PG8_WAIT_L(0); PG8_BAR; PG8_MMA(1, 0, At, B0); PG8_MMA(1, 1, At, B1); PG8_BAR; PG8_SCHED;
            } else {
            PG8_LDB(B0, 0, 0); PG8_SCHED; PG8_LDA(At, 0, 0); PG8_STAGE(PG8_SA(1, 1), a1 + hstepA, voffA);
            PG8_WAIT_L(8); PG8_BAR; PG8_WAIT_L(0); PG8_MMA(0, 0, At, B0); PG8_BAR; PG8_SCHED;
            PG8_LDB(B1, 0, 1); PG8_STAGE(PG8_SB(0, 0), b2, voffB);
            PG8_BAR; PG8_WAIT_L(0); PG8_MMA(0, 1, At, B1); PG8_BAR;
            PG8_LDA(At, 0, 1); PG8_STAGE(PG8_SA(0, 0), a2, voffA);
            PG8_BAR; PG8_WAIT_L(0); PG8_MMA(1, 0, At, B0); PG8_BAR; PG8_SCHED;
            PG8_STAGE(PG8_SB(0, 1), b2 + hstepB, voffB);
            PG8_WAIT_V(6); PG8_BAR; PG8_MMA(1, 1, At, B1); PG8_BAR;
            PG8_LDB(B0, 1, 0); PG8_SCHED; PG8_LDA(At, 1, 0); PG8_STAGE(PG8_SA(0, 1), a2 + hstepA, voffA);
            PG8_WAIT_L(8); PG8_BAR; PG8_WAIT_L(0); PG8_MMA(0, 0, At, B0); PG8_BAR; PG8_SCHED;
            PG8_LDB(B1, 1, 1); PG8_STAGE(PG8_SB(1, 0), b3, voffB);
            PG8_BAR; PG8_WAIT_L(0); PG8_MMA(0, 1, At, B1); PG8_BAR;
            PG8_LDA(At, 1, 1); PG8_STAGE(PG8_SA(1, 0), a3, voffA);
            PG8_BAR; PG8_WAIT_L(0); PG8_MMA(1, 0, At, B0); PG8_BAR; PG8_SCHED;
            PG8_STAGE(PG8_SB(1, 1), b3 + hstepB, voffB);
            PG8_WAIT_V(6); PG8_BAR; PG8_MMA(1, 1, At, B1); PG8_BAR;
            }
        }
        if constexpr (ALIGN_EPI) { if (wr == 0) PG8_BAR; }
        if constexpr (!Epi::AFTER_DRAIN) { E(acc, cur, wr, wc, fr, fq); S.done(cur); }
        if (!has_next) break;
#pragma unroll
        for (int a = 0; a < 2; ++a)
#pragma unroll
            for (int b = 0; b < 2; ++b)
#pragma unroll
                for (int m = 0; m < 4; ++m)
#pragma unroll
                    for (int n = 0; n < 2; ++n) acc[a][b][m][n] = (f32x4){0.f, 0.f, 0.f, 0.f};
        cur = nxt; cA = nA; cB = nB; ++ui;
        if constexpr (ALIGN_EPI) { if (wr == 1) PG8_BAR; }
    }
    PG8_WAIT_V(0);
    if constexpr (!ALIGN_EPI) { if (wr == 0) PG8_BAR; }
    PG8_BAR;
    if constexpr (Epi::AFTER_DRAIN) { E.fused(acc, cur, wr, wc, fr, fq, lds, wid, lane); S.done(cur); }
#undef PG8_SA
#undef PG8_SB
#undef PG8_STAGE
#undef PG8_LDA
#undef PG8_LDB
#undef PG8_MMA
#undef PG8_WAIT_V
#undef PG8_WAIT_L
#undef PG8_BAR
#undef PG8_SCHED
}
}
template <class T> __device__ __forceinline__ T* uni_ptr(T* p) {
    unsigned long long v = (unsigned long long)p; unsigned lo = __builtin_amdgcn_readfirstlane((unsigned)v), hi = __builtin_amdgcn_readfirstlane((unsigned)(v >> 32));
    unsigned long long r = ((unsigned long long)hi << 32) | lo; asm volatile("" : "+s"(r)); return (T*)r; }
__device__ __forceinline__ int rfl(int x) { int t = __builtin_amdgcn_readfirstlane(x); asm volatile("" : "+s"(t)); return t; }
namespace pg8 {
__device__ __forceinline__ unsigned cvt_pk_bf16(float lo, float hi) { unsigned r; asm volatile("v_cvt_pk_bf16_f32 %0, %1, %2" : "=v"(r) : "v"(lo), "v"(hi)); return r; }
struct EpiF32 {
    static constexpr bool PERM = false, AFTER_DRAIN = false;
    float* C; int ldc, Mreal, Nreal;
    __device__ __forceinline__ void operator()(const f32x4 (&acc)[2][2][4][2], const Unit& u, int wr, int wc, int fr, int fq) const {
        const int row0 = u.pm * BM + wr * 64 + fr, col0 = u.pn * BM + wc * 32 + 4 * fq;
#pragma unroll
        for (int ai = 0; ai < 2; ++ai)
#pragma unroll
            for (int m = 0; m < 4; ++m) { const int r = row0 + ai * HALF + m * 16; if (r < Mreal) { float* rowp = C + (size_t)r * ldc + col0;
#pragma unroll
                for (int bj = 0; bj < 2; ++bj)
#pragma unroll
                    for (int n = 0; n < 2; ++n) { const int c = col0 + bj * HALF + n * 16; if (c < Nreal) *(f32x4*)(rowp + bj * HALF + n * 16) = acc[ai][bj][m][n]; } } }
    }
};
struct EpiBf16Plain {
    static constexpr bool PERM = true, AFTER_DRAIN = false;
    bf16_t* O; int ldc;
    __device__ __forceinline__ void operator()(const f32x4 (&acc)[2][2][4][2], const Unit& u, int wr, int wc, int fr, int fq) const {
        const int row0 = u.pm * BM + wr * 64 + fr, col0 = u.pn * BM + wc * 32 + 8 * fq;
#pragma unroll
        for (int ai = 0; ai < 2; ++ai)
#pragma unroll
            for (int m = 0; m < 4; ++m) { bf16_t* rowp = O + (size_t)(row0 + ai * HALF + m * 16) * ldc + col0;
#pragma unroll
                for (int bj = 0; bj < 2; ++bj) { const f32x4 v0 = acc[ai][bj][m][0], v1 = acc[ai][bj][m][1]; u32x4 w;
                    w.x = cvt_pk_bf16(v0[0], v0[1]); w.y = cvt_pk_bf16(v0[2], v0[3]); w.z = cvt_pk_bf16(v1[0], v1[1]); w.w = cvt_pk_bf16(v1[2], v1[3]);
                    *(u32x4*)(rowp + bj * HALF) = w; } }
    }
};
struct EpiLru {
    static constexpr bool PERM = false, AFTER_DRAIN = false;
    const float* ba; const float* bx; const float* spl; const bf16_t* XC; float* AT; float* BT; int Mreal;
    __device__ __forceinline__ void operator()(const f32x4 (&acc)[2][2][4][2], const Unit& u, int wr, int wc, int fr, int fq) const {
        const int row0 = u.pm * BM + wr * 64 + fr, ch0 = u.pn * 128 + wc * 32 + 4 * fq;
#pragma unroll
        for (int n = 0; n < 2; ++n) { const int c = ch0 + 16 * n; const f32x4 ba4 = *(const f32x4*)(ba + c), bx4 = *(const f32x4*)(bx + c), sp4 = *(const f32x4*)(spl + c);
#pragma unroll
            for (int ai = 0; ai < 2; ++ai)
#pragma unroll
                for (int m = 0; m < 4; ++m) { const int r = row0 + ai * HALF + m * 16; if (r < Mreal) { const unsigned long long xw_ = *(const unsigned long long*)(XC + (size_t)r * 512 + c); const unsigned xl_ = (unsigned)xw_, xh_ = (unsigned)(xw_ >> 32); const f32x4 xc = {__uint_as_float(xl_ << 16), __uint_as_float(xl_ & 0xffff0000u), __uint_as_float(xh_ << 16), __uint_as_float(xh_ & 0xffff0000u)}; const f32x4 ga = acc[ai][0][m][n] + ba4, gx = acc[ai][1][m][n] + bx4; f32x4 at, bt;
#pragma unroll
                    for (int i = 0; i < 4; ++i) { const float gate_a = __builtin_amdgcn_rcpf(1.f + __expf(-ga[i])), gate_x = __builtin_amdgcn_rcpf(1.f + __expf(-gx[i])); const float la = gate_a * sp4[i]; at[i] = __expf(la); bt[i] = sqrtf(-expm1f(2.f * la)) * (gate_x * xc[i]); }
                    *(f32x4*)(AT + (size_t)r * 512 + c) = at; *(f32x4*)(BT + (size_t)r * 512 + c) = bt; } } }
    }
};
struct GroupOrder {
    const PG8_LAS Op* tab; int ng, nM, G, c; size_t tsA, tsB;
    __device__ __forceinline__ bool next(int i, Unit& u) const {
        int L = i * G + c, g = 0;
        for (; g < ng; ++g) { const int cnt = nM * (__builtin_amdgcn_readfirstlane(tab[g].i5) >> 8); if (L < cnt) break; L -= cnt; }
        if (g >= ng) return false;
        u.pm = L % nM; u.pn = L / nM; u.grp = g; u.pad_ = 0;
        u.A = (const char*)uni_ptr(tab[g].a) + (size_t)u.pm * tsA; u.B = (const char*)uni_ptr(tab[g].b) + (size_t)u.pn * tsB; return true;
    }
    __device__ __forceinline__ void a_ready(const Unit&) const {}
    __device__ __forceinline__ void done(const Unit&) const {}
};
struct EpiGroup {
    static constexpr bool PERM = true, AFTER_DRAIN = false;
    const PG8_LAS Op* tab; int Mreal;
    __device__ __forceinline__ void operator()(const f32x4 (&acc)[2][2][4][2], const Unit& u, int wr, int wc, int fr, int fq) const {
        const int ldc = rfl(tab[u.grp].i4), Nreal = rfl(tab[u.grp].i0), fl = rfl(tab[u.grp].i6);
        if (fl & 1) { const EpiBf16Plain E{(bf16_t*)uni_ptr(tab[u.grp].o0), ldc}; E(acc, u, wr, wc, fr, fq); return; }
        float* C = uni_ptr(tab[u.grp].o0); const int row0 = u.pm * BM + wr * 64 + fr, col0 = u.pn * BM + wc * 32 + 8 * fq;
#pragma unroll
        for (int ai = 0; ai < 2; ++ai)
#pragma unroll
            for (int m = 0; m < 4; ++m) { const int r = row0 + ai * HALF + m * 16; if (r < Mreal) { float* rowp = C + (size_t)r * ldc + col0;
#pragma unroll
                for (int bj = 0; bj < 2; ++bj) { if (col0 + bj * HALF < Nreal) { *(f32x4*)(rowp + bj * HALF) = acc[ai][bj][m][0]; *(f32x4*)(rowp + bj * HALF + 4) = acc[ai][bj][m][1]; } } } }
    }
};
}

#define XB_TMO      128
#define XB_XCNT(j)  (256  + 64 * (j))
#define XB_XSUB(j)  (1280 + 64 * (j))
#define XB_XGEN(j)  (2304 + 64 * (j))
#define XB_TOP      3328
#define XB_TOPGEN   3392
#define XCD_BAR_WORDS 3456
#define XB_SPIN_CAP (1u << 18)
#define LAS __attribute__((address_space(3)))
__device__ __forceinline__ unsigned xb_ld(unsigned* p)              { return __hip_atomic_load(p, __ATOMIC_RELAXED, __HIP_MEMORY_SCOPE_AGENT); }
__device__ __forceinline__ unsigned xb_add(unsigned* p, unsigned v) { return __hip_atomic_fetch_add(p, v, __ATOMIC_RELAXED, __HIP_MEMORY_SCOPE_AGENT); }
__device__ __forceinline__ unsigned xb_xcc_id() { return (unsigned)__builtin_amdgcn_s_getreg((3 << 11) | 20) & 0xFu; }
#define XB_SPIN(cond, bar) do { unsigned _sp = 0; while (cond) { __builtin_amdgcn_s_sleep(1); \
    if ((++_sp & 255u) == 0u) { if (xb_ld(&(bar)[XB_TMO])) break; if (_sp > XB_SPIN_CAP) { atomicAdd(&(bar)[XB_TMO], 1u); break; } } } } while (0)
struct XcdBarrier { unsigned* bar; unsigned x; volatile LAS unsigned* st; };
__device__ __forceinline__ XcdBarrier xcd_barrier_post(unsigned* bar, volatile LAS unsigned* st) {
    XcdBarrier b; b.bar = bar; b.x = xb_xcc_id(); b.st = st;
    if (threadIdx.x == 0) (void)xb_add(&bar[XB_XCNT(b.x)], 1u);
    return b;
}
__device__ __forceinline__ void xcd_barrier_complete(unsigned* bar, unsigned x, unsigned& nloc, unsigned& nx) {
    const unsigned G = gridDim.x * gridDim.y * gridDim.z;
    unsigned sum, cnt, mine, sp = 0u;
    for (;;) {
        sum = 0u; cnt = 0u; mine = 0u;
#pragma unroll
        for (unsigned j = 0; j < 16; ++j) { const unsigned c = xb_ld(&bar[XB_XCNT(j)]); sum += c; cnt += (c > 0u) ? 1u : 0u; mine = (j == x) ? c : mine; }
        if (sum == G) break;
        __builtin_amdgcn_s_sleep(1);
        if ((++sp & 255u) == 0u) { if (xb_ld(&bar[XB_TMO])) break; if (sp > XB_SPIN_CAP) { atomicAdd(&bar[XB_TMO], 1u); break; } }
    }
    nloc = mine > 0u ? mine : 1u; nx = cnt > 0u ? cnt : 1u;
}
__device__ __forceinline__ void xcd_barrier(const XcdBarrier& b) {
    asm volatile("s_waitcnt vmcnt(0)" ::: "memory");
    __syncthreads();
    if (threadIdx.x == 0) {
        unsigned* bar = b.bar;
        __builtin_amdgcn_s_waitcnt(0);
        unsigned nloc = b.st[0], nx = b.st[1];
        if (nloc == 0u) { xcd_barrier_complete(bar, b.x, nloc, nx); b.st[0] = nloc; b.st[1] = nx; }
        const unsigned old = xb_add(&bar[XB_XSUB(b.x)], 1u);
        const unsigned gen = old / nloc;
        if (old + 1u == (gen + 1u) * nloc) {
            __builtin_amdgcn_fence(__ATOMIC_RELEASE, "agent");
            asm volatile("s_waitcnt vmcnt(0)" ::: "memory");
            const unsigned og = xb_add(&bar[XB_TOP], 1u);
            const unsigned tg = og / nx;
            if (og + 1u == (tg + 1u) * nx) xb_add(&bar[XB_TOPGEN], 1u);
            else XB_SPIN(xb_ld(&bar[XB_TOPGEN]) == tg, bar);
            __builtin_amdgcn_fence(__ATOMIC_ACQUIRE, "agent");
            xb_add(&bar[XB_XGEN(b.x)], 1u);
            asm volatile("s_waitcnt vmcnt(0)" ::: "memory");
        } else {
            XB_SPIN(xb_ld(&bar[XB_XGEN(b.x)]) == gen, bar);
            __builtin_amdgcn_fence(__ATOMIC_ACQUIRE, "agent");
            asm volatile("s_waitcnt vmcnt(0)" ::: "memory");
        }
    }
    __syncthreads();
}

namespace fk {
#define GAS __attribute__((address_space(1)))
typedef unsigned u32x4 __attribute__((ext_vector_type(4)));
typedef unsigned u32x2 __attribute__((ext_vector_type(2)));
typedef float f32x4 __attribute__((ext_vector_type(4)));
typedef float f32x2 __attribute__((ext_vector_type(2)));
typedef __bf16 bf2 __attribute__((ext_vector_type(2)));
typedef unsigned short bf16_t;
__device__ __forceinline__ float bflo(unsigned u) { return __uint_as_float(u << 16); }
__device__ __forceinline__ float bfhi(unsigned u) { return __uint_as_float(u & 0xffff0000u); }
__device__ __forceinline__ float dot2(unsigned a, unsigned b, float c) { return __builtin_amdgcn_fdot2_f32_bf16(__builtin_bit_cast(bf2, a), __builtin_bit_cast(bf2, b), c, false); }
__device__ __forceinline__ unsigned pk_bf16(float lo, float hi) { unsigned r; asm volatile("v_cvt_pk_bf16_f32 %0, %1, %2" : "=v"(r) : "v"(lo), "v"(hi)); return r; }
template <int CTRL> __device__ __forceinline__ float dppf(float v) { return __int_as_float(__builtin_amdgcn_update_dpp(0, __float_as_int(v), CTRL, 0xf, 0xf, true)); }
__device__ __forceinline__ float row_max16(float v) { v = fmaxf(v, dppf<0xB1>(v)); v = fmaxf(v, dppf<0x4E>(v)); v = fmaxf(v, dppf<0x141>(v)); v = fmaxf(v, dppf<0x140>(v)); return v; }
__device__ __forceinline__ float frcp(float x) { return __builtin_amdgcn_rcpf(x); }
__device__ __forceinline__ float fsqrt(float x) { return __builtin_amdgcn_sqrtf(x); }
__device__ __forceinline__ float row_sum8(float v) { v += dppf<0xB1>(v); v += dppf<0x4E>(v); v += dppf<0x141>(v); return v; }
__device__ __forceinline__ float row_sum16(float v) { v += dppf<0xB1>(v); v += dppf<0x4E>(v); v += dppf<0x141>(v); v += dppf<0x140>(v); return v; }
__device__ __forceinline__ float shx(float v, int m, int lane) { return __int_as_float(__builtin_amdgcn_ds_bpermute((lane ^ m) << 2, __float_as_int(v))); }
__device__ __forceinline__ float wave_sum(float v, int lane) { v = row_sum16(v); v += shx(v, 16, lane); v += shx(v, 32, lane); return v; }
__device__ __forceinline__ float gelu_tanh(float x) { return 0.5f * x * (1.f + tanhf(0.7978845608028654f * (x + 0.044715f * x * x * x))); }
#define FK_NEG (-3.0e38f)

template <int CTRL> __device__ __forceinline__ int dppi(int v) { return __builtin_amdgcn_update_dpp(0, v, CTRL, 0xf, 0xf, true); }
__device__ __forceinline__ int row_min16i(int v) { v = min(v, dppi<0xB1>(v)); v = min(v, dppi<0x4E>(v)); v = min(v, dppi<0x141>(v)); v = min(v, dppi<0x140>(v)); return v; }
#define FK_CE(a, b) do { const bool sw_ = v[b] > v[a]; const float tv_ = sw_ ? v[b] : v[a]; v[b] = sw_ ? v[a] : v[b]; v[a] = tv_; const int ti_ = sw_ ? id[b] : id[a]; id[b] = sw_ ? id[a] : id[b]; id[a] = ti_; } while (0)
#define FK_SORT8(v, id) do { FK_CE2(v, id, 0, 1); FK_CE2(v, id, 2, 3); FK_CE2(v, id, 4, 5); FK_CE2(v, id, 6, 7); FK_CE2(v, id, 0, 2); FK_CE2(v, id, 1, 3); FK_CE2(v, id, 4, 6); FK_CE2(v, id, 5, 7); FK_CE2(v, id, 1, 2); FK_CE2(v, id, 5, 6); \
    FK_CE2(v, id, 0, 4); FK_CE2(v, id, 1, 5); FK_CE2(v, id, 2, 6); FK_CE2(v, id, 3, 7); FK_CE2(v, id, 2, 4); FK_CE2(v, id, 3, 5); FK_CE2(v, id, 1, 2); FK_CE2(v, id, 3, 4); FK_CE2(v, id, 5, 6); } while (0)
#define FK_CE2(v, id, a, b) do { const bool sw_ = v[b] > v[a]; const float tv_ = sw_ ? v[b] : v[a]; v[b] = sw_ ? v[a] : v[b]; v[a] = tv_; const int ti_ = sw_ ? id[b] : id[a]; id[b] = sw_ ? id[a] : id[b]; id[a] = ti_; } while (0)
__device__ __forceinline__ void top16_of_128_x2(float (&v)[8], int (&id)[8], float (&u)[8], int (&jd)[8], int lane16, float& rv1, int& ri1, float& rv2, int& ri2) {
    FK_SORT8(v, id); FK_SORT8(u, jd);
    rv1 = FK_NEG; ri1 = 0; rv2 = FK_NEG; ri2 = 0;
#pragma unroll
    for (int r = 0; r < 16; ++r) {
        const float wm = row_max16(v[0]), xm = row_max16(u[0]);
        const int cand = (v[0] == wm) ? id[0] : 0x7fffffff, dand = (u[0] == xm) ? jd[0] : 0x7fffffff;
        const int sel = row_min16i(cand), tel = row_min16i(dand);
        const bool mine = (cand == sel), nine = (dand == tel);
        if (lane16 == r) { rv1 = wm; ri1 = sel; rv2 = xm; ri2 = tel; }
#pragma unroll
        for (int i = 0; i < 7; ++i) { v[i] = mine ? v[i + 1] : v[i]; id[i] = mine ? id[i + 1] : id[i]; u[i] = nine ? u[i + 1] : u[i]; jd[i] = nine ? jd[i + 1] : jd[i]; }
        v[7] = mine ? FK_NEG : v[7]; u[7] = nine ? FK_NEG : u[7];
    }
}
__device__ __forceinline__ int fk_key(float x, int lane16) { int k = __float_as_int(x); k ^= (k >> 31) & 0x7fffffff; return (k & ~15) | (15 - lane16); }
__device__ __forceinline__ float fk_unkey(int k) { k &= ~15; k ^= (k >> 31) & 0x7fffffff; return __int_as_float(k); }
__device__ __forceinline__ int row_max16i(int v) { v = max(v, dppi<0xB1>(v)); v = max(v, dppi<0x4E>(v)); v = max(v, dppi<0x141>(v)); v = max(v, dppi<0x140>(v)); return v; }
__device__ __forceinline__ void topk_phase(const GAS bf16_t* __restrict__ SC, const GAS bf16_t* __restrict__ Q, const GAS float* __restrict__ KSUM, GAS float* __restrict__ GATE, GAS int* __restrict__ EIDX, int nitems,
                                           LAS unsigned char* lds, int wid, int lane, int wave_gid, int nwaves) {
    LAS unsigned char* wb = lds + wid * 6144;
    LAS int* IDS1 = (LAS int*)wb; LAS int* IDS2 = (LAS int*)(wb + 2048); LAS int* LC1 = (LAS int*)(wb + 4096); LAS int* LC2 = (LAS int*)(wb + 4352); LAS int* CI = (LAS int*)(wb + 4608);
    LAS float* xv = (LAS float*)(wb + 4864); LAS int* DUMP = (LAS int*)(wb + 5120) + lane; LAS int* WL1 = (LAS int*)(wb + 5376); LAS int* WL2 = (LAS int*)(wb + 5632);
    const int lane16 = lane & 15, rowbase = lane & 48;
    u32x4 nqa, nqb, nsw, ntw;
#define TK_LOAD(wi_) do { int it_ = (wi_) * 4 + (lane >> 4); it_ = it_ < nitems ? it_ : nitems - 1; const GAS u32x4* qp_ = (const GAS u32x4*)(Q + (size_t)it_ * 256 + 16 * lane16); nqa = qp_[0]; nqb = qp_[1]; \
        const GAS bf16_t* sp_ = SC + (size_t)it_ * 256 + 8 * lane16; nsw = *(const GAS u32x4*)sp_; ntw = *(const GAS u32x4*)(sp_ + 128); } while (0)
    TK_LOAD(wave_gid);
    const GAS float* kp = KSUM + ((wave_gid * 4 + (lane >> 4)) & 7) * 256 + 8 * lane16; const f32x4 k0 = *(const GAS f32x4*)kp, k1 = *(const GAS f32x4*)(kp + 4), m0 = *(const GAS f32x4*)(kp + 128), m1 = *(const GAS f32x4*)(kp + 132);
    for (int wi = wave_gid; wi * 4 < nitems; wi += nwaves) {
        const int it = wi * 4 + (lane >> 4);
        const u32x4 qa = nqa, qb = nqb; const f32x4 s0 = (f32x4){bflo(nsw[0]), bfhi(nsw[0]), bflo(nsw[1]), bfhi(nsw[1])}, s1 = (f32x4){bflo(nsw[2]), bfhi(nsw[2]), bflo(nsw[3]), bfhi(nsw[3])},
                    t0 = (f32x4){bflo(ntw[0]), bfhi(ntw[0]), bflo(ntw[1]), bfhi(ntw[1])}, t1 = (f32x4){bflo(ntw[2]), bfhi(ntw[2]), bflo(ntw[3]), bfhi(ntw[3])};
        TK_LOAD(wi + nwaves);
        float qs = 0.f, qq = 0.f;
#pragma unroll
        for (int i = 0; i < 4; ++i) { const float a = bflo(qa[i]), b = bfhi(qa[i]), c = bflo(qb[i]), d = bfhi(qb[i]); qs += (a + b) + (c + d); qq += (a * a + b * b) + (c * c + d * d); }
        const float mu = row_sum16(qs) * (1.f / 256.f); const float var = fmaxf(row_sum16(qq) * (1.f / 256.f) - mu * mu, 0.f); const float rs = 1.f / sqrtf(var + 1e-5f);
        float v[8], u[8]; int id[8], jd[8];
        {
#pragma unroll
          for (int i = 0; i < 4; ++i) { v[i] = rs * (s0[i] - mu * k0[i]); v[4 + i] = rs * (s1[i] - mu * k1[i]); u[i] = rs * (t0[i] - mu * m0[i]); u[4 + i] = rs * (t1[i] - mu * m1[i]);
              id[i] = 8 * lane16 + i; id[4 + i] = 8 * lane16 + 4 + i; jd[i] = 8 * lane16 + i; jd[4 + i] = 8 * lane16 + 4 + i; } }
        FK_SORT8(v, id); FK_SORT8(u, jd);
#pragma unroll
        for (int i = 0; i < 8; ++i) { IDS1[lane * 8 + i] = id[i]; IDS2[lane * 8 + i] = jd[i]; }
        float rv1 = FK_NEG, rv2 = FK_NEG; int wl1 = 0, wl2 = 0, cn1 = 0, cn2 = 0;
#pragma unroll
        for (int r = 0; r < 16; ++r) {
            const int key1 = fk_key(v[0], lane16), key2 = fk_key(u[0], lane16);
            const int wm1 = row_max16i(key1), wm2 = row_max16i(key2);
            const bool mine = (key1 == wm1), nine = (key2 == wm2);
            if (lane16 == r) { rv1 = fk_unkey(wm1); wl1 = 15 - (wm1 & 15); rv2 = fk_unkey(wm2); wl2 = 15 - (wm2 & 15); }
            *(mine ? LC1 + rowbase + r : DUMP) = cn1; *(nine ? LC2 + rowbase + r : DUMP) = cn2;
#pragma unroll
            for (int i = 0; i < 7; ++i) { v[i] = mine ? v[i + 1] : v[i]; u[i] = nine ? u[i + 1] : u[i]; }
            v[7] = mine ? FK_NEG : v[7]; u[7] = nine ? FK_NEG : u[7]; cn1 += mine ? 1 : 0; cn2 += nine ? 1 : 0;
        }
        xv[lane] = rv2; WL1[lane] = wl1; WL2[lane] = wl2;
        float c[16];
        { const LAS f32x4* xp = (const LAS f32x4*)(xv + rowbase);
#pragma unroll
          for (int q = 0; q < 4; ++q) { const f32x4 t = xp[q]; c[4 * q] = rv1 + t.x; c[4 * q + 1] = rv1 + t.y; c[4 * q + 2] = rv1 + t.z; c[4 * q + 3] = rv1 + t.w; } }
        int p = 0, wli = 0; float sc = FK_NEG;
#pragma unroll
        for (int r = 0; r < 16; ++r) {
            const int key = fk_key(c[0], lane16); const int wm = row_max16i(key); const bool mine = (key == wm);
            if (lane16 == r) { sc = fk_unkey(wm); wli = 15 - (wm & 15); }
            *(mine ? CI + rowbase + r : DUMP) = p;
#pragma unroll
            for (int i = 0; i < 15; ++i) c[i] = mine ? c[i + 1] : c[i];
            c[15] = mine ? FK_NEG : c[15]; p += mine ? 1 : 0;
        }
        const int i1 = wli & 15, j2 = CI[rowbase + lane16] & 15;
        const int e1 = IDS1[(rowbase + (WL1[rowbase + i1] & 15)) * 8 + (LC1[rowbase + i1] & 7)], e2 = IDS2[(rowbase + (WL2[rowbase + j2] & 15)) * 8 + (LC2[rowbase + j2] & 7)];
        const float mx = fk_unkey(row_max16i(fk_key(sc, 0))); const float ex = __expf(sc - mx); const float den = row_sum16(ex);
        GATE[(size_t)it * 16 + lane16] = ex / den; EIDX[(size_t)it * 16 + lane16] = (e1 & 127) * 128 + (e2 & 127);
    }
#undef TK_LOAD
}

__device__ __forceinline__ f32x2 fp8lo(unsigned w) { return __builtin_amdgcn_cvt_pk_f32_fp8((int)w, false); }
__device__ __forceinline__ f32x2 fp8hi(unsigned w) { return __builtin_amdgcn_cvt_pk_f32_fp8((int)w, true); }
__device__ __forceinline__ void act_phase(const GAS bf16_t* __restrict__ XB, const GAS unsigned char* __restrict__ U8, const GAS float* __restrict__ GATE, const GAS int* __restrict__ EIDX, GAS float* __restrict__ COEF, int nitems,
                                          int lane, int wave_gid, int nwaves) {
    int it = wave_gid; if (it >= nitems) return;
    u32x4 uc[16], un[16], xac, xbc, xan, xbn;
    int evc = EIDX[(size_t)it * 16 + (lane & 15)];
    { const GAS u32x4* xp = (const GAS u32x4*)(XB + (size_t)(it >> 3) * 1024 + 16 * lane); xac = xp[0]; xbc = xp[1]; }
#pragma unroll
    for (int k = 0; k < 16; ++k) uc[k] = *(const GAS u32x4*)(U8 + (size_t)__builtin_amdgcn_readlane(evc, k) * 1024 + 16 * lane);
    int itn = it + nwaves; int evn = (itn < nitems) ? EIDX[(size_t)itn * 16 + (lane & 15)] : 0;
    for (;;) {
        const bool hasn = itn < nitems;
        if (hasn) {
            const GAS u32x4* xp = (const GAS u32x4*)(XB + (size_t)(itn >> 3) * 1024 + 16 * lane); xan = xp[0]; xbn = xp[1];
#pragma unroll
            for (int k = 0; k < 16; ++k) un[k] = *(const GAS u32x4*)(U8 + (size_t)__builtin_amdgcn_readlane(evn, k) * 1024 + 16 * lane);
        }
        const int itnn = itn + nwaves; const int evnn = (itnn < nitems) ? EIDX[(size_t)itnn * 16 + (lane & 15)] : 0;
        const float gt = GATE[(size_t)it * 16 + (lane >> 2)];
        float x[16];
#pragma unroll
        for (int i = 0; i < 4; ++i) { x[2 * i] = bflo(xac[i]); x[2 * i + 1] = bfhi(xac[i]); x[8 + 2 * i] = bflo(xbc[i]); x[8 + 2 * i + 1] = bfhi(xbc[i]); }
        float a[16];
#pragma unroll
        for (int k = 0; k < 16; ++k) { const u32x4 uw = uc[k]; float s = 0.f;
#pragma unroll
            for (int d = 0; d < 4; ++d) { const f32x2 lo = fp8lo(uw[d]), hi = fp8hi(uw[d]); s = fmaf(lo.x, x[4 * d], s); s = fmaf(lo.y, x[4 * d + 1], s); s = fmaf(hi.x, x[4 * d + 2], s); s = fmaf(hi.y, x[4 * d + 3], s); }
            asm volatile("" : "+v"(s)); a[k] = s; }
#pragma unroll
        for (int k = 0; k < 8; ++k) { const bool hi = lane & 32; const float send = hi ? a[k] : a[k + 8], keep = hi ? a[k + 8] : a[k]; a[k] = keep + shx(send, 32, lane); }
#pragma unroll
        for (int k = 0; k < 4; ++k) { const bool hi = lane & 16; const float send = hi ? a[k] : a[k + 4], keep = hi ? a[k + 4] : a[k]; a[k] = keep + shx(send, 16, lane); }
#pragma unroll
        for (int k = 0; k < 2; ++k) { const bool hi = lane & 8; const float send = hi ? a[k] : a[k + 2], keep = hi ? a[k + 2] : a[k]; a[k] = keep + shx(send, 8, lane); }
        { const bool hi = lane & 4; const float send = hi ? a[0] : a[1], keep = hi ? a[1] : a[0]; a[0] = keep + shx(send, 4, lane); }
        float dsum = a[0]; dsum += shx(dsum, 2, lane); dsum += shx(dsum, 1, lane);
        if ((lane & 3) == 0) COEF[(size_t)it * 16 + (lane >> 2)] = gt * gelu_tanh(dsum * (1.f / 128.f));
        if (!hasn) break;
#pragma unroll
        for (int k = 0; k < 16; ++k) uc[k] = un[k];
        xac = xan; xbc = xbn; evc = evn; evn = evnn; it = itn; itn = itnn;
    }
}

__device__ __forceinline__ void outln_phase(const GAS float* COEF, const GAS int* EIDX, const GAS unsigned char* V8,     const GAS float* __restrict__ lg, const GAS float* __restrict__ lb, GAS float* X, GAS bf16_t* XB, int nrows,
                                            int lane, int wave_gid, int nwaves) {
    const float alpha = 1.6817928305074292f;
    int row = wave_gid; if (row >= nrows) return;
    u32x4 vc[16], vn[16];
    float cf0 = COEF[(size_t)row * 128 + lane] * (1.f / 64.f), cf1 = COEF[(size_t)row * 128 + 64 + lane] * (1.f / 64.f); int ev0 = EIDX[(size_t)row * 128 + lane], ev1 = EIDX[(size_t)row * 128 + 64 + lane];
#define OUT_LOADCH(dst, evreg, base) do { _Pragma("unroll") for (int k_ = 0; k_ < 16; ++k_) dst[k_] = *(const GAS u32x4*)(V8 + (size_t)__builtin_amdgcn_readlane(evreg, (base) + k_) * 1024 + 16 * lane); } while (0)
#define OUT_COMPCH(src, cfreg, base) do { _Pragma("unroll") for (int k_ = 0; k_ < 16; ++k_) { const float c_ = __int_as_float(__builtin_amdgcn_readlane(__float_as_int(cfreg), (base) + k_)); const u32x4 vw_ = src[k_]; \
        _Pragma("unroll") for (int d_ = 0; d_ < 4; ++d_) { const f32x2 lo_ = fp8lo(vw_[d_]), hi_ = fp8hi(vw_[d_]); acc[4 * d_] = fmaf(c_, lo_.x, acc[4 * d_]); acc[4 * d_ + 1] = fmaf(c_, lo_.y, acc[4 * d_ + 1]); acc[4 * d_ + 2] = fmaf(c_, hi_.x, acc[4 * d_ + 2]); acc[4 * d_ + 3] = fmaf(c_, hi_.y, acc[4 * d_ + 3]); } \
        _Pragma("unroll") for (int p_ = 0; p_ < 16; ++p_) asm volatile("" : "+v"(acc[p_]));     \
        } } while (0)
    for (;;) {
        OUT_LOADCH(vc, ev0, 0);
        const int rown = row + nwaves; const bool hasn = rown < nrows;
        float ncf0 = 0.f, ncf1 = 0.f; int nev0 = 0, nev1 = 0;
        if (hasn) { ncf0 = COEF[(size_t)rown * 128 + lane] * (1.f / 64.f); ncf1 = COEF[(size_t)rown * 128 + 64 + lane] * (1.f / 64.f); nev0 = EIDX[(size_t)rown * 128 + lane]; nev1 = EIDX[(size_t)rown * 128 + 64 + lane]; }
        float acc[16];
#pragma unroll
        for (int k = 0; k < 16; ++k) acc[k] = 0.f;
#define OUT_FENCE() asm volatile("" ::: "memory")
        OUT_LOADCH(vn, ev0, 16); OUT_FENCE(); OUT_COMPCH(vc, cf0, 0); OUT_FENCE();
        OUT_LOADCH(vc, ev0, 32); OUT_FENCE(); OUT_COMPCH(vn, cf0, 16); OUT_FENCE();
        OUT_LOADCH(vn, ev0, 48); OUT_FENCE(); OUT_COMPCH(vc, cf0, 32); OUT_FENCE();
        OUT_LOADCH(vc, ev1, 0);  OUT_FENCE(); OUT_COMPCH(vn, cf0, 48); OUT_FENCE();
        OUT_LOADCH(vn, ev1, 16); OUT_FENCE(); OUT_COMPCH(vc, cf1, 0); OUT_FENCE();
        OUT_LOADCH(vc, ev1, 32); OUT_FENCE(); OUT_COMPCH(vn, cf1, 16); OUT_FENCE();
        OUT_LOADCH(vn, ev1, 48); OUT_FENCE(); OUT_COMPCH(vc, cf1, 32); OUT_FENCE();
        OUT_COMPCH(vn, cf1, 48); OUT_FENCE();
#undef OUT_FENCE
        GAS float* xr = X + (size_t)row * 1024 + 16 * lane; float t[16];
#pragma unroll
        for (int q = 0; q < 4; ++q) { const f32x4 xv = *(const GAS f32x4*)(xr + 4 * q); t[4 * q] = fmaf(alpha, xv.x, acc[4 * q]); t[4 * q + 1] = fmaf(alpha, xv.y, acc[4 * q + 1]); t[4 * q + 2] = fmaf(alpha, xv.z, acc[4 * q + 2]); t[4 * q + 3] = fmaf(alpha, xv.w, acc[4 * q + 3]); }
        float s = 0.f;
#pragma unroll
        for (int k = 0; k < 16; ++k) s += t[k];
        const float mu = wave_sum(s, lane) * (1.f / 1024.f); float vs = 0.f;
#pragma unroll
        for (int k = 0; k < 16; ++k) { t[k] -= mu; vs = fmaf(t[k], t[k], vs); }
        const float rs = 1.f / sqrtf(wave_sum(vs, lane) * (1.f / 1024.f) + 1e-5f);
        unsigned w[8];
#pragma unroll
        for (int q = 0; q < 4; ++q) { const f32x4 g = *(const GAS f32x4*)(lg + 16 * lane + 4 * q), b = *(const GAS f32x4*)(lb + 16 * lane + 4 * q); f32x4 o;
            o.x = t[4 * q] * rs * g.x + b.x; o.y = t[4 * q + 1] * rs * g.y + b.y; o.z = t[4 * q + 2] * rs * g.z + b.z; o.w = t[4 * q + 3] * rs * g.w + b.w;
            *(GAS f32x4*)(xr + 4 * q) = o; w[2 * q] = pk_bf16(o.x, o.y); w[2 * q + 1] = pk_bf16(o.z, o.w); }
        u32x4 w0, w1; w0.x = w[0]; w0.y = w[1]; w0.z = w[2]; w0.w = w[3]; w1.x = w[4]; w1.y = w[5]; w1.z = w[6]; w1.w = w[7];
        GAS u32x4* xbp = (GAS u32x4*)(XB + (size_t)row * 1024 + 16 * lane); xbp[0] = w0; xbp[1] = w1;
        if (!hasn) break;
        row = rown; cf0 = ncf0; cf1 = ncf1; ev0 = nev0; ev1 = nev1;
    }
#undef OUT_LOADCH
#undef OUT_COMPCH
}

__device__ __forceinline__ void lnres_phase(const GAS bf16_t* __restrict__ Y, const GAS float* __restrict__ lg, const GAS float* __restrict__ lb, GAS float* X, GAS bf16_t* XB, GAS unsigned char* XF8, int nrows, int lane, int wave_gid, int nwaves) {
    const float alpha = 1.6817928305074292f; (void)X;
    for (int row = wave_gid; row < nrows; row += nwaves) {
        GAS bf16_t* xr = XB + (size_t)row * 1024; const GAS bf16_t* yr = Y + (size_t)row * 1024; float t[16];
#pragma unroll
        for (int q = 0; q < 4; ++q) { const u32x2 xw = *(const GAS u32x2*)(xr + 256 * q + 4 * lane); const u32x2 yw = *(const GAS u32x2*)(yr + 256 * q + 4 * lane);
            t[4 * q] = fmaf(alpha, bflo(xw.x), bflo(yw.x)); t[4 * q + 1] = fmaf(alpha, bfhi(xw.x), bfhi(yw.x)); t[4 * q + 2] = fmaf(alpha, bflo(xw.y), bflo(yw.y)); t[4 * q + 3] = fmaf(alpha, bfhi(xw.y), bfhi(yw.y)); }
        float s = 0.f;
#pragma unroll
        for (int k = 0; k < 16; ++k) s += t[k];
        const float mu = wave_sum(s, lane) * (1.f / 1024.f); float vs = 0.f;
#pragma unroll
        for (int k = 0; k < 16; ++k) { t[k] -= mu; vs = fmaf(t[k], t[k], vs); }
        const float rs = 1.f / sqrtf(wave_sum(vs, lane) * (1.f / 1024.f) + 1e-5f);
#pragma unroll
        for (int q = 0; q < 4; ++q) { const int c = 256 * q + 4 * lane; const f32x4 g = *(const GAS f32x4*)(lg + c), b = *(const GAS f32x4*)(lb + c); f32x4 o;
            o.x = t[4 * q] * rs * g.x + b.x; o.y = t[4 * q + 1] * rs * g.y + b.y; o.z = t[4 * q + 2] * rs * g.z + b.z; o.w = t[4 * q + 3] * rs * g.w + b.w;
            u32x2 w; w.x = pk_bf16(o.x, o.y); w.y = pk_bf16(o.z, o.w); *(GAS u32x2*)(xr + c) = w;
            if (XF8) {
                const float s0 = __builtin_amdgcn_fmed3f(o.x * 16.f, -448.f, 448.f), s1 = __builtin_amdgcn_fmed3f(o.y * 16.f, -448.f, 448.f), s2 = __builtin_amdgcn_fmed3f(o.z * 16.f, -448.f, 448.f), s3 = __builtin_amdgcn_fmed3f(o.w * 16.f, -448.f, 448.f);
                int hp = __builtin_amdgcn_cvt_pk_fp8_f32(s0, s1, 0, false); hp = __builtin_amdgcn_cvt_pk_fp8_f32(s2, s3, hp, true);
                const f32x2 d01 = fp8lo((unsigned)hp), d23 = fp8hi((unsigned)hp);
                int lp = __builtin_amdgcn_cvt_pk_fp8_f32(s0 - d01.x, s1 - d01.y, 0, false); lp = __builtin_amdgcn_cvt_pk_fp8_f32(s2 - d23.x, s3 - d23.y, lp, true);
                *(GAS int*)(XF8 + (size_t)row * 2048 + c) = hp; *(GAS int*)(XF8 + (size_t)row * 2048 + 1024 + c) = lp; } }
    }
}

__device__ __forceinline__ void glanorm_phase(const GAS float* __restrict__ O, const GAS float* __restrict__ PROJ, const GAS float* __restrict__ gnorm, GAS bf16_t* XB, int nitems, int lane, int wave_gid, int nwaves) {
    const float g0 = gnorm[lane], g1 = gnorm[64 + lane];
    for (int it0 = wave_gid * 8; it0 < nitems; it0 += nwaves * 8) {
        float a0[8], a1[8], r0[8], r1[8];
#pragma unroll
        for (int q = 0; q < 8; ++q) { int it = it0 + q; it = it < nitems ? it : it0; const int row = it >> 2, h = it & 3; const GAS float* o = O + (size_t)row * 512 + h * 128; const GAS float* r = PROJ + (size_t)row * 2576 + 1040 + h * 128;
            a0[q] = o[lane]; a1[q] = o[64 + lane]; r0[q] = r[lane]; r1[q] = r[64 + lane]; }
#pragma unroll
        for (int q = 0; q < 8; ++q) { const int it = it0 + q; const int row = it >> 2, h = it & 3;
            const float rs = 1.f / sqrtf(wave_sum(a0[q] * a0[q] + a1[q] * a1[q], lane) * (1.f / 128.f) + 1e-5f);
            const float y0 = a0[q] * rs * g0 * (r0[q] * frcp(1.f + __expf(-r0[q]))), y1 = a1[q] * rs * g1 * (r1[q] * frcp(1.f + __expf(-r1[q])));
            if (it < nitems) { GAS bf16_t* d = XB + (size_t)row * 1024 + h * 128; d[lane] = (bf16_t)(pk_bf16(y0, 0.f) & 0xffffu); d[64 + lane] = (bf16_t)(pk_bf16(y1, 0.f) & 0xffffu); } }
    }
}

__device__ __forceinline__ float sigm(float x) { return frcp(1.f + __expf(-x)); }
__device__ __forceinline__ float softplusf(float x) { return fmaxf(x, 0.f) + log1pf(__expf(-fabsf(x))); }
__device__ __forceinline__ void rwkvprep_phase(const GAS float* __restrict__ w0, const GAS float* __restrict__ a0, const GAS float* __restrict__ v0, const GAS float* __restrict__ k_k, const GAS float* __restrict__ k_a, const GAS float* __restrict__ Vg,
                                               GAS float* K, GAS float* Wd, GAS float* Aa, GAS float* V, GAS float* NKK, GAS float* VFIRST, int has_vres, int nitems, int lane, int wave_gid, int nwaves) {
    for (int it0 = wave_gid * 4; it0 < nitems; it0 += nwaves * 4) {
        float kq[4], wq[4], aq[4], vq[4], gq[4], fq[4];
#pragma unroll
        for (int q = 0; q < 4; ++q) { const int it = it0 + q; const size_t ix = (size_t)(it >> 4) * 1024 + (it & 15) * 64 + lane; kq[q] = K[ix]; wq[q] = Wd[ix]; aq[q] = Aa[ix]; vq[q] = V[ix]; gq[q] = has_vres ? Vg[ix] : 0.f; fq[q] = has_vres ? VFIRST[ix] : 0.f; }
#pragma unroll
        for (int q = 0; q < 4; ++q) { const int it = it0 + q; const int h = it & 15; const size_t ix = (size_t)(it >> 4) * 1024 + h * 64 + lane; const int c = h * 64 + lane;
            const float k0 = kq[q]; const float kv = k0 * k_k[c]; const float inv = 1.f / fmaxf(sqrtf(wave_sum(kv * kv, lane)), 1e-12f);
            const float w = -softplusf(-(w0[c] + wq[q])) - 0.5f; const float dec = __expf(-__expf(w));
            const float a = sigm(a0[c] + aq[q]);
            float v = vq[q]; if (has_vres) v = v + (fq[q] - v) * sigm(v0[c] + gq[q]); else VFIRST[ix] = v;
            const float kk = kv * inv;
            NKK[ix] = -kk; K[ix] = k0 * (1.f + (a - 1.f) * k_a[c]); Wd[ix] = dec; Aa[ix] = kk * a; V[ix] = v; }
    }
}

__device__ __forceinline__ void rwkvpost_phase(const GAS float* __restrict__ Y, const GAS float* __restrict__ R, const GAS float* __restrict__ K2, const GAS float* __restrict__ V, const GAS float* __restrict__ G, const GAS float* __restrict__ r_k,
                                               const GAS float* __restrict__ lnx_g, const GAS float* __restrict__ lnx_b, GAS bf16_t* XB, int nitems, int lane, int wave_gid, int nwaves) {
    for (int it0 = wave_gid * 4; it0 < nitems; it0 += nwaves * 4) {
        float yq[4], rq[4], kq[4], vq[4], gq[4];
#pragma unroll
        for (int q = 0; q < 4; ++q) { const int it = it0 + q; const size_t ix = (size_t)(it >> 4) * 1024 + (it & 15) * 64 + lane; yq[q] = Y[ix]; rq[q] = R[ix]; kq[q] = K2[ix]; vq[q] = V[ix]; gq[q] = G[ix]; }
#pragma unroll
        for (int q = 0; q < 4; ++q) { const int it = it0 + q; const int h = it & 15; const size_t ix = (size_t)(it >> 4) * 1024 + h * 64 + lane; const int c = h * 64 + lane;
            const float y = yq[q]; const float mu = wave_sum(y, lane) * (1.f / 64.f); const float d = y - mu; const float rs = 1.f / sqrtf(wave_sum(d * d, lane) * (1.f / 64.f) + 64e-5f);
            const float bon = wave_sum(rq[q] * kq[q] * r_k[c], lane);
            const float o = (d * rs * lnx_g[c] + lnx_b[c] + bon * vq[q]) * gq[q];
            XB[ix] = (bf16_t)(pk_bf16(o, 0.f) & 0xffffu); }
    }
}

__device__ __forceinline__ void wkv_phase(const GAS float* __restrict__ R, const GAS float* __restrict__ Wd, const GAS float* __restrict__ K2, const GAS float* __restrict__ V, const GAS float* __restrict__ BB, const GAS float* __restrict__ NKK,
                                          const GAS float* __restrict__ SIN, GAS float* __restrict__ Y, GAS float* __restrict__ P, GAS float* __restrict__ SOUT, int B, int T, int DB, int DT, LAS unsigned char* lds, int tid, int bid, int nb) {
    constexpr int TB = 32, NLD = 6, VECB = TB * 1280, VVB = TB * 128, BUF = VECB + 2 * VVB;
    const int rowl = tid >> 4, part = tid & 15;
    const int nprompt = B * 32, nunits = nprompt + DB * 32;
    for (int u = bid; u < nunits; u += nb) {
        const bool smp = u >= nprompt; const int q0_ = smp ? u - nprompt : u; const int q = ((q0_ & 7) << 1 | ((q0_ >> 3) & 1)) + ((q0_ >> 4) << 4);
        const int half = q & 1, pair = q >> 1, sq = pair >> 4, h = pair & 15;
        const int Tu = smp ? DT : T; const int r0 = smp ? B * T + sq * DT : sq * T, vrow = half * 32 + rowl;
        f32x2 S01 = (f32x2){0.f, 0.f}, S23 = (f32x2){0.f, 0.f};
        if (smp) { const f32x4 s4 = *(const GAS f32x4*)(SIN + ((size_t)pair * 64 + vrow) * 64 + part * 4); S01 = (f32x2){s4.x, s4.y}; S23 = (f32x2){s4.z, s4.w};
                   asm volatile("" : "+v"(S01), "+v"(S23)); }
        const int nblk = (Tu + TB - 1) / TB;
        f32x4 ld[NLD];
        const size_t eo_ = (size_t)(r0 + (tid >> 4)) * 1024 + h * 64 + (tid & 15) * 4, ev_ = (size_t)(r0 + ((tid & 255) >> 3)) * 1024 + h * 64 + half * 32 + (tid & 7) * 4;
        const int lo_ = ((tid >> 4) * 320 + (tid & 15) * 4) * 4, lv_ = VECB + (tid & 255) * 16;
#define WKV_LOAD(tb0) do { const size_t bo_ = (size_t)(tb0) * 1024; ld[0] = *(const GAS f32x4*)(Wd + eo_ + bo_); ld[1] = *(const GAS f32x4*)(NKK + eo_ + bo_); ld[2] = *(const GAS f32x4*)(BB + eo_ + bo_); \
            ld[3] = *(const GAS f32x4*)(K2 + eo_ + bo_); ld[4] = *(const GAS f32x4*)(R + eo_ + bo_); ld[5] = *(const GAS f32x4*)(V + ev_ + bo_); } while (0)
#define WKV_STORE(bufp) do { _Pragma("unroll") for (int q_ = 0; q_ < 5; ++q_) *(LAS f32x4*)((bufp) + lo_ + q_ * 256) = ld[q_]; *(LAS f32x4*)((bufp) + lv_) = ld[5]; } while (0)
        WKV_LOAD(0); WKV_STORE(lds); __syncthreads();
        for (int b = 0; b < nblk; ++b) {
            LAS unsigned char* cur = lds + (b & 1) * BUF; LAS unsigned char* nxt = lds + ((b + 1) & 1) * BUF; const int tb0 = b * TB; const int nt = (Tu - tb0) < TB ? (Tu - tb0) : TB;
            if (b + 1 < nblk) WKV_LOAD(tb0 + TB);
            const LAS float* vec = (const LAS float*)cur + part * 4; const LAS float* vv = (const LAS float*)(cur + VECB) + rowl; LAS float* yb = (LAS float*)(cur + VECB + VVB);
            float ykeep0 = 0.f, ykeep1 = 0.f;
#define WKV_STEP(t, keep, tl) do { const LAS f32x2* vp_ = (const LAS f32x2*)(vec + (t) * 320); \
                const f32x2 w01 = vp_[0], w23 = vp_[1], n01 = vp_[32], n23 = vp_[33], b01 = vp_[64], b23 = vp_[65], k01 = vp_[96], k23 = vp_[97], r01 = vp_[128], r23 = vp_[129]; \
                const float v = vv[(t) * 32]; \
                const f32x2 sp = __builtin_elementwise_fma(S23, n23, S01 * n01); const float sa = row_sum16(sp.x + sp.y); const f32x2 sa2 = (f32x2){sa, sa}, v2 = (f32x2){v, v}; \
                S01 = __builtin_elementwise_fma(S01, w01, __builtin_elementwise_fma(b01, sa2, k01 * v2)); S23 = __builtin_elementwise_fma(S23, w23, __builtin_elementwise_fma(b23, sa2, k23 * v2)); \
                const f32x2 yp = __builtin_elementwise_fma(S23, r23, S01 * r01); const float y = row_sum16(yp.x + yp.y); \
                keep = (part == (tl)) ? y : keep; } while (0)
            if (nt == TB) {
#pragma unroll 1
                for (int t = 0; t < 16; t += 8) { WKV_STEP(t, ykeep0, t); WKV_STEP(t + 1, ykeep0, t + 1); WKV_STEP(t + 2, ykeep0, t + 2); WKV_STEP(t + 3, ykeep0, t + 3); WKV_STEP(t + 4, ykeep0, t + 4); WKV_STEP(t + 5, ykeep0, t + 5); WKV_STEP(t + 6, ykeep0, t + 6); WKV_STEP(t + 7, ykeep0, t + 7); }
#pragma unroll 1
                for (int t = 16; t < 32; t += 8) { WKV_STEP(t, ykeep1, t - 16); WKV_STEP(t + 1, ykeep1, t - 15); WKV_STEP(t + 2, ykeep1, t - 14); WKV_STEP(t + 3, ykeep1, t - 13); WKV_STEP(t + 4, ykeep1, t - 12); WKV_STEP(t + 5, ykeep1, t - 11); WKV_STEP(t + 6, ykeep1, t - 10); WKV_STEP(t + 7, ykeep1, t - 9); }
            } else { for (int t = 0; t < nt; ++t) { if (t < 16) WKV_STEP(t, ykeep0, t); else WKV_STEP(t, ykeep1, t - 16); } }
#undef WKV_STEP
            yb[part * 32 + rowl] = ykeep0; yb[(16 + part) * 32 + rowl] = ykeep1;
            if (b + 1 < nblk) WKV_STORE(nxt);
            __syncthreads();
            { const int rl = tid & 31; _Pragma("unroll") for (int t = tid >> 5; t < TB; t += 16) if (t < nt) Y[(size_t)(r0 + tb0 + t) * 1024 + h * 64 + half * 32 + rl] = yb[t * 32 + rl]; }
        }
#undef WKV_LOAD
#undef WKV_STORE
        *(GAS f32x4*)((smp ? SOUT : P) + ((size_t)pair * 64 + vrow) * 64 + part * 4) = (f32x4){S01.x, S01.y, S23.x, S23.y};
        __syncthreads();
    }
}

__device__ __forceinline__ void rwkvpost2_phase(const GAS bf16_t* __restrict__ Y, const GAS bf16_t* __restrict__ G, const GAS bf16_t* __restrict__ VF, const GAS float* __restrict__ BON, const GAS float* __restrict__ lnx_g, const GAS float* __restrict__ lnx_b,
                                                GAS bf16_t* XB, int nitems, int lane, int wave_gid, int nwaves) {
    const int nit4 = nitems >> 2, hg = wave_gid & 3, cofs = hg * 256 + 4 * lane; const f32x4 lg = *(const GAS f32x4*)(lnx_g + cofs), lb = *(const GAS f32x4*)(lnx_b + cofs);
    for (int it0 = wave_gid; it0 < nit4; it0 += nwaves * 4) {
        u32x2 yq[4], vq[4], gq[4]; float bq[4];
#pragma unroll
        for (int q = 0; q < 4; ++q) { int it = it0 + q * nwaves; it = it < nit4 ? it : it0; const int row = it >> 2; const size_t ix = (size_t)row * 1024 + cofs;
            yq[q] = *(const GAS u32x2*)(Y + ix); vq[q] = *(const GAS u32x2*)(VF + ix); gq[q] = *(const GAS u32x2*)(G + ix); bq[q] = BON[row * 16 + hg * 4 + (lane >> 4)]; }
#pragma unroll
        for (int q = 0; q < 4; ++q) { const int it = it0 + q * nwaves; const int row = it >> 2; const f32x4 y = (f32x4){bflo(yq[q].x), bfhi(yq[q].x), bflo(yq[q].y), bfhi(yq[q].y)}, vv4 = (f32x4){bflo(vq[q].x), bfhi(vq[q].x), bflo(vq[q].y), bfhi(vq[q].y)};
            const float mu = row_sum16((y.x + y.y) + (y.z + y.w)) * (1.f / 64.f); const f32x4 d = y - mu; const float rs = __builtin_amdgcn_rsqf(row_sum16((d.x * d.x + d.y * d.y) + (d.z * d.z + d.w * d.w)) * (1.f / 64.f) + 64e-5f);
            const f32x4 gg = (f32x4){bflo(gq[q].x), bfhi(gq[q].x), bflo(gq[q].y), bfhi(gq[q].y)}; const f32x4 o = (d * rs * lg + lb + bq[q] * vv4) * gg;
            if (it < nit4) { u32x2 w_; w_.x = pk_bf16(o.x, o.y); w_.y = pk_bf16(o.z, o.w); *(GAS u32x2*)(XB + (size_t)row * 1024 + cofs) = w_; } }
    }
}

__device__ __forceinline__ void wkv2_phase(const GAS bf16_t* __restrict__ R, const GAS bf16_t* __restrict__ KR, const GAS bf16_t* __restrict__ WL, const GAS bf16_t* __restrict__ AL, const GAS bf16_t* __restrict__ V, const GAS bf16_t* __restrict__ VG,
                                           const GAS bf16_t* VFI, const GAS float* __restrict__ PRM, const GAS float* __restrict__ SIN, GAS bf16_t* __restrict__ Y, GAS float* __restrict__ P, GAS float* __restrict__ SOUT, GAS bf16_t* VFO, GAS float* __restrict__ BON,
                                           int has_vres, int B, int T, int DB, int DT, LAS unsigned char* lds, int tid, int bid, int nb) {
    constexpr int TB = 32, VECB = TB * 1280, VVB = TB * 128, BUF = VECB + 2 * VVB;
    const bool scanw = __builtin_amdgcn_readfirstlane(tid) < 256; const int pt = tid & 255;
    const int rowl = pt >> 4, part = pt & 15;
    const int nprompt = B * 32, nunits_all = nprompt + DB * 32, nunits = DT <= 4 ? nprompt : nunits_all;
    for (int u = bid; u < nunits; u += nb) {
        const bool smp = u >= nprompt; const int q0_ = smp ? u - nprompt : u; const int q = ((q0_ & 7) << 1 | ((q0_ >> 3) & 1)) + ((q0_ >> 4) << 4);
        const int half = q & 1, pair = q >> 1, sq = pair >> 4, h = pair & 15;
        const int Tu = smp ? DT : T; const int r0 = smp ? B * T + sq * DT : sq * T, vrow = half * 32 + rowl;
        const int srow = pt >> 3, sp8 = pt & 7;
        f32x2 S0 = (f32x2){0.f, 0.f}, S1 = (f32x2){0.f, 0.f}, S2 = (f32x2){0.f, 0.f}, S3 = (f32x2){0.f, 0.f};
        if (smp && scanw) { const GAS f32x4* sp_ = (const GAS f32x4*)(SIN + ((size_t)pair * 64 + half * 32 + srow) * 64 + sp8 * 8); const f32x4 sa4 = sp_[0], sb4 = sp_[1];
                   S0 = (f32x2){sa4.x, sa4.y}; S1 = (f32x2){sa4.z, sa4.w}; S2 = (f32x2){sb4.x, sb4.y}; S3 = (f32x2){sb4.z, sb4.w};
                   asm volatile("" : "+v"(S0), "+v"(S1), "+v"(S2), "+v"(S3)); }
        const int nblk = (Tu + TB - 1) / TB;
        u32x2 lk0, lw0, la0, lr0, lk1, lw1, la1, lr1, lv, lg = (u32x2){0u, 0u}, lf = (u32x2){0u, 0u};
        const size_t eo_ = (size_t)(r0 + (pt >> 4)) * 1024 + h * 64 + part * 4, ev_ = (size_t)(r0 + (pt >> 3)) * 1024 + h * 64 + half * 32 + (pt & 7) * 4;
        const int lo_ = ((pt >> 4) * 320 + part * 4) * 4, lv_ = VECB + pt * 16;
        const int pc_ = h * 64 + part * 4; const f32x4 w0v = *(const GAS f32x4*)(PRM + pc_), a0v = *(const GAS f32x4*)(PRM + 1024 + pc_), kkp = *(const GAS f32x4*)(PRM + 3072 + pc_), kap = *(const GAS f32x4*)(PRM + 4096 + pc_), rkp = *(const GAS f32x4*)(PRM + 5120 + pc_);
        const f32x4 v0v = *(const GAS f32x4*)(PRM + 2048 + h * 64 + half * 32 + (pt & 7) * 4);
#define WKV_LOAD(tb0) do { const size_t bo_ = (size_t)(tb0) * 1024, b1_ = bo_ + 16 * 1024; lk0 = *(const GAS u32x2*)(KR + eo_ + bo_); lw0 = *(const GAS u32x2*)(WL + eo_ + bo_); la0 = *(const GAS u32x2*)(AL + eo_ + bo_); lr0 = *(const GAS u32x2*)(R + eo_ + bo_); \
            lk1 = *(const GAS u32x2*)(KR + eo_ + b1_); lw1 = *(const GAS u32x2*)(WL + eo_ + b1_); la1 = *(const GAS u32x2*)(AL + eo_ + b1_); lr1 = *(const GAS u32x2*)(R + eo_ + b1_); \
            lv = *(const GAS u32x2*)(V + ev_ + bo_); if (has_vres) { lg = *(const GAS u32x2*)(VG + ev_ + bo_); lf = *(const GAS u32x2*)(VFI + ev_ + bo_); } } while (0)
#define WKV_UNPK(w_) ((f32x4){bflo((w_).x), bfhi((w_).x), bflo((w_).y), bfhi((w_).y)})
#define WKV_ITEM(bufp, tb0, lk, lw, la, lr, ti_) do { const f32x4 k4 = WKV_UNPK(lk), wl4 = WKV_UNPK(lw), al4 = WKV_UNPK(la); const f32x4 kv = k4 * kkp; const float ss = row_sum16((kv.x * kv.x + kv.y * kv.y) + (kv.z * kv.z + kv.w * kv.w)); const float inv = frcp(fmaxf(fsqrt(ss), 1e-12f)); \
            f32x4 dec, a4; _Pragma("unroll") for (int i_ = 0; i_ < 4; ++i_) { dec[i_] = __expf(-0.6065306597126334f * frcp(1.f + __expf(-(w0v[i_] + wl4[i_])))); a4[i_] = frcp(1.f + __expf(-(a0v[i_] + al4[i_]))); } \
            const f32x4 kk = kv * inv; const f32x4 k2 = k4 * ((a4 - 1.f) * kap + 1.f); const f32x4 r4 = WKV_UNPK(lr); const f32x4 rk = r4 * k2 * rkp; const float bon = row_sum16((rk.x + rk.y) + (rk.z + rk.w)); \
            LAS unsigned char* d_ = (bufp) + lo_ + (ti_) * 1280; *(LAS f32x4*)(d_) = dec; *(LAS f32x4*)(d_ + 256) = -kk; *(LAS f32x4*)(d_ + 512) = kk * a4; *(LAS f32x4*)(d_ + 768) = k2; *(LAS f32x4*)(d_ + 1024) = r4; \
            const int tr_ = (tb0) + (pt >> 4) + (ti_); if (half == 0 && part == 0 && tr_ < Tu) BON[(size_t)(r0 + tr_) * 16 + h] = bon; } while (0)
#define WKV_STORE(bufp, tb0) do { WKV_ITEM(bufp, tb0, lk0, lw0, la0, lr0, 0); if ((tb0) + 16 < Tu) WKV_ITEM(bufp, tb0, lk1, lw1, la1, lr1, 16); \
            f32x4 v4 = WKV_UNPK(lv); if (has_vres) { const f32x4 g4 = WKV_UNPK(lg), f4 = WKV_UNPK(lf); _Pragma("unroll") for (int i_ = 0; i_ < 4; ++i_) v4[i_] = v4[i_] + (f4[i_] - v4[i_]) * frcp(1.f + __expf(-(v0v[i_] + g4[i_]))); } \
            *(LAS f32x4*)((bufp) + lv_) = v4; const int tv_ = (tb0) + (pt >> 3); if (tv_ < Tu) { u32x2 w_; w_.x = pk_bf16(v4.x, v4.y); w_.y = pk_bf16(v4.z, v4.w); *(GAS u32x2*)(VFO + ev_ + (size_t)(tb0) * 1024) = w_; } } while (0)
#define WKV_YOUT(bufp, tb0, ntp) do { const LAS float* yb_ = (const LAS float*)((bufp) + VECB + VVB); const int rl = (pt & 15) * 2; _Pragma("unroll") for (int t = pt >> 4; t < TB; t += 16) if (t < (ntp)) { const f32x2 y2 = *(const LAS f32x2*)(yb_ + t * 32 + rl); \
            *(GAS unsigned*)(Y + (size_t)(r0 + (tb0) + t) * 1024 + h * 64 + half * 32 + rl) = pk_bf16(y2.x, y2.y); } } while (0)
        if (!scanw) { WKV_LOAD(0); WKV_STORE(lds, 0); if (nblk > 1) WKV_LOAD(TB); }
        __syncthreads();
        for (int b = 0; b < nblk; ++b) {
            LAS unsigned char* cur = lds + (b & 1) * BUF; LAS unsigned char* nxt = lds + ((b + 1) & 1) * BUF; const int tb0 = b * TB; const int nt = (Tu - tb0) < TB ? (Tu - tb0) : TB;
            if (scanw) {
                const LAS float* vec = (const LAS float*)cur + sp8 * 8; const LAS float* vv = (const LAS float*)(cur + VECB) + srow; LAS float* yb = (LAS float*)(cur + VECB + VVB);
                LAS float* ybl = yb + srow;
                struct StepV { f32x4 w0, w1, n0, n1, b0, b1, k0, k1, r0, r1; float v; };
#define WKV_RD(dst, t) do { const LAS f32x4* vp_ = (const LAS f32x4*)(vec + (t) * 320); dst.w0 = vp_[0]; dst.w1 = vp_[1]; dst.n0 = vp_[16]; dst.n1 = vp_[17]; dst.b0 = vp_[32]; dst.b1 = vp_[33]; \
                dst.k0 = vp_[48]; dst.k1 = vp_[49]; dst.r0 = vp_[64]; dst.r1 = vp_[65]; dst.v = vv[(t) * 32]; } while (0)
#define WKV_LO(q_) ((f32x2){(q_).x, (q_).y})
#define WKV_HI(q_) ((f32x2){(q_).z, (q_).w})
#define WKV_UPD(S, w_, b_, k_) S = __builtin_elementwise_fma(S, w_, __builtin_elementwise_fma(b_, sa2, (k_) * v2))
#define WKV_CMP(src, t_) do { const f32x2 spa = __builtin_elementwise_fma(S1, WKV_HI(src.n0), S0 * WKV_LO(src.n0)), spb = __builtin_elementwise_fma(S3, WKV_HI(src.n1), S2 * WKV_LO(src.n1)); const f32x2 sp = spa + spb; \
                const float sa = row_sum8(sp.x + sp.y); const f32x2 sa2 = (f32x2){sa, sa}, v2 = (f32x2){src.v, src.v}; \
                WKV_UPD(S0, WKV_LO(src.w0), WKV_LO(src.b0), WKV_LO(src.k0)); WKV_UPD(S1, WKV_HI(src.w0), WKV_HI(src.b0), WKV_HI(src.k0)); WKV_UPD(S2, WKV_LO(src.w1), WKV_LO(src.b1), WKV_LO(src.k1)); WKV_UPD(S3, WKV_HI(src.w1), WKV_HI(src.b1), WKV_HI(src.k1)); \
                const f32x2 ypa = __builtin_elementwise_fma(S1, WKV_HI(src.r0), S0 * WKV_LO(src.r0)), ypb = __builtin_elementwise_fma(S3, WKV_HI(src.r1), S2 * WKV_LO(src.r1)); const f32x2 yp = ypa + ypb; \
                ybl[(t_) * 32] = row_sum8(yp.x + yp.y); } while (0)
#define WKV_ST(t_, cur_, nx2_) do { WKV_RD(nx2_, ((t_) + 2) & 31); __builtin_amdgcn_sched_barrier(0); WKV_CMP(cur_, t_); } while (0)
                if (nt == TB) {
                    StepV sA, sB, sC; WKV_RD(sA, 0); WKV_RD(sB, 1);
#pragma unroll 1
                    for (int t = 0; t < 30; t += 3) { WKV_ST(t, sA, sC); WKV_ST(t + 1, sB, sA); WKV_ST(t + 2, sC, sB); }
                    WKV_ST(30, sA, sC); WKV_ST(31, sB, sA);
                } else { StepV sA; for (int t = 0; t < nt; ++t) { WKV_RD(sA, t); WKV_CMP(sA, t); } }
#undef WKV_RD
#undef WKV_LO
#undef WKV_HI
#undef WKV_UPD
#undef WKV_CMP
#undef WKV_ST
            } else {
                if (b > 0) WKV_YOUT(nxt, tb0 - TB, TB);
                if (b + 1 < nblk) { WKV_STORE(nxt, tb0 + TB); if (b + 2 < nblk) WKV_LOAD(tb0 + 2 * TB); }
            }
            __syncthreads();
        }
        if (!scanw) { const int tbl = (nblk - 1) * TB; WKV_YOUT(lds + ((nblk - 1) & 1) * BUF, tbl, Tu - tbl); }
#undef WKV_LOAD
#undef WKV_STORE
#undef WKV_ITEM
#undef WKV_YOUT
#undef WKV_UNPK
        if (scanw) { GAS float* so = (smp ? SOUT : P) + ((size_t)pair * 64 + half * 32 + srow) * 64 + sp8 * 8; *(GAS f32x4*)so = (f32x4){S0.x, S0.y, S1.x, S1.y}; *(GAS f32x4*)(so + 4) = (f32x4){S2.x, S2.y, S3.x, S3.y}; }
        __syncthreads();
    }
    if (DT <= 4) {
        const int grp = __builtin_amdgcn_readfirstlane(tid) >> 8, t4 = tid & 255, srow = t4 >> 3, sp8 = t4 & 7;
        for (int u = nprompt + bid + nb * grp; u < nunits_all; u += nb * 2) {
            const int q0_ = u - nprompt; const int q = ((q0_ & 7) << 1 | ((q0_ >> 3) & 1)) + ((q0_ >> 4) << 4);
            const int half = q & 1, pair = q >> 1, sq = pair >> 4, h = pair & 15; const int r0 = B * T + sq * DT, vrow = half * 32 + srow;
            const size_t cb_ = (size_t)h * 64 + sp8 * 8, cv_ = (size_t)h * 64 + vrow;
            const GAS f32x4* sp_ = (const GAS f32x4*)(SIN + ((size_t)pair * 64 + vrow) * 64 + sp8 * 8); const f32x4 sa4 = sp_[0], sb4 = sp_[1];
            f32x4 pw0[2], pa0[2], pkk[2], pka[2], prk[2];
#pragma unroll
            for (int i = 0; i < 2; ++i) { pw0[i] = *(const GAS f32x4*)(PRM + cb_ + 4 * i); pa0[i] = *(const GAS f32x4*)(PRM + 1024 + cb_ + 4 * i); pkk[i] = *(const GAS f32x4*)(PRM + 3072 + cb_ + 4 * i); pka[i] = *(const GAS f32x4*)(PRM + 4096 + cb_ + 4 * i); prk[i] = *(const GAS f32x4*)(PRM + 5120 + cb_ + 4 * i); }
            const float v0c = PRM[2048 + cv_];
            u32x4 lk[4], lw[4], la[4], lr[4]; unsigned short lv[4], lg[4], lf[4];
#pragma unroll
            for (int t = 0; t < 4; ++t) { const int tt = t < DT ? t : DT - 1; const size_t ro = (size_t)(r0 + tt) * 1024; lk[t] = *(const GAS u32x4*)(KR + ro + cb_); lw[t] = *(const GAS u32x4*)(WL + ro + cb_); la[t] = *(const GAS u32x4*)(AL + ro + cb_); lr[t] = *(const GAS u32x4*)(R + ro + cb_);
                lv[t] = V[ro + cv_]; lg[t] = has_vres ? VG[ro + cv_] : (unsigned short)0; lf[t] = has_vres ? VFI[ro + cv_] : (unsigned short)0; }
            float S[8] = {sa4.x, sa4.y, sa4.z, sa4.w, sb4.x, sb4.y, sb4.z, sb4.w};
#pragma unroll
            for (int t = 0; t < 4; ++t) if (t < DT) {
                float k8[8], w8[8], a8[8], r8[8];
#pragma unroll
                for (int i = 0; i < 4; ++i) { k8[2 * i] = bflo(lk[t][i]); k8[2 * i + 1] = bfhi(lk[t][i]); w8[2 * i] = bflo(lw[t][i]); w8[2 * i + 1] = bfhi(lw[t][i]); a8[2 * i] = bflo(la[t][i]); a8[2 * i + 1] = bfhi(la[t][i]); r8[2 * i] = bflo(lr[t][i]); r8[2 * i + 1] = bfhi(lr[t][i]); }
                float kv[8], ss = 0.f;
#pragma unroll
                for (int i = 0; i < 8; ++i) { kv[i] = k8[i] * pkk[i >> 2][i & 3]; ss = fmaf(kv[i], kv[i], ss); }
                const float inv = frcp(fmaxf(fsqrt(row_sum8(ss)), 1e-12f));
                float dec[8], nn[8], bb[8], k2[8], bsum = 0.f, sdot = 0.f;
#pragma unroll
                for (int i = 0; i < 8; ++i) { dec[i] = __expf(-0.6065306597126334f * frcp(1.f + __expf(-(pw0[i >> 2][i & 3] + w8[i])))); const float av = frcp(1.f + __expf(-(pa0[i >> 2][i & 3] + a8[i]))); const float kk = kv[i] * inv;
                    nn[i] = -kk; bb[i] = kk * av; k2[i] = k8[i] * ((av - 1.f) * pka[i >> 2][i & 3] + 1.f); bsum = fmaf(r8[i] * k2[i], prk[i >> 2][i & 3], bsum); sdot = fmaf(S[i], nn[i], sdot); }
                const float bon = row_sum8(bsum), sa = row_sum8(sdot);
                float vv = __uint_as_float((unsigned)lv[t] << 16); if (has_vres) vv = vv + (__uint_as_float((unsigned)lf[t] << 16) - vv) * frcp(1.f + __expf(-(v0c + __uint_as_float((unsigned)lg[t] << 16))));
                float yd = 0.f;
#pragma unroll
                for (int i = 0; i < 8; ++i) { S[i] = fmaf(S[i], dec[i], fmaf(bb[i], sa, k2[i] * vv)); yd = fmaf(S[i], r8[i], yd); }
                const float y = row_sum8(yd); const size_t ro = (size_t)(r0 + t) * 1024;
                if (sp8 == 0) { Y[ro + cv_] = (bf16_t)(pk_bf16(y, 0.f) & 0xffffu); VFO[ro + cv_] = (bf16_t)(pk_bf16(vv, 0.f) & 0xffffu); if (vrow == 0) BON[(size_t)(r0 + t) * 16 + h] = bon; } }
            GAS float* so = SOUT + ((size_t)pair * 64 + vrow) * 64 + sp8 * 8; *(GAS f32x4*)so = (f32x4){S[0], S[1], S[2], S[3]}; *(GAS f32x4*)(so + 4) = (f32x4){S[4], S[5], S[6], S[7]};
        }
    }
}

__device__ __forceinline__ void gla_phase(const GAS float* __restrict__ PROJ, const GAS float* __restrict__ LOGA, GAS float* __restrict__ O, GAS float* __restrict__ P, int B, int T, LAS unsigned char* lds, int tid, int bid, int nb) {
    constexpr int TB = 32, OA = 0, OK = 8192, OQ = 16384, OV = 24576, BUF = 26624;
    const int wv = __builtin_amdgcn_readfirstlane(tid) >> 6; const bool scanw = wv < 4; const int pt = tid & 255, lane = tid & 63;
    const int col = pt >> 4, p = pt & 15, dk = p * 4;
    const int nunits = B * 32;
#define GLA_WAITV(n_) asm volatile("s_waitcnt vmcnt(" #n_ ")" ::: "memory")
#define GLA_BAR() do { asm volatile("s_waitcnt lgkmcnt(0)" ::: "memory"); __builtin_amdgcn_s_barrier(); asm volatile("" ::: "memory"); } while (0)
    for (int u = bid; u < nunits; u += nb) {
        const int ug_ = ((u & 7) << 3 | ((u >> 3) & 7)) + ((u >> 6) << 6);
        const int cb = ug_ & 7, pair = ug_ >> 3, s = pair >> 2, h = pair & 3; const int r0 = s * T;
        f32x2 S01 = (f32x2){0.f, 0.f}, S23 = (f32x2){0.f, 0.f};
        const int nblk = (T + TB - 1) / TB;
        const GAS unsigned char* gsrc; size_t gins, gblk; int ldst;
        if (wv == 4) { gsrc = (const GAS unsigned char*)(LOGA + (size_t)(r0 + (lane >> 4)) * 256 + h * 64 + (lane & 15) * 4); gins = (size_t)4 * 256 * 4; gblk = (size_t)TB * 256 * 4; ldst = OA; }
        else if (wv == 7) { gsrc = (const GAS unsigned char*)(PROJ + (size_t)(r0 + (lane >> 2)) * 2576 + 512 + h * 128 + cb * 16 + (lane & 3) * 4); gins = (size_t)16 * 2576 * 4; gblk = (size_t)TB * 2576 * 4; ldst = OV; }
        else { gsrc = (const GAS unsigned char*)(PROJ + (size_t)(r0 + (lane >> 4)) * 2576 + (wv == 5 ? 256 : 0) + h * 64 + (lane & 15) * 4); gins = (size_t)4 * 2576 * 4; gblk = (size_t)TB * 2576 * 4; ldst = wv == 5 ? OK : OQ; }
#define GLA_DMA(blk_) do { const GAS unsigned char* s_ = gsrc + (size_t)(blk_) * gblk; LAS unsigned char* d_ = lds + ((blk_) % 3) * BUF + ldst; \
            if (wv == 7) { __builtin_amdgcn_global_load_lds((const GAS unsigned*)s_, (LAS unsigned*)d_, 16, 0, 0); __builtin_amdgcn_global_load_lds((const GAS unsigned*)(s_ + gins), (LAS unsigned*)(d_ + 1024), 16, 0, 0); } \
            else { _Pragma("unroll") for (int i_ = 0; i_ < 8; ++i_) __builtin_amdgcn_global_load_lds((const GAS unsigned*)(s_ + i_ * gins), (LAS unsigned*)(d_ + i_ * 1024), 16, 0, 0); } } while (0)
        if (!scanw) { GLA_DMA(0); if (nblk > 1) { GLA_DMA(1); if (wv == 7) GLA_WAITV(2); else GLA_WAITV(8); } else GLA_WAITV(0); }
        GLA_BAR();
        for (int b = 0; b < nblk; ++b) {
            const int tb0 = b * TB; const int nt = (T - tb0) < TB ? (T - tb0) : TB;
            if (scanw) {
                const LAS unsigned char* cur = lds + (b % 3) * BUF; const LAS float* vec = (const LAS float*)cur + dk; const LAS float* vv = (const LAS float*)(cur + OV) + col;
                float okeep0 = 0.f, okeep1 = 0.f;
                struct G4 { f32x4 a[4], k[4], q[4]; float v[4]; };
#define GLA_RD4(dst, t0_) do { _Pragma("unroll") for (int i_ = 0; i_ < 4; ++i_) { const LAS float* vp_ = vec + ((t0_) + i_) * 64; dst.a[i_] = *(const LAS f32x4*)vp_; dst.k[i_] = *(const LAS f32x4*)(vp_ + OK / 4); dst.q[i_] = *(const LAS f32x4*)(vp_ + OQ / 4); dst.v[i_] = vv[((t0_) + i_) * 16]; } } while (0)
#define GLA_ONE(src, i_, keep, tl) do { const f32x4 a4 = src.a[i_], k4 = src.k[i_], q4 = src.q[i_]; const f32x2 v2 = (f32x2){src.v[i_], src.v[i_]}; \
                S01 = __builtin_elementwise_fma((f32x2){a4.x, a4.y}, S01, (f32x2){k4.x, k4.y} * v2); S23 = __builtin_elementwise_fma((f32x2){a4.z, a4.w}, S23, (f32x2){k4.z, k4.w} * v2); \
                const f32x2 o2 = __builtin_elementwise_fma((f32x2){q4.z, q4.w}, S23, (f32x2){q4.x, q4.y} * S01); const float o = row_sum16(o2.x + o2.y); keep = (p == (tl)) ? o : keep; } while (0)
#define GLA_CMP4(src, keep, tl0) do { GLA_ONE(src, 0, keep, tl0); GLA_ONE(src, 1, keep, (tl0) + 1); GLA_ONE(src, 2, keep, (tl0) + 2); GLA_ONE(src, 3, keep, (tl0) + 3); } while (0)
                if (nt == TB) {
                    G4 gA, gB; GLA_RD4(gA, 0);
                    GLA_RD4(gB, 4); __builtin_amdgcn_sched_barrier(0); GLA_CMP4(gA, okeep0, 0); GLA_RD4(gA, 8); __builtin_amdgcn_sched_barrier(0); GLA_CMP4(gB, okeep0, 4);
                    GLA_RD4(gB, 12); __builtin_amdgcn_sched_barrier(0); GLA_CMP4(gA, okeep0, 8); GLA_RD4(gA, 16); __builtin_amdgcn_sched_barrier(0); GLA_CMP4(gB, okeep0, 12);
                    GLA_RD4(gB, 20); __builtin_amdgcn_sched_barrier(0); GLA_CMP4(gA, okeep1, 0); GLA_RD4(gA, 24); __builtin_amdgcn_sched_barrier(0); GLA_CMP4(gB, okeep1, 4);
                    GLA_RD4(gB, 28); __builtin_amdgcn_sched_barrier(0); GLA_CMP4(gA, okeep1, 8); __builtin_amdgcn_sched_barrier(0); GLA_CMP4(gB, okeep1, 12);
                } else { G4 g1; for (int t = 0; t < nt; ++t) { const LAS float* vp_ = vec + t * 64; g1.a[0] = *(const LAS f32x4*)vp_; g1.k[0] = *(const LAS f32x4*)(vp_ + OK / 4); g1.q[0] = *(const LAS f32x4*)(vp_ + OQ / 4); g1.v[0] = vv[t * 16];
                    if (t < 16) GLA_ONE(g1, 0, okeep0, t); else GLA_ONE(g1, 0, okeep1, t - 16); } }
#undef GLA_RD4
#undef GLA_ONE
#undef GLA_CMP4
                { int pt_ = pt; asm volatile("" : "+v"(pt_)); const int p_ = pt_ & 15; GAS float* od = O + (size_t)(r0 + tb0 + p_) * 512 + h * 128 + cb * 16 + (pt_ >> 4);
                  if (p_ < nt) od[0] = okeep0 * 0.125f; if (16 + p_ < nt) od[(size_t)16 * 512] = okeep1 * 0.125f; }
            } else {
                if (b + 2 < nblk) { GLA_DMA(b + 2); if (wv == 7) GLA_WAITV(2); else GLA_WAITV(8); } else GLA_WAITV(0);
            }
            GLA_BAR();
        }
#undef GLA_DMA
        if (scanw) { int pt_ = pt; asm volatile("" : "+v"(pt_));
                     GAS float* so = P + ((size_t)pair * 64 + (pt_ & 15) * 4) * 128 + cb * 16 + (pt_ >> 4); so[0] = S01.x; so[128] = S01.y; so[256] = S23.x; so[384] = S23.y; }
        GLA_BAR();
    }
#undef GLA_WAITV
#undef GLA_BAR
}
__device__ __forceinline__ float grp8_sum(float v) { v += dppf<0xB1>(v); v += dppf<0x4E>(v); v += dppf<0x141>(v); return v; }
__device__ __forceinline__ float dot16_fp8_bf16(const u32x4 uw, const float (&x)[16]) { float s = 0.f;
#pragma unroll
    for (int d = 0; d < 4; ++d) { const f32x2 lo = fp8lo(uw[d]), hi = fp8hi(uw[d]); s = fmaf(lo.x, x[4 * d], s); s = fmaf(lo.y, x[4 * d + 1], s); s = fmaf(hi.x, x[4 * d + 2], s); s = fmaf(hi.y, x[4 * d + 3], s); }
    return s; }
typedef int i32x8 __attribute__((ext_vector_type(8)));
typedef unsigned u32x8 __attribute__((ext_vector_type(8)));
__device__ __forceinline__ void pacts_phase(const GAS unsigned char* XF8, const GAS unsigned char* U8S, const GAS int* EIDX, GAS bf16_t* __restrict__ PART, int M, int emask,
                                            LAS unsigned char* lds, int wid, int lane, int bid, int nb) {
    const bool spl = (nb & 7) == 0; const int s0 = spl ? (bid & 7) : 0, s1 = spl ? s0 + 1 : 8, r = spl ? (bid >> 3) : bid, nr = spl ? (nb >> 3) : nb;
    const int g = lane >> 3, c = lane & 7, fg = ((g >> 2) & 1) | (((g >> 1) & 1) << 2);
    const int m16 = lane & 15, kb = lane >> 4, fm = ((m16 >> 2) & 1) | (((m16 >> 1) & 1) << 2);
    LAS unsigned char* const wl = lds + wid * 16384;
    const LAS unsigned char* const ard = wl + m16 * 128 + (((2 * kb) ^ fm) * 16);
    const LAS unsigned char* const xrd = wl + 12288 + (m16 & 1) * 128 + kb * 32;
    const LAS unsigned char* const ird = wl + 13824 + g * 4;
    if (r >= M) return;
    const int ntok = (M - r + nr - 1) / nr;
#define PL_ROW(t_) ({ int rw_ = r + nr * (t_); rw_ < M ? rw_ : r; })
#define PL_IDS(t_, slot_) __builtin_amdgcn_global_load_lds((const GAS unsigned*)(isrc + (size_t)PL_ROW(t_) * 128), (LAS unsigned*)(wl + 13824 + (slot_) * 256), 4, 0, 0)
#define PL_RDIDS(slot_, e0_, e1_) do { e0_ = *(const LAS int*)(ird + (slot_) * 256); e1_ = *(const LAS int*)(ird + (slot_) * 256 + 32); } while (0)
#define PL_TILE(t_, slot_, e0_, e1_) do { \
        __builtin_amdgcn_global_load_lds((const GAS unsigned*)(tb + (size_t)((e0_) & emask) * 128), (LAS unsigned*)(wl + (slot_) * 2048), 16, 0, 0); \
        __builtin_amdgcn_global_load_lds((const GAS unsigned*)(tb + (size_t)((e1_) & emask) * 128), (LAS unsigned*)(wl + (slot_) * 2048 + 1024), 16, 0, 0); \
        __builtin_amdgcn_global_load_lds((const GAS unsigned*)(xsrc + (size_t)PL_ROW(t_) * 2048), (LAS unsigned*)(wl + 12288 + (slot_) * 256), 4, 0, 0); } while (0)
#define PL_RD(slot_, a0_, a1_, x0_, x1_) do { a0_ = *(const LAS u32x4*)(ard + (slot_) * 2048); a1_ = *(const LAS u32x4*)(ard2 + (slot_) * 2048); x0_ = *(const LAS u32x4*)(xrd + (slot_) * 256); x1_ = *(const LAS u32x4*)(xrd + (slot_) * 256 + 16); } while (0)
#define PL_MMA(cc_, a0_, a1_, x0_, x1_) do { const i32x8 av = (i32x8)__builtin_shufflevector(a0_, a1_, 0, 1, 2, 3, 4, 5, 6, 7), bv = (i32x8)__builtin_shufflevector(x0_, x1_, 0, 1, 2, 3, 4, 5, 6, 7); const f32x4 z = {0.f, 0.f, 0.f, 0.f}; \
        cc_ = __builtin_amdgcn_mfma_scale_f32_16x16x128_f8f6f4(av, bv, z, 0, 0, 0, 0, 0, 0); } while (0)
#define PL_OUT(t_, cc_) do { f32x4 o; _Pragma("unroll") for (int i = 0; i < 4; ++i) { float v = cc_[i]; v += dppf<0xB1>(v); o[i] = v * (1.f / 16.f); } \
        const int rw = r + nr * (t_); if (m16 == 0 && rw < M) { u32x2 w_; w_.x = pk_bf16(o[0], o[1]); w_.y = pk_bf16(o[2], o[3]); *(GAS u32x2*)(po + (size_t)rw * 128) = w_; } } while (0)
#define PL_WAIT(n_) asm volatile("s_waitcnt vmcnt(" #n_ ")" ::: "memory")
#define PL_STEP(j_, h_) do { PL_WAIT(12); u32x4 a0[3], a1[3], x0[3], x1[3]; int e0[3], e1[3]; f32x4 cc[3]; \
        _Pragma("unroll") for (int k = 0; k < 3; ++k) PL_RD((h_) * 3 + k, a0[k], a1[k], x0[k], x1[k]); \
        _Pragma("unroll") for (int k = 0; k < 3; ++k) PL_RDIDS((h_) * 3 + k, e0[k], e1[k]); \
        _Pragma("unroll") for (int k = 0; k < 3; ++k) PL_MMA(cc[k], a0[k], a1[k], x0[k], x1[k]); \
        _Pragma("unroll") for (int k = 0; k < 3; ++k) PL_TILE((j_) + 6 + k, (h_) * 3 + k, e0[k], e1[k]); \
        _Pragma("unroll") for (int k = 0; k < 3; ++k) PL_IDS((j_) + 12 + k, (h_) * 3 + k); \
        _Pragma("unroll") for (int k = 0; k < 3; ++k) PL_OUT((j_) + k, cc[k]); } while (0)
    const LAS unsigned char* const ard2 = (const LAS unsigned char*)((unsigned)(size_t)ard ^ 16u);
    for (int s = s0; s < s1; ++s) {
        const GAS unsigned char* tb = U8S + (size_t)s * 16384 * 128 + ((c ^ fg) * 16);
        const GAS unsigned char* xsrc = XF8 + (size_t)(lane >> 5) * 1024 + s * 128 + (lane & 31) * 4;
        const GAS int* isrc = EIDX + wid * 16 + m16;
        GAS bf16_t* po = PART + (size_t)s * M * 128 + wid * 16 + kb * 4;
        PL_IDS(0, 0); PL_IDS(1, 1); PL_IDS(2, 2); PL_IDS(3, 3); PL_IDS(4, 4); PL_IDS(5, 5); PL_WAIT(0);
        { int e0[6], e1[6];
#pragma unroll
          for (int k = 0; k < 6; ++k) PL_RDIDS(k, e0[k], e1[k]);
#pragma unroll
          for (int k = 0; k < 3; ++k) PL_TILE(k, k, e0[k], e1[k]);
#pragma unroll
          for (int k = 0; k < 3; ++k) PL_IDS(6 + k, k);
#pragma unroll
          for (int k = 3; k < 6; ++k) PL_TILE(k, k, e0[k], e1[k]);
#pragma unroll
          for (int k = 3; k < 6; ++k) PL_IDS(6 + k, k); }
        for (int j = 0; j < ntok; j += 6) { PL_STEP(j, 0); PL_STEP(j + 3, 1); }
        PL_WAIT(0);
    }
#undef PL_ROW
#undef PL_IDS
#undef PL_RDIDS
#undef PL_TILE
#undef PL_RD
#undef PL_MMA
#undef PL_OUT
#undef PL_WAIT
#undef PL_STEP
}
__device__ __forceinline__ void pouts_phase(const GAS float* __restrict__ COEF, const GAS int* __restrict__ EIDX, const GAS unsigned char* V8S, GAS bf16_t* __restrict__ YBUF, int M,
                                            int wid, int lane, int bid, int nb) {
    const bool spl = (nb & 7) == 0; const int s0 = spl ? (bid & 7) : 0, s1 = spl ? s0 + 1 : 8, r = spl ? (bid >> 3) : bid, nr = spl ? (nb >> 3) : nb;
    const int g = lane >> 3, ch = lane & 7, rstep = nr * 8;
#define PO_LOADCE(rw, c0, c1, v0, v1) do { c0 = COEF[(size_t)(rw) * 128 + lane] * (1.f / 64.f); c1 = COEF[(size_t)(rw) * 128 + 64 + lane] * (1.f / 64.f); v0 = EIDX[(size_t)(rw) * 128 + lane]; v1 = EIDX[(size_t)(rw) * 128 + 64 + lane]; } while (0)
#define PO_GATHER(vv_, vreg) do { _Pragma("unroll") for (int k = 0; k < 8; ++k) { const int e = __builtin_amdgcn_ds_bpermute((8 * k + g) << 2, vreg); vv_[k] = *(const GAS u32x4*)(tb + (size_t)(e & 16383) * 128); } } while (0)
#define PO_COMP(vv_, creg) do { _Pragma("unroll") for (int k = 0; k < 8; ++k) { const float c = __int_as_float(__builtin_amdgcn_ds_bpermute((8 * k + g) << 2, __float_as_int(creg))); const u32x4 w = vv_[k]; \
        const f32x2 c2 = (f32x2){c, c}; _Pragma("unroll") for (int d = 0; d < 4; ++d) { ac2[2 * d] = __builtin_elementwise_fma(c2, fp8lo(w[d]), ac2[2 * d]); ac2[2 * d + 1] = __builtin_elementwise_fma(c2, fp8hi(w[d]), ac2[2 * d + 1]); } \
        _Pragma("unroll") for (int i = 0; i < 8; ++i) asm volatile("" : "+v"(ac2[i])); } } while (0)
    for (int s = s0; s < s1; ++s) {
        const GAS unsigned char* tb = V8S + (size_t)s * 16384 * 128 + ch * 16;
        int row = r + nr * wid; if (row >= M) continue;
        float c0c, c1c, c0n = 0.f, c1n = 0.f; int v0c, v1c, v0n = 0, v1n = 0;
        PO_LOADCE(row, c0c, c1c, v0c, v1c);
        u32x4 va[8], vb[8];
        PO_GATHER(va, v0c);
        for (;;) {
            const int rown = row + rstep; const bool hasn = rown < M;
            PO_GATHER(vb, v1c);
            if (hasn) PO_LOADCE(rown, c0n, c1n, v0n, v1n);
            f32x2 ac2[8];
#pragma unroll
            for (int i = 0; i < 8; ++i) ac2[i] = (f32x2){0.f, 0.f};
            PO_COMP(va, c0c);
            if (hasn) PO_GATHER(va, v0n);
            PO_COMP(vb, c1c);
            float acc[16];
#pragma unroll
            for (int i = 0; i < 8; ++i) { acc[2 * i] = ac2[i].x; acc[2 * i + 1] = ac2[i].y; }
#pragma unroll
            for (int i = 0; i < 16; ++i) acc[i] += dppf<0x128>(acc[i]);
#pragma unroll
            for (int i = 0; i < 8; ++i) { const bool hi = lane & 16; const float send = hi ? acc[i] : acc[i + 8], keep = hi ? acc[i + 8] : acc[i]; acc[i] = keep + shx(send, 16, lane); }
#pragma unroll
            for (int i = 0; i < 4; ++i) { const bool hi = lane & 32; const float send = hi ? acc[i] : acc[i + 4], keep = hi ? acc[i + 4] : acc[i]; acc[i] = keep + shx(send, 32, lane); }
            if ((lane & 8) == 0) { u32x2 w_; w_.x = pk_bf16(acc[0], acc[1]); w_.y = pk_bf16(acc[2], acc[3]); *(GAS u32x2*)(YBUF + (size_t)row * 1024 + s * 128 + ch * 16 + ((lane >> 4) & 1) * 8 + ((lane >> 5) & 1) * 4) = w_; }
            if (!hasn) break;
            row = rown; c0c = c0n; c1c = c1n; v0c = v0n; v1c = v1n;
        }
    }
#undef PO_LOADCE
#undef PO_GATHER
#undef PO_COMP
}
}

template <class T> __device__ __forceinline__ __attribute__((address_space(1))) T* gp(T* p) { return (__attribute__((address_space(1))) T*)uni_ptr(p); }
constexpr int MK_THREADS = 512, LDS_BYTES = 163840, LDSCTL_OFF = 131072, TAB_OFF = LDSCTL_OFF + 1024, MAX_OPS = 208;
static_assert(TAB_OFF + MAX_OPS * (int)sizeof(Op) <= LDS_BYTES, "LDS map");
constexpr int MPAD = 17152;
constexpr size_t CTL_BYTES = (size_t)1 << 20;
struct MArgs { const float* in[47]; float* out; char* ws; unsigned long long ws_size; };
__global__ void __launch_bounds__(MK_THREADS, 2) mega_fwd(MArgs a) {
    extern __shared__ __attribute__((aligned(16))) unsigned char lds[];
    volatile LAS unsigned* ctl = (volatile LAS unsigned*)((LAS unsigned char*)lds + LDSCTL_OFF);
    if (threadIdx.x < 64) ctl[threadIdx.x] = 0u;
    __syncthreads();
    (void)xcd_barrier_post((unsigned*)a.ws, ctl + 8);
    const Dm dm = make_dm(1024, 8, 2048, 128, 4);
    Op* tab = (Op*)(lds + TAB_OFF);
    if (threadIdx.x == 0) {
        const float* const* inp_ = (const float* const*)__builtin_amdgcn_kernarg_segment_ptr(); asm volatile("" : "+s"(inp_));
        NvIO io; io.in = inp_; io.out = a.out; io.ws = a.ws + CTL_BYTES; io.ws_size = a.ws_size - CTL_BYTES;
        int n = 0;
        #ifdef PROBE_DUPCODE
        nv_forward(io, dm, [&](const Op& o) __attribute__((always_inline)) { if (n < MAX_OPS) tab[n] = o; ++n; if ((o.code & 0xff) == PROBE_DUPCODE) { if (n < MAX_OPS) tab[n] = o; ++n; } asm volatile("" ::: "memory"); });
#else
        nv_forward(io, dm, [&](const Op& o) __attribute__((always_inline)) { if (n < MAX_OPS) tab[n] = o; ++n; asm volatile("" ::: "memory"); });
#endif
        ctl[16] = (unsigned)(n <= MAX_OPS ? n : 0);
    }
    __syncthreads();
    const int nops = (int)ctl[16];
    for (int i = 0; i < nops; ++i) {
        int tid_ = (int)threadIdx.x, bid_ = (int)blockIdx.x, nb_ = (int)gridDim.x;
        asm volatile("" : "+v"(tid_)); asm volatile("" : "+s"(bid_)); asm volatile("" : "+s"(nb_));
        const long long g0 = (long long)bid_ * MK_THREADS + tid_, gs = (long long)nb_ * MK_THREADS;
        const Op& o = tab[i];
        const int rawc = __builtin_amdgcn_readfirstlane(o.code); const int code = rawc & 0xff; const long long n = o.n;
        switch (code) {
        case OP_FGEMM: {
            const int fl = rfl(o.i6);
            pg8::Gemm g{uni_ptr((const pg8::bf16_t*)o.a), uni_ptr((const pg8::bf16_t*)o.b), MPAD, rfl(o.i5), rfl(o.i1), rfl(o.i2), rfl(o.i3)};
            if (rawc & OPF_GROUP) {
                int ng = 1; while (ng < 8 && (rfl(tab[i + ng - 1].code) & OPF_GROUP)) ++ng;
                const PG8_LAS Op* gt = (const PG8_LAS Op*)((PG8_LAS unsigned char*)lds + TAB_OFF) + i;
                pg8::GroupOrder S; S.tab = gt; S.ng = ng; S.nM = MPAD / 256; S.G = nb_; S.c = bid_; S.tsA = (size_t)256 * g.lda * 2; S.tsB = (size_t)256 * g.ldb * 2;
                pg8::EpiGroup E{gt, dm.M};
                pg8::gemm_phase<pg8::EpiGroup, pg8::GroupOrder, true, true>((PG8_LAS unsigned char*)lds, g, S, E);
                i += ng - 1;
            } else {
            pg8::StaticOrder S; S.init(g, nb_, bid_); if (fl & 2) S.acs = 512;
            float* const c0 = uni_ptr(o.o0); const int ldc0 = rfl(o.i4), nreal0 = rfl(o.i0);
            if (fl & 1) { pg8::EpiBf16Plain E{(pg8::bf16_t*)c0, ldc0}; pg8::gemm_phase<pg8::EpiBf16Plain, pg8::StaticOrder, true, true>((PG8_LAS unsigned char*)lds, g, S, E); }
            else { pg8::EpiF32 E{c0, ldc0, dm.M, nreal0}; pg8::gemm_phase<pg8::EpiF32, pg8::StaticOrder, true, true>((PG8_LAS unsigned char*)lds, g, S, E); }
            }
        } break;
        case OP_LRUG2: {
            pg8::Gemm g{uni_ptr((const pg8::bf16_t*)o.a), uni_ptr((const pg8::bf16_t*)o.b), MPAD, 1024, 512, 512, 512};
            pg8::StaticOrder S; S.init(g, nb_, bid_);
            pg8::EpiLru E{uni_ptr(o.c), uni_ptr(o.d), uni_ptr(o.e), uni_ptr((const pg8::bf16_t*)o.f), uni_ptr(o.o0), uni_ptr(o.o1), dm.M};
            pg8::gemm_phase<pg8::EpiLru, pg8::StaticOrder, true, true>((PG8_LAS unsigned char*)lds, g, S, E);
        } break;
        case OP_WKVP: fk::wkv2_phase(gp((const fk::bf16_t*)o.a), gp((const fk::bf16_t*)o.b), gp((const fk::bf16_t*)o.c), gp((const fk::bf16_t*)o.d), gp((const fk::bf16_t*)o.e), gp((const fk::bf16_t*)o.f), gp((const fk::bf16_t*)o.g), gp(o.h), gp((const float*)o.o5), gp((fk::bf16_t*)o.o0), gp(o.o1), gp(o.o2), gp((fk::bf16_t*)o.o3), gp(o.o4), rfl(o.i0), dm.B, dm.T, dm.DB, dm.DT, (LAS unsigned char*)lds, tid_, bid_, nb_); break;
        case OP_POST2: fk::rwkvpost2_phase(gp((const fk::bf16_t*)o.a), gp((const fk::bf16_t*)o.b), gp((const fk::bf16_t*)o.c), gp(o.d), gp(o.e), gp(o.f), gp((fk::bf16_t*)o.o0), dm.M * 16, tid_ & 63, bid_ * 8 + (tid_ >> 6), nb_ * 8); break;
        case OP_GLAF: fk::gla_phase(gp(o.a), gp(o.b), gp(o.o0), gp(o.o1), dm.B, dm.T, (LAS unsigned char*)lds, tid_, bid_, nb_); break;
        case OP_PACTS: fk::pacts_phase(gp((const unsigned char*)o.a), gp((const unsigned char*)o.b), gp((const int*)o.d), gp((fk::bf16_t*)o.o0), dm.M, rfl(o.i0), (LAS unsigned char*)lds, rfl(tid_ >> 6), tid_ & 63, bid_, nb_); break;
        case OP_POUTS: fk::pouts_phase(gp(o.a), gp((const int*)o.b), gp((const unsigned char*)o.c), gp((fk::bf16_t*)o.o0), dm.M, tid_ >> 6, tid_ & 63, bid_, nb_); break;
        case OP_TOPK2: fk::topk_phase(gp((const fk::bf16_t*)o.a), gp((const fk::bf16_t*)o.b), gp(o.c), gp(o.o0), gp((int*)o.o1), dm.M * 8, (LAS unsigned char*)lds, tid_ >> 6, tid_ & 63, bid_ * 8 + (tid_ >> 6), nb_ * 8); break;
        case OP_LNRES: fk::lnres_phase(gp((const fk::bf16_t*)o.a), gp(o.b), gp(o.c), gp(o.o0), gp((fk::bf16_t*)o.o1), gp((unsigned char*)o.o2), dm.M, tid_ & 63, bid_ * 8 + (tid_ >> 6), nb_ * 8); break;
        case OP_GLANORM: fk::glanorm_phase(gp(o.a), gp(o.b), gp(o.c), gp((fk::bf16_t*)o.o0), dm.M * 4, tid_ & 63, bid_ * 8 + (tid_ >> 6), nb_ * 8); break;
        case OP_CVTTAB8S: {
            int X = rfl(o.i6) % nb_; X = (X < nb_ - 1) ? X : 0;
            if (bid_ >= X) { const long long gs2 = (long long)(nb_ - X) * MK_THREADS; for (long long g = (long long)(bid_ - X) * MK_THREADS + tid_; g < n; g += gs2) nv_elem(OP_CVTTAB8S, o, dm, g); } } break;
#define NVC(c) case c: for (long long g = g0; g < n; g += gs) nv_elem(c, o, dm, g); break;
        NVC(OP_LOGA4) NVC(OP_CONVOUT) NVC(OP_SHIFTOUT) NVC(OP_EMBED4) NVC(OP_YOUT4) NVC(OP_MIX6) NVC(OP_CONV4) NVC(OP_CVT8) NVC(OP_WGATE)
        NVC(OP_WT) NVC(OP_PRED) NVC(OP_PRM) NVC(OP_KEYS) NVC(OP_GLA3) NVC(OP_LRU1) NVC(OP_LRU3)
#undef NVC
        default: break;
        }
        if (__builtin_amdgcn_readfirstlane(tab[i].code) & OPF_NOBAR) __syncthreads(); else { XcdBarrier bar; bar.bar = (unsigned*)a.ws; bar.x = xb_xcc_id(); bar.st = ctl + 8; xcd_barrier(bar); }
    }
}
extern "C" void kernel_launch(void* const* d_in, const int* in_sizes, int n_in, void* d_out, int out_size, void* d_ws, size_t ws_size, hipStream_t stream) {
    static int grid = 0;
    if (grid == 0) {
        if (n_in != 47 || ws_size < ((size_t)900 << 20)) { fprintf(stderr, "kernel_launch: expected 47 inputs and >= 900 MiB of workspace; got %d, %zu\n", n_in, ws_size); grid = -1; return; }
        int dev = 0, cus = 0, per_cu = 0;
        if (hipGetDevice(&dev) != hipSuccess || hipDeviceGetAttribute(&cus, hipDeviceAttributeMultiprocessorCount, dev) != hipSuccess) { grid = -1; return; }
        if (hipFuncSetAttribute((const void*)mega_fwd, hipFuncAttributeMaxDynamicSharedMemorySize, LDS_BYTES) != hipSuccess) { fprintf(stderr, "kernel_launch: hipFuncSetAttribute failed\n"); grid = -1; return; }
        if (hipOccupancyMaxActiveBlocksPerMultiprocessor(&per_cu, (const void*)mega_fwd, MK_THREADS, LDS_BYTES) != hipSuccess || per_cu < 1) fprintf(stderr, "kernel_launch: occupancy query says %d per CU\n", per_cu);
        (void)hipGetLastError();
        grid = cus;
    }
    if (grid < 0) return;
    if (hipMemsetAsync(d_ws, 0, CTL_BYTES, stream) != hipSuccess) { fprintf(stderr, "kernel_launch: memset failed\n"); return; }
    MArgs a{}; for (int i = 0; i < 47; ++i) a.in[i] = (const float*)d_in[i]; a.out = (float*)d_out; a.ws = (char*)d_ws; a.ws_size = (unsigned long long)ws_size;
    hipLaunchKernelGGL(mega_fwd, dim3(grid), dim3(MK_THREADS), LDS_BYTES, stream, a);
}
```

```cpp
#include <hip/hip_runtime.h>
#include <cstdio>
#include <cmath>
#ifndef HD
#define HD __host__ __device__ __forceinline__
#endif
struct Dm { int D, B, T, DB, DT, M, NSEQ, RH; };
HD Dm make_dm(int D, int B, int SEQ, int DB, int DT) { Dm d; d.D = D; d.B = B; d.T = SEQ + 16; d.DB = DB; d.DT = DT; d.M = B * d.T + DB * DT; d.NSEQ = B + DB; d.RH = D / 64; return d; }
HD int seq_row0(const Dm& d, int s) { return s < d.B ? s * d.T : d.B * d.T + (s - d.B) * d.DT; }
HD int seq_len(const Dm& d, int s) { return s < d.B ? d.T : d.DT; }
HD void row_to_seq(const Dm& d, int row, int& s, int& t) { if (row < d.B * d.T) { s = row / d.T; t = row % d.T; } else { int r = row - d.B * d.T; s = d.B + r / d.DT; t = r % d.DT; } }

constexpr int MIXIN = 2576, C_Q = 0, C_K = 256, C_V = 512, C_GLR = 1024, C_R = 1040, C_XB = 1552, C_GB = 2064;

enum { OP_EMBED = 1, OP_GEMM, OP_LOGA, OP_GLA, OP_GLANORM, OP_CONV, OP_CONVOUT, OP_LRUG, OP_LRUSCAN, OP_LNRES, OP_MIX, OP_SHIFTOUT,
       OP_RWKVPREP, OP_WKV, OP_RWKVPOST, OP_QNORM, OP_SCORES, OP_TOPK, OP_PACT1, OP_PACT2, OP_POUT, OP_YOUT, OP_WT, OP_CVT, OP_FGEMM, OP_CVTTAB, OP_KEYS, OP_TOPK2, OP_PACT, OP_POUTLN, OP_GLA1, OP_GLA2, OP_GLA3, OP_LRU1, OP_LRU2, OP_LRU3, OP_EMBED4, OP_YOUT4, OP_MIX8, OP_CONV4, OP_CVT8, OP_WGATE, OP_LRUG2, OP_WKVF, OP_GLAF, OP_CVTTAB8, OP_CVTTAB8S, OP_PACTS, OP_PRED, OP_POUTS, OP_MIX6, OP_PRM, OP_WKVP, OP_POST2, OP_LOGA4 };

constexpr int OPF_NOBAR = 0x100, OPF_GROUP = 0x200;
struct Op {
    const float *a, *b, *c, *d, *e, *f, *g, *h;
    float *o0, *o1, *o2, *o3, *o4, *o5;
    long long n;
    int code, i0, i1, i2, i3, i4, i5, i6;
};

#if defined(__HIP_DEVICE_COMPILE__)
#define NV_UNI(x) __builtin_amdgcn_readfirstlane(x)
#define NV_LAUNDER(p) asm volatile("" : "+s"(p))
#define NV_FENCE() asm volatile("" ::: "memory")
#else
#define NV_FENCE() do {} while (0)
#define NV_UNI(x) (x)
#define NV_LAUNDER(p) do {} while (0)
#endif
typedef unsigned short nvbf;
HD nvbf nv_f2bf(float f) { unsigned u; __builtin_memcpy(&u, &f, 4); return (nvbf)((u + 0x7fffu + ((u >> 16) & 1u)) >> 16); }
HD float nv_bf2f(nvbf h) { unsigned u = (unsigned)h << 16; float f; __builtin_memcpy(&f, &u, 4); return f; }
HD unsigned nv_f2e4m3(float f) {
    unsigned u; __builtin_memcpy(&u, &f, 4); const unsigned sign = (u >> 24) & 0x80u; const float a = fabsf(f);
    if (!(a < 448.f)) return sign | 0x7Eu;
    if (a < 0.015625f) return sign | (unsigned)rintf(a * 512.f);
    unsigned au = u & 0x7fffffffu; au += 0x7ffffu + ((au >> 20) & 1u);
    const unsigned e = ((au >> 23) & 0xffu) - 120u, m = (au >> 20) & 7u; unsigned code = (e << 3) | m; if (code > 0x7Eu) code = 0x7Eu;
    return sign | code; }
HD float nv_e4m32f(unsigned c) { const unsigned e = (c >> 3) & 15u, m = c & 7u; const float v = e ? ldexpf(1.f + m * 0.125f, (int)e - 7) : m * 0.001953125f; return (c & 0x80u) ? -v : v; }
HD int nv_rup(int x, int m) { return (x + m - 1) / m * m; }
struct alignas(16) NvF4 { float x, y, z, w; };
struct alignas(16) NvU4 { unsigned x, y, z, w; };
struct alignas(8) NvU2 { unsigned x, y; };
#if defined(__HIP_DEVICE_COMPILE__)
#define NV_EXP(x) __expf(x)
#define NV_TANH(x) (1.f - 2.f * __builtin_amdgcn_rcpf(1.f + __expf(2.f * (x))))
HD float nv_sigmoid(float x) { return __builtin_amdgcn_rcpf(1.f + __expf(-x)); }
HD float nv_softplus(float x) { return fmaxf(x, 0.f) + __logf(1.f + __expf(-fabsf(x))); }
HD float nv_gelu(float x) { return x * __builtin_amdgcn_rcpf(1.f + __expf(-1.5957691216057308f * (x + 0.044715f * x * x * x))); }
#else
#define NV_EXP(x) expf(x)
#define NV_TANH(x) tanhf(x)
HD float nv_sigmoid(float x) { return 1.f / (1.f + expf(-x)); }
HD float nv_softplus(float x) { return fmaxf(x, 0.f) + log1pf(expf(-fabsf(x))); }
HD float nv_gelu(float x) { return 0.5f * x * (1.f + tanhf(0.7978845608028654f * (x + 0.044715f * x * x * x))); }
#endif

#define NV_INS16(tv, ti, val, idx) do { float _v = (val); int _i = (idx); _Pragma("unroll") for (int _j = 0; _j < 16; ++_j) { if (_v > tv[_j]) { float _tv = tv[_j]; int _ti = ti[_j]; tv[_j] = _v; ti[_j] = _i; _v = _tv; _i = _ti; } } } while (0)

HD void nv_elem(const int code, const Op& p, const Dm& dm, long long gid) {
    const int D = dm.D; float* const PO1 = p.o1; float* const PO2 = p.o2;
    switch (code) {
    case OP_EMBED: {
        int row = (int)(gid / D), c = (int)(gid % D); float v;
        if (row < dm.B * dm.T) { int bb = row / dm.T, t = row % dm.T; v = t < 16 ? p.c[t * D + c] : p.a[((size_t)bb * (dm.T - 16) + (t - 16)) * D + c]; }
        else v = p.b[(size_t)(row - dm.B * dm.T) * D + c];
        p.o0[gid] = v; ((nvbf*)p.o1)[gid] = nv_f2bf(v); } break;
    case OP_GEMM: {
        int N4 = p.i0 >> 2, K = p.i1; int m = (int)(gid / N4), nn = (int)(gid % N4) * 4; const float* A = p.a + (size_t)m * p.i2; const float* Bw = p.b + nn; float c0 = 0.f, c1 = 0.f, c2 = 0.f, c3 = 0.f;
        for (int k = 0; k < K; ++k) { float av = A[k]; if (p.i5 == 1) av = NV_TANH(av); else if (p.i5 == 2) av = nv_sigmoid(av); const NvF4 bv = *(const NvF4*)(Bw + (size_t)k * p.i3);
            c0 = fmaf(av, bv.x, c0); c1 = fmaf(av, bv.y, c1); c2 = fmaf(av, bv.z, c2); c3 = fmaf(av, bv.w, c3); }
        float* C = p.o0 + (size_t)m * p.i4 + nn; C[0] = c0; C[1] = c1; C[2] = c2; C[3] = c3; } break;
    case OP_LOGA: {
        int row = (int)(gid / 256), c = (int)(gid % 256); float z = p.c[c];
        for (int r = 0; r < 16; ++r) z = fmaf(p.a[(size_t)row * MIXIN + C_GLR + r], p.b[r * 256 + c], z);
        p.o0[gid] = NV_EXP(-nv_softplus(-z) * (1.f / 16.f)); } break;
    case OP_GLAF:
    case OP_GLA: {
        int s = (int)(gid / 512), h = (int)((gid / 128) % 4), col = (int)(gid % 128);
        float S[64];
        const float* sin = (s < dm.B) ? nullptr : p.c + (((size_t)(s - dm.B) * 4 + h) * 64) * 128 + col;
#pragma unroll
        for (int k = 0; k < 64; ++k) S[k] = sin ? sin[(size_t)k * 128] : 0.f;
        int r0 = seq_row0(dm, s), L = seq_len(dm, s);
        for (int t = 0; t < L; ++t) {
            const float* pr = p.a + (size_t)(r0 + t) * MIXIN; const float* la = p.b + (size_t)(r0 + t) * 256 + h * 64;
            float v = pr[C_V + h * 128 + col], o = 0.f;
#pragma unroll
            for (int k = 0; k < 64; ++k) { if ((k & 7) == 0) NV_FENCE(); S[k] = fmaf(la[k], S[k], pr[C_K + h * 64 + k] * v); o = fmaf(pr[C_Q + h * 64 + k] * 0.125f, S[k], o); }
            p.o0[(size_t)(r0 + t) * 512 + h * 128 + col] = o;
        }
        float* so = (s < dm.B) ? PO1 + (((size_t)s * 4 + h) * 64) * 128 + col : PO2 + (((size_t)(s - dm.B) * 4 + h) * 64) * 128 + col;
#pragma unroll
        for (int k = 0; k < 64; ++k) so[(size_t)k * 128] = S[k]; } break;
    case OP_GLA1: {
        const int NC = p.i0; const int u = NV_UNI((int)(gid / 128)), col = (int)(gid % 128); const int s = u / (4 * NC), h = (u / NC) % 4, c = u % NC;
        const int r0 = seq_row0(dm, s) + c * 64; int L = dm.T - c * 64; L = L > 64 ? 64 : L;
        float S[64];
#pragma unroll
        for (int k = 0; k < 64; ++k) S[k] = 0.f;
        float dprod = 1.f;
        for (int t = 0; t < L; ++t) {
            const float* pr = p.a + (size_t)(r0 + t) * MIXIN; const float* la = p.b + (size_t)(r0 + t) * 256 + h * 64; const float v = pr[C_V + h * 128 + col];
            if (col < 64) dprod *= la[col];
#pragma unroll
            for (int k = 0; k < 64; ++k) { if ((k & 7) == 0) NV_FENCE(); S[k] = fmaf(la[k], S[k], pr[C_K + h * 64 + k] * v); }
        }
        float* so = p.o0 + (size_t)u * 8192 + col;
#pragma unroll
        for (int k = 0; k < 64; ++k) so[(size_t)k * 128] = S[k];
        if (col < 64) p.o1[(size_t)u * 64 + col] = dprod; } break;
    case OP_GLA2: {
        const int NC = p.i0; const int pair = (int)(gid / 8192), e = (int)(gid % 8192), dk = e / 128; float S = 0.f;
        for (int c = 0; c < NC; ++c) { const size_t ix = ((size_t)pair * NC + c) * 8192 + e; const float l = p.o0[ix]; p.o0[ix] = S; S = fmaf(p.a[((size_t)pair * NC + c) * 64 + dk], S, l); }
        p.o1[gid] = S; } break;
    case OP_GLA3: {
        const int NC = p.i0; const int NP = dm.B * 4 * NC; const int u = NV_UNI((int)(gid / 128)) + (p.i1 ? NP : 0), col = (int)(gid % 128); int s, h, r0, L; const float* sin; float* sout = nullptr;
        if (u < NP) { s = u / (4 * NC); h = (u / NC) % 4; const int c = u % NC; r0 = seq_row0(dm, s) + c * 64; L = dm.T - c * 64; L = L > 64 ? 64 : L; sin = p.d + (size_t)u * 8192 + col; }
        else { const int q = u - NP; s = dm.B + q / 4; h = q % 4; r0 = seq_row0(dm, s); L = dm.DT; sin = p.c + (((size_t)(s - dm.B) * 4 + h) * 64) * 128 + col; sout = p.o2 + (((size_t)(s - dm.B) * 4 + h) * 64) * 128 + col; }
        float S[64];
#pragma unroll
        for (int k = 0; k < 64; ++k) S[k] = sin[(size_t)k * 128];
        for (int t = 0; t < L; ++t) {
            const float* pr = p.a + (size_t)(r0 + t) * MIXIN; const float* la = p.b + (size_t)(r0 + t) * 256 + h * 64; const float v = pr[C_V + h * 128 + col]; float o = 0.f;
#pragma unroll
            for (int k = 0; k < 64; ++k) { if ((k & 7) == 0) NV_FENCE(); S[k] = fmaf(la[k], S[k], pr[C_K + h * 64 + k] * v); o = fmaf(pr[C_Q + h * 64 + k] * 0.125f, S[k], o); }
            p.o0[(size_t)(r0 + t) * 512 + h * 128 + col] = o;
        }
        if (sout) {
#pragma unroll
            for (int k = 0; k < 64; ++k) sout[(size_t)k * 128] = S[k]; } } break;
    case OP_LRU1: {
        const int NC = p.i0; const int u = (int)(gid / 512), c = (int)(gid % 512); const int s = u / NC, ch = u % NC; const int r0 = seq_row0(dm, s) + ch * 64; int L = dm.T - ch * 64; L = L > 64 ? 64 : L; float hh = 0.f, ap = 1.f;
#pragma unroll 16
        for (int t = 0; t < L; ++t) { const size_t ix = (size_t)(r0 + t) * 512 + c; const float a = p.a[ix]; hh = fmaf(a, hh, p.b[ix]); ap *= a; }
        p.o0[gid] = ap; p.o1[gid] = hh; } break;
    case OP_LRU2: {
        const int NC = p.i0; const int s = (int)(gid / 512), c = (int)(gid % 512); float hh = 0.f;
#pragma unroll 8
        for (int ch = 0; ch < NC; ++ch) { const size_t ix = ((size_t)s * NC + ch) * 512 + c; const float l = p.o0[ix]; p.o0[ix] = hh; hh = fmaf(p.a[ix], hh, l); }
        p.o1[gid] = hh; } break;
    case OP_LRU3: {
        const int NC = p.i0; const int u = (int)(gid / 512), c = (int)(gid % 512); const int NP = dm.B * NC; int r0, L; float hh; float* hout = nullptr;
        if (u < NP) { const int s = u / NC, ch = u % NC; r0 = seq_row0(dm, s) + ch * 64; L = dm.T - ch * 64; L = L > 64 ? 64 : L; hh = 0.f;
            for (int k0 = 0; k0 < ch; k0 += 16) { float la[16], lb[16];
#pragma unroll
                for (int k = 0; k < 16; ++k) { int kk = k0 + k; kk = kk < ch ? kk : ch - 1; const size_t ix = ((size_t)s * NC + kk) * 512 + c; la[k] = p.f[ix]; lb[k] = p.e[ix]; }
#pragma unroll
                for (int k = 0; k < 16; ++k) if (k0 + k < ch) hh = fmaf(la[k], hh, lb[k]); }
            if (ch == NC - 1) hout = p.o1 + (size_t)s * 512 + c; }
        else { const int q = u - NP; r0 = seq_row0(dm, dm.B + q); L = dm.DT; hh = p.d[(size_t)q * 512 + c]; hout = p.o2 + (size_t)q * 512 + c; }
        for (int t0 = 0; t0 < L; t0 += 16) {
            float av[16], bv[16], gv[16];
#pragma unroll
            for (int k = 0; k < 16; ++k) { int t = t0 + k; t = t < L ? t : L - 1; const size_t r = (size_t)(r0 + t); av[k] = p.a[r * 512 + c]; bv[k] = p.b[r * 512 + c]; gv[k] = p.c[r * MIXIN + C_GB + c]; }
#pragma unroll
            for (int k = 0; k < 16; ++k) if (t0 + k < L) { const size_t r = (size_t)(r0 + t0 + k); hh = fmaf(av[k], hh, bv[k]); ((nvbf*)p.o0)[r * 1024 + 512 + c] = nv_f2bf(hh * nv_gelu(gv[k])); } }
        if (hout) *hout = hh; } break;
    case OP_EMBED4: {
        const int D4 = D / 4; const int row = (int)(gid / D4), c = (int)(gid % D4) * 4; const float* src;
        if (row < dm.B * dm.T) { const int bb = row / dm.T, t = row % dm.T; src = t < 16 ? p.c + (size_t)t * D + c : p.a + ((size_t)bb * (dm.T - 16) + (t - 16)) * D + c; } else src = p.b + (size_t)(row - dm.B * dm.T) * D + c;
        const NvF4 v = *(const NvF4*)src; NvU2 w; w.x = nv_f2bf(v.x) | ((unsigned)nv_f2bf(v.y) << 16); w.y = nv_f2bf(v.z) | ((unsigned)nv_f2bf(v.w) << 16); *(NvU2*)((nvbf*)p.o1 + (size_t)row * D + c) = w; } break;
    case OP_YOUT4: {
        const int D4 = D / 4; const int row = (int)(gid / D4), c = (int)(gid % D4) * 4; const NvU2 w_ = *(const NvU2*)((const nvbf*)p.a + (size_t)row * D + c); NvF4 v; v.x = nv_bf2f((nvbf)(w_.x & 0xffffu)); v.y = nv_bf2f((nvbf)(w_.x >> 16)); v.z = nv_bf2f((nvbf)(w_.y & 0xffffu)); v.w = nv_bf2f((nvbf)(w_.y >> 16));
        if (row < dm.B * dm.T) { const int bb = row / dm.T, t = row % dm.T; if (t >= 16) *(NvF4*)(p.o0 + ((size_t)bb * (dm.T - 16) + (t - 16)) * D + c) = v; }
        else *(NvF4*)(p.o0 + ((size_t)dm.B * (dm.T - 16) + (row - dm.B * dm.T)) * D + c) = v; } break;
    case OP_MIX8: {
        const int D8 = D / 8; const int row = (int)(gid / D8), c = (int)(gid % D8) * 8; int s, t; row_to_seq(dm, row, s, t); const float* x = p.a + (size_t)row * D + c; float xp[8];
        if (t > 0) { for (int i = 0; i < 8; ++i) xp[i] = x[i - D]; } else if (s < dm.B) { for (int i = 0; i < 8; ++i) xp[i] = 0.f; } else { for (int i = 0; i < 8; ++i) xp[i] = p.b[(size_t)(s - dm.B) * D + c + i]; }
        unsigned w[4];
#pragma unroll
        for (int i = 0; i < 4; ++i) { const float lo = x[2 * i] + (xp[2 * i] - x[2 * i]) * p.c[c + 2 * i], hi = x[2 * i + 1] + (xp[2 * i + 1] - x[2 * i + 1]) * p.c[c + 2 * i + 1]; w[i] = nv_f2bf(lo) | ((unsigned)nv_f2bf(hi) << 16); }
        NvU4 o; o.x = w[0]; o.y = w[1]; o.z = w[2]; o.w = w[3]; *(NvU4*)((nvbf*)p.o0 + (size_t)row * D + c) = o; } break;
    case OP_MIX6: {
        const int D8 = D / 8, Q = (dm.M + 3) / 4; const int row0 = (int)(gid / D8), c = (int)(gid % D8) * 8; NvU4 xw[4], pw[4]; NvF4 sh0[4], sh1[4]; int kind[4];
#pragma unroll
        for (int q = 0; q < 4; ++q) { int row = row0 + q * Q; row = row < dm.M ? row : row0; int s, t; row_to_seq(dm, row, s, t); const nvbf* x = (const nvbf*)p.a + (size_t)row * D + c;
            kind[q] = t > 0 ? 0 : (s < dm.B ? 1 : 2); xw[q] = *(const NvU4*)x; pw[q] = *(const NvU4*)(x - (t > 0 ? D : 0));
            const float* sp = p.b + (size_t)(s >= dm.B ? s - dm.B : 0) * D + c; sh0[q] = *(const NvF4*)sp; sh1[q] = *(const NvF4*)(sp + 4); }
        NvF4 mu0[6], mu1[6];
#pragma unroll
        for (int m = 0; m < 6; ++m) { mu0[m] = *(const NvF4*)(p.c + (size_t)m * D + c); mu1[m] = *(const NvF4*)(p.c + (size_t)m * D + c + 4); }
#pragma unroll
        for (int q = 0; q < 4; ++q) { const int row = row0 + q * Q; if (row < dm.M) { float xv[8], dx[8]; const unsigned xs[4] = {xw[q].x, xw[q].y, xw[q].z, xw[q].w}, ps[4] = {pw[q].x, pw[q].y, pw[q].z, pw[q].w};
            const float shv[8] = {sh0[q].x, sh0[q].y, sh0[q].z, sh0[q].w, sh1[q].x, sh1[q].y, sh1[q].z, sh1[q].w};
#pragma unroll
            for (int i = 0; i < 4; ++i) { xv[2 * i] = nv_bf2f((nvbf)(xs[i] & 0xffffu)); xv[2 * i + 1] = nv_bf2f((nvbf)(xs[i] >> 16)); const float p0 = nv_bf2f((nvbf)(ps[i] & 0xffffu)), p1 = nv_bf2f((nvbf)(ps[i] >> 16));
                const float q0 = kind[q] == 0 ? p0 : (kind[q] == 1 ? 0.f : shv[2 * i]), q1 = kind[q] == 0 ? p1 : (kind[q] == 1 ? 0.f : shv[2 * i + 1]); dx[2 * i] = q0 - xv[2 * i]; dx[2 * i + 1] = q1 - xv[2 * i + 1]; }
#pragma unroll
            for (int m = 0; m < 6; ++m) { const float mv[8] = {mu0[m].x, mu0[m].y, mu0[m].z, mu0[m].w, mu1[m].x, mu1[m].y, mu1[m].z, mu1[m].w}; unsigned w[4];
#pragma unroll
                for (int i = 0; i < 4; ++i) w[i] = nv_f2bf(xv[2 * i] + dx[2 * i] * mv[2 * i]) | ((unsigned)nv_f2bf(xv[2 * i + 1] + dx[2 * i + 1] * mv[2 * i + 1]) << 16);
                NvU4 o; o.x = w[0]; o.y = w[1]; o.z = w[2]; o.w = w[3]; *(NvU4*)((nvbf*)p.o0 + (size_t)m * (size_t)p.i1 * 1024 + (size_t)row * D + c) = o; } } } } break;
    case OP_CONV4: {
        const int Q = (dm.M + 3) / 4; const int row0 = (int)(gid / 128), c = (int)(gid % 128) * 4; const NvF4 bias = *(const NvF4*)(p.d + c); NvF4 wt[4]; for (int i = 0; i < 4; ++i) wt[i] = *(const NvF4*)(p.c + i * 512 + c);
        NvF4 xv[4][4]; int ok[4];
#pragma unroll
        for (int q = 0; q < 4; ++q) { int row = row0 + q * Q; ok[q] = row < dm.M; row = ok[q] ? row : row0; int s, t; row_to_seq(dm, row, s, t);
#pragma unroll
            for (int i = 0; i < 4; ++i) { const int j = t + i; const int sb = s >= dm.B ? s - dm.B : 0, jb = j < 3 ? j : 0;
                const float* src = j >= 3 ? p.a + (size_t)(row - t + (j - 3)) * MIXIN + C_XB + c : p.b + ((size_t)sb * 3 + jb) * 512 + c; const float msk = (j >= 3 || s >= dm.B) ? 1.f : 0.f;
                const NvF4 v = *(const NvF4*)src; xv[q][i].x = v.x * msk; xv[q][i].y = v.y * msk; xv[q][i].z = v.z * msk; xv[q][i].w = v.w * msk; } }
#pragma unroll
        for (int q = 0; q < 4; ++q) if (ok[q]) { const int row = row0 + q * Q; NvF4 o = bias;
#pragma unroll
            for (int i = 0; i < 4; ++i) { o.x = fmaf(xv[q][i].x, wt[i].x, o.x); o.y = fmaf(xv[q][i].y, wt[i].y, o.y); o.z = fmaf(xv[q][i].z, wt[i].z, o.z); o.w = fmaf(xv[q][i].w, wt[i].w, o.w); }
            NvU2 w; w.x = nv_f2bf(o.x) | ((unsigned)nv_f2bf(o.y) << 16); w.y = nv_f2bf(o.z) | ((unsigned)nv_f2bf(o.w) << 16); *(NvU2*)((nvbf*)p.o1 + (size_t)row * 512 + c) = w; } } break;
    case OP_CVT8: {
        const int K8 = p.i2 / 8; const int row = (int)(gid / K8), k = (int)(gid % K8) * 8; unsigned w[4] = {0u, 0u, 0u, 0u};
        if (row < dm.M && k < p.i0) { const float* sp = p.a + (size_t)row * p.i1 + k;
#pragma unroll
            for (int i = 0; i < 4; ++i) { float lo = sp[2 * i], hi = sp[2 * i + 1]; if (p.i3 == 1) { lo = NV_TANH(lo); hi = NV_TANH(hi); } else if (p.i3 == 2) { lo = nv_sigmoid(lo); hi = nv_sigmoid(hi); } w[i] = nv_f2bf(lo) | ((unsigned)nv_f2bf(hi) << 16); } }
        NvU4 o; o.x = w[0]; o.y = w[1]; o.z = w[2]; o.w = w[3]; *(NvU4*)((nvbf*)p.o0 + (size_t)row * p.i2 + k) = o; } break;
    case OP_WGATE: {
        const int ch = (int)(gid % 64), n = (int)(gid / 64), pn = n >> 8, within = n & 127, isx = (n >> 7) & 1, c = pn * 128 + within, nb = c >> 6, e = c & 63, k0 = ch * 8; const float* w = isx ? p.b : p.a; NvU4 o; o.x = o.y = o.z = o.w = 0u;
        if ((k0 >> 6) == nb) { float v[8];
#pragma unroll
            for (int i = 0; i < 8; ++i) v[i] = w[((size_t)nb * 64 + ((k0 + i) & 63)) * 64 + e];
            o.x = nv_f2bf(v[0]) | ((unsigned)nv_f2bf(v[1]) << 16); o.y = nv_f2bf(v[2]) | ((unsigned)nv_f2bf(v[3]) << 16); o.z = nv_f2bf(v[4]) | ((unsigned)nv_f2bf(v[5]) << 16); o.w = nv_f2bf(v[6]) | ((unsigned)nv_f2bf(v[7]) << 16); }
        *(NvU4*)((nvbf*)p.o0 + (size_t)n * 512 + k0) = o;
        if (ch == 0 && n < 512) p.o1[n] = -8.f * nv_softplus(-p.c[n]); } break;
    case OP_LRUG2: {
        const int row = (int)(gid / 512), c = (int)(gid % 512), pn = c >> 7, within = c & 127; const nvbf* x = (const nvbf*)p.a + (size_t)row * 512; const nvbf* wa_ = (const nvbf*)p.b + (size_t)(pn * 256 + within) * 512; const nvbf* wx_ = wa_ + (size_t)128 * 512; float ga = 0.f, gx = 0.f;
        for (int k = 0; k < 512; ++k) { const float xv = nv_bf2f(x[k]); ga = fmaf(xv, nv_bf2f(wa_[k]), ga); gx = fmaf(xv, nv_bf2f(wx_[k]), gx); }
        const float gate_a = nv_sigmoid(ga + p.c[c]), gate_x = nv_sigmoid(gx + p.d[c]); const float log_at = gate_a * p.e[c];
        p.o0[gid] = NV_EXP(log_at); p.o1[gid] = sqrtf(-expm1f(2.f * log_at)) * (gate_x * nv_bf2f(((const nvbf*)p.f)[gid])); } break;
    case OP_LOGA4: {
        const int row = (int)(gid / 64), c = (int)(gid % 64) * 4; const float* gl = p.a + (size_t)row * MIXIN + C_GLR; NvF4 z = *(const NvF4*)(p.c + c);
#pragma unroll
        for (int r4 = 0; r4 < 4; ++r4) { const NvF4 g = *(const NvF4*)(gl + 4 * r4);
            const NvF4 w0 = *(const NvF4*)(p.b + (4 * r4 + 0) * 256 + c), w1 = *(const NvF4*)(p.b + (4 * r4 + 1) * 256 + c), w2 = *(const NvF4*)(p.b + (4 * r4 + 2) * 256 + c), w3 = *(const NvF4*)(p.b + (4 * r4 + 3) * 256 + c);
            z.x = fmaf(g.x, w0.x, z.x); z.y = fmaf(g.x, w0.y, z.y); z.z = fmaf(g.x, w0.z, z.z); z.w = fmaf(g.x, w0.w, z.w); z.x = fmaf(g.y, w1.x, z.x); z.y = fmaf(g.y, w1.y, z.y); z.z = fmaf(g.y, w1.z, z.z); z.w = fmaf(g.y, w1.w, z.w);
            z.x = fmaf(g.z, w2.x, z.x); z.y = fmaf(g.z, w2.y, z.y); z.z = fmaf(g.z, w2.z, z.z); z.w = fmaf(g.z, w2.w, z.w); z.x = fmaf(g.w, w3.x, z.x); z.y = fmaf(g.w, w3.y, z.y); z.z = fmaf(g.w, w3.z, z.z); z.w = fmaf(g.w, w3.w, z.w); }
        NvF4 o; o.x = NV_EXP(-nv_softplus(-z.x) * (1.f / 16.f)); o.y = NV_EXP(-nv_softplus(-z.y) * (1.f / 16.f)); o.z = NV_EXP(-nv_softplus(-z.z) * (1.f / 16.f)); o.w = NV_EXP(-nv_softplus(-z.w) * (1.f / 16.f));
        *(NvF4*)(p.o0 + (size_t)row * 256 + c) = o; } break;
    case OP_GLANORM: {
        int row = (int)(gid / 4), h = (int)(gid % 4); const float* o = p.a + (size_t)row * 512 + h * 128; float ss = 0.f;
        for (int c = 0; c < 128; ++c) ss = fmaf(o[c], o[c], ss);
        float rs = 1.f / sqrtf(ss * (1.f / 128.f) + 1e-5f);
        for (int c = 0; c < 128; ++c) { float r = p.b[(size_t)row * MIXIN + C_R + h * 128 + c]; ((nvbf*)p.o0)[(size_t)row * 1024 + h * 128 + c] = nv_f2bf(o[c] * rs * p.c[c] * (r * nv_sigmoid(r))); } } break;
    case OP_CONV: {
        int row = (int)(gid / 512), c = (int)(gid % 512); int s, t; row_to_seq(dm, row, s, t); float acc = p.d[c];
        for (int i = 0; i < 4; ++i) { int j = t + i; float xv;
            if (j < 3) xv = (s < dm.B) ? 0.f : p.b[((size_t)(s - dm.B) * 3 + j) * 512 + c]; else xv = p.a[(size_t)(row - t + (j - 3)) * MIXIN + C_XB + c];
            acc = fmaf(xv, p.c[i * 512 + c], acc); }
        p.o0[gid] = acc; } break;
    case OP_CONVOUT: {
        int s = (int)(gid / 1536), i = (int)((gid / 512) % 3), c = (int)(gid % 512); int L = seq_len(dm, s), r0 = seq_row0(dm, s); int j = L + i; float xv;
        if (j < 3) xv = (s < dm.B) ? 0.f : p.b[((size_t)(s - dm.B) * 3 + j) * 512 + c]; else xv = p.a[(size_t)(r0 + j - 3) * MIXIN + C_XB + c];
        float* o = (s < dm.B) ? PO1 + ((size_t)s * 3 + i) * 512 + c : PO2 + ((size_t)(s - dm.B) * 3 + i) * 512 + c; *o = xv; } break;
    case OP_LRUG: {
        int row = (int)(gid / 512), c = (int)(gid % 512), nb = c / 64, e = c % 64; const float* x = p.a + (size_t)row * 512 + nb * 64; float ga = p.c[c], gx = p.e[c];
        for (int dd = 0; dd < 64; ++dd) { ga = fmaf(x[dd], p.b[((size_t)nb * 64 + dd) * 64 + e], ga); gx = fmaf(x[dd], p.d[((size_t)nb * 64 + dd) * 64 + e], gx); }
        float gate_a = nv_sigmoid(ga), gate_x = nv_sigmoid(gx); float log_at = -8.f * gate_a * nv_softplus(-p.f[c]);
        p.o0[gid] = NV_EXP(log_at); p.o1[gid] = sqrtf(-expm1f(2.f * log_at)) * (gate_x * p.a[(size_t)row * 512 + c]); } break;
    case OP_LRUSCAN: {
        int s = (int)(gid / 512), c = (int)(gid % 512); int r0 = seq_row0(dm, s), L = seq_len(dm, s); float hh = (s < dm.B) ? 0.f : p.d[(size_t)(s - dm.B) * 512 + c];
        for (int t = 0; t < L; ++t) { size_t r = (size_t)(r0 + t); hh = fmaf(p.a[r * 512 + c], hh, p.b[r * 512 + c]); p.o0[r * 1024 + 512 + c] = hh * nv_gelu(p.c[r * MIXIN + C_GB + c]); }
        float* o = (s < dm.B) ? PO1 + (size_t)s * 512 + c : PO2 + (size_t)(s - dm.B) * 512 + c; *o = hh; } break;
    case OP_LNRES: {
        const float alpha = 1.6817928305074292f; nvbf* x = (nvbf*)p.o1 + (size_t)gid * D; const nvbf* y = (const nvbf*)p.a + (size_t)gid * D; float mu = 0.f;
        for (int c = 0; c < D; ++c) mu += alpha * nv_bf2f(x[c]) + nv_bf2f(y[c]);
        mu /= D; float var = 0.f;
        for (int c = 0; c < D; ++c) { float v = alpha * nv_bf2f(x[c]) + nv_bf2f(y[c]) - mu; var = fmaf(v, v, var); }
        float rs = 1.f / sqrtf(var / D + 1e-5f);
        for (int c = 0; c < D; ++c) { const float o = (alpha * nv_bf2f(x[c]) + nv_bf2f(y[c]) - mu) * rs * p.b[c] + p.c[c]; x[c] = nv_f2bf(o);
            if (p.o2) { unsigned char* f8 = (unsigned char*)p.o2 + (size_t)gid * 2 * D; const float xs = fminf(fmaxf(o * 16.f, -448.f), 448.f); const unsigned hc = nv_f2e4m3(xs); f8[c] = (unsigned char)hc; f8[D + c] = (unsigned char)nv_f2e4m3(xs - nv_e4m32f(hc)); } } } break;
    case OP_MIX: {
        int row = (int)(gid / D), c = (int)(gid % D); int s, t; row_to_seq(dm, row, s, t); float x = p.a[gid];
        float xp = t > 0 ? p.a[gid - D] : ((s < dm.B) ? 0.f : p.b[(size_t)(s - dm.B) * D + c]);
        ((nvbf*)p.o0)[gid] = nv_f2bf(x + (xp - x) * p.c[c]); } break;
    case OP_SHIFTOUT: {
        int s = (int)(gid / D), c = (int)(gid % D); float v = nv_bf2f(((const nvbf*)p.a)[(size_t)(seq_row0(dm, s) + seq_len(dm, s) - 1) * D + c]);
        float* o = (s < dm.B) ? PO1 + (size_t)s * D + c : PO2 + (size_t)(s - dm.B) * D + c; *o = v; } break;
    case OP_RWKVPREP: {
        int row = (int)(gid / dm.RH), h = (int)(gid % dm.RH); size_t base = (size_t)row * D + h * 64; float ss = 0.f;
        for (int k = 0; k < 64; ++k) { float kv = p.o0[base + k] * p.d[h * 64 + k]; ss = fmaf(kv, kv, ss); }
        float inv = 1.f / fmaxf(sqrtf(ss), 1e-12f);
        for (int k = 0; k < 64; ++k) { int c = h * 64 + k; size_t ix = base + k;
            float w = -nv_softplus(-(p.a[c] + p.o1[ix])) - 0.5f; float dec = NV_EXP(-NV_EXP(w));
            float a = nv_sigmoid(p.b[c] + p.o2[ix]);
            float v = p.o3[ix]; if (p.i0) v = v + (p.o5[ix] - v) * nv_sigmoid(p.c[c] + p.f[ix]); else p.o5[ix] = v;
            float k0 = p.o0[ix]; const float kk = k0 * p.d[c] * inv; p.o4[ix] = -kk; p.o0[ix] = k0 * (1.f + (a - 1.f) * p.e[c]); p.o1[ix] = dec; p.o2[ix] = kk * a; p.o3[ix] = v; } } break;
    case OP_WKVF:
    case OP_WKV: {
        int RH = dm.RH; int s = p.i0 + (int)(gid / (RH * 64)), h = (int)((gid / 64) % RH), vr = (int)(gid % 64); float S[64];
        const float* sin = (s < dm.B) ? nullptr : p.g + (((size_t)(s - dm.B) * RH + h) * 64 + vr) * 64;
#pragma unroll
        for (int k = 0; k < 64; ++k) S[k] = sin ? sin[k] : 0.f;
        int r0 = seq_row0(dm, s), L = seq_len(dm, s);
        for (int t = 0; t < L; ++t) { size_t base = (size_t)(r0 + t) * D + h * 64; float sa = 0.f;
#pragma unroll
            for (int k = 0; k < 64; ++k) { if ((k & 7) == 0) NV_FENCE(); sa = fmaf(S[k], p.f[base + k], sa); }
            float vv = p.d[base + vr], y = 0.f;
#pragma unroll
            for (int k = 0; k < 64; ++k) { if ((k & 7) == 0) NV_FENCE(); S[k] = fmaf(S[k], p.b[base + k], fmaf(sa, p.e[base + k], vv * p.c[base + k])); y = fmaf(S[k], p.a[base + k], y); }
            p.o0[base + vr] = y; }
        float* so = (s < dm.B) ? PO1 + (((size_t)s * RH + h) * 64 + vr) * 64 : PO2 + (((size_t)(s - dm.B) * RH + h) * 64 + vr) * 64;
#pragma unroll
        for (int k = 0; k < 64; ++k) so[k] = S[k]; } break;
    case OP_RWKVPOST: {
        int row = (int)(gid / dm.RH), h = (int)(gid % dm.RH); size_t base = (size_t)row * D + h * 64; float mu = 0.f, bon = 0.f;
        for (int k = 0; k < 64; ++k) { mu += p.a[base + k]; bon = fmaf(p.b[base + k] * p.c[base + k], p.f[h * 64 + k], bon); }
        mu *= (1.f / 64.f); float var = 0.f;
        for (int k = 0; k < 64; ++k) { float dlt = p.a[base + k] - mu; var = fmaf(dlt, dlt, var); }
        float rs = 1.f / sqrtf(var * (1.f / 64.f) + 64e-5f);
        for (int k = 0; k < 64; ++k) { int c = h * 64 + k; float y = (p.a[base + k] - mu) * rs * p.g[c] + p.h[c] + bon * p.d[base + k]; ((nvbf*)p.o0)[base + k] = nv_f2bf(y * p.e[base + k]); } } break;
    case OP_PRM: {
        const int m = (int)(gid / D), c = (int)(gid % D); const float* src = m == 0 ? p.a : m == 1 ? p.b : m == 2 ? p.c : m == 3 ? p.d : m == 4 ? p.e : p.f; p.o0[gid] = src ? src[c] : 0.f; } break;
    case OP_WKVP: {
        const int RH = dm.RH; const int s = (int)(gid / (RH * 64)), h = (int)((gid / 64) % RH), vr = (int)(gid % 64); float S[64];
        const float* sin = (s < dm.B) ? nullptr : p.o5 + (((size_t)(s - dm.B) * RH + h) * 64 + vr) * 64;
        for (int k = 0; k < 64; ++k) S[k] = sin ? sin[k] : 0.f;
        const float* w0 = p.h + h * 64; const float* a0 = p.h + D + h * 64; const float* v0 = p.h + 2 * D + h * 64; const float* k_k = p.h + 3 * D + h * 64; const float* k_a = p.h + 4 * D + h * 64; const float* r_k = p.h + 5 * D + h * 64;
        const int r0 = seq_row0(dm, s), L = seq_len(dm, s); const nvbf* bR = (const nvbf*)p.a; const nvbf* bK = (const nvbf*)p.b; const nvbf* bWL = (const nvbf*)p.c; const nvbf* bAL = (const nvbf*)p.d; const nvbf* bV = (const nvbf*)p.e; const nvbf* bVG = (const nvbf*)p.f;
        for (int t = 0; t < L; ++t) { const size_t base = (size_t)(r0 + t) * D + h * 64; float ss = 0.f;
            for (int k = 0; k < 64; ++k) { const float kv = nv_bf2f(bK[base + k]) * k_k[k]; ss = fmaf(kv, kv, ss); }
            const float inv = 1.f / fmaxf(sqrtf(ss), 1e-12f);
            float vv = nv_bf2f(bV[base + vr]); if (p.i0) vv = vv + (nv_bf2f(((const nvbf*)p.g)[base + vr]) - vv) * nv_sigmoid(v0[vr] + nv_bf2f(bVG[base + vr]));
            float sa = 0.f, bon = 0.f, dec[64], bb[64], k2[64];
            for (int k = 0; k < 64; ++k) { const float k0 = nv_bf2f(bK[base + k]); const float kk = k0 * k_k[k] * inv; const float a = nv_sigmoid(a0[k] + nv_bf2f(bAL[base + k]));
                dec[k] = NV_EXP(-0.6065306597126334f * nv_sigmoid(w0[k] + nv_bf2f(bWL[base + k])));
                bb[k] = kk * a; k2[k] = k0 * (1.f + (a - 1.f) * k_a[k]); sa = fmaf(S[k], -kk, sa); bon = fmaf(nv_bf2f(bR[base + k]) * k2[k], r_k[k], bon); }
            float y = 0.f;
            for (int k = 0; k < 64; ++k) { S[k] = fmaf(S[k], dec[k], fmaf(sa, bb[k], vv * k2[k])); y = fmaf(S[k], nv_bf2f(bR[base + k]), y); }
            ((nvbf*)p.o0)[base + vr] = nv_f2bf(y); ((nvbf*)p.o3)[base + vr] = nv_f2bf(vv); if (vr == 0) p.o4[(size_t)(r0 + t) * RH + h] = bon; }
        float* so = (s < dm.B) ? PO1 + (((size_t)s * RH + h) * 64 + vr) * 64 : PO2 + (((size_t)(s - dm.B) * RH + h) * 64 + vr) * 64;
        for (int k = 0; k < 64; ++k) so[k] = S[k]; } break;
    case OP_POST2: {
        const int row = (int)(gid / dm.RH), h = (int)(gid % dm.RH); const size_t base = (size_t)row * D + h * 64; const nvbf* ya = (const nvbf*)p.a; const nvbf* vf = (const nvbf*)p.c; float mu = 0.f;
        for (int k = 0; k < 64; ++k) mu += nv_bf2f(ya[base + k]);
        mu *= (1.f / 64.f); float var = 0.f;
        for (int k = 0; k < 64; ++k) { const float dlt = nv_bf2f(ya[base + k]) - mu; var = fmaf(dlt, dlt, var); }
        const float rs = 1.f / sqrtf(var * (1.f / 64.f) + 64e-5f), bon = p.d[gid];
        for (int k = 0; k < 64; ++k) { const int c = h * 64 + k; const float y = (nv_bf2f(ya[base + k]) - mu) * rs * p.e[c] + p.f[c] + bon * nv_bf2f(vf[base + k]); ((nvbf*)p.o0)[base + k] = nv_f2bf(y * nv_bf2f(((const nvbf*)p.b)[base + k])); } } break;
    case OP_QNORM: {
        float* q = p.o0 + (size_t)gid * 256; float mu = 0.f;
        for (int c = 0; c < 256; ++c) mu += q[c];
        mu *= (1.f / 256.f); float var = 0.f;
        for (int c = 0; c < 256; ++c) { float dlt = q[c] - mu; var = fmaf(dlt, dlt, var); }
        float rs = 1.f / sqrtf(var * (1.f / 256.f) + 1e-5f);
        for (int c = 0; c < 256; ++c) q[c] = (q[c] - mu) * rs; } break;
    case OP_SCORES: {
        int row = (int)(gid / 2048), r = (int)(gid % 2048), h = r / 256, half = (r / 128) & 1, key = r % 128;
        const float* q = p.a + (size_t)row * 2048 + h * 256 + half * 128; const float* kv = p.b + (((size_t)h * 2 + half) * 128 + key) * 128; float acc = 0.f;
        for (int dd = 0; dd < 128; ++dd) acc = fmaf(q[dd], kv[dd], acc);
        p.o0[gid] = acc; } break;
    case OP_TOPK: {
        const float* sc = p.a + (size_t)gid * 256; float tv[16]; int ti[16]; float* tmpv = p.o2 + (size_t)gid * 32; int* tmpi = (int*)p.o3 + (size_t)gid * 32;
        for (int half = 0; half < 2; ++half) {
#pragma unroll
            for (int j = 0; j < 16; ++j) { tv[j] = -3.0e38f; ti[j] = 0; }
            for (int k = 0; k < 128; ++k) NV_INS16(tv, ti, sc[half * 128 + k], k);
#pragma unroll
            for (int j = 0; j < 16; ++j) { tmpv[half * 16 + j] = tv[j]; tmpi[half * 16 + j] = ti[j]; }
        }
#pragma unroll
        for (int j = 0; j < 16; ++j) { tv[j] = -3.0e38f; ti[j] = 0; }
        for (int i = 0; i < 16; ++i) for (int j = 0; j < 16; ++j) NV_INS16(tv, ti, tmpv[i] + tmpv[16 + j], tmpi[i] * 128 + tmpi[16 + j]);
        float den = 0.f, ev[16];
#pragma unroll
        for (int j = 0; j < 16; ++j) { ev[j] = NV_EXP(tv[j] - tv[0]); den += ev[j]; }
        float inv = 1.f / den;
#pragma unroll
        for (int j = 0; j < 16; ++j) { p.o0[(size_t)gid * 16 + j] = ev[j] * inv; ((int*)p.o1)[(size_t)gid * 16 + j] = ti[j]; } } break;
    case OP_PACT1: {
        size_t pr = (size_t)(gid / 16); int part = (int)(gid % 16); int row = (int)(pr / 128); int e = ((const int*)p.d)[pr]; int w = D / 16;
        const float* u = p.b + (size_t)e * D + part * w; const float* x = p.a + (size_t)row * D + part * w; float acc = 0.f;
        for (int c = 0; c < w; ++c) acc = fmaf(u[c], x[c], acc);
        p.o0[gid] = acc; } break;
    case OP_PACT2: {
        float acc = 0.f; for (int i = 0; i < 16; ++i) acc += p.a[(size_t)gid * 16 + i];
        p.o0[gid] = p.c[gid] * nv_gelu(acc); } break;
    case OP_POUT: {
        int row = (int)(gid / D), c = (int)(gid % D); float acc = 0.f;
        for (int i = 0; i < 128; ++i) acc = fmaf(p.a[(size_t)row * 128 + i], p.c[(size_t)((const int*)p.b)[(size_t)row * 128 + i] * D + c], acc);
        p.o0[gid] = acc; } break;
    case OP_YOUT: {
        int row = (int)(gid / D), c = (int)(gid % D);
        if (row < dm.B * dm.T) { int bb = row / dm.T, t = row % dm.T; if (t >= 16) p.o0[((size_t)bb * (dm.T - 16) + (t - 16)) * D + c] = p.a[gid]; }
        else p.o0[((size_t)dm.B * (dm.T - 16) + (row - dm.B * dm.T)) * D + c] = p.a[gid]; } break;
    case OP_WT: {
        const int N = p.i0, K = p.i1, Np = p.i3, Kp = p.i4; const long long per8 = (long long)Np * (Kp / 8); const int bt = (int)(gid / per8); const long long r = gid % per8; const int k0 = (int)(r / Np) * 8, nn = (int)(r % Np);
        unsigned w[4];
#pragma unroll
        for (int i = 0; i < 4; ++i) { float lo = 0.f, hi = 0.f; if (nn < N) { if (k0 + 2 * i < K) lo = p.a[((size_t)bt * K + k0 + 2 * i) * p.i2 + nn]; if (k0 + 2 * i + 1 < K) hi = p.a[((size_t)bt * K + k0 + 2 * i + 1) * p.i2 + nn]; } w[i] = nv_f2bf(lo) | ((unsigned)nv_f2bf(hi) << 16); }
        NvU4 o; o.x = w[0]; o.y = w[1]; o.z = w[2]; o.w = w[3];
        *(NvU4*)((nvbf*)p.o0 + (size_t)bt * Np * Kp + (size_t)nn * Kp + k0) = o; } break;
    case OP_CVT: {
        const int Kp = p.i2; const int row = (int)(gid / Kp), k = (int)(gid % Kp); float v = 0.f;
        if (row < dm.M && k < p.i0) { v = p.a[(size_t)row * p.i1 + k]; if (p.i3 == 1) v = NV_TANH(v); else if (p.i3 == 2) v = nv_sigmoid(v); }
        ((nvbf*)p.o0)[gid] = nv_f2bf(v); } break;
    case OP_FGEMM: {
        const int N = p.i0; const int m = (int)(gid / N), nn = (int)(gid % N); const nvbf* A = (const nvbf*)p.a + (size_t)m * p.i2 + ((p.i6 & 2) ? (nn / 256) * 256 : 0); const nvbf* Bt = (const nvbf*)p.b + (size_t)nn * p.i3; float acc = 0.f;
        for (int k = 0; k < p.i1; ++k) acc = fmaf(nv_bf2f(A[k]), nv_bf2f(Bt[k]), acc);
        if (p.i6 & 1) ((nvbf*)p.o0)[(size_t)m * p.i4 + nn] = nv_f2bf(acc); else p.o0[(size_t)m * p.i4 + nn] = acc; } break;
    case OP_CVTTAB: {
        const NvF4 v0 = *(const NvF4*)(p.a + gid * 8), v1 = *(const NvF4*)(p.a + gid * 8 + 4); NvU4 o;
        o.x = nv_f2bf(v0.x) | ((unsigned)nv_f2bf(v0.y) << 16); o.y = nv_f2bf(v0.z) | ((unsigned)nv_f2bf(v0.w) << 16); o.z = nv_f2bf(v1.x) | ((unsigned)nv_f2bf(v1.y) << 16); o.w = nv_f2bf(v1.z) | ((unsigned)nv_f2bf(v1.w) << 16);
        *(NvU4*)((nvbf*)p.o0 + gid * 8) = o; } break;
    case OP_CVTTAB8: {
        const float sc = (float)(1 << p.i0); const float* sp = p.a + gid * 16; unsigned w[4];
#pragma unroll
        for (int q = 0; q < 4; ++q) { const NvF4 v = *(const NvF4*)(sp + 4 * q); w[q] = nv_f2e4m3(v.x * sc) | (nv_f2e4m3(v.y * sc) << 8) | (nv_f2e4m3(v.z * sc) << 16) | (nv_f2e4m3(v.w * sc) << 24); }
        NvU4 o; o.x = w[0]; o.y = w[1]; o.z = w[2]; o.w = w[3]; *(NvU4*)((unsigned char*)p.o0 + gid * 16) = o; } break;
    case OP_CVTTAB8S: {
        const float sc = (float)(1 << p.i0); const int per = D / 16; const int e = (int)(gid / per), c0 = (int)(gid % per) * 16; const float* sp = p.a + (size_t)e * D + c0; unsigned w[4];
#pragma unroll
        for (int q = 0; q < 4; ++q) { const NvF4 v = *(const NvF4*)(sp + 4 * q);
#if defined(__HIP_DEVICE_COMPILE__)
            int pk = __builtin_amdgcn_cvt_pk_fp8_f32(v.x * sc, v.y * sc, 0, false); pk = __builtin_amdgcn_cvt_pk_fp8_f32(v.z * sc, v.w * sc, pk, true); w[q] = (unsigned)pk;
#else
            w[q] = nv_f2e4m3(v.x * sc) | (nv_f2e4m3(v.y * sc) << 8) | (nv_f2e4m3(v.z * sc) << 16) | (nv_f2e4m3(v.w * sc) << 24);
#endif
        }
        NvU4 o; o.x = w[0]; o.y = w[1]; o.z = w[2]; o.w = w[3]; *(NvU4*)((unsigned char*)p.o0 + ((size_t)(c0 >> 7) * 16384 + e) * 128 + (c0 & 127)) = o; } break;
    case OP_PACTS: {
        const long long NP = (long long)dm.M * 128; const int sl = (int)(gid / NP); const long long pr = gid % NP; const int row = (int)(pr / 128); const int e = ((const int*)p.d)[pr] & p.i0;
        const unsigned char* u = (const unsigned char*)p.b + ((size_t)sl * 16384 + e) * 128; const unsigned char* x = (const unsigned char*)p.a + (size_t)row * 2 * D + sl * 128; float acc = 0.f;
        for (int c = 0; c < 128; ++c) acc = fmaf(nv_e4m32f(u[c]), nv_e4m32f(x[c]) + nv_e4m32f(x[D + c]), acc);
        ((nvbf*)p.o0)[gid] = nv_f2bf(acc * (1.f / 16.f)); } break;
    case OP_PRED: {
        const long long NP = (long long)dm.M * 128; const size_t e0 = (size_t)gid * 4; float a0 = 0.f, a1 = 0.f, a2 = 0.f, a3 = 0.f;
#pragma unroll 8
        for (int sl = 0; sl < p.i0; ++sl) { const NvU2 w = *(const NvU2*)((const nvbf*)p.a + (size_t)sl * NP + e0); a0 += nv_bf2f((nvbf)(w.x & 0xffffu)); a1 += nv_bf2f((nvbf)(w.x >> 16)); a2 += nv_bf2f((nvbf)(w.y & 0xffffu)); a3 += nv_bf2f((nvbf)(w.y >> 16)); }
        const NvF4 g = *(const NvF4*)(p.c + e0); NvF4 o; o.x = g.x * nv_gelu(a0 * (1.f / 128.f)); o.y = g.y * nv_gelu(a1 * (1.f / 128.f)); o.z = g.z * nv_gelu(a2 * (1.f / 128.f)); o.w = g.w * nv_gelu(a3 * (1.f / 128.f));
        *(NvF4*)(p.o0 + e0) = o; } break;
    case OP_POUTS: {
        const int row = (int)(gid / D), c = (int)(gid % D); const unsigned char* vb = (const unsigned char*)p.c + (size_t)(c >> 7) * 16384 * 128 + (c & 127); float acc = 0.f;
        for (int i = 0; i < 128; ++i) acc = fmaf(p.a[(size_t)row * 128 + i] * (1.f / 64.f), nv_e4m32f(vb[(size_t)((const int*)p.b)[(size_t)row * 128 + i] * 128]), acc);
        ((nvbf*)p.o0)[gid] = nv_f2bf(acc); } break;
    case OP_KEYS: {
        const int ch = (int)(gid % 32), hr = (int)(gid / 32), h = hr / 256, nrow = hr % 256, half = nrow >> 7, k0 = ch * 8; const float* src = p.a + (((size_t)h * 2 + half) * 128 + (nrow & 127)) * 128;
        NvU4 o; o.x = o.y = o.z = o.w = 0u;
        if ((k0 >> 7) == half) { const NvF4 v0 = *(const NvF4*)(src + (k0 & 127)), v1 = *(const NvF4*)(src + (k0 & 127) + 4);
            o.x = nv_f2bf(v0.x) | ((unsigned)nv_f2bf(v0.y) << 16); o.y = nv_f2bf(v0.z) | ((unsigned)nv_f2bf(v0.w) << 16); o.z = nv_f2bf(v1.x) | ((unsigned)nv_f2bf(v1.y) << 16); o.w = nv_f2bf(v1.z) | ((unsigned)nv_f2bf(v1.w) << 16); }
        *(NvU4*)((nvbf*)p.o0 + ((size_t)h * 256 + nrow) * 256 + k0) = o;
        if (ch == 0) { float ks = 0.f;
#pragma unroll 8
            for (int k = 0; k < 128; k += 4) { const NvF4 v = *(const NvF4*)(src + k); ks += (nv_bf2f(nv_f2bf(v.x)) + nv_bf2f(nv_f2bf(v.y))) + (nv_bf2f(nv_f2bf(v.z)) + nv_bf2f(nv_f2bf(v.w))); }
            p.o1[hr] = ks; } } break;
    case OP_TOPK2: {
        const int h = (int)(gid % 8); const nvbf* sc = (const nvbf*)p.a + (size_t)gid * 256; const nvbf* q = (const nvbf*)p.b + (size_t)gid * 256; const float* ksum = p.c + h * 256; float mu = 0.f;
        for (int c = 0; c < 256; ++c) mu += nv_bf2f(q[c]);
        mu *= (1.f / 256.f); float var = 0.f;
        for (int c = 0; c < 256; ++c) { float dlt = nv_bf2f(q[c]) - mu; var = fmaf(dlt, dlt, var); }
        const float rs = 1.f / sqrtf(var * (1.f / 256.f) + 1e-5f);
        float tv[16]; int ti[16]; float* tmpv = p.o2 + (size_t)gid * 32; int* tmpi = (int*)p.o3 + (size_t)gid * 32;
        for (int half = 0; half < 2; ++half) {
#pragma unroll
            for (int j = 0; j < 16; ++j) { tv[j] = -3.0e38f; ti[j] = 0; }
            for (int k = 0; k < 128; ++k) NV_INS16(tv, ti, rs * (nv_bf2f(sc[half * 128 + k]) - mu * ksum[half * 128 + k]), k);
#pragma unroll
            for (int j = 0; j < 16; ++j) { tmpv[half * 16 + j] = tv[j]; tmpi[half * 16 + j] = ti[j]; }
        }
#pragma unroll
        for (int j = 0; j < 16; ++j) { tv[j] = -3.0e38f; ti[j] = 0; }
        for (int i = 0; i < 16; ++i) for (int j = 0; j < 16; ++j) NV_INS16(tv, ti, tmpv[i] + tmpv[16 + j], tmpi[i] * 128 + tmpi[16 + j]);
        float den = 0.f, ev[16];
#pragma unroll
        for (int j = 0; j < 16; ++j) { ev[j] = NV_EXP(tv[j] - tv[0]); den += ev[j]; }
        float inv = 1.f / den;
#pragma unroll
        for (int j = 0; j < 16; ++j) { p.o0[(size_t)gid * 16 + j] = ev[j] * inv; ((int*)p.o1)[(size_t)gid * 16 + j] = ti[j]; } } break;
    case OP_PACT: {
        const int row = (int)(gid / 128); const int e = ((const int*)p.d)[gid]; const unsigned char* u = (const unsigned char*)p.b + (size_t)e * D; const nvbf* x = (const nvbf*)p.a + (size_t)row * D; float acc = 0.f;
        for (int c = 0; c < D; ++c) acc = fmaf(nv_e4m32f(u[c]), nv_bf2f(x[c]), acc);
        p.o0[gid] = p.c[gid] * nv_gelu(acc * (1.f / 128.f)); } break;
#if defined(HOST_TEST)
    case OP_POUTLN: {
        const float alpha = 1.6817928305074292f; float* x = p.o0 + (size_t)gid * D; std::vector<float> y(D, 0.f);
        for (int i = 0; i < 128; ++i) { const float cf = p.a[(size_t)gid * 128 + i] * (1.f / 64.f); const unsigned char* v = (const unsigned char*)p.c + (size_t)((const int*)p.b)[(size_t)gid * 128 + i] * D; for (int c = 0; c < D; ++c) y[c] = fmaf(cf, nv_e4m32f(v[c]), y[c]); }
        float mu = 0.f; for (int c = 0; c < D; ++c) { y[c] = alpha * x[c] + y[c]; mu += y[c]; }
        mu /= D; float var = 0.f; for (int c = 0; c < D; ++c) { float dlt = y[c] - mu; var = fmaf(dlt, dlt, var); }
        const float rs = 1.f / sqrtf(var / D + 1e-5f);
        for (int c = 0; c < D; ++c) { const float o = (y[c] - mu) * rs * p.d[c] + p.e[c]; x[c] = o; ((nvbf*)p.o1)[(size_t)gid * D + c] = nv_f2bf(o);
            if (p.o2) { unsigned char* f8 = (unsigned char*)p.o2 + (size_t)gid * 2 * D; const float xs = fminf(fmaxf(o * 16.f, -448.f), 448.f); const unsigned hc = nv_f2e4m3(xs); f8[c] = (unsigned char)hc; f8[D + c] = (unsigned char)nv_f2e4m3(xs - nv_e4m32f(hc)); } } } break;
#endif
    default: break;
    }
}

struct NvIO { const float* const* in; float* out; char* ws; size_t ws_size; };
template <class Launch> HD void nv_forward(const NvIO& io, const Dm& dm, Launch&& launch) {
    const int D = dm.D, M = dm.M, B = dm.B, DB = dm.DB, RH = dm.RH; const size_t MD = (size_t)M * D;
    float* y_prompt = io.out; float* y_sample = y_prompt + (size_t)B * (dm.T - 16) * D; float* p_gla = y_sample + (size_t)DB * dm.DT * D;
    float* p_h = p_gla + (size_t)2 * B * 4 * 64 * 128; float* p_conv = p_h + (size_t)2 * B * 512; float* p_rwkv = p_conv + (size_t)2 * B * 3 * 512;
    float* p_shift = p_rwkv + (size_t)2 * B * RH * 4096; float* s_gla = p_shift + (size_t)2 * B * D; float* s_h = s_gla + (size_t)2 * DB * 4 * 64 * 128;
    float* s_conv = s_h + (size_t)2 * DB * 512; float* s_rwkv = s_conv + (size_t)2 * DB * 3 * 512; float* s_shift = s_rwkv + (size_t)2 * DB * RH * 4096;
    float* w = (float*)io.ws; size_t off = 0; auto take = [&](size_t n) __attribute__((always_inline)) { float* r = w + off; off += (n + 63) & ~(size_t)63; return r; };
    float* X = take(MD > (size_t)nv_rup(M, 256) * 512 ? MD : (size_t)nv_rup(M, 256) * 512); float* VFIRST = take(MD); float* MOUT = take(MD);
    auto mk = [&](int code, long long n) __attribute__((always_inline)) { Op o{}; o.code = code; o.n = n; return o; };
    const int Mp = nv_rup(M, 256), Dp = nv_rup(D, 256), Dk = nv_rup(D, 128);
    auto takeh = [&](size_t n) __attribute__((always_inline)) { return (nvbf*)take((n + 1) / 2); };
    const size_t ABFN = (size_t)Mp * 1024 > (size_t)Mp * Dk ? (size_t)Mp * 1024 : (size_t)Mp * Dk; nvbf* ABF = takeh(ABFN + (size_t)Mp * D);
    const size_t SZ_WIN = (size_t)2816 * Dk, SZ_WOUT = (size_t)Dp * 1024, SZ_DD = (size_t)Dp * Dk, SZ_DN = (size_t)256 * Dk, SZ_UP = (size_t)Dp * 128, SZ_WQ = (size_t)2048 * Dk;
    nvbf* WT_WIN = takeh(2 * SZ_WIN); nvbf* WT_WOUT = takeh(2 * SZ_WOUT); nvbf* WT_WR = takeh(2 * SZ_DD); nvbf* WT_WK = takeh(2 * SZ_DD); nvbf* WT_WV = takeh(2 * SZ_DD); nvbf* WT_WO = takeh(2 * SZ_DD);
    nvbf* WT_W1 = takeh(2 * SZ_DN); nvbf* WT_W2 = takeh(2 * SZ_UP); nvbf* WT_A1 = takeh(2 * SZ_DN); nvbf* WT_A2 = takeh(2 * SZ_UP); nvbf* WT_G1 = takeh(2 * SZ_DN); nvbf* WT_G2 = takeh(2 * SZ_UP);
    nvbf* WT_V1 = takeh(SZ_DN); nvbf* WT_V2 = takeh(SZ_UP); nvbf* WT_WQ = takeh(4 * SZ_WQ); nvbf* WT_WG = takeh((size_t)2 * 1024 * 512); float* SPL = take(2 * 512); float* PRM = take((size_t)2 * 6 * D);
    nvbf* UB = takeh((size_t)16384 * D / 2); nvbf* VB = takeh((size_t)16384 * D / 2); nvbf* KB = takeh((size_t)8 * 256 * 256); float* KSUM = take(8 * 256);
    const size_t scratch0 = off;
    auto nb = [&](Op o) __attribute__((always_inline)) { o.code |= OPF_NOBAR; launch(o); };
    auto wt = [&](const float* W, int K, int N, int batch, nvbf* dst) __attribute__((always_inline)) { const int Np = nv_rup(N, 256), Kp = nv_rup(K, 128); Op o = mk(OP_WT, (long long)batch * Np * (Kp / 8)); o.a = W; o.o0 = (float*)dst; o.i0 = N; o.i1 = K; o.i2 = N; o.i3 = Np; o.i4 = Kp; nb(o); };
    wt(io.in[10], D, MIXIN, 2, WT_WIN); wt(io.in[21], 1024, D, 2, WT_WOUT); wt(io.in[23], D, D, 2, WT_WR); wt(io.in[24], D, D, 2, WT_WK); wt(io.in[25], D, D, 2, WT_WV); wt(io.in[26], D, D, 2, WT_WO);
    wt(io.in[28], D, 64, 2, WT_W1); wt(io.in[29], 64, D, 2, WT_W2); wt(io.in[31], D, 64, 2, WT_A1); wt(io.in[32], 64, D, 2, WT_A2); wt(io.in[36], D, 128, 2, WT_G1); wt(io.in[37], 128, D, 2, WT_G2);
    wt(io.in[34], D, 32, 1, WT_V1); wt(io.in[35], 32, D, 1, WT_V2); wt(io.in[43], D, 2048, 4, WT_WQ);
    for (int jj = 0; jj < 2; ++jj) { Op o = mk(OP_PRM, (long long)6 * D); o.a = io.in[27] + (size_t)jj * D; o.b = io.in[30] + (size_t)jj * D; o.c = jj > 0 ? io.in[33] + (size_t)(jj - 1) * D : nullptr; o.d = io.in[38] + (size_t)jj * D; o.e = io.in[39] + (size_t)jj * D; o.f = io.in[40] + (size_t)jj * RH * 64; o.o0 = PRM + (size_t)jj * 6 * D; nb(o); }
    for (int jj = 0; jj < 2; ++jj) { Op o = mk(OP_WGATE, 1024 * 64); o.a = io.in[16] + (size_t)jj * 8 * 64 * 64; o.b = io.in[18] + (size_t)jj * 8 * 64 * 64; o.c = io.in[20] + (size_t)jj * 512; o.o0 = (float*)(WT_WG + (size_t)jj * 1024 * 512); o.o1 = SPL + (size_t)jj * 512; nb(o); }
    auto fgemm = [&](const nvbf* Wt, float* C, int ldc, int N, int K, int bf16out = 0, const float* Aop = nullptr, bool nobar_ = false) __attribute__((always_inline)) {
        const int Kp = nv_rup(K, 128), Np = nv_rup(N, 256);
        Op o = mk(OP_FGEMM, (long long)M * N); o.a = Aop ? Aop : (const float*)ABF; o.b = (const float*)Wt; o.o0 = C; o.i0 = N; o.i1 = Kp; o.i2 = Kp; o.i3 = Kp; o.i4 = ldc; o.i5 = Np; o.i6 = bf16out; if (nobar_) nb(o); else launch(o); };
    auto gemm = [&](const float* A, int lda, const nvbf* Wt, float* C, int ldc, int N, int K, int act) __attribute__((always_inline)) {
        const int Kp = nv_rup(K, 128);
        { Op o = mk(OP_CVT8, (long long)Mp * (Kp / 8)); o.a = A; o.o0 = (float*)ABF; o.i0 = K; o.i1 = lda; o.i2 = Kp; o.i3 = act; launch(o); }
        fgemm(Wt, C, ldc, N, K); };
    { Op o = mk(OP_EMBED4, (long long)MD / 4); o.a = io.in[0]; o.b = io.in[1]; o.c = io.in[7]; o.o0 = X; o.o1 = (float*)ABF; launch(o); }
    const float* const w_outer = w; float* const out_outer = io.out;
    for (int layer = 0; layer < 4; ++layer) {
        float* wl = (float*)w_outer; float* ol = out_outer; NV_LAUNDER(wl); NV_LAUNDER(ol);
#define NV_RB(T, v) T const v##_rb = (T)((char*)wl + ((const char*)(v) - (const char*)w_outer))
#define NV_RO(v) float* const v##_rb = (float*)((char*)ol + ((const char*)(v) - (const char*)out_outer))
        NV_RB(float*, X); NV_RB(float*, VFIRST); NV_RB(float*, MOUT); NV_RB(nvbf*, ABF); NV_RB(nvbf*, WT_WIN); NV_RB(nvbf*, WT_WOUT); NV_RB(nvbf*, WT_WR); NV_RB(nvbf*, WT_WK); NV_RB(nvbf*, WT_WV); NV_RB(nvbf*, WT_WO);
        NV_RB(nvbf*, WT_W1); NV_RB(nvbf*, WT_W2); NV_RB(nvbf*, WT_A1); NV_RB(nvbf*, WT_A2); NV_RB(nvbf*, WT_G1); NV_RB(nvbf*, WT_G2); NV_RB(nvbf*, WT_V1); NV_RB(nvbf*, WT_V2); NV_RB(nvbf*, WT_WQ); NV_RB(nvbf*, WT_WG);
        NV_RB(float*, SPL); NV_RB(float*, PRM); NV_RB(nvbf*, UB); NV_RB(nvbf*, VB); NV_RB(nvbf*, KB); NV_RB(float*, KSUM);
        NV_RO(p_gla); NV_RO(p_h); NV_RO(p_conv); NV_RO(p_rwkv); NV_RO(p_shift); NV_RO(s_gla); NV_RO(s_h); NV_RO(s_conv); NV_RO(s_rwkv); NV_RO(s_shift);
#undef NV_RB
#undef NV_RO
        { float* const X = X_rb; float* const VFIRST = VFIRST_rb; float* const MOUT = MOUT_rb; nvbf* const ABF = ABF_rb; nvbf* const WT_WIN = WT_WIN_rb; nvbf* const WT_WOUT = WT_WOUT_rb; nvbf* const WT_WR = WT_WR_rb; nvbf* const WT_WK = WT_WK_rb;
          nvbf* const WT_WV = WT_WV_rb; nvbf* const WT_WO = WT_WO_rb; nvbf* const WT_W1 = WT_W1_rb; nvbf* const WT_W2 = WT_W2_rb; nvbf* const WT_A1 = WT_A1_rb; nvbf* const WT_A2 = WT_A2_rb; nvbf* const WT_G1 = WT_G1_rb; nvbf* const WT_G2 = WT_G2_rb;
          nvbf* const WT_V1 = WT_V1_rb; nvbf* const WT_V2 = WT_V2_rb; nvbf* const WT_WQ = WT_WQ_rb; nvbf* const WT_WG = WT_WG_rb; float* const SPL = SPL_rb; float* const PRM = PRM_rb; nvbf* const UB = UB_rb; nvbf* const VB = VB_rb; nvbf* const KB = KB_rb; float* const KSUM = KSUM_rb;
          float* const p_gla = p_gla_rb; float* const p_h = p_h_rb; float* const p_conv = p_conv_rb; float* const p_rwkv = p_rwkv_rb; float* const p_shift = p_shift_rb; float* const s_gla = s_gla_rb; float* const s_h = s_h_rb; float* const s_conv = s_conv_rb;
          float* const s_rwkv = s_rwkv_rb; float* const s_shift = s_shift_rb; float* const w = wl; (void)SPL; (void)WT_WG; (void)VFIRST;
        const int j = layer / 2; off = scratch0;
        if (layer % 2 == 0) {
            float* PROJ = take((size_t)M * MIXIN); float* LOGA = take((size_t)M * 256); float* O = take((size_t)M * 512); float* MIXO = X;
            float* XC = take((size_t)M * 512); nvbf* XCB = takeh((size_t)Mp * 512); float* AT = take((size_t)M * 512); float* BT = take((size_t)M * 512);
            const int NC = (dm.T + 63) / 64; float* LEND = take((size_t)B * 4 * NC * 8192); float* DEC = take((size_t)B * 4 * NC * 64); float* LA = take((size_t)B * NC * 512); float* LB = take((size_t)B * NC * 512);
            fgemm(WT_WIN + (size_t)j * SZ_WIN, PROJ, MIXIN, MIXIN, D);
            { Op o = mk(OP_LOGA4, (long long)M * 64); o.a = PROJ; o.b = io.in[11] + (size_t)j * 16 * 256; o.c = io.in[12] + (size_t)j * 256; o.o0 = LOGA; nb(o); }
            { Op o = mk(OP_CONV4, (long long)((M + 3) / 4) * 128); o.a = PROJ; o.b = io.in[4] + (size_t)j * DB * 3 * 512; o.c = io.in[14] + (size_t)j * 4 * 512; o.d = io.in[15] + (size_t)j * 512; o.o0 = XC; o.o1 = (float*)XCB; nb(o); }
            { Op o = mk(OP_CONVOUT, (long long)dm.NSEQ * 1536); o.a = PROJ; o.b = io.in[4] + (size_t)j * DB * 3 * 512; o.o1 = p_conv + (size_t)j * B * 3 * 512; o.o2 = s_conv + (size_t)j * DB * 3 * 512; launch(o); }
            { Op o = mk(OP_GLAF, (long long)B * 512); o.a = PROJ; o.b = LOGA; o.o0 = O; o.o1 = p_gla + (size_t)j * B * 4 * 64 * 128; nb(o); }
            { Op o = mk(OP_GLA3, (long long)(DB * 4) * 128); o.a = PROJ; o.b = LOGA; o.c = io.in[2] + (size_t)j * DB * 4 * 64 * 128; o.d = LEND; o.o0 = O; o.o2 = s_gla + (size_t)j * DB * 4 * 64 * 128; o.i0 = NC; o.i1 = 1; nb(o); }
            { Op o = mk(OP_LRUG2, (long long)M * 512); o.a = (const float*)XCB; o.b = (const float*)(WT_WG + (size_t)j * 1024 * 512); o.c = io.in[17] + (size_t)j * 512; o.d = io.in[19] + (size_t)j * 512; o.e = SPL + (size_t)j * 512; o.f = (const float*)XCB; o.o0 = AT; o.o1 = BT; launch(o); }
            { Op o = mk(OP_GLANORM, (long long)M * 4); o.a = O; o.b = PROJ; o.c = io.in[13] + (size_t)j * 128; o.o0 = MIXO; nb(o); }
            { Op o = mk(OP_LRU1, (long long)B * NC * 512); o.a = AT; o.b = BT; o.o0 = LA; o.o1 = LB; o.i0 = NC; launch(o); }
            { Op o = mk(OP_LRU3, (long long)(B * NC + DB) * 512); o.a = AT; o.b = BT; o.c = PROJ; o.d = io.in[3] + (size_t)j * DB * 512; o.e = LB; o.f = LA; o.o0 = MIXO; o.o1 = p_h + (size_t)j * B * 512; o.o2 = s_h + (size_t)j * DB * 512; o.i0 = NC; launch(o); }
            fgemm(WT_WOUT + (size_t)j * SZ_WOUT, MOUT, D, D, 1024, 1, X, true);
        } else {
            float* Y = take(MD); float* R = take(MD); float* K = take(MD); float* V = take(MD); float* G = take(MD); float* KK = take(MD);
            const size_t XMSZ = (size_t)Mp * D;
            float* WAV = take(3 * MD > 3 * XMSZ ? 3 * MD : 3 * XMSZ); float* Wd = WAV; float* Aa = WAV + MD; float* Vg = WAV + 2 * MD; nvbf* XM6 = (nvbf*)WAV;
            float* BON = take((size_t)M * RH); float* HLw = take((size_t)M * 64); float* HLa = take((size_t)M * 64); float* HLg = take((size_t)M * 128); float* HLv = take((size_t)M * 32);
            nvbf* ABw = takeh((size_t)Mp * 128); nvbf* ABa = takeh((size_t)Mp * 128); nvbf* ABg = takeh((size_t)Mp * 128); nvbf* ABv = takeh((size_t)Mp * 128);
            const float* shin = io.in[6] + (size_t)j * DB * D; const float* mu = io.in[22] + (size_t)j * 6 * D;
            { Op o = mk(OP_SHIFTOUT, (long long)dm.NSEQ * D); o.a = (const float*)ABF; o.o1 = p_shift + (size_t)j * B * D; o.o2 = s_shift + (size_t)j * DB * D; nb(o); }
            { Op o = mk(OP_MIX6, (long long)((M + 3) / 4) * (D / 8)); o.a = (const float*)ABF; o.b = shin; o.c = mu; o.o0 = (float*)XM6; o.i1 = (int)(XMSZ / 1024); launch(o); }
            auto gg = [&](const nvbf* A, const nvbf* Wt, float* C, int ldc, int N, int K, bool last, int bf16out = 0) __attribute__((always_inline)) { const int Kp = nv_rup(K, 128), Np = nv_rup(N, 256);
                Op o = mk(OP_FGEMM, (long long)M * N); o.a = (const float*)A; o.b = (const float*)Wt; o.o0 = C; o.i0 = N; o.i1 = Kp; o.i2 = Kp; o.i3 = Kp; o.i4 = ldc; o.i5 = Np; o.i6 = bf16out; if (!last) o.code |= OPF_GROUP; launch(o); };
            gg(XM6 + 0 * XMSZ, WT_WR + (size_t)j * SZ_DD, R, D, D, D, false, 1); gg(XM6 + 2 * XMSZ, WT_WK + (size_t)j * SZ_DD, K, D, D, D, false, 1); gg(XM6 + 3 * XMSZ, WT_WV + (size_t)j * SZ_DD, V, D, D, D, false, 1);
            gg(XM6 + 1 * XMSZ, WT_W1 + (size_t)j * SZ_DN, HLw, 64, 64, D, false); gg(XM6 + 4 * XMSZ, WT_A1 + (size_t)j * SZ_DN, HLa, 64, 64, D, false);
            if (j > 0) gg(XM6 + 3 * XMSZ, WT_V1 + (size_t)(j - 1) * SZ_DN, HLv, 32, 32, D, false);
            gg(XM6 + 5 * XMSZ, WT_G1 + (size_t)j * SZ_DN, HLg, 128, 128, D, true);
            auto cv = [&](const float* A, int K, nvbf* dst, int act, bool last) __attribute__((always_inline)) { Op o = mk(OP_CVT8, (long long)Mp * 16); o.a = A; o.o0 = (float*)dst; o.i0 = K; o.i1 = K; o.i2 = 128; o.i3 = act; if (last) launch(o); else nb(o); };
            cv(HLw, 64, ABw, 1, false); cv(HLa, 64, ABa, 0, false); if (j > 0) cv(HLv, 32, ABv, 0, false); cv(HLg, 128, ABg, 2, true);
            gg(ABw, WT_W2 + (size_t)j * SZ_UP, Wd, D, D, 64, false, 1); gg(ABa, WT_A2 + (size_t)j * SZ_UP, Aa, D, D, 64, false, 1); if (j > 0) gg(ABv, WT_V2 + (size_t)(j - 1) * SZ_UP, Vg, D, D, 32, false, 1); gg(ABg, WT_G2 + (size_t)j * SZ_UP, G, D, D, 128, true, 1);
            { Op o = mk(OP_WKVP, (long long)dm.NSEQ * RH * 64); o.a = R; o.b = K; o.c = Wd; o.d = Aa; o.e = V; o.f = Vg; o.g = VFIRST; o.h = PRM + (size_t)j * 6 * D; o.o0 = Y; o.o1 = p_rwkv + (size_t)j * B * RH * 4096; o.o2 = s_rwkv + (size_t)j * DB * RH * 4096;
              o.o3 = j > 0 ? KK : VFIRST; o.o4 = BON; o.o5 = (float*)(io.in[5] + (size_t)j * DB * RH * 4096); o.i0 = j > 0 ? 1 : 0; launch(o); }
            { Op o = mk(OP_POST2, (long long)M * RH); o.a = Y; o.b = G; o.c = j > 0 ? KK : VFIRST; o.d = BON; o.e = io.in[41] + (size_t)j * D; o.f = io.in[42] + (size_t)j * D; o.o0 = X; launch(o); }
            fgemm(WT_WO + (size_t)j * SZ_DD, MOUT, D, D, D, 1, X, true);
        }
        { Op o = mk(OP_CVTTAB8S, (long long)16384 * D / 16); o.a = io.in[45] + (size_t)layer * 16384 * D; o.o0 = (float*)UB; o.i0 = 7; o.i6 = (Mp / 256) * (nv_rup(D, 256) / 256); launch(o); }
        { Op o = mk(OP_LNRES, M); o.a = MOUT; o.b = io.in[8] + (size_t)(layer * 2 + 0) * D; o.c = io.in[9] + (size_t)(layer * 2 + 0) * D; o.o0 = X; o.o1 = (float*)ABF; o.o2 = (float*)(ABF + ABFN); launch(o); }
        off = scratch0;
        { nvbf* Q = takeh((size_t)Mp * 2048); float* SC = take((size_t)M * 2048); float* GATE = take((size_t)M * 128); float* EIDX = take((size_t)M * 128); float* TMPV = take((size_t)M * 256); float* TMPI = take((size_t)M * 256);
          float* COEF = take((size_t)M * 128);
          { Op o = mk(OP_FGEMM, (long long)M * 2048); o.a = (const float*)ABF; o.b = (const float*)(WT_WQ + (size_t)layer * SZ_WQ); o.o0 = (float*)Q; o.i0 = 2048; o.i1 = Dk; o.i2 = Dk; o.i3 = Dk; o.i4 = 2048; o.i5 = 2048; o.i6 = 1; nb(o); }
          { Op o = mk(OP_CVTTAB8S, (long long)16384 * D / 16); o.a = io.in[46] + (size_t)layer * 16384 * D; o.o0 = (float*)VB; o.i0 = 6; o.i6 = (Mp / 256) * 8; nb(o); }
          { Op o = mk(OP_KEYS, 8 * 256 * 32); o.a = io.in[44] + (size_t)layer * 8 * 2 * 128 * 128; o.o0 = (float*)KB; o.o1 = KSUM; launch(o); }
          { Op o = mk(OP_FGEMM, (long long)M * 2048); o.a = (const float*)Q; o.b = (const float*)KB; o.o0 = SC; o.i0 = 2048; o.i1 = 256; o.i2 = 2048; o.i3 = 256; o.i4 = 2048; o.i5 = 2048; o.i6 = 3; launch(o); }
          { Op o = mk(OP_TOPK2, (long long)M * 8); o.a = SC; o.b = (const float*)Q; o.c = KSUM; o.o0 = GATE; o.o1 = EIDX; o.o2 = TMPV; o.o3 = TMPI; launch(o); }
          { const int NS = D / 128; float* PART = take((size_t)NS * M * 128); float* YBUF = take(MD);
            #ifdef PROBE_EMASK
            { Op o = mk(OP_PACTS, (long long)NS * M * 128); o.a = (const float*)(ABF + ABFN); o.b = (const float*)UB; o.d = EIDX; o.o0 = PART; o.i0 = PROBE_EMASK; launch(o); }
#endif
            { Op o = mk(OP_PACTS, (long long)NS * M * 128); o.a = (const float*)(ABF + ABFN); o.b = (const float*)UB; o.d = EIDX; o.o0 = PART; o.i0 = 16383; launch(o); }
            { Op o = mk(OP_PRED, (long long)M * 32); o.a = PART; o.c = GATE; o.o0 = COEF; o.i0 = NS; launch(o); }
            { Op o = mk(OP_POUTS, (long long)MD); o.a = COEF; o.b = EIDX; o.c = (const float*)VB; o.o0 = YBUF; launch(o); }
            { Op o = mk(OP_LNRES, M); o.a = YBUF; o.b = io.in[8] + (size_t)(layer * 2 + 1) * D; o.c = io.in[9] + (size_t)(layer * 2 + 1) * D; o.o0 = X; o.o1 = (float*)ABF; launch(o); } } }
        }
    }
    { Op o = mk(OP_YOUT4, (long long)MD / 4); o.a = (const float*)ABF; o.o0 = y_prompt; launch(o); }
    (void)y_sample;
}

#include <cstdint>
namespace pg8 {
#define PG8_LAS __attribute__((address_space(3)))
typedef unsigned short bf16_t;
typedef short bf16x8 __attribute__((ext_vector_type(8)));
typedef float f32x4 __attribute__((ext_vector_type(4)));
typedef unsigned u32x4 __attribute__((ext_vector_type(4)));
constexpr int BM = 256, BK = 64, HALF = 128, HTB = HALF * BK * 2  , STAGE_BYTES = 8 * HTB, NXCD = 8, WGM = 8;

__host__ __device__ __forceinline__ int lds_byte(int r, int c) { const int st = (r >> 4) * 2 + (c >> 5), rr = r & 15, cc = c & 31, ob = rr * 64 + cc * 2; return st * 1024 + (ob ^ (((ob >> 9) & 1) << 5)); }
__host__ __device__ __forceinline__ void stage_rc(int b, int& R, int& C) { const int st = b / 1024, sb = b % 1024, swz = sb ^ (((sb >> 9) & 1) << 5); R = (st >> 1) * 16 + swz / 64; C = (st & 1) * 32 + (swz % 64) / 2; }
__host__ __device__ __forceinline__ int perm32(int rho) { const int n = rho >> 4, i = rho & 15; return 8 * (i >> 2) + 4 * n + (i & 3); }

struct Unit { int pm, pn, grp, pad_; const char* A; const char* B; };
struct Gemm { const bf16_t* A; const bf16_t* Bt; int M, N, K, lda, ldb; };

struct StaticOrder {
    int nM, nN, nwg, G, c; const char* A; const char* B; size_t tsA, tsB, acs;
    __host__ __device__ void init(const Gemm& g, int G_, int c_) { nM = g.M / BM; nN = g.N / BM; nwg = nM * nN; G = G_; c = c_; A = (const char*)g.A; B = (const char*)g.Bt; tsA = (size_t)BM * g.lda * 2; tsB = (size_t)BM * g.ldb * 2; acs = 0; }
    __host__ __device__ bool next(int i, Unit& u) const {
        const long L = (long)i * G + c; if (L >= nwg) return false;
        int wgid = (int)L; { const int q = nwg / NXCD, r = nwg % NXCD, xcd = wgid % NXCD, off = wgid / NXCD; wgid = (xcd < r ? xcd * (q + 1) : r * (q + 1) + (xcd - r) * q) + off; }
        const int nig = WGM * nN, gid = wgid / nig, fm = gid * WGM, gsz = (nM - fm) < WGM ? (nM - fm) : WGM;
        u.pm = fm + ((wgid % nig) % gsz); u.pn = (wgid % nig) / gsz; u.grp = 0; u.pad_ = 0; u.A = A + (size_t)u.pm * tsA + (size_t)u.pn * acs; u.B = B + (size_t)u.pn * tsB; return true;
    }
    __device__ __forceinline__ void a_ready(const Unit&) const {}
    __device__ __forceinline__ void done(const Unit&) const {}
};

template <class Epi, class Sched, bool ALIGN_EPI = false, bool SP2 = false>
__device__ __forceinline__ void gemm_phase(PG8_LAS unsigned char* lds, const Gemm g, const Sched& S, const Epi& E) {
    int tid_raw = threadIdx.x; asm volatile("" : "+v"(tid_raw));
    const int tid = tid_raw, wid = __builtin_amdgcn_readfirstlane(tid >> 6), lane = tid & 63, wr = wid >> 2, wc = wid & 3, fr = lane & 15, fq = lane >> 4;
    const int K = g.K, nt = K / BK;
    unsigned voffA[2], voffB[2];
#pragma unroll
    for (int i = 0; i < 2; ++i) { int R, C; stage_rc(tid * 16 + i * 8192, R, C); const int Rb = Epi::PERM ? ((R & ~31) + perm32(R & 31)) : R;
        voffA[i] = (unsigned)(R * g.lda + C) * 2u; voffB[i] = (unsigned)(Rb * g.ldb + C) * 2u; }
    const size_t kstep = (size_t)(BK * 2);
    const size_t hstepA = (size_t)HALF * g.lda * 2, hstepB = (size_t)HALF * g.ldb * 2;
    const unsigned ldsw = (unsigned)wid * 1024u;
    const int aoff = lds_byte(wr * 64 + fr, fq * 8), boff = lds_byte(wc * 32 + fr, fq * 8);
#define PG8_SA(b, h) (((b) * 2 + (h)) * HTB)
#define PG8_SB(b, h) ((4 + (b) * 2 + (h)) * HTB)
#define PG8_STAGE(bufoff, gbase, voff) do { _Pragma("unroll") for (int _i = 0; _i < 2; ++_i) \
        __builtin_amdgcn_global_load_lds((const unsigned*)((const char*)(gbase) + (voff)[_i]), (PG8_LAS unsigned*)(lds + (bufoff) + ldsw + _i * 8192), 16, 0, 0); } while (0)
#define PG8_LDA(dst, b, h) do { _Pragma("unroll") for (int m = 0; m < 4; ++m) _Pragma("unroll") for (int k = 0; k < 2; ++k) dst[m][k] = *(const PG8_LAS bf16x8*)(lds + PG8_SA(b, h) + aoff + m * 2048 + k * 1024); } while (0)
#define PG8_LDB(dst, b, h) do { _Pragma("unroll") for (int n = 0; n < 2; ++n) _Pragma("unroll") for (int k = 0; k < 2; ++k) dst[n][k] = *(const PG8_LAS bf16x8*)(lds + PG8_SB(b, h) + boff + n * 2048 + k * 1024); } while (0)
#define PG8_MMA(ai, bj, At, Bt) do { __builtin_amdgcn_s_setprio(1); _Pragma("unroll") for (int m = 0; m < 4; ++m) _Pragma("unroll") for (int n = 0; n < 2; ++n) _Pragma("unroll") for (int k = 0; k < 2; ++k) \
        acc[ai][bj][m][n] = __builtin_amdgcn_mfma_f32_16x16x32_bf16(Bt[n][k], At[m][k], acc[ai][bj][m][n], 0, 0, 0); __builtin_amdgcn_s_setprio(0); } while (0)
#define PG8_WAIT_V(n) asm volatile("s_waitcnt vmcnt(" #n ")" ::: "memory")
#define PG8_WAIT_L(n) asm volatile("s_waitcnt lgkmcnt(" #n ")" ::: "memory")
#define PG8_BAR __builtin_amdgcn_s_barrier()
#define PG8_SCHED __builtin_amdgcn_sched_barrier(0)
    Unit cur, nxt; int ui = 0;
    if (!S.next(0, cur)) return;
    f32x4 acc[2][2][4][2];
#pragma unroll
    for (int a = 0; a < 2; ++a)
#pragma unroll
        for (int b = 0; b < 2; ++b)
#pragma unroll
            for (int m = 0; m < 4; ++m)
#pragma unroll
                for (int n = 0; n < 2; ++n) acc[a][b][m][n] = (f32x4){0.f, 0.f, 0.f, 0.f};
    bf16x8 At[4][2], B0[2][2], B1[2][2];
    const char* cA = cur.A; const char* cB = cur.B;
    S.a_ready(cur);
    if constexpr (SP2) {
        PG8_STAGE(PG8_SB(0, 0), cB, voffB); PG8_STAGE(PG8_SB(0, 1), cB + hstepB, voffB); PG8_STAGE(PG8_SA(0, 0), cA, voffA); PG8_STAGE(PG8_SA(0, 1), cA + hstepA, voffA);
        if (wr == 1) PG8_BAR;
        PG8_WAIT_V(2); PG8_BAR;
        PG8_STAGE(PG8_SB(1, 0), cB + kstep, voffB); PG8_STAGE(PG8_SA(1, 0), cA + kstep, voffA); PG8_STAGE(PG8_SB(1, 1), cB + hstepB + kstep, voffB);
        PG8_WAIT_V(6); PG8_BAR;
    } else {
        PG8_STAGE(PG8_SB(0, 0), cB, voffB); PG8_STAGE(PG8_SA(0, 0), cA, voffA); PG8_STAGE(PG8_SB(0, 1), cB + hstepB, voffB); PG8_STAGE(PG8_SA(0, 1), cA + hstepA, voffA);
        if (wr == 1) PG8_BAR;
        PG8_WAIT_V(4); PG8_BAR;
        PG8_STAGE(PG8_SB(1, 0), cB + kstep, voffB); PG8_STAGE(PG8_SA(1, 0), cA + kstep, voffA); PG8_STAGE(PG8_SB(1, 1), cB + hstepB + kstep, voffB);
        PG8_WAIT_V(6); PG8_BAR;
    }
    for (;;) {
        const bool has_next = S.next(ui + 1, nxt);
        const char* nA = has_next ? nxt.A : cA; const char* nB = has_next ? nxt.B : cB;
        for (int t = 0; t < nt; t += 2) {
            const bool last = (t == nt - 2);
            const char* a1 = cA + (size_t)(t + 1) * kstep;
            const char* a2 = last ? nA : cA + (size_t)(t + 2) * kstep; const char* b2 = last ? nB : cB + (size_t)(t + 2) * kstep;
            const char* a3 = a2 + kstep; const char* b3 = b2 + kstep;
            if (last && has_next) S.a_ready(nxt);
            if constexpr (SP2) {
            PG8_LDB(B0, 0, 0); PG8_LDB(B1, 0, 1); PG8_SCHED; PG8_LDA(At, 0, 0); PG8_STAGE(PG8_SA(1, 1), a1 + hstepA, voffA);
            PG8_WAIT_V(8); PG8_WAIT_L(0); PG8_BAR; PG8_MMA(0, 0, At, B0); PG8_MMA(0, 1, At, B1); PG8_BAR; PG8_SCHED;
            PG8_LDA(At, 0, 1); PG8_STAGE(PG8_SB(0, 0), b2, voffB); PG8_STAGE(PG8_SB(0, 1), b2 + hstepB, voffB); PG8_STAGE(PG8_SA(0, 0), a2, voffA);
            PG8_WAIT_V(8); PG8_WAIT_L(0); PG8_BAR; PG8_MMA(1, 0, At, B0); PG8_MMA(1, 1, At, B1); PG8_BAR; PG8_SCHED;
            PG8_LDB(B0, 1, 0); PG8_LDB(B1, 1, 1); PG8_SCHED; PG8_LDA(At, 1, 0); PG8_STAGE(PG8_SA(0, 1), a2 + hstepA, voffA);
            PG8_WAIT_V(8); PG8_WAIT_L(0); PG8_BAR; PG8_MMA(0, 0, At, B0); PG8_MMA(0, 1, At, B1); PG8_BAR; PG8_SCHED;
            PG8_LDA(At, 1, 1); PG8_STAGE(PG8_SB(1, 0), b3, voffB); PG8_STAGE(PG8_SB(1, 1), b3 + hstepB, voffB); PG8_STAGE(PG8_SA(1, 0), a3, voffA);
            PG8_WAIT_V(8); PG8_WAIT_L(0); PG8_BAR; PG8_MMA(1, 0, At, B0); PG8_MMA(1, 1, At, B1); PG8_BAR; PG8_SCHED;
            } else {
            PG8_LDB(B0, 0, 0); PG8_SCHED; PG8_LDA(At, 0, 0); PG8_STAGE(PG8_SA(1, 1), a1 + hstepA, voffA);
            PG8_WAIT_L(8); PG8_BAR; PG8_WAIT_L(0); PG8_MMA(0, 0, At, B0); PG8_BAR; PG8_SCHED;
            PG8_LDB(B1, 0, 1); PG8_STAGE(PG8_SB(0, 0), b2, voffB);
            PG8_BAR; PG8_WAIT_L(0); PG8_MMA(0, 1, At, B1); PG8_BAR;
            PG8_LDA(At, 0, 1); PG8_STAGE(PG8_SA(0, 0), a2, voffA);
            PG8_BAR; PG8_WAIT_L(0); PG8_MMA(1, 0, At, B0); PG8_BAR; PG8_SCHED;
            PG8_STAGE(PG8_SB(0, 1), b2 + hstepB, voffB);
            PG8_WAIT_V(6); PG8_BAR; PG8_MMA(1, 1, At, B1); PG8_BAR;
            PG8_LDB(B0, 1, 0); PG8_SCHED; PG8_LDA(At, 1, 0); PG8_STAGE(PG8_SA(0, 1), a2 + hstepA, voffA);
            PG8_WAIT_L(8); PG8_BAR; PG8_WAIT_L(0); PG8_MMA(0, 0, At, B0); PG8_BAR; PG8_SCHED;
            PG8_LDB(B1, 1, 1); PG8_STAGE(PG8_SB(1, 0), b3, voffB);
            PG8_BAR; PG8_WAIT_L(0); PG8_MMA(0, 1, At, B1); PG8_BAR;
            PG8_LDA(At, 1, 1); PG8_STAGE(PG8_SA(1, 0), a3, voffA);
            PG8_BAR; PG8_WAIT_L(0); PG8_MMA(1, 0, At, B0); PG8_BAR; PG8_SCHED;
            PG8_STAGE(PG8_SB(1, 1), b3 + hstepB, voffB);
            PG8_WAIT_V(6); PG8_BAR; PG8_MMA(1, 1, At, B1); PG8_BAR;
            }
        }
        if constexpr (ALIGN_EPI) { if (wr == 0) PG8_BAR; }
        if constexpr (!Epi::AFTER_DRAIN) { E(acc, cur, wr, wc, fr, fq); S.done(cur); }
        if (!has_next) break;
#pragma unroll
        for (int a = 0; a < 2; ++a)
#pragma unroll
            for (int b = 0; b < 2; ++b)
#pragma unroll
                for (int m = 0; m < 4; ++m)
#pragma unroll
                    for (int n = 0; n < 2; ++n) acc[a][b][m][n] = (f32x4){0.f, 0.f, 0.f, 0.f};
        cur = nxt; cA = nA; cB = nB; ++ui;
        if constexpr (ALIGN_EPI) { if (wr == 1) PG8_BAR; }
    }
    PG8_WAIT_V(0);
    if constexpr (!ALIGN_EPI) { if (wr == 0) PG8_BAR; }
    PG8_BAR;
    if constexpr (Epi::AFTER_DRAIN) { E.fused(acc, cur, wr, wc, fr, fq, lds, wid, lane); S.done(cur); }
#undef PG8_SA
#undef PG8_SB
#undef PG8_STAGE
#undef PG8_LDA
#undef PG8_LDB
#undef PG8_MMA
#undef PG8_WAIT_V
#undef PG8_WAIT_L
#undef PG8_BAR
#undef PG8_SCHED
}
}
template <class T> __device__ __forceinline__ T* uni_ptr(T* p) {
    unsigned long long v = (unsigned long long)p; unsigned lo = __builtin_amdgcn_readfirstlane((unsigned)v), hi = __builtin_amdgcn_readfirstlane((unsigned)(v >> 32));
    unsigned long long r = ((unsigned long long)hi << 32) | lo; asm volatile("" : "+s"(r)); return (T*)r; }
__device__ __forceinline__ int rfl(int x) { int t = __builtin_amdgcn_readfirstlane(x); asm volatile("" : "+s"(t)); return t; }
namespace pg8 {
__device__ __forceinline__ unsigned cvt_pk_bf16(float lo, float hi) { unsigned r; asm volatile("v_cvt_pk_bf16_f32 %0, %1, %2" : "=v"(r) : "v"(lo), "v"(hi)); return r; }
struct EpiF32 {
    static constexpr bool PERM = false, AFTER_DRAIN = false;
    float* C; int ldc, Mreal, Nreal;
    __device__ __forceinline__ void operator()(const f32x4 (&acc)[2][2][4][2], const Unit& u, int wr, int wc, int fr, int fq) const {
        const int row0 = u.pm * BM + wr * 64 + fr, col0 = u.pn * BM + wc * 32 + 4 * fq;
#pragma unroll
        for (int ai = 0; ai < 2; ++ai)
#pragma unroll
            for (int m = 0; m < 4; ++m) { const int r = row0 + ai * HALF + m * 16; if (r < Mreal) { float* rowp = C + (size_t)r * ldc + col0;
#pragma unroll
                for (int bj = 0; bj < 2; ++bj)
#pragma unroll
                    for (int n = 0; n < 2; ++n) { const int c = col0 + bj * HALF + n * 16; if (c < Nreal) *(f32x4*)(rowp + bj * HALF + n * 16) = acc[ai][bj][m][n]; } } }
    }
};
struct EpiBf16Plain {
    static constexpr bool PERM = true, AFTER_DRAIN = false;
    bf16_t* O; int ldc;
    __device__ __forceinline__ void operator()(const f32x4 (&acc)[2][2][4][2], const Unit& u, int wr, int wc, int fr, int fq) const {
        const int row0 = u.pm * BM + wr * 64 + fr, col0 = u.pn * BM + wc * 32 + 8 * fq;
#pragma unroll
        for (int ai = 0; ai < 2; ++ai)
#pragma unroll
            for (int m = 0; m < 4; ++m) { bf16_t* rowp = O + (size_t)(row0 + ai * HALF + m * 16) * ldc + col0;
#pragma unroll
                for (int bj = 0; bj < 2; ++bj) { const f32x4 v0 = acc[ai][bj][m][0], v1 = acc[ai][bj][m][1]; u32x4 w;
                    w.x = cvt_pk_bf16(v0[0], v0[1]); w.y = cvt_pk_bf16(v0[2], v0[3]); w.z = cvt_pk_bf16(v1[0], v1[1]); w.w = cvt_pk_bf16(v1[2], v1[3]);
                    *(u32x4*)(rowp + bj * HALF) = w; } }
    }
};
struct EpiLru {
    static constexpr bool PERM = false, AFTER_DRAIN = false;
    const float* ba; const float* bx; const float* spl; const bf16_t* XC; float* AT; float* BT; int Mreal;
    __device__ __forceinline__ void operator()(const f32x4 (&acc)[2][2][4][2], const Unit& u, int wr, int wc, int fr, int fq) const {
        const int row0 = u.pm * BM + wr * 64 + fr, ch0 = u.pn * 128 + wc * 32 + 4 * fq;
#pragma unroll
        for (int n = 0; n < 2; ++n) { const int c = ch0 + 16 * n; const f32x4 ba4 = *(const f32x4*)(ba + c), bx4 = *(const f32x4*)(bx + c), sp4 = *(const f32x4*)(spl + c);
#pragma unroll
            for (int ai = 0; ai < 2; ++ai)
#pragma unroll
                for (int m = 0; m < 4; ++m) { const int r = row0 + ai * HALF + m * 16; if (r < Mreal) { const unsigned long long xw_ = *(const unsigned long long*)(XC + (size_t)r * 512 + c); const unsigned xl_ = (unsigned)xw_, xh_ = (unsigned)(xw_ >> 32); const f32x4 xc = {__uint_as_float(xl_ << 16), __uint_as_float(xl_ & 0xffff0000u), __uint_as_float(xh_ << 16), __uint_as_float(xh_ & 0xffff0000u)}; const f32x4 ga = acc[ai][0][m][n] + ba4, gx = acc[ai][1][m][n] + bx4; f32x4 at, bt;
#pragma unroll
                    for (int i = 0; i < 4; ++i) { const float gate_a = __builtin_amdgcn_rcpf(1.f + __expf(-ga[i])), gate_x = __builtin_amdgcn_rcpf(1.f + __expf(-gx[i])); const float la = gate_a * sp4[i]; at[i] = __expf(la); bt[i] = sqrtf(-expm1f(2.f * la)) * (gate_x * xc[i]); }
                    *(f32x4*)(AT + (size_t)r * 512 + c) = at; *(f32x4*)(BT + (size_t)r * 512 + c) = bt; } } }
    }
};
struct GroupOrder {
    const PG8_LAS Op* tab; int ng, nM, G, c; size_t tsA, tsB;
    __device__ __forceinline__ bool next(int i, Unit& u) const {
        int L = i * G + c, g = 0;
        for (; g < ng; ++g) { const int cnt = nM * (__builtin_amdgcn_readfirstlane(tab[g].i5) >> 8); if (L < cnt) break; L -= cnt; }
        if (g >= ng) return false;
        u.pm = L % nM; u.pn = L / nM; u.grp = g; u.pad_ = 0;
        u.A = (const char*)uni_ptr(tab[g].a) + (size_t)u.pm * tsA; u.B = (const char*)uni_ptr(tab[g].b) + (size_t)u.pn * tsB; return true;
    }
    __device__ __forceinline__ void a_ready(const Unit&) const {}
    __device__ __forceinline__ void done(const Unit&) const {}
};
struct EpiGroup {
    static constexpr bool PERM = true, AFTER_DRAIN = false;
    const PG8_LAS Op* tab; int Mreal;
    __device__ __forceinline__ void operator()(const f32x4 (&acc)[2][2][4][2], const Unit& u, int wr, int wc, int fr, int fq) const {
        const int ldc = rfl(tab[u.grp].i4), Nreal = rfl(tab[u.grp].i0), fl = rfl(tab[u.grp].i6);
        if (fl & 1) { const EpiBf16Plain E{(bf16_t*)uni_ptr(tab[u.grp].o0), ldc}; E(acc, u, wr, wc, fr, fq); return; }
        float* C = uni_ptr(tab[u.grp].o0); const int row0 = u.pm * BM + wr * 64 + fr, col0 = u.pn * BM + wc * 32 + 8 * fq;
#pragma unroll
        for (int ai = 0; ai < 2; ++ai)
#pragma unroll
            for (int m = 0; m < 4; ++m) { const int r = row0 + ai * HALF + m * 16; if (r < Mreal) { float* rowp = C + (size_t)r * ldc + col0;
#pragma unroll
                for (int bj = 0; bj < 2; ++bj) { if (col0 + bj * HALF < Nreal) { *(f32x4*)(rowp + bj * HALF) = acc[ai][bj][m][0]; *(f32x4*)(rowp + bj * HALF + 4) = acc[ai][bj][m][1]; } } } }
    }
};
}

#define XB_TMO      128
#define XB_XCNT(j)  (256  + 64 * (j))
#define XB_XSUB(j)  (1280 + 64 * (j))
#define XB_XGEN(j)  (2304 + 64 * (j))
#define XB_TOP      3328
#define XB_TOPGEN   3392
#define XCD_BAR_WORDS 3456
#define XB_SPIN_CAP (1u << 18)
#define LAS __attribute__((address_space(3)))
__device__ __forceinline__ unsigned xb_ld(unsigned* p)              { return __hip_atomic_load(p, __ATOMIC_RELAXED, __HIP_MEMORY_SCOPE_AGENT); }
__device__ __forceinline__ unsigned xb_add(unsigned* p, unsigned v) { return __hip_atomic_fetch_add(p, v, __ATOMIC_RELAXED, __HIP_MEMORY_SCOPE_AGENT); }
__device__ __forceinline__ unsigned xb_xcc_id() { return (unsigned)__builtin_amdgcn_s_getreg((3 << 11) | 20) & 0xFu; }
#define XB_SPIN(cond, bar) do { unsigned _sp = 0; while (cond) { __builtin_amdgcn_s_sleep(1); \
    if ((++_sp & 255u) == 0u) { if (xb_ld(&(bar)[XB_TMO])) break; if (_sp > XB_SPIN_CAP) { atomicAdd(&(bar)[XB_TMO], 1u); break; } } } } while (0)
struct XcdBarrier { unsigned* bar; unsigned x; volatile LAS unsigned* st; };
__device__ __forceinline__ XcdBarrier xcd_barrier_post(unsigned* bar, volatile LAS unsigned* st) {
    XcdBarrier b; b.bar = bar; b.x = xb_xcc_id(); b.st = st;
    if (threadIdx.x == 0) (void)xb_add(&bar[XB_XCNT(b.x)], 1u);
    return b;
}
__device__ __forceinline__ void xcd_barrier_complete(unsigned* bar, unsigned x, unsigned& nloc, unsigned& nx) {
    const unsigned G = gridDim.x * gridDim.y * gridDim.z;
    unsigned sum, cnt, mine, sp = 0u;
    for (;;) {
        sum = 0u; cnt = 0u; mine = 0u;
#pragma unroll
        for (unsigned j = 0; j < 16; ++j) { const unsigned c = xb_ld(&bar[XB_XCNT(j)]); sum += c; cnt += (c > 0u) ? 1u : 0u; mine = (j == x) ? c : mine; }
        if (sum == G) break;
        __builtin_amdgcn_s_sleep(1);
        if ((++sp & 255u) == 0u) { if (xb_ld(&bar[XB_TMO])) break; if (sp > XB_SPIN_CAP) { atomicAdd(&bar[XB_TMO], 1u); break; } }
    }
    nloc = mine > 0u ? mine : 1u; nx = cnt > 0u ? cnt : 1u;
}
__device__ __forceinline__ void xcd_barrier(const XcdBarrier& b) {
    asm volatile("s_waitcnt vmcnt(0)" ::: "memory");
    __syncthreads();
    if (threadIdx.x == 0) {
        unsigned* bar = b.bar;
        __builtin_amdgcn_s_waitcnt(0);
        unsigned nloc = b.st[0], nx = b.st[1];
        if (nloc == 0u) { xcd_barrier_complete(bar, b.x, nloc, nx); b.st[0] = nloc; b.st[1] = nx; }
        const unsigned old = xb_add(&bar[XB_XSUB(b.x)], 1u);
        const unsigned gen = old / nloc;
        if (old + 1u == (gen + 1u) * nloc) {
            __builtin_amdgcn_fence(__ATOMIC_RELEASE, "agent");
            asm volatile("s_waitcnt vmcnt(0)" ::: "memory");
            const unsigned og = xb_add(&bar[XB_TOP], 1u);
            const unsigned tg = og / nx;
            if (og + 1u == (tg + 1u) * nx) xb_add(&bar[XB_TOPGEN], 1u);
            else XB_SPIN(xb_ld(&bar[XB_TOPGEN]) == tg, bar);
            __builtin_amdgcn_fence(__ATOMIC_ACQUIRE, "agent");
            xb_add(&bar[XB_XGEN(b.x)], 1u);
            asm volatile("s_waitcnt vmcnt(0)" ::: "memory");
        } else {
            XB_SPIN(xb_ld(&bar[XB_XGEN(b.x)]) == gen, bar);
            __builtin_amdgcn_fence(__ATOMIC_ACQUIRE, "agent");
            asm volatile("s_waitcnt vmcnt(0)" ::: "memory");
        }
    }
    __syncthreads();
}

namespace fk {
#define GAS __attribute__((address_space(1)))
typedef unsigned u32x4 __attribute__((ext_vector_type(4)));
typedef unsigned u32x2 __attribute__((ext_vector_type(2)));
typedef float f32x4 __attribute__((ext_vector_type(4)));
typedef float f32x2 __attribute__((ext_vector_type(2)));
typedef __bf16 bf2 __attribute__((ext_vector_type(2)));
typedef unsigned short bf16_t;
__device__ __forceinline__ float bflo(unsigned u) { return __uint_as_float(u << 16); }
__device__ __forceinline__ float bfhi(unsigned u) { return __uint_as_float(u & 0xffff0000u); }
__device__ __forceinline__ float dot2(unsigned a, unsigned b, float c) { return __builtin_amdgcn_fdot2_f32_bf16(__builtin_bit_cast(bf2, a), __builtin_bit_cast(bf2, b), c, false); }
__device__ __forceinline__ unsigned pk_bf16(float lo, float hi) { unsigned r; asm volatile("v_cvt_pk_bf16_f32 %0, %1, %2" : "=v"(r) : "v"(lo), "v"(hi)); return r; }
template <int CTRL> __device__ __forceinline__ float dppf(float v) { return __int_as_float(__builtin_amdgcn_update_dpp(0, __float_as_int(v), CTRL, 0xf, 0xf, true)); }
__device__ __forceinline__ float row_max16(float v) { v = fmaxf(v, dppf<0xB1>(v)); v = fmaxf(v, dppf<0x4E>(v)); v = fmaxf(v, dppf<0x141>(v)); v = fmaxf(v, dppf<0x140>(v)); return v; }
__device__ __forceinline__ float frcp(float x) { return __builtin_amdgcn_rcpf(x); }
__device__ __forceinline__ float fsqrt(float x) { return __builtin_amdgcn_sqrtf(x); }
__device__ __forceinline__ float row_sum8(float v) { v += dppf<0xB1>(v); v += dppf<0x4E>(v); v += dppf<0x141>(v); return v; }
__device__ __forceinline__ float row_sum16(float v) { v += dppf<0xB1>(v); v += dppf<0x4E>(v); v += dppf<0x141>(v); v += dppf<0x140>(v); return v; }
__device__ __forceinline__ float shx(float v, int m, int lane) { return __int_as_float(__builtin_amdgcn_ds_bpermute((lane ^ m) << 2, __float_as_int(v))); }
__device__ __forceinline__ float wave_sum(float v, int lane) { v = row_sum16(v); v += shx(v, 16, lane); v += shx(v, 32, lane); return v; }
__device__ __forceinline__ float gelu_tanh(float x) { return 0.5f * x * (1.f + tanhf(0.7978845608028654f * (x + 0.044715f * x * x * x))); }
#define FK_NEG (-3.0e38f)

template <int CTRL> __device__ __forceinline__ int dppi(int v) { return __builtin_amdgcn_update_dpp(0, v, CTRL, 0xf, 0xf, true); }
__device__ __forceinline__ int row_min16i(int v) { v = min(v, dppi<0xB1>(v)); v = min(v, dppi<0x4E>(v)); v = min(v, dppi<0x141>(v)); v = min(v, dppi<0x140>(v)); return v; }
#define FK_CE(a, b) do { const bool sw_ = v[b] > v[a]; const float tv_ = sw_ ? v[b] : v[a]; v[b] = sw_ ? v[a] : v[b]; v[a] = tv_; const int ti_ = sw_ ? id[b] : id[a]; id[b] = sw_ ? id[a] : id[b]; id[a] = ti_; } while (0)
#define FK_SORT8(v, id) do { FK_CE2(v, id, 0, 1); FK_CE2(v, id, 2, 3); FK_CE2(v, id, 4, 5); FK_CE2(v, id, 6, 7); FK_CE2(v, id, 0, 2); FK_CE2(v, id, 1, 3); FK_CE2(v, id, 4, 6); FK_CE2(v, id, 5, 7); FK_CE2(v, id, 1, 2); FK_CE2(v, id, 5, 6); \
    FK_CE2(v, id, 0, 4); FK_CE2(v, id, 1, 5); FK_CE2(v, id, 2, 6); FK_CE2(v, id, 3, 7); FK_CE2(v, id, 2, 4); FK_CE2(v, id, 3, 5); FK_CE2(v, id, 1, 2); FK_CE2(v, id, 3, 4); FK_CE2(v, id, 5, 6); } while (0)
#define FK_CE2(v, id, a, b) do { const bool sw_ = v[b] > v[a]; const float tv_ = sw_ ? v[b] : v[a]; v[b] = sw_ ? v[a] : v[b]; v[a] = tv_; const int ti_ = sw_ ? id[b] : id[a]; id[b] = sw_ ? id[a] : id[b]; id[a] = ti_; } while (0)
__device__ __forceinline__ void top16_of_128_x2(float (&v)[8], int (&id)[8], float (&u)[8], int (&jd)[8], int lane16, float& rv1, int& ri1, float& rv2, int& ri2) {
    FK_SORT8(v, id); FK_SORT8(u, jd);
    rv1 = FK_NEG; ri1 = 0; rv2 = FK_NEG; ri2 = 0;
#pragma unroll
    for (int r = 0; r < 16; ++r) {
        const float wm = row_max16(v[0]), xm = row_max16(u[0]);
        const int cand = (v[0] == wm) ? id[0] : 0x7fffffff, dand = (u[0] == xm) ? jd[0] : 0x7fffffff;
        const int sel = row_min16i(cand), tel = row_min16i(dand);
        const bool mine = (cand == sel), nine = (dand == tel);
        if (lane16 == r) { rv1 = wm; ri1 = sel; rv2 = xm; ri2 = tel; }
#pragma unroll
        for (int i = 0; i < 7; ++i) { v[i] = mine ? v[i + 1] : v[i]; id[i] = mine ? id[i + 1] : id[i]; u[i] = nine ? u[i + 1] : u[i]; jd[i] = nine ? jd[i + 1] : jd[i]; }
        v[7] = mine ? FK_NEG : v[7]; u[7] = nine ? FK_NEG : u[7];
    }
}
__device__ __forceinline__ int fk_key(float x, int lane16) { int k = __float_as_int(x); k ^= (k >> 31) & 0x7fffffff; return (k & ~15) | (15 - lane16); }
__device__ __forceinline__ float fk_unkey(int k) { k &= ~15; k ^= (k >> 31) & 0x7fffffff; return __int_as_float(k); }
__device__ __forceinline__ int row_max16i(int v) { v = max(v, dppi<0xB1>(v)); v = max(v, dppi<0x4E>(v)); v = max(v, dppi<0x141>(v)); v = max(v, dppi<0x140>(v)); return v; }
__device__ __forceinline__ void topk_phase(const GAS bf16_t* __restrict__ SC, const GAS bf16_t* __restrict__ Q, const GAS float* __restrict__ KSUM, GAS float* __restrict__ GATE, GAS int* __restrict__ EIDX, int nitems,
                                           LAS unsigned char* lds, int wid, int lane, int wave_gid, int nwaves) {
    LAS unsigned char* wb = lds + wid * 6144;
    LAS int* IDS1 = (LAS int*)wb; LAS int* IDS2 = (LAS int*)(wb + 2048); LAS int* LC1 = (LAS int*)(wb + 4096); LAS int* LC2 = (LAS int*)(wb + 4352); LAS int* CI = (LAS int*)(wb + 4608);
    LAS float* xv = (LAS float*)(wb + 4864); LAS int* DUMP = (LAS int*)(wb + 5120) + lane; LAS int* WL1 = (LAS int*)(wb + 5376); LAS int* WL2 = (LAS int*)(wb + 5632);
    const int lane16 = lane & 15, rowbase = lane & 48;
    u32x4 nqa, nqb, nsw, ntw;
#define TK_LOAD(wi_) do { int it_ = (wi_) * 4 + (lane >> 4); it_ = it_ < nitems ? it_ : nitems - 1; const GAS u32x4* qp_ = (const GAS u32x4*)(Q + (size_t)it_ * 256 + 16 * lane16); nqa = qp_[0]; nqb = qp_[1]; \
        const GAS bf16_t* sp_ = SC + (size_t)it_ * 256 + 8 * lane16; nsw = *(const GAS u32x4*)sp_; ntw = *(const GAS u32x4*)(sp_ + 128); } while (0)
    TK_LOAD(wave_gid);
    const GAS float* kp = KSUM + ((wave_gid * 4 + (lane >> 4)) & 7) * 256 + 8 * lane16; const f32x4 k0 = *(const GAS f32x4*)kp, k1 = *(const GAS f32x4*)(kp + 4), m0 = *(const GAS f32x4*)(kp + 128), m1 = *(const GAS f32x4*)(kp + 132);
    for (int wi = wave_gid; wi * 4 < nitems; wi += nwaves) {
        const int it = wi * 4 + (lane >> 4);
        const u32x4 qa = nqa, qb = nqb; const f32x4 s0 = (f32x4){bflo(nsw[0]), bfhi(nsw[0]), bflo(nsw[1]), bfhi(nsw[1])}, s1 = (f32x4){bflo(nsw[2]), bfhi(nsw[2]), bflo(nsw[3]), bfhi(nsw[3])},
                    t0 = (f32x4){bflo(ntw[0]), bfhi(ntw[0]), bflo(ntw[1]), bfhi(ntw[1])}, t1 = (f32x4){bflo(ntw[2]), bfhi(ntw[2]), bflo(ntw[3]), bfhi(ntw[3])};
        TK_LOAD(wi + nwaves);
        float qs = 0.f, qq = 0.f;
#pragma unroll
        for (int i = 0; i < 4; ++i) { const float a = bflo(qa[i]), b = bfhi(qa[i]), c = bflo(qb[i]), d = bfhi(qb[i]); qs += (a + b) + (c + d); qq += (a * a + b * b) + (c * c + d * d); }
        const float mu = row_sum16(qs) * (1.f / 256.f); const float var = fmaxf(row_sum16(qq) * (1.f / 256.f) - mu * mu, 0.f); const float rs = 1.f / sqrtf(var + 1e-5f);
        float v[8], u[8]; int id[8], jd[8];
        {
#pragma unroll
          for (int i = 0; i < 4; ++i) { v[i] = rs * (s0[i] - mu * k0[i]); v[4 + i] = rs * (s1[i] - mu * k1[i]); u[i] = rs * (t0[i] - mu * m0[i]); u[4 + i] = rs * (t1[i] - mu * m1[i]);
              id[i] = 8 * lane16 + i; id[4 + i] = 8 * lane16 + 4 + i; jd[i] = 8 * lane16 + i; jd[4 + i] = 8 * lane16 + 4 + i; } }
        FK_SORT8(v, id); FK_SORT8(u, jd);
#pragma unroll
        for (int i = 0; i < 8; ++i) { IDS1[lane * 8 + i] = id[i]; IDS2[lane * 8 + i] = jd[i]; }
        float rv1 = FK_NEG, rv2 = FK_NEG; int wl1 = 0, wl2 = 0, cn1 = 0, cn2 = 0;
#pragma unroll
        for (int r = 0; r < 16; ++r) {
            const int key1 = fk_key(v[0], lane16), key2 = fk_key(u[0], lane16);
            const int wm1 = row_max16i(key1), wm2 = row_max16i(key2);
            const bool mine = (key1 == wm1), nine = (key2 == wm2);
            if (lane16 == r) { rv1 = fk_unkey(wm1); wl1 = 15 - (wm1 & 15); rv2 = fk_unkey(wm2); wl2 = 15 - (wm2 & 15); }
            *(mine ? LC1 + rowbase + r : DUMP) = cn1; *(nine ? LC2 + rowbase + r : DUMP) = cn2;
#pragma unroll
            for (int i = 0; i < 7; ++i) { v[i] = mine ? v[i + 1] : v[i]; u[i] = nine ? u[i + 1] : u[i]; }
            v[7] = mine ? FK_NEG : v[7]; u[7] = nine ? FK_NEG : u[7]; cn1 += mine ? 1 : 0; cn2 += nine ? 1 : 0;
        }
        xv[lane] = rv2; WL1[lane] = wl1; WL2[lane] = wl2;
        float c[16];
        { const LAS f32x4* xp = (const LAS f32x4*)(xv + rowbase);
#pragma unroll
          for (int q = 0; q < 4; ++q) { const f32x4 t = xp[q]; c[4 * q] = rv1 + t.x; c[4 * q + 1] = rv1 + t.y; c[4 * q + 2] = rv1 + t.z; c[4 * q + 3] = rv1 + t.w; } }
        int p = 0, wli = 0; float sc = FK_NEG;
#pragma unroll
        for (int r = 0; r < 16; ++r) {
            const int key = fk_key(c[0], lane16); const int wm = row_max16i(key); const bool mine = (key == wm);
            if (lane16 == r) { sc = fk_unkey(wm); wli = 15 - (wm & 15); }
            *(mine ? CI + rowbase + r : DUMP) = p;
#pragma unroll
            for (int i = 0; i < 15; ++i) c[i] = mine ? c[i + 1] : c[i];
            c[15] = mine ? FK_NEG : c[15]; p += mine ? 1 : 0;
        }
        const int i1 = wli & 15, j2 = CI[rowbase + lane16] & 15;
        const int e1 = IDS1[(rowbase + (WL1[rowbase + i1] & 15)) * 8 + (LC1[rowbase + i1] & 7)], e2 = IDS2[(rowbase + (WL2[rowbase + j2] & 15)) * 8 + (LC2[rowbase + j2] & 7)];
        const float mx = fk_unkey(row_max16i(fk_key(sc, 0))); const float ex = __expf(sc - mx); const float den = row_sum16(ex);
        GATE[(size_t)it * 16 + lane16] = ex / den; EIDX[(size_t)it * 16 + lane16] = (e1 & 127) * 128 + (e2 & 127);
    }
#undef TK_LOAD
}

__device__ __forceinline__ f32x2 fp8lo(unsigned w) { return __builtin_amdgcn_cvt_pk_f32_fp8((int)w, false); }
__device__ __forceinline__ f32x2 fp8hi(unsigned w) { return __builtin_amdgcn_cvt_pk_f32_fp8((int)w, true); }
__device__ __forceinline__ void act_phase(const GAS bf16_t* __restrict__ XB, const GAS unsigned char* __restrict__ U8, const GAS float* __restrict__ GATE, const GAS int* __restrict__ EIDX, GAS float* __restrict__ COEF, int nitems,
                                          int lane, int wave_gid, int nwaves) {
    int it = wave_gid; if (it >= nitems) return;
    u32x4 uc[16], un[16], xac, xbc, xan, xbn;
    int evc = EIDX[(size_t)it * 16 + (lane & 15)];
    { const GAS u32x4* xp = (const GAS u32x4*)(XB + (size_t)(it >> 3) * 1024 + 16 * lane); xac = xp[0]; xbc = xp[1]; }
#pragma unroll
    for (int k = 0; k < 16; ++k) uc[k] = *(const GAS u32x4*)(U8 + (size_t)__builtin_amdgcn_readlane(evc, k) * 1024 + 16 * lane);
    int itn = it + nwaves; int evn = (itn < nitems) ? EIDX[(size_t)itn * 16 + (lane & 15)] : 0;
    for (;;) {
        const bool hasn = itn < nitems;
        if (hasn) {
            const GAS u32x4* xp = (const GAS u32x4*)(XB + (size_t)(itn >> 3) * 1024 + 16 * lane); xan = xp[0]; xbn = xp[1];
#pragma unroll
            for (int k = 0; k < 16; ++k) un[k] = *(const GAS u32x4*)(U8 + (size_t)__builtin_amdgcn_readlane(evn, k) * 1024 + 16 * lane);
        }
        const int itnn = itn + nwaves; const int evnn = (itnn < nitems) ? EIDX[(size_t)itnn * 16 + (lane & 15)] : 0;
        const float gt = GATE[(size_t)it * 16 + (lane >> 2)];
        float x[16];
#pragma unroll
        for (int i = 0; i < 4; ++i) { x[2 * i] = bflo(xac[i]); x[2 * i + 1] = bfhi(xac[i]); x[8 + 2 * i] = bflo(xbc[i]); x[8 + 2 * i + 1] = bfhi(xbc[i]); }
        float a[16];
#pragma unroll
        for (int k = 0; k < 16; ++k) { const u32x4 uw = uc[k]; float s = 0.f;
#pragma unroll
            for (int d = 0; d < 4; ++d) { const f32x2 lo = fp8lo(uw[d]), hi = fp8hi(uw[d]); s = fmaf(lo.x, x[4 * d], s); s = fmaf(lo.y, x[4 * d + 1], s); s = fmaf(hi.x, x[4 * d + 2], s); s = fmaf(hi.y, x[4 * d + 3], s); }
            asm volatile("" : "+v"(s)); a[k] = s; }
#pragma unroll
        for (int k = 0; k < 8; ++k) { const bool hi = lane & 32; const float send = hi ? a[k] : a[k + 8], keep = hi ? a[k + 8] : a[k]; a[k] = keep + shx(send, 32, lane); }
#pragma unroll
        for (int k = 0; k < 4; ++k) { const bool hi = lane & 16; const float send = hi ? a[k] : a[k + 4], keep = hi ? a[k + 4] : a[k]; a[k] = keep + shx(send, 16, lane); }
#pragma unroll
        for (int k = 0; k < 2; ++k) { const bool hi = lane & 8; const float send = hi ? a[k] : a[k + 2], keep = hi ? a[k + 2] : a[k]; a[k] = keep + shx(send, 8, lane); }
        { const bool hi = lane & 4; const float send = hi ? a[0] : a[1], keep = hi ? a[1] : a[0]; a[0] = keep + shx(send, 4, lane); }
        float dsum = a[0]; dsum += shx(dsum, 2, lane); dsum += shx(dsum, 1, lane);
        if ((lane & 3) == 0) COEF[(size_t)it * 16 + (lane >> 2)] = gt * gelu_tanh(dsum * (1.f / 128.f));
        if (!hasn) break;
#pragma unroll
        for (int k = 0; k < 16; ++k) uc[k] = un[k];
        xac = xan; xbc = xbn; evc = evn; evn = evnn; it = itn; itn = itnn;
    }
}

__device__ __forceinline__ void outln_phase(const GAS float* COEF, const GAS int* EIDX, const GAS unsigned char* V8,     const GAS float* __restrict__ lg, const GAS float* __restrict__ lb, GAS float* X, GAS bf16_t* XB, int nrows,
                                            int lane, int wave_gid, int nwaves) {
    const float alpha = 1.6817928305074292f;
    int row = wave_gid; if (row >= nrows) return;
    u32x4 vc[16], vn[16];
    float cf0 = COEF[(size_t)row * 128 + lane] * (1.f / 64.f), cf1 = COEF[(size_t)row * 128 + 64 + lane] * (1.f / 64.f); int ev0 = EIDX[(size_t)row * 128 + lane], ev1 = EIDX[(size_t)row * 128 + 64 + lane];
#define OUT_LOADCH(dst, evreg, base) do { _Pragma("unroll") for (int k_ = 0; k_ < 16; ++k_) dst[k_] = *(const GAS u32x4*)(V8 + (size_t)__builtin_amdgcn_readlane(evreg, (base) + k_) * 1024 + 16 * lane); } while (0)
#define OUT_COMPCH(src, cfreg, base) do { _Pragma("unroll") for (int k_ = 0; k_ < 16; ++k_) { const float c_ = __int_as_float(__builtin_amdgcn_readlane(__float_as_int(cfreg), (base) + k_)); const u32x4 vw_ = src[k_]; \
        _Pragma("unroll") for (int d_ = 0; d_ < 4; ++d_) { const f32x2 lo_ = fp8lo(vw_[d_]), hi_ = fp8hi(vw_[d_]); acc[4 * d_] = fmaf(c_, lo_.x, acc[4 * d_]); acc[4 * d_ + 1] = fmaf(c_, lo_.y, acc[4 * d_ + 1]); acc[4 * d_ + 2] = fmaf(c_, hi_.x, acc[4 * d_ + 2]); acc[4 * d_ + 3] = fmaf(c_, hi_.y, acc[4 * d_ + 3]); } \
        _Pragma("unroll") for (int p_ = 0; p_ < 16; ++p_) asm volatile("" : "+v"(acc[p_]));     \
        } } while (0)
    for (;;) {
        OUT_LOADCH(vc, ev0, 0);
        const int rown = row + nwaves; const bool hasn = rown < nrows;
        float ncf0 = 0.f, ncf1 = 0.f; int nev0 = 0, nev1 = 0;
        if (hasn) { ncf0 = COEF[(size_t)rown * 128 + lane] * (1.f / 64.f); ncf1 = COEF[(size_t)rown * 128 + 64 + lane] * (1.f / 64.f); nev0 = EIDX[(size_t)rown * 128 + lane]; nev1 = EIDX[(size_t)rown * 128 + 64 + lane]; }
        float acc[16];
#pragma unroll
        for (int k = 0; k < 16; ++k) acc[k] = 0.f;
#define OUT_FENCE() asm volatile("" ::: "memory")
        OUT_LOADCH(vn, ev0, 16); OUT_FENCE(); OUT_COMPCH(vc, cf0, 0); OUT_FENCE();
        OUT_LOADCH(vc, ev0, 32); OUT_FENCE(); OUT_COMPCH(vn, cf0, 16); OUT_FENCE();
        OUT_LOADCH(vn, ev0, 48); OUT_FENCE(); OUT_COMPCH(vc, cf0, 32); OUT_FENCE();
        OUT_LOADCH(vc, ev1, 0);  OUT_FENCE(); OUT_COMPCH(vn, cf0, 48); OUT_FENCE();
        OUT_LOADCH(vn, ev1, 16); OUT_FENCE(); OUT_COMPCH(vc, cf1, 0); OUT_FENCE();
        OUT_LOADCH(vc, ev1, 32); OUT_FENCE(); OUT_COMPCH(vn, cf1, 16); OUT_FENCE();
        OUT_LOADCH(vn, ev1, 48); OUT_FENCE(); OUT_COMPCH(vc, cf1, 32); OUT_FENCE();
        OUT_COMPCH(vn, cf1, 48); OUT_FENCE();
#undef OUT_FENCE
        GAS float* xr = X + (size_t)row * 1024 + 16 * lane; float t[16];
#pragma unroll
        for (int q = 0; q < 4; ++q) { const f32x4 xv = *(const GAS f32x4*)(xr + 4 * q); t[4 * q] = fmaf(alpha, xv.x, acc[4 * q]); t[4 * q + 1] = fmaf(alpha, xv.y, acc[4 * q + 1]); t[4 * q + 2] = fmaf(alpha, xv.z, acc[4 * q + 2]); t[4 * q + 3] = fmaf(alpha, xv.w, acc[4 * q + 3]); }
        float s = 0.f;
#pragma unroll
        for (int k = 0; k < 16; ++k) s += t[k];
        const float mu = wave_sum(s, lane) * (1.f / 1024.f); float vs = 0.f;
#pragma unroll
        for (int k = 0; k < 16; ++k) { t[k] -= mu; vs = fmaf(t[k], t[k], vs); }
        const float rs = 1.f / sqrtf(wave_sum(vs, lane) * (1.f / 1024.f) + 1e-5f);
        unsigned w[8];
#pragma unroll
        for (int q = 0; q < 4; ++q) { const f32x4 g = *(const GAS f32x4*)(lg + 16 * lane + 4 * q), b = *(const GAS f32x4*)(lb + 16 * lane + 4 * q); f32x4 o;
            o.x = t[4 * q] * rs * g.x + b.x; o.y = t[4 * q + 1] * rs * g.y + b.y; o.z = t[4 * q + 2] * rs * g.z + b.z; o.w = t[4 * q + 3] * rs * g.w + b.w;
            *(GAS f32x4*)(xr + 4 * q) = o; w[2 * q] = pk_bf16(o.x, o.y); w[2 * q + 1] = pk_bf16(o.z, o.w); }
        u32x4 w0, w1; w0.x = w[0]; w0.y = w[1]; w0.z = w[2]; w0.w = w[3]; w1.x = w[4]; w1.y = w[5]; w1.z = w[6]; w1.w = w[7];
        GAS u32x4* xbp = (GAS u32x4*)(XB + (size_t)row * 1024 + 16 * lane); xbp[0] = w0; xbp[1] = w1;
        if (!hasn) break;
        row = rown; cf0 = ncf0; cf1 = ncf1; ev0 = nev0; ev1 = nev1;
    }
#undef OUT_LOADCH
#undef OUT_COMPCH
}

__device__ __forceinline__ void lnres_phase(const GAS bf16_t* __restrict__ Y, const GAS float* __restrict__ lg, const GAS float* __restrict__ lb, GAS float* X, GAS bf16_t* XB, GAS unsigned char* XF8, int nrows, int lane, int wave_gid, int nwaves) {
    const float alpha = 1.6817928305074292f; (void)X;
    for (int row = wave_gid; row < nrows; row += nwaves) {
        GAS bf16_t* xr = XB + (size_t)row * 1024; const GAS bf16_t* yr = Y + (size_t)row * 1024; float t[16];
#pragma unroll
        for (int q = 0; q < 4; ++q) { const u32x2 xw = *(const GAS u32x2*)(xr + 256 * q + 4 * lane); const u32x2 yw = *(const GAS u32x2*)(yr + 256 * q + 4 * lane);
            t[4 * q] = fmaf(alpha, bflo(xw.x), bflo(yw.x)); t[4 * q + 1] = fmaf(alpha, bfhi(xw.x), bfhi(yw.x)); t[4 * q + 2] = fmaf(alpha, bflo(xw.y), bflo(yw.y)); t[4 * q + 3] = fmaf(alpha, bfhi(xw.y), bfhi(yw.y)); }
        float s = 0.f;
#pragma unroll
        for (int k = 0; k < 16; ++k) s += t[k];
        const float mu = wave_sum(s, lane) * (1.f / 1024.f); float vs = 0.f;
#pragma unroll
        for (int k = 0; k < 16; ++k) { t[k] -= mu; vs = fmaf(t[k], t[k], vs); }
        const float rs = 1.f / sqrtf(wave_sum(vs, lane) * (1.f / 1024.f) + 1e-5f);
#pragma unroll
        for (int q = 0; q < 4; ++q) { const int c = 256 * q + 4 * lane; const f32x4 g = *(const GAS f32x4*)(lg + c), b = *(const GAS f32x4*)(lb + c); f32x4 o;
            o.x = t[4 * q] * rs * g.x + b.x; o.y = t[4 * q + 1] * rs * g.y + b.y; o.z = t[4 * q + 2] * rs * g.z + b.z; o.w = t[4 * q + 3] * rs * g.w + b.w;
            u32x2 w; w.x = pk_bf16(o.x, o.y); w.y = pk_bf16(o.z, o.w); *(GAS u32x2*)(xr + c) = w;
            if (XF8) {
                const float s0 = __builtin_amdgcn_fmed3f(o.x * 16.f, -448.f, 448.f), s1 = __builtin_amdgcn_fmed3f(o.y * 16.f, -448.f, 448.f), s2 = __builtin_amdgcn_fmed3f(o.z * 16.f, -448.f, 448.f), s3 = __builtin_amdgcn_fmed3f(o.w * 16.f, -448.f, 448.f);
                int hp = __builtin_amdgcn_cvt_pk_fp8_f32(s0, s1, 0, false); hp = __builtin_amdgcn_cvt_pk_fp8_f32(s2, s3, hp, true);
                const f32x2 d01 = fp8lo((unsigned)hp), d23 = fp8hi((unsigned)hp);
                int lp = __builtin_amdgcn_cvt_pk_fp8_f32(s0 - d01.x, s1 - d01.y, 0, false); lp = __builtin_amdgcn_cvt_pk_fp8_f32(s2 - d23.x, s3 - d23.y, lp, true);
                *(GAS int*)(XF8 + (size_t)row * 2048 + c) = hp; *(GAS int*)(XF8 + (size_t)row * 2048 + 1024 + c) = lp; } }
    }
}

__device__ __forceinline__ void glanorm_phase(const GAS float* __restrict__ O, const GAS float* __restrict__ PROJ, const GAS float* __restrict__ gnorm, GAS bf16_t* XB, int nitems, int lane, int wave_gid, int nwaves) {
    const float g0 = gnorm[lane], g1 = gnorm[64 + lane];
    for (int it0 = wave_gid * 8; it0 < nitems; it0 += nwaves * 8) {
        float a0[8], a1[8], r0[8], r1[8];
#pragma unroll
        for (int q = 0; q < 8; ++q) { int it = it0 + q; it = it < nitems ? it : it0; const int row = it >> 2, h = it & 3; const GAS float* o = O + (size_t)row * 512 + h * 128; const GAS float* r = PROJ + (size_t)row * 2576 + 1040 + h * 128;
            a0[q] = o[lane]; a1[q] = o[64 + lane]; r0[q] = r[lane]; r1[q] = r[64 + lane]; }
#pragma unroll
        for (int q = 0; q < 8; ++q) { const int it = it0 + q; const int row = it >> 2, h = it & 3;
            const float rs = 1.f / sqrtf(wave_sum(a0[q] * a0[q] + a1[q] * a1[q], lane) * (1.f / 128.f) + 1e-5f);
            const float y0 = a0[q] * rs * g0 * (r0[q] * frcp(1.f + __expf(-r0[q]))), y1 = a1[q] * rs * g1 * (r1[q] * frcp(1.f + __expf(-r1[q])));
            if (it < nitems) { GAS bf16_t* d = XB + (size_t)row * 1024 + h * 128; d[lane] = (bf16_t)(pk_bf16(y0, 0.f) & 0xffffu); d[64 + lane] = (bf16_t)(pk_bf16(y1, 0.f) & 0xffffu); } }
    }
}

__device__ __forceinline__ float sigm(float x) { return frcp(1.f + __expf(-x)); }
__device__ __forceinline__ float softplusf(float x) { return fmaxf(x, 0.f) + log1pf(__expf(-fabsf(x))); }
__device__ __forceinline__ void rwkvprep_phase(const GAS float* __restrict__ w0, const GAS float* __restrict__ a0, const GAS float* __restrict__ v0, const GAS float* __restrict__ k_k, const GAS float* __restrict__ k_a, const GAS float* __restrict__ Vg,
                                               GAS float* K, GAS float* Wd, GAS float* Aa, GAS float* V, GAS float* NKK, GAS float* VFIRST, int has_vres, int nitems, int lane, int wave_gid, int nwaves) {
    for (int it0 = wave_gid * 4; it0 < nitems; it0 += nwaves * 4) {
        float kq[4], wq[4], aq[4], vq[4], gq[4], fq[4];
#pragma unroll
        for (int q = 0; q < 4; ++q) { const int it = it0 + q; const size_t ix = (size_t)(it >> 4) * 1024 + (it & 15) * 64 + lane; kq[q] = K[ix]; wq[q] = Wd[ix]; aq[q] = Aa[ix]; vq[q] = V[ix]; gq[q] = has_vres ? Vg[ix] : 0.f; fq[q] = has_vres ? VFIRST[ix] : 0.f; }
#pragma unroll
        for (int q = 0; q < 4; ++q) { const int it = it0 + q; const int h = it & 15; const size_t ix = (size_t)(it >> 4) * 1024 + h * 64 + lane; const int c = h * 64 + lane;
            const float k0 = kq[q]; const float kv = k0 * k_k[c]; const float inv = 1.f / fmaxf(sqrtf(wave_sum(kv * kv, lane)), 1e-12f);
            const float w = -softplusf(-(w0[c] + wq[q])) - 0.5f; const float dec = __expf(-__expf(w));
            const float a = sigm(a0[c] + aq[q]);
            float v = vq[q]; if (has_vres) v = v + (fq[q] - v) * sigm(v0[c] + gq[q]); else VFIRST[ix] = v;
            const float kk = kv * inv;
            NKK[ix] = -kk; K[ix] = k0 * (1.f + (a - 1.f) * k_a[c]); Wd[ix] = dec; Aa[ix] = kk * a; V[ix] = v; }
    }
}

__device__ __forceinline__ void rwkvpost_phase(const GAS float* __restrict__ Y, const GAS float* __restrict__ R, const GAS float* __restrict__ K2, const GAS float* __restrict__ V, const GAS float* __restrict__ G, const GAS float* __restrict__ r_k,
                                               const GAS float* __restrict__ lnx_g, const GAS float* __restrict__ lnx_b, GAS bf16_t* XB, int nitems, int lane, int wave_gid, int nwaves) {
    for (int it0 = wave_gid * 4; it0 < nitems; it0 += nwaves * 4) {
        float yq[4], rq[4], kq[4], vq[4], gq[4];
#pragma unroll
        for (int q = 0; q < 4; ++q) { const int it = it0 + q; const size_t ix = (size_t)(it >> 4) * 1024 + (it & 15) * 64 + lane; yq[q] = Y[ix]; rq[q] = R[ix]; kq[q] = K2[ix]; vq[q] = V[ix]; gq[q] = G[ix]; }
#pragma unroll
        for (int q = 0; q < 4; ++q) { const int it = it0 + q; const int h = it & 15; const size_t ix = (size_t)(it >> 4) * 1024 + h * 64 + lane; const int c = h * 64 + lane;
            const float y = yq[q]; const float mu = wave_sum(y, lane) * (1.f / 64.f); const float d = y - mu; const float rs = 1.f / sqrtf(wave_sum(d * d, lane) * (1.f / 64.f) + 64e-5f);
            const float bon = wave_sum(rq[q] * kq[q] * r_k[c], lane);
            const float o = (d * rs * lnx_g[c] + lnx_b[c] + bon * vq[q]) * gq[q];
            XB[ix] = (bf16_t)(pk_bf16(o, 0.f) & 0xffffu); }
    }
}

__device__ __forceinline__ void wkv_phase(const GAS float* __restrict__ R, const GAS float* __restrict__ Wd, const GAS float* __restrict__ K2, const GAS float* __restrict__ V, const GAS float* __restrict__ BB, const GAS float* __restrict__ NKK,
                                          const GAS float* __restrict__ SIN, GAS float* __restrict__ Y, GAS float* __restrict__ P, GAS float* __restrict__ SOUT, int B, int T, int DB, int DT, LAS unsigned char* lds, int tid, int bid, int nb) {
    constexpr int TB = 32, NLD = 6, VECB = TB * 1280, VVB = TB * 128, BUF = VECB + 2 * VVB;
    const int rowl = tid >> 4, part = tid & 15;
    const int nprompt = B * 32, nunits = nprompt + DB * 32;
    for (int u = bid; u < nunits; u += nb) {
        const bool smp = u >= nprompt; const int q0_ = smp ? u - nprompt : u; const int q = ((q0_ & 7) << 1 | ((q0_ >> 3) & 1)) + ((q0_ >> 4) << 4);
        const int half = q & 1, pair = q >> 1, sq = pair >> 4, h = pair & 15;
        const int Tu = smp ? DT : T; const int r0 = smp ? B * T + sq * DT : sq * T, vrow = half * 32 + rowl;
        f32x2 S01 = (f32x2){0.f, 0.f}, S23 = (f32x2){0.f, 0.f};
        if (smp) { const f32x4 s4 = *(const GAS f32x4*)(SIN + ((size_t)pair * 64 + vrow) * 64 + part * 4); S01 = (f32x2){s4.x, s4.y}; S23 = (f32x2){s4.z, s4.w};
                   asm volatile("" : "+v"(S01), "+v"(S23)); }
        const int nblk = (Tu + TB - 1) / TB;
        f32x4 ld[NLD];
        const size_t eo_ = (size_t)(r0 + (tid >> 4)) * 1024 + h * 64 + (tid & 15) * 4, ev_ = (size_t)(r0 + ((tid & 255) >> 3)) * 1024 + h * 64 + half * 32 + (tid & 7) * 4;
        const int lo_ = ((tid >> 4) * 320 + (tid & 15) * 4) * 4, lv_ = VECB + (tid & 255) * 16;
#define WKV_LOAD(tb0) do { const size_t bo_ = (size_t)(tb0) * 1024; ld[0] = *(const GAS f32x4*)(Wd + eo_ + bo_); ld[1] = *(const GAS f32x4*)(NKK + eo_ + bo_); ld[2] = *(const GAS f32x4*)(BB + eo_ + bo_); \
            ld[3] = *(const GAS f32x4*)(K2 + eo_ + bo_); ld[4] = *(const GAS f32x4*)(R + eo_ + bo_); ld[5] = *(const GAS f32x4*)(V + ev_ + bo_); } while (0)
#define WKV_STORE(bufp) do { _Pragma("unroll") for (int q_ = 0; q_ < 5; ++q_) *(LAS f32x4*)((bufp) + lo_ + q_ * 256) = ld[q_]; *(LAS f32x4*)((bufp) + lv_) = ld[5]; } while (0)
        WKV_LOAD(0); WKV_STORE(lds); __syncthreads();
        for (int b = 0; b < nblk; ++b) {
            LAS unsigned char* cur = lds + (b & 1) * BUF; LAS unsigned char* nxt = lds + ((b + 1) & 1) * BUF; const int tb0 = b * TB; const int nt = (Tu - tb0) < TB ? (Tu - tb0) : TB;
            if (b + 1 < nblk) WKV_LOAD(tb0 + TB);
            const LAS float* vec = (const LAS float*)cur + part * 4; const LAS float* vv = (const LAS float*)(cur + VECB) + rowl; LAS float* yb = (LAS float*)(cur + VECB + VVB);
            float ykeep0 = 0.f, ykeep1 = 0.f;
#define WKV_STEP(t, keep, tl) do { const LAS f32x2* vp_ = (const LAS f32x2*)(vec + (t) * 320); \
                const f32x2 w01 = vp_[0], w23 = vp_[1], n01 = vp_[32], n23 = vp_[33], b01 = vp_[64], b23 = vp_[65], k01 = vp_[96], k23 = vp_[97], r01 = vp_[128], r23 = vp_[129]; \
                const float v = vv[(t) * 32]; \
                const f32x2 sp = __builtin_elementwise_fma(S23, n23, S01 * n01); const float sa = row_sum16(sp.x + sp.y); const f32x2 sa2 = (f32x2){sa, sa}, v2 = (f32x2){v, v}; \
                S01 = __builtin_elementwise_fma(S01, w01, __builtin_elementwise_fma(b01, sa2, k01 * v2)); S23 = __builtin_elementwise_fma(S23, w23, __builtin_elementwise_fma(b23, sa2, k23 * v2)); \
                const f32x2 yp = __builtin_elementwise_fma(S23, r23, S01 * r01); const float y = row_sum16(yp.x + yp.y); \
                keep = (part == (tl)) ? y : keep; } while (0)
            if (nt == TB) {
#pragma unroll 1
                for (int t = 0; t < 16; t += 8) { WKV_STEP(t, ykeep0, t); WKV_STEP(t + 1, ykeep0, t + 1); WKV_STEP(t + 2, ykeep0, t + 2); WKV_STEP(t + 3, ykeep0, t + 3); WKV_STEP(t + 4, ykeep0, t + 4); WKV_STEP(t + 5, ykeep0, t + 5); WKV_STEP(t + 6, ykeep0, t + 6); WKV_STEP(t + 7, ykeep0, t + 7); }
#pragma unroll 1
                for (int t = 16; t < 32; t += 8) { WKV_STEP(t, ykeep1, t - 16); WKV_STEP(t + 1, ykeep1, t - 15); WKV_STEP(t + 2, ykeep1, t - 14); WKV_STEP(t + 3, ykeep1, t - 13); WKV_STEP(t + 4, ykeep1, t - 12); WKV_STEP(t + 5, ykeep1, t - 11); WKV_STEP(t + 6, ykeep1, t - 10); WKV_STEP(t + 7, ykeep1, t - 9); }
            } else { for (int t = 0; t < nt; ++t) { if (t < 16) WKV_STEP(t, ykeep0, t); else WKV_STEP(t, ykeep1, t - 16); } }
#undef WKV_STEP
            yb[part * 32 + rowl] = ykeep0; yb[(16 + part) * 32 + rowl] = ykeep1;
            if (b + 1 < nblk) WKV_STORE(nxt);
            __syncthreads();
            { const int rl = tid & 31; _Pragma("unroll") for (int t = tid >> 5; t < TB; t += 16) if (t < nt) Y[(size_t)(r0 + tb0 + t) * 1024 + h * 64 + half * 32 + rl] = yb[t * 32 + rl]; }
        }
#undef WKV_LOAD
#undef WKV_STORE
        *(GAS f32x4*)((smp ? SOUT : P) + ((size_t)pair * 64 + vrow) * 64 + part * 4) = (f32x4){S01.x, S01.y, S23.x, S23.y};
        __syncthreads();
    }
}

__device__ __forceinline__ void rwkvpost2_phase(const GAS bf16_t* __restrict__ Y, const GAS bf16_t* __restrict__ G, const GAS bf16_t* __restrict__ VF, const GAS float* __restrict__ BON, const GAS float* __restrict__ lnx_g, const GAS float* __restrict__ lnx_b,
                                                GAS bf16_t* XB, int nitems, int lane, int wave_gid, int nwaves) {
    const int nit4 = nitems >> 2, hg = wave_gid & 3, cofs = hg * 256 + 4 * lane; const f32x4 lg = *(const GAS f32x4*)(lnx_g + cofs), lb = *(const GAS f32x4*)(lnx_b + cofs);
    for (int it0 = wave_gid; it0 < nit4; it0 += nwaves * 4) {
        u32x2 yq[4], vq[4], gq[4]; float bq[4];
#pragma unroll
        for (int q = 0; q < 4; ++q) { int it = it0 + q * nwaves; it = it < nit4 ? it : it0; const int row = it >> 2; const size_t ix = (size_t)row * 1024 + cofs;
            yq[q] = *(const GAS u32x2*)(Y + ix); vq[q] = *(const GAS u32x2*)(VF + ix); gq[q] = *(const GAS u32x2*)(G + ix); bq[q] = BON[row * 16 + hg * 4 + (lane >> 4)]; }
#pragma unroll
        for (int q = 0; q < 4; ++q) { const int it = it0 + q * nwaves; const int row = it >> 2; const f32x4 y = (f32x4){bflo(yq[q].x), bfhi(yq[q].x), bflo(yq[q].y), bfhi(yq[q].y)}, vv4 = (f32x4){bflo(vq[q].x), bfhi(vq[q].x), bflo(vq[q].y), bfhi(vq[q].y)};
            const float mu = row_sum16((y.x + y.y) + (y.z + y.w)) * (1.f / 64.f); const f32x4 d = y - mu; const float rs = __builtin_amdgcn_rsqf(row_sum16((d.x * d.x + d.y * d.y) + (d.z * d.z + d.w * d.w)) * (1.f / 64.f) + 64e-5f);
            const f32x4 gg = (f32x4){bflo(gq[q].x), bfhi(gq[q].x), bflo(gq[q].y), bfhi(gq[q].y)}; const f32x4 o = (d * rs * lg + lb + bq[q] * vv4) * gg;
            if (it < nit4) { u32x2 w_; w_.x = pk_bf16(o.x, o.y); w_.y = pk_bf16(o.z, o.w); *(GAS u32x2*)(XB + (size_t)row * 1024 + cofs) = w_; } }
    }
}

__device__ __forceinline__ void wkv2_phase(const GAS bf16_t* __restrict__ R, const GAS bf16_t* __restrict__ KR, const GAS bf16_t* __restrict__ WL, const GAS bf16_t* __restrict__ AL, const GAS bf16_t* __restrict__ V, const GAS bf16_t* __restrict__ VG,
                                           const GAS bf16_t* VFI, const GAS float* __restrict__ PRM, const GAS float* __restrict__ SIN, GAS bf16_t* __restrict__ Y, GAS float* __restrict__ P, GAS float* __restrict__ SOUT, GAS bf16_t* VFO, GAS float* __restrict__ BON,
                                           int has_vres, int B, int T, int DB, int DT, LAS unsigned char* lds, int tid, int bid, int nb) {
    constexpr int TB = 32, VECB = TB * 1280, VVB = TB * 128, BUF = VECB + 2 * VVB;
    const bool scanw = __builtin_amdgcn_readfirstlane(tid) < 256; const int pt = tid & 255;
    const int rowl = pt >> 4, part = pt & 15;
    const int nprompt = B * 32, nunits_all = nprompt + DB * 32, nunits = DT <= 4 ? nprompt : nunits_all;
    for (int u = bid; u < nunits; u += nb) {
        const bool smp = u >= nprompt; const int q0_ = smp ? u - nprompt : u; const int q = ((q0_ & 7) << 1 | ((q0_ >> 3) & 1)) + ((q0_ >> 4) << 4);
        const int half = q & 1, pair = q >> 1, sq = pair >> 4, h = pair & 15;
        const int Tu = smp ? DT : T; const int r0 = smp ? B * T + sq * DT : sq * T, vrow = half * 32 + rowl;
        const int srow = pt >> 3, sp8 = pt & 7;
        f32x2 S0 = (f32x2){0.f, 0.f}, S1 = (f32x2){0.f, 0.f}, S2 = (f32x2){0.f, 0.f}, S3 = (f32x2){0.f, 0.f};
        if (smp && scanw) { const GAS f32x4* sp_ = (const GAS f32x4*)(SIN + ((size_t)pair * 64 + half * 32 + srow) * 64 + sp8 * 8); const f32x4 sa4 = sp_[0], sb4 = sp_[1];
                   S0 = (f32x2){sa4.x, sa4.y}; S1 = (f32x2){sa4.z, sa4.w}; S2 = (f32x2){sb4.x, sb4.y}; S3 = (f32x2){sb4.z, sb4.w};
                   asm volatile("" : "+v"(S0), "+v"(S1), "+v"(S2), "+v"(S3)); }
        const int nblk = (Tu + TB - 1) / TB;
        u32x2 lk0, lw0, la0, lr0, lk1, lw1, la1, lr1, lv, lg = (u32x2){0u, 0u}, lf = (u32x2){0u, 0u};
        const size_t eo_ = (size_t)(r0 + (pt >> 4)) * 1024 + h * 64 + part * 4, ev_ = (size_t)(r0 + (pt >> 3)) * 1024 + h * 64 + half * 32 + (pt & 7) * 4;
        const int lo_ = ((pt >> 4) * 320 + part * 4) * 4, lv_ = VECB + pt * 16;
        const int pc_ = h * 64 + part * 4; const f32x4 w0v = *(const GAS f32x4*)(PRM + pc_), a0v = *(const GAS f32x4*)(PRM + 1024 + pc_), kkp = *(const GAS f32x4*)(PRM + 3072 + pc_), kap = *(const GAS f32x4*)(PRM + 4096 + pc_), rkp = *(const GAS f32x4*)(PRM + 5120 + pc_);
        const f32x4 v0v = *(const GAS f32x4*)(PRM + 2048 + h * 64 + half * 32 + (pt & 7) * 4);
#define WKV_LOAD(tb0) do { const size_t bo_ = (size_t)(tb0) * 1024, b1_ = bo_ + 16 * 1024; lk0 = *(const GAS u32x2*)(KR + eo_ + bo_); lw0 = *(const GAS u32x2*)(WL + eo_ + bo_); la0 = *(const GAS u32x2*)(AL + eo_ + bo_); lr0 = *(const GAS u32x2*)(R + eo_ + bo_); \
            lk1 = *(const GAS u32x2*)(KR + eo_ + b1_); lw1 = *(const GAS u32x2*)(WL + eo_ + b1_); la1 = *(const GAS u32x2*)(AL + eo_ + b1_); lr1 = *(const GAS u32x2*)(R + eo_ + b1_); \
            lv = *(const GAS u32x2*)(V + ev_ + bo_); if (has_vres) { lg = *(const GAS u32x2*)(VG + ev_ + bo_); lf = *(const GAS u32x2*)(VFI + ev_ + bo_); } } while (0)
#define WKV_UNPK(w_) ((f32x4){bflo((w_).x), bfhi((w_).x), bflo((w_).y), bfhi((w_).y)})
#define WKV_ITEM(bufp, tb0, lk, lw, la, lr, ti_) do { const f32x4 k4 = WKV_UNPK(lk), wl4 = WKV_UNPK(lw), al4 = WKV_UNPK(la); const f32x4 kv = k4 * kkp; const float ss = row_sum16((kv.x * kv.x + kv.y * kv.y) + (kv.z * kv.z + kv.w * kv.w)); const float inv = frcp(fmaxf(fsqrt(ss), 1e-12f)); \
            f32x4 dec, a4; _Pragma("unroll") for (int i_ = 0; i_ < 4; ++i_) { dec[i_] = __expf(-0.6065306597126334f * frcp(1.f + __expf(-(w0v[i_] + wl4[i_])))); a4[i_] = frcp(1.f + __expf(-(a0v[i_] + al4[i_]))); } \
            const f32x4 kk = kv * inv; const f32x4 k2 = k4 * ((a4 - 1.f) * kap + 1.f); const f32x4 r4 = WKV_UNPK(lr); const f32x4 rk = r4 * k2 * rkp; const float bon = row_sum16((rk.x + rk.y) + (rk.z + rk.w)); \
            LAS unsigned char* d_ = (bufp) + lo_ + (ti_) * 1280; *(LAS f32x4*)(d_) = dec; *(LAS f32x4*)(d_ + 256) = -kk; *(LAS f32x4*)(d_ + 512) = kk * a4; *(LAS f32x4*)(d_ + 768) = k2; *(LAS f32x4*)(d_ + 1024) = r4; \
            const int tr_ = (tb0) + (pt >> 4) + (ti_); if (half == 0 && part == 0 && tr_ < Tu) BON[(size_t)(r0 + tr_) * 16 + h] = bon; } while (0)
#define WKV_STORE(bufp, tb0) do { WKV_ITEM(bufp, tb0, lk0, lw0, la0, lr0, 0); if ((tb0) + 16 < Tu) WKV_ITEM(bufp, tb0, lk1, lw1, la1, lr1, 16); \
            f32x4 v4 = WKV_UNPK(lv); if (has_vres) { const f32x4 g4 = WKV_UNPK(lg), f4 = WKV_UNPK(lf); _Pragma("unroll") for (int i_ = 0; i_ < 4; ++i_) v4[i_] = v4[i_] + (f4[i_] - v4[i_]) * frcp(1.f + __expf(-(v0v[i_] + g4[i_]))); } \
            *(LAS f32x4*)((bufp) + lv_) = v4; const int tv_ = (tb0) + (pt >> 3); if (tv_ < Tu) { u32x2 w_; w_.x = pk_bf16(v4.x, v4.y); w_.y = pk_bf16(v4.z, v4.w); *(GAS u32x2*)(VFO + ev_ + (size_t)(tb0) * 1024) = w_; } } while (0)
#define WKV_YOUT(bufp, tb0, ntp) do { const LAS float* yb_ = (const LAS float*)((bufp) + VECB + VVB); const int rl = (pt & 15) * 2; _Pragma("unroll") for (int t = pt >> 4; t < TB; t += 16) if (t < (ntp)) { const f32x2 y2 = *(const LAS f32x2*)(yb_ + t * 32 + rl); \
            *(GAS unsigned*)(Y + (size_t)(r0 + (tb0) + t) * 1024 + h * 64 + half * 32 + rl) = pk_bf16(y2.x, y2.y); } } while (0)
        if (!scanw) { WKV_LOAD(0); WKV_STORE(lds, 0); if (nblk > 1) WKV_LOAD(TB); }
        __syncthreads();
        for (int b = 0; b < nblk; ++b) {
            LAS unsigned char* cur = lds + (b & 1) * BUF; LAS unsigned char* nxt = lds + ((b + 1) & 1) * BUF; const int tb0 = b * TB; const int nt = (Tu - tb0) < TB ? (Tu - tb0) : TB;
            if (scanw) {
                const LAS float* vec = (const LAS float*)cur + sp8 * 8; const LAS float* vv = (const LAS float*)(cur + VECB) + srow; LAS float* yb = (LAS float*)(cur + VECB + VVB);
                LAS float* ybl = yb + srow;
                struct StepV { f32x4 w0, w1, n0, n1, b0, b1, k0, k1, r0, r1; float v; };
#define WKV_RD(dst, t) do { const LAS f32x4* vp_ = (const LAS f32x4*)(vec + (t) * 320); dst.w0 = vp_[0]; dst.w1 = vp_[1]; dst.n0 = vp_[16]; dst.n1 = vp_[17]; dst.b0 = vp_[32]; dst.b1 = vp_[33]; \
                dst.k0 = vp_[48]; dst.k1 = vp_[49]; dst.r0 = vp_[64]; dst.r1 = vp_[65]; dst.v = vv[(t) * 32]; } while (0)
#define WKV_LO(q_) ((f32x2){(q_).x, (q_).y})
#define WKV_HI(q_) ((f32x2){(q_).z, (q_).w})
#define WKV_UPD(S, w_, b_, k_) S = __builtin_elementwise_fma(S, w_, __builtin_elementwise_fma(b_, sa2, (k_) * v2))
#define WKV_CMP(src, t_) do { const f32x2 spa = __builtin_elementwise_fma(S1, WKV_HI(src.n0), S0 * WKV_LO(src.n0)), spb = __builtin_elementwise_fma(S3, WKV_HI(src.n1), S2 * WKV_LO(src.n1)); const f32x2 sp = spa + spb; \
                const float sa = row_sum8(sp.x + sp.y); const f32x2 sa2 = (f32x2){sa, sa}, v2 = (f32x2){src.v, src.v}; \
                WKV_UPD(S0, WKV_LO(src.w0), WKV_LO(src.b0), WKV_LO(src.k0)); WKV_UPD(S1, WKV_HI(src.w0), WKV_HI(src.b0), WKV_HI(src.k0)); WKV_UPD(S2, WKV_LO(src.w1), WKV_LO(src.b1), WKV_LO(src.k1)); WKV_UPD(S3, WKV_HI(src.w1), WKV_HI(src.b1), WKV_HI(src.k1)); \
                const f32x2 ypa = __builtin_elementwise_fma(S1, WKV_HI(src.r0), S0 * WKV_LO(src.r0)), ypb = __builtin_elementwise_fma(S3, WKV_HI(src.r1), S2 * WKV_LO(src.r1)); const f32x2 yp = ypa + ypb; \
                ybl[(t_) * 32] = row_sum8(yp.x + yp.y); } while (0)
#define WKV_ST(t_, cur_, nx2_) do { WKV_RD(nx2_, ((t_) + 2) & 31); __builtin_amdgcn_sched_barrier(0); WKV_CMP(cur_, t_); } while (0)
                if (nt == TB) {
                    StepV sA, sB, sC; WKV_RD(sA, 0); WKV_RD(sB, 1);
#pragma unroll 1
                    for (int t = 0; t < 30; t += 3) { WKV_ST(t, sA, sC); WKV_ST(t + 1, sB, sA); WKV_ST(t + 2, sC, sB); }
                    WKV_ST(30, sA, sC); WKV_ST(31, sB, sA);
                } else { StepV sA; for (int t = 0; t < nt; ++t) { WKV_RD(sA, t); WKV_CMP(sA, t); } }
#undef WKV_RD
#undef WKV_LO
#undef WKV_HI
#undef WKV_UPD
#undef WKV_CMP
#undef WKV_ST
            } else {
                if (b > 0) WKV_YOUT(nxt, tb0 - TB, TB);
                if (b + 1 < nblk) { WKV_STORE(nxt, tb0 + TB); if (b + 2 < nblk) WKV_LOAD(tb0 + 2 * TB); }
            }
            __syncthreads();
        }
        if (!scanw) { const int tbl = (nblk - 1) * TB; WKV_YOUT(lds + ((nblk - 1) & 1) * BUF, tbl, Tu - tbl); }
#undef WKV_LOAD
#undef WKV_STORE
#undef WKV_ITEM
#undef WKV_YOUT
#undef WKV_UNPK
        if (scanw) { GAS float* so = (smp ? SOUT : P) + ((size_t)pair * 64 + half * 32 + srow) * 64 + sp8 * 8; *(GAS f32x4*)so = (f32x4){S0.x, S0.y, S1.x, S1.y}; *(GAS f32x4*)(so + 4) = (f32x4){S2.x, S2.y, S3.x, S3.y}; }
        __syncthreads();
    }
    if (DT <= 4) {
        const int grp = __builtin_amdgcn_readfirstlane(tid) >> 8, t4 = tid & 255, srow = t4 >> 3, sp8 = t4 & 7;
        for (int u = nprompt + bid + nb * grp; u < nunits_all; u += nb * 2) {
            const int q0_ = u - nprompt; const int q = ((q0_ & 7) << 1 | ((q0_ >> 3) & 1)) + ((q0_ >> 4) << 4);
            const int half = q & 1, pair = q >> 1, sq = pair >> 4, h = pair & 15; const int r0 = B * T + sq * DT, vrow = half * 32 + srow;
            const size_t cb_ = (size_t)h * 64 + sp8 * 8, cv_ = (size_t)h * 64 + vrow;
            const GAS f32x4* sp_ = (const GAS f32x4*)(SIN + ((size_t)pair * 64 + vrow) * 64 + sp8 * 8); const f32x4 sa4 = sp_[0], sb4 = sp_[1];
            f32x4 pw0[2], pa0[2], pkk[2], pka[2], prk[2];
#pragma unroll
            for (int i = 0; i < 2; ++i) { pw0[i] = *(const GAS f32x4*)(PRM + cb_ + 4 * i); pa0[i] = *(const GAS f32x4*)(PRM + 1024 + cb_ + 4 * i); pkk[i] = *(const GAS f32x4*)(PRM + 3072 + cb_ + 4 * i); pka[i] = *(const GAS f32x4*)(PRM + 4096 + cb_ + 4 * i); prk[i] = *(const GAS f32x4*)(PRM + 5120 + cb_ + 4 * i); }
            const float v0c = PRM[2048 + cv_];
            u32x4 lk[4], lw[4], la[4], lr[4]; unsigned short lv[4], lg[4], lf[4];
#pragma unroll
            for (int t = 0; t < 4; ++t) { const int tt = t < DT ? t : DT - 1; const size_t ro = (size_t)(r0 + tt) * 1024; lk[t] = *(const GAS u32x4*)(KR + ro + cb_); lw[t] = *(const GAS u32x4*)(WL + ro + cb_); la[t] = *(const GAS u32x4*)(AL + ro + cb_); lr[t] = *(const GAS u32x4*)(R + ro + cb_);
                lv[t] = V[ro + cv_]; lg[t] = has_vres ? VG[ro + cv_] : (unsigned short)0; lf[t] = has_vres ? VFI[ro + cv_] : (unsigned short)0; }
            float S[8] = {sa4.x, sa4.y, sa4.z, sa4.w, sb4.x, sb4.y, sb4.z, sb4.w};
#pragma unroll
            for (int t = 0; t < 4; ++t) if (t < DT) {
                float k8[8], w8[8], a8[8], r8[8];
#pragma unroll
                for (int i = 0; i < 4; ++i) { k8[2 * i] = bflo(lk[t][i]); k8[2 * i + 1] = bfhi(lk[t][i]); w8[2 * i] = bflo(lw[t][i]); w8[2 * i + 1] = bfhi(lw[t][i]); a8[2 * i] = bflo(la[t][i]); a8[2 * i + 1] = bfhi(la[t][i]); r8[2 * i] = bflo(lr[t][i]); r8[2 * i + 1] = bfhi(lr[t][i]); }
                float kv[8], ss = 0.f;
#pragma unroll
                for (int i = 0; i < 8; ++i) { kv[i] = k8[i] * pkk[i >> 2][i & 3]; ss = fmaf(kv[i], kv[i], ss); }
                const float inv = frcp(fmaxf(fsqrt(row_sum8(ss)), 1e-12f));
                float dec[8], nn[8], bb[8], k2[8], bsum = 0.f, sdot = 0.f;
#pragma unroll
                for (int i = 0; i < 8; ++i) { dec[i] = __expf(-0.6065306597126334f * frcp(1.f + __expf(-(pw0[i >> 2][i & 3] + w8[i])))); const float av = frcp(1.f + __expf(-(pa0[i >> 2][i & 3] + a8[i]))); const float kk = kv[i] * inv;
                    nn[i] = -kk; bb[i] = kk * av; k2[i] = k8[i] * ((av - 1.f) * pka[i >> 2][i & 3] + 1.f); bsum = fmaf(r8[i] * k2[i], prk[i >> 2][i & 3], bsum); sdot = fmaf(S[i], nn[i], sdot); }
                const float bon = row_sum8(bsum), sa = row_sum8(sdot);
                float vv = __uint_as_float((unsigned)lv[t] << 16); if (has_vres) vv = vv + (__uint_as_float((unsigned)lf[t] << 16) - vv) * frcp(1.f + __expf(-(v0c + __uint_as_float((unsigned)lg[t] << 16))));
                float yd = 0.f;
#pragma unroll
                for (int i = 0; i < 8; ++i) { S[i] = fmaf(S[i], dec[i], fmaf(bb[i], sa, k2[i] * vv)); yd = fmaf(S[i], r8[i], yd); }
                const float y = row_sum8(yd); const size_t ro = (size_t)(r0 + t) * 1024;
                if (sp8 == 0) { Y[ro + cv_] = (bf16_t)(pk_bf16(y, 0.f) & 0xffffu); VFO[ro + cv_] = (bf16_t)(pk_bf16(vv, 0.f) & 0xffffu); if (vrow == 0) BON[(size_t)(r0 + t) * 16 + h] = bon; } }
            GAS float* so = SOUT + ((size_t)pair * 64 + vrow) * 64 + sp8 * 8; *(GAS f32x4*)so = (f32x4){S[0], S[1], S[2], S[3]}; *(GAS f32x4*)(so + 4) = (f32x4){S[4], S[5], S[6], S[7]};
        }
    }
}

__device__ __forceinline__ void gla_phase(const GAS float* __restrict__ PROJ, const GAS float* __restrict__ LOGA, GAS float* __restrict__ O, GAS float* __restrict__ P, int B, int T, LAS unsigned char* lds, int tid, int bid, int nb) {
    constexpr int TB = 32, OA = 0, OK = 8192, OQ = 16384, OV = 24576, BUF = 26624;
    const int wv = __builtin_amdgcn_readfirstlane(tid) >> 6; const bool scanw = wv < 4; const int pt = tid & 255, lane = tid & 63;
    const int col = pt >> 4, p = pt & 15, dk = p * 4;
    const int nunits = B * 32;
#define GLA_WAITV(n_) asm volatile("s_waitcnt vmcnt(" #n_ ")" ::: "memory")
#define GLA_BAR() do { asm volatile("s_waitcnt lgkmcnt(0)" ::: "memory"); __builtin_amdgcn_s_barrier(); asm volatile("" ::: "memory"); } while (0)
    for (int u = bid; u < nunits; u += nb) {
        const int ug_ = ((u & 7) << 3 | ((u >> 3) & 7)) + ((u >> 6) << 6);
        const int cb = ug_ & 7, pair = ug_ >> 3, s = pair >> 2, h = pair & 3; const int r0 = s * T;
        f32x2 S01 = (f32x2){0.f, 0.f}, S23 = (f32x2){0.f, 0.f};
        const int nblk = (T + TB - 1) / TB;
        const GAS unsigned char* gsrc; size_t gins, gblk; int ldst;
        if (wv == 4) { gsrc = (const GAS unsigned char*)(LOGA + (size_t)(r0 + (lane >> 4)) * 256 + h * 64 + (lane & 15) * 4); gins = (size_t)4 * 256 * 4; gblk = (size_t)TB * 256 * 4; ldst = OA; }
        else if (wv == 7) { gsrc = (const GAS unsigned char*)(PROJ + (size_t)(r0 + (lane >> 2)) * 2576 + 512 + h * 128 + cb * 16 + (lane & 3) * 4); gins = (size_t)16 * 2576 * 4; gblk = (size_t)TB * 2576 * 4; ldst = OV; }
        else { gsrc = (const GAS unsigned char*)(PROJ + (size_t)(r0 + (lane >> 4)) * 2576 + (wv == 5 ? 256 : 0) + h * 64 + (lane & 15) * 4); gins = (size_t)4 * 2576 * 4; gblk = (size_t)TB * 2576 * 4; ldst = wv == 5 ? OK : OQ; }
#define GLA_DMA(blk_) do { const GAS unsigned char* s_ = gsrc + (size_t)(blk_) * gblk; LAS unsigned char* d_ = lds + ((blk_) % 3) * BUF + ldst; \
            if (wv == 7) { __builtin_amdgcn_global_load_lds((const GAS unsigned*)s_, (LAS unsigned*)d_, 16, 0, 0); __builtin_amdgcn_global_load_lds((const GAS unsigned*)(s_ + gins), (LAS unsigned*)(d_ + 1024), 16, 0, 0); } \
            else { _Pragma("unroll") for (int i_ = 0; i_ < 8; ++i_) __builtin_amdgcn_global_load_lds((const GAS unsigned*)(s_ + i_ * gins), (LAS unsigned*)(d_ + i_ * 1024), 16, 0, 0); } } while (0)
        if (!scanw) { GLA_DMA(0); if (nblk > 1) { GLA_DMA(1); if (wv == 7) GLA_WAITV(2); else GLA_WAITV(8); } else GLA_WAITV(0); }
        GLA_BAR();
        for (int b = 0; b < nblk; ++b) {
            const int tb0 = b * TB; const int nt = (T - tb0) < TB ? (T - tb0) : TB;
            if (scanw) {
                const LAS unsigned char* cur = lds + (b % 3) * BUF; const LAS float* vec = (const LAS float*)cur + dk; const LAS float* vv = (const LAS float*)(cur + OV) + col;
                float okeep0 = 0.f, okeep1 = 0.f;
                struct G4 { f32x4 a[4], k[4], q[4]; float v[4]; };
#define GLA_RD4(dst, t0_) do { _Pragma("unroll") for (int i_ = 0; i_ < 4; ++i_) { const LAS float* vp_ = vec + ((t0_) + i_) * 64; dst.a[i_] = *(const LAS f32x4*)vp_; dst.k[i_] = *(const LAS f32x4*)(vp_ + OK / 4); dst.q[i_] = *(const LAS f32x4*)(vp_ + OQ / 4); dst.v[i_] = vv[((t0_) + i_) * 16]; } } while (0)
#define GLA_ONE(src, i_, keep, tl) do { const f32x4 a4 = src.a[i_], k4 = src.k[i_], q4 = src.q[i_]; const f32x2 v2 = (f32x2){src.v[i_], src.v[i_]}; \
                S01 = __builtin_elementwise_fma((f32x2){a4.x, a4.y}, S01, (f32x2){k4.x, k4.y} * v2); S23 = __builtin_elementwise_fma((f32x2){a4.z, a4.w}, S23, (f32x2){k4.z, k4.w} * v2); \
                const f32x2 o2 = __builtin_elementwise_fma((f32x2){q4.z, q4.w}, S23, (f32x2){q4.x, q4.y} * S01); const float o = row_sum16(o2.x + o2.y); keep = (p == (tl)) ? o : keep; } while (0)
#define GLA_CMP4(src, keep, tl0) do { GLA_ONE(src, 0, keep, tl0); GLA_ONE(src, 1, keep, (tl0) + 1); GLA_ONE(src, 2, keep, (tl0) + 2); GLA_ONE(src, 3, keep, (tl0) + 3); } while (0)
                if (nt == TB) {
                    G4 gA, gB; GLA_RD4(gA, 0);
                    GLA_RD4(gB, 4); __builtin_amdgcn_sched_barrier(0); GLA_CMP4(gA, okeep0, 0); GLA_RD4(gA, 8); __builtin_amdgcn_sched_barrier(0); GLA_CMP4(gB, okeep0, 4);
                    GLA_RD4(gB, 12); __builtin_amdgcn_sched_barrier(0); GLA_CMP4(gA, okeep0, 8); GLA_RD4(gA, 16); __builtin_amdgcn_sched_barrier(0); GLA_CMP4(gB, okeep0, 12);
                    GLA_RD4(gB, 20); __builtin_amdgcn_sched_barrier(0); GLA_CMP4(gA, okeep1, 0); GLA_RD4(gA, 24); __builtin_amdgcn_sched_barrier(0); GLA_CMP4(gB, okeep1, 4);
                    GLA_RD4(gB, 28); __builtin_amdgcn_sched_barrier(0); GLA_CMP4(gA, okeep1, 8); __builtin_amdgcn_sched_barrier(0); GLA_CMP4(gB, okeep1, 12);
                } else { G4 g1; for (int t = 0; t < nt; ++t) { const LAS float* vp_ = vec + t * 64; g1.a[0] = *(const LAS f32x4*)vp_; g1.k[0] = *(const LAS f32x4*)(vp_ + OK / 4); g1.q[0] = *(const LAS f32x4*)(vp_ + OQ / 4); g1.v[0] = vv[t * 16];
                    if (t < 16) GLA_ONE(g1, 0, okeep0, t); else GLA_ONE(g1, 0, okeep1, t - 16); } }
#undef GLA_RD4
#undef GLA_ONE
#undef GLA_CMP4
                { int pt_ = pt; asm volatile("" : "+v"(pt_)); const int p_ = pt_ & 15; GAS float* od = O + (size_t)(r0 + tb0 + p_) * 512 + h * 128 + cb * 16 + (pt_ >> 4);
                  if (p_ < nt) od[0] = okeep0 * 0.125f; if (16 + p_ < nt) od[(size_t)16 * 512] = okeep1 * 0.125f; }
            } else {
                if (b + 2 < nblk) { GLA_DMA(b + 2); if (wv == 7) GLA_WAITV(2); else GLA_WAITV(8); } else GLA_WAITV(0);
            }
            GLA_BAR();
        }
#undef GLA_DMA
        if (scanw) { int pt_ = pt; asm volatile("" : "+v"(pt_));
                     GAS float* so = P + ((size_t)pair * 64 + (pt_ & 15) * 4) * 128 + cb * 16 + (pt_ >> 4); so[0] = S01.x; so[128] = S01.y; so[256] = S23.x; so[384] = S23.y; }
        GLA_BAR();
    }
#undef GLA_WAITV
#undef GLA_BAR
}
__device__ __forceinline__ float grp8_sum(float v) { v += dppf<0xB1>(v); v += dppf<0x4E>(v); v += dppf<0x141>(v); return v; }
__device__ __forceinline__ float dot16_fp8_bf16(const u32x4 uw, const float (&x)[16]) { float s = 0.f;
#pragma unroll
    for (int d = 0; d < 4; ++d) { const f32x2 lo = fp8lo(uw[d]), hi = fp8hi(uw[d]); s = fmaf(lo.x, x[4 * d], s); s = fmaf(lo.y, x[4 * d + 1], s); s = fmaf(hi.x, x[4 * d + 2], s); s = fmaf(hi.y, x[4 * d + 3], s); }
    return s; }
typedef int i32x8 __attribute__((ext_vector_type(8)));
typedef unsigned u32x8 __attribute__((ext_vector_type(8)));
__device__ __forceinline__ void pacts_phase(const GAS unsigned char* XF8, const GAS unsigned char* U8S, const GAS int* EIDX, GAS bf16_t* __restrict__ PART, int M, int emask,
                                            LAS unsigned char* lds, int wid, int lane, int bid, int nb) {
    const bool spl = (nb & 7) == 0; const int s0 = spl ? (bid & 7) : 0, s1 = spl ? s0 + 1 : 8, r = spl ? (bid >> 3) : bid, nr = spl ? (nb >> 3) : nb;
    const int g = lane >> 3, c = lane & 7, fg = ((g >> 2) & 1) | (((g >> 1) & 1) << 2);
    const int m16 = lane & 15, kb = lane >> 4, fm = ((m16 >> 2) & 1) | (((m16 >> 1) & 1) << 2);
    LAS unsigned char* const wl = lds + wid * 16384;
    const LAS unsigned char* const ard = wl + m16 * 128 + (((2 * kb) ^ fm) * 16);
    const LAS unsigned char* const xrd = wl + 12288 + (m16 & 1) * 128 + kb * 32;
    const LAS unsigned char* const ird = wl + 13824 + g * 4;
    if (r >= M) return;
    const int ntok = (M - r + nr - 1) / nr;
#define PL_ROW(t_) ({ int rw_ = r + nr * (t_); rw_ < M ? rw_ : r; })
#define PL_IDS(t_, slot_) __builtin_amdgcn_global_load_lds((const GAS unsigned*)(isrc + (size_t)PL_ROW(t_) * 128), (LAS unsigned*)(wl + 13824 + (slot_) * 256), 4, 0, 0)
#define PL_RDIDS(slot_, e0_, e1_) do { e0_ = *(const LAS int*)(ird + (slot_) * 256); e1_ = *(const LAS int*)(ird + (slot_) * 256 + 32); } while (0)
#define PL_TILE(t_, slot_, e0_, e1_) do { \
        __builtin_amdgcn_global_load_lds((const GAS unsigned*)(tb + (size_t)((e0_) & emask) * 128), (LAS unsigned*)(wl + (slot_) * 2048), 16, 0, 0); \
        __builtin_amdgcn_global_load_lds((const GAS unsigned*)(tb + (size_t)((e1_) & emask) * 128), (LAS unsigned*)(wl + (slot_) * 2048 + 1024), 16, 0, 0); \
        __builtin_amdgcn_global_load_lds((const GAS unsigned*)(xsrc + (size_t)PL_ROW(t_) * 2048), (LAS unsigned*)(wl + 12288 + (slot_) * 256), 4, 0, 0); } while (0)
#define PL_RD(slot_, a0_, a1_, x0_, x1_) do { a0_ = *(const LAS u32x4*)(ard + (slot_) * 2048); a1_ = *(const LAS u32x4*)(ard2 + (slot_) * 2048); x0_ = *(const LAS u32x4*)(xrd + (slot_) * 256); x1_ = *(const LAS u32x4*)(xrd + (slot_) * 256 + 16); } while (0)
#define PL_MMA(cc_, a0_, a1_, x0_, x1_) do { const i32x8 av = (i32x8)__builtin_shufflevector(a0_, a1_, 0, 1, 2, 3, 4, 5, 6, 7), bv = (i32x8)__builtin_shufflevector(x0_, x1_, 0, 1, 2, 3, 4, 5, 6, 7); const f32x4 z = {0.f, 0.f, 0.f, 0.f}; \
        cc_ = __builtin_amdgcn_mfma_scale_f32_16x16x128_f8f6f4(av, bv, z, 0, 0, 0, 0, 0, 0); } while (0)
#define PL_OUT(t_, cc_) do { f32x4 o; _Pragma("unroll") for (int i = 0; i < 4; ++i) { float v = cc_[i]; v += dppf<0xB1>(v); o[i] = v * (1.f / 16.f); } \
        const int rw = r + nr * (t_); if (m16 == 0 && rw < M) { u32x2 w_; w_.x = pk_bf16(o[0], o[1]); w_.y = pk_bf16(o[2], o[3]); *(GAS u32x2*)(po + (size_t)rw * 128) = w_; } } while (0)
#define PL_WAIT(n_) asm volatile("s_waitcnt vmcnt(" #n_ ")" ::: "memory")
#define PL_STEP(j_, h_) do { PL_WAIT(12); u32x4 a0[3], a1[3], x0[3], x1[3]; int e0[3], e1[3]; f32x4 cc[3]; \
        _Pragma("unroll") for (int k = 0; k < 3; ++k) PL_RD((h_) * 3 + k, a0[k], a1[k], x0[k], x1[k]); \
        _Pragma("unroll") for (int k = 0; k < 3; ++k) PL_RDIDS((h_) * 3 + k, e0[k], e1[k]); \
        _Pragma("unroll") for (int k = 0; k < 3; ++k) PL_MMA(cc[k], a0[k], a1[k], x0[k], x1[k]); \
        _Pragma("unroll") for (int k = 0; k < 3; ++k) PL_TILE((j_) + 6 + k, (h_) * 3 + k, e0[k], e1[k]); \
        _Pragma("unroll") for (int k = 0; k < 3; ++k) PL_IDS((j_) + 12 + k, (h_) * 3 + k); \
        _Pragma("unroll") for (int k = 0; k < 3; ++k) PL_OUT((j_) + k, cc[k]); } while (0)
    const LAS unsigned char* const ard2 = (const LAS unsigned char*)((unsigned)(size_t)ard ^ 16u);
    for (int s = s0; s < s1; ++s) {
        const GAS unsigned char* tb = U8S + (size_t)s * 16384 * 128 + ((c ^ fg) * 16);
        const GAS unsigned char* xsrc = XF8 + (size_t)(lane >> 5) * 1024 + s * 128 + (lane & 31) * 4;
        const GAS int* isrc = EIDX + wid * 16 + m16;
        GAS bf16_t* po = PART + (size_t)s * M * 128 + wid * 16 + kb * 4;
        PL_IDS(0, 0); PL_IDS(1, 1); PL_IDS(2, 2); PL_IDS(3, 3); PL_IDS(4, 4); PL_IDS(5, 5); PL_WAIT(0);
        { int e0[6], e1[6];
#pragma unroll
          for (int k = 0; k < 6; ++k) PL_RDIDS(k, e0[k], e1[k]);
#pragma unroll
          for (int k = 0; k < 3; ++k) PL_TILE(k, k, e0[k], e1[k]);
#pragma unroll
          for (int k = 0; k < 3; ++k) PL_IDS(6 + k, k);
#pragma unroll
          for (int k = 3; k < 6; ++k) PL_TILE(k, k, e0[k], e1[k]);
#pragma unroll
          for (int k = 3; k < 6; ++k) PL_IDS(6 + k, k); }
        for (int j = 0; j < ntok; j += 6) { PL_STEP(j, 0); PL_STEP(j + 3, 1); }
        PL_WAIT(0);
    }
#undef PL_ROW
#undef PL_IDS
#undef PL_RDIDS
#undef PL_TILE
#undef PL_RD
#undef PL_MMA
#undef PL_OUT
#undef PL_WAIT
#undef PL_STEP
}
__device__ __forceinline__ void pouts_phase(const GAS float* __restrict__ COEF, const GAS int* __restrict__ EIDX, const GAS unsigned char* V8S, GAS bf16_t* __restrict__ YBUF, int M,
                                            int wid, int lane, int bid, int nb) {
    const bool spl = (nb & 7) == 0; const int s0 = spl ? (bid & 7) : 0, s1 = spl ? s0 + 1 : 8, r = spl ? (bid >> 3) : bid, nr = spl ? (nb >> 3) : nb;
    const int g = lane >> 3, ch = lane & 7, rstep = nr * 8;
#define PO_LOADCE(rw, c0, c1, v0, v1) do { c0 = COEF[(size_t)(rw) * 128 + lane] * (1.f / 64.f); c1 = COEF[(size_t)(rw) * 128 + 64 + lane] * (1.f / 64.f); v0 = EIDX[(size_t)(rw) * 128 + lane]; v1 = EIDX[(size_t)(rw) * 128 + 64 + lane]; } while (0)
#define PO_GATHER(vv_, vreg) do { _Pragma("unroll") for (int k = 0; k < 8; ++k) { const int e = __builtin_amdgcn_ds_bpermute((8 * k + g) << 2, vreg); vv_[k] = *(const GAS u32x4*)(tb + (size_t)(e & 16383) * 128); } } while (0)
#define PO_COMP(vv_, creg) do { _Pragma("unroll") for (int k = 0; k < 8; ++k) { const float c = __int_as_float(__builtin_amdgcn_ds_bpermute((8 * k + g) << 2, __float_as_int(creg))); const u32x4 w = vv_[k]; \
        const f32x2 c2 = (f32x2){c, c}; _Pragma("unroll") for (int d = 0; d < 4; ++d) { ac2[2 * d] = __builtin_elementwise_fma(c2, fp8lo(w[d]), ac2[2 * d]); ac2[2 * d + 1] = __builtin_elementwise_fma(c2, fp8hi(w[d]), ac2[2 * d + 1]); } \
        _Pragma("unroll") for (int i = 0; i < 8; ++i) asm volatile("" : "+v"(ac2[i])); } } while (0)
    for (int s = s0; s < s1; ++s) {
        const GAS unsigned char* tb = V8S + (size_t)s * 16384 * 128 + ch * 16;
        int row = r + nr * wid; if (row >= M) continue;
        float c0c, c1c, c0n = 0.f, c1n = 0.f; int v0c, v1c, v0n = 0, v1n = 0;
        PO_LOADCE(row, c0c, c1c, v0c, v1c);
        u32x4 va[8], vb[8];
        PO_GATHER(va, v0c);
        for (;;) {
            const int rown = row + rstep; const bool hasn = rown < M;
            PO_GATHER(vb, v1c);
            if (hasn) PO_LOADCE(rown, c0n, c1n, v0n, v1n);
            f32x2 ac2[8];
#pragma unroll
            for (int i = 0; i < 8; ++i) ac2[i] = (f32x2){0.f, 0.f};
            PO_COMP(va, c0c);
            if (hasn) PO_GATHER(va, v0n);
            PO_COMP(vb, c1c);
            float acc[16];
#pragma unroll
            for (int i = 0; i < 8; ++i) { acc[2 * i] = ac2[i].x; acc[2 * i + 1] = ac2[i].y; }
#pragma unroll
            for (int i = 0; i < 16; ++i) acc[i] += dppf<0x128>(acc[i]);
#pragma unroll
            for (int i = 0; i < 8; ++i) { const bool hi = lane & 16; const float send = hi ? acc[i] : acc[i + 8], keep = hi ? acc[i + 8] : acc[i]; acc[i] = keep + shx(send, 16, lane); }
#pragma unroll
            for (int i = 0; i < 4; ++i) { const bool hi = lane & 32; const float send = hi ? acc[i] : acc[i + 4], keep = hi ? acc[i + 4] : acc[i]; acc[i] = keep + shx(send, 32, lane); }
            if ((lane & 8) == 0) { u32x2 w_; w_.x = pk_bf16(acc[0], acc[1]); w_.y = pk_bf16(acc[2], acc[3]); *(GAS u32x2*)(YBUF + (size_t)row * 1024 + s * 128 + ch * 16 + ((lane >> 4) & 1) * 8 + ((lane >> 5) & 1) * 4) = w_; }
            if (!hasn) break;
            row = rown; c0c = c0n; c1c = c1n; v0c = v0n; v1c = v1n;
        }
    }
#undef PO_LOADCE
#undef PO_GATHER
#undef PO_COMP
}
}

template <class T> __device__ __forceinline__ __attribute__((address_space(1))) T* gp(T* p) { return (__attribute__((address_space(1))) T*)uni_ptr(p); }
constexpr int MK_THREADS = 512, LDS_BYTES = 163840, LDSCTL_OFF = 131072, TAB_OFF = LDSCTL_OFF + 1024, MAX_OPS = 208;
static_assert(TAB_OFF + MAX_OPS * (int)sizeof(Op) <= LDS_BYTES, "LDS map");
constexpr int MPAD = 17152;
constexpr size_t CTL_BYTES = (size_t)1 << 20;
struct MArgs { const float* in[47]; float* out; char* ws; unsigned long long ws_size; };
__global__ void __launch_bounds__(MK_THREADS, 2) mega_fwd(MArgs a) {
    extern __shared__ __attribute__((aligned(16))) unsigned char lds[];
    volatile LAS unsigned* ctl = (volatile LAS unsigned*)((LAS unsigned char*)lds + LDSCTL_OFF);
    if (threadIdx.x < 64) ctl[threadIdx.x] = 0u;
    __syncthreads();
    (void)xcd_barrier_post((unsigned*)a.ws, ctl + 8);
    const Dm dm = make_dm(1024, 8, 2048, 128, 4);
    Op* tab = (Op*)(lds + TAB_OFF);
    if (threadIdx.x == 0) {
        const float* const* inp_ = (const float* const*)__builtin_amdgcn_kernarg_segment_ptr(); asm volatile("" : "+s"(inp_));
        NvIO io; io.in = inp_; io.out = a.out; io.ws = a.ws + CTL_BYTES; io.ws_size = a.ws_size - CTL_BYTES;
        int n = 0;
        #ifdef PROBE_DUPCODE
        nv_forward(io, dm, [&](const Op& o) __attribute__((always_inline)) { if (n < MAX_OPS) tab[n] = o; ++n; if ((o.code & 0xff) == PROBE_DUPCODE) { if (n < MAX_OPS) tab[n] = o; ++n; } asm volatile("" ::: "memory"); });
#else
        nv_forward(io, dm, [&](const Op& o) __attribute__((always_inline)) { if (n < MAX_OPS) tab[n] = o; ++n; asm volatile("" ::: "memory"); });
#endif
        ctl[16] = (unsigned)(n <= MAX_OPS ? n : 0);
    }
    __syncthreads();
    const int nops = (int)ctl[16];
    for (int i = 0; i < nops; ++i) {
        int tid_ = (int)threadIdx.x, bid_ = (int)blockIdx.x, nb_ = (int)gridDim.x;
        asm volatile("" : "+v"(tid_)); asm volatile("" : "+s"(bid_)); asm volatile("" : "+s"(nb_));
        const long long g0 = (long long)bid_ * MK_THREADS + tid_, gs = (long long)nb_ * MK_THREADS;
        const Op& o = tab[i];
        const int rawc = __builtin_amdgcn_readfirstlane(o.code); const int code = rawc & 0xff; const long long n = o.n;
        switch (code) {
        case OP_FGEMM: {
            const int fl = rfl(o.i6);
            pg8::Gemm g{uni_ptr((const pg8::bf16_t*)o.a), uni_ptr((const pg8::bf16_t*)o.b), MPAD, rfl(o.i5), rfl(o.i1), rfl(o.i2), rfl(o.i3)};
            if (rawc & OPF_GROUP) {
                int ng = 1; while (ng < 8 && (rfl(tab[i + ng - 1].code) & OPF_GROUP)) ++ng;
                const PG8_LAS Op* gt = (const PG8_LAS Op*)((PG8_LAS unsigned char*)lds + TAB_OFF) + i;
                pg8::GroupOrder S; S.tab = gt; S.ng = ng; S.nM = MPAD / 256; S.G = nb_; S.c = bid_; S.tsA = (size_t)256 * g.lda * 2; S.tsB = (size_t)256 * g.ldb * 2;
                pg8::EpiGroup E{gt, dm.M};
                pg8::gemm_phase<pg8::EpiGroup, pg8::GroupOrder, true, true>((PG8_LAS unsigned char*)lds, g, S, E);
                i += ng - 1;
            } else {
            pg8::StaticOrder S; S.init(g, nb_, bid_); if (fl & 2) S.acs = 512;
            float* const c0 = uni_ptr(o.o0); const int ldc0 = rfl(o.i4), nreal0 = rfl(o.i0);
            if (fl & 1) { pg8::EpiBf16Plain E{(pg8::bf16_t*)c0, ldc0}; pg8::gemm_phase<pg8::EpiBf16Plain, pg8::StaticOrder, true, true>((PG8_LAS unsigned char*)lds, g, S, E); }
            else { pg8::EpiF32 E{c0, ldc0, dm.M, nreal0}; pg8::gemm_phase<pg8::EpiF32, pg8::StaticOrder, true, true>((PG8_LAS unsigned char*)lds, g, S, E); }
            }
        } break;
        case OP_LRUG2: {
            pg8::Gemm g{uni_ptr((const pg8::bf16_t*)o.a), uni_ptr((const pg8::bf16_t*)o.b), MPAD, 1024, 512, 512, 512};
            pg8::StaticOrder S; S.init(g, nb_, bid_);
            pg8::EpiLru E{uni_ptr(o.c), uni_ptr(o.d), uni_ptr(o.e), uni_ptr((const pg8::bf16_t*)o.f), uni_ptr(o.o0), uni_ptr(o.o1), dm.M};
            pg8::gemm_phase<pg8::EpiLru, pg8::StaticOrder, true, true>((PG8_LAS unsigned char*)lds, g, S, E);
        } break;
        case OP_WKVP: fk::wkv2_phase(gp((const fk::bf16_t*)o.a), gp((const fk::bf16_t*)o.b), gp((const fk::bf16_t*)o.c), gp((const fk::bf16_t*)o.d), gp((const fk::bf16_t*)o.e), gp((const fk::bf16_t*)o.f), gp((const fk::bf16_t*)o.g), gp(o.h), gp((const float*)o.o5), gp((fk::bf16_t*)o.o0), gp(o.o1), gp(o.o2), gp((fk::bf16_t*)o.o3), gp(o.o4), rfl(o.i0), dm.B, dm.T, dm.DB, dm.DT, (LAS unsigned char*)lds, tid_, bid_, nb_); break;
        case OP_POST2: fk::rwkvpost2_phase(gp((const fk::bf16_t*)o.a), gp((const fk::bf16_t*)o.b), gp((const fk::bf16_t*)o.c), gp(o.d), gp(o.e), gp(o.f), gp((fk::bf16_t*)o.o0), dm.M * 16, tid_ & 63, bid_ * 8 + (tid_ >> 6), nb_ * 8); break;
        case OP_GLAF: fk::gla_phase(gp(o.a), gp(o.b), gp(o.o0), gp(o.o1), dm.B, dm.T, (LAS unsigned char*)lds, tid_, bid_, nb_); break;
        case OP_PACTS: fk::pacts_phase(gp((const unsigned char*)o.a), gp((const unsigned char*)o.b), gp((const int*)o.d), gp((fk::bf16_t*)o.o0), dm.M, rfl(o.i0), (LAS unsigned char*)lds, rfl(tid_ >> 6), tid_ & 63, bid_, nb_); break;
        case OP_POUTS: fk::pouts_phase(gp(o.a), gp((const int*)o.b), gp((const unsigned char*)o.c), gp((fk::bf16_t*)o.o0), dm.M, tid_ >> 6, tid_ & 63, bid_, nb_); break;
        case OP_TOPK2: fk::topk_phase(gp((const fk::bf16_t*)o.a), gp((const fk::bf16_t*)o.b), gp(o.c), gp(o.o0), gp((int*)o.o1), dm.M * 8, (LAS unsigned char*)lds, tid_ >> 6, tid_ & 63, bid_ * 8 + (tid_ >> 6), nb_ * 8); break;
        case OP_LNRES: fk::lnres_phase(gp((const fk::bf16_t*)o.a), gp(o.b), gp(o.c), gp(o.o0), gp((fk::bf16_t*)o.o1), gp((unsigned char*)o.o2), dm.M, tid_ & 63, bid_ * 8 + (tid_ >> 6), nb_ * 8); break;
        case OP_GLANORM: fk::glanorm_phase(gp(o.a), gp(o.b), gp(o.c), gp((fk::bf16_t*)o.o0), dm.M * 4, tid_ & 63, bid_ * 8 + (tid_ >> 6), nb_ * 8); break;
        case OP_CVTTAB8S: {
            int X = rfl(o.i6) % nb_; X = (X < nb_ - 1) ? X : 0;
            if (bid_ >= X) { const long long gs2 = (long long)(nb_ - X) * MK_THREADS; for (long long g = (long long)(bid_ - X) * MK_THREADS + tid_; g < n; g += gs2) nv_elem(OP_CVTTAB8S, o, dm, g); } } break;
#define NVC(c) case c: for (long long g = g0; g < n; g += gs) nv_elem(c, o, dm, g); break;
        NVC(OP_LOGA4) NVC(OP_CONVOUT) NVC(OP_SHIFTOUT) NVC(OP_EMBED4) NVC(OP_YOUT4) NVC(OP_MIX6) NVC(OP_CONV4) NVC(OP_CVT8) NVC(OP_WGATE)
        NVC(OP_WT) NVC(OP_PRED) NVC(OP_PRM) NVC(OP_KEYS) NVC(OP_GLA3) NVC(OP_LRU1) NVC(OP_LRU3)
#undef NVC
        default: break;
        }
        if (__builtin_amdgcn_readfirstlane(tab[i].code) & OPF_NOBAR) __syncthreads(); else { XcdBarrier bar; bar.bar = (unsigned*)a.ws; bar.x = xb_xcc_id(); bar.st = ctl + 8; xcd_barrier(bar); }
    }
}
extern "C" void kernel_launch(void* const* d_in, const int* in_sizes, int n_in, void* d_out, int out_size, void* d_ws, size_t ws_size, hipStream_t stream) {
    static int grid = 0;
    if (grid == 0) {
        if (n_in != 47 || ws_size < ((size_t)900 << 20)) { fprintf(stderr, "kernel_launch: expected 47 inputs and >= 900 MiB of workspace; got %d, %zu\n", n_in, ws_size); grid = -1; return; }
        int dev = 0, cus = 0, per_cu = 0;
        if (hipGetDevice(&dev) != hipSuccess || hipDeviceGetAttribute(&cus, hipDeviceAttributeMultiprocessorCount, dev) != hipSuccess) { grid = -1; return; }
        if (hipFuncSetAttribute((const void*)mega_fwd, hipFuncAttributeMaxDynamicSharedMemorySize, LDS_BYTES) != hipSuccess) { fprintf(stderr, "kernel_launch: hipFuncSetAttribute failed\n"); grid = -1; return; }
        if (hipOccupancyMaxActiveBlocksPerMultiprocessor(&per_cu, (const void*)mega_fwd, MK_THREADS, LDS_BYTES) != hipSuccess || per_cu < 1) fprintf(stderr, "kernel_launch: occupancy query says %d per CU\n", per_cu);
        (void)hipGetLastError();
        grid = cus;
    }
    if (grid < 0) return;
    if (hipMemsetAsync(d_ws, 0, CTL_BYTES, stream) != hipSuccess) { fprintf(stderr, "kernel_launch: memset failed\n"); return; }
    MArgs a{}; for (int i = 0; i < 47; ++i) a.in[i] = (const float*)d_in[i]; a.out = (float*)d_out; a.ws = (char*)d_ws; a.ws_size = (unsigned long long)ws_size;
    hipLaunchKernelGGL(mega_fwd, dim3(grid), dim3(MK_THREADS), LDS_BYTES, stream, a);
}
```

```cpp
#include <hip/hip_runtime.h>
#include <cstdio>
#include <cmath>
#ifndef HD
#define HD __host__ __device__ __forceinline__
#endif
struct Dm { int D, B, T, DB, DT, M, NSEQ, RH; };
HD Dm make_dm(int D, int B, int SEQ, int DB, int DT) { Dm d; d.D = D; d.B = B; d.T = SEQ + 16; d.DB = DB; d.DT = DT; d.M = B * d.T + DB * DT; d.NSEQ = B + DB; d.RH = D / 64; return d; }
HD int seq_row0(const Dm& d, int s) { return s < d.B ? s * d.T : d.B * d.T + (s - d.B) * d.DT; }
HD int seq_len(const Dm& d, int s) { return s < d.B ? d.T : d.DT; }
HD void row_to_seq(const Dm& d, int row, int& s, int& t) { if (row < d.B * d.T) { s = row / d.T; t = row % d.T; } else { int r = row - d.B * d.T; s = d.B + r / d.DT; t = r % d.DT; } }

constexpr int MIXIN = 2576, C_Q = 0, C_K = 256, C_V = 512, C_GLR = 1024, C_R = 1040, C_XB = 1552, C_GB = 2064;

enum { OP_EMBED = 1, OP_GEMM, OP_LOGA, OP_GLA, OP_GLANORM, OP_CONV, OP_CONVOUT, OP_LRUG, OP_LRUSCAN, OP_LNRES, OP_MIX, OP_SHIFTOUT,
       OP_RWKVPREP, OP_WKV, OP_RWKVPOST, OP_QNORM, OP_SCORES, OP_TOPK, OP_PACT1, OP_PACT2, OP_POUT, OP_YOUT, OP_WT, OP_CVT, OP_FGEMM, OP_CVTTAB, OP_KEYS, OP_TOPK2, OP_PACT, OP_POUTLN, OP_GLA1, OP_GLA2, OP_GLA3, OP_LRU1, OP_LRU2, OP_LRU3, OP_EMBED4, OP_YOUT4, OP_MIX8, OP_CONV4, OP_CVT8, OP_WGATE, OP_LRUG2, OP_WKVF, OP_GLAF, OP_CVTTAB8, OP_CVTTAB8S, OP_PACTS, OP_PRED, OP_POUTS, OP_MIX6, OP_PRM, OP_WKVP, OP_POST2, OP_LOGA4 };

constexpr int OPF_NOBAR = 0x100, OPF_GROUP = 0x200;
struct Op {
    const float *a, *b, *c, *d, *e, *f, *g, *h;
    float *o0, *o1, *o2, *o3, *o4, *o5;
    long long n;
    int code, i0, i1, i2, i3, i4, i5, i6;
};

#if defined(__HIP_DEVICE_COMPILE__)
#define NV_UNI(x) __builtin_amdgcn_readfirstlane(x)
#define NV_LAUNDER(p) asm volatile("" : "+s"(p))
#define NV_FENCE() asm volatile("" ::: "memory")
#else
#define NV_FENCE() do {} while (0)
#define NV_UNI(x) (x)
#define NV_LAUNDER(p) do {} while (0)
#endif
typedef unsigned short nvbf;
HD nvbf nv_f2bf(float f) { unsigned u; __builtin_memcpy(&u, &f, 4); return (nvbf)((u + 0x7fffu + ((u >> 16) & 1u)) >> 16); }
HD float nv_bf2f(nvbf h) { unsigned u = (unsigned)h << 16; float f; __builtin_memcpy(&f, &u, 4); return f; }
HD unsigned nv_f2e4m3(float f) {
    unsigned u; __builtin_memcpy(&u, &f, 4); const unsigned sign = (u >> 24) & 0x80u; const float a = fabsf(f);
    if (!(a < 448.f)) return sign | 0x7Eu;
    if (a < 0.015625f) return sign | (unsigned)rintf(a * 512.f);
    unsigned au = u & 0x7fffffffu; au += 0x7ffffu + ((au >> 20) & 1u);
    const unsigned e = ((au >> 23) & 0xffu) - 120u, m = (au >> 20) & 7u; unsigned code = (e << 3) | m; if (code > 0x7Eu) code = 0x7Eu;
    return sign | code; }
HD float nv_e4m32f(unsigned c) { const unsigned e = (c >> 3) & 15u, m = c & 7u; const float v = e ? ldexpf(1.f + m * 0.125f, (int)e - 7) : m * 0.001953125f; return (c & 0x80u) ? -v : v; }
HD int nv_rup(int x, int m) { return (x + m - 1) / m * m; }
struct alignas(16) NvF4 { float x, y, z, w; };
struct alignas(16) NvU4 { unsigned x, y, z, w; };
struct alignas(8) NvU2 { unsigned x, y; };
#if defined(__HIP_DEVICE_COMPILE__)
#define NV_EXP(x) __expf(x)
#define NV_TANH(x) (1.f - 2.f * __builtin_amdgcn_rcpf(1.f + __expf(2.f * (x))))
HD float nv_sigmoid(float x) { return __builtin_amdgcn_rcpf(1.f + __expf(-x)); }
HD float nv_softplus(float x) { return fmaxf(x, 0.f) + __logf(1.f + __expf(-fabsf(x))); }
HD float nv_gelu(float x) { return x * __builtin_amdgcn_rcpf(1.f + __expf(-1.5957691216057308f * (x + 0.044715f * x * x * x))); }
#else
#define NV_EXP(x) expf(x)
#define NV_TANH(x) tanhf(x)
HD float nv_sigmoid(float x) { return 1.f / (1.f + expf(-x)); }
HD float nv_softplus(float x) { return fmaxf(x, 0.f) + log1pf(expf(-fabsf(x))); }
HD float nv_gelu(float x) { return 0.5f * x * (1.f + tanhf(0.7978845608028654f * (x + 0.044715f * x * x * x))); }
#endif

#define NV_INS16(tv, ti, val, idx) do { float _v = (val); int _i = (idx); _Pragma("unroll") for (int _j = 0; _j < 16; ++_j) { if (_v > tv[_j]) { float _tv = tv[_j]; int _ti = ti[_j]; tv[_j] = _v; ti[_j] = _i; _v = _tv; _i = _ti; } } } while (0)

HD void nv_elem(const int code, const Op& p, const Dm& dm, long long gid) {
    const int D = dm.D; float* const PO1 = p.o1; float* const PO2 = p.o2;
    switch (code) {
    case OP_EMBED: {
        int row = (int)(gid / D), c = (int)(gid % D); float v;
        if (row < dm.B * dm.T) { int bb = row / dm.T, t = row % dm.T; v = t < 16 ? p.c[t * D + c] : p.a[((size_t)bb * (dm.T - 16) + (t - 16)) * D + c]; }
        else v = p.b[(size_t)(row - dm.B * dm.T) * D + c];
        p.o0[gid] = v; ((nvbf*)p.o1)[gid] = nv_f2bf(v); } break;
    case OP_GEMM: {
        int N4 = p.i0 >> 2, K = p.i1; int m = (int)(gid / N4), nn = (int)(gid % N4) * 4; const float* A = p.a + (size_t)m * p.i2; const float* Bw = p.b + nn; float c0 = 0.f, c1 = 0.f, c2 = 0.f, c3 = 0.f;
        for (int k = 0; k < K; ++k) { float av = A[k]; if (p.i5 == 1) av = NV_TANH(av); else if (p.i5 == 2) av = nv_sigmoid(av); const NvF4 bv = *(const NvF4*)(Bw + (size_t)k * p.i3);
            c0 = fmaf(av, bv.x, c0); c1 = fmaf(av, bv.y, c1); c2 = fmaf(av, bv.z, c2); c3 = fmaf(av, bv.w, c3); }
        float* C = p.o0 + (size_t)m * p.i4 + nn; C[0] = c0; C[1] = c1; C[2] = c2; C[3] = c3; } break;
    case OP_LOGA: {
        int row = (int)(gid / 256), c = (int)(gid % 256); float z = p.c[c];
        for (int r = 0; r < 16; ++r) z = fmaf(p.a[(size_t)row * MIXIN + C_GLR + r], p.b[r * 256 + c], z);
        p.o0[gid] = NV_EXP(-nv_softplus(-z) * (1.f / 16.f)); } break;
    case OP_GLAF:
    case OP_GLA: {
        int s = (int)(gid / 512), h = (int)((gid / 128) % 4), col = (int)(gid % 128);
        float S[64];
        const float* sin = (s < dm.B) ? nullptr : p.c + (((size_t)(s - dm.B) * 4 + h) * 64) * 128 + col;
#pragma unroll
        for (int k = 0; k < 64; ++k) S[k] = sin ? sin[(size_t)k * 128] : 0.f;
        int r0 = seq_row0(dm, s), L = seq_len(dm, s);
        for (int t = 0; t < L; ++t) {
            const float* pr = p.a + (size_t)(r0 + t) * MIXIN; const float* la = p.b + (size_t)(r0 + t) * 256 + h * 64;
            float v = pr[C_V + h * 128 + col], o = 0.f;
#pragma unroll
            for (int k = 0; k < 64; ++k) { if ((k & 7) == 0) NV_FENCE(); S[k] = fmaf(la[k], S[k], pr[C_K + h * 64 + k] * v); o = fmaf(pr[C_Q + h * 64 + k] * 0.125f, S[k], o); }
            p.o0[(size_t)(r0 + t) * 512 + h * 128 + col] = o;
        }
        float* so = (s < dm.B) ? PO1 + (((size_t)s * 4 + h) * 64) * 128 + col : PO2 + (((size_t)(s - dm.B) * 4 + h) * 64) * 128 + col;
#pragma unroll
        for (int k = 0; k < 64; ++k) so[(size_t)k * 128] = S[k]; } break;
    case OP_GLA1: {
        const int NC = p.i0; const int u = NV_UNI((int)(gid / 128)), col = (int)(gid % 128); const int s = u / (4 * NC), h = (u / NC) % 4, c = u % NC;
        const int r0 = seq_row0(dm, s) + c * 64; int L = dm.T - c * 64; L = L > 64 ? 64 : L;
        float S[64];
#pragma unroll
        for (int k = 0; k < 64; ++k) S[k] = 0.f;
        float dprod = 1.f;
        for (int t = 0; t < L; ++t) {
            const float* pr = p.a + (size_t)(r0 + t) * MIXIN; const float* la = p.b + (size_t)(r0 + t) * 256 + h * 64; const float v = pr[C_V + h * 128 + col];
            if (col < 64) dprod *= la[col];
#pragma unroll
            for (int k = 0; k < 64; ++k) { if ((k & 7) == 0) NV_FENCE(); S[k] = fmaf(la[k], S[k], pr[C_K + h * 64 + k] * v); }
        }
        float* so = p.o0 + (size_t)u * 8192 + col;
#pragma unroll
        for (int k = 0; k < 64; ++k) so[(size_t)k * 128] = S[k];
        if (col < 64) p.o1[(size_t)u * 64 + col] = dprod; } break;
    case OP_GLA2: {
        const int NC = p.i0; const int pair = (int)(gid / 8192), e = (int)(gid % 8192), dk = e / 128; float S = 0.f;
        for (int c = 0; c < NC; ++c) { const size_t ix = ((size_t)pair * NC + c) * 8192 + e; const float l = p.o0[ix]; p.o0[ix] = S; S = fmaf(p.a[((size_t)pair * NC + c) * 64 + dk], S, l); }
        p.o1[gid] = S; } break;
    case OP_GLA3: {
        const int NC = p.i0; const int NP = dm.B * 4 * NC; const int u = NV_UNI((int)(gid / 128)) + (p.i1 ? NP : 0), col = (int)(gid % 128); int s, h, r0, L; const float* sin; float* sout = nullptr;
        if (u < NP) { s = u / (4 * NC); h = (u / NC) % 4; const int c = u % NC; r0 = seq_row0(dm, s) + c * 64; L = dm.T - c * 64; L = L > 64 ? 64 : L; sin = p.d + (size_t)u * 8192 + col; }
        else { const int q = u - NP; s = dm.B + q / 4; h = q % 4; r0 = seq_row0(dm, s); L = dm.DT; sin = p.c + (((size_t)(s - dm.B) * 4 + h) * 64) * 128 + col; sout = p.o2 + (((size_t)(s - dm.B) * 4 + h) * 64) * 128 + col; }
        float S[64];
#pragma unroll
        for (int k = 0; k < 64; ++k) S[k] = sin[(size_t)k * 128];
        for (int t = 0; t < L; ++t) {
            const float* pr = p.a + (size_t)(r0 + t) * MIXIN; const float* la = p.b + (size_t)(r0 + t) * 256 + h * 64; const float v = pr[C_V + h * 128 + col]; float o = 0.f;
#pragma unroll
            for (int k = 0; k < 64; ++k) { if ((k & 7) == 0) NV_FENCE(); S[k] = fmaf(la[k], S[k], pr[C_K + h * 64 + k] * v); o = fmaf(pr[C_Q + h * 64 + k] * 0.125f, S[k], o); }
            p.o0[(size_t)(r0 + t) * 512 + h * 128 + col] = o;
        }
        if (sout) {
#pragma unroll
            for (int k = 0; k < 64; ++k) sout[(size_t)k * 128] = S[k]; } } break;
    case OP_LRU1: {
        const int NC = p.i0; const int u = (int)(gid / 512), c = (int)(gid % 512); const int s = u / NC, ch = u % NC; const int r0 = seq_row0(dm, s) + ch * 64; int L = dm.T - ch * 64; L = L > 64 ? 64 : L; float hh = 0.f, ap = 1.f;
#pragma unroll 16
        for (int t = 0; t < L; ++t) { const size_t ix = (size_t)(r0 + t) * 512 + c; const float a = p.a[ix]; hh = fmaf(a, hh, p.b[ix]); ap *= a; }
        p.o0[gid] = ap; p.o1[gid] = hh; } break;
    case OP_LRU2: {
        const int NC = p.i0; const int s = (int)(gid / 512), c = (int)(gid % 512); float hh = 0.f;
#pragma unroll 8
        for (int ch = 0; ch < NC; ++ch) { const size_t ix = ((size_t)s * NC + ch) * 512 + c; const float l = p.o0[ix]; p.o0[ix] = hh; hh = fmaf(p.a[ix], hh, l); }
        p.o1[gid] = hh; } break;
    case OP_LRU3: {
        const int NC = p.i0; const int u = (int)(gid / 512), c = (int)(gid % 512); const int NP = dm.B * NC; int r0, L; float hh; float* hout = nullptr;
        if (u < NP) { const int s = u / NC, ch = u % NC; r0 = seq_row0(dm, s) + ch * 64; L = dm.T - ch * 64; L = L > 64 ? 64 : L; hh = 0.f;
            for (int k0 = 0; k0 < ch; k0 += 16) { float la[16], lb[16];
#pragma unroll
                for (int k = 0; k < 16; ++k) { int kk = k0 + k; kk = kk < ch ? kk : ch - 1; const size_t ix = ((size_t)s * NC + kk) * 512 + c; la[k] = p.f[ix]; lb[k] = p.e[ix]; }
#pragma unroll
                for (int k = 0; k < 16; ++k) if (k0 + k < ch) hh = fmaf(la[k], hh, lb[k]); }
            if (ch == NC - 1) hout = p.o1 + (size_t)s * 512 + c; }
        else { const int q = u - NP; r0 = seq_row0(dm, dm.B + q); L = dm.DT; hh = p.d[(size_t)q * 512 + c]; hout = p.o2 + (size_t)q * 512 + c; }
        for (int t0 = 0; t0 < L; t0 += 16) {
            float av[16], bv[16], gv[16];
#pragma unroll
            for (int k = 0; k < 16; ++k) { int t = t0 + k; t = t < L ? t : L - 1; const size_t r = (size_t)(r0 + t); av[k] = p.a[r * 512 + c]; bv[k] = p.b[r * 512 + c]; gv[k] = p.c[r * MIXIN + C_GB + c]; }
#pragma unroll
            for (int k = 0; k < 16; ++k) if (t0 + k < L) { const size_t r = (size_t)(r0 + t0 + k); hh = fmaf(av[k], hh, bv[k]); ((nvbf*)p.o0)[r * 1024 + 512 + c] = nv_f2bf(hh * nv_gelu(gv[k])); } }
        if (hout) *hout = hh; } break;
    case OP_EMBED4: {
        const int D4 = D / 4; const int row = (int)(gid / D4), c = (int)(gid % D4) * 4; const float* src;
        if (row < dm.B * dm.T) { const int bb = row / dm.T, t = row % dm.T; src = t < 16 ? p.c + (size_t)t * D + c : p.a + ((size_t)bb * (dm.T - 16) + (t - 16)) * D + c; } else src = p.b + (size_t)(row - dm.B * dm.T) * D + c;
        const NvF4 v = *(const NvF4*)src; NvU2 w; w.x = nv_f2bf(v.x) | ((unsigned)nv_f2bf(v.y) << 16); w.y = nv_f2bf(v.z) | ((unsigned)nv_f2bf(v.w) << 16); *(NvU2*)((nvbf*)p.o1 + (size_t)row * D + c) = w; } break;
    case OP_YOUT4: {
        const int D4 = D / 4; const int row = (int)(gid / D4), c = (int)(gid % D4) * 4; const NvU2 w_ = *(const NvU2*)((const nvbf*)p.a + (size_t)row * D + c); NvF4 v; v.x = nv_bf2f((nvbf)(w_.x & 0xffffu)); v.y = nv_bf2f((nvbf)(w_.x >> 16)); v.z = nv_bf2f((nvbf)(w_.y & 0xffffu)); v.w = nv_bf2f((nvbf)(w_.y >> 16));
        if (row < dm.B * dm.T) { const int bb = row / dm.T, t = row % dm.T; if (t >= 16) *(NvF4*)(p.o0 + ((size_t)bb * (dm.T - 16) + (t - 16)) * D + c) = v; }
        else *(NvF4*)(p.o0 + ((size_t)dm.B * (dm.T - 16) + (row - dm.B * dm.T)) * D + c) = v; } break;
    case OP_MIX8: {
        const int D8 = D / 8; const int row = (int)(gid / D8), c = (int)(gid % D8) * 8; int s, t; row_to_seq(dm, row, s, t); const float* x = p.a + (size_t)row * D + c; float xp[8];
        if (t > 0) { for (int i = 0; i < 8; ++i) xp[i] = x[i - D]; } else if (s < dm.B) { for (int i = 0; i < 8; ++i) xp[i] = 0.f; } else { for (int i = 0; i < 8; ++i) xp[i] = p.b[(size_t)(s - dm.B) * D + c + i]; }
        unsigned w[4];
#pragma unroll
        for (int i = 0; i < 4; ++i) { const float lo = x[2 * i] + (xp[2 * i] - x[2 * i]) * p.c[c + 2 * i], hi = x[2 * i + 1] + (xp[2 * i + 1] - x[2 * i + 1]) * p.c[c + 2 * i + 1]; w[i] = nv_f2bf(lo) | ((unsigned)nv_f2bf(hi) << 16); }
        NvU4 o; o.x = w[0]; o.y = w[1]; o.z = w[2]; o.w = w[3]; *(NvU4*)((nvbf*)p.o0 + (size_t)row * D + c) = o; } break;
    case OP_MIX6: {
        const int D8 = D / 8, Q = (dm.M + 3) / 4; const int row0 = (int)(gid / D8), c = (int)(gid % D8) * 8; NvU4 xw[4], pw[4]; NvF4 sh0[4], sh1[4]; int kind[4];
#pragma unroll
        for (int q = 0; q < 4; ++q) { int row = row0 + q * Q; row = row < dm.M ? row : row0; int s, t; row_to_seq(dm, row, s, t); const nvbf* x = (const nvbf*)p.a + (size_t)row * D + c;
            kind[q] = t > 0 ? 0 : (s < dm.B ? 1 : 2); xw[q] = *(const NvU4*)x; pw[q] = *(const NvU4*)(x - (t > 0 ? D : 0));
            const float* sp = p.b + (size_t)(s >= dm.B ? s - dm.B : 0) * D + c; sh0[q] = *(const NvF4*)sp; sh1[q] = *(const NvF4*)(sp + 4); }
        NvF4 mu0[6], mu1[6];
#pragma unroll
        for (int m = 0; m < 6; ++m) { mu0[m] = *(const NvF4*)(p.c + (size_t)m * D + c); mu1[m] = *(const NvF4*)(p.c + (size_t)m * D + c + 4); }
#pragma unroll
        for (int q = 0; q < 4; ++q) { const int row = row0 + q * Q; if (row < dm.M) { float xv[8], dx[8]; const unsigned xs[4] = {xw[q].x, xw[q].y, xw[q].z, xw[q].w}, ps[4] = {pw[q].x, pw[q].y, pw[q].z, pw[q].w};
            const float shv[8] = {sh0[q].x, sh0[q].y, sh0[q].z, sh0[q].w, sh1[q].x, sh1[q].y, sh1[q].z, sh1[q].w};
#pragma unroll
            for (int i = 0; i < 4; ++i) { xv[2 * i] = nv_bf2f((nvbf)(xs[i] & 0xffffu)); xv[2 * i + 1] = nv_bf2f((nvbf)(xs[i] >> 16)); const float p0 = nv_bf2f((nvbf)(ps[i] & 0xffffu)), p1 = nv_bf2f((nvbf)(ps[i] >> 16));
                const float q0 = kind[q] == 0 ? p0 : (kind[q] == 1 ? 0.f : shv[2 * i]), q1 = kind[q] == 0 ? p1 : (kind[q] == 1 ? 0.f : shv[2 * i + 1]); dx[2 * i] = q0 - xv[2 * i]; dx[2 * i + 1] = q1 - xv[2 * i + 1]; }
#pragma unroll
            for (int m = 0; m < 6; ++m) { const float mv[8] = {mu0[m].x, mu0[m].y, mu0[m].z, mu0[m].w, mu1[m].x, mu1[m].y, mu1[m].z, mu1[m].w}; unsigned w[4];
#pragma unroll
                for (int i = 0; i < 4; ++i) w[i] = nv_f2bf(xv[2 * i] + dx[2 * i] * mv[2 * i]) | ((unsigned)nv_f2bf(xv[2 * i + 1] + dx[2 * i + 1] * mv[2 * i + 1]) << 16);
                NvU4 o; o.x = w[0]; o.y = w[1]; o.z = w[2]; o.w = w[3]; *(NvU4*)((nvbf*)p.o0 + (size_t)m * (size_t)p.i1 * 1024 + (size_t)row * D + c) = o; } } } } break;
    case OP_CONV4: {
        const int Q = (dm.M + 3) / 4; const int row0 = (int)(gid / 128), c = (int)(gid % 128) * 4; const NvF4 bias = *(const NvF4*)(p.d + c); NvF4 wt[4]; for (int i = 0; i < 4; ++i) wt[i] = *(const NvF4*)(p.c + i * 512 + c);
        NvF4 xv[4][4]; int ok[4];
#pragma unroll
        for (int q = 0; q < 4; ++q) { int row = row0 + q * Q; ok[q] = row < dm.M; row = ok[q] ? row : row0; int s, t; row_to_seq(dm, row, s, t);
#pragma unroll
            for (int i = 0; i < 4; ++i) { const int j = t + i; const int sb = s >= dm.B ? s - dm.B : 0, jb = j < 3 ? j : 0;
                const float* src = j >= 3 ? p.a + (size_t)(row - t + (j - 3)) * MIXIN + C_XB + c : p.b + ((size_t)sb * 3 + jb) * 512 + c; const float msk = (j >= 3 || s >= dm.B) ? 1.f : 0.f;
                const NvF4 v = *(const NvF4*)src; xv[q][i].x = v.x * msk; xv[q][i].y = v.y * msk; xv[q][i].z = v.z * msk; xv[q][i].w = v.w * msk; } }
#pragma unroll
        for (int q = 0; q < 4; ++q) if (ok[q]) { const int row = row0 + q * Q; NvF4 o = bias;
#pragma unroll
            for (int i = 0; i < 4; ++i) { o.x = fmaf(xv[q][i].x, wt[i].x, o.x); o.y = fmaf(xv[q][i].y, wt[i].y, o.y); o.z = fmaf(xv[q][i].z, wt[i].z, o.z); o.w = fmaf(xv[q][i].w, wt[i].w, o.w); }
            NvU2 w; w.x = nv_f2bf(o.x) | ((unsigned)nv_f2bf(o.y) << 16); w.y = nv_f2bf(o.z) | ((unsigned)nv_f2bf(o.w) << 16); *(NvU2*)((nvbf*)p.o1 + (size_t)row * 512 + c) = w; } } break;
    case OP_CVT8: {
        const int K8 = p.i2 / 8; const int row = (int)(gid / K8), k = (int)(gid % K8) * 8; unsigned w[4] = {0u, 0u, 0u, 0u};
        if (row < dm.M && k < p.i0) { const float* sp = p.a + (size_t)row * p.i1 + k;
#pragma unroll
            for (int i = 0; i < 4; ++i) { float lo = sp[2 * i], hi = sp[2 * i + 1]; if (p.i3 == 1) { lo = NV_TANH(lo); hi = NV_TANH(hi); } else if (p.i3 == 2) { lo = nv_sigmoid(lo); hi = nv_sigmoid(hi); } w[i] = nv_f2bf(lo) | ((unsigned)nv_f2bf(hi) << 16); } }
        NvU4 o; o.x = w[0]; o.y = w[1]; o.z = w[2]; o.w = w[3]; *(NvU4*)((nvbf*)p.o0 + (size_t)row * p.i2 + k) = o; } break;
    case OP_WGATE: {
        const int ch = (int)(gid % 64), n = (int)(gid / 64), pn = n >> 8, within = n & 127, isx = (n >> 7) & 1, c = pn * 128 + within, nb = c >> 6, e = c & 63, k0 = ch * 8; const float* w = isx ? p.b : p.a; NvU4 o; o.x = o.y = o.z = o.w = 0u;
        if ((k0 >> 6) == nb) { float v[8];
#pragma unroll
            for (int i = 0; i < 8; ++i) v[i] = w[((size_t)nb * 64 + ((k0 + i) & 63)) * 64 + e];
            o.x = nv_f2bf(v[0]) | ((unsigned)nv_f2bf(v[1]) << 16); o.y = nv_f2bf(v[2]) | ((unsigned)nv_f2bf(v[3]) << 16); o.z = nv_f2bf(v[4]) | ((unsigned)nv_f2bf(v[5]) << 16); o.w = nv_f2bf(v[6]) | ((unsigned)nv_f2bf(v[7]) << 16); }
        *(NvU4*)((nvbf*)p.o0 + (size_t)n * 512 + k0) = o;
        if (ch == 0 && n < 512) p.o1[n] = -8.f * nv_softplus(-p.c[n]); } break;
    case OP_LRUG2: {
        const int row = (int)(gid / 512), c = (int)(gid % 512), pn = c >> 7, within = c & 127; const nvbf* x = (const nvbf*)p.a + (size_t)row * 512; const nvbf* wa_ = (const nvbf*)p.b + (size_t)(pn * 256 + within) * 512; const nvbf* wx_ = wa_ + (size_t)128 * 512; float ga = 0.f, gx = 0.f;
        for (int k = 0; k < 512; ++k) { const float xv = nv_bf2f(x[k]); ga = fmaf(xv, nv_bf2f(wa_[k]), ga); gx = fmaf(xv, nv_bf2f(wx_[k]), gx); }
        const float gate_a = nv_sigmoid(ga + p.c[c]), gate_x = nv_sigmoid(gx + p.d[c]); const float log_at = gate_a * p.e[c];
        p.o0[gid] = NV_EXP(log_at); p.o1[gid] = sqrtf(-expm1f(2.f * log_at)) * (gate_x * nv_bf2f(((const nvbf*)p.f)[gid])); } break;
    case OP_LOGA4: {
        const int row = (int)(gid / 64), c = (int)(gid % 64) * 4; const float* gl = p.a + (size_t)row * MIXIN + C_GLR; NvF4 z = *(const NvF4*)(p.c + c);
#pragma unroll
        for (int r4 = 0; r4 < 4; ++r4) { const NvF4 g = *(const NvF4*)(gl + 4 * r4);
            const NvF4 w0 = *(const NvF4*)(p.b + (4 * r4 + 0) * 256 + c), w1 = *(const NvF4*)(p.b + (4 * r4 + 1) * 256 + c), w2 = *(const NvF4*)(p.b + (4 * r4 + 2) * 256 + c), w3 = *(const NvF4*)(p.b + (4 * r4 + 3) * 256 + c);
            z.x = fmaf(g.x, w0.x, z.x); z.y = fmaf(g.x, w0.y, z.y); z.z = fmaf(g.x, w0.z, z.z); z.w = fmaf(g.x, w0.w, z.w); z.x = fmaf(g.y, w1.x, z.x); z.y = fmaf(g.y, w1.y, z.y); z.z = fmaf(g.y, w1.z, z.z); z.w = fmaf(g.y, w1.w, z.w);
            z.x = fmaf(g.z, w2.x, z.x); z.y = fmaf(g.z, w2.y, z.y); z.z = fmaf(g.z, w2.z, z.z); z.w = fmaf(g.z, w2.w, z.w); z.x = fmaf(g.w, w3.x, z.x); z.y = fmaf(g.w, w3.y, z.y); z.z = fmaf(g.w, w3.z, z.z); z.w = fmaf(g.w, w3.w, z.w); }
        NvF4 o; o.x = NV_EXP(-nv_softplus(-z.x) * (1.f / 16.f)); o.y = NV_EXP(-nv_softplus(-z.y) * (1.f / 16.f)); o.z = NV_EXP(-nv_softplus(-z.z) * (1.f / 16.f)); o.w = NV_EXP(-nv_softplus(-z.w) * (1.f / 16.f));
        *(NvF4*)(p.o0 + (size_t)row * 256 + c) = o; } break;
    case OP_GLANORM: {
        int row = (int)(gid / 4), h = (int)(gid % 4); const float* o = p.a + (size_t)row * 512 + h * 128; float ss = 0.f;
        for (int c = 0; c < 128; ++c) ss = fmaf(o[c], o[c], ss);
        float rs = 1.f / sqrtf(ss * (1.f / 128.f) + 1e-5f);
        for (int c = 0; c < 128; ++c) { float r = p.b[(size_t)row * MIXIN + C_R + h * 128 + c]; ((nvbf*)p.o0)[(size_t)row * 1024 + h * 128 + c] = nv_f2bf(o[c] * rs * p.c[c] * (r * nv_sigmoid(r))); } } break;
    case OP_CONV: {
        int row = (int)(gid / 512), c = (int)(gid % 512); int s, t; row_to_seq(dm, row, s, t); float acc = p.d[c];
        for (int i = 0; i < 4; ++i) { int j = t + i; float xv;
            if (j < 3) xv = (s < dm.B) ? 0.f : p.b[((size_t)(s - dm.B) * 3 + j) * 512 + c]; else xv = p.a[(size_t)(row - t + (j - 3)) * MIXIN + C_XB + c];
            acc = fmaf(xv, p.c[i * 512 + c], acc); }
        p.o0[gid] = acc; } break;
    case OP_CONVOUT: {
        int s = (int)(gid / 1536), i = (int)((gid / 512) % 3), c = (int)(gid % 512); int L = seq_len(dm, s), r0 = seq_row0(dm, s); int j = L + i; float xv;
        if (j < 3) xv = (s < dm.B) ? 0.f : p.b[((size_t)(s - dm.B) * 3 + j) * 512 + c]; else xv = p.a[(size_t)(r0 + j - 3) * MIXIN + C_XB + c];
        float* o = (s < dm.B) ? PO1 + ((size_t)s * 3 + i) * 512 + c : PO2 + ((size_t)(s - dm.B) * 3 + i) * 512 + c; *o = xv; } break;
    case OP_LRUG: {
        int row = (int)(gid / 512), c = (int)(gid % 512), nb = c / 64, e = c % 64; const float* x = p.a + (size_t)row * 512 + nb * 64; float ga = p.c[c], gx = p.e[c];
        for (int dd = 0; dd < 64; ++dd) { ga = fmaf(x[dd], p.b[((size_t)nb * 64 + dd) * 64 + e], ga); gx = fmaf(x[dd], p.d[((size_t)nb * 64 + dd) * 64 + e], gx); }
        float gate_a = nv_sigmoid(ga), gate_x = nv_sigmoid(gx); float log_at = -8.f * gate_a * nv_softplus(-p.f[c]);
        p.o0[gid] = NV_EXP(log_at); p.o1[gid] = sqrtf(-expm1f(2.f * log_at)) * (gate_x * p.a[(size_t)row * 512 + c]); } break;
    case OP_LRUSCAN: {
        int s = (int)(gid / 512), c = (int)(gid % 512); int r0 = seq_row0(dm, s), L = seq_len(dm, s); float hh = (s < dm.B) ? 0.f : p.d[(size_t)(s - dm.B) * 512 + c];
        for (int t = 0; t < L; ++t) { size_t r = (size_t)(r0 + t); hh = fmaf(p.a[r * 512 + c], hh, p.b[r * 512 + c]); p.o0[r * 1024 + 512 + c] = hh * nv_gelu(p.c[r * MIXIN + C_GB + c]); }
        float* o = (s < dm.B) ? PO1 + (size_t)s * 512 + c : PO2 + (size_t)(s - dm.B) * 512 + c; *o = hh; } break;
    case OP_LNRES: {
        const float alpha = 1.6817928305074292f; nvbf* x = (nvbf*)p.o1 + (size_t)gid * D; const nvbf* y = (const nvbf*)p.a + (size_t)gid * D; float mu = 0.f;
        for (int c = 0; c < D; ++c) mu += alpha * nv_bf2f(x[c]) + nv_bf2f(y[c]);
        mu /= D; float var = 0.f;
        for (int c = 0; c < D; ++c) { float v = alpha * nv_bf2f(x[c]) + nv_bf2f(y[c]) - mu; var = fmaf(v, v, var); }
        float rs = 1.f / sqrtf(var / D + 1e-5f);
        for (int c = 0; c < D; ++c) { const float o = (alpha * nv_bf2f(x[c]) + nv_bf2f(y[c]) - mu) * rs * p.b[c] + p.c[c]; x[c] = nv_f2bf(o);
            if (p.o2) { unsigned char* f8 = (unsigned char*)p.o2 + (size_t)gid * 2 * D; const float xs = fminf(fmaxf(o * 16.f, -448.f), 448.f); const unsigned hc = nv_f2e4m3(xs); f8[c] = (unsigned char)hc; f8[D + c] = (unsigned char)nv_f2e4m3(xs - nv_e4m32f(hc)); } } } break;
    case OP_MIX: {
        int row = (int)(gid / D), c = (int)(gid % D); int s, t; row_to_seq(dm, row, s, t); float x = p.a[gid];
        float xp = t > 0 ? p.a[gid - D] : ((s < dm.B) ? 0.f : p.b[(size_t)(s - dm.B) * D + c]);
        ((nvbf*)p.o0)[gid] = nv_f2bf(x + (xp - x) * p.c[c]); } break;
    case OP_SHIFTOUT: {
        int s = (int)(gid / D), c = (int)(gid % D); float v = nv_bf2f(((const nvbf*)p.a)[(size_t)(seq_row0(dm, s) + seq_len(dm, s) - 1) * D + c]);
        float* o = (s < dm.B) ? PO1 + (size_t)s * D + c : PO2 + (size_t)(s - dm.B) * D + c; *o = v; } break;
    case OP_RWKVPREP: {
        int row = (int)(gid / dm.RH), h = (int)(gid % dm.RH); size_t base = (size_t)row * D + h * 64; float ss = 0.f;
        for (int k = 0; k < 64; ++k) { float kv = p.o0[base + k] * p.d[h * 64 + k]; ss = fmaf(kv, kv, ss); }
        float inv = 1.f / fmaxf(sqrtf(ss), 1e-12f);
        for (int k = 0; k < 64; ++k) { int c = h * 64 + k; size_t ix = base + k;
            float w = -nv_softplus(-(p.a[c] + p.o1[ix])) - 0.5f; float dec = NV_EXP(-NV_EXP(w));
            float a = nv_sigmoid(p.b[c] + p.o2[ix]);
            float v = p.o3[ix]; if (p.i0) v = v + (p.o5[ix] - v) * nv_sigmoid(p.c[c] + p.f[ix]); else p.o5[ix] = v;
            float k0 = p.o0[ix]; const float kk = k0 * p.d[c] * inv; p.o4[ix] = -kk; p.o0[ix] = k0 * (1.f + (a - 1.f) * p.e[c]); p.o1[ix] = dec; p.o2[ix] = kk * a; p.o3[ix] = v; } } break;
    case OP_WKVF:
    case OP_WKV: {
        int RH = dm.RH; int s = p.i0 + (int)(gid / (RH * 64)), h = (int)((gid / 64) % RH), vr = (int)(gid % 64); float S[64];
        const float* sin = (s < dm.B) ? nullptr : p.g + (((size_t)(s - dm.B) * RH + h) * 64 + vr) * 64;
#pragma unroll
        for (int k = 0; k < 64; ++k) S[k] = sin ? sin[k] : 0.f;
        int r0 = seq_row0(dm, s), L = seq_len(dm, s);
        for (int t = 0; t < L; ++t) { size_t base = (size_t)(r0 + t) * D + h * 64; float sa = 0.f;
#pragma unroll
            for (int k = 0; k < 64; ++k) { if ((k & 7) == 0) NV_FENCE(); sa = fmaf(S[k], p.f[base + k], sa); }
            float vv = p.d[base + vr], y = 0.f;
#pragma unroll
            for (int k = 0; k < 64; ++k) { if ((k & 7) == 0) NV_FENCE(); S[k] = fmaf(S[k], p.b[base + k], fmaf(sa, p.e[base + k], vv * p.c[base + k])); y = fmaf(S[k], p.a[base + k], y); }
            p.o0[base + vr] = y; }
        float* so = (s < dm.B) ? PO1 + (((size_t)s * RH + h) * 64 + vr) * 64 : PO2 + (((size_t)(s - dm.B) * RH + h) * 64 + vr) * 64;
#pragma unroll
        for (int k = 0; k < 64; ++k) so[k] = S[k]; } break;
    case OP_RWKVPOST: {
        int row = (int)(gid / dm.RH), h = (int)(gid % dm.RH); size_t base = (size_t)row * D + h * 64; float mu = 0.f, bon = 0.f;
        for (int k = 0; k < 64; ++k) { mu += p.a[base + k]; bon = fmaf(p.b[base + k] * p.c[base + k], p.f[h * 64 + k], bon); }
        mu *= (1.f / 64.f); float var = 0.f;
        for (int k = 0; k < 64; ++k) { float dlt = p.a[base + k] - mu; var = fmaf(dlt, dlt, var); }
        float rs = 1.f / sqrtf(var * (1.f / 64.f) + 64e-5f);
        for (int k = 0; k < 64; ++k) { int c = h * 64 + k; float y = (p.a[base + k] - mu) * rs * p.g[c] + p.h[c] + bon * p.d[base + k]; ((nvbf*)p.o0)[base + k] = nv_f2bf(y * p.e[base + k]); } } break;
    case OP_PRM: {
        const int m = (int)(gid / D), c = (int)(gid % D); const float* src = m == 0 ? p.a : m == 1 ? p.b : m == 2 ? p.c : m == 3 ? p.d : m == 4 ? p.e : p.f; p.o0[gid] = src ? src[c] : 0.f; } break;
    case OP_WKVP: {
        const int RH = dm.RH; const int s = (int)(gid / (RH * 64)), h = (int)((gid / 64) % RH), vr = (int)(gid % 64); float S[64];
        const float* sin = (s < dm.B) ? nullptr : p.o5 + (((size_t)(s - dm.B) * RH + h) * 64 + vr) * 64;
        for (int k = 0; k < 64; ++k) S[k] = sin ? sin[k] : 0.f;
        const float* w0 = p.h + h * 64; const float* a0 = p.h + D + h * 64; const float* v0 = p.h + 2 * D + h * 64; const float* k_k = p.h + 3 * D + h * 64; const float* k_a = p.h + 4 * D + h * 64; const float* r_k = p.h + 5 * D + h * 64;
        const int r0 = seq_row0(dm, s), L = seq_len(dm, s); const nvbf* bR = (const nvbf*)p.a; const nvbf* bK = (const nvbf*)p.b; const nvbf* bWL = (const nvbf*)p.c; const nvbf* bAL = (const nvbf*)p.d; const nvbf* bV = (const nvbf*)p.e; const nvbf* bVG = (const nvbf*)p.f;
        for (int t = 0; t < L; ++t) { const size_t base = (size_t)(r0 + t) * D + h * 64; float ss = 0.f;
            for (int k = 0; k < 64; ++k) { const float kv = nv_bf2f(bK[base + k]) * k_k[k]; ss = fmaf(kv, kv, ss); }
            const float inv = 1.f / fmaxf(sqrtf(ss), 1e-12f);
            float vv = nv_bf2f(bV[base + vr]); if (p.i0) vv = vv + (nv_bf2f(((const nvbf*)p.g)[base + vr]) - vv) * nv_sigmoid(v0[vr] + nv_bf2f(bVG[base + vr]));
            float sa = 0.f, bon = 0.f, dec[64], bb[64], k2[64];
            for (int k = 0; k < 64; ++k) { const float k0 = nv_bf2f(bK[base + k]); const float kk = k0 * k_k[k] * inv; const float a = nv_sigmoid(a0[k] + nv_bf2f(bAL[base + k]));
                dec[k] = NV_EXP(-0.6065306597126334f * nv_sigmoid(w0[k] + nv_bf2f(bWL[base + k])));
                bb[k] = kk * a; k2[k] = k0 * (1.f + (a - 1.f) * k_a[k]); sa = fmaf(S[k], -kk, sa); bon = fmaf(nv_bf2f(bR[base + k]) * k2[k], r_k[k], bon); }
            float y = 0.f;
            for (int k = 0; k < 64; ++k) { S[k] = fmaf(S[k], dec[k], fmaf(sa, bb[k], vv * k2[k])); y = fmaf(S[k], nv_bf2f(bR[base + k]), y); }
            ((nvbf*)p.o0)[base + vr] = nv_f2bf(y); ((nvbf*)p.o3)[base + vr] = nv_f2bf(vv); if (vr == 0) p.o4[(size_t)(r0 + t) * RH + h] = bon; }
        float* so = (s < dm.B) ? PO1 + (((size_t)s * RH + h) * 64 + vr) * 64 : PO2 + (((size_t)(s - dm.B) * RH + h) * 64 + vr) * 64;
        for (int k = 0; k < 64; ++k) so[k] = S[k]; } break;
    case OP_POST2: {
        const int row = (int)(gid / dm.RH), h = (int)(gid % dm.RH); const size_t base = (size_t)row * D + h * 64; const nvbf* ya = (const nvbf*)p.a; const nvbf* vf = (const nvbf*)p.c; float mu = 0.f;
        for (int k = 0; k < 64; ++k) mu += nv_bf2f(ya[base + k]);
        mu *= (1.f / 64.f); float var = 0.f;
        for (int k = 0; k < 64; ++k) { const float dlt = nv_bf2f(ya[base + k]) - mu; var = fmaf(dlt, dlt, var); }
        const float rs = 1.f / sqrtf(var * (1.f / 64.f) + 64e-5f), bon = p.d[gid];
        for (int k = 0; k < 64; ++k) { const int c = h * 64 + k; const float y = (nv_bf2f(ya[base + k]) - mu) * rs * p.e[c] + p.f[c] + bon * nv_bf2f(vf[base + k]); ((nvbf*)p.o0)[base + k] = nv_f2bf(y * nv_bf2f(((const nvbf*)p.b)[base + k])); } } break;
    case OP_QNORM: {
        float* q = p.o0 + (size_t)gid * 256; float mu = 0.f;
        for (int c = 0; c < 256; ++c) mu += q[c];
        mu *= (1.f / 256.f); float var = 0.f;
        for (int c = 0; c < 256; ++c) { float dlt = q[c] - mu; var = fmaf(dlt, dlt, var); }
        float rs = 1.f / sqrtf(var * (1.f / 256.f) + 1e-5f);
        for (int c = 0; c < 256; ++c) q[c] = (q[c] - mu) * rs; } break;
    case OP_SCORES: {
        int row = (int)(gid / 2048), r = (int)(gid % 2048), h = r / 256, half = (r / 128) & 1, key = r % 128;
        const float* q = p.a + (size_t)row * 2048 + h * 256 + half * 128; const float* kv = p.b + (((size_t)h * 2 + half) * 128 + key) * 128; float acc = 0.f;
        for (int dd = 0; dd < 128; ++dd) acc = fmaf(q[dd], kv[dd], acc);
        p.o0[gid] = acc; } break;
    case OP_TOPK: {
        const float* sc = p.a + (size_t)gid * 256; float tv[16]; int ti[16]; float* tmpv = p.o2 + (size_t)gid * 32; int* tmpi = (int*)p.o3 + (size_t)gid * 32;
        for (int half = 0; half < 2; ++half) {
#pragma unroll
            for (int j = 0; j < 16; ++j) { tv[j] = -3.0e38f; ti[j] = 0; }
            for (int k = 0; k < 128; ++k) NV_INS16(tv, ti, sc[half * 128 + k], k);
#pragma unroll
            for (int j = 0; j < 16; ++j) { tmpv[half * 16 + j] = tv[j]; tmpi[half * 16 + j] = ti[j]; }
        }
#pragma unroll
        for (int j = 0; j < 16; ++j) { tv[j] = -3.0e38f; ti[j] = 0; }
        for (int i = 0; i < 16; ++i) for (int j = 0; j < 16; ++j) NV_INS16(tv, ti, tmpv[i] + tmpv[16 + j], tmpi[i] * 128 + tmpi[16 + j]);
        float den = 0.f, ev[16];
#pragma unroll
        for (int j = 0; j < 16; ++j) { ev[j] = NV_EXP(tv[j] - tv[0]); den += ev[j]; }
        float inv = 1.f / den;
#pragma unroll
        for (int j = 0; j < 16; ++j) { p.o0[(size_t)gid * 16 + j] = ev[j] * inv; ((int*)p.o1)[(size_t)gid * 16 + j] = ti[j]; } } break;
    case OP_PACT1: {
        size_t pr = (size_t)(gid / 16); int part = (int)(gid % 16); int row = (int)(pr / 128); int e = ((const int*)p.d)[pr]; int w = D / 16;
        const float* u = p.b + (size_t)e * D + part * w; const float* x = p.a + (size_t)row * D + part * w; float acc = 0.f;
        for (int c = 0; c < w; ++c) acc = fmaf(u[c], x[c], acc);
        p.o0[gid] = acc; } break;
    case OP_PACT2: {
        float acc = 0.f; for (int i = 0; i < 16; ++i) acc += p.a[(size_t)gid * 16 + i];
        p.o0[gid] = p.c[gid] * nv_gelu(acc); } break;
    case OP_POUT: {
        int row = (int)(gid / D), c = (int)(gid % D); float acc = 0.f;
        for (int i = 0; i < 128; ++i) acc = fmaf(p.a[(size_t)row * 128 + i], p.c[(size_t)((const int*)p.b)[(size_t)row * 128 + i] * D + c], acc);
        p.o0[gid] = acc; } break;
    case OP_YOUT: {
        int row = (int)(gid / D), c = (int)(gid % D);
        if (row < dm.B * dm.T) { int bb = row / dm.T, t = row % dm.T; if (t >= 16) p.o0[((size_t)bb * (dm.T - 16) + (t - 16)) * D + c] = p.a[gid]; }
        else p.o0[((size_t)dm.B * (dm.T - 16) + (row - dm.B * dm.T)) * D + c] = p.a[gid]; } break;
    case OP_WT: {
        const int N = p.i0, K = p.i1, Np = p.i3, Kp = p.i4; const long long per8 = (long long)Np * (Kp / 8); const int bt = (int)(gid / per8); const long long r = gid % per8; const int k0 = (int)(r / Np) * 8, nn = (int)(r % Np);
        unsigned w[4];
#pragma unroll
        for (int i = 0; i < 4; ++i) { float lo = 0.f, hi = 0.f; if (nn < N) { if (k0 + 2 * i < K) lo = p.a[((size_t)bt * K + k0 + 2 * i) * p.i2 + nn]; if (k0 + 2 * i + 1 < K) hi = p.a[((size_t)bt * K + k0 + 2 * i + 1) * p.i2 + nn]; } w[i] = nv_f2bf(lo) | ((unsigned)nv_f2bf(hi) << 16); }
        NvU4 o; o.x = w[0]; o.y = w[1]; o.z = w[2]; o.w = w[3];
        *(NvU4*)((nvbf*)p.o0 + (size_t)bt * Np * Kp + (size_t)nn * Kp + k0) = o; } break;
    case OP_CVT: {
        const int Kp = p.i2; const int row = (int)(gid / Kp), k = (int)(gid % Kp); float v = 0.f;
        if (row < dm.M && k < p.i0) { v = p.a[(size_t)row * p.i1 + k]; if (p.i3 == 1) v = NV_TANH(v); else if (p.i3 == 2) v = nv_sigmoid(v); }
        ((nvbf*)p.o0)[gid] = nv_f2bf(v); } break;
    case OP_FGEMM: {
        const int N = p.i0; const int m = (int)(gid / N), nn = (int)(gid % N); const nvbf* A = (const nvbf*)p.a + (size_t)m * p.i2 + ((p.i6 & 2) ? (nn / 256) * 256 : 0); const nvbf* Bt = (const nvbf*)p.b + (size_t)nn * p.i3; float acc = 0.f;
        for (int k = 0; k < p.i1; ++k) acc = fmaf(nv_bf2f(A[k]), nv_bf2f(Bt[k]), acc);
        if (p.i6 & 1) ((nvbf*)p.o0)[(size_t)m * p.i4 + nn] = nv_f2bf(acc); else p.o0[(size_t)m * p.i4 + nn] = acc; } break;
    case OP_CVTTAB: {
        const NvF4 v0 = *(const NvF4*)(p.a + gid * 8), v1 = *(const NvF4*)(p.a + gid * 8 + 4); NvU4 o;
        o.x = nv_f2bf(v0.x) | ((unsigned)nv_f2bf(v0.y) << 16); o.y = nv_f2bf(v0.z) | ((unsigned)nv_f2bf(v0.w) << 16); o.z = nv_f2bf(v1.x) | ((unsigned)nv_f2bf(v1.y) << 16); o.w = nv_f2bf(v1.z) | ((unsigned)nv_f2bf(v1.w) << 16);
        *(NvU4*)((nvbf*)p.o0 + gid * 8) = o; } break;
    case OP_CVTTAB8: {
        const float sc = (float)(1 << p.i0); const float* sp = p.a + gid * 16; unsigned w[4];
#pragma unroll
        for (int q = 0; q < 4; ++q) { const NvF4 v = *(const NvF4*)(sp + 4 * q); w[q] = nv_f2e4m3(v.x * sc) | (nv_f2e4m3(v.y * sc) << 8) | (nv_f2e4m3(v.z * sc) << 16) | (nv_f2e4m3(v.w * sc) << 24); }
        NvU4 o; o.x = w[0]; o.y = w[1]; o.z = w[2]; o.w = w[3]; *(NvU4*)((unsigned char*)p.o0 + gid * 16) = o; } break;
    case OP_CVTTAB8S: {
        const float sc = (float)(1 << p.i0); const int per = D / 16; const int e = (int)(gid / per), c0 = (int)(gid % per) * 16; const float* sp = p.a + (size_t)e * D + c0; unsigned w[4];
#pragma unroll
        for (int q = 0; q < 4; ++q) { const NvF4 v = *(const NvF4*)(sp + 4 * q);
#if defined(__HIP_DEVICE_COMPILE__)
            int pk = __builtin_amdgcn_cvt_pk_fp8_f32(v.x * sc, v.y * sc, 0, false); pk = __builtin_amdgcn_cvt_pk_fp8_f32(v.z * sc, v.w * sc, pk, true); w[q] = (unsigned)pk;
#else
            w[q] = nv_f2e4m3(v.x * sc) | (nv_f2e4m3(v.y * sc) << 8) | (nv_f2e4m3(v.z * sc) << 16) | (nv_f2e4m3(v.w * sc) << 24);
#endif
        }
        NvU4 o; o.x = w[0]; o.y = w[1]; o.z = w[2]; o.w = w[3]; *(NvU4*)((unsigned char*)p.o0 + ((size_t)(c0 >> 7) * 16384 + e) * 128 + (c0 & 127)) = o; } break;
    case OP_PACTS: {
        const long long NP = (long long)dm.M * 128; const int sl = (int)(gid / NP); const long long pr = gid % NP; const int row = (int)(pr / 128); const int e = ((const int*)p.d)[pr] & p.i0;
        const unsigned char* u = (const unsigned char*)p.b + ((size_t)sl * 16384 + e) * 128; const unsigned char* x = (const unsigned char*)p.a + (size_t)row * 2 * D + sl * 128; float acc = 0.f;
        for (int c = 0; c < 128; ++c) acc = fmaf(nv_e4m32f(u[c]), nv_e4m32f(x[c]) + nv_e4m32f(x[D + c]), acc);
        ((nvbf*)p.o0)[gid] = nv_f2bf(acc * (1.f / 16.f)); } break;
    case OP_PRED: {
        const long long NP = (long long)dm.M * 128; const size_t e0 = (size_t)gid * 4; float a0 = 0.f, a1 = 0.f, a2 = 0.f, a3 = 0.f;
#pragma unroll 8
        for (int sl = 0; sl < p.i0; ++sl) { const NvU2 w = *(const NvU2*)((const nvbf*)p.a + (size_t)sl * NP + e0); a0 += nv_bf2f((nvbf)(w.x & 0xffffu)); a1 += nv_bf2f((nvbf)(w.x >> 16)); a2 += nv_bf2f((nvbf)(w.y & 0xffffu)); a3 += nv_bf2f((nvbf)(w.y >> 16)); }
        const NvF4 g = *(const NvF4*)(p.c + e0); NvF4 o; o.x = g.x * nv_gelu(a0 * (1.f / 128.f)); o.y = g.y * nv_gelu(a1 * (1.f / 128.f)); o.z = g.z * nv_gelu(a2 * (1.f / 128.f)); o.w = g.w * nv_gelu(a3 * (1.f / 128.f));
        *(NvF4*)(p.o0 + e0) = o; } break;
    case OP_POUTS: {
        const int row = (int)(gid / D), c = (int)(gid % D); const unsigned char* vb = (const unsigned char*)p.c + (size_t)(c >> 7) * 16384 * 128 + (c & 127); float acc = 0.f;
        for (int i = 0; i < 128; ++i) acc = fmaf(p.a[(size_t)row * 128 + i] * (1.f / 64.f), nv_e4m32f(vb[(size_t)((const int*)p.b)[(size_t)row * 128 + i] * 128]), acc);
        ((nvbf*)p.o0)[gid] = nv_f2bf(acc); } break;
    case OP_KEYS: {
        const int ch = (int)(gid % 32), hr = (int)(gid / 32), h = hr / 256, nrow = hr % 256, half = nrow >> 7, k0 = ch * 8; const float* src = p.a + (((size_t)h * 2 + half) * 128 + (nrow & 127)) * 128;
        NvU4 o; o.x = o.y = o.z = o.w = 0u;
        if ((k0 >> 7) == half) { const NvF4 v0 = *(const NvF4*)(src + (k0 & 127)), v1 = *(const NvF4*)(src + (k0 & 127) + 4);
            o.x = nv_f2bf(v0.x) | ((unsigned)nv_f2bf(v0.y) << 16); o.y = nv_f2bf(v0.z) | ((unsigned)nv_f2bf(v0.w) << 16); o.z = nv_f2bf(v1.x) | ((unsigned)nv_f2bf(v1.y) << 16); o.w = nv_f2bf(v1.z) | ((unsigned)nv_f2bf(v1.w) << 16); }
        *(NvU4*)((nvbf*)p.o0 + ((size_t)h * 256 + nrow) * 256 + k0) = o;
        if (ch == 0) { float ks = 0.f;
#pragma unroll 8
            for (int k = 0; k < 128; k += 4) { const NvF4 v = *(const NvF4*)(src + k); ks += (nv_bf2f(nv_f2bf(v.x)) + nv_bf2f(nv_f2bf(v.y))) + (nv_bf2f(nv_f2bf(v.z)) + nv_bf2f(nv_f2bf(v.w))); }
            p.o1[hr] = ks; } } break;
    case OP_TOPK2: {
        const int h = (int)(gid % 8); const nvbf* sc = (const nvbf*)p.a + (size_t)gid * 256; const nvbf* q = (const nvbf*)p.b + (size_t)gid * 256; const float* ksum = p.c + h * 256; float mu = 0.f;
        for (int c = 0; c < 256; ++c) mu += nv_bf2f(q[c]);
        mu *= (1.f / 256.f); float var = 0.f;
        for (int c = 0; c < 256; ++c) { float dlt = nv_bf2f(q[c]) - mu; var = fmaf(dlt, dlt, var); }
        const float rs = 1.f / sqrtf(var * (1.f / 256.f) + 1e-5f);
        float tv[16]; int ti[16]; float* tmpv = p.o2 + (size_t)gid * 32; int* tmpi = (int*)p.o3 + (size_t)gid * 32;
        for (int half = 0; half < 2; ++half) {
#pragma unroll
            for (int j = 0; j < 16; ++j) { tv[j] = -3.0e38f; ti[j] = 0; }
            for (int k = 0; k < 128; ++k) NV_INS16(tv, ti, rs * (nv_bf2f(sc[half * 128 + k]) - mu * ksum[half * 128 + k]), k);
#pragma unroll
            for (int j = 0; j < 16; ++j) { tmpv[half * 16 + j] = tv[j]; tmpi[half * 16 + j] = ti[j]; }
        }
#pragma unroll
        for (int j = 0; j < 16; ++j) { tv[j] = -3.0e38f; ti[j] = 0; }
        for (int i = 0; i < 16; ++i) for (int j = 0; j < 16; ++j) NV_INS16(tv, ti, tmpv[i] + tmpv[16 + j], tmpi[i] * 128 + tmpi[16 + j]);
        float den = 0.f, ev[16];
#pragma unroll
        for (int j = 0; j < 16; ++j) { ev[j] = NV_EXP(tv[j] - tv[0]); den += ev[j]; }
        float inv = 1.f / den;
#pragma unroll
        for (int j = 0; j < 16; ++j) { p.o0[(size_t)gid * 16 + j] = ev[j] * inv; ((int*)p.o1)[(size_t)gid * 16 + j] = ti[j]; } } break;
    case OP_PACT: {
        const int row = (int)(gid / 128); const int e = ((const int*)p.d)[gid]; const unsigned char* u = (const unsigned char*)p.b + (size_t)e * D; const nvbf* x = (const nvbf*)p.a + (size_t)row * D; float acc = 0.f;
        for (int c = 0; c < D; ++c) acc = fmaf(nv_e4m32f(u[c]), nv_bf2f(x[c]), acc);
        p.o0[gid] = p.c[gid] * nv_gelu(acc * (1.f / 128.f)); } break;
#if defined(HOST_TEST)
    case OP_POUTLN: {
        const float alpha = 1.6817928305074292f; float* x = p.o0 + (size_t)gid * D; std::vector<float> y(D, 0.f);
        for (int i = 0; i < 128; ++i) { const float cf = p.a[(size_t)gid * 128 + i] * (1.f / 64.f); const unsigned char* v = (const unsigned char*)p.c + (size_t)((const int*)p.b)[(size_t)gid * 128 + i] * D; for (int c = 0; c < D; ++c) y[c] = fmaf(cf, nv_e4m32f(v[c]), y[c]); }
        float mu = 0.f; for (int c = 0; c < D; ++c) { y[c] = alpha * x[c] + y[c]; mu += y[c]; }
        mu /= D; float var = 0.f; for (int c = 0; c < D; ++c) { float dlt = y[c] - mu; var = fmaf(dlt, dlt, var); }
        const float rs = 1.f / sqrtf(var / D + 1e-5f);
        for (int c = 0; c < D; ++c) { const float o = (y[c] - mu) * rs * p.d[c] + p.e[c]; x[c] = o; ((nvbf*)p.o1)[(size_t)gid * D + c] = nv_f2bf(o);
            if (p.o2) { unsigned char* f8 = (unsigned char*)p.o2 + (size_t)gid * 2 * D; const float xs = fminf(fmaxf(o * 16.f, -448.f), 448.f); const unsigned hc = nv_f2e4m3(xs); f8[c] = (unsigned char)hc; f8[D + c] = (unsigned char)nv_f2e4m3(xs - nv_e4m32f(hc)); } } } break;
#endif
    default: break;
    }
}

struct NvIO { const float* const* in; float* out; char* ws; size_t ws_size; };
template <class Launch> HD void nv_forward(const NvIO& io, const Dm& dm, Launch&& launch) {
    const int D = dm.D, M = dm.M, B = dm.B, DB = dm.DB, RH = dm.RH; const size_t MD = (size_t)M * D;
    float* y_prompt = io.out; float* y_sample = y_prompt + (size_t)B * (dm.T - 16) * D; float* p_gla = y_sample + (size_t)DB * dm.DT * D;
    float* p_h = p_gla + (size_t)2 * B * 4 * 64 * 128; float* p_conv = p_h + (size_t)2 * B * 512; float* p_rwkv = p_conv + (size_t)2 * B * 3 * 512;
    float* p_shift = p_rwkv + (size_t)2 * B * RH * 4096; float* s_gla = p_shift + (size_t)2 * B * D; float* s_h = s_gla + (size_t)2 * DB * 4 * 64 * 128;
    float* s_conv = s_h + (size_t)2 * DB * 512; float* s_rwkv = s_conv + (size_t)2 * DB * 3 * 512; float* s_shift = s_rwkv + (size_t)2 * DB * RH * 4096;
    float* w = (float*)io.ws; size_t off = 0; auto take = [&](size_t n) __attribute__((always_inline)) { float* r = w + off; off += (n + 63) & ~(size_t)63; return r; };
    float* X = take(MD > (size_t)nv_rup(M, 256) * 512 ? MD : (size_t)nv_rup(M, 256) * 512); float* VFIRST = take(MD); float* MOUT = take(MD);
    auto mk = [&](int code, long long n) __attribute__((always_inline)) { Op o{}; o.code = code; o.n = n; return o; };
    const int Mp = nv_rup(M, 256), Dp = nv_rup(D, 256), Dk = nv_rup(D, 128);
    auto takeh = [&](size_t n) __attribute__((always_inline)) { return (nvbf*)take((n + 1) / 2); };
    const size_t ABFN = (size_t)Mp * 1024 > (size_t)Mp * Dk ? (size_t)Mp * 1024 : (size_t)Mp * Dk; nvbf* ABF = takeh(ABFN + (size_t)Mp * D);
    const size_t SZ_WIN = (size_t)2816 * Dk, SZ_WOUT = (size_t)Dp * 1024, SZ_DD = (size_t)Dp * Dk, SZ_DN = (size_t)256 * Dk, SZ_UP = (size_t)Dp * 128, SZ_WQ = (size_t)2048 * Dk;
    nvbf* WT_WIN = takeh(2 * SZ_WIN); nvbf* WT_WOUT = takeh(2 * SZ_WOUT); nvbf* WT_WR = takeh(2 * SZ_DD); nvbf* WT_WK = takeh(2 * SZ_DD); nvbf* WT_WV = takeh(2 * SZ_DD); nvbf* WT_WO = takeh(2 * SZ_DD);
    nvbf* WT_W1 = takeh(2 * SZ_DN); nvbf* WT_W2 = takeh(2 * SZ_UP); nvbf* WT_A1 = takeh(2 * SZ_DN); nvbf* WT_A2 = takeh(2 * SZ_UP); nvbf* WT_G1 = takeh(2 * SZ_DN); nvbf* WT_G2 = takeh(2 * SZ_UP);
    nvbf* WT_V1 = takeh(SZ_DN); nvbf* WT_V2 = takeh(SZ_UP); nvbf* WT_WQ = takeh(4 * SZ_WQ); nvbf* WT_WG = takeh((size_t)2 * 1024 * 512); float* SPL = take(2 * 512); float* PRM = take((size_t)2 * 6 * D);
    nvbf* UB = takeh((size_t)16384 * D / 2); nvbf* VB = takeh((size_t)16384 * D / 2); nvbf* KB = takeh((size_t)8 * 256 * 256); float* KSUM = take(8 * 256);
    const size_t scratch0 = off;
    auto nb = [&](Op o) __attribute__((always_inline)) { o.code |= OPF_NOBAR; launch(o); };
    auto wt = [&](const float* W, int K, int N, int batch, nvbf* dst) __attribute__((always_inline)) { const int Np = nv_rup(N, 256), Kp = nv_rup(K, 128); Op o = mk(OP_WT, (long long)batch * Np * (Kp / 8)); o.a = W; o.o0 = (float*)dst; o.i0 = N; o.i1 = K; o.i2 = N; o.i3 = Np; o.i4 = Kp; nb(o); };
    wt(io.in[10], D, MIXIN, 2, WT_WIN); wt(io.in[21], 1024, D, 2, WT_WOUT); wt(io.in[23], D, D, 2, WT_WR); wt(io.in[24], D, D, 2, WT_WK); wt(io.in[25], D, D, 2, WT_WV); wt(io.in[26], D, D, 2, WT_WO);
    wt(io.in[28], D, 64, 2, WT_W1); wt(io.in[29], 64, D, 2, WT_W2); wt(io.in[31], D, 64, 2, WT_A1); wt(io.in[32], 64, D, 2, WT_A2); wt(io.in[36], D, 128, 2, WT_G1); wt(io.in[37], 128, D, 2, WT_G2);
    wt(io.in[34], D, 32, 1, WT_V1); wt(io.in[35], 32, D, 1, WT_V2); wt(io.in[43], D, 2048, 4, WT_WQ);
    for (int jj = 0; jj < 2; ++jj) { Op o = mk(OP_PRM, (long long)6 * D); o.a = io.in[27] + (size_t)jj * D; o.b = io.in[30] + (size_t)jj * D; o.c = jj > 0 ? io.in[33] + (size_t)(jj - 1) * D : nullptr; o.d = io.in[38] + (size_t)jj * D; o.e = io.in[39] + (size_t)jj * D; o.f = io.in[40] + (size_t)jj * RH * 64; o.o0 = PRM + (size_t)jj * 6 * D; nb(o); }
    for (int jj = 0; jj < 2; ++jj) { Op o = mk(OP_WGATE, 1024 * 64); o.a = io.in[16] + (size_t)jj * 8 * 64 * 64; o.b = io.in[18] + (size_t)jj * 8 * 64 * 64; o.c = io.in[20] + (size_t)jj * 512; o.o0 = (float*)(WT_WG + (size_t)jj * 1024 * 512); o.o1 = SPL + (size_t)jj * 512; nb(o); }
    auto fgemm = [&](const nvbf* Wt, float* C, int ldc, int N, int K, int bf16out = 0, const float* Aop = nullptr, bool nobar_ = false) __attribute__((always_inline)) {
        const int Kp = nv_rup(K, 128), Np = nv_rup(N, 256);
        Op o = mk(OP_FGEMM, (long long)M * N); o.a = Aop ? Aop : (const float*)ABF; o.b = (const float*)Wt; o.o0 = C; o.i0 = N; o.i1 = Kp; o.i2 = Kp; o.i3 = Kp; o.i4 = ldc; o.i5 = Np; o.i6 = bf16out; if (nobar_) nb(o); else launch(o); };
    auto gemm = [&](const float* A, int lda, const nvbf* Wt, float* C, int ldc, int N, int K, int act) __attribute__((always_inline)) {
        const int Kp = nv_rup(K, 128);
        { Op o = mk(OP_CVT8, (long long)Mp * (Kp / 8)); o.a = A; o.o0 = (float*)ABF; o.i0 = K; o.i1 = lda; o.i2 = Kp; o.i3 = act; launch(o); }
        fgemm(Wt, C, ldc, N, K); };
    { Op o = mk(OP_EMBED4, (long long)MD / 4); o.a = io.in[0]; o.b = io.in[1]; o.c = io.in[7]; o.o0 = X; o.o1 = (float*)ABF; launch(o); }
    const float* const w_outer = w; float* const out_outer = io.out;
    for (int layer = 0; layer < 4; ++layer) {
        float* wl = (float*)w_outer; float* ol = out_outer; NV_LAUNDER(wl); NV_LAUNDER(ol);
#define NV_RB(T, v) T const v##_rb = (T)((char*)wl + ((const char*)(v) - (const char*)w_outer))
#define NV_RO(v) float* const v##_rb = (float*)((char*)ol + ((const char*)(v) - (const char*)out_outer))
        NV_RB(float*, X); NV_RB(float*, VFIRST); NV_RB(float*, MOUT); NV_RB(nvbf*, ABF); NV_RB(nvbf*, WT_WIN); NV_RB(nvbf*, WT_WOUT); NV_RB(nvbf*, WT_WR); NV_RB(nvbf*, WT_WK); NV_RB(nvbf*, WT_WV); NV_RB(nvbf*, WT_WO);
        NV_RB(nvbf*, WT_W1); NV_RB(nvbf*, WT_W2); NV_RB(nvbf*, WT_A1); NV_RB(nvbf*, WT_A2); NV_RB(nvbf*, WT_G1); NV_RB(nvbf*, WT_G2); NV_RB(nvbf*, WT_V1); NV_RB(nvbf*, WT_V2); NV_RB(nvbf*, WT_WQ); NV_RB(nvbf*, WT_WG);
        NV_RB(float*, SPL); NV_RB(float*, PRM); NV_RB(nvbf*, UB); NV_RB(nvbf*, VB); NV_RB(nvbf*, KB); NV_RB(float*, KSUM);
        NV_RO(p_gla); NV_RO(p_h); NV_RO(p_conv); NV_RO(p_rwkv); NV_RO(p_shift); NV_RO(s_gla); NV_RO(s_h); NV_RO(s_conv); NV_RO(s_rwkv); NV_RO(s_shift);
#undef NV_RB
#undef NV_RO
        { float* const X = X_rb; float* const VFIRST = VFIRST_rb; float* const MOUT = MOUT_rb; nvbf* const ABF = ABF_rb; nvbf* const WT_WIN = WT_WIN_rb; nvbf* const WT_WOUT = WT_WOUT_rb; nvbf* const WT_WR = WT_WR_rb; nvbf* const WT_WK = WT_WK_rb;
          nvbf* const WT_WV = WT_WV_rb; nvbf* const WT_WO = WT_WO_rb; nvbf* const WT_W1 = WT_W1_rb; nvbf* const WT_W2 = WT_W2_rb; nvbf* const WT_A1 = WT_A1_rb; nvbf* const WT_A2 = WT_A2_rb; nvbf* const WT_G1 = WT_G1_rb; nvbf* const WT_G2 = WT_G2_rb;
          nvbf* const WT_V1 = WT_V1_rb; nvbf* const WT_V2 = WT_V2_rb; nvbf* const WT_WQ = WT_WQ_rb; nvbf* const WT_WG = WT_WG_rb; float* const SPL = SPL_rb; float* const PRM = PRM_rb; nvbf* const UB = UB_rb; nvbf* const VB = VB_rb; nvbf* const KB = KB_rb; float* const KSUM = KSUM_rb;
          float* const p_gla = p_gla_rb; float* const p_h = p_h_rb; float* const p_conv = p_conv_rb; float* const p_rwkv = p_rwkv_rb; float* const p_shift = p_shift_rb; float* const s_gla = s_gla_rb; float* const s_h = s_h_rb; float* const s_conv = s_conv_rb;
          float* const s_rwkv = s_rwkv_rb; float* const s_shift = s_shift_rb; float* const w = wl; (void)SPL; (void)WT_WG; (void)VFIRST;
        const int j = layer / 2; off = scratch0;
        if (layer % 2 == 0) {
            float* PROJ = take((size_t)M * MIXIN); float* LOGA = take((size_t)M * 256); float* O = take((size_t)M * 512); float* MIXO = X;
            float* XC = take((size_t)M * 512); nvbf* XCB = takeh((size_t)Mp * 512); float* AT = take((size_t)M * 512); float* BT = take((size_t)M * 512);
            const int NC = (dm.T + 63) / 64; float* LEND = take((size_t)B * 4 * NC * 8192); float* DEC = take((size_t)B * 4 * NC * 64); float* LA = take((size_t)B * NC * 512); float* LB = take((size_t)B * NC * 512);
            fgemm(WT_WIN + (size_t)j * SZ_WIN, PROJ, MIXIN, MIXIN, D);
            { Op o = mk(OP_LOGA4, (long long)M * 64); o.a = PROJ; o.b = io.in[11] + (size_t)j * 16 * 256; o.c = io.in[12] + (size_t)j * 256; o.o0 = LOGA; nb(o); }
            { Op o = mk(OP_CONV4, (long long)((M + 3) / 4) * 128); o.a = PROJ; o.b = io.in[4] + (size_t)j * DB * 3 * 512; o.c = io.in[14] + (size_t)j * 4 * 512; o.d = io.in[15] + (size_t)j * 512; o.o0 = XC; o.o1 = (float*)XCB; nb(o); }
            { Op o = mk(OP_CONVOUT, (long long)dm.NSEQ * 1536); o.a = PROJ; o.b = io.in[4] + (size_t)j * DB * 3 * 512; o.o1 = p_conv + (size_t)j * B * 3 * 512; o.o2 = s_conv + (size_t)j * DB * 3 * 512; launch(o); }
            { Op o = mk(OP_GLAF, (long long)B * 512); o.a = PROJ; o.b = LOGA; o.o0 = O; o.o1 = p_gla + (size_t)j * B * 4 * 64 * 128; nb(o); }
            { Op o = mk(OP_GLA3, (long long)(DB * 4) * 128); o.a = PROJ; o.b = LOGA; o.c = io.in[2] + (size_t)j * DB * 4 * 64 * 128; o.d = LEND; o.o0 = O; o.o2 = s_gla + (size_t)j * DB * 4 * 64 * 128; o.i0 = NC; o.i1 = 1; nb(o); }
            { Op o = mk(OP_LRUG2, (long long)M * 512); o.a = (const float*)XCB; o.b = (const float*)(WT_WG + (size_t)j * 1024 * 512); o.c = io.in[17] + (size_t)j * 512; o.d = io.in[19] + (size_t)j * 512; o.e = SPL + (size_t)j * 512; o.f = (const float*)XCB; o.o0 = AT; o.o1 = BT; launch(o); }
            { Op o = mk(OP_GLANORM, (long long)M * 4); o.a = O; o.b = PROJ; o.c = io.in[13] + (size_t)j * 128; o.o0 = MIXO; nb(o); }
            { Op o = mk(OP_LRU1, (long long)B * NC * 512); o.a = AT; o.b = BT; o.o0 = LA; o.o1 = LB; o.i0 = NC; launch(o); }
            { Op o = mk(OP_LRU3, (long long)(B * NC + DB) * 512); o.a = AT; o.b = BT; o.c = PROJ; o.d = io.in[3] + (size_t)j * DB * 512; o.e = LB; o.f = LA; o.o0 = MIXO; o.o1 = p_h + (size_t)j * B * 512; o.o2 = s_h + (size_t)j * DB * 512; o.i0 = NC; launch(o); }
            fgemm(WT_WOUT + (size_t)j * SZ_WOUT, MOUT, D, D, 1024, 1, X, true);
        } else {
            float* Y = take(MD); float* R = take(MD); float* K = take(MD); float* V = take(MD); float* G = take(MD); float* KK = take(MD);
            const size_t XMSZ = (size_t)Mp * D;
            float* WAV = take(3 * MD > 3 * XMSZ ? 3 * MD : 3 * XMSZ); float* Wd = WAV; float* Aa = WAV + MD; float* Vg = WAV + 2 * MD; nvbf* XM6 = (nvbf*)WAV;
            float* BON = take((size_t)M * RH); float* HLw = take((size_t)M * 64); float* HLa = take((size_t)M * 64); float* HLg = take((size_t)M * 128); float* HLv = take((size_t)M * 32);
            nvbf* ABw = takeh((size_t)Mp * 128); nvbf* ABa = takeh((size_t)Mp * 128); nvbf* ABg = takeh((size_t)Mp * 128); nvbf* ABv = takeh((size_t)Mp * 128);
            const float* shin = io.in[6] + (size_t)j * DB * D; const float* mu = io.in[22] + (size_t)j * 6 * D;
            { Op o = mk(OP_SHIFTOUT, (long long)dm.NSEQ * D); o.a = (const float*)ABF; o.o1 = p_shift + (size_t)j * B * D; o.o2 = s_shift + (size_t)j * DB * D; nb(o); }
            { Op o = mk(OP_MIX6, (long long)((M + 3) / 4) * (D / 8)); o.a = (const float*)ABF; o.b = shin; o.c = mu; o.o0 = (float*)XM6; o.i1 = (int)(XMSZ / 1024); launch(o); }
            auto gg = [&](const nvbf* A, const nvbf* Wt, float* C, int ldc, int N, int K, bool last, int bf16out = 0) __attribute__((always_inline)) { const int Kp = nv_rup(K, 128), Np = nv_rup(N, 256);
                Op o = mk(OP_FGEMM, (long long)M * N); o.a = (const float*)A; o.b = (const float*)Wt; o.o0 = C; o.i0 = N; o.i1 = Kp; o.i2 = Kp; o.i3 = Kp; o.i4 = ldc; o.i5 = Np; o.i6 = bf16out; if (!last) o.code |= OPF_GROUP; launch(o); };
            gg(XM6 + 0 * XMSZ, WT_WR + (size_t)j * SZ_DD, R, D, D, D, false, 1); gg(XM6 + 2 * XMSZ, WT_WK + (size_t)j * SZ_DD, K, D, D, D, false, 1); gg(XM6 + 3 * XMSZ, WT_WV + (size_t)j * SZ_DD, V, D, D, D, false, 1);
            gg(XM6 + 1 * XMSZ, WT_W1 + (size_t)j * SZ_DN, HLw, 64, 64, D, false); gg(XM6 + 4 * XMSZ, WT_A1 + (size_t)j * SZ_DN, HLa, 64, 64, D, false);
            if (j > 0) gg(XM6 + 3 * XMSZ, WT_V1 + (size_t)(j - 1) * SZ_DN, HLv, 32, 32, D, false);
            gg(XM6 + 5 * XMSZ, WT_G1 + (size_t)j * SZ_DN, HLg, 128, 128, D, true);
            auto cv = [&](const float* A, int K, nvbf* dst, int act, bool last) __attribute__((always_inline)) { Op o = mk(OP_CVT8, (long long)Mp * 16); o.a = A; o.o0 = (float*)dst; o.i0 = K; o.i1 = K; o.i2 = 128; o.i3 = act; if (last) launch(o); else nb(o); };
            cv(HLw, 64, ABw, 1, false); cv(HLa, 64, ABa, 0, false); if (j > 0) cv(HLv, 32, ABv, 0, false); cv(HLg, 128, ABg, 2, true);
            gg(ABw, WT_W2 + (size_t)j * SZ_UP, Wd, D, D, 64, false, 1); gg(ABa, WT_A2 + (size_t)j * SZ_UP, Aa, D, D, 64, false, 1); if (j > 0) gg(ABv, WT_V2 + (size_t)(j - 1) * SZ_UP, Vg, D, D, 32, false, 1); gg(ABg, WT_G2 + (size_t)j * SZ_UP, G, D, D, 128, true, 1);
            { Op o = mk(OP_WKVP, (long long)dm.NSEQ * RH * 64); o.a = R; o.b = K; o.c = Wd; o.d = Aa; o.e = V; o.f = Vg; o.g = VFIRST; o.h = PRM + (size_t)j * 6 * D; o.o0 = Y; o.o1 = p_rwkv + (size_t)j * B * RH * 4096; o.o2 = s_rwkv + (size_t)j * DB * RH * 4096;
              o.o3 = j > 0 ? KK : VFIRST; o.o4 = BON; o.o5 = (float*)(io.in[5] + (size_t)j * DB * RH * 4096); o.i0 = j > 0 ? 1 : 0; launch(o); }
            { Op o = mk(OP_POST2, (long long)M * RH); o.a = Y; o.b = G; o.c = j > 0 ? KK : VFIRST; o.d = BON; o.e = io.in[41] + (size_t)j * D; o.f = io.in[42] + (size_t)j * D; o.o0 = X; launch(o); }
            fgemm(WT_WO + (size_t)j * SZ_DD, MOUT, D, D, D, 1, X, true);
        }
        { Op o = mk(OP_CVTTAB8S, (long long)16384 * D / 16); o.a = io.in[45] + (size_t)layer * 16384 * D; o.o0 = (float*)UB; o.i0 = 7; o.i6 = (Mp / 256) * (nv_rup(D, 256) / 256); launch(o); }
        { Op o = mk(OP_LNRES, M); o.a = MOUT; o.b = io.in[8] + (size_t)(layer * 2 + 0) * D; o.c = io.in[9] + (size_t)(layer * 2 + 0) * D; o.o0 = X; o.o1 = (float*)ABF; o.o2 = (float*)(ABF + ABFN); launch(o); }
        off = scratch0;
        { nvbf* Q = takeh((size_t)Mp * 2048); float* SC = take((size_t)M * 2048); float* GATE = take((size_t)M * 128); float* EIDX = take((size_t)M * 128); float* TMPV = take((size_t)M * 256); float* TMPI = take((size_t)M * 256);
          float* COEF = take((size_t)M * 128);
          { Op o = mk(OP_FGEMM, (long long)M * 2048); o.a = (const float*)ABF; o.b = (const float*)(WT_WQ + (size_t)layer * SZ_WQ); o.o0 = (float*)Q; o.i0 = 2048; o.i1 = Dk; o.i2 = Dk; o.i3 = Dk; o.i4 = 2048; o.i5 = 2048; o.i6 = 1; nb(o); }
          { Op o = mk(OP_CVTTAB8S, (long long)16384 * D / 16); o.a = io.in[46] + (size_t)layer * 16384 * D; o.o0 = (float*)VB; o.i0 = 6; o.i6 = (Mp / 256) * 8; nb(o); }
          { Op o = mk(OP_KEYS, 8 * 256 * 32); o.a = io.in[44] + (size_t)layer * 8 * 2 * 128 * 128; o.o0 = (float*)KB; o.o1 = KSUM; launch(o); }
          { Op o = mk(OP_FGEMM, (long long)M * 2048); o.a = (const float*)Q; o.b = (const float*)KB; o.o0 = SC; o.i0 = 2048; o.i1 = 256; o.i2 = 2048; o.i3 = 256; o.i4 = 2048; o.i5 = 2048; o.i6 = 3; launch(o); }
          { Op o = mk(OP_TOPK2, (long long)M * 8); o.a = SC; o.b = (const float*)Q; o.c = KSUM; o.o0 = GATE; o.o1 = EIDX; o.o2 = TMPV; o.o3 = TMPI; launch(o); }
          { const int NS = D / 128; float* PART = take((size_t)NS * M * 128); float* YBUF = take(MD);
            #ifdef PROBE_EMASK
            { Op o = mk(OP_PACTS, (long long)NS * M * 128); o.a = (const float*)(ABF + ABFN); o.b = (const float*)UB; o.d = EIDX; o.o0 = PART; o.i0 = PROBE_EMASK; launch(o); }
#endif
            { Op o = mk(OP_PACTS, (long long)NS * M * 128); o.a = (const float*)(ABF + ABFN); o.b = (const float*)UB; o.d = EIDX; o.o0 = PART; o.i0 = 16383; launch(o); }
            { Op o = mk(OP_PRED, (long long)M * 32); o.a = PART; o.c = GATE; o.o0 = COEF; o.i0 = NS; launch(o); }
            { Op o = mk(OP_POUTS, (long long)MD); o.a = COEF; o.b = EIDX; o.c = (const float*)VB; o.o0 = YBUF; launch(o); }
            { Op o = mk(OP_LNRES, M); o.a = YBUF; o.b = io.in[8] + (size_t)(layer * 2 + 1) * D; o.c = io.in[9] + (size_t)(layer * 2 + 1) * D; o.o0 = X; o.o1 = (float*)ABF; launch(o); } } }
        }
    }
    { Op o = mk(OP_YOUT4, (long long)MD / 4); o.a = (const float*)ABF; o.o0 = y_prompt; launch(o); }
    (void)y_sample;
}

#include <cstdint>
namespace pg8 {
#define PG8_LAS __attribute__((address_space(3)))
typedef unsigned short bf16_t;
typedef short bf16x8 __attribute__((ext_vector_type(8)));
typedef float f32x4 __attribute__((ext_vector_type(4)));
typedef unsigned u32x4 __attribute__((ext_vector_type(4)));
constexpr int BM = 256, BK = 64, HALF = 128, HTB = HALF * BK * 2  , STAGE_BYTES = 8 * HTB, NXCD = 8, WGM = 8;

__host__ __device__ __forceinline__ int lds_byte(int r, int c) { const int st = (r >> 4) * 2 + (c >> 5), rr = r & 15, cc = c & 31, ob = rr * 64 + cc * 2; return st * 1024 + (ob ^ (((ob >> 9) & 1) << 5)); }
__host__ __device__ __forceinline__ void stage_rc(int b, int& R, int& C) { const int st = b / 1024, sb = b % 1024, swz = sb ^ (((sb >> 9) & 1) << 5); R = (st >> 1) * 16 + swz / 64; C = (st & 1) * 32 + (swz % 64) / 2; }
__host__ __device__ __forceinline__ int perm32(int rho) { const int n = rho >> 4, i = rho & 15; return 8 * (i >> 2) + 4 * n + (i & 3); }

struct Unit { int pm, pn, grp, pad_; const char* A; const char* B; };
struct Gemm { const bf16_t* A; const bf16_t* Bt; int M, N, K, lda, ldb; };

struct StaticOrder {
    int nM, nN, nwg, G, c; const char* A; const char* B; size_t tsA, tsB, acs;
    __host__ __device__ void init(const Gemm& g, int G_, int c_) { nM = g.M / BM; nN = g.N / BM; nwg = nM * nN; G = G_; c = c_; A = (const char*)g.A; B = (const char*)g.Bt; tsA = (size_t)BM * g.lda * 2; tsB = (size_t)BM * g.ldb * 2; acs = 0; }
    __host__ __device__ bool next(int i, Unit& u) const {
        const long L = (long)i * G + c; if (L >= nwg) return false;
        int wgid = (int)L; { const int q = nwg / NXCD, r = nwg % NXCD, xcd = wgid % NXCD, off = wgid / NXCD; wgid = (xcd < r ? xcd * (q + 1) : r * (q + 1) + (xcd - r) * q) + off; }
        const int nig = WGM * nN, gid = wgid / nig, fm = gid * WGM, gsz = (nM - fm) < WGM ? (nM - fm) : WGM;
        u.pm = fm + ((wgid % nig) % gsz); u.pn = (wgid % nig) / gsz; u.grp = 0; u.pad_ = 0; u.A = A + (size_t)u.pm * tsA + (size_t)u.pn * acs; u.B = B + (size_t)u.pn * tsB; return true;
    }
    __device__ __forceinline__ void a_ready(const Unit&) const {}
    __device__ __forceinline__ void done(const Unit&) const {}
};

template <class Epi, class Sched, bool ALIGN_EPI = false, bool SP2 = false>
__device__ __forceinline__ void gemm_phase(PG8_LAS unsigned char* lds, const Gemm g, const Sched& S, const Epi& E) {
    int tid_raw = threadIdx.x; asm volatile("" : "+v"(tid_raw));
    const int tid = tid_raw, wid = __builtin_amdgcn_readfirstlane(tid >> 6), lane = tid & 63, wr = wid >> 2, wc = wid & 3, fr = lane & 15, fq = lane >> 4;
    const int K = g.K, nt = K / BK;
    unsigned voffA[2], voffB[2];
#pragma unroll
    for (int i = 0; i < 2; ++i) { int R, C; stage_rc(tid * 16 + i * 8192, R, C); const int Rb = Epi::PERM ? ((R & ~31) + perm32(R & 31)) : R;
        voffA[i] = (unsigned)(R * g.lda + C) * 2u; voffB[i] = (unsigned)(Rb * g.ldb + C) * 2u; }
    const size_t kstep = (size_t)(BK * 2);
    const size_t hstepA = (size_t)HALF * g.lda * 2, hstepB = (size_t)HALF * g.ldb * 2;
    const unsigned ldsw = (unsigned)wid * 1024u;
    const int aoff = lds_byte(wr * 64 + fr, fq * 8), boff = lds_byte(wc * 32 + fr, fq * 8);
#define PG8_SA(b, h) (((b) * 2 + (h)) * HTB)
#define PG8_SB(b, h) ((4 + (b) * 2 + (h)) * HTB)
#define PG8_STAGE(bufoff, gbase, voff) do { _Pragma("unroll") for (int _i = 0; _i < 2; ++_i) \
        __builtin_amdgcn_global_load_lds((const unsigned*)((const char*)(gbase) + (voff)[_i]), (PG8_LAS unsigned*)(lds + (bufoff) + ldsw + _i * 8192), 16, 0, 0); } while (0)
#define PG8_LDA(dst, b, h) do { _Pragma("unroll") for (int m = 0; m < 4; ++m) _Pragma("unroll") for (int k = 0; k < 2; ++k) dst[m][k] = *(const PG8_LAS bf16x8*)(lds + PG8_SA(b, h) + aoff + m * 2048 + k * 1024); } while (0)
#define PG8_LDB(dst, b, h) do { _Pragma("unroll") for (int n = 0; n < 2; ++n) _Pragma("unroll") for (int k = 0; k < 2; ++k) dst[n][k] = *(const PG8_LAS bf16x8*)(lds + PG8_SB(b, h) + boff + n * 2048 + k * 1024); } while (0)
#define PG8_MMA(ai, bj, At, Bt) do { __builtin_amdgcn_s_setprio(1); _Pragma("unroll") for (int m = 0; m < 4; ++m) _Pragma("unroll") for (int n = 0; n < 2; ++n) _Pragma("unroll") for (int k = 0; k < 2; ++k) \
        acc[ai][bj][m][n] = __builtin_amdgcn_mfma_f32_16x16x32_bf16(Bt[n][k], At[m][k], acc[ai][bj][m][n], 0, 0, 0); __builtin_amdgcn_s_setprio(0); } while (0)
#define PG8_WAIT_V(n) asm volatile("s_waitcnt vmcnt(" #n ")" ::: "memory")
#define PG8_WAIT_L(n) asm volatile("s_waitcnt lgkmcnt(" #n ")" ::: "memory")
#define PG8_BAR __builtin_amdgcn_s_barrier()
#define PG8_SCHED __builtin_amdgcn_sched_barrier(0)
    Unit cur, nxt; int ui = 0;
    if (!S.next(0, cur)) return;
    f32x4 acc[2][2][4][2];
#pragma unroll
    for (int a = 0; a < 2; ++a)
#pragma unroll
        for (int b = 0; b < 2; ++b)
#pragma unroll
            for (int m = 0; m < 4; ++m)
#pragma unroll
                for (int n = 0; n < 2; ++n) acc[a][b][m][n] = (f32x4){0.f, 0.f, 0.f, 0.f};
    bf16x8 At[4][2], B0[2][2], B1[2][2];
    const char* cA = cur.A; const char* cB = cur.B;
    S.a_ready(cur);
    if constexpr (SP2) {
        PG8_STAGE(PG8_SB(0, 0), cB, voffB); PG8_STAGE(PG8_SB(0, 1), cB + hstepB, voffB); PG8_STAGE(PG8_SA(0, 0), cA, voffA); PG8_STAGE(PG8_SA(0, 1), cA + hstepA, voffA);
        if (wr == 1) PG8_BAR;
        PG8_WAIT_V(2); PG8_BAR;
        PG8_STAGE(PG8_SB(1, 0), cB + kstep, voffB); PG8_STAGE(PG8_SA(1, 0), cA + kstep, voffA); PG8_STAGE(PG8_SB(1, 1), cB + hstepB + kstep, voffB);
        PG8_WAIT_V(6); PG8_BAR;
    } else {
        PG8_STAGE(PG8_SB(0, 0), cB, voffB); PG8_STAGE(PG8_SA(0, 0), cA, voffA); PG8_STAGE(PG8_SB(0, 1), cB + hstepB, voffB); PG8_STAGE(PG8_SA(0, 1), cA + hstepA, voffA);
        if (wr == 1) PG8_BAR;
        PG8_WAIT_V(4); PG8_BAR;
        PG8_STAGE(PG8_SB(1, 0), cB + kstep, voffB); PG8_STAGE(PG8_SA(1, 0), cA + kstep, voffA); PG8_STAGE(PG8_SB(1, 1), cB + hstepB + kstep, voffB);
        PG8_WAIT_V(6); PG8_BAR;
    }
    for (;;) {
        const bool has_next = S.next(ui + 1, nxt);
        const char* nA = has_next ? nxt.A : cA; const char* nB = has_next ? nxt.B : cB;
        for (int t = 0; t < nt; t += 2) {
            const bool last = (t == nt - 2);
            const char* a1 = cA + (size_t)(t + 1) * kstep;
            const char* a2 = last ? nA : cA + (size_t)(t + 2) * kstep; const char* b2 = last ? nB : cB + (size_t)(t + 2) * kstep;
            const char* a3 = a2 + kstep; const char* b3 = b2 + kstep;
            if (last && has_next) S.a_ready(nxt);
            if constexpr (SP2) {
            PG8_LDB(B0, 0, 0); PG8_LDB(B1, 0, 1); PG8_SCHED; PG8_LDA(At, 0, 0); PG8_STAGE(PG8_SA(1, 1), a1 + hstepA, voffA);
            PG8_WAIT_V(8); PG8_WAIT_L(0); PG8_BAR; PG8_MMA(0, 0, At, B0); PG8_MMA(0, 1, At, B1); PG8_BAR; PG8_SCHED;
            PG8_LDA(At, 0, 1); PG8_STAGE(PG8_SB(0, 0), b2, voffB); PG8_STAGE(PG8_SB(0, 1), b2 + hstepB, voffB); PG8_STAGE(PG8_SA(0, 0), a2, voffA);
            PG8_WAIT_V(8); PG8_WAIT_L(0); PG8_BAR; PG8_MMA(1, 0, At, B0); PG8_MMA(1, 1, At, B1); PG8_BAR; PG8_SCHED;
            PG8_LDB(B0, 1, 0); PG8_LDB(B1, 1, 1); PG8_SCHED; PG8_LDA(At, 1, 0); PG8_STAGE(PG8_SA(0, 1), a2 + hstepA, voffA);
            PG8_WAIT_V(8); PG8_WAIT_L(0); PG8_BAR; PG8_MMA(0, 0, At, B0); PG8_MMA(0, 1, At, B1); PG8_BAR; PG8_SCHED;
            PG8_LDA(At, 1, 1); PG8_STAGE(PG8_SB(1, 0), b3, voffB); PG8_STAGE(PG8_SB(1, 1), b3 + hstepB, voffB); PG8_STAGE(PG8_SA(1, 0), a3, voffA);
            PG8_WAIT_V(8); PG8_WAIT_L(0); PG8_BAR; PG8_MMA(1, 0, At, B0); PG8_MMA(1, 1, At, B1); PG8_BAR; PG8_SCHED;
            } else {
            PG8_LDB(B0, 0, 0); PG8_SCHED; PG8_LDA(At, 0, 0); PG8_STAGE(PG8_SA(1, 1), a1 + hstepA, voffA);
            PG8_WAIT_L(8); PG8_BAR; PG8_WAIT_L(0); PG8_MMA(0, 0, At, B0); PG8_BAR; PG8_SCHED;
            PG8_LDB(B1, 0, 1); PG8_STAGE(PG8_SB(0, 0), b2, voffB);
            PG8_BAR; PG8_WAIT_L(0); PG8_MMA(0, 1, At, B1); PG8_BAR;
            PG8_LDA(At, 0, 1); PG8_STAGE(PG8_SA(0, 0), a2, voffA);
            PG8_BAR; PG8_WAIT_L(0); PG8_MMA(1, 0, At, B0); PG8_BAR; PG8_SCHED;
            PG8_STAGE(PG8_SB(0, 1), b2 + hstepB, voffB);
            PG8_WAIT_V(6); PG8_BAR; PG8_MMA(1, 1, At, B1); PG8_BAR;
            PG8_LDB(B0, 1, 0); PG8_SCHED; PG8_LDA(At, 1, 0); PG8_STAGE(PG8_SA(0, 1), a2 + hstepA, voffA);
            PG8_WAIT_L(8); PG8_BAR; PG8_WAIT_L(0); PG8_MMA(0, 0, At, B0); PG8_BAR; PG8_SCHED;
            PG8_LDB(B1, 1, 1); PG8_STAGE(PG8_SB(1, 0), b3, voffB);
            PG8_BAR; PG8_WAIT_L(0); PG8_MMA(0, 1, At, B1); PG8_BAR;
            PG8_LDA(At, 1, 1); PG8_STAGE(PG8_SA(1, 0), a3, voffA);
            PG8_BAR; PG8_WAIT_L(0); PG8_MMA(1, 0, At, B0); PG8_BAR; PG8_SCHED;
            PG8_STAGE(PG8_SB(1, 1), b3 + hstepB, voffB);
            PG8_WAIT_V(6); PG8_BAR; PG8_MMA(1, 1, At, B1); PG8_BAR;
            }
        }
        if constexpr (ALIGN_EPI) { if (wr == 0) PG8_BAR; }
        if constexpr (!Epi::AFTER_DRAIN) { E(acc, cur, wr, wc, fr, fq); S.done(cur); }
        if (!has_next) break;
#pragma unroll
        for (int a = 0; a < 2; ++a)
#pragma unroll
            for (int b = 0; b < 2; ++b)
#pragma unroll
                for (int m = 0; m < 4; ++m)
#pragma unroll
                    for (int n = 0; n < 2; ++n) acc[a][b][m][n] = (f32x4){0.f, 0.f, 0.f, 0.f};
        cur = nxt; cA = nA; cB = nB; ++ui;
        if constexpr (ALIGN_EPI) { if (wr == 1) PG8_BAR; }
    }
    PG8_WAIT_V(0);
    if constexpr (!ALIGN_EPI) { if (wr == 0) PG8_BAR; }
    PG8_BAR;
    if constexpr (Epi::AFTER_DRAIN) { E.fused(acc, cur, wr, wc, fr, fq, lds, wid, lane); S.done(cur); }
#undef PG8_SA
#undef PG8_SB
#undef PG8_STAGE
#undef PG8_LDA
#undef PG8_LDB
#undef PG8_MMA
#undef PG8_WAIT_V
#undef PG8_WAIT_L
#undef PG8_BAR
#undef PG8_SCHED
}
}
template <class T> __device__ __forceinline__ T* uni_ptr(T* p) {
    unsigned long long v = (unsigned long long)p; unsigned lo = __builtin_amdgcn_readfirstlane((unsigned)v), hi = __builtin_amdgcn_readfirstlane((unsigned)(v >> 32));
    unsigned long long r = ((unsigned long long)hi << 32) | lo; asm volatile("" : "+s"(r)); return (T*)r; }
__device__ __forceinline__ int rfl(int x) { int t = __builtin_amdgcn_readfirstlane(x); asm volatile("" : "+s"(t)); return t; }
namespace pg8 {
__device__ __forceinline__ unsigned cvt_pk_bf16(float lo, float hi) { unsigned r; asm volatile("v_cvt_pk_bf16_f32 %0, %1, %2" : "=v"(r) : "v"(lo), "v"(hi)); return r; }
struct EpiF32 {
    static constexpr bool PERM = false, AFTER_DRAIN = false;
    float* C; int ldc, Mreal, Nreal;
    __device__ __forceinline__ void operator()(const f32x4 (&acc)[2][2][4][2], const Unit& u, int wr, int wc, int fr, int fq) const {
        const int row0 = u.pm * BM + wr * 64 + fr, col0 = u.pn * BM + wc * 32 + 4 * fq;
#pragma unroll
        for (int ai = 0; ai < 2; ++ai)
#pragma unroll
            for (int m = 0; m < 4; ++m) { const int r = row0 + ai * HALF + m * 16; if (r < Mreal) { float* rowp = C + (size_t)r * ldc + col0;
#pragma unroll
                for (int bj = 0; bj < 2; ++bj)
#pragma unroll
                    for (int n = 0; n < 2; ++n) { const int c = col0 + bj * HALF + n * 16; if (c < Nreal) *(f32x4*)(rowp + bj * HALF + n * 16) = acc[ai][bj][m][n]; } } }
    }
};
struct EpiBf16Plain {
    static constexpr bool PERM = true, AFTER_DRAIN = false;
    bf16_t* O; int ldc;
    __device__ __forceinline__ void operator()(const f32x4 (&acc)[2][2][4][2], const Unit& u, int wr, int wc, int fr, int fq) const {
        const int row0 = u.pm * BM + wr * 64 + fr, col0 = u.pn * BM + wc * 32 + 8 * fq;
#pragma unroll
        for (int ai = 0; ai < 2; ++ai)
#pragma unroll
            for (int m = 0; m < 4; ++m) { bf16_t* rowp = O + (size_t)(row0 + ai * HALF + m * 16) * ldc + col0;
#pragma unroll
                for (int bj = 0; bj < 2; ++bj) { const f32x4 v0 = acc[ai][bj][m][0], v1 = acc[ai][bj][m][1]; u32x4 w;
                    w.x = cvt_pk_bf16(v0[0], v0[1]); w.y = cvt_pk_bf16(v0[2], v0[3]); w.z = cvt_pk_bf16(v1[0], v1[1]); w.w = cvt_pk_bf16(v1[2], v1[3]);
                    *(u32x4*)(rowp + bj * HALF) = w; } }
    }
};
struct EpiLru {
    static constexpr bool PERM = false, AFTER_DRAIN = false;
    const float* ba; const float* bx; const float* spl; const bf16_t* XC; float* AT; float* BT; int Mreal;
    __device__ __forceinline__ void operator()(const f32x4 (&acc)[2][2][4][2], const Unit& u, int wr, int wc, int fr, int fq) const {
        const int row0 = u.pm * BM + wr * 64 + fr, ch0 = u.pn * 128 + wc * 32 + 4 * fq;
#pragma unroll
        for (int n = 0; n < 2; ++n) { const int c = ch0 + 16 * n; const f32x4 ba4 = *(const f32x4*)(ba + c), bx4 = *(const f32x4*)(bx + c), sp4 = *(const f32x4*)(spl + c);
#pragma unroll
            for (int ai = 0; ai < 2; ++ai)
#pragma unroll
                for (int m = 0; m < 4; ++m) { const int r = row0 + ai * HALF + m * 16; if (r < Mreal) { const unsigned long long xw_ = *(const unsigned long long*)(XC + (size_t)r * 512 + c); const unsigned xl_ = (unsigned)xw_, xh_ = (unsigned)(xw_ >> 32); const f32x4 xc = {__uint_as_float(xl_ << 16), __uint_as_float(xl_ & 0xffff0000u), __uint_as_float(xh_ << 16), __uint_as_float(xh_ & 0xffff0000u)}; const f32x4 ga = acc[ai][0][m][n] + ba4, gx = acc[ai][1][m][n] + bx4; f32x4 at, bt;
#pragma unroll
                    for (int i = 0; i < 4; ++i) { const float gate_a = __builtin_amdgcn_rcpf(1.f + __expf(-ga[i])), gate_x = __builtin_amdgcn_rcpf(1.f + __expf(-gx[i])); const float la = gate_a * sp4[i]; at[i] = __expf(la); bt[i] = sqrtf(-expm1f(2.f * la)) * (gate_x * xc[i]); }
                    *(f32x4*)(AT + (size_t)r * 512 + c) = at; *(f32x4*)(BT + (size_t)r * 512 + c) = bt; } } }
    }
};
struct GroupOrder {
    const PG8_LAS Op* tab; int ng, nM, G, c; size_t tsA, tsB;
    __device__ __forceinline__ bool next(int i, Unit& u) const {
        int L = i * G + c, g = 0;
        for (; g < ng; ++g) { const int cnt = nM * (__builtin_amdgcn_readfirstlane(tab[g].i5) >> 8); if (L < cnt) break; L -= cnt; }
        if (g >= ng) return false;
        u.pm = L % nM; u.pn = L / nM; u.grp = g; u.pad_ = 0;
        u.A = (const char*)uni_ptr(tab[g].a) + (size_t)u.pm * tsA; u.B = (const char*)uni_ptr(tab[g].b) + (size_t)u.pn * tsB; return true;
    }
    __device__ __forceinline__ void a_ready(const Unit&) const {}
    __device__ __forceinline__ void done(const Unit&) const {}
};
struct EpiGroup {
    static constexpr bool PERM = true, AFTER_DRAIN = false;
    const PG8_LAS Op* tab; int Mreal;
    __device__ __forceinline__ void operator()(const f32x4 (&acc)[2][2][4][2], const Unit& u, int wr, int wc, int fr, int fq) const {
        const int ldc = rfl(tab[u.grp].i4), Nreal = rfl(tab[u.grp].i0), fl = rfl(tab[u.grp].i6);
        if (fl & 1) { const EpiBf16Plain E{(bf16_t*)uni_ptr(tab[u.grp].o0), ldc}; E(acc, u, wr, wc, fr, fq); return; }
        float* C = uni_ptr(tab[u.grp].o0); const int row0 = u.pm * BM + wr * 64 + fr, col0 = u.pn * BM + wc * 32 + 8 * fq;
#pragma unroll
        for (int ai = 0; ai < 2; ++ai)
#pragma unroll
            for (int m = 0; m < 4; ++m) { const int r = row0 + ai * HALF + m * 16; if (r < Mreal) { float* rowp = C + (size_t)r * ldc + col0;
#pragma unroll
                for (int bj = 0; bj < 2; ++bj) { if (col0 + bj * HALF < Nreal) { *(f32x4*)(rowp + bj * HALF) = acc[ai][bj][m][0]; *(f32x4*)(rowp + bj * HALF + 4) = acc[ai][bj][m][1]; } } } }
    }
};
}

#define XB_TMO      128
#define XB_XCNT(j)  (256  + 64 * (j))
#define XB_XSUB(j)  (1280 + 64 * (j))
#define XB_XGEN(j)  (2304 + 64 * (j))
#define XB_TOP      3328
#define XB_TOPGEN   3392
#define XCD_BAR_WORDS 3456
#define XB_SPIN_CAP (1u << 18)
#define LAS __attribute__((address_space(3)))
__device__ __forceinline__ unsigned xb_ld(unsigned* p)              { return __hip_atomic_load(p, __ATOMIC_RELAXED, __HIP_MEMORY_SCOPE_AGENT); }
__device__ __forceinline__ unsigned xb_add(unsigned* p, unsigned v) { return __hip_atomic_fetch_add(p, v, __ATOMIC_RELAXED, __HIP_MEMORY_SCOPE_AGENT); }
__device__ __forceinline__ unsigned xb_xcc_id() { return (unsigned)__builtin_amdgcn_s_getreg((3 << 11) | 20) & 0xFu; }
#define XB_SPIN(cond, bar) do { unsigned _sp = 0; while (cond) { __builtin_amdgcn_s_sleep(1); \
    if ((++_sp & 255u) == 0u) { if (xb_ld(&(bar)[XB_TMO])) break; if (_sp > XB_SPIN_CAP) { atomicAdd(&(bar)[XB_TMO], 1u); break; } } } } while (0)
struct XcdBarrier { unsigned* bar; unsigned x; volatile LAS unsigned* st; };
__device__ __forceinline__ XcdBarrier xcd_barrier_post(unsigned* bar, volatile LAS unsigned* st) {
    XcdBarrier b; b.bar = bar; b.x = xb_xcc_id(); b.st = st;
    if (threadIdx.x == 0) (void)xb_add(&bar[XB_XCNT(b.x)], 1u);
    return b;
}
__device__ __forceinline__ void xcd_barrier_complete(unsigned* bar, unsigned x, unsigned& nloc, unsigned& nx) {
    const unsigned G = gridDim.x * gridDim.y * gridDim.z;
    unsigned sum, cnt, mine, sp = 0u;
    for (;;) {
        sum = 0u; cnt = 0u; mine = 0u;
#pragma unroll
        for (unsigned j = 0; j < 16; ++j) { const unsigned c = xb_ld(&bar[XB_XCNT(j)]); sum += c; cnt += (c > 0u) ? 1u : 0u; mine = (j == x) ? c : mine; }
        if (sum == G) break;
        __builtin_amdgcn_s_sleep(1);
        if ((++sp & 255u) == 0u) { if (xb_ld(&bar[XB_TMO])) break; if (sp > XB_SPIN_CAP) { atomicAdd(&bar[XB_TMO], 1u); break; } }
    }
    nloc = mine > 0u ? mine : 1u; nx = cnt > 0u ? cnt : 1u;
}
__device__ __forceinline__ void xcd_barrier(const XcdBarrier& b) {
    asm volatile("s_waitcnt vmcnt(0)" ::: "memory");
    __syncthreads();
    if (threadIdx.x == 0) {
        unsigned* bar = b.bar;
        __builtin_amdgcn_s_waitcnt(0);
        unsigned nloc = b.st[0], nx = b.st[1];
        if (nloc == 0u) { xcd_barrier_complete(bar, b.x, nloc, nx); b.st[0] = nloc; b.st[1] = nx; }
        const unsigned old = xb_add(&bar[XB_XSUB(b.x)], 1u);
        const unsigned gen = old / nloc;
        if (old + 1u == (gen + 1u) * nloc) {
            __builtin_amdgcn_fence(__ATOMIC_RELEASE, "agent");
            asm volatile("s_waitcnt vmcnt(0)" ::: "memory");
            const unsigned og = xb_add(&bar[XB_TOP], 1u);
            const unsigned tg = og / nx;
            if (og + 1u == (tg + 1u) * nx) xb_add(&bar[XB_TOPGEN], 1u);
            else XB_SPIN(xb_ld(&bar[XB_TOPGEN]) == tg, bar);
            __builtin_amdgcn_fence(__ATOMIC_ACQUIRE, "agent");
            xb_add(&bar[XB_XGEN(b.x)], 1u);
            asm volatile("s_waitcnt vmcnt(0)" ::: "memory");
        } else {
            XB_SPIN(xb_ld(&bar[XB_XGEN(b.x)]) == gen, bar);
            __builtin_amdgcn_fence(__ATOMIC_ACQUIRE, "agent");
            asm volatile("s_waitcnt vmcnt(0)" ::: "memory");
        }
    }
    __syncthreads();
}

namespace fk {
#define GAS __attribute__((address_space(1)))
typedef unsigned u32x4 __attribute__((ext_vector_type(4)));
typedef unsigned u32x2 __attribute__((ext_vector_type(2)));
typedef float f32x4 __attribute__((ext_vector_type(4)));
typedef float f32x2 __attribute__((ext_vector_type(2)));
typedef __bf16 bf2 __attribute__((ext_vector_type(2)));
typedef unsigned short bf16_t;
__device__ __forceinline__ float bflo(unsigned u) { return __uint_as_float(u << 16); }
__device__ __forceinline__ float bfhi(unsigned u) { return __uint_as_float(u & 0xffff0000u); }
__device__ __forceinline__ float dot2(unsigned a, unsigned b, float c) { return __builtin_amdgcn_fdot2_f32_bf16(__builtin_bit_cast(bf2, a), __builtin_bit_cast(bf2, b), c, false); }
__device__ __forceinline__ unsigned pk_bf16(float lo, float hi) { unsigned r; asm volatile("v_cvt_pk_bf16_f32 %0, %1, %2" : "=v"(r) : "v"(lo), "v"(hi)); return r; }
template <int CTRL> __device__ __forceinline__ float dppf(float v) { return __int_as_float(__builtin_amdgcn_update_dpp(0, __float_as_int(v), CTRL, 0xf, 0xf, true)); }
__device__ __forceinline__ float row_max16(float v) { v = fmaxf(v, dppf<0xB1>(v)); v = fmaxf(v, dppf<0x4E>(v)); v = fmaxf(v, dppf<0x141>(v)); v = fmaxf(v, dppf<0x140>(v)); return v; }
__device__ __forceinline__ float frcp(float x) { return __builtin_amdgcn_rcpf(x); }
__device__ __forceinline__ float fsqrt(float x) { return __builtin_amdgcn_sqrtf(x); }
__device__ __forceinline__ float row_sum8(float v) { v += dppf<0xB1>(v); v += dppf<0x4E>(v); v += dppf<0x141>(v); return v; }
__device__ __forceinline__ float row_sum16(float v) { v += dppf<0xB1>(v); v += dppf<0x4E>(v); v += dppf<0x141>(v); v += dppf<0x140>(v); return v; }
__device__ __forceinline__ float shx(float v, int m, int lane) { return __int_as_float(__builtin_amdgcn_ds_bpermute((lane ^ m) << 2, __float_as_int(v))); }
__device__ __forceinline__ float wave_sum(float v, int lane) { v = row_sum16(v); v += shx(v, 16, lane); v += shx(v, 32, lane); return v; }
__device__ __forceinline__ float gelu_tanh(float x) { return 0.5f * x * (1.f + tanhf(0.7978845608028654f * (x + 0.044715f * x * x * x))); }
#define FK_NEG (-3.0e38f)

template <int CTRL> __device__ __forceinline__ int dppi(int v) { return __builtin_amdgcn_update_dpp(0, v, CTRL, 0xf, 0xf, true); }
__device__ __forceinline__ int row_min16i(int v) { v = min(v, dppi<0xB1>(v)); v = min(v, dppi<0x4E>(v)); v = min(v, dppi<0x141>(v)); v = min(v, dppi<0x140>(v)); return v; }
#define FK_CE(a, b) do { const bool sw_ = v[b] > v[a]; const float tv_ = sw_ ? v[b] : v[a]; v[b] = sw_ ? v[a] : v[b]; v[a] = tv_; const int ti_ = sw_ ? id[b] : id[a]; id[b] = sw_ ? id[a] : id[b]; id[a] = ti_; } while (0)
#define FK_SORT8(v, id) do { FK_CE2(v, id, 0, 1); FK_CE2(v, id, 2, 3); FK_CE2(v, id, 4, 5); FK_CE2(v, id, 6, 7); FK_CE2(v, id, 0, 2); FK_CE2(v, id, 1, 3); FK_CE2(v, id, 4, 6); FK_CE2(v, id, 5, 7); FK_CE2(v, id, 1, 2); FK_CE2(v, id, 5, 6); \
    FK_CE2(v, id, 0, 4); FK_CE2(v, id, 1, 5); FK_CE2(v, id, 2, 6); FK_CE2(v, id, 3, 7); FK_CE2(v, id, 2, 4); FK_CE2(v, id, 3, 5); FK_CE2(v, id, 1, 2); FK_CE2(v, id, 3, 4); FK_CE2(v, id, 5, 6); } while (0)
#define FK_CE2(v, id, a, b) do { const bool sw_ = v[b] > v[a]; const float tv_ = sw_ ? v[b] : v[a]; v[b] = sw_ ? v[a] : v[b]; v[a] = tv_; const int ti_ = sw_ ? id[b] : id[a]; id[b] = sw_ ? id[a] : id[b]; id[a] = ti_; } while (0)
__device__ __forceinline__ void top16_of_128_x2(float (&v)[8], int (&id)[8], float (&u)[8], int (&jd)[8], int lane16, float& rv1, int& ri1, float& rv2, int& ri2) {
    FK_SORT8(v, id); FK_SORT8(u, jd);
    rv1 = FK_NEG; ri1 = 0; rv2 = FK_NEG; ri2 = 0;
#pragma unroll
    for (int r = 0; r < 16; ++r) {
        const float wm = row_max16(v[0]), xm = row_max16(u[0]);
        const int cand = (v[0] == wm) ? id[0] : 0x7fffffff, dand = (u[0] == xm) ? jd[0] : 0x7fffffff;
        const int sel = row_min16i(cand), tel = row_min16i(dand);
        const bool mine = (cand == sel), nine = (dand == tel);
        if (lane16 == r) { rv1 = wm; ri1 = sel; rv2 = xm; ri2 = tel; }
#pragma unroll
        for (int i = 0; i < 7; ++i) { v[i] = mine ? v[i + 1] : v[i]; id[i] = mine ? id[i + 1] : id[i]; u[i] = nine ? u[i + 1] : u[i]; jd[i] = nine ? jd[i + 1] : jd[i]; }
        v[7] = mine ? FK_NEG : v[7]; u[7] = nine ? FK_NEG : u[7];
    }
}
__device__ __forceinline__ int fk_key(float x, int lane16) { int k = __float_as_int(x); k ^= (k >> 31) & 0x7fffffff; return (k & ~15) | (15 - lane16); }
__device__ __forceinline__ float fk_unkey(int k) { k &= ~15; k ^= (k >> 31) & 0x7fffffff; return __int_as_float(k); }
__device__ __forceinline__ int row_max16i(int v) { v = max(v, dppi<0xB1>(v)); v = max(v, dppi<0x4E>(v)); v = max(v, dppi<0x141>(v)); v = max(v, dppi<0x140>(v)); return v; }
__device__ __forceinline__ void topk_phase(const GAS bf16_t* __restrict__ SC, const GAS bf16_t* __restrict__ Q, const GAS float* __restrict__ KSUM, GAS float* __restrict__ GATE, GAS int* __restrict__ EIDX, int nitems,
                                           LAS unsigned char* lds, int wid, int lane, int wave_gid, int nwaves) {
    LAS float* xv = (LAS float*)(lds + wid * 256);
    const int lane16 = lane & 15, rowbase = lane & 48;
    u32x4 nqa, nqb, nsw, ntw;
#define TK_LOAD(wi_) do { int it_ = (wi_) * 4 + (lane >> 4); it_ = it_ < nitems ? it_ : nitems - 1; const GAS u32x4* qp_ = (const GAS u32x4*)(Q + (size_t)it_ * 256 + 16 * lane16); nqa = qp_[0]; nqb = qp_[1]; \
        const GAS bf16_t* sp_ = SC + (size_t)it_ * 256 + 8 * lane16; nsw = *(const GAS u32x4*)sp_; ntw = *(const GAS u32x4*)(sp_ + 128); } while (0)
    TK_LOAD(wave_gid);
    const GAS float* kp = KSUM + ((wave_gid * 4 + (lane >> 4)) & 7) * 256 + 8 * lane16; const f32x4 k0 = *(const GAS f32x4*)kp, k1 = *(const GAS f32x4*)(kp + 4), m0 = *(const GAS f32x4*)(kp + 128), m1 = *(const GAS f32x4*)(kp + 132);
    for (int wi = wave_gid; wi * 4 < nitems; wi += nwaves) {
        const int it = wi * 4 + (lane >> 4);
        const u32x4 qa = nqa, qb = nqb; const f32x4 s0 = (f32x4){bflo(nsw[0]), bfhi(nsw[0]), bflo(nsw[1]), bfhi(nsw[1])}, s1 = (f32x4){bflo(nsw[2]), bfhi(nsw[2]), bflo(nsw[3]), bfhi(nsw[3])},
                    t0 = (f32x4){bflo(ntw[0]), bfhi(ntw[0]), bflo(ntw[1]), bfhi(ntw[1])}, t1 = (f32x4){bflo(ntw[2]), bfhi(ntw[2]), bflo(ntw[3]), bfhi(ntw[3])};
        TK_LOAD(wi + nwaves);
        float qs = 0.f, qq = 0.f;
#pragma unroll
        for (int i = 0; i < 4; ++i) { const float a = bflo(qa[i]), b = bfhi(qa[i]), c = bflo(qb[i]), d = bfhi(qb[i]); qs += (a + b) + (c + d); qq += (a * a + b * b) + (c * c + d * d); }
        const float mu = row_sum16(qs) * (1.f / 256.f); const float var = fmaxf(row_sum16(qq) * (1.f / 256.f) - mu * mu, 0.f); const float rs = 1.f / sqrtf(var + 1e-5f);
        int ka[8], kb[8];
#define TK_KEY(x_, id_) ({ int k_ = __float_as_int(x_); k_ ^= (k_ >> 31) & 0x7fffffff; (k_ & ~127) | (127 - (id_)); })
#define TK_VAL(k_) ({ int q_ = (k_) & ~127; q_ ^= (q_ >> 31) & 0x7fffffff; __int_as_float(q_); })
#pragma unroll
        for (int i = 0; i < 4; ++i) { ka[i] = TK_KEY(rs * (s0[i] - mu * k0[i]), 8 * lane16 + i); ka[4 + i] = TK_KEY(rs * (s1[i] - mu * k1[i]), 8 * lane16 + 4 + i);
            kb[i] = TK_KEY(rs * (t0[i] - mu * m0[i]), 8 * lane16 + i); kb[4 + i] = TK_KEY(rs * (t1[i] - mu * m1[i]), 8 * lane16 + 4 + i); }
#define TK_CE(k_, a_, b_) do { const int hi_ = max(k_[a_], k_[b_]), lo_ = min(k_[a_], k_[b_]); k_[a_] = hi_; k_[b_] = lo_; } while (0)
#define TK_SORT8(k_) do { TK_CE(k_, 0, 1); TK_CE(k_, 2, 3); TK_CE(k_, 4, 5); TK_CE(k_, 6, 7); TK_CE(k_, 0, 2); TK_CE(k_, 1, 3); TK_CE(k_, 4, 6); TK_CE(k_, 5, 7); TK_CE(k_, 1, 2); TK_CE(k_, 5, 6); \
        TK_CE(k_, 0, 4); TK_CE(k_, 1, 5); TK_CE(k_, 2, 6); TK_CE(k_, 3, 7); TK_CE(k_, 2, 4); TK_CE(k_, 3, 5); TK_CE(k_, 1, 2); TK_CE(k_, 3, 4); TK_CE(k_, 5, 6); } while (0)
        TK_SORT8(ka); TK_SORT8(kb);
        constexpr int KMIN = (int)0x80000000;
        int r1 = KMIN, r2 = KMIN;
#pragma unroll
        for (int r = 0; r < 16; ++r) {
            const int wm1 = row_max16i(ka[0]), wm2 = row_max16i(kb[0]); const bool mine = (ka[0] == wm1), nine = (kb[0] == wm2);
            if (lane16 == r) { r1 = wm1; r2 = wm2; }
#pragma unroll
            for (int i = 0; i < 7; ++i) { ka[i] = mine ? ka[i + 1] : ka[i]; kb[i] = nine ? kb[i + 1] : kb[i]; }
            ka[7] = mine ? KMIN : ka[7]; kb[7] = nine ? KMIN : kb[7];
        }
        const float rv1 = TK_VAL(r1), rv2 = TK_VAL(r2);
        xv[lane] = rv2;
        int kc[16];
        { const LAS f32x4* xp = (const LAS f32x4*)(xv + rowbase);
#pragma unroll
          for (int q = 0; q < 4; ++q) { const f32x4 tq = xp[q];
#pragma unroll
              for (int j = 0; j < 4; ++j) { int k_ = __float_as_int(rv1 + tq[j]); k_ ^= (k_ >> 31) & 0x7fffffff; kc[4 * q + j] = (k_ & ~255) | (255 - (16 * lane16 + 4 * q + j)); } } }
        int rk = KMIN;
#pragma unroll
        for (int r = 0; r < 16; ++r) {
            const int wm = row_max16i(kc[0]); const bool mine = (kc[0] == wm);
            if (lane16 == r) rk = wm;
#pragma unroll
            for (int i = 0; i < 15; ++i) kc[i] = mine ? kc[i + 1] : kc[i];
            kc[15] = mine ? KMIN : kc[15];
        }
        const int pid = 255 - (rk & 255), i1 = pid >> 4, j2 = pid & 15;
        const int g1 = __builtin_amdgcn_ds_bpermute((rowbase + i1) << 2, r1), g2 = __builtin_amdgcn_ds_bpermute((rowbase + j2) << 2, r2);
        const int e1 = 127 - (g1 & 127), e2 = 127 - (g2 & 127);
        float sc; { int q_ = rk & ~255; q_ ^= (q_ >> 31) & 0x7fffffff; sc = __int_as_float(q_); }
        const float mx = TK_VAL(row_max16i(TK_KEY(sc, 0))); const float ex = __expf(sc - mx); const float den = row_sum16(ex);
        GATE[(size_t)it * 16 + lane16] = ex / den; EIDX[(size_t)it * 16 + lane16] = e1 * 128 + e2;
#undef TK_KEY
#undef TK_VAL
#undef TK_CE
#undef TK_SORT8
    }
#undef TK_LOAD
}

__device__ __forceinline__ f32x2 fp8lo(unsigned w) { return __builtin_amdgcn_cvt_pk_f32_fp8((int)w, false); }
__device__ __forceinline__ f32x2 fp8hi(unsigned w) { return __builtin_amdgcn_cvt_pk_f32_fp8((int)w, true); }
__device__ __forceinline__ void act_phase(const GAS bf16_t* __restrict__ XB, const GAS unsigned char* __restrict__ U8, const GAS float* __restrict__ GATE, const GAS int* __restrict__ EIDX, GAS float* __restrict__ COEF, int nitems,
                                          int lane, int wave_gid, int nwaves) {
    int it = wave_gid; if (it >= nitems) return;
    u32x4 uc[16], un[16], xac, xbc, xan, xbn;
    int evc = EIDX[(size_t)it * 16 + (lane & 15)];
    { const GAS u32x4* xp = (const GAS u32x4*)(XB + (size_t)(it >> 3) * 1024 + 16 * lane); xac = xp[0]; xbc = xp[1]; }
#pragma unroll
    for (int k = 0; k < 16; ++k) uc[k] = *(const GAS u32x4*)(U8 + (size_t)__builtin_amdgcn_readlane(evc, k) * 1024 + 16 * lane);
    int itn = it + nwaves; int evn = (itn < nitems) ? EIDX[(size_t)itn * 16 + (lane & 15)] : 0;
    for (;;) {
        const bool hasn = itn < nitems;
        if (hasn) {
            const GAS u32x4* xp = (const GAS u32x4*)(XB + (size_t)(itn >> 3) * 1024 + 16 * lane); xan = xp[0]; xbn = xp[1];
#pragma unroll
            for (int k = 0; k < 16; ++k) un[k] = *(const GAS u32x4*)(U8 + (size_t)__builtin_amdgcn_readlane(evn, k) * 1024 + 16 * lane);
        }
        const int itnn = itn + nwaves; const int evnn = (itnn < nitems) ? EIDX[(size_t)itnn * 16 + (lane & 15)] : 0;
        const float gt = GATE[(size_t)it * 16 + (lane >> 2)];
        float x[16];
#pragma unroll
        for (int i = 0; i < 4; ++i) { x[2 * i] = bflo(xac[i]); x[2 * i + 1] = bfhi(xac[i]); x[8 + 2 * i] = bflo(xbc[i]); x[8 + 2 * i + 1] = bfhi(xbc[i]); }
        float a[16];
#pragma unroll
        for (int k = 0; k < 16; ++k) { const u32x4 uw = uc[k]; float s = 0.f;
#pragma unroll
            for (int d = 0; d < 4; ++d) { const f32x2 lo = fp8lo(uw[d]), hi = fp8hi(uw[d]); s = fmaf(lo.x, x[4 * d], s); s = fmaf(lo.y, x[4 * d + 1], s); s = fmaf(hi.x, x[4 * d + 2], s); s = fmaf(hi.y, x[4 * d + 3], s); }
            asm volatile("" : "+v"(s)); a[k] = s; }
#pragma unroll
        for (int k = 0; k < 8; ++k) { const bool hi = lane & 32; const float send = hi ? a[k] : a[k + 8], keep = hi ? a[k + 8] : a[k]; a[k] = keep + shx(send, 32, lane); }
#pragma unroll
        for (int k = 0; k < 4; ++k) { const bool hi = lane & 16; const float send = hi ? a[k] : a[k + 4], keep = hi ? a[k + 4] : a[k]; a[k] = keep + shx(send, 16, lane); }
#pragma unroll
        for (int k = 0; k < 2; ++k) { const bool hi = lane & 8; const float send = hi ? a[k] : a[k + 2], keep = hi ? a[k + 2] : a[k]; a[k] = keep + shx(send, 8, lane); }
        { const bool hi = lane & 4; const float send = hi ? a[0] : a[1], keep = hi ? a[1] : a[0]; a[0] = keep + shx(send, 4, lane); }
        float dsum = a[0]; dsum += shx(dsum, 2, lane); dsum += shx(dsum, 1, lane);
        if ((lane & 3) == 0) COEF[(size_t)it * 16 + (lane >> 2)] = gt * gelu_tanh(dsum * (1.f / 128.f));
        if (!hasn) break;
#pragma unroll
        for (int k = 0; k < 16; ++k) uc[k] = un[k];
        xac = xan; xbc = xbn; evc = evn; evn = evnn; it = itn; itn = itnn;
    }
}

__device__ __forceinline__ void outln_phase(const GAS float* COEF, const GAS int* EIDX, const GAS unsigned char* V8,     const GAS float* __restrict__ lg, const GAS float* __restrict__ lb, GAS float* X, GAS bf16_t* XB, int nrows,
                                            int lane, int wave_gid, int nwaves) {
    const float alpha = 1.6817928305074292f;
    int row = wave_gid; if (row >= nrows) return;
    u32x4 vc[16], vn[16];
    float cf0 = COEF[(size_t)row * 128 + lane] * (1.f / 64.f), cf1 = COEF[(size_t)row * 128 + 64 + lane] * (1.f / 64.f); int ev0 = EIDX[(size_t)row * 128 + lane], ev1 = EIDX[(size_t)row * 128 + 64 + lane];
#define OUT_LOADCH(dst, evreg, base) do { _Pragma("unroll") for (int k_ = 0; k_ < 16; ++k_) dst[k_] = *(const GAS u32x4*)(V8 + (size_t)__builtin_amdgcn_readlane(evreg, (base) + k_) * 1024 + 16 * lane); } while (0)
#define OUT_COMPCH(src, cfreg, base) do { _Pragma("unroll") for (int k_ = 0; k_ < 16; ++k_) { const float c_ = __int_as_float(__builtin_amdgcn_readlane(__float_as_int(cfreg), (base) + k_)); const u32x4 vw_ = src[k_]; \
        _Pragma("unroll") for (int d_ = 0; d_ < 4; ++d_) { const f32x2 lo_ = fp8lo(vw_[d_]), hi_ = fp8hi(vw_[d_]); acc[4 * d_] = fmaf(c_, lo_.x, acc[4 * d_]); acc[4 * d_ + 1] = fmaf(c_, lo_.y, acc[4 * d_ + 1]); acc[4 * d_ + 2] = fmaf(c_, hi_.x, acc[4 * d_ + 2]); acc[4 * d_ + 3] = fmaf(c_, hi_.y, acc[4 * d_ + 3]); } \
        _Pragma("unroll") for (int p_ = 0; p_ < 16; ++p_) asm volatile("" : "+v"(acc[p_]));     \
        } } while (0)
    for (;;) {
        OUT_LOADCH(vc, ev0, 0);
        const int rown = row + nwaves; const bool hasn = rown < nrows;
        float ncf0 = 0.f, ncf1 = 0.f; int nev0 = 0, nev1 = 0;
        if (hasn) { ncf0 = COEF[(size_t)rown * 128 + lane] * (1.f / 64.f); ncf1 = COEF[(size_t)rown * 128 + 64 + lane] * (1.f / 64.f); nev0 = EIDX[(size_t)rown * 128 + lane]; nev1 = EIDX[(size_t)rown * 128 + 64 + lane]; }
        float acc[16];
#pragma unroll
        for (int k = 0; k < 16; ++k) acc[k] = 0.f;
#define OUT_FENCE() asm volatile("" ::: "memory")
        OUT_LOADCH(vn, ev0, 16); OUT_FENCE(); OUT_COMPCH(vc, cf0, 0); OUT_FENCE();
        OUT_LOADCH(vc, ev0, 32); OUT_FENCE(); OUT_COMPCH(vn, cf0, 16); OUT_FENCE();
        OUT_LOADCH(vn, ev0, 48); OUT_FENCE(); OUT_COMPCH(vc, cf0, 32); OUT_FENCE();
        OUT_LOADCH(vc, ev1, 0);  OUT_FENCE(); OUT_COMPCH(vn, cf0, 48); OUT_FENCE();
        OUT_LOADCH(vn, ev1, 16); OUT_FENCE(); OUT_COMPCH(vc, cf1, 0); OUT_FENCE();
        OUT_LOADCH(vc, ev1, 32); OUT_FENCE(); OUT_COMPCH(vn, cf1, 16); OUT_FENCE();
        OUT_LOADCH(vn, ev1, 48); OUT_FENCE(); OUT_COMPCH(vc, cf1, 32); OUT_FENCE();
        OUT_COMPCH(vn, cf1, 48); OUT_FENCE();
#undef OUT_FENCE
        GAS float* xr = X + (size_t)row * 1024 + 16 * lane; float t[16];
#pragma unroll
        for (int q = 0; q < 4; ++q) { const f32x4 xv = *(const GAS f32x4*)(xr + 4 * q); t[4 * q] = fmaf(alpha, xv.x, acc[4 * q]); t[4 * q + 1] = fmaf(alpha, xv.y, acc[4 * q + 1]); t[4 * q + 2] = fmaf(alpha, xv.z, acc[4 * q + 2]); t[4 * q + 3] = fmaf(alpha, xv.w, acc[4 * q + 3]); }
        float s = 0.f;
#pragma unroll
        for (int k = 0; k < 16; ++k) s += t[k];
        const float mu = wave_sum(s, lane) * (1.f / 1024.f); float vs = 0.f;
#pragma unroll
        for (int k = 0; k < 16; ++k) { t[k] -= mu; vs = fmaf(t[k], t[k], vs); }
        const float rs = 1.f / sqrtf(wave_sum(vs, lane) * (1.f / 1024.f) + 1e-5f);
        unsigned w[8];
#pragma unroll
        for (int q = 0; q < 4; ++q) { const f32x4 g = *(const GAS f32x4*)(lg + 16 * lane + 4 * q), b = *(const GAS f32x4*)(lb + 16 * lane + 4 * q); f32x4 o;
            o.x = t[4 * q] * rs * g.x + b.x; o.y = t[4 * q + 1] * rs * g.y + b.y; o.z = t[4 * q + 2] * rs * g.z + b.z; o.w = t[4 * q + 3] * rs * g.w + b.w;
            *(GAS f32x4*)(xr + 4 * q) = o; w[2 * q] = pk_bf16(o.x, o.y); w[2 * q + 1] = pk_bf16(o.z, o.w); }
        u32x4 w0, w1; w0.x = w[0]; w0.y = w[1]; w0.z = w[2]; w0.w = w[3]; w1.x = w[4]; w1.y = w[5]; w1.z = w[6]; w1.w = w[7];
        GAS u32x4* xbp = (GAS u32x4*)(XB + (size_t)row * 1024 + 16 * lane); xbp[0] = w0; xbp[1] = w1;
        if (!hasn) break;
        row = rown; cf0 = ncf0; cf1 = ncf1; ev0 = nev0; ev1 = nev1;
    }
#undef OUT_LOADCH
#undef OUT_COMPCH
}

__device__ __forceinline__ void lnres_phase(const GAS bf16_t* __restrict__ Y, const GAS float* __restrict__ lg, const GAS float* __restrict__ lb, GAS float* X, GAS bf16_t* XB, GAS unsigned char* XF8, int nrows, int lane, int wave_gid, int nwaves) {
    const float alpha = 1.6817928305074292f; (void)X;
    for (int row = wave_gid; row < nrows; row += nwaves) {
        GAS bf16_t* xr = XB + (size_t)row * 1024; const GAS bf16_t* yr = Y + (size_t)row * 1024; float t[16];
#pragma unroll
        for (int q = 0; q < 4; ++q) { const u32x2 xw = *(const GAS u32x2*)(xr + 256 * q + 4 * lane); const u32x2 yw = *(const GAS u32x2*)(yr + 256 * q + 4 * lane);
            t[4 * q] = fmaf(alpha, bflo(xw.x), bflo(yw.x)); t[4 * q + 1] = fmaf(alpha, bfhi(xw.x), bfhi(yw.x)); t[4 * q + 2] = fmaf(alpha, bflo(xw.y), bflo(yw.y)); t[4 * q + 3] = fmaf(alpha, bfhi(xw.y), bfhi(yw.y)); }
        float s = 0.f;
#pragma unroll
        for (int k = 0; k < 16; ++k) s += t[k];
        const float mu = wave_sum(s, lane) * (1.f / 1024.f); float vs = 0.f;
#pragma unroll
        for (int k = 0; k < 16; ++k) { t[k] -= mu; vs = fmaf(t[k], t[k], vs); }
        const float rs = 1.f / sqrtf(wave_sum(vs, lane) * (1.f / 1024.f) + 1e-5f);
#pragma unroll
        for (int q = 0; q < 4; ++q) { const int c = 256 * q + 4 * lane; const f32x4 g = *(const GAS f32x4*)(lg + c), b = *(const GAS f32x4*)(lb + c); f32x4 o;
            o.x = t[4 * q] * rs * g.x + b.x; o.y = t[4 * q + 1] * rs * g.y + b.y; o.z = t[4 * q + 2] * rs * g.z + b.z; o.w = t[4 * q + 3] * rs * g.w + b.w;
            u32x2 w; w.x = pk_bf16(o.x, o.y); w.y = pk_bf16(o.z, o.w); *(GAS u32x2*)(xr + c) = w;
            if (XF8) {
                const float s0 = __builtin_amdgcn_fmed3f(o.x * 16.f, -448.f, 448.f), s1 = __builtin_amdgcn_fmed3f(o.y * 16.f, -448.f, 448.f), s2 = __builtin_amdgcn_fmed3f(o.z * 16.f, -448.f, 448.f), s3 = __builtin_amdgcn_fmed3f(o.w * 16.f, -448.f, 448.f);
                int hp = __builtin_amdgcn_cvt_pk_fp8_f32(s0, s1, 0, false); hp = __builtin_amdgcn_cvt_pk_fp8_f32(s2, s3, hp, true);
                const f32x2 d01 = fp8lo((unsigned)hp), d23 = fp8hi((unsigned)hp);
                int lp = __builtin_amdgcn_cvt_pk_fp8_f32(s0 - d01.x, s1 - d01.y, 0, false); lp = __builtin_amdgcn_cvt_pk_fp8_f32(s2 - d23.x, s3 - d23.y, lp, true);
                *(GAS int*)(XF8 + (size_t)row * 2048 + c) = hp; *(GAS int*)(XF8 + (size_t)row * 2048 + 1024 + c) = lp; } }
    }
}

__device__ __forceinline__ void glanorm_phase(const GAS float* __restrict__ O, const GAS float* __restrict__ PROJ, const GAS float* __restrict__ gnorm, GAS bf16_t* XB, int nitems, int lane, int wave_gid, int nwaves) {
    const float g0 = gnorm[lane], g1 = gnorm[64 + lane];
    for (int it0 = wave_gid * 8; it0 < nitems; it0 += nwaves * 8) {
        float a0[8], a1[8], r0[8], r1[8];
#pragma unroll
        for (int q = 0; q < 8; ++q) { int it = it0 + q; it = it < nitems ? it : it0; const int row = it >> 2, h = it & 3; const GAS float* o = O + (size_t)row * 512 + h * 128; const GAS float* r = PROJ + (size_t)row * 2576 + 1040 + h * 128;
            a0[q] = o[lane]; a1[q] = o[64 + lane]; r0[q] = r[lane]; r1[q] = r[64 + lane]; }
#pragma unroll
        for (int q = 0; q < 8; ++q) { const int it = it0 + q; const int row = it >> 2, h = it & 3;
            const float rs = 1.f / sqrtf(wave_sum(a0[q] * a0[q] + a1[q] * a1[q], lane) * (1.f / 128.f) + 1e-5f);
            const float y0 = a0[q] * rs * g0 * (r0[q] * frcp(1.f + __expf(-r0[q]))), y1 = a1[q] * rs * g1 * (r1[q] * frcp(1.f + __expf(-r1[q])));
            if (it < nitems) { GAS bf16_t* d = XB + (size_t)row * 1024 + h * 128; d[lane] = (bf16_t)(pk_bf16(y0, 0.f) & 0xffffu); d[64 + lane] = (bf16_t)(pk_bf16(y1, 0.f) & 0xffffu); } }
    }
}

__device__ __forceinline__ float sigm(float x) { return frcp(1.f + __expf(-x)); }
__device__ __forceinline__ float softplusf(float x) { return fmaxf(x, 0.f) + log1pf(__expf(-fabsf(x))); }
__device__ __forceinline__ void rwkvprep_phase(const GAS float* __restrict__ w0, const GAS float* __restrict__ a0, const GAS float* __restrict__ v0, const GAS float* __restrict__ k_k, const GAS float* __restrict__ k_a, const GAS float* __restrict__ Vg,
                                               GAS float* K, GAS float* Wd, GAS float* Aa, GAS float* V, GAS float* NKK, GAS float* VFIRST, int has_vres, int nitems, int lane, int wave_gid, int nwaves) {
    for (int it0 = wave_gid * 4; it0 < nitems; it0 += nwaves * 4) {
        float kq[4], wq[4], aq[4], vq[4], gq[4], fq[4];
#pragma unroll
        for (int q = 0; q < 4; ++q) { const int it = it0 + q; const size_t ix = (size_t)(it >> 4) * 1024 + (it & 15) * 64 + lane; kq[q] = K[ix]; wq[q] = Wd[ix]; aq[q] = Aa[ix]; vq[q] = V[ix]; gq[q] = has_vres ? Vg[ix] : 0.f; fq[q] = has_vres ? VFIRST[ix] : 0.f; }
#pragma unroll
        for (int q = 0; q < 4; ++q) { const int it = it0 + q; const int h = it & 15; const size_t ix = (size_t)(it >> 4) * 1024 + h * 64 + lane; const int c = h * 64 + lane;
            const float k0 = kq[q]; const float kv = k0 * k_k[c]; const float inv = 1.f / fmaxf(sqrtf(wave_sum(kv * kv, lane)), 1e-12f);
            const float w = -softplusf(-(w0[c] + wq[q])) - 0.5f; const float dec = __expf(-__expf(w));
            const float a = sigm(a0[c] + aq[q]);
            float v = vq[q]; if (has_vres) v = v + (fq[q] - v) * sigm(v0[c] + gq[q]); else VFIRST[ix] = v;
            const float kk = kv * inv;
            NKK[ix] = -kk; K[ix] = k0 * (1.f + (a - 1.f) * k_a[c]); Wd[ix] = dec; Aa[ix] = kk * a; V[ix] = v; }
    }
}

__device__ __forceinline__ void rwkvpost_phase(const GAS float* __restrict__ Y, const GAS float* __restrict__ R, const GAS float* __restrict__ K2, const GAS float* __restrict__ V, const GAS float* __restrict__ G, const GAS float* __restrict__ r_k,
                                               const GAS float* __restrict__ lnx_g, const GAS float* __restrict__ lnx_b, GAS bf16_t* XB, int nitems, int lane, int wave_gid, int nwaves) {
    for (int it0 = wave_gid * 4; it0 < nitems; it0 += nwaves * 4) {
        float yq[4], rq[4], kq[4], vq[4], gq[4];
#pragma unroll
        for (int q = 0; q < 4; ++q) { const int it = it0 + q; const size_t ix = (size_t)(it >> 4) * 1024 + (it & 15) * 64 + lane; yq[q] = Y[ix]; rq[q] = R[ix]; kq[q] = K2[ix]; vq[q] = V[ix]; gq[q] = G[ix]; }
#pragma unroll
        for (int q = 0; q < 4; ++q) { const int it = it0 + q; const int h = it & 15; const size_t ix = (size_t)(it >> 4) * 1024 + h * 64 + lane; const int c = h * 64 + lane;
            const float y = yq[q]; const float mu = wave_sum(y, lane) * (1.f / 64.f); const float d = y - mu; const float rs = 1.f / sqrtf(wave_sum(d * d, lane) * (1.f / 64.f) + 64e-5f);
            const float bon = wave_sum(rq[q] * kq[q] * r_k[c], lane);
            const float o = (d * rs * lnx_g[c] + lnx_b[c] + bon * vq[q]) * gq[q];
            XB[ix] = (bf16_t)(pk_bf16(o, 0.f) & 0xffffu); }
    }
}

__device__ __forceinline__ void wkv_phase(const GAS float* __restrict__ R, const GAS float* __restrict__ Wd, const GAS float* __restrict__ K2, const GAS float* __restrict__ V, const GAS float* __restrict__ BB, const GAS float* __restrict__ NKK,
                                          const GAS float* __restrict__ SIN, GAS float* __restrict__ Y, GAS float* __restrict__ P, GAS float* __restrict__ SOUT, int B, int T, int DB, int DT, LAS unsigned char* lds, int tid, int bid, int nb) {
    constexpr int TB = 32, NLD = 6, VECB = TB * 1280, VVB = TB * 128, BUF = VECB + 2 * VVB;
    const int rowl = tid >> 4, part = tid & 15;
    const int nprompt = B * 32, nunits = nprompt + DB * 32;
    for (int u = bid; u < nunits; u += nb) {
        const bool smp = u >= nprompt; const int q0_ = smp ? u - nprompt : u; const int q = ((q0_ & 7) << 1 | ((q0_ >> 3) & 1)) + ((q0_ >> 4) << 4);
        const int half = q & 1, pair = q >> 1, sq = pair >> 4, h = pair & 15;
        const int Tu = smp ? DT : T; const int r0 = smp ? B * T + sq * DT : sq * T, vrow = half * 32 + rowl;
        f32x2 S01 = (f32x2){0.f, 0.f}, S23 = (f32x2){0.f, 0.f};
        if (smp) { const f32x4 s4 = *(const GAS f32x4*)(SIN + ((size_t)pair * 64 + vrow) * 64 + part * 4); S01 = (f32x2){s4.x, s4.y}; S23 = (f32x2){s4.z, s4.w};
                   asm volatile("" : "+v"(S01), "+v"(S23)); }
        const int nblk = (Tu + TB - 1) / TB;
        f32x4 ld[NLD];
        const size_t eo_ = (size_t)(r0 + (tid >> 4)) * 1024 + h * 64 + (tid & 15) * 4, ev_ = (size_t)(r0 + ((tid & 255) >> 3)) * 1024 + h * 64 + half * 32 + (tid & 7) * 4;
        const int lo_ = ((tid >> 4) * 320 + (tid & 15) * 4) * 4, lv_ = VECB + (tid & 255) * 16;
#define WKV_LOAD(tb0) do { const size_t bo_ = (size_t)(tb0) * 1024; ld[0] = *(const GAS f32x4*)(Wd + eo_ + bo_); ld[1] = *(const GAS f32x4*)(NKK + eo_ + bo_); ld[2] = *(const GAS f32x4*)(BB + eo_ + bo_); \
            ld[3] = *(const GAS f32x4*)(K2 + eo_ + bo_); ld[4] = *(const GAS f32x4*)(R + eo_ + bo_); ld[5] = *(const GAS f32x4*)(V + ev_ + bo_); } while (0)
#define WKV_STORE(bufp) do { _Pragma("unroll") for (int q_ = 0; q_ < 5; ++q_) *(LAS f32x4*)((bufp) + lo_ + q_ * 256) = ld[q_]; *(LAS f32x4*)((bufp) + lv_) = ld[5]; } while (0)
        WKV_LOAD(0); WKV_STORE(lds); __syncthreads();
        for (int b = 0; b < nblk; ++b) {
            LAS unsigned char* cur = lds + (b & 1) * BUF; LAS unsigned char* nxt = lds + ((b + 1) & 1) * BUF; const int tb0 = b * TB; const int nt = (Tu - tb0) < TB ? (Tu - tb0) : TB;
            if (b + 1 < nblk) WKV_LOAD(tb0 + TB);
            const LAS float* vec = (const LAS float*)cur + part * 4; const LAS float* vv = (const LAS float*)(cur + VECB) + rowl; LAS float* yb = (LAS float*)(cur + VECB + VVB);
            float ykeep0 = 0.f, ykeep1 = 0.f;
#define WKV_STEP(t, keep, tl) do { const LAS f32x2* vp_ = (const LAS f32x2*)(vec + (t) * 320); \
                const f32x2 w01 = vp_[0], w23 = vp_[1], n01 = vp_[32], n23 = vp_[33], b01 = vp_[64], b23 = vp_[65], k01 = vp_[96], k23 = vp_[97], r01 = vp_[128], r23 = vp_[129]; \
                const float v = vv[(t) * 32]; \
                const f32x2 sp = __builtin_elementwise_fma(S23, n23, S01 * n01); const float sa = row_sum16(sp.x + sp.y); const f32x2 sa2 = (f32x2){sa, sa}, v2 = (f32x2){v, v}; \
                S01 = __builtin_elementwise_fma(S01, w01, __builtin_elementwise_fma(b01, sa2, k01 * v2)); S23 = __builtin_elementwise_fma(S23, w23, __builtin_elementwise_fma(b23, sa2, k23 * v2)); \
                const f32x2 yp = __builtin_elementwise_fma(S23, r23, S01 * r01); const float y = row_sum16(yp.x + yp.y); \
                keep = (part == (tl)) ? y : keep; } while (0)
            if (nt == TB) {
#pragma unroll 1
                for (int t = 0; t < 16; t += 8) { WKV_STEP(t, ykeep0, t); WKV_STEP(t + 1, ykeep0, t + 1); WKV_STEP(t + 2, ykeep0, t + 2); WKV_STEP(t + 3, ykeep0, t + 3); WKV_STEP(t + 4, ykeep0, t + 4); WKV_STEP(t + 5, ykeep0, t + 5); WKV_STEP(t + 6, ykeep0, t + 6); WKV_STEP(t + 7, ykeep0, t + 7); }
#pragma unroll 1
                for (int t = 16; t < 32; t += 8) { WKV_STEP(t, ykeep1, t - 16); WKV_STEP(t + 1, ykeep1, t - 15); WKV_STEP(t + 2, ykeep1, t - 14); WKV_STEP(t + 3, ykeep1, t - 13); WKV_STEP(t + 4, ykeep1, t - 12); WKV_STEP(t + 5, ykeep1, t - 11); WKV_STEP(t + 6, ykeep1, t - 10); WKV_STEP(t + 7, ykeep1, t - 9); }
            } else { for (int t = 0; t < nt; ++t) { if (t < 16) WKV_STEP(t, ykeep0, t); else WKV_STEP(t, ykeep1, t - 16); } }
#undef WKV_STEP
            yb[part * 32 + rowl] = ykeep0; yb[(16 + part) * 32 + rowl] = ykeep1;
            if (b + 1 < nblk) WKV_STORE(nxt);
            __syncthreads();
            { const int rl = tid & 31; _Pragma("unroll") for (int t = tid >> 5; t < TB; t += 16) if (t < nt) Y[(size_t)(r0 + tb0 + t) * 1024 + h * 64 + half * 32 + rl] = yb[t * 32 + rl]; }
        }
#undef WKV_LOAD
#undef WKV_STORE
        *(GAS f32x4*)((smp ? SOUT : P) + ((size_t)pair * 64 + vrow) * 64 + part * 4) = (f32x4){S01.x, S01.y, S23.x, S23.y};
        __syncthreads();
    }
}

__device__ __forceinline__ void rwkvpost2_phase(const GAS bf16_t* __restrict__ Y, const GAS bf16_t* __restrict__ G, const GAS bf16_t* __restrict__ VF, const GAS float* __restrict__ BON, const GAS float* __restrict__ lnx_g, const GAS float* __restrict__ lnx_b,
                                                GAS bf16_t* XB, int nitems, int lane, int wave_gid, int nwaves) {
    const int nit4 = nitems >> 2, hg = wave_gid & 3, cofs = hg * 256 + 4 * lane; const f32x4 lg = *(const GAS f32x4*)(lnx_g + cofs), lb = *(const GAS f32x4*)(lnx_b + cofs);
    for (int it0 = wave_gid; it0 < nit4; it0 += nwaves * 4) {
        u32x2 yq[4], vq[4], gq[4]; float bq[4];
#pragma unroll
        for (int q = 0; q < 4; ++q) { int it = it0 + q * nwaves; it = it < nit4 ? it : it0; const int row = it >> 2; const size_t ix = (size_t)row * 1024 + cofs;
            yq[q] = *(const GAS u32x2*)(Y + ix); vq[q] = *(const GAS u32x2*)(VF + ix); gq[q] = *(const GAS u32x2*)(G + ix); bq[q] = BON[row * 16 + hg * 4 + (lane >> 4)]; }
#pragma unroll
        for (int q = 0; q < 4; ++q) { const int it = it0 + q * nwaves; const int row = it >> 2; const f32x4 y = (f32x4){bflo(yq[q].x), bfhi(yq[q].x), bflo(yq[q].y), bfhi(yq[q].y)}, vv4 = (f32x4){bflo(vq[q].x), bfhi(vq[q].x), bflo(vq[q].y), bfhi(vq[q].y)};
            const float mu = row_sum16((y.x + y.y) + (y.z + y.w)) * (1.f / 64.f); const f32x4 d = y - mu; const float rs = __builtin_amdgcn_rsqf(row_sum16((d.x * d.x + d.y * d.y) + (d.z * d.z + d.w * d.w)) * (1.f / 64.f) + 64e-5f);
            const f32x4 gg = (f32x4){bflo(gq[q].x), bfhi(gq[q].x), bflo(gq[q].y), bfhi(gq[q].y)}; const f32x4 o = (d * rs * lg + lb + bq[q] * vv4) * gg;
            if (it < nit4) { u32x2 w_; w_.x = pk_bf16(o.x, o.y); w_.y = pk_bf16(o.z, o.w); *(GAS u32x2*)(XB + (size_t)row * 1024 + cofs) = w_; } }
    }
}

__device__ __forceinline__ void wkv2_phase(const GAS bf16_t* __restrict__ R, const GAS bf16_t* __restrict__ KR, const GAS bf16_t* __restrict__ WL, const GAS bf16_t* __restrict__ AL, const GAS bf16_t* __restrict__ V, const GAS bf16_t* __restrict__ VG,
                                           const GAS bf16_t* VFI, const GAS float* __restrict__ PRM, const GAS float* __restrict__ SIN, GAS bf16_t* __restrict__ Y, GAS float* __restrict__ P, GAS float* __restrict__ SOUT, GAS bf16_t* VFO, GAS float* __restrict__ BON,
                                           int has_vres, int B, int T, int DB, int DT, LAS unsigned char* lds, int tid, int bid, int nb) {
    constexpr int TB = 32, VECB = TB * 1280, VVB = TB * 128, BUF = VECB + 2 * VVB;
    const bool scanw = __builtin_amdgcn_readfirstlane(tid) < 256; const int pt = tid & 255;
    const int rowl = pt >> 4, part = pt & 15;
    const int nprompt = B * 32, nunits_all = nprompt + DB * 32, nunits = DT <= 4 ? nprompt : nunits_all;
    for (int u = bid; u < nunits; u += nb) {
        const bool smp = u >= nprompt; const int q0_ = smp ? u - nprompt : u; const int q = ((q0_ & 7) << 1 | ((q0_ >> 3) & 1)) + ((q0_ >> 4) << 4);
        const int half = q & 1, pair = q >> 1, sq = pair >> 4, h = pair & 15;
        const int Tu = smp ? DT : T; const int r0 = smp ? B * T + sq * DT : sq * T, vrow = half * 32 + rowl;
        const int srow = pt >> 3, sp8 = pt & 7;
        f32x2 S0 = (f32x2){0.f, 0.f}, S1 = (f32x2){0.f, 0.f}, S2 = (f32x2){0.f, 0.f}, S3 = (f32x2){0.f, 0.f};
        if (smp && scanw) { const GAS f32x4* sp_ = (const GAS f32x4*)(SIN + ((size_t)pair * 64 + half * 32 + srow) * 64 + sp8 * 8); const f32x4 sa4 = sp_[0], sb4 = sp_[1];
                   S0 = (f32x2){sa4.x, sa4.y}; S1 = (f32x2){sa4.z, sa4.w}; S2 = (f32x2){sb4.x, sb4.y}; S3 = (f32x2){sb4.z, sb4.w};
                   asm volatile("" : "+v"(S0), "+v"(S1), "+v"(S2), "+v"(S3)); }
        const int nblk = (Tu + TB - 1) / TB;
        u32x2 lk0, lw0, la0, lr0, lk1, lw1, la1, lr1, lv, lg = (u32x2){0u, 0u}, lf = (u32x2){0u, 0u};
        const size_t eo_ = (size_t)(r0 + (pt >> 4)) * 1024 + h * 64 + part * 4, ev_ = (size_t)(r0 + (pt >> 3)) * 1024 + h * 64 + half * 32 + (pt & 7) * 4;
        const int lo_ = ((pt >> 4) * 320 + part * 4) * 4, lv_ = VECB + pt * 16;
        const int pc_ = h * 64 + part * 4; const f32x4 w0v = *(const GAS f32x4*)(PRM + pc_), a0v = *(const GAS f32x4*)(PRM + 1024 + pc_), kkp = *(const GAS f32x4*)(PRM + 3072 + pc_), kap = *(const GAS f32x4*)(PRM + 4096 + pc_), rkp = *(const GAS f32x4*)(PRM + 5120 + pc_);
        const f32x4 v0v = *(const GAS f32x4*)(PRM + 2048 + h * 64 + half * 32 + (pt & 7) * 4);
#define WKV_LOAD(tb0) do { const size_t bo_ = (size_t)(tb0) * 1024, b1_ = bo_ + 16 * 1024; lk0 = *(const GAS u32x2*)(KR + eo_ + bo_); lw0 = *(const GAS u32x2*)(WL + eo_ + bo_); la0 = *(const GAS u32x2*)(AL + eo_ + bo_); lr0 = *(const GAS u32x2*)(R + eo_ + bo_); \
            lk1 = *(const GAS u32x2*)(KR + eo_ + b1_); lw1 = *(const GAS u32x2*)(WL + eo_ + b1_); la1 = *(const GAS u32x2*)(AL + eo_ + b1_); lr1 = *(const GAS u32x2*)(R + eo_ + b1_); \
            lv = *(const GAS u32x2*)(V + ev_ + bo_); if (has_vres) { lg = *(const GAS u32x2*)(VG + ev_ + bo_); lf = *(const GAS u32x2*)(VFI + ev_ + bo_); } } while (0)
#define WKV_UNPK(w_) ((f32x4){bflo((w_).x), bfhi((w_).x), bflo((w_).y), bfhi((w_).y)})
#define WKV_ITEM(bufp, tb0, lk, lw, la, lr, ti_) do { const f32x4 k4 = WKV_UNPK(lk), wl4 = WKV_UNPK(lw), al4 = WKV_UNPK(la); const f32x4 kv = k4 * kkp; const float ss = row_sum16((kv.x * kv.x + kv.y * kv.y) + (kv.z * kv.z + kv.w * kv.w)); const float inv = frcp(fmaxf(fsqrt(ss), 1e-12f)); \
            f32x4 dec, a4; _Pragma("unroll") for (int i_ = 0; i_ < 4; ++i_) { dec[i_] = __expf(-0.6065306597126334f * frcp(1.f + __expf(-(w0v[i_] + wl4[i_])))); a4[i_] = frcp(1.f + __expf(-(a0v[i_] + al4[i_]))); } \
            const f32x4 kk = kv * inv; const f32x4 k2 = k4 * ((a4 - 1.f) * kap + 1.f); const f32x4 r4 = WKV_UNPK(lr); const f32x4 rk = r4 * k2 * rkp; const float bon = row_sum16((rk.x + rk.y) + (rk.z + rk.w)); \
            LAS unsigned char* d_ = (bufp) + lo_ + (ti_) * 1280; *(LAS f32x4*)(d_) = dec; *(LAS f32x4*)(d_ + 256) = -kk; *(LAS f32x4*)(d_ + 512) = kk * a4; *(LAS f32x4*)(d_ + 768) = k2; *(LAS f32x4*)(d_ + 1024) = r4; \
            const int tr_ = (tb0) + (pt >> 4) + (ti_); if (half == 0 && part == 0 && tr_ < Tu) BON[(size_t)(r0 + tr_) * 16 + h] = bon; } while (0)
#define WKV_STORE(bufp, tb0) do { WKV_ITEM(bufp, tb0, lk0, lw0, la0, lr0, 0); if ((tb0) + 16 < Tu) WKV_ITEM(bufp, tb0, lk1, lw1, la1, lr1, 16); \
            f32x4 v4 = WKV_UNPK(lv); if (has_vres) { const f32x4 g4 = WKV_UNPK(lg), f4 = WKV_UNPK(lf); _Pragma("unroll") for (int i_ = 0; i_ < 4; ++i_) v4[i_] = v4[i_] + (f4[i_] - v4[i_]) * frcp(1.f + __expf(-(v0v[i_] + g4[i_]))); } \
            *(LAS f32x4*)((bufp) + lv_) = v4; const int tv_ = (tb0) + (pt >> 3); if (tv_ < Tu) { u32x2 w_; w_.x = pk_bf16(v4.x, v4.y); w_.y = pk_bf16(v4.z, v4.w); *(GAS u32x2*)(VFO + ev_ + (size_t)(tb0) * 1024) = w_; } } while (0)
#define WKV_YOUT(bufp, tb0, ntp) do { const LAS float* yb_ = (const LAS float*)((bufp) + VECB + VVB); const int rl = (pt & 15) * 2; _Pragma("unroll") for (int t = pt >> 4; t < TB; t += 16) if (t < (ntp)) { const f32x2 y2 = *(const LAS f32x2*)(yb_ + t * 32 + rl); \
            *(GAS unsigned*)(Y + (size_t)(r0 + (tb0) + t) * 1024 + h * 64 + half * 32 + rl) = pk_bf16(y2.x, y2.y); } } while (0)
        if (!scanw) { WKV_LOAD(0); WKV_STORE(lds, 0); if (nblk > 1) WKV_LOAD(TB); }
        __syncthreads();
        for (int b = 0; b < nblk; ++b) {
            LAS unsigned char* cur = lds + (b & 1) * BUF; LAS unsigned char* nxt = lds + ((b + 1) & 1) * BUF; const int tb0 = b * TB; const int nt = (Tu - tb0) < TB ? (Tu - tb0) : TB;
            if (scanw) {
                const LAS float* vec = (const LAS float*)cur + sp8 * 8; const LAS float* vv = (const LAS float*)(cur + VECB) + srow; LAS float* yb = (LAS float*)(cur + VECB + VVB);
                LAS float* ybl = yb + srow;
                struct StepV { f32x4 w0, w1, n0, n1, b0, b1, k0, k1, r0, r1; float v; };
#define WKV_RD(dst, t) do { const LAS f32x4* vp_ = (const LAS f32x4*)(vec + (t) * 320); dst.w0 = vp_[0]; dst.w1 = vp_[1]; dst.n0 = vp_[16]; dst.n1 = vp_[17]; dst.b0 = vp_[32]; dst.b1 = vp_[33]; \
                dst.k0 = vp_[48]; dst.k1 = vp_[49]; dst.r0 = vp_[64]; dst.r1 = vp_[65]; dst.v = vv[(t) * 32]; } while (0)
#define WKV_LO(q_) ((f32x2){(q_).x, (q_).y})
#define WKV_HI(q_) ((f32x2){(q_).z, (q_).w})
#define WKV_UPD(S, w_, b_, k_) S = __builtin_elementwise_fma(S, w_, __builtin_elementwise_fma(b_, sa2, (k_) * v2))
#define WKV_CMP(src, t_) do { const f32x2 spa = __builtin_elementwise_fma(S1, WKV_HI(src.n0), S0 * WKV_LO(src.n0)), spb = __builtin_elementwise_fma(S3, WKV_HI(src.n1), S2 * WKV_LO(src.n1)); const f32x2 sp = spa + spb; \
                const float sa = row_sum8(sp.x + sp.y); const f32x2 sa2 = (f32x2){sa, sa}, v2 = (f32x2){src.v, src.v}; \
                WKV_UPD(S0, WKV_LO(src.w0), WKV_LO(src.b0), WKV_LO(src.k0)); WKV_UPD(S1, WKV_HI(src.w0), WKV_HI(src.b0), WKV_HI(src.k0)); WKV_UPD(S2, WKV_LO(src.w1), WKV_LO(src.b1), WKV_LO(src.k1)); WKV_UPD(S3, WKV_HI(src.w1), WKV_HI(src.b1), WKV_HI(src.k1)); \
                const f32x2 ypa = __builtin_elementwise_fma(S1, WKV_HI(src.r0), S0 * WKV_LO(src.r0)), ypb = __builtin_elementwise_fma(S3, WKV_HI(src.r1), S2 * WKV_LO(src.r1)); const f32x2 yp = ypa + ypb; \
                ybl[(t_) * 32] = row_sum8(yp.x + yp.y); } while (0)
#define WKV_ST(t_, cur_, nx2_) do { WKV_RD(nx2_, ((t_) + 2) & 31); __builtin_amdgcn_sched_barrier(0); WKV_CMP(cur_, t_); } while (0)
                if (nt == TB) {
                    StepV sA, sB, sC; WKV_RD(sA, 0); WKV_RD(sB, 1);
#pragma unroll 1
                    for (int t = 0; t < 30; t += 3) { WKV_ST(t, sA, sC); WKV_ST(t + 1, sB, sA); WKV_ST(t + 2, sC, sB); }
                    WKV_ST(30, sA, sC); WKV_ST(31, sB, sA);
                } else { StepV sA; for (int t = 0; t < nt; ++t) { WKV_RD(sA, t); WKV_CMP(sA, t); } }
#undef WKV_RD
#undef WKV_LO
#undef WKV_HI
#undef WKV_UPD
#undef WKV_CMP
#undef WKV_ST
            } else {
                if (b > 0) WKV_YOUT(nxt, tb0 - TB, TB);
                if (b + 1 < nblk) { WKV_STORE(nxt, tb0 + TB); if (b + 2 < nblk) WKV_LOAD(tb0 + 2 * TB); }
            }
            __syncthreads();
        }
        if (!scanw) { const int tbl = (nblk - 1) * TB; WKV_YOUT(lds + ((nblk - 1) & 1) * BUF, tbl, Tu - tbl); }
#undef WKV_LOAD
#undef WKV_STORE
#undef WKV_ITEM
#undef WKV_YOUT
#undef WKV_UNPK
        if (scanw) { GAS float* so = (smp ? SOUT : P) + ((size_t)pair * 64 + half * 32 + srow) * 64 + sp8 * 8; *(GAS f32x4*)so = (f32x4){S0.x, S0.y, S1.x, S1.y}; *(GAS f32x4*)(so + 4) = (f32x4){S2.x, S2.y, S3.x, S3.y}; }
        __syncthreads();
    }
    if (DT <= 4) {
        const int grp = __builtin_amdgcn_readfirstlane(tid) >> 8, t4 = tid & 255, srow = t4 >> 3, sp8 = t4 & 7;
        for (int u = nprompt + bid + nb * grp; u < nunits_all; u += nb * 2) {
            const int q0_ = u - nprompt; const int q = ((q0_ & 7) << 1 | ((q0_ >> 3) & 1)) + ((q0_ >> 4) << 4);
            const int half = q & 1, pair = q >> 1, sq = pair >> 4, h = pair & 15; const int r0 = B * T + sq * DT, vrow = half * 32 + srow;
            const size_t cb_ = (size_t)h * 64 + sp8 * 8, cv_ = (size_t)h * 64 + vrow;
            const GAS f32x4* sp_ = (const GAS f32x4*)(SIN + ((size_t)pair * 64 + vrow) * 64 + sp8 * 8); const f32x4 sa4 = sp_[0], sb4 = sp_[1];
            f32x4 pw0[2], pa0[2], pkk[2], pka[2], prk[2];
#pragma unroll
            for (int i = 0; i < 2; ++i) { pw0[i] = *(const GAS f32x4*)(PRM + cb_ + 4 * i); pa0[i] = *(const GAS f32x4*)(PRM + 1024 + cb_ + 4 * i); pkk[i] = *(const GAS f32x4*)(PRM + 3072 + cb_ + 4 * i); pka[i] = *(const GAS f32x4*)(PRM + 4096 + cb_ + 4 * i); prk[i] = *(const GAS f32x4*)(PRM + 5120 + cb_ + 4 * i); }
            const float v0c = PRM[2048 + cv_];
            u32x4 lk[4], lw[4], la[4], lr[4]; unsigned short lv[4], lg[4], lf[4];
#pragma unroll
            for (int t = 0; t < 4; ++t) { const int tt = t < DT ? t : DT - 1; const size_t ro = (size_t)(r0 + tt) * 1024; lk[t] = *(const GAS u32x4*)(KR + ro + cb_); lw[t] = *(const GAS u32x4*)(WL + ro + cb_); la[t] = *(const GAS u32x4*)(AL + ro + cb_); lr[t] = *(const GAS u32x4*)(R + ro + cb_);
                lv[t] = V[ro + cv_]; lg[t] = has_vres ? VG[ro + cv_] : (unsigned short)0; lf[t] = has_vres ? VFI[ro + cv_] : (unsigned short)0; }
            float S[8] = {sa4.x, sa4.y, sa4.z, sa4.w, sb4.x, sb4.y, sb4.z, sb4.w};
#pragma unroll
            for (int t = 0; t < 4; ++t) if (t < DT) {
                float k8[8], w8[8], a8[8], r8[8];
#pragma unroll
                for (int i = 0; i < 4; ++i) { k8[2 * i] = bflo(lk[t][i]); k8[2 * i + 1] = bfhi(lk[t][i]); w8[2 * i] = bflo(lw[t][i]); w8[2 * i + 1] = bfhi(lw[t][i]); a8[2 * i] = bflo(la[t][i]); a8[2 * i + 1] = bfhi(la[t][i]); r8[2 * i] = bflo(lr[t][i]); r8[2 * i + 1] = bfhi(lr[t][i]); }
                float kv[8], ss = 0.f;
#pragma unroll
                for (int i = 0; i < 8; ++i) { kv[i] = k8[i] * pkk[i >> 2][i & 3]; ss = fmaf(kv[i], kv[i], ss); }
                const float inv = frcp(fmaxf(fsqrt(row_sum8(ss)), 1e-12f));
                float dec[8], nn[8], bb[8], k2[8], bsum = 0.f, sdot = 0.f;
#pragma unroll
                for (int i = 0; i < 8; ++i) { dec[i] = __expf(-0.6065306597126334f * frcp(1.f + __expf(-(pw0[i >> 2][i & 3] + w8[i])))); const float av = frcp(1.f + __expf(-(pa0[i >> 2][i & 3] + a8[i]))); const float kk = kv[i] * inv;
                    nn[i] = -kk; bb[i] = kk * av; k2[i] = k8[i] * ((av - 1.f) * pka[i >> 2][i & 3] + 1.f); bsum = fmaf(r8[i] * k2[i], prk[i >> 2][i & 3], bsum); sdot = fmaf(S[i], nn[i], sdot); }
                const float bon = row_sum8(bsum), sa = row_sum8(sdot);
                float vv = __uint_as_float((unsigned)lv[t] << 16); if (has_vres) vv = vv + (__uint_as_float((unsigned)lf[t] << 16) - vv) * frcp(1.f + __expf(-(v0c + __uint_as_float((unsigned)lg[t] << 16))));
                float yd = 0.f;
#pragma unroll
                for (int i = 0; i < 8; ++i) { S[i] = fmaf(S[i], dec[i], fmaf(bb[i], sa, k2[i] * vv)); yd = fmaf(S[i], r8[i], yd); }
                const float y = row_sum8(yd); const size_t ro = (size_t)(r0 + t) * 1024;
                if (sp8 == 0) { Y[ro + cv_] = (bf16_t)(pk_bf16(y, 0.f) & 0xffffu); VFO[ro + cv_] = (bf16_t)(pk_bf16(vv, 0.f) & 0xffffu); if (vrow == 0) BON[(size_t)(r0 + t) * 16 + h] = bon; } }
            GAS float* so = SOUT + ((size_t)pair * 64 + vrow) * 64 + sp8 * 8; *(GAS f32x4*)so = (f32x4){S[0], S[1], S[2], S[3]}; *(GAS f32x4*)(so + 4) = (f32x4){S[4], S[5], S[6], S[7]};
        }
    }
}

__device__ __forceinline__ void gla_phase(const GAS float* __restrict__ PROJ, const GAS float* __restrict__ LOGA, GAS float* __restrict__ O, GAS float* __restrict__ P, int B, int T, LAS unsigned char* lds, int tid, int bid, int nb) {
    constexpr int TB = 32, OA = 0, OK = 8192, OQ = 16384, OV = 24576, BUF = 26624;
    const int wv = __builtin_amdgcn_readfirstlane(tid) >> 6; const bool scanw = wv < 4; const int pt = tid & 255, lane = tid & 63;
    const int col = pt >> 4, p = pt & 15, dk = p * 4;
    const int nunits = B * 32;
#define GLA_WAITV(n_) asm volatile("s_waitcnt vmcnt(" #n_ ")" ::: "memory")
#define GLA_BAR() do { asm volatile("s_waitcnt lgkmcnt(0)" ::: "memory"); __builtin_amdgcn_s_barrier(); asm volatile("" ::: "memory"); } while (0)
    for (int u = bid; u < nunits; u += nb) {
        const int ug_ = ((u & 7) << 3 | ((u >> 3) & 7)) + ((u >> 6) << 6);
        const int cb = ug_ & 7, pair = ug_ >> 3, s = pair >> 2, h = pair & 3; const int r0 = s * T;
        f32x2 S01 = (f32x2){0.f, 0.f}, S23 = (f32x2){0.f, 0.f};
        const int nblk = (T + TB - 1) / TB;
        const GAS unsigned char* gsrc; size_t gins, gblk; int ldst;
        if (wv == 4) { gsrc = (const GAS unsigned char*)(LOGA + (size_t)(r0 + (lane >> 4)) * 256 + h * 64 + (lane & 15) * 4); gins = (size_t)4 * 256 * 4; gblk = (size_t)TB * 256 * 4; ldst = OA; }
        else if (wv == 7) { gsrc = (const GAS unsigned char*)(PROJ + (size_t)(r0 + (lane >> 2)) * 2576 + 512 + h * 128 + cb * 16 + (lane & 3) * 4); gins = (size_t)16 * 2576 * 4; gblk = (size_t)TB * 2576 * 4; ldst = OV; }
        else { gsrc = (const GAS unsigned char*)(PROJ + (size_t)(r0 + (lane >> 4)) * 2576 + (wv == 5 ? 256 : 0) + h * 64 + (lane & 15) * 4); gins = (size_t)4 * 2576 * 4; gblk = (size_t)TB * 2576 * 4; ldst = wv == 5 ? OK : OQ; }
#define GLA_DMA(blk_) do { const GAS unsigned char* s_ = gsrc + (size_t)(blk_) * gblk; LAS unsigned char* d_ = lds + ((blk_) % 3) * BUF + ldst; \
            if (wv == 7) { __builtin_amdgcn_global_load_lds((const GAS unsigned*)s_, (LAS unsigned*)d_, 16, 0, 0); __builtin_amdgcn_global_load_lds((const GAS unsigned*)(s_ + gins), (LAS unsigned*)(d_ + 1024), 16, 0, 0); } \
            else { _Pragma("unroll") for (int i_ = 0; i_ < 8; ++i_) __builtin_amdgcn_global_load_lds((const GAS unsigned*)(s_ + i_ * gins), (LAS unsigned*)(d_ + i_ * 1024), 16, 0, 0); } } while (0)
        if (!scanw) { GLA_DMA(0); if (nblk > 1) { GLA_DMA(1); if (wv == 7) GLA_WAITV(2); else GLA_WAITV(8); } else GLA_WAITV(0); }
        GLA_BAR();
        for (int b = 0; b < nblk; ++b) {
            const int tb0 = b * TB; const int nt = (T - tb0) < TB ? (T - tb0) : TB;
            if (scanw) {
                const LAS unsigned char* cur = lds + (b % 3) * BUF; const LAS float* vec = (const LAS float*)cur + dk; const LAS float* vv = (const LAS float*)(cur + OV) + col;
                float okeep0 = 0.f, okeep1 = 0.f;
                struct G4 { f32x4 a[4], k[4], q[4]; float v[4]; };
#define GLA_RD4(dst, t0_) do { _Pragma("unroll") for (int i_ = 0; i_ < 4; ++i_) { const LAS float* vp_ = vec + ((t0_) + i_) * 64; dst.a[i_] = *(const LAS f32x4*)vp_; dst.k[i_] = *(const LAS f32x4*)(vp_ + OK / 4); dst.q[i_] = *(const LAS f32x4*)(vp_ + OQ / 4); dst.v[i_] = vv[((t0_) + i_) * 16]; } } while (0)
#define GLA_ONE(src, i_, keep, tl) do { const f32x4 a4 = src.a[i_], k4 = src.k[i_], q4 = src.q[i_]; const f32x2 v2 = (f32x2){src.v[i_], src.v[i_]}; \
                S01 = __builtin_elementwise_fma((f32x2){a4.x, a4.y}, S01, (f32x2){k4.x, k4.y} * v2); S23 = __builtin_elementwise_fma((f32x2){a4.z, a4.w}, S23, (f32x2){k4.z, k4.w} * v2); \
                const f32x2 o2 = __builtin_elementwise_fma((f32x2){q4.z, q4.w}, S23, (f32x2){q4.x, q4.y} * S01); const float o = row_sum16(o2.x + o2.y); keep = (p == (tl)) ? o : keep; } while (0)
#define GLA_CMP4(src, keep, tl0) do { GLA_ONE(src, 0, keep, tl0); GLA_ONE(src, 1, keep, (tl0) + 1); GLA_ONE(src, 2, keep, (tl0) + 2); GLA_ONE(src, 3, keep, (tl0) + 3); } while (0)
                if (nt == TB) {
                    G4 gA, gB; GLA_RD4(gA, 0);
                    GLA_RD4(gB, 4); __builtin_amdgcn_sched_barrier(0); GLA_CMP4(gA, okeep0, 0); GLA_RD4(gA, 8); __builtin_amdgcn_sched_barrier(0); GLA_CMP4(gB, okeep0, 4);
                    GLA_RD4(gB, 12); __builtin_amdgcn_sched_barrier(0); GLA_CMP4(gA, okeep0, 8); GLA_RD4(gA, 16); __builtin_amdgcn_sched_barrier(0); GLA_CMP4(gB, okeep0, 12);
                    GLA_RD4(gB, 20); __builtin_amdgcn_sched_barrier(0); GLA_CMP4(gA, okeep1, 0); GLA_RD4(gA, 24); __builtin_amdgcn_sched_barrier(0); GLA_CMP4(gB, okeep1, 4);
                    GLA_RD4(gB, 28); __builtin_amdgcn_sched_barrier(0); GLA_CMP4(gA, okeep1, 8); __builtin_amdgcn_sched_barrier(0); GLA_CMP4(gB, okeep1, 12);
                } else { G4 g1; for (int t = 0; t < nt; ++t) { const LAS float* vp_ = vec + t * 64; g1.a[0] = *(const LAS f32x4*)vp_; g1.k[0] = *(const LAS f32x4*)(vp_ + OK / 4); g1.q[0] = *(const LAS f32x4*)(vp_ + OQ / 4); g1.v[0] = vv[t * 16];
                    if (t < 16) GLA_ONE(g1, 0, okeep0, t); else GLA_ONE(g1, 0, okeep1, t - 16); } }
#undef GLA_RD4
#undef GLA_ONE
#undef GLA_CMP4
                { int pt_ = pt; asm volatile("" : "+v"(pt_)); const int p_ = pt_ & 15; GAS float* od = O + (size_t)(r0 + tb0 + p_) * 512 + h * 128 + cb * 16 + (pt_ >> 4);
                  if (p_ < nt) od[0] = okeep0 * 0.125f; if (16 + p_ < nt) od[(size_t)16 * 512] = okeep1 * 0.125f; }
            } else {
                if (b + 2 < nblk) { GLA_DMA(b + 2); if (wv == 7) GLA_WAITV(2); else GLA_WAITV(8); } else GLA_WAITV(0);
            }
            GLA_BAR();
        }
#undef GLA_DMA
        if (scanw) { int pt_ = pt; asm volatile("" : "+v"(pt_));
                     GAS float* so = P + ((size_t)pair * 64 + (pt_ & 15) * 4) * 128 + cb * 16 + (pt_ >> 4); so[0] = S01.x; so[128] = S01.y; so[256] = S23.x; so[384] = S23.y; }
        GLA_BAR();
    }
#undef GLA_WAITV
#undef GLA_BAR
}
__device__ __forceinline__ float grp8_sum(float v) { v += dppf<0xB1>(v); v += dppf<0x4E>(v); v += dppf<0x141>(v); return v; }
__device__ __forceinline__ float dot16_fp8_bf16(const u32x4 uw, const float (&x)[16]) { float s = 0.f;
#pragma unroll
    for (int d = 0; d < 4; ++d) { const f32x2 lo = fp8lo(uw[d]), hi = fp8hi(uw[d]); s = fmaf(lo.x, x[4 * d], s); s = fmaf(lo.y, x[4 * d + 1], s); s = fmaf(hi.x, x[4 * d + 2], s); s = fmaf(hi.y, x[4 * d + 3], s); }
    return s; }
typedef int i32x8 __attribute__((ext_vector_type(8)));
typedef unsigned u32x8 __attribute__((ext_vector_type(8)));
__device__ __forceinline__ void pacts_phase(const GAS unsigned char* XF8, const GAS unsigned char* U8S, const GAS int* EIDX, GAS bf16_t* __restrict__ PART, int M, int emask,
                                            LAS unsigned char* lds, int wid, int lane, int bid, int nb) {
    const bool spl = (nb & 7) == 0; const int s0 = spl ? (bid & 7) : 0, s1 = spl ? s0 + 1 : 8, r = spl ? (bid >> 3) : bid, nr = spl ? (nb >> 3) : nb;
    const int g = lane >> 3, c = lane & 7, fg = ((g >> 2) & 1) | (((g >> 1) & 1) << 2);
    const int m16 = lane & 15, kb = lane >> 4, fm = ((m16 >> 2) & 1) | (((m16 >> 1) & 1) << 2);
    LAS unsigned char* const wl = lds + wid * 16384;
    const LAS unsigned char* const ard = wl + m16 * 128 + (((2 * kb) ^ fm) * 16);
    const LAS unsigned char* const xrd = wl + 12288 + (m16 & 1) * 128 + kb * 32;
    const LAS unsigned char* const ird = wl + 13824 + g * 4;
    if (r >= M) return;
    const int ntok = (M - r + nr - 1) / nr;
#define PL_ROW(t_) ({ int rw_ = r + nr * (t_); rw_ < M ? rw_ : r; })
#define PL_IDS(t_, slot_) __builtin_amdgcn_global_load_lds((const GAS unsigned*)(isrc + (size_t)PL_ROW(t_) * 128), (LAS unsigned*)(wl + 13824 + (slot_) * 256), 4, 0, 0)
#define PL_RDIDS(slot_, e0_, e1_) do { e0_ = *(const LAS int*)(ird + (slot_) * 256); e1_ = *(const LAS int*)(ird + (slot_) * 256 + 32); } while (0)
#define PL_TILE(t_, slot_, e0_, e1_) do { \
        __builtin_amdgcn_global_load_lds((const GAS unsigned*)(tb + (size_t)((e0_) & emask) * 128), (LAS unsigned*)(wl + (slot_) * 2048), 16, 0, 0); \
        __builtin_amdgcn_global_load_lds((const GAS unsigned*)(tb + (size_t)((e1_) & emask) * 128), (LAS unsigned*)(wl + (slot_) * 2048 + 1024), 16, 0, 0); \
        __builtin_amdgcn_global_load_lds((const GAS unsigned*)(xsrc + (size_t)PL_ROW(t_) * 2048), (LAS unsigned*)(wl + 12288 + (slot_) * 256), 4, 0, 0); } while (0)
#define PL_RD(slot_, a0_, a1_, x0_, x1_) do { a0_ = *(const LAS u32x4*)(ard + (slot_) * 2048); a1_ = *(const LAS u32x4*)(ard2 + (slot_) * 2048); x0_ = *(const LAS u32x4*)(xrd + (slot_) * 256); x1_ = *(const LAS u32x4*)(xrd + (slot_) * 256 + 16); } while (0)
#define PL_MMA(cc_, a0_, a1_, x0_, x1_) do { const i32x8 av = (i32x8)__builtin_shufflevector(a0_, a1_, 0, 1, 2, 3, 4, 5, 6, 7), bv = (i32x8)__builtin_shufflevector(x0_, x1_, 0, 1, 2, 3, 4, 5, 6, 7); const f32x4 z = {0.f, 0.f, 0.f, 0.f}; \
        cc_ = __builtin_amdgcn_mfma_scale_f32_16x16x128_f8f6f4(av, bv, z, 0, 0, 0, 0, 0, 0); } while (0)
#define PL_OUT(t_, cc_) do { f32x4 o; _Pragma("unroll") for (int i = 0; i < 4; ++i) { float v = cc_[i]; v += dppf<0xB1>(v); o[i] = v * (1.f / 16.f); } \
        const int rw = r + nr * (t_); if (m16 == 0 && rw < M) { u32x2 w_; w_.x = pk_bf16(o[0], o[1]); w_.y = pk_bf16(o[2], o[3]); *(GAS u32x2*)(po + (size_t)rw * 128) = w_; } } while (0)
#define PL_WAIT(n_) asm volatile("s_waitcnt vmcnt(" #n_ ")" ::: "memory")
#define PL_STEP(j_, h_) do { PL_WAIT(12); u32x4 a0[3], a1[3], x0[3], x1[3]; int e0[3], e1[3]; f32x4 cc[3]; \
        _Pragma("unroll") for (int k = 0; k < 3; ++k) PL_RD((h_) * 3 + k, a0[k], a1[k], x0[k], x1[k]); \
        _Pragma("unroll") for (int k = 0; k < 3; ++k) PL_RDIDS((h_) * 3 + k, e0[k], e1[k]); \
        _Pragma("unroll") for (int k = 0; k < 3; ++k) PL_MMA(cc[k], a0[k], a1[k], x0[k], x1[k]); \
        _Pragma("unroll") for (int k = 0; k < 3; ++k) PL_TILE((j_) + 6 + k, (h_) * 3 + k, e0[k], e1[k]); \
        _Pragma("unroll") for (int k = 0; k < 3; ++k) PL_IDS((j_) + 12 + k, (h_) * 3 + k); \
        _Pragma("unroll") for (int k = 0; k < 3; ++k) PL_OUT((j_) + k, cc[k]); } while (0)
    const LAS unsigned char* const ard2 = (const LAS unsigned char*)((unsigned)(size_t)ard ^ 16u);
    for (int s = s0; s < s1; ++s) {
        const GAS unsigned char* tb = U8S + (size_t)s * 16384 * 128 + ((c ^ fg) * 16);
        const GAS unsigned char* xsrc = XF8 + (size_t)(lane >> 5) * 1024 + s * 128 + (lane & 31) * 4;
        const GAS int* isrc = EIDX + wid * 16 + m16;
        GAS bf16_t* po = PART + (size_t)s * M * 128 + wid * 16 + kb * 4;
        PL_IDS(0, 0); PL_IDS(1, 1); PL_IDS(2, 2); PL_IDS(3, 3); PL_IDS(4, 4); PL_IDS(5, 5); PL_WAIT(0);
        { int e0[6], e1[6];
#pragma unroll
          for (int k = 0; k < 6; ++k) PL_RDIDS(k, e0[k], e1[k]);
#pragma unroll
          for (int k = 0; k < 3; ++k) PL_TILE(k, k, e0[k], e1[k]);
#pragma unroll
          for (int k = 0; k < 3; ++k) PL_IDS(6 + k, k);
#pragma unroll
          for (int k = 3; k < 6; ++k) PL_TILE(k, k, e0[k], e1[k]);
#pragma unroll
          for (int k = 3; k < 6; ++k) PL_IDS(6 + k, k); }
        for (int j = 0; j < ntok; j += 6) { PL_STEP(j, 0); PL_STEP(j + 3, 1); }
        PL_WAIT(0);
    }
#undef PL_ROW
#undef PL_IDS
#undef PL_RDIDS
#undef PL_TILE
#undef PL_RD
#undef PL_MMA
#undef PL_OUT
#undef PL_WAIT
#undef PL_STEP
}
__device__ __forceinline__ void pouts_phase(const GAS float* __restrict__ COEF, const GAS int* __restrict__ EIDX, const GAS unsigned char* V8S, GAS bf16_t* __restrict__ YBUF, int M,
                                            int wid, int lane, int bid, int nb) {
    const bool spl = (nb & 7) == 0; const int s0 = spl ? (bid & 7) : 0, s1 = spl ? s0 + 1 : 8, r = spl ? (bid >> 3) : bid, nr = spl ? (nb >> 3) : nb;
    const int g = lane >> 3, ch = lane & 7, rstep = nr * 8;
#define PO_LOADCE(rw, c0, c1, v0, v1) do { c0 = COEF[(size_t)(rw) * 128 + lane] * (1.f / 64.f); c1 = COEF[(size_t)(rw) * 128 + 64 + lane] * (1.f / 64.f); v0 = EIDX[(size_t)(rw) * 128 + lane]; v1 = EIDX[(size_t)(rw) * 128 + 64 + lane]; } while (0)
#define PO_GATHER(vv_, vreg) do { _Pragma("unroll") for (int k = 0; k < 8; ++k) { const int e = __builtin_amdgcn_ds_bpermute((8 * k + g) << 2, vreg); vv_[k] = *(const GAS u32x4*)(tb + (size_t)(e & 16383) * 128); } } while (0)
#define PO_COMP(vv_, creg) do { _Pragma("unroll") for (int k = 0; k < 8; ++k) { const float c = __int_as_float(__builtin_amdgcn_ds_bpermute((8 * k + g) << 2, __float_as_int(creg))); const u32x4 w = vv_[k]; \
        const f32x2 c2 = (f32x2){c, c}; _Pragma("unroll") for (int d = 0; d < 4; ++d) { ac2[2 * d] = __builtin_elementwise_fma(c2, fp8lo(w[d]), ac2[2 * d]); ac2[2 * d + 1] = __builtin_elementwise_fma(c2, fp8hi(w[d]), ac2[2 * d + 1]); } \
        _Pragma("unroll") for (int i = 0; i < 8; ++i) asm volatile("" : "+v"(ac2[i])); } } while (0)
    for (int s = s0; s < s1; ++s) {
        const GAS unsigned char* tb = V8S + (size_t)s * 16384 * 128 + ch * 16;
        int row = r + nr * wid; if (row >= M) continue;
        float c0c, c1c, c0n = 0.f, c1n = 0.f; int v0c, v1c, v0n = 0, v1n = 0;
        PO_LOADCE(row, c0c, c1c, v0c, v1c);
        u32x4 va[8], vb[8];
        PO_GATHER(va, v0c);
        for (;;) {
            const int rown = row + rstep; const bool hasn = rown < M;
            PO_GATHER(vb, v1c);
            if (hasn) PO_LOADCE(rown, c0n, c1n, v0n, v1n);
            f32x2 ac2[8];
#pragma unroll
            for (int i = 0; i < 8; ++i) ac2[i] = (f32x2){0.f, 0.f};
            PO_COMP(va, c0c);
            if (hasn) PO_GATHER(va, v0n);
            PO_COMP(vb, c1c);
            float acc[16];
#pragma unroll
            for (int i = 0; i < 8; ++i) { acc[2 * i] = ac2[i].x; acc[2 * i + 1] = ac2[i].y; }
#pragma unroll
            for (int i = 0; i < 16; ++i) acc[i] += dppf<0x128>(acc[i]);
#pragma unroll
            for (int i = 0; i < 8; ++i) { const bool hi = lane & 16; const float send = hi ? acc[i] : acc[i + 8], keep = hi ? acc[i + 8] : acc[i]; acc[i] = keep + shx(send, 16, lane); }
#pragma unroll
            for (int i = 0; i < 4; ++i) { const bool hi = lane & 32; const float send = hi ? acc[i] : acc[i + 4], keep = hi ? acc[i + 4] : acc[i]; acc[i] = keep + shx(send, 32, lane); }
            if ((lane & 8) == 0) { u32x2 w_; w_.x = pk_bf16(acc[0], acc[1]); w_.y = pk_bf16(acc[2], acc[3]); *(GAS u32x2*)(YBUF + (size_t)row * 1024 + s * 128 + ch * 16 + ((lane >> 4) & 1) * 8 + ((lane >> 5) & 1) * 4) = w_; }
            if (!hasn) break;
            row = rown; c0c = c0n; c1c = c1n; v0c = v0n; v1c = v1n;
        }
    }
#undef PO_LOADCE
#undef PO_GATHER
#undef PO_COMP
}
}

template <class T> __device__ __forceinline__ __attribute__((address_space(1))) T* gp(T* p) { return (__attribute__((address_space(1))) T*)uni_ptr(p); }
constexpr int MK_THREADS = 512, LDS_BYTES = 163840, LDSCTL_OFF = 131072, TAB_OFF = LDSCTL_OFF + 1024, MAX_OPS = 208;
static_assert(TAB_OFF + MAX_OPS * (int)sizeof(Op) <= LDS_BYTES, "LDS map");
constexpr int MPAD = 17152;
constexpr size_t CTL_BYTES = (size_t)1 << 20;
struct MArgs { const float* in[47]; float* out; char* ws; unsigned long long ws_size; };
__global__ void __launch_bounds__(MK_THREADS, 2) mega_fwd(MArgs a) {
    extern __shared__ __attribute__((aligned(16))) unsigned char lds[];
    volatile LAS unsigned* ctl = (volatile LAS unsigned*)((LAS unsigned char*)lds + LDSCTL_OFF);
    if (threadIdx.x < 64) ctl[threadIdx.x] = 0u;
    __syncthreads();
    (void)xcd_barrier_post((unsigned*)a.ws, ctl + 8);
    const Dm dm = make_dm(1024, 8, 2048, 128, 4);
    Op* tab = (Op*)(lds + TAB_OFF);
    if (threadIdx.x == 0) {
        const float* const* inp_ = (const float* const*)__builtin_amdgcn_kernarg_segment_ptr(); asm volatile("" : "+s"(inp_));
        NvIO io; io.in = inp_; io.out = a.out; io.ws = a.ws + CTL_BYTES; io.ws_size = a.ws_size - CTL_BYTES;
        int n = 0;
        #ifdef PROBE_DUPCODE
        nv_forward(io, dm, [&](const Op& o) __attribute__((always_inline)) { if (n < MAX_OPS) tab[n] = o; ++n; if ((o.code & 0xff) == PROBE_DUPCODE) { if (n < MAX_OPS) tab[n] = o; ++n; } asm volatile("" ::: "memory"); });
#else
        nv_forward(io, dm, [&](const Op& o) __attribute__((always_inline)) { if (n < MAX_OPS) tab[n] = o; ++n; asm volatile("" ::: "memory"); });
#endif
        ctl[16] = (unsigned)(n <= MAX_OPS ? n : 0);
    }
    __syncthreads();
    const int nops = (int)ctl[16];
    for (int i = 0; i < nops; ++i) {
        int tid_ = (int)threadIdx.x, bid_ = (int)blockIdx.x, nb_ = (int)gridDim.x;
        asm volatile("" : "+v"(tid_)); asm volatile("" : "+s"(bid_)); asm volatile("" : "+s"(nb_));
        const long long g0 = (long long)bid_ * MK_THREADS + tid_, gs = (long long)nb_ * MK_THREADS;
        const Op& o = tab[i];
        const int rawc = __builtin_amdgcn_readfirstlane(o.code); const int code = rawc & 0xff; const long long n = o.n;
        switch (code) {
        case OP_FGEMM: {
            const int fl = rfl(o.i6);
            pg8::Gemm g{uni_ptr((const pg8::bf16_t*)o.a), uni_ptr((const pg8::bf16_t*)o.b), MPAD, rfl(o.i5), rfl(o.i1), rfl(o.i2), rfl(o.i3)};
            if (rawc & OPF_GROUP) {
                int ng = 1; while (ng < 8 && (rfl(tab[i + ng - 1].code) & OPF_GROUP)) ++ng;
                const PG8_LAS Op* gt = (const PG8_LAS Op*)((PG8_LAS unsigned char*)lds + TAB_OFF) + i;
                pg8::GroupOrder S; S.tab = gt; S.ng = ng; S.nM = MPAD / 256; S.G = nb_; S.c = bid_; S.tsA = (size_t)256 * g.lda * 2; S.tsB = (size_t)256 * g.ldb * 2;
                pg8::EpiGroup E{gt, dm.M};
                pg8::gemm_phase<pg8::EpiGroup, pg8::GroupOrder, true, true>((PG8_LAS unsigned char*)lds, g, S, E);
                i += ng - 1;
            } else {
            pg8::StaticOrder S; S.init(g, nb_, bid_); if (fl & 2) S.acs = 512;
            float* const c0 = uni_ptr(o.o0); const int ldc0 = rfl(o.i4), nreal0 = rfl(o.i0);
            if (fl & 1) { pg8::EpiBf16Plain E{(pg8::bf16_t*)c0, ldc0}; pg8::gemm_phase<pg8::EpiBf16Plain, pg8::StaticOrder, true, true>((PG8_LAS unsigned char*)lds, g, S, E); }
            else { pg8::EpiF32 E{c0, ldc0, dm.M, nreal0}; pg8::gemm_phase<pg8::EpiF32, pg8::StaticOrder, true, true>((PG8_LAS unsigned char*)lds, g, S, E); }
            }
        } break;
        case OP_LRUG2: {
            pg8::Gemm g{uni_ptr((const pg8::bf16_t*)o.a), uni_ptr((const pg8::bf16_t*)o.b), MPAD, 1024, 512, 512, 512};
            pg8::StaticOrder S; S.init(g, nb_, bid_);
            pg8::EpiLru E{uni_ptr(o.c), uni_ptr(o.d), uni_ptr(o.e), uni_ptr((const pg8::bf16_t*)o.f), uni_ptr(o.o0), uni_ptr(o.o1), dm.M};
            pg8::gemm_phase<pg8::EpiLru, pg8::StaticOrder, true, true>((PG8_LAS unsigned char*)lds, g, S, E);
        } break;
        case OP_WKVP: fk::wkv2_phase(gp((const fk::bf16_t*)o.a), gp((const fk::bf16_t*)o.b), gp((const fk::bf16_t*)o.c), gp((const fk::bf16_t*)o.d), gp((const fk::bf16_t*)o.e), gp((const fk::bf16_t*)o.f), gp((const fk::bf16_t*)o.g), gp(o.h), gp((const float*)o.o5), gp((fk::bf16_t*)o.o0), gp(o.o1), gp(o.o2), gp((fk::bf16_t*)o.o3), gp(o.o4), rfl(o.i0), dm.B, dm.T, dm.DB, dm.DT, (LAS unsigned char*)lds, tid_, bid_, nb_); break;
        case OP_POST2: fk::rwkvpost2_phase(gp((const fk::bf16_t*)o.a), gp((const fk::bf16_t*)o.b), gp((const fk::bf16_t*)o.c), gp(o.d), gp(o.e), gp(o.f), gp((fk::bf16_t*)o.o0), dm.M * 16, tid_ & 63, bid_ * 8 + (tid_ >> 6), nb_ * 8); break;
        case OP_GLAF: fk::gla_phase(gp(o.a), gp(o.b), gp(o.o0), gp(o.o1), dm.B, dm.T, (LAS unsigned char*)lds, tid_, bid_, nb_); break;
        case OP_PACTS: fk::pacts_phase(gp((const unsigned char*)o.a), gp((const unsigned char*)o.b), gp((const int*)o.d), gp((fk::bf16_t*)o.o0), dm.M, rfl(o.i0), (LAS unsigned char*)lds, rfl(tid_ >> 6), tid_ & 63, bid_, nb_); break;
        case OP_POUTS: fk::pouts_phase(gp(o.a), gp((const int*)o.b), gp((const unsigned char*)o.c), gp((fk::bf16_t*)o.o0), dm.M, tid_ >> 6, tid_ & 63, bid_, nb_); break;
        case OP_TOPK2: fk::topk_phase(gp((const fk::bf16_t*)o.a), gp((const fk::bf16_t*)o.b), gp(o.c), gp(o.o0), gp((int*)o.o1), dm.M * 8, (LAS unsigned char*)lds, tid_ >> 6, tid_ & 63, bid_ * 8 + (tid_ >> 6), nb_ * 8); break;
        case OP_LNRES: fk::lnres_phase(gp((const fk::bf16_t*)o.a), gp(o.b), gp(o.c), gp(o.o0), gp((fk::bf16_t*)o.o1), gp((unsigned char*)o.o2), dm.M, tid_ & 63, bid_ * 8 + (tid_ >> 6), nb_ * 8); break;
        case OP_GLANORM: fk::glanorm_phase(gp(o.a), gp(o.b), gp(o.c), gp((fk::bf16_t*)o.o0), dm.M * 4, tid_ & 63, bid_ * 8 + (tid_ >> 6), nb_ * 8); break;
        case OP_CVTTAB8S: {
            int X = rfl(o.i6) % nb_; X = (X < nb_ - 1) ? X : 0;
            if (bid_ >= X) { const long long gs2 = (long long)(nb_ - X) * MK_THREADS; for (long long g = (long long)(bid_ - X) * MK_THREADS + tid_; g < n; g += gs2) nv_elem(OP_CVTTAB8S, o, dm, g); } } break;
#define NVC(c) case c: for (long long g = g0; g < n; g += gs) nv_elem(c, o, dm, g); break;
        NVC(OP_LOGA4) NVC(OP_CONVOUT) NVC(OP_SHIFTOUT) NVC(OP_EMBED4) NVC(OP_YOUT4) NVC(OP_MIX6) NVC(OP_CONV4) NVC(OP_CVT8) NVC(OP_WGATE)
        NVC(OP_WT) NVC(OP_PRED) NVC(OP_PRM) NVC(OP_KEYS) NVC(OP_GLA3) NVC(OP_LRU1) NVC(OP_LRU3)
#undef NVC
        default: break;
        }
        if (__builtin_amdgcn_readfirstlane(tab[i].code) & OPF_NOBAR) __syncthreads(); else { XcdBarrier bar; bar.bar = (unsigned*)a.ws; bar.x = xb_xcc_id(); bar.st = ctl + 8; xcd_barrier(bar); }
    }
}
extern "C" void kernel_launch(void* const* d_in, const int* in_sizes, int n_in, void* d_out, int out_size, void* d_ws, size_t ws_size, hipStream_t stream) {
    static int grid = 0;
    if (grid == 0) {
        if (n_in != 47 || ws_size < ((size_t)900 << 20)) { fprintf(stderr, "kernel_launch: expected 47 inputs and >= 900 MiB of workspace; got %d, %zu\n", n_in, ws_size); grid = -1; return; }
        int dev = 0, cus = 0, per_cu = 0;
        if (hipGetDevice(&dev) != hipSuccess || hipDeviceGetAttribute(&cus, hipDeviceAttributeMultiprocessorCount, dev) != hipSuccess) { grid = -1; return; }
        if (hipFuncSetAttribute((const void*)mega_fwd, hipFuncAttributeMaxDynamicSharedMemorySize, LDS_BYTES) != hipSuccess) { fprintf(stderr, "kernel_launch: hipFuncSetAttribute failed\n"); grid = -1; return; }
        if (hipOccupancyMaxActiveBlocksPerMultiprocessor(&per_cu, (const void*)mega_fwd, MK_THREADS, LDS_BYTES) != hipSuccess || per_cu < 1) fprintf(stderr, "kernel_launch: occupancy query says %d per CU\n", per_cu);
        (void)hipGetLastError();
        grid = cus;
    }
    if (grid < 0) return;
    if (hipMemsetAsync(d_ws, 0, CTL_BYTES, stream) != hipSuccess) { fprintf(stderr, "kernel_launch: memset failed\n"); return; }
    MArgs a{}; for (int i = 0; i < 47; ++i) a.in[i] = (const float*)d_in[i]; a.out = (float*)d_out; a.ws = (char*)d_ws; a.ws_size = (unsigned long long)ws_size;
    hipLaunchKernelGGL(mega_fwd, dim3(grid), dim3(MK_THREADS), LDS_BYTES, stream, a);
}
```

```cpp
#include <hip/hip_runtime.h>
#include <cstdio>
#include <cmath>
#ifndef HD
#define HD __host__ __device__ __forceinline__
#endif
struct Dm { int D, B, T, DB, DT, M, NSEQ, RH; };
HD Dm make_dm(int D, int B, int SEQ, int DB, int DT) { Dm d; d.D = D; d.B = B; d.T = SEQ + 16; d.DB = DB; d.DT = DT; d.M = B * d.T + DB * DT; d.NSEQ = B + DB; d.RH = D / 64; return d; }
HD int seq_row0(const Dm& d, int s) { return s < d.B ? s * d.T : d.B * d.T + (s - d.B) * d.DT; }
HD int seq_len(const Dm& d, int s) { return s < d.B ? d.T : d.DT; }
HD void row_to_seq(const Dm& d, int row, int& s, int& t) { if (row < d.B * d.T) { s = row / d.T; t = row % d.T; } else { int r = row - d.B * d.T; s = d.B + r / d.DT; t = r % d.DT; } }

constexpr int MIXIN = 2576, C_Q = 0, C_K = 256, C_V = 512, C_GLR = 1024, C_R = 1040, C_XB = 1552, C_GB = 2064;

enum { OP_EMBED = 1, OP_GEMM, OP_LOGA, OP_GLA, OP_GLANORM, OP_CONV, OP_CONVOUT, OP_LRUG, OP_LRUSCAN, OP_LNRES, OP_MIX, OP_SHIFTOUT,
       OP_RWKVPREP, OP_WKV, OP_RWKVPOST, OP_QNORM, OP_SCORES, OP_TOPK, OP_PACT1, OP_PACT2, OP_POUT, OP_YOUT, OP_WT, OP_CVT, OP_FGEMM, OP_CVTTAB, OP_KEYS, OP_TOPK2, OP_PACT, OP_POUTLN, OP_GLA1, OP_GLA2, OP_GLA3, OP_LRU1, OP_LRU2, OP_LRU3, OP_EMBED4, OP_YOUT4, OP_MIX8, OP_CONV4, OP_CVT8, OP_WGATE, OP_LRUG2, OP_WKVF, OP_GLAF, OP_CVTTAB8, OP_CVTTAB8S, OP_PACTS, OP_PRED, OP_POUTS, OP_MIX6, OP_PRM, OP_WKVP, OP_POST2, OP_LOGA4 };

constexpr int OPF_NOBAR = 0x100, OPF_GROUP = 0x200;
struct Op {
    const float *a, *b, *c, *d, *e, *f, *g, *h;
    float *o0, *o1, *o2, *o3, *o4, *o5;
    long long n;
    int code, i0, i1, i2, i3, i4, i5, i6;
};

#if defined(__HIP_DEVICE_COMPILE__)
#define NV_UNI(x) __builtin_amdgcn_readfirstlane(x)
#define NV_LAUNDER(p) asm volatile("" : "+s"(p))
#define NV_FENCE() asm volatile("" ::: "memory")
#else
#define NV_FENCE() do {} while (0)
#define NV_UNI(x) (x)
#define NV_LAUNDER(p) do {} while (0)
#endif
typedef unsigned short nvbf;
HD nvbf nv_f2bf(float f) { unsigned u; __builtin_memcpy(&u, &f, 4); return (nvbf)((u + 0x7fffu + ((u >> 16) & 1u)) >> 16); }
HD float nv_bf2f(nvbf h) { unsigned u = (unsigned)h << 16; float f; __builtin_memcpy(&f, &u, 4); return f; }
HD unsigned nv_f2e4m3(float f) {
    unsigned u; __builtin_memcpy(&u, &f, 4); const unsigned sign = (u >> 24) & 0x80u; const float a = fabsf(f);
    if (!(a < 448.f)) return sign | 0x7Eu;
    if (a < 0.015625f) return sign | (unsigned)rintf(a * 512.f);
    unsigned au = u & 0x7fffffffu; au += 0x7ffffu + ((au >> 20) & 1u);
    const unsigned e = ((au >> 23) & 0xffu) - 120u, m = (au >> 20) & 7u; unsigned code = (e << 3) | m; if (code > 0x7Eu) code = 0x7Eu;
    return sign | code; }
HD float nv_e4m32f(unsigned c) { const unsigned e = (c >> 3) & 15u, m = c & 7u; const float v = e ? ldexpf(1.f + m * 0.125f, (int)e - 7) : m * 0.001953125f; return (c & 0x80u) ? -v : v; }
HD int nv_rup(int x, int m) { return (x + m - 1) / m * m; }
struct alignas(16) NvF4 { float x, y, z, w; };
struct alignas(16) NvU4 { unsigned x, y, z, w; };
struct alignas(8) NvU2 { unsigned x, y; };
#if defined(__HIP_DEVICE_COMPILE__)
#define NV_EXP(x) __expf(x)
#define NV_TANH(x) (1.f - 2.f * __builtin_amdgcn_rcpf(1.f + __expf(2.f * (x))))
HD float nv_sigmoid(float x) { return __builtin_amdgcn_rcpf(1.f + __expf(-x)); }
HD float nv_softplus(float x) { return fmaxf(x, 0.f) + __logf(1.f + __expf(-fabsf(x))); }
HD float nv_gelu(float x) { return x * __builtin_amdgcn_rcpf(1.f + __expf(-1.5957691216057308f * (x + 0.044715f * x * x * x))); }
#else
#define NV_EXP(x) expf(x)
#define NV_TANH(x) tanhf(x)
HD float nv_sigmoid(float x) { return 1.f / (1.f + expf(-x)); }
HD float nv_softplus(float x) { return fmaxf(x, 0.f) + log1pf(expf(-fabsf(x))); }
HD float nv_gelu(float x) { return 0.5f * x * (1.f + tanhf(0.7978845608028654f * (x + 0.044715f * x * x * x))); }
#endif

#define NV_INS16(tv, ti, val, idx) do { float _v = (val); int _i = (idx); _Pragma("unroll") for (int _j = 0; _j < 16; ++_j) { if (_v > tv[_j]) { float _tv = tv[_j]; int _ti = ti[_j]; tv[_j] = _v; ti[_j] = _i; _v = _tv; _i = _ti; } } } while (0)

HD void nv_elem(const int code, const Op& p, const Dm& dm, long long gid) {
    const int D = dm.D; float* const PO1 = p.o1; float* const PO2 = p.o2;
    switch (code) {
    case OP_EMBED: {
        int row = (int)(gid / D), c = (int)(gid % D); float v;
        if (row < dm.B * dm.T) { int bb = row / dm.T, t = row % dm.T; v = t < 16 ? p.c[t * D + c] : p.a[((size_t)bb * (dm.T - 16) + (t - 16)) * D + c]; }
        else v = p.b[(size_t)(row - dm.B * dm.T) * D + c];
        p.o0[gid] = v; ((nvbf*)p.o1)[gid] = nv_f2bf(v); } break;
    case OP_GEMM: {
        int N4 = p.i0 >> 2, K = p.i1; int m = (int)(gid / N4), nn = (int)(gid % N4) * 4; const float* A = p.a + (size_t)m * p.i2; const float* Bw = p.b + nn; float c0 = 0.f, c1 = 0.f, c2 = 0.f, c3 = 0.f;
        for (int k = 0; k < K; ++k) { float av = A[k]; if (p.i5 == 1) av = NV_TANH(av); else if (p.i5 == 2) av = nv_sigmoid(av); const NvF4 bv = *(const NvF4*)(Bw + (size_t)k * p.i3);
            c0 = fmaf(av, bv.x, c0); c1 = fmaf(av, bv.y, c1); c2 = fmaf(av, bv.z, c2); c3 = fmaf(av, bv.w, c3); }
        float* C = p.o0 + (size_t)m * p.i4 + nn; C[0] = c0; C[1] = c1; C[2] = c2; C[3] = c3; } break;
    case OP_LOGA: {
        int row = (int)(gid / 256), c = (int)(gid % 256); float z = p.c[c];
        for (int r = 0; r < 16; ++r) z = fmaf(p.a[(size_t)row * MIXIN + C_GLR + r], p.b[r * 256 + c], z);
        p.o0[gid] = NV_EXP(-nv_softplus(-z) * (1.f / 16.f)); } break;
    case OP_GLAF:
    case OP_GLA: {
        int s = (int)(gid / 512), h = (int)((gid / 128) % 4), col = (int)(gid % 128);
        float S[64];
        const float* sin = (s < dm.B) ? nullptr : p.c + (((size_t)(s - dm.B) * 4 + h) * 64) * 128 + col;
#pragma unroll
        for (int k = 0; k < 64; ++k) S[k] = sin ? sin[(size_t)k * 128] : 0.f;
        int r0 = seq_row0(dm, s), L = seq_len(dm, s);
        for (int t = 0; t < L; ++t) {
            const float* pr = p.a + (size_t)(r0 + t) * MIXIN; const float* la = p.b + (size_t)(r0 + t) * 256 + h * 64;
            float v = pr[C_V + h * 128 + col], o = 0.f;
#pragma unroll
            for (int k = 0; k < 64; ++k) { if ((k & 7) == 0) NV_FENCE(); S[k] = fmaf(la[k], S[k], pr[C_K + h * 64 + k] * v); o = fmaf(pr[C_Q + h * 64 + k] * 0.125f, S[k], o); }
            p.o0[(size_t)(r0 + t) * 512 + h * 128 + col] = o;
        }
        float* so = (s < dm.B) ? PO1 + (((size_t)s * 4 + h) * 64) * 128 + col : PO2 + (((size_t)(s - dm.B) * 4 + h) * 64) * 128 + col;
#pragma unroll
        for (int k = 0; k < 64; ++k) so[(size_t)k * 128] = S[k]; } break;
    case OP_GLA1: {
        const int NC = p.i0; const int u = NV_UNI((int)(gid / 128)), col = (int)(gid % 128); const int s = u / (4 * NC), h = (u / NC) % 4, c = u % NC;
        const int r0 = seq_row0(dm, s) + c * 64; int L = dm.T - c * 64; L = L > 64 ? 64 : L;
        float S[64];
#pragma unroll
        for (int k = 0; k < 64; ++k) S[k] = 0.f;
        float dprod = 1.f;
        for (int t = 0; t < L; ++t) {
            const float* pr = p.a + (size_t)(r0 + t) * MIXIN; const float* la = p.b + (size_t)(r0 + t) * 256 + h * 64; const float v = pr[C_V + h * 128 + col];
            if (col < 64) dprod *= la[col];
#pragma unroll
            for (int k = 0; k < 64; ++k) { if ((k & 7) == 0) NV_FENCE(); S[k] = fmaf(la[k], S[k], pr[C_K + h * 64 + k] * v); }
        }
        float* so = p.o0 + (size_t)u * 8192 + col;
#pragma unroll
        for (int k = 0; k < 64; ++k) so[(size_t)k * 128] = S[k];
        if (col < 64) p.o1[(size_t)u * 64 + col] = dprod; } break;
    case OP_GLA2: {
        const int NC = p.i0; const int pair = (int)(gid / 8192), e = (int)(gid % 8192), dk = e / 128; float S = 0.f;
        for (int c = 0; c < NC; ++c) { const size_t ix = ((size_t)pair * NC + c) * 8192 + e; const float l = p.o0[ix]; p.o0[ix] = S; S = fmaf(p.a[((size_t)pair * NC + c) * 64 + dk], S, l); }
        p.o1[gid] = S; } break;
    case OP_GLA3: {
        const int NC = p.i0; const int NP = dm.B * 4 * NC; const int u = NV_UNI((int)(gid / 128)) + (p.i1 ? NP : 0), col = (int)(gid % 128); int s, h, r0, L; const float* sin; float* sout = nullptr;
        if (u < NP) { s = u / (4 * NC); h = (u / NC) % 4; const int c = u % NC; r0 = seq_row0(dm, s) + c * 64; L = dm.T - c * 64; L = L > 64 ? 64 : L; sin = p.d + (size_t)u * 8192 + col; }
        else { const int q = u - NP; s = dm.B + q / 4; h = q % 4; r0 = seq_row0(dm, s); L = dm.DT; sin = p.c + (((size_t)(s - dm.B) * 4 + h) * 64) * 128 + col; sout = p.o2 + (((size_t)(s - dm.B) * 4 + h) * 64) * 128 + col; }
        float S[64];
#pragma unroll
        for (int k = 0; k < 64; ++k) S[k] = sin[(size_t)k * 128];
        for (int t = 0; t < L; ++t) {
            const float* pr = p.a + (size_t)(r0 + t) * MIXIN; const float* la = p.b + (size_t)(r0 + t) * 256 + h * 64; const float v = pr[C_V + h * 128 + col]; float o = 0.f;
#pragma unroll
            for (int k = 0; k < 64; ++k) { if ((k & 7) == 0) NV_FENCE(); S[k] = fmaf(la[k], S[k], pr[C_K + h * 64 + k] * v); o = fmaf(pr[C_Q + h * 64 + k] * 0.125f, S[k], o); }
            p.o0[(size_t)(r0 + t) * 512 + h * 128 + col] = o;
        }
        if (sout) {
#pragma unroll
            for (int k = 0; k < 64; ++k) sout[(size_t)k * 128] = S[k]; } } break;
    case OP_LRU1: {
        const int NC = p.i0; const int u = (int)(gid / 512), c = (int)(gid % 512); const int s = u / NC, ch = u % NC; const int r0 = seq_row0(dm, s) + ch * 64; int L = dm.T - ch * 64; L = L > 64 ? 64 : L; float hh = 0.f, ap = 1.f;
#pragma unroll 16
        for (int t = 0; t < L; ++t) { const size_t ix = (size_t)(r0 + t) * 512 + c; const float a = p.a[ix]; hh = fmaf(a, hh, p.b[ix]); ap *= a; }
        p.o0[gid] = ap; p.o1[gid] = hh; } break;
    case OP_LRU2: {
        const int NC = p.i0; const int s = (int)(gid / 512), c = (int)(gid % 512); float hh = 0.f;
#pragma unroll 8
        for (int ch = 0; ch < NC; ++ch) { const size_t ix = ((size_t)s * NC + ch) * 512 + c; const float l = p.o0[ix]; p.o0[ix] = hh; hh = fmaf(p.a[ix], hh, l); }
        p.o1[gid] = hh; } break;
    case OP_LRU3: {
        const int NC = p.i0; const int u = (int)(gid / 512), c = (int)(gid % 512); const int NP = dm.B * NC; int r0, L; float hh; float* hout = nullptr;
        if (u < NP) { const int s = u / NC, ch = u % NC; r0 = seq_row0(dm, s) + ch * 64; L = dm.T - ch * 64; L = L > 64 ? 64 : L; hh = 0.f;
            for (int k0 = 0; k0 < ch; k0 += 16) { float la[16], lb[16];
#pragma unroll
                for (int k = 0; k < 16; ++k) { int kk = k0 + k; kk = kk < ch ? kk : ch - 1; const size_t ix = ((size_t)s * NC + kk) * 512 + c; la[k] = p.f[ix]; lb[k] = p.e[ix]; }
#pragma unroll
                for (int k = 0; k < 16; ++k) if (k0 + k < ch) hh = fmaf(la[k], hh, lb[k]); }
            if (ch == NC - 1) hout = p.o1 + (size_t)s * 512 + c; }
        else { const int q = u - NP; r0 = seq_row0(dm, dm.B + q); L = dm.DT; hh = p.d[(size_t)q * 512 + c]; hout = p.o2 + (size_t)q * 512 + c; }
        for (int t0 = 0; t0 < L; t0 += 16) {
            float av[16], bv[16], gv[16];
#pragma unroll
            for (int k = 0; k < 16; ++k) { int t = t0 + k; t = t < L ? t : L - 1; const size_t r = (size_t)(r0 + t); av[k] = p.a[r * 512 + c]; bv[k] = p.b[r * 512 + c]; gv[k] = p.c[r * MIXIN + C_GB + c]; }
#pragma unroll
            for (int k = 0; k < 16; ++k) if (t0 + k < L) { const size_t r = (size_t)(r0 + t0 + k); hh = fmaf(av[k], hh, bv[k]); ((nvbf*)p.o0)[r * 1024 + 512 + c] = nv_f2bf(hh * nv_gelu(gv[k])); } }
        if (hout) *hout = hh; } break;
    case OP_EMBED4: {
        const int D4 = D / 4; const int row = (int)(gid / D4), c = (int)(gid % D4) * 4; const float* src;
        if (row < dm.B * dm.T) { const int bb = row / dm.T, t = row % dm.T; src = t < 16 ? p.c + (size_t)t * D + c : p.a + ((size_t)bb * (dm.T - 16) + (t - 16)) * D + c; } else src = p.b + (size_t)(row - dm.B * dm.T) * D + c;
        const NvF4 v = *(const NvF4*)src; NvU2 w; w.x = nv_f2bf(v.x) | ((unsigned)nv_f2bf(v.y) << 16); w.y = nv_f2bf(v.z) | ((unsigned)nv_f2bf(v.w) << 16); *(NvU2*)((nvbf*)p.o1 + (size_t)row * D + c) = w; } break;
    case OP_YOUT4: {
        const int D4 = D / 4; const int row = (int)(gid / D4), c = (int)(gid % D4) * 4; const NvU2 w_ = *(const NvU2*)((const nvbf*)p.a + (size_t)row * D + c); NvF4 v; v.x = nv_bf2f((nvbf)(w_.x & 0xffffu)); v.y = nv_bf2f((nvbf)(w_.x >> 16)); v.z = nv_bf2f((nvbf)(w_.y & 0xffffu)); v.w = nv_bf2f((nvbf)(w_.y >> 16));
        if (row < dm.B * dm.T) { const int bb = row / dm.T, t = row % dm.T; if (t >= 16) *(NvF4*)(p.o0 + ((size_t)bb * (dm.T - 16) + (t - 16)) * D + c) = v; }
        else *(NvF4*)(p.o0 + ((size_t)dm.B * (dm.T - 16) + (row - dm.B * dm.T)) * D + c) = v; } break;
    case OP_MIX8: {
        const int D8 = D / 8; const int row = (int)(gid / D8), c = (int)(gid % D8) * 8; int s, t; row_to_seq(dm, row, s, t); const float* x = p.a + (size_t)row * D + c; float xp[8];
        if (t > 0) { for (int i = 0; i < 8; ++i) xp[i] = x[i - D]; } else if (s < dm.B) { for (int i = 0; i < 8; ++i) xp[i] = 0.f; } else { for (int i = 0; i < 8; ++i) xp[i] = p.b[(size_t)(s - dm.B) * D + c + i]; }
        unsigned w[4];
#pragma unroll
        for (int i = 0; i < 4; ++i) { const float lo = x[2 * i] + (xp[2 * i] - x[2 * i]) * p.c[c + 2 * i], hi = x[2 * i + 1] + (xp[2 * i + 1] - x[2 * i + 1]) * p.c[c + 2 * i + 1]; w[i] = nv_f2bf(lo) | ((unsigned)nv_f2bf(hi) << 16); }
        NvU4 o; o.x = w[0]; o.y = w[1]; o.z = w[2]; o.w = w[3]; *(NvU4*)((nvbf*)p.o0 + (size_t)row * D + c) = o; } break;
    case OP_MIX6: {
        const int D8 = D / 8, Q = (dm.M + 3) / 4; const int row0 = (int)(gid / D8), c = (int)(gid % D8) * 8; NvU4 xw[4], pw[4]; NvF4 sh0[4], sh1[4]; int kind[4];
#pragma unroll
        for (int q = 0; q < 4; ++q) { int row = row0 + q * Q; row = row < dm.M ? row : row0; int s, t; row_to_seq(dm, row, s, t); const nvbf* x = (const nvbf*)p.a + (size_t)row * D + c;
            kind[q] = t > 0 ? 0 : (s < dm.B ? 1 : 2); xw[q] = *(const NvU4*)x; pw[q] = *(const NvU4*)(x - (t > 0 ? D : 0));
            const float* sp = p.b + (size_t)(s >= dm.B ? s - dm.B : 0) * D + c; sh0[q] = *(const NvF4*)sp; sh1[q] = *(const NvF4*)(sp + 4); }
        NvF4 mu0[6], mu1[6];
#pragma unroll
        for (int m = 0; m < 6; ++m) { mu0[m] = *(const NvF4*)(p.c + (size_t)m * D + c); mu1[m] = *(const NvF4*)(p.c + (size_t)m * D + c + 4); }
#pragma unroll
        for (int q = 0; q < 4; ++q) { const int row = row0 + q * Q; if (row < dm.M) { float xv[8], dx[8]; const unsigned xs[4] = {xw[q].x, xw[q].y, xw[q].z, xw[q].w}, ps[4] = {pw[q].x, pw[q].y, pw[q].z, pw[q].w};
            const float shv[8] = {sh0[q].x, sh0[q].y, sh0[q].z, sh0[q].w, sh1[q].x, sh1[q].y, sh1[q].z, sh1[q].w};
#pragma unroll
            for (int i = 0; i < 4; ++i) { xv[2 * i] = nv_bf2f((nvbf)(xs[i] & 0xffffu)); xv[2 * i + 1] = nv_bf2f((nvbf)(xs[i] >> 16)); const float p0 = nv_bf2f((nvbf)(ps[i] & 0xffffu)), p1 = nv_bf2f((nvbf)(ps[i] >> 16));
                const float q0 = kind[q] == 0 ? p0 : (kind[q] == 1 ? 0.f : shv[2 * i]), q1 = kind[q] == 0 ? p1 : (kind[q] == 1 ? 0.f : shv[2 * i + 1]); dx[2 * i] = q0 - xv[2 * i]; dx[2 * i + 1] = q1 - xv[2 * i + 1]; }
#pragma unroll
            for (int m = 0; m < 6; ++m) { const float mv[8] = {mu0[m].x, mu0[m].y, mu0[m].z, mu0[m].w, mu1[m].x, mu1[m].y, mu1[m].z, mu1[m].w}; unsigned w[4];
#pragma unroll
                for (int i = 0; i < 4; ++i) w[i] = nv_f2bf(xv[2 * i] + dx[2 * i] * mv[2 * i]) | ((unsigned)nv_f2bf(xv[2 * i + 1] + dx[2 * i + 1] * mv[2 * i + 1]) << 16);
                NvU4 o; o.x = w[0]; o.y = w[1]; o.z = w[2]; o.w = w[3]; *(NvU4*)((nvbf*)p.o0 + (size_t)m * (size_t)p.i1 * 1024 + (size_t)row * D + c) = o; } } } } break;
    case OP_CONV4: {
        const int Q = (dm.M + 3) / 4; const int row0 = (int)(gid / 128), c = (int)(gid % 128) * 4; const NvF4 bias = *(const NvF4*)(p.d + c); NvF4 wt[4]; for (int i = 0; i < 4; ++i) wt[i] = *(const NvF4*)(p.c + i * 512 + c);
        NvF4 xv[4][4]; int ok[4];
#pragma unroll
        for (int q = 0; q < 4; ++q) { int row = row0 + q * Q; ok[q] = row < dm.M; row = ok[q] ? row : row0; int s, t; row_to_seq(dm, row, s, t);
#pragma unroll
            for (int i = 0; i < 4; ++i) { const int j = t + i; const int sb = s >= dm.B ? s - dm.B : 0, jb = j < 3 ? j : 0;
                const float* src = j >= 3 ? p.a + (size_t)(row - t + (j - 3)) * MIXIN + C_XB + c : p.b + ((size_t)sb * 3 + jb) * 512 + c; const float msk = (j >= 3 || s >= dm.B) ? 1.f : 0.f;
                const NvF4 v = *(const NvF4*)src; xv[q][i].x = v.x * msk; xv[q][i].y = v.y * msk; xv[q][i].z = v.z * msk; xv[q][i].w = v.w * msk; } }
#pragma unroll
        for (int q = 0; q < 4; ++q) if (ok[q]) { const int row = row0 + q * Q; NvF4 o = bias;
#pragma unroll
            for (int i = 0; i < 4; ++i) { o.x = fmaf(xv[q][i].x, wt[i].x, o.x); o.y = fmaf(xv[q][i].y, wt[i].y, o.y); o.z = fmaf(xv[q][i].z, wt[i].z, o.z); o.w = fmaf(xv[q][i].w, wt[i].w, o.w); }
            NvU2 w; w.x = nv_f2bf(o.x) | ((unsigned)nv_f2bf(o.y) << 16); w.y = nv_f2bf(o.z) | ((unsigned)nv_f2bf(o.w) << 16); *(NvU2*)((nvbf*)p.o1 + (size_t)row * 512 + c) = w; } } break;
    case OP_CVT8: {
        const int K8 = p.i2 / 8; const int row = (int)(gid / K8), k = (int)(gid % K8) * 8; unsigned w[4] = {0u, 0u, 0u, 0u};
        if (row < dm.M && k < p.i0) { const float* sp = p.a + (size_t)row * p.i1 + k;
#pragma unroll
            for (int i = 0; i < 4; ++i) { float lo = sp[2 * i], hi = sp[2 * i + 1]; if (p.i3 == 1) { lo = NV_TANH(lo); hi = NV_TANH(hi); } else if (p.i3 == 2) { lo = nv_sigmoid(lo); hi = nv_sigmoid(hi); } w[i] = nv_f2bf(lo) | ((unsigned)nv_f2bf(hi) << 16); } }
        NvU4 o; o.x = w[0]; o.y = w[1]; o.z = w[2]; o.w = w[3]; *(NvU4*)((nvbf*)p.o0 + (size_t)row * p.i2 + k) = o; } break;
    case OP_WGATE: {
        const int ch = (int)(gid % 64), n = (int)(gid / 64), pn = n >> 8, within = n & 127, isx = (n >> 7) & 1, c = pn * 128 + within, nb = c >> 6, e = c & 63, k0 = ch * 8; const float* w = isx ? p.b : p.a; NvU4 o; o.x = o.y = o.z = o.w = 0u;
        if ((k0 >> 6) == nb) { float v[8];
#pragma unroll
            for (int i = 0; i < 8; ++i) v[i] = w[((size_t)nb * 64 + ((k0 + i) & 63)) * 64 + e];
            o.x = nv_f2bf(v[0]) | ((unsigned)nv_f2bf(v[1]) << 16); o.y = nv_f2bf(v[2]) | ((unsigned)nv_f2bf(v[3]) << 16); o.z = nv_f2bf(v[4]) | ((unsigned)nv_f2bf(v[5]) << 16); o.w = nv_f2bf(v[6]) | ((unsigned)nv_f2bf(v[7]) << 16); }
        *(NvU4*)((nvbf*)p.o0 + (size_t)n * 512 + k0) = o;
        if (ch == 0 && n < 512) p.o1[n] = -8.f * nv_softplus(-p.c[n]); } break;
    case OP_LRUG2: {
        const int row = (int)(gid / 512), c = (int)(gid % 512), pn = c >> 7, within = c & 127; const nvbf* x = (const nvbf*)p.a + (size_t)row * 512; const nvbf* wa_ = (const nvbf*)p.b + (size_t)(pn * 256 + within) * 512; const nvbf* wx_ = wa_ + (size_t)128 * 512; float ga = 0.f, gx = 0.f;
        for (int k = 0; k < 512; ++k) { const float xv = nv_bf2f(x[k]); ga = fmaf(xv, nv_bf2f(wa_[k]), ga); gx = fmaf(xv, nv_bf2f(wx_[k]), gx); }
        const float gate_a = nv_sigmoid(ga + p.c[c]), gate_x = nv_sigmoid(gx + p.d[c]); const float log_at = gate_a * p.e[c];
        p.o0[gid] = NV_EXP(log_at); p.o1[gid] = sqrtf(-expm1f(2.f * log_at)) * (gate_x * nv_bf2f(((const nvbf*)p.f)[gid])); } break;
    case OP_LOGA4: {
        const int row = (int)(gid / 64), c = (int)(gid % 64) * 4; const float* gl = p.a + (size_t)row * MIXIN + C_GLR; NvF4 z = *(const NvF4*)(p.c + c);
#pragma unroll
        for (int r4 = 0; r4 < 4; ++r4) { const NvF4 g = *(const NvF4*)(gl + 4 * r4);
            const NvF4 w0 = *(const NvF4*)(p.b + (4 * r4 + 0) * 256 + c), w1 = *(const NvF4*)(p.b + (4 * r4 + 1) * 256 + c), w2 = *(const NvF4*)(p.b + (4 * r4 + 2) * 256 + c), w3 = *(const NvF4*)(p.b + (4 * r4 + 3) * 256 + c);
            z.x = fmaf(g.x, w0.x, z.x); z.y = fmaf(g.x, w0.y, z.y); z.z = fmaf(g.x, w0.z, z.z); z.w = fmaf(g.x, w0.w, z.w); z.x = fmaf(g.y, w1.x, z.x); z.y = fmaf(g.y, w1.y, z.y); z.z = fmaf(g.y, w1.z, z.z); z.w = fmaf(g.y, w1.w, z.w);
            z.x = fmaf(g.z, w2.x, z.x); z.y = fmaf(g.z, w2.y, z.y); z.z = fmaf(g.z, w2.z, z.z); z.w = fmaf(g.z, w2.w, z.w); z.x = fmaf(g.w, w3.x, z.x); z.y = fmaf(g.w, w3.y, z.y); z.z = fmaf(g.w, w3.z, z.z); z.w = fmaf(g.w, w3.w, z.w); }
        NvF4 o; o.x = NV_EXP(-nv_softplus(-z.x) * (1.f / 16.f)); o.y = NV_EXP(-nv_softplus(-z.y) * (1.f / 16.f)); o.z = NV_EXP(-nv_softplus(-z.z) * (1.f / 16.f)); o.w = NV_EXP(-nv_softplus(-z.w) * (1.f / 16.f));
        *(NvF4*)(p.o0 + (size_t)row * 256 + c) = o; } break;
    case OP_GLANORM: {
        int row = (int)(gid / 4), h = (int)(gid % 4); const float* o = p.a + (size_t)row * 512 + h * 128; float ss = 0.f;
        for (int c = 0; c < 128; ++c) ss = fmaf(o[c], o[c], ss);
        float rs = 1.f / sqrtf(ss * (1.f / 128.f) + 1e-5f);
        for (int c = 0; c < 128; ++c) { float r = p.b[(size_t)row * MIXIN + C_R + h * 128 + c]; ((nvbf*)p.o0)[(size_t)row * 1024 + h * 128 + c] = nv_f2bf(o[c] * rs * p.c[c] * (r * nv_sigmoid(r))); } } break;
    case OP_CONV: {
        int row = (int)(gid / 512), c = (int)(gid % 512); int s, t; row_to_seq(dm, row, s, t); float acc = p.d[c];
        for (int i = 0; i < 4; ++i) { int j = t + i; float xv;
            if (j < 3) xv = (s < dm.B) ? 0.f : p.b[((size_t)(s - dm.B) * 3 + j) * 512 + c]; else xv = p.a[(size_t)(row - t + (j - 3)) * MIXIN + C_XB + c];
            acc = fmaf(xv, p.c[i * 512 + c], acc); }
        p.o0[gid] = acc; } break;
    case OP_CONVOUT: {
        int s = (int)(gid / 1536), i = (int)((gid / 512) % 3), c = (int)(gid % 512); int L = seq_len(dm, s), r0 = seq_row0(dm, s); int j = L + i; float xv;
        if (j < 3) xv = (s < dm.B) ? 0.f : p.b[((size_t)(s - dm.B) * 3 + j) * 512 + c]; else xv = p.a[(size_t)(r0 + j - 3) * MIXIN + C_XB + c];
        float* o = (s < dm.B) ? PO1 + ((size_t)s * 3 + i) * 512 + c : PO2 + ((size_t)(s - dm.B) * 3 + i) * 512 + c; *o = xv; } break;
    case OP_LRUG: {
        int row = (int)(gid / 512), c = (int)(gid % 512), nb = c / 64, e = c % 64; const float* x = p.a + (size_t)row * 512 + nb * 64; float ga = p.c[c], gx = p.e[c];
        for (int dd = 0; dd < 64; ++dd) { ga = fmaf(x[dd], p.b[((size_t)nb * 64 + dd) * 64 + e], ga); gx = fmaf(x[dd], p.d[((size_t)nb * 64 + dd) * 64 + e], gx); }
        float gate_a = nv_sigmoid(ga), gate_x = nv_sigmoid(gx); float log_at = -8.f * gate_a * nv_softplus(-p.f[c]);
        p.o0[gid] = NV_EXP(log_at); p.o1[gid] = sqrtf(-expm1f(2.f * log_at)) * (gate_x * p.a[(size_t)row * 512 + c]); } break;
    case OP_LRUSCAN: {
        int s = (int)(gid / 512), c = (int)(gid % 512); int r0 = seq_row0(dm, s), L = seq_len(dm, s); float hh = (s < dm.B) ? 0.f : p.d[(size_t)(s - dm.B) * 512 + c];
        for (int t = 0; t < L; ++t) { size_t r = (size_t)(r0 + t); hh = fmaf(p.a[r * 512 + c], hh, p.b[r * 512 + c]); p.o0[r * 1024 + 512 + c] = hh * nv_gelu(p.c[r * MIXIN + C_GB + c]); }
        float* o = (s < dm.B) ? PO1 + (size_t)s * 512 + c : PO2 + (size_t)(s - dm.B) * 512 + c; *o = hh; } break;
    case OP_LNRES: {
        const float alpha = 1.6817928305074292f; nvbf* x = (nvbf*)p.o1 + (size_t)gid * D; const nvbf* y = (const nvbf*)p.a + (size_t)gid * D; float mu = 0.f;
        for (int c = 0; c < D; ++c) mu += alpha * nv_bf2f(x[c]) + nv_bf2f(y[c]);
        mu /= D; float var = 0.f;
        for (int c = 0; c < D; ++c) { float v = alpha * nv_bf2f(x[c]) + nv_bf2f(y[c]) - mu; var = fmaf(v, v, var); }
        float rs = 1.f / sqrtf(var / D + 1e-5f);
        for (int c = 0; c < D; ++c) { const float o = (alpha * nv_bf2f(x[c]) + nv_bf2f(y[c]) - mu) * rs * p.b[c] + p.c[c]; x[c] = nv_f2bf(o);
            if (p.o2) { unsigned char* f8 = (unsigned char*)p.o2 + (size_t)gid * 2 * D; const float xs = fminf(fmaxf(o * 16.f, -448.f), 448.f); const unsigned hc = nv_f2e4m3(xs); f8[c] = (unsigned char)hc; f8[D + c] = (unsigned char)nv_f2e4m3(xs - nv_e4m32f(hc)); } } } break;
    case OP_MIX: {
        int row = (int)(gid / D), c = (int)(gid % D); int s, t; row_to_seq(dm, row, s, t); float x = p.a[gid];
        float xp = t > 0 ? p.a[gid - D] : ((s < dm.B) ? 0.f : p.b[(size_t)(s - dm.B) * D + c]);
        ((nvbf*)p.o0)[gid] = nv_f2bf(x + (xp - x) * p.c[c]); } break;
    case OP_SHIFTOUT: {
        int s = (int)(gid / D), c = (int)(gid % D); float v = nv_bf2f(((const nvbf*)p.a)[(size_t)(seq_row0(dm, s) + seq_len(dm, s) - 1) * D + c]);
        float* o = (s < dm.B) ? PO1 + (size_t)s * D + c : PO2 + (size_t)(s - dm.B) * D + c; *o = v; } break;
    case OP_RWKVPREP: {
        int row = (int)(gid / dm.RH), h = (int)(gid % dm.RH); size_t base = (size_t)row * D + h * 64; float ss = 0.f;
        for (int k = 0; k < 64; ++k) { float kv = p.o0[base + k] * p.d[h * 64 + k]; ss = fmaf(kv, kv, ss); }
        float inv = 1.f / fmaxf(sqrtf(ss), 1e-12f);
        for (int k = 0; k < 64; ++k) { int c = h * 64 + k; size_t ix = base + k;
            float w = -nv_softplus(-(p.a[c] + p.o1[ix])) - 0.5f; float dec = NV_EXP(-NV_EXP(w));
            float a = nv_sigmoid(p.b[c] + p.o2[ix]);
            float v = p.o3[ix]; if (p.i0) v = v + (p.o5[ix] - v) * nv_sigmoid(p.c[c] + p.f[ix]); else p.o5[ix] = v;
            float k0 = p.o0[ix]; const float kk = k0 * p.d[c] * inv; p.o4[ix] = -kk; p.o0[ix] = k0 * (1.f + (a - 1.f) * p.e[c]); p.o1[ix] = dec; p.o2[ix] = kk * a; p.o3[ix] = v; } } break;
    case OP_WKVF:
    case OP_WKV: {
        int RH = dm.RH; int s = p.i0 + (int)(gid / (RH * 64)), h = (int)((gid / 64) % RH), vr = (int)(gid % 64); float S[64];
        const float* sin = (s < dm.B) ? nullptr : p.g + (((size_t)(s - dm.B) * RH + h) * 64 + vr) * 64;
#pragma unroll
        for (int k = 0; k < 64; ++k) S[k] = sin ? sin[k] : 0.f;
        int r0 = seq_row0(dm, s), L = seq_len(dm, s);
        for (int t = 0; t < L; ++t) { size_t base = (size_t)(r0 + t) * D + h * 64; float sa = 0.f;
#pragma unroll
            for (int k = 0; k < 64; ++k) { if ((k & 7) == 0) NV_FENCE(); sa = fmaf(S[k], p.f[base + k], sa); }
            float vv = p.d[base + vr], y = 0.f;
#pragma unroll
            for (int k = 0; k < 64; ++k) { if ((k & 7) == 0) NV_FENCE(); S[k] = fmaf(S[k], p.b[base + k], fmaf(sa, p.e[base + k], vv * p.c[base + k])); y = fmaf(S[k], p.a[base + k], y); }
            p.o0[base + vr] = y; }
        float* so = (s < dm.B) ? PO1 + (((size_t)s * RH + h) * 64 + vr) * 64 : PO2 + (((size_t)(s - dm.B) * RH + h) * 64 + vr) * 64;
#pragma unroll
        for (int k = 0; k < 64; ++k) so[k] = S[k]; } break;
    case OP_RWKVPOST: {
        int row = (int)(gid / dm.RH), h = (int)(gid % dm.RH); size_t base = (size_t)row * D + h * 64; float mu = 0.f, bon = 0.f;
        for (int k = 0; k < 64; ++k) { mu += p.a[base + k]; bon = fmaf(p.b[base + k] * p.c[base + k], p.f[h * 64 + k], bon); }
        mu *= (1.f / 64.f); float var = 0.f;
        for (int k = 0; k < 64; ++k) { float dlt = p.a[base + k] - mu; var = fmaf(dlt, dlt, var); }
        float rs = 1.f / sqrtf(var * (1.f / 64.f) + 64e-5f);
        for (int k = 0; k < 64; ++k) { int c = h * 64 + k; float y = (p.a[base + k] - mu) * rs * p.g[c] + p.h[c] + bon * p.d[base + k]; ((nvbf*)p.o0)[base + k] = nv_f2bf(y * p.e[base + k]); } } break;
    case OP_PRM: {
        const int m = (int)(gid / D), c = (int)(gid % D); const float* src = m == 0 ? p.a : m == 1 ? p.b : m == 2 ? p.c : m == 3 ? p.d : m == 4 ? p.e : p.f; p.o0[gid] = src ? src[c] : 0.f; } break;
    case OP_WKVP: {
        const int RH = dm.RH; const int s = (int)(gid / (RH * 64)), h = (int)((gid / 64) % RH), vr = (int)(gid % 64); float S[64];
        const float* sin = (s < dm.B) ? nullptr : p.o5 + (((size_t)(s - dm.B) * RH + h) * 64 + vr) * 64;
        for (int k = 0; k < 64; ++k) S[k] = sin ? sin[k] : 0.f;
        const float* w0 = p.h + h * 64; const float* a0 = p.h + D + h * 64; const float* v0 = p.h + 2 * D + h * 64; const float* k_k = p.h + 3 * D + h * 64; const float* k_a = p.h + 4 * D + h * 64; const float* r_k = p.h + 5 * D + h * 64;
        const int r0 = seq_row0(dm, s), L = seq_len(dm, s); const nvbf* bR = (const nvbf*)p.a; const nvbf* bK = (const nvbf*)p.b; const nvbf* bWL = (const nvbf*)p.c; const nvbf* bAL = (const nvbf*)p.d; const nvbf* bV = (const nvbf*)p.e; const nvbf* bVG = (const nvbf*)p.f;
        for (int t = 0; t < L; ++t) { const size_t base = (size_t)(r0 + t) * D + h * 64; float ss = 0.f;
            for (int k = 0; k < 64; ++k) { const float kv = nv_bf2f(bK[base + k]) * k_k[k]; ss = fmaf(kv, kv, ss); }
            const float inv = 1.f / fmaxf(sqrtf(ss), 1e-12f);
            float vv = nv_bf2f(bV[base + vr]); if (p.i0) vv = vv + (nv_bf2f(((const nvbf*)p.g)[base + vr]) - vv) * nv_sigmoid(v0[vr] + nv_bf2f(bVG[base + vr]));
            float sa = 0.f, bon = 0.f, dec[64], bb[64], k2[64];
            for (int k = 0; k < 64; ++k) { const float k0 = nv_bf2f(bK[base + k]); const float kk = k0 * k_k[k] * inv; const float a = nv_sigmoid(a0[k] + nv_bf2f(bAL[base + k]));
                dec[k] = NV_EXP(-0.6065306597126334f * nv_sigmoid(w0[k] + nv_bf2f(bWL[base + k])));
                bb[k] = kk * a; k2[k] = k0 * (1.f + (a - 1.f) * k_a[k]); sa = fmaf(S[k], -kk, sa); bon = fmaf(nv_bf2f(bR[base + k]) * k2[k], r_k[k], bon); }
            float y = 0.f;
            for (int k = 0; k < 64; ++k) { S[k] = fmaf(S[k], dec[k], fmaf(sa, bb[k], vv * k2[k])); y = fmaf(S[k], nv_bf2f(bR[base + k]), y); }
            ((nvbf*)p.o0)[base + vr] = nv_f2bf(y); ((nvbf*)p.o3)[base + vr] = nv_f2bf(vv); if (vr == 0) p.o4[(size_t)(r0 + t) * RH + h] = bon; }
        float* so = (s < dm.B) ? PO1 + (((size_t)s * RH + h) * 64 + vr) * 64 : PO2 + (((size_t)(s - dm.B) * RH + h) * 64 + vr) * 64;
        for (int k = 0; k < 64; ++k) so[k] = S[k]; } break;
    case OP_POST2: {
        const int row = (int)(gid / dm.RH), h = (int)(gid % dm.RH); const size_t base = (size_t)row * D + h * 64; const nvbf* ya = (const nvbf*)p.a; const nvbf* vf = (const nvbf*)p.c; float mu = 0.f;
        for (int k = 0; k < 64; ++k) mu += nv_bf2f(ya[base + k]);
        mu *= (1.f / 64.f); float var = 0.f;
        for (int k = 0; k < 64; ++k) { const float dlt = nv_bf2f(ya[base + k]) - mu; var = fmaf(dlt, dlt, var); }
        const float rs = 1.f / sqrtf(var * (1.f / 64.f) + 64e-5f), bon = p.d[gid];
        for (int k = 0; k < 64; ++k) { const int c = h * 64 + k; const float y = (nv_bf2f(ya[base + k]) - mu) * rs * p.e[c] + p.f[c] + bon * nv_bf2f(vf[base + k]); ((nvbf*)p.o0)[base + k] = nv_f2bf(y * nv_bf2f(((const nvbf*)p.b)[base + k])); } } break;
    case OP_QNORM: {
        float* q = p.o0 + (size_t)gid * 256; float mu = 0.f;
        for (int c = 0; c < 256; ++c) mu += q[c];
        mu *= (1.f / 256.f); float var = 0.f;
        for (int c = 0; c < 256; ++c) { float dlt = q[c] - mu; var = fmaf(dlt, dlt, var); }
        float rs = 1.f / sqrtf(var * (1.f / 256.f) + 1e-5f);
        for (int c = 0; c < 256; ++c) q[c] = (q[c] - mu) * rs; } break;
    case OP_SCORES: {
        int row = (int)(gid / 2048), r = (int)(gid % 2048), h = r / 256, half = (r / 128) & 1, key = r % 128;
        const float* q = p.a + (size_t)row * 2048 + h * 256 + half * 128; const float* kv = p.b + (((size_t)h * 2 + half) * 128 + key) * 128; float acc = 0.f;
        for (int dd = 0; dd < 128; ++dd) acc = fmaf(q[dd], kv[dd], acc);
        p.o0[gid] = acc; } break;
    case OP_TOPK: {
        const float* sc = p.a + (size_t)gid * 256; float tv[16]; int ti[16]; float* tmpv = p.o2 + (size_t)gid * 32; int* tmpi = (int*)p.o3 + (size_t)gid * 32;
        for (int half = 0; half < 2; ++half) {
#pragma unroll
            for (int j = 0; j < 16; ++j) { tv[j] = -3.0e38f; ti[j] = 0; }
            for (int k = 0; k < 128; ++k) NV_INS16(tv, ti, sc[half * 128 + k], k);
#pragma unroll
            for (int j = 0; j < 16; ++j) { tmpv[half * 16 + j] = tv[j]; tmpi[half * 16 + j] = ti[j]; }
        }
#pragma unroll
        for (int j = 0; j < 16; ++j) { tv[j] = -3.0e38f; ti[j] = 0; }
        for (int i = 0; i < 16; ++i) for (int j = 0; j < 16; ++j) NV_INS16(tv, ti, tmpv[i] + tmpv[16 + j], tmpi[i] * 128 + tmpi[16 + j]);
        float den = 0.f, ev[16];
#pragma unroll
        for (int j = 0; j < 16; ++j) { ev[j] = NV_EXP(tv[j] - tv[0]); den += ev[j]; }
        float inv = 1.f / den;
#pragma unroll
        for (int j = 0; j < 16; ++j) { p.o0[(size_t)gid * 16 + j] = ev[j] * inv; ((int*)p.o1)[(size_t)gid * 16 + j] = ti[j]; } } break;
    case OP_PACT1: {
        size_t pr = (size_t)(gid / 16); int part = (int)(gid % 16); int row = (int)(pr / 128); int e = ((const int*)p.d)[pr]; int w = D / 16;
        const float* u = p.b + (size_t)e * D + part * w; const float* x = p.a + (size_t)row * D + part * w; float acc = 0.f;
        for (int c = 0; c < w; ++c) acc = fmaf(u[c], x[c], acc);
        p.o0[gid] = acc; } break;
    case OP_PACT2: {
        float acc = 0.f; for (int i = 0; i < 16; ++i) acc += p.a[(size_t)gid * 16 + i];
        p.o0[gid] = p.c[gid] * nv_gelu(acc); } break;
    case OP_POUT: {
        int row = (int)(gid / D), c = (int)(gid % D); float acc = 0.f;
        for (int i = 0; i < 128; ++i) acc = fmaf(p.a[(size_t)row * 128 + i], p.c[(size_t)((const int*)p.b)[(size_t)row * 128 + i] * D + c], acc);
        p.o0[gid] = acc; } break;
    case OP_YOUT: {
        int row = (int)(gid / D), c = (int)(gid % D);
        if (row < dm.B * dm.T) { int bb = row / dm.T, t = row % dm.T; if (t >= 16) p.o0[((size_t)bb * (dm.T - 16) + (t - 16)) * D + c] = p.a[gid]; }
        else p.o0[((size_t)dm.B * (dm.T - 16) + (row - dm.B * dm.T)) * D + c] = p.a[gid]; } break;
    case OP_WT: {
        const int N = p.i0, K = p.i1, Np = p.i3, Kp = p.i4; const long long per8 = (long long)Np * (Kp / 8); const int bt = (int)(gid / per8); const long long r = gid % per8; const int k0 = (int)(r / Np) * 8, nn = (int)(r % Np);
        unsigned w[4];
#pragma unroll
        for (int i = 0; i < 4; ++i) { float lo = 0.f, hi = 0.f; if (nn < N) { if (k0 + 2 * i < K) lo = p.a[((size_t)bt * K + k0 + 2 * i) * p.i2 + nn]; if (k0 + 2 * i + 1 < K) hi = p.a[((size_t)bt * K + k0 + 2 * i + 1) * p.i2 + nn]; } w[i] = nv_f2bf(lo) | ((unsigned)nv_f2bf(hi) << 16); }
        NvU4 o; o.x = w[0]; o.y = w[1]; o.z = w[2]; o.w = w[3];
        *(NvU4*)((nvbf*)p.o0 + (size_t)bt * Np * Kp + (size_t)nn * Kp + k0) = o; } break;
    case OP_CVT: {
        const int Kp = p.i2; const int row = (int)(gid / Kp), k = (int)(gid % Kp); float v = 0.f;
        if (row < dm.M && k < p.i0) { v = p.a[(size_t)row * p.i1 + k]; if (p.i3 == 1) v = NV_TANH(v); else if (p.i3 == 2) v = nv_sigmoid(v); }
        ((nvbf*)p.o0)[gid] = nv_f2bf(v); } break;
    case OP_FGEMM: {
        const int N = p.i0; const int m = (int)(gid / N), nn = (int)(gid % N); const nvbf* A = (const nvbf*)p.a + (size_t)m * p.i2 + ((p.i6 & 2) ? (nn / 256) * 256 : 0); const nvbf* Bt = (const nvbf*)p.b + (size_t)nn * p.i3; float acc = 0.f;
        for (int k = 0; k < p.i1; ++k) acc = fmaf(nv_bf2f(A[k]), nv_bf2f(Bt[k]), acc);
        if (p.i6 & 1) ((nvbf*)p.o0)[(size_t)m * p.i4 + nn] = nv_f2bf(acc); else p.o0[(size_t)m * p.i4 + nn] = acc; } break;
    case OP_CVTTAB: {
        const NvF4 v0 = *(const NvF4*)(p.a + gid * 8), v1 = *(const NvF4*)(p.a + gid * 8 + 4); NvU4 o;
        o.x = nv_f2bf(v0.x) | ((unsigned)nv_f2bf(v0.y) << 16); o.y = nv_f2bf(v0.z) | ((unsigned)nv_f2bf(v0.w) << 16); o.z = nv_f2bf(v1.x) | ((unsigned)nv_f2bf(v1.y) << 16); o.w = nv_f2bf(v1.z) | ((unsigned)nv_f2bf(v1.w) << 16);
        *(NvU4*)((nvbf*)p.o0 + gid * 8) = o; } break;
    case OP_CVTTAB8: {
        const float sc = (float)(1 << p.i0); const float* sp = p.a + gid * 16; unsigned w[4];
#pragma unroll
        for (int q = 0; q < 4; ++q) { const NvF4 v = *(const NvF4*)(sp + 4 * q); w[q] = nv_f2e4m3(v.x * sc) | (nv_f2e4m3(v.y * sc) << 8) | (nv_f2e4m3(v.z * sc) << 16) | (nv_f2e4m3(v.w * sc) << 24); }
        NvU4 o; o.x = w[0]; o.y = w[1]; o.z = w[2]; o.w = w[3]; *(NvU4*)((unsigned char*)p.o0 + gid * 16) = o; } break;
    case OP_CVTTAB8S: {
        const float sc = (float)(1 << p.i0); const int per = D / 16; const int e = (int)(gid / per), c0 = (int)(gid % per) * 16; const float* sp = p.a + (size_t)e * D + c0; unsigned w[4];
#pragma unroll
        for (int q = 0; q < 4; ++q) { const NvF4 v = *(const NvF4*)(sp + 4 * q);
#if defined(__HIP_DEVICE_COMPILE__)
            int pk = __builtin_amdgcn_cvt_pk_fp8_f32(v.x * sc, v.y * sc, 0, false); pk = __builtin_amdgcn_cvt_pk_fp8_f32(v.z * sc, v.w * sc, pk, true); w[q] = (unsigned)pk;
#else
            w[q] = nv_f2e4m3(v.x * sc) | (nv_f2e4m3(v.y * sc) << 8) | (nv_f2e4m3(v.z * sc) << 16) | (nv_f2e4m3(v.w * sc) << 24);
#endif
        }
        NvU4 o; o.x = w[0]; o.y = w[1]; o.z = w[2]; o.w = w[3]; *(NvU4*)((unsigned char*)p.o0 + ((size_t)(c0 >> 7) * 16384 + e) * 128 + (c0 & 127)) = o; } break;
    case OP_PACTS: {
        const long long NP = (long long)dm.M * 128; const int sl = (int)(gid / NP); const long long pr = gid % NP; const int row = (int)(pr / 128); const int e = ((const int*)p.d)[pr] & p.i0;
        const unsigned char* u = (const unsigned char*)p.b + ((size_t)sl * 16384 + e) * 128; const unsigned char* x = (const unsigned char*)p.a + (size_t)row * 2 * D + sl * 128; float acc = 0.f;
        for (int c = 0; c < 128; ++c) acc = fmaf(nv_e4m32f(u[c]), nv_e4m32f(x[c]) + nv_e4m32f(x[D + c]), acc);
        ((nvbf*)p.o0)[gid] = nv_f2bf(acc * (1.f / 16.f)); } break;
    case OP_PRED: {
        const long long NP = (long long)dm.M * 128; const size_t e0 = (size_t)gid * 4; float a0 = 0.f, a1 = 0.f, a2 = 0.f, a3 = 0.f;
#pragma unroll 8
        for (int sl = 0; sl < p.i0; ++sl) { const NvU2 w = *(const NvU2*)((const nvbf*)p.a + (size_t)sl * NP + e0); a0 += nv_bf2f((nvbf)(w.x & 0xffffu)); a1 += nv_bf2f((nvbf)(w.x >> 16)); a2 += nv_bf2f((nvbf)(w.y & 0xffffu)); a3 += nv_bf2f((nvbf)(w.y >> 16)); }
        const NvF4 g = *(const NvF4*)(p.c + e0); NvF4 o; o.x = g.x * nv_gelu(a0 * (1.f / 128.f)); o.y = g.y * nv_gelu(a1 * (1.f / 128.f)); o.z = g.z * nv_gelu(a2 * (1.f / 128.f)); o.w = g.w * nv_gelu(a3 * (1.f / 128.f));
        *(NvF4*)(p.o0 + e0) = o; } break;
    case OP_POUTS: {
        const int row = (int)(gid / D), c = (int)(gid % D); const unsigned char* vb = (const unsigned char*)p.c + (size_t)(c >> 7) * 16384 * 128 + (c & 127); float acc = 0.f;
        for (int i = 0; i < 128; ++i) acc = fmaf(p.a[(size_t)row * 128 + i] * (1.f / 64.f), nv_e4m32f(vb[(size_t)((const int*)p.b)[(size_t)row * 128 + i] * 128]), acc);
        ((nvbf*)p.o0)[gid] = nv_f2bf(acc); } break;
    case OP_KEYS: {
        const int ch = (int)(gid % 32), hr = (int)(gid / 32), h = hr / 256, nrow = hr % 256, half = nrow >> 7, k0 = ch * 8; const float* src = p.a + (((size_t)h * 2 + half) * 128 + (nrow & 127)) * 128;
        NvU4 o; o.x = o.y = o.z = o.w = 0u;
        if ((k0 >> 7) == half) { const NvF4 v0 = *(const NvF4*)(src + (k0 & 127)), v1 = *(const NvF4*)(src + (k0 & 127) + 4);
            o.x = nv_f2bf(v0.x) | ((unsigned)nv_f2bf(v0.y) << 16); o.y = nv_f2bf(v0.z) | ((unsigned)nv_f2bf(v0.w) << 16); o.z = nv_f2bf(v1.x) | ((unsigned)nv_f2bf(v1.y) << 16); o.w = nv_f2bf(v1.z) | ((unsigned)nv_f2bf(v1.w) << 16); }
        *(NvU4*)((nvbf*)p.o0 + ((size_t)h * 256 + nrow) * 256 + k0) = o;
        if (ch == 0) { float ks = 0.f;
#pragma unroll 8
            for (int k = 0; k < 128; k += 4) { const NvF4 v = *(const NvF4*)(src + k); ks += (nv_bf2f(nv_f2bf(v.x)) + nv_bf2f(nv_f2bf(v.y))) + (nv_bf2f(nv_f2bf(v.z)) + nv_bf2f(nv_f2bf(v.w))); }
            p.o1[hr] = ks; } } break;
    case OP_TOPK2: {
        const int h = (int)(gid % 8); const nvbf* sc = (const nvbf*)p.a + (size_t)gid * 256; const nvbf* q = (const nvbf*)p.b + (size_t)gid * 256; const float* ksum = p.c + h * 256; float mu = 0.f;
        for (int c = 0; c < 256; ++c) mu += nv_bf2f(q[c]);
        mu *= (1.f / 256.f); float var = 0.f;
        for (int c = 0; c < 256; ++c) { float dlt = nv_bf2f(q[c]) - mu; var = fmaf(dlt, dlt, var); }
        const float rs = 1.f / sqrtf(var * (1.f / 256.f) + 1e-5f);
        float tv[16]; int ti[16]; float* tmpv = p.o2 + (size_t)gid * 32; int* tmpi = (int*)p.o3 + (size_t)gid * 32;
        for (int half = 0; half < 2; ++half) {
#pragma unroll
            for (int j = 0; j < 16; ++j) { tv[j] = -3.0e38f; ti[j] = 0; }
            for (int k = 0; k < 128; ++k) NV_INS16(tv, ti, rs * (nv_bf2f(sc[half * 128 + k]) - mu * ksum[half * 128 + k]), k);
#pragma unroll
            for (int j = 0; j < 16; ++j) { tmpv[half * 16 + j] = tv[j]; tmpi[half * 16 + j] = ti[j]; }
        }
#pragma unroll
        for (int j = 0; j < 16; ++j) { tv[j] = -3.0e38f; ti[j] = 0; }
        for (int i = 0; i < 16; ++i) for (int j = 0; j < 16; ++j) NV_INS16(tv, ti, tmpv[i] + tmpv[16 + j], tmpi[i] * 128 + tmpi[16 + j]);
        float den = 0.f, ev[16];
#pragma unroll
        for (int j = 0; j < 16; ++j) { ev[j] = NV_EXP(tv[j] - tv[0]); den += ev[j]; }
        float inv = 1.f / den;
#pragma unroll
        for (int j = 0; j < 16; ++j) { p.o0[(size_t)gid * 16 + j] = ev[j] * inv; ((int*)p.o1)[(size_t)gid * 16 + j] = ti[j]; } } break;
    case OP_PACT: {
        const int row = (int)(gid / 128); const int e = ((const int*)p.d)[gid]; const unsigned char* u = (const unsigned char*)p.b + (size_t)e * D; const nvbf* x = (const nvbf*)p.a + (size_t)row * D; float acc = 0.f;
        for (int c = 0; c < D; ++c) acc = fmaf(nv_e4m32f(u[c]), nv_bf2f(x[c]), acc);
        p.o0[gid] = p.c[gid] * nv_gelu(acc * (1.f / 128.f)); } break;
#if defined(HOST_TEST)
    case OP_POUTLN: {
        const float alpha = 1.6817928305074292f; float* x = p.o0 + (size_t)gid * D; std::vector<float> y(D, 0.f);
        for (int i = 0; i < 128; ++i) { const float cf = p.a[(size_t)gid * 128 + i] * (1.f / 64.f); const unsigned char* v = (const unsigned char*)p.c + (size_t)((const int*)p.b)[(size_t)gid * 128 + i] * D; for (int c = 0; c < D; ++c) y[c] = fmaf(cf, nv_e4m32f(v[c]), y[c]); }
        float mu = 0.f; for (int c = 0; c < D; ++c) { y[c] = alpha * x[c] + y[c]; mu += y[c]; }
        mu /= D; float var = 0.f; for (int c = 0; c < D; ++c) { float dlt = y[c] - mu; var = fmaf(dlt, dlt, var); }
        const float rs = 1.f / sqrtf(var / D + 1e-5f);
        for (int c = 0; c < D; ++c) { const float o = (y[c] - mu) * rs * p.d[c] + p.e[c]; x[c] = o; ((nvbf*)p.o1)[(size_t)gid * D + c] = nv_f2bf(o);
            if (p.o2) { unsigned char* f8 = (unsigned char*)p.o2 + (size_t)gid * 2 * D; const float xs = fminf(fmaxf(o * 16.f, -448.f), 448.f); const unsigned hc = nv_f2e4m3(xs); f8[c] = (unsigned char)hc; f8[D + c] = (unsigned char)nv_f2e4m3(xs - nv_e4m32f(hc)); } } } break;
#endif
    default: break;
    }
}

struct NvIO { const float* const* in; float* out; char* ws; size_t ws_size; };
template <class Launch> HD void nv_forward(const NvIO& io, const Dm& dm, Launch&& launch) {
    const int D = dm.D, M = dm.M, B = dm.B, DB = dm.DB, RH = dm.RH; const size_t MD = (size_t)M * D;
    float* y_prompt = io.out; float* y_sample = y_prompt + (size_t)B * (dm.T - 16) * D; float* p_gla = y_sample + (size_t)DB * dm.DT * D;
    float* p_h = p_gla + (size_t)2 * B * 4 * 64 * 128; float* p_conv = p_h + (size_t)2 * B * 512; float* p_rwkv = p_conv + (size_t)2 * B * 3 * 512;
    float* p_shift = p_rwkv + (size_t)2 * B * RH * 4096; float* s_gla = p_shift + (size_t)2 * B * D; float* s_h = s_gla + (size_t)2 * DB * 4 * 64 * 128;
    float* s_conv = s_h + (size_t)2 * DB * 512; float* s_rwkv = s_conv + (size_t)2 * DB * 3 * 512; float* s_shift = s_rwkv + (size_t)2 * DB * RH * 4096;
    float* w = (float*)io.ws; size_t off = 0; auto take = [&](size_t n) __attribute__((always_inline)) { float* r = w + off; off += (n + 63) & ~(size_t)63; return r; };
    float* X = take(MD > (size_t)nv_rup(M, 256) * 512 ? MD : (size_t)nv_rup(M, 256) * 512); float* VFIRST = take(MD); float* MOUT = take(MD);
    auto mk = [&](int code, long long n) __attribute__((always_inline)) { Op o{}; o.code = code; o.n = n; return o; };
    const int Mp = nv_rup(M, 256), Dp = nv_rup(D, 256), Dk = nv_rup(D, 128);
    auto takeh = [&](size_t n) __attribute__((always_inline)) { return (nvbf*)take((n + 1) / 2); };
    const size_t ABFN = (size_t)Mp * 1024 > (size_t)Mp * Dk ? (size_t)Mp * 1024 : (size_t)Mp * Dk; nvbf* ABF = takeh(ABFN + (size_t)Mp * D);
    const size_t SZ_WIN = (size_t)2816 * Dk, SZ_WOUT = (size_t)Dp * 1024, SZ_DD = (size_t)Dp * Dk, SZ_DN = (size_t)256 * Dk, SZ_UP = (size_t)Dp * 128, SZ_WQ = (size_t)2048 * Dk;
    nvbf* WT_WIN = takeh(2 * SZ_WIN); nvbf* WT_WOUT = takeh(2 * SZ_WOUT); nvbf* WT_WR = takeh(2 * SZ_DD); nvbf* WT_WK = takeh(2 * SZ_DD); nvbf* WT_WV = takeh(2 * SZ_DD); nvbf* WT_WO = takeh(2 * SZ_DD);
    nvbf* WT_W1 = takeh(2 * SZ_DN); nvbf* WT_W2 = takeh(2 * SZ_UP); nvbf* WT_A1 = takeh(2 * SZ_DN); nvbf* WT_A2 = takeh(2 * SZ_UP); nvbf* WT_G1 = takeh(2 * SZ_DN); nvbf* WT_G2 = takeh(2 * SZ_UP);
    nvbf* WT_V1 = takeh(SZ_DN); nvbf* WT_V2 = takeh(SZ_UP); nvbf* WT_WQ = takeh(4 * SZ_WQ); nvbf* WT_WG = takeh((size_t)2 * 1024 * 512); float* SPL = take(2 * 512); float* PRM = take((size_t)2 * 6 * D);
    nvbf* UB = takeh((size_t)16384 * D / 2); nvbf* VB = takeh((size_t)16384 * D / 2); nvbf* KB = takeh((size_t)8 * 256 * 256); float* KSUM = take(8 * 256);
    const size_t scratch0 = off;
    auto nb = [&](Op o) __attribute__((always_inline)) { o.code |= OPF_NOBAR; launch(o); };
    auto wt = [&](const float* W, int K, int N, int batch, nvbf* dst) __attribute__((always_inline)) { const int Np = nv_rup(N, 256), Kp = nv_rup(K, 128); Op o = mk(OP_WT, (long long)batch * Np * (Kp / 8)); o.a = W; o.o0 = (float*)dst; o.i0 = N; o.i1 = K; o.i2 = N; o.i3 = Np; o.i4 = Kp; nb(o); };
    wt(io.in[10], D, MIXIN, 2, WT_WIN); wt(io.in[21], 1024, D, 2, WT_WOUT); wt(io.in[23], D, D, 2, WT_WR); wt(io.in[24], D, D, 2, WT_WK); wt(io.in[25], D, D, 2, WT_WV); wt(io.in[26], D, D, 2, WT_WO);
    wt(io.in[28], D, 64, 2, WT_W1); wt(io.in[29], 64, D, 2, WT_W2); wt(io.in[31], D, 64, 2, WT_A1); wt(io.in[32], 64, D, 2, WT_A2); wt(io.in[36], D, 128, 2, WT_G1); wt(io.in[37], 128, D, 2, WT_G2);
    wt(io.in[34], D, 32, 1, WT_V1); wt(io.in[35], 32, D, 1, WT_V2); wt(io.in[43], D, 2048, 4, WT_WQ);
    for (int jj = 0; jj < 2; ++jj) { Op o = mk(OP_PRM, (long long)6 * D); o.a = io.in[27] + (size_t)jj * D; o.b = io.in[30] + (size_t)jj * D; o.c = jj > 0 ? io.in[33] + (size_t)(jj - 1) * D : nullptr; o.d = io.in[38] + (size_t)jj * D; o.e = io.in[39] + (size_t)jj * D; o.f = io.in[40] + (size_t)jj * RH * 64; o.o0 = PRM + (size_t)jj * 6 * D; nb(o); }
    for (int jj = 0; jj < 2; ++jj) { Op o = mk(OP_WGATE, 1024 * 64); o.a = io.in[16] + (size_t)jj * 8 * 64 * 64; o.b = io.in[18] + (size_t)jj * 8 * 64 * 64; o.c = io.in[20] + (size_t)jj * 512; o.o0 = (float*)(WT_WG + (size_t)jj * 1024 * 512); o.o1 = SPL + (size_t)jj * 512; nb(o); }
    auto fgemm = [&](const nvbf* Wt, float* C, int ldc, int N, int K, int bf16out = 0, const float* Aop = nullptr, bool nobar_ = false) __attribute__((always_inline)) {
        const int Kp = nv_rup(K, 128), Np = nv_rup(N, 256);
        Op o = mk(OP_FGEMM, (long long)M * N); o.a = Aop ? Aop : (const float*)ABF; o.b = (const float*)Wt; o.o0 = C; o.i0 = N; o.i1 = Kp; o.i2 = Kp; o.i3 = Kp; o.i4 = ldc; o.i5 = Np; o.i6 = bf16out; if (nobar_) nb(o); else launch(o); };
    auto gemm = [&](const float* A, int lda, const nvbf* Wt, float* C, int ldc, int N, int K, int act) __attribute__((always_inline)) {
        const int Kp = nv_rup(K, 128);
        { Op o = mk(OP_CVT8, (long long)Mp * (Kp / 8)); o.a = A; o.o0 = (float*)ABF; o.i0 = K; o.i1 = lda; o.i2 = Kp; o.i3 = act; launch(o); }
        fgemm(Wt, C, ldc, N, K); };
    { Op o = mk(OP_EMBED4, (long long)MD / 4); o.a = io.in[0]; o.b = io.in[1]; o.c = io.in[7]; o.o0 = X; o.o1 = (float*)ABF; launch(o); }
    const float* const w_outer = w; float* const out_outer = io.out;
    for (int layer = 0; layer < 4; ++layer) {
        float* wl = (float*)w_outer; float* ol = out_outer; NV_LAUNDER(wl); NV_LAUNDER(ol);
#define NV_RB(T, v) T const v##_rb = (T)((char*)wl + ((const char*)(v) - (const char*)w_outer))
#define NV_RO(v) float* const v##_rb = (float*)((char*)ol + ((const char*)(v) - (const char*)out_outer))
        NV_RB(float*, X); NV_RB(float*, VFIRST); NV_RB(float*, MOUT); NV_RB(nvbf*, ABF); NV_RB(nvbf*, WT_WIN); NV_RB(nvbf*, WT_WOUT); NV_RB(nvbf*, WT_WR); NV_RB(nvbf*, WT_WK); NV_RB(nvbf*, WT_WV); NV_RB(nvbf*, WT_WO);
        NV_RB(nvbf*, WT_W1); NV_RB(nvbf*, WT_W2); NV_RB(nvbf*, WT_A1); NV_RB(nvbf*, WT_A2); NV_RB(nvbf*, WT_G1); NV_RB(nvbf*, WT_G2); NV_RB(nvbf*, WT_V1); NV_RB(nvbf*, WT_V2); NV_RB(nvbf*, WT_WQ); NV_RB(nvbf*, WT_WG);
        NV_RB(float*, SPL); NV_RB(float*, PRM); NV_RB(nvbf*, UB); NV_RB(nvbf*, VB); NV_RB(nvbf*, KB); NV_RB(float*, KSUM);
        NV_RO(p_gla); NV_RO(p_h); NV_RO(p_conv); NV_RO(p_rwkv); NV_RO(p_shift); NV_RO(s_gla); NV_RO(s_h); NV_RO(s_conv); NV_RO(s_rwkv); NV_RO(s_shift);
#undef NV_RB
#undef NV_RO
        { float* const X = X_rb; float* const VFIRST = VFIRST_rb; float* const MOUT = MOUT_rb; nvbf* const ABF = ABF_rb; nvbf* const WT_WIN = WT_WIN_rb; nvbf* const WT_WOUT = WT_WOUT_rb; nvbf* const WT_WR = WT_WR_rb; nvbf* const WT_WK = WT_WK_rb;
          nvbf* const WT_WV = WT_WV_rb; nvbf* const WT_WO = WT_WO_rb; nvbf* const WT_W1 = WT_W1_rb; nvbf* const WT_W2 = WT_W2_rb; nvbf* const WT_A1 = WT_A1_rb; nvbf* const WT_A2 = WT_A2_rb; nvbf* const WT_G1 = WT_G1_rb; nvbf* const WT_G2 = WT_G2_rb;
          nvbf* const WT_V1 = WT_V1_rb; nvbf* const WT_V2 = WT_V2_rb; nvbf* const WT_WQ = WT_WQ_rb; nvbf* const WT_WG = WT_WG_rb; float* const SPL = SPL_rb; float* const PRM = PRM_rb; nvbf* const UB = UB_rb; nvbf* const VB = VB_rb; nvbf* const KB = KB_rb; float* const KSUM = KSUM_rb;
          float* const p_gla = p_gla_rb; float* const p_h = p_h_rb; float* const p_conv = p_conv_rb; float* const p_rwkv = p_rwkv_rb; float* const p_shift = p_shift_rb; float* const s_gla = s_gla_rb; float* const s_h = s_h_rb; float* const s_conv = s_conv_rb;
          float* const s_rwkv = s_rwkv_rb; float* const s_shift = s_shift_rb; float* const w = wl; (void)SPL; (void)WT_WG; (void)VFIRST;
        const int j = layer / 2; off = scratch0;
        if (layer % 2 == 0) {
            float* PROJ = take((size_t)M * MIXIN); float* LOGA = take((size_t)M * 256); float* O = take((size_t)M * 512); float* MIXO = X;
            float* XC = take((size_t)M * 512); nvbf* XCB = takeh((size_t)Mp * 512); float* AT = take((size_t)M * 512); float* BT = take((size_t)M * 512);
            const int NC = (dm.T + 63) / 64; float* LEND = take((size_t)B * 4 * NC * 8192); float* DEC = take((size_t)B * 4 * NC * 64); float* LA = take((size_t)B * NC * 512); float* LB = take((size_t)B * NC * 512);
            fgemm(WT_WIN + (size_t)j * SZ_WIN, PROJ, MIXIN, MIXIN, D);
            { Op o = mk(OP_LOGA4, (long long)M * 64); o.a = PROJ; o.b = io.in[11] + (size_t)j * 16 * 256; o.c = io.in[12] + (size_t)j * 256; o.o0 = LOGA; nb(o); }
            { Op o = mk(OP_CONV4, (long long)((M + 3) / 4) * 128); o.a = PROJ; o.b = io.in[4] + (size_t)j * DB * 3 * 512; o.c = io.in[14] + (size_t)j * 4 * 512; o.d = io.in[15] + (size_t)j * 512; o.o0 = XC; o.o1 = (float*)XCB; nb(o); }
            { Op o = mk(OP_CONVOUT, (long long)dm.NSEQ * 1536); o.a = PROJ; o.b = io.in[4] + (size_t)j * DB * 3 * 512; o.o1 = p_conv + (size_t)j * B * 3 * 512; o.o2 = s_conv + (size_t)j * DB * 3 * 512; launch(o); }
            { Op o = mk(OP_GLAF, (long long)B * 512); o.a = PROJ; o.b = LOGA; o.o0 = O; o.o1 = p_gla + (size_t)j * B * 4 * 64 * 128; nb(o); }
            { Op o = mk(OP_GLA3, (long long)(DB * 4) * 128); o.a = PROJ; o.b = LOGA; o.c = io.in[2] + (size_t)j * DB * 4 * 64 * 128; o.d = LEND; o.o0 = O; o.o2 = s_gla + (size_t)j * DB * 4 * 64 * 128; o.i0 = NC; o.i1 = 1; nb(o); }
            { Op o = mk(OP_LRUG2, (long long)M * 512); o.a = (const float*)XCB; o.b = (const float*)(WT_WG + (size_t)j * 1024 * 512); o.c = io.in[17] + (size_t)j * 512; o.d = io.in[19] + (size_t)j * 512; o.e = SPL + (size_t)j * 512; o.f = (const float*)XCB; o.o0 = AT; o.o1 = BT; launch(o); }
            { Op o = mk(OP_GLANORM, (long long)M * 4); o.a = O; o.b = PROJ; o.c = io.in[13] + (size_t)j * 128; o.o0 = MIXO; nb(o); }
            { Op o = mk(OP_LRU1, (long long)B * NC * 512); o.a = AT; o.b = BT; o.o0 = LA; o.o1 = LB; o.i0 = NC; launch(o); }
            { Op o = mk(OP_LRU3, (long long)(B * NC + DB) * 512); o.a = AT; o.b = BT; o.c = PROJ; o.d = io.in[3] + (size_t)j * DB * 512; o.e = LB; o.f = LA; o.o0 = MIXO; o.o1 = p_h + (size_t)j * B * 512; o.o2 = s_h + (size_t)j * DB * 512; o.i0 = NC; launch(o); }
            fgemm(WT_WOUT + (size_t)j * SZ_WOUT, MOUT, D, D, 1024, 1, X, true);
        } else {
            float* Y = take(MD); float* R = take(MD); float* K = take(MD); float* V = take(MD); float* G = take(MD); float* KK = take(MD);
            const size_t XMSZ = (size_t)Mp * D;
            float* WAV = take(3 * MD > 3 * XMSZ ? 3 * MD : 3 * XMSZ); float* Wd = WAV; float* Aa = WAV + MD; float* Vg = WAV + 2 * MD; nvbf* XM6 = (nvbf*)WAV;
            float* BON = take((size_t)M * RH); float* HLw = take((size_t)M * 64); float* HLa = take((size_t)M * 64); float* HLg = take((size_t)M * 128); float* HLv = take((size_t)M * 32);
            nvbf* ABw = takeh((size_t)Mp * 128); nvbf* ABa = takeh((size_t)Mp * 128); nvbf* ABg = takeh((size_t)Mp * 128); nvbf* ABv = takeh((size_t)Mp * 128);
            const float* shin = io.in[6] + (size_t)j * DB * D; const float* mu = io.in[22] + (size_t)j * 6 * D;
            { Op o = mk(OP_SHIFTOUT, (long long)dm.NSEQ * D); o.a = (const float*)ABF; o.o1 = p_shift + (size_t)j * B * D; o.o2 = s_shift + (size_t)j * DB * D; nb(o); }
            { Op o = mk(OP_MIX6, (long long)((M + 3) / 4) * (D / 8)); o.a = (const float*)ABF; o.b = shin; o.c = mu; o.o0 = (float*)XM6; o.i1 = (int)(XMSZ / 1024); launch(o); }
            auto gg = [&](const nvbf* A, const nvbf* Wt, float* C, int ldc, int N, int K, bool last, int bf16out = 0) __attribute__((always_inline)) { const int Kp = nv_rup(K, 128), Np = nv_rup(N, 256);
                Op o = mk(OP_FGEMM, (long long)M * N); o.a = (const float*)A; o.b = (const float*)Wt; o.o0 = C; o.i0 = N; o.i1 = Kp; o.i2 = Kp; o.i3 = Kp; o.i4 = ldc; o.i5 = Np; o.i6 = bf16out; if (!last) o.code |= OPF_GROUP; launch(o); };
            gg(XM6 + 0 * XMSZ, WT_WR + (size_t)j * SZ_DD, R, D, D, D, false, 1); gg(XM6 + 2 * XMSZ, WT_WK + (size_t)j * SZ_DD, K, D, D, D, false, 1); gg(XM6 + 3 * XMSZ, WT_WV + (size_t)j * SZ_DD, V, D, D, D, false, 1);
            gg(XM6 + 1 * XMSZ, WT_W1 + (size_t)j * SZ_DN, HLw, 64, 64, D, false); gg(XM6 + 4 * XMSZ, WT_A1 + (size_t)j * SZ_DN, HLa, 64, 64, D, false);
            if (j > 0) gg(XM6 + 3 * XMSZ, WT_V1 + (size_t)(j - 1) * SZ_DN, HLv, 32, 32, D, false);
            gg(XM6 + 5 * XMSZ, WT_G1 + (size_t)j * SZ_DN, HLg, 128, 128, D, true);
            auto cv = [&](const float* A, int K, nvbf* dst, int act, bool last) __attribute__((always_inline)) { Op o = mk(OP_CVT8, (long long)Mp * 16); o.a = A; o.o0 = (float*)dst; o.i0 = K; o.i1 = K; o.i2 = 128; o.i3 = act; if (last) launch(o); else nb(o); };
            cv(HLw, 64, ABw, 1, false); cv(HLa, 64, ABa, 0, false); if (j > 0) cv(HLv, 32, ABv, 0, false); cv(HLg, 128, ABg, 2, true);
            gg(ABw, WT_W2 + (size_t)j * SZ_UP, Wd, D, D, 64, false, 1); gg(ABa, WT_A2 + (size_t)j * SZ_UP, Aa, D, D, 64, false, 1); if (j > 0) gg(ABv, WT_V2 + (size_t)(j - 1) * SZ_UP, Vg, D, D, 32, false, 1); gg(ABg, WT_G2 + (size_t)j * SZ_UP, G, D, D, 128, true, 1);
            { Op o = mk(OP_WKVP, (long long)dm.NSEQ * RH * 64); o.a = R; o.b = K; o.c = Wd; o.d = Aa; o.e = V; o.f = Vg; o.g = VFIRST; o.h = PRM + (size_t)j * 6 * D; o.o0 = Y; o.o1 = p_rwkv + (size_t)j * B * RH * 4096; o.o2 = s_rwkv + (size_t)j * DB * RH * 4096;
              o.o3 = j > 0 ? KK : VFIRST; o.o4 = BON; o.o5 = (float*)(io.in[5] + (size_t)j * DB * RH * 4096); o.i0 = j > 0 ? 1 : 0; launch(o); }
            { Op o = mk(OP_POST2, (long long)M * RH); o.a = Y; o.b = G; o.c = j > 0 ? KK : VFIRST; o.d = BON; o.e = io.in[41] + (size_t)j * D; o.f = io.in[42] + (size_t)j * D; o.o0 = X; launch(o); }
            fgemm(WT_WO + (size_t)j * SZ_DD, MOUT, D, D, D, 1, X, true);
        }
        { Op o = mk(OP_CVTTAB8S, (long long)16384 * D / 16); o.a = io.in[45] + (size_t)layer * 16384 * D; o.o0 = (float*)UB; o.i0 = 7; o.i6 = (Mp / 256) * (nv_rup(D, 256) / 256); launch(o); }
        { Op o = mk(OP_LNRES, M); o.a = MOUT; o.b = io.in[8] + (size_t)(layer * 2 + 0) * D; o.c = io.in[9] + (size_t)(layer * 2 + 0) * D; o.o0 = X; o.o1 = (float*)ABF; o.o2 = (float*)(ABF + ABFN); launch(o); }
        off = scratch0;
        { nvbf* Q = takeh((size_t)Mp * 2048); float* SC = take((size_t)M * 2048); float* GATE = take((size_t)M * 128); float* EIDX = take((size_t)M * 128); float* TMPV = take((size_t)M * 256); float* TMPI = take((size_t)M * 256);
          float* COEF = take((size_t)M * 128);
          { Op o = mk(OP_FGEMM, (long long)M * 2048); o.a = (const float*)ABF; o.b = (const float*)(WT_WQ + (size_t)layer * SZ_WQ); o.o0 = (float*)Q; o.i0 = 2048; o.i1 = Dk; o.i2 = Dk; o.i3 = Dk; o.i4 = 2048; o.i5 = 2048; o.i6 = 1; nb(o); }
          { Op o = mk(OP_CVTTAB8S, (long long)16384 * D / 16); o.a = io.in[46] + (size_t)layer * 16384 * D; o.o0 = (float*)VB; o.i0 = 6; o.i6 = (Mp / 256) * 8; nb(o); }
          { Op o = mk(OP_KEYS, 8 * 256 * 32); o.a = io.in[44] + (size_t)layer * 8 * 2 * 128 * 128; o.o0 = (float*)KB; o.o1 = KSUM; launch(o); }
          { Op o = mk(OP_FGEMM, (long long)M * 2048); o.a = (const float*)Q; o.b = (const float*)KB; o.o0 = SC; o.i0 = 2048; o.i1 = 256; o.i2 = 2048; o.i3 = 256; o.i4 = 2048; o.i5 = 2048; o.i6 = 3; launch(o); }
          { Op o = mk(OP_TOPK2, (long long)M * 8); o.a = SC; o.b = (const float*)Q; o.c = KSUM; o.o0 = GATE; o.o1 = EIDX; o.o2 = TMPV; o.o3 = TMPI; launch(o); }
          { const int NS = D / 128; float* PART = take((size_t)NS * M * 128); float* YBUF = take(MD);
            #ifdef PROBE_EMASK
            { Op o = mk(OP_PACTS, (long long)NS * M * 128); o.a = (const float*)(ABF + ABFN); o.b = (const float*)UB; o.d = EIDX; o.o0 = PART; o.i0 = PROBE_EMASK; launch(o); }
#endif
            { Op o = mk(OP_PACTS, (long long)NS * M * 128); o.a = (const float*)(ABF + ABFN); o.b = (const float*)UB; o.d = EIDX; o.o0 = PART; o.i0 = 16383; launch(o); }
            { Op o = mk(OP_PRED, (long long)M * 32); o.a = PART; o.c = GATE; o.o0 = COEF; o.i0 = NS; launch(o); }
            { Op o = mk(OP_POUTS, (long long)MD); o.a = COEF; o.b = EIDX; o.c = (const float*)VB; o.o0 = YBUF; launch(o); }
            { Op o = mk(OP_LNRES, M); o.a = YBUF; o.b = io.in[8] + (size_t)(layer * 2 + 1) * D; o.c = io.in[9] + (size_t)(layer * 2 + 1) * D; o.o0 = X; o.o1 = (float*)ABF; launch(o); } } }
        }
    }
    { Op o = mk(OP_YOUT4, (long long)MD / 4); o.a = (const float*)ABF; o.o0 = y_prompt; launch(o); }
    (void)y_sample;
}

#include <cstdint>
namespace pg8 {
#define PG8_LAS __attribute__((address_space(3)))
typedef unsigned short bf16_t;
typedef short bf16x8 __attribute__((ext_vector_type(8)));
typedef float f32x4 __attribute__((ext_vector_type(4)));
typedef unsigned u32x4 __attribute__((ext_vector_type(4)));
constexpr int BM = 256, BK = 64, HALF = 128, HTB = HALF * BK * 2  , STAGE_BYTES = 8 * HTB, NXCD = 8, WGM = 8;

__host__ __device__ __forceinline__ int lds_byte(int r, int c) { const int st = (r >> 4) * 2 + (c >> 5), rr = r & 15, cc = c & 31, ob = rr * 64 + cc * 2; return st * 1024 + (ob ^ (((ob >> 9) & 1) << 5)); }
__host__ __device__ __forceinline__ void stage_rc(int b, int& R, int& C) { const int st = b / 1024, sb = b % 1024, swz = sb ^ (((sb >> 9) & 1) << 5); R = (st >> 1) * 16 + swz / 64; C = (st & 1) * 32 + (swz % 64) / 2; }
__host__ __device__ __forceinline__ int perm32(int rho) { const int n = rho >> 4, i = rho & 15; return 8 * (i >> 2) + 4 * n + (i & 3); }

struct Unit { int pm, pn, grp, pad_; const char* A; const char* B; };
struct Gemm { const bf16_t* A; const bf16_t* Bt; int M, N, K, lda, ldb; };

struct StaticOrder {
    int nM, nN, nwg, G, c; const char* A; const char* B; size_t tsA, tsB, acs;
    __host__ __device__ void init(const Gemm& g, int G_, int c_) { nM = g.M / BM; nN = g.N / BM; nwg = nM * nN; G = G_; c = c_; A = (const char*)g.A; B = (const char*)g.Bt; tsA = (size_t)BM * g.lda * 2; tsB = (size_t)BM * g.ldb * 2; acs = 0; }
    __host__ __device__ bool next(int i, Unit& u) const {
        const long L = (long)i * G + c; if (L >= nwg) return false;
        int wgid = (int)L; { const int q = nwg / NXCD, r = nwg % NXCD, xcd = wgid % NXCD, off = wgid / NXCD; wgid = (xcd < r ? xcd * (q + 1) : r * (q + 1) + (xcd - r) * q) + off; }
        const int nig = WGM * nN, gid = wgid / nig, fm = gid * WGM, gsz = (nM - fm) < WGM ? (nM - fm) : WGM;
        u.pm = fm + ((wgid % nig) % gsz); u.pn = (wgid % nig) / gsz; u.grp = 0; u.pad_ = 0; u.A = A + (size_t)u.pm * tsA + (size_t)u.pn * acs; u.B = B + (size_t)u.pn * tsB; return true;
    }
    __device__ __forceinline__ void a_ready(const Unit&) const {}
    __device__ __forceinline__ void done(const Unit&) const {}
};

template <class Epi, class Sched, bool ALIGN_EPI = false, bool SP2 = false>
__device__ __forceinline__ void gemm_phase(PG8_LAS unsigned char* lds, const Gemm g, const Sched& S, const Epi& E) {
    int tid_raw = threadIdx.x; asm volatile("" : "+v"(tid_raw));
    const int tid = tid_raw, wid = __builtin_amdgcn_readfirstlane(tid >> 6), lane = tid & 63, wr = wid >> 2, wc = wid & 3, fr = lane & 15, fq = lane >> 4;
    const int K = g.K, nt = K / BK;
    unsigned voffA[2], voffB[2];
#pragma unroll
    for (int i = 0; i < 2; ++i) { int R, C; stage_rc(tid * 16 + i * 8192, R, C); const int Rb = Epi::PERM ? ((R & ~31) + perm32(R & 31)) : R;
        voffA[i] = (unsigned)(R * g.lda + C) * 2u; voffB[i] = (unsigned)(Rb * g.ldb + C) * 2u; }
    const size_t kstep = (size_t)(BK * 2);
    const size_t hstepA = (size_t)HALF * g.lda * 2, hstepB = (size_t)HALF * g.ldb * 2;
    const unsigned ldsw = (unsigned)wid * 1024u;
    const int aoff = lds_byte(wr * 64 + fr, fq * 8), boff = lds_byte(wc * 32 + fr, fq * 8);
#define PG8_SA(b, h) (((b) * 2 + (h)) * HTB)
#define PG8_SB(b, h) ((4 + (b) * 2 + (h)) * HTB)
#define PG8_STAGE(bufoff, gbase, voff) do { _Pragma("unroll") for (int _i = 0; _i < 2; ++_i) \
        __builtin_amdgcn_global_load_lds((const unsigned*)((const char*)(gbase) + (voff)[_i]), (PG8_LAS unsigned*)(lds + (bufoff) + ldsw + _i * 8192), 16, 0, 0); } while (0)
#define PG8_LDA(dst, b, h) do { _Pragma("unroll") for (int m = 0; m < 4; ++m) _Pragma("unroll") for (int k = 0; k < 2; ++k) dst[m][k] = *(const PG8_LAS bf16x8*)(lds + PG8_SA(b, h) + aoff + m * 2048 + k * 1024); } while (0)
#define PG8_LDB(dst, b, h) do { _Pragma("unroll") for (int n = 0; n < 2; ++n) _Pragma("unroll") for (int k = 0; k < 2; ++k) dst[n][k] = *(const PG8_LAS bf16x8*)(lds + PG8_SB(b, h) + boff + n * 2048 + k * 1024); } while (0)
#define PG8_MMA(ai, bj, At, Bt) do { __builtin_amdgcn_s_setprio(1); _Pragma("unroll") for (int m = 0; m < 4; ++m) _Pragma("unroll") for (int n = 0; n < 2; ++n) _Pragma("unroll") for (int k = 0; k < 2; ++k) \
        acc[ai][bj][m][n] = __builtin_amdgcn_mfma_f32_16x16x32_bf16(Bt[n][k], At[m][k], acc[ai][bj][m][n], 0, 0, 0); __builtin_amdgcn_s_setprio(0); } while (0)
#define PG8_WAIT_V(n) asm volatile("s_waitcnt vmcnt(" #n ")" ::: "memory")
#define PG8_WAIT_L(n) asm volatile("s_waitcnt lgkmcnt(" #n ")" ::: "memory")
#define PG8_BAR __builtin_amdgcn_s_barrier()
#define PG8_SCHED __builtin_amdgcn_sched_barrier(0)
    Unit cur, nxt; int ui = 0;
    if (!S.next(0, cur)) return;
    f32x4 acc[2][2][4][2];
#pragma unroll
    for (int a = 0; a < 2; ++a)
#pragma unroll
        for (int b = 0; b < 2; ++b)
#pragma unroll
            for (int m = 0; m < 4; ++m)
#pragma unroll
                for (int n = 0; n < 2; ++n) acc[a][b][m][n] = (f32x4){0.f, 0.f, 0.f, 0.f};
    bf16x8 At[4][2], B0[2][2], B1[2][2];
    const char* cA = cur.A; const char* cB = cur.B;
    S.a_ready(cur);
    if constexpr (SP2) {
        PG8_STAGE(PG8_SB(0, 0), cB, voffB); PG8_STAGE(PG8_SB(0, 1), cB + hstepB, voffB); PG8_STAGE(PG8_SA(0, 0), cA, voffA); PG8_STAGE(PG8_SA(0, 1), cA + hstepA, voffA);
        if (wr == 1) PG8_BAR;
        PG8_WAIT_V(2); PG8_BAR;
        PG8_STAGE(PG8_SB(1, 0), cB + kstep, voffB); PG8_STAGE(PG8_SA(1, 0), cA + kstep, voffA); PG8_STAGE(PG8_SB(1, 1), cB + hstepB + kstep, voffB);
        PG8_WAIT_V(6); PG8_BAR;
    } else {
        PG8_STAGE(PG8_SB(0, 0), cB, voffB); PG8_STAGE(PG8_SA(0, 0), cA, voffA); PG8_STAGE(PG8_SB(0, 1), cB + hstepB, voffB); PG8_STAGE(PG8_SA(0, 1), cA + hstepA, voffA);
        if (wr == 1) PG8_BAR;
        PG8_WAIT_V(4); PG8_BAR;
        PG8_STAGE(PG8_SB(1, 0), cB + kstep, voffB); PG8_STAGE(PG8_SA(1, 0), cA + kstep, voffA); PG8_STAGE(PG8_SB(1, 1), cB + hstepB + kstep, voffB);
        PG8_WAIT_V(6); PG8_BAR;
    }
    for (;;) {
        const bool has_next = S.next(ui + 1, nxt);
        const char* nA = has_next ? nxt.A : cA; const char* nB = has_next ? nxt.B : cB;
        for (int t = 0; t < nt; t += 2) {
            const bool last = (t == nt - 2);
            const char* a1 = cA + (size_t)(t + 1) * kstep;
            const char* a2 = last ? nA : cA + (size_t)(t + 2) * kstep; const char* b2 = last ? nB : cB + (size_t)(t + 2) * kstep;
            const char* a3 = a2 + kstep; const char* b3 = b2 + kstep;
            if (last && has_next) S.a_ready(nxt);
            if constexpr (SP2) {
            PG8_LDB(B0, 0, 0); PG8_LDB(B1, 0, 1); PG8_SCHED; PG8_LDA(At, 0, 0); PG8_STAGE(PG8_SA(1, 1), a1 + hstepA, voffA);
            PG8_WAIT_V(8); PG8_WAIT_L(0); PG8_BAR; PG8_MMA(0, 0, At, B0); PG8_MMA(0, 1, At, B1); PG8_BAR; PG8_SCHED;
            PG8_LDA(At, 0, 1); PG8_STAGE(PG8_SB(0, 0), b2, voffB); PG8_STAGE(PG8_SB(0, 1), b2 + hstepB, voffB); PG8_STAGE(PG8_SA(0, 0), a2, voffA);
            PG8_WAIT_V(8); PG8_WAIT_L(0); PG8_BAR; PG8_MMA(1, 0, At, B0); PG8_MMA(1, 1, At, B1); PG8_BAR; PG8_SCHED;
            PG8_LDB(B0, 1, 0); PG8_LDB(B1, 1, 1); PG8_SCHED; PG8_LDA(At, 1, 0); PG8_STAGE(PG8_SA(0, 1), a2 + hstepA, voffA);
            PG8_WAIT_V(8); PG8_WAIT_L(0); PG8_BAR; PG8_MMA(0, 0, At, B0); PG8_MMA(0, 1, At, B1); PG8_BAR; PG8_SCHED;
            PG8_LDA(At, 1, 1); PG8_STAGE(PG8_SB(1, 0), b3, voffB); PG8_STAGE(PG8_SB(1, 1), b3 + hstepB, voffB); PG8_STAGE(PG8_SA(1, 0), a3, voffA);
            PG8_WAIT_V(8); PG8_WAIT_L(0); PG8_BAR; PG8_MMA(1, 0, At, B0); PG8_MMA(1, 1, At, B1); PG8_BAR; PG8_SCHED;
            } else {
            PG8_LDB(B0, 0, 0); PG8_SCHED; PG8_LDA(At, 0, 0); PG8_STAGE(PG8_SA(1, 1), a1 + hstepA, voffA);
            PG8_WAIT_L(8); PG8_BAR; PG8_WAIT_L(0); PG8_MMA(0, 0, At, B0); PG8_BAR; PG8_SCHED;
            PG8_LDB(B1, 0, 1); PG8_STAGE(PG8_SB(0, 0), b2, voffB);
            PG8_BAR; PG8_WAIT_L(0); PG8_MMA(0, 1, At, B1); PG8_BAR;
            PG8_LDA(At, 0, 1); PG8_STAGE(PG8_SA(0, 0), a2, voffA);
            PG8_BAR; PG8_WAIT_L(0); PG8_MMA(1, 0, At, B0); PG8_BAR; PG8_SCHED;
            PG8_STAGE(PG8_SB(0, 1), b2 + hstepB, voffB);
            PG8_WAIT_V(6); PG8_BAR; PG8_MMA(1, 1, At, B1); PG8_BAR;
            PG8_LDB(B0, 1, 0); PG8_SCHED; PG8_LDA(At, 1, 0); PG8_STAGE(PG8_SA(0, 1), a2 + hstepA, voffA);
            PG8_WAIT_L(8); PG8_BAR; PG8_WAIT_L(0); PG8_MMA(0, 0, At, B0); PG8_BAR; PG8_SCHED;
            PG8_LDB(B1, 1, 1); PG8_STAGE(PG8_SB(1, 0), b3, voffB);
            PG8_BAR; PG8_WAIT_L(0); PG8_MMA(0, 1, At, B1); PG8_BAR;
            PG8_LDA(At, 1, 1); PG8_STAGE(PG8_SA(1, 0), a3, voffA);
            PG8_BAR; PG8_WAIT_L(0); PG8_MMA(1, 0, At, B0); PG8_BAR; PG8_SCHED;
            PG8_STAGE(PG8_SB(1, 1), b3 + hstepB, voffB);
            PG8_WAIT_V(6); PG8_BAR; PG8_MMA(1, 1, At, B1); PG8_BAR;
            }
        }
        if constexpr (ALIGN_EPI) { if (wr == 0) PG8_BAR; }
        if constexpr (!Epi::AFTER_DRAIN) { E(acc, cur, wr, wc, fr, fq); S.done(cur); }
        if (!has_next) break;
#pragma unroll
        for (int a = 0; a < 2; ++a)
#pragma unroll
            for (int b = 0; b < 2; ++b)
#pragma unroll
                for (int m = 0; m < 4; ++m)
#pragma unroll
                    for (int n = 0; n < 2; ++n) acc[a][b][m][n] = (f32x4){0.f, 0.f, 0.f, 0.f};
        cur = nxt; cA = nA; cB = nB; ++ui;
        if constexpr (ALIGN_EPI) { if (wr == 1) PG8_BAR; }
    }
    PG8_WAIT_V(0);
    if constexpr (!ALIGN_EPI) { if (wr == 0) PG8_BAR; }
    PG8_BAR;
    if constexpr (Epi::AFTER_DRAIN) { E.fused(acc, cur, wr, wc, fr, fq, lds, wid, lane); S.done(cur); }
#undef PG8_SA
#undef PG8_SB
#undef PG8_STAGE
#undef PG8_LDA
#undef PG8_LDB
#undef PG8_MMA
#undef PG8_WAIT_V
#undef PG8_WAIT_L
#undef PG8_BAR
#undef PG8_SCHED
}
}
template <class T> __device__ __forceinline__ T* uni_ptr(T* p) {
    unsigned long long v = (unsigned long long)p; unsigned lo = __builtin_amdgcn_readfirstlane((unsigned)v), hi = __builtin_amdgcn_readfirstlane((unsigned)(v >> 32));
    unsigned long long r = ((unsigned long long)hi << 32) | lo; asm volatile("" : "+s"(r)); return (T*)r; }
__device__ __forceinline__ int rfl(int x) { int t = __builtin_amdgcn_readfirstlane(x); asm volatile("" : "+s"(t)); return t; }
namespace pg8 {
__device__ __forceinline__ unsigned cvt_pk_bf16(float lo, float hi) { unsigned r; asm volatile("v_cvt_pk_bf16_f32 %0, %1, %2" : "=v"(r) : "v"(lo), "v"(hi)); return r; }
struct EpiF32 {
    static constexpr bool PERM = false, AFTER_DRAIN = false;
    float* C; int ldc, Mreal, Nreal;
    __device__ __forceinline__ void operator()(const f32x4 (&acc)[2][2][4][2], const Unit& u, int wr, int wc, int fr, int fq) const {
        const int row0 = u.pm * BM + wr * 64 + fr, col0 = u.pn * BM + wc * 32 + 4 * fq;
#pragma unroll
        for (int ai = 0; ai < 2; ++ai)
#pragma unroll
            for (int m = 0; m < 4; ++m) { const int r = row0 + ai * HALF + m * 16; if (r < Mreal) { float* rowp = C + (size_t)r * ldc + col0;
#pragma unroll
                for (int bj = 0; bj < 2; ++bj)
#pragma unroll
                    for (int n = 0; n < 2; ++n) { const int c = col0 + bj * HALF + n * 16; if (c < Nreal) *(f32x4*)(rowp + bj * HALF + n * 16) = acc[ai][bj][m][n]; } } }
    }
};
struct EpiBf16Plain {
    static constexpr bool PERM = true, AFTER_DRAIN = false;
    bf16_t* O; int ldc;
    __device__ __forceinline__ void operator()(const f32x4 (&acc)[2][2][4][2], const Unit& u, int wr, int wc, int fr, int fq) const {
        const int row0 = u.pm * BM + wr * 64 + fr, col0 = u.pn * BM + wc * 32 + 8 * fq;
#pragma unroll
        for (int ai = 0; ai < 2; ++ai)
#pragma unroll
            for (int m = 0; m < 4; ++m) { bf16_t* rowp = O + (size_t)(row0 + ai * HALF + m * 16) * ldc + col0;
#pragma unroll
                for (int bj = 0; bj < 2; ++bj) { const f32x4 v0 = acc[ai][bj][m][0], v1 = acc[ai][bj][m][1]; u32x4 w;
                    w.x = cvt_pk_bf16(v0[0], v0[1]); w.y = cvt_pk_bf16(v0[2], v0[3]); w.z = cvt_pk_bf16(v1[0], v1[1]); w.w = cvt_pk_bf16(v1[2], v1[3]);
                    *(u32x4*)(rowp + bj * HALF) = w; } }
    }
};
struct EpiLru {
    static constexpr bool PERM = false, AFTER_DRAIN = false;
    const float* ba; const float* bx; const float* spl; const bf16_t* XC; float* AT; float* BT; int Mreal;
    __device__ __forceinline__ void operator()(const f32x4 (&acc)[2][2][4][2], const Unit& u, int wr, int wc, int fr, int fq) const {
        const int row0 = u.pm * BM + wr * 64 + fr, ch0 = u.pn * 128 + wc * 32 + 4 * fq;
#pragma unroll
        for (int n = 0; n < 2; ++n) { const int c = ch0 + 16 * n; const f32x4 ba4 = *(const f32x4*)(ba + c), bx4 = *(const f32x4*)(bx + c), sp4 = *(const f32x4*)(spl + c);
#pragma unroll
            for (int ai = 0; ai < 2; ++ai)
#pragma unroll
                for (int m = 0; m < 4; ++m) { const int r = row0 + ai * HALF + m * 16; if (r < Mreal) { const unsigned long long xw_ = *(const unsigned long long*)(XC + (size_t)r * 512 + c); const unsigned xl_ = (unsigned)xw_, xh_ = (unsigned)(xw_ >> 32); const f32x4 xc = {__uint_as_float(xl_ << 16), __uint_as_float(xl_ & 0xffff0000u), __uint_as_float(xh_ << 16), __uint_as_float(xh_ & 0xffff0000u)}; const f32x4 ga = acc[ai][0][m][n] + ba4, gx = acc[ai][1][m][n] + bx4; f32x4 at, bt;
#pragma unroll
                    for (int i = 0; i < 4; ++i) { const float gate_a = __builtin_amdgcn_rcpf(1.f + __expf(-ga[i])), gate_x = __builtin_amdgcn_rcpf(1.f + __expf(-gx[i])); const float la = gate_a * sp4[i]; at[i] = __expf(la); bt[i] = sqrtf(-expm1f(2.f * la)) * (gate_x * xc[i]); }
                    *(f32x4*)(AT + (size_t)r * 512 + c) = at; *(f32x4*)(BT + (size_t)r * 512 + c) = bt; } } }
    }
};
struct GroupOrder {
    const PG8_LAS Op* tab; int ng, nM, G, c; size_t tsA, tsB;
    __device__ __forceinline__ bool next(int i, Unit& u) const {
        int L = i * G + c, g = 0;
        for (; g < ng; ++g) { const int cnt = nM * (__builtin_amdgcn_readfirstlane(tab[g].i5) >> 8); if (L < cnt) break; L -= cnt; }
        if (g >= ng) return false;
        u.pm = L % nM; u.pn = L / nM; u.grp = g; u.pad_ = 0;
        u.A = (const char*)uni_ptr(tab[g].a) + (size_t)u.pm * tsA; u.B = (const char*)uni_ptr(tab[g].b) + (size_t)u.pn * tsB; return true;
    }
    __device__ __forceinline__ void a_ready(const Unit&) const {}
    __device__ __forceinline__ void done(const Unit&) const {}
};
struct EpiGroup {
    static constexpr bool PERM = true, AFTER_DRAIN = false;
    const PG8_LAS Op* tab; int Mreal;
    __device__ __forceinline__ void operator()(const f32x4 (&acc)[2][2][4][2], const Unit& u, int wr, int wc, int fr, int fq) const {
        const int ldc = rfl(tab[u.grp].i4), Nreal = rfl(tab[u.grp].i0), fl = rfl(tab[u.grp].i6);
        if (fl & 1) { const EpiBf16Plain E{(bf16_t*)uni_ptr(tab[u.grp].o0), ldc}; E(acc, u, wr, wc, fr, fq); return; }
        float* C = uni_ptr(tab[u.grp].o0); const int row0 = u.pm * BM + wr * 64 + fr, col0 = u.pn * BM + wc * 32 + 8 * fq;
#pragma unroll
        for (int ai = 0; ai < 2; ++ai)
#pragma unroll
            for (int m = 0; m < 4; ++m) { const int r = row0 + ai * HALF + m * 16; if (r < Mreal) { float* rowp = C + (size_t)r * ldc + col0;
#pragma unroll
                for (int bj = 0; bj < 2; ++bj) { if (col0 + bj * HALF < Nreal) { *(f32x4*)(rowp + bj * HALF) = acc[ai][bj][m][0]; *(f32x4*)(rowp + bj * HALF + 4) = acc[ai][bj][m][1]; } } } }
    }
};
}

#define XB_TMO      128
#define XB_XCNT(j)  (256  + 64 * (j))
#define XB_XSUB(j)  (1280 + 64 * (j))
#define XB_XGEN(j)  (2304 + 64 * (j))
#define XB_TOP      3328
#define XB_TOPGEN   3392
#define XCD_BAR_WORDS 3456
#define XB_SPIN_CAP (1u << 18)
#define LAS __attribute__((address_space(3)))
__device__ __forceinline__ unsigned xb_ld(unsigned* p)              { return __hip_atomic_load(p, __ATOMIC_RELAXED, __HIP_MEMORY_SCOPE_AGENT); }
__device__ __forceinline__ unsigned xb_add(unsigned* p, unsigned v) { return __hip_atomic_fetch_add(p, v, __ATOMIC_RELAXED, __HIP_MEMORY_SCOPE_AGENT); }
__device__ __forceinline__ unsigned xb_xcc_id() { return (unsigned)__builtin_amdgcn_s_getreg((3 << 11) | 20) & 0xFu; }
#define XB_SPIN(cond, bar) do { unsigned _sp = 0; while (cond) { __builtin_amdgcn_s_sleep(1); \
    if ((++_sp & 255u) == 0u) { if (xb_ld(&(bar)[XB_TMO])) break; if (_sp > XB_SPIN_CAP) { atomicAdd(&(bar)[XB_TMO], 1u); break; } } } } while (0)
struct XcdBarrier { unsigned* bar; unsigned x; volatile LAS unsigned* st; };
__device__ __forceinline__ XcdBarrier xcd_barrier_post(unsigned* bar, volatile LAS unsigned* st) {
    XcdBarrier b; b.bar = bar; b.x = xb_xcc_id(); b.st = st;
    if (threadIdx.x == 0) (void)xb_add(&bar[XB_XCNT(b.x)], 1u);
    return b;
}
__device__ __forceinline__ void xcd_barrier_complete(unsigned* bar, unsigned x, unsigned& nloc, unsigned& nx) {
    const unsigned G = gridDim.x * gridDim.y * gridDim.z;
    unsigned sum, cnt, mine, sp = 0u;
    for (;;) {
        sum = 0u; cnt = 0u; mine = 0u;
#pragma unroll
        for (unsigned j = 0; j < 16; ++j) { const unsigned c = xb_ld(&bar[XB_XCNT(j)]); sum += c; cnt += (c > 0u) ? 1u : 0u; mine = (j == x) ? c : mine; }
        if (sum == G) break;
        __builtin_amdgcn_s_sleep(1);
        if ((++sp & 255u) == 0u) { if (xb_ld(&bar[XB_TMO])) break; if (sp > XB_SPIN_CAP) { atomicAdd(&bar[XB_TMO], 1u); break; } }
    }
    nloc = mine > 0u ? mine : 1u; nx = cnt > 0u ? cnt : 1u;
}
__device__ __forceinline__ void xcd_barrier(const XcdBarrier& b) {
    asm volatile("s_waitcnt vmcnt(0)" ::: "memory");
    __syncthreads();
    if (threadIdx.x == 0) {
        unsigned* bar = b.bar;
        __builtin_amdgcn_s_waitcnt(0);
        unsigned nloc = b.st[0], nx = b.st[1];
        if (nloc == 0u) { xcd_barrier_complete(bar, b.x, nloc, nx); b.st[0] = nloc; b.st[1] = nx; }
        const unsigned old = xb_add(&bar[XB_XSUB(b.x)], 1u);
        const unsigned gen = old / nloc;
        if (old + 1u == (gen + 1u) * nloc) {
            __builtin_amdgcn_fence(__ATOMIC_RELEASE, "agent");
            asm volatile("s_waitcnt vmcnt(0)" ::: "memory");
            const unsigned og = xb_add(&bar[XB_TOP], 1u);
            const unsigned tg = og / nx;
            if (og + 1u == (tg + 1u) * nx) xb_add(&bar[XB_TOPGEN], 1u);
            else XB_SPIN(xb_ld(&bar[XB_TOPGEN]) == tg, bar);
            __builtin_amdgcn_fence(__ATOMIC_ACQUIRE, "agent");
            xb_add(&bar[XB_XGEN(b.x)], 1u);
            asm volatile("s_waitcnt vmcnt(0)" ::: "memory");
        } else {
            XB_SPIN(xb_ld(&bar[XB_XGEN(b.x)]) == gen, bar);
            __builtin_amdgcn_fence(__ATOMIC_ACQUIRE, "agent");
            asm volatile("s_waitcnt vmcnt(0)" ::: "memory");
        }
    }
    __syncthreads();
}

namespace fk {
#define GAS __attribute__((address_space(1)))
typedef unsigned u32x4 __attribute__((ext_vector_type(4)));
typedef unsigned u32x2 __attribute__((ext_vector_type(2)));
typedef float f32x4 __attribute__((ext_vector_type(4)));
typedef float f32x2 __attribute__((ext_vector_type(2)));
typedef __bf16 bf2 __attribute__((ext_vector_type(2)));
typedef unsigned short bf16_t;
__device__ __forceinline__ float bflo(unsigned u) { return __uint_as_float(u << 16); }
__device__ __forceinline__ float bfhi(unsigned u) { return __uint_as_float(u & 0xffff0000u); }
__device__ __forceinline__ float dot2(unsigned a, unsigned b, float c) { return __builtin_amdgcn_fdot2_f32_bf16(__builtin_bit_cast(bf2, a), __builtin_bit_cast(bf2, b), c, false); }
__device__ __forceinline__ unsigned pk_bf16(float lo, float hi) { unsigned r; asm volatile("v_cvt_pk_bf16_f32 %0, %1, %2" : "=v"(r) : "v"(lo), "v"(hi)); return r; }
template <int CTRL> __device__ __forceinline__ float dppf(float v) { return __int_as_float(__builtin_amdgcn_update_dpp(0, __float_as_int(v), CTRL, 0xf, 0xf, true)); }
__device__ __forceinline__ float row_max16(float v) { v = fmaxf(v, dppf<0xB1>(v)); v = fmaxf(v, dppf<0x4E>(v)); v = fmaxf(v, dppf<0x141>(v)); v = fmaxf(v, dppf<0x140>(v)); return v; }
__device__ __forceinline__ float frcp(float x) { return __builtin_amdgcn_rcpf(x); }
__device__ __forceinline__ float fsqrt(float x) { return __builtin_amdgcn_sqrtf(x); }
__device__ __forceinline__ float row_sum8(float v) { v += dppf<0xB1>(v); v += dppf<0x4E>(v); v += dppf<0x141>(v); return v; }
__device__ __forceinline__ float row_sum16(float v) { v += dppf<0xB1>(v); v += dppf<0x4E>(v); v += dppf<0x141>(v); v += dppf<0x140>(v); return v; }
__device__ __forceinline__ float shx(float v, int m, int lane) { return __int_as_float(__builtin_amdgcn_ds_bpermute((lane ^ m) << 2, __float_as_int(v))); }
__device__ __forceinline__ float wave_sum(float v, int lane) { v = row_sum16(v); v += shx(v, 16, lane); v += shx(v, 32, lane); return v; }
__device__ __forceinline__ float gelu_tanh(float x) { return 0.5f * x * (1.f + tanhf(0.7978845608028654f * (x + 0.044715f * x * x * x))); }
#define FK_NEG (-3.0e38f)

template <int CTRL> __device__ __forceinline__ int dppi(int v) { return __builtin_amdgcn_update_dpp(0, v, CTRL, 0xf, 0xf, true); }
__device__ __forceinline__ int row_min16i(int v) { v = min(v, dppi<0xB1>(v)); v = min(v, dppi<0x4E>(v)); v = min(v, dppi<0x141>(v)); v = min(v, dppi<0x140>(v)); return v; }
#define FK_CE(a, b) do { const bool sw_ = v[b] > v[a]; const float tv_ = sw_ ? v[b] : v[a]; v[b] = sw_ ? v[a] : v[b]; v[a] = tv_; const int ti_ = sw_ ? id[b] : id[a]; id[b] = sw_ ? id[a] : id[b]; id[a] = ti_; } while (0)
#define FK_SORT8(v, id) do { FK_CE2(v, id, 0, 1); FK_CE2(v, id, 2, 3); FK_CE2(v, id, 4, 5); FK_CE2(v, id, 6, 7); FK_CE2(v, id, 0, 2); FK_CE2(v, id, 1, 3); FK_CE2(v, id, 4, 6); FK_CE2(v, id, 5, 7); FK_CE2(v, id, 1, 2); FK_CE2(v, id, 5, 6); \
    FK_CE2(v, id, 0, 4); FK_CE2(v, id, 1, 5); FK_CE2(v, id, 2, 6); FK_CE2(v, id, 3, 7); FK_CE2(v, id, 2, 4); FK_CE2(v, id, 3, 5); FK_CE2(v, id, 1, 2); FK_CE2(v, id, 3, 4); FK_CE2(v, id, 5, 6); } while (0)
#define FK_CE2(v, id, a, b) do { const bool sw_ = v[b] > v[a]; const float tv_ = sw_ ? v[b] : v[a]; v[b] = sw_ ? v[a] : v[b]; v[a] = tv_; const int ti_ = sw_ ? id[b] : id[a]; id[b] = sw_ ? id[a] : id[b]; id[a] = ti_; } while (0)
__device__ __forceinline__ void top16_of_128_x2(float (&v)[8], int (&id)[8], float (&u)[8], int (&jd)[8], int lane16, float& rv1, int& ri1, float& rv2, int& ri2) {
    FK_SORT8(v, id); FK_SORT8(u, jd);
    rv1 = FK_NEG; ri1 = 0; rv2 = FK_NEG; ri2 = 0;
#pragma unroll
    for (int r = 0; r < 16; ++r) {
        const float wm = row_max16(v[0]), xm = row_max16(u[0]);
        const int cand = (v[0] == wm) ? id[0] : 0x7fffffff, dand = (u[0] == xm) ? jd[0] : 0x7fffffff;
        const int sel = row_min16i(cand), tel = row_min16i(dand);
        const bool mine = (cand == sel), nine = (dand == tel);
        if (lane16 == r) { rv1 = wm; ri1 = sel; rv2 = xm; ri2 = tel; }
#pragma unroll
        for (int i = 0; i < 7; ++i) { v[i] = mine ? v[i + 1] : v[i]; id[i] = mine ? id[i + 1] : id[i]; u[i] = nine ? u[i + 1] : u[i]; jd[i] = nine ? jd[i + 1] : jd[i]; }
        v[7] = mine ? FK_NEG : v[7]; u[7] = nine ? FK_NEG : u[7];
    }
}
__device__ __forceinline__ int fk_key(float x, int lane16) { int k = __float_as_int(x); k ^= (k >> 31) & 0x7fffffff; return (k & ~15) | (15 - lane16); }
__device__ __forceinline__ float fk_unkey(int k) { k &= ~15; k ^= (k >> 31) & 0x7fffffff; return __int_as_float(k); }
__device__ __forceinline__ int row_max16i(int v) { v = max(v, dppi<0xB1>(v)); v = max(v, dppi<0x4E>(v)); v = max(v, dppi<0x141>(v)); v = max(v, dppi<0x140>(v)); return v; }
__device__ __forceinline__ void topk_phase(const GAS bf16_t* __restrict__ SC, const GAS bf16_t* __restrict__ Q, const GAS float* __restrict__ KSUM, GAS float* __restrict__ GATE, GAS int* __restrict__ EIDX, int nitems,
                                           LAS unsigned char* lds, int wid, int lane, int wave_gid, int nwaves) {
    LAS float* xv = (LAS float*)(lds + wid * 512);
    const int lane16 = lane & 15, rowbase = lane & 48;
    unsigned ctab = 0xffffffffu;
    { const unsigned T_[14] = {0x03020100u, 0x07060504u, 0x0b0a0908u, 0x0f0e0d0cu, 0x13121110u, 0x17161514u, 0x23222120u, 0xffffff24u, 0x33323130u, 0xff424140u, 0x71615150u, 0x90807060u, 0xd0c0b0a0u, 0xfffff0e0u};
#pragma unroll
      for (int i = 0; i < 14; ++i) ctab = lane16 == i ? T_[i] : ctab; }
    u32x4 nqa, nqb, nsw, ntw;
#define TK_LOAD(wi_) do { int it_ = (wi_) * 4 + (lane >> 4); it_ = it_ < nitems ? it_ : nitems - 1; const GAS u32x4* qp_ = (const GAS u32x4*)(Q + (size_t)it_ * 256 + 16 * lane16); nqa = qp_[0]; nqb = qp_[1]; \
        const GAS bf16_t* sp_ = SC + (size_t)it_ * 256 + 8 * lane16; nsw = *(const GAS u32x4*)sp_; ntw = *(const GAS u32x4*)(sp_ + 128); } while (0)
    TK_LOAD(wave_gid);
    const GAS float* kp = KSUM + ((wave_gid * 4 + (lane >> 4)) & 7) * 256 + 8 * lane16; const f32x4 k0 = *(const GAS f32x4*)kp, k1 = *(const GAS f32x4*)(kp + 4), m0 = *(const GAS f32x4*)(kp + 128), m1 = *(const GAS f32x4*)(kp + 132);
    for (int wi = wave_gid; wi * 4 < nitems; wi += nwaves) {
        const int it = wi * 4 + (lane >> 4);
        const u32x4 qa = nqa, qb = nqb; const f32x4 s0 = (f32x4){bflo(nsw[0]), bfhi(nsw[0]), bflo(nsw[1]), bfhi(nsw[1])}, s1 = (f32x4){bflo(nsw[2]), bfhi(nsw[2]), bflo(nsw[3]), bfhi(nsw[3])},
                    t0 = (f32x4){bflo(ntw[0]), bfhi(ntw[0]), bflo(ntw[1]), bfhi(ntw[1])}, t1 = (f32x4){bflo(ntw[2]), bfhi(ntw[2]), bflo(ntw[3]), bfhi(ntw[3])};
        TK_LOAD(wi + nwaves);
        float qs = 0.f, qq = 0.f;
#pragma unroll
        for (int i = 0; i < 4; ++i) { const float a = bflo(qa[i]), b = bfhi(qa[i]), c = bflo(qb[i]), d = bfhi(qb[i]); qs += (a + b) + (c + d); qq += (a * a + b * b) + (c * c + d * d); }
        const float mu = row_sum16(qs) * (1.f / 256.f); const float var = fmaxf(row_sum16(qq) * (1.f / 256.f) - mu * mu, 0.f); const float rs = 1.f / sqrtf(var + 1e-5f);
        int ka[8], kb[8];
#define TK_KEY(x_, id_) ({ int k_ = __float_as_int(x_); k_ ^= (k_ >> 31) & 0x7fffffff; (k_ & ~127) | (127 - (id_)); })
#define TK_VAL(k_) ({ int q_ = (k_) & ~127; q_ ^= (q_ >> 31) & 0x7fffffff; __int_as_float(q_); })
#pragma unroll
        for (int i = 0; i < 4; ++i) { ka[i] = TK_KEY(rs * (s0[i] - mu * k0[i]), 8 * lane16 + i); ka[4 + i] = TK_KEY(rs * (s1[i] - mu * k1[i]), 8 * lane16 + 4 + i);
            kb[i] = TK_KEY(rs * (t0[i] - mu * m0[i]), 8 * lane16 + i); kb[4 + i] = TK_KEY(rs * (t1[i] - mu * m1[i]), 8 * lane16 + 4 + i); }
#define TK_CE(k_, a_, b_) do { const int hi_ = max(k_[a_], k_[b_]), lo_ = min(k_[a_], k_[b_]); k_[a_] = hi_; k_[b_] = lo_; } while (0)
#define TK_SORT8(k_) do { TK_CE(k_, 0, 1); TK_CE(k_, 2, 3); TK_CE(k_, 4, 5); TK_CE(k_, 6, 7); TK_CE(k_, 0, 2); TK_CE(k_, 1, 3); TK_CE(k_, 4, 6); TK_CE(k_, 5, 7); TK_CE(k_, 1, 2); TK_CE(k_, 5, 6); \
        TK_CE(k_, 0, 4); TK_CE(k_, 1, 5); TK_CE(k_, 2, 6); TK_CE(k_, 3, 7); TK_CE(k_, 2, 4); TK_CE(k_, 3, 5); TK_CE(k_, 1, 2); TK_CE(k_, 3, 4); TK_CE(k_, 5, 6); } while (0)
        TK_SORT8(ka); TK_SORT8(kb);
        constexpr int KMIN = (int)0x80000000;
        int r1 = KMIN, r2 = KMIN;
#pragma unroll
        for (int r = 0; r < 16; ++r) {
            const int wm1 = row_max16i(ka[0]), wm2 = row_max16i(kb[0]); const bool mine = (ka[0] == wm1), nine = (kb[0] == wm2);
            if (lane16 == r) { r1 = wm1; r2 = wm2; }
#pragma unroll
            for (int i = 0; i < 7; ++i) { ka[i] = mine ? ka[i + 1] : ka[i]; kb[i] = nine ? kb[i + 1] : kb[i]; }
            ka[7] = mine ? KMIN : ka[7]; kb[7] = nine ? KMIN : kb[7];
        }
        const float rv1 = TK_VAL(r1), rv2 = TK_VAL(r2);
        xv[lane] = rv1; xv[64 + lane] = rv2;
        int kc[4];
#pragma unroll
        for (int q = 0; q < 4; ++q) { const int ij = (ctab >> (8 * q)) & 255; const float sm = xv[rowbase + ((ij >> 4) & 15)] + xv[64 + rowbase + (ij & 15)]; int k_ = __float_as_int(sm); k_ ^= (k_ >> 31) & 0x7fffffff; kc[q] = ij == 255 ? KMIN : ((k_ & ~255) | (255 - ij)); }
        int rk = KMIN;
#pragma unroll
        for (int r = 0; r < 16; ++r) {
            const int wm = row_max16i(kc[0]); const bool mine = (kc[0] == wm);
            if (lane16 == r) rk = wm;
            kc[0] = mine ? kc[1] : kc[0]; kc[1] = mine ? kc[2] : kc[1]; kc[2] = mine ? kc[3] : kc[2]; kc[3] = mine ? KMIN : kc[3];
        }
        const int pid = 255 - (rk & 255), i1 = pid >> 4, j2 = pid & 15;
        const int g1 = __builtin_amdgcn_ds_bpermute((rowbase + i1) << 2, r1), g2 = __builtin_amdgcn_ds_bpermute((rowbase + j2) << 2, r2);
        const int e1 = 127 - (g1 & 127), e2 = 127 - (g2 & 127);
        float sc; { int q_ = rk & ~255; q_ ^= (q_ >> 31) & 0x7fffffff; sc = __int_as_float(q_); }
        const float mx = TK_VAL(row_max16i(TK_KEY(sc, 0))); const float ex = __expf(sc - mx); const float den = row_sum16(ex);
        GATE[(size_t)it * 16 + lane16] = ex / den; EIDX[(size_t)it * 16 + lane16] = e1 * 128 + e2;
#undef TK_KEY
#undef TK_VAL
#undef TK_CE
#undef TK_SORT8
    }
#undef TK_LOAD
}

__device__ __forceinline__ f32x2 fp8lo(unsigned w) { return __builtin_amdgcn_cvt_pk_f32_fp8((int)w, false); }
__device__ __forceinline__ f32x2 fp8hi(unsigned w) { return __builtin_amdgcn_cvt_pk_f32_fp8((int)w, true); }
__device__ __forceinline__ void act_phase(const GAS bf16_t* __restrict__ XB, const GAS unsigned char* __restrict__ U8, const GAS float* __restrict__ GATE, const GAS int* __restrict__ EIDX, GAS float* __restrict__ COEF, int nitems,
                                          int lane, int wave_gid, int nwaves) {
    int it = wave_gid; if (it >= nitems) return;
    u32x4 uc[16], un[16], xac, xbc, xan, xbn;
    int evc = EIDX[(size_t)it * 16 + (lane & 15)];
    { const GAS u32x4* xp = (const GAS u32x4*)(XB + (size_t)(it >> 3) * 1024 + 16 * lane); xac = xp[0]; xbc = xp[1]; }
#pragma unroll
    for (int k = 0; k < 16; ++k) uc[k] = *(const GAS u32x4*)(U8 + (size_t)__builtin_amdgcn_readlane(evc, k) * 1024 + 16 * lane);
    int itn = it + nwaves; int evn = (itn < nitems) ? EIDX[(size_t)itn * 16 + (lane & 15)] : 0;
    for (;;) {
        const bool hasn = itn < nitems;
        if (hasn) {
            const GAS u32x4* xp = (const GAS u32x4*)(XB + (size_t)(itn >> 3) * 1024 + 16 * lane); xan = xp[0]; xbn = xp[1];
#pragma unroll
            for (int k = 0; k < 16; ++k) un[k] = *(const GAS u32x4*)(U8 + (size_t)__builtin_amdgcn_readlane(evn, k) * 1024 + 16 * lane);
        }
        const int itnn = itn + nwaves; const int evnn = (itnn < nitems) ? EIDX[(size_t)itnn * 16 + (lane & 15)] : 0;
        const float gt = GATE[(size_t)it * 16 + (lane >> 2)];
        float x[16];
#pragma unroll
        for (int i = 0; i < 4; ++i) { x[2 * i] = bflo(xac[i]); x[2 * i + 1] = bfhi(xac[i]); x[8 + 2 * i] = bflo(xbc[i]); x[8 + 2 * i + 1] = bfhi(xbc[i]); }
        float a[16];
#pragma unroll
        for (int k = 0; k < 16; ++k) { const u32x4 uw = uc[k]; float s = 0.f;
#pragma unroll
            for (int d = 0; d < 4; ++d) { const f32x2 lo = fp8lo(uw[d]), hi = fp8hi(uw[d]); s = fmaf(lo.x, x[4 * d], s); s = fmaf(lo.y, x[4 * d + 1], s); s = fmaf(hi.x, x[4 * d + 2], s); s = fmaf(hi.y, x[4 * d + 3], s); }
            asm volatile("" : "+v"(s)); a[k] = s; }
#pragma unroll
        for (int k = 0; k < 8; ++k) { const bool hi = lane & 32; const float send = hi ? a[k] : a[k + 8], keep = hi ? a[k + 8] : a[k]; a[k] = keep + shx(send, 32, lane); }
#pragma unroll
        for (int k = 0; k < 4; ++k) { const bool hi = lane & 16; const float send = hi ? a[k] : a[k + 4], keep = hi ? a[k + 4] : a[k]; a[k] = keep + shx(send, 16, lane); }
#pragma unroll
        for (int k = 0; k < 2; ++k) { const bool hi = lane & 8; const float send = hi ? a[k] : a[k + 2], keep = hi ? a[k + 2] : a[k]; a[k] = keep + shx(send, 8, lane); }
        { const bool hi = lane & 4; const float send = hi ? a[0] : a[1], keep = hi ? a[1] : a[0]; a[0] = keep + shx(send, 4, lane); }
        float dsum = a[0]; dsum += shx(dsum, 2, lane); dsum += shx(dsum, 1, lane);
        if ((lane & 3) == 0) COEF[(size_t)it * 16 + (lane >> 2)] = gt * gelu_tanh(dsum * (1.f / 128.f));
        if (!hasn) break;
#pragma unroll
        for (int k = 0; k < 16; ++k) uc[k] = un[k];
        xac = xan; xbc = xbn; evc = evn; evn = evnn; it = itn; itn = itnn;
    }
}

__device__ __forceinline__ void outln_phase(const GAS float* COEF, const GAS int* EIDX, const GAS unsigned char* V8,     const GAS float* __restrict__ lg, const GAS float* __restrict__ lb, GAS float* X, GAS bf16_t* XB, int nrows,
                                            int lane, int wave_gid, int nwaves) {
    const float alpha = 1.6817928305074292f;
    int row = wave_gid; if (row >= nrows) return;
    u32x4 vc[16], vn[16];
    float cf0 = COEF[(size_t)row * 128 + lane] * (1.f / 64.f), cf1 = COEF[(size_t)row * 128 + 64 + lane] * (1.f / 64.f); int ev0 = EIDX[(size_t)row * 128 + lane], ev1 = EIDX[(size_t)row * 128 + 64 + lane];
#define OUT_LOADCH(dst, evreg, base) do { _Pragma("unroll") for (int k_ = 0; k_ < 16; ++k_) dst[k_] = *(const GAS u32x4*)(V8 + (size_t)__builtin_amdgcn_readlane(evreg, (base) + k_) * 1024 + 16 * lane); } while (0)
#define OUT_COMPCH(src, cfreg, base) do { _Pragma("unroll") for (int k_ = 0; k_ < 16; ++k_) { const float c_ = __int_as_float(__builtin_amdgcn_readlane(__float_as_int(cfreg), (base) + k_)); const u32x4 vw_ = src[k_]; \
        _Pragma("unroll") for (int d_ = 0; d_ < 4; ++d_) { const f32x2 lo_ = fp8lo(vw_[d_]), hi_ = fp8hi(vw_[d_]); acc[4 * d_] = fmaf(c_, lo_.x, acc[4 * d_]); acc[4 * d_ + 1] = fmaf(c_, lo_.y, acc[4 * d_ + 1]); acc[4 * d_ + 2] = fmaf(c_, hi_.x, acc[4 * d_ + 2]); acc[4 * d_ + 3] = fmaf(c_, hi_.y, acc[4 * d_ + 3]); } \
        _Pragma("unroll") for (int p_ = 0; p_ < 16; ++p_) asm volatile("" : "+v"(acc[p_]));     \
        } } while (0)
    for (;;) {
        OUT_LOADCH(vc, ev0, 0);
        const int rown = row + nwaves; const bool hasn = rown < nrows;
        float ncf0 = 0.f, ncf1 = 0.f; int nev0 = 0, nev1 = 0;
        if (hasn) { ncf0 = COEF[(size_t)rown * 128 + lane] * (1.f / 64.f); ncf1 = COEF[(size_t)rown * 128 + 64 + lane] * (1.f / 64.f); nev0 = EIDX[(size_t)rown * 128 + lane]; nev1 = EIDX[(size_t)rown * 128 + 64 + lane]; }
        float acc[16];
#pragma unroll
        for (int k = 0; k < 16; ++k) acc[k] = 0.f;
#define OUT_FENCE() asm volatile("" ::: "memory")
        OUT_LOADCH(vn, ev0, 16); OUT_FENCE(); OUT_COMPCH(vc, cf0, 0); OUT_FENCE();
        OUT_LOADCH(vc, ev0, 32); OUT_FENCE(); OUT_COMPCH(vn, cf0, 16); OUT_FENCE();
        OUT_LOADCH(vn, ev0, 48); OUT_FENCE(); OUT_COMPCH(vc, cf0, 32); OUT_FENCE();
        OUT_LOADCH(vc, ev1, 0);  OUT_FENCE(); OUT_COMPCH(vn, cf0, 48); OUT_FENCE();
        OUT_LOADCH(vn, ev1, 16); OUT_FENCE(); OUT_COMPCH(vc, cf1, 0); OUT_FENCE();
        OUT_LOADCH(vc, ev1, 32); OUT_FENCE(); OUT_COMPCH(vn, cf1, 16); OUT_FENCE();
        OUT_LOADCH(vn, ev1, 48); OUT_FENCE(); OUT_COMPCH(vc, cf1, 32); OUT_FENCE();
        OUT_COMPCH(vn, cf1, 48); OUT_FENCE();
#undef OUT_FENCE
        GAS float* xr = X + (size_t)row * 1024 + 16 * lane; float t[16];
#pragma unroll
        for (int q = 0; q < 4; ++q) { const f32x4 xv = *(const GAS f32x4*)(xr + 4 * q); t[4 * q] = fmaf(alpha, xv.x, acc[4 * q]); t[4 * q + 1] = fmaf(alpha, xv.y, acc[4 * q + 1]); t[4 * q + 2] = fmaf(alpha, xv.z, acc[4 * q + 2]); t[4 * q + 3] = fmaf(alpha, xv.w, acc[4 * q + 3]); }
        float s = 0.f;
#pragma unroll
        for (int k = 0; k < 16; ++k) s += t[k];
        const float mu = wave_sum(s, lane) * (1.f / 1024.f); float vs = 0.f;
#pragma unroll
        for (int k = 0; k < 16; ++k) { t[k] -= mu; vs = fmaf(t[k], t[k], vs); }
        const float rs = 1.f / sqrtf(wave_sum(vs, lane) * (1.f / 1024.f) + 1e-5f);
        unsigned w[8];
#pragma unroll
        for (int q = 0; q < 4; ++q) { const f32x4 g = *(const GAS f32x4*)(lg + 16 * lane + 4 * q), b = *(const GAS f32x4*)(lb + 16 * lane + 4 * q); f32x4 o;
            o.x = t[4 * q] * rs * g.x + b.x; o.y = t[4 * q + 1] * rs * g.y + b.y; o.z = t[4 * q + 2] * rs * g.z + b.z; o.w = t[4 * q + 3] * rs * g.w + b.w;
            *(GAS f32x4*)(xr + 4 * q) = o; w[2 * q] = pk_bf16(o.x, o.y); w[2 * q + 1] = pk_bf16(o.z, o.w); }
        u32x4 w0, w1; w0.x = w[0]; w0.y = w[1]; w0.z = w[2]; w0.w = w[3]; w1.x = w[4]; w1.y = w[5]; w1.z = w[6]; w1.w = w[7];
        GAS u32x4* xbp = (GAS u32x4*)(XB + (size_t)row * 1024 + 16 * lane); xbp[0] = w0; xbp[1] = w1;
        if (!hasn) break;
        row = rown; cf0 = ncf0; cf1 = ncf1; ev0 = nev0; ev1 = nev1;
    }
#undef OUT_LOADCH
#undef OUT_COMPCH
}

__device__ __forceinline__ void lnres_phase(const GAS bf16_t* __restrict__ Y, const GAS float* __restrict__ lg, const GAS float* __restrict__ lb, GAS float* X, GAS bf16_t* XB, GAS unsigned char* XF8, int nrows, int lane, int wave_gid, int nwaves) {
    const float alpha = 1.6817928305074292f; (void)X;
    for (int row = wave_gid; row < nrows; row += nwaves) {
        GAS bf16_t* xr = XB + (size_t)row * 1024; const GAS bf16_t* yr = Y + (size_t)row * 1024; float t[16];
#pragma unroll
        for (int q = 0; q < 4; ++q) { const u32x2 xw = *(const GAS u32x2*)(xr + 256 * q + 4 * lane); const u32x2 yw = *(const GAS u32x2*)(yr + 256 * q + 4 * lane);
            t[4 * q] = fmaf(alpha, bflo(xw.x), bflo(yw.x)); t[4 * q + 1] = fmaf(alpha, bfhi(xw.x), bfhi(yw.x)); t[4 * q + 2] = fmaf(alpha, bflo(xw.y), bflo(yw.y)); t[4 * q + 3] = fmaf(alpha, bfhi(xw.y), bfhi(yw.y)); }
        float s = 0.f;
#pragma unroll
        for (int k = 0; k < 16; ++k) s += t[k];
        const float mu = wave_sum(s, lane) * (1.f / 1024.f); float vs = 0.f;
#pragma unroll
        for (int k = 0; k < 16; ++k) { t[k] -= mu; vs = fmaf(t[k], t[k], vs); }
        const float rs = 1.f / sqrtf(wave_sum(vs, lane) * (1.f / 1024.f) + 1e-5f);
#pragma unroll
        for (int q = 0; q < 4; ++q) { const int c = 256 * q + 4 * lane; const f32x4 g = *(const GAS f32x4*)(lg + c), b = *(const GAS f32x4*)(lb + c); f32x4 o;
            o.x = t[4 * q] * rs * g.x + b.x; o.y = t[4 * q + 1] * rs * g.y + b.y; o.z = t[4 * q + 2] * rs * g.z + b.z; o.w = t[4 * q + 3] * rs * g.w + b.w;
            u32x2 w; w.x = pk_bf16(o.x, o.y); w.y = pk_bf16(o.z, o.w); *(GAS u32x2*)(xr + c) = w;
            if (XF8) {
                const float s0 = __builtin_amdgcn_fmed3f(o.x * 16.f, -448.f, 448.f), s1 = __builtin_amdgcn_fmed3f(o.y * 16.f, -448.f, 448.f), s2 = __builtin_amdgcn_fmed3f(o.z * 16.f, -448.f, 448.f), s3 = __builtin_amdgcn_fmed3f(o.w * 16.f, -448.f, 448.f);
                int hp = __builtin_amdgcn_cvt_pk_fp8_f32(s0, s1, 0, false); hp = __builtin_amdgcn_cvt_pk_fp8_f32(s2, s3, hp, true);
                const f32x2 d01 = fp8lo((unsigned)hp), d23 = fp8hi((unsigned)hp);
                int lp = __builtin_amdgcn_cvt_pk_fp8_f32(s0 - d01.x, s1 - d01.y, 0, false); lp = __builtin_amdgcn_cvt_pk_fp8_f32(s2 - d23.x, s3 - d23.y, lp, true);
                *(GAS int*)(XF8 + (size_t)row * 2048 + c) = hp; *(GAS int*)(XF8 + (size_t)row * 2048 + 1024 + c) = lp; } }
    }
}

__device__ __forceinline__ void glanorm_phase(const GAS float* __restrict__ O, const GAS float* __restrict__ PROJ, const GAS float* __restrict__ gnorm, GAS bf16_t* XB, int nitems, int lane, int wave_gid, int nwaves) {
    const float g0 = gnorm[lane], g1 = gnorm[64 + lane];
    for (int it0 = wave_gid * 8; it0 < nitems; it0 += nwaves * 8) {
        float a0[8], a1[8], r0[8], r1[8];
#pragma unroll
        for (int q = 0; q < 8; ++q) { int it = it0 + q; it = it < nitems ? it : it0; const int row = it >> 2, h = it & 3; const GAS float* o = O + (size_t)row * 512 + h * 128; const GAS float* r = PROJ + (size_t)row * 2576 + 1040 + h * 128;
            a0[q] = o[lane]; a1[q] = o[64 + lane]; r0[q] = r[lane]; r1[q] = r[64 + lane]; }
#pragma unroll
        for (int q = 0; q < 8; ++q) { const int it = it0 + q; const int row = it >> 2, h = it & 3;
            const float rs = 1.f / sqrtf(wave_sum(a0[q] * a0[q] + a1[q] * a1[q], lane) * (1.f / 128.f) + 1e-5f);
            const float y0 = a0[q] * rs * g0 * (r0[q] * frcp(1.f + __expf(-r0[q]))), y1 = a1[q] * rs * g1 * (r1[q] * frcp(1.f + __expf(-r1[q])));
            if (it < nitems) { GAS bf16_t* d = XB + (size_t)row * 1024 + h * 128; d[lane] = (bf16_t)(pk_bf16(y0, 0.f) & 0xffffu); d[64 + lane] = (bf16_t)(pk_bf16(y1, 0.f) & 0xffffu); } }
    }
}

__device__ __forceinline__ float sigm(float x) { return frcp(1.f + __expf(-x)); }
__device__ __forceinline__ float softplusf(float x) { return fmaxf(x, 0.f) + log1pf(__expf(-fabsf(x))); }
__device__ __forceinline__ void rwkvprep_phase(const GAS float* __restrict__ w0, const GAS float* __restrict__ a0, const GAS float* __restrict__ v0, const GAS float* __restrict__ k_k, const GAS float* __restrict__ k_a, const GAS float* __restrict__ Vg,
                                               GAS float* K, GAS float* Wd, GAS float* Aa, GAS float* V, GAS float* NKK, GAS float* VFIRST, int has_vres, int nitems, int lane, int wave_gid, int nwaves) {
    for (int it0 = wave_gid * 4; it0 < nitems; it0 += nwaves * 4) {
        float kq[4], wq[4], aq[4], vq[4], gq[4], fq[4];
#pragma unroll
        for (int q = 0; q < 4; ++q) { const int it = it0 + q; const size_t ix = (size_t)(it >> 4) * 1024 + (it & 15) * 64 + lane; kq[q] = K[ix]; wq[q] = Wd[ix]; aq[q] = Aa[ix]; vq[q] = V[ix]; gq[q] = has_vres ? Vg[ix] : 0.f; fq[q] = has_vres ? VFIRST[ix] : 0.f; }
#pragma unroll
        for (int q = 0; q < 4; ++q) { const int it = it0 + q; const int h = it & 15; const size_t ix = (size_t)(it >> 4) * 1024 + h * 64 + lane; const int c = h * 64 + lane;
            const float k0 = kq[q]; const float kv = k0 * k_k[c]; const float inv = 1.f / fmaxf(sqrtf(wave_sum(kv * kv, lane)), 1e-12f);
            const float w = -softplusf(-(w0[c] + wq[q])) - 0.5f; const float dec = __expf(-__expf(w));
            const float a = sigm(a0[c] + aq[q]);
            float v = vq[q]; if (has_vres) v = v + (fq[q] - v) * sigm(v0[c] + gq[q]); else VFIRST[ix] = v;
            const float kk = kv * inv;
            NKK[ix] = -kk; K[ix] = k0 * (1.f + (a - 1.f) * k_a[c]); Wd[ix] = dec; Aa[ix] = kk * a; V[ix] = v; }
    }
}

__device__ __forceinline__ void rwkvpost_phase(const GAS float* __restrict__ Y, const GAS float* __restrict__ R, const GAS float* __restrict__ K2, const GAS float* __restrict__ V, const GAS float* __restrict__ G, const GAS float* __restrict__ r_k,
                                               const GAS float* __restrict__ lnx_g, const GAS float* __restrict__ lnx_b, GAS bf16_t* XB, int nitems, int lane, int wave_gid, int nwaves) {
    for (int it0 = wave_gid * 4; it0 < nitems; it0 += nwaves * 4) {
        float yq[4], rq[4], kq[4], vq[4], gq[4];
#pragma unroll
        for (int q = 0; q < 4; ++q) { const int it = it0 + q; const size_t ix = (size_t)(it >> 4) * 1024 + (it & 15) * 64 + lane; yq[q] = Y[ix]; rq[q] = R[ix]; kq[q] = K2[ix]; vq[q] = V[ix]; gq[q] = G[ix]; }
#pragma unroll
        for (int q = 0; q < 4; ++q) { const int it = it0 + q; const int h = it & 15; const size_t ix = (size_t)(it >> 4) * 1024 + h * 64 + lane; const int c = h * 64 + lane;
            const float y = yq[q]; const float mu = wave_sum(y, lane) * (1.f / 64.f); const float d = y - mu; const float rs = 1.f / sqrtf(wave_sum(d * d, lane) * (1.f / 64.f) + 64e-5f);
            const float bon = wave_sum(rq[q] * kq[q] * r_k[c], lane);
            const float o = (d * rs * lnx_g[c] + lnx_b[c] + bon * vq[q]) * gq[q];
            XB[ix] = (bf16_t)(pk_bf16(o, 0.f) & 0xffffu); }
    }
}

__device__ __forceinline__ void wkv_phase(const GAS float* __restrict__ R, const GAS float* __restrict__ Wd, const GAS float* __restrict__ K2, const GAS float* __restrict__ V, const GAS float* __restrict__ BB, const GAS float* __restrict__ NKK,
                                          const GAS float* __restrict__ SIN, GAS float* __restrict__ Y, GAS float* __restrict__ P, GAS float* __restrict__ SOUT, int B, int T, int DB, int DT, LAS unsigned char* lds, int tid, int bid, int nb) {
    constexpr int TB = 32, NLD = 6, VECB = TB * 1280, VVB = TB * 128, BUF = VECB + 2 * VVB;
    const int rowl = tid >> 4, part = tid & 15;
    const int nprompt = B * 32, nunits = nprompt + DB * 32;
    for (int u = bid; u < nunits; u += nb) {
        const bool smp = u >= nprompt; const int q0_ = smp ? u - nprompt : u; const int q = ((q0_ & 7) << 1 | ((q0_ >> 3) & 1)) + ((q0_ >> 4) << 4);
        const int half = q & 1, pair = q >> 1, sq = pair >> 4, h = pair & 15;
        const int Tu = smp ? DT : T; const int r0 = smp ? B * T + sq * DT : sq * T, vrow = half * 32 + rowl;
        f32x2 S01 = (f32x2){0.f, 0.f}, S23 = (f32x2){0.f, 0.f};
        if (smp) { const f32x4 s4 = *(const GAS f32x4*)(SIN + ((size_t)pair * 64 + vrow) * 64 + part * 4); S01 = (f32x2){s4.x, s4.y}; S23 = (f32x2){s4.z, s4.w};
                   asm volatile("" : "+v"(S01), "+v"(S23)); }
        const int nblk = (Tu + TB - 1) / TB;
        f32x4 ld[NLD];
        const size_t eo_ = (size_t)(r0 + (tid >> 4)) * 1024 + h * 64 + (tid & 15) * 4, ev_ = (size_t)(r0 + ((tid & 255) >> 3)) * 1024 + h * 64 + half * 32 + (tid & 7) * 4;
        const int lo_ = ((tid >> 4) * 320 + (tid & 15) * 4) * 4, lv_ = VECB + (tid & 255) * 16;
#define WKV_LOAD(tb0) do { const size_t bo_ = (size_t)(tb0) * 1024; ld[0] = *(const GAS f32x4*)(Wd + eo_ + bo_); ld[1] = *(const GAS f32x4*)(NKK + eo_ + bo_); ld[2] = *(const GAS f32x4*)(BB + eo_ + bo_); \
            ld[3] = *(const GAS f32x4*)(K2 + eo_ + bo_); ld[4] = *(const GAS f32x4*)(R + eo_ + bo_); ld[5] = *(const GAS f32x4*)(V + ev_ + bo_); } while (0)
#define WKV_STORE(bufp) do { _Pragma("unroll") for (int q_ = 0; q_ < 5; ++q_) *(LAS f32x4*)((bufp) + lo_ + q_ * 256) = ld[q_]; *(LAS f32x4*)((bufp) + lv_) = ld[5]; } while (0)
        WKV_LOAD(0); WKV_STORE(lds); __syncthreads();
        for (int b = 0; b < nblk; ++b) {
            LAS unsigned char* cur = lds + (b & 1) * BUF; LAS unsigned char* nxt = lds + ((b + 1) & 1) * BUF; const int tb0 = b * TB; const int nt = (Tu - tb0) < TB ? (Tu - tb0) : TB;
            if (b + 1 < nblk) WKV_LOAD(tb0 + TB);
            const LAS float* vec = (const LAS float*)cur + part * 4; const LAS float* vv = (const LAS float*)(cur + VECB) + rowl; LAS float* yb = (LAS float*)(cur + VECB + VVB);
            float ykeep0 = 0.f, ykeep1 = 0.f;
#define WKV_STEP(t, keep, tl) do { const LAS f32x2* vp_ = (const LAS f32x2*)(vec + (t) * 320); \
                const f32x2 w01 = vp_[0], w23 = vp_[1], n01 = vp_[32], n23 = vp_[33], b01 = vp_[64], b23 = vp_[65], k01 = vp_[96], k23 = vp_[97], r01 = vp_[128], r23 = vp_[129]; \
                const float v = vv[(t) * 32]; \
                const f32x2 sp = __builtin_elementwise_fma(S23, n23, S01 * n01); const float sa = row_sum16(sp.x + sp.y); const f32x2 sa2 = (f32x2){sa, sa}, v2 = (f32x2){v, v}; \
                S01 = __builtin_elementwise_fma(S01, w01, __builtin_elementwise_fma(b01, sa2, k01 * v2)); S23 = __builtin_elementwise_fma(S23, w23, __builtin_elementwise_fma(b23, sa2, k23 * v2)); \
                const f32x2 yp = __builtin_elementwise_fma(S23, r23, S01 * r01); const float y = row_sum16(yp.x + yp.y); \
                keep = (part == (tl)) ? y : keep; } while (0)
            if (nt == TB) {
#pragma unroll 1
                for (int t = 0; t < 16; t += 8) { WKV_STEP(t, ykeep0, t); WKV_STEP(t + 1, ykeep0, t + 1); WKV_STEP(t + 2, ykeep0, t + 2); WKV_STEP(t + 3, ykeep0, t + 3); WKV_STEP(t + 4, ykeep0, t + 4); WKV_STEP(t + 5, ykeep0, t + 5); WKV_STEP(t + 6, ykeep0, t + 6); WKV_STEP(t + 7, ykeep0, t + 7); }
#pragma unroll 1
                for (int t = 16; t < 32; t += 8) { WKV_STEP(t, ykeep1, t - 16); WKV_STEP(t + 1, ykeep1, t - 15); WKV_STEP(t + 2, ykeep1, t - 14); WKV_STEP(t + 3, ykeep1, t - 13); WKV_STEP(t + 4, ykeep1, t - 12); WKV_STEP(t + 5, ykeep1, t - 11); WKV_STEP(t + 6, ykeep1, t - 10); WKV_STEP(t + 7, ykeep1, t - 9); }
            } else { for (int t = 0; t < nt; ++t) { if (t < 16) WKV_STEP(t, ykeep0, t); else WKV_STEP(t, ykeep1, t - 16); } }
#undef WKV_STEP
            yb[part * 32 + rowl] = ykeep0; yb[(16 + part) * 32 + rowl] = ykeep1;
            if (b + 1 < nblk) WKV_STORE(nxt);
            __syncthreads();
            { const int rl = tid & 31; _Pragma("unroll") for (int t = tid >> 5; t < TB; t += 16) if (t < nt) Y[(size_t)(r0 + tb0 + t) * 1024 + h * 64 + half * 32 + rl] = yb[t * 32 + rl]; }
        }
#undef WKV_LOAD
#undef WKV_STORE
        *(GAS f32x4*)((smp ? SOUT : P) + ((size_t)pair * 64 + vrow) * 64 + part * 4) = (f32x4){S01.x, S01.y, S23.x, S23.y};
        __syncthreads();
    }
}

__device__ __forceinline__ void rwkvpost2_phase(const GAS bf16_t* __restrict__ Y, const GAS bf16_t* __restrict__ G, const GAS bf16_t* __restrict__ VF, const GAS float* __restrict__ BON, const GAS float* __restrict__ lnx_g, const GAS float* __restrict__ lnx_b,
                                                GAS bf16_t* XB, int nitems, int lane, int wave_gid, int nwaves) {
    const int nit4 = nitems >> 2, hg = wave_gid & 3, cofs = hg * 256 + 4 * lane; const f32x4 lg = *(const GAS f32x4*)(lnx_g + cofs), lb = *(const GAS f32x4*)(lnx_b + cofs);
    for (int it0 = wave_gid; it0 < nit4; it0 += nwaves * 4) {
        u32x2 yq[4], vq[4], gq[4]; float bq[4];
#pragma unroll
        for (int q = 0; q < 4; ++q) { int it = it0 + q * nwaves; it = it < nit4 ? it : it0; const int row = it >> 2; const size_t ix = (size_t)row * 1024 + cofs;
            yq[q] = *(const GAS u32x2*)(Y + ix); vq[q] = *(const GAS u32x2*)(VF + ix); gq[q] = *(const GAS u32x2*)(G + ix); bq[q] = BON[row * 16 + hg * 4 + (lane >> 4)]; }
#pragma unroll
        for (int q = 0; q < 4; ++q) { const int it = it0 + q * nwaves; const int row = it >> 2; const f32x4 y = (f32x4){bflo(yq[q].x), bfhi(yq[q].x), bflo(yq[q].y), bfhi(yq[q].y)}, vv4 = (f32x4){bflo(vq[q].x), bfhi(vq[q].x), bflo(vq[q].y), bfhi(vq[q].y)};
            const float mu = row_sum16((y.x + y.y) + (y.z + y.w)) * (1.f / 64.f); const f32x4 d = y - mu; const float rs = __builtin_amdgcn_rsqf(row_sum16((d.x * d.x + d.y * d.y) + (d.z * d.z + d.w * d.w)) * (1.f / 64.f) + 64e-5f);
            const f32x4 gg = (f32x4){bflo(gq[q].x), bfhi(gq[q].x), bflo(gq[q].y), bfhi(gq[q].y)}; const f32x4 o = (d * rs * lg + lb + bq[q] * vv4) * gg;
            if (it < nit4) { u32x2 w_; w_.x = pk_bf16(o.x, o.y); w_.y = pk_bf16(o.z, o.w); *(GAS u32x2*)(XB + (size_t)row * 1024 + cofs) = w_; } }
    }
}

__device__ __forceinline__ void wkv2_phase(const GAS bf16_t* __restrict__ R, const GAS bf16_t* __restrict__ KR, const GAS bf16_t* __restrict__ WL, const GAS bf16_t* __restrict__ AL, const GAS bf16_t* __restrict__ V, const GAS bf16_t* __restrict__ VG,
                                           const GAS bf16_t* VFI, const GAS float* __restrict__ PRM, const GAS float* __restrict__ SIN, GAS bf16_t* __restrict__ Y, GAS float* __restrict__ P, GAS float* __restrict__ SOUT, GAS bf16_t* VFO, GAS float* __restrict__ BON,
                                           int has_vres, int B, int T, int DB, int DT, LAS unsigned char* lds, int tid, int bid, int nb) {
    constexpr int TB = 32, VECB = TB * 1280, VVB = TB * 128, BUF = VECB + 2 * VVB;
    const bool scanw = __builtin_amdgcn_readfirstlane(tid) < 256; const int pt = tid & 255;
    const int rowl = pt >> 4, part = pt & 15;
    const int nprompt = B * 32, nunits_all = nprompt + DB * 32, nunits = DT <= 4 ? nprompt : nunits_all;
    for (int u = bid; u < nunits; u += nb) {
        const bool smp = u >= nprompt; const int q0_ = smp ? u - nprompt : u; const int q = ((q0_ & 7) << 1 | ((q0_ >> 3) & 1)) + ((q0_ >> 4) << 4);
        const int half = q & 1, pair = q >> 1, sq = pair >> 4, h = pair & 15;
        const int Tu = smp ? DT : T; const int r0 = smp ? B * T + sq * DT : sq * T, vrow = half * 32 + rowl;
        const int srow = pt >> 3, sp8 = pt & 7;
        f32x2 S0 = (f32x2){0.f, 0.f}, S1 = (f32x2){0.f, 0.f}, S2 = (f32x2){0.f, 0.f}, S3 = (f32x2){0.f, 0.f};
        if (smp && scanw) { const GAS f32x4* sp_ = (const GAS f32x4*)(SIN + ((size_t)pair * 64 + half * 32 + srow) * 64 + sp8 * 8); const f32x4 sa4 = sp_[0], sb4 = sp_[1];
                   S0 = (f32x2){sa4.x, sa4.y}; S1 = (f32x2){sa4.z, sa4.w}; S2 = (f32x2){sb4.x, sb4.y}; S3 = (f32x2){sb4.z, sb4.w};
                   asm volatile("" : "+v"(S0), "+v"(S1), "+v"(S2), "+v"(S3)); }
        const int nblk = (Tu + TB - 1) / TB;
        u32x2 lk0, lw0, la0, lr0, lk1, lw1, la1, lr1, lv, lg = (u32x2){0u, 0u}, lf = (u32x2){0u, 0u};
        const size_t eo_ = (size_t)(r0 + (pt >> 4)) * 1024 + h * 64 + part * 4, ev_ = (size_t)(r0 + (pt >> 3)) * 1024 + h * 64 + half * 32 + (pt & 7) * 4;
        const int lo_ = ((pt >> 4) * 320 + part * 4) * 4, lv_ = VECB + pt * 16;
        const int pc_ = h * 64 + part * 4; const f32x4 w0v = *(const GAS f32x4*)(PRM + pc_), a0v = *(const GAS f32x4*)(PRM + 1024 + pc_), kkp = *(const GAS f32x4*)(PRM + 3072 + pc_), kap = *(const GAS f32x4*)(PRM + 4096 + pc_), rkp = *(const GAS f32x4*)(PRM + 5120 + pc_);
        const f32x4 v0v = *(const GAS f32x4*)(PRM + 2048 + h * 64 + half * 32 + (pt & 7) * 4);
#define WKV_LOAD(tb0) do { const size_t bo_ = (size_t)(tb0) * 1024, b1_ = bo_ + 16 * 1024; lk0 = *(const GAS u32x2*)(KR + eo_ + bo_); lw0 = *(const GAS u32x2*)(WL + eo_ + bo_); la0 = *(const GAS u32x2*)(AL + eo_ + bo_); lr0 = *(const GAS u32x2*)(R + eo_ + bo_); \
            lk1 = *(const GAS u32x2*)(KR + eo_ + b1_); lw1 = *(const GAS u32x2*)(WL + eo_ + b1_); la1 = *(const GAS u32x2*)(AL + eo_ + b1_); lr1 = *(const GAS u32x2*)(R + eo_ + b1_); \
            lv = *(const GAS u32x2*)(V + ev_ + bo_); if (has_vres) { lg = *(const GAS u32x2*)(VG + ev_ + bo_); lf = *(const GAS u32x2*)(VFI + ev_ + bo_); } } while (0)
#define WKV_UNPK(w_) ((f32x4){bflo((w_).x), bfhi((w_).x), bflo((w_).y), bfhi((w_).y)})
#define WKV_ITEM(bufp, tb0, lk, lw, la, lr, ti_) do { const f32x4 k4 = WKV_UNPK(lk), wl4 = WKV_UNPK(lw), al4 = WKV_UNPK(la); const f32x4 kv = k4 * kkp; const float ss = row_sum16((kv.x * kv.x + kv.y * kv.y) + (kv.z * kv.z + kv.w * kv.w)); const float inv = frcp(fmaxf(fsqrt(ss), 1e-12f)); \
            f32x4 dec, a4; _Pragma("unroll") for (int i_ = 0; i_ < 4; ++i_) { dec[i_] = __expf(-0.6065306597126334f * frcp(1.f + __expf(-(w0v[i_] + wl4[i_])))); a4[i_] = frcp(1.f + __expf(-(a0v[i_] + al4[i_]))); } \
            const f32x4 kk = kv * inv; const f32x4 k2 = k4 * ((a4 - 1.f) * kap + 1.f); const f32x4 r4 = WKV_UNPK(lr); const f32x4 rk = r4 * k2 * rkp; const float bon = row_sum16((rk.x + rk.y) + (rk.z + rk.w)); \
            LAS unsigned char* d_ = (bufp) + lo_ + (ti_) * 1280; *(LAS f32x4*)(d_) = dec; *(LAS f32x4*)(d_ + 256) = -kk; *(LAS f32x4*)(d_ + 512) = kk * a4; *(LAS f32x4*)(d_ + 768) = k2; *(LAS f32x4*)(d_ + 1024) = r4; \
            const int tr_ = (tb0) + (pt >> 4) + (ti_); if (half == 0 && part == 0 && tr_ < Tu) BON[(size_t)(r0 + tr_) * 16 + h] = bon; } while (0)
#define WKV_STORE(bufp, tb0) do { WKV_ITEM(bufp, tb0, lk0, lw0, la0, lr0, 0); if ((tb0) + 16 < Tu) WKV_ITEM(bufp, tb0, lk1, lw1, la1, lr1, 16); \
            f32x4 v4 = WKV_UNPK(lv); if (has_vres) { const f32x4 g4 = WKV_UNPK(lg), f4 = WKV_UNPK(lf); _Pragma("unroll") for (int i_ = 0; i_ < 4; ++i_) v4[i_] = v4[i_] + (f4[i_] - v4[i_]) * frcp(1.f + __expf(-(v0v[i_] + g4[i_]))); } \
            *(LAS f32x4*)((bufp) + lv_) = v4; const int tv_ = (tb0) + (pt >> 3); if (tv_ < Tu) { u32x2 w_; w_.x = pk_bf16(v4.x, v4.y); w_.y = pk_bf16(v4.z, v4.w); *(GAS u32x2*)(VFO + ev_ + (size_t)(tb0) * 1024) = w_; } } while (0)
#define WKV_YOUT(bufp, tb0, ntp) do { const LAS float* yb_ = (const LAS float*)((bufp) + VECB + VVB); const int rl = (pt & 15) * 2; _Pragma("unroll") for (int t = pt >> 4; t < TB; t += 16) if (t < (ntp)) { const f32x2 y2 = *(const LAS f32x2*)(yb_ + t * 32 + rl); \
            *(GAS unsigned*)(Y + (size_t)(r0 + (tb0) + t) * 1024 + h * 64 + half * 32 + rl) = pk_bf16(y2.x, y2.y); } } while (0)
        if (!scanw) { WKV_LOAD(0); WKV_STORE(lds, 0); if (nblk > 1) WKV_LOAD(TB); }
        __syncthreads();
        for (int b = 0; b < nblk; ++b) {
            LAS unsigned char* cur = lds + (b & 1) * BUF; LAS unsigned char* nxt = lds + ((b + 1) & 1) * BUF; const int tb0 = b * TB; const int nt = (Tu - tb0) < TB ? (Tu - tb0) : TB;
            if (scanw) {
                const LAS float* vec = (const LAS float*)cur + sp8 * 8; const LAS float* vv = (const LAS float*)(cur + VECB) + srow; LAS float* yb = (LAS float*)(cur + VECB + VVB);
                LAS float* ybl = yb + srow;
                struct StepV { f32x4 w0, w1, n0, n1, b0, b1, k0, k1, r0, r1; float v; };
#define WKV_RD(dst, t) do { const LAS f32x4* vp_ = (const LAS f32x4*)(vec + (t) * 320); dst.w0 = vp_[0]; dst.w1 = vp_[1]; dst.n0 = vp_[16]; dst.n1 = vp_[17]; dst.b0 = vp_[32]; dst.b1 = vp_[33]; \
                dst.k0 = vp_[48]; dst.k1 = vp_[49]; dst.r0 = vp_[64]; dst.r1 = vp_[65]; dst.v = vv[(t) * 32]; } while (0)
#define WKV_LO(q_) ((f32x2){(q_).x, (q_).y})
#define WKV_HI(q_) ((f32x2){(q_).z, (q_).w})
#define WKV_UPD(S, w_, b_, k_) S = __builtin_elementwise_fma(S, w_, __builtin_elementwise_fma(b_, sa2, (k_) * v2))
#define WKV_CMP(src, t_) do { const f32x2 spa = __builtin_elementwise_fma(S1, WKV_HI(src.n0), S0 * WKV_LO(src.n0)), spb = __builtin_elementwise_fma(S3, WKV_HI(src.n1), S2 * WKV_LO(src.n1)); const f32x2 sp = spa + spb; \
                const float sa = row_sum8(sp.x + sp.y); const f32x2 sa2 = (f32x2){sa, sa}, v2 = (f32x2){src.v, src.v}; \
                WKV_UPD(S0, WKV_LO(src.w0), WKV_LO(src.b0), WKV_LO(src.k0)); WKV_UPD(S1, WKV_HI(src.w0), WKV_HI(src.b0), WKV_HI(src.k0)); WKV_UPD(S2, WKV_LO(src.w1), WKV_LO(src.b1), WKV_LO(src.k1)); WKV_UPD(S3, WKV_HI(src.w1), WKV_HI(src.b1), WKV_HI(src.k1)); \
                const f32x2 ypa = __builtin_elementwise_fma(S1, WKV_HI(src.r0), S0 * WKV_LO(src.r0)), ypb = __builtin_elementwise_fma(S3, WKV_HI(src.r1), S2 * WKV_LO(src.r1)); const f32x2 yp = ypa + ypb; \
                ybl[(t_) * 32] = row_sum8(yp.x + yp.y); } while (0)
#define WKV_ST(t_, cur_, nx2_) do { WKV_RD(nx2_, ((t_) + 2) & 31); __builtin_amdgcn_sched_barrier(0); WKV_CMP(cur_, t_); } while (0)
                if (nt == TB) {
                    StepV sA, sB, sC; WKV_RD(sA, 0); WKV_RD(sB, 1);
#pragma unroll 1
                    for (int t = 0; t < 30; t += 3) { WKV_ST(t, sA, sC); WKV_ST(t + 1, sB, sA); WKV_ST(t + 2, sC, sB); }
                    WKV_ST(30, sA, sC); WKV_ST(31, sB, sA);
                } else { StepV sA; for (int t = 0; t < nt; ++t) { WKV_RD(sA, t); WKV_CMP(sA, t); } }
#undef WKV_RD
#undef WKV_LO
#undef WKV_HI
#undef WKV_UPD
#undef WKV_CMP
#undef WKV_ST
            } else {
                if (b > 0) WKV_YOUT(nxt, tb0 - TB, TB);
                if (b + 1 < nblk) { WKV_STORE(nxt, tb0 + TB); if (b + 2 < nblk) WKV_LOAD(tb0 + 2 * TB); }
            }
            __syncthreads();
        }
        if (!scanw) { const int tbl = (nblk - 1) * TB; WKV_YOUT(lds + ((nblk - 1) & 1) * BUF, tbl, Tu - tbl); }
#undef WKV_LOAD
#undef WKV_STORE
#undef WKV_ITEM
#undef WKV_YOUT
#undef WKV_UNPK
        if (scanw) { GAS float* so = (smp ? SOUT : P) + ((size_t)pair * 64 + half * 32 + srow) * 64 + sp8 * 8; *(GAS f32x4*)so = (f32x4){S0.x, S0.y, S1.x, S1.y}; *(GAS f32x4*)(so + 4) = (f32x4){S2.x, S2.y, S3.x, S3.y}; }
        __syncthreads();
    }
    if (DT <= 4) {
        const int grp = __builtin_amdgcn_readfirstlane(tid) >> 8, t4 = tid & 255, srow = t4 >> 3, sp8 = t4 & 7;
        for (int u = nprompt + bid + nb * grp; u < nunits_all; u += nb * 2) {
            const int q0_ = u - nprompt; const int q = ((q0_ & 7) << 1 | ((q0_ >> 3) & 1)) + ((q0_ >> 4) << 4);
            const int half = q & 1, pair = q >> 1, sq = pair >> 4, h = pair & 15; const int r0 = B * T + sq * DT, vrow = half * 32 + srow;
            const size_t cb_ = (size_t)h * 64 + sp8 * 8, cv_ = (size_t)h * 64 + vrow;
            const GAS f32x4* sp_ = (const GAS f32x4*)(SIN + ((size_t)pair * 64 + vrow) * 64 + sp8 * 8); const f32x4 sa4 = sp_[0], sb4 = sp_[1];
            f32x4 pw0[2], pa0[2], pkk[2], pka[2], prk[2];
#pragma unroll
            for (int i = 0; i < 2; ++i) { pw0[i] = *(const GAS f32x4*)(PRM + cb_ + 4 * i); pa0[i] = *(const GAS f32x4*)(PRM + 1024 + cb_ + 4 * i); pkk[i] = *(const GAS f32x4*)(PRM + 3072 + cb_ + 4 * i); pka[i] = *(const GAS f32x4*)(PRM + 4096 + cb_ + 4 * i); prk[i] = *(const GAS f32x4*)(PRM + 5120 + cb_ + 4 * i); }
            const float v0c = PRM[2048 + cv_];
            u32x4 lk[4], lw[4], la[4], lr[4]; unsigned short lv[4], lg[4], lf[4];
#pragma unroll
            for (int t = 0; t < 4; ++t) { const int tt = t < DT ? t : DT - 1; const size_t ro = (size_t)(r0 + tt) * 1024; lk[t] = *(const GAS u32x4*)(KR + ro + cb_); lw[t] = *(const GAS u32x4*)(WL + ro + cb_); la[t] = *(const GAS u32x4*)(AL + ro + cb_); lr[t] = *(const GAS u32x4*)(R + ro + cb_);
                lv[t] = V[ro + cv_]; lg[t] = has_vres ? VG[ro + cv_] : (unsigned short)0; lf[t] = has_vres ? VFI[ro + cv_] : (unsigned short)0; }
            float S[8] = {sa4.x, sa4.y, sa4.z, sa4.w, sb4.x, sb4.y, sb4.z, sb4.w};
#pragma unroll
            for (int t = 0; t < 4; ++t) if (t < DT) {
                float k8[8], w8[8], a8[8], r8[8];
#pragma unroll
                for (int i = 0; i < 4; ++i) { k8[2 * i] = bflo(lk[t][i]); k8[2 * i + 1] = bfhi(lk[t][i]); w8[2 * i] = bflo(lw[t][i]); w8[2 * i + 1] = bfhi(lw[t][i]); a8[2 * i] = bflo(la[t][i]); a8[2 * i + 1] = bfhi(la[t][i]); r8[2 * i] = bflo(lr[t][i]); r8[2 * i + 1] = bfhi(lr[t][i]); }
                float kv[8], ss = 0.f;
#pragma unroll
                for (int i = 0; i < 8; ++i) { kv[i] = k8[i] * pkk[i >> 2][i & 3]; ss = fmaf(kv[i], kv[i], ss); }
                const float inv = frcp(fmaxf(fsqrt(row_sum8(ss)), 1e-12f));
                float dec[8], nn[8], bb[8], k2[8], bsum = 0.f, sdot = 0.f;
#pragma unroll
                for (int i = 0; i < 8; ++i) { dec[i] = __expf(-0.6065306597126334f * frcp(1.f + __expf(-(pw0[i >> 2][i & 3] + w8[i])))); const float av = frcp(1.f + __expf(-(pa0[i >> 2][i & 3] + a8[i]))); const float kk = kv[i] * inv;
                    nn[i] = -kk; bb[i] = kk * av; k2[i] = k8[i] * ((av - 1.f) * pka[i >> 2][i & 3] + 1.f); bsum = fmaf(r8[i] * k2[i], prk[i >> 2][i & 3], bsum); sdot = fmaf(S[i], nn[i], sdot); }
                const float bon = row_sum8(bsum), sa = row_sum8(sdot);
                float vv = __uint_as_float((unsigned)lv[t] << 16); if (has_vres) vv = vv + (__uint_as_float((unsigned)lf[t] << 16) - vv) * frcp(1.f + __expf(-(v0c + __uint_as_float((unsigned)lg[t] << 16))));
                float yd = 0.f;
#pragma unroll
                for (int i = 0; i < 8; ++i) { S[i] = fmaf(S[i], dec[i], fmaf(bb[i], sa, k2[i] * vv)); yd = fmaf(S[i], r8[i], yd); }
                const float y = row_sum8(yd); const size_t ro = (size_t)(r0 + t) * 1024;
                if (sp8 == 0) { Y[ro + cv_] = (bf16_t)(pk_bf16(y, 0.f) & 0xffffu); VFO[ro + cv_] = (bf16_t)(pk_bf16(vv, 0.f) & 0xffffu); if (vrow == 0) BON[(size_t)(r0 + t) * 16 + h] = bon; } }
            GAS float* so = SOUT + ((size_t)pair * 64 + vrow) * 64 + sp8 * 8; *(GAS f32x4*)so = (f32x4){S[0], S[1], S[2], S[3]}; *(GAS f32x4*)(so + 4) = (f32x4){S[4], S[5], S[6], S[7]};
        }
    }
}

__device__ __forceinline__ void gla_phase(const GAS float* __restrict__ PROJ, const GAS float* __restrict__ LOGA, GAS float* __restrict__ O, GAS float* __restrict__ P, int B, int T, LAS unsigned char* lds, int tid, int bid, int nb) {
    constexpr int TB = 32, OA = 0, OK = 8192, OQ = 16384, OV = 24576, BUF = 26624;
    const int wv = __builtin_amdgcn_readfirstlane(tid) >> 6; const bool scanw = wv < 4; const int pt = tid & 255, lane = tid & 63;
    const int col = pt >> 4, p = pt & 15, dk = p * 4;
    const int nunits = B * 32;
#define GLA_WAITV(n_) asm volatile("s_waitcnt vmcnt(" #n_ ")" ::: "memory")
#define GLA_BAR() do { asm volatile("s_waitcnt lgkmcnt(0)" ::: "memory"); __builtin_amdgcn_s_barrier(); asm volatile("" ::: "memory"); } while (0)
    for (int u = bid; u < nunits; u += nb) {
        const int ug_ = ((u & 7) << 3 | ((u >> 3) & 7)) + ((u >> 6) << 6);
        const int cb = ug_ & 7, pair = ug_ >> 3, s = pair >> 2, h = pair & 3; const int r0 = s * T;
        f32x2 S01 = (f32x2){0.f, 0.f}, S23 = (f32x2){0.f, 0.f};
        const int nblk = (T + TB - 1) / TB;
        const GAS unsigned char* gsrc; size_t gins, gblk; int ldst;
        if (wv == 4) { gsrc = (const GAS unsigned char*)(LOGA + (size_t)(r0 + (lane >> 4)) * 256 + h * 64 + (lane & 15) * 4); gins = (size_t)4 * 256 * 4; gblk = (size_t)TB * 256 * 4; ldst = OA; }
        else if (wv == 7) { gsrc = (const GAS unsigned char*)(PROJ + (size_t)(r0 + (lane >> 2)) * 2576 + 512 + h * 128 + cb * 16 + (lane & 3) * 4); gins = (size_t)16 * 2576 * 4; gblk = (size_t)TB * 2576 * 4; ldst = OV; }
        else { gsrc = (const GAS unsigned char*)(PROJ + (size_t)(r0 + (lane >> 4)) * 2576 + (wv == 5 ? 256 : 0) + h * 64 + (lane & 15) * 4); gins = (size_t)4 * 2576 * 4; gblk = (size_t)TB * 2576 * 4; ldst = wv == 5 ? OK : OQ; }
#define GLA_DMA(blk_) do { const GAS unsigned char* s_ = gsrc + (size_t)(blk_) * gblk; LAS unsigned char* d_ = lds + ((blk_) % 3) * BUF + ldst; \
            if (wv == 7) { __builtin_amdgcn_global_load_lds((const GAS unsigned*)s_, (LAS unsigned*)d_, 16, 0, 0); __builtin_amdgcn_global_load_lds((const GAS unsigned*)(s_ + gins), (LAS unsigned*)(d_ + 1024), 16, 0, 0); } \
            else { _Pragma("unroll") for (int i_ = 0; i_ < 8; ++i_) __builtin_amdgcn_global_load_lds((const GAS unsigned*)(s_ + i_ * gins), (LAS unsigned*)(d_ + i_ * 1024), 16, 0, 0); } } while (0)
        if (!scanw) { GLA_DMA(0); if (nblk > 1) { GLA_DMA(1); if (wv == 7) GLA_WAITV(2); else GLA_WAITV(8); } else GLA_WAITV(0); }
        GLA_BAR();
        for (int b = 0; b < nblk; ++b) {
            const int tb0 = b * TB; const int nt = (T - tb0) < TB ? (T - tb0) : TB;
            if (scanw) {
                const LAS unsigned char* cur = lds + (b % 3) * BUF; const LAS float* vec = (const LAS float*)cur + dk; const LAS float* vv = (const LAS float*)(cur + OV) + col;
                float okeep0 = 0.f, okeep1 = 0.f;
                struct G4 { f32x4 a[4], k[4], q[4]; float v[4]; };
#define GLA_RD4(dst, t0_) do { _Pragma("unroll") for (int i_ = 0; i_ < 4; ++i_) { const LAS float* vp_ = vec + ((t0_) + i_) * 64; dst.a[i_] = *(const LAS f32x4*)vp_; dst.k[i_] = *(const LAS f32x4*)(vp_ + OK / 4); dst.q[i_] = *(const LAS f32x4*)(vp_ + OQ / 4); dst.v[i_] = vv[((t0_) + i_) * 16]; } } while (0)
#define GLA_ONE(src, i_, keep, tl) do { const f32x4 a4 = src.a[i_], k4 = src.k[i_], q4 = src.q[i_]; const f32x2 v2 = (f32x2){src.v[i_], src.v[i_]}; \
                S01 = __builtin_elementwise_fma((f32x2){a4.x, a4.y}, S01, (f32x2){k4.x, k4.y} * v2); S23 = __builtin_elementwise_fma((f32x2){a4.z, a4.w}, S23, (f32x2){k4.z, k4.w} * v2); \
                const f32x2 o2 = __builtin_elementwise_fma((f32x2){q4.z, q4.w}, S23, (f32x2){q4.x, q4.y} * S01); const float o = row_sum16(o2.x + o2.y); keep = (p == (tl)) ? o : keep; } while (0)
#define GLA_CMP4(src, keep, tl0) do { GLA_ONE(src, 0, keep, tl0); GLA_ONE(src, 1, keep, (tl0) + 1); GLA_ONE(src, 2, keep, (tl0) + 2); GLA_ONE(src, 3, keep, (tl0) + 3); } while (0)
                if (nt == TB) {
                    G4 gA, gB; GLA_RD4(gA, 0);
                    GLA_RD4(gB, 4); __builtin_amdgcn_sched_barrier(0); GLA_CMP4(gA, okeep0, 0); GLA_RD4(gA, 8); __builtin_amdgcn_sched_barrier(0); GLA_CMP4(gB, okeep0, 4);
                    GLA_RD4(gB, 12); __builtin_amdgcn_sched_barrier(0); GLA_CMP4(gA, okeep0, 8); GLA_RD4(gA, 16); __builtin_amdgcn_sched_barrier(0); GLA_CMP4(gB, okeep0, 12);
                    GLA_RD4(gB, 20); __builtin_amdgcn_sched_barrier(0); GLA_CMP4(gA, okeep1, 0); GLA_RD4(gA, 24); __builtin_amdgcn_sched_barrier(0); GLA_CMP4(gB, okeep1, 4);
                    GLA_RD4(gB, 28); __builtin_amdgcn_sched_barrier(0); GLA_CMP4(gA, okeep1, 8); __builtin_amdgcn_sched_barrier(0); GLA_CMP4(gB, okeep1, 12);
                } else { G4 g1; for (int t = 0; t < nt; ++t) { const LAS float* vp_ = vec + t * 64; g1.a[0] = *(const LAS f32x4*)vp_; g1.k[0] = *(const LAS f32x4*)(vp_ + OK / 4); g1.q[0] = *(const LAS f32x4*)(vp_ + OQ / 4); g1.v[0] = vv[t * 16];
                    if (t < 16) GLA_ONE(g1, 0, okeep0, t); else GLA_ONE(g1, 0, okeep1, t - 16); } }
#undef GLA_RD4
#undef GLA_ONE
#undef GLA_CMP4
                { int pt_ = pt; asm volatile("" : "+v"(pt_)); const int p_ = pt_ & 15; GAS float* od = O + (size_t)(r0 + tb0 + p_) * 512 + h * 128 + cb * 16 + (pt_ >> 4);
                  if (p_ < nt) od[0] = okeep0 * 0.125f; if (16 + p_ < nt) od[(size_t)16 * 512] = okeep1 * 0.125f; }
            } else {
                if (b + 2 < nblk) { GLA_DMA(b + 2); if (wv == 7) GLA_WAITV(2); else GLA_WAITV(8); } else GLA_WAITV(0);
            }
            GLA_BAR();
        }
#undef GLA_DMA
        if (scanw) { int pt_ = pt; asm volatile("" : "+v"(pt_));
                     GAS float* so = P + ((size_t)pair * 64 + (pt_ & 15) * 4) * 128 + cb * 16 + (pt_ >> 4); so[0] = S01.x; so[128] = S01.y; so[256] = S23.x; so[384] = S23.y; }
        GLA_BAR();
    }
#undef GLA_WAITV
#undef GLA_BAR
}
__device__ __forceinline__ float grp8_sum(float v) { v += dppf<0xB1>(v); v += dppf<0x4E>(v); v += dppf<0x141>(v); return v; }
__device__ __forceinline__ float dot16_fp8_bf16(const u32x4 uw, const float (&x)[16]) { float s = 0.f;
#pragma unroll
    for (int d = 0; d < 4; ++d) { const f32x2 lo = fp8lo(uw[d]), hi = fp8hi(uw[d]); s = fmaf(lo.x, x[4 * d], s); s = fmaf(lo.y, x[4 * d + 1], s); s = fmaf(hi.x, x[4 * d + 2], s); s = fmaf(hi.y, x[4 * d + 3], s); }
    return s; }
typedef int i32x8 __attribute__((ext_vector_type(8)));
typedef unsigned u32x8 __attribute__((ext_vector_type(8)));
__device__ __forceinline__ void pacts_phase(const GAS unsigned char* XF8, const GAS unsigned char* U8S, const GAS int* EIDX, GAS bf16_t* __restrict__ PART, int M, int emask,
                                            LAS unsigned char* lds, int wid, int lane, int bid, int nb) {
    const bool spl = (nb & 7) == 0; const int s0 = spl ? (bid & 7) : 0, s1 = spl ? s0 + 1 : 8, r = spl ? (bid >> 3) : bid, nr = spl ? (nb >> 3) : nb;
    const int g = lane >> 3, c = lane & 7, fg = ((g >> 2) & 1) | (((g >> 1) & 1) << 2);
    const int m16 = lane & 15, kb = lane >> 4, fm = ((m16 >> 2) & 1) | (((m16 >> 1) & 1) << 2);
    LAS unsigned char* const wl = lds + wid * 16384;
    const LAS unsigned char* const ard = wl + m16 * 128 + (((2 * kb) ^ fm) * 16);
    const LAS unsigned char* const xrd = wl + 12288 + (m16 & 1) * 128 + kb * 32;
    const LAS unsigned char* const ird = wl + 13824 + g * 4;
    if (r >= M) return;
    const int ntok = (M - r + nr - 1) / nr;
#define PL_ROW(t_) ({ int rw_ = r + nr * (t_); rw_ < M ? rw_ : r; })
#define PL_IDS(t_, slot_) __builtin_amdgcn_global_load_lds((const GAS unsigned*)(isrc + (size_t)PL_ROW(t_) * 128), (LAS unsigned*)(wl + 13824 + (slot_) * 256), 4, 0, 0)
#define PL_RDIDS(slot_, e0_, e1_) do { e0_ = *(const LAS int*)(ird + (slot_) * 256); e1_ = *(const LAS int*)(ird + (slot_) * 256 + 32); } while (0)
#define PL_TILE(t_, slot_, e0_, e1_) do { \
        __builtin_amdgcn_global_load_lds((const GAS unsigned*)(tb + (size_t)((e0_) & emask) * 128), (LAS unsigned*)(wl + (slot_) * 2048), 16, 0, 0); \
        __builtin_amdgcn_global_load_lds((const GAS unsigned*)(tb + (size_t)((e1_) & emask) * 128), (LAS unsigned*)(wl + (slot_) * 2048 + 1024), 16, 0, 0); \
        __builtin_amdgcn_global_load_lds((const GAS unsigned*)(xsrc + (size_t)PL_ROW(t_) * 2048), (LAS unsigned*)(wl + 12288 + (slot_) * 256), 4, 0, 0); } while (0)
#define PL_RD(slot_, a0_, a1_, x0_, x1_) do { a0_ = *(const LAS u32x4*)(ard + (slot_) * 2048); a1_ = *(const LAS u32x4*)(ard2 + (slot_) * 2048); x0_ = *(const LAS u32x4*)(xrd + (slot_) * 256); x1_ = *(const LAS u32x4*)(xrd + (slot_) * 256 + 16); } while (0)
#define PL_MMA(cc_, a0_, a1_, x0_, x1_) do { const i32x8 av = (i32x8)__builtin_shufflevector(a0_, a1_, 0, 1, 2, 3, 4, 5, 6, 7), bv = (i32x8)__builtin_shufflevector(x0_, x1_, 0, 1, 2, 3, 4, 5, 6, 7); const f32x4 z = {0.f, 0.f, 0.f, 0.f}; \
        cc_ = __builtin_amdgcn_mfma_scale_f32_16x16x128_f8f6f4(av, bv, z, 0, 0, 0, 0, 0, 0); } while (0)
#define PL_OUT(t_, cc_) do { f32x4 o; _Pragma("unroll") for (int i = 0; i < 4; ++i) { float v = cc_[i]; v += dppf<0xB1>(v); o[i] = v * (1.f / 16.f); } \
        const int rw = r + nr * (t_); if (m16 == 0 && rw < M) { u32x2 w_; w_.x = pk_bf16(o[0], o[1]); w_.y = pk_bf16(o[2], o[3]); *(GAS u32x2*)(po + (size_t)rw * 128) = w_; } } while (0)
#define PL_WAIT(n_) asm volatile("s_waitcnt vmcnt(" #n_ ")" ::: "memory")
#define PL_STEP(j_, h_) do { PL_WAIT(12); u32x4 a0[3], a1[3], x0[3], x1[3]; int e0[3], e1[3]; f32x4 cc[3]; \
        _Pragma("unroll") for (int k = 0; k < 3; ++k) PL_RD((h_) * 3 + k, a0[k], a1[k], x0[k], x1[k]); \
        _Pragma("unroll") for (int k = 0; k < 3; ++k) PL_RDIDS((h_) * 3 + k, e0[k], e1[k]); \
        _Pragma("unroll") for (int k = 0; k < 3; ++k) PL_MMA(cc[k], a0[k], a1[k], x0[k], x1[k]); \
        _Pragma("unroll") for (int k = 0; k < 3; ++k) PL_TILE((j_) + 6 + k, (h_) * 3 + k, e0[k], e1[k]); \
        _Pragma("unroll") for (int k = 0; k < 3; ++k) PL_IDS((j_) + 12 + k, (h_) * 3 + k); \
        _Pragma("unroll") for (int k = 0; k < 3; ++k) PL_OUT((j_) + k, cc[k]); } while (0)
    const LAS unsigned char* const ard2 = (const LAS unsigned char*)((unsigned)(size_t)ard ^ 16u);
    for (int s = s0; s < s1; ++s) {
        const GAS unsigned char* tb = U8S + (size_t)s * 16384 * 128 + ((c ^ fg) * 16);
        const GAS unsigned char* xsrc = XF8 + (size_t)(lane >> 5) * 1024 + s * 128 + (lane & 31) * 4;
        const GAS int* isrc = EIDX + wid * 16 + m16;
        GAS bf16_t* po = PART + (size_t)s * M * 128 + wid * 16 + kb * 4;
        PL_IDS(0, 0); PL_IDS(1, 1); PL_IDS(2, 2); PL_IDS(3, 3); PL_IDS(4, 4); PL_IDS(5, 5); PL_WAIT(0);
        { int e0[6], e1[6];
#pragma unroll
          for (int k = 0; k < 6; ++k) PL_RDIDS(k, e0[k], e1[k]);
#pragma unroll
          for (int k = 0; k < 3; ++k) PL_TILE(k, k, e0[k], e1[k]);
#pragma unroll
          for (int k = 0; k < 3; ++k) PL_IDS(6 + k, k);
#pragma unroll
          for (int k = 3; k < 6; ++k) PL_TILE(k, k, e0[k], e1[k]);
#pragma unroll
          for (int k = 3; k < 6; ++k) PL_IDS(6 + k, k); }
        for (int j = 0; j < ntok; j += 6) { PL_STEP(j, 0); PL_STEP(j + 3, 1); }
        PL_WAIT(0);
    }
#undef PL_ROW
#undef PL_IDS
#undef PL_RDIDS
#undef PL_TILE
#undef PL_RD
#undef PL_MMA
#undef PL_OUT
#undef PL_WAIT
#undef PL_STEP
}
__device__ __forceinline__ void pouts_phase(const GAS float* __restrict__ COEF, const GAS int* __restrict__ EIDX, const GAS unsigned char* V8S, GAS bf16_t* __restrict__ YBUF, int M,
                                            int wid, int lane, int bid, int nb) {
    const bool spl = (nb & 7) == 0; const int s0 = spl ? (bid & 7) : 0, s1 = spl ? s0 + 1 : 8, r = spl ? (bid >> 3) : bid, nr = spl ? (nb >> 3) : nb;
    const int g = lane >> 3, ch = lane & 7, rstep = nr * 8;
#define PO_LOADCE(rw, c0, c1, v0, v1) do { c0 = COEF[(size_t)(rw) * 128 + lane] * (1.f / 64.f); c1 = COEF[(size_t)(rw) * 128 + 64 + lane] * (1.f / 64.f); v0 = EIDX[(size_t)(rw) * 128 + lane]; v1 = EIDX[(size_t)(rw) * 128 + 64 + lane]; } while (0)
#define PO_GATHER(vv_, vreg) do { _Pragma("unroll") for (int k = 0; k < 8; ++k) { const int e = __builtin_amdgcn_ds_bpermute((8 * k + g) << 2, vreg); vv_[k] = *(const GAS u32x4*)(tb + (size_t)(e & 16383) * 128); } } while (0)
#define PO_COMP(vv_, creg) do { _Pragma("unroll") for (int k = 0; k < 8; ++k) { const float c = __int_as_float(__builtin_amdgcn_ds_bpermute((8 * k + g) << 2, __float_as_int(creg))); const u32x4 w = vv_[k]; \
        const f32x2 c2 = (f32x2){c, c}; _Pragma("unroll") for (int d = 0; d < 4; ++d) { ac2[2 * d] = __builtin_elementwise_fma(c2, fp8lo(w[d]), ac2[2 * d]); ac2[2 * d + 1] = __builtin_elementwise_fma(c2, fp8hi(w[d]), ac2[2 * d + 1]); } \
        _Pragma("unroll") for (int i = 0; i < 8; ++i) asm volatile("" : "+v"(ac2[i])); } } while (0)
    for (int s = s0; s < s1; ++s) {
        const GAS unsigned char* tb = V8S + (size_t)s * 16384 * 128 + ch * 16;
        int row = r + nr * wid; if (row >= M) continue;
        float c0c, c1c, c0n = 0.f, c1n = 0.f; int v0c, v1c, v0n = 0, v1n = 0;
        PO_LOADCE(row, c0c, c1c, v0c, v1c);
        u32x4 va[8], vb[8];
        PO_GATHER(va, v0c);
        for (;;) {
            const int rown = row + rstep; const bool hasn = rown < M;
            PO_GATHER(vb, v1c);
            if (hasn) PO_LOADCE(rown, c0n, c1n, v0n, v1n);
            f32x2 ac2[8];
#pragma unroll
            for (int i = 0; i < 8; ++i) ac2[i] = (f32x2){0.f, 0.f};
            PO_COMP(va, c0c);
            if (hasn) PO_GATHER(va, v0n);
            PO_COMP(vb, c1c);
            float acc[16];
#pragma unroll
            for (int i = 0; i < 8; ++i) { acc[2 * i] = ac2[i].x; acc[2 * i + 1] = ac2[i].y; }
#pragma unroll
            for (int i = 0; i < 16; ++i) acc[i] += dppf<0x128>(acc[i]);
#pragma unroll
            for (int i = 0; i < 8; ++i) { const bool hi = lane & 16; const float send = hi ? acc[i] : acc[i + 8], keep = hi ? acc[i + 8] : acc[i]; acc[i] = keep + shx(send, 16, lane); }
#pragma unroll
            for (int i = 0; i < 4; ++i) { const bool hi = lane & 32; const float send = hi ? acc[i] : acc[i + 4], keep = hi ? acc[i + 4] : acc[i]; acc[i] = keep + shx(send, 32, lane); }
            if ((lane & 8) == 0) { u32x2 w_; w_.x = pk_bf16(acc[0], acc[1]); w_.y = pk_bf16(acc[2], acc[3]); *(GAS u32x2*)(YBUF + (size_t)row * 1024 + s * 128 + ch * 16 + ((lane >> 4) & 1) * 8 + ((lane >> 5) & 1) * 4) = w_; }
            if (!hasn) break;
            row = rown; c0c = c0n; c1c = c1n; v0c = v0n; v1c = v1n;
        }
    }
#undef PO_LOADCE
#undef PO_GATHER
#undef PO_COMP
}
}

template <class T> __device__ __forceinline__ __attribute__((address_space(1))) T* gp(T* p) { return (__attribute__((address_space(1))) T*)uni_ptr(p); }
constexpr int MK_THREADS = 512, LDS_BYTES = 163840, LDSCTL_OFF = 131072, TAB_OFF = LDSCTL_OFF + 1024, MAX_OPS = 208;
static_assert(TAB_OFF + MAX_OPS * (int)sizeof(Op) <= LDS_BYTES, "LDS map");
constexpr int MPAD = 17152;
constexpr size_t CTL_BYTES = (size_t)1 << 20;
struct MArgs { const float* in[47]; float* out; char* ws; unsigned long long ws_size; };
__global__ void __launch_bounds__(MK_THREADS, 2) mega_fwd(MArgs a) {
    extern __shared__ __attribute__((aligned(16))) unsigned char lds[];
    volatile LAS unsigned* ctl = (volatile LAS unsigned*)((LAS unsigned char*)lds + LDSCTL_OFF);
    if (threadIdx.x < 64) ctl[threadIdx.x] = 0u;
    __syncthreads();
    (void)xcd_barrier_post((unsigned*)a.ws, ctl + 8);
    const Dm dm = make_dm(1024, 8, 2048, 128, 4);
    Op* tab = (Op*)(lds + TAB_OFF);
    if (threadIdx.x == 0) {
        const float* const* inp_ = (const float* const*)__builtin_amdgcn_kernarg_segment_ptr(); asm volatile("" : "+s"(inp_));
        NvIO io; io.in = inp_; io.out = a.out; io.ws = a.ws + CTL_BYTES; io.ws_size = a.ws_size - CTL_BYTES;
        int n = 0;
        #ifdef PROBE_DUPCODE
        nv_forward(io, dm, [&](const Op& o) __attribute__((always_inline)) { if (n < MAX_OPS) tab[n] = o; ++n; if ((o.code & 0xff) == PROBE_DUPCODE) { if (n < MAX_OPS) tab[n] = o; ++n; } asm volatile("" ::: "memory"); });
#else
        nv_forward(io, dm, [&](const Op& o) __attribute__((always_inline)) { if (n < MAX_OPS) tab[n] = o; ++n; asm volatile("" ::: "memory"); });
#endif
        ctl[16] = (unsigned)(n <= MAX_OPS ? n : 0);
    }
    __syncthreads();
    const int nops = (int)ctl[16];
    for (int i = 0; i < nops; ++i) {
        int tid_ = (int)threadIdx.x, bid_ = (int)blockIdx.x, nb_ = (int)gridDim.x;
        asm volatile("" : "+v"(tid_)); asm volatile("" : "+s"(bid_)); asm volatile("" : "+s"(nb_));
        const long long g0 = (long long)bid_ * MK_THREADS + tid_, gs = (long long)nb_ * MK_THREADS;
        const Op& o = tab[i];
        const int rawc = __builtin_amdgcn_readfirstlane(o.code); const int code = rawc & 0xff; const long long n = o.n;
        switch (code) {
        case OP_FGEMM: {
            const int fl = rfl(o.i6);
            pg8::Gemm g{uni_ptr((const pg8::bf16_t*)o.a), uni_ptr((const pg8::bf16_t*)o.b), MPAD, rfl(o.i5), rfl(o.i1), rfl(o.i2), rfl(o.i3)};
            if (rawc & OPF_GROUP) {
                int ng = 1; while (ng < 8 && (rfl(tab[i + ng - 1].code) & OPF_GROUP)) ++ng;
                const PG8_LAS Op* gt = (const PG8_LAS Op*)((PG8_LAS unsigned char*)lds + TAB_OFF) + i;
                pg8::GroupOrder S; S.tab = gt; S.ng = ng; S.nM = MPAD / 256; S.G = nb_; S.c = bid_; S.tsA = (size_t)256 * g.lda * 2; S.tsB = (size_t)256 * g.ldb * 2;
                pg8::EpiGroup E{gt, dm.M};
                pg8::gemm_phase<pg8::EpiGroup, pg8::GroupOrder, true, true>((PG8_LAS unsigned char*)lds, g, S, E);
                i += ng - 1;
            } else {
            pg8::StaticOrder S; S.init(g, nb_, bid_); if (fl & 2) S.acs = 512;
            float* const c0 = uni_ptr(o.o0); const int ldc0 = rfl(o.i4), nreal0 = rfl(o.i0);
            if (fl & 1) { pg8::EpiBf16Plain E{(pg8::bf16_t*)c0, ldc0}; pg8::gemm_phase<pg8::EpiBf16Plain, pg8::StaticOrder, true, true>((PG8_LAS unsigned char*)lds, g, S, E); }
            else { pg8::EpiF32 E{c0, ldc0, dm.M, nreal0}; pg8::gemm_phase<pg8::EpiF32, pg8::StaticOrder, true, true>((PG8_LAS unsigned char*)lds, g, S, E); }
            }
        } break;
        case OP_LRUG2: {
            pg8::Gemm g{uni_ptr((const pg8::bf16_t*)o.a), uni_ptr((const pg8::bf16_t*)o.b), MPAD, 1024, 512, 512, 512};
            pg8::StaticOrder S; S.init(g, nb_, bid_);
            pg8::EpiLru E{uni_ptr(o.c), uni_ptr(o.d), uni_ptr(o.e), uni_ptr((const pg8::bf16_t*)o.f), uni_ptr(o.o0), uni_ptr(o.o1), dm.M};
            pg8::gemm_phase<pg8::EpiLru, pg8::StaticOrder, true, true>((PG8_LAS unsigned char*)lds, g, S, E);
        } break;
        case OP_WKVP: fk::wkv2_phase(gp((const fk::bf16_t*)o.a), gp((const fk::bf16_t*)o.b), gp((const fk::bf16_t*)o.c), gp((const fk::bf16_t*)o.d), gp((const fk::bf16_t*)o.e), gp((const fk::bf16_t*)o.f), gp((const fk::bf16_t*)o.g), gp(o.h), gp((const float*)o.o5), gp((fk::bf16_t*)o.o0), gp(o.o1), gp(o.o2), gp((fk::bf16_t*)o.o3), gp(o.o4), rfl(o.i0), dm.B, dm.T, dm.DB, dm.DT, (LAS unsigned char*)lds, tid_, bid_, nb_); break;
        case OP_POST2: fk::rwkvpost2_phase(gp((const fk::bf16_t*)o.a), gp((const fk::bf16_t*)o.b), gp((const fk::bf16_t*)o.c), gp(o.d), gp(o.e), gp(o.f), gp((fk::bf16_t*)o.o0), dm.M * 16, tid_ & 63, bid_ * 8 + (tid_ >> 6), nb_ * 8); break;
        case OP_GLAF: fk::gla_phase(gp(o.a), gp(o.b), gp(o.o0), gp(o.o1), dm.B, dm.T, (LAS unsigned char*)lds, tid_, bid_, nb_); break;
        case OP_PACTS: fk::pacts_phase(gp((const unsigned char*)o.a), gp((const unsigned char*)o.b), gp((const int*)o.d), gp((fk::bf16_t*)o.o0), dm.M, rfl(o.i0), (LAS unsigned char*)lds, rfl(tid_ >> 6), tid_ & 63, bid_, nb_); break;
        case OP_POUTS: fk::pouts_phase(gp(o.a), gp((const int*)o.b), gp((const unsigned char*)o.c), gp((fk::bf16_t*)o.o0), dm.M, tid_ >> 6, tid_ & 63, bid_, nb_); break;
        case OP_TOPK2: fk::topk_phase(gp((const fk::bf16_t*)o.a), gp((const fk::bf16_t*)o.b), gp(o.c), gp(o.o0), gp((int*)o.o1), dm.M * 8, (LAS unsigned char*)lds, tid_ >> 6, tid_ & 63, bid_ * 8 + (tid_ >> 6), nb_ * 8); break;
        case OP_LNRES: fk::lnres_phase(gp((const fk::bf16_t*)o.a), gp(o.b), gp(o.c), gp(o.o0), gp((fk::bf16_t*)o.o1), gp((unsigned char*)o.o2), dm.M, tid_ & 63, bid_ * 8 + (tid_ >> 6), nb_ * 8); break;
        case OP_GLANORM: fk::glanorm_phase(gp(o.a), gp(o.b), gp(o.c), gp((fk::bf16_t*)o.o0), dm.M * 4, tid_ & 63, bid_ * 8 + (tid_ >> 6), nb_ * 8); break;
        case OP_CVTTAB8S: {
            int X = rfl(o.i6) % nb_; X = (X < nb_ - 1) ? X : 0;
            if (bid_ >= X) { const long long gs2 = (long long)(nb_ - X) * MK_THREADS; for (long long g = (long long)(bid_ - X) * MK_THREADS + tid_; g < n; g += gs2) nv_elem(OP_CVTTAB8S, o, dm, g); } } break;
#define NVC(c) case c: for (long long g = g0; g < n; g += gs) nv_elem(c, o, dm, g); break;
        NVC(OP_LOGA4) NVC(OP_CONVOUT) NVC(OP_SHIFTOUT) NVC(OP_EMBED4) NVC(OP_YOUT4) NVC(OP_MIX6) NVC(OP_CONV4) NVC(OP_CVT8) NVC(OP_WGATE)
        NVC(OP_WT) NVC(OP_PRED) NVC(OP_PRM) NVC(OP_KEYS) NVC(OP_GLA3) NVC(OP_LRU1) NVC(OP_LRU3)
#undef NVC
        default: break;
        }
        if (__builtin_amdgcn_readfirstlane(tab[i].code) & OPF_NOBAR) __syncthreads(); else { XcdBarrier bar; bar.bar = (unsigned*)a.ws; bar.x = xb_xcc_id(); bar.st = ctl + 8; xcd_barrier(bar); }
    }
}
extern "C" void kernel_launch(void* const* d_in, const int* in_sizes, int n_in, void* d_out, int out_size, void* d_ws, size_t ws_size, hipStream_t stream) {
    static int grid = 0;
    if (grid == 0) {
        if (n_in != 47 || ws_size < ((size_t)900 << 20)) { fprintf(stderr, "kernel_launch: expected 47 inputs and >= 900 MiB of workspace; got %d, %zu\n", n_in, ws_size); grid = -1; return; }
        int dev = 0, cus = 0, per_cu = 0;
        if (hipGetDevice(&dev) != hipSuccess || hipDeviceGetAttribute(&cus, hipDeviceAttributeMultiprocessorCount, dev) != hipSuccess) { grid = -1; return; }
        if (hipFuncSetAttribute((const void*)mega_fwd, hipFuncAttributeMaxDynamicSharedMemorySize, LDS_BYTES) != hipSuccess) { fprintf(stderr, "kernel_launch: hipFuncSetAttribute failed\n"); grid = -1; return; }
        if (hipOccupancyMaxActiveBlocksPerMultiprocessor(&per_cu, (const void*)mega_fwd, MK_THREADS, LDS_BYTES) != hipSuccess || per_cu < 1) fprintf(stderr, "kernel_launch: occupancy query says %d per CU\n", per_cu);
        (void)hipGetLastError();
        grid = cus;
    }
    if (grid < 0) return;
    if (hipMemsetAsync(d_ws, 0, CTL_BYTES, stream) != hipSuccess) { fprintf(stderr, "kernel_launch: memset failed\n"); return; }
    MArgs a{}; for (int i = 0; i < 47; ++i) a.in[i] = (const float*)d_in[i]; a.out = (float*)d_out; a.ws = (char*)d_ws; a.ws_size = (unsigned long long)ws_size;
    hipLaunchKernelGGL(mega_fwd, dim3(grid), dim3(MK_THREADS), LDS_BYTES, stream, a);
}
```

```cpp
#include <hip/hip_runtime.h>
#include <cstdio>
#include <cmath>
#ifndef HD
#define HD __host__ __device__ __forceinline__
#endif
struct Dm { int D, B, T, DB, DT, M, NSEQ, RH; };
HD Dm make_dm(int D, int B, int SEQ, int DB, int DT) { Dm d; d.D = D; d.B = B; d.T = SEQ + 16; d.DB = DB; d.DT = DT; d.M = B * d.T + DB * DT; d.NSEQ = B + DB; d.RH = D / 64; return d; }
HD int seq_row0(const Dm& d, int s) { return s < d.B ? s * d.T : d.B * d.T + (s - d.B) * d.DT; }
HD int seq_len(const Dm& d, int s) { return s < d.B ? d.T : d.DT; }
HD void row_to_seq(const Dm& d, int row, int& s, int& t) { if (row < d.B * d.T) { s = row / d.T; t = row % d.T; } else { int r = row - d.B * d.T; s = d.B + r / d.DT; t = r % d.DT; } }

constexpr int MIXIN = 2576, C_Q = 0, C_K = 256, C_V = 512, C_GLR = 1024, C_R = 1040, C_XB = 1552, C_GB = 2064;

enum { OP_EMBED = 1, OP_GEMM, OP_LOGA, OP_GLA, OP_GLANORM, OP_CONV, OP_CONVOUT, OP_LRUG, OP_LRUSCAN, OP_LNRES, OP_MIX, OP_SHIFTOUT,
       OP_RWKVPREP, OP_WKV, OP_RWKVPOST, OP_QNORM, OP_SCORES, OP_TOPK, OP_PACT1, OP_PACT2, OP_POUT, OP_YOUT, OP_WT, OP_CVT, OP_FGEMM, OP_CVTTAB, OP_KEYS, OP_TOPK2, OP_PACT, OP_POUTLN, OP_GLA1, OP_GLA2, OP_GLA3, OP_LRU1, OP_LRU2, OP_LRU3, OP_EMBED4, OP_YOUT4, OP_MIX8, OP_CONV4, OP_CVT8, OP_WGATE, OP_LRUG2, OP_WKVF, OP_GLAF, OP_CVTTAB8, OP_CVTTAB8S, OP_PACTS, OP_PRED, OP_POUTS, OP_MIX6, OP_PRM, OP_WKVP, OP_POST2, OP_LOGA4 };

constexpr int OPF_NOBAR = 0x100, OPF_GROUP = 0x200;
struct Op {
    const float *a, *b, *c, *d, *e, *f, *g, *h;
    float *o0, *o1, *o2, *o3, *o4, *o5;
    long long n;
    int code, i0, i1, i2, i3, i4, i5, i6;
};

#if defined(__HIP_DEVICE_COMPILE__)
#define NV_UNI(x) __builtin_amdgcn_readfirstlane(x)
#define NV_LAUNDER(p) asm volatile("" : "+s"(p))
#define NV_FENCE() asm volatile("" ::: "memory")
#else
#define NV_FENCE() do {} while (0)
#define NV_UNI(x) (x)
#define NV_LAUNDER(p) do {} while (0)
#endif
typedef unsigned short nvbf;
HD nvbf nv_f2bf(float f) { unsigned u; __builtin_memcpy(&u, &f, 4); return (nvbf)((u + 0x7fffu + ((u >> 16) & 1u)) >> 16); }
HD float nv_bf2f(nvbf h) { unsigned u = (unsigned)h << 16; float f; __builtin_memcpy(&f, &u, 4); return f; }
HD unsigned nv_f2e4m3(float f) {
    unsigned u; __builtin_memcpy(&u, &f, 4); const unsigned sign = (u >> 24) & 0x80u; const float a = fabsf(f);
    if (!(a < 448.f)) return sign | 0x7Eu;
    if (a < 0.015625f) return sign | (unsigned)rintf(a * 512.f);
    unsigned au = u & 0x7fffffffu; au += 0x7ffffu + ((au >> 20) & 1u);
    const unsigned e = ((au >> 23) & 0xffu) - 120u, m = (au >> 20) & 7u; unsigned code = (e << 3) | m; if (code > 0x7Eu) code = 0x7Eu;
    return sign | code; }
HD float nv_e4m32f(unsigned c) { const unsigned e = (c >> 3) & 15u, m = c & 7u; const float v = e ? ldexpf(1.f + m * 0.125f, (int)e - 7) : m * 0.001953125f; return (c & 0x80u) ? -v : v; }
HD int nv_rup(int x, int m) { return (x + m - 1) / m * m; }
struct alignas(16) NvF4 { float x, y, z, w; };
struct alignas(16) NvU4 { unsigned x, y, z, w; };
struct alignas(8) NvU2 { unsigned x, y; };
#if defined(__HIP_DEVICE_COMPILE__)
#define NV_EXP(x) __expf(x)
#define NV_TANH(x) (1.f - 2.f * __builtin_amdgcn_rcpf(1.f + __expf(2.f * (x))))
HD float nv_sigmoid(float x) { return __builtin_amdgcn_rcpf(1.f + __expf(-x)); }
HD float nv_softplus(float x) { return fmaxf(x, 0.f) + __logf(1.f + __expf(-fabsf(x))); }
HD float nv_gelu(float x) { return x * __builtin_amdgcn_rcpf(1.f + __expf(-1.5957691216057308f * (x + 0.044715f * x * x * x))); }
#else
#define NV_EXP(x) expf(x)
#define NV_TANH(x) tanhf(x)
HD float nv_sigmoid(float x) { return 1.f / (1.f + expf(-x)); }
HD float nv_softplus(float x) { return fmaxf(x, 0.f) + log1pf(expf(-fabsf(x))); }
HD float nv_gelu(float x) { return 0.5f * x * (1.f + tanhf(0.7978845608028654f * (x + 0.044715f * x * x * x))); }
#endif

#define NV_INS16(tv, ti, val, idx) do { float _v = (val); int _i = (idx); _Pragma("unroll") for (int _j = 0; _j < 16; ++_j) { if (_v > tv[_j]) { float _tv = tv[_j]; int _ti = ti[_j]; tv[_j] = _v; ti[_j] = _i; _v = _tv; _i = _ti; } } } while (0)

HD void nv_elem(const int code, const Op& p, const Dm& dm, long long gid) {
    const int D = dm.D; float* const PO1 = p.o1; float* const PO2 = p.o2;
    switch (code) {
    case OP_EMBED: {
        int row = (int)(gid / D), c = (int)(gid % D); float v;
        if (row < dm.B * dm.T) { int bb = row / dm.T, t = row % dm.T; v = t < 16 ? p.c[t * D + c] : p.a[((size_t)bb * (dm.T - 16) + (t - 16)) * D + c]; }
        else v = p.b[(size_t)(row - dm.B * dm.T) * D + c];
        p.o0[gid] = v; ((nvbf*)p.o1)[gid] = nv_f2bf(v); } break;
    case OP_GEMM: {
        int N4 = p.i0 >> 2, K = p.i1; int m = (int)(gid / N4), nn = (int)(gid % N4) * 4; const float* A = p.a + (size_t)m * p.i2; const float* Bw = p.b + nn; float c0 = 0.f, c1 = 0.f, c2 = 0.f, c3 = 0.f;
        for (int k = 0; k < K; ++k) { float av = A[k]; if (p.i5 == 1) av = NV_TANH(av); else if (p.i5 == 2) av = nv_sigmoid(av); const NvF4 bv = *(const NvF4*)(Bw + (size_t)k * p.i3);
            c0 = fmaf(av, bv.x, c0); c1 = fmaf(av, bv.y, c1); c2 = fmaf(av, bv.z, c2); c3 = fmaf(av, bv.w, c3); }
        float* C = p.o0 + (size_t)m * p.i4 + nn; C[0] = c0; C[1] = c1; C[2] = c2; C[3] = c3; } break;
    case OP_LOGA: {
        int row = (int)(gid / 256), c = (int)(gid % 256); float z = p.c[c];
        for (int r = 0; r < 16; ++r) z = fmaf(p.a[(size_t)row * MIXIN + C_GLR + r], p.b[r * 256 + c], z);
        p.o0[gid] = NV_EXP(-nv_softplus(-z) * (1.f / 16.f)); } break;
    case OP_GLAF:
    case OP_GLA: {
        int s = (int)(gid / 512), h = (int)((gid / 128) % 4), col = (int)(gid % 128);
        float S[64];
        const float* sin = (s < dm.B) ? nullptr : p.c + (((size_t)(s - dm.B) * 4 + h) * 64) * 128 + col;
#pragma unroll
        for (int k = 0; k < 64; ++k) S[k] = sin ? sin[(size_t)k * 128] : 0.f;
        int r0 = seq_row0(dm, s), L = seq_len(dm, s);
        for (int t = 0; t < L; ++t) {
            const float* pr = p.a + (size_t)(r0 + t) * MIXIN; const float* la = p.b + (size_t)(r0 + t) * 256 + h * 64;
            float v = pr[C_V + h * 128 + col], o = 0.f;
#pragma unroll
            for (int k = 0; k < 64; ++k) { if ((k & 7) == 0) NV_FENCE(); S[k] = fmaf(la[k], S[k], pr[C_K + h * 64 + k] * v); o = fmaf(pr[C_Q + h * 64 + k] * 0.125f, S[k], o); }
            p.o0[(size_t)(r0 + t) * 512 + h * 128 + col] = o;
        }
        float* so = (s < dm.B) ? PO1 + (((size_t)s * 4 + h) * 64) * 128 + col : PO2 + (((size_t)(s - dm.B) * 4 + h) * 64) * 128 + col;
#pragma unroll
        for (int k = 0; k < 64; ++k) so[(size_t)k * 128] = S[k]; } break;
    case OP_GLA1: {
        const int NC = p.i0; const int u = NV_UNI((int)(gid / 128)), col = (int)(gid % 128); const int s = u / (4 * NC), h = (u / NC) % 4, c = u % NC;
        const int r0 = seq_row0(dm, s) + c * 64; int L = dm.T - c * 64; L = L > 64 ? 64 : L;
        float S[64];
#pragma unroll
        for (int k = 0; k < 64; ++k) S[k] = 0.f;
        float dprod = 1.f;
        for (int t = 0; t < L; ++t) {
            const float* pr = p.a + (size_t)(r0 + t) * MIXIN; const float* la = p.b + (size_t)(r0 + t) * 256 + h * 64; const float v = pr[C_V + h * 128 + col];
            if (col < 64) dprod *= la[col];
#pragma unroll
            for (int k = 0; k < 64; ++k) { if ((k & 7) == 0) NV_FENCE(); S[k] = fmaf(la[k], S[k], pr[C_K + h * 64 + k] * v); }
        }
        float* so = p.o0 + (size_t)u * 8192 + col;
#pragma unroll
        for (int k = 0; k < 64; ++k) so[(size_t)k * 128] = S[k];
        if (col < 64) p.o1[(size_t)u * 64 + col] = dprod; } break;
    case OP_GLA2: {
        const int NC = p.i0; const int pair = (int)(gid / 8192), e = (int)(gid % 8192), dk = e / 128; float S = 0.f;
        for (int c = 0; c < NC; ++c) { const size_t ix = ((size_t)pair * NC + c) * 8192 + e; const float l = p.o0[ix]; p.o0[ix] = S; S = fmaf(p.a[((size_t)pair * NC + c) * 64 + dk], S, l); }
        p.o1[gid] = S; } break;
    case OP_GLA3: {
        const int NC = p.i0; const int NP = dm.B * 4 * NC; const int u = NV_UNI((int)(gid / 128)) + (p.i1 ? NP : 0), col = (int)(gid % 128); int s, h, r0, L; const float* sin; float* sout = nullptr;
        if (u < NP) { s = u / (4 * NC); h = (u / NC) % 4; const int c = u % NC; r0 = seq_row0(dm, s) + c * 64; L = dm.T - c * 64; L = L > 64 ? 64 : L; sin = p.d + (size_t)u * 8192 + col; }
        else { const int q = u - NP; s = dm.B + q / 4; h = q % 4; r0 = seq_row0(dm, s); L = dm.DT; sin = p.c + (((size_t)(s - dm.B) * 4 + h) * 64) * 128 + col; sout = p.o2 + (((size_t)(s - dm.B) * 4 + h) * 64) * 128 + col; }
        float S[64];
#pragma unroll
        for (int k = 0; k < 64; ++k) S[k] = sin[(size_t)k * 128];
        for (int t = 0; t < L; ++t) {
            const float* pr = p.a + (size_t)(r0 + t) * MIXIN; const float* la = p.b + (size_t)(r0 + t) * 256 + h * 64; const float v = pr[C_V + h * 128 + col]; float o = 0.f;
#pragma unroll
            for (int k = 0; k < 64; ++k) { if ((k & 7) == 0) NV_FENCE(); S[k] = fmaf(la[k], S[k], pr[C_K + h * 64 + k] * v); o = fmaf(pr[C_Q + h * 64 + k] * 0.125f, S[k], o); }
            p.o0[(size_t)(r0 + t) * 512 + h * 128 + col] = o;
        }
        if (sout) {
#pragma unroll
            for (int k = 0; k < 64; ++k) sout[(size_t)k * 128] = S[k]; } } break;
    case OP_LRU1: {
        const int NC = p.i0; const int u = (int)(gid / 512), c = (int)(gid % 512); const int nfull = dm.B * (NC - 1); const int s = u < nfull ? u / (NC - 1) : u - nfull, ch = u < nfull ? u % (NC - 1) : NC - 1;
        const int r0 = seq_row0(dm, s) + ch * 64; int L = dm.T - ch * 64; L = L > 64 ? 64 : L; float hh = 0.f, ap = 1.f; const size_t oi = ((size_t)s * NC + ch) * 512 + c;
#pragma unroll 16
        for (int t = 0; t < L; ++t) { const size_t ix = (size_t)(r0 + t) * 512 + c; const float a = p.a[ix]; hh = fmaf(a, hh, p.b[ix]); ap *= a; }
        p.o0[oi] = ap; p.o1[oi] = hh; } break;
    case OP_LRU2: {
        const int NC = p.i0; const int s = (int)(gid / 512), c = (int)(gid % 512); float hh = 0.f;
#pragma unroll 8
        for (int ch = 0; ch < NC; ++ch) { const size_t ix = ((size_t)s * NC + ch) * 512 + c; const float l = p.o0[ix]; p.o0[ix] = hh; hh = fmaf(p.a[ix], hh, l); }
        p.o1[gid] = hh; } break;
    case OP_LRU3: {
        const int NC = p.i0; const int u = (int)(gid / 512), c = (int)(gid % 512); const int NP = dm.B * NC; int r0, L; float hh; float* hout = nullptr;
        if (u < NP) { const int nfull = dm.B * (NC - 1); const int s = u < nfull ? u / (NC - 1) : u - nfull, ch = u < nfull ? u % (NC - 1) : NC - 1; r0 = seq_row0(dm, s) + ch * 64; L = dm.T - ch * 64; L = L > 64 ? 64 : L; hh = 0.f;
            for (int k0 = 0; k0 < ch; k0 += 16) { float la[16], lb[16];
#pragma unroll
                for (int k = 0; k < 16; ++k) { int kk = k0 + k; kk = kk < ch ? kk : ch - 1; const size_t ix = ((size_t)s * NC + kk) * 512 + c; la[k] = p.f[ix]; lb[k] = p.e[ix]; }
#pragma unroll
                for (int k = 0; k < 16; ++k) if (k0 + k < ch) hh = fmaf(la[k], hh, lb[k]); }
            if (ch == NC - 1) hout = p.o1 + (size_t)s * 512 + c; }
        else { const int q = u - NP; r0 = seq_row0(dm, dm.B + q); L = dm.DT; hh = p.d[(size_t)q * 512 + c]; hout = p.o2 + (size_t)q * 512 + c; }
        for (int t0 = 0; t0 < L; t0 += 16) {
            float av[16], bv[16], gv[16];
#pragma unroll
            for (int k = 0; k < 16; ++k) { int t = t0 + k; t = t < L ? t : L - 1; const size_t r = (size_t)(r0 + t); av[k] = p.a[r * 512 + c]; bv[k] = p.b[r * 512 + c]; gv[k] = p.c[r * MIXIN + C_GB + c]; }
#pragma unroll
            for (int k = 0; k < 16; ++k) if (t0 + k < L) { const size_t r = (size_t)(r0 + t0 + k); hh = fmaf(av[k], hh, bv[k]); ((nvbf*)p.o0)[r * 1024 + 512 + c] = nv_f2bf(hh * nv_gelu(gv[k])); } }
        if (hout) *hout = hh; } break;
    case OP_EMBED4: {
        const int D4 = D / 4; const int row = (int)(gid / D4), c = (int)(gid % D4) * 4; const float* src;
        if (row < dm.B * dm.T) { const int bb = row / dm.T, t = row % dm.T; src = t < 16 ? p.c + (size_t)t * D + c : p.a + ((size_t)bb * (dm.T - 16) + (t - 16)) * D + c; } else src = p.b + (size_t)(row - dm.B * dm.T) * D + c;
        const NvF4 v = *(const NvF4*)src; NvU2 w; w.x = nv_f2bf(v.x) | ((unsigned)nv_f2bf(v.y) << 16); w.y = nv_f2bf(v.z) | ((unsigned)nv_f2bf(v.w) << 16); *(NvU2*)((nvbf*)p.o1 + (size_t)row * D + c) = w; } break;
    case OP_YOUT4: {
        const int D4 = D / 4; const int row = (int)(gid / D4), c = (int)(gid % D4) * 4; const NvU2 w_ = *(const NvU2*)((const nvbf*)p.a + (size_t)row * D + c); NvF4 v; v.x = nv_bf2f((nvbf)(w_.x & 0xffffu)); v.y = nv_bf2f((nvbf)(w_.x >> 16)); v.z = nv_bf2f((nvbf)(w_.y & 0xffffu)); v.w = nv_bf2f((nvbf)(w_.y >> 16));
        if (row < dm.B * dm.T) { const int bb = row / dm.T, t = row % dm.T; if (t >= 16) *(NvF4*)(p.o0 + ((size_t)bb * (dm.T - 16) + (t - 16)) * D + c) = v; }
        else *(NvF4*)(p.o0 + ((size_t)dm.B * (dm.T - 16) + (row - dm.B * dm.T)) * D + c) = v; } break;
    case OP_MIX8: {
        const int D8 = D / 8; const int row = (int)(gid / D8), c = (int)(gid % D8) * 8; int s, t; row_to_seq(dm, row, s, t); const float* x = p.a + (size_t)row * D + c; float xp[8];
        if (t > 0) { for (int i = 0; i < 8; ++i) xp[i] = x[i - D]; } else if (s < dm.B) { for (int i = 0; i < 8; ++i) xp[i] = 0.f; } else { for (int i = 0; i < 8; ++i) xp[i] = p.b[(size_t)(s - dm.B) * D + c + i]; }
        unsigned w[4];
#pragma unroll
        for (int i = 0; i < 4; ++i) { const float lo = x[2 * i] + (xp[2 * i] - x[2 * i]) * p.c[c + 2 * i], hi = x[2 * i + 1] + (xp[2 * i + 1] - x[2 * i + 1]) * p.c[c + 2 * i + 1]; w[i] = nv_f2bf(lo) | ((unsigned)nv_f2bf(hi) << 16); }
        NvU4 o; o.x = w[0]; o.y = w[1]; o.z = w[2]; o.w = w[3]; *(NvU4*)((nvbf*)p.o0 + (size_t)row * D + c) = o; } break;
    case OP_MIX6: {
        const int D8 = D / 8, Q = (dm.M + 3) / 4; const int row0 = (int)(gid / D8), c = (int)(gid % D8) * 8; NvU4 xw[4], pw[4]; NvF4 sh0[4], sh1[4]; int kind[4];
#pragma unroll
        for (int q = 0; q < 4; ++q) { int row = row0 + q * Q; row = row < dm.M ? row : row0; int s, t; row_to_seq(dm, row, s, t); const nvbf* x = (const nvbf*)p.a + (size_t)row * D + c;
            kind[q] = t > 0 ? 0 : (s < dm.B ? 1 : 2); xw[q] = *(const NvU4*)x; pw[q] = *(const NvU4*)(x - (t > 0 ? D : 0));
            const float* sp = p.b + (size_t)(s >= dm.B ? s - dm.B : 0) * D + c; sh0[q] = *(const NvF4*)sp; sh1[q] = *(const NvF4*)(sp + 4); }
        NvF4 mu0[6], mu1[6];
#pragma unroll
        for (int m = 0; m < 6; ++m) { mu0[m] = *(const NvF4*)(p.c + (size_t)m * D + c); mu1[m] = *(const NvF4*)(p.c + (size_t)m * D + c + 4); }
#pragma unroll
        for (int q = 0; q < 4; ++q) { const int row = row0 + q * Q; if (row < dm.M) { float xv[8], dx[8]; const unsigned xs[4] = {xw[q].x, xw[q].y, xw[q].z, xw[q].w}, ps[4] = {pw[q].x, pw[q].y, pw[q].z, pw[q].w};
            const float shv[8] = {sh0[q].x, sh0[q].y, sh0[q].z, sh0[q].w, sh1[q].x, sh1[q].y, sh1[q].z, sh1[q].w};
#pragma unroll
            for (int i = 0; i < 4; ++i) { xv[2 * i] = nv_bf2f((nvbf)(xs[i] & 0xffffu)); xv[2 * i + 1] = nv_bf2f((nvbf)(xs[i] >> 16)); const float p0 = nv_bf2f((nvbf)(ps[i] & 0xffffu)), p1 = nv_bf2f((nvbf)(ps[i] >> 16));
                const float q0 = kind[q] == 0 ? p0 : (kind[q] == 1 ? 0.f : shv[2 * i]), q1 = kind[q] == 0 ? p1 : (kind[q] == 1 ? 0.f : shv[2 * i + 1]); dx[2 * i] = q0 - xv[2 * i]; dx[2 * i + 1] = q1 - xv[2 * i + 1]; }
#pragma unroll
            for (int m = 0; m < 6; ++m) { const float mv[8] = {mu0[m].x, mu0[m].y, mu0[m].z, mu0[m].w, mu1[m].x, mu1[m].y, mu1[m].z, mu1[m].w}; unsigned w[4];
#pragma unroll
                for (int i = 0; i < 4; ++i) w[i] = nv_f2bf(xv[2 * i] + dx[2 * i] * mv[2 * i]) | ((unsigned)nv_f2bf(xv[2 * i + 1] + dx[2 * i + 1] * mv[2 * i + 1]) << 16);
                NvU4 o; o.x = w[0]; o.y = w[1]; o.z = w[2]; o.w = w[3]; *(NvU4*)((nvbf*)p.o0 + (size_t)m * (size_t)p.i1 * 1024 + (size_t)row * D + c) = o; } } } } break;
    case OP_CONV4: {
        const int Q = (dm.M + 3) / 4; const int row0 = (int)(gid / 128), c = (int)(gid % 128) * 4; const NvF4 bias = *(const NvF4*)(p.d + c); NvF4 wt[4]; for (int i = 0; i < 4; ++i) wt[i] = *(const NvF4*)(p.c + i * 512 + c);
        NvF4 xv[4][4]; int ok[4];
#pragma unroll
        for (int q = 0; q < 4; ++q) { int row = row0 + q * Q; ok[q] = row < dm.M; row = ok[q] ? row : row0; int s, t; row_to_seq(dm, row, s, t);
#pragma unroll
            for (int i = 0; i < 4; ++i) { const int j = t + i; const int sb = s >= dm.B ? s - dm.B : 0, jb = j < 3 ? j : 0;
                const float* src = j >= 3 ? p.a + (size_t)(row - t + (j - 3)) * MIXIN + C_XB + c : p.b + ((size_t)sb * 3 + jb) * 512 + c; const float msk = (j >= 3 || s >= dm.B) ? 1.f : 0.f;
                const NvF4 v = *(const NvF4*)src; xv[q][i].x = v.x * msk; xv[q][i].y = v.y * msk; xv[q][i].z = v.z * msk; xv[q][i].w = v.w * msk; } }
#pragma unroll
        for (int q = 0; q < 4; ++q) if (ok[q]) { const int row = row0 + q * Q; NvF4 o = bias;
#pragma unroll
            for (int i = 0; i < 4; ++i) { o.x = fmaf(xv[q][i].x, wt[i].x, o.x); o.y = fmaf(xv[q][i].y, wt[i].y, o.y); o.z = fmaf(xv[q][i].z, wt[i].z, o.z); o.w = fmaf(xv[q][i].w, wt[i].w, o.w); }
            NvU2 w; w.x = nv_f2bf(o.x) | ((unsigned)nv_f2bf(o.y) << 16); w.y = nv_f2bf(o.z) | ((unsigned)nv_f2bf(o.w) << 16); *(NvU2*)((nvbf*)p.o1 + (size_t)row * 512 + c) = w; } } break;
    case OP_CVT8: {
        const int K8 = p.i2 / 8; const int row = (int)(gid / K8), k = (int)(gid % K8) * 8; unsigned w[4] = {0u, 0u, 0u, 0u};
        if (row < dm.M && k < p.i0) { const float* sp = p.a + (size_t)row * p.i1 + k;
#pragma unroll
            for (int i = 0; i < 4; ++i) { float lo = sp[2 * i], hi = sp[2 * i + 1]; if (p.i3 == 1) { lo = NV_TANH(lo); hi = NV_TANH(hi); } else if (p.i3 == 2) { lo = nv_sigmoid(lo); hi = nv_sigmoid(hi); } w[i] = nv_f2bf(lo) | ((unsigned)nv_f2bf(hi) << 16); } }
        NvU4 o; o.x = w[0]; o.y = w[1]; o.z = w[2]; o.w = w[3]; *(NvU4*)((nvbf*)p.o0 + (size_t)row * p.i2 + k) = o; } break;
    case OP_WGATE: {
        const int ch = (int)(gid % 64), n = (int)(gid / 64), pn = n >> 8, within = n & 127, isx = (n >> 7) & 1, c = pn * 128 + within, nb = c >> 6, e = c & 63, k0 = ch * 8; const float* w = isx ? p.b : p.a; NvU4 o; o.x = o.y = o.z = o.w = 0u;
        if ((k0 >> 6) == nb) { float v[8];
#pragma unroll
            for (int i = 0; i < 8; ++i) v[i] = w[((size_t)nb * 64 + ((k0 + i) & 63)) * 64 + e];
            o.x = nv_f2bf(v[0]) | ((unsigned)nv_f2bf(v[1]) << 16); o.y = nv_f2bf(v[2]) | ((unsigned)nv_f2bf(v[3]) << 16); o.z = nv_f2bf(v[4]) | ((unsigned)nv_f2bf(v[5]) << 16); o.w = nv_f2bf(v[6]) | ((unsigned)nv_f2bf(v[7]) << 16); }
        *(NvU4*)((nvbf*)p.o0 + (size_t)n * 512 + k0) = o;
        if (ch == 0 && n < 512) p.o1[n] = -8.f * nv_softplus(-p.c[n]); } break;
    case OP_LRUG2: {
        const int row = (int)(gid / 512), c = (int)(gid % 512), pn = c >> 7, within = c & 127; const nvbf* x = (const nvbf*)p.a + (size_t)row * 512; const nvbf* wa_ = (const nvbf*)p.b + (size_t)(pn * 256 + within) * 512; const nvbf* wx_ = wa_ + (size_t)128 * 512; float ga = 0.f, gx = 0.f;
        for (int k = 0; k < 512; ++k) { const float xv = nv_bf2f(x[k]); ga = fmaf(xv, nv_bf2f(wa_[k]), ga); gx = fmaf(xv, nv_bf2f(wx_[k]), gx); }
        const float gate_a = nv_sigmoid(ga + p.c[c]), gate_x = nv_sigmoid(gx + p.d[c]); const float log_at = gate_a * p.e[c];
        p.o0[gid] = NV_EXP(log_at); p.o1[gid] = sqrtf(-expm1f(2.f * log_at)) * (gate_x * nv_bf2f(((const nvbf*)p.f)[gid])); } break;
    case OP_LOGA4: {
        const int row = (int)(gid / 64), c = (int)(gid % 64) * 4; const float* gl = p.a + (size_t)row * MIXIN + C_GLR; NvF4 z = *(const NvF4*)(p.c + c);
#pragma unroll
        for (int r4 = 0; r4 < 4; ++r4) { const NvF4 g = *(const NvF4*)(gl + 4 * r4);
            const NvF4 w0 = *(const NvF4*)(p.b + (4 * r4 + 0) * 256 + c), w1 = *(const NvF4*)(p.b + (4 * r4 + 1) * 256 + c), w2 = *(const NvF4*)(p.b + (4 * r4 + 2) * 256 + c), w3 = *(const NvF4*)(p.b + (4 * r4 + 3) * 256 + c);
            z.x = fmaf(g.x, w0.x, z.x); z.y = fmaf(g.x, w0.y, z.y); z.z = fmaf(g.x, w0.z, z.z); z.w = fmaf(g.x, w0.w, z.w); z.x = fmaf(g.y, w1.x, z.x); z.y = fmaf(g.y, w1.y, z.y); z.z = fmaf(g.y, w1.z, z.z); z.w = fmaf(g.y, w1.w, z.w);
            z.x = fmaf(g.z, w2.x, z.x); z.y = fmaf(g.z, w2.y, z.y); z.z = fmaf(g.z, w2.z, z.z); z.w = fmaf(g.z, w2.w, z.w); z.x = fmaf(g.w, w3.x, z.x); z.y = fmaf(g.w, w3.y, z.y); z.z = fmaf(g.w, w3.z, z.z); z.w = fmaf(g.w, w3.w, z.w); }
        NvF4 o; o.x = NV_EXP(-nv_softplus(-z.x) * (1.f / 16.f)); o.y = NV_EXP(-nv_softplus(-z.y) * (1.f / 16.f)); o.z = NV_EXP(-nv_softplus(-z.z) * (1.f / 16.f)); o.w = NV_EXP(-nv_softplus(-z.w) * (1.f / 16.f));
        *(NvF4*)(p.o0 + (size_t)row * 256 + c) = o; } break;
    case OP_GLANORM: {
        int row = (int)(gid / 4), h = (int)(gid % 4); const float* o = p.a + (size_t)row * 512 + h * 128; float ss = 0.f;
        for (int c = 0; c < 128; ++c) ss = fmaf(o[c], o[c], ss);
        float rs = 1.f / sqrtf(ss * (1.f / 128.f) + 1e-5f);
        for (int c = 0; c < 128; ++c) { float r = p.b[(size_t)row * MIXIN + C_R + h * 128 + c]; ((nvbf*)p.o0)[(size_t)row * 1024 + h * 128 + c] = nv_f2bf(o[c] * rs * p.c[c] * (r * nv_sigmoid(r))); } } break;
    case OP_CONV: {
        int row = (int)(gid / 512), c = (int)(gid % 512); int s, t; row_to_seq(dm, row, s, t); float acc = p.d[c];
        for (int i = 0; i < 4; ++i) { int j = t + i; float xv;
            if (j < 3) xv = (s < dm.B) ? 0.f : p.b[((size_t)(s - dm.B) * 3 + j) * 512 + c]; else xv = p.a[(size_t)(row - t + (j - 3)) * MIXIN + C_XB + c];
            acc = fmaf(xv, p.c[i * 512 + c], acc); }
        p.o0[gid] = acc; } break;
    case OP_CONVOUT: {
        int s = (int)(gid / 1536), i = (int)((gid / 512) % 3), c = (int)(gid % 512); int L = seq_len(dm, s), r0 = seq_row0(dm, s); int j = L + i; float xv;
        if (j < 3) xv = (s < dm.B) ? 0.f : p.b[((size_t)(s - dm.B) * 3 + j) * 512 + c]; else xv = p.a[(size_t)(r0 + j - 3) * MIXIN + C_XB + c];
        float* o = (s < dm.B) ? PO1 + ((size_t)s * 3 + i) * 512 + c : PO2 + ((size_t)(s - dm.B) * 3 + i) * 512 + c; *o = xv; } break;
    case OP_LRUG: {
        int row = (int)(gid / 512), c = (int)(gid % 512), nb = c / 64, e = c % 64; const float* x = p.a + (size_t)row * 512 + nb * 64; float ga = p.c[c], gx = p.e[c];
        for (int dd = 0; dd < 64; ++dd) { ga = fmaf(x[dd], p.b[((size_t)nb * 64 + dd) * 64 + e], ga); gx = fmaf(x[dd], p.d[((size_t)nb * 64 + dd) * 64 + e], gx); }
        float gate_a = nv_sigmoid(ga), gate_x = nv_sigmoid(gx); float log_at = -8.f * gate_a * nv_softplus(-p.f[c]);
        p.o0[gid] = NV_EXP(log_at); p.o1[gid] = sqrtf(-expm1f(2.f * log_at)) * (gate_x * p.a[(size_t)row * 512 + c]); } break;
    case OP_LRUSCAN: {
        int s = (int)(gid / 512), c = (int)(gid % 512); int r0 = seq_row0(dm, s), L = seq_len(dm, s); float hh = (s < dm.B) ? 0.f : p.d[(size_t)(s - dm.B) * 512 + c];
        for (int t = 0; t < L; ++t) { size_t r = (size_t)(r0 + t); hh = fmaf(p.a[r * 512 + c], hh, p.b[r * 512 + c]); p.o0[r * 1024 + 512 + c] = hh * nv_gelu(p.c[r * MIXIN + C_GB + c]); }
        float* o = (s < dm.B) ? PO1 + (size_t)s * 512 + c : PO2 + (size_t)(s - dm.B) * 512 + c; *o = hh; } break;
    case OP_LNRES: {
        const float alpha = 1.6817928305074292f; nvbf* x = (nvbf*)p.o1 + (size_t)gid * D; const nvbf* y = (const nvbf*)p.a + (size_t)gid * D; float mu = 0.f;
        for (int c = 0; c < D; ++c) mu += alpha * nv_bf2f(x[c]) + nv_bf2f(y[c]);
        mu /= D; float var = 0.f;
        for (int c = 0; c < D; ++c) { float v = alpha * nv_bf2f(x[c]) + nv_bf2f(y[c]) - mu; var = fmaf(v, v, var); }
        float rs = 1.f / sqrtf(var / D + 1e-5f);
        for (int c = 0; c < D; ++c) { const float o = (alpha * nv_bf2f(x[c]) + nv_bf2f(y[c]) - mu) * rs * p.b[c] + p.c[c]; x[c] = nv_f2bf(o);
            if (p.o3) { const int row = (int)gid; if (row < dm.B * dm.T) { const int bb = row / dm.T, t = row % dm.T; if (t >= 16) p.o3[((size_t)bb * (dm.T - 16) + (t - 16)) * D + c] = o; } else p.o3[((size_t)dm.B * (dm.T - 16) + (row - dm.B * dm.T)) * D + c] = o; }
            if (p.o2) { unsigned char* f8 = (unsigned char*)p.o2 + (size_t)gid * 2 * D; const float xs = fminf(fmaxf(o * 16.f, -448.f), 448.f); const unsigned hc = nv_f2e4m3(xs); f8[c] = (unsigned char)hc; f8[D + c] = (unsigned char)nv_f2e4m3(xs - nv_e4m32f(hc)); } } } break;
    case OP_MIX: {
        int row = (int)(gid / D), c = (int)(gid % D); int s, t; row_to_seq(dm, row, s, t); float x = p.a[gid];
        float xp = t > 0 ? p.a[gid - D] : ((s < dm.B) ? 0.f : p.b[(size_t)(s - dm.B) * D + c]);
        ((nvbf*)p.o0)[gid] = nv_f2bf(x + (xp - x) * p.c[c]); } break;
    case OP_SHIFTOUT: {
        int s = (int)(gid / D), c = (int)(gid % D); float v = nv_bf2f(((const nvbf*)p.a)[(size_t)(seq_row0(dm, s) + seq_len(dm, s) - 1) * D + c]);
        float* o = (s < dm.B) ? PO1 + (size_t)s * D + c : PO2 + (size_t)(s - dm.B) * D + c; *o = v; } break;
    case OP_RWKVPREP: {
        int row = (int)(gid / dm.RH), h = (int)(gid % dm.RH); size_t base = (size_t)row * D + h * 64; float ss = 0.f;
        for (int k = 0; k < 64; ++k) { float kv = p.o0[base + k] * p.d[h * 64 + k]; ss = fmaf(kv, kv, ss); }
        float inv = 1.f / fmaxf(sqrtf(ss), 1e-12f);
        for (int k = 0; k < 64; ++k) { int c = h * 64 + k; size_t ix = base + k;
            float w = -nv_softplus(-(p.a[c] + p.o1[ix])) - 0.5f; float dec = NV_EXP(-NV_EXP(w));
            float a = nv_sigmoid(p.b[c] + p.o2[ix]);
            float v = p.o3[ix]; if (p.i0) v = v + (p.o5[ix] - v) * nv_sigmoid(p.c[c] + p.f[ix]); else p.o5[ix] = v;
            float k0 = p.o0[ix]; const float kk = k0 * p.d[c] * inv; p.o4[ix] = -kk; p.o0[ix] = k0 * (1.f + (a - 1.f) * p.e[c]); p.o1[ix] = dec; p.o2[ix] = kk * a; p.o3[ix] = v; } } break;
    case OP_WKVF:
    case OP_WKV: {
        int RH = dm.RH; int s = p.i0 + (int)(gid / (RH * 64)), h = (int)((gid / 64) % RH), vr = (int)(gid % 64); float S[64];
        const float* sin = (s < dm.B) ? nullptr : p.g + (((size_t)(s - dm.B) * RH + h) * 64 + vr) * 64;
#pragma unroll
        for (int k = 0; k < 64; ++k) S[k] = sin ? sin[k] : 0.f;
        int r0 = seq_row0(dm, s), L = seq_len(dm, s);
        for (int t = 0; t < L; ++t) { size_t base = (size_t)(r0 + t) * D + h * 64; float sa = 0.f;
#pragma unroll
            for (int k = 0; k < 64; ++k) { if ((k & 7) == 0) NV_FENCE(); sa = fmaf(S[k], p.f[base + k], sa); }
            float vv = p.d[base + vr], y = 0.f;
#pragma unroll
            for (int k = 0; k < 64; ++k) { if ((k & 7) == 0) NV_FENCE(); S[k] = fmaf(S[k], p.b[base + k], fmaf(sa, p.e[base + k], vv * p.c[base + k])); y = fmaf(S[k], p.a[base + k], y); }
            p.o0[base + vr] = y; }
        float* so = (s < dm.B) ? PO1 + (((size_t)s * RH + h) * 64 + vr) * 64 : PO2 + (((size_t)(s - dm.B) * RH + h) * 64 + vr) * 64;
#pragma unroll
        for (int k = 0; k < 64; ++k) so[k] = S[k]; } break;
    case OP_RWKVPOST: {
        int row = (int)(gid / dm.RH), h = (int)(gid % dm.RH); size_t base = (size_t)row * D + h * 64; float mu = 0.f, bon = 0.f;
        for (int k = 0; k < 64; ++k) { mu += p.a[base + k]; bon = fmaf(p.b[base + k] * p.c[base + k], p.f[h * 64 + k], bon); }
        mu *= (1.f / 64.f); float var = 0.f;
        for (int k = 0; k < 64; ++k) { float dlt = p.a[base + k] - mu; var = fmaf(dlt, dlt, var); }
        float rs = 1.f / sqrtf(var * (1.f / 64.f) + 64e-5f);
        for (int k = 0; k < 64; ++k) { int c = h * 64 + k; float y = (p.a[base + k] - mu) * rs * p.g[c] + p.h[c] + bon * p.d[base + k]; ((nvbf*)p.o0)[base + k] = nv_f2bf(y * p.e[base + k]); } } break;
    case OP_PRM: {
        const int m = (int)(gid / D), c = (int)(gid % D); const float* src = m == 0 ? p.a : m == 1 ? p.b : m == 2 ? p.c : m == 3 ? p.d : m == 4 ? p.e : p.f; p.o0[gid] = src ? src[c] : 0.f; } break;
    case OP_WKVP: {
        const int RH = dm.RH; const int s = (int)(gid / (RH * 64)), h = (int)((gid / 64) % RH), vr = (int)(gid % 64); float S[64];
        const float* sin = (s < dm.B) ? nullptr : p.o5 + (((size_t)(s - dm.B) * RH + h) * 64 + vr) * 64;
        for (int k = 0; k < 64; ++k) S[k] = sin ? sin[k] : 0.f;
        const float* w0 = p.h + h * 64; const float* a0 = p.h + D + h * 64; const float* v0 = p.h + 2 * D + h * 64; const float* k_k = p.h + 3 * D + h * 64; const float* k_a = p.h + 4 * D + h * 64; const float* r_k = p.h + 5 * D + h * 64;
        const int r0 = seq_row0(dm, s), L = seq_len(dm, s); const nvbf* bR = (const nvbf*)p.a; const nvbf* bK = (const nvbf*)p.b; const nvbf* bWL = (const nvbf*)p.c; const nvbf* bAL = (const nvbf*)p.d; const nvbf* bV = (const nvbf*)p.e; const nvbf* bVG = (const nvbf*)p.f;
        for (int t = 0; t < L; ++t) { const size_t base = (size_t)(r0 + t) * D + h * 64; float ss = 0.f;
            for (int k = 0; k < 64; ++k) { const float kv = nv_bf2f(bK[base + k]) * k_k[k]; ss = fmaf(kv, kv, ss); }
            const float inv = 1.f / fmaxf(sqrtf(ss), 1e-12f);
            float vv = nv_bf2f(bV[base + vr]); if (p.i0) vv = vv + (nv_bf2f(((const nvbf*)p.g)[base + vr]) - vv) * nv_sigmoid(v0[vr] + nv_bf2f(bVG[base + vr]));
            float sa = 0.f, bon = 0.f, dec[64], bb[64], k2[64];
            for (int k = 0; k < 64; ++k) { const float k0 = nv_bf2f(bK[base + k]); const float kk = k0 * k_k[k] * inv; const float a = nv_sigmoid(a0[k] + nv_bf2f(bAL[base + k]));
                dec[k] = NV_EXP(-0.6065306597126334f * nv_sigmoid(w0[k] + nv_bf2f(bWL[base + k])));
                bb[k] = kk * a; k2[k] = k0 * (1.f + (a - 1.f) * k_a[k]); sa = fmaf(S[k], -kk, sa); bon = fmaf(nv_bf2f(bR[base + k]) * k2[k], r_k[k], bon); }
            float y = 0.f;
            for (int k = 0; k < 64; ++k) { S[k] = fmaf(S[k], dec[k], fmaf(sa, bb[k], vv * k2[k])); y = fmaf(S[k], nv_bf2f(bR[base + k]), y); }
            ((nvbf*)p.o0)[base + vr] = nv_f2bf(y); ((nvbf*)p.o3)[base + vr] = nv_f2bf(vv); if (vr == 0) p.o4[(size_t)(r0 + t) * RH + h] = bon; }
        float* so = (s < dm.B) ? PO1 + (((size_t)s * RH + h) * 64 + vr) * 64 : PO2 + (((size_t)(s - dm.B) * RH + h) * 64 + vr) * 64;
        for (int k = 0; k < 64; ++k) so[k] = S[k]; } break;
    case OP_POST2: {
        const int row = (int)(gid / dm.RH), h = (int)(gid % dm.RH); const size_t base = (size_t)row * D + h * 64; const nvbf* ya = (const nvbf*)p.a; const nvbf* vf = (const nvbf*)p.c; float mu = 0.f;
        for (int k = 0; k < 64; ++k) mu += nv_bf2f(ya[base + k]);
        mu *= (1.f / 64.f); float var = 0.f;
        for (int k = 0; k < 64; ++k) { const float dlt = nv_bf2f(ya[base + k]) - mu; var = fmaf(dlt, dlt, var); }
        const float rs = 1.f / sqrtf(var * (1.f / 64.f) + 64e-5f), bon = p.d[gid];
        for (int k = 0; k < 64; ++k) { const int c = h * 64 + k; const float y = (nv_bf2f(ya[base + k]) - mu) * rs * p.e[c] + p.f[c] + bon * nv_bf2f(vf[base + k]); ((nvbf*)p.o0)[base + k] = nv_f2bf(y * nv_bf2f(((const nvbf*)p.b)[base + k])); } } break;
    case OP_QNORM: {
        float* q = p.o0 + (size_t)gid * 256; float mu = 0.f;
        for (int c = 0; c < 256; ++c) mu += q[c];
        mu *= (1.f / 256.f); float var = 0.f;
        for (int c = 0; c < 256; ++c) { float dlt = q[c] - mu; var = fmaf(dlt, dlt, var); }
        float rs = 1.f / sqrtf(var * (1.f / 256.f) + 1e-5f);
        for (int c = 0; c < 256; ++c) q[c] = (q[c] - mu) * rs; } break;
    case OP_SCORES: {
        int row = (int)(gid / 2048), r = (int)(gid % 2048), h = r / 256, half = (r / 128) & 1, key = r % 128;
        const float* q = p.a + (size_t)row * 2048 + h * 256 + half * 128; const float* kv = p.b + (((size_t)h * 2 + half) * 128 + key) * 128; float acc = 0.f;
        for (int dd = 0; dd < 128; ++dd) acc = fmaf(q[dd], kv[dd], acc);
        p.o0[gid] = acc; } break;
    case OP_TOPK: {
        const float* sc = p.a + (size_t)gid * 256; float tv[16]; int ti[16]; float* tmpv = p.o2 + (size_t)gid * 32; int* tmpi = (int*)p.o3 + (size_t)gid * 32;
        for (int half = 0; half < 2; ++half) {
#pragma unroll
            for (int j = 0; j < 16; ++j) { tv[j] = -3.0e38f; ti[j] = 0; }
            for (int k = 0; k < 128; ++k) NV_INS16(tv, ti, sc[half * 128 + k], k);
#pragma unroll
            for (int j = 0; j < 16; ++j) { tmpv[half * 16 + j] = tv[j]; tmpi[half * 16 + j] = ti[j]; }
        }
#pragma unroll
        for (int j = 0; j < 16; ++j) { tv[j] = -3.0e38f; ti[j] = 0; }
        for (int i = 0; i < 16; ++i) for (int j = 0; j < 16; ++j) NV_INS16(tv, ti, tmpv[i] + tmpv[16 + j], tmpi[i] * 128 + tmpi[16 + j]);
        float den = 0.f, ev[16];
#pragma unroll
        for (int j = 0; j < 16; ++j) { ev[j] = NV_EXP(tv[j] - tv[0]); den += ev[j]; }
        float inv = 1.f / den;
#pragma unroll
        for (int j = 0; j < 16; ++j) { p.o0[(size_t)gid * 16 + j] = ev[j] * inv; ((int*)p.o1)[(size_t)gid * 16 + j] = ti[j]; } } break;
    case OP_PACT1: {
        size_t pr = (size_t)(gid / 16); int part = (int)(gid % 16); int row = (int)(pr / 128); int e = ((const int*)p.d)[pr]; int w = D / 16;
        const float* u = p.b + (size_t)e * D + part * w; const float* x = p.a + (size_t)row * D + part * w; float acc = 0.f;
        for (int c = 0; c < w; ++c) acc = fmaf(u[c], x[c], acc);
        p.o0[gid] = acc; } break;
    case OP_PACT2: {
        float acc = 0.f; for (int i = 0; i < 16; ++i) acc += p.a[(size_t)gid * 16 + i];
        p.o0[gid] = p.c[gid] * nv_gelu(acc); } break;
    case OP_POUT: {
        int row = (int)(gid / D), c = (int)(gid % D); float acc = 0.f;
        for (int i = 0; i < 128; ++i) acc = fmaf(p.a[(size_t)row * 128 + i], p.c[(size_t)((const int*)p.b)[(size_t)row * 128 + i] * D + c], acc);
        p.o0[gid] = acc; } break;
    case OP_YOUT: {
        int row = (int)(gid / D), c = (int)(gid % D);
        if (row < dm.B * dm.T) { int bb = row / dm.T, t = row % dm.T; if (t >= 16) p.o0[((size_t)bb * (dm.T - 16) + (t - 16)) * D + c] = p.a[gid]; }
        else p.o0[((size_t)dm.B * (dm.T - 16) + (row - dm.B * dm.T)) * D + c] = p.a[gid]; } break;
    case OP_WT: {
        const int N = p.i0, K = p.i1, Np = p.i3, Kp = p.i4; const long long per8 = (long long)Np * (Kp / 8); const int bt = (int)(gid / per8); const long long r = gid % per8; const int k0 = (int)(r / Np) * 8, nn = (int)(r % Np);
        unsigned w[4];
#pragma unroll
        for (int i = 0; i < 4; ++i) { float lo = 0.f, hi = 0.f; if (nn < N) { if (k0 + 2 * i < K) lo = p.a[((size_t)bt * K + k0 + 2 * i) * p.i2 + nn]; if (k0 + 2 * i + 1 < K) hi = p.a[((size_t)bt * K + k0 + 2 * i + 1) * p.i2 + nn]; } w[i] = nv_f2bf(lo) | ((unsigned)nv_f2bf(hi) << 16); }
        NvU4 o; o.x = w[0]; o.y = w[1]; o.z = w[2]; o.w = w[3];
        *(NvU4*)((nvbf*)p.o0 + (size_t)bt * Np * Kp + (size_t)nn * Kp + k0) = o; } break;
    case OP_CVT: {
        const int Kp = p.i2; const int row = (int)(gid / Kp), k = (int)(gid % Kp); float v = 0.f;
        if (row < dm.M && k < p.i0) { v = p.a[(size_t)row * p.i1 + k]; if (p.i3 == 1) v = NV_TANH(v); else if (p.i3 == 2) v = nv_sigmoid(v); }
        ((nvbf*)p.o0)[gid] = nv_f2bf(v); } break;
    case OP_FGEMM: {
        const int N = p.i0; const int m = (int)(gid / N), nn = (int)(gid % N); const nvbf* A = (const nvbf*)p.a + (size_t)m * p.i2 + ((p.i6 & 2) ? (nn / 256) * 256 : 0); const nvbf* Bt = (const nvbf*)p.b + (size_t)nn * p.i3; float acc = 0.f;
        for (int k = 0; k < p.i1; ++k) acc = fmaf(nv_bf2f(A[k]), nv_bf2f(Bt[k]), acc);
        if (p.i6 & 4) { const int act = p.i6 >> 3; float v = acc; if (act == 1) v = NV_TANH(v); else if (act == 2) v = nv_sigmoid(v); nvbf* d = (nvbf*)p.o0 + (size_t)m * 128; d[nn] = nv_f2bf(v);
            if (nn == N - 1) for (int c = N; c < 128; ++c) d[c] = 0; }
        else if (p.i6 & 1) ((nvbf*)p.o0)[(size_t)m * p.i4 + nn] = nv_f2bf(acc); else p.o0[(size_t)m * p.i4 + nn] = acc; } break;
    case OP_CVTTAB: {
        const NvF4 v0 = *(const NvF4*)(p.a + gid * 8), v1 = *(const NvF4*)(p.a + gid * 8 + 4); NvU4 o;
        o.x = nv_f2bf(v0.x) | ((unsigned)nv_f2bf(v0.y) << 16); o.y = nv_f2bf(v0.z) | ((unsigned)nv_f2bf(v0.w) << 16); o.z = nv_f2bf(v1.x) | ((unsigned)nv_f2bf(v1.y) << 16); o.w = nv_f2bf(v1.z) | ((unsigned)nv_f2bf(v1.w) << 16);
        *(NvU4*)((nvbf*)p.o0 + gid * 8) = o; } break;
    case OP_CVTTAB8: {
        const float sc = (float)(1 << p.i0); const float* sp = p.a + gid * 16; unsigned w[4];
#pragma unroll
        for (int q = 0; q < 4; ++q) { const NvF4 v = *(const NvF4*)(sp + 4 * q); w[q] = nv_f2e4m3(v.x * sc) | (nv_f2e4m3(v.y * sc) << 8) | (nv_f2e4m3(v.z * sc) << 16) | (nv_f2e4m3(v.w * sc) << 24); }
        NvU4 o; o.x = w[0]; o.y = w[1]; o.z = w[2]; o.w = w[3]; *(NvU4*)((unsigned char*)p.o0 + gid * 16) = o; } break;
    case OP_CVTTAB8S: {
        const float sc = (float)(1 << p.i0); const int per = D / 16; const int e = (int)(gid / per), c0 = (int)(gid % per) * 16; const float* sp = p.a + (size_t)e * D + c0; unsigned w[4];
#pragma unroll
        for (int q = 0; q < 4; ++q) { const NvF4 v = *(const NvF4*)(sp + 4 * q);
#if defined(__HIP_DEVICE_COMPILE__)
            int pk = __builtin_amdgcn_cvt_pk_fp8_f32(v.x * sc, v.y * sc, 0, false); pk = __builtin_amdgcn_cvt_pk_fp8_f32(v.z * sc, v.w * sc, pk, true); w[q] = (unsigned)pk;
#else
            w[q] = nv_f2e4m3(v.x * sc) | (nv_f2e4m3(v.y * sc) << 8) | (nv_f2e4m3(v.z * sc) << 16) | (nv_f2e4m3(v.w * sc) << 24);
#endif
        }
        NvU4 o; o.x = w[0]; o.y = w[1]; o.z = w[2]; o.w = w[3]; *(NvU4*)((unsigned char*)p.o0 + ((size_t)(c0 >> 7) * 16384 + e) * 128 + (c0 & 127)) = o; } break;
    case OP_PACTS: {
        const long long NP = (long long)dm.M * 128; const int sl = (int)(gid / NP); const long long pr = gid % NP; const int row = (int)(pr / 128); const int e = ((const int*)p.d)[pr] & p.i0;
        const unsigned char* u = (const unsigned char*)p.b + ((size_t)sl * 16384 + e) * 128; const unsigned char* x = (const unsigned char*)p.a + (size_t)row * 2 * D + sl * 128; float acc = 0.f;
        for (int c = 0; c < 128; ++c) acc = fmaf(nv_e4m32f(u[c]), nv_e4m32f(x[c]) + nv_e4m32f(x[D + c]), acc);
        ((nvbf*)p.o0)[gid] = nv_f2bf(acc * (1.f / 16.f)); } break;
    case OP_PRED: {
        const long long NP = (long long)dm.M * 128; const size_t e0 = (size_t)gid * 8; float ac[8] = {0.f, 0.f, 0.f, 0.f, 0.f, 0.f, 0.f, 0.f};
#pragma unroll 8
        for (int sl = 0; sl < p.i0; ++sl) { const NvU4 w = *(const NvU4*)((const nvbf*)p.a + (size_t)sl * NP + e0); const unsigned ws[4] = {w.x, w.y, w.z, w.w};
#pragma unroll
            for (int i = 0; i < 4; ++i) { ac[2 * i] += nv_bf2f((nvbf)(ws[i] & 0xffffu)); ac[2 * i + 1] += nv_bf2f((nvbf)(ws[i] >> 16)); } }
        const NvF4 g0 = *(const NvF4*)(p.c + e0), g1 = *(const NvF4*)(p.c + e0 + 4); NvF4 o0, o1;
        o0.x = g0.x * nv_gelu(ac[0] * (1.f / 128.f)); o0.y = g0.y * nv_gelu(ac[1] * (1.f / 128.f)); o0.z = g0.z * nv_gelu(ac[2] * (1.f / 128.f)); o0.w = g0.w * nv_gelu(ac[3] * (1.f / 128.f));
        o1.x = g1.x * nv_gelu(ac[4] * (1.f / 128.f)); o1.y = g1.y * nv_gelu(ac[5] * (1.f / 128.f)); o1.z = g1.z * nv_gelu(ac[6] * (1.f / 128.f)); o1.w = g1.w * nv_gelu(ac[7] * (1.f / 128.f));
        *(NvF4*)(p.o0 + e0) = o0; *(NvF4*)(p.o0 + e0 + 4) = o1; } break;
    case OP_POUTS: {
        const int row = (int)(gid / D), c = (int)(gid % D); const unsigned char* vb = (const unsigned char*)p.c + (size_t)(c >> 7) * 16384 * 128 + (c & 127); float acc = 0.f;
        for (int i = 0; i < 128; ++i) acc = fmaf(p.a[(size_t)row * 128 + i] * (1.f / 64.f), nv_e4m32f(vb[(size_t)((const int*)p.b)[(size_t)row * 128 + i] * 128]), acc);
        ((nvbf*)p.o0)[gid] = nv_f2bf(acc); } break;
    case OP_KEYS: {
        const int ch = (int)(gid % 32), hr = (int)(gid / 32), h = hr / 256, nrow = hr % 256, half = nrow >> 7, k0 = ch * 8; const float* src = p.a + (((size_t)h * 2 + half) * 128 + (nrow & 127)) * 128;
        NvU4 o; o.x = o.y = o.z = o.w = 0u;
        if ((k0 >> 7) == half) { const NvF4 v0 = *(const NvF4*)(src + (k0 & 127)), v1 = *(const NvF4*)(src + (k0 & 127) + 4);
            o.x = nv_f2bf(v0.x) | ((unsigned)nv_f2bf(v0.y) << 16); o.y = nv_f2bf(v0.z) | ((unsigned)nv_f2bf(v0.w) << 16); o.z = nv_f2bf(v1.x) | ((unsigned)nv_f2bf(v1.y) << 16); o.w = nv_f2bf(v1.z) | ((unsigned)nv_f2bf(v1.w) << 16); }
        *(NvU4*)((nvbf*)p.o0 + ((size_t)h * 256 + nrow) * 256 + k0) = o;
        if (ch == 0) { float ks = 0.f;
#pragma unroll 8
            for (int k = 0; k < 128; k += 4) { const NvF4 v = *(const NvF4*)(src + k); ks += (nv_bf2f(nv_f2bf(v.x)) + nv_bf2f(nv_f2bf(v.y))) + (nv_bf2f(nv_f2bf(v.z)) + nv_bf2f(nv_f2bf(v.w))); }
            p.o1[hr] = ks; } } break;
    case OP_TOPK2: {
        const int h = (int)(gid % 8); const nvbf* sc = (const nvbf*)p.a + (size_t)gid * 256; const nvbf* q = (const nvbf*)p.b + (size_t)gid * 256; const float* ksum = p.c + h * 256; float mu = 0.f;
        for (int c = 0; c < 256; ++c) mu += nv_bf2f(q[c]);
        mu *= (1.f / 256.f); float var = 0.f;
        for (int c = 0; c < 256; ++c) { float dlt = nv_bf2f(q[c]) - mu; var = fmaf(dlt, dlt, var); }
        const float rs = 1.f / sqrtf(var * (1.f / 256.f) + 1e-5f);
        float tv[16]; int ti[16]; float* tmpv = p.o2 + (size_t)gid * 32; int* tmpi = (int*)p.o3 + (size_t)gid * 32;
        for (int half = 0; half < 2; ++half) {
#pragma unroll
            for (int j = 0; j < 16; ++j) { tv[j] = -3.0e38f; ti[j] = 0; }
            for (int k = 0; k < 128; ++k) NV_INS16(tv, ti, rs * (nv_bf2f(sc[half * 128 + k]) - mu * ksum[half * 128 + k]), k);
#pragma unroll
            for (int j = 0; j < 16; ++j) { tmpv[half * 16 + j] = tv[j]; tmpi[half * 16 + j] = ti[j]; }
        }
#pragma unroll
        for (int j = 0; j < 16; ++j) { tv[j] = -3.0e38f; ti[j] = 0; }
        for (int i = 0; i < 16; ++i) for (int j = 0; j < 16; ++j) NV_INS16(tv, ti, tmpv[i] + tmpv[16 + j], tmpi[i] * 128 + tmpi[16 + j]);
        float den = 0.f, ev[16];
#pragma unroll
        for (int j = 0; j < 16; ++j) { ev[j] = NV_EXP(tv[j] - tv[0]); den += ev[j]; }
        float inv = 1.f / den;
#pragma unroll
        for (int j = 0; j < 16; ++j) { p.o0[(size_t)gid * 16 + j] = ev[j] * inv; ((int*)p.o1)[(size_t)gid * 16 + j] = ti[j]; } } break;
    case OP_PACT: {
        const int row = (int)(gid / 128); const int e = ((const int*)p.d)[gid]; const unsigned char* u = (const unsigned char*)p.b + (size_t)e * D; const nvbf* x = (const nvbf*)p.a + (size_t)row * D; float acc = 0.f;
        for (int c = 0; c < D; ++c) acc = fmaf(nv_e4m32f(u[c]), nv_bf2f(x[c]), acc);
        p.o0[gid] = p.c[gid] * nv_gelu(acc * (1.f / 128.f)); } break;
#if defined(HOST_TEST)
    case OP_POUTLN: {
        const float alpha = 1.6817928305074292f; float* x = p.o0 + (size_t)gid * D; std::vector<float> y(D, 0.f);
        for (int i = 0; i < 128; ++i) { const float cf = p.a[(size_t)gid * 128 + i] * (1.f / 64.f); const unsigned char* v = (const unsigned char*)p.c + (size_t)((const int*)p.b)[(size_t)gid * 128 + i] * D; for (int c = 0; c < D; ++c) y[c] = fmaf(cf, nv_e4m32f(v[c]), y[c]); }
        float mu = 0.f; for (int c = 0; c < D; ++c) { y[c] = alpha * x[c] + y[c]; mu += y[c]; }
        mu /= D; float var = 0.f; for (int c = 0; c < D; ++c) { float dlt = y[c] - mu; var = fmaf(dlt, dlt, var); }
        const float rs = 1.f / sqrtf(var / D + 1e-5f);
        for (int c = 0; c < D; ++c) { const float o = (y[c] - mu) * rs * p.d[c] + p.e[c]; x[c] = o; ((nvbf*)p.o1)[(size_t)gid * D + c] = nv_f2bf(o);
            if (p.o3) { const int row = (int)gid; if (row < dm.B * dm.T) { const int bb = row / dm.T, t = row % dm.T; if (t >= 16) p.o3[((size_t)bb * (dm.T - 16) + (t - 16)) * D + c] = o; } else p.o3[((size_t)dm.B * (dm.T - 16) + (row - dm.B * dm.T)) * D + c] = o; }
            if (p.o2) { unsigned char* f8 = (unsigned char*)p.o2 + (size_t)gid * 2 * D; const float xs = fminf(fmaxf(o * 16.f, -448.f), 448.f); const unsigned hc = nv_f2e4m3(xs); f8[c] = (unsigned char)hc; f8[D + c] = (unsigned char)nv_f2e4m3(xs - nv_e4m32f(hc)); } } } break;
#endif
    default: break;
    }
}

struct NvIO { const float* const* in; float* out; char* ws; size_t ws_size; };
template <class Launch> HD void nv_forward(const NvIO& io, const Dm& dm, Launch&& launch) {
    const int D = dm.D, M = dm.M, B = dm.B, DB = dm.DB, RH = dm.RH; const size_t MD = (size_t)M * D;
    float* y_prompt = io.out; float* y_sample = y_prompt + (size_t)B * (dm.T - 16) * D; float* p_gla = y_sample + (size_t)DB * dm.DT * D;
    float* p_h = p_gla + (size_t)2 * B * 4 * 64 * 128; float* p_conv = p_h + (size_t)2 * B * 512; float* p_rwkv = p_conv + (size_t)2 * B * 3 * 512;
    float* p_shift = p_rwkv + (size_t)2 * B * RH * 4096; float* s_gla = p_shift + (size_t)2 * B * D; float* s_h = s_gla + (size_t)2 * DB * 4 * 64 * 128;
    float* s_conv = s_h + (size_t)2 * DB * 512; float* s_rwkv = s_conv + (size_t)2 * DB * 3 * 512; float* s_shift = s_rwkv + (size_t)2 * DB * RH * 4096;
    float* w = (float*)io.ws; size_t off = 0; auto take = [&](size_t n) __attribute__((always_inline)) { float* r = w + off; off += (n + 63) & ~(size_t)63; return r; };
    float* X = take(MD > (size_t)nv_rup(M, 256) * 512 ? MD : (size_t)nv_rup(M, 256) * 512); float* VFIRST = take(MD); float* MOUT = take(MD);
    auto mk = [&](int code, long long n) __attribute__((always_inline)) { Op o{}; o.code = code; o.n = n; return o; };
    const int Mp = nv_rup(M, 256), Dp = nv_rup(D, 256), Dk = nv_rup(D, 128);
    auto takeh = [&](size_t n) __attribute__((always_inline)) { return (nvbf*)take((n + 1) / 2); };
    const size_t ABFN = (size_t)Mp * 1024 > (size_t)Mp * Dk ? (size_t)Mp * 1024 : (size_t)Mp * Dk; nvbf* ABF = takeh(ABFN + (size_t)Mp * D);
    const size_t SZ_WIN = (size_t)2816 * Dk, SZ_WOUT = (size_t)Dp * 1024, SZ_DD = (size_t)Dp * Dk, SZ_DN = (size_t)256 * Dk, SZ_UP = (size_t)Dp * 128, SZ_WQ = (size_t)2048 * Dk;
    nvbf* WT_WIN = takeh(2 * SZ_WIN); nvbf* WT_WOUT = takeh(2 * SZ_WOUT); nvbf* WT_WR = takeh(2 * SZ_DD); nvbf* WT_WK = takeh(2 * SZ_DD); nvbf* WT_WV = takeh(2 * SZ_DD); nvbf* WT_WO = takeh(2 * SZ_DD);
    nvbf* WT_W1 = takeh(2 * SZ_DN); nvbf* WT_W2 = takeh(2 * SZ_UP); nvbf* WT_A1 = takeh(2 * SZ_DN); nvbf* WT_A2 = takeh(2 * SZ_UP); nvbf* WT_G1 = takeh(2 * SZ_DN); nvbf* WT_G2 = takeh(2 * SZ_UP);
    nvbf* WT_V1 = takeh(SZ_DN); nvbf* WT_V2 = takeh(SZ_UP); nvbf* WT_WQ = takeh(4 * SZ_WQ); nvbf* WT_WG = takeh((size_t)2 * 1024 * 512); float* SPL = take(2 * 512); float* PRM = take((size_t)2 * 6 * D);
    nvbf* UB = takeh((size_t)16384 * D / 2); nvbf* VB = takeh((size_t)16384 * D / 2); nvbf* KB = takeh((size_t)8 * 256 * 256); float* KSUM = take(8 * 256);
    const size_t scratch0 = off;
    auto nb = [&](Op o) __attribute__((always_inline)) { o.code |= OPF_NOBAR; launch(o); };
    auto wt = [&](const float* W, int K, int N, int batch, nvbf* dst) __attribute__((always_inline)) { const int Np = nv_rup(N, 256), Kp = nv_rup(K, 128); Op o = mk(OP_WT, (long long)batch * Np * (Kp / 8)); o.a = W; o.o0 = (float*)dst; o.i0 = N; o.i1 = K; o.i2 = N; o.i3 = Np; o.i4 = Kp; nb(o); };
    wt(io.in[10], D, MIXIN, 2, WT_WIN); wt(io.in[21], 1024, D, 2, WT_WOUT); wt(io.in[23], D, D, 2, WT_WR); wt(io.in[24], D, D, 2, WT_WK); wt(io.in[25], D, D, 2, WT_WV); wt(io.in[26], D, D, 2, WT_WO);
    wt(io.in[28], D, 64, 2, WT_W1); wt(io.in[29], 64, D, 2, WT_W2); wt(io.in[31], D, 64, 2, WT_A1); wt(io.in[32], 64, D, 2, WT_A2); wt(io.in[36], D, 128, 2, WT_G1); wt(io.in[37], 128, D, 2, WT_G2);
    wt(io.in[34], D, 32, 1, WT_V1); wt(io.in[35], 32, D, 1, WT_V2); wt(io.in[43], D, 2048, 4, WT_WQ);
    for (int jj = 0; jj < 2; ++jj) { Op o = mk(OP_PRM, (long long)6 * D); o.a = io.in[27] + (size_t)jj * D; o.b = io.in[30] + (size_t)jj * D; o.c = jj > 0 ? io.in[33] + (size_t)(jj - 1) * D : nullptr; o.d = io.in[38] + (size_t)jj * D; o.e = io.in[39] + (size_t)jj * D; o.f = io.in[40] + (size_t)jj * RH * 64; o.o0 = PRM + (size_t)jj * 6 * D; nb(o); }
    for (int jj = 0; jj < 2; ++jj) { Op o = mk(OP_WGATE, 1024 * 64); o.a = io.in[16] + (size_t)jj * 8 * 64 * 64; o.b = io.in[18] + (size_t)jj * 8 * 64 * 64; o.c = io.in[20] + (size_t)jj * 512; o.o0 = (float*)(WT_WG + (size_t)jj * 1024 * 512); o.o1 = SPL + (size_t)jj * 512; nb(o); }
    auto fgemm = [&](const nvbf* Wt, float* C, int ldc, int N, int K, int bf16out = 0, const float* Aop = nullptr, bool nobar_ = false) __attribute__((always_inline)) {
        const int Kp = nv_rup(K, 128), Np = nv_rup(N, 256);
        Op o = mk(OP_FGEMM, (long long)M * N); o.a = Aop ? Aop : (const float*)ABF; o.b = (const float*)Wt; o.o0 = C; o.i0 = N; o.i1 = Kp; o.i2 = Kp; o.i3 = Kp; o.i4 = ldc; o.i5 = Np; o.i6 = bf16out; if (nobar_) nb(o); else launch(o); };
    auto gemm = [&](const float* A, int lda, const nvbf* Wt, float* C, int ldc, int N, int K, int act) __attribute__((always_inline)) {
        const int Kp = nv_rup(K, 128);
        { Op o = mk(OP_CVT8, (long long)Mp * (Kp / 8)); o.a = A; o.o0 = (float*)ABF; o.i0 = K; o.i1 = lda; o.i2 = Kp; o.i3 = act; launch(o); }
        fgemm(Wt, C, ldc, N, K); };
    { Op o = mk(OP_EMBED4, (long long)MD / 4); o.a = io.in[0]; o.b = io.in[1]; o.c = io.in[7]; o.o0 = X; o.o1 = (float*)ABF; launch(o); }
    const float* const w_outer = w; float* const out_outer = io.out;
    for (int layer = 0; layer < 4; ++layer) {
        float* wl = (float*)w_outer; float* ol = out_outer; NV_LAUNDER(wl); NV_LAUNDER(ol);
#define NV_RB(T, v) T const v##_rb = (T)((char*)wl + ((const char*)(v) - (const char*)w_outer))
#define NV_RO(v) float* const v##_rb = (float*)((char*)ol + ((const char*)(v) - (const char*)out_outer))
        NV_RB(float*, X); NV_RB(float*, VFIRST); NV_RB(float*, MOUT); NV_RB(nvbf*, ABF); NV_RB(nvbf*, WT_WIN); NV_RB(nvbf*, WT_WOUT); NV_RB(nvbf*, WT_WR); NV_RB(nvbf*, WT_WK); NV_RB(nvbf*, WT_WV); NV_RB(nvbf*, WT_WO);
        NV_RB(nvbf*, WT_W1); NV_RB(nvbf*, WT_W2); NV_RB(nvbf*, WT_A1); NV_RB(nvbf*, WT_A2); NV_RB(nvbf*, WT_G1); NV_RB(nvbf*, WT_G2); NV_RB(nvbf*, WT_V1); NV_RB(nvbf*, WT_V2); NV_RB(nvbf*, WT_WQ); NV_RB(nvbf*, WT_WG);
        NV_RB(float*, SPL); NV_RB(float*, PRM); NV_RB(nvbf*, UB); NV_RB(nvbf*, VB); NV_RB(nvbf*, KB); NV_RB(float*, KSUM);
        NV_RO(p_gla); NV_RO(p_h); NV_RO(p_conv); NV_RO(p_rwkv); NV_RO(p_shift); NV_RO(s_gla); NV_RO(s_h); NV_RO(s_conv); NV_RO(s_rwkv); NV_RO(s_shift);
#undef NV_RB
#undef NV_RO
        { float* const X = X_rb; float* const VFIRST = VFIRST_rb; float* const MOUT = MOUT_rb; nvbf* const ABF = ABF_rb; nvbf* const WT_WIN = WT_WIN_rb; nvbf* const WT_WOUT = WT_WOUT_rb; nvbf* const WT_WR = WT_WR_rb; nvbf* const WT_WK = WT_WK_rb;
          nvbf* const WT_WV = WT_WV_rb; nvbf* const WT_WO = WT_WO_rb; nvbf* const WT_W1 = WT_W1_rb; nvbf* const WT_W2 = WT_W2_rb; nvbf* const WT_A1 = WT_A1_rb; nvbf* const WT_A2 = WT_A2_rb; nvbf* const WT_G1 = WT_G1_rb; nvbf* const WT_G2 = WT_G2_rb;
          nvbf* const WT_V1 = WT_V1_rb; nvbf* const WT_V2 = WT_V2_rb; nvbf* const WT_WQ = WT_WQ_rb; nvbf* const WT_WG = WT_WG_rb; float* const SPL = SPL_rb; float* const PRM = PRM_rb; nvbf* const UB = UB_rb; nvbf* const VB = VB_rb; nvbf* const KB = KB_rb; float* const KSUM = KSUM_rb;
          float* const p_gla = p_gla_rb; float* const p_h = p_h_rb; float* const p_conv = p_conv_rb; float* const p_rwkv = p_rwkv_rb; float* const p_shift = p_shift_rb; float* const s_gla = s_gla_rb; float* const s_h = s_h_rb; float* const s_conv = s_conv_rb;
          float* const s_rwkv = s_rwkv_rb; float* const s_shift = s_shift_rb; float* const w = wl; (void)SPL; (void)WT_WG; (void)VFIRST;
        const int j = layer / 2; off = scratch0;
        if (layer % 2 == 0) {
            float* PROJ = take((size_t)M * MIXIN); float* LOGA = take((size_t)M * 256); float* O = take((size_t)M * 512); float* MIXO = X;
            float* XC = take((size_t)M * 512); nvbf* XCB = takeh((size_t)Mp * 512); float* AT = take((size_t)M * 512); float* BT = take((size_t)M * 512);
            const int NC = (dm.T + 63) / 64; float* LEND = take((size_t)B * 4 * NC * 8192); float* DEC = take((size_t)B * 4 * NC * 64); float* LA = take((size_t)B * NC * 512); float* LB = take((size_t)B * NC * 512);
            fgemm(WT_WIN + (size_t)j * SZ_WIN, PROJ, MIXIN, MIXIN, D);
            { Op o = mk(OP_LOGA4, (long long)M * 64); o.a = PROJ; o.b = io.in[11] + (size_t)j * 16 * 256; o.c = io.in[12] + (size_t)j * 256; o.o0 = LOGA; nb(o); }
            { Op o = mk(OP_CONV4, (long long)((M + 3) / 4) * 128); o.a = PROJ; o.b = io.in[4] + (size_t)j * DB * 3 * 512; o.c = io.in[14] + (size_t)j * 4 * 512; o.d = io.in[15] + (size_t)j * 512; o.o0 = XC; o.o1 = (float*)XCB; nb(o); }
            { Op o = mk(OP_CONVOUT, (long long)dm.NSEQ * 1536); o.a = PROJ; o.b = io.in[4] + (size_t)j * DB * 3 * 512; o.o1 = p_conv + (size_t)j * B * 3 * 512; o.o2 = s_conv + (size_t)j * DB * 3 * 512; launch(o); }
            { Op o = mk(OP_GLAF, (long long)B * 512); o.a = PROJ; o.b = LOGA; o.o0 = O; o.o1 = p_gla + (size_t)j * B * 4 * 64 * 128; nb(o); }
            { Op o = mk(OP_GLA3, (long long)(DB * 4) * 128); o.a = PROJ; o.b = LOGA; o.c = io.in[2] + (size_t)j * DB * 4 * 64 * 128; o.d = LEND; o.o0 = O; o.o2 = s_gla + (size_t)j * DB * 4 * 64 * 128; o.i0 = NC; o.i1 = 1; nb(o); }
            { Op o = mk(OP_LRUG2, (long long)M * 512); o.a = (const float*)XCB; o.b = (const float*)(WT_WG + (size_t)j * 1024 * 512); o.c = io.in[17] + (size_t)j * 512; o.d = io.in[19] + (size_t)j * 512; o.e = SPL + (size_t)j * 512; o.f = (const float*)XCB; o.o0 = AT; o.o1 = BT; launch(o); }
            { Op o = mk(OP_GLANORM, (long long)M * 4); o.a = O; o.b = PROJ; o.c = io.in[13] + (size_t)j * 128; o.o0 = MIXO; nb(o); }
            { Op o = mk(OP_LRU1, (long long)B * NC * 512); o.a = AT; o.b = BT; o.o0 = LA; o.o1 = LB; o.i0 = NC; launch(o); }
            { Op o = mk(OP_LRU3, (long long)(B * NC + DB) * 512); o.a = AT; o.b = BT; o.c = PROJ; o.d = io.in[3] + (size_t)j * DB * 512; o.e = LB; o.f = LA; o.o0 = MIXO; o.o1 = p_h + (size_t)j * B * 512; o.o2 = s_h + (size_t)j * DB * 512; o.i0 = NC; launch(o); }
            fgemm(WT_WOUT + (size_t)j * SZ_WOUT, MOUT, D, D, 1024, 1, X, true);
        } else {
            float* Y = take(MD); float* R = take(MD); float* K = take(MD); float* V = take(MD); float* G = take(MD); float* KK = take(MD);
            const size_t XMSZ = (size_t)Mp * D;
            float* WAV = take(3 * MD > 3 * XMSZ ? 3 * MD : 3 * XMSZ); float* Wd = WAV; float* Aa = WAV + MD; float* Vg = WAV + 2 * MD; nvbf* XM6 = (nvbf*)WAV;
            float* BON = take((size_t)M * RH); float* HLw = take((size_t)M * 64); float* HLa = take((size_t)M * 64); float* HLg = take((size_t)M * 128); float* HLv = take((size_t)M * 32);
            nvbf* ABw = takeh((size_t)Mp * 128); nvbf* ABa = takeh((size_t)Mp * 128); nvbf* ABg = takeh((size_t)Mp * 128); nvbf* ABv = takeh((size_t)Mp * 128);
            const float* shin = io.in[6] + (size_t)j * DB * D; const float* mu = io.in[22] + (size_t)j * 6 * D;
            { Op o = mk(OP_SHIFTOUT, (long long)dm.NSEQ * D); o.a = (const float*)ABF; o.o1 = p_shift + (size_t)j * B * D; o.o2 = s_shift + (size_t)j * DB * D; nb(o); }
            { Op o = mk(OP_MIX6, (long long)((M + 3) / 4) * (D / 8)); o.a = (const float*)ABF; o.b = shin; o.c = mu; o.o0 = (float*)XM6; o.i1 = (int)(XMSZ / 1024); launch(o); }
            auto gg = [&](const nvbf* A, const nvbf* Wt, float* C, int ldc, int N, int K, bool last, int bf16out = 0) __attribute__((always_inline)) { const int Kp = nv_rup(K, 128), Np = nv_rup(N, 256);
                Op o = mk(OP_FGEMM, (long long)M * N); o.a = (const float*)A; o.b = (const float*)Wt; o.o0 = C; o.i0 = N; o.i1 = Kp; o.i2 = Kp; o.i3 = Kp; o.i4 = ldc; o.i5 = Np; o.i6 = bf16out; if (!last) o.code |= OPF_GROUP; launch(o); };
            gg(XM6 + 0 * XMSZ, WT_WR + (size_t)j * SZ_DD, R, D, D, D, false, 1); gg(XM6 + 2 * XMSZ, WT_WK + (size_t)j * SZ_DD, K, D, D, D, false, 1); gg(XM6 + 3 * XMSZ, WT_WV + (size_t)j * SZ_DD, V, D, D, D, false, 1);
            gg(XM6 + 1 * XMSZ, WT_W1 + (size_t)j * SZ_DN, (float*)ABw, 128, 64, D, false, 4 | (1 << 3)); gg(XM6 + 4 * XMSZ, WT_A1 + (size_t)j * SZ_DN, (float*)ABa, 128, 64, D, false, 4);
            if (j > 0) gg(XM6 + 3 * XMSZ, WT_V1 + (size_t)(j - 1) * SZ_DN, (float*)ABv, 128, 32, D, false, 4);
            gg(XM6 + 5 * XMSZ, WT_G1 + (size_t)j * SZ_DN, (float*)ABg, 128, 128, D, true, 4 | (2 << 3));
            auto cv = [&](const float* A, int K, nvbf* dst, int act, bool last) __attribute__((always_inline)) { Op o = mk(OP_CVT8, (long long)Mp * 16); o.a = A; o.o0 = (float*)dst; o.i0 = K; o.i1 = K; o.i2 = 128; o.i3 = act; if (last) launch(o); else nb(o); };

            gg(ABw, WT_W2 + (size_t)j * SZ_UP, Wd, D, D, 64, false, 1); gg(ABa, WT_A2 + (size_t)j * SZ_UP, Aa, D, D, 64, false, 1); if (j > 0) gg(ABv, WT_V2 + (size_t)(j - 1) * SZ_UP, Vg, D, D, 32, false, 1); gg(ABg, WT_G2 + (size_t)j * SZ_UP, G, D, D, 128, true, 1);
            { Op o = mk(OP_WKVP, (long long)dm.NSEQ * RH * 64); o.a = R; o.b = K; o.c = Wd; o.d = Aa; o.e = V; o.f = Vg; o.g = VFIRST; o.h = PRM + (size_t)j * 6 * D; o.o0 = Y; o.o1 = p_rwkv + (size_t)j * B * RH * 4096; o.o2 = s_rwkv + (size_t)j * DB * RH * 4096;
              o.o3 = j > 0 ? KK : VFIRST; o.o4 = BON; o.o5 = (float*)(io.in[5] + (size_t)j * DB * RH * 4096); o.i0 = j > 0 ? 1 : 0; launch(o); }
            { Op o = mk(OP_POST2, (long long)M * RH); o.a = Y; o.b = G; o.c = j > 0 ? KK : VFIRST; o.d = BON; o.e = io.in[41] + (size_t)j * D; o.f = io.in[42] + (size_t)j * D; o.o0 = X; launch(o); }
            fgemm(WT_WO + (size_t)j * SZ_DD, MOUT, D, D, D, 1, X, true);
        }
        { Op o = mk(OP_CVTTAB8S, (long long)16384 * D / 16); o.a = io.in[45] + (size_t)layer * 16384 * D; o.o0 = (float*)UB; o.i0 = 7; o.i6 = (Mp / 256) * (nv_rup(D, 256) / 256); launch(o); }
        { Op o = mk(OP_LNRES, M); o.a = MOUT; o.b = io.in[8] + (size_t)(layer * 2 + 0) * D; o.c = io.in[9] + (size_t)(layer * 2 + 0) * D; o.o0 = X; o.o1 = (float*)ABF; o.o2 = (float*)(ABF + ABFN); launch(o); }
        off = scratch0;
        { nvbf* Q = takeh((size_t)Mp * 2048); float* SC = take((size_t)M * 2048); float* GATE = take((size_t)M * 128); float* EIDX = take((size_t)M * 128); float* TMPV = take((size_t)M * 256); float* TMPI = take((size_t)M * 256);
          float* COEF = take((size_t)M * 128);
          { Op o = mk(OP_FGEMM, (long long)M * 2048); o.a = (const float*)ABF; o.b = (const float*)(WT_WQ + (size_t)layer * SZ_WQ); o.o0 = (float*)Q; o.i0 = 2048; o.i1 = Dk; o.i2 = Dk; o.i3 = Dk; o.i4 = 2048; o.i5 = 2048; o.i6 = 1; nb(o); }
          { Op o = mk(OP_CVTTAB8S, (long long)16384 * D / 16); o.a = io.in[46] + (size_t)layer * 16384 * D; o.o0 = (float*)VB; o.i0 = 6; o.i6 = (Mp / 256) * 8; nb(o); }
          { Op o = mk(OP_KEYS, 8 * 256 * 32); o.a = io.in[44] + (size_t)layer * 8 * 2 * 128 * 128; o.o0 = (float*)KB; o.o1 = KSUM; launch(o); }
          { Op o = mk(OP_FGEMM, (long long)M * 2048); o.a = (const float*)Q; o.b = (const float*)KB; o.o0 = SC; o.i0 = 2048; o.i1 = 256; o.i2 = 2048; o.i3 = 256; o.i4 = 2048; o.i5 = 2048; o.i6 = 3; launch(o); }
          { Op o = mk(OP_TOPK2, (long long)M * 8); o.a = SC; o.b = (const float*)Q; o.c = KSUM; o.o0 = GATE; o.o1 = EIDX; o.o2 = TMPV; o.o3 = TMPI; launch(o); }
          { const int NS = D / 128; float* PART = take((size_t)NS * M * 128); float* YBUF = take(MD);
            #ifdef PROBE_EMASK
            { Op o = mk(OP_PACTS, (long long)NS * M * 128); o.a = (const float*)(ABF + ABFN); o.b = (const float*)UB; o.d = EIDX; o.o0 = PART; o.i0 = PROBE_EMASK; launch(o); }
#endif
            { Op o = mk(OP_PACTS, (long long)NS * M * 128); o.a = (const float*)(ABF + ABFN); o.b = (const float*)UB; o.d = EIDX; o.o0 = PART; o.i0 = 16383; launch(o); }
            { Op o = mk(OP_PRED, (long long)M * 16); o.a = PART; o.c = GATE; o.o0 = COEF; o.i0 = NS; launch(o); }
            { Op o = mk(OP_POUTS, (long long)MD); o.a = COEF; o.b = EIDX; o.c = (const float*)VB; o.o0 = YBUF; launch(o); }
            { Op o = mk(OP_LNRES, M); o.a = YBUF; o.b = io.in[8] + (size_t)(layer * 2 + 1) * D; o.c = io.in[9] + (size_t)(layer * 2 + 1) * D; o.o0 = X; o.o1 = (float*)ABF; if (layer == 3) o.o3 = y_prompt; launch(o); } } }
        }
    }

    (void)y_sample;
}

#include <cstdint>
namespace pg8 {
#define PG8_LAS __attribute__((address_space(3)))
typedef unsigned short bf16_t;
typedef short bf16x8 __attribute__((ext_vector_type(8)));
typedef float f32x4 __attribute__((ext_vector_type(4)));
typedef unsigned u32x4 __attribute__((ext_vector_type(4)));
constexpr int BM = 256, BK = 64, HALF = 128, HTB = HALF * BK * 2  , STAGE_BYTES = 8 * HTB, NXCD = 8, WGM = 8;

__host__ __device__ __forceinline__ int lds_byte(int r, int c) { const int st = (r >> 4) * 2 + (c >> 5), rr = r & 15, cc = c & 31, ob = rr * 64 + cc * 2; return st * 1024 + (ob ^ (((ob >> 9) & 1) << 5)); }
__host__ __device__ __forceinline__ void stage_rc(int b, int& R, int& C) { const int st = b / 1024, sb = b % 1024, swz = sb ^ (((sb >> 9) & 1) << 5); R = (st >> 1) * 16 + swz / 64; C = (st & 1) * 32 + (swz % 64) / 2; }
__host__ __device__ __forceinline__ int perm32(int rho) { const int n = rho >> 4, i = rho & 15; return 8 * (i >> 2) + 4 * n + (i & 3); }

struct Unit { int pm, pn, grp, pad_; const char* A; const char* B; };
struct Gemm { const bf16_t* A; const bf16_t* Bt; int M, N, K, lda, ldb; };

struct StaticOrder {
    int nM, nN, nwg, G, c; const char* A; const char* B; size_t tsA, tsB, acs;
    __host__ __device__ void init(const Gemm& g, int G_, int c_) { nM = g.M / BM; nN = g.N / BM; nwg = nM * nN; G = G_; c = c_; A = (const char*)g.A; B = (const char*)g.Bt; tsA = (size_t)BM * g.lda * 2; tsB = (size_t)BM * g.ldb * 2; acs = 0; }
    __host__ __device__ bool next(int i, Unit& u) const {
        const int fr_ = nwg / G, R_ = nwg - fr_ * G; const bool split_ = R_ > 0 && 2 * R_ <= G; long L; int hf_ = 0;
        if (!split_ || i < fr_) { L = (long)i * G + c; if (L >= nwg) return false; }
        else { if (i > fr_ || c >= 2 * R_) return false; L = (long)fr_ * G + (c >> 1); hf_ = 1 | ((c & 1) << 1); }
        int wgid = (int)L; { const int q = nwg / NXCD, r = nwg % NXCD, xcd = wgid % NXCD, off = wgid / NXCD; wgid = (xcd < r ? xcd * (q + 1) : r * (q + 1) + (xcd - r) * q) + off; }
        const int nig = WGM * nN, gid = wgid / nig, fm = gid * WGM, gsz = (nM - fm) < WGM ? (nM - fm) : WGM;
        u.pm = fm + ((wgid % nig) % gsz); u.pn = (wgid % nig) / gsz; u.grp = 0; u.pad_ = hf_; u.A = A + (size_t)u.pm * tsA + ((hf_ & 2) ? (tsA >> 1) : 0) + (size_t)u.pn * acs; u.B = B + (size_t)u.pn * tsB; return true;
    }
    __device__ __forceinline__ void a_ready(const Unit&) const {}
    __device__ __forceinline__ void done(const Unit&) const {}
};

template <class Epi, class Sched, bool ALIGN_EPI = false, bool SP2 = false>
__device__ __forceinline__ void gemm_phase(PG8_LAS unsigned char* lds, const Gemm g, const Sched& S, const Epi& E) {
    int tid_raw = threadIdx.x; asm volatile("" : "+v"(tid_raw));
    const int tid = tid_raw, wid = __builtin_amdgcn_readfirstlane(tid >> 6), lane = tid & 63, wr = wid >> 2, wc = wid & 3, fr = lane & 15, fq = lane >> 4;
    const int K = g.K, nt = K / BK;
    unsigned voffA[2], voffB[2];
#pragma unroll
    for (int i = 0; i < 2; ++i) { int R, C; stage_rc(tid * 16 + i * 8192, R, C); const int Rb = Epi::PERM ? ((R & ~31) + perm32(R & 31)) : R;
        voffA[i] = (unsigned)(R * g.lda + C) * 2u; voffB[i] = (unsigned)(Rb * g.ldb + C) * 2u; }
    const size_t kstep = (size_t)(BK * 2);
    const size_t hstepA = (size_t)HALF * g.lda * 2, hstepB = (size_t)HALF * g.ldb * 2;
    const unsigned ldsw = (unsigned)wid * 1024u;
    const int aoff = lds_byte(wr * 64 + fr, fq * 8), boff = lds_byte(wc * 32 + fr, fq * 8);
#define PG8_SA(b, h) (((b) * 2 + (h)) * HTB)
#define PG8_SB(b, h) ((4 + (b) * 2 + (h)) * HTB)
#define PG8_STAGE(bufoff, gbase, voff) do { _Pragma("unroll") for (int _i = 0; _i < 2; ++_i) \
        __builtin_amdgcn_global_load_lds((const unsigned*)((const char*)(gbase) + (voff)[_i]), (PG8_LAS unsigned*)(lds + (bufoff) + ldsw + _i * 8192), 16, 0, 0); } while (0)
#define PG8_LDA(dst, b, h) do { _Pragma("unroll") for (int m = 0; m < 4; ++m) _Pragma("unroll") for (int k = 0; k < 2; ++k) dst[m][k] = *(const PG8_LAS bf16x8*)(lds + PG8_SA(b, h) + aoff + m * 2048 + k * 1024); } while (0)
#define PG8_LDB(dst, b, h) do { _Pragma("unroll") for (int n = 0; n < 2; ++n) _Pragma("unroll") for (int k = 0; k < 2; ++k) dst[n][k] = *(const PG8_LAS bf16x8*)(lds + PG8_SB(b, h) + boff + n * 2048 + k * 1024); } while (0)
#define PG8_MMA(ai, bj, At, Bt) do { __builtin_amdgcn_s_setprio(1); _Pragma("unroll") for (int m = 0; m < 4; ++m) _Pragma("unroll") for (int n = 0; n < 2; ++n) _Pragma("unroll") for (int k = 0; k < 2; ++k) \
        acc[ai][bj][m][n] = __builtin_amdgcn_mfma_f32_16x16x32_bf16(Bt[n][k], At[m][k], acc[ai][bj][m][n], 0, 0, 0); __builtin_amdgcn_s_setprio(0); } while (0)
#define PG8_WAIT_V(n) asm volatile("s_waitcnt vmcnt(" #n ")" ::: "memory")
#define PG8_WAIT_L(n) asm volatile("s_waitcnt lgkmcnt(" #n ")" ::: "memory")
#define PG8_BAR __builtin_amdgcn_s_barrier()
#define PG8_SCHED __builtin_amdgcn_sched_barrier(0)
    Unit cur, nxt; int ui = 0;
    if (!S.next(0, cur)) return;
    f32x4 acc[2][2][4][2];
#pragma unroll
    for (int a = 0; a < 2; ++a)
#pragma unroll
        for (int b = 0; b < 2; ++b)
#pragma unroll
            for (int m = 0; m < 4; ++m)
#pragma unroll
                for (int n = 0; n < 2; ++n) acc[a][b][m][n] = (f32x4){0.f, 0.f, 0.f, 0.f};
    bf16x8 At[4][2], B0[2][2], B1[2][2];
    const char* cA = cur.A; const char* cB = cur.B;
    S.a_ready(cur);
    if constexpr (SP2) {
        PG8_STAGE(PG8_SB(0, 0), cB, voffB); PG8_STAGE(PG8_SB(0, 1), cB + hstepB, voffB); PG8_STAGE(PG8_SA(0, 0), cA, voffA); PG8_STAGE(PG8_SA(0, 1), cA + hstepA, voffA);
        if (wr == 1) PG8_BAR;
        PG8_WAIT_V(2); PG8_BAR;
        PG8_STAGE(PG8_SB(1, 0), cB + kstep, voffB); PG8_STAGE(PG8_SA(1, 0), cA + kstep, voffA); PG8_STAGE(PG8_SB(1, 1), cB + hstepB + kstep, voffB);
        PG8_WAIT_V(6); PG8_BAR;
    } else {
        PG8_STAGE(PG8_SB(0, 0), cB, voffB); PG8_STAGE(PG8_SA(0, 0), cA, voffA); PG8_STAGE(PG8_SB(0, 1), cB + hstepB, voffB); PG8_STAGE(PG8_SA(0, 1), cA + hstepA, voffA);
        if (wr == 1) PG8_BAR;
        PG8_WAIT_V(4); PG8_BAR;
        PG8_STAGE(PG8_SB(1, 0), cB + kstep, voffB); PG8_STAGE(PG8_SA(1, 0), cA + kstep, voffA); PG8_STAGE(PG8_SB(1, 1), cB + hstepB + kstep, voffB);
        PG8_WAIT_V(6); PG8_BAR;
    }
    for (;;) {
        const bool has_next = S.next(ui + 1, nxt);
        const char* nA = has_next ? nxt.A : cA; const char* nB = has_next ? nxt.B : cB;
        const bool full_ = !(__builtin_amdgcn_readfirstlane(cur.pad_) & 1);
        for (int t = 0; t < nt; t += 2) {
            const bool last = (t == nt - 2);
            const char* a1 = cA + (size_t)(t + 1) * kstep;
            const char* a2 = last ? nA : cA + (size_t)(t + 2) * kstep; const char* b2 = last ? nB : cB + (size_t)(t + 2) * kstep;
            const char* a3 = a2 + kstep; const char* b3 = b2 + kstep;
            if (last && has_next) S.a_ready(nxt);
            if constexpr (SP2) {
            PG8_LDB(B0, 0, 0); PG8_LDB(B1, 0, 1); PG8_SCHED; PG8_LDA(At, 0, 0); PG8_STAGE(PG8_SA(1, 1), a1 + hstepA, voffA);
            PG8_WAIT_V(8); PG8_WAIT_L(0); PG8_BAR; PG8_MMA(0, 0, At, B0); PG8_MMA(0, 1, At, B1); PG8_BAR; PG8_SCHED;
            if (full_) PG8_LDA(At, 0, 1); PG8_STAGE(PG8_SB(0, 0), b2, voffB); PG8_STAGE(PG8_SB(0, 1), b2 + hstepB, voffB); PG8_STAGE(PG8_SA(0, 0), a2, voffA);
            PG8_WAIT_V(8); PG8_WAIT_L(0); PG8_BAR; if (full_) { PG8_MMA(1, 0, At, B0); PG8_MMA(1, 1, At, B1); } PG8_BAR; PG8_SCHED;
            PG8_LDB(B0, 1, 0); PG8_LDB(B1, 1, 1); PG8_SCHED; PG8_LDA(At, 1, 0); PG8_STAGE(PG8_SA(0, 1), a2 + hstepA, voffA);
            PG8_WAIT_V(8); PG8_WAIT_L(0); PG8_BAR; PG8_MMA(0, 0, At, B0); PG8_MMA(0, 1, At, B1); PG8_BAR; PG8_SCHED;
            if (full_) PG8_LDA(At, 1, 1); PG8_STAGE(PG8_SB(1, 0), b3, voffB); PG8_STAGE(PG8_SB(1, 1), b3 + hstepB, voffB); PG8_STAGE(PG8_SA(1, 0), a3, voffA);
            PG8_WAIT_V(8); PG8_WAIT_L(0); PG8_BAR; if (full_) { PG8_MMA(1, 0, At, B0); PG8_MMA(1, 1, At, B1); } PG8_BAR; PG8_SCHED;
            } else {
            PG8_LDB(B0, 0, 0); PG8_SCHED; PG8_LDA(At, 0, 0); PG8_STAGE(PG8_SA(1, 1), a1 + hstepA, voffA);
            PG8_WAIT_L(8); PG8_BAR; PG8_WAIT_L(0); PG8_MMA(0, 0, At, B0); PG8_BAR; PG8_SCHED;
            PG8_LDB(B1, 0, 1); PG8_STAGE(PG8_SB(0, 0), b2, voffB);
            PG8_BAR; PG8_WAIT_L(0); PG8_MMA(0, 1, At, B1); PG8_BAR;
            PG8_LDA(At, 0, 1); PG8_STAGE(PG8_SA(0, 0), a2, voffA);
            PG8_BAR; PG8_WAIT_L(0); PG8_MMA(1, 0, At, B0); PG8_BAR; PG8_SCHED;
            PG8_STAGE(PG8_SB(0, 1), b2 + hstepB, voffB);
            PG8_WAIT_V(6); PG8_BAR; PG8_MMA(1, 1, At, B1); PG8_BAR;
            PG8_LDB(B0, 1, 0); PG8_SCHED; PG8_LDA(At, 1, 0); PG8_STAGE(PG8_SA(0, 1), a2 + hstepA, voffA);
            PG8_WAIT_L(8); PG8_BAR; PG8_WAIT_L(0); PG8_MMA(0, 0, At, B0); PG8_BAR; PG8_SCHED;
            PG8_LDB(B1, 1, 1); PG8_STAGE(PG8_SB(1, 0), b3, voffB);
            PG8_BAR; PG8_WAIT_L(0); PG8_MMA(0, 1, At, B1); PG8_BAR;
            PG8_LDA(At, 1, 1); PG8_STAGE(PG8_SA(1, 0), a3, voffA);
            PG8_BAR; PG8_WAIT_L(0); PG8_MMA(1, 0, At, B0); PG8_BAR; PG8_SCHED;
            PG8_STAGE(PG8_SB(1, 1), b3 + hstepB, voffB);
            PG8_WAIT_V(6); PG8_BAR; PG8_MMA(1, 1, At, B1); PG8_BAR;
            }
        }
        if constexpr (ALIGN_EPI) { if (wr == 0) PG8_BAR; }
        if constexpr (!Epi::AFTER_DRAIN) { E(acc, cur, wr, wc, fr, fq); S.done(cur); }
        if (!has_next) break;
#pragma unroll
        for (int a = 0; a < 2; ++a)
#pragma unroll
            for (int b = 0; b < 2; ++b)
#pragma unroll
                for (int m = 0; m < 4; ++m)
#pragma unroll
                    for (int n = 0; n < 2; ++n) acc[a][b][m][n] = (f32x4){0.f, 0.f, 0.f, 0.f};
        cur = nxt; cA = nA; cB = nB; ++ui;
        if constexpr (ALIGN_EPI) { if (wr == 1) PG8_BAR; }
    }
    PG8_WAIT_V(0);
    if constexpr (!ALIGN_EPI) { if (wr == 0) PG8_BAR; }
    PG8_BAR;
    if constexpr (Epi::AFTER_DRAIN) { E.fused(acc, cur, wr, wc, fr, fq, lds, wid, lane); S.done(cur); }
#undef PG8_SA
#undef PG8_SB
#undef PG8_STAGE
#undef PG8_LDA
#undef PG8_LDB
#undef PG8_MMA
#undef PG8_WAIT_V
#undef PG8_WAIT_L
#undef PG8_BAR
#undef PG8_SCHED
}
}
template <class T> __device__ __forceinline__ T* uni_ptr(T* p) {
    unsigned long long v = (unsigned long long)p; unsigned lo = __builtin_amdgcn_readfirstlane((unsigned)v), hi = __builtin_amdgcn_readfirstlane((unsigned)(v >> 32));
    unsigned long long r = ((unsigned long long)hi << 32) | lo; asm volatile("" : "+s"(r)); return (T*)r; }
__device__ __forceinline__ int rfl(int x) { int t = __builtin_amdgcn_readfirstlane(x); asm volatile("" : "+s"(t)); return t; }
namespace pg8 {
__device__ __forceinline__ unsigned cvt_pk_bf16(float lo, float hi) { unsigned r; asm volatile("v_cvt_pk_bf16_f32 %0, %1, %2" : "=v"(r) : "v"(lo), "v"(hi)); return r; }
struct EpiF32 {
    static constexpr bool PERM = false, AFTER_DRAIN = false;
    float* C; int ldc, Mreal, Nreal;
    __device__ __forceinline__ void operator()(const f32x4 (&acc)[2][2][4][2], const Unit& u, int wr, int wc, int fr, int fq) const {
        const int nai = (u.pad_ & 1) ? 1 : 2, row0 = u.pm * BM + ((u.pad_ & 2) ? HALF : 0) + wr * 64 + fr, col0 = u.pn * BM + wc * 32 + 4 * fq;
#pragma unroll
        for (int ai = 0; ai < 2; ++ai) if (ai < nai)
#pragma unroll
            for (int m = 0; m < 4; ++m) { const int r = row0 + ai * HALF + m * 16; if (r < Mreal) { float* rowp = C + (size_t)r * ldc + col0;
#pragma unroll
                for (int bj = 0; bj < 2; ++bj)
#pragma unroll
                    for (int n = 0; n < 2; ++n) { const int c = col0 + bj * HALF + n * 16; if (c < Nreal) *(f32x4*)(rowp + bj * HALF + n * 16) = acc[ai][bj][m][n]; } } }
    }
};
struct EpiBf16Plain {
    static constexpr bool PERM = true, AFTER_DRAIN = false;
    bf16_t* O; int ldc;
    __device__ __forceinline__ void operator()(const f32x4 (&acc)[2][2][4][2], const Unit& u, int wr, int wc, int fr, int fq) const {
        const int nai = (u.pad_ & 1) ? 1 : 2, row0 = u.pm * BM + ((u.pad_ & 2) ? HALF : 0) + wr * 64 + fr, col0 = u.pn * BM + wc * 32 + 8 * fq;
#pragma unroll
        for (int ai = 0; ai < 2; ++ai) if (ai < nai)
#pragma unroll
            for (int m = 0; m < 4; ++m) { bf16_t* rowp = O + (size_t)(row0 + ai * HALF + m * 16) * ldc + col0;
#pragma unroll
                for (int bj = 0; bj < 2; ++bj) { const f32x4 v0 = acc[ai][bj][m][0], v1 = acc[ai][bj][m][1]; u32x4 w;
                    w.x = cvt_pk_bf16(v0[0], v0[1]); w.y = cvt_pk_bf16(v0[2], v0[3]); w.z = cvt_pk_bf16(v1[0], v1[1]); w.w = cvt_pk_bf16(v1[2], v1[3]);
                    *(u32x4*)(rowp + bj * HALF) = w; } }
    }
};
struct EpiLru {
    static constexpr bool PERM = false, AFTER_DRAIN = false;
    const float* ba; const float* bx; const float* spl; const bf16_t* XC; float* AT; float* BT; int Mreal;
    __device__ __forceinline__ void operator()(const f32x4 (&acc)[2][2][4][2], const Unit& u, int wr, int wc, int fr, int fq) const {
        const int nai = (u.pad_ & 1) ? 1 : 2, row0 = u.pm * BM + ((u.pad_ & 2) ? HALF : 0) + wr * 64 + fr, ch0 = u.pn * 128 + wc * 32 + 4 * fq;
#pragma unroll
        for (int n = 0; n < 2; ++n) { const int c = ch0 + 16 * n; const f32x4 ba4 = *(const f32x4*)(ba + c), bx4 = *(const f32x4*)(bx + c), sp4 = *(const f32x4*)(spl + c);
#pragma unroll
            for (int ai = 0; ai < 2; ++ai) if (ai < nai)
#pragma unroll
                for (int m = 0; m < 4; ++m) { const int r = row0 + ai * HALF + m * 16; if (r < Mreal) { const unsigned long long xw_ = *(const unsigned long long*)(XC + (size_t)r * 512 + c); const unsigned xl_ = (unsigned)xw_, xh_ = (unsigned)(xw_ >> 32); const f32x4 xc = {__uint_as_float(xl_ << 16), __uint_as_float(xl_ & 0xffff0000u), __uint_as_float(xh_ << 16), __uint_as_float(xh_ & 0xffff0000u)}; const f32x4 ga = acc[ai][0][m][n] + ba4, gx = acc[ai][1][m][n] + bx4; f32x4 at, bt;
#pragma unroll
                    for (int i = 0; i < 4; ++i) { const float gate_a = __builtin_amdgcn_rcpf(1.f + __expf(-ga[i])), gate_x = __builtin_amdgcn_rcpf(1.f + __expf(-gx[i])); const float la = gate_a * sp4[i]; at[i] = __expf(la); bt[i] = sqrtf(-expm1f(2.f * la)) * (gate_x * xc[i]); }
                    *(f32x4*)(AT + (size_t)r * 512 + c) = at; *(f32x4*)(BT + (size_t)r * 512 + c) = bt; } } }
    }
};
struct GroupOrder {
    const PG8_LAS Op* tab; int ng, nM, G, c; size_t tsA, tsB;
    __device__ __forceinline__ bool next(int i, Unit& u) const {
        int tot = 0; for (int q = 0; q < ng; ++q) tot += nM * (__builtin_amdgcn_readfirstlane(tab[q].i5) >> 8);
        const int fr_ = tot / G, R_ = tot - fr_ * G; const bool split_ = R_ > 0 && 2 * R_ <= G && tsA >= (size_t)256 * 512 * 2; int L, hf_ = 0, g = 0;
        if (!split_ || i < fr_) L = i * G + c; else { if (i > fr_ || c >= 2 * R_) return false; L = fr_ * G + (c >> 1); hf_ = 1 | ((c & 1) << 1); }
        for (; g < ng; ++g) { const int cnt = nM * (__builtin_amdgcn_readfirstlane(tab[g].i5) >> 8); if (L < cnt) break; L -= cnt; }
        if (g >= ng) return false;
        u.pm = L % nM; u.pn = L / nM; u.grp = g; u.pad_ = hf_;
        u.A = (const char*)uni_ptr(tab[g].a) + (size_t)u.pm * tsA + ((hf_ & 2) ? (tsA >> 1) : 0); u.B = (const char*)uni_ptr(tab[g].b) + (size_t)u.pn * tsB; return true;
    }
    __device__ __forceinline__ void a_ready(const Unit&) const {}
    __device__ __forceinline__ void done(const Unit&) const {}
};
struct EpiGroup {
    static constexpr bool PERM = true, AFTER_DRAIN = false;
    const PG8_LAS Op* tab; int Mreal;
    __device__ __forceinline__ void operator()(const f32x4 (&acc)[2][2][4][2], const Unit& u, int wr, int wc, int fr, int fq) const {
        const int ldc = rfl(tab[u.grp].i4), Nreal = rfl(tab[u.grp].i0), fl = rfl(tab[u.grp].i6);
        if (fl & 1) { const EpiBf16Plain E{(bf16_t*)uni_ptr(tab[u.grp].o0), ldc}; E(acc, u, wr, wc, fr, fq); return; }
        if (fl & 4) {
            if (u.pn == 0) { bf16_t* O = (bf16_t*)uni_ptr(tab[u.grp].o0); const int act = fl >> 3, nai = (u.pad_ & 1) ? 1 : 2, rw0 = u.pm * BM + ((u.pad_ & 2) ? HALF : 0) + wr * 64 + fr, cl0 = wc * 32 + 8 * fq;
#pragma unroll
                for (int ai = 0; ai < 2; ++ai) if (ai < nai)
#pragma unroll
                    for (int m = 0; m < 4; ++m) { f32x4 v0 = acc[ai][0][m][0], v1 = acc[ai][0][m][1];
                        if (act == 1) {
#pragma unroll
                            for (int i = 0; i < 4; ++i) { v0[i] = 1.f - 2.f * __builtin_amdgcn_rcpf(1.f + __expf(2.f * v0[i])); v1[i] = 1.f - 2.f * __builtin_amdgcn_rcpf(1.f + __expf(2.f * v1[i])); } }
                        else if (act == 2) {
#pragma unroll
                            for (int i = 0; i < 4; ++i) { v0[i] = __builtin_amdgcn_rcpf(1.f + __expf(-v0[i])); v1[i] = __builtin_amdgcn_rcpf(1.f + __expf(-v1[i])); } }
                        u32x4 w; w.x = cvt_pk_bf16(v0[0], v0[1]); w.y = cvt_pk_bf16(v0[2], v0[3]); w.z = cvt_pk_bf16(v1[0], v1[1]); w.w = cvt_pk_bf16(v1[2], v1[3]);
                        *(u32x4*)(O + (size_t)(rw0 + ai * HALF + m * 16) * 128 + cl0) = w; } }
            return; }
        float* C = uni_ptr(tab[u.grp].o0); const int nai = (u.pad_ & 1) ? 1 : 2, row0 = u.pm * BM + ((u.pad_ & 2) ? HALF : 0) + wr * 64 + fr, col0 = u.pn * BM + wc * 32 + 8 * fq;
#pragma unroll
        for (int ai = 0; ai < 2; ++ai) if (ai < nai)
#pragma unroll
            for (int m = 0; m < 4; ++m) { const int r = row0 + ai * HALF + m * 16; if (r < Mreal) { float* rowp = C + (size_t)r * ldc + col0;
#pragma unroll
                for (int bj = 0; bj < 2; ++bj) { if (col0 + bj * HALF < Nreal) { *(f32x4*)(rowp + bj * HALF) = acc[ai][bj][m][0]; *(f32x4*)(rowp + bj * HALF + 4) = acc[ai][bj][m][1]; } } } }
    }
};
}

#define XB_TMO      128
#define XB_XCNT(j)  (256  + 64 * (j))
#define XB_XSUB(j)  (1280 + 64 * (j))
#define XB_XGEN(j)  (2304 + 64 * (j))
#define XB_TOP      3328
#define XB_TOPGEN   3392
#define XCD_BAR_WORDS 3456
#define XB_SPIN_CAP (1u << 18)
#define LAS __attribute__((address_space(3)))
__device__ __forceinline__ unsigned xb_ld(unsigned* p)              { return __hip_atomic_load(p, __ATOMIC_RELAXED, __HIP_MEMORY_SCOPE_AGENT); }
__device__ __forceinline__ unsigned xb_add(unsigned* p, unsigned v) { return __hip_atomic_fetch_add(p, v, __ATOMIC_RELAXED, __HIP_MEMORY_SCOPE_AGENT); }
__device__ __forceinline__ unsigned xb_xcc_id() { return (unsigned)__builtin_amdgcn_s_getreg((3 << 11) | 20) & 0xFu; }
#define XB_SPIN(cond, bar) do { unsigned _sp = 0; while (cond) { __builtin_amdgcn_s_sleep(1); \
    if ((++_sp & 255u) == 0u) { if (xb_ld(&(bar)[XB_TMO])) break; if (_sp > XB_SPIN_CAP) { atomicAdd(&(bar)[XB_TMO], 1u); break; } } } } while (0)
struct XcdBarrier { unsigned* bar; unsigned x; volatile LAS unsigned* st; };
__device__ __forceinline__ XcdBarrier xcd_barrier_post(unsigned* bar, volatile LAS unsigned* st) {
    XcdBarrier b; b.bar = bar; b.x = xb_xcc_id(); b.st = st;
    if (threadIdx.x == 0) (void)xb_add(&bar[XB_XCNT(b.x)], 1u);
    return b;
}
__device__ __forceinline__ void xcd_barrier_complete(unsigned* bar, unsigned x, unsigned& nloc, unsigned& nx) {
    const unsigned G = gridDim.x * gridDim.y * gridDim.z;
    unsigned sum, cnt, mine, sp = 0u;
    for (;;) {
        sum = 0u; cnt = 0u; mine = 0u;
#pragma unroll
        for (unsigned j = 0; j < 16; ++j) { const unsigned c = xb_ld(&bar[XB_XCNT(j)]); sum += c; cnt += (c > 0u) ? 1u : 0u; mine = (j == x) ? c : mine; }
        if (sum == G) break;
        __builtin_amdgcn_s_sleep(1);
        if ((++sp & 255u) == 0u) { if (xb_ld(&bar[XB_TMO])) break; if (sp > XB_SPIN_CAP) { atomicAdd(&bar[XB_TMO], 1u); break; } }
    }
    nloc = mine > 0u ? mine : 1u; nx = cnt > 0u ? cnt : 1u;
}
__device__ __forceinline__ void xcd_barrier(const XcdBarrier& b) {
    asm volatile("s_waitcnt vmcnt(0)" ::: "memory");
    __syncthreads();
    if (threadIdx.x == 0) {
        unsigned* bar = b.bar;
        __builtin_amdgcn_s_waitcnt(0);
        unsigned nloc = b.st[0], nx = b.st[1];
        if (nloc == 0u) { xcd_barrier_complete(bar, b.x, nloc, nx); b.st[0] = nloc; b.st[1] = nx; }
        const unsigned old = xb_add(&bar[XB_XSUB(b.x)], 1u);
        const unsigned gen = old / nloc;
        if (old + 1u == (gen + 1u) * nloc) {
            __builtin_amdgcn_fence(__ATOMIC_RELEASE, "agent");
            asm volatile("s_waitcnt vmcnt(0)" ::: "memory");
            const unsigned og = xb_add(&bar[XB_TOP], 1u);
            const unsigned tg = og / nx;
            if (og + 1u == (tg + 1u) * nx) xb_add(&bar[XB_TOPGEN], 1u);
            else XB_SPIN(xb_ld(&bar[XB_TOPGEN]) == tg, bar);
            __builtin_amdgcn_fence(__ATOMIC_ACQUIRE, "agent");
            xb_add(&bar[XB_XGEN(b.x)], 1u);
            asm volatile("s_waitcnt vmcnt(0)" ::: "memory");
        } else {
            XB_SPIN(xb_ld(&bar[XB_XGEN(b.x)]) == gen, bar);
            __builtin_amdgcn_fence(__ATOMIC_ACQUIRE, "agent");
            asm volatile("s_waitcnt vmcnt(0)" ::: "memory");
        }
    }
    __syncthreads();
}

namespace fk {
#define GAS __attribute__((address_space(1)))
typedef unsigned u32x4 __attribute__((ext_vector_type(4)));
typedef unsigned u32x2 __attribute__((ext_vector_type(2)));
typedef float f32x4 __attribute__((ext_vector_type(4)));
typedef float f32x2 __attribute__((ext_vector_type(2)));
typedef __bf16 bf2 __attribute__((ext_vector_type(2)));
typedef unsigned short bf16_t;
__device__ __forceinline__ float bflo(unsigned u) { return __uint_as_float(u << 16); }
__device__ __forceinline__ float bfhi(unsigned u) { return __uint_as_float(u & 0xffff0000u); }
__device__ __forceinline__ float dot2(unsigned a, unsigned b, float c) { return __builtin_amdgcn_fdot2_f32_bf16(__builtin_bit_cast(bf2, a), __builtin_bit_cast(bf2, b), c, false); }
__device__ __forceinline__ unsigned pk_bf16(float lo, float hi) { unsigned r; asm volatile("v_cvt_pk_bf16_f32 %0, %1, %2" : "=v"(r) : "v"(lo), "v"(hi)); return r; }
template <int CTRL> __device__ __forceinline__ float dppf(float v) { return __int_as_float(__builtin_amdgcn_update_dpp(0, __float_as_int(v), CTRL, 0xf, 0xf, true)); }
__device__ __forceinline__ float row_max16(float v) { v = fmaxf(v, dppf<0xB1>(v)); v = fmaxf(v, dppf<0x4E>(v)); v = fmaxf(v, dppf<0x141>(v)); v = fmaxf(v, dppf<0x140>(v)); return v; }
__device__ __forceinline__ float frcp(float x) { return __builtin_amdgcn_rcpf(x); }
__device__ __forceinline__ float fsqrt(float x) { return __builtin_amdgcn_sqrtf(x); }
__device__ __forceinline__ float row_sum8(float v) { v += dppf<0xB1>(v); v += dppf<0x4E>(v); v += dppf<0x141>(v); return v; }
__device__ __forceinline__ float row_sum16(float v) { v += dppf<0xB1>(v); v += dppf<0x4E>(v); v += dppf<0x141>(v); v += dppf<0x140>(v); return v; }
__device__ __forceinline__ float shx(float v, int m, int lane) { return __int_as_float(__builtin_amdgcn_ds_bpermute((lane ^ m) << 2, __float_as_int(v))); }
__device__ __forceinline__ float wave_sum(float v, int lane) { v = row_sum16(v); v += shx(v, 16, lane); v += shx(v, 32, lane); return v; }
__device__ __forceinline__ float gelu_tanh(float x) { return 0.5f * x * (1.f + tanhf(0.7978845608028654f * (x + 0.044715f * x * x * x))); }
#define FK_NEG (-3.0e38f)

template <int CTRL> __device__ __forceinline__ int dppi(int v) { return __builtin_amdgcn_update_dpp(0, v, CTRL, 0xf, 0xf, true); }
__device__ __forceinline__ int row_min16i(int v) { v = min(v, dppi<0xB1>(v)); v = min(v, dppi<0x4E>(v)); v = min(v, dppi<0x141>(v)); v = min(v, dppi<0x140>(v)); return v; }
#define FK_CE(a, b) do { const bool sw_ = v[b] > v[a]; const float tv_ = sw_ ? v[b] : v[a]; v[b] = sw_ ? v[a] : v[b]; v[a] = tv_; const int ti_ = sw_ ? id[b] : id[a]; id[b] = sw_ ? id[a] : id[b]; id[a] = ti_; } while (0)
#define FK_SORT8(v, id) do { FK_CE2(v, id, 0, 1); FK_CE2(v, id, 2, 3); FK_CE2(v, id, 4, 5); FK_CE2(v, id, 6, 7); FK_CE2(v, id, 0, 2); FK_CE2(v, id, 1, 3); FK_CE2(v, id, 4, 6); FK_CE2(v, id, 5, 7); FK_CE2(v, id, 1, 2); FK_CE2(v, id, 5, 6); \
    FK_CE2(v, id, 0, 4); FK_CE2(v, id, 1, 5); FK_CE2(v, id, 2, 6); FK_CE2(v, id, 3, 7); FK_CE2(v, id, 2, 4); FK_CE2(v, id, 3, 5); FK_CE2(v, id, 1, 2); FK_CE2(v, id, 3, 4); FK_CE2(v, id, 5, 6); } while (0)
#define FK_CE2(v, id, a, b) do { const bool sw_ = v[b] > v[a]; const float tv_ = sw_ ? v[b] : v[a]; v[b] = sw_ ? v[a] : v[b]; v[a] = tv_; const int ti_ = sw_ ? id[b] : id[a]; id[b] = sw_ ? id[a] : id[b]; id[a] = ti_; } while (0)
__device__ __forceinline__ void top16_of_128_x2(float (&v)[8], int (&id)[8], float (&u)[8], int (&jd)[8], int lane16, float& rv1, int& ri1, float& rv2, int& ri2) {
    FK_SORT8(v, id); FK_SORT8(u, jd);
    rv1 = FK_NEG; ri1 = 0; rv2 = FK_NEG; ri2 = 0;
#pragma unroll
    for (int r = 0; r < 16; ++r) {
        const float wm = row_max16(v[0]), xm = row_max16(u[0]);
        const int cand = (v[0] == wm) ? id[0] : 0x7fffffff, dand = (u[0] == xm) ? jd[0] : 0x7fffffff;
        const int sel = row_min16i(cand), tel = row_min16i(dand);
        const bool mine = (cand == sel), nine = (dand == tel);
        if (lane16 == r) { rv1 = wm; ri1 = sel; rv2 = xm; ri2 = tel; }
#pragma unroll
        for (int i = 0; i < 7; ++i) { v[i] = mine ? v[i + 1] : v[i]; id[i] = mine ? id[i + 1] : id[i]; u[i] = nine ? u[i + 1] : u[i]; jd[i] = nine ? jd[i + 1] : jd[i]; }
        v[7] = mine ? FK_NEG : v[7]; u[7] = nine ? FK_NEG : u[7];
    }
}
__device__ __forceinline__ int fk_key(float x, int lane16) { int k = __float_as_int(x); k ^= (k >> 31) & 0x7fffffff; return (k & ~15) | (15 - lane16); }
__device__ __forceinline__ float fk_unkey(int k) { k &= ~15; k ^= (k >> 31) & 0x7fffffff; return __int_as_float(k); }
__device__ __forceinline__ int row_max16i(int v) { v = max(v, dppi<0xB1>(v)); v = max(v, dppi<0x4E>(v)); v = max(v, dppi<0x141>(v)); v = max(v, dppi<0x140>(v)); return v; }
__device__ __forceinline__ void topk_phase(const GAS bf16_t* __restrict__ SC, const GAS bf16_t* __restrict__ Q, const GAS float* __restrict__ KSUM, GAS float* __restrict__ GATE, GAS int* __restrict__ EIDX, int nitems,
                                           LAS unsigned char* lds, int wid, int lane, int wave_gid, int nwaves) {
    LAS float* xv = (LAS float*)(lds + wid * 512);
    const int lane16 = lane & 15, rowbase = lane & 48;
    unsigned ctab = 0xffffffffu;
    { const unsigned T_[14] = {0x03020100u, 0x07060504u, 0x0b0a0908u, 0x0f0e0d0cu, 0x13121110u, 0x17161514u, 0x23222120u, 0xffffff24u, 0x33323130u, 0xff424140u, 0x71615150u, 0x90807060u, 0xd0c0b0a0u, 0xfffff0e0u};
#pragma unroll
      for (int i = 0; i < 14; ++i) ctab = lane16 == i ? T_[i] : ctab; }
    u32x4 nqa, nqb, nsw, ntw;
#define TK_LOAD(wi_) do { int it_ = (wi_) * 4 + (lane >> 4); it_ = it_ < nitems ? it_ : nitems - 1; const GAS u32x4* qp_ = (const GAS u32x4*)(Q + (size_t)it_ * 256 + 16 * lane16); nqa = qp_[0]; nqb = qp_[1]; \
        const GAS bf16_t* sp_ = SC + (size_t)it_ * 256 + 8 * lane16; nsw = *(const GAS u32x4*)sp_; ntw = *(const GAS u32x4*)(sp_ + 128); } while (0)
    TK_LOAD(wave_gid);
    const GAS float* kp = KSUM + ((wave_gid * 4 + (lane >> 4)) & 7) * 256 + 8 * lane16; const f32x4 k0 = *(const GAS f32x4*)kp, k1 = *(const GAS f32x4*)(kp + 4), m0 = *(const GAS f32x4*)(kp + 128), m1 = *(const GAS f32x4*)(kp + 132);
    for (int wi = wave_gid; wi * 4 < nitems; wi += nwaves) {
        const int it = wi * 4 + (lane >> 4);
        const u32x4 qa = nqa, qb = nqb; const f32x4 s0 = (f32x4){bflo(nsw[0]), bfhi(nsw[0]), bflo(nsw[1]), bfhi(nsw[1])}, s1 = (f32x4){bflo(nsw[2]), bfhi(nsw[2]), bflo(nsw[3]), bfhi(nsw[3])},
                    t0 = (f32x4){bflo(ntw[0]), bfhi(ntw[0]), bflo(ntw[1]), bfhi(ntw[1])}, t1 = (f32x4){bflo(ntw[2]), bfhi(ntw[2]), bflo(ntw[3]), bfhi(ntw[3])};
        TK_LOAD(wi + nwaves);
        float qs = 0.f, qq = 0.f;
#pragma unroll
        for (int i = 0; i < 4; ++i) { const float a = bflo(qa[i]), b = bfhi(qa[i]), c = bflo(qb[i]), d = bfhi(qb[i]); qs += (a + b) + (c + d); qq += (a * a + b * b) + (c * c + d * d); }
        const float mu = row_sum16(qs) * (1.f / 256.f); const float var = fmaxf(row_sum16(qq) * (1.f / 256.f) - mu * mu, 0.f); const float rs = 1.f / sqrtf(var + 1e-5f);
        int ka[8], kb[8];
#define TK_KEY(x_, id_) ({ int k_ = __float_as_int(x_); k_ ^= (k_ >> 31) & 0x7fffffff; (k_ & ~127) | (127 - (id_)); })
#define TK_VAL(k_) ({ int q_ = (k_) & ~127; q_ ^= (q_ >> 31) & 0x7fffffff; __int_as_float(q_); })
#pragma unroll
        for (int i = 0; i < 4; ++i) { ka[i] = TK_KEY(rs * (s0[i] - mu * k0[i]), 8 * lane16 + i); ka[4 + i] = TK_KEY(rs * (s1[i] - mu * k1[i]), 8 * lane16 + 4 + i);
            kb[i] = TK_KEY(rs * (t0[i] - mu * m0[i]), 8 * lane16 + i); kb[4 + i] = TK_KEY(rs * (t1[i] - mu * m1[i]), 8 * lane16 + 4 + i); }
#define TK_CE(k_, a_, b_) do { const int hi_ = max(k_[a_], k_[b_]), lo_ = min(k_[a_], k_[b_]); k_[a_] = hi_; k_[b_] = lo_; } while (0)
#define TK_SORT8(k_) do { TK_CE(k_, 0, 1); TK_CE(k_, 2, 3); TK_CE(k_, 4, 5); TK_CE(k_, 6, 7); TK_CE(k_, 0, 2); TK_CE(k_, 1, 3); TK_CE(k_, 4, 6); TK_CE(k_, 5, 7); TK_CE(k_, 1, 2); TK_CE(k_, 5, 6); \
        TK_CE(k_, 0, 4); TK_CE(k_, 1, 5); TK_CE(k_, 2, 6); TK_CE(k_, 3, 7); TK_CE(k_, 2, 4); TK_CE(k_, 3, 5); TK_CE(k_, 1, 2); TK_CE(k_, 3, 4); TK_CE(k_, 5, 6); } while (0)
        TK_SORT8(ka); TK_SORT8(kb);
        constexpr int KMIN = (int)0x80000000;
        int r1 = KMIN, r2 = KMIN;
#pragma unroll
        for (int r = 0; r < 16; ++r) {
            const int wm1 = row_max16i(ka[0]), wm2 = row_max16i(kb[0]); const bool mine = (ka[0] == wm1), nine = (kb[0] == wm2);
            if (lane16 == r) { r1 = wm1; r2 = wm2; }
#pragma unroll
            for (int i = 0; i < 7; ++i) { ka[i] = mine ? ka[i + 1] : ka[i]; kb[i] = nine ? kb[i + 1] : kb[i]; }
            ka[7] = mine ? KMIN : ka[7]; kb[7] = nine ? KMIN : kb[7];
        }
        const float rv1 = TK_VAL(r1), rv2 = TK_VAL(r2);
        xv[lane] = rv1; xv[64 + lane] = rv2;
        int kc[4];
#pragma unroll
        for (int q = 0; q < 4; ++q) { const int ij = (ctab >> (8 * q)) & 255; const float sm = xv[rowbase + ((ij >> 4) & 15)] + xv[64 + rowbase + (ij & 15)]; int k_ = __float_as_int(sm); k_ ^= (k_ >> 31) & 0x7fffffff; kc[q] = ij == 255 ? KMIN : ((k_ & ~255) | (255 - ij)); }
        int rk = KMIN;
#pragma unroll
        for (int r = 0; r < 16; ++r) {
            const int wm = row_max16i(kc[0]); const bool mine = (kc[0] == wm);
            if (lane16 == r) rk = wm;
            kc[0] = mine ? kc[1] : kc[0]; kc[1] = mine ? kc[2] : kc[1]; kc[2] = mine ? kc[3] : kc[2]; kc[3] = mine ? KMIN : kc[3];
        }
        const int pid = 255 - (rk & 255), i1 = pid >> 4, j2 = pid & 15;
        const int g1 = __builtin_amdgcn_ds_bpermute((rowbase + i1) << 2, r1), g2 = __builtin_amdgcn_ds_bpermute((rowbase + j2) << 2, r2);
        const int e1 = 127 - (g1 & 127), e2 = 127 - (g2 & 127);
        float sc; { int q_ = rk & ~255; q_ ^= (q_ >> 31) & 0x7fffffff; sc = __int_as_float(q_); }
        const float mx = TK_VAL(row_max16i(TK_KEY(sc, 0))); const float ex = __expf(sc - mx); const float den = row_sum16(ex);
        GATE[(size_t)it * 16 + lane16] = ex / den; EIDX[(size_t)it * 16 + lane16] = e1 * 128 + e2;
#undef TK_KEY
#undef TK_VAL
#undef TK_CE
#undef TK_SORT8
    }
#undef TK_LOAD
}

__device__ __forceinline__ f32x2 fp8lo(unsigned w) { return __builtin_amdgcn_cvt_pk_f32_fp8((int)w, false); }
__device__ __forceinline__ f32x2 fp8hi(unsigned w) { return __builtin_amdgcn_cvt_pk_f32_fp8((int)w, true); }
__device__ __forceinline__ void act_phase(const GAS bf16_t* __restrict__ XB, const GAS unsigned char* __restrict__ U8, const GAS float* __restrict__ GATE, const GAS int* __restrict__ EIDX, GAS float* __restrict__ COEF, int nitems,
                                          int lane, int wave_gid, int nwaves) {
    int it = wave_gid; if (it >= nitems) return;
    u32x4 uc[16], un[16], xac, xbc, xan, xbn;
    int evc = EIDX[(size_t)it * 16 + (lane & 15)];
    { const GAS u32x4* xp = (const GAS u32x4*)(XB + (size_t)(it >> 3) * 1024 + 16 * lane); xac = xp[0]; xbc = xp[1]; }
#pragma unroll
    for (int k = 0; k < 16; ++k) uc[k] = *(const GAS u32x4*)(U8 + (size_t)__builtin_amdgcn_readlane(evc, k) * 1024 + 16 * lane);
    int itn = it + nwaves; int evn = (itn < nitems) ? EIDX[(size_t)itn * 16 + (lane & 15)] : 0;
    for (;;) {
        const bool hasn = itn < nitems;
        if (hasn) {
            const GAS u32x4* xp = (const GAS u32x4*)(XB + (size_t)(itn >> 3) * 1024 + 16 * lane); xan = xp[0]; xbn = xp[1];
#pragma unroll
            for (int k = 0; k < 16; ++k) un[k] = *(const GAS u32x4*)(U8 + (size_t)__builtin_amdgcn_readlane(evn, k) * 1024 + 16 * lane);
        }
        const int itnn = itn + nwaves; const int evnn = (itnn < nitems) ? EIDX[(size_t)itnn * 16 + (lane & 15)] : 0;
        const float gt = GATE[(size_t)it * 16 + (lane >> 2)];
        float x[16];
#pragma unroll
        for (int i = 0; i < 4; ++i) { x[2 * i] = bflo(xac[i]); x[2 * i + 1] = bfhi(xac[i]); x[8 + 2 * i] = bflo(xbc[i]); x[8 + 2 * i + 1] = bfhi(xbc[i]); }
        float a[16];
#pragma unroll
        for (int k = 0; k < 16; ++k) { const u32x4 uw = uc[k]; float s = 0.f;
#pragma unroll
            for (int d = 0; d < 4; ++d) { const f32x2 lo = fp8lo(uw[d]), hi = fp8hi(uw[d]); s = fmaf(lo.x, x[4 * d], s); s = fmaf(lo.y, x[4 * d + 1], s); s = fmaf(hi.x, x[4 * d + 2], s); s = fmaf(hi.y, x[4 * d + 3], s); }
            asm volatile("" : "+v"(s)); a[k] = s; }
#pragma unroll
        for (int k = 0; k < 8; ++k) { const bool hi = lane & 32; const float send = hi ? a[k] : a[k + 8], keep = hi ? a[k + 8] : a[k]; a[k] = keep + shx(send, 32, lane); }
#pragma unroll
        for (int k = 0; k < 4; ++k) { const bool hi = lane & 16; const float send = hi ? a[k] : a[k + 4], keep = hi ? a[k + 4] : a[k]; a[k] = keep + shx(send, 16, lane); }
#pragma unroll
        for (int k = 0; k < 2; ++k) { const bool hi = lane & 8; const float send = hi ? a[k] : a[k + 2], keep = hi ? a[k + 2] : a[k]; a[k] = keep + shx(send, 8, lane); }
        { const bool hi = lane & 4; const float send = hi ? a[0] : a[1], keep = hi ? a[1] : a[0]; a[0] = keep + shx(send, 4, lane); }
        float dsum = a[0]; dsum += shx(dsum, 2, lane); dsum += shx(dsum, 1, lane);
        if ((lane & 3) == 0) COEF[(size_t)it * 16 + (lane >> 2)] = gt * gelu_tanh(dsum * (1.f / 128.f));
        if (!hasn) break;
#pragma unroll
        for (int k = 0; k < 16; ++k) uc[k] = un[k];
        xac = xan; xbc = xbn; evc = evn; evn = evnn; it = itn; itn = itnn;
    }
}

__device__ __forceinline__ void outln_phase(const GAS float* COEF, const GAS int* EIDX, const GAS unsigned char* V8,     const GAS float* __restrict__ lg, const GAS float* __restrict__ lb, GAS float* X, GAS bf16_t* XB, int nrows,
                                            int lane, int wave_gid, int nwaves) {
    const float alpha = 1.6817928305074292f;
    int row = wave_gid; if (row >= nrows) return;
    u32x4 vc[16], vn[16];
    float cf0 = COEF[(size_t)row * 128 + lane] * (1.f / 64.f), cf1 = COEF[(size_t)row * 128 + 64 + lane] * (1.f / 64.f); int ev0 = EIDX[(size_t)row * 128 + lane], ev1 = EIDX[(size_t)row * 128 + 64 + lane];
#define OUT_LOADCH(dst, evreg, base) do { _Pragma("unroll") for (int k_ = 0; k_ < 16; ++k_) dst[k_] = *(const GAS u32x4*)(V8 + (size_t)__builtin_amdgcn_readlane(evreg, (base) + k_) * 1024 + 16 * lane); } while (0)
#define OUT_COMPCH(src, cfreg, base) do { _Pragma("unroll") for (int k_ = 0; k_ < 16; ++k_) { const float c_ = __int_as_float(__builtin_amdgcn_readlane(__float_as_int(cfreg), (base) + k_)); const u32x4 vw_ = src[k_]; \
        _Pragma("unroll") for (int d_ = 0; d_ < 4; ++d_) { const f32x2 lo_ = fp8lo(vw_[d_]), hi_ = fp8hi(vw_[d_]); acc[4 * d_] = fmaf(c_, lo_.x, acc[4 * d_]); acc[4 * d_ + 1] = fmaf(c_, lo_.y, acc[4 * d_ + 1]); acc[4 * d_ + 2] = fmaf(c_, hi_.x, acc[4 * d_ + 2]); acc[4 * d_ + 3] = fmaf(c_, hi_.y, acc[4 * d_ + 3]); } \
        _Pragma("unroll") for (int p_ = 0; p_ < 16; ++p_) asm volatile("" : "+v"(acc[p_]));     \
        } } while (0)
    for (;;) {
        OUT_LOADCH(vc, ev0, 0);
        const int rown = row + nwaves; const bool hasn = rown < nrows;
        float ncf0 = 0.f, ncf1 = 0.f; int nev0 = 0, nev1 = 0;
        if (hasn) { ncf0 = COEF[(size_t)rown * 128 + lane] * (1.f / 64.f); ncf1 = COEF[(size_t)rown * 128 + 64 + lane] * (1.f / 64.f); nev0 = EIDX[(size_t)rown * 128 + lane]; nev1 = EIDX[(size_t)rown * 128 + 64 + lane]; }
        float acc[16];
#pragma unroll
        for (int k = 0; k < 16; ++k) acc[k] = 0.f;
#define OUT_FENCE() asm volatile("" ::: "memory")
        OUT_LOADCH(vn, ev0, 16); OUT_FENCE(); OUT_COMPCH(vc, cf0, 0); OUT_FENCE();
        OUT_LOADCH(vc, ev0, 32); OUT_FENCE(); OUT_COMPCH(vn, cf0, 16); OUT_FENCE();
        OUT_LOADCH(vn, ev0, 48); OUT_FENCE(); OUT_COMPCH(vc, cf0, 32); OUT_FENCE();
        OUT_LOADCH(vc, ev1, 0);  OUT_FENCE(); OUT_COMPCH(vn, cf0, 48); OUT_FENCE();
        OUT_LOADCH(vn, ev1, 16); OUT_FENCE(); OUT_COMPCH(vc, cf1, 0); OUT_FENCE();
        OUT_LOADCH(vc, ev1, 32); OUT_FENCE(); OUT_COMPCH(vn, cf1, 16); OUT_FENCE();
        OUT_LOADCH(vn, ev1, 48); OUT_FENCE(); OUT_COMPCH(vc, cf1, 32); OUT_FENCE();
        OUT_COMPCH(vn, cf1, 48); OUT_FENCE();
#undef OUT_FENCE
        GAS float* xr = X + (size_t)row * 1024 + 16 * lane; float t[16];
#pragma unroll
        for (int q = 0; q < 4; ++q) { const f32x4 xv = *(const GAS f32x4*)(xr + 4 * q); t[4 * q] = fmaf(alpha, xv.x, acc[4 * q]); t[4 * q + 1] = fmaf(alpha, xv.y, acc[4 * q + 1]); t[4 * q + 2] = fmaf(alpha, xv.z, acc[4 * q + 2]); t[4 * q + 3] = fmaf(alpha, xv.w, acc[4 * q + 3]); }
        float s = 0.f;
#pragma unroll
        for (int k = 0; k < 16; ++k) s += t[k];
        const float mu = wave_sum(s, lane) * (1.f / 1024.f); float vs = 0.f;
#pragma unroll
        for (int k = 0; k < 16; ++k) { t[k] -= mu; vs = fmaf(t[k], t[k], vs); }
        const float rs = 1.f / sqrtf(wave_sum(vs, lane) * (1.f / 1024.f) + 1e-5f);
        unsigned w[8];
#pragma unroll
        for (int q = 0; q < 4; ++q) { const f32x4 g = *(const GAS f32x4*)(lg + 16 * lane + 4 * q), b = *(const GAS f32x4*)(lb + 16 * lane + 4 * q); f32x4 o;
            o.x = t[4 * q] * rs * g.x + b.x; o.y = t[4 * q + 1] * rs * g.y + b.y; o.z = t[4 * q + 2] * rs * g.z + b.z; o.w = t[4 * q + 3] * rs * g.w + b.w;
            *(GAS f32x4*)(xr + 4 * q) = o; w[2 * q] = pk_bf16(o.x, o.y); w[2 * q + 1] = pk_bf16(o.z, o.w); }
        u32x4 w0, w1; w0.x = w[0]; w0.y = w[1]; w0.z = w[2]; w0.w = w[3]; w1.x = w[4]; w1.y = w[5]; w1.z = w[6]; w1.w = w[7];
        GAS u32x4* xbp = (GAS u32x4*)(XB + (size_t)row * 1024 + 16 * lane); xbp[0] = w0; xbp[1] = w1;
        if (!hasn) break;
        row = rown; cf0 = ncf0; cf1 = ncf1; ev0 = nev0; ev1 = nev1;
    }
#undef OUT_LOADCH
#undef OUT_COMPCH
}

__device__ __forceinline__ void lnres_phase(const GAS bf16_t* __restrict__ Y, const GAS float* __restrict__ lg, const GAS float* __restrict__ lb, GAS float* X, GAS bf16_t* XB, GAS unsigned char* XF8, GAS float* YO, int B, int T, int nrows, int lane, int wave_gid, int nwaves) {
    const float alpha = 1.6817928305074292f; (void)X;
    for (int row = wave_gid; row < nrows; row += nwaves) {
        GAS bf16_t* xr = XB + (size_t)row * 1024; const GAS bf16_t* yr = Y + (size_t)row * 1024; float t[16];
        GAS float* yo = nullptr; if (YO) { if (row < B * T) { const int bb = row / T, tt = row - bb * T; if (tt >= 16) yo = YO + ((size_t)bb * (T - 16) + (tt - 16)) * 1024; } else yo = YO + ((size_t)B * (T - 16) + (row - B * T)) * 1024; }
#pragma unroll
        for (int q = 0; q < 4; ++q) { const u32x2 xw = *(const GAS u32x2*)(xr + 256 * q + 4 * lane); const u32x2 yw = *(const GAS u32x2*)(yr + 256 * q + 4 * lane);
            t[4 * q] = fmaf(alpha, bflo(xw.x), bflo(yw.x)); t[4 * q + 1] = fmaf(alpha, bfhi(xw.x), bfhi(yw.x)); t[4 * q + 2] = fmaf(alpha, bflo(xw.y), bflo(yw.y)); t[4 * q + 3] = fmaf(alpha, bfhi(xw.y), bfhi(yw.y)); }
        float s = 0.f;
#pragma unroll
        for (int k = 0; k < 16; ++k) s += t[k];
        const float mu = wave_sum(s, lane) * (1.f / 1024.f); float vs = 0.f;
#pragma unroll
        for (int k = 0; k < 16; ++k) { t[k] -= mu; vs = fmaf(t[k], t[k], vs); }
        const float rs = 1.f / sqrtf(wave_sum(vs, lane) * (1.f / 1024.f) + 1e-5f);
#pragma unroll
        for (int q = 0; q < 4; ++q) { const int c = 256 * q + 4 * lane; const f32x4 g = *(const GAS f32x4*)(lg + c), b = *(const GAS f32x4*)(lb + c); f32x4 o;
            o.x = t[4 * q] * rs * g.x + b.x; o.y = t[4 * q + 1] * rs * g.y + b.y; o.z = t[4 * q + 2] * rs * g.z + b.z; o.w = t[4 * q + 3] * rs * g.w + b.w;
            if (YO) { if (yo) *(GAS f32x4*)(yo + c) = o; }
            else { u32x2 w; w.x = pk_bf16(o.x, o.y); w.y = pk_bf16(o.z, o.w); *(GAS u32x2*)(xr + c) = w; }
            if (XF8) {
                const float s0 = __builtin_amdgcn_fmed3f(o.x * 16.f, -448.f, 448.f), s1 = __builtin_amdgcn_fmed3f(o.y * 16.f, -448.f, 448.f), s2 = __builtin_amdgcn_fmed3f(o.z * 16.f, -448.f, 448.f), s3 = __builtin_amdgcn_fmed3f(o.w * 16.f, -448.f, 448.f);
                int hp = __builtin_amdgcn_cvt_pk_fp8_f32(s0, s1, 0, false); hp = __builtin_amdgcn_cvt_pk_fp8_f32(s2, s3, hp, true);
                const f32x2 d01 = fp8lo((unsigned)hp), d23 = fp8hi((unsigned)hp);
                int lp = __builtin_amdgcn_cvt_pk_fp8_f32(s0 - d01.x, s1 - d01.y, 0, false); lp = __builtin_amdgcn_cvt_pk_fp8_f32(s2 - d23.x, s3 - d23.y, lp, true);
                *(GAS int*)(XF8 + (size_t)row * 2048 + c) = hp; *(GAS int*)(XF8 + (size_t)row * 2048 + 1024 + c) = lp; } }
    }
}

__device__ __forceinline__ void glanorm_phase(const GAS float* __restrict__ O, const GAS float* __restrict__ PROJ, const GAS float* __restrict__ gnorm, GAS bf16_t* XB, int nitems, int lane, int wave_gid, int nwaves) {
    const float g0 = gnorm[lane], g1 = gnorm[64 + lane];
    for (int it0 = wave_gid * 8; it0 < nitems; it0 += nwaves * 8) {
        float a0[8], a1[8], r0[8], r1[8];
#pragma unroll
        for (int q = 0; q < 8; ++q) { int it = it0 + q; it = it < nitems ? it : it0; const int row = it >> 2, h = it & 3; const GAS float* o = O + (size_t)row * 512 + h * 128; const GAS float* r = PROJ + (size_t)row * 2576 + 1040 + h * 128;
            a0[q] = o[lane]; a1[q] = o[64 + lane]; r0[q] = r[lane]; r1[q] = r[64 + lane]; }
#pragma unroll
        for (int q = 0; q < 8; ++q) { const int it = it0 + q; const int row = it >> 2, h = it & 3;
            const float rs = 1.f / sqrtf(wave_sum(a0[q] * a0[q] + a1[q] * a1[q], lane) * (1.f / 128.f) + 1e-5f);
            const float y0 = a0[q] * rs * g0 * (r0[q] * frcp(1.f + __expf(-r0[q]))), y1 = a1[q] * rs * g1 * (r1[q] * frcp(1.f + __expf(-r1[q])));
            if (it < nitems) { GAS bf16_t* d = XB + (size_t)row * 1024 + h * 128; d[lane] = (bf16_t)(pk_bf16(y0, 0.f) & 0xffffu); d[64 + lane] = (bf16_t)(pk_bf16(y1, 0.f) & 0xffffu); } }
    }
}

__device__ __forceinline__ float sigm(float x) { return frcp(1.f + __expf(-x)); }
__device__ __forceinline__ float softplusf(float x) { return fmaxf(x, 0.f) + log1pf(__expf(-fabsf(x))); }
__device__ __forceinline__ void rwkvprep_phase(const GAS float* __restrict__ w0, const GAS float* __restrict__ a0, const GAS float* __restrict__ v0, const GAS float* __restrict__ k_k, const GAS float* __restrict__ k_a, const GAS float* __restrict__ Vg,
                                               GAS float* K, GAS float* Wd, GAS float* Aa, GAS float* V, GAS float* NKK, GAS float* VFIRST, int has_vres, int nitems, int lane, int wave_gid, int nwaves) {
    for (int it0 = wave_gid * 4; it0 < nitems; it0 += nwaves * 4) {
        float kq[4], wq[4], aq[4], vq[4], gq[4], fq[4];
#pragma unroll
        for (int q = 0; q < 4; ++q) { const int it = it0 + q; const size_t ix = (size_t)(it >> 4) * 1024 + (it & 15) * 64 + lane; kq[q] = K[ix]; wq[q] = Wd[ix]; aq[q] = Aa[ix]; vq[q] = V[ix]; gq[q] = has_vres ? Vg[ix] : 0.f; fq[q] = has_vres ? VFIRST[ix] : 0.f; }
#pragma unroll
        for (int q = 0; q < 4; ++q) { const int it = it0 + q; const int h = it & 15; const size_t ix = (size_t)(it >> 4) * 1024 + h * 64 + lane; const int c = h * 64 + lane;
            const float k0 = kq[q]; const float kv = k0 * k_k[c]; const float inv = 1.f / fmaxf(sqrtf(wave_sum(kv * kv, lane)), 1e-12f);
            const float w = -softplusf(-(w0[c] + wq[q])) - 0.5f; const float dec = __expf(-__expf(w));
            const float a = sigm(a0[c] + aq[q]);
            float v = vq[q]; if (has_vres) v = v + (fq[q] - v) * sigm(v0[c] + gq[q]); else VFIRST[ix] = v;
            const float kk = kv * inv;
            NKK[ix] = -kk; K[ix] = k0 * (1.f + (a - 1.f) * k_a[c]); Wd[ix] = dec; Aa[ix] = kk * a; V[ix] = v; }
    }
}

__device__ __forceinline__ void rwkvpost_phase(const GAS float* __restrict__ Y, const GAS float* __restrict__ R, const GAS float* __restrict__ K2, const GAS float* __restrict__ V, const GAS float* __restrict__ G, const GAS float* __restrict__ r_k,
                                               const GAS float* __restrict__ lnx_g, const GAS float* __restrict__ lnx_b, GAS bf16_t* XB, int nitems, int lane, int wave_gid, int nwaves) {
    for (int it0 = wave_gid * 4; it0 < nitems; it0 += nwaves * 4) {
        float yq[4], rq[4], kq[4], vq[4], gq[4];
#pragma unroll
        for (int q = 0; q < 4; ++q) { const int it = it0 + q; const size_t ix = (size_t)(it >> 4) * 1024 + (it & 15) * 64 + lane; yq[q] = Y[ix]; rq[q] = R[ix]; kq[q] = K2[ix]; vq[q] = V[ix]; gq[q] = G[ix]; }
#pragma unroll
        for (int q = 0; q < 4; ++q) { const int it = it0 + q; const int h = it & 15; const size_t ix = (size_t)(it >> 4) * 1024 + h * 64 + lane; const int c = h * 64 + lane;
            const float y = yq[q]; const float mu = wave_sum(y, lane) * (1.f / 64.f); const float d = y - mu; const float rs = 1.f / sqrtf(wave_sum(d * d, lane) * (1.f / 64.f) + 64e-5f);
            const float bon = wave_sum(rq[q] * kq[q] * r_k[c], lane);
            const float o = (d * rs * lnx_g[c] + lnx_b[c] + bon * vq[q]) * gq[q];
            XB[ix] = (bf16_t)(pk_bf16(o, 0.f) & 0xffffu); }
    }
}

__device__ __forceinline__ void wkv_phase(const GAS float* __restrict__ R, const GAS float* __restrict__ Wd, const GAS float* __restrict__ K2, const GAS float* __restrict__ V, const GAS float* __restrict__ BB, const GAS float* __restrict__ NKK,
                                          const GAS float* __restrict__ SIN, GAS float* __restrict__ Y, GAS float* __restrict__ P, GAS float* __restrict__ SOUT, int B, int T, int DB, int DT, LAS unsigned char* lds, int tid, int bid, int nb) {
    constexpr int TB = 32, NLD = 6, VECB = TB * 1280, VVB = TB * 128, BUF = VECB + 2 * VVB;
    const int rowl = tid >> 4, part = tid & 15;
    const int nprompt = B * 32, nunits = nprompt + DB * 32;
    for (int u = bid; u < nunits; u += nb) {
        const bool smp = u >= nprompt; const int q0_ = smp ? u - nprompt : u; const int q = ((q0_ & 7) << 1 | ((q0_ >> 3) & 1)) + ((q0_ >> 4) << 4);
        const int half = q & 1, pair = q >> 1, sq = pair >> 4, h = pair & 15;
        const int Tu = smp ? DT : T; const int r0 = smp ? B * T + sq * DT : sq * T, vrow = half * 32 + rowl;
        f32x2 S01 = (f32x2){0.f, 0.f}, S23 = (f32x2){0.f, 0.f};
        if (smp) { const f32x4 s4 = *(const GAS f32x4*)(SIN + ((size_t)pair * 64 + vrow) * 64 + part * 4); S01 = (f32x2){s4.x, s4.y}; S23 = (f32x2){s4.z, s4.w};
                   asm volatile("" : "+v"(S01), "+v"(S23)); }
        const int nblk = (Tu + TB - 1) / TB;
        f32x4 ld[NLD];
        const size_t eo_ = (size_t)(r0 + (tid >> 4)) * 1024 + h * 64 + (tid & 15) * 4, ev_ = (size_t)(r0 + ((tid & 255) >> 3)) * 1024 + h * 64 + half * 32 + (tid & 7) * 4;
        const int lo_ = ((tid >> 4) * 320 + (tid & 15) * 4) * 4, lv_ = VECB + (tid & 255) * 16;
#define WKV_LOAD(tb0) do { const size_t bo_ = (size_t)(tb0) * 1024; ld[0] = *(const GAS f32x4*)(Wd + eo_ + bo_); ld[1] = *(const GAS f32x4*)(NKK + eo_ + bo_); ld[2] = *(const GAS f32x4*)(BB + eo_ + bo_); \
            ld[3] = *(const GAS f32x4*)(K2 + eo_ + bo_); ld[4] = *(const GAS f32x4*)(R + eo_ + bo_); ld[5] = *(const GAS f32x4*)(V + ev_ + bo_); } while (0)
#define WKV_STORE(bufp) do { _Pragma("unroll") for (int q_ = 0; q_ < 5; ++q_) *(LAS f32x4*)((bufp) + lo_ + q_ * 256) = ld[q_]; *(LAS f32x4*)((bufp) + lv_) = ld[5]; } while (0)
        WKV_LOAD(0); WKV_STORE(lds); __syncthreads();
        for (int b = 0; b < nblk; ++b) {
            LAS unsigned char* cur = lds + (b & 1) * BUF; LAS unsigned char* nxt = lds + ((b + 1) & 1) * BUF; const int tb0 = b * TB; const int nt = (Tu - tb0) < TB ? (Tu - tb0) : TB;
            if (b + 1 < nblk) WKV_LOAD(tb0 + TB);
            const LAS float* vec = (const LAS float*)cur + part * 4; const LAS float* vv = (const LAS float*)(cur + VECB) + rowl; LAS float* yb = (LAS float*)(cur + VECB + VVB);
            float ykeep0 = 0.f, ykeep1 = 0.f;
#define WKV_STEP(t, keep, tl) do { const LAS f32x2* vp_ = (const LAS f32x2*)(vec + (t) * 320); \
                const f32x2 w01 = vp_[0], w23 = vp_[1], n01 = vp_[32], n23 = vp_[33], b01 = vp_[64], b23 = vp_[65], k01 = vp_[96], k23 = vp_[97], r01 = vp_[128], r23 = vp_[129]; \
                const float v = vv[(t) * 32]; \
                const f32x2 sp = __builtin_elementwise_fma(S23, n23, S01 * n01); const float sa = row_sum16(sp.x + sp.y); const f32x2 sa2 = (f32x2){sa, sa}, v2 = (f32x2){v, v}; \
                S01 = __builtin_elementwise_fma(S01, w01, __builtin_elementwise_fma(b01, sa2, k01 * v2)); S23 = __builtin_elementwise_fma(S23, w23, __builtin_elementwise_fma(b23, sa2, k23 * v2)); \
                const f32x2 yp = __builtin_elementwise_fma(S23, r23, S01 * r01); const float y = row_sum16(yp.x + yp.y); \
                keep = (part == (tl)) ? y : keep; } while (0)
            if (nt == TB) {
#pragma unroll 1
                for (int t = 0; t < 16; t += 8) { WKV_STEP(t, ykeep0, t); WKV_STEP(t + 1, ykeep0, t + 1); WKV_STEP(t + 2, ykeep0, t + 2); WKV_STEP(t + 3, ykeep0, t + 3); WKV_STEP(t + 4, ykeep0, t + 4); WKV_STEP(t + 5, ykeep0, t + 5); WKV_STEP(t + 6, ykeep0, t + 6); WKV_STEP(t + 7, ykeep0, t + 7); }
#pragma unroll 1
                for (int t = 16; t < 32; t += 8) { WKV_STEP(t, ykeep1, t - 16); WKV_STEP(t + 1, ykeep1, t - 15); WKV_STEP(t + 2, ykeep1, t - 14); WKV_STEP(t + 3, ykeep1, t - 13); WKV_STEP(t + 4, ykeep1, t - 12); WKV_STEP(t + 5, ykeep1, t - 11); WKV_STEP(t + 6, ykeep1, t - 10); WKV_STEP(t + 7, ykeep1, t - 9); }
            } else { for (int t = 0; t < nt; ++t) { if (t < 16) WKV_STEP(t, ykeep0, t); else WKV_STEP(t, ykeep1, t - 16); } }
#undef WKV_STEP
            yb[part * 32 + rowl] = ykeep0; yb[(16 + part) * 32 + rowl] = ykeep1;
            if (b + 1 < nblk) WKV_STORE(nxt);
            __syncthreads();
            { const int rl = tid & 31; _Pragma("unroll") for (int t = tid >> 5; t < TB; t += 16) if (t < nt) Y[(size_t)(r0 + tb0 + t) * 1024 + h * 64 + half * 32 + rl] = yb[t * 32 + rl]; }
        }
#undef WKV_LOAD
#undef WKV_STORE
        *(GAS f32x4*)((smp ? SOUT : P) + ((size_t)pair * 64 + vrow) * 64 + part * 4) = (f32x4){S01.x, S01.y, S23.x, S23.y};
        __syncthreads();
    }
}

__device__ __forceinline__ void rwkvpost2_phase(const GAS bf16_t* __restrict__ Y, const GAS bf16_t* __restrict__ G, const GAS bf16_t* __restrict__ VF, const GAS float* __restrict__ BON, const GAS float* __restrict__ lnx_g, const GAS float* __restrict__ lnx_b,
                                                GAS bf16_t* XB, int nitems, int lane, int wave_gid, int nwaves) {
    const int nit4 = nitems >> 2, hg = wave_gid & 3, cofs = hg * 256 + 4 * lane; const f32x4 lg = *(const GAS f32x4*)(lnx_g + cofs), lb = *(const GAS f32x4*)(lnx_b + cofs);
    for (int it0 = wave_gid; it0 < nit4; it0 += nwaves * 4) {
        u32x2 yq[4], vq[4], gq[4]; float bq[4];
#pragma unroll
        for (int q = 0; q < 4; ++q) { int it = it0 + q * nwaves; it = it < nit4 ? it : it0; const int row = it >> 2; const size_t ix = (size_t)row * 1024 + cofs;
            yq[q] = *(const GAS u32x2*)(Y + ix); vq[q] = *(const GAS u32x2*)(VF + ix); gq[q] = *(const GAS u32x2*)(G + ix); bq[q] = BON[row * 16 + hg * 4 + (lane >> 4)]; }
#pragma unroll
        for (int q = 0; q < 4; ++q) { const int it = it0 + q * nwaves; const int row = it >> 2; const f32x4 y = (f32x4){bflo(yq[q].x), bfhi(yq[q].x), bflo(yq[q].y), bfhi(yq[q].y)}, vv4 = (f32x4){bflo(vq[q].x), bfhi(vq[q].x), bflo(vq[q].y), bfhi(vq[q].y)};
            const float mu = row_sum16((y.x + y.y) + (y.z + y.w)) * (1.f / 64.f); const f32x4 d = y - mu; const float rs = __builtin_amdgcn_rsqf(row_sum16((d.x * d.x + d.y * d.y) + (d.z * d.z + d.w * d.w)) * (1.f / 64.f) + 64e-5f);
            const f32x4 gg = (f32x4){bflo(gq[q].x), bfhi(gq[q].x), bflo(gq[q].y), bfhi(gq[q].y)}; const f32x4 o = (d * rs * lg + lb + bq[q] * vv4) * gg;
            if (it < nit4) { u32x2 w_; w_.x = pk_bf16(o.x, o.y); w_.y = pk_bf16(o.z, o.w); *(GAS u32x2*)(XB + (size_t)row * 1024 + cofs) = w_; } }
    }
}

__device__ __forceinline__ void wkv2_phase(const GAS bf16_t* __restrict__ R, const GAS bf16_t* __restrict__ KR, const GAS bf16_t* __restrict__ WL, const GAS bf16_t* __restrict__ AL, const GAS bf16_t* __restrict__ V, const GAS bf16_t* __restrict__ VG,
                                           const GAS bf16_t* VFI, const GAS float* __restrict__ PRM, const GAS float* __restrict__ SIN, GAS bf16_t* __restrict__ Y, GAS float* __restrict__ P, GAS float* __restrict__ SOUT, GAS bf16_t* VFO, GAS float* __restrict__ BON,
                                           int has_vres, int B, int T, int DB, int DT, LAS unsigned char* lds, int tid, int bid, int nb) {
    constexpr int TB = 32, VECB = TB * 1280, VVB = TB * 128, BGO = VECB + 2 * VVB, BUF = BGO + TB * 8;
    const bool scanw = __builtin_amdgcn_readfirstlane(tid) < 256; const int pt = tid & 255;
    const int rowl = pt >> 4, part = pt & 15;
    const int nprompt = B * 32, nunits_all = nprompt + DB * 32, nunits = DT <= 4 ? nprompt : nunits_all;
    for (int u = bid; u < nunits; u += nb) {
        const bool smp = u >= nprompt; const int q0_ = smp ? u - nprompt : u; const int q = ((q0_ & 7) << 1 | ((q0_ >> 3) & 1)) + ((q0_ >> 4) << 4);
        const int half = q & 1, pair = q >> 1, sq = pair >> 4, h = pair & 15;
        const int Tu = smp ? DT : T; const int r0 = smp ? B * T + sq * DT : sq * T, vrow = half * 32 + rowl;
        const int srow = pt >> 3, sp8 = pt & 7;
        f32x2 S0 = (f32x2){0.f, 0.f}, S1 = (f32x2){0.f, 0.f}, S2 = (f32x2){0.f, 0.f}, S3 = (f32x2){0.f, 0.f}; float sa = 0.f;
        if (smp && scanw) { const GAS f32x4* sp_ = (const GAS f32x4*)(SIN + ((size_t)pair * 64 + half * 32 + srow) * 64 + sp8 * 8); const f32x4 sa4 = sp_[0], sb4 = sp_[1];
                   S0 = (f32x2){sa4.x, sa4.y}; S1 = (f32x2){sa4.z, sa4.w}; S2 = (f32x2){sb4.x, sb4.y}; S3 = (f32x2){sb4.z, sb4.w};
                   asm volatile("" : "+v"(S0), "+v"(S1), "+v"(S2), "+v"(S3));
                   { const u32x4 kw = *(const GAS u32x4*)(KR + (size_t)r0 * 1024 + h * 64 + sp8 * 8); const f32x4 q0 = *(const GAS f32x4*)(PRM + 3072 + h * 64 + sp8 * 8), q1 = *(const GAS f32x4*)(PRM + 3072 + h * 64 + sp8 * 8 + 4);
                     const float kv[8] = {bflo(kw[0]) * q0.x, bfhi(kw[0]) * q0.y, bflo(kw[1]) * q0.z, bfhi(kw[1]) * q0.w, bflo(kw[2]) * q1.x, bfhi(kw[2]) * q1.y, bflo(kw[3]) * q1.z, bfhi(kw[3]) * q1.w}; float ss = 0.f, sd = 0.f; const float sv[8] = {S0.x, S0.y, S1.x, S1.y, S2.x, S2.y, S3.x, S3.y};
                     _Pragma("unroll") for (int i = 0; i < 8; ++i) { ss = fmaf(kv[i], kv[i], ss); sd = fmaf(sv[i], kv[i], sd); }
                     sa = -row_sum8(sd) * frcp(fmaxf(fsqrt(row_sum8(ss)), 1e-12f)); } }
        const int nblk = (Tu + TB - 1) / TB;
        u32x2 lk0, lw0, la0, lr0, lk1, lw1, la1, lr1, ln0, ln1, lv, lg = (u32x2){0u, 0u}, lf = (u32x2){0u, 0u};
        const size_t eo_ = (size_t)(r0 + (pt >> 4)) * 1024 + h * 64 + part * 4, ev_ = (size_t)(r0 + (pt >> 3)) * 1024 + h * 64 + half * 32 + (pt & 7) * 4;
        const int lo_ = ((pt >> 4) * 320 + part * 4) * 4, lv_ = VECB + pt * 16;
        const int pc_ = h * 64 + part * 4; const f32x4 w0v = *(const GAS f32x4*)(PRM + pc_), a0v = *(const GAS f32x4*)(PRM + 1024 + pc_), kkp = *(const GAS f32x4*)(PRM + 3072 + pc_), kap = *(const GAS f32x4*)(PRM + 4096 + pc_), rkp = *(const GAS f32x4*)(PRM + 5120 + pc_);
        const f32x4 v0v = *(const GAS f32x4*)(PRM + 2048 + h * 64 + half * 32 + (pt & 7) * 4);
#define WKV_LOAD(tb0) do { const size_t bo_ = (size_t)(tb0) * 1024, b1_ = bo_ + 16 * 1024; lk0 = *(const GAS u32x2*)(KR + eo_ + bo_); lw0 = *(const GAS u32x2*)(WL + eo_ + bo_); la0 = *(const GAS u32x2*)(AL + eo_ + bo_); lr0 = *(const GAS u32x2*)(R + eo_ + bo_); \
            ln0 = *(const GAS u32x2*)(KR + eo_ + bo_ + 1024); ln1 = *(const GAS u32x2*)(KR + eo_ + b1_ + 1024); lk1 = *(const GAS u32x2*)(KR + eo_ + b1_); lw1 = *(const GAS u32x2*)(WL + eo_ + b1_); la1 = *(const GAS u32x2*)(AL + eo_ + b1_); lr1 = *(const GAS u32x2*)(R + eo_ + b1_); \
            lv = *(const GAS u32x2*)(V + ev_ + bo_); if (has_vres) { lg = *(const GAS u32x2*)(VG + ev_ + bo_); lf = *(const GAS u32x2*)(VFI + ev_ + bo_); } } while (0)
#define WKV_UNPK(w_) ((f32x4){bflo((w_).x), bfhi((w_).x), bflo((w_).y), bfhi((w_).y)})
#define WKV_ITEM(bufp, tb0, lk, lw, la, lr, ln, ti_) do { const f32x4 k4 = WKV_UNPK(lk), wl4 = WKV_UNPK(lw), al4 = WKV_UNPK(la); const f32x4 kv = k4 * kkp; const float ss = row_sum16((kv.x * kv.x + kv.y * kv.y) + (kv.z * kv.z + kv.w * kv.w)); \
            const f32x4 kn = WKV_UNPK(ln) * kkp; const float sn = row_sum16((kn.x * kn.x + kn.y * kn.y) + (kn.z * kn.z + kn.w * kn.w)); const f32x4 nn = kn * (-frcp(fmaxf(fsqrt(sn), 1e-12f)));     \
            const float inv = frcp(fmaxf(fsqrt(ss), 1e-12f)); \
            f32x4 dec, a4; _Pragma("unroll") for (int i_ = 0; i_ < 4; ++i_) { dec[i_] = __expf(-0.6065306597126334f * frcp(1.f + __expf(-(w0v[i_] + wl4[i_])))); a4[i_] = frcp(1.f + __expf(-(a0v[i_] + al4[i_]))); } \
            const f32x4 kk = kv * inv; const f32x4 k2 = k4 * ((a4 - 1.f) * kap + 1.f); const f32x4 r4 = WKV_UNPK(lr); const f32x4 rk = r4 * k2 * rkp; const float bon = row_sum16((rk.x + rk.y) + (rk.z + rk.w)); \
            const f32x4 bq = kk * a4, bn = bq * nn, kn2 = k2 * nn; const float be_ = row_sum16((bn.x + bn.y) + (bn.z + bn.w)), ga_ = row_sum16((kn2.x + kn2.y) + (kn2.z + kn2.w)); \
            if (part == 0) *(LAS f32x2*)((bufp) + BGO + ((pt >> 4) + (ti_)) * 8) = (f32x2){be_, ga_}; \
            LAS unsigned char* d_ = (bufp) + lo_ + (ti_) * 1280; *(LAS f32x4*)(d_) = dec; *(LAS f32x4*)(d_ + 256) = dec * nn; *(LAS f32x4*)(d_ + 512) = bq; *(LAS f32x4*)(d_ + 768) = k2; *(LAS f32x4*)(d_ + 1024) = r4; \
            const int tr_ = (tb0) + (pt >> 4) + (ti_); if (half == 0 && part == 0 && tr_ < Tu) BON[(size_t)(r0 + tr_) * 16 + h] = bon; } while (0)
#define WKV_STORE(bufp, tb0) do { WKV_ITEM(bufp, tb0, lk0, lw0, la0, lr0, ln0, 0); if ((tb0) + 16 < Tu) WKV_ITEM(bufp, tb0, lk1, lw1, la1, lr1, ln1, 16); \
            f32x4 v4 = WKV_UNPK(lv); if (has_vres) { const f32x4 g4 = WKV_UNPK(lg), f4 = WKV_UNPK(lf); _Pragma("unroll") for (int i_ = 0; i_ < 4; ++i_) v4[i_] = v4[i_] + (f4[i_] - v4[i_]) * frcp(1.f + __expf(-(v0v[i_] + g4[i_]))); } \
            *(LAS f32x4*)((bufp) + lv_) = v4; const int tv_ = (tb0) + (pt >> 3); if (tv_ < Tu) { u32x2 w_; w_.x = pk_bf16(v4.x, v4.y); w_.y = pk_bf16(v4.z, v4.w); *(GAS u32x2*)(VFO + ev_ + (size_t)(tb0) * 1024) = w_; } } while (0)
#define WKV_YOUT(bufp, tb0, ntp) do { const LAS float* yb_ = (const LAS float*)((bufp) + VECB + VVB); const int rl = (pt & 15) * 2; _Pragma("unroll") for (int t = pt >> 4; t < TB; t += 16) if (t < (ntp)) { const f32x2 y2 = *(const LAS f32x2*)(yb_ + t * 32 + rl); \
            *(GAS unsigned*)(Y + (size_t)(r0 + (tb0) + t) * 1024 + h * 64 + half * 32 + rl) = pk_bf16(y2.x, y2.y); } } while (0)
        if (!scanw) { WKV_LOAD(0); WKV_STORE(lds, 0); if (nblk > 1) WKV_LOAD(TB); }
        __syncthreads();
        for (int b = 0; b < nblk; ++b) {
            LAS unsigned char* cur = lds + (b & 1) * BUF; LAS unsigned char* nxt = lds + ((b + 1) & 1) * BUF; const int tb0 = b * TB; const int nt = (Tu - tb0) < TB ? (Tu - tb0) : TB;
            if (scanw) {
                const LAS float* vec = (const LAS float*)cur + sp8 * 8; const LAS float* vv = (const LAS float*)(cur + VECB) + srow; LAS float* yb = (LAS float*)(cur + VECB + VVB);
                LAS float* ybl = yb + srow;
                struct StepV { f32x4 w0, w1, n0, n1, b0, b1, k0, k1, r0, r1; float v; f32x2 bg; };
                const LAS unsigned char* bgp = cur + BGO;
#define WKV_RD(dst, t) do { const LAS f32x4* vp_ = (const LAS f32x4*)(vec + (t) * 320); dst.w0 = vp_[0]; dst.w1 = vp_[1]; dst.n0 = vp_[16]; dst.n1 = vp_[17]; dst.b0 = vp_[32]; dst.b1 = vp_[33]; \
                dst.k0 = vp_[48]; dst.k1 = vp_[49]; dst.r0 = vp_[64]; dst.r1 = vp_[65]; dst.v = vv[(t) * 32]; dst.bg = *(const LAS f32x2*)(bgp + (t) * 8); } while (0)
#define WKV_LO(q_) ((f32x2){(q_).x, (q_).y})
#define WKV_HI(q_) ((f32x2){(q_).z, (q_).w})
#define WKV_UPD(S, w_, b_, k_) S = __builtin_elementwise_fma(S, w_, __builtin_elementwise_fma(b_, sa2, (k_) * v2))
#define WKV_CMP(src, t_) do { const f32x2 spa = __builtin_elementwise_fma(S1, WKV_HI(src.n0), S0 * WKV_LO(src.n0)), spb = __builtin_elementwise_fma(S3, WKV_HI(src.n1), S2 * WKV_LO(src.n1)); const f32x2 sp = spa + spb; \
                const float pr_ = row_sum8(sp.x + sp.y); const f32x2 sa2 = (f32x2){sa, sa}, v2 = (f32x2){src.v, src.v};     \
                WKV_UPD(S0, WKV_LO(src.w0), WKV_LO(src.b0), WKV_LO(src.k0)); WKV_UPD(S1, WKV_HI(src.w0), WKV_HI(src.b0), WKV_HI(src.k0)); WKV_UPD(S2, WKV_LO(src.w1), WKV_LO(src.b1), WKV_LO(src.k1)); WKV_UPD(S3, WKV_HI(src.w1), WKV_HI(src.b1), WKV_HI(src.k1)); \
                const f32x2 ypa = __builtin_elementwise_fma(S1, WKV_HI(src.r0), S0 * WKV_LO(src.r0)), ypb = __builtin_elementwise_fma(S3, WKV_HI(src.r1), S2 * WKV_LO(src.r1)); const f32x2 yp = ypa + ypb; \
                ybl[(t_) * 32] = row_sum8(yp.x + yp.y); sa = fmaf(sa, src.bg.x, fmaf(src.v, src.bg.y, pr_)); } while (0)
#define WKV_ST(t_, cur_, nx2_) do { WKV_RD(nx2_, ((t_) + 2) & 31); __builtin_amdgcn_sched_barrier(0); WKV_CMP(cur_, t_); } while (0)
                if (nt == TB) {
                    StepV sA, sB, sC; WKV_RD(sA, 0); WKV_RD(sB, 1);
#pragma unroll 1
                    for (int t = 0; t < 30; t += 3) { WKV_ST(t, sA, sC); WKV_ST(t + 1, sB, sA); WKV_ST(t + 2, sC, sB); }
                    WKV_ST(30, sA, sC); WKV_ST(31, sB, sA);
                } else { StepV sA; for (int t = 0; t < nt; ++t) { WKV_RD(sA, t); WKV_CMP(sA, t); } }
#undef WKV_RD
#undef WKV_LO
#undef WKV_HI
#undef WKV_UPD
#undef WKV_CMP
#undef WKV_ST
            } else {
                if (b > 0) WKV_YOUT(nxt, tb0 - TB, TB);
                if (b + 1 < nblk) { WKV_STORE(nxt, tb0 + TB); if (b + 2 < nblk) WKV_LOAD(tb0 + 2 * TB); }
            }
            __syncthreads();
        }
        if (!scanw) { const int tbl = (nblk - 1) * TB; WKV_YOUT(lds + ((nblk - 1) & 1) * BUF, tbl, Tu - tbl); }
#undef WKV_LOAD
#undef WKV_STORE
#undef WKV_ITEM
#undef WKV_YOUT
#undef WKV_UNPK
        if (scanw) { GAS float* so = (smp ? SOUT : P) + ((size_t)pair * 64 + half * 32 + srow) * 64 + sp8 * 8; *(GAS f32x4*)so = (f32x4){S0.x, S0.y, S1.x, S1.y}; *(GAS f32x4*)(so + 4) = (f32x4){S2.x, S2.y, S3.x, S3.y}; }
        __syncthreads();
    }
    if (DT <= 4) {
        const int grp = __builtin_amdgcn_readfirstlane(tid) >> 8, t4 = tid & 255, srow = t4 >> 3, sp8 = t4 & 7;
        for (int u = nprompt + bid + nb * grp; u < nunits_all; u += nb * 2) {
            const int q0_ = u - nprompt; const int q = ((q0_ & 7) << 1 | ((q0_ >> 3) & 1)) + ((q0_ >> 4) << 4);
            const int half = q & 1, pair = q >> 1, sq = pair >> 4, h = pair & 15; const int r0 = B * T + sq * DT, vrow = half * 32 + srow;
            const size_t cb_ = (size_t)h * 64 + sp8 * 8, cv_ = (size_t)h * 64 + vrow;
            const GAS f32x4* sp_ = (const GAS f32x4*)(SIN + ((size_t)pair * 64 + vrow) * 64 + sp8 * 8); const f32x4 sa4 = sp_[0], sb4 = sp_[1];
            f32x4 pw0[2], pa0[2], pkk[2], pka[2], prk[2];
#pragma unroll
            for (int i = 0; i < 2; ++i) { pw0[i] = *(const GAS f32x4*)(PRM + cb_ + 4 * i); pa0[i] = *(const GAS f32x4*)(PRM + 1024 + cb_ + 4 * i); pkk[i] = *(const GAS f32x4*)(PRM + 3072 + cb_ + 4 * i); pka[i] = *(const GAS f32x4*)(PRM + 4096 + cb_ + 4 * i); prk[i] = *(const GAS f32x4*)(PRM + 5120 + cb_ + 4 * i); }
            const float v0c = PRM[2048 + cv_];
            u32x4 lk[4], lw[4], la[4], lr[4]; unsigned short lv[4], lg[4], lf[4];
#pragma unroll
            for (int t = 0; t < 4; ++t) { const int tt = t < DT ? t : DT - 1; const size_t ro = (size_t)(r0 + tt) * 1024; lk[t] = *(const GAS u32x4*)(KR + ro + cb_); lw[t] = *(const GAS u32x4*)(WL + ro + cb_); la[t] = *(const GAS u32x4*)(AL + ro + cb_); lr[t] = *(const GAS u32x4*)(R + ro + cb_);
                lv[t] = V[ro + cv_]; lg[t] = has_vres ? VG[ro + cv_] : (unsigned short)0; lf[t] = has_vres ? VFI[ro + cv_] : (unsigned short)0; }
            float S[8] = {sa4.x, sa4.y, sa4.z, sa4.w, sb4.x, sb4.y, sb4.z, sb4.w};
#pragma unroll
            for (int t = 0; t < 4; ++t) if (t < DT) {
                float k8[8], w8[8], a8[8], r8[8];
#pragma unroll
                for (int i = 0; i < 4; ++i) { k8[2 * i] = bflo(lk[t][i]); k8[2 * i + 1] = bfhi(lk[t][i]); w8[2 * i] = bflo(lw[t][i]); w8[2 * i + 1] = bfhi(lw[t][i]); a8[2 * i] = bflo(la[t][i]); a8[2 * i + 1] = bfhi(la[t][i]); r8[2 * i] = bflo(lr[t][i]); r8[2 * i + 1] = bfhi(lr[t][i]); }
                float kv[8], ss = 0.f;
#pragma unroll
                for (int i = 0; i < 8; ++i) { kv[i] = k8[i] * pkk[i >> 2][i & 3]; ss = fmaf(kv[i], kv[i], ss); }
                const float inv = frcp(fmaxf(fsqrt(row_sum8(ss)), 1e-12f));
                float dec[8], nn[8], bb[8], k2[8], bsum = 0.f, sdot = 0.f;
#pragma unroll
                for (int i = 0; i < 8; ++i) { dec[i] = __expf(-0.6065306597126334f * frcp(1.f + __expf(-(pw0[i >> 2][i & 3] + w8[i])))); const float av = frcp(1.f + __expf(-(pa0[i >> 2][i & 3] + a8[i]))); const float kk = kv[i] * inv;
                    nn[i] = -kk; bb[i] = kk * av; k2[i] = k8[i] * ((av - 1.f) * pka[i >> 2][i & 3] + 1.f); bsum = fmaf(r8[i] * k2[i], prk[i >> 2][i & 3], bsum); sdot = fmaf(S[i], nn[i], sdot); }
                const float bon = row_sum8(bsum), sa = row_sum8(sdot);
                float vv = __uint_as_float((unsigned)lv[t] << 16); if (has_vres) vv = vv + (__uint_as_float((unsigned)lf[t] << 16) - vv) * frcp(1.f + __expf(-(v0c + __uint_as_float((unsigned)lg[t] << 16))));
                float yd = 0.f;
#pragma unroll
                for (int i = 0; i < 8; ++i) { S[i] = fmaf(S[i], dec[i], fmaf(bb[i], sa, k2[i] * vv)); yd = fmaf(S[i], r8[i], yd); }
                const float y = row_sum8(yd); const size_t ro = (size_t)(r0 + t) * 1024;
                if (sp8 == 0) { Y[ro + cv_] = (bf16_t)(pk_bf16(y, 0.f) & 0xffffu); VFO[ro + cv_] = (bf16_t)(pk_bf16(vv, 0.f) & 0xffffu); if (vrow == 0) BON[(size_t)(r0 + t) * 16 + h] = bon; } }
            GAS float* so = SOUT + ((size_t)pair * 64 + vrow) * 64 + sp8 * 8; *(GAS f32x4*)so = (f32x4){S[0], S[1], S[2], S[3]}; *(GAS f32x4*)(so + 4) = (f32x4){S[4], S[5], S[6], S[7]};
        }
    }
}

__device__ __forceinline__ void gla_phase(const GAS float* __restrict__ PROJ, const GAS float* __restrict__ LOGA, GAS float* __restrict__ O, GAS float* __restrict__ P, int B, int T, LAS unsigned char* lds, int tid, int bid, int nb) {
    constexpr int TB = 32, OA = 0, OK = 8192, OQ = 16384, OV = 24576, BUF = 26624;
    const int wv = __builtin_amdgcn_readfirstlane(tid) >> 6; const bool scanw = wv < 4; const int pt = tid & 255, lane = tid & 63;
    const int col = pt >> 4, p = pt & 15, dk = p * 4;
    const int nunits = B * 32;
#define GLA_WAITV(n_) asm volatile("s_waitcnt vmcnt(" #n_ ")" ::: "memory")
#define GLA_BAR() do { asm volatile("s_waitcnt lgkmcnt(0)" ::: "memory"); __builtin_amdgcn_s_barrier(); asm volatile("" ::: "memory"); } while (0)
    for (int u = bid; u < nunits; u += nb) {
        const int ug_ = ((u & 7) << 3 | ((u >> 3) & 7)) + ((u >> 6) << 6);
        const int cb = ug_ & 7, pair = ug_ >> 3, s = pair >> 2, h = pair & 3; const int r0 = s * T;
        f32x2 S01 = (f32x2){0.f, 0.f}, S23 = (f32x2){0.f, 0.f};
        const int nblk = (T + TB - 1) / TB;
        const GAS unsigned char* gsrc; size_t gins, gblk; int ldst;
        if (wv == 4) { gsrc = (const GAS unsigned char*)(LOGA + (size_t)(r0 + (lane >> 4)) * 256 + h * 64 + (lane & 15) * 4); gins = (size_t)4 * 256 * 4; gblk = (size_t)TB * 256 * 4; ldst = OA; }
        else if (wv == 7) { gsrc = (const GAS unsigned char*)(PROJ + (size_t)(r0 + (lane >> 2)) * 2576 + 512 + h * 128 + cb * 16 + (lane & 3) * 4); gins = (size_t)16 * 2576 * 4; gblk = (size_t)TB * 2576 * 4; ldst = OV; }
        else { gsrc = (const GAS unsigned char*)(PROJ + (size_t)(r0 + (lane >> 4)) * 2576 + (wv == 5 ? 256 : 0) + h * 64 + (lane & 15) * 4); gins = (size_t)4 * 2576 * 4; gblk = (size_t)TB * 2576 * 4; ldst = wv == 5 ? OK : OQ; }
#define GLA_DMA(blk_) do { const GAS unsigned char* s_ = gsrc + (size_t)(blk_) * gblk; LAS unsigned char* d_ = lds + ((blk_) % 3) * BUF + ldst; \
            if (wv == 7) { __builtin_amdgcn_global_load_lds((const GAS unsigned*)s_, (LAS unsigned*)d_, 16, 0, 0); __builtin_amdgcn_global_load_lds((const GAS unsigned*)(s_ + gins), (LAS unsigned*)(d_ + 1024), 16, 0, 0); } \
            else { _Pragma("unroll") for (int i_ = 0; i_ < 8; ++i_) __builtin_amdgcn_global_load_lds((const GAS unsigned*)(s_ + i_ * gins), (LAS unsigned*)(d_ + i_ * 1024), 16, 0, 0); } } while (0)
        if (!scanw) { GLA_DMA(0); if (nblk > 1) { GLA_DMA(1); if (wv == 7) GLA_WAITV(2); else GLA_WAITV(8); } else GLA_WAITV(0); }
        GLA_BAR();
        for (int b = 0; b < nblk; ++b) {
            const int tb0 = b * TB; const int nt = (T - tb0) < TB ? (T - tb0) : TB;
            if (scanw) {
                const LAS unsigned char* cur = lds + (b % 3) * BUF; const LAS float* vec = (const LAS float*)cur + dk; const LAS float* vv = (const LAS float*)(cur + OV) + col;
                float okeep0 = 0.f, okeep1 = 0.f;
                struct G4 { f32x4 a[4], k[4], q[4]; float v[4]; };
#define GLA_RD4(dst, t0_) do { _Pragma("unroll") for (int i_ = 0; i_ < 4; ++i_) { const LAS float* vp_ = vec + ((t0_) + i_) * 64; dst.a[i_] = *(const LAS f32x4*)vp_; dst.k[i_] = *(const LAS f32x4*)(vp_ + OK / 4); dst.q[i_] = *(const LAS f32x4*)(vp_ + OQ / 4); dst.v[i_] = vv[((t0_) + i_) * 16]; } } while (0)
#define GLA_ONE(src, i_, keep, tl) do { const f32x4 a4 = src.a[i_], k4 = src.k[i_], q4 = src.q[i_]; const f32x2 v2 = (f32x2){src.v[i_], src.v[i_]}; \
                S01 = __builtin_elementwise_fma((f32x2){a4.x, a4.y}, S01, (f32x2){k4.x, k4.y} * v2); S23 = __builtin_elementwise_fma((f32x2){a4.z, a4.w}, S23, (f32x2){k4.z, k4.w} * v2); \
                const f32x2 o2 = __builtin_elementwise_fma((f32x2){q4.z, q4.w}, S23, (f32x2){q4.x, q4.y} * S01); const float o = row_sum16(o2.x + o2.y); keep = (p == (tl)) ? o : keep; } while (0)
#define GLA_CMP4(src, keep, tl0) do { GLA_ONE(src, 0, keep, tl0); GLA_ONE(src, 1, keep, (tl0) + 1); GLA_ONE(src, 2, keep, (tl0) + 2); GLA_ONE(src, 3, keep, (tl0) + 3); } while (0)
                if (nt == TB) {
                    G4 gA, gB; GLA_RD4(gA, 0);
                    GLA_RD4(gB, 4); __builtin_amdgcn_sched_barrier(0); GLA_CMP4(gA, okeep0, 0); GLA_RD4(gA, 8); __builtin_amdgcn_sched_barrier(0); GLA_CMP4(gB, okeep0, 4);
                    GLA_RD4(gB, 12); __builtin_amdgcn_sched_barrier(0); GLA_CMP4(gA, okeep0, 8); GLA_RD4(gA, 16); __builtin_amdgcn_sched_barrier(0); GLA_CMP4(gB, okeep0, 12);
                    GLA_RD4(gB, 20); __builtin_amdgcn_sched_barrier(0); GLA_CMP4(gA, okeep1, 0); GLA_RD4(gA, 24); __builtin_amdgcn_sched_barrier(0); GLA_CMP4(gB, okeep1, 4);
                    GLA_RD4(gB, 28); __builtin_amdgcn_sched_barrier(0); GLA_CMP4(gA, okeep1, 8); __builtin_amdgcn_sched_barrier(0); GLA_CMP4(gB, okeep1, 12);
                } else { G4 g1; for (int t = 0; t < nt; ++t) { const LAS float* vp_ = vec + t * 64; g1.a[0] = *(const LAS f32x4*)vp_; g1.k[0] = *(const LAS f32x4*)(vp_ + OK / 4); g1.q[0] = *(const LAS f32x4*)(vp_ + OQ / 4); g1.v[0] = vv[t * 16];
                    if (t < 16) GLA_ONE(g1, 0, okeep0, t); else GLA_ONE(g1, 0, okeep1, t - 16); } }
#undef GLA_RD4
#undef GLA_ONE
#undef GLA_CMP4
                { int pt_ = pt; asm volatile("" : "+v"(pt_)); const int p_ = pt_ & 15; GAS float* od = O + (size_t)(r0 + tb0 + p_) * 512 + h * 128 + cb * 16 + (pt_ >> 4);
                  if (p_ < nt) od[0] = okeep0 * 0.125f; if (16 + p_ < nt) od[(size_t)16 * 512] = okeep1 * 0.125f; }
            } else {
                if (b + 2 < nblk) { GLA_DMA(b + 2); if (wv == 7) GLA_WAITV(2); else GLA_WAITV(8); } else GLA_WAITV(0);
            }
            GLA_BAR();
        }
#undef GLA_DMA
        if (scanw) { int pt_ = pt; asm volatile("" : "+v"(pt_));
                     GAS float* so = P + ((size_t)pair * 64 + (pt_ & 15) * 4) * 128 + cb * 16 + (pt_ >> 4); so[0] = S01.x; so[128] = S01.y; so[256] = S23.x; so[384] = S23.y; }
        GLA_BAR();
    }
#undef GLA_WAITV
#undef GLA_BAR
}
__device__ __forceinline__ float grp8_sum(float v) { v += dppf<0xB1>(v); v += dppf<0x4E>(v); v += dppf<0x141>(v); return v; }
__device__ __forceinline__ float dot16_fp8_bf16(const u32x4 uw, const float (&x)[16]) { float s = 0.f;
#pragma unroll
    for (int d = 0; d < 4; ++d) { const f32x2 lo = fp8lo(uw[d]), hi = fp8hi(uw[d]); s = fmaf(lo.x, x[4 * d], s); s = fmaf(lo.y, x[4 * d + 1], s); s = fmaf(hi.x, x[4 * d + 2], s); s = fmaf(hi.y, x[4 * d + 3], s); }
    return s; }
typedef int i32x8 __attribute__((ext_vector_type(8)));
typedef unsigned u32x8 __attribute__((ext_vector_type(8)));
__device__ __forceinline__ void pacts_phase(const GAS unsigned char* XF8, const GAS unsigned char* U8S, const GAS int* EIDX, GAS bf16_t* __restrict__ PART, int M, int emask,
                                            LAS unsigned char* lds, int wid, int lane, int bid, int nb) {
    const bool spl = (nb & 7) == 0; const int s0 = spl ? (bid & 7) : 0, s1 = spl ? s0 + 1 : 8, r = spl ? (bid >> 3) : bid, nr = spl ? (nb >> 3) : nb;
    const int g = lane >> 3, c = lane & 7, fg = ((g >> 2) & 1) | (((g >> 1) & 1) << 2);
    const int m16 = lane & 15, kb = lane >> 4, fm = ((m16 >> 2) & 1) | (((m16 >> 1) & 1) << 2);
    LAS unsigned char* const wl = lds + wid * 16384;
    const LAS unsigned char* const ard = wl + m16 * 128 + (((2 * kb) ^ fm) * 16);
    const LAS unsigned char* const xrd = wl + 12288 + (m16 & 1) * 128 + kb * 32;
    const LAS unsigned char* const ird = wl + 13824 + g * 4;
    if (r >= M) return;
    const int ntok = (M - r + nr - 1) / nr;
#define PL_ROW(t_) ({ int rw_ = r + nr * (t_); rw_ < M ? rw_ : r; })
#define PL_IDS(t_, slot_) __builtin_amdgcn_global_load_lds((const GAS unsigned*)(isrc + (size_t)PL_ROW(t_) * 128), (LAS unsigned*)(wl + 13824 + (slot_) * 256), 4, 0, 0)
#define PL_RDIDS(slot_, e0_, e1_) do { e0_ = *(const LAS int*)(ird + (slot_) * 256); e1_ = *(const LAS int*)(ird + (slot_) * 256 + 32); } while (0)
#define PL_TILE(t_, slot_, e0_, e1_) do { \
        __builtin_amdgcn_global_load_lds((const GAS unsigned*)(tb + (size_t)((e0_) & emask) * 128), (LAS unsigned*)(wl + (slot_) * 2048), 16, 0, 0); \
        __builtin_amdgcn_global_load_lds((const GAS unsigned*)(tb + (size_t)((e1_) & emask) * 128), (LAS unsigned*)(wl + (slot_) * 2048 + 1024), 16, 0, 0); \
        __builtin_amdgcn_global_load_lds((const GAS unsigned*)(xsrc + (size_t)PL_ROW(t_) * 2048), (LAS unsigned*)(wl + 12288 + (slot_) * 256), 4, 0, 0); } while (0)
#define PL_RD(slot_, a0_, a1_, x0_, x1_) do { a0_ = *(const LAS u32x4*)(ard + (slot_) * 2048); a1_ = *(const LAS u32x4*)(ard2 + (slot_) * 2048); x0_ = *(const LAS u32x4*)(xrd + (slot_) * 256); x1_ = *(const LAS u32x4*)(xrd + (slot_) * 256 + 16); } while (0)
#define PL_MMA(cc_, a0_, a1_, x0_, x1_) do { const i32x8 av = (i32x8)__builtin_shufflevector(a0_, a1_, 0, 1, 2, 3, 4, 5, 6, 7), bv = (i32x8)__builtin_shufflevector(x0_, x1_, 0, 1, 2, 3, 4, 5, 6, 7); const f32x4 z = {0.f, 0.f, 0.f, 0.f}; \
        cc_ = __builtin_amdgcn_mfma_scale_f32_16x16x128_f8f6f4(av, bv, z, 0, 0, 0, 0, 0, 0); } while (0)
#define PL_OUT(t_, cc_) do { f32x4 o; _Pragma("unroll") for (int i = 0; i < 4; ++i) { float v = cc_[i]; v += dppf<0xB1>(v); o[i] = v * (1.f / 16.f); } \
        const int rw = r + nr * (t_); if (m16 == 0 && rw < M) { u32x2 w_; w_.x = pk_bf16(o[0], o[1]); w_.y = pk_bf16(o[2], o[3]); *(GAS u32x2*)(po + (size_t)rw * 128) = w_; } } while (0)
#define PL_WAIT(n_) asm volatile("s_waitcnt vmcnt(" #n_ ")" ::: "memory")
#define PL_STEP(j_, h_) do { PL_WAIT(12); u32x4 a0[3], a1[3], x0[3], x1[3]; int e0[3], e1[3]; f32x4 cc[3]; \
        _Pragma("unroll") for (int k = 0; k < 3; ++k) PL_RD((h_) * 3 + k, a0[k], a1[k], x0[k], x1[k]); \
        _Pragma("unroll") for (int k = 0; k < 3; ++k) PL_RDIDS((h_) * 3 + k, e0[k], e1[k]); \
        _Pragma("unroll") for (int k = 0; k < 3; ++k) PL_MMA(cc[k], a0[k], a1[k], x0[k], x1[k]); \
        _Pragma("unroll") for (int k = 0; k < 3; ++k) PL_TILE((j_) + 6 + k, (h_) * 3 + k, e0[k], e1[k]); \
        _Pragma("unroll") for (int k = 0; k < 3; ++k) PL_IDS((j_) + 12 + k, (h_) * 3 + k); \
        _Pragma("unroll") for (int k = 0; k < 3; ++k) PL_OUT((j_) + k, cc[k]); } while (0)
    const LAS unsigned char* const ard2 = (const LAS unsigned char*)((unsigned)(size_t)ard ^ 16u);
    for (int s = s0; s < s1; ++s) {
        const GAS unsigned char* tb = U8S + (size_t)s * 16384 * 128 + ((c ^ fg) * 16);
        const GAS unsigned char* xsrc = XF8 + (size_t)(lane >> 5) * 1024 + s * 128 + (lane & 31) * 4;
        const GAS int* isrc = EIDX + wid * 16 + m16;
        GAS bf16_t* po = PART + (size_t)s * M * 128 + wid * 16 + kb * 4;
        PL_IDS(0, 0); PL_IDS(1, 1); PL_IDS(2, 2); PL_IDS(3, 3); PL_IDS(4, 4); PL_IDS(5, 5); PL_WAIT(0);
        { int e0[6], e1[6];
#pragma unroll
          for (int k = 0; k < 6; ++k) PL_RDIDS(k, e0[k], e1[k]);
#pragma unroll
          for (int k = 0; k < 3; ++k) PL_TILE(k, k, e0[k], e1[k]);
#pragma unroll
          for (int k = 0; k < 3; ++k) PL_IDS(6 + k, k);
#pragma unroll
          for (int k = 3; k < 6; ++k) PL_TILE(k, k, e0[k], e1[k]);
#pragma unroll
          for (int k = 3; k < 6; ++k) PL_IDS(6 + k, k); }
        for (int j = 0; j < ntok; j += 6) { PL_STEP(j, 0); PL_STEP(j + 3, 1); }
        PL_WAIT(0);
    }
#undef PL_ROW
#undef PL_IDS
#undef PL_RDIDS
#undef PL_TILE
#undef PL_RD
#undef PL_MMA
#undef PL_OUT
#undef PL_WAIT
#undef PL_STEP
}
__device__ __forceinline__ void pouts_phase(const GAS float* __restrict__ COEF, const GAS int* __restrict__ EIDX, const GAS unsigned char* V8S, GAS bf16_t* __restrict__ YBUF, int M,
                                            int wid, int lane, int bid, int nb) {
    const bool spl = (nb & 7) == 0; const int s0 = spl ? (bid & 7) : 0, s1 = spl ? s0 + 1 : 8, r = spl ? (bid >> 3) : bid, nr = spl ? (nb >> 3) : nb;
    const int g = lane >> 3, ch = lane & 7, rstep = nr * 8;
#define PO_LOADCE(rw, c0, c1, v0, v1) do { c0 = COEF[(size_t)(rw) * 128 + lane] * (1.f / 64.f); c1 = COEF[(size_t)(rw) * 128 + 64 + lane] * (1.f / 64.f); v0 = EIDX[(size_t)(rw) * 128 + lane]; v1 = EIDX[(size_t)(rw) * 128 + 64 + lane]; } while (0)
#define PO_GATHER(vv_, vreg) do { _Pragma("unroll") for (int k = 0; k < 8; ++k) { const int e = __builtin_amdgcn_ds_bpermute((8 * k + g) << 2, vreg); vv_[k] = *(const GAS u32x4*)(tbs + (unsigned)((e << 7) + cho)); } } while (0)
#define PO_COMP(vv_, creg) do { _Pragma("unroll") for (int k = 0; k < 8; ++k) { const float c = __int_as_float(__builtin_amdgcn_ds_bpermute((8 * k + g) << 2, __float_as_int(creg))); const u32x4 w = vv_[k]; \
        const f32x2 c2 = (f32x2){c, c}; _Pragma("unroll") for (int d = 0; d < 4; ++d) { ac2[2 * d] = __builtin_elementwise_fma(c2, fp8lo(w[d]), ac2[2 * d]); ac2[2 * d + 1] = __builtin_elementwise_fma(c2, fp8hi(w[d]), ac2[2 * d + 1]); } \
        _Pragma("unroll") for (int i = 0; i < 8; ++i) asm volatile("" : "+v"(ac2[i])); } } while (0)
    for (int s = s0; s < s1; ++s) {
        const GAS unsigned char* tbs = V8S + (size_t)s * 16384 * 128; const int cho = ch * 16;
        int row = r + nr * wid; if (row >= M) continue;
        float c0c, c1c, c0n = 0.f, c1n = 0.f; int v0c, v1c, v0n = 0, v1n = 0;
        PO_LOADCE(row, c0c, c1c, v0c, v1c);
        u32x4 va[8], vb[8];
        PO_GATHER(va, v0c);
        for (;;) {
            const int rown = row + rstep; const bool hasn = rown < M;
            PO_GATHER(vb, v1c);
            if (hasn) PO_LOADCE(rown, c0n, c1n, v0n, v1n);
            f32x2 ac2[8];
#pragma unroll
            for (int i = 0; i < 8; ++i) ac2[i] = (f32x2){0.f, 0.f};
            PO_COMP(va, c0c);
            if (hasn) PO_GATHER(va, v0n);
            PO_COMP(vb, c1c);
            float acc[16];
#pragma unroll
            for (int i = 0; i < 8; ++i) { acc[2 * i] = ac2[i].x; acc[2 * i + 1] = ac2[i].y; }
#pragma unroll
            for (int i = 0; i < 16; ++i) acc[i] += dppf<0x128>(acc[i]);
#pragma unroll
            for (int i = 0; i < 8; ++i) { const u32x2 sw = __builtin_amdgcn_permlane16_swap(__float_as_uint(acc[i]), __float_as_uint(acc[i + 8]), false, false); acc[i] = __uint_as_float(sw.x) + __uint_as_float(sw.y); }
#pragma unroll
            for (int i = 0; i < 4; ++i) { const u32x2 sw = __builtin_amdgcn_permlane32_swap(__float_as_uint(acc[i]), __float_as_uint(acc[i + 4]), false, false); acc[i] = __uint_as_float(sw.x) + __uint_as_float(sw.y); }
            if ((lane & 8) == 0) { u32x2 w_; w_.x = pk_bf16(acc[0], acc[1]); w_.y = pk_bf16(acc[2], acc[3]); *(GAS u32x2*)(YBUF + (size_t)row * 1024 + s * 128 + ch * 16 + ((lane >> 4) & 1) * 8 + ((lane >> 5) & 1) * 4) = w_; }
            if (!hasn) break;
            row = rown; c0c = c0n; c1c = c1n; v0c = v0n; v1c = v1n;
        }
    }
#undef PO_LOADCE
#undef PO_GATHER
#undef PO_COMP
}
}

template <class T> __device__ __forceinline__ __attribute__((address_space(1))) T* gp(T* p) { return (__attribute__((address_space(1))) T*)uni_ptr(p); }
constexpr int MK_THREADS = 512, LDS_BYTES = 163840, LDSCTL_OFF = 131072, TAB_OFF = LDSCTL_OFF + 1024, MAX_OPS = 208;
static_assert(TAB_OFF + MAX_OPS * (int)sizeof(Op) <= LDS_BYTES, "LDS map");
constexpr int MPAD = 17152;
constexpr size_t CTL_BYTES = (size_t)1 << 20;
struct MArgs { const float* in[47]; float* out; char* ws; unsigned long long ws_size; };
__global__ void __launch_bounds__(MK_THREADS, 2) mega_fwd(MArgs a) {
    extern __shared__ __attribute__((aligned(16))) unsigned char lds[];
    volatile LAS unsigned* ctl = (volatile LAS unsigned*)((LAS unsigned char*)lds + LDSCTL_OFF);
    if (threadIdx.x < 64) ctl[threadIdx.x] = 0u;
    __syncthreads();
    (void)xcd_barrier_post((unsigned*)a.ws, ctl + 8);
    const Dm dm = make_dm(1024, 8, 2048, 128, 4);
    Op* tab = (Op*)(lds + TAB_OFF);
    if (threadIdx.x == 0) {
        const float* const* inp_ = (const float* const*)__builtin_amdgcn_kernarg_segment_ptr(); asm volatile("" : "+s"(inp_));
        NvIO io; io.in = inp_; io.out = a.out; io.ws = a.ws + CTL_BYTES; io.ws_size = a.ws_size - CTL_BYTES;
        int n = 0;
        #ifdef PROBE_DUPCODE
        nv_forward(io, dm, [&](const Op& o) __attribute__((always_inline)) { if (n < MAX_OPS) tab[n] = o; ++n; if ((o.code & 0xff) == PROBE_DUPCODE) { if (n < MAX_OPS) tab[n] = o; ++n; } asm volatile("" ::: "memory"); });
#else
        nv_forward(io, dm, [&](const Op& o) __attribute__((always_inline)) { if (n < MAX_OPS) tab[n] = o; ++n; asm volatile("" ::: "memory"); });
#endif
        ctl[16] = (unsigned)(n <= MAX_OPS ? n : 0);
    }
    __syncthreads();
    const int nops = (int)ctl[16];
    for (int i = 0; i < nops; ++i) {
        int tid_ = (int)threadIdx.x, bid_ = (int)blockIdx.x, nb_ = (int)gridDim.x;
        asm volatile("" : "+v"(tid_)); asm volatile("" : "+s"(bid_)); asm volatile("" : "+s"(nb_));
        const long long g0 = (long long)bid_ * MK_THREADS + tid_, gs = (long long)nb_ * MK_THREADS;
        const Op& o = tab[i];
        const int rawc = __builtin_amdgcn_readfirstlane(o.code); const int code = rawc & 0xff; const long long n = o.n;
        switch (code) {
        case OP_FGEMM: {
            const int fl = rfl(o.i6);
            pg8::Gemm g{uni_ptr((const pg8::bf16_t*)o.a), uni_ptr((const pg8::bf16_t*)o.b), MPAD, rfl(o.i5), rfl(o.i1), rfl(o.i2), rfl(o.i3)};
            if (rawc & OPF_GROUP) {
                int ng = 1; while (ng < 8 && (rfl(tab[i + ng - 1].code) & OPF_GROUP)) ++ng;
                const PG8_LAS Op* gt = (const PG8_LAS Op*)((PG8_LAS unsigned char*)lds + TAB_OFF) + i;
                pg8::GroupOrder S; S.tab = gt; S.ng = ng; S.nM = MPAD / 256; S.G = nb_; S.c = bid_; S.tsA = (size_t)256 * g.lda * 2; S.tsB = (size_t)256 * g.ldb * 2;
                pg8::EpiGroup E{gt, dm.M};
                pg8::gemm_phase<pg8::EpiGroup, pg8::GroupOrder, true, true>((PG8_LAS unsigned char*)lds, g, S, E);
                i += ng - 1;
            } else {
            pg8::StaticOrder S; S.init(g, nb_, bid_); if (fl & 2) S.acs = 512;
            float* const c0 = uni_ptr(o.o0); const int ldc0 = rfl(o.i4), nreal0 = rfl(o.i0);
            if (fl & 1) { pg8::EpiBf16Plain E{(pg8::bf16_t*)c0, ldc0}; pg8::gemm_phase<pg8::EpiBf16Plain, pg8::StaticOrder, true, true>((PG8_LAS unsigned char*)lds, g, S, E); }
            else { pg8::EpiF32 E{c0, ldc0, dm.M, nreal0}; pg8::gemm_phase<pg8::EpiF32, pg8::StaticOrder, true, true>((PG8_LAS unsigned char*)lds, g, S, E); }
            }
        } break;
        case OP_LRUG2: {
            int kw_ = 128; asm volatile("" : "+s"(kw_));
            pg8::Gemm g{uni_ptr((const pg8::bf16_t*)o.a), uni_ptr((const pg8::bf16_t*)o.b), MPAD, 1024, kw_, 512, 512};
            pg8::StaticOrder S; S.init(g, nb_, bid_); S.acs = 256; S.tsB += 256;
            pg8::EpiLru E{uni_ptr(o.c), uni_ptr(o.d), uni_ptr(o.e), uni_ptr((const pg8::bf16_t*)o.f), uni_ptr(o.o0), uni_ptr(o.o1), dm.M};
            pg8::gemm_phase<pg8::EpiLru, pg8::StaticOrder, true, true>((PG8_LAS unsigned char*)lds, g, S, E);
        } break;
        case OP_WKVP: fk::wkv2_phase(gp((const fk::bf16_t*)o.a), gp((const fk::bf16_t*)o.b), gp((const fk::bf16_t*)o.c), gp((const fk::bf16_t*)o.d), gp((const fk::bf16_t*)o.e), gp((const fk::bf16_t*)o.f), gp((const fk::bf16_t*)o.g), gp(o.h), gp((const float*)o.o5), gp((fk::bf16_t*)o.o0), gp(o.o1), gp(o.o2), gp((fk::bf16_t*)o.o3), gp(o.o4), rfl(o.i0), dm.B, dm.T, dm.DB, dm.DT, (LAS unsigned char*)lds, tid_, bid_, nb_); break;
        case OP_POST2: fk::rwkvpost2_phase(gp((const fk::bf16_t*)o.a), gp((const fk::bf16_t*)o.b), gp((const fk::bf16_t*)o.c), gp(o.d), gp(o.e), gp(o.f), gp((fk::bf16_t*)o.o0), dm.M * 16, tid_ & 63, bid_ * 8 + (tid_ >> 6), nb_ * 8); break;
        case OP_GLAF: fk::gla_phase(gp(o.a), gp(o.b), gp(o.o0), gp(o.o1), dm.B, dm.T, (LAS unsigned char*)lds, tid_, bid_, nb_); break;
        case OP_PACTS: fk::pacts_phase(gp((const unsigned char*)o.a), gp((const unsigned char*)o.b), gp((const int*)o.d), gp((fk::bf16_t*)o.o0), dm.M, rfl(o.i0), (LAS unsigned char*)lds, rfl(tid_ >> 6), tid_ & 63, bid_, nb_); break;
        case OP_POUTS: fk::pouts_phase(gp(o.a), gp((const int*)o.b), gp((const unsigned char*)o.c), gp((fk::bf16_t*)o.o0), dm.M, tid_ >> 6, tid_ & 63, bid_, nb_); break;
        case OP_TOPK2: fk::topk_phase(gp((const fk::bf16_t*)o.a), gp((const fk::bf16_t*)o.b), gp(o.c), gp(o.o0), gp((int*)o.o1), dm.M * 8, (LAS unsigned char*)lds, tid_ >> 6, tid_ & 63, bid_ * 8 + (tid_ >> 6), nb_ * 8); break;
        case OP_LNRES: fk::lnres_phase(gp((const fk::bf16_t*)o.a), gp(o.b), gp(o.c), gp(o.o0), gp((fk::bf16_t*)o.o1), gp((unsigned char*)o.o2), gp(o.o3), dm.B, dm.T, dm.M, tid_ & 63, bid_ * 8 + (tid_ >> 6), nb_ * 8); break;
        case OP_GLANORM: fk::glanorm_phase(gp(o.a), gp(o.b), gp(o.c), gp((fk::bf16_t*)o.o0), dm.M * 4, tid_ & 63, bid_ * 8 + (tid_ >> 6), nb_ * 8); break;
        case OP_CVTTAB8S: {
            int X = rfl(o.i6) % nb_; X = (2 * X <= nb_) ? 2 * X : X; X = (X < nb_ - 1) ? X : 0;
            if (bid_ >= X) { const long long gs2 = (long long)(nb_ - X) * MK_THREADS; for (long long g = (long long)(bid_ - X) * MK_THREADS + tid_; g < n; g += gs2) nv_elem(OP_CVTTAB8S, o, dm, g); } } break;
        case OP_GLA3: { const int rb = (bid_ + (nb_ >> 1)) % nb_;
            for (long long g = (long long)rb * MK_THREADS + tid_; g < n; g += gs) nv_elem(OP_GLA3, o, dm, g); } break;
#define NVC(c) case c: for (long long g = g0; g < n; g += gs) nv_elem(c, o, dm, g); break;
        NVC(OP_LOGA4) NVC(OP_CONVOUT) NVC(OP_SHIFTOUT) NVC(OP_EMBED4) NVC(OP_MIX6) NVC(OP_CONV4) NVC(OP_CVT8) NVC(OP_WGATE)
        NVC(OP_WT) NVC(OP_PRED) NVC(OP_PRM) NVC(OP_KEYS) NVC(OP_LRU1) NVC(OP_LRU3)
#undef NVC
        default: break;
        }
        if (__builtin_amdgcn_readfirstlane(tab[i].code) & OPF_NOBAR) __syncthreads(); else { XcdBarrier bar; bar.bar = (unsigned*)a.ws; bar.x = xb_xcc_id(); bar.st = ctl + 8; xcd_barrier(bar); }
    }
}
extern "C" void kernel_launch(void* const* d_in, const int* in_sizes, int n_in, void* d_out, int out_size, void* d_ws, size_t ws_size, hipStream_t stream) {
    static int grid = 0;
    if (grid == 0) {
        if (n_in != 47 || ws_size < ((size_t)900 << 20)) { fprintf(stderr, "kernel_launch: expected 47 inputs and >= 900 MiB of workspace; got %d, %zu\n", n_in, ws_size); grid = -1; return; }
        int dev = 0, cus = 0, per_cu = 0;
        if (hipGetDevice(&dev) != hipSuccess || hipDeviceGetAttribute(&cus, hipDeviceAttributeMultiprocessorCount, dev) != hipSuccess) { grid = -1; return; }
        if (hipFuncSetAttribute((const void*)mega_fwd, hipFuncAttributeMaxDynamicSharedMemorySize, LDS_BYTES) != hipSuccess) { fprintf(stderr, "kernel_launch: hipFuncSetAttribute failed\n"); grid = -1; return; }
        if (hipOccupancyMaxActiveBlocksPerMultiprocessor(&per_cu, (const void*)mega_fwd, MK_THREADS, LDS_BYTES) != hipSuccess || per_cu < 1) fprintf(stderr, "kernel_launch: occupancy query says %d per CU\n", per_cu);
        (void)hipGetLastError();
        grid = cus;
    }
    if (grid < 0) return;
    if (hipMemsetAsync(d_ws, 0, CTL_BYTES, stream) != hipSuccess) { fprintf(stderr, "kernel_launch: memset failed\n"); return; }
    MArgs a{}; for (int i = 0; i < 47; ++i) a.in[i] = (const float*)d_in[i]; a.out = (float*)d_out; a.ws = (char*)d_ws; a.ws_size = (unsigned long long)ws_size;
    hipLaunchKernelGGL(mega_fwd, dim3(grid), dim3(MK_THREADS), LDS_BYTES, stream, a);
}
```
